# Optimizing an MI355X kernel written in HIP

```python
import math
import jax
import jax.numpy as jnp
from jax import lax
import numpy as np

D_MODEL = 4096
BATCH = 2
SEQ = 8192
DEPTH = 2

D_MIX = D_MODEL
GROUP = D_MIX // 4
DIFF_HEADS = 8
DIFF_HD = GROUP // DIFF_HEADS
DIFF_QK = DIFF_HD // 2
GLA_HEADS = 4
GLA_DV = GROUP // GLA_HEADS
GLA_DK = GLA_DV // 2
GLA_RANK = 16
GLA_NORMALIZER = 16.0
GLA_CHUNK = 64
RWKV_HD = 64
RWKV_HEADS = GROUP // RWKV_HD
RWKV_W_RANK = 64
RWKV_A_RANK = 64
RWKV_G_RANK = 64
RWKV_V_RANK = 32
RWKV_LN_EPS = 64e-5
SWA_HD = 64
SWA_HEADS = GROUP // SWA_HD
SWA_KV_HEADS = 2
SWA_WINDOW = 128
SWA_BLOCK = 128
REL_BUCKETS = 32
REL_MAX_DIST = 128
REL_HEADS = DIFF_HEADS + SWA_HEADS
ATTN_BLOCK = 128
D_FF = -(-8 * D_MODEL // (3 * 256)) * 256
NORM_EPS = 1e-6
NEG_INF = -1e30
DIFF_COLS = 3 * GROUP
GLA_COLS = 2 * GLA_HEADS * GLA_DK + 2 * GROUP + GLA_RANK
RWKV_COLS = 3 * GROUP + RWKV_W_RANK + RWKV_A_RANK + RWKV_G_RANK
SWA_COLS = GROUP + 2 * SWA_KV_HEADS * SWA_HD
P_IN = DIFF_COLS + GLA_COLS + RWKV_COLS + SWA_COLS

kernel_name = "hybrid_parallel_heads_diff_gla_rwkv7_swa"


def _rms(t, eps=NORM_EPS):
    tf = t.astype(jnp.float32)
    return (tf * lax.rsqrt(jnp.mean(tf * tf, axis=-1, keepdims=True) + eps)).astype(t.dtype)


def _t5_bucket(dist):
    max_exact = REL_BUCKETS // 2
    n = jnp.maximum(dist, 0)
    nf = jnp.maximum(n, 1).astype(jnp.float32)
    large = max_exact + (jnp.log(nf / max_exact) / math.log(REL_MAX_DIST / max_exact)
                         * (REL_BUCKETS - max_exact)).astype(jnp.int32)
    large = jnp.minimum(large, REL_BUCKETS - 1)
    return jnp.where(n < max_exact, n, large)


def _token_shift(t, mu):
    prev = jnp.pad(t, ((0, 0), (1, 0), (0, 0)))[:, :-1]
    return t + (prev - t) * mu


def _diff_attention(cols, layer_idx, q_gain, k_gain, lam, subln, bias_tab):
    bsz, seq, _ = cols.shape
    q, k, v = jnp.split(cols, [GROUP, 2 * GROUP], axis=-1)
    q = _rms(q.reshape(bsz, seq, DIFF_HEADS, 2, DIFF_QK)) * q_gain
    k = _rms(k.reshape(bsz, seq, DIFF_HEADS, 2, DIFF_QK)) * k_gain
    v = v.reshape(bsz, seq, DIFF_HEADS, DIFF_HD)
    lam_init = 0.8 - 0.6 * math.exp(-0.3 * layer_idx)
    lam = lam.astype(jnp.float32)
    lam_full = jnp.exp(jnp.sum(lam[0] * lam[1])) - jnp.exp(jnp.sum(lam[2] * lam[3])) + lam_init
    n_blk = seq // ATTN_BLOCK
    q_blocks = q.reshape(bsz, n_blk, ATTN_BLOCK, DIFF_HEADS, 2, DIFF_QK).transpose(1, 0, 2, 3, 4, 5)
    k_pos = jnp.arange(seq)
    scale = DIFF_QK ** -0.5

    def one_block(args):
        q_i, i = args
        s = jnp.einsum("bqhpd,bkhpd->bphqk", q_i, k).astype(jnp.float32) * scale
        dist = (i * ATTN_BLOCK + jnp.arange(ATTN_BLOCK))[:, None] - k_pos[None, :]
        bias = bias_tab[_t5_bucket(dist)].astype(jnp.float32).transpose(2, 0, 1)
        s = jnp.where(dist >= 0, s + bias, NEG_INF)
        p = jax.nn.softmax(s, axis=-1)
        attn = p[:, 0] - lam_full * p[:, 1]
        return jnp.einsum("bhqk,bkhd->bqhd", attn.astype(v.dtype), v)

    o = lax.map(one_block, (q_blocks, jnp.arange(n_blk)))
    o = o.transpose(1, 0, 2, 3, 4).reshape(bsz, seq, DIFF_HEADS, DIFF_HD)
    o = _rms(o) * subln * (1.0 - lam_init)
    return o.reshape(bsz, seq, GROUP)


def _gla(cols, gate_up, gate_bias, out_gain):
    bsz, seq, _ = cols.shape
    f32 = jnp.float32
    kd = GLA_HEADS * GLA_DK
    q, k, v, g, gd = jnp.split(cols, np.cumsum([kd, kd, GROUP, GROUP]).tolist(), axis=-1)
    log_a = jax.nn.log_sigmoid((gd @ gate_up + gate_bias).astype(f32)) / GLA_NORMALIZER
    n = seq // GLA_CHUNK

    def heads(t, d):
        return (t.astype(f32).reshape(bsz, seq, GLA_HEADS, d).transpose(0, 2, 1, 3)
                .reshape(bsz, GLA_HEADS, n, GLA_CHUNK, d))

    q = heads(q, GLA_DK) * GLA_DK ** -0.5
    k = heads(k, GLA_DK)
    v = heads(v, GLA_DV)
    b = jnp.cumsum(heads(log_a, GLA_DK), axis=3)
    b_last = b[:, :, :, -1:]
    q_dec = q * jnp.exp(b)
    causal = jnp.tril(jnp.ones((GLA_CHUNK, GLA_CHUNK), dtype=bool))
    a_intra = jnp.where(causal, jnp.einsum("bhncd,bhnsd->bhncs", q_dec, k * jnp.exp(-b)), 0.0)
    o = jnp.einsum("bhncs,bhnsv->bhncv", a_intra, v)
    upd = jnp.einsum("bhnsd,bhnsv->bhndv", k * jnp.exp(b_last - b), v)
    chunk_decay = jnp.exp(b_last[:, :, :, 0])

    def step(state, inp):
        dec, u = inp
        return dec[..., None] * state + u, state

    _, s_prev = lax.scan(step, jnp.zeros((bsz, GLA_HEADS, GLA_DK, GLA_DV), f32),
                         (jnp.moveaxis(chunk_decay, 2, 0), jnp.moveaxis(upd, 2, 0)))
    s_prev = jnp.moveaxis(s_prev, 0, 2)
    o = o + jnp.einsum("bhncd,bhndv->bhncv", q_dec, s_prev)
    o = o.reshape(bsz, GLA_HEADS, seq, GLA_DV).transpose(0, 2, 1, 3)
    o = _rms(o) * out_gain
    return (o.reshape(bsz, seq, GROUP) * jax.nn.silu(g.astype(f32))).astype(cols.dtype)


def _rwkv7_scan(r, w, k, v, a, b):
    bsz, seq, nh, hd = r.shape
    xs = tuple(jnp.moveaxis(t, 1, 0) for t in (r, w, k, v, a, b))

    def step(state, inp):
        r_t, w_t, k_t, v_t, a_t, b_t = inp
        sa = jnp.einsum("bhij,bhj->bhi", state, a_t)
        state = (state * w_t[:, :, None, :] + sa[..., None] * b_t[:, :, None, :]
                 + v_t[..., None] * k_t[:, :, None, :])
        return state, jnp.einsum("bhij,bhj->bhi", state, r_t)

    _, y = lax.scan(step, jnp.zeros((bsz, nh, hd, hd), jnp.float32), xs)
    return jnp.moveaxis(y, 0, 1)


def _rwkv7_time_mix(cols, xn, v_first, vres, mu, w_up, w0, a_up, a0, g_up,
                    k_k, k_a, r_k, ln_w, ln_b):
    bsz, seq, _ = cols.shape
    f32 = jnp.float32
    cols = _token_shift(cols, mu)
    r, k, v, wd, ad, gd = jnp.split(
        cols, np.cumsum([GROUP, GROUP, GROUP, RWKV_W_RANK, RWKV_A_RANK]).tolist(), axis=-1)
    if vres is None:
        v_first = v
    else:
        vres_down, vres_mu, vres_up, v0 = vres
        v_gate = jax.nn.sigmoid(v0 + _token_shift(xn @ vres_down, vres_mu) @ vres_up)
        v = v + (v_first - v) * v_gate
    w_log = -jax.nn.softplus(-(w0 + jnp.tanh(wd) @ w_up).astype(f32)) - 0.5
    decay = jnp.exp(-jnp.exp(w_log))
    a = jax.nn.sigmoid((a0 + ad @ a_up).astype(f32))
    g = jax.nn.sigmoid(gd) @ g_up
    k = k.astype(f32)

    def heads(t):
        return t.astype(f32).reshape(bsz, seq, RWKV_HEADS, RWKV_HD)

    kk = heads(k * k_k)
    kk = kk / jnp.maximum(jnp.sqrt(jnp.sum(kk * kk, axis=-1, keepdims=True)), 1e-12)
    k_mod = heads(k * (1.0 + (a - 1.0) * k_a))
    a_h = heads(a)
    r_h = heads(r)
    v_h = heads(v)
    y = _rwkv7_scan(r_h, heads(decay), k_mod, v_h, -kk, kk * a_h)
    mean = jnp.mean(y, axis=-1, keepdims=True)
    var = jnp.mean(jnp.square(y - mean), axis=-1, keepdims=True)
    y = ((y - mean) * lax.rsqrt(var + RWKV_LN_EPS)).reshape(bsz, seq, GROUP) * ln_w + ln_b
    bonus = jnp.sum(r_h * k_mod * r_k, axis=-1, keepdims=True) * v_h
    out = (y + bonus.reshape(bsz, seq, GROUP)) * g
    return out.astype(cols.dtype), v_first


def _swa_attention(cols, q_gain, k_gain, sinks, bias_tab):
    bsz, seq, _ = cols.shape
    f32 = jnp.float32
    grp = SWA_HEADS // SWA_KV_HEADS
    n_blk = seq // SWA_BLOCK
    q, k, v = jnp.split(cols, [GROUP, GROUP + SWA_KV_HEADS * SWA_HD], axis=-1)
    q = _rms(q.reshape(bsz, seq, SWA_HEADS, SWA_HD)) * q_gain
    k = _rms(k.reshape(bsz, seq, SWA_KV_HEADS, SWA_HD)) * k_gain
    v = v.reshape(bsz, seq, SWA_KV_HEADS, SWA_HD)
    q = q.reshape(bsz, n_blk, SWA_BLOCK, SWA_KV_HEADS, grp, SWA_HD)

    def band(t):
        tp = jnp.pad(t, ((0, 0), (SWA_BLOCK, 0), (0, 0), (0, 0)))
        tp = tp.reshape(bsz, n_blk + 1, SWA_BLOCK, SWA_KV_HEADS, SWA_HD)
        return jnp.concatenate([tp[:, :-1], tp[:, 1:]], axis=2)

    kb, vb = band(k), band(v)
    s = jnp.einsum("bnqhgd,bnkhd->bnhgqk", q, kb).astype(f32) * SWA_HD ** -0.5
    qi = jnp.arange(SWA_BLOCK)
    kj = jnp.arange(2 * SWA_BLOCK)
    dist = SWA_BLOCK + qi[:, None] - kj[None, :]
    k_pos = (jnp.arange(n_blk)[:, None] - 1) * SWA_BLOCK + kj[None, :]
    valid = ((dist >= 0) & (dist < SWA_WINDOW))[None] & (k_pos >= 0)[:, None, :]
    bias = (bias_tab[_t5_bucket(dist)].astype(f32)
            .reshape(SWA_BLOCK, 2 * SWA_BLOCK, SWA_KV_HEADS, grp).transpose(2, 3, 0, 1))
    s = jnp.where(valid[None, :, None, None], s + bias, NEG_INF)
    sink = sinks.astype(f32).reshape(SWA_KV_HEADS, grp)[:, :, None, None]
    m = jnp.maximum(jnp.max(s, axis=-1, keepdims=True), sink)
    p = jnp.exp(s - m)
    p = p / (jnp.sum(p, axis=-1, keepdims=True) + jnp.exp(sink - m))
    o = jnp.einsum("bnhgqk,bnkhd->bnqhgd", p.astype(v.dtype), vb)
    return o.reshape(bsz, seq, GROUP)


def _hybrid_layer(x, c, layer_idx, v_first, vres, bias_a, bias_d, p):
    mod = (jax.nn.silu(c) @ p["ada_w"] + p["ada_b"])[:, None, :]
    sh1, sc1, g1, sh2, sc2, g2 = jnp.split(mod, 6, axis=-1)
    h = _rms(x) * (1.0 + sc1) + sh1
    cols_a, cols_b, cols_c, cols_d = jnp.split(
        h @ p["w_in"], np.cumsum([DIFF_COLS, GLA_COLS, RWKV_COLS]).tolist(), axis=-1)
    o_a = _diff_attention(cols_a, layer_idx, p["diff_q_norm"], p["diff_k_norm"],
                          p["diff_lambda"], p["diff_subln"], bias_a)
    o_b = _gla(cols_b, p["gla_gate_up"], p["gla_gate_bias"], p["gla_out_norm"])
    o_c, v_first = _rwkv7_time_mix(cols_c, h, v_first, vres, p["rwkv_mu"], p["rwkv_w_up"],
                                   p["rwkv_w0"], p["rwkv_a_up"], p["rwkv_a0"], p["rwkv_g_up"],
                                   p["rwkv_k_k"], p["rwkv_k_a"], p["rwkv_r_k"],
                                   p["rwkv_ln_w"], p["rwkv_ln_b"])
    o_d = _swa_attention(cols_d, p["swa_q_norm"], p["swa_k_norm"], p["swa_sinks"], bias_d)
    mixed = jnp.concatenate([o_a, o_b, o_c, o_d], axis=-1)
    x = x + g1 * (mixed @ p["w_out"])
    h = _rms(x) * (1.0 + sc2) + sh2
    x = x + g2 * ((jax.nn.silu(h @ p["ffn_w1"]) * (h @ p["ffn_w3"])) @ p["ffn_w2"])
    return x, v_first


def setup_inputs(seed: int = 0) -> dict:
    key = jax.random.key(seed)
    ks = iter(jax.random.split(key, 40))
    L, D = DEPTH, D_MODEL
    f32 = jnp.float32

    def nrm(shape, scale):
        return jax.random.normal(next(ks), shape, f32) * scale

    def gain(shape):
        return 1.0 + nrm(shape, 0.1)

    return {
        "x": nrm((BATCH, SEQ, D), 1.0),
        "c": nrm((BATCH, D), 1.0),
        "rel_bias": nrm((REL_BUCKETS, REL_HEADS), 0.3),
        "ada_w": nrm((L, D, 6 * D), 0.5 * D ** -0.5),
        "ada_b": nrm((L, 6 * D), 0.02),
        "w_in": nrm((L, D, P_IN), D ** -0.5),
        "w_out": nrm((L, D_MIX, D), D_MIX ** -0.5),
        "diff_q_norm": gain((L, DIFF_QK)),
        "diff_k_norm": gain((L, DIFF_QK)),
        "diff_lambda": nrm((L, 4, DIFF_QK), 0.1),
        "diff_subln": gain((L, DIFF_HD)),
        "gla_gate_up": nrm((L, GLA_RANK, GLA_HEADS * GLA_DK), GLA_RANK ** -0.5),
        "gla_gate_bias": nrm((L, GLA_HEADS * GLA_DK), 0.1),
        "gla_out_norm": gain((L, GLA_DV)),
        "rwkv_mu": jax.random.uniform(next(ks), (L, RWKV_COLS), f32),
        "rwkv_w_up": nrm((L, RWKV_W_RANK, GROUP), RWKV_W_RANK ** -0.5),
        "rwkv_w0": nrm((L, GROUP), 0.5),
        "rwkv_a_up": nrm((L, RWKV_A_RANK, GROUP), RWKV_A_RANK ** -0.5),
        "rwkv_a0": nrm((L, GROUP), 0.1),
        "rwkv_g_up": nrm((L, RWKV_G_RANK, GROUP), RWKV_G_RANK ** -0.5),
        "rwkv_k_k": 0.85 + nrm((L, GROUP), 0.05),
        "rwkv_k_a": gain((L, GROUP)),
        "rwkv_r_k": nrm((L, RWKV_HEADS, RWKV_HD), 0.1),
        "rwkv_ln_w": gain((L, GROUP)),
        "rwkv_ln_b": nrm((L, GROUP), 0.02),
        "rwkv_vres_down": nrm((L - 1, D, RWKV_V_RANK), D ** -0.5),
        "rwkv_vres_mu": jax.random.uniform(next(ks), (L - 1, RWKV_V_RANK), f32),
        "rwkv_vres_up": nrm((L - 1, RWKV_V_RANK, GROUP), RWKV_V_RANK ** -0.5),
        "rwkv_v0": nrm((L - 1, GROUP), 0.5),
        "swa_q_norm": gain((L, SWA_HD)),
        "swa_k_norm": gain((L, SWA_HD)),
        "swa_sinks": nrm((L, SWA_HEADS), 0.5),
        "ffn_w1": nrm((L, D, D_FF), D ** -0.5),
        "ffn_w3": nrm((L, D, D_FF), D ** -0.5),
        "ffn_w2": nrm((L, D_FF, D), D_FF ** -0.5),
    }


def reference(x, c, rel_bias, ada_w, ada_b, w_in, w_out, diff_q_norm, diff_k_norm,
              diff_lambda, diff_subln, gla_gate_up, gla_gate_bias, gla_out_norm, rwkv_mu,
              rwkv_w_up, rwkv_w0, rwkv_a_up, rwkv_a0, rwkv_g_up, rwkv_k_k, rwkv_k_a, rwkv_r_k,
              rwkv_ln_w, rwkv_ln_b, rwkv_vres_down, rwkv_vres_mu, rwkv_vres_up, rwkv_v0,
              swa_q_norm, swa_k_norm, swa_sinks, ffn_w1, ffn_w3, ffn_w2):
    bias_a = rel_bias[:, :DIFF_HEADS]
    bias_d = rel_bias[:, DIFF_HEADS:]
    v_first = None
    for l in range(DEPTH):
        p = dict(ada_w=ada_w[l], ada_b=ada_b[l], w_in=w_in[l], w_out=w_out[l],
                 diff_q_norm=diff_q_norm[l], diff_k_norm=diff_k_norm[l],
                 diff_lambda=diff_lambda[l], diff_subln=diff_subln[l],
                 gla_gate_up=gla_gate_up[l], gla_gate_bias=gla_gate_bias[l],
                 gla_out_norm=gla_out_norm[l], rwkv_mu=rwkv_mu[l], rwkv_w_up=rwkv_w_up[l],
                 rwkv_w0=rwkv_w0[l], rwkv_a_up=rwkv_a_up[l], rwkv_a0=rwkv_a0[l],
                 rwkv_g_up=rwkv_g_up[l], rwkv_k_k=rwkv_k_k[l], rwkv_k_a=rwkv_k_a[l],
                 rwkv_r_k=rwkv_r_k[l], rwkv_ln_w=rwkv_ln_w[l], rwkv_ln_b=rwkv_ln_b[l],
                 swa_q_norm=swa_q_norm[l], swa_k_norm=swa_k_norm[l], swa_sinks=swa_sinks[l],
                 ffn_w1=ffn_w1[l], ffn_w3=ffn_w3[l], ffn_w2=ffn_w2[l])
        if l == 0:
            vres = None
        else:
            vres = (rwkv_vres_down[l - 1], rwkv_vres_mu[l - 1], rwkv_vres_up[l - 1], rwkv_v0[l - 1])
        x, v_first = _hybrid_layer(x, c, l, v_first, vres, bias_a, bias_d, p)
    return x
```

```cpp
#include <hip/hip_runtime.h>
#include <cstdio>
#include <cstdint>
namespace pg8 {
#define PG8_LAS __attribute__((address_space(3)))
typedef unsigned short bf16_t;
typedef short bf16x8 __attribute__((ext_vector_type(8)));
typedef float f32x4 __attribute__((ext_vector_type(4)));
typedef unsigned u32x4 __attribute__((ext_vector_type(4)));
constexpr int BM = 256, BK = 64, HALF = 128, HTB = HALF * BK * 2  , STAGE_BYTES = 8 * HTB, NXCD = 8, WGM = 8;

__host__ __device__ __forceinline__ int lds_byte(int r, int c) { const int st = (r >> 4) * 2 + (c >> 5), rr = r & 15, cc = c & 31, ob = rr * 64 + cc * 2; return st * 1024 + (ob ^ (((ob >> 9) & 1) << 5)); }
__host__ __device__ __forceinline__ void stage_rc(int b, int& R, int& C) { const int st = b / 1024, sb = b % 1024, swz = sb ^ (((sb >> 9) & 1) << 5); R = (st >> 1) * 16 + swz / 64; C = (st & 1) * 32 + (swz % 64) / 2; }
__host__ __device__ __forceinline__ int perm32(int rho) { const int n = rho >> 4, i = rho & 15; return 8 * (i >> 2) + 4 * n + (i & 3); }

struct Unit { int pm, pn; };
struct Gemm { const bf16_t* A; const bf16_t* Bt; int M, N, K; };

struct StaticOrder {
    int nM, nN, nwg, G, c;
    __host__ __device__ void init(int M, int N, int G_, int c_) { nM = M / BM; nN = N / BM; nwg = nM * nN; G = G_; c = c_; }
    __host__ __device__ bool next(int i, Unit& u) const {
        const long L = (long)i * G + c; if (L >= nwg) return false;
        int wgid = (int)L; { const int q = nwg / NXCD, r = nwg % NXCD, xcd = wgid % NXCD, off = wgid / NXCD; wgid = (xcd < r ? xcd * (q + 1) : r * (q + 1) + (xcd - r) * q) + off; }
        const int nig = WGM * nN, gid = wgid / nig, fm = gid * WGM, gsz = (nM - fm) < WGM ? (nM - fm) : WGM;
        u.pm = fm + ((wgid % nig) % gsz); u.pn = (wgid % nig) / gsz; return true;
    }
    __device__ __forceinline__ void a_ready(const Unit&) const {}
    __device__ __forceinline__ void done(const Unit&) const {}
};

__device__ __forceinline__ unsigned cvt_pk_bf16(float lo, float hi) { unsigned r; asm volatile("v_cvt_pk_bf16_f32 %0, %1, %2" : "=v"(r) : "v"(lo), "v"(hi)); return r; }
typedef float f32x2 __attribute__((ext_vector_type(2)));
__device__ __forceinline__ float silu_f(float x) { return x * __builtin_amdgcn_rcpf(1.0f + __builtin_amdgcn_exp2f(-1.4426950408889634f * x)); }
struct EpiCols {
    static constexpr bool PERM = true, AFTER_DRAIN = false;
    bf16_t* O; float* L;
    __device__ __forceinline__ void operator()(const f32x4 (&acc)[2][2][4][2], const Unit& u, int wr, int wc, int fr, int fq) const {
        const int row0 = u.pm * BM + wr * 64 + fr;
        if (u.pn < 41) {
            const int col0 = u.pn * BM + wc * 32 + 8 * fq;
#pragma unroll
            for (int ai = 0; ai < 2; ++ai)
#pragma unroll
                for (int m = 0; m < 4; ++m) { bf16_t* rowp = O + (size_t)(row0 + ai * HALF + m * 16) * 10496 + col0;
#pragma unroll
                    for (int bj = 0; bj < 2; ++bj) { const f32x4 v0 = acc[ai][bj][m][0], v1 = acc[ai][bj][m][1];
                        u32x4 w; w.x = cvt_pk_bf16(v0[0], v0[1]); w.y = cvt_pk_bf16(v0[2], v0[3]); w.z = cvt_pk_bf16(v1[0], v1[1]); w.w = cvt_pk_bf16(v1[2], v1[3]);
                        *(u32x4*)(rowp + bj * HALF) = w; } }
        } else {
            const int col0 = wc * 32 + 8 * fq;
#pragma unroll
            for (int ai = 0; ai < 2; ++ai)
#pragma unroll
                for (int m = 0; m < 4; ++m) { float* rowp = L + (size_t)(row0 + ai * HALF + m * 16) * 256 + col0;
#pragma unroll
                    for (int bj = 0; bj < 2; ++bj) { *(f32x4*)(rowp + bj * HALF) = acc[ai][bj][m][0]; *(f32x4*)(rowp + bj * HALF + 4) = acc[ai][bj][m][1]; } }
        }
    }
};
struct EpiRes {
    static constexpr bool PERM = false, AFTER_DRAIN = false;
    const float* base; float* out; const float* gate;
    __device__ __forceinline__ void operator()(const f32x4 (&acc)[2][2][4][2], const Unit& u, int wr, int wc, int fr, int fq) const {
        const int row0 = u.pm * BM + wr * 64 + fr, col0 = u.pn * BM + wc * 32 + 4 * fq;
        const float* gp = gate + (size_t)(u.pm >> 5) * 24576 + col0;
        f32x4 gv[2][2];
#pragma unroll
        for (int bj = 0; bj < 2; ++bj)
#pragma unroll
            for (int n = 0; n < 2; ++n) gv[bj][n] = *(const f32x4*)(gp + bj * HALF + n * 16);
#pragma unroll
        for (int ai = 0; ai < 2; ++ai)
#pragma unroll
            for (int m = 0; m < 4; ++m) { const size_t off = (size_t)(row0 + ai * HALF + m * 16) * 4096 + col0;
#pragma unroll
                for (int bj = 0; bj < 2; ++bj)
#pragma unroll
                    for (int n = 0; n < 2; ++n) { const f32x4 bs = *(const f32x4*)(base + off + bj * HALF + n * 16); *(f32x4*)(out + off + bj * HALF + n * 16) = bs + gv[bj][n] * acc[ai][bj][m][n]; }
                if (m & 1) asm volatile("" ::: "memory"); }
    }
};
struct EpiSwiglu {
    static constexpr bool PERM = true, AFTER_DRAIN = false;
    bf16_t* H;
    __device__ __forceinline__ void operator()(const f32x4 (&acc)[2][2][4][2], const Unit& u, int wr, int wc, int fr, int fq) const {
        const int row0 = u.pm * BM + wr * 64 + fr, col0 = u.pn * HALF + wc * 32 + 8 * fq;
#pragma unroll
        for (int ai = 0; ai < 2; ++ai)
#pragma unroll
            for (int m = 0; m < 4; ++m) { bf16_t* rowp = H + (size_t)(row0 + ai * HALF + m * 16) * 11008 + col0;
                const f32x4 a0 = acc[ai][0][m][0], a1 = acc[ai][0][m][1], b0 = acc[ai][1][m][0], b1 = acc[ai][1][m][1];
                u32x4 w; w.x = cvt_pk_bf16(silu_f(a0[0]) * b0[0], silu_f(a0[1]) * b0[1]); w.y = cvt_pk_bf16(silu_f(a0[2]) * b0[2], silu_f(a0[3]) * b0[3]);
                w.z = cvt_pk_bf16(silu_f(a1[0]) * b1[0], silu_f(a1[1]) * b1[1]); w.w = cvt_pk_bf16(silu_f(a1[2]) * b1[2], silu_f(a1[3]) * b1[3]);
                *(u32x4*)rowp = w; }
    }
};
template <class Epi, class Sched, bool ALIGN_EPI = false, bool SP2 = false>
__device__ __forceinline__ void gemm_phase(PG8_LAS unsigned char* lds, const Gemm g, const Sched& S, const Epi& E, int tid_in) {
    int tid_ = tid_in; asm volatile("" : "+v"(tid_));
    const int tid = tid_, wid = __builtin_amdgcn_readfirstlane(tid >> 6), lane = tid & 63, wr = wid >> 2, wc = wid & 3, fr = lane & 15, fq = lane >> 4;
    const int K = g.K, nt = K / BK;
    unsigned voffA[2], voffB[2];
#pragma unroll
    for (int i = 0; i < 2; ++i) { int R, C; stage_rc(tid * 16 + i * 8192, R, C); const int Rb = Epi::PERM ? ((R & ~31) + perm32(R & 31)) : R;
        voffA[i] = (unsigned)(R * K + C) * 2u; voffB[i] = (unsigned)(Rb * K + C) * 2u; }
    const size_t kstep = (size_t)(BK * 2);
    const size_t hstep = (size_t)HALF * K * 2;
    const size_t tstep = 2 * hstep;
    const unsigned ldsw = (unsigned)wid * 1024u;
    const int aoff = lds_byte(wr * 64 + fr, fq * 8), boff = lds_byte(wc * 32 + fr, fq * 8);
#define PG8_SA(b, h) (((b) * 2 + (h)) * HTB)
#define PG8_SB(b, h) ((4 + (b) * 2 + (h)) * HTB)
#define PG8_STAGE(bufoff, gbase, voff) do { _Pragma("unroll") for (int _i = 0; _i < 2; ++_i) \
        __builtin_amdgcn_global_load_lds((const unsigned*)((const char*)(gbase) + (voff)[_i]), (PG8_LAS unsigned*)(lds + (bufoff) + ldsw + _i * 8192), 16, 0, 0); } while (0)
#define PG8_LDA(dst, b, h) do { _Pragma("unroll") for (int m = 0; m < 4; ++m) _Pragma("unroll") for (int k = 0; k < 2; ++k) dst[m][k] = *(const PG8_LAS bf16x8*)(lds + PG8_SA(b, h) + aoff + m * 2048 + k * 1024); } while (0)
#define PG8_LDB(dst, b, h) do { _Pragma("unroll") for (int n = 0; n < 2; ++n) _Pragma("unroll") for (int k = 0; k < 2; ++k) dst[n][k] = *(const PG8_LAS bf16x8*)(lds + PG8_SB(b, h) + boff + n * 2048 + k * 1024); } while (0)
#define PG8_MMA(ai, bj, At, Bt) do { __builtin_amdgcn_s_setprio(1); _Pragma("unroll") for (int m = 0; m < 4; ++m) _Pragma("unroll") for (int n = 0; n < 2; ++n) _Pragma("unroll") for (int k = 0; k < 2; ++k) \
        acc[ai][bj][m][n] = __builtin_amdgcn_mfma_f32_16x16x32_bf16(Bt[n][k], At[m][k], acc[ai][bj][m][n], 0, 0, 0); __builtin_amdgcn_s_setprio(0); } while (0)
#define PG8_WAIT_V(n) asm volatile("s_waitcnt vmcnt(" #n ")" ::: "memory")
#define PG8_WAIT_L(n) asm volatile("s_waitcnt lgkmcnt(" #n ")" ::: "memory")
#define PG8_BAR __builtin_amdgcn_s_barrier()
#define PG8_SCHED __builtin_amdgcn_sched_barrier(0)
    Unit cur, nxt; int ui = 0;
    if (!S.next(0, cur)) return;
    f32x4 acc[2][2][4][2];
#pragma unroll
    for (int a = 0; a < 2; ++a)
#pragma unroll
        for (int b = 0; b < 2; ++b)
#pragma unroll
            for (int m = 0; m < 4; ++m)
#pragma unroll
                for (int n = 0; n < 2; ++n) acc[a][b][m][n] = (f32x4){0.f, 0.f, 0.f, 0.f};
    bf16x8 At[4][2], B0[2][2], B1[2][2];
    const char* cA = (const char*)g.A + (size_t)cur.pm * tstep; const char* cB = (const char*)g.Bt + (size_t)cur.pn * tstep;
    S.a_ready(cur);
    if constexpr (SP2) {
        PG8_STAGE(PG8_SB(0, 0), cB, voffB); PG8_STAGE(PG8_SB(0, 1), cB + hstep, voffB); PG8_STAGE(PG8_SA(0, 0), cA, voffA); PG8_STAGE(PG8_SA(0, 1), cA + hstep, voffA);
        if (wr == 1) PG8_BAR;
        PG8_WAIT_V(2); PG8_BAR;
        PG8_STAGE(PG8_SB(1, 0), cB + kstep, voffB); PG8_STAGE(PG8_SA(1, 0), cA + kstep, voffA); PG8_STAGE(PG8_SB(1, 1), cB + hstep + kstep, voffB);
        PG8_WAIT_V(6); PG8_BAR;
    } else {
        PG8_STAGE(PG8_SB(0, 0), cB, voffB); PG8_STAGE(PG8_SA(0, 0), cA, voffA); PG8_STAGE(PG8_SB(0, 1), cB + hstep, voffB); PG8_STAGE(PG8_SA(0, 1), cA + hstep, voffA);
        if (wr == 1) PG8_BAR;
        PG8_WAIT_V(4); PG8_BAR;
        PG8_STAGE(PG8_SB(1, 0), cB + kstep, voffB); PG8_STAGE(PG8_SA(1, 0), cA + kstep, voffA); PG8_STAGE(PG8_SB(1, 1), cB + hstep + kstep, voffB);
        PG8_WAIT_V(6); PG8_BAR;
    }
    for (;;) {
        const bool has_next = S.next(ui + 1, nxt);
        const char* nA = has_next ? (const char*)g.A + (size_t)nxt.pm * tstep : cA; const char* nB = has_next ? (const char*)g.Bt + (size_t)nxt.pn * tstep : cB;
        for (int t = 0; t < nt; t += 2) {
            const bool last = (t == nt - 2);
            const char* a1 = cA + (size_t)(t + 1) * kstep;
            const char* a2 = last ? nA : cA + (size_t)(t + 2) * kstep; const char* b2 = last ? nB : cB + (size_t)(t + 2) * kstep;
            const char* a3 = a2 + kstep; const char* b3 = b2 + kstep;
            if (last && has_next) S.a_ready(nxt);
            if constexpr (SP2) {
            PG8_LDB(B0, 0, 0); PG8_LDB(B1, 0, 1); PG8_SCHED; PG8_LDA(At, 0, 0); PG8_STAGE(PG8_SA(1, 1), a1 + hstep, voffA);
            PG8_WAIT_V(8); PG8_WAIT_L(0); PG8_BAR; PG8_MMA(0, 0, At, B0); PG8_MMA(0, 1, At, B1); PG8_BAR; PG8_SCHED;
            PG8_LDA(At, 0, 1); PG8_STAGE(PG8_SB(0, 0), b2, voffB); PG8_STAGE(PG8_SB(0, 1), b2 + hstep, voffB); PG8_STAGE(PG8_SA(0, 0), a2, voffA);
            PG8_WAIT_V(8); PG8_WAIT_L(0); PG8_BAR; PG8_MMA(1, 0, At, B0); PG8_MMA(1, 1, At, B1); PG8_BAR; PG8_SCHED;
            PG8_LDB(B0, 1, 0); PG8_LDB(B1, 1, 1); PG8_SCHED; PG8_LDA(At, 1, 0); PG8_STAGE(PG8_SA(0, 1), a2 + hstep, voffA);
            PG8_WAIT_V(8); PG8_WAIT_L(0); PG8_BAR; PG8_MMA(0, 0, At, B0); PG8_MMA(0, 1, At, B1); PG8_BAR; PG8_SCHED;
            PG8_LDA(At, 1, 1); PG8_STAGE(PG8_SB(1, 0), b3, voffB); PG8_STAGE(PG8_SB(1, 1), b3 + hstep, voffB); PG8_STAGE(PG8_SA(1, 0), a3, voffA);
            PG8_WAIT_V(8); PG8_WAIT_L(0); PG8_BAR; PG8_MMA(1, 0, At, B0); PG8_MMA(1, 1, At, B1); PG8_BAR; PG8_SCHED;
            } else {
            PG8_LDB(B0, 0, 0); PG8_SCHED; PG8_LDA(At, 0, 0); PG8_STAGE(PG8_SA(1, 1), a1 + hstep, voffA);
            PG8_WAIT_L(8); PG8_BAR; PG8_WAIT_L(0); PG8_MMA(0, 0, At, B0); PG8_BAR; PG8_SCHED;
            PG8_LDB(B1, 0, 1); PG8_STAGE(PG8_SB(0, 0), b2, voffB);
            PG8_BAR; PG8_WAIT_L(0); PG8_MMA(0, 1, At, B1); PG8_BAR;
            PG8_LDA(At, 0, 1); PG8_STAGE(PG8_SA(0, 0), a2, voffA);
            PG8_BAR; PG8_WAIT_L(0); PG8_MMA(1, 0, At, B0); PG8_BAR; PG8_SCHED;
            PG8_STAGE(PG8_SB(0, 1), b2 + hstep, voffB);
            PG8_WAIT_V(6); PG8_BAR; PG8_MMA(1, 1, At, B1); PG8_BAR;
            PG8_LDB(B0, 1, 0); PG8_SCHED; PG8_LDA(At, 1, 0); PG8_STAGE(PG8_SA(0, 1), a2 + hstep, voffA);
            PG8_WAIT_L(8); PG8_BAR; PG8_WAIT_L(0); PG8_MMA(0, 0, At, B0); PG8_BAR; PG8_SCHED;
            PG8_LDB(B1, 1, 1); PG8_STAGE(PG8_SB(1, 0), b3, voffB);
            PG8_BAR; PG8_WAIT_L(0); PG8_MMA(0, 1, At, B1); PG8_BAR;
            PG8_LDA(At, 1, 1); PG8_STAGE(PG8_SA(1, 0), a3, voffA);
            PG8_BAR; PG8_WAIT_L(0); PG8_MMA(1, 0, At, B0); PG8_BAR; PG8_SCHED;
            PG8_STAGE(PG8_SB(1, 1), b3 + hstep, voffB);
            PG8_WAIT_V(6); PG8_BAR; PG8_MMA(1, 1, At, B1); PG8_BAR;
            }
        }
        if constexpr (ALIGN_EPI) { if (wr == 0) PG8_BAR; }
        if constexpr (!Epi::AFTER_DRAIN) { E(acc, cur, wr, wc, fr, fq); S.done(cur); }
        if (!has_next) break;
#pragma unroll
        for (int a = 0; a < 2; ++a)
#pragma unroll
            for (int b = 0; b < 2; ++b)
#pragma unroll
                for (int m = 0; m < 4; ++m)
#pragma unroll
                    for (int n = 0; n < 2; ++n) acc[a][b][m][n] = (f32x4){0.f, 0.f, 0.f, 0.f};
        cur = nxt; cA = nA; cB = nB; ++ui;
        if constexpr (ALIGN_EPI) { if (wr == 1) PG8_BAR; }
    }
    PG8_WAIT_V(0);
    if constexpr (!ALIGN_EPI) { if (wr == 0) PG8_BAR; }
    PG8_BAR;
    if constexpr (Epi::AFTER_DRAIN) { E.fused(acc, cur, wr, wc, fr, fq, lds, wid, lane); S.done(cur); }
#undef PG8_SA
#undef PG8_SB
#undef PG8_STAGE
#undef PG8_LDA
#undef PG8_LDB
#undef PG8_MMA
#undef PG8_WAIT_V
#undef PG8_WAIT_L
#undef PG8_BAR
#undef PG8_SCHED
}
}
constexpr int BATCH = 2, SEQ = 8192, DM = 4096, M = BATCH * SEQ, DFF = 11008, NLAYER = 2;
constexpr int P_IN = 10704, NIN = 10752, NMAIN = 10496;
constexpr int CA_Q = 0, CA_K = 1024, CA_V = 2048;
constexpr int CB_Q = 3072, CB_K = 3584, CB_V = 4096, CB_G = 5120;
constexpr int CC_R = 6144, CC_K = 7168, CC_V = 8192;
constexpr int CD_Q = 9216, CD_K = 10240, CD_V = 10368;
constexpr float LOG2E = 1.4426950408889634f;
constexpr float QSCALE = 0.125f * LOG2E;
constexpr int NWAVES = 8;

constexpr size_t MiB = 1u << 20;
constexpr size_t WS_CTL = 0, CTL_ZERO_BYTES = 1 * MiB;
constexpr size_t WS_MODP = 2 * MiB;
constexpr size_t WS_MOD = 14 * MiB;
constexpr size_t WS_TAB = 15 * MiB;
constexpr size_t WS_WIN = 16 * MiB, WIN_L = 84 * MiB;
constexpr size_t WS_WOUT = 184 * MiB, WOUT_L = 32 * MiB;
constexpr size_t WS_W13 = 248 * MiB, W13_L = 172 * MiB;
constexpr size_t WS_W2 = 592 * MiB, W2_L = 86 * MiB;
constexpr size_t WS_XN = 764 * MiB;
constexpr size_t WS_COLS = 892 * MiB;
constexpr size_t WS_LOWR = 1220 * MiB;
constexpr size_t WS_HID = 892 * MiB;
constexpr size_t WS_QKA = 1236 * MiB;
constexpr size_t WS_QKD = 1300 * MiB;
constexpr size_t WS_LOGA = 1336 * MiB;
constexpr size_t WS_RW = 1368 * MiB, RW_ONE = 64 * MiB;
constexpr size_t WS_VFIRST = 1816 * MiB;
constexpr size_t WS_MIXED = 1880 * MiB;
constexpr size_t WS_VTA = 2008 * MiB;
constexpr size_t WS_VTD = 2040 * MiB;
constexpr size_t WS_END = 2044 * MiB;
constexpr int CW_BAR = 4096;
constexpr int CW_Q = 16384;

constexpr int RING_OFF = 0, RING_BYTES = 131072;
constexpr int LDSCTL_OFF = RING_BYTES, MISC_OFF = LDSCTL_OFF + 320;
constexpr int LDS_BYTES = 147456;

#define GAS __attribute__((address_space(1)))
#define LAS __attribute__((address_space(3)))
typedef unsigned short bf16;
typedef unsigned v4u __attribute__((ext_vector_type(4)));
typedef unsigned v2u __attribute__((ext_vector_type(2)));
typedef float f32x4 __attribute__((ext_vector_type(4)));
typedef short bf16x8 __attribute__((ext_vector_type(8)));
typedef GAS unsigned gu32;
#define RLX_AGENT __ATOMIC_RELAXED, __HIP_MEMORY_SCOPE_AGENT
#define LDS_WAIT() asm volatile("s_waitcnt lgkmcnt(0)" ::: "memory")
#define VM_WAIT() asm volatile("s_waitcnt vmcnt(0)" ::: "memory")
__device__ __forceinline__ unsigned f2bf(float f) { unsigned u = __builtin_bit_cast(unsigned, f); return (u + 0x7fffu + ((u >> 16) & 1u)) >> 16; }
__device__ __forceinline__ unsigned pk2(float lo, float hi) { return f2bf(lo) | (f2bf(hi) << 16); }
__device__ __forceinline__ float bf2f(unsigned short h) { return __builtin_bit_cast(float, (unsigned)h << 16); }
__device__ __forceinline__ float bflo(unsigned w) { return __builtin_bit_cast(float, w << 16); }
__device__ __forceinline__ float bfhi(unsigned w) { return __builtin_bit_cast(float, w & 0xffff0000u); }
template <int CTRL> __device__ __forceinline__ float dpp_f(float v) { return __builtin_bit_cast(float, __builtin_amdgcn_update_dpp(0, __builtin_bit_cast(int, v), CTRL, 0xF, 0xF, true)); }
__device__ __forceinline__ float sum8(float v) {
    v += dpp_f<0xB1>(v); v += dpp_f<0x4E>(v); v += dpp_f<0x141>(v); return v; }
__device__ __forceinline__ float wave_sum(float v) {
    v = sum8(v); v += dpp_f<0x140>(v);
    v += __builtin_bit_cast(float, __builtin_amdgcn_ds_swizzle(__builtin_bit_cast(int, v), 0x401F));
    { const int u = __builtin_bit_cast(int, v); v = __builtin_bit_cast(float, __builtin_amdgcn_readlane(u, 0)) + __builtin_bit_cast(float, __builtin_amdgcn_readlane(u, 32)); }
    return v;
}
__device__ __forceinline__ float sigmoid_f(float x) { return __builtin_amdgcn_rcpf(1.0f + __builtin_amdgcn_exp2f(-LOG2E * x)); }
__device__ __forceinline__ float silu_g(float x) { return x * sigmoid_f(x); }

#define XB_TMO      128
#define XB_XCNT(j)  (256  + 64 * (j))
#define XB_XSUB(j)  (1280 + 64 * (j))
#define XB_XGEN(j)  (2304 + 64 * (j))
#define XB_TOP      3328
#define XB_TOPGEN   3392
#define XCD_BAR_WORDS 3456
#define XB_SPIN_CAP (1u << 23)

__device__ __forceinline__ unsigned xb_ld(unsigned* p)              { return __hip_atomic_load(p, __ATOMIC_RELAXED, __HIP_MEMORY_SCOPE_AGENT); }
__device__ __forceinline__ unsigned xb_add(unsigned* p, unsigned v) { return __hip_atomic_fetch_add(p, v, __ATOMIC_RELAXED, __HIP_MEMORY_SCOPE_AGENT); }
__device__ __forceinline__ unsigned xb_xcc_id() { return (unsigned)__builtin_amdgcn_s_getreg((3 << 11) | 20) & 0xFu; }
#define XB_SPIN(cond, bar) do { unsigned _sp = 0; while (cond) { __builtin_amdgcn_s_sleep(1); \
    if ((++_sp & 255u) == 0u) { if (xb_ld(&(bar)[XB_TMO])) break; if (_sp > XB_SPIN_CAP) { atomicAdd(&(bar)[XB_TMO], 1u); break; } } } } while (0)

struct XcdBarrier {
    unsigned* bar; unsigned x;
    volatile LAS unsigned* st;
};

__device__ __forceinline__ XcdBarrier xcd_barrier_post(unsigned* bar, volatile LAS unsigned* st) {
    XcdBarrier b; b.bar = bar; b.x = xb_xcc_id(); b.st = st;
    if (threadIdx.x == 0) (void)xb_add(&bar[XB_XCNT(b.x)], 1u);
    return b;
}
__device__ __forceinline__ void xcd_barrier_complete(unsigned* bar, unsigned x, unsigned& nloc, unsigned& nx) {
    const unsigned G = gridDim.x * gridDim.y * gridDim.z;
    unsigned sum, cnt, mine, sp = 0u;
    for (;;) {
        sum = 0u; cnt = 0u; mine = 0u;
#pragma unroll
        for (unsigned j = 0; j < 16; ++j) { const unsigned c = xb_ld(&bar[XB_XCNT(j)]); sum += c; cnt += (c > 0u) ? 1u : 0u; mine = (j == x) ? c : mine; }
        if (sum == G) break;
        __builtin_amdgcn_s_sleep(1);
        if ((++sp & 255u) == 0u) { if (xb_ld(&bar[XB_TMO])) break; if (sp > XB_SPIN_CAP) { atomicAdd(&bar[XB_TMO], 1u); break; } }
    }
    nloc = mine > 0u ? mine : 1u; nx = cnt > 0u ? cnt : 1u;
}

__device__ __forceinline__ void xcd_barrier(const XcdBarrier& b) {
    asm volatile("s_waitcnt vmcnt(0)" ::: "memory");
    __syncthreads();
    if (threadIdx.x == 0) {
        unsigned* bar = b.bar;
        __builtin_amdgcn_s_waitcnt(0);
        unsigned nloc = b.st[0], nx = b.st[1];
        if (nloc == 0u) { xcd_barrier_complete(bar, b.x, nloc, nx); b.st[0] = nloc; b.st[1] = nx; }
        const unsigned old = xb_add(&bar[XB_XSUB(b.x)], 1u);
        const unsigned gen = old / nloc;
        if (old + 1u == (gen + 1u) * nloc) {
            __builtin_amdgcn_fence(__ATOMIC_RELEASE, "agent");
            asm volatile("s_waitcnt vmcnt(0)" ::: "memory");
            const unsigned og = xb_add(&bar[XB_TOP], 1u);
            const unsigned tg = og / nx;
            if (og + 1u == (tg + 1u) * nx) xb_add(&bar[XB_TOPGEN], 1u);
            else XB_SPIN(xb_ld(&bar[XB_TOPGEN]) == tg, bar);
            __builtin_amdgcn_fence(__ATOMIC_ACQUIRE, "agent");
            xb_add(&bar[XB_XGEN(b.x)], 1u);
            asm volatile("s_waitcnt vmcnt(0)" ::: "memory");
        } else {
            XB_SPIN(xb_ld(&bar[XB_XGEN(b.x)]) == gen, bar);
            __builtin_amdgcn_fence(__ATOMIC_ACQUIRE, "agent");
            asm volatile("s_waitcnt vmcnt(0)" ::: "memory");
        }
    }
    __syncthreads();
}

typedef const float* const __attribute__((address_space(4)))* kargp;
struct Frame {
    LAS unsigned char* lds;
    volatile LAS unsigned* MISC;
    gu32* ctl;
    int tid, lane, wave;
    int vcu, G, bx;
    kargp kin;
    float* out;
    unsigned char* ws;
};
enum { I_X = 0, I_C, I_RELB, I_ADAW, I_ADAB, I_WIN, I_WOUT, I_DQN, I_DKN, I_DLAM, I_DSUB, I_GGU, I_GGB, I_GON, I_RMU, I_RWUP, I_RW0, I_RAUP, I_RA0, I_RGUP,
       I_RKK, I_RKA, I_RRK, I_RLNW, I_RLNB, I_VRD, I_VRMU, I_VRUP, I_VR0, I_SQN, I_SKN, I_SSINK, I_W1, I_W3, I_W2 };

#define WSP(T, off) ((T*)(F.ws + (off)))
__device__ __forceinline__ void relaunder_tid(Frame& F) { int t = F.tid; asm volatile("" : "+v"(t)); F.tid = t; F.lane = t & 63; F.wave = __builtin_amdgcn_readfirstlane(t >> 6); }
__device__ __forceinline__ void relaunder(Frame& F) { kargp p = F.kin; asm volatile("" : "+s"(p)); F.kin = p; }

__device__ __forceinline__ void conv_item(const float* src, int ld, int col0, int ncols, int K, bf16* WT, int row0, int kb, LAS float* scr, int lane) {
    const int k0 = 64 * kb;
#pragma unroll 8
    for (int i = 0; i < 32; ++i) { const int kk = 2 * i + (lane >> 5), n = lane & 31; float v = 0.f;
        if (src != nullptr && n < ncols) v = src[(size_t)(k0 + kk) * ld + col0 + n];
        scr[kk * 33 + n] = v; }
    LDS_WAIT(); asm volatile("" ::: "memory");
    const int c = lane & 7;
#pragma unroll
    for (int j = 0; j < 4; ++j) { const int n = (lane >> 3) + 8 * j; const LAS float* s = scr + (8 * c) * 33 + n;
        v4u o; o.x = pk2(s[0 * 33], s[1 * 33]); o.y = pk2(s[2 * 33], s[3 * 33]); o.z = pk2(s[4 * 33], s[5 * 33]); o.w = pk2(s[6 * 33], s[7 * 33]);
        if (n < ncols) *(GAS v4u*)(WT + (size_t)(row0 + n) * K + k0 + 8 * c) = o; }
    LDS_WAIT(); asm volatile("" ::: "memory");
}
__device__ __forceinline__ int t5_bucket(int d) {
    if (d < 16) return d;
    int v = 16 + (int)(logf((float)d * (1.0f / 16.0f)) / logf(8.0f) * 16.0f);
    return v < 31 ? v : 31;
}
__device__ __forceinline__ void p0_prologue_a(Frame& F) {
    const int gw = F.vcu * NWAVES + F.wave, NGW = F.G * NWAVES;
    LAS float* ldsf = (LAS float*)(F.lds + RING_OFF);
    for (int i = F.tid; i < 2 * DM; i += NWAVES * 64) ldsf[i] = silu_g(F.kin[I_C][i]);
    __syncthreads();
    float* MODP = WSP(float, WS_MODP);
    for (int it = gw; it < 6144; it += NGW) {
        const int l = it / 3072, rem = it % 3072, kc = rem / 96, ng = rem % 96, n0 = 256 * ng + 4 * F.lane;
        const float* w = F.kin[I_ADAW] + ((size_t)l * DM + kc * 128) * 24576 + n0;
        f32x4 a0 = {0.f, 0.f, 0.f, 0.f}, a1 = {0.f, 0.f, 0.f, 0.f};
#pragma unroll 8
        for (int k = 0; k < 128; ++k) { const f32x4 wv = *(const f32x4*)(w + (size_t)k * 24576); const float s0 = ldsf[kc * 128 + k], s1 = ldsf[DM + kc * 128 + k]; a0 += wv * s0; a1 += wv * s1; }
        *(f32x4*)(MODP + ((size_t)(l * 32 + kc) * 2 + 0) * 24576 + n0) = a0;
        *(f32x4*)(MODP + ((size_t)(l * 32 + kc) * 2 + 1) * 24576 + n0) = a1;
    }
    __syncthreads();
    LAS float* scr = (LAS float*)(F.lds + RING_OFF + F.wave * 16384);
    constexpr int I_IN = 337 * 64, I_OUT = 128 * 64, I_13 = 688 * 64, I_2 = 128 * 172, I_L = I_IN + I_OUT + I_13 + I_2;
    for (int it = gw; it < NLAYER * I_L; it += NGW) {
        const int l = it / I_L; int r = it % I_L;
        if (r < I_IN) {
            const int kb = r / 337, cb = r % 337; const float* src = F.kin[I_WIN] + (size_t)l * DM * P_IN; int ld = P_IN, col0, row0, nc = 32;
            if (cb < 192) { col0 = 32 * cb; row0 = 32 * cb; }
            else if (cb < 288) { col0 = 6160 + 32 * (cb - 192); row0 = 6144 + 32 * (cb - 192); }
            else if (cb < 328) { col0 = 9424 + 32 * (cb - 288); row0 = 9216 + 32 * (cb - 288); }
            else if (cb == 328) { col0 = 6144; row0 = 10496; nc = 16; }
            else if (cb < 335) { col0 = 9232 + 32 * (cb - 329); row0 = 10512 + 32 * (cb - 329); }
            else if (cb == 335) { src = l ? F.kin[I_VRD] + (size_t)(l - 1) * DM * 32 : nullptr; ld = 32; col0 = 0; row0 = 10704; }
            else { src = nullptr; col0 = 0; row0 = 10736; nc = 16; }
            conv_item(src, ld, col0, nc, DM, WSP(bf16, WS_WIN + l * WIN_L), row0, kb, scr, F.lane); continue; }
        r -= I_IN;
        if (r < I_OUT) { const int kb = r / 128, cb = r % 128; conv_item(F.kin[I_WOUT] + (size_t)l * DM * DM, DM, 32 * cb, 32, DM, WSP(bf16, WS_WOUT + l * WOUT_L), 32 * cb, kb, scr, F.lane); continue; }
        r -= I_OUT;
        if (r < I_13) { const int kb = r / 688, cb = r % 688, pn = cb >> 3, wi = cb & 7;
            const float* src = (wi < 4 ? F.kin[I_W1] : F.kin[I_W3]) + (size_t)l * DM * DFF;
            conv_item(src, DFF, 128 * pn + 32 * (wi & 3), 32, DM, WSP(bf16, WS_W13 + l * W13_L), 32 * cb, kb, scr, F.lane); continue; }
        r -= I_13;
        { const int kb = r / 128, cb = r % 128; conv_item(F.kin[I_W2] + (size_t)l * DFF * DM, DM, 32 * cb, 32, DFF, WSP(bf16, WS_W2 + l * W2_L), 32 * cb, kb, scr, F.lane); }
    }
}
__device__ __forceinline__ void p0_prologue_b(Frame& F) {
    const int gt = F.bx * (NWAVES * 64) + F.tid, NT = F.G * NWAVES * 64;
    const float* MODP = WSP(float, WS_MODP); float* MOD = WSP(float, WS_MOD);
    for (int idx = gt; idx < NLAYER * 2 * 24576; idx += NT) {
        const int l = idx / 49152, rem = idx % 49152, b = rem / 24576, n = rem % 24576;
        float s = F.kin[I_ADAB][l * 24576 + n];
#pragma unroll 8
        for (int kc = 0; kc < 32; ++kc) s += MODP[((size_t)(l * 32 + kc) * 2 + b) * 24576 + n];
        MOD[idx] = s;
    }
    if (F.bx == 0) { float* TAB = WSP(float, WS_TAB);
        for (int i = F.tid; i < 24 * 128; i += NWAVES * 64) { const int hh = i >> 7, d = i & 127; TAB[i] = F.kin[I_RELB][t5_bucket(d) * 24 + hh] * LOG2E; } }
}
__device__ __forceinline__ void rms_phase(Frame& F, const float* xin, const float* sh, const float* sc) {
    const int gw = F.vcu * NWAVES + F.wave, NGW = F.G * NWAVES;
    bf16* XN = WSP(bf16, WS_XN);
    for (int m = gw; m < M; m += NGW) {
        const int b = m >> 13;
        const f32x4* xr = (const f32x4*)(xin + (size_t)m * DM) + F.lane;
        f32x4 v[16]; float ss = 0.f;
#pragma unroll
        for (int j = 0; j < 16; ++j) { v[j] = xr[64 * j]; ss += (v[j].x * v[j].x + v[j].y * v[j].y) + (v[j].z * v[j].z + v[j].w * v[j].w); }
        const float rstd = rsqrtf(wave_sum(ss) * (1.0f / DM) + 1e-6f);
        const f32x4* scp = (const f32x4*)(sc + (size_t)b * 24576) + F.lane; const f32x4* shp = (const f32x4*)(sh + (size_t)b * 24576) + F.lane;
        v2u* o8 = (v2u*)(XN + (size_t)m * DM) + F.lane;
#pragma unroll
        for (int j = 0; j < 16; ++j) { const f32x4 s4 = scp[64 * j], h4 = shp[64 * j]; const f32x4 o = v[j] * rstd * (s4 + 1.0f) + h4;
            v2u w; w.x = pk2(o.x, o.y); w.y = pk2(o.z, o.w); o8[64 * j] = w; }
    }
}
__device__ __forceinline__ void unpack8(const v4u r, float (&f)[8]) { f[0] = bflo(r.x); f[1] = bfhi(r.x); f[2] = bflo(r.y); f[3] = bfhi(r.y); f[4] = bflo(r.z); f[5] = bfhi(r.z); f[6] = bflo(r.w); f[7] = bfhi(r.w); }
__device__ __forceinline__ v4u pack8(const float (&f)[8]) { v4u o; o.x = pk2(f[0], f[1]); o.y = pk2(f[2], f[3]); o.z = pk2(f[4], f[5]); o.w = pk2(f[6], f[7]); return o; }
__device__ __forceinline__ void prep_norm(Frame& F, int l) {
    const int gw = F.vcu * NWAVES + F.wave, NGW = F.G * NWAVES, lane = F.lane, sub = lane >> 3, ch = lane & 7;
    float gqa[8], gka[8], gqd[8], gkd[8];
#pragma unroll
    for (int e = 0; e < 8; ++e) { gqa[e] = F.kin[I_DQN][l * 64 + ch * 8 + e] * QSCALE; gka[e] = F.kin[I_DKN][l * 64 + ch * 8 + e];
                                  gqd[e] = F.kin[I_SQN][l * 64 + ch * 8 + e] * QSCALE; gkd[e] = F.kin[I_SKN][l * 64 + ch * 8 + e]; }
    const bf16* COLS = WSP(bf16, WS_COLS); bf16* QKA = WSP(bf16, WS_QKA); bf16* QKD = WSP(bf16, WS_QKD);
    for (int m = gw; m < M; m += NGW) {
        const bf16* src = COLS + (size_t)m * NMAIN;
#pragma unroll
        for (int i = 0; i < 4; ++i) { const int vec = i * 8 + sub, col = vec * 64 + ch * 8;
            float f[8]; unpack8(*(const v4u*)(src + CA_Q + col), f); float ss = 0.f;
#pragma unroll
            for (int e = 0; e < 8; ++e) ss += f[e] * f[e];
            ss = sum8(ss);
            const float rstd = rsqrtf(ss * (1.0f / 64.0f) + 1e-6f);
#pragma unroll
            for (int e = 0; e < 8; ++e) f[e] = f[e] * rstd * (i < 2 ? gqa[e] : gka[e]);
            *(v4u*)(QKA + (size_t)m * 2048 + col) = pack8(f); }
#pragma unroll
        for (int i = 0; i < 3; ++i) { const int vec = i * 8 + sub, col = vec * 64 + ch * 8;
            if (vec < 18) { float f[8]; unpack8(*(const v4u*)(src + CD_Q + col), f); float ss = 0.f;
#pragma unroll
                for (int e = 0; e < 8; ++e) ss += f[e] * f[e];
                ss = sum8(ss);
                const float rstd = rsqrtf(ss * (1.0f / 64.0f) + 1e-6f);
#pragma unroll
                for (int e = 0; e < 8; ++e) f[e] = f[e] * rstd * (vec < 16 ? gqd[e] : gkd[e]);
                *(v4u*)(QKD + (size_t)m * 1152 + col) = pack8(f); } }
    }
}
__device__ __forceinline__ void prep_loga(Frame& F, int l) {
    float gu[16];
#pragma unroll
    for (int j = 0; j < 16; ++j) gu[j] = F.kin[I_GGU][((size_t)l * 16 + j) * 512 + F.tid];
    const float bias = F.kin[I_GGB][l * 512 + F.tid];
    const float* LOWR = WSP(float, WS_LOWR); float* LOGA = WSP(float, WS_LOGA);
    for (int m = F.bx; m < M; m += F.G) {
        const float* gd = LOWR + (size_t)m * 256; float z = bias;
#pragma unroll
        for (int j = 0; j < 16; ++j) z += gd[j] * gu[j];
        LOGA[(size_t)m * 512 + F.tid] = (fminf(z, 0.f) - log1pf(expf(-fabsf(z)))) * (1.0f / 16.0f);
    }
}
__device__ __forceinline__ void prep_rwkv(Frame& F, int l) {
    LAS float* in = (LAS float*)(F.lds + RING_OFF);
    const float* mu = F.kin[I_RMU] + (size_t)l * 3264;
    const float* LOWR = WSP(float, WS_LOWR); const bf16* COLS = WSP(bf16, WS_COLS);
    float* RW = WSP(float, WS_RW); float* VF = WSP(float, WS_VFIRST);
    constexpr size_t RS = RW_ONE / 4;
    for (int tile = F.bx; tile < M / 16; tile += F.G) {
        const int row0 = tile * 16;
        __syncthreads();
        for (int idx = F.tid; idx < 16 * 224; idx += NWAVES * 64) { const int tt = idx / 224, j = idx % 224, row = row0 + tt, t = row & (SEQ - 1);
            const int col = j < 192 ? 16 + j : 208 + (j - 192);
            const float cur = LOWR[(size_t)row * 256 + col], prev = t > 0 ? LOWR[(size_t)(row - 1) * 256 + col] : 0.f;
            const float muv = j < 192 ? mu[3072 + j] : (l ? F.kin[I_VRMU][(l - 1) * 32 + (j - 192)] : 0.f);
            float x = cur + (prev - cur) * muv;
            if (j < 64) x = tanhf(x); else if (j >= 128 && j < 192) x = sigmoid_f(x);
            in[j * 16 + tt] = x; }
        __syncthreads();
#pragma unroll 1
        for (int pass = 0; pass < 2; ++pass) {
            const int c = pass * 512 + F.tid;
            float accw[16], acca[16], accg[16], accv[16];
            { const float bw = F.kin[I_RW0][l * 1024 + c], ba = F.kin[I_RA0][l * 1024 + c], bv = l ? F.kin[I_VR0][(l - 1) * 1024 + c] : 0.f;
#pragma unroll
              for (int tt = 0; tt < 16; ++tt) { accw[tt] = bw; acca[tt] = ba; accg[tt] = 0.f; accv[tt] = bv; } }
#define LOWRANK_ACC(ACC, WPTR, JOFF, NJ) do { const float* wp_ = (WPTR) + c; \
            _Pragma("unroll 2") for (int j = 0; j < (NJ); ++j) { const float w_ = wp_[(size_t)j * 1024]; const LAS f32x4* ip_ = (const LAS f32x4*)(in + ((JOFF) + j) * 16); \
                const f32x4 i0 = ip_[0], i1 = ip_[1], i2 = ip_[2], i3 = ip_[3]; \
                ACC[0] += i0.x * w_; ACC[1] += i0.y * w_; ACC[2] += i0.z * w_; ACC[3] += i0.w * w_; ACC[4] += i1.x * w_; ACC[5] += i1.y * w_; ACC[6] += i1.z * w_; ACC[7] += i1.w * w_; \
                ACC[8] += i2.x * w_; ACC[9] += i2.y * w_; ACC[10] += i2.z * w_; ACC[11] += i2.w * w_; ACC[12] += i3.x * w_; ACC[13] += i3.y * w_; ACC[14] += i3.z * w_; ACC[15] += i3.w * w_; } } while (0)
            relaunder(F); LOWRANK_ACC(accw, F.kin[I_RWUP] + (size_t)l * 64 * 1024, 0, 64);
            relaunder(F); LOWRANK_ACC(acca, F.kin[I_RAUP] + (size_t)l * 64 * 1024, 64, 64);
            relaunder(F); LOWRANK_ACC(accg, F.kin[I_RGUP] + (size_t)l * 64 * 1024, 128, 64);
            relaunder(F); if (l) LOWRANK_ACC(accv, F.kin[I_VRUP] + (size_t)(l - 1) * 32 * 1024, 192, 32);
#undef LOWRANK_ACC
            relaunder(F);
            const float mur = F.kin[I_RMU][l * 3264 + c], muk = F.kin[I_RMU][l * 3264 + 1024 + c], muv = F.kin[I_RMU][l * 3264 + 2048 + c], kkv = F.kin[I_RKK][l * 1024 + c], kav = F.kin[I_RKA][l * 1024 + c];
            float pr = 0.f, pk = 0.f, pv = 0.f;
            if ((row0 & (SEQ - 1)) != 0) { const bf16* p = COLS + (size_t)(row0 - 1) * NMAIN + c; pr = bf2f(p[CC_R]); pk = bf2f(p[CC_K]); pv = bf2f(p[CC_V]); }
#pragma unroll
            for (int tt = 0; tt < 16; ++tt) { const int row = row0 + tt; const bf16* p = COLS + (size_t)row * NMAIN + c;
                const float cr = bf2f(p[CC_R]), ck = bf2f(p[CC_K]), cv = bf2f(p[CC_V]);
                const float r = cr + (pr - cr) * mur, k = ck + (pk - ck) * muk; float v = cv + (pv - cv) * muv;
                pr = cr; pk = ck; pv = cv;
                const size_t o = (size_t)row * 1024 + c;
                if (l == 0) VF[o] = v; else { const float vg = sigmoid_f(accv[tt]); v = v + (VF[o] - v) * vg; }
                const float dec = __expf(-0.6065306597126334f * sigmoid_f(accw[tt]));
                const float a = sigmoid_f(acca[tt]);
                float kk = k * kkv; const float ss = wave_sum(kk * kk); kk = kk / fmaxf(sqrtf(ss), 1e-12f);
                const float km = k * (1.0f + (a - 1.0f) * kav);
                RW[o] = r; RW[RS + o] = dec; RW[2 * RS + o] = km; RW[3 * RS + o] = v; RW[4 * RS + o] = -kk; RW[5 * RS + o] = kk * a; RW[6 * RS + o] = accg[tt]; }
        }
    }
}
__device__ __forceinline__ void diff_unit_v1(Frame& F, int l, int b, int h, int qt) {
    LAS float* ldsf = (LAS float*)(F.lds + RING_OFF);
    LAS float* Kt = ldsf; LAS float* Vt = ldsf + 8192; LAS float* Bt = ldsf + 16640;
    const int p = F.wave >> 2, dq = F.wave & 3, lane = F.lane, q0 = qt * 64, qpos = q0 + lane;
    const bf16* QKA = WSP(bf16, WS_QKA); const bf16* COLS = WSP(bf16, WS_COLS); const float* TAB = WSP(float, WS_TAB);
    float q[64];
    { const bf16* qp = QKA + (size_t)(b * SEQ + qpos) * 2048 + h * 128 + p * 64;
#pragma unroll
      for (int i = 0; i < 8; ++i) { float f[8]; unpack8(*(const v4u*)(qp + 8 * i), f);
#pragma unroll
          for (int e = 0; e < 8; ++e) q[8 * i + e] = f[e]; } }
    float lam_init = 0.8f - 0.6f * __expf(-0.3f * (float)l), lam_full;
    { const float* lm = F.kin[I_DLAM] + (size_t)l * 256; const float s1 = wave_sum(lm[lane] * lm[64 + lane]), s2 = wave_sum(lm[128 + lane] * lm[192 + lane]); lam_full = __expf(s1) - __expf(s2) + lam_init; }
    float o[32];
#pragma unroll
    for (int i = 0; i < 32; ++i) o[i] = 0.f;
    float mx = -1e30f, lsum = 0.f;
    if (F.tid < 128) Bt[F.tid] = TAB[h * 128 + F.tid];
    for (int kt = 0; kt <= qt; ++kt) {
        __syncthreads();
        { const int key = F.tid >> 3, chn = F.tid & 7; const size_t krow = (size_t)(b * SEQ + kt * 64 + key);
          const bf16* kp = QKA + krow * 2048 + 1024 + h * 128 + chn * 16; const bf16* vp = COLS + krow * NMAIN + CA_V + h * 128 + chn * 16;
          float f[8];
          unpack8(*(const v4u*)kp, f);
#pragma unroll
          for (int e = 0; e < 8; ++e) Kt[key * 128 + chn * 16 + e] = f[e];
          unpack8(*(const v4u*)(kp + 8), f);
#pragma unroll
          for (int e = 0; e < 8; ++e) Kt[key * 128 + chn * 16 + 8 + e] = f[e];
          unpack8(*(const v4u*)vp, f);
#pragma unroll
          for (int e = 0; e < 8; ++e) Vt[key * 128 + chn * 16 + e] = f[e];
          unpack8(*(const v4u*)(vp + 8), f);
#pragma unroll
          for (int e = 0; e < 8; ++e) Vt[key * 128 + chn * 16 + 8 + e] = f[e]; }
        __syncthreads();
        const int kbase = kt * 64;
#pragma unroll 2
        for (int j = 0; j < 64; ++j) {
            const int dist = qpos - (kbase + j);
            const LAS f32x4* kp = (const LAS f32x4*)(Kt + j * 128 + p * 64);
            float s0 = 0.f, s1 = 0.f;
#pragma unroll
            for (int d = 0; d < 16; d += 2) { const f32x4 k0 = kp[d], k1 = kp[d + 1];
                s0 += q[4 * d] * k0.x + q[4 * d + 1] * k0.y + q[4 * d + 2] * k0.z + q[4 * d + 3] * k0.w;
                s1 += q[4 * d + 4] * k1.x + q[4 * d + 5] * k1.y + q[4 * d + 6] * k1.z + q[4 * d + 7] * k1.w; }
            if (dist >= 0) {
                const float s = s0 + s1 + Bt[dist < 127 ? dist : 127];
                if (s > mx) { const float sc = __builtin_amdgcn_exp2f(mx - s); lsum *= sc;
#pragma unroll
                    for (int i = 0; i < 32; ++i) o[i] *= sc;
                    mx = s; }
                const float pw = __builtin_amdgcn_exp2f(s - mx); lsum += pw;
                const LAS f32x4* vp = (const LAS f32x4*)(Vt + j * 128 + dq * 32);
#pragma unroll
                for (int i = 0; i < 8; ++i) { const f32x4 v4 = vp[i]; o[4 * i] += pw * v4.x; o[4 * i + 1] += pw * v4.y; o[4 * i + 2] += pw * v4.z; o[4 * i + 3] += pw * v4.w; }
            }
        }
    }
    __syncthreads();
    LAS float* E = ldsf;
    { const float inv = 1.0f / lsum;
#pragma unroll
      for (int i = 0; i < 32; ++i) E[(p * 64 + lane) * 129 + dq * 32 + i] = o[i] * inv; }
    __syncthreads();
    { const int qq = F.tid >> 3, part = F.tid & 7; float dv[16]; float ss = 0.f;
#pragma unroll
      for (int i = 0; i < 16; ++i) { const int c = part * 16 + i; const float d = E[qq * 129 + c] - lam_full * E[(64 + qq) * 129 + c]; dv[i] = d; ss += d * d; }
      ss = sum8(ss);
      const float rstd = rsqrtf(ss * (1.0f / 128.0f) + 1e-6f) * (1.0f - lam_init);
      const float* sl = F.kin[I_DSUB] + l * 128 + part * 16;
      float f[8]; bf16* op = WSP(bf16, WS_MIXED) + (size_t)(b * SEQ + q0 + qq) * DM + h * 128 + part * 16;
#pragma unroll
      for (int e = 0; e < 8; ++e) f[e] = dv[e] * rstd * sl[e];
      *(v4u*)op = pack8(f);
#pragma unroll
      for (int e = 0; e < 8; ++e) f[e] = dv[8 + e] * rstd * sl[8 + e];
      *(v4u*)(op + 8) = pack8(f); }
}
__device__ __forceinline__ void swa_unit_v1(Frame& F, int l, int b, int kvh, int qt) {
    LAS float* ldsf = (LAS float*)(F.lds + RING_OFF);
    LAS float* Kt = ldsf; LAS float* Vt = ldsf + 192 * 68; LAS float* Bt = ldsf + 2 * 192 * 68;
    const int lane = F.lane, hd = kvh * 8 + F.wave, q0 = qt * 64, qpos = q0 + lane, kstart = q0 - 127;
    const bf16* QKD = WSP(bf16, WS_QKD); const bf16* COLS = WSP(bf16, WS_COLS); const float* TAB = WSP(float, WS_TAB);
    __syncthreads();
    for (int idx = F.tid; idx < 192 * 8; idx += NWAVES * 64) { const int r = idx >> 3, chn = idx & 7, key = kstart + r;
        float fk[8], fv[8];
        if (key >= 0 && r < 191) { const size_t krow = (size_t)(b * SEQ + key);
            unpack8(*(const v4u*)(QKD + krow * 1152 + 1024 + kvh * 64 + chn * 8), fk); unpack8(*(const v4u*)(COLS + krow * NMAIN + CD_V + kvh * 64 + chn * 8), fv); }
        else {
#pragma unroll
            for (int e = 0; e < 8; ++e) { fk[e] = 0.f; fv[e] = 0.f; } }
#pragma unroll
        for (int e = 0; e < 8; ++e) { Kt[r * 68 + chn * 8 + e] = fk[e]; Vt[r * 68 + chn * 8 + e] = fv[e]; } }
    for (int idx = F.tid; idx < 1024; idx += NWAVES * 64) Bt[idx] = TAB[(8 + kvh * 8 + (idx >> 7)) * 128 + (idx & 127)];
    float q[64];
    { const bf16* qp = QKD + (size_t)(b * SEQ + qpos) * 1152 + hd * 64;
#pragma unroll
      for (int i = 0; i < 8; ++i) { float f[8]; unpack8(*(const v4u*)(qp + 8 * i), f);
#pragma unroll
          for (int e = 0; e < 8; ++e) q[8 * i + e] = f[e]; } }
    __syncthreads();
    float o[64];
#pragma unroll
    for (int i = 0; i < 64; ++i) o[i] = 0.f;
    float mx = F.kin[I_SSINK][l * 16 + hd] * LOG2E, lsum = 1.0f;
#pragma unroll 1
    for (int jj = 0; jj < 128; ++jj) {
        const int key = qpos - 127 + jj;
        if (key >= 0) {
            const int r = lane + jj; const LAS f32x4* kp = (const LAS f32x4*)(Kt + r * 68);
            float s0 = 0.f, s1 = 0.f;
#pragma unroll
            for (int d = 0; d < 16; d += 2) { const f32x4 k0 = kp[d], k1 = kp[d + 1];
                s0 += q[4 * d] * k0.x + q[4 * d + 1] * k0.y + q[4 * d + 2] * k0.z + q[4 * d + 3] * k0.w;
                s1 += q[4 * d + 4] * k1.x + q[4 * d + 5] * k1.y + q[4 * d + 6] * k1.z + q[4 * d + 7] * k1.w; }
            const float s = s0 + s1 + Bt[F.wave * 128 + 127 - jj];
            if (s > mx) { const float sc = __builtin_amdgcn_exp2f(mx - s); lsum *= sc;
#pragma unroll
                for (int i = 0; i < 64; ++i) o[i] *= sc;
                mx = s; }
            const float pw = __builtin_amdgcn_exp2f(s - mx); lsum += pw;
            const LAS f32x4* vp = (const LAS f32x4*)(Vt + r * 68);
#pragma unroll
            for (int i = 0; i < 16; ++i) { const f32x4 v4 = vp[i]; o[4 * i] += pw * v4.x; o[4 * i + 1] += pw * v4.y; o[4 * i + 2] += pw * v4.z; o[4 * i + 3] += pw * v4.w; }
        }
    }
    { const float inv = 1.0f / lsum; bf16* op = WSP(bf16, WS_MIXED) + (size_t)(b * SEQ + qpos) * DM + 3072 + hd * 64;
#pragma unroll
      for (int i = 0; i < 8; ++i) { float f[8];
#pragma unroll
          for (int e = 0; e < 8; ++e) f[e] = o[8 * i + e] * inv;
          *(v4u*)(op + 8 * i) = pack8(f); } }
}
__device__ __forceinline__ void gla_unit_v1(Frame& F, int l, int b, int h) {
    LAS float* ldsf = (LAS float*)(F.lds + RING_OFF);
    LAS float* Ad = ldsf; LAS float* Kd = ldsf + 2048; LAS float* Qd = ldsf + 4096; LAS float* Vd = ldsf + 6144; LAS float* Ob = ldsf + 10240;
    const int dh = F.tid >> 8, vcol = F.tid & 255, lane = F.lane;
    const bf16* COLS = WSP(bf16, WS_COLS); const float* LOGA = WSP(float, WS_LOGA); bf16* MIX = WSP(bf16, WS_MIXED);
    float S[64];
#pragma unroll
    for (int d = 0; d < 64; ++d) S[d] = 0.f;
    float og[4];
#pragma unroll
    for (int e = 0; e < 4; ++e) og[e] = F.kin[I_GON][l * 256 + lane * 4 + e];
#pragma unroll 1
    for (int ck = 0; ck < SEQ / 16; ++ck) {
        const int row0 = b * SEQ + ck * 16;
        __syncthreads();
#pragma unroll 2
        for (int i = 0; i < 4; ++i) { const int idx = F.tid + 512 * i, tok = idx >> 7, c = idx & 127; const size_t row = (size_t)(row0 + tok);
            Ad[idx] = __expf(LOGA[row * 512 + h * 128 + c]); Kd[idx] = bf2f(COLS[row * NMAIN + CB_K + h * 128 + c]); Qd[idx] = bf2f(COLS[row * NMAIN + CB_Q + h * 128 + c]) * 0.08838834764831845f; }
#pragma unroll 4
        for (int i = 0; i < 8; ++i) { const int idx = F.tid + 512 * i, tok = idx >> 8, c = idx & 255; Vd[idx] = bf2f(COLS[(size_t)(row0 + tok) * NMAIN + CB_V + h * 256 + c]); }
        __syncthreads();
#pragma unroll 1
        for (int t = 0; t < 16; ++t) {
            const LAS f32x4* ap = (const LAS f32x4*)(Ad + t * 128 + dh * 64); const LAS f32x4* kp = (const LAS f32x4*)(Kd + t * 128 + dh * 64); const LAS f32x4* qp = (const LAS f32x4*)(Qd + t * 128 + dh * 64);
            float o0 = 0.f, o1 = 0.f; const float vt = Vd[t * 256 + vcol];
#pragma unroll
            for (int d = 0; d < 16; ++d) { const f32x4 a4 = ap[d], k4 = kp[d], q4 = qp[d];
                S[4 * d] = a4.x * S[4 * d] + k4.x * vt; S[4 * d + 1] = a4.y * S[4 * d + 1] + k4.y * vt; S[4 * d + 2] = a4.z * S[4 * d + 2] + k4.z * vt; S[4 * d + 3] = a4.w * S[4 * d + 3] + k4.w * vt;
                o0 += q4.x * S[4 * d] + q4.y * S[4 * d + 1]; o1 += q4.z * S[4 * d + 2] + q4.w * S[4 * d + 3];
                if ((d & 3) == 3) __builtin_amdgcn_sched_barrier(0); }
            Ob[t * 512 + F.tid] = o0 + o1;
        }
        __syncthreads();
#pragma unroll 1
        for (int i = 0; i < 2; ++i) { const int t = 2 * F.wave + i; const size_t row = (size_t)(row0 + t);
            const f32x4 xa = *(const LAS f32x4*)(Ob + t * 512 + lane * 4), xb = *(const LAS f32x4*)(Ob + t * 512 + 256 + lane * 4); const f32x4 x = xa + xb;
            const float ss = wave_sum(x.x * x.x + x.y * x.y + x.z * x.z + x.w * x.w); const float rstd = rsqrtf(ss * (1.0f / 256.0f) + 1e-6f);
            const v2u graw = *(const v2u*)(COLS + row * NMAIN + CB_G + h * 256 + lane * 4);
            const float g0 = bflo(graw.x), g1 = bfhi(graw.x), g2 = bflo(graw.y), g3 = bfhi(graw.y);
            v2u w; w.x = pk2(x.x * rstd * og[0] * silu_g(g0), x.y * rstd * og[1] * silu_g(g1)); w.y = pk2(x.z * rstd * og[2] * silu_g(g2), x.w * rstd * og[3] * silu_g(g3));
            *(v2u*)(MIX + row * DM + 1024 + h * 256 + lane * 4) = w; }
    }
}
__device__ __forceinline__ void rwkv_unit_v1(Frame& F, int l, int b, int hg) {
    const int lane = F.lane, h = hg * 8 + F.wave, c = h * 64 + lane;
    LAS float* st = (LAS float*)(F.lds + RING_OFF) + F.wave * 3584;
    const float* RW = WSP(float, WS_RW); bf16* MIX = WSP(bf16, WS_MIXED);
    constexpr size_t RS = RW_ONE / 4;
    float S[64];
#pragma unroll
    for (int j = 0; j < 64; ++j) S[j] = 0.f;
    const float lnw = F.kin[I_RLNW][l * 1024 + c], lnb = F.kin[I_RLNB][l * 1024 + c], rk = F.kin[I_RRK][l * 1024 + c];
#pragma unroll 1
    for (int ck = 0; ck < SEQ / 8; ++ck) {
        const size_t row0 = (size_t)b * SEQ + ck * 8;
#pragma unroll 2
        for (int s = 0; s < 8; ++s) { const size_t o = (row0 + s) * 1024 + c;
            st[(s * 7 + 0) * 64 + lane] = RW[o]; st[(s * 7 + 1) * 64 + lane] = RW[RS + o]; st[(s * 7 + 2) * 64 + lane] = RW[2 * RS + o];
            st[(s * 7 + 3) * 64 + lane] = RW[4 * RS + o]; st[(s * 7 + 4) * 64 + lane] = RW[5 * RS + o]; st[(s * 7 + 5) * 64 + lane] = RW[3 * RS + o]; st[(s * 7 + 6) * 64 + lane] = RW[6 * RS + o]; }
#pragma unroll 1
        for (int s = 0; s < 8; ++s) {
            const LAS f32x4* rp = (const LAS f32x4*)(st + (s * 7 + 0) * 64); const LAS f32x4* wp = (const LAS f32x4*)(st + (s * 7 + 1) * 64); const LAS f32x4* kp = (const LAS f32x4*)(st + (s * 7 + 2) * 64);
            const LAS f32x4* ap = (const LAS f32x4*)(st + (s * 7 + 3) * 64); const LAS f32x4* bp = (const LAS f32x4*)(st + (s * 7 + 4) * 64);
            float sa0 = 0.f, sa1 = 0.f;
#pragma unroll
            for (int j = 0; j < 16; ++j) { const f32x4 a4 = ap[j]; sa0 += S[4 * j] * a4.x + S[4 * j + 1] * a4.y; sa1 += S[4 * j + 2] * a4.z + S[4 * j + 3] * a4.w; }
            __builtin_amdgcn_sched_barrier(0);
            const float sa = sa0 + sa1, vs = st[(s * 7 + 5) * 64 + lane], gs = st[(s * 7 + 6) * 64 + lane]; float y0 = 0.f, y1 = 0.f;
#pragma unroll
            for (int j = 0; j < 16; ++j) { const f32x4 w4 = wp[j], b4 = bp[j], k4 = kp[j], r4 = rp[j];
                S[4 * j] = S[4 * j] * w4.x + sa * b4.x + vs * k4.x; S[4 * j + 1] = S[4 * j + 1] * w4.y + sa * b4.y + vs * k4.y;
                S[4 * j + 2] = S[4 * j + 2] * w4.z + sa * b4.z + vs * k4.z; S[4 * j + 3] = S[4 * j + 3] * w4.w + sa * b4.w + vs * k4.w;
                y0 += S[4 * j] * r4.x + S[4 * j + 1] * r4.y; y1 += S[4 * j + 2] * r4.z + S[4 * j + 3] * r4.w;
                if ((j & 3) == 3) __builtin_amdgcn_sched_barrier(0); }
            const float y = y0 + y1, mean = wave_sum(y) * (1.0f / 64.0f), dd = y - mean, var = wave_sum(dd * dd) * (1.0f / 64.0f);
            const float yl = dd * rsqrtf(var + 64e-5f) * lnw + lnb;
            const float bonus = wave_sum(st[(s * 7 + 0) * 64 + lane] * st[(s * 7 + 2) * 64 + lane] * rk) * vs;
            MIX[(row0 + s) * DM + 2048 + c] = (bf16)f2bf((yl + bonus) * gs);
        }
    }
}
__device__ __forceinline__ int next_item(Frame& F, gu32* ctr) {
    volatile LAS int* slot = (volatile LAS int*)(F.lds + LDSCTL_OFF + 64);
    __syncthreads();
    if (F.tid == 0) *slot = (int)__hip_atomic_fetch_add(ctr, 1u, RLX_AGENT);
    __syncthreads();
    return *slot;
}
__device__ __forceinline__ void mixers_v1(Frame& F, int l) {
    gu32* ctr = F.ctl + CW_Q + 64 * l;
    for (;;) {
        const int it = next_item(F, ctr); relaunder(F); relaunder_tid(F);
        if (it < 4) { rwkv_unit_v1(F, l, it >> 1, it & 1); }
        else if (it < 12) { const int j = it - 4; gla_unit_v1(F, l, j >> 2, j & 3); }
        else if (it < 12 + 2048) { const int j = it - 12, qt = 127 - (j >> 4), bh = j & 15; diff_unit_v1(F, l, bh >> 3, bh & 7, qt); }
        else if (it < 12 + 2048 + 512) { const int j = it - 2060, qt = j & 127, bk = j >> 7; swa_unit_v1(F, l, bk >> 1, bk & 1, qt); }
        else break;
    }
}
__device__ __forceinline__ void prep_vt(Frame& F) {
    LAS bf16* T = (LAS bf16*)(F.lds + RING_OFF);
    const bf16* COLS = WSP(bf16, WS_COLS); bf16* VTA = WSP(bf16, WS_VTA); bf16* VTD = WSP(bf16, WS_VTD);
    for (int tile = F.bx; tile < M / 32; tile += F.G) {
        const int b = tile >> 8, t0 = (tile & 255) * 32;
        __syncthreads();
        for (int idx = F.tid; idx < 32 * 144; idx += NWAVES * 64) { const int tok = idx / 144, ch = idx % 144;
            const bf16* src = COLS + (size_t)(b * SEQ + t0 + tok) * NMAIN + (ch < 128 ? CA_V + ch * 8 : CD_V + (ch - 128) * 8);
            const v4u v = *(const v4u*)src; LAS v2u* d = (LAS v2u*)(T + tok * 1160 + ch * 8); d[0] = (v2u){v.x, v.y}; d[1] = (v2u){v.z, v.w}; }
        __syncthreads();
        for (int idx = F.tid; idx < 1152 * 4; idx += NWAVES * 64) { const int ch = idx / 1152, vrow = idx % 1152;
            unsigned e[8];
#pragma unroll
            for (int k = 0; k < 8; ++k) e[k] = T[(ch * 8 + k) * 1160 + vrow];
            v4u o; o.x = e[0] | (e[1] << 16); o.y = e[2] | (e[3] << 16); o.z = e[4] | (e[5] << 16); o.w = e[6] | (e[7] << 16);
            bf16* dst = vrow < 1024 ? VTA + ((size_t)(b * 8 + (vrow >> 7)) * 128 + (vrow & 127)) * SEQ : VTD + ((size_t)(b * 2 + ((vrow - 1024) >> 6)) * 64 + ((vrow - 1024) & 63)) * SEQ;
            *(v4u*)(dst + t0 + ch * 8) = o; }
    }
}
typedef float f32x16 __attribute__((ext_vector_type(16)));
__device__ __forceinline__ float xother32(float v) { unsigned a = __builtin_bit_cast(unsigned, v), b = a; asm volatile("" : "+v"(b)); auto rr = __builtin_amdgcn_permlane32_swap(a, b, false, false);
    const unsigned lo = rr[0], hi = rr[1]; return __builtin_bit_cast(float, (unsigned)((__builtin_amdgcn_mbcnt_hi(~0u, __builtin_amdgcn_mbcnt_lo(~0u, 0u)) & 32u) ? lo : hi)); }
__device__ __forceinline__ float xsum32(float v) { return v + xother32(v); }
__device__ __forceinline__ float xmax32(float v) { return fmaxf(v, xother32(v)); }
__device__ __forceinline__ int crow16(int r, int hi) { return (r & 3) + 8 * (r >> 2) + 4 * hi; }
template <bool ISA>
__device__ __forceinline__ void attn_unit(Frame& F, int l, int b, int hx, int qb) {
    constexpr int DV = ISA ? 128 : 64, NDV = DV / 32, KSTR = ISA ? 272 : 144, VSTR = 144, KBYTES = 64 * KSTR, VBYTES = DV * VSTR, BUFB = KBYTES + VBYTES, NCH = ISA ? 2 : 1;
    constexpr float NEG = -1e30f;
    LAS unsigned char* L = F.lds + RING_OFF;
    const int tid = F.tid, lane = F.lane, r32 = lane & 31, hi = lane >> 5, qs = F.wave & 3, grp = F.wave >> 2, q0 = qb * 128;
    const int kvh = hx >> 2, hd = kvh * 8 + (hx & 3) * 2 + grp;
    const bf16* Qp; const bf16* Kp; const bf16* VT; int ldq;
    if (ISA) { const bf16* QKA = WSP(bf16, WS_QKA); Qp = QKA + (size_t)b * SEQ * 2048 + hx * 128 + grp * 64; Kp = QKA + (size_t)b * SEQ * 2048 + 1024 + hx * 128; ldq = 2048; VT = WSP(bf16, WS_VTA) + (size_t)(b * 8 + hx) * 128 * SEQ; }
    else { const bf16* QKD = WSP(bf16, WS_QKD); Qp = QKD + (size_t)b * SEQ * 1152 + hd * 64; Kp = QKD + (size_t)b * SEQ * 1152 + 1024 + kvh * 64; ldq = 1152; VT = WSP(bf16, WS_VTD) + (size_t)(b * 2 + kvh) * 64 * SEQ; }
    const int qpos = q0 + 32 * qs + r32;
    bf16x8 qr[4];
#pragma unroll
    for (int d0 = 0; d0 < 4; ++d0) qr[d0] = *(const bf16x8*)(Qp + (size_t)qpos * ldq + d0 * 16 + hi * 8);
    LAS float* Bt = (LAS float*)(L + 2 * BUFB);
    { const float* TAB = WSP(float, WS_TAB);
      if (ISA) { if (tid < 128) Bt[tid] = TAB[hx * 128 + tid] - TAB[hx * 128 + 127]; }
      else { if (tid < 256) Bt[tid] = TAB[(8 + kvh * 8 + (hx & 3) * 2 + (tid >> 7)) * 128 + (tid & 127)]; } }
    const int TQ = q0 >> 6, T0 = ISA ? 0 : (TQ >= 2 ? TQ - 2 : 0), T1 = TQ + 1;
    v4u kreg[NCH], vreg[NCH];
#define AT_GLOAD(T) do { _Pragma("unroll") for (int i_ = 0; i_ < NCH; ++i_) { const int c_ = tid + 512 * i_; \
        const int kr_ = ISA ? (c_ >> 4) : (c_ >> 3), kc_ = ISA ? (c_ & 15) : (c_ & 7); kreg[i_] = *(const v4u*)(Kp + (size_t)((T) * 64 + kr_) * ldq + kc_ * 8); \
        const int vr_ = c_ >> 3, vc_ = c_ & 7; vreg[i_] = *(const v4u*)(VT + (size_t)vr_ * SEQ + (T) * 64 + vc_ * 8); } } while (0)
#define AT_LWRITE(buf) do { _Pragma("unroll") for (int i_ = 0; i_ < NCH; ++i_) { const int c_ = tid + 512 * i_; \
        const int kr_ = ISA ? (c_ >> 4) : (c_ >> 3), kc_ = ISA ? (c_ & 15) : (c_ & 7); *(LAS v4u*)(L + (buf) * BUFB + kr_ * KSTR + kc_ * 16) = kreg[i_]; \
        const int vr_ = c_ >> 3, vc_ = c_ & 7; *(LAS v4u*)(L + (buf) * BUFB + KBYTES + vr_ * VSTR + vc_ * 16) = vreg[i_]; } } while (0)
    f32x16 o[NDV];
#pragma unroll
    for (int i = 0; i < NDV; ++i) o[i] = (f32x16){0.f, 0.f, 0.f, 0.f, 0.f, 0.f, 0.f, 0.f, 0.f, 0.f, 0.f, 0.f, 0.f, 0.f, 0.f, 0.f};
    float m_run = ISA ? NEG : F.kin[I_SSINK][l * 16 + hd] * LOG2E, l_run = ISA ? 0.f : (hi == 0 ? 1.f : 0.f);
    const int krow = (r32 & 16) | (r32 & 3) | ((r32 & 4) << 1) | ((r32 & 8) >> 1);
    const int koff = krow * KSTR + (ISA ? grp * 128 : 0) + hi * 16, voff = KBYTES + r32 * VSTR + hi * 16;
    AT_GLOAD(T0); AT_LWRITE(0); __syncthreads();
#pragma unroll 1
    for (int T = T0; T <= T1; ++T) {
        const int cur = (T - T0) & 1;
        if (T < T1) AT_GLOAD(T + 1);
        LAS const unsigned char* Kb = L + cur * BUFB;
        f32x16 s[2];
#pragma unroll
        for (int blk = 0; blk < 2; ++blk) { s[blk] = (f32x16){0.f, 0.f, 0.f, 0.f, 0.f, 0.f, 0.f, 0.f, 0.f, 0.f, 0.f, 0.f, 0.f, 0.f, 0.f, 0.f};
#pragma unroll
            for (int d0 = 0; d0 < 4; ++d0) { const bf16x8 kf = *(const LAS bf16x8*)(Kb + koff + blk * 32 * KSTR + d0 * 32); s[blk] = __builtin_amdgcn_mfma_f32_32x32x16_bf16(kf, qr[d0], s[blk], 0, 0, 0); } }
        if (!ISA || T >= TQ - 2) {
#pragma unroll
            for (int blk = 0; blk < 2; ++blk)
#pragma unroll
                for (int r = 0; r < 16; ++r) { const int kvl = 32 * blk + 16 * (r >> 3) + 8 * hi + (r & 7), dist = qpos - (T * 64 + kvl);
                    const int di = dist < 0 ? 0 : (dist > 127 ? 127 : dist);
                    const float bv = Bt[(ISA ? 0 : grp * 128) + di];
                    if (ISA) s[blk][r] = dist < 0 ? NEG : (dist < 128 ? s[blk][r] + bv : s[blk][r]);
                    else s[blk][r] = (dist < 0 || dist > 127) ? NEG : s[blk][r] + bv; } }
        float mt = s[0][0];
#pragma unroll
        for (int r = 1; r < 16; ++r) mt = fmaxf(mt, s[0][r]);
#pragma unroll
        for (int r = 0; r < 16; ++r) mt = fmaxf(mt, s[1][r]);
        mt = xmax32(mt);
        const float m_new = fmaxf(m_run, mt);
        if (__any(m_new > m_run)) { const float alpha = __builtin_amdgcn_exp2f(m_run - m_new); l_run *= alpha;
#pragma unroll
            for (int i = 0; i < NDV; ++i)
#pragma unroll
                for (int r = 0; r < 16; ++r) o[i][r] *= alpha;
            m_run = m_new; }
        float ls = 0.f;
#pragma unroll
        for (int blk = 0; blk < 2; ++blk)
#pragma unroll
            for (int r = 0; r < 16; ++r) { const float pv_ = __builtin_amdgcn_exp2f(s[blk][r] - m_run); s[blk][r] = pv_; ls += pv_; }
        l_run += ls;
#pragma unroll
        for (int sl = 0; sl < 4; ++sl) { const int blk = sl >> 1, r0 = 8 * (sl & 1);
            v4u pw; pw.x = pg8::cvt_pk_bf16(s[blk][r0], s[blk][r0 + 1]); pw.y = pg8::cvt_pk_bf16(s[blk][r0 + 2], s[blk][r0 + 3]); pw.z = pg8::cvt_pk_bf16(s[blk][r0 + 4], s[blk][r0 + 5]); pw.w = pg8::cvt_pk_bf16(s[blk][r0 + 6], s[blk][r0 + 7]);
            const bf16x8 pf = __builtin_bit_cast(bf16x8, pw);
#pragma unroll
            for (int i = 0; i < NDV; ++i) { const bf16x8 vf = *(const LAS bf16x8*)(Kb + voff + i * 32 * VSTR + sl * 32); o[i] = __builtin_amdgcn_mfma_f32_32x32x16_bf16(vf, pf, o[i], 0, 0, 0); } }
        if (T < T1) AT_LWRITE(cur ^ 1);
        __syncthreads();
    }
#undef AT_GLOAD
#undef AT_LWRITE
    const float inv = 1.0f / xsum32(l_run);
    bf16* MIX = WSP(bf16, WS_MIXED);
    if (ISA) {
        const float lam_init = 0.8f - 0.6f * __expf(-0.3f * (float)l); float lam_full;
        { const float* lm = F.kin[I_DLAM] + (size_t)l * 256; const float s1 = wave_sum(lm[lane] * lm[64 + lane]), s2 = wave_sum(lm[128 + lane] * lm[192 + lane]); lam_full = __expf(s1) - __expf(s2) + lam_init; }
        LAS float* R1 = (LAS float*)L;
        LAS bf16* R2 = (LAS bf16*)(L + 66048);
        const int ql = 32 * qs + r32;
        if (grp == 1) {
#pragma unroll
            for (int i = 0; i < NDV; ++i)
#pragma unroll
                for (int r = 0; r < 16; ++r) R1[ql * 129 + 32 * i + crow16(r, hi)] = lam_full * inv * o[i][r]; }
        __syncthreads();
        if (grp == 0) { float ss = 0.f;
#pragma unroll
            for (int i = 0; i < NDV; ++i)
#pragma unroll
                for (int r = 0; r < 16; ++r) { const float d = o[i][r] * inv - R1[ql * 129 + 32 * i + crow16(r, hi)]; o[i][r] = d; ss += d * d; }
            const float rstd = rsqrtf(xsum32(ss) * (1.0f / 128.0f) + 1e-6f) * (1.0f - lam_init);
            const float* sl = F.kin[I_DSUB] + l * 128;
#pragma unroll
            for (int i = 0; i < NDV; ++i)
#pragma unroll
                for (int r = 0; r < 16; ++r) { const int dv = 32 * i + crow16(r, hi); R2[ql * 132 + dv] = (bf16)f2bf(o[i][r] * rstd * sl[dv]); } }
        __syncthreads();
#pragma unroll
        for (int i = 0; i < 4; ++i) { const int c = tid + 512 * i, row = c >> 4, ch = c & 15; const LAS v2u* sp = (const LAS v2u*)(R2 + row * 132 + ch * 8); const v2u a = sp[0], bb = sp[1];
            *(v4u*)(MIX + (size_t)(b * SEQ + q0 + row) * DM + hx * 128 + ch * 8) = (v4u){a.x, a.y, bb.x, bb.y}; }
    } else {
        LAS bf16* R = (LAS bf16*)L + F.wave * 2176;
#pragma unroll
        for (int i = 0; i < NDV; ++i)
#pragma unroll
            for (int r = 0; r < 16; ++r) R[r32 * 68 + 32 * i + crow16(r, hi)] = (bf16)f2bf(o[i][r] * inv);
#pragma unroll
        for (int i = 0; i < 4; ++i) { const int c = lane + 64 * i, row = c >> 3, ch = c & 7; const LAS v2u* sp = (const LAS v2u*)(R + row * 68 + ch * 8); const v2u a = sp[0], bb = sp[1];
            *(v4u*)(MIX + (size_t)(b * SEQ + q0 + 32 * qs + row) * DM + 3072 + hd * 64 + ch * 8) = (v4u){a.x, a.y, bb.x, bb.y}; }
    }
}
__device__ __forceinline__ void mixers_v2(Frame& F, int l) {
    gu32* ctr = F.ctl + CW_Q + 64 * l;
    for (;;) {
        const int it = next_item(F, ctr); relaunder(F); relaunder_tid(F);
        if (it < 4) { rwkv_unit_v1(F, l, it >> 1, it & 1); }
        else if (it < 12) { const int j = it - 4; gla_unit_v1(F, l, j >> 2, j & 3); }
        else if (it < 12 + 1024) { const int j = it - 12, qb = 63 - (j >> 4), bh = j & 15; attn_unit<true>(F, l, bh >> 3, bh & 7, qb); }
        else if (it < 12 + 2048) { const int j = it - 1036, qb = j & 63, bh = j >> 6; attn_unit<false>(F, l, bh >> 3, bh & 7, qb); }
        else break;
    }
}
struct Args { const float* in[35]; float* out; unsigned char* ws; };
__device__ __forceinline__ void mk_frame(Frame& F, int wv) {
    extern __shared__ __attribute__((aligned(16))) unsigned char lds[];
    kargp kp = (kargp)__builtin_amdgcn_kernarg_segment_ptr(); asm volatile("" : "+s"(kp));
    F.kin = kp;
    F.lds = (LAS unsigned char*)lds;
    F.MISC = (volatile LAS unsigned*)(F.lds + MISC_OFF);
    { int t_ = wv * 64 + (int)__builtin_amdgcn_mbcnt_hi(~0u, __builtin_amdgcn_mbcnt_lo(~0u, 0u)); asm volatile("" : "+v"(t_)); F.tid = t_; } F.lane = F.tid & 63; F.wave = __builtin_amdgcn_readfirstlane(F.tid >> 6);
    F.G = gridDim.x; { int bx = blockIdx.x; asm volatile("" : "+s"(bx)); F.bx = bx; F.vcu = (F.G % 8 == 0) ? (bx % 8) * (F.G / 8) + bx / 8 : bx; }
    F.out = (float*)kp[35]; F.ws = (unsigned char*)kp[36]; F.ctl = (gu32*)(F.ws + WS_CTL);
}
__device__ __forceinline__ void grid_bar(int wv) {
    Frame F; mk_frame(F, wv);
    XcdBarrier bar; bar.bar = (unsigned*)(F.ctl + CW_BAR); bar.x = xb_xcc_id(); bar.st = F.MISC + 8;
    xcd_barrier(bar);
}
__global__ void __launch_bounds__(NWAVES * 64, 2) mega_fwd(Args args) {
    const int wv = __builtin_amdgcn_readfirstlane((int)threadIdx.x >> 6);
    { Frame F; mk_frame(F, wv);
      for (int u = F.tid; u < (LDS_BYTES - LDSCTL_OFF) / 4; u += NWAVES * 64) ((LAS unsigned*)(F.lds + LDSCTL_OFF))[u] = 0u;
      __syncthreads();
      (void)xcd_barrier_post((unsigned*)(F.ctl + CW_BAR), F.MISC + 8);
#ifndef NO_P0
      p0_prologue_a(F);
#endif
    }
    grid_bar(wv);
    { Frame F; mk_frame(F, wv); p0_prologue_b(F); }
    grid_bar(wv);
#pragma unroll 1
    for (int l = 0; l < NLAYER; ++l) {
#define LAYER_VARS const float* mod = WSP(float, WS_MOD) + (size_t)l * 2 * 24576; const float* xin = l == 0 ? F.kin[I_X] : F.out; (void)mod; (void)xin
#ifndef NO_RMS
        { Frame F; mk_frame(F, wv); LAYER_VARS; rms_phase(F, xin, mod + 0, mod + 4096); }
#endif
        grid_bar(wv);
#ifndef NO_G1
        { Frame F; mk_frame(F, wv);
          pg8::Gemm g{WSP(pg8::bf16_t, WS_XN), WSP(pg8::bf16_t, WS_WIN + l * WIN_L), M, NIN, DM}; pg8::StaticOrder S; S.init(M, NIN, F.G, F.bx);
          pg8::EpiCols E{WSP(pg8::bf16_t, WS_COLS), WSP(float, WS_LOWR)};
          pg8::gemm_phase<pg8::EpiCols, pg8::StaticOrder, true, true>(F.lds + RING_OFF, g, S, E, F.tid); }
#endif
        grid_bar(wv);
#ifndef NO_PREP
        { Frame F; mk_frame(F, wv); prep_norm(F, l); }
        { Frame F; mk_frame(F, wv); prep_loga(F, l); }
        { Frame F; mk_frame(F, wv); prep_rwkv(F, l); }
        { Frame F; mk_frame(F, wv); prep_vt(F); }
#endif
        grid_bar(wv);
#ifndef NO_MIX
        { Frame F; mk_frame(F, wv); mixers_v2(F, l); }
#endif
        grid_bar(wv);
#ifndef NO_G2
        { Frame F; mk_frame(F, wv); LAYER_VARS;
          pg8::Gemm g{WSP(pg8::bf16_t, WS_MIXED), WSP(pg8::bf16_t, WS_WOUT + l * WOUT_L), M, DM, DM}; pg8::StaticOrder S; S.init(M, DM, F.G, F.bx);
          pg8::EpiRes E{xin, F.out, mod + 2 * 4096};
          pg8::gemm_phase<pg8::EpiRes, pg8::StaticOrder, true, true>(F.lds + RING_OFF, g, S, E, F.tid); }
#endif
        grid_bar(wv);
        { Frame F; mk_frame(F, wv); LAYER_VARS; rms_phase(F, F.out, mod + 3 * 4096, mod + 4 * 4096); }
        grid_bar(wv);
#ifndef NO_G3
        { Frame F; mk_frame(F, wv);
          pg8::Gemm g{WSP(pg8::bf16_t, WS_XN), WSP(pg8::bf16_t, WS_W13 + l * W13_L), M, 2 * DFF, DM}; pg8::StaticOrder S; S.init(M, 2 * DFF, F.G, F.bx);
          pg8::EpiSwiglu E{WSP(pg8::bf16_t, WS_HID)};
          pg8::gemm_phase<pg8::EpiSwiglu, pg8::StaticOrder, true, true>(F.lds + RING_OFF, g, S, E, F.tid); }
#endif
        grid_bar(wv);
#ifndef NO_G4
        { Frame F; mk_frame(F, wv); LAYER_VARS;
          pg8::Gemm g{WSP(pg8::bf16_t, WS_HID), WSP(pg8::bf16_t, WS_W2 + l * W2_L), M, DM, DFF}; pg8::StaticOrder S; S.init(M, DM, F.G, F.bx);
          pg8::EpiRes E{F.out, F.out, mod + 5 * 4096};
          pg8::gemm_phase<pg8::EpiRes, pg8::StaticOrder, true, true>(F.lds + RING_OFF, g, S, E, F.tid); }
#endif
        if (l + 1 < NLAYER) grid_bar(wv);
#undef LAYER_VARS
    }
}

extern "C" void kernel_launch(void* const* d_in, const int* in_sizes, int n_in, void* d_out, int out_size, void* d_ws, size_t ws_size, hipStream_t stream) {
    static int grid = 0;
    if (grid == 0) {
        if (n_in != 35 || in_sizes[0] != M * DM || out_size != M * DM || ws_size < WS_END) { fprintf(stderr, "kernel_launch: unexpected shapes: n_in %d in0 %d out %d ws %zu (need %zu)\n", n_in, n_in > 0 ? in_sizes[0] : -1, out_size, ws_size, (size_t)WS_END); grid = -1; return; }
        int dev = 0, cus = 0, per_cu = 0;
        if (hipGetDevice(&dev) != hipSuccess || hipDeviceGetAttribute(&cus, hipDeviceAttributeMultiprocessorCount, dev) != hipSuccess) { grid = -1; return; }
        if (hipFuncSetAttribute((const void*)mega_fwd, hipFuncAttributeMaxDynamicSharedMemorySize, LDS_BYTES) != hipSuccess) { fprintf(stderr, "kernel_launch: hipFuncSetAttribute failed\n"); grid = -1; return; }
        if (hipOccupancyMaxActiveBlocksPerMultiprocessor(&per_cu, (const void*)mega_fwd, NWAVES * 64, LDS_BYTES) != hipSuccess || per_cu < 1) fprintf(stderr, "kernel_launch: occupancy query says %d\n", per_cu);
        (void)hipGetLastError();
        grid = cus;
    }
    if (grid < 0) return;
    if (hipMemsetAsync((char*)d_ws + WS_CTL, 0, CTL_ZERO_BYTES, stream) != hipSuccess) return;
    Args a{};
    for (int i = 0; i < 35; ++i) a.in[i] = (const float*)d_in[i];
    a.out = (float*)d_out; a.ws = (unsigned char*)d_ws;
    hipLaunchKernelGGL(mega_fwd, dim3(grid), dim3(NWAVES * 64), LDS_BYTES, stream, a);
}
```

```cpp
#include <hip/hip_runtime.h>
#include <cstdio>
#include <cstdint>
namespace pg8 {
#define PG8_LAS __attribute__((address_space(3)))
typedef unsigned short bf16_t;
typedef short bf16x8 __attribute__((ext_vector_type(8)));
typedef float f32x4 __attribute__((ext_vector_type(4)));
typedef unsigned u32x4 __attribute__((ext_vector_type(4)));
constexpr int BM = 256, BK = 64, HALF = 128, HTB = HALF * BK * 2  , STAGE_BYTES = 8 * HTB, NXCD = 8, WGM = 8;

__host__ __device__ __forceinline__ int lds_byte(int r, int c) { const int st = (r >> 4) * 2 + (c >> 5), rr = r & 15, cc = c & 31, ob = rr * 64 + cc * 2; return st * 1024 + (ob ^ (((ob >> 9) & 1) << 5)); }
__host__ __device__ __forceinline__ void stage_rc(int b, int& R, int& C) { const int st = b / 1024, sb = b % 1024, swz = sb ^ (((sb >> 9) & 1) << 5); R = (st >> 1) * 16 + swz / 64; C = (st & 1) * 32 + (swz % 64) / 2; }
__host__ __device__ __forceinline__ int perm32(int rho) { const int n = rho >> 4, i = rho & 15; return 8 * (i >> 2) + 4 * n + (i & 3); }

struct Unit { int pm, pn; };
struct Gemm { const bf16_t* A; const bf16_t* Bt; int M, N, K; };

struct StaticOrder {
    int nM, nN, nwg, G, c;
    __host__ __device__ void init(int M, int N, int G_, int c_) { nM = M / BM; nN = N / BM; nwg = nM * nN; G = G_; c = c_; }
    __host__ __device__ bool next(int i, Unit& u) const {
        const long L = (long)i * G + c; if (L >= nwg) return false;
        int wgid = (int)L; { const int q = nwg / NXCD, r = nwg % NXCD, xcd = wgid % NXCD, off = wgid / NXCD; wgid = (xcd < r ? xcd * (q + 1) : r * (q + 1) + (xcd - r) * q) + off; }
        const int nig = WGM * nN, gid = wgid / nig, fm = gid * WGM, gsz = (nM - fm) < WGM ? (nM - fm) : WGM;
        u.pm = fm + ((wgid % nig) % gsz); u.pn = (wgid % nig) / gsz; return true;
    }
    __device__ __forceinline__ void a_ready(const Unit&) const {}
    __device__ __forceinline__ void done(const Unit&) const {}
};

__device__ __forceinline__ unsigned cvt_pk_bf16(float lo, float hi) { unsigned r; asm volatile("v_cvt_pk_bf16_f32 %0, %1, %2" : "=v"(r) : "v"(lo), "v"(hi)); return r; }
typedef float f32x2 __attribute__((ext_vector_type(2)));
__device__ __forceinline__ float silu_f(float x) { return x * __builtin_amdgcn_rcpf(1.0f + __builtin_amdgcn_exp2f(-1.4426950408889634f * x)); }
struct EpiCols {
    static constexpr bool PERM = true, AFTER_DRAIN = false;
    bf16_t* O; float* L;
    __device__ __forceinline__ void operator()(const f32x4 (&acc)[2][2][4][2], const Unit& u, int wr, int wc, int fr, int fq) const {
        const int row0 = u.pm * BM + wr * 64 + fr;
        if (u.pn < 41) {
            const int col0 = u.pn * BM + wc * 32 + 8 * fq;
#pragma unroll
            for (int ai = 0; ai < 2; ++ai)
#pragma unroll
                for (int m = 0; m < 4; ++m) { bf16_t* rowp = O + (size_t)(row0 + ai * HALF + m * 16) * 10496 + col0;
#pragma unroll
                    for (int bj = 0; bj < 2; ++bj) { const f32x4 v0 = acc[ai][bj][m][0], v1 = acc[ai][bj][m][1];
                        u32x4 w; w.x = cvt_pk_bf16(v0[0], v0[1]); w.y = cvt_pk_bf16(v0[2], v0[3]); w.z = cvt_pk_bf16(v1[0], v1[1]); w.w = cvt_pk_bf16(v1[2], v1[3]);
                        *(u32x4*)(rowp + bj * HALF) = w; } }
        } else {
            const int col0 = wc * 32 + 8 * fq;
#pragma unroll
            for (int ai = 0; ai < 2; ++ai)
#pragma unroll
                for (int m = 0; m < 4; ++m) { float* rowp = L + (size_t)(row0 + ai * HALF + m * 16) * 256 + col0;
#pragma unroll
                    for (int bj = 0; bj < 2; ++bj) { *(f32x4*)(rowp + bj * HALF) = acc[ai][bj][m][0]; *(f32x4*)(rowp + bj * HALF + 4) = acc[ai][bj][m][1]; } }
        }
    }
};
struct EpiRes {
    static constexpr bool PERM = false, AFTER_DRAIN = false;
    const float* base; float* out; const float* gate;
    __device__ __forceinline__ void operator()(const f32x4 (&acc)[2][2][4][2], const Unit& u, int wr, int wc, int fr, int fq) const {
        const int row0 = u.pm * BM + wr * 64 + fr, col0 = u.pn * BM + wc * 32 + 4 * fq;
        const float* gp = gate + (size_t)(u.pm >> 5) * 24576 + col0;
        f32x4 gv[2][2];
#pragma unroll
        for (int bj = 0; bj < 2; ++bj)
#pragma unroll
            for (int n = 0; n < 2; ++n) gv[bj][n] = *(const f32x4*)(gp + bj * HALF + n * 16);
#pragma unroll
        for (int ai = 0; ai < 2; ++ai)
#pragma unroll
            for (int m = 0; m < 4; ++m) { const size_t off = (size_t)(row0 + ai * HALF + m * 16) * 4096 + col0;
#pragma unroll
                for (int bj = 0; bj < 2; ++bj)
#pragma unroll
                    for (int n = 0; n < 2; ++n) { const f32x4 bs = *(const f32x4*)(base + off + bj * HALF + n * 16); *(f32x4*)(out + off + bj * HALF + n * 16) = bs + gv[bj][n] * acc[ai][bj][m][n]; }
                if (m & 1) asm volatile("" ::: "memory"); }
    }
};
struct EpiSwiglu {
    static constexpr bool PERM = true, AFTER_DRAIN = false;
    bf16_t* H;
    __device__ __forceinline__ void operator()(const f32x4 (&acc)[2][2][4][2], const Unit& u, int wr, int wc, int fr, int fq) const {
        const int row0 = u.pm * BM + wr * 64 + fr, col0 = u.pn * HALF + wc * 32 + 8 * fq;
#pragma unroll
        for (int ai = 0; ai < 2; ++ai)
#pragma unroll
            for (int m = 0; m < 4; ++m) { bf16_t* rowp = H + (size_t)(row0 + ai * HALF + m * 16) * 11008 + col0;
                const f32x4 a0 = acc[ai][0][m][0], a1 = acc[ai][0][m][1], b0 = acc[ai][1][m][0], b1 = acc[ai][1][m][1];
                u32x4 w; w.x = cvt_pk_bf16(silu_f(a0[0]) * b0[0], silu_f(a0[1]) * b0[1]); w.y = cvt_pk_bf16(silu_f(a0[2]) * b0[2], silu_f(a0[3]) * b0[3]);
                w.z = cvt_pk_bf16(silu_f(a1[0]) * b1[0], silu_f(a1[1]) * b1[1]); w.w = cvt_pk_bf16(silu_f(a1[2]) * b1[2], silu_f(a1[3]) * b1[3]);
                *(u32x4*)rowp = w; }
    }
};
template <class Epi, class Sched, bool ALIGN_EPI = false, bool SP2 = false>
__device__ __forceinline__ void gemm_phase(PG8_LAS unsigned char* lds, const Gemm g, const Sched& S, const Epi& E, int tid_in) {
    int tid_ = tid_in; asm volatile("" : "+v"(tid_));
    const int tid = tid_, wid = __builtin_amdgcn_readfirstlane(tid >> 6), lane = tid & 63, wr = wid >> 2, wc = wid & 3, fr = lane & 15, fq = lane >> 4;
    const int K = g.K, nt = K / BK;
    unsigned voffA[2], voffB[2];
#pragma unroll
    for (int i = 0; i < 2; ++i) { int R, C; stage_rc(tid * 16 + i * 8192, R, C); const int Rb = Epi::PERM ? ((R & ~31) + perm32(R & 31)) : R;
        voffA[i] = (unsigned)(R * K + C) * 2u; voffB[i] = (unsigned)(Rb * K + C) * 2u; }
    const size_t kstep = (size_t)(BK * 2);
    const size_t hstep = (size_t)HALF * K * 2;
    const size_t tstep = 2 * hstep;
    const unsigned ldsw = (unsigned)wid * 1024u;
    const int aoff = lds_byte(wr * 64 + fr, fq * 8), boff = lds_byte(wc * 32 + fr, fq * 8);
#define PG8_SA(b, h) (((b) * 2 + (h)) * HTB)
#define PG8_SB(b, h) ((4 + (b) * 2 + (h)) * HTB)
#define PG8_STAGE(bufoff, gbase, voff) do { _Pragma("unroll") for (int _i = 0; _i < 2; ++_i) \
        __builtin_amdgcn_global_load_lds((const unsigned*)((const char*)(gbase) + (voff)[_i]), (PG8_LAS unsigned*)(lds + (bufoff) + ldsw + _i * 8192), 16, 0, 0); } while (0)
#define PG8_LDA(dst, b, h) do { _Pragma("unroll") for (int m = 0; m < 4; ++m) _Pragma("unroll") for (int k = 0; k < 2; ++k) dst[m][k] = *(const PG8_LAS bf16x8*)(lds + PG8_SA(b, h) + aoff + m * 2048 + k * 1024); } while (0)
#define PG8_LDB(dst, b, h) do { _Pragma("unroll") for (int n = 0; n < 2; ++n) _Pragma("unroll") for (int k = 0; k < 2; ++k) dst[n][k] = *(const PG8_LAS bf16x8*)(lds + PG8_SB(b, h) + boff + n * 2048 + k * 1024); } while (0)
#define PG8_MMA(ai, bj, At, Bt) do { __builtin_amdgcn_s_setprio(1); _Pragma("unroll") for (int m = 0; m < 4; ++m) _Pragma("unroll") for (int n = 0; n < 2; ++n) _Pragma("unroll") for (int k = 0; k < 2; ++k) \
        acc[ai][bj][m][n] = __builtin_amdgcn_mfma_f32_16x16x32_bf16(Bt[n][k], At[m][k], acc[ai][bj][m][n], 0, 0, 0); __builtin_amdgcn_s_setprio(0); } while (0)
#define PG8_WAIT_V(n) asm volatile("s_waitcnt vmcnt(" #n ")" ::: "memory")
#define PG8_WAIT_L(n) asm volatile("s_waitcnt lgkmcnt(" #n ")" ::: "memory")
#define PG8_BAR __builtin_amdgcn_s_barrier()
#define PG8_SCHED __builtin_amdgcn_sched_barrier(0)
    Unit cur, nxt; int ui = 0;
    if (!S.next(0, cur)) return;
    f32x4 acc[2][2][4][2];
#pragma unroll
    for (int a = 0; a < 2; ++a)
#pragma unroll
        for (int b = 0; b < 2; ++b)
#pragma unroll
            for (int m = 0; m < 4; ++m)
#pragma unroll
                for (int n = 0; n < 2; ++n) acc[a][b][m][n] = (f32x4){0.f, 0.f, 0.f, 0.f};
    bf16x8 At[4][2], B0[2][2], B1[2][2];
    const char* cA = (const char*)g.A + (size_t)cur.pm * tstep; const char* cB = (const char*)g.Bt + (size_t)cur.pn * tstep;
    S.a_ready(cur);
    if constexpr (SP2) {
        PG8_STAGE(PG8_SB(0, 0), cB, voffB); PG8_STAGE(PG8_SB(0, 1), cB + hstep, voffB); PG8_STAGE(PG8_SA(0, 0), cA, voffA); PG8_STAGE(PG8_SA(0, 1), cA + hstep, voffA);
        if (wr == 1) PG8_BAR;
        PG8_WAIT_V(2); PG8_BAR;
        PG8_STAGE(PG8_SB(1, 0), cB + kstep, voffB); PG8_STAGE(PG8_SA(1, 0), cA + kstep, voffA); PG8_STAGE(PG8_SB(1, 1), cB + hstep + kstep, voffB);
        PG8_WAIT_V(6); PG8_BAR;
    } else {
        PG8_STAGE(PG8_SB(0, 0), cB, voffB); PG8_STAGE(PG8_SA(0, 0), cA, voffA); PG8_STAGE(PG8_SB(0, 1), cB + hstep, voffB); PG8_STAGE(PG8_SA(0, 1), cA + hstep, voffA);
        if (wr == 1) PG8_BAR;
        PG8_WAIT_V(4); PG8_BAR;
        PG8_STAGE(PG8_SB(1, 0), cB + kstep, voffB); PG8_STAGE(PG8_SA(1, 0), cA + kstep, voffA); PG8_STAGE(PG8_SB(1, 1), cB + hstep + kstep, voffB);
        PG8_WAIT_V(6); PG8_BAR;
    }
    for (;;) {
        const bool has_next = S.next(ui + 1, nxt);
        const char* nA = has_next ? (const char*)g.A + (size_t)nxt.pm * tstep : cA; const char* nB = has_next ? (const char*)g.Bt + (size_t)nxt.pn * tstep : cB;
        for (int t = 0; t < nt; t += 2) {
            const bool last = (t == nt - 2);
            const char* a1 = cA + (size_t)(t + 1) * kstep;
            const char* a2 = last ? nA : cA + (size_t)(t + 2) * kstep; const char* b2 = last ? nB : cB + (size_t)(t + 2) * kstep;
            const char* a3 = a2 + kstep; const char* b3 = b2 + kstep;
            if (last && has_next) S.a_ready(nxt);
            if constexpr (SP2) {
            PG8_LDB(B0, 0, 0); PG8_LDB(B1, 0, 1); PG8_SCHED; PG8_LDA(At, 0, 0); PG8_STAGE(PG8_SA(1, 1), a1 + hstep, voffA);
            PG8_WAIT_V(8); PG8_WAIT_L(0); PG8_BAR; PG8_MMA(0, 0, At, B0); PG8_MMA(0, 1, At, B1); PG8_BAR; PG8_SCHED;
            PG8_LDA(At, 0, 1); PG8_STAGE(PG8_SB(0, 0), b2, voffB); PG8_STAGE(PG8_SB(0, 1), b2 + hstep, voffB); PG8_STAGE(PG8_SA(0, 0), a2, voffA);
            PG8_WAIT_V(8); PG8_WAIT_L(0); PG8_BAR; PG8_MMA(1, 0, At, B0); PG8_MMA(1, 1, At, B1); PG8_BAR; PG8_SCHED;
            PG8_LDB(B0, 1, 0); PG8_LDB(B1, 1, 1); PG8_SCHED; PG8_LDA(At, 1, 0); PG8_STAGE(PG8_SA(0, 1), a2 + hstep, voffA);
            PG8_WAIT_V(8); PG8_WAIT_L(0); PG8_BAR; PG8_MMA(0, 0, At, B0); PG8_MMA(0, 1, At, B1); PG8_BAR; PG8_SCHED;
            PG8_LDA(At, 1, 1); PG8_STAGE(PG8_SB(1, 0), b3, voffB); PG8_STAGE(PG8_SB(1, 1), b3 + hstep, voffB); PG8_STAGE(PG8_SA(1, 0), a3, voffA);
            PG8_WAIT_V(8); PG8_WAIT_L(0); PG8_BAR; PG8_MMA(1, 0, At, B0); PG8_MMA(1, 1, At, B1); PG8_BAR; PG8_SCHED;
            } else {
            PG8_LDB(B0, 0, 0); PG8_SCHED; PG8_LDA(At, 0, 0); PG8_STAGE(PG8_SA(1, 1), a1 + hstep, voffA);
            PG8_WAIT_L(8); PG8_BAR; PG8_WAIT_L(0); PG8_MMA(0, 0, At, B0); PG8_BAR; PG8_SCHED;
            PG8_LDB(B1, 0, 1); PG8_STAGE(PG8_SB(0, 0), b2, voffB);
            PG8_BAR; PG8_WAIT_L(0); PG8_MMA(0, 1, At, B1); PG8_BAR;
            PG8_LDA(At, 0, 1); PG8_STAGE(PG8_SA(0, 0), a2, voffA);
            PG8_BAR; PG8_WAIT_L(0); PG8_MMA(1, 0, At, B0); PG8_BAR; PG8_SCHED;
            PG8_STAGE(PG8_SB(0, 1), b2 + hstep, voffB);
            PG8_WAIT_V(6); PG8_BAR; PG8_MMA(1, 1, At, B1); PG8_BAR;
            PG8_LDB(B0, 1, 0); PG8_SCHED; PG8_LDA(At, 1, 0); PG8_STAGE(PG8_SA(0, 1), a2 + hstep, voffA);
            PG8_WAIT_L(8); PG8_BAR; PG8_WAIT_L(0); PG8_MMA(0, 0, At, B0); PG8_BAR; PG8_SCHED;
            PG8_LDB(B1, 1, 1); PG8_STAGE(PG8_SB(1, 0), b3, voffB);
            PG8_BAR; PG8_WAIT_L(0); PG8_MMA(0, 1, At, B1); PG8_BAR;
            PG8_LDA(At, 1, 1); PG8_STAGE(PG8_SA(1, 0), a3, voffA);
            PG8_BAR; PG8_WAIT_L(0); PG8_MMA(1, 0, At, B0); PG8_BAR; PG8_SCHED;
            PG8_STAGE(PG8_SB(1, 1), b3 + hstep, voffB);
            PG8_WAIT_V(6); PG8_BAR; PG8_MMA(1, 1, At, B1); PG8_BAR;
            }
        }
        if constexpr (ALIGN_EPI) { if (wr == 0) PG8_BAR; }
        if constexpr (!Epi::AFTER_DRAIN) { E(acc, cur, wr, wc, fr, fq); S.done(cur); }
        if (!has_next) break;
#pragma unroll
        for (int a = 0; a < 2; ++a)
#pragma unroll
            for (int b = 0; b < 2; ++b)
#pragma unroll
                for (int m = 0; m < 4; ++m)
#pragma unroll
                    for (int n = 0; n < 2; ++n) acc[a][b][m][n] = (f32x4){0.f, 0.f, 0.f, 0.f};
        cur = nxt; cA = nA; cB = nB; ++ui;
        if constexpr (ALIGN_EPI) { if (wr == 1) PG8_BAR; }
    }
    PG8_WAIT_V(0);
    if constexpr (!ALIGN_EPI) { if (wr == 0) PG8_BAR; }
    PG8_BAR;
    if constexpr (Epi::AFTER_DRAIN) { E.fused(acc, cur, wr, wc, fr, fq, lds, wid, lane); S.done(cur); }
#undef PG8_SA
#undef PG8_SB
#undef PG8_STAGE
#undef PG8_LDA
#undef PG8_LDB
#undef PG8_MMA
#undef PG8_WAIT_V
#undef PG8_WAIT_L
#undef PG8_BAR
#undef PG8_SCHED
}
}
constexpr int BATCH = 2, SEQ = 8192, DM = 4096, M = BATCH * SEQ, DFF = 11008, NLAYER = 2;
constexpr int P_IN = 10704, NIN = 10752, NMAIN = 10496;
constexpr int CA_Q = 0, CA_K = 1024, CA_V = 2048;
constexpr int CB_Q = 3072, CB_K = 3584, CB_V = 4096, CB_G = 5120;
constexpr int CC_R = 6144, CC_K = 7168, CC_V = 8192;
constexpr int CD_Q = 9216, CD_K = 10240, CD_V = 10368;
constexpr float LOG2E = 1.4426950408889634f;
constexpr float QSCALE = 0.125f * LOG2E;
constexpr int NWAVES = 8;

constexpr size_t MiB = 1u << 20;
constexpr size_t WS_CTL = 0, CTL_ZERO_BYTES = 1 * MiB;
constexpr size_t WS_MODP = 2 * MiB;
constexpr size_t WS_MOD = 14 * MiB;
constexpr size_t WS_TAB = 15 * MiB;
constexpr size_t WS_WIN = 16 * MiB, WIN_L = 84 * MiB;
constexpr size_t WS_WOUT = 184 * MiB, WOUT_L = 32 * MiB;
constexpr size_t WS_W13 = 248 * MiB, W13_L = 172 * MiB;
constexpr size_t WS_W2 = 592 * MiB, W2_L = 86 * MiB;
constexpr size_t WS_XN = 764 * MiB;
constexpr size_t WS_COLS = 892 * MiB;
constexpr size_t WS_LOWR = 1220 * MiB;
constexpr size_t WS_HID = 892 * MiB;
constexpr size_t WS_QKA = 1236 * MiB;
constexpr size_t WS_QKD = 1300 * MiB;
constexpr size_t WS_LOGA = 1336 * MiB;
constexpr size_t WS_RW = 1368 * MiB, RW_ONE = 64 * MiB;
constexpr size_t WS_VFIRST = 1816 * MiB;
constexpr size_t WS_MIXED = 1880 * MiB;
constexpr size_t WS_VTA = 2008 * MiB;
constexpr size_t WS_VTD = 2040 * MiB;
constexpr size_t WS_QDEC = 2044 * MiB, WS_KDT = 2060 * MiB, WS_AM = 2076 * MiB, WS_EBL = 2084 * MiB;
constexpr size_t WS_VTB = 2086 * MiB, WS_GTB = 2118 * MiB;
constexpr size_t WS_RWC = 2150 * MiB;
constexpr size_t WS_END = 2476 * MiB;
constexpr int CW_BAR = 4096;
constexpr int CW_Q = 16384;

constexpr int RING_OFF = 0, RING_BYTES = 131072;
constexpr int LDSCTL_OFF = RING_BYTES, MISC_OFF = LDSCTL_OFF + 320;
constexpr int LDS_BYTES = 147456;

#define GAS __attribute__((address_space(1)))
#define LAS __attribute__((address_space(3)))
typedef unsigned short bf16;
typedef unsigned v4u __attribute__((ext_vector_type(4)));
typedef unsigned v2u __attribute__((ext_vector_type(2)));
typedef float f32x4 __attribute__((ext_vector_type(4)));
typedef short bf16x8 __attribute__((ext_vector_type(8)));
typedef GAS unsigned gu32;
#define RLX_AGENT __ATOMIC_RELAXED, __HIP_MEMORY_SCOPE_AGENT
#define LDS_WAIT() asm volatile("s_waitcnt lgkmcnt(0)" ::: "memory")
#define VM_WAIT() asm volatile("s_waitcnt vmcnt(0)" ::: "memory")
__device__ __forceinline__ unsigned f2bf(float f) { unsigned u = __builtin_bit_cast(unsigned, f); return (u + 0x7fffu + ((u >> 16) & 1u)) >> 16; }
__device__ __forceinline__ unsigned pk2(float lo, float hi) { return f2bf(lo) | (f2bf(hi) << 16); }
__device__ __forceinline__ float bf2f(unsigned short h) { return __builtin_bit_cast(float, (unsigned)h << 16); }
__device__ __forceinline__ float bflo(unsigned w) { return __builtin_bit_cast(float, w << 16); }
__device__ __forceinline__ float bfhi(unsigned w) { return __builtin_bit_cast(float, w & 0xffff0000u); }
template <int CTRL> __device__ __forceinline__ float dpp_f(float v) { return __builtin_bit_cast(float, __builtin_amdgcn_update_dpp(0, __builtin_bit_cast(int, v), CTRL, 0xF, 0xF, true)); }
__device__ __forceinline__ float sum8(float v) {
    v += dpp_f<0xB1>(v); v += dpp_f<0x4E>(v); v += dpp_f<0x141>(v); return v; }
__device__ __forceinline__ float wave_sum(float v) {
    v = sum8(v); v += dpp_f<0x140>(v);
    v += __builtin_bit_cast(float, __builtin_amdgcn_ds_swizzle(__builtin_bit_cast(int, v), 0x401F));
    { const int u = __builtin_bit_cast(int, v); v = __builtin_bit_cast(float, __builtin_amdgcn_readlane(u, 0)) + __builtin_bit_cast(float, __builtin_amdgcn_readlane(u, 32)); }
    return v;
}
__device__ __forceinline__ float sigmoid_f(float x) { return __builtin_amdgcn_rcpf(1.0f + __builtin_amdgcn_exp2f(-LOG2E * x)); }
__device__ __forceinline__ float silu_g(float x) { return x * sigmoid_f(x); }

#define XB_TMO      128
#define XB_XCNT(j)  (256  + 64 * (j))
#define XB_XSUB(j)  (1280 + 64 * (j))
#define XB_XGEN(j)  (2304 + 64 * (j))
#define XB_TOP      3328
#define XB_TOPGEN   3392
#define XCD_BAR_WORDS 3456
#define XB_SPIN_CAP (1u << 23)

__device__ __forceinline__ unsigned xb_ld(unsigned* p)              { return __hip_atomic_load(p, __ATOMIC_RELAXED, __HIP_MEMORY_SCOPE_AGENT); }
__device__ __forceinline__ unsigned xb_add(unsigned* p, unsigned v) { return __hip_atomic_fetch_add(p, v, __ATOMIC_RELAXED, __HIP_MEMORY_SCOPE_AGENT); }
__device__ __forceinline__ unsigned xb_xcc_id() { return (unsigned)__builtin_amdgcn_s_getreg((3 << 11) | 20) & 0xFu; }
#define XB_SPIN(cond, bar) do { unsigned _sp = 0; while (cond) { __builtin_amdgcn_s_sleep(1); \
    if ((++_sp & 255u) == 0u) { if (xb_ld(&(bar)[XB_TMO])) break; if (_sp > XB_SPIN_CAP) { atomicAdd(&(bar)[XB_TMO], 1u); break; } } } } while (0)

struct XcdBarrier {
    unsigned* bar; unsigned x;
    volatile LAS unsigned* st;
};

__device__ __forceinline__ XcdBarrier xcd_barrier_post(unsigned* bar, volatile LAS unsigned* st) {
    XcdBarrier b; b.bar = bar; b.x = xb_xcc_id(); b.st = st;
    if (threadIdx.x == 0) (void)xb_add(&bar[XB_XCNT(b.x)], 1u);
    return b;
}
__device__ __forceinline__ void xcd_barrier_complete(unsigned* bar, unsigned x, unsigned& nloc, unsigned& nx) {
    const unsigned G = gridDim.x * gridDim.y * gridDim.z;
    unsigned sum, cnt, mine, sp = 0u;
    for (;;) {
        sum = 0u; cnt = 0u; mine = 0u;
#pragma unroll
        for (unsigned j = 0; j < 16; ++j) { const unsigned c = xb_ld(&bar[XB_XCNT(j)]); sum += c; cnt += (c > 0u) ? 1u : 0u; mine = (j == x) ? c : mine; }
        if (sum == G) break;
        __builtin_amdgcn_s_sleep(1);
        if ((++sp & 255u) == 0u) { if (xb_ld(&bar[XB_TMO])) break; if (sp > XB_SPIN_CAP) { atomicAdd(&bar[XB_TMO], 1u); break; } }
    }
    nloc = mine > 0u ? mine : 1u; nx = cnt > 0u ? cnt : 1u;
}

__device__ __forceinline__ void xcd_barrier(const XcdBarrier& b) {
    asm volatile("s_waitcnt vmcnt(0)" ::: "memory");
    __syncthreads();
    if (threadIdx.x == 0) {
        unsigned* bar = b.bar;
        __builtin_amdgcn_s_waitcnt(0);
        unsigned nloc = b.st[0], nx = b.st[1];
        if (nloc == 0u) { xcd_barrier_complete(bar, b.x, nloc, nx); b.st[0] = nloc; b.st[1] = nx; }
        const unsigned old = xb_add(&bar[XB_XSUB(b.x)], 1u);
        const unsigned gen = old / nloc;
        if (old + 1u == (gen + 1u) * nloc) {
            __builtin_amdgcn_fence(__ATOMIC_RELEASE, "agent");
            asm volatile("s_waitcnt vmcnt(0)" ::: "memory");
            const unsigned og = xb_add(&bar[XB_TOP], 1u);
            const unsigned tg = og / nx;
            if (og + 1u == (tg + 1u) * nx) xb_add(&bar[XB_TOPGEN], 1u);
            else XB_SPIN(xb_ld(&bar[XB_TOPGEN]) == tg, bar);
            __builtin_amdgcn_fence(__ATOMIC_ACQUIRE, "agent");
            xb_add(&bar[XB_XGEN(b.x)], 1u);
            asm volatile("s_waitcnt vmcnt(0)" ::: "memory");
        } else {
            XB_SPIN(xb_ld(&bar[XB_XGEN(b.x)]) == gen, bar);
            __builtin_amdgcn_fence(__ATOMIC_ACQUIRE, "agent");
            asm volatile("s_waitcnt vmcnt(0)" ::: "memory");
        }
    }
    __syncthreads();
}

typedef const float* const __attribute__((address_space(4)))* kargp;
struct Frame {
    LAS unsigned char* lds;
    volatile LAS unsigned* MISC;
    gu32* ctl;
    int tid, lane, wave;
    int vcu, G, bx;
    kargp kin;
    float* out;
    unsigned char* ws;
};
enum { I_X = 0, I_C, I_RELB, I_ADAW, I_ADAB, I_WIN, I_WOUT, I_DQN, I_DKN, I_DLAM, I_DSUB, I_GGU, I_GGB, I_GON, I_RMU, I_RWUP, I_RW0, I_RAUP, I_RA0, I_RGUP,
       I_RKK, I_RKA, I_RRK, I_RLNW, I_RLNB, I_VRD, I_VRMU, I_VRUP, I_VR0, I_SQN, I_SKN, I_SSINK, I_W1, I_W3, I_W2 };

#define WSP(T, off) ((T*)(F.ws + (off)))
__device__ __forceinline__ void relaunder_tid(Frame& F) { int t = F.tid; asm volatile("" : "+v"(t)); F.tid = t; F.lane = t & 63; F.wave = __builtin_amdgcn_readfirstlane(t >> 6); }
__device__ __forceinline__ void relaunder(Frame& F) { kargp p = F.kin; asm volatile("" : "+s"(p)); F.kin = p; }

__device__ __forceinline__ void conv_item(const float* src, int ld, int col0, int ncols, int K, bf16* WT, int row0, int kb, LAS float* scr, int lane) {
    const int k0 = 64 * kb;
#pragma unroll 8
    for (int i = 0; i < 32; ++i) { const int kk = 2 * i + (lane >> 5), n = lane & 31; float v = 0.f;
        if (src != nullptr && n < ncols) v = src[(size_t)(k0 + kk) * ld + col0 + n];
        scr[kk * 33 + n] = v; }
    LDS_WAIT(); asm volatile("" ::: "memory");
    const int c = lane & 7;
#pragma unroll
    for (int j = 0; j < 4; ++j) { const int n = (lane >> 3) + 8 * j; const LAS float* s = scr + (8 * c) * 33 + n;
        v4u o; o.x = pk2(s[0 * 33], s[1 * 33]); o.y = pk2(s[2 * 33], s[3 * 33]); o.z = pk2(s[4 * 33], s[5 * 33]); o.w = pk2(s[6 * 33], s[7 * 33]);
        if (n < ncols) *(GAS v4u*)(WT + (size_t)(row0 + n) * K + k0 + 8 * c) = o; }
    LDS_WAIT(); asm volatile("" ::: "memory");
}
__device__ __forceinline__ int t5_bucket(int d) {
    if (d < 16) return d;
    int v = 16 + (int)(logf((float)d * (1.0f / 16.0f)) / logf(8.0f) * 16.0f);
    return v < 31 ? v : 31;
}
__device__ __forceinline__ void p0_prologue_a(Frame& F) {
    const int gw = F.vcu * NWAVES + F.wave, NGW = F.G * NWAVES;
    LAS float* ldsf = (LAS float*)(F.lds + RING_OFF);
    for (int i = F.tid; i < 2 * DM; i += NWAVES * 64) ldsf[i] = silu_g(F.kin[I_C][i]);
    __syncthreads();
    float* MODP = WSP(float, WS_MODP);
    for (int it = gw; it < 6144; it += NGW) {
        const int l = it / 3072, rem = it % 3072, kc = rem / 96, ng = rem % 96, n0 = 256 * ng + 4 * F.lane;
        const float* w = F.kin[I_ADAW] + ((size_t)l * DM + kc * 128) * 24576 + n0;
        f32x4 a0 = {0.f, 0.f, 0.f, 0.f}, a1 = {0.f, 0.f, 0.f, 0.f};
#pragma unroll 8
        for (int k = 0; k < 128; ++k) { const f32x4 wv = *(const f32x4*)(w + (size_t)k * 24576); const float s0 = ldsf[kc * 128 + k], s1 = ldsf[DM + kc * 128 + k]; a0 += wv * s0; a1 += wv * s1; }
        *(f32x4*)(MODP + ((size_t)(l * 32 + kc) * 2 + 0) * 24576 + n0) = a0;
        *(f32x4*)(MODP + ((size_t)(l * 32 + kc) * 2 + 1) * 24576 + n0) = a1;
    }
    __syncthreads();
    LAS float* scr = (LAS float*)(F.lds + RING_OFF + F.wave * 16384);
    constexpr int I_IN = 337 * 64, I_OUT = 128 * 64, I_13 = 688 * 64, I_2 = 128 * 172, I_L = I_IN + I_OUT + I_13 + I_2;
    for (int it = gw; it < NLAYER * I_L; it += NGW) {
        const int l = it / I_L; int r = it % I_L;
        if (r < I_IN) {
            const int kb = r / 337, cb = r % 337; const float* src = F.kin[I_WIN] + (size_t)l * DM * P_IN; int ld = P_IN, col0, row0, nc = 32;
            if (cb < 192) { col0 = 32 * cb; row0 = 32 * cb; }
            else if (cb < 288) { col0 = 6160 + 32 * (cb - 192); row0 = 6144 + 32 * (cb - 192); }
            else if (cb < 328) { col0 = 9424 + 32 * (cb - 288); row0 = 9216 + 32 * (cb - 288); }
            else if (cb == 328) { col0 = 6144; row0 = 10496; nc = 16; }
            else if (cb < 335) { col0 = 9232 + 32 * (cb - 329); row0 = 10512 + 32 * (cb - 329); }
            else if (cb == 335) { src = l ? F.kin[I_VRD] + (size_t)(l - 1) * DM * 32 : nullptr; ld = 32; col0 = 0; row0 = 10704; }
            else { src = nullptr; col0 = 0; row0 = 10736; nc = 16; }
            conv_item(src, ld, col0, nc, DM, WSP(bf16, WS_WIN + l * WIN_L), row0, kb, scr, F.lane); continue; }
        r -= I_IN;
        if (r < I_OUT) { const int kb = r / 128, cb = r % 128; conv_item(F.kin[I_WOUT] + (size_t)l * DM * DM, DM, 32 * cb, 32, DM, WSP(bf16, WS_WOUT + l * WOUT_L), 32 * cb, kb, scr, F.lane); continue; }
        r -= I_OUT;
        if (r < I_13) { const int kb = r / 688, cb = r % 688, pn = cb >> 3, wi = cb & 7;
            const float* src = (wi < 4 ? F.kin[I_W1] : F.kin[I_W3]) + (size_t)l * DM * DFF;
            conv_item(src, DFF, 128 * pn + 32 * (wi & 3), 32, DM, WSP(bf16, WS_W13 + l * W13_L), 32 * cb, kb, scr, F.lane); continue; }
        r -= I_13;
        { const int kb = r / 128, cb = r % 128; conv_item(F.kin[I_W2] + (size_t)l * DFF * DM, DM, 32 * cb, 32, DFF, WSP(bf16, WS_W2 + l * W2_L), 32 * cb, kb, scr, F.lane); }
    }
}
__device__ __forceinline__ void p0_prologue_b(Frame& F) {
    const int gt = F.bx * (NWAVES * 64) + F.tid, NT = F.G * NWAVES * 64;
    const float* MODP = WSP(float, WS_MODP); float* MOD = WSP(float, WS_MOD);
    for (int idx = gt; idx < NLAYER * 2 * 24576; idx += NT) {
        const int l = idx / 49152, rem = idx % 49152, b = rem / 24576, n = rem % 24576;
        float s = F.kin[I_ADAB][l * 24576 + n];
#pragma unroll 8
        for (int kc = 0; kc < 32; ++kc) s += MODP[((size_t)(l * 32 + kc) * 2 + b) * 24576 + n];
        MOD[idx] = s;
    }
    if (F.bx == 0) { float* TAB = WSP(float, WS_TAB);
        for (int i = F.tid; i < 24 * 128; i += NWAVES * 64) { const int hh = i >> 7, d = i & 127; TAB[i] = F.kin[I_RELB][t5_bucket(d) * 24 + hh] * LOG2E; } }
}
__device__ __forceinline__ void rms_phase(Frame& F, const float* xin, const float* sh, const float* sc) {
    const int gw = F.vcu * NWAVES + F.wave, NGW = F.G * NWAVES;
    bf16* XN = WSP(bf16, WS_XN);
    for (int m = gw; m < M; m += NGW) {
        const int b = m >> 13;
        const f32x4* xr = (const f32x4*)(xin + (size_t)m * DM) + F.lane;
        f32x4 v[16]; float ss = 0.f;
#pragma unroll
        for (int j = 0; j < 16; ++j) { v[j] = xr[64 * j]; ss += (v[j].x * v[j].x + v[j].y * v[j].y) + (v[j].z * v[j].z + v[j].w * v[j].w); }
        const float rstd = rsqrtf(wave_sum(ss) * (1.0f / DM) + 1e-6f);
        const f32x4* scp = (const f32x4*)(sc + (size_t)b * 24576) + F.lane; const f32x4* shp = (const f32x4*)(sh + (size_t)b * 24576) + F.lane;
        v2u* o8 = (v2u*)(XN + (size_t)m * DM) + F.lane;
#pragma unroll
        for (int j = 0; j < 16; ++j) { const f32x4 s4 = scp[64 * j], h4 = shp[64 * j]; const f32x4 o = v[j] * rstd * (s4 + 1.0f) + h4;
            v2u w; w.x = pk2(o.x, o.y); w.y = pk2(o.z, o.w); o8[64 * j] = w; }
    }
}
__device__ __forceinline__ void unpack8(const v4u r, float (&f)[8]) { f[0] = bflo(r.x); f[1] = bfhi(r.x); f[2] = bflo(r.y); f[3] = bfhi(r.y); f[4] = bflo(r.z); f[5] = bfhi(r.z); f[6] = bflo(r.w); f[7] = bfhi(r.w); }
__device__ __forceinline__ v4u pack8(const float (&f)[8]) { v4u o; o.x = pk2(f[0], f[1]); o.y = pk2(f[2], f[3]); o.z = pk2(f[4], f[5]); o.w = pk2(f[6], f[7]); return o; }
__device__ __forceinline__ void prep_norm(Frame& F, int l) {
    const int gw = F.vcu * NWAVES + F.wave, NGW = F.G * NWAVES, lane = F.lane, sub = lane >> 3, ch = lane & 7;
    float gqa[8], gka[8], gqd[8], gkd[8];
#pragma unroll
    for (int e = 0; e < 8; ++e) { gqa[e] = F.kin[I_DQN][l * 64 + ch * 8 + e] * QSCALE; gka[e] = F.kin[I_DKN][l * 64 + ch * 8 + e];
                                  gqd[e] = F.kin[I_SQN][l * 64 + ch * 8 + e] * QSCALE; gkd[e] = F.kin[I_SKN][l * 64 + ch * 8 + e]; }
    const bf16* COLS = WSP(bf16, WS_COLS); bf16* QKA = WSP(bf16, WS_QKA); bf16* QKD = WSP(bf16, WS_QKD);
    for (int m = gw; m < M; m += NGW) {
        const bf16* src = COLS + (size_t)m * NMAIN;
#pragma unroll
        for (int i = 0; i < 4; ++i) { const int vec = i * 8 + sub, col = vec * 64 + ch * 8;
            float f[8]; unpack8(*(const v4u*)(src + CA_Q + col), f); float ss = 0.f;
#pragma unroll
            for (int e = 0; e < 8; ++e) ss += f[e] * f[e];
            ss = sum8(ss);
            const float rstd = rsqrtf(ss * (1.0f / 64.0f) + 1e-6f);
#pragma unroll
            for (int e = 0; e < 8; ++e) f[e] = f[e] * rstd * (i < 2 ? gqa[e] : gka[e]);
            *(v4u*)(QKA + (size_t)m * 2048 + col) = pack8(f); }
#pragma unroll
        for (int i = 0; i < 3; ++i) { const int vec = i * 8 + sub, col = vec * 64 + ch * 8;
            if (vec < 18) { float f[8]; unpack8(*(const v4u*)(src + CD_Q + col), f); float ss = 0.f;
#pragma unroll
                for (int e = 0; e < 8; ++e) ss += f[e] * f[e];
                ss = sum8(ss);
                const float rstd = rsqrtf(ss * (1.0f / 64.0f) + 1e-6f);
#pragma unroll
                for (int e = 0; e < 8; ++e) f[e] = f[e] * rstd * (vec < 16 ? gqd[e] : gkd[e]);
                *(v4u*)(QKD + (size_t)m * 1152 + col) = pack8(f); } }
    }
}
__device__ __forceinline__ void prep_loga(Frame& F, int l) {
    float gu[16];
#pragma unroll
    for (int j = 0; j < 16; ++j) gu[j] = F.kin[I_GGU][((size_t)l * 16 + j) * 512 + F.tid];
    const float bias = F.kin[I_GGB][l * 512 + F.tid];
    const float* LOWR = WSP(float, WS_LOWR); float* LOGA = WSP(float, WS_LOGA);
    for (int m = F.bx; m < M; m += F.G) {
        const float* gd = LOWR + (size_t)m * 256; float z = bias;
#pragma unroll
        for (int j = 0; j < 16; ++j) z += gd[j] * gu[j];
        LOGA[(size_t)m * 512 + F.tid] = (fminf(z, 0.f) - log1pf(expf(-fabsf(z)))) * (1.0f / 16.0f);
    }
}
__device__ __forceinline__ void prep_rwkv(Frame& F, int l) {
    LAS float* in = (LAS float*)(F.lds + RING_OFF);
    const float* mu = F.kin[I_RMU] + (size_t)l * 3264;
    const float* LOWR = WSP(float, WS_LOWR); const bf16* COLS = WSP(bf16, WS_COLS);
    float* RW = WSP(float, WS_RW); float* VF = WSP(float, WS_VFIRST);
    constexpr size_t RS = RW_ONE / 4;
    for (int tile = F.bx; tile < M / 16; tile += F.G) {
        const int row0 = tile * 16;
        __syncthreads();
        for (int idx = F.tid; idx < 16 * 224; idx += NWAVES * 64) { const int tt = idx / 224, j = idx % 224, row = row0 + tt, t = row & (SEQ - 1);
            const int col = j < 192 ? 16 + j : 208 + (j - 192);
            const float cur = LOWR[(size_t)row * 256 + col], prev = t > 0 ? LOWR[(size_t)(row - 1) * 256 + col] : 0.f;
            const float muv = j < 192 ? mu[3072 + j] : (l ? F.kin[I_VRMU][(l - 1) * 32 + (j - 192)] : 0.f);
            float x = cur + (prev - cur) * muv;
            if (j < 64) x = tanhf(x); else if (j >= 128 && j < 192) x = sigmoid_f(x);
            in[j * 16 + tt] = x; }
        __syncthreads();
#pragma unroll 1
        for (int pass = 0; pass < 2; ++pass) {
            const int c = pass * 512 + F.tid;
            float accw[16], acca[16], accg[16], accv[16];
            { const float bw = F.kin[I_RW0][l * 1024 + c], ba = F.kin[I_RA0][l * 1024 + c], bv = l ? F.kin[I_VR0][(l - 1) * 1024 + c] : 0.f;
#pragma unroll
              for (int tt = 0; tt < 16; ++tt) { accw[tt] = bw; acca[tt] = ba; accg[tt] = 0.f; accv[tt] = bv; } }
#define LOWRANK_ACC(ACC, WPTR, JOFF, NJ) do { const float* wp_ = (WPTR) + c; \
            _Pragma("unroll 2") for (int j = 0; j < (NJ); ++j) { const float w_ = wp_[(size_t)j * 1024]; const LAS f32x4* ip_ = (const LAS f32x4*)(in + ((JOFF) + j) * 16); \
                const f32x4 i0 = ip_[0], i1 = ip_[1], i2 = ip_[2], i3 = ip_[3]; \
                ACC[0] += i0.x * w_; ACC[1] += i0.y * w_; ACC[2] += i0.z * w_; ACC[3] += i0.w * w_; ACC[4] += i1.x * w_; ACC[5] += i1.y * w_; ACC[6] += i1.z * w_; ACC[7] += i1.w * w_; \
                ACC[8] += i2.x * w_; ACC[9] += i2.y * w_; ACC[10] += i2.z * w_; ACC[11] += i2.w * w_; ACC[12] += i3.x * w_; ACC[13] += i3.y * w_; ACC[14] += i3.z * w_; ACC[15] += i3.w * w_; } } while (0)
            relaunder(F); LOWRANK_ACC(accw, F.kin[I_RWUP] + (size_t)l * 64 * 1024, 0, 64);
            relaunder(F); LOWRANK_ACC(acca, F.kin[I_RAUP] + (size_t)l * 64 * 1024, 64, 64);
            relaunder(F); LOWRANK_ACC(accg, F.kin[I_RGUP] + (size_t)l * 64 * 1024, 128, 64);
            relaunder(F); if (l) LOWRANK_ACC(accv, F.kin[I_VRUP] + (size_t)(l - 1) * 32 * 1024, 192, 32);
#undef LOWRANK_ACC
            relaunder(F);
            const float mur = F.kin[I_RMU][l * 3264 + c], muk = F.kin[I_RMU][l * 3264 + 1024 + c], muv = F.kin[I_RMU][l * 3264 + 2048 + c], kkv = F.kin[I_RKK][l * 1024 + c], kav = F.kin[I_RKA][l * 1024 + c];
            float pr = 0.f, pk = 0.f, pv = 0.f;
            if ((row0 & (SEQ - 1)) != 0) { const bf16* p = COLS + (size_t)(row0 - 1) * NMAIN + c; pr = bf2f(p[CC_R]); pk = bf2f(p[CC_K]); pv = bf2f(p[CC_V]); }
#pragma unroll
            for (int tt = 0; tt < 16; ++tt) { const int row = row0 + tt; const bf16* p = COLS + (size_t)row * NMAIN + c;
                const float cr = bf2f(p[CC_R]), ck = bf2f(p[CC_K]), cv = bf2f(p[CC_V]);
                const float r = cr + (pr - cr) * mur, k = ck + (pk - ck) * muk; float v = cv + (pv - cv) * muv;
                pr = cr; pk = ck; pv = cv;
                const size_t o = (size_t)row * 1024 + c;
                if (l == 0) VF[o] = v; else { const float vg = sigmoid_f(accv[tt]); v = v + (VF[o] - v) * vg; }
                const float dec = __expf(-0.6065306597126334f * sigmoid_f(accw[tt]));
                const float a = sigmoid_f(acca[tt]);
                float kk = k * kkv; const float ss = wave_sum(kk * kk); kk = kk / fmaxf(sqrtf(ss), 1e-12f);
                const float km = k * (1.0f + (a - 1.0f) * kav);
                RW[o] = r; RW[RS + o] = dec; RW[2 * RS + o] = km; RW[3 * RS + o] = v; RW[4 * RS + o] = -kk; RW[5 * RS + o] = kk * a; RW[6 * RS + o] = accg[tt]; }
        }
    }
}
__device__ __forceinline__ void diff_unit_v1(Frame& F, int l, int b, int h, int qt) {
    LAS float* ldsf = (LAS float*)(F.lds + RING_OFF);
    LAS float* Kt = ldsf; LAS float* Vt = ldsf + 8192; LAS float* Bt = ldsf + 16640;
    const int p = F.wave >> 2, dq = F.wave & 3, lane = F.lane, q0 = qt * 64, qpos = q0 + lane;
    const bf16* QKA = WSP(bf16, WS_QKA); const bf16* COLS = WSP(bf16, WS_COLS); const float* TAB = WSP(float, WS_TAB);
    float q[64];
    { const bf16* qp = QKA + (size_t)(b * SEQ + qpos) * 2048 + h * 128 + p * 64;
#pragma unroll
      for (int i = 0; i < 8; ++i) { float f[8]; unpack8(*(const v4u*)(qp + 8 * i), f);
#pragma unroll
          for (int e = 0; e < 8; ++e) q[8 * i + e] = f[e]; } }
    float lam_init = 0.8f - 0.6f * __expf(-0.3f * (float)l), lam_full;
    { const float* lm = F.kin[I_DLAM] + (size_t)l * 256; const float s1 = wave_sum(lm[lane] * lm[64 + lane]), s2 = wave_sum(lm[128 + lane] * lm[192 + lane]); lam_full = __expf(s1) - __expf(s2) + lam_init; }
    float o[32];
#pragma unroll
    for (int i = 0; i < 32; ++i) o[i] = 0.f;
    float mx = -1e30f, lsum = 0.f;
    if (F.tid < 128) Bt[F.tid] = TAB[h * 128 + F.tid];
    for (int kt = 0; kt <= qt; ++kt) {
        __syncthreads();
        { const int key = F.tid >> 3, chn = F.tid & 7; const size_t krow = (size_t)(b * SEQ + kt * 64 + key);
          const bf16* kp = QKA + krow * 2048 + 1024 + h * 128 + chn * 16; const bf16* vp = COLS + krow * NMAIN + CA_V + h * 128 + chn * 16;
          float f[8];
          unpack8(*(const v4u*)kp, f);
#pragma unroll
          for (int e = 0; e < 8; ++e) Kt[key * 128 + chn * 16 + e] = f[e];
          unpack8(*(const v4u*)(kp + 8), f);
#pragma unroll
          for (int e = 0; e < 8; ++e) Kt[key * 128 + chn * 16 + 8 + e] = f[e];
          unpack8(*(const v4u*)vp, f);
#pragma unroll
          for (int e = 0; e < 8; ++e) Vt[key * 128 + chn * 16 + e] = f[e];
          unpack8(*(const v4u*)(vp + 8), f);
#pragma unroll
          for (int e = 0; e < 8; ++e) Vt[key * 128 + chn * 16 + 8 + e] = f[e]; }
        __syncthreads();
        const int kbase = kt * 64;
#pragma unroll 2
        for (int j = 0; j < 64; ++j) {
            const int dist = qpos - (kbase + j);
            const LAS f32x4* kp = (const LAS f32x4*)(Kt + j * 128 + p * 64);
            float s0 = 0.f, s1 = 0.f;
#pragma unroll
            for (int d = 0; d < 16; d += 2) { const f32x4 k0 = kp[d], k1 = kp[d + 1];
                s0 += q[4 * d] * k0.x + q[4 * d + 1] * k0.y + q[4 * d + 2] * k0.z + q[4 * d + 3] * k0.w;
                s1 += q[4 * d + 4] * k1.x + q[4 * d + 5] * k1.y + q[4 * d + 6] * k1.z + q[4 * d + 7] * k1.w; }
            if (dist >= 0) {
                const float s = s0 + s1 + Bt[dist < 127 ? dist : 127];
                if (s > mx) { const float sc = __builtin_amdgcn_exp2f(mx - s); lsum *= sc;
#pragma unroll
                    for (int i = 0; i < 32; ++i) o[i] *= sc;
                    mx = s; }
                const float pw = __builtin_amdgcn_exp2f(s - mx); lsum += pw;
                const LAS f32x4* vp = (const LAS f32x4*)(Vt + j * 128 + dq * 32);
#pragma unroll
                for (int i = 0; i < 8; ++i) { const f32x4 v4 = vp[i]; o[4 * i] += pw * v4.x; o[4 * i + 1] += pw * v4.y; o[4 * i + 2] += pw * v4.z; o[4 * i + 3] += pw * v4.w; }
            }
        }
    }
    __syncthreads();
    LAS float* E = ldsf;
    { const float inv = 1.0f / lsum;
#pragma unroll
      for (int i = 0; i < 32; ++i) E[(p * 64 + lane) * 129 + dq * 32 + i] = o[i] * inv; }
    __syncthreads();
    { const int qq = F.tid >> 3, part = F.tid & 7; float dv[16]; float ss = 0.f;
#pragma unroll
      for (int i = 0; i < 16; ++i) { const int c = part * 16 + i; const float d = E[qq * 129 + c] - lam_full * E[(64 + qq) * 129 + c]; dv[i] = d; ss += d * d; }
      ss = sum8(ss);
      const float rstd = rsqrtf(ss * (1.0f / 128.0f) + 1e-6f) * (1.0f - lam_init);
      const float* sl = F.kin[I_DSUB] + l * 128 + part * 16;
      float f[8]; bf16* op = WSP(bf16, WS_MIXED) + (size_t)(b * SEQ + q0 + qq) * DM + h * 128 + part * 16;
#pragma unroll
      for (int e = 0; e < 8; ++e) f[e] = dv[e] * rstd * sl[e];
      *(v4u*)op = pack8(f);
#pragma unroll
      for (int e = 0; e < 8; ++e) f[e] = dv[8 + e] * rstd * sl[8 + e];
      *(v4u*)(op + 8) = pack8(f); }
}
__device__ __forceinline__ void swa_unit_v1(Frame& F, int l, int b, int kvh, int qt) {
    LAS float* ldsf = (LAS float*)(F.lds + RING_OFF);
    LAS float* Kt = ldsf; LAS float* Vt = ldsf + 192 * 68; LAS float* Bt = ldsf + 2 * 192 * 68;
    const int lane = F.lane, hd = kvh * 8 + F.wave, q0 = qt * 64, qpos = q0 + lane, kstart = q0 - 127;
    const bf16* QKD = WSP(bf16, WS_QKD); const bf16* COLS = WSP(bf16, WS_COLS); const float* TAB = WSP(float, WS_TAB);
    __syncthreads();
    for (int idx = F.tid; idx < 192 * 8; idx += NWAVES * 64) { const int r = idx >> 3, chn = idx & 7, key = kstart + r;
        float fk[8], fv[8];
        if (key >= 0 && r < 191) { const size_t krow = (size_t)(b * SEQ + key);
            unpack8(*(const v4u*)(QKD + krow * 1152 + 1024 + kvh * 64 + chn * 8), fk); unpack8(*(const v4u*)(COLS + krow * NMAIN + CD_V + kvh * 64 + chn * 8), fv); }
        else {
#pragma unroll
            for (int e = 0; e < 8; ++e) { fk[e] = 0.f; fv[e] = 0.f; } }
#pragma unroll
        for (int e = 0; e < 8; ++e) { Kt[r * 68 + chn * 8 + e] = fk[e]; Vt[r * 68 + chn * 8 + e] = fv[e]; } }
    for (int idx = F.tid; idx < 1024; idx += NWAVES * 64) Bt[idx] = TAB[(8 + kvh * 8 + (idx >> 7)) * 128 + (idx & 127)];
    float q[64];
    { const bf16* qp = QKD + (size_t)(b * SEQ + qpos) * 1152 + hd * 64;
#pragma unroll
      for (int i = 0; i < 8; ++i) { float f[8]; unpack8(*(const v4u*)(qp + 8 * i), f);
#pragma unroll
          for (int e = 0; e < 8; ++e) q[8 * i + e] = f[e]; } }
    __syncthreads();
    float o[64];
#pragma unroll
    for (int i = 0; i < 64; ++i) o[i] = 0.f;
    float mx = F.kin[I_SSINK][l * 16 + hd] * LOG2E, lsum = 1.0f;
#pragma unroll 1
    for (int jj = 0; jj < 128; ++jj) {
        const int key = qpos - 127 + jj;
        if (key >= 0) {
            const int r = lane + jj; const LAS f32x4* kp = (const LAS f32x4*)(Kt + r * 68);
            float s0 = 0.f, s1 = 0.f;
#pragma unroll
            for (int d = 0; d < 16; d += 2) { const f32x4 k0 = kp[d], k1 = kp[d + 1];
                s0 += q[4 * d] * k0.x + q[4 * d + 1] * k0.y + q[4 * d + 2] * k0.z + q[4 * d + 3] * k0.w;
                s1 += q[4 * d + 4] * k1.x + q[4 * d + 5] * k1.y + q[4 * d + 6] * k1.z + q[4 * d + 7] * k1.w; }
            const float s = s0 + s1 + Bt[F.wave * 128 + 127 - jj];
            if (s > mx) { const float sc = __builtin_amdgcn_exp2f(mx - s); lsum *= sc;
#pragma unroll
                for (int i = 0; i < 64; ++i) o[i] *= sc;
                mx = s; }
            const float pw = __builtin_amdgcn_exp2f(s - mx); lsum += pw;
            const LAS f32x4* vp = (const LAS f32x4*)(Vt + r * 68);
#pragma unroll
            for (int i = 0; i < 16; ++i) { const f32x4 v4 = vp[i]; o[4 * i] += pw * v4.x; o[4 * i + 1] += pw * v4.y; o[4 * i + 2] += pw * v4.z; o[4 * i + 3] += pw * v4.w; }
        }
    }
    { const float inv = 1.0f / lsum; bf16* op = WSP(bf16, WS_MIXED) + (size_t)(b * SEQ + qpos) * DM + 3072 + hd * 64;
#pragma unroll
      for (int i = 0; i < 8; ++i) { float f[8];
#pragma unroll
          for (int e = 0; e < 8; ++e) f[e] = o[8 * i + e] * inv;
          *(v4u*)(op + 8 * i) = pack8(f); } }
}
__device__ __forceinline__ void gla_unit_v1(Frame& F, int l, int b, int h) {
    LAS float* ldsf = (LAS float*)(F.lds + RING_OFF);
    LAS float* Ad = ldsf; LAS float* Kd = ldsf + 2048; LAS float* Qd = ldsf + 4096; LAS float* Vd = ldsf + 6144; LAS float* Ob = ldsf + 10240;
    const int dh = F.tid >> 8, vcol = F.tid & 255, lane = F.lane;
    const bf16* COLS = WSP(bf16, WS_COLS); const float* LOGA = WSP(float, WS_LOGA); bf16* MIX = WSP(bf16, WS_MIXED);
    float S[64];
#pragma unroll
    for (int d = 0; d < 64; ++d) S[d] = 0.f;
    float og[4];
#pragma unroll
    for (int e = 0; e < 4; ++e) og[e] = F.kin[I_GON][l * 256 + lane * 4 + e];
#pragma unroll 1
    for (int ck = 0; ck < SEQ / 16; ++ck) {
        const int row0 = b * SEQ + ck * 16;
        __syncthreads();
#pragma unroll 2
        for (int i = 0; i < 4; ++i) { const int idx = F.tid + 512 * i, tok = idx >> 7, c = idx & 127; const size_t row = (size_t)(row0 + tok);
            Ad[idx] = __expf(LOGA[row * 512 + h * 128 + c]); Kd[idx] = bf2f(COLS[row * NMAIN + CB_K + h * 128 + c]); Qd[idx] = bf2f(COLS[row * NMAIN + CB_Q + h * 128 + c]) * 0.08838834764831845f; }
#pragma unroll 4
        for (int i = 0; i < 8; ++i) { const int idx = F.tid + 512 * i, tok = idx >> 8, c = idx & 255; Vd[idx] = bf2f(COLS[(size_t)(row0 + tok) * NMAIN + CB_V + h * 256 + c]); }
        __syncthreads();
#pragma unroll 1
        for (int t = 0; t < 16; ++t) {
            const LAS f32x4* ap = (const LAS f32x4*)(Ad + t * 128 + dh * 64); const LAS f32x4* kp = (const LAS f32x4*)(Kd + t * 128 + dh * 64); const LAS f32x4* qp = (const LAS f32x4*)(Qd + t * 128 + dh * 64);
            float o0 = 0.f, o1 = 0.f; const float vt = Vd[t * 256 + vcol];
#pragma unroll
            for (int d = 0; d < 16; ++d) { const f32x4 a4 = ap[d], k4 = kp[d], q4 = qp[d];
                S[4 * d] = a4.x * S[4 * d] + k4.x * vt; S[4 * d + 1] = a4.y * S[4 * d + 1] + k4.y * vt; S[4 * d + 2] = a4.z * S[4 * d + 2] + k4.z * vt; S[4 * d + 3] = a4.w * S[4 * d + 3] + k4.w * vt;
                o0 += q4.x * S[4 * d] + q4.y * S[4 * d + 1]; o1 += q4.z * S[4 * d + 2] + q4.w * S[4 * d + 3];
                if ((d & 3) == 3) __builtin_amdgcn_sched_barrier(0); }
            Ob[t * 512 + F.tid] = o0 + o1;
        }
        __syncthreads();
#pragma unroll 1
        for (int i = 0; i < 2; ++i) { const int t = 2 * F.wave + i; const size_t row = (size_t)(row0 + t);
            const f32x4 xa = *(const LAS f32x4*)(Ob + t * 512 + lane * 4), xb = *(const LAS f32x4*)(Ob + t * 512 + 256 + lane * 4); const f32x4 x = xa + xb;
            const float ss = wave_sum(x.x * x.x + x.y * x.y + x.z * x.z + x.w * x.w); const float rstd = rsqrtf(ss * (1.0f / 256.0f) + 1e-6f);
            const v2u graw = *(const v2u*)(COLS + row * NMAIN + CB_G + h * 256 + lane * 4);
            const float g0 = bflo(graw.x), g1 = bfhi(graw.x), g2 = bflo(graw.y), g3 = bfhi(graw.y);
            v2u w; w.x = pk2(x.x * rstd * og[0] * silu_g(g0), x.y * rstd * og[1] * silu_g(g1)); w.y = pk2(x.z * rstd * og[2] * silu_g(g2), x.w * rstd * og[3] * silu_g(g3));
            *(v2u*)(MIX + row * DM + 1024 + h * 256 + lane * 4) = w; }
    }
}
__device__ __forceinline__ void rwkv_unit_v1(Frame& F, int l, int b, int hg) {
    const int lane = F.lane, h = hg * 8 + F.wave, c = h * 64 + lane;
    LAS float* st = (LAS float*)(F.lds + RING_OFF) + F.wave * 3584;
    const float* RW = WSP(float, WS_RW); bf16* MIX = WSP(bf16, WS_MIXED);
    constexpr size_t RS = RW_ONE / 4;
    float S[64];
#pragma unroll
    for (int j = 0; j < 64; ++j) S[j] = 0.f;
    const float lnw = F.kin[I_RLNW][l * 1024 + c], lnb = F.kin[I_RLNB][l * 1024 + c], rk = F.kin[I_RRK][l * 1024 + c];
#pragma unroll 1
    for (int ck = 0; ck < SEQ / 8; ++ck) {
        const size_t row0 = (size_t)b * SEQ + ck * 8;
#pragma unroll 2
        for (int s = 0; s < 8; ++s) { const size_t o = (row0 + s) * 1024 + c;
            st[(s * 7 + 0) * 64 + lane] = RW[o]; st[(s * 7 + 1) * 64 + lane] = RW[RS + o]; st[(s * 7 + 2) * 64 + lane] = RW[2 * RS + o];
            st[(s * 7 + 3) * 64 + lane] = RW[4 * RS + o]; st[(s * 7 + 4) * 64 + lane] = RW[5 * RS + o]; st[(s * 7 + 5) * 64 + lane] = RW[3 * RS + o]; st[(s * 7 + 6) * 64 + lane] = RW[6 * RS + o]; }
#pragma unroll 1
        for (int s = 0; s < 8; ++s) {
            const LAS f32x4* rp = (const LAS f32x4*)(st + (s * 7 + 0) * 64); const LAS f32x4* wp = (const LAS f32x4*)(st + (s * 7 + 1) * 64); const LAS f32x4* kp = (const LAS f32x4*)(st + (s * 7 + 2) * 64);
            const LAS f32x4* ap = (const LAS f32x4*)(st + (s * 7 + 3) * 64); const LAS f32x4* bp = (const LAS f32x4*)(st + (s * 7 + 4) * 64);
            float sa0 = 0.f, sa1 = 0.f;
#pragma unroll
            for (int j = 0; j < 16; ++j) { const f32x4 a4 = ap[j]; sa0 += S[4 * j] * a4.x + S[4 * j + 1] * a4.y; sa1 += S[4 * j + 2] * a4.z + S[4 * j + 3] * a4.w; }
            __builtin_amdgcn_sched_barrier(0);
            const float sa = sa0 + sa1, vs = st[(s * 7 + 5) * 64 + lane], gs = st[(s * 7 + 6) * 64 + lane]; float y0 = 0.f, y1 = 0.f;
#pragma unroll
            for (int j = 0; j < 16; ++j) { const f32x4 w4 = wp[j], b4 = bp[j], k4 = kp[j], r4 = rp[j];
                S[4 * j] = S[4 * j] * w4.x + sa * b4.x + vs * k4.x; S[4 * j + 1] = S[4 * j + 1] * w4.y + sa * b4.y + vs * k4.y;
                S[4 * j + 2] = S[4 * j + 2] * w4.z + sa * b4.z + vs * k4.z; S[4 * j + 3] = S[4 * j + 3] * w4.w + sa * b4.w + vs * k4.w;
                y0 += S[4 * j] * r4.x + S[4 * j + 1] * r4.y; y1 += S[4 * j + 2] * r4.z + S[4 * j + 3] * r4.w;
                if ((j & 3) == 3) __builtin_amdgcn_sched_barrier(0); }
            const float y = y0 + y1, mean = wave_sum(y) * (1.0f / 64.0f), dd = y - mean, var = wave_sum(dd * dd) * (1.0f / 64.0f);
            const float yl = dd * rsqrtf(var + 64e-5f) * lnw + lnb;
            const float bonus = wave_sum(st[(s * 7 + 0) * 64 + lane] * st[(s * 7 + 2) * 64 + lane] * rk) * vs;
            MIX[(row0 + s) * DM + 2048 + c] = (bf16)f2bf((yl + bonus) * gs);
        }
    }
}
__device__ __forceinline__ int next_item(Frame& F, gu32* ctr) {
    volatile LAS int* slot = (volatile LAS int*)(F.lds + LDSCTL_OFF + 64);
    __syncthreads();
    if (F.tid == 0) *slot = (int)__hip_atomic_fetch_add(ctr, 1u, RLX_AGENT);
    __syncthreads();
    return *slot;
}
__device__ __forceinline__ void mixers_v1(Frame& F, int l) {
    gu32* ctr = F.ctl + CW_Q + 64 * l;
    for (;;) {
        const int it = next_item(F, ctr); relaunder(F); relaunder_tid(F);
        if (it < 4) { rwkv_unit_v1(F, l, it >> 1, it & 1); }
        else if (it < 12) { const int j = it - 4; gla_unit_v1(F, l, j >> 2, j & 3); }
        else if (it < 12 + 2048) { const int j = it - 12, qt = 127 - (j >> 4), bh = j & 15; diff_unit_v1(F, l, bh >> 3, bh & 7, qt); }
        else if (it < 12 + 2048 + 512) { const int j = it - 2060, qt = j & 127, bk = j >> 7; swa_unit_v1(F, l, bk >> 1, bk & 1, qt); }
        else break;
    }
}
typedef float f32x16 __attribute__((ext_vector_type(16)));
__device__ __forceinline__ float xother32(float v) { unsigned a = __builtin_bit_cast(unsigned, v), b = a; asm volatile("" : "+v"(b)); auto rr = __builtin_amdgcn_permlane32_swap(a, b, false, false);
    const unsigned lo = rr[0], hi = rr[1]; return __builtin_bit_cast(float, (unsigned)((__builtin_amdgcn_mbcnt_hi(~0u, __builtin_amdgcn_mbcnt_lo(~0u, 0u)) & 32u) ? lo : hi)); }
__device__ __forceinline__ float xsum32(float v) { return v + xother32(v); }
__device__ __forceinline__ float xmax32(float v) { return fmaxf(v, xother32(v)); }
__device__ __forceinline__ int crow16(int r, int hi) { return (r & 3) + 8 * (r >> 2) + 4 * hi; }
template <bool ISA>
__device__ __forceinline__ void attn_unit(Frame& F, int l, int b, int hx, int qb) {
    constexpr int DV = ISA ? 128 : 64, NDV = DV / 32, KSTR = ISA ? 272 : 144, VSTR = 144, KBYTES = 64 * KSTR, VBYTES = DV * VSTR, BUFB = KBYTES + VBYTES, NCH = ISA ? 2 : 1;
    constexpr float NEG = -1e30f;
    LAS unsigned char* L = F.lds + RING_OFF;
    const int tid = F.tid, lane = F.lane, r32 = lane & 31, hi = lane >> 5, qs = F.wave & 3, grp = F.wave >> 2, q0 = qb * 128;
    const int kvh = hx >> 2, hd = kvh * 8 + (hx & 3) * 2 + grp;
    const bf16* Qp; const bf16* Kp; const bf16* VT; int ldq;
    if (ISA) { const bf16* QKA = WSP(bf16, WS_QKA); Qp = QKA + (size_t)b * SEQ * 2048 + hx * 128 + grp * 64; Kp = QKA + (size_t)b * SEQ * 2048 + 1024 + hx * 128; ldq = 2048; VT = WSP(bf16, WS_VTA) + (size_t)(b * 8 + hx) * 128 * SEQ; }
    else { const bf16* QKD = WSP(bf16, WS_QKD); Qp = QKD + (size_t)b * SEQ * 1152 + hd * 64; Kp = QKD + (size_t)b * SEQ * 1152 + 1024 + kvh * 64; ldq = 1152; VT = WSP(bf16, WS_VTD) + (size_t)(b * 2 + kvh) * 64 * SEQ; }
    const int qpos = q0 + 32 * qs + r32;
    bf16x8 qr[4];
#pragma unroll
    for (int d0 = 0; d0 < 4; ++d0) qr[d0] = *(const bf16x8*)(Qp + (size_t)qpos * ldq + d0 * 16 + hi * 8);
    LAS float* Bt = (LAS float*)(L + 2 * BUFB);
    { const float* TAB = WSP(float, WS_TAB);
      if (ISA) { if (tid < 128) Bt[tid] = TAB[hx * 128 + tid] - TAB[hx * 128 + 127]; }
      else { if (tid < 256) Bt[tid] = TAB[(8 + kvh * 8 + (hx & 3) * 2 + (tid >> 7)) * 128 + (tid & 127)]; } }
    const int TQ = q0 >> 6, T0 = ISA ? 0 : (TQ >= 2 ? TQ - 2 : 0), T1 = TQ + 1;
    v4u kreg[NCH], vreg[NCH];
#define AT_GLOAD(T) do { _Pragma("unroll") for (int i_ = 0; i_ < NCH; ++i_) { const int c_ = tid + 512 * i_; \
        const int kr_ = ISA ? (c_ >> 4) : (c_ >> 3), kc_ = ISA ? (c_ & 15) : (c_ & 7); kreg[i_] = *(const v4u*)(Kp + (size_t)((T) * 64 + kr_) * ldq + kc_ * 8); \
        const int vr_ = c_ >> 3, vc_ = c_ & 7; vreg[i_] = *(const v4u*)(VT + (size_t)vr_ * SEQ + (T) * 64 + vc_ * 8); } } while (0)
#define AT_LWRITE(buf) do { _Pragma("unroll") for (int i_ = 0; i_ < NCH; ++i_) { const int c_ = tid + 512 * i_; \
        const int kr_ = ISA ? (c_ >> 4) : (c_ >> 3), kc_ = ISA ? (c_ & 15) : (c_ & 7); *(LAS v4u*)(L + (buf) * BUFB + kr_ * KSTR + kc_ * 16) = kreg[i_]; \
        const int vr_ = c_ >> 3, vc_ = c_ & 7; *(LAS v4u*)(L + (buf) * BUFB + KBYTES + vr_ * VSTR + vc_ * 16) = vreg[i_]; } } while (0)
    f32x16 o[NDV];
#pragma unroll
    for (int i = 0; i < NDV; ++i) o[i] = (f32x16){0.f, 0.f, 0.f, 0.f, 0.f, 0.f, 0.f, 0.f, 0.f, 0.f, 0.f, 0.f, 0.f, 0.f, 0.f, 0.f};
    float m_run = ISA ? NEG : F.kin[I_SSINK][l * 16 + hd] * LOG2E, l_run = ISA ? 0.f : (hi == 0 ? 1.f : 0.f);
    const int krow = (r32 & 16) | (r32 & 3) | ((r32 & 4) << 1) | ((r32 & 8) >> 1);
    const int koff = krow * KSTR + (ISA ? grp * 128 : 0) + hi * 16, voff = KBYTES + r32 * VSTR + hi * 16;
    AT_GLOAD(T0); AT_LWRITE(0); __syncthreads();
#pragma unroll 1
    for (int T = T0; T <= T1; ++T) {
        const int cur = (T - T0) & 1;
        if (T < T1) AT_GLOAD(T + 1);
        LAS const unsigned char* Kb = L + cur * BUFB;
        f32x16 s[2];
#pragma unroll
        for (int blk = 0; blk < 2; ++blk) { s[blk] = (f32x16){0.f, 0.f, 0.f, 0.f, 0.f, 0.f, 0.f, 0.f, 0.f, 0.f, 0.f, 0.f, 0.f, 0.f, 0.f, 0.f};
#pragma unroll
            for (int d0 = 0; d0 < 4; ++d0) { const bf16x8 kf = *(const LAS bf16x8*)(Kb + koff + blk * 32 * KSTR + d0 * 32); s[blk] = __builtin_amdgcn_mfma_f32_32x32x16_bf16(kf, qr[d0], s[blk], 0, 0, 0); } }
        if (!ISA || T >= TQ - 2) {
#pragma unroll
            for (int blk = 0; blk < 2; ++blk)
#pragma unroll
                for (int r = 0; r < 16; ++r) { const int kvl = 32 * blk + 16 * (r >> 3) + 8 * hi + (r & 7), dist = qpos - (T * 64 + kvl);
                    const int di = dist < 0 ? 0 : (dist > 127 ? 127 : dist);
                    const float bv = Bt[(ISA ? 0 : grp * 128) + di];
                    if (ISA) s[blk][r] = dist < 0 ? NEG : (dist < 128 ? s[blk][r] + bv : s[blk][r]);
                    else s[blk][r] = (dist < 0 || dist > 127) ? NEG : s[blk][r] + bv; } }
        float mt = s[0][0];
#pragma unroll
        for (int r = 1; r < 16; ++r) mt = fmaxf(mt, s[0][r]);
#pragma unroll
        for (int r = 0; r < 16; ++r) mt = fmaxf(mt, s[1][r]);
        mt = xmax32(mt);
        const float m_new = fmaxf(m_run, mt);
        if (__any(m_new > m_run)) { const float alpha = __builtin_amdgcn_exp2f(m_run - m_new); l_run *= alpha;
#pragma unroll
            for (int i = 0; i < NDV; ++i)
#pragma unroll
                for (int r = 0; r < 16; ++r) o[i][r] *= alpha;
            m_run = m_new; }
        float ls = 0.f;
#pragma unroll
        for (int blk = 0; blk < 2; ++blk)
#pragma unroll
            for (int r = 0; r < 16; ++r) { const float pv_ = __builtin_amdgcn_exp2f(s[blk][r] - m_run); s[blk][r] = pv_; ls += pv_; }
        l_run += ls;
#pragma unroll
        for (int sl = 0; sl < 4; ++sl) { const int blk = sl >> 1, r0 = 8 * (sl & 1);
            v4u pw; pw.x = pg8::cvt_pk_bf16(s[blk][r0], s[blk][r0 + 1]); pw.y = pg8::cvt_pk_bf16(s[blk][r0 + 2], s[blk][r0 + 3]); pw.z = pg8::cvt_pk_bf16(s[blk][r0 + 4], s[blk][r0 + 5]); pw.w = pg8::cvt_pk_bf16(s[blk][r0 + 6], s[blk][r0 + 7]);
            const bf16x8 pf = __builtin_bit_cast(bf16x8, pw);
#pragma unroll
            for (int i = 0; i < NDV; ++i) { const bf16x8 vf = *(const LAS bf16x8*)(Kb + voff + i * 32 * VSTR + sl * 32); o[i] = __builtin_amdgcn_mfma_f32_32x32x16_bf16(vf, pf, o[i], 0, 0, 0); } }
        if (T < T1) AT_LWRITE(cur ^ 1);
        __syncthreads();
    }
#undef AT_GLOAD
#undef AT_LWRITE
    const float inv = 1.0f / xsum32(l_run);
    bf16* MIX = WSP(bf16, WS_MIXED);
    if (ISA) {
        const float lam_init = 0.8f - 0.6f * __expf(-0.3f * (float)l); float lam_full;
        { const float* lm = F.kin[I_DLAM] + (size_t)l * 256; const float s1 = wave_sum(lm[lane] * lm[64 + lane]), s2 = wave_sum(lm[128 + lane] * lm[192 + lane]); lam_full = __expf(s1) - __expf(s2) + lam_init; }
        LAS float* R1 = (LAS float*)L;
        LAS bf16* R2 = (LAS bf16*)(L + 66048);
        const int ql = 32 * qs + r32;
        if (grp == 1) {
#pragma unroll
            for (int i = 0; i < NDV; ++i)
#pragma unroll
                for (int r = 0; r < 16; ++r) R1[ql * 129 + 32 * i + crow16(r, hi)] = lam_full * inv * o[i][r]; }
        __syncthreads();
        if (grp == 0) { float ss = 0.f;
#pragma unroll
            for (int i = 0; i < NDV; ++i)
#pragma unroll
                for (int r = 0; r < 16; ++r) { const float d = o[i][r] * inv - R1[ql * 129 + 32 * i + crow16(r, hi)]; o[i][r] = d; ss += d * d; }
            const float rstd = rsqrtf(xsum32(ss) * (1.0f / 128.0f) + 1e-6f) * (1.0f - lam_init);
            const float* sl = F.kin[I_DSUB] + l * 128;
#pragma unroll
            for (int i = 0; i < NDV; ++i)
#pragma unroll
                for (int r = 0; r < 16; ++r) { const int dv = 32 * i + crow16(r, hi); R2[ql * 132 + dv] = (bf16)f2bf(o[i][r] * rstd * sl[dv]); } }
        __syncthreads();
#pragma unroll
        for (int i = 0; i < 4; ++i) { const int c = tid + 512 * i, row = c >> 4, ch = c & 15; const LAS v2u* sp = (const LAS v2u*)(R2 + row * 132 + ch * 8); const v2u a = sp[0], bb = sp[1];
            *(v4u*)(MIX + (size_t)(b * SEQ + q0 + row) * DM + hx * 128 + ch * 8) = (v4u){a.x, a.y, bb.x, bb.y}; }
    } else {
        LAS bf16* R = (LAS bf16*)L + F.wave * 2176;
#pragma unroll
        for (int i = 0; i < NDV; ++i)
#pragma unroll
            for (int r = 0; r < 16; ++r) R[r32 * 68 + 32 * i + crow16(r, hi)] = (bf16)f2bf(o[i][r] * inv);
#pragma unroll
        for (int i = 0; i < 4; ++i) { const int c = lane + 64 * i, row = c >> 3, ch = c & 7; const LAS v2u* sp = (const LAS v2u*)(R + row * 68 + ch * 8); const v2u a = sp[0], bb = sp[1];
            *(v4u*)(MIX + (size_t)(b * SEQ + q0 + 32 * qs + row) * DM + 3072 + hd * 64 + ch * 8) = (v4u){a.x, a.y, bb.x, bb.y}; }
    }
}
__device__ __forceinline__ void prep_gla(Frame& F) {
    LAS float* Lb = (LAS float*)(F.lds + RING_OFF); LAS float* Qd = Lb + 64 * 129; LAS float* Ki = Qd + 64 * 129; LAS bf16* Kt = (LAS bf16*)(Ki + 64 * 129);
    const bf16* COLS = WSP(bf16, WS_COLS); const float* LOGA = WSP(float, WS_LOGA);
    bf16* QDEC = WSP(bf16, WS_QDEC); bf16* KDT = WSP(bf16, WS_KDT); bf16* AMg = WSP(bf16, WS_AM); float* EBL = WSP(float, WS_EBL);
    for (int u = F.bx; u < 1024; u += F.G) {
        const int b = u >> 9, h = (u >> 7) & 3, ck = u & 127; const size_t row0 = (size_t)b * SEQ + ck * 64;
        __syncthreads();
        for (int idx = F.tid; idx < 8192; idx += NWAVES * 64) { const int t = idx >> 7, d = idx & 127; Lb[t * 129 + d] = LOGA[(row0 + t) * 512 + h * 128 + d]; }
        __syncthreads();
        if (F.tid < 128) { float acc = 0.f;
#pragma unroll 8
            for (int t = 0; t < 64; ++t) { acc += Lb[t * 129 + F.tid]; Lb[t * 129 + F.tid] = acc; }
            EBL[(size_t)u * 128 + F.tid] = __expf(acc); }
        __syncthreads();
        for (int idx = F.tid; idx < 8192; idx += NWAVES * 64) { const int t = idx >> 7, d = idx & 127; const float bt = Lb[t * 129 + d], bl = Lb[63 * 129 + d];
            const float q = bf2f(COLS[(row0 + t) * NMAIN + CB_Q + h * 128 + d]) * 0.08838834764831845f, k = bf2f(COLS[(row0 + t) * NMAIN + CB_K + h * 128 + d]);
            const float qd = q * __expf(bt); Qd[t * 129 + d] = qd; Ki[t * 129 + d] = k * __expf(-bt); Kt[d * 72 + t] = (bf16)f2bf(k * __expf(bl - bt));
            QDEC[((size_t)u * 64 + t) * 128 + d] = (bf16)f2bf(qd); }
        __syncthreads();
#pragma unroll
        for (int i = 0; i < 2; ++i) { const int c_ = F.tid + 512 * i, row = c_ >> 3, ch = c_ & 7; const LAS v2u* sp = (const LAS v2u*)(Kt + row * 72 + ch * 8); const v2u a = sp[0], bb = sp[1];
            *(v4u*)(KDT + ((size_t)u * 128 + row) * 64 + ch * 8) = (v4u){a.x, a.y, bb.x, bb.y}; }
        { const int c = F.tid >> 3, sg = F.tid & 7; float acc[8];
#pragma unroll
          for (int e = 0; e < 8; ++e) acc[e] = 0.f;
#pragma unroll 4
          for (int d = 0; d < 128; ++d) { const float q = Qd[c * 129 + d];
#pragma unroll
              for (int e = 0; e < 8; ++e) acc[e] += q * Ki[(sg * 8 + e) * 129 + d]; }
#pragma unroll
          for (int e = 0; e < 8; ++e) if (sg * 8 + e > c) acc[e] = 0.f;
          *(v4u*)(AMg + ((size_t)u * 64 + c) * 64 + sg * 8) = pack8(acc); }
    }
}
__device__ __forceinline__ void prep_vt(Frame& F, int pass) {
    LAS bf16* T = (LAS bf16*)(F.lds + RING_OFF);
    const bf16* COLS = WSP(bf16, WS_COLS);
    const int nch = pass == 0 ? 144 : 128, nvr = nch * 8;
    for (int tile = F.bx; tile < M / 32; tile += F.G) {
        const int b = tile >> 8, t0 = (tile & 255) * 32;
        __syncthreads();
        for (int idx = F.tid; idx < 32 * nch; idx += NWAVES * 64) { const int tok = idx / nch, ch = idx % nch;
            const int col = pass == 0 ? (ch < 128 ? CA_V + ch * 8 : CD_V + (ch - 128) * 8) : (pass == 1 ? CB_V + ch * 8 : CB_G + ch * 8);
            const v4u v = *(const v4u*)(COLS + (size_t)(b * SEQ + t0 + tok) * NMAIN + col); LAS v2u* d = (LAS v2u*)(T + tok * 1160 + ch * 8); d[0] = (v2u){v.x, v.y}; d[1] = (v2u){v.z, v.w}; }
        __syncthreads();
        for (int idx = F.tid; idx < nvr * 4; idx += NWAVES * 64) { const int ch = idx / nvr, vrow = idx % nvr;
            unsigned e[8];
#pragma unroll
            for (int k = 0; k < 8; ++k) e[k] = T[(ch * 8 + k) * 1160 + vrow];
            v4u o; o.x = e[0] | (e[1] << 16); o.y = e[2] | (e[3] << 16); o.z = e[4] | (e[5] << 16); o.w = e[6] | (e[7] << 16);
            bf16* dst;
            if (pass == 0) dst = vrow < 1024 ? WSP(bf16, WS_VTA) + ((size_t)(b * 8 + (vrow >> 7)) * 128 + (vrow & 127)) * SEQ : WSP(bf16, WS_VTD) + ((size_t)(b * 2 + ((vrow - 1024) >> 6)) * 64 + ((vrow - 1024) & 63)) * SEQ;
            else dst = WSP(bf16, pass == 1 ? WS_VTB : WS_GTB) + ((size_t)b * 1024 + vrow) * SEQ;
            *(v4u*)(dst + t0 + ch * 8) = o; }
    }
}
typedef float f32x4v __attribute__((ext_vector_type(4)));
__device__ __forceinline__ float sum16(float v) { v = sum8(v); v += dpp_f<0x140>(v); return v; }
__device__ __forceinline__ void gla_scan_unit(Frame& F, int l, int b, int h) {
    LAS unsigned char* L = F.lds + RING_OFF;
    constexpr int OQD = 0, OKT = 17408, OAM = 35840, OVT = 45056, OGT = 81920, OEB = 118784, OPS = 119296;
    const int tid = F.tid, lane = F.lane, n = lane & 15, g = lane >> 4, w = F.wave;
    const bf16* QDEC = WSP(bf16, WS_QDEC); const bf16* KDT = WSP(bf16, WS_KDT); const bf16* AMg = WSP(bf16, WS_AM); const float* EBL = WSP(float, WS_EBL);
    const bf16* VTB = WSP(bf16, WS_VTB) + (size_t)(b * 4 + h) * 256 * SEQ; const bf16* GTB = WSP(bf16, WS_GTB) + (size_t)(b * 4 + h) * 256 * SEQ; bf16* MIX = WSP(bf16, WS_MIXED);
    f32x4v S[8][2];
#pragma unroll
    for (int dt = 0; dt < 8; ++dt)
#pragma unroll
        for (int vt = 0; vt < 2; ++vt) S[dt][vt] = (f32x4v){0.f, 0.f, 0.f, 0.f};
    float gain[2];
#pragma unroll
    for (int vt = 0; vt < 2; ++vt) gain[vt] = F.kin[I_GON][l * 256 + 32 * w + 16 * vt + n];
#pragma unroll 1
    for (int ck = 0; ck < 128; ++ck) {
        const size_t u = (size_t)(b * 4 + h) * 128 + ck; const size_t row0 = (size_t)b * SEQ + ck * 64;
        __syncthreads();
#pragma unroll
        for (int i = 0; i < 2; ++i) { const int c_ = tid + 512 * i; *(LAS v4u*)(L + OQD + (c_ >> 4) * 272 + (c_ & 15) * 16) = *(const v4u*)(QDEC + (u * 64 + (c_ >> 4)) * 128 + (c_ & 15) * 8);
            *(LAS v4u*)(L + OKT + (c_ >> 3) * 144 + (c_ & 7) * 16) = *(const v4u*)(KDT + (u * 128 + (c_ >> 3)) * 64 + (c_ & 7) * 8); }
        *(LAS v4u*)(L + OAM + (tid >> 3) * 144 + (tid & 7) * 16) = *(const v4u*)(AMg + (u * 64 + (tid >> 3)) * 64 + (tid & 7) * 8);
#pragma unroll
        for (int i = 0; i < 4; ++i) { const int c_ = tid + 512 * i, row = c_ >> 3, ch = c_ & 7;
            *(LAS v4u*)(L + OVT + row * 144 + ch * 16) = *(const v4u*)(VTB + (size_t)row * SEQ + ck * 64 + ch * 8);
            *(LAS v4u*)(L + OGT + row * 144 + ch * 16) = *(const v4u*)(GTB + (size_t)row * SEQ + ck * 64 + ch * 8); }
        if (tid < 128) ((LAS float*)(L + OEB))[tid] = EBL[u * 128 + tid];
        __syncthreads();
        bf16x8 vf[2][2];
#pragma unroll
        for (int vt = 0; vt < 2; ++vt)
#pragma unroll
            for (int ks = 0; ks < 2; ++ks) vf[vt][ks] = *(const LAS bf16x8*)(L + OVT + (32 * w + 16 * vt + n) * 144 + (32 * ks + 8 * g) * 2);
        f32x4v o[4][2];
#pragma unroll
        for (int ct = 0; ct < 4; ++ct)
#pragma unroll
            for (int vt = 0; vt < 2; ++vt) o[ct][vt] = (f32x4v){0.f, 0.f, 0.f, 0.f};
#pragma unroll
        for (int ct = 0; ct < 4; ++ct)
#pragma unroll
            for (int ks = 0; ks < 2; ++ks) { const bf16x8 af = *(const LAS bf16x8*)(L + OAM + (16 * ct + n) * 144 + (32 * ks + 8 * g) * 2);
#pragma unroll
                for (int vt = 0; vt < 2; ++vt) o[ct][vt] = __builtin_amdgcn_mfma_f32_16x16x32_bf16(af, vf[vt][ks], o[ct][vt], 0, 0, 0); }
#pragma unroll
        for (int kk = 0; kk < 4; ++kk) { bf16x8 sf[2];
#pragma unroll
            for (int vt = 0; vt < 2; ++vt) { v4u pw; pw.x = pg8::cvt_pk_bf16(S[2 * kk][vt][0], S[2 * kk][vt][1]); pw.y = pg8::cvt_pk_bf16(S[2 * kk][vt][2], S[2 * kk][vt][3]);
                pw.z = pg8::cvt_pk_bf16(S[2 * kk + 1][vt][0], S[2 * kk + 1][vt][1]); pw.w = pg8::cvt_pk_bf16(S[2 * kk + 1][vt][2], S[2 * kk + 1][vt][3]); sf[vt] = __builtin_bit_cast(bf16x8, pw); }
#pragma unroll
            for (int ct = 0; ct < 4; ++ct) { const LAS unsigned char* qp = L + OQD + (16 * ct + n) * 272 + (32 * kk + 4 * g) * 2; const v2u qa = *(const LAS v2u*)qp, qb = *(const LAS v2u*)(qp + 32);
                const bf16x8 qf = __builtin_bit_cast(bf16x8, (v4u){qa.x, qa.y, qb.x, qb.y});
#pragma unroll
                for (int vt = 0; vt < 2; ++vt) o[ct][vt] = __builtin_amdgcn_mfma_f32_16x16x32_bf16(qf, sf[vt], o[ct][vt], 0, 0, 0); } }
#pragma unroll
        for (int dt = 0; dt < 8; ++dt) { const f32x4v eb = *(const LAS f32x4v*)(L + OEB + (16 * dt + 4 * g) * 4);
#pragma unroll
            for (int vt = 0; vt < 2; ++vt) S[dt][vt] = S[dt][vt] * eb;
#pragma unroll
            for (int ks = 0; ks < 2; ++ks) { const bf16x8 kf = *(const LAS bf16x8*)(L + OKT + (16 * dt + n) * 144 + (32 * ks + 8 * g) * 2);
#pragma unroll
                for (int vt = 0; vt < 2; ++vt) S[dt][vt] = __builtin_amdgcn_mfma_f32_16x16x32_bf16(kf, vf[vt][ks], S[dt][vt], 0, 0, 0); } }
        LAS float* PS = (LAS float*)(L + OPS);
#pragma unroll
        for (int ct = 0; ct < 4; ++ct)
#pragma unroll
            for (int r = 0; r < 4; ++r) { const float ss = sum16(o[ct][0][r] * o[ct][0][r] + o[ct][1][r] * o[ct][1][r]); if (n == 0) PS[(16 * ct + 4 * g + r) * 8 + w] = ss; }
        __syncthreads();
#pragma unroll
        for (int ct = 0; ct < 4; ++ct) { float rstd[4];
#pragma unroll
            for (int r = 0; r < 4; ++r) { const LAS f32x4v* pp = (const LAS f32x4v*)(PS + (16 * ct + 4 * g + r) * 8); const f32x4v p0 = pp[0], p1 = pp[1];
                rstd[r] = rsqrtf(((p0.x + p0.y) + (p0.z + p0.w) + (p1.x + p1.y) + (p1.z + p1.w)) * (1.0f / 256.0f) + 1e-6f); }
#pragma unroll
            for (int vt = 0; vt < 2; ++vt) { const int vc = 32 * w + 16 * vt + n; const v2u gr = *(const LAS v2u*)(L + OGT + vc * 144 + (16 * ct + 4 * g) * 2);
                const float gg[4] = {bflo(gr.x), bfhi(gr.x), bflo(gr.y), bfhi(gr.y)};
#pragma unroll
                for (int r = 0; r < 4; ++r) MIX[(row0 + 16 * ct + 4 * g + r) * DM + 1024 + h * 256 + vc] = (bf16)f2bf(o[ct][vt][r] * rstd[r] * gain[vt] * silu_g(gg[r])); } }
    }
}
__device__ __forceinline__ void mixers_v3(Frame& F, int l) {
    gu32* ctr = F.ctl + CW_Q + 64 * l;
    for (;;) {
        const int it = next_item(F, ctr); relaunder(F); relaunder_tid(F);
        if (it < 4) { rwkv_unit_v1(F, l, it >> 1, it & 1); }
        else if (it < 12) { const int j = it - 4; gla_scan_unit(F, l, j >> 2, j & 3); }
        else if (it < 12 + 1024) { const int j = it - 12, qb = 63 - (j >> 4), bh = j & 15; attn_unit<true>(F, l, bh >> 3, bh & 7, qb); }
        else if (it < 12 + 2048) { const int j = it - 1036, qb = j & 63, bh = j >> 6; attn_unit<false>(F, l, bh >> 3, bh & 7, qb); }
        else break;
    }
}
constexpr int RC_AT = 0, RC_RT = 2048, RC_BK = 4096, RC_VF = 8192, RC_GF = 10240, RC_U0 = 12288, RC_Y0 = 16384, RC_P15 = 20480, RC_BN = 20736, RC_BYTES = 20800;
__device__ __forceinline__ void prep_rwkv_chunks(Frame& F, int l) {
    const int team = F.tid >> 8, tt = F.tid & 255;
    LAS float* Lt = (LAS float*)(F.lds + RING_OFF) + team * 12288;
    LAS float* XA = Lt; LAS float* XR = Lt + 1040; LAS float* ZB = Lt + 2080; LAS float* ZK = Lt + 3120; LAS float* TB = Lt + 4160; LAS float* TK = Lt + 5200; LAS float* VV = Lt + 6240;
    LAS float* ATl = Lt + 7280; LAS float* U0l = Lt + 8320; LAS float* W1 = Lt + 9360;
    LAS float* Aab = Lt + 10400; LAS float* Aak = Lt + 10672; LAS float* Arb = Lt + 10944; LAS float* Ark = Lt + 11216; LAS float* TT = Lt + 11488;
    const float* RW = WSP(float, WS_RW); constexpr size_t RS = RW_ONE / 4; unsigned char* RWC = F.ws + WS_RWC;
    for (int pair = F.bx; pair < 8192; pair += F.G) {
        const int uc = pair * 2 + team, b = uc >> 13, h = (uc >> 9) & 15, ck = uc & 511; const size_t row0 = (size_t)b * SEQ + ck * 16; unsigned char* rec = RWC + (size_t)uc * RC_BYTES;
        __syncthreads();
        {
          const int j = tt & 63, q = tt >> 6; const size_t cb = row0 * 1024 + h * 64 + j;
          float cl = 0.f, clq[4] = {0.f, 0.f, 0.f, 0.f}, clm = 0.f;
#pragma unroll
          for (int t = 0; t < 16; ++t) { const float lw = __logf(RW[RS + cb + (size_t)t * 1024]); if (t == 4 * q) clm = cl; cl += lw; if ((t >> 2) == q) clq[t & 3] = cl; }
#pragma unroll
          for (int e = 0; e < 4; ++e) { const int t = 4 * q + e; const size_t o = cb + (size_t)t * 1024; const float cprev = e == 0 ? clm : clq[e - 1], cc = clq[e];
              const float rr = RW[o], kk = RW[2 * RS + o], vv = RW[3 * RS + o], aa = RW[4 * RS + o], bb = RW[5 * RS + o];
              XA[t * 65 + j] = aa * __expf(cprev); XR[t * 65 + j] = rr * __expf(cc); const float ei = __expf(-cc), ef = __expf(cl - cc);
              ZB[t * 65 + j] = bb * ei; ZK[t * 65 + j] = kk * ei; TB[t * 65 + j] = bb * ef; TK[t * 65 + j] = kk * ef; VV[t * 65 + j] = vv; }
          if (q == 0) ((float*)(rec + RC_P15))[j] = __expf(cl);
          { v2u gw; const size_t o = cb + (size_t)(4 * q) * 1024; gw.x = pk2(RW[6 * RS + o], RW[6 * RS + o + 1024]); gw.y = pk2(RW[6 * RS + o + 2048], RW[6 * RS + o + 3072]);
            *(v2u*)(rec + RC_GF + (((j >> 4) * 64 + 16 * q + (j & 15)) * 8)) = gw; } }
        __syncthreads();
        {
          const int t = tt >> 4, s = tt & 15; float ab = 0.f, ak = 0.f, rb = 0.f, rk = 0.f;
#pragma unroll 8
          for (int j = 0; j < 64; ++j) { const float xa = XA[t * 65 + j], xr = XR[t * 65 + j], zb = ZB[s * 65 + j], zk = ZK[s * 65 + j]; ab += xa * zb; ak += xa * zk; rb += xr * zb; rk += xr * zk; }
          Aab[t * 17 + s] = s < t ? ab : 0.f; Aak[t * 17 + s] = s < t ? ak : 0.f; Arb[t * 17 + s] = s <= t ? rb : 0.f; Ark[t * 17 + s] = s <= t ? rk : 0.f;
          if (tt < 16) { float bn = 0.f; const float* rkp = F.kin[I_RRK] + l * 1024 + h * 64;
#pragma unroll 8
              for (int j = 0; j < 64; ++j) bn += XR[tt * 65 + j] * ZK[tt * 65 + j] * rkp[j];
              ((float*)(rec + RC_BN))[tt] = bn; } }
        __syncthreads();
        {
          if (tt < 16) { float col[16];
#pragma unroll
              for (int t = 0; t < 16; ++t) { float acc = (t == tt) ? 1.f : 0.f;
#pragma unroll
                  for (int s = 0; s < 16; ++s) if (s < t) acc += Aab[t * 17 + s] * col[s];
                  col[t] = acc; TT[t * 17 + tt] = acc; } }
          const int i = tt & 63, tq = tt >> 6; float acc[4] = {0.f, 0.f, 0.f, 0.f};
#pragma unroll
          for (int s = 0; s < 16; ++s) { const float vv = VV[s * 65 + i];
#pragma unroll
              for (int e = 0; e < 4; ++e) acc[e] += Aak[(4 * tq + e) * 17 + s] * vv; }
#pragma unroll
          for (int e = 0; e < 4; ++e) W1[(4 * tq + e) * 65 + i] = acc[e]; }
        __syncthreads();
        {
          const int j = tt & 63, tq = tt >> 6; float a4[4] = {0.f, 0.f, 0.f, 0.f}, u4[4] = {0.f, 0.f, 0.f, 0.f};
#pragma unroll
          for (int s = 0; s < 16; ++s) { const float xa = XA[s * 65 + j], w1 = W1[s * 65 + j];
#pragma unroll
              for (int e = 0; e < 4; ++e) { const float tv = TT[(4 * tq + e) * 17 + s]; a4[e] += tv * xa; u4[e] += tv * w1; } }
#pragma unroll
          for (int e = 0; e < 4; ++e) { ATl[(4 * tq + e) * 65 + j] = a4[e]; U0l[(4 * tq + e) * 65 + j] = u4[e]; }
          *(f32x4*)(rec + RC_U0 + (((j >> 4) * 64 + 16 * tq + (j & 15)) * 16)) = (f32x4){u4[0], u4[1], u4[2], u4[3]}; }
        __syncthreads();
        {
          const int j = tt & 63, tq = tt >> 6; float r4[4], y4[4];
#pragma unroll
          for (int e = 0; e < 4; ++e) { r4[e] = XR[(4 * tq + e) * 65 + j]; y4[e] = 0.f; }
#pragma unroll
          for (int s = 0; s < 16; ++s) { const float at = ATl[s * 65 + j], u0 = U0l[s * 65 + j], vv = VV[s * 65 + j];
#pragma unroll
              for (int e = 0; e < 4; ++e) { const float arb = Arb[(4 * tq + e) * 17 + s], ark = Ark[(4 * tq + e) * 17 + s]; r4[e] += arb * at; y4[e] += arb * u0 + ark * vv; } }
          *(f32x4*)(rec + RC_Y0 + (((j >> 4) * 64 + 16 * tq + (j & 15)) * 16)) = (f32x4){y4[0], y4[1], y4[2], y4[3]};
#pragma unroll
          for (int e = 0; e < 4; ++e) W1[(4 * tq + e) * 65 + j] = r4[e]; }
        __syncthreads();
        { const int t = tt & 15, jq = tt >> 4, kk = jq >> 3, half = (jq & 7) >> 2, g = jq & 3, j0 = 4 * jq;
          v2u wa, wr; wa.x = pk2(ATl[t * 65 + j0], ATl[t * 65 + j0 + 1]); wa.y = pk2(ATl[t * 65 + j0 + 2], ATl[t * 65 + j0 + 3]); wr.x = pk2(W1[t * 65 + j0], W1[t * 65 + j0 + 1]); wr.y = pk2(W1[t * 65 + j0 + 2], W1[t * 65 + j0 + 3]);
          *(v2u*)(rec + RC_AT + kk * 1024 + (16 * g + t) * 16 + half * 8) = wa; *(v2u*)(rec + RC_RT + kk * 1024 + (16 * g + t) * 16 + half * 8) = wr;
          const int j = tt & 63, gg = tt >> 6; v4u bk; bk.x = pk2(TB[(4 * gg) * 65 + j], TB[(4 * gg + 1) * 65 + j]); bk.y = pk2(TB[(4 * gg + 2) * 65 + j], TB[(4 * gg + 3) * 65 + j]);
          bk.z = pk2(TK[(4 * gg) * 65 + j], TK[(4 * gg + 1) * 65 + j]); bk.w = pk2(TK[(4 * gg + 2) * 65 + j], TK[(4 * gg + 3) * 65 + j]);
          *(v4u*)(rec + RC_BK + (j >> 4) * 1024 + (16 * gg + (j & 15)) * 16) = bk;
          v2u vf; vf.x = pk2(VV[(4 * gg) * 65 + j], VV[(4 * gg + 1) * 65 + j]); vf.y = pk2(VV[(4 * gg + 2) * 65 + j], VV[(4 * gg + 3) * 65 + j]);
          *(v2u*)(rec + RC_VF + ((j >> 4) * 64 + 16 * gg + (j & 15)) * 8) = vf; }
    }
}
__device__ __forceinline__ void rwkv_scan_unit(Frame& F, int l, int b, int h) {
    LAS unsigned char* L = F.lds + RING_OFF;
    const unsigned char* recs = F.ws + WS_RWC + (size_t)((b * 16 + h) * 512) * RC_BYTES;
    const int lane = F.lane, n = lane & 15, g = lane >> 4;
    if (F.wave != 0) {
        const int li = F.tid - 64; const bool act0 = li < 1300, act1 = li + 448 < 1300, act2 = li + 896 < 1300;
        v4u p0[3], p1[3], p2[3];
#define RWL_ISSUE(P, CK) do { if ((CK) < 512) { const v4u* src_ = (const v4u*)(recs + (size_t)(CK) * RC_BYTES); if (act0) P[0] = src_[li]; if (act1) P[1] = src_[li + 448]; if (act2) P[2] = src_[li + 896]; } } while (0)
#define RWL_WRITE(P, CK) do { if ((CK) < 512) { LAS v4u* dst_ = (LAS v4u*)(L + ((CK) & 1) * RC_BYTES); if (act0) dst_[li] = P[0]; if (act1) dst_[li + 448] = P[1]; if (act2) dst_[li + 896] = P[2]; } } while (0)
        RWL_ISSUE(p0, 0); RWL_ISSUE(p1, 1); RWL_ISSUE(p2, 2);
        RWL_WRITE(p0, 0); RWL_ISSUE(p0, 3);
        __syncthreads();
#pragma unroll 1
        for (int ck = 0; ck < 512; ck += 3) {
            RWL_WRITE(p1, ck + 1); RWL_ISSUE(p1, ck + 4); __syncthreads();
            if (ck + 1 < 512) { RWL_WRITE(p2, ck + 2); RWL_ISSUE(p2, ck + 5); __syncthreads(); }
            if (ck + 2 < 512) { RWL_WRITE(p0, ck + 3); RWL_ISSUE(p0, ck + 6); __syncthreads(); }
        }
#undef RWL_ISSUE
#undef RWL_WRITE
        return;
    }
    f32x4v S[4][4];
#pragma unroll
    for (int jt = 0; jt < 4; ++jt)
#pragma unroll
        for (int it = 0; it < 4; ++it) S[jt][it] = (f32x4v){0.f, 0.f, 0.f, 0.f};
    float lnw[4], lnb[4];
#pragma unroll
    for (int it = 0; it < 4; ++it) { lnw[it] = F.kin[I_RLNW][l * 1024 + h * 64 + 16 * it + n]; lnb[it] = F.kin[I_RLNB][l * 1024 + h * 64 + 16 * it + n]; }
    bf16* MIX = WSP(bf16, WS_MIXED) + ((size_t)b * SEQ) * DM + 2048 + h * 64 + n;
    __syncthreads();
#pragma unroll 1
    for (int ck = 0; ck < 512; ++ck) {
        const LAS unsigned char* R = L + (ck & 1) * RC_BYTES;
        bf16x8 at[2], rt[2];
#pragma unroll
        for (int kk = 0; kk < 2; ++kk) { at[kk] = *(const LAS bf16x8*)(R + RC_AT + kk * 1024 + lane * 16); rt[kk] = *(const LAS bf16x8*)(R + RC_RT + kk * 1024 + lane * 16); }
        f32x4v U[4], Y[4];
#pragma unroll
        for (int it = 0; it < 4; ++it) { U[it] = *(const LAS f32x4v*)(R + RC_U0 + it * 1024 + lane * 16); Y[it] = *(const LAS f32x4v*)(R + RC_Y0 + it * 1024 + lane * 16); }
#pragma unroll
        for (int kk = 0; kk < 2; ++kk)
#pragma unroll
            for (int it = 0; it < 4; ++it) { v4u pw; pw.x = pg8::cvt_pk_bf16(S[2 * kk][it][0], S[2 * kk][it][1]); pw.y = pg8::cvt_pk_bf16(S[2 * kk][it][2], S[2 * kk][it][3]);
                pw.z = pg8::cvt_pk_bf16(S[2 * kk + 1][it][0], S[2 * kk + 1][it][1]); pw.w = pg8::cvt_pk_bf16(S[2 * kk + 1][it][2], S[2 * kk + 1][it][3]); const bf16x8 sf = __builtin_bit_cast(bf16x8, pw);
                U[it] = __builtin_amdgcn_mfma_f32_16x16x32_bf16(at[kk], sf, U[it], 0, 0, 0); Y[it] = __builtin_amdgcn_mfma_f32_16x16x32_bf16(rt[kk], sf, Y[it], 0, 0, 0); }
        bf16x8 uv[4]; v2u vfr[4];
#pragma unroll
        for (int it = 0; it < 4; ++it) { vfr[it] = *(const LAS v2u*)(R + RC_VF + it * 512 + lane * 8); v4u pw; pw.x = pg8::cvt_pk_bf16(U[it][0], U[it][1]); pw.y = pg8::cvt_pk_bf16(U[it][2], U[it][3]); pw.z = vfr[it].x; pw.w = vfr[it].y; uv[it] = __builtin_bit_cast(bf16x8, pw); }
#pragma unroll
        for (int jt = 0; jt < 4; ++jt) { const bf16x8 bk = *(const LAS bf16x8*)(R + RC_BK + jt * 1024 + lane * 16); const f32x4v p15 = *(const LAS f32x4v*)(R + RC_P15 + (16 * jt + 4 * g) * 4);
#pragma unroll
            for (int it = 0; it < 4; ++it) S[jt][it] = __builtin_amdgcn_mfma_f32_16x16x32_bf16(bk, uv[it], S[jt][it] * p15, 0, 0, 0); }
        const f32x4v bn = *(const LAS f32x4v*)(R + RC_BN + 16 * g);
        f32x4v sm = (Y[0] + Y[1]) + (Y[2] + Y[3]);
#pragma unroll
        for (int r = 0; r < 4; ++r) sm[r] = sum16(sm[r]) * (1.0f / 64.0f);
        f32x4v vr = (f32x4v){0.f, 0.f, 0.f, 0.f};
#pragma unroll
        for (int it = 0; it < 4; ++it) { Y[it] = Y[it] - sm; vr += Y[it] * Y[it]; }
#pragma unroll
        for (int r = 0; r < 4; ++r) vr[r] = rsqrtf(sum16(vr[r]) * (1.0f / 64.0f) + 64e-5f);
#pragma unroll
        for (int it = 0; it < 4; ++it) { const v2u gr = *(const LAS v2u*)(R + RC_GF + it * 512 + lane * 8); const float gt[4] = {bflo(gr.x), bfhi(gr.x), bflo(gr.y), bfhi(gr.y)}, vt[4] = {bflo(vfr[it].x), bfhi(vfr[it].x), bflo(vfr[it].y), bfhi(vfr[it].y)};
#pragma unroll
            for (int r = 0; r < 4; ++r) MIX[(size_t)(ck * 16 + 4 * g + r) * DM + 16 * it] = (bf16)f2bf((Y[it][r] * vr[r] * lnw[it] + lnb[it] + bn[r] * vt[r]) * gt[r]); }
        __syncthreads();
    }
}
__device__ __forceinline__ void mixers_v4(Frame& F, int l) {
    gu32* ctr = F.ctl + CW_Q + 64 * l;
    for (;;) {
        const int it = next_item(F, ctr); relaunder(F); relaunder_tid(F);
        if (it < 32) { rwkv_scan_unit(F, l, it >> 4, it & 15); }
        else if (it < 40) { const int j = it - 32; gla_scan_unit(F, l, j >> 2, j & 3); }
        else if (it < 40 + 1024) { const int j = it - 40, qb = 63 - (j >> 4), bh = j & 15; attn_unit<true>(F, l, bh >> 3, bh & 7, qb); }
        else if (it < 40 + 2048) { const int j = it - 1064, qb = j & 63, bh = j >> 6; attn_unit<false>(F, l, bh >> 3, bh & 7, qb); }
        else break;
    }
}
struct Args { const float* in[35]; float* out; unsigned char* ws; };
__device__ __forceinline__ void mk_frame(Frame& F, int wv) {
    extern __shared__ __attribute__((aligned(16))) unsigned char lds[];
    kargp kp = (kargp)__builtin_amdgcn_kernarg_segment_ptr(); asm volatile("" : "+s"(kp));
    F.kin = kp;
    F.lds = (LAS unsigned char*)lds;
    F.MISC = (volatile LAS unsigned*)(F.lds + MISC_OFF);
    { int t_ = wv * 64 + (int)__builtin_amdgcn_mbcnt_hi(~0u, __builtin_amdgcn_mbcnt_lo(~0u, 0u)); asm volatile("" : "+v"(t_)); F.tid = t_; } F.lane = F.tid & 63; F.wave = __builtin_amdgcn_readfirstlane(F.tid >> 6);
    F.G = gridDim.x; { int bx = blockIdx.x; asm volatile("" : "+s"(bx)); F.bx = bx; F.vcu = (F.G % 8 == 0) ? (bx % 8) * (F.G / 8) + bx / 8 : bx; }
    F.out = (float*)kp[35]; F.ws = (unsigned char*)kp[36]; F.ctl = (gu32*)(F.ws + WS_CTL);
}
__device__ __forceinline__ void grid_bar(int wv) {
    Frame F; mk_frame(F, wv);
    XcdBarrier bar; bar.bar = (unsigned*)(F.ctl + CW_BAR); bar.x = xb_xcc_id(); bar.st = F.MISC + 8;
    xcd_barrier(bar);
}
__global__ void __launch_bounds__(NWAVES * 64, 2) mega_fwd(Args args) {
    const int wv = __builtin_amdgcn_readfirstlane((int)threadIdx.x >> 6);
    { Frame F; mk_frame(F, wv);
      for (int u = F.tid; u < (LDS_BYTES - LDSCTL_OFF) / 4; u += NWAVES * 64) ((LAS unsigned*)(F.lds + LDSCTL_OFF))[u] = 0u;
      __syncthreads();
      (void)xcd_barrier_post((unsigned*)(F.ctl + CW_BAR), F.MISC + 8);
#ifndef NO_P0
      p0_prologue_a(F);
#endif
    }
    grid_bar(wv);
    { Frame F; mk_frame(F, wv); p0_prologue_b(F); }
    grid_bar(wv);
#pragma unroll 1
    for (int l = 0; l < NLAYER; ++l) {
#define LAYER_VARS const float* mod = WSP(float, WS_MOD) + (size_t)l * 2 * 24576; const float* xin = l == 0 ? F.kin[I_X] : F.out; (void)mod; (void)xin
#ifndef NO_RMS
        { Frame F; mk_frame(F, wv); LAYER_VARS; rms_phase(F, xin, mod + 0, mod + 4096); }
#endif
        grid_bar(wv);
#ifndef NO_G1
        { Frame F; mk_frame(F, wv);
          pg8::Gemm g{WSP(pg8::bf16_t, WS_XN), WSP(pg8::bf16_t, WS_WIN + l * WIN_L), M, NIN, DM}; pg8::StaticOrder S; S.init(M, NIN, F.G, F.bx);
          pg8::EpiCols E{WSP(pg8::bf16_t, WS_COLS), WSP(float, WS_LOWR)};
          pg8::gemm_phase<pg8::EpiCols, pg8::StaticOrder, true, true>(F.lds + RING_OFF, g, S, E, F.tid); }
#endif
        grid_bar(wv);
#ifndef NO_PREP
        { Frame F; mk_frame(F, wv); prep_norm(F, l); }
        { Frame F; mk_frame(F, wv); prep_loga(F, l); }
        { Frame F; mk_frame(F, wv); prep_rwkv(F, l); }
        { Frame F; mk_frame(F, wv); prep_vt(F, 0); }
        { Frame F; mk_frame(F, wv); prep_vt(F, 1); }
        { Frame F; mk_frame(F, wv); prep_vt(F, 2); }
        { Frame F; mk_frame(F, wv); prep_gla(F); }
        grid_bar(wv);
        { Frame F; mk_frame(F, wv); prep_rwkv_chunks(F, l); }
#endif
        grid_bar(wv);
#ifndef NO_MIX
        { Frame F; mk_frame(F, wv); mixers_v4(F, l); }
#endif
        grid_bar(wv);
#ifndef NO_G2
        { Frame F; mk_frame(F, wv); LAYER_VARS;
          pg8::Gemm g{WSP(pg8::bf16_t, WS_MIXED), WSP(pg8::bf16_t, WS_WOUT + l * WOUT_L), M, DM, DM}; pg8::StaticOrder S; S.init(M, DM, F.G, F.bx);
          pg8::EpiRes E{xin, F.out, mod + 2 * 4096};
          pg8::gemm_phase<pg8::EpiRes, pg8::StaticOrder, true, true>(F.lds + RING_OFF, g, S, E, F.tid); }
#endif
        grid_bar(wv);
        { Frame F; mk_frame(F, wv); LAYER_VARS; rms_phase(F, F.out, mod + 3 * 4096, mod + 4 * 4096); }
        grid_bar(wv);
#ifndef NO_G3
        { Frame F; mk_frame(F, wv);
          pg8::Gemm g{WSP(pg8::bf16_t, WS_XN), WSP(pg8::bf16_t, WS_W13 + l * W13_L), M, 2 * DFF, DM}; pg8::StaticOrder S; S.init(M, 2 * DFF, F.G, F.bx);
          pg8::EpiSwiglu E{WSP(pg8::bf16_t, WS_HID)};
          pg8::gemm_phase<pg8::EpiSwiglu, pg8::StaticOrder, true, true>(F.lds + RING_OFF, g, S, E, F.tid); }
#endif
        grid_bar(wv);
#ifndef NO_G4
        { Frame F; mk_frame(F, wv); LAYER_VARS;
          pg8::Gemm g{WSP(pg8::bf16_t, WS_HID), WSP(pg8::bf16_t, WS_W2 + l * W2_L), M, DM, DFF}; pg8::StaticOrder S; S.init(M, DM, F.G, F.bx);
          pg8::EpiRes E{F.out, F.out, mod + 5 * 4096};
          pg8::gemm_phase<pg8::EpiRes, pg8::StaticOrder, true, true>(F.lds + RING_OFF, g, S, E, F.tid); }
#endif
        if (l + 1 < NLAYER) grid_bar(wv);
#undef LAYER_VARS
    }
}

extern "C" void kernel_launch(void* const* d_in, const int* in_sizes, int n_in, void* d_out, int out_size, void* d_ws, size_t ws_size, hipStream_t stream) {
    static int grid = 0;
    if (grid == 0) {
        if (n_in != 35 || in_sizes[0] != M * DM || out_size != M * DM || ws_size < WS_END) { fprintf(stderr, "kernel_launch: unexpected shapes: n_in %d in0 %d out %d ws %zu (need %zu)\n", n_in, n_in > 0 ? in_sizes[0] : -1, out_size, ws_size, (size_t)WS_END); grid = -1; return; }
        int dev = 0, cus = 0, per_cu = 0;
        if (hipGetDevice(&dev) != hipSuccess || hipDeviceGetAttribute(&cus, hipDeviceAttributeMultiprocessorCount, dev) != hipSuccess) { grid = -1; return; }
        if (hipFuncSetAttribute((const void*)mega_fwd, hipFuncAttributeMaxDynamicSharedMemorySize, LDS_BYTES) != hipSuccess) { fprintf(stderr, "kernel_launch: hipFuncSetAttribute failed\n"); grid = -1; return; }
        if (hipOccupancyMaxActiveBlocksPerMultiprocessor(&per_cu, (const void*)mega_fwd, NWAVES * 64, LDS_BYTES) != hipSuccess || per_cu < 1) fprintf(stderr, "kernel_launch: occupancy query says %d\n", per_cu);
        (void)hipGetLastError();
        grid = cus;
    }
    if (grid < 0) return;
    if (hipMemsetAsync((char*)d_ws + WS_CTL, 0, CTL_ZERO_BYTES, stream) != hipSuccess) return;
    Args a{};
    for (int i = 0; i < 35; ++i) a.in[i] = (const float*)d_in[i];
    a.out = (float*)d_out; a.ws = (unsigned char*)d_ws;
    hipLaunchKernelGGL(mega_fwd, dim3(grid), dim3(NWAVES * 64), LDS_BYTES, stream, a);
}
```

```cpp
#include <hip/hip_runtime.h>
#include <cstdio>
#include <cstdint>
namespace pg8 {
#define PG8_LAS __attribute__((address_space(3)))
typedef unsigned short bf16_t;
typedef short bf16x8 __attribute__((ext_vector_type(8)));
typedef float f32x4 __attribute__((ext_vector_type(4)));
typedef unsigned u32x4 __attribute__((ext_vector_type(4)));
constexpr int BM = 256, BK = 64, HALF = 128, HTB = HALF * BK * 2  , STAGE_BYTES = 8 * HTB, NXCD = 8, WGM = 8;

__host__ __device__ __forceinline__ int lds_byte(int r, int c) { const int st = (r >> 4) * 2 + (c >> 5), rr = r & 15, cc = c & 31, ob = rr * 64 + cc * 2; return st * 1024 + (ob ^ (((ob >> 9) & 1) << 5)); }
__host__ __device__ __forceinline__ void stage_rc(int b, int& R, int& C) { const int st = b / 1024, sb = b % 1024, swz = sb ^ (((sb >> 9) & 1) << 5); R = (st >> 1) * 16 + swz / 64; C = (st & 1) * 32 + (swz % 64) / 2; }
__host__ __device__ __forceinline__ int perm32(int rho) { const int n = rho >> 4, i = rho & 15; return 8 * (i >> 2) + 4 * n + (i & 3); }

struct Unit { int pm, pn; };
struct Gemm { const bf16_t* A; const bf16_t* Bt; int M, N, K; };

struct StaticOrder {
    int nM, nN, nwg, G, c;
    __host__ __device__ void init(int M, int N, int G_, int c_) { nM = M / BM; nN = N / BM; nwg = nM * nN; G = G_; c = c_; }
    __host__ __device__ bool next(int i, Unit& u) const {
        const long L = (long)i * G + c; if (L >= nwg) return false;
        int wgid = (int)L; { const int q = nwg / NXCD, r = nwg % NXCD, xcd = wgid % NXCD, off = wgid / NXCD; wgid = (xcd < r ? xcd * (q + 1) : r * (q + 1) + (xcd - r) * q) + off; }
        const int nig = WGM * nN, gid = wgid / nig, fm = gid * WGM, gsz = (nM - fm) < WGM ? (nM - fm) : WGM;
        u.pm = fm + ((wgid % nig) % gsz); u.pn = (wgid % nig) / gsz; return true;
    }
    __device__ __forceinline__ void a_ready(const Unit&) const {}
    __device__ __forceinline__ void done(const Unit&) const {}
};

__device__ __forceinline__ unsigned cvt_pk_bf16(float lo, float hi) { unsigned r; asm volatile("v_cvt_pk_bf16_f32 %0, %1, %2" : "=v"(r) : "v"(lo), "v"(hi)); return r; }
typedef float f32x2 __attribute__((ext_vector_type(2)));
__device__ __forceinline__ float silu_f(float x) { return x * __builtin_amdgcn_rcpf(1.0f + __builtin_amdgcn_exp2f(-1.4426950408889634f * x)); }
struct EpiCols {
    static constexpr bool PERM = true, AFTER_DRAIN = false;
    bf16_t* O; float* L;
    __device__ __forceinline__ void operator()(const f32x4 (&acc)[2][2][4][2], const Unit& u, int wr, int wc, int fr, int fq) const {
        const int row0 = u.pm * BM + wr * 64 + fr;
        if (u.pn < 41) {
            const int col0 = u.pn * BM + wc * 32 + 8 * fq;
#pragma unroll
            for (int ai = 0; ai < 2; ++ai)
#pragma unroll
                for (int m = 0; m < 4; ++m) { bf16_t* rowp = O + (size_t)(row0 + ai * HALF + m * 16) * 10496 + col0;
#pragma unroll
                    for (int bj = 0; bj < 2; ++bj) { const f32x4 v0 = acc[ai][bj][m][0], v1 = acc[ai][bj][m][1];
                        u32x4 w; w.x = cvt_pk_bf16(v0[0], v0[1]); w.y = cvt_pk_bf16(v0[2], v0[3]); w.z = cvt_pk_bf16(v1[0], v1[1]); w.w = cvt_pk_bf16(v1[2], v1[3]);
                        *(u32x4*)(rowp + bj * HALF) = w; } }
        } else {
            const int col0 = wc * 32 + 8 * fq;
#pragma unroll
            for (int ai = 0; ai < 2; ++ai)
#pragma unroll
                for (int m = 0; m < 4; ++m) { float* rowp = L + (size_t)(row0 + ai * HALF + m * 16) * 256 + col0;
#pragma unroll
                    for (int bj = 0; bj < 2; ++bj) { *(f32x4*)(rowp + bj * HALF) = acc[ai][bj][m][0]; *(f32x4*)(rowp + bj * HALF + 4) = acc[ai][bj][m][1]; } }
        }
    }
};
struct EpiRes {
    static constexpr bool PERM = false, AFTER_DRAIN = false;
    const float* base; float* out; const float* gate;
    __device__ __forceinline__ void operator()(const f32x4 (&acc)[2][2][4][2], const Unit& u, int wr, int wc, int fr, int fq) const {
        const int row0 = u.pm * BM + wr * 64 + fr, col0 = u.pn * BM + wc * 32 + 4 * fq;
        const float* gp = gate + (size_t)(u.pm >> 5) * 24576 + col0;
        f32x4 gv[2][2];
#pragma unroll
        for (int bj = 0; bj < 2; ++bj)
#pragma unroll
            for (int n = 0; n < 2; ++n) gv[bj][n] = *(const f32x4*)(gp + bj * HALF + n * 16);
#pragma unroll
        for (int ai = 0; ai < 2; ++ai)
#pragma unroll
            for (int m = 0; m < 4; ++m) { const size_t off = (size_t)(row0 + ai * HALF + m * 16) * 4096 + col0;
#pragma unroll
                for (int bj = 0; bj < 2; ++bj)
#pragma unroll
                    for (int n = 0; n < 2; ++n) { const f32x4 bs = *(const f32x4*)(base + off + bj * HALF + n * 16); *(f32x4*)(out + off + bj * HALF + n * 16) = bs + gv[bj][n] * acc[ai][bj][m][n]; }
                if (m & 1) asm volatile("" ::: "memory"); }
    }
};
struct EpiSwiglu {
    static constexpr bool PERM = true, AFTER_DRAIN = false;
    bf16_t* H;
    __device__ __forceinline__ void operator()(const f32x4 (&acc)[2][2][4][2], const Unit& u, int wr, int wc, int fr, int fq) const {
        const int row0 = u.pm * BM + wr * 64 + fr, col0 = u.pn * HALF + wc * 32 + 8 * fq;
#pragma unroll
        for (int ai = 0; ai < 2; ++ai)
#pragma unroll
            for (int m = 0; m < 4; ++m) { bf16_t* rowp = H + (size_t)(row0 + ai * HALF + m * 16) * 11008 + col0;
                const f32x4 a0 = acc[ai][0][m][0], a1 = acc[ai][0][m][1], b0 = acc[ai][1][m][0], b1 = acc[ai][1][m][1];
                u32x4 w; w.x = cvt_pk_bf16(silu_f(a0[0]) * b0[0], silu_f(a0[1]) * b0[1]); w.y = cvt_pk_bf16(silu_f(a0[2]) * b0[2], silu_f(a0[3]) * b0[3]);
                w.z = cvt_pk_bf16(silu_f(a1[0]) * b1[0], silu_f(a1[1]) * b1[1]); w.w = cvt_pk_bf16(silu_f(a1[2]) * b1[2], silu_f(a1[3]) * b1[3]);
                *(u32x4*)rowp = w; }
    }
};
template <class Epi, class Sched, bool ALIGN_EPI = false, bool SP2 = false>
__device__ __forceinline__ void gemm_phase(PG8_LAS unsigned char* lds, const Gemm g, const Sched& S, const Epi& E, int tid_in) {
    int tid_ = tid_in; asm volatile("" : "+v"(tid_));
    const int tid = tid_, wid = __builtin_amdgcn_readfirstlane(tid >> 6), lane = tid & 63, wr = wid >> 2, wc = wid & 3, fr = lane & 15, fq = lane >> 4;
    const int K = g.K, nt = K / BK;
    unsigned voffA[2], voffB[2];
#pragma unroll
    for (int i = 0; i < 2; ++i) { int R, C; stage_rc(tid * 16 + i * 8192, R, C); const int Rb = Epi::PERM ? ((R & ~31) + perm32(R & 31)) : R;
        voffA[i] = (unsigned)(R * K + C) * 2u; voffB[i] = (unsigned)(Rb * K + C) * 2u; }
    const size_t kstep = (size_t)(BK * 2);
    const size_t hstep = (size_t)HALF * K * 2;
    const size_t tstep = 2 * hstep;
    const unsigned ldsw = (unsigned)wid * 1024u;
    const int aoff = lds_byte(wr * 64 + fr, fq * 8), boff = lds_byte(wc * 32 + fr, fq * 8);
#define PG8_SA(b, h) (((b) * 2 + (h)) * HTB)
#define PG8_SB(b, h) ((4 + (b) * 2 + (h)) * HTB)
#define PG8_STAGE(bufoff, gbase, voff) do { _Pragma("unroll") for (int _i = 0; _i < 2; ++_i) \
        __builtin_amdgcn_global_load_lds((const unsigned*)((const char*)(gbase) + (voff)[_i]), (PG8_LAS unsigned*)(lds + (bufoff) + ldsw + _i * 8192), 16, 0, 0); } while (0)
#define PG8_LDA(dst, b, h) do { _Pragma("unroll") for (int m = 0; m < 4; ++m) _Pragma("unroll") for (int k = 0; k < 2; ++k) dst[m][k] = *(const PG8_LAS bf16x8*)(lds + PG8_SA(b, h) + aoff + m * 2048 + k * 1024); } while (0)
#define PG8_LDB(dst, b, h) do { _Pragma("unroll") for (int n = 0; n < 2; ++n) _Pragma("unroll") for (int k = 0; k < 2; ++k) dst[n][k] = *(const PG8_LAS bf16x8*)(lds + PG8_SB(b, h) + boff + n * 2048 + k * 1024); } while (0)
#define PG8_MMA(ai, bj, At, Bt) do { __builtin_amdgcn_s_setprio(1); _Pragma("unroll") for (int m = 0; m < 4; ++m) _Pragma("unroll") for (int n = 0; n < 2; ++n) _Pragma("unroll") for (int k = 0; k < 2; ++k) \
        acc[ai][bj][m][n] = __builtin_amdgcn_mfma_f32_16x16x32_bf16(Bt[n][k], At[m][k], acc[ai][bj][m][n], 0, 0, 0); __builtin_amdgcn_s_setprio(0); } while (0)
#define PG8_WAIT_V(n) asm volatile("s_waitcnt vmcnt(" #n ")" ::: "memory")
#define PG8_WAIT_L(n) asm volatile("s_waitcnt lgkmcnt(" #n ")" ::: "memory")
#define PG8_BAR __builtin_amdgcn_s_barrier()
#define PG8_SCHED __builtin_amdgcn_sched_barrier(0)
    Unit cur, nxt; int ui = 0;
    if (!S.next(0, cur)) return;
    f32x4 acc[2][2][4][2];
#pragma unroll
    for (int a = 0; a < 2; ++a)
#pragma unroll
        for (int b = 0; b < 2; ++b)
#pragma unroll
            for (int m = 0; m < 4; ++m)
#pragma unroll
                for (int n = 0; n < 2; ++n) acc[a][b][m][n] = (f32x4){0.f, 0.f, 0.f, 0.f};
    bf16x8 At[4][2], B0[2][2], B1[2][2];
    const char* cA = (const char*)g.A + (size_t)cur.pm * tstep; const char* cB = (const char*)g.Bt + (size_t)cur.pn * tstep;
    S.a_ready(cur);
    if constexpr (SP2) {
        PG8_STAGE(PG8_SB(0, 0), cB, voffB); PG8_STAGE(PG8_SB(0, 1), cB + hstep, voffB); PG8_STAGE(PG8_SA(0, 0), cA, voffA); PG8_STAGE(PG8_SA(0, 1), cA + hstep, voffA);
        if (wr == 1) PG8_BAR;
        PG8_WAIT_V(2); PG8_BAR;
        PG8_STAGE(PG8_SB(1, 0), cB + kstep, voffB); PG8_STAGE(PG8_SA(1, 0), cA + kstep, voffA); PG8_STAGE(PG8_SB(1, 1), cB + hstep + kstep, voffB);
        PG8_WAIT_V(6); PG8_BAR;
    } else {
        PG8_STAGE(PG8_SB(0, 0), cB, voffB); PG8_STAGE(PG8_SA(0, 0), cA, voffA); PG8_STAGE(PG8_SB(0, 1), cB + hstep, voffB); PG8_STAGE(PG8_SA(0, 1), cA + hstep, voffA);
        if (wr == 1) PG8_BAR;
        PG8_WAIT_V(4); PG8_BAR;
        PG8_STAGE(PG8_SB(1, 0), cB + kstep, voffB); PG8_STAGE(PG8_SA(1, 0), cA + kstep, voffA); PG8_STAGE(PG8_SB(1, 1), cB + hstep + kstep, voffB);
        PG8_WAIT_V(6); PG8_BAR;
    }
    for (;;) {
        const bool has_next = S.next(ui + 1, nxt);
        const char* nA = has_next ? (const char*)g.A + (size_t)nxt.pm * tstep : cA; const char* nB = has_next ? (const char*)g.Bt + (size_t)nxt.pn * tstep : cB;
        for (int t = 0; t < nt; t += 2) {
            const bool last = (t == nt - 2);
            const char* a1 = cA + (size_t)(t + 1) * kstep;
            const char* a2 = last ? nA : cA + (size_t)(t + 2) * kstep; const char* b2 = last ? nB : cB + (size_t)(t + 2) * kstep;
            const char* a3 = a2 + kstep; const char* b3 = b2 + kstep;
            if (last && has_next) S.a_ready(nxt);
            if constexpr (SP2) {
            PG8_LDB(B0, 0, 0); PG8_LDB(B1, 0, 1); PG8_SCHED; PG8_LDA(At, 0, 0); PG8_STAGE(PG8_SA(1, 1), a1 + hstep, voffA);
            PG8_WAIT_V(8); PG8_WAIT_L(0); PG8_BAR; PG8_MMA(0, 0, At, B0); PG8_MMA(0, 1, At, B1); PG8_BAR; PG8_SCHED;
            PG8_LDA(At, 0, 1); PG8_STAGE(PG8_SB(0, 0), b2, voffB); PG8_STAGE(PG8_SB(0, 1), b2 + hstep, voffB); PG8_STAGE(PG8_SA(0, 0), a2, voffA);
            PG8_WAIT_V(8); PG8_WAIT_L(0); PG8_BAR; PG8_MMA(1, 0, At, B0); PG8_MMA(1, 1, At, B1); PG8_BAR; PG8_SCHED;
            PG8_LDB(B0, 1, 0); PG8_LDB(B1, 1, 1); PG8_SCHED; PG8_LDA(At, 1, 0); PG8_STAGE(PG8_SA(0, 1), a2 + hstep, voffA);
            PG8_WAIT_V(8); PG8_WAIT_L(0); PG8_BAR; PG8_MMA(0, 0, At, B0); PG8_MMA(0, 1, At, B1); PG8_BAR; PG8_SCHED;
            PG8_LDA(At, 1, 1); PG8_STAGE(PG8_SB(1, 0), b3, voffB); PG8_STAGE(PG8_SB(1, 1), b3 + hstep, voffB); PG8_STAGE(PG8_SA(1, 0), a3, voffA);
            PG8_WAIT_V(8); PG8_WAIT_L(0); PG8_BAR; PG8_MMA(1, 0, At, B0); PG8_MMA(1, 1, At, B1); PG8_BAR; PG8_SCHED;
            } else {
            PG8_LDB(B0, 0, 0); PG8_SCHED; PG8_LDA(At, 0, 0); PG8_STAGE(PG8_SA(1, 1), a1 + hstep, voffA);
            PG8_WAIT_L(8); PG8_BAR; PG8_WAIT_L(0); PG8_MMA(0, 0, At, B0); PG8_BAR; PG8_SCHED;
            PG8_LDB(B1, 0, 1); PG8_STAGE(PG8_SB(0, 0), b2, voffB);
            PG8_BAR; PG8_WAIT_L(0); PG8_MMA(0, 1, At, B1); PG8_BAR;
            PG8_LDA(At, 0, 1); PG8_STAGE(PG8_SA(0, 0), a2, voffA);
            PG8_BAR; PG8_WAIT_L(0); PG8_MMA(1, 0, At, B0); PG8_BAR; PG8_SCHED;
            PG8_STAGE(PG8_SB(0, 1), b2 + hstep, voffB);
            PG8_WAIT_V(6); PG8_BAR; PG8_MMA(1, 1, At, B1); PG8_BAR;
            PG8_LDB(B0, 1, 0); PG8_SCHED; PG8_LDA(At, 1, 0); PG8_STAGE(PG8_SA(0, 1), a2 + hstep, voffA);
            PG8_WAIT_L(8); PG8_BAR; PG8_WAIT_L(0); PG8_MMA(0, 0, At, B0); PG8_BAR; PG8_SCHED;
            PG8_LDB(B1, 1, 1); PG8_STAGE(PG8_SB(1, 0), b3, voffB);
            PG8_BAR; PG8_WAIT_L(0); PG8_MMA(0, 1, At, B1); PG8_BAR;
            PG8_LDA(At, 1, 1); PG8_STAGE(PG8_SA(1, 0), a3, voffA);
            PG8_BAR; PG8_WAIT_L(0); PG8_MMA(1, 0, At, B0); PG8_BAR; PG8_SCHED;
            PG8_STAGE(PG8_SB(1, 1), b3 + hstep, voffB);
            PG8_WAIT_V(6); PG8_BAR; PG8_MMA(1, 1, At, B1); PG8_BAR;
            }
        }
        if constexpr (ALIGN_EPI) { if (wr == 0) PG8_BAR; }
        if constexpr (!Epi::AFTER_DRAIN) { E(acc, cur, wr, wc, fr, fq); S.done(cur); }
        if (!has_next) break;
#pragma unroll
        for (int a = 0; a < 2; ++a)
#pragma unroll
            for (int b = 0; b < 2; ++b)
#pragma unroll
                for (int m = 0; m < 4; ++m)
#pragma unroll
                    for (int n = 0; n < 2; ++n) acc[a][b][m][n] = (f32x4){0.f, 0.f, 0.f, 0.f};
        cur = nxt; cA = nA; cB = nB; ++ui;
        if constexpr (ALIGN_EPI) { if (wr == 1) PG8_BAR; }
    }
    PG8_WAIT_V(0);
    if constexpr (!ALIGN_EPI) { if (wr == 0) PG8_BAR; }
    PG8_BAR;
    if constexpr (Epi::AFTER_DRAIN) { E.fused(acc, cur, wr, wc, fr, fq, lds, wid, lane); S.done(cur); }
#undef PG8_SA
#undef PG8_SB
#undef PG8_STAGE
#undef PG8_LDA
#undef PG8_LDB
#undef PG8_MMA
#undef PG8_WAIT_V
#undef PG8_WAIT_L
#undef PG8_BAR
#undef PG8_SCHED
}
}
constexpr int BATCH = 2, SEQ = 8192, DM = 4096, M = BATCH * SEQ, DFF = 11008, NLAYER = 2;
constexpr int P_IN = 10704, NIN = 10752, NMAIN = 10496;
constexpr int CA_Q = 0, CA_K = 1024, CA_V = 2048;
constexpr int CB_Q = 3072, CB_K = 3584, CB_V = 4096, CB_G = 5120;
constexpr int CC_R = 6144, CC_K = 7168, CC_V = 8192;
constexpr int CD_Q = 9216, CD_K = 10240, CD_V = 10368;
constexpr float LOG2E = 1.4426950408889634f;
constexpr float QSCALE = 0.125f * LOG2E;
constexpr int NWAVES = 8;

constexpr size_t MiB = 1u << 20;
constexpr size_t WS_CTL = 0, CTL_ZERO_BYTES = 1 * MiB;
constexpr size_t WS_MODP = 2 * MiB;
constexpr size_t WS_MOD = 14 * MiB;
constexpr size_t WS_TAB = 15 * MiB;
constexpr size_t WS_WIN = 16 * MiB, WIN_L = 84 * MiB;
constexpr size_t WS_WOUT = 184 * MiB, WOUT_L = 32 * MiB;
constexpr size_t WS_W13 = 248 * MiB, W13_L = 172 * MiB;
constexpr size_t WS_W2 = 592 * MiB, W2_L = 86 * MiB;
constexpr size_t WS_XN = 764 * MiB;
constexpr size_t WS_COLS = 892 * MiB;
constexpr size_t WS_LOWR = 1220 * MiB;
constexpr size_t WS_HID = 892 * MiB;
constexpr size_t WS_QKA = 1236 * MiB;
constexpr size_t WS_QKD = 1300 * MiB;
constexpr size_t WS_LOGA = 1336 * MiB;
constexpr size_t WS_RW = 1368 * MiB, RW_ONE = 64 * MiB;
constexpr size_t WS_VFIRST = 1816 * MiB;
constexpr size_t WS_MIXED = 1880 * MiB;
constexpr size_t WS_VTA = 2008 * MiB;
constexpr size_t WS_VTD = 2040 * MiB;
constexpr size_t WS_QDEC = 2044 * MiB, WS_KDT = 2060 * MiB, WS_AM = 2076 * MiB, WS_EBL = 2084 * MiB;
constexpr size_t WS_VTB = 2086 * MiB, WS_GTB = 2118 * MiB;
constexpr size_t WS_RWC = 2150 * MiB;
constexpr size_t WS_END = 2476 * MiB;
constexpr int CW_BAR = 4096;
constexpr int CW_Q = 16384;

constexpr int RING_OFF = 0, RING_BYTES = 131072;
constexpr int LDSCTL_OFF = RING_BYTES, MISC_OFF = LDSCTL_OFF + 320;
constexpr int LDS_BYTES = 147456;

#define GAS __attribute__((address_space(1)))
#define LAS __attribute__((address_space(3)))
typedef unsigned short bf16;
typedef unsigned v4u __attribute__((ext_vector_type(4)));
typedef unsigned v2u __attribute__((ext_vector_type(2)));
typedef float f32x4 __attribute__((ext_vector_type(4)));
typedef short bf16x8 __attribute__((ext_vector_type(8)));
typedef GAS unsigned gu32;
#define RLX_AGENT __ATOMIC_RELAXED, __HIP_MEMORY_SCOPE_AGENT
#define LDS_WAIT() asm volatile("s_waitcnt lgkmcnt(0)" ::: "memory")
#define VM_WAIT() asm volatile("s_waitcnt vmcnt(0)" ::: "memory")
__device__ __forceinline__ unsigned f2bf(float f) { unsigned u = __builtin_bit_cast(unsigned, f); return (u + 0x7fffu + ((u >> 16) & 1u)) >> 16; }
__device__ __forceinline__ unsigned pk2(float lo, float hi) { return f2bf(lo) | (f2bf(hi) << 16); }
__device__ __forceinline__ float bf2f(unsigned short h) { return __builtin_bit_cast(float, (unsigned)h << 16); }
__device__ __forceinline__ float bflo(unsigned w) { return __builtin_bit_cast(float, w << 16); }
__device__ __forceinline__ float bfhi(unsigned w) { return __builtin_bit_cast(float, w & 0xffff0000u); }
template <int CTRL> __device__ __forceinline__ float dpp_f(float v) { return __builtin_bit_cast(float, __builtin_amdgcn_update_dpp(0, __builtin_bit_cast(int, v), CTRL, 0xF, 0xF, true)); }
__device__ __forceinline__ float sum8(float v) {
    v += dpp_f<0xB1>(v); v += dpp_f<0x4E>(v); v += dpp_f<0x141>(v); return v; }
__device__ __forceinline__ float wave_sum(float v) {
    v = sum8(v); v += dpp_f<0x140>(v);
    v += __builtin_bit_cast(float, __builtin_amdgcn_ds_swizzle(__builtin_bit_cast(int, v), 0x401F));
    { const int u = __builtin_bit_cast(int, v); v = __builtin_bit_cast(float, __builtin_amdgcn_readlane(u, 0)) + __builtin_bit_cast(float, __builtin_amdgcn_readlane(u, 32)); }
    return v;
}
__device__ __forceinline__ float sigmoid_f(float x) { return __builtin_amdgcn_rcpf(1.0f + __builtin_amdgcn_exp2f(-LOG2E * x)); }
__device__ __forceinline__ float silu_g(float x) { return x * sigmoid_f(x); }

#define XB_TMO      128
#define XB_XCNT(j)  (256  + 64 * (j))
#define XB_XSUB(j)  (1280 + 64 * (j))
#define XB_XGEN(j)  (2304 + 64 * (j))
#define XB_TOP      3328
#define XB_TOPGEN   3392
#define XCD_BAR_WORDS 3456
#define XB_SPIN_CAP (1u << 23)

__device__ __forceinline__ unsigned xb_ld(unsigned* p)              { return __hip_atomic_load(p, __ATOMIC_RELAXED, __HIP_MEMORY_SCOPE_AGENT); }
__device__ __forceinline__ unsigned xb_add(unsigned* p, unsigned v) { return __hip_atomic_fetch_add(p, v, __ATOMIC_RELAXED, __HIP_MEMORY_SCOPE_AGENT); }
__device__ __forceinline__ unsigned xb_xcc_id() { return (unsigned)__builtin_amdgcn_s_getreg((3 << 11) | 20) & 0xFu; }
#define XB_SPIN(cond, bar) do { unsigned _sp = 0; while (cond) { __builtin_amdgcn_s_sleep(1); \
    if ((++_sp & 255u) == 0u) { if (xb_ld(&(bar)[XB_TMO])) break; if (_sp > XB_SPIN_CAP) { atomicAdd(&(bar)[XB_TMO], 1u); break; } } } } while (0)

struct XcdBarrier {
    unsigned* bar; unsigned x;
    volatile LAS unsigned* st;
};

__device__ __forceinline__ XcdBarrier xcd_barrier_post(unsigned* bar, volatile LAS unsigned* st) {
    XcdBarrier b; b.bar = bar; b.x = xb_xcc_id(); b.st = st;
    if (threadIdx.x == 0) (void)xb_add(&bar[XB_XCNT(b.x)], 1u);
    return b;
}
__device__ __forceinline__ void xcd_barrier_complete(unsigned* bar, unsigned x, unsigned& nloc, unsigned& nx) {
    const unsigned G = gridDim.x * gridDim.y * gridDim.z;
    unsigned sum, cnt, mine, sp = 0u;
    for (;;) {
        sum = 0u; cnt = 0u; mine = 0u;
#pragma unroll
        for (unsigned j = 0; j < 16; ++j) { const unsigned c = xb_ld(&bar[XB_XCNT(j)]); sum += c; cnt += (c > 0u) ? 1u : 0u; mine = (j == x) ? c : mine; }
        if (sum == G) break;
        __builtin_amdgcn_s_sleep(1);
        if ((++sp & 255u) == 0u) { if (xb_ld(&bar[XB_TMO])) break; if (sp > XB_SPIN_CAP) { atomicAdd(&bar[XB_TMO], 1u); break; } }
    }
    nloc = mine > 0u ? mine : 1u; nx = cnt > 0u ? cnt : 1u;
}

__device__ __forceinline__ void xcd_barrier(const XcdBarrier& b) {
    asm volatile("s_waitcnt vmcnt(0)" ::: "memory");
    __syncthreads();
    if (threadIdx.x == 0) {
        unsigned* bar = b.bar;
        __builtin_amdgcn_s_waitcnt(0);
        unsigned nloc = b.st[0], nx = b.st[1];
        if (nloc == 0u) { xcd_barrier_complete(bar, b.x, nloc, nx); b.st[0] = nloc; b.st[1] = nx; }
        const unsigned old = xb_add(&bar[XB_XSUB(b.x)], 1u);
        const unsigned gen = old / nloc;
        if (old + 1u == (gen + 1u) * nloc) {
            __builtin_amdgcn_fence(__ATOMIC_RELEASE, "agent");
            asm volatile("s_waitcnt vmcnt(0)" ::: "memory");
            const unsigned og = xb_add(&bar[XB_TOP], 1u);
            const unsigned tg = og / nx;
            if (og + 1u == (tg + 1u) * nx) xb_add(&bar[XB_TOPGEN], 1u);
            else XB_SPIN(xb_ld(&bar[XB_TOPGEN]) == tg, bar);
            __builtin_amdgcn_fence(__ATOMIC_ACQUIRE, "agent");
            xb_add(&bar[XB_XGEN(b.x)], 1u);
            asm volatile("s_waitcnt vmcnt(0)" ::: "memory");
        } else {
            XB_SPIN(xb_ld(&bar[XB_XGEN(b.x)]) == gen, bar);
            __builtin_amdgcn_fence(__ATOMIC_ACQUIRE, "agent");
            asm volatile("s_waitcnt vmcnt(0)" ::: "memory");
        }
    }
    __syncthreads();
}

typedef const float* const __attribute__((address_space(4)))* kargp;
struct Frame {
    LAS unsigned char* lds;
    volatile LAS unsigned* MISC;
    gu32* ctl;
    int tid, lane, wave;
    int vcu, G, bx;
    kargp kin;
    float* out;
    unsigned char* ws;
};
enum { I_X = 0, I_C, I_RELB, I_ADAW, I_ADAB, I_WIN, I_WOUT, I_DQN, I_DKN, I_DLAM, I_DSUB, I_GGU, I_GGB, I_GON, I_RMU, I_RWUP, I_RW0, I_RAUP, I_RA0, I_RGUP,
       I_RKK, I_RKA, I_RRK, I_RLNW, I_RLNB, I_VRD, I_VRMU, I_VRUP, I_VR0, I_SQN, I_SKN, I_SSINK, I_W1, I_W3, I_W2 };

#define WSP(T, off) ((T*)(F.ws + (off)))
__device__ __forceinline__ void relaunder_tid(Frame& F) { int t = F.tid; asm volatile("" : "+v"(t)); F.tid = t; F.lane = t & 63; F.wave = __builtin_amdgcn_readfirstlane(t >> 6); }
__device__ __forceinline__ void relaunder(Frame& F) { kargp p = F.kin; asm volatile("" : "+s"(p)); F.kin = p; }

__device__ __forceinline__ void conv_item(const float* src, int ld, int col0, int ncols, int K, bf16* WT, int row0, int kb, LAS float* scr, int lane) {
    const int k0 = 64 * kb;
#pragma unroll 8
    for (int i = 0; i < 32; ++i) { const int kk = 2 * i + (lane >> 5), n = lane & 31; float v = 0.f;
        if (src != nullptr && n < ncols) v = src[(size_t)(k0 + kk) * ld + col0 + n];
        scr[kk * 33 + n] = v; }
    LDS_WAIT(); asm volatile("" ::: "memory");
    const int c = lane & 7;
#pragma unroll
    for (int j = 0; j < 4; ++j) { const int n = (lane >> 3) + 8 * j; const LAS float* s = scr + (8 * c) * 33 + n;
        v4u o; o.x = pk2(s[0 * 33], s[1 * 33]); o.y = pk2(s[2 * 33], s[3 * 33]); o.z = pk2(s[4 * 33], s[5 * 33]); o.w = pk2(s[6 * 33], s[7 * 33]);
        if (n < ncols) *(GAS v4u*)(WT + (size_t)(row0 + n) * K + k0 + 8 * c) = o; }
    LDS_WAIT(); asm volatile("" ::: "memory");
}
__device__ __forceinline__ int t5_bucket(int d) {
    if (d < 16) return d;
    int v = 16 + (int)(logf((float)d * (1.0f / 16.0f)) / logf(8.0f) * 16.0f);
    return v < 31 ? v : 31;
}
__device__ __forceinline__ void p0_prologue_a(Frame& F) {
    const int gw = F.vcu * NWAVES + F.wave, NGW = F.G * NWAVES;
    LAS float* ldsf = (LAS float*)(F.lds + RING_OFF);
    for (int i = F.tid; i < 2 * DM; i += NWAVES * 64) ldsf[i] = silu_g(F.kin[I_C][i]);
    __syncthreads();
    float* MODP = WSP(float, WS_MODP);
    for (int it = gw; it < 6144; it += NGW) {
        const int l = it / 3072, rem = it % 3072, kc = rem / 96, ng = rem % 96, n0 = 256 * ng + 4 * F.lane;
        const float* w = F.kin[I_ADAW] + ((size_t)l * DM + kc * 128) * 24576 + n0;
        f32x4 a0 = {0.f, 0.f, 0.f, 0.f}, a1 = {0.f, 0.f, 0.f, 0.f};
#pragma unroll 8
        for (int k = 0; k < 128; ++k) { const f32x4 wv = *(const f32x4*)(w + (size_t)k * 24576); const float s0 = ldsf[kc * 128 + k], s1 = ldsf[DM + kc * 128 + k]; a0 += wv * s0; a1 += wv * s1; }
        *(f32x4*)(MODP + ((size_t)(l * 32 + kc) * 2 + 0) * 24576 + n0) = a0;
        *(f32x4*)(MODP + ((size_t)(l * 32 + kc) * 2 + 1) * 24576 + n0) = a1;
    }
    __syncthreads();
    LAS float* scr = (LAS float*)(F.lds + RING_OFF + F.wave * 16384);
    constexpr int I_IN = 337 * 64, I_OUT = 128 * 64, I_13 = 688 * 64, I_2 = 128 * 172, I_L = I_IN + I_OUT + I_13 + I_2;
    for (int it = gw; it < NLAYER * I_L; it += NGW) {
        const int l = it / I_L; int r = it % I_L;
        if (r < I_IN) {
            const int kb = r / 337, cb = r % 337; const float* src = F.kin[I_WIN] + (size_t)l * DM * P_IN; int ld = P_IN, col0, row0, nc = 32;
            if (cb < 192) { col0 = 32 * cb; row0 = 32 * cb; }
            else if (cb < 288) { col0 = 6160 + 32 * (cb - 192); row0 = 6144 + 32 * (cb - 192); }
            else if (cb < 328) { col0 = 9424 + 32 * (cb - 288); row0 = 9216 + 32 * (cb - 288); }
            else if (cb == 328) { col0 = 6144; row0 = 10496; nc = 16; }
            else if (cb < 335) { col0 = 9232 + 32 * (cb - 329); row0 = 10512 + 32 * (cb - 329); }
            else if (cb == 335) { src = l ? F.kin[I_VRD] + (size_t)(l - 1) * DM * 32 : nullptr; ld = 32; col0 = 0; row0 = 10704; }
            else { src = nullptr; col0 = 0; row0 = 10736; nc = 16; }
            conv_item(src, ld, col0, nc, DM, WSP(bf16, WS_WIN + l * WIN_L), row0, kb, scr, F.lane); continue; }
        r -= I_IN;
        if (r < I_OUT) { const int kb = r / 128, cb = r % 128; conv_item(F.kin[I_WOUT] + (size_t)l * DM * DM, DM, 32 * cb, 32, DM, WSP(bf16, WS_WOUT + l * WOUT_L), 32 * cb, kb, scr, F.lane); continue; }
        r -= I_OUT;
        if (r < I_13) { const int kb = r / 688, cb = r % 688, pn = cb >> 3, wi = cb & 7;
            const float* src = (wi < 4 ? F.kin[I_W1] : F.kin[I_W3]) + (size_t)l * DM * DFF;
            conv_item(src, DFF, 128 * pn + 32 * (wi & 3), 32, DM, WSP(bf16, WS_W13 + l * W13_L), 32 * cb, kb, scr, F.lane); continue; }
        r -= I_13;
        { const int kb = r / 128, cb = r % 128; conv_item(F.kin[I_W2] + (size_t)l * DFF * DM, DM, 32 * cb, 32, DFF, WSP(bf16, WS_W2 + l * W2_L), 32 * cb, kb, scr, F.lane); }
    }
}
__device__ __forceinline__ void p0_prologue_b(Frame& F) {
    const int gt = F.bx * (NWAVES * 64) + F.tid, NT = F.G * NWAVES * 64;
    const float* MODP = WSP(float, WS_MODP); float* MOD = WSP(float, WS_MOD);
    for (int idx = gt; idx < NLAYER * 2 * 24576; idx += NT) {
        const int l = idx / 49152, rem = idx % 49152, b = rem / 24576, n = rem % 24576;
        float s = F.kin[I_ADAB][l * 24576 + n];
#pragma unroll 8
        for (int kc = 0; kc < 32; ++kc) s += MODP[((size_t)(l * 32 + kc) * 2 + b) * 24576 + n];
        MOD[idx] = s;
    }
    if (F.bx == 0) { float* TAB = WSP(float, WS_TAB);
        for (int i = F.tid; i < 24 * 128; i += NWAVES * 64) { const int hh = i >> 7, d = i & 127; TAB[i] = F.kin[I_RELB][t5_bucket(d) * 24 + hh] * LOG2E; } }
}
__device__ __forceinline__ void rms_phase(Frame& F, const float* xin, const float* sh, const float* sc) {
    const int gw = F.vcu * NWAVES + F.wave, NGW = F.G * NWAVES;
    bf16* XN = WSP(bf16, WS_XN);
    for (int m = gw; m < M; m += NGW) {
        const int b = m >> 13;
        const f32x4* xr = (const f32x4*)(xin + (size_t)m * DM) + F.lane;
        f32x4 v[16]; float ss = 0.f;
#pragma unroll
        for (int j = 0; j < 16; ++j) { v[j] = xr[64 * j]; ss += (v[j].x * v[j].x + v[j].y * v[j].y) + (v[j].z * v[j].z + v[j].w * v[j].w); }
        const float rstd = rsqrtf(wave_sum(ss) * (1.0f / DM) + 1e-6f);
        const f32x4* scp = (const f32x4*)(sc + (size_t)b * 24576) + F.lane; const f32x4* shp = (const f32x4*)(sh + (size_t)b * 24576) + F.lane;
        v2u* o8 = (v2u*)(XN + (size_t)m * DM) + F.lane;
#pragma unroll
        for (int j = 0; j < 16; ++j) { const f32x4 s4 = scp[64 * j], h4 = shp[64 * j]; const f32x4 o = v[j] * rstd * (s4 + 1.0f) + h4;
            v2u w; w.x = pk2(o.x, o.y); w.y = pk2(o.z, o.w); o8[64 * j] = w; }
    }
}
__device__ __forceinline__ void unpack8(const v4u r, float (&f)[8]) { f[0] = bflo(r.x); f[1] = bfhi(r.x); f[2] = bflo(r.y); f[3] = bfhi(r.y); f[4] = bflo(r.z); f[5] = bfhi(r.z); f[6] = bflo(r.w); f[7] = bfhi(r.w); }
__device__ __forceinline__ v4u pack8(const float (&f)[8]) { v4u o; o.x = pk2(f[0], f[1]); o.y = pk2(f[2], f[3]); o.z = pk2(f[4], f[5]); o.w = pk2(f[6], f[7]); return o; }
__device__ __forceinline__ void prep_norm(Frame& F, int l) {
    const int gw = F.vcu * NWAVES + F.wave, NGW = F.G * NWAVES, lane = F.lane, sub = lane >> 3, ch = lane & 7;
    float gqa[8], gka[8], gqd[8], gkd[8];
#pragma unroll
    for (int e = 0; e < 8; ++e) { gqa[e] = F.kin[I_DQN][l * 64 + ch * 8 + e] * QSCALE; gka[e] = F.kin[I_DKN][l * 64 + ch * 8 + e];
                                  gqd[e] = F.kin[I_SQN][l * 64 + ch * 8 + e] * QSCALE; gkd[e] = F.kin[I_SKN][l * 64 + ch * 8 + e]; }
    const bf16* COLS = WSP(bf16, WS_COLS); bf16* QKA = WSP(bf16, WS_QKA); bf16* QKD = WSP(bf16, WS_QKD);
    for (int m = gw; m < M; m += NGW) {
        const bf16* src = COLS + (size_t)m * NMAIN;
#pragma unroll
        for (int i = 0; i < 4; ++i) { const int vec = i * 8 + sub, col = vec * 64 + ch * 8;
            float f[8]; unpack8(*(const v4u*)(src + CA_Q + col), f); float ss = 0.f;
#pragma unroll
            for (int e = 0; e < 8; ++e) ss += f[e] * f[e];
            ss = sum8(ss);
            const float rstd = rsqrtf(ss * (1.0f / 64.0f) + 1e-6f);
#pragma unroll
            for (int e = 0; e < 8; ++e) f[e] = f[e] * rstd * (i < 2 ? gqa[e] : gka[e]);
            *(v4u*)(QKA + (size_t)m * 2048 + col) = pack8(f); }
#pragma unroll
        for (int i = 0; i < 3; ++i) { const int vec = i * 8 + sub, col = vec * 64 + ch * 8;
            if (vec < 18) { float f[8]; unpack8(*(const v4u*)(src + CD_Q + col), f); float ss = 0.f;
#pragma unroll
                for (int e = 0; e < 8; ++e) ss += f[e] * f[e];
                ss = sum8(ss);
                const float rstd = rsqrtf(ss * (1.0f / 64.0f) + 1e-6f);
#pragma unroll
                for (int e = 0; e < 8; ++e) f[e] = f[e] * rstd * (vec < 16 ? gqd[e] : gkd[e]);
                *(v4u*)(QKD + (size_t)m * 1152 + col) = pack8(f); } }
    }
}
__device__ __forceinline__ void prep_loga(Frame& F, int l) {
    LAS float* gdl = (LAS float*)(F.lds + RING_OFF);
    float gu[16];
#pragma unroll
    for (int j = 0; j < 16; ++j) gu[j] = F.kin[I_GGU][((size_t)l * 16 + j) * 512 + F.tid];
    const float bias = F.kin[I_GGB][l * 512 + F.tid];
    const float* LOWR = WSP(float, WS_LOWR); float* LOGA = WSP(float, WS_LOGA);
    for (int tile = F.bx; tile < M / 64; tile += F.G) {
        const size_t row0 = (size_t)tile * 64;
        __syncthreads();
#pragma unroll
        for (int i = 0; i < 2; ++i) { const int idx = F.tid + 512 * i; gdl[idx] = LOWR[(row0 + (idx >> 4)) * 256 + (idx & 15)]; }
        __syncthreads();
#pragma unroll 4
        for (int t = 0; t < 64; ++t) { const LAS f32x4* gp = (const LAS f32x4*)(gdl + t * 16); const f32x4 g0 = gp[0], g1 = gp[1], g2 = gp[2], g3 = gp[3];
            float z = bias + g0.x * gu[0] + g0.y * gu[1] + g0.z * gu[2] + g0.w * gu[3] + g1.x * gu[4] + g1.y * gu[5] + g1.z * gu[6] + g1.w * gu[7]
                    + g2.x * gu[8] + g2.y * gu[9] + g2.z * gu[10] + g2.w * gu[11] + g3.x * gu[12] + g3.y * gu[13] + g3.z * gu[14] + g3.w * gu[15];
            LOGA[(row0 + t) * 512 + F.tid] = (fminf(z, 0.f) - __logf(1.0f + __expf(-fabsf(z)))) * (1.0f / 16.0f); }
    }
}
__device__ __forceinline__ void prep_rwkv(Frame& F, int l) {
    LAS float* wst = (LAS float*)(F.lds + RING_OFF) + 4096;
    LAS float* in = (LAS float*)(F.lds + RING_OFF);
    const float* mu = F.kin[I_RMU] + (size_t)l * 3264;
    const float* LOWR = WSP(float, WS_LOWR); const bf16* COLS = WSP(bf16, WS_COLS);
    float* RW = WSP(float, WS_RW); float* VF = WSP(float, WS_VFIRST);
    constexpr size_t RS = RW_ONE / 4;
    for (int tile = F.bx; tile < M / 16; tile += F.G) {
        const int row0 = tile * 16;
        __syncthreads();
        for (int idx = F.tid; idx < 16 * 224; idx += NWAVES * 64) { const int tt = idx / 224, j = idx % 224, row = row0 + tt, t = row & (SEQ - 1);
            const int col = j < 192 ? 16 + j : 208 + (j - 192);
            const float cur = LOWR[(size_t)row * 256 + col], prev = t > 0 ? LOWR[(size_t)(row - 1) * 256 + col] : 0.f;
            const float muv = j < 192 ? mu[3072 + j] : (l ? F.kin[I_VRMU][(l - 1) * 32 + (j - 192)] : 0.f);
            float x = cur + (prev - cur) * muv;
            if (j < 64) x = tanhf(x); else if (j >= 128 && j < 192) x = sigmoid_f(x);
            in[j * 16 + tt] = x; }
        __syncthreads();
#pragma unroll 1
        for (int pass = 0; pass < 2; ++pass) {
            const int c = pass * 512 + F.tid;
            float accw[16], acca[16], accg[16], accv[16];
            { const float bw = F.kin[I_RW0][l * 1024 + c], ba = F.kin[I_RA0][l * 1024 + c], bv = l ? F.kin[I_VR0][(l - 1) * 1024 + c] : 0.f;
#pragma unroll
              for (int tt = 0; tt < 16; ++tt) { accw[tt] = bw; acca[tt] = ba; accg[tt] = 0.f; accv[tt] = bv; } }
#define LOWRANK_ACC(ACC, WPTR, JOFF, NJ) do { const float* wp_ = (WPTR) + c; float nx_[16]; \
            _Pragma("unroll") for (int j_ = 0; j_ < 16; ++j_) nx_[j_] = wp_[(size_t)j_ * 1024]; \
            _Pragma("unroll 1") for (int jb = 0; jb < (NJ) / 16; ++jb) { LAS float* wl_ = wst + (jb & 1) * 8192 + F.tid; \
                _Pragma("unroll") for (int j_ = 0; j_ < 16; ++j_) wl_[j_ * 512] = nx_[j_]; \
                if (jb + 1 < (NJ) / 16) { _Pragma("unroll") for (int j_ = 0; j_ < 16; ++j_) nx_[j_] = wp_[(size_t)((jb + 1) * 16 + j_) * 1024]; } \
                _Pragma("unroll 2") for (int j_ = 0; j_ < 16; ++j_) { const float w_ = wl_[j_ * 512]; const LAS f32x4* ip_ = (const LAS f32x4*)(in + ((JOFF) + jb * 16 + j_) * 16); \
                    const f32x4 i0 = ip_[0], i1 = ip_[1], i2 = ip_[2], i3 = ip_[3]; \
                    ACC[0] += i0.x * w_; ACC[1] += i0.y * w_; ACC[2] += i0.z * w_; ACC[3] += i0.w * w_; ACC[4] += i1.x * w_; ACC[5] += i1.y * w_; ACC[6] += i1.z * w_; ACC[7] += i1.w * w_; \
                    ACC[8] += i2.x * w_; ACC[9] += i2.y * w_; ACC[10] += i2.z * w_; ACC[11] += i2.w * w_; ACC[12] += i3.x * w_; ACC[13] += i3.y * w_; ACC[14] += i3.z * w_; ACC[15] += i3.w * w_; } } } while (0)
            relaunder(F); LOWRANK_ACC(accw, F.kin[I_RWUP] + (size_t)l * 64 * 1024, 0, 64);
            relaunder(F); LOWRANK_ACC(acca, F.kin[I_RAUP] + (size_t)l * 64 * 1024, 64, 64);
            relaunder(F); LOWRANK_ACC(accg, F.kin[I_RGUP] + (size_t)l * 64 * 1024, 128, 64);
            relaunder(F); if (l) LOWRANK_ACC(accv, F.kin[I_VRUP] + (size_t)(l - 1) * 32 * 1024, 192, 32);
#undef LOWRANK_ACC
            relaunder(F);
            const float mur = F.kin[I_RMU][l * 3264 + c], muk = F.kin[I_RMU][l * 3264 + 1024 + c], muv = F.kin[I_RMU][l * 3264 + 2048 + c], kkv = F.kin[I_RKK][l * 1024 + c], kav = F.kin[I_RKA][l * 1024 + c];
            float pr = 0.f, pk = 0.f, pv = 0.f;
            if ((row0 & (SEQ - 1)) != 0) { const bf16* p = COLS + (size_t)(row0 - 1) * NMAIN + c; pr = bf2f(p[CC_R]); pk = bf2f(p[CC_K]); pv = bf2f(p[CC_V]); }
#pragma unroll
            for (int tt = 0; tt < 16; ++tt) { const int row = row0 + tt; const bf16* p = COLS + (size_t)row * NMAIN + c;
                const float cr = bf2f(p[CC_R]), ck = bf2f(p[CC_K]), cv = bf2f(p[CC_V]);
                const float r = cr + (pr - cr) * mur, k = ck + (pk - ck) * muk; float v = cv + (pv - cv) * muv;
                pr = cr; pk = ck; pv = cv;
                const size_t o = (size_t)row * 1024 + c;
                if (l == 0) VF[o] = v; else { const float vg = sigmoid_f(accv[tt]); v = v + (VF[o] - v) * vg; }
                const float dec = __expf(-0.6065306597126334f * sigmoid_f(accw[tt]));
                const float a = sigmoid_f(acca[tt]);
                float kk = k * kkv; const float ss = wave_sum(kk * kk); kk = kk / fmaxf(sqrtf(ss), 1e-12f);
                const float km = k * (1.0f + (a - 1.0f) * kav);
                RW[o] = r; RW[RS + o] = dec; RW[2 * RS + o] = km; RW[3 * RS + o] = v; RW[4 * RS + o] = -kk; RW[5 * RS + o] = kk * a; RW[6 * RS + o] = accg[tt]; }
        }
    }
}
__device__ __forceinline__ void diff_unit_v1(Frame& F, int l, int b, int h, int qt) {
    LAS float* ldsf = (LAS float*)(F.lds + RING_OFF);
    LAS float* Kt = ldsf; LAS float* Vt = ldsf + 8192; LAS float* Bt = ldsf + 16640;
    const int p = F.wave >> 2, dq = F.wave & 3, lane = F.lane, q0 = qt * 64, qpos = q0 + lane;
    const bf16* QKA = WSP(bf16, WS_QKA); const bf16* COLS = WSP(bf16, WS_COLS); const float* TAB = WSP(float, WS_TAB);
    float q[64];
    { const bf16* qp = QKA + (size_t)(b * SEQ + qpos) * 2048 + h * 128 + p * 64;
#pragma unroll
      for (int i = 0; i < 8; ++i) { float f[8]; unpack8(*(const v4u*)(qp + 8 * i), f);
#pragma unroll
          for (int e = 0; e < 8; ++e) q[8 * i + e] = f[e]; } }
    float lam_init = 0.8f - 0.6f * __expf(-0.3f * (float)l), lam_full;
    { const float* lm = F.kin[I_DLAM] + (size_t)l * 256; const float s1 = wave_sum(lm[lane] * lm[64 + lane]), s2 = wave_sum(lm[128 + lane] * lm[192 + lane]); lam_full = __expf(s1) - __expf(s2) + lam_init; }
    float o[32];
#pragma unroll
    for (int i = 0; i < 32; ++i) o[i] = 0.f;
    float mx = -1e30f, lsum = 0.f;
    if (F.tid < 128) Bt[F.tid] = TAB[h * 128 + F.tid];
    for (int kt = 0; kt <= qt; ++kt) {
        __syncthreads();
        { const int key = F.tid >> 3, chn = F.tid & 7; const size_t krow = (size_t)(b * SEQ + kt * 64 + key);
          const bf16* kp = QKA + krow * 2048 + 1024 + h * 128 + chn * 16; const bf16* vp = COLS + krow * NMAIN + CA_V + h * 128 + chn * 16;
          float f[8];
          unpack8(*(const v4u*)kp, f);
#pragma unroll
          for (int e = 0; e < 8; ++e) Kt[key * 128 + chn * 16 + e] = f[e];
          unpack8(*(const v4u*)(kp + 8), f);
#pragma unroll
          for (int e = 0; e < 8; ++e) Kt[key * 128 + chn * 16 + 8 + e] = f[e];
          unpack8(*(const v4u*)vp, f);
#pragma unroll
          for (int e = 0; e < 8; ++e) Vt[key * 128 + chn * 16 + e] = f[e];
          unpack8(*(const v4u*)(vp + 8), f);
#pragma unroll
          for (int e = 0; e < 8; ++e) Vt[key * 128 + chn * 16 + 8 + e] = f[e]; }
        __syncthreads();
        const int kbase = kt * 64;
#pragma unroll 2
        for (int j = 0; j < 64; ++j) {
            const int dist = qpos - (kbase + j);
            const LAS f32x4* kp = (const LAS f32x4*)(Kt + j * 128 + p * 64);
            float s0 = 0.f, s1 = 0.f;
#pragma unroll
            for (int d = 0; d < 16; d += 2) { const f32x4 k0 = kp[d], k1 = kp[d + 1];
                s0 += q[4 * d] * k0.x + q[4 * d + 1] * k0.y + q[4 * d + 2] * k0.z + q[4 * d + 3] * k0.w;
                s1 += q[4 * d + 4] * k1.x + q[4 * d + 5] * k1.y + q[4 * d + 6] * k1.z + q[4 * d + 7] * k1.w; }
            if (dist >= 0) {
                const float s = s0 + s1 + Bt[dist < 127 ? dist : 127];
                if (s > mx) { const float sc = __builtin_amdgcn_exp2f(mx - s); lsum *= sc;
#pragma unroll
                    for (int i = 0; i < 32; ++i) o[i] *= sc;
                    mx = s; }
                const float pw = __builtin_amdgcn_exp2f(s - mx); lsum += pw;
                const LAS f32x4* vp = (const LAS f32x4*)(Vt + j * 128 + dq * 32);
#pragma unroll
                for (int i = 0; i < 8; ++i) { const f32x4 v4 = vp[i]; o[4 * i] += pw * v4.x; o[4 * i + 1] += pw * v4.y; o[4 * i + 2] += pw * v4.z; o[4 * i + 3] += pw * v4.w; }
            }
        }
    }
    __syncthreads();
    LAS float* E = ldsf;
    { const float inv = 1.0f / lsum;
#pragma unroll
      for (int i = 0; i < 32; ++i) E[(p * 64 + lane) * 129 + dq * 32 + i] = o[i] * inv; }
    __syncthreads();
    { const int qq = F.tid >> 3, part = F.tid & 7; float dv[16]; float ss = 0.f;
#pragma unroll
      for (int i = 0; i < 16; ++i) { const int c = part * 16 + i; const float d = E[qq * 129 + c] - lam_full * E[(64 + qq) * 129 + c]; dv[i] = d; ss += d * d; }
      ss = sum8(ss);
      const float rstd = rsqrtf(ss * (1.0f / 128.0f) + 1e-6f) * (1.0f - lam_init);
      const float* sl = F.kin[I_DSUB] + l * 128 + part * 16;
      float f[8]; bf16* op = WSP(bf16, WS_MIXED) + (size_t)(b * SEQ + q0 + qq) * DM + h * 128 + part * 16;
#pragma unroll
      for (int e = 0; e < 8; ++e) f[e] = dv[e] * rstd * sl[e];
      *(v4u*)op = pack8(f);
#pragma unroll
      for (int e = 0; e < 8; ++e) f[e] = dv[8 + e] * rstd * sl[8 + e];
      *(v4u*)(op + 8) = pack8(f); }
}
__device__ __forceinline__ void swa_unit_v1(Frame& F, int l, int b, int kvh, int qt) {
    LAS float* ldsf = (LAS float*)(F.lds + RING_OFF);
    LAS float* Kt = ldsf; LAS float* Vt = ldsf + 192 * 68; LAS float* Bt = ldsf + 2 * 192 * 68;
    const int lane = F.lane, hd = kvh * 8 + F.wave, q0 = qt * 64, qpos = q0 + lane, kstart = q0 - 127;
    const bf16* QKD = WSP(bf16, WS_QKD); const bf16* COLS = WSP(bf16, WS_COLS); const float* TAB = WSP(float, WS_TAB);
    __syncthreads();
    for (int idx = F.tid; idx < 192 * 8; idx += NWAVES * 64) { const int r = idx >> 3, chn = idx & 7, key = kstart + r;
        float fk[8], fv[8];
        if (key >= 0 && r < 191) { const size_t krow = (size_t)(b * SEQ + key);
            unpack8(*(const v4u*)(QKD + krow * 1152 + 1024 + kvh * 64 + chn * 8), fk); unpack8(*(const v4u*)(COLS + krow * NMAIN + CD_V + kvh * 64 + chn * 8), fv); }
        else {
#pragma unroll
            for (int e = 0; e < 8; ++e) { fk[e] = 0.f; fv[e] = 0.f; } }
#pragma unroll
        for (int e = 0; e < 8; ++e) { Kt[r * 68 + chn * 8 + e] = fk[e]; Vt[r * 68 + chn * 8 + e] = fv[e]; } }
    for (int idx = F.tid; idx < 1024; idx += NWAVES * 64) Bt[idx] = TAB[(8 + kvh * 8 + (idx >> 7)) * 128 + (idx & 127)];
    float q[64];
    { const bf16* qp = QKD + (size_t)(b * SEQ + qpos) * 1152 + hd * 64;
#pragma unroll
      for (int i = 0; i < 8; ++i) { float f[8]; unpack8(*(const v4u*)(qp + 8 * i), f);
#pragma unroll
          for (int e = 0; e < 8; ++e) q[8 * i + e] = f[e]; } }
    __syncthreads();
    float o[64];
#pragma unroll
    for (int i = 0; i < 64; ++i) o[i] = 0.f;
    float mx = F.kin[I_SSINK][l * 16 + hd] * LOG2E, lsum = 1.0f;
#pragma unroll 1
    for (int jj = 0; jj < 128; ++jj) {
        const int key = qpos - 127 + jj;
        if (key >= 0) {
            const int r = lane + jj; const LAS f32x4* kp = (const LAS f32x4*)(Kt + r * 68);
            float s0 = 0.f, s1 = 0.f;
#pragma unroll
            for (int d = 0; d < 16; d += 2) { const f32x4 k0 = kp[d], k1 = kp[d + 1];
                s0 += q[4 * d] * k0.x + q[4 * d + 1] * k0.y + q[4 * d + 2] * k0.z + q[4 * d + 3] * k0.w;
                s1 += q[4 * d + 4] * k1.x + q[4 * d + 5] * k1.y + q[4 * d + 6] * k1.z + q[4 * d + 7] * k1.w; }
            const float s = s0 + s1 + Bt[F.wave * 128 + 127 - jj];
            if (s > mx) { const float sc = __builtin_amdgcn_exp2f(mx - s); lsum *= sc;
#pragma unroll
                for (int i = 0; i < 64; ++i) o[i] *= sc;
                mx = s; }
            const float pw = __builtin_amdgcn_exp2f(s - mx); lsum += pw;
            const LAS f32x4* vp = (const LAS f32x4*)(Vt + r * 68);
#pragma unroll
            for (int i = 0; i < 16; ++i) { const f32x4 v4 = vp[i]; o[4 * i] += pw * v4.x; o[4 * i + 1] += pw * v4.y; o[4 * i + 2] += pw * v4.z; o[4 * i + 3] += pw * v4.w; }
        }
    }
    { const float inv = 1.0f / lsum; bf16* op = WSP(bf16, WS_MIXED) + (size_t)(b * SEQ + qpos) * DM + 3072 + hd * 64;
#pragma unroll
      for (int i = 0; i < 8; ++i) { float f[8];
#pragma unroll
          for (int e = 0; e < 8; ++e) f[e] = o[8 * i + e] * inv;
          *(v4u*)(op + 8 * i) = pack8(f); } }
}
__device__ __forceinline__ void gla_unit_v1(Frame& F, int l, int b, int h) {
    LAS float* ldsf = (LAS float*)(F.lds + RING_OFF);
    LAS float* Ad = ldsf; LAS float* Kd = ldsf + 2048; LAS float* Qd = ldsf + 4096; LAS float* Vd = ldsf + 6144; LAS float* Ob = ldsf + 10240;
    const int dh = F.tid >> 8, vcol = F.tid & 255, lane = F.lane;
    const bf16* COLS = WSP(bf16, WS_COLS); const float* LOGA = WSP(float, WS_LOGA); bf16* MIX = WSP(bf16, WS_MIXED);
    float S[64];
#pragma unroll
    for (int d = 0; d < 64; ++d) S[d] = 0.f;
    float og[4];
#pragma unroll
    for (int e = 0; e < 4; ++e) og[e] = F.kin[I_GON][l * 256 + lane * 4 + e];
#pragma unroll 1
    for (int ck = 0; ck < SEQ / 16; ++ck) {
        const int row0 = b * SEQ + ck * 16;
        __syncthreads();
#pragma unroll 2
        for (int i = 0; i < 4; ++i) { const int idx = F.tid + 512 * i, tok = idx >> 7, c = idx & 127; const size_t row = (size_t)(row0 + tok);
            Ad[idx] = __expf(LOGA[row * 512 + h * 128 + c]); Kd[idx] = bf2f(COLS[row * NMAIN + CB_K + h * 128 + c]); Qd[idx] = bf2f(COLS[row * NMAIN + CB_Q + h * 128 + c]) * 0.08838834764831845f; }
#pragma unroll 4
        for (int i = 0; i < 8; ++i) { const int idx = F.tid + 512 * i, tok = idx >> 8, c = idx & 255; Vd[idx] = bf2f(COLS[(size_t)(row0 + tok) * NMAIN + CB_V + h * 256 + c]); }
        __syncthreads();
#pragma unroll 1
        for (int t = 0; t < 16; ++t) {
            const LAS f32x4* ap = (const LAS f32x4*)(Ad + t * 128 + dh * 64); const LAS f32x4* kp = (const LAS f32x4*)(Kd + t * 128 + dh * 64); const LAS f32x4* qp = (const LAS f32x4*)(Qd + t * 128 + dh * 64);
            float o0 = 0.f, o1 = 0.f; const float vt = Vd[t * 256 + vcol];
#pragma unroll
            for (int d = 0; d < 16; ++d) { const f32x4 a4 = ap[d], k4 = kp[d], q4 = qp[d];
                S[4 * d] = a4.x * S[4 * d] + k4.x * vt; S[4 * d + 1] = a4.y * S[4 * d + 1] + k4.y * vt; S[4 * d + 2] = a4.z * S[4 * d + 2] + k4.z * vt; S[4 * d + 3] = a4.w * S[4 * d + 3] + k4.w * vt;
                o0 += q4.x * S[4 * d] + q4.y * S[4 * d + 1]; o1 += q4.z * S[4 * d + 2] + q4.w * S[4 * d + 3];
                if ((d & 3) == 3) __builtin_amdgcn_sched_barrier(0); }
            Ob[t * 512 + F.tid] = o0 + o1;
        }
        __syncthreads();
#pragma unroll 1
        for (int i = 0; i < 2; ++i) { const int t = 2 * F.wave + i; const size_t row = (size_t)(row0 + t);
            const f32x4 xa = *(const LAS f32x4*)(Ob + t * 512 + lane * 4), xb = *(const LAS f32x4*)(Ob + t * 512 + 256 + lane * 4); const f32x4 x = xa + xb;
            const float ss = wave_sum(x.x * x.x + x.y * x.y + x.z * x.z + x.w * x.w); const float rstd = rsqrtf(ss * (1.0f / 256.0f) + 1e-6f);
            const v2u graw = *(const v2u*)(COLS + row * NMAIN + CB_G + h * 256 + lane * 4);
            const float g0 = bflo(graw.x), g1 = bfhi(graw.x), g2 = bflo(graw.y), g3 = bfhi(graw.y);
            v2u w; w.x = pk2(x.x * rstd * og[0] * silu_g(g0), x.y * rstd * og[1] * silu_g(g1)); w.y = pk2(x.z * rstd * og[2] * silu_g(g2), x.w * rstd * og[3] * silu_g(g3));
            *(v2u*)(MIX + row * DM + 1024 + h * 256 + lane * 4) = w; }
    }
}
__device__ __forceinline__ void rwkv_unit_v1(Frame& F, int l, int b, int hg) {
    const int lane = F.lane, h = hg * 8 + F.wave, c = h * 64 + lane;
    LAS float* st = (LAS float*)(F.lds + RING_OFF) + F.wave * 3584;
    const float* RW = WSP(float, WS_RW); bf16* MIX = WSP(bf16, WS_MIXED);
    constexpr size_t RS = RW_ONE / 4;
    float S[64];
#pragma unroll
    for (int j = 0; j < 64; ++j) S[j] = 0.f;
    const float lnw = F.kin[I_RLNW][l * 1024 + c], lnb = F.kin[I_RLNB][l * 1024 + c], rk = F.kin[I_RRK][l * 1024 + c];
#pragma unroll 1
    for (int ck = 0; ck < SEQ / 8; ++ck) {
        const size_t row0 = (size_t)b * SEQ + ck * 8;
#pragma unroll 2
        for (int s = 0; s < 8; ++s) { const size_t o = (row0 + s) * 1024 + c;
            st[(s * 7 + 0) * 64 + lane] = RW[o]; st[(s * 7 + 1) * 64 + lane] = RW[RS + o]; st[(s * 7 + 2) * 64 + lane] = RW[2 * RS + o];
            st[(s * 7 + 3) * 64 + lane] = RW[4 * RS + o]; st[(s * 7 + 4) * 64 + lane] = RW[5 * RS + o]; st[(s * 7 + 5) * 64 + lane] = RW[3 * RS + o]; st[(s * 7 + 6) * 64 + lane] = RW[6 * RS + o]; }
#pragma unroll 1
        for (int s = 0; s < 8; ++s) {
            const LAS f32x4* rp = (const LAS f32x4*)(st + (s * 7 + 0) * 64); const LAS f32x4* wp = (const LAS f32x4*)(st + (s * 7 + 1) * 64); const LAS f32x4* kp = (const LAS f32x4*)(st + (s * 7 + 2) * 64);
            const LAS f32x4* ap = (const LAS f32x4*)(st + (s * 7 + 3) * 64); const LAS f32x4* bp = (const LAS f32x4*)(st + (s * 7 + 4) * 64);
            float sa0 = 0.f, sa1 = 0.f;
#pragma unroll
            for (int j = 0; j < 16; ++j) { const f32x4 a4 = ap[j]; sa0 += S[4 * j] * a4.x + S[4 * j + 1] * a4.y; sa1 += S[4 * j + 2] * a4.z + S[4 * j + 3] * a4.w; }
            __builtin_amdgcn_sched_barrier(0);
            const float sa = sa0 + sa1, vs = st[(s * 7 + 5) * 64 + lane], gs = st[(s * 7 + 6) * 64 + lane]; float y0 = 0.f, y1 = 0.f;
#pragma unroll
            for (int j = 0; j < 16; ++j) { const f32x4 w4 = wp[j], b4 = bp[j], k4 = kp[j], r4 = rp[j];
                S[4 * j] = S[4 * j] * w4.x + sa * b4.x + vs * k4.x; S[4 * j + 1] = S[4 * j + 1] * w4.y + sa * b4.y + vs * k4.y;
                S[4 * j + 2] = S[4 * j + 2] * w4.z + sa * b4.z + vs * k4.z; S[4 * j + 3] = S[4 * j + 3] * w4.w + sa * b4.w + vs * k4.w;
                y0 += S[4 * j] * r4.x + S[4 * j + 1] * r4.y; y1 += S[4 * j + 2] * r4.z + S[4 * j + 3] * r4.w;
                if ((j & 3) == 3) __builtin_amdgcn_sched_barrier(0); }
            const float y = y0 + y1, mean = wave_sum(y) * (1.0f / 64.0f), dd = y - mean, var = wave_sum(dd * dd) * (1.0f / 64.0f);
            const float yl = dd * rsqrtf(var + 64e-5f) * lnw + lnb;
            const float bonus = wave_sum(st[(s * 7 + 0) * 64 + lane] * st[(s * 7 + 2) * 64 + lane] * rk) * vs;
            MIX[(row0 + s) * DM + 2048 + c] = (bf16)f2bf((yl + bonus) * gs);
        }
    }
}
__device__ __forceinline__ int next_item(Frame& F, gu32* ctr) {
    volatile LAS int* slot = (volatile LAS int*)(F.lds + LDSCTL_OFF + 64);
    __syncthreads();
    if (F.tid == 0) *slot = (int)__hip_atomic_fetch_add(ctr, 1u, RLX_AGENT);
    __syncthreads();
    return *slot;
}
__device__ __forceinline__ void mixers_v1(Frame& F, int l) {
    gu32* ctr = F.ctl + CW_Q + 64 * l;
    for (;;) {
        const int it = next_item(F, ctr); relaunder(F); relaunder_tid(F);
        if (it < 4) { rwkv_unit_v1(F, l, it >> 1, it & 1); }
        else if (it < 12) { const int j = it - 4; gla_unit_v1(F, l, j >> 2, j & 3); }
        else if (it < 12 + 2048) { const int j = it - 12, qt = 127 - (j >> 4), bh = j & 15; diff_unit_v1(F, l, bh >> 3, bh & 7, qt); }
        else if (it < 12 + 2048 + 512) { const int j = it - 2060, qt = j & 127, bk = j >> 7; swa_unit_v1(F, l, bk >> 1, bk & 1, qt); }
        else break;
    }
}
typedef float f32x16 __attribute__((ext_vector_type(16)));
__device__ __forceinline__ float xother32(float v) { unsigned a = __builtin_bit_cast(unsigned, v), b = a; asm volatile("" : "+v"(b)); auto rr = __builtin_amdgcn_permlane32_swap(a, b, false, false);
    const unsigned lo = rr[0], hi = rr[1]; return __builtin_bit_cast(float, (unsigned)((__builtin_amdgcn_mbcnt_hi(~0u, __builtin_amdgcn_mbcnt_lo(~0u, 0u)) & 32u) ? lo : hi)); }
__device__ __forceinline__ float xsum32(float v) { return v + xother32(v); }
__device__ __forceinline__ float xmax32(float v) { return fmaxf(v, xother32(v)); }
__device__ __forceinline__ int crow16(int r, int hi) { return (r & 3) + 8 * (r >> 2) + 4 * hi; }
template <bool ISA>
__device__ __forceinline__ void attn_unit(Frame& F, int l, int b, int hx, int qb) {
    constexpr int DV = ISA ? 128 : 64, NDV = DV / 32, KSTR = ISA ? 272 : 144, VSTR = 144, KBYTES = 64 * KSTR, VBYTES = DV * VSTR, BUFB = KBYTES + VBYTES, NCH = ISA ? 2 : 1;
    constexpr float NEG = -1e30f;
    LAS unsigned char* L = F.lds + RING_OFF;
    const int tid = F.tid, lane = F.lane, r32 = lane & 31, hi = lane >> 5, qs = F.wave & 3, grp = F.wave >> 2, q0 = qb * 128;
    const int kvh = hx >> 2, hd = kvh * 8 + (hx & 3) * 2 + grp;
    const bf16* Qp; const bf16* Kp; const bf16* VT; int ldq;
    if (ISA) { const bf16* QKA = WSP(bf16, WS_QKA); Qp = QKA + (size_t)b * SEQ * 2048 + hx * 128 + grp * 64; Kp = QKA + (size_t)b * SEQ * 2048 + 1024 + hx * 128; ldq = 2048; VT = WSP(bf16, WS_VTA) + (size_t)(b * 8 + hx) * 128 * SEQ; }
    else { const bf16* QKD = WSP(bf16, WS_QKD); Qp = QKD + (size_t)b * SEQ * 1152 + hd * 64; Kp = QKD + (size_t)b * SEQ * 1152 + 1024 + kvh * 64; ldq = 1152; VT = WSP(bf16, WS_VTD) + (size_t)(b * 2 + kvh) * 64 * SEQ; }
    const int qpos = q0 + 32 * qs + r32;
    bf16x8 qr[4];
#pragma unroll
    for (int d0 = 0; d0 < 4; ++d0) qr[d0] = *(const bf16x8*)(Qp + (size_t)qpos * ldq + d0 * 16 + hi * 8);
    LAS float* Bt = (LAS float*)(L + 2 * BUFB);
    { const float* TAB = WSP(float, WS_TAB);
      if (ISA) { if (tid < 128) Bt[tid] = TAB[hx * 128 + tid] - TAB[hx * 128 + 127]; }
      else { if (tid < 256) Bt[tid] = TAB[(8 + kvh * 8 + (hx & 3) * 2 + (tid >> 7)) * 128 + (tid & 127)]; } }
    const int TQ = q0 >> 6, T0 = ISA ? 0 : (TQ >= 2 ? TQ - 2 : 0), T1 = TQ + 1;
    v4u kreg[NCH], vreg[NCH];
#define AT_GLOAD(T) do { _Pragma("unroll") for (int i_ = 0; i_ < NCH; ++i_) { const int c_ = tid + 512 * i_; \
        const int kr_ = ISA ? (c_ >> 4) : (c_ >> 3), kc_ = ISA ? (c_ & 15) : (c_ & 7); kreg[i_] = *(const v4u*)(Kp + (size_t)((T) * 64 + kr_) * ldq + kc_ * 8); \
        const int vr_ = c_ >> 3, vc_ = c_ & 7; vreg[i_] = *(const v4u*)(VT + (size_t)vr_ * SEQ + (T) * 64 + vc_ * 8); } } while (0)
#define AT_LWRITE(buf) do { _Pragma("unroll") for (int i_ = 0; i_ < NCH; ++i_) { const int c_ = tid + 512 * i_; \
        const int kr_ = ISA ? (c_ >> 4) : (c_ >> 3), kc_ = ISA ? (c_ & 15) : (c_ & 7); *(LAS v4u*)(L + (buf) * BUFB + kr_ * KSTR + kc_ * 16) = kreg[i_]; \
        const int vr_ = c_ >> 3, vc_ = c_ & 7; *(LAS v4u*)(L + (buf) * BUFB + KBYTES + vr_ * VSTR + vc_ * 16) = vreg[i_]; } } while (0)
    f32x16 o[NDV];
#pragma unroll
    for (int i = 0; i < NDV; ++i) o[i] = (f32x16){0.f, 0.f, 0.f, 0.f, 0.f, 0.f, 0.f, 0.f, 0.f, 0.f, 0.f, 0.f, 0.f, 0.f, 0.f, 0.f};
    float m_run = ISA ? NEG : F.kin[I_SSINK][l * 16 + hd] * LOG2E, l_run = ISA ? 0.f : (hi == 0 ? 1.f : 0.f);
    const int krow = (r32 & 16) | (r32 & 3) | ((r32 & 4) << 1) | ((r32 & 8) >> 1);
    const int koff = krow * KSTR + (ISA ? grp * 128 : 0) + hi * 16, voff = KBYTES + r32 * VSTR + hi * 16;
    AT_GLOAD(T0); AT_LWRITE(0); __syncthreads();
#pragma unroll 1
    for (int T = T0; T <= T1; ++T) {
        const int cur = (T - T0) & 1;
        if (T < T1) AT_GLOAD(T + 1);
        LAS const unsigned char* Kb = L + cur * BUFB;
        f32x16 s[2];
#pragma unroll
        for (int blk = 0; blk < 2; ++blk) { s[blk] = (f32x16){0.f, 0.f, 0.f, 0.f, 0.f, 0.f, 0.f, 0.f, 0.f, 0.f, 0.f, 0.f, 0.f, 0.f, 0.f, 0.f};
#pragma unroll
            for (int d0 = 0; d0 < 4; ++d0) { const bf16x8 kf = *(const LAS bf16x8*)(Kb + koff + blk * 32 * KSTR + d0 * 32); s[blk] = __builtin_amdgcn_mfma_f32_32x32x16_bf16(kf, qr[d0], s[blk], 0, 0, 0); } }
        if (!ISA || T >= TQ - 2) {
#pragma unroll
            for (int blk = 0; blk < 2; ++blk)
#pragma unroll
                for (int r = 0; r < 16; ++r) { const int kvl = 32 * blk + 16 * (r >> 3) + 8 * hi + (r & 7), dist = qpos - (T * 64 + kvl);
                    const int di = dist < 0 ? 0 : (dist > 127 ? 127 : dist);
                    const float bv = Bt[(ISA ? 0 : grp * 128) + di];
                    if (ISA) s[blk][r] = dist < 0 ? NEG : (dist < 128 ? s[blk][r] + bv : s[blk][r]);
                    else s[blk][r] = (dist < 0 || dist > 127) ? NEG : s[blk][r] + bv; } }
        float mt = s[0][0];
#pragma unroll
        for (int r = 1; r < 16; ++r) mt = fmaxf(mt, s[0][r]);
#pragma unroll
        for (int r = 0; r < 16; ++r) mt = fmaxf(mt, s[1][r]);
        mt = xmax32(mt);
        const float m_new = fmaxf(m_run, mt);
        if (__any(m_new > m_run)) { const float alpha = __builtin_amdgcn_exp2f(m_run - m_new); l_run *= alpha;
#pragma unroll
            for (int i = 0; i < NDV; ++i)
#pragma unroll
                for (int r = 0; r < 16; ++r) o[i][r] *= alpha;
            m_run = m_new; }
        float ls = 0.f;
#pragma unroll
        for (int blk = 0; blk < 2; ++blk)
#pragma unroll
            for (int r = 0; r < 16; ++r) { const float pv_ = __builtin_amdgcn_exp2f(s[blk][r] - m_run); s[blk][r] = pv_; ls += pv_; }
        l_run += ls;
#pragma unroll
        for (int sl = 0; sl < 4; ++sl) { const int blk = sl >> 1, r0 = 8 * (sl & 1);
            v4u pw; pw.x = pg8::cvt_pk_bf16(s[blk][r0], s[blk][r0 + 1]); pw.y = pg8::cvt_pk_bf16(s[blk][r0 + 2], s[blk][r0 + 3]); pw.z = pg8::cvt_pk_bf16(s[blk][r0 + 4], s[blk][r0 + 5]); pw.w = pg8::cvt_pk_bf16(s[blk][r0 + 6], s[blk][r0 + 7]);
            const bf16x8 pf = __builtin_bit_cast(bf16x8, pw);
#pragma unroll
            for (int i = 0; i < NDV; ++i) { const bf16x8 vf = *(const LAS bf16x8*)(Kb + voff + i * 32 * VSTR + sl * 32); o[i] = __builtin_amdgcn_mfma_f32_32x32x16_bf16(vf, pf, o[i], 0, 0, 0); } }
        if (T < T1) AT_LWRITE(cur ^ 1);
        __syncthreads();
    }
#undef AT_GLOAD
#undef AT_LWRITE
    const float inv = 1.0f / xsum32(l_run);
    bf16* MIX = WSP(bf16, WS_MIXED);
    if (ISA) {
        int ll_ = l; asm volatile("" : "+s"(ll_)); const float lam_init = ll_ == 0 ? 0.2f : 0.35550906759f;     float lam_full;
        { const float* lm = F.kin[I_DLAM] + (size_t)l * 256; const float s1 = wave_sum(lm[lane] * lm[64 + lane]), s2 = wave_sum(lm[128 + lane] * lm[192 + lane]); lam_full = __expf(s1) - __expf(s2) + lam_init; }
        LAS float* R1 = (LAS float*)L;
        LAS bf16* R2 = (LAS bf16*)(L + 66048);
        const int ql = 32 * qs + r32;
        if (grp == 1) {
#pragma unroll
            for (int i = 0; i < NDV; ++i)
#pragma unroll
                for (int r = 0; r < 16; ++r) R1[ql * 129 + 32 * i + crow16(r, hi)] = lam_full * inv * o[i][r]; }
        __syncthreads();
        if (grp == 0) { float ss = 0.f;
#pragma unroll
            for (int i = 0; i < NDV; ++i)
#pragma unroll
                for (int r = 0; r < 16; ++r) { const float d = o[i][r] * inv - R1[ql * 129 + 32 * i + crow16(r, hi)]; o[i][r] = d; ss += d * d; }
            const float rstd = rsqrtf(xsum32(ss) * (1.0f / 128.0f) + 1e-6f) * (1.0f - lam_init);
            const float* sl = F.kin[I_DSUB] + l * 128;
#pragma unroll
            for (int i = 0; i < NDV; ++i)
#pragma unroll
                for (int r = 0; r < 16; ++r) { const int dv = 32 * i + crow16(r, hi); R2[ql * 132 + dv] = (bf16)f2bf(o[i][r] * rstd * sl[dv]); } }
        __syncthreads();
#pragma unroll
        for (int i = 0; i < 4; ++i) { const int c = tid + 512 * i, row = c >> 4, ch = c & 15; const LAS v2u* sp = (const LAS v2u*)(R2 + row * 132 + ch * 8); const v2u a = sp[0], bb = sp[1];
            *(v4u*)(MIX + (size_t)(b * SEQ + q0 + row) * DM + hx * 128 + ch * 8) = (v4u){a.x, a.y, bb.x, bb.y}; }
    } else {
        LAS bf16* R = (LAS bf16*)L + F.wave * 2176;
#pragma unroll
        for (int i = 0; i < NDV; ++i)
#pragma unroll
            for (int r = 0; r < 16; ++r) R[r32 * 68 + 32 * i + crow16(r, hi)] = (bf16)f2bf(o[i][r] * inv);
#pragma unroll
        for (int i = 0; i < 4; ++i) { const int c = lane + 64 * i, row = c >> 3, ch = c & 7; const LAS v2u* sp = (const LAS v2u*)(R + row * 68 + ch * 8); const v2u a = sp[0], bb = sp[1];
            *(v4u*)(MIX + (size_t)(b * SEQ + q0 + 32 * qs + row) * DM + 3072 + hd * 64 + ch * 8) = (v4u){a.x, a.y, bb.x, bb.y}; }
    }
}
__device__ __forceinline__ void prep_gla(Frame& F) {
    LAS float* Lb = (LAS float*)(F.lds + RING_OFF); LAS float* Qd = Lb + 64 * 129; LAS float* Ki = Qd + 64 * 129; LAS bf16* Kt = (LAS bf16*)(Ki + 64 * 129);
    const bf16* COLS = WSP(bf16, WS_COLS); const float* LOGA = WSP(float, WS_LOGA);
    bf16* QDEC = WSP(bf16, WS_QDEC); bf16* KDT = WSP(bf16, WS_KDT); bf16* AMg = WSP(bf16, WS_AM); float* EBL = WSP(float, WS_EBL);
    for (int u = F.bx; u < 1024; u += F.G) {
        const int b = u >> 9, h = (u >> 7) & 3, ck = u & 127; const size_t row0 = (size_t)b * SEQ + ck * 64;
        __syncthreads();
        for (int idx = F.tid; idx < 8192; idx += NWAVES * 64) { const int t = idx >> 7, d = idx & 127; Lb[t * 129 + d] = LOGA[(row0 + t) * 512 + h * 128 + d]; }
        __syncthreads();
        if (F.tid < 128) { float acc = 0.f;
#pragma unroll 8
            for (int t = 0; t < 64; ++t) { acc += Lb[t * 129 + F.tid]; Lb[t * 129 + F.tid] = acc; }
            EBL[(size_t)u * 128 + F.tid] = __expf(acc); }
        __syncthreads();
        for (int idx = F.tid; idx < 8192; idx += NWAVES * 64) { const int t = idx >> 7, d = idx & 127; const float bt = Lb[t * 129 + d], bl = Lb[63 * 129 + d];
            const float q = bf2f(COLS[(row0 + t) * NMAIN + CB_Q + h * 128 + d]) * 0.08838834764831845f, k = bf2f(COLS[(row0 + t) * NMAIN + CB_K + h * 128 + d]);
            const float qd = q * __expf(bt); Qd[t * 129 + d] = qd; Ki[t * 129 + d] = k * __expf(-bt); Kt[d * 72 + t] = (bf16)f2bf(k * __expf(bl - bt));
            QDEC[((size_t)u * 64 + t) * 128 + d] = (bf16)f2bf(qd); }
        __syncthreads();
#pragma unroll
        for (int i = 0; i < 2; ++i) { const int c_ = F.tid + 512 * i, row = c_ >> 3, ch = c_ & 7; const LAS v2u* sp = (const LAS v2u*)(Kt + row * 72 + ch * 8); const v2u a = sp[0], bb = sp[1];
            *(v4u*)(KDT + ((size_t)u * 128 + row) * 64 + ch * 8) = (v4u){a.x, a.y, bb.x, bb.y}; }
        { const int c = F.tid >> 3, sg = F.tid & 7; float acc[8];
#pragma unroll
          for (int e = 0; e < 8; ++e) acc[e] = 0.f;
#pragma unroll 4
          for (int d = 0; d < 128; ++d) { const float q = Qd[c * 129 + d];
#pragma unroll
              for (int e = 0; e < 8; ++e) acc[e] += q * Ki[(sg * 8 + e) * 129 + d]; }
#pragma unroll
          for (int e = 0; e < 8; ++e) if (sg * 8 + e > c) acc[e] = 0.f;
          *(v4u*)(AMg + ((size_t)u * 64 + c) * 64 + sg * 8) = pack8(acc); }
    }
}
__device__ __forceinline__ void prep_vt(Frame& F, int pass) {
    LAS bf16* T = (LAS bf16*)(F.lds + RING_OFF);
    const bf16* COLS = WSP(bf16, WS_COLS);
    const int nch = pass == 0 ? 144 : 128, nvr = nch * 8;
    for (int tile = F.bx; tile < M / 32; tile += F.G) {
        const int b = tile >> 8, t0 = (tile & 255) * 32;
        __syncthreads();
        for (int idx = F.tid; idx < 32 * nch; idx += NWAVES * 64) { const int tok = idx / nch, ch = idx % nch;
            const int col = pass == 0 ? (ch < 128 ? CA_V + ch * 8 : CD_V + (ch - 128) * 8) : (pass == 1 ? CB_V + ch * 8 : CB_G + ch * 8);
            const v4u v = *(const v4u*)(COLS + (size_t)(b * SEQ + t0 + tok) * NMAIN + col); LAS v2u* d = (LAS v2u*)(T + tok * 1160 + ch * 8); d[0] = (v2u){v.x, v.y}; d[1] = (v2u){v.z, v.w}; }
        __syncthreads();
        for (int idx = F.tid; idx < nvr * 4; idx += NWAVES * 64) { const int ch = idx / nvr, vrow = idx % nvr;
            unsigned e[8];
#pragma unroll
            for (int k = 0; k < 8; ++k) e[k] = T[(ch * 8 + k) * 1160 + vrow];
            v4u o; o.x = e[0] | (e[1] << 16); o.y = e[2] | (e[3] << 16); o.z = e[4] | (e[5] << 16); o.w = e[6] | (e[7] << 16);
            bf16* dst;
            if (pass == 0) dst = vrow < 1024 ? WSP(bf16, WS_VTA) + ((size_t)(b * 8 + (vrow >> 7)) * 128 + (vrow & 127)) * SEQ : WSP(bf16, WS_VTD) + ((size_t)(b * 2 + ((vrow - 1024) >> 6)) * 64 + ((vrow - 1024) & 63)) * SEQ;
            else dst = WSP(bf16, pass == 1 ? WS_VTB : WS_GTB) + ((size_t)b * 1024 + vrow) * SEQ;
            *(v4u*)(dst + t0 + ch * 8) = o; }
    }
}
typedef float f32x4v __attribute__((ext_vector_type(4)));
__device__ __forceinline__ float sum16(float v) { v = sum8(v); v += dpp_f<0x140>(v); return v; }
__device__ __forceinline__ void gla_scan_unit(Frame& F, int l, int b, int h) {
    LAS unsigned char* L = F.lds + RING_OFF;
    constexpr int OQD = 0, OKT = 17408, OAM = 35840, OVT = 45056, OEB = 81920, OPS = 82432;
    const int tid = F.tid, lane = F.lane, n = lane & 15, g = lane >> 4, w = F.wave;
    const bf16* QDEC = WSP(bf16, WS_QDEC); const bf16* KDT = WSP(bf16, WS_KDT); const bf16* AMg = WSP(bf16, WS_AM); const float* EBL = WSP(float, WS_EBL);
    const bf16* VTB = WSP(bf16, WS_VTB) + (size_t)(b * 4 + h) * 256 * SEQ; const bf16* GTB = WSP(bf16, WS_GTB) + (size_t)(b * 4 + h) * 256 * SEQ; bf16* MIX = WSP(bf16, WS_MIXED);
    f32x4v S[8][2];
#pragma unroll
    for (int dt = 0; dt < 8; ++dt)
#pragma unroll
        for (int vt = 0; vt < 2; ++vt) S[dt][vt] = (f32x4v){0.f, 0.f, 0.f, 0.f};
    float gain[2];
#pragma unroll
    for (int vt = 0; vt < 2; ++vt) gain[vt] = F.kin[I_GON][l * 256 + 32 * w + 16 * vt + n];
    v4u pq[2], pk[2], pa, pv[4]; float pe = 0.f;
#define GL_ISSUE(CK) do { const size_t u_ = (size_t)(b * 4 + h) * 128 + (CK); \
        _Pragma("unroll") for (int i = 0; i < 2; ++i) { const int c_ = tid + 512 * i; pq[i] = *(const v4u*)(QDEC + (u_ * 64 + (c_ >> 4)) * 128 + (c_ & 15) * 8); pk[i] = *(const v4u*)(KDT + (u_ * 128 + (c_ >> 3)) * 64 + (c_ & 7) * 8); } \
        pa = *(const v4u*)(AMg + (u_ * 64 + (tid >> 3)) * 64 + (tid & 7) * 8); \
        _Pragma("unroll") for (int i = 0; i < 4; ++i) { const int c_ = tid + 512 * i; pv[i] = *(const v4u*)(VTB + (size_t)(c_ >> 3) * SEQ + (CK) * 64 + (c_ & 7) * 8); } \
        if (tid < 128) pe = EBL[u_ * 128 + tid]; } while (0)
#define GL_WRITE() do { _Pragma("unroll") for (int i = 0; i < 2; ++i) { const int c_ = tid + 512 * i; *(LAS v4u*)(L + OQD + (c_ >> 4) * 272 + (c_ & 15) * 16) = pq[i]; *(LAS v4u*)(L + OKT + (c_ >> 3) * 144 + (c_ & 7) * 16) = pk[i]; } \
        *(LAS v4u*)(L + OAM + (tid >> 3) * 144 + (tid & 7) * 16) = pa; \
        _Pragma("unroll") for (int i = 0; i < 4; ++i) { const int c_ = tid + 512 * i; *(LAS v4u*)(L + OVT + (c_ >> 3) * 144 + (c_ & 7) * 16) = pv[i]; } \
        if (tid < 128) ((LAS float*)(L + OEB))[tid] = pe; } while (0)
    GL_ISSUE(0); GL_WRITE();
    __syncthreads();
#pragma unroll 1
    for (int ck = 0; ck < 128; ++ck) {
        const size_t row0 = (size_t)b * SEQ + ck * 64;
        if (ck + 1 < 128) GL_ISSUE(ck + 1);
        v2u gr[4][2];
#pragma unroll
        for (int ct = 0; ct < 4; ++ct)
#pragma unroll
            for (int vt = 0; vt < 2; ++vt) gr[ct][vt] = *(const v2u*)(GTB + (size_t)(32 * w + 16 * vt + n) * SEQ + ck * 64 + 16 * ct + 4 * g);
        bf16x8 vf[2][2];
#pragma unroll
        for (int vt = 0; vt < 2; ++vt)
#pragma unroll
            for (int ks = 0; ks < 2; ++ks) vf[vt][ks] = *(const LAS bf16x8*)(L + OVT + (32 * w + 16 * vt + n) * 144 + (32 * ks + 8 * g) * 2);
        f32x4v o[4][2];
#pragma unroll
        for (int ct = 0; ct < 4; ++ct)
#pragma unroll
            for (int vt = 0; vt < 2; ++vt) o[ct][vt] = (f32x4v){0.f, 0.f, 0.f, 0.f};
#pragma unroll
        for (int ct = 0; ct < 4; ++ct)
#pragma unroll
            for (int ks = 0; ks < 2; ++ks) { const bf16x8 af = *(const LAS bf16x8*)(L + OAM + (16 * ct + n) * 144 + (32 * ks + 8 * g) * 2);
#pragma unroll
                for (int vt = 0; vt < 2; ++vt) o[ct][vt] = __builtin_amdgcn_mfma_f32_16x16x32_bf16(af, vf[vt][ks], o[ct][vt], 0, 0, 0); }
#pragma unroll
        for (int kk = 0; kk < 4; ++kk) { bf16x8 sf[2];
#pragma unroll
            for (int vt = 0; vt < 2; ++vt) { v4u pw; pw.x = pg8::cvt_pk_bf16(S[2 * kk][vt][0], S[2 * kk][vt][1]); pw.y = pg8::cvt_pk_bf16(S[2 * kk][vt][2], S[2 * kk][vt][3]);
                pw.z = pg8::cvt_pk_bf16(S[2 * kk + 1][vt][0], S[2 * kk + 1][vt][1]); pw.w = pg8::cvt_pk_bf16(S[2 * kk + 1][vt][2], S[2 * kk + 1][vt][3]); sf[vt] = __builtin_bit_cast(bf16x8, pw); }
#pragma unroll
            for (int ct = 0; ct < 4; ++ct) { const LAS unsigned char* qp = L + OQD + (16 * ct + n) * 272 + (32 * kk + 4 * g) * 2; const v2u qa = *(const LAS v2u*)qp, qb = *(const LAS v2u*)(qp + 32);
                const bf16x8 qf = __builtin_bit_cast(bf16x8, (v4u){qa.x, qa.y, qb.x, qb.y});
#pragma unroll
                for (int vt = 0; vt < 2; ++vt) o[ct][vt] = __builtin_amdgcn_mfma_f32_16x16x32_bf16(qf, sf[vt], o[ct][vt], 0, 0, 0); } }
#pragma unroll
        for (int dt = 0; dt < 8; ++dt) { const f32x4v eb = *(const LAS f32x4v*)(L + OEB + (16 * dt + 4 * g) * 4);
#pragma unroll
            for (int vt = 0; vt < 2; ++vt) S[dt][vt] = S[dt][vt] * eb;
#pragma unroll
            for (int ks = 0; ks < 2; ++ks) { const bf16x8 kf = *(const LAS bf16x8*)(L + OKT + (16 * dt + n) * 144 + (32 * ks + 8 * g) * 2);
#pragma unroll
                for (int vt = 0; vt < 2; ++vt) S[dt][vt] = __builtin_amdgcn_mfma_f32_16x16x32_bf16(kf, vf[vt][ks], S[dt][vt], 0, 0, 0); } }
        LAS float* PS = (LAS float*)(L + OPS) + (ck & 1) * 512;
#pragma unroll
        for (int ct = 0; ct < 4; ++ct)
#pragma unroll
            for (int r = 0; r < 4; ++r) { const float ss = sum16(o[ct][0][r] * o[ct][0][r] + o[ct][1][r] * o[ct][1][r]); if (n == 0) PS[(16 * ct + 4 * g + r) * 8 + w] = ss; }
        __syncthreads();
        if (ck + 1 < 128) GL_WRITE();
#pragma unroll
        for (int ct = 0; ct < 4; ++ct) { float rstd[4];
#pragma unroll
            for (int r = 0; r < 4; ++r) { const LAS f32x4v* pp = (const LAS f32x4v*)(PS + (16 * ct + 4 * g + r) * 8); const f32x4v p0 = pp[0], p1 = pp[1];
                rstd[r] = rsqrtf(((p0.x + p0.y) + (p0.z + p0.w) + (p1.x + p1.y) + (p1.z + p1.w)) * (1.0f / 256.0f) + 1e-6f); }
#pragma unroll
            for (int vt = 0; vt < 2; ++vt) { const int vc = 32 * w + 16 * vt + n; const v2u gq = gr[ct][vt];
                const float gg[4] = {bflo(gq.x), bfhi(gq.x), bflo(gq.y), bfhi(gq.y)};
#pragma unroll
                for (int r = 0; r < 4; ++r) MIX[(row0 + 16 * ct + 4 * g + r) * DM + 1024 + h * 256 + vc] = (bf16)f2bf(o[ct][vt][r] * rstd[r] * gain[vt] * silu_g(gg[r])); } }
        __syncthreads();
    }
#undef GL_ISSUE
#undef GL_WRITE
}
__device__ __forceinline__ void mixers_v3(Frame& F, int l) {
    gu32* ctr = F.ctl + CW_Q + 64 * l;
    for (;;) {
        const int it = next_item(F, ctr); relaunder(F); relaunder_tid(F);
        if (it < 4) { rwkv_unit_v1(F, l, it >> 1, it & 1); }
        else if (it < 12) { const int j = it - 4; gla_scan_unit(F, l, j >> 2, j & 3); }
        else if (it < 12 + 1024) { const int j = it - 12, qb = 63 - (j >> 4), bh = j & 15; attn_unit<true>(F, l, bh >> 3, bh & 7, qb); }
        else if (it < 12 + 2048) { const int j = it - 1036, qb = j & 63, bh = j >> 6; attn_unit<false>(F, l, bh >> 3, bh & 7, qb); }
        else break;
    }
}
constexpr int RC_AT = 0, RC_RT = 2048, RC_BK = 4096, RC_VF = 8192, RC_GF = 10240, RC_U0 = 12288, RC_Y0 = 16384, RC_P15 = 20480, RC_BN = 20736, RC_BYTES = 20800;
__device__ __forceinline__ void prep_rwkv_chunks(Frame& F, int l) {
    const int team = F.tid >> 8, tt = F.tid & 255;
    LAS float* Lt = (LAS float*)(F.lds + RING_OFF) + team * 12288;
    LAS float* XA = Lt; LAS float* XR = Lt + 1040; LAS float* ZB = Lt + 2080; LAS float* ZK = Lt + 3120; LAS float* TB = Lt + 4160; LAS float* TK = Lt + 5200; LAS float* VV = Lt + 6240;
    LAS float* ATl = Lt + 7280; LAS float* U0l = Lt + 8320; LAS float* W1 = Lt + 9360;
    LAS float* Aab = Lt + 10400; LAS float* Aak = Lt + 10672; LAS float* Arb = Lt + 10944; LAS float* Ark = Lt + 11216; LAS float* TT = Lt + 11488;
    const float* RW = WSP(float, WS_RW); constexpr size_t RS = RW_ONE / 4; unsigned char* RWC = F.ws + WS_RWC;
    for (int pair = F.bx; pair < 8192; pair += F.G) {
        const int uc = pair * 2 + team, b = uc >> 13, h = (uc >> 9) & 15, ck = uc & 511; const size_t row0 = (size_t)b * SEQ + ck * 16; unsigned char* rec = RWC + (size_t)uc * RC_BYTES;
        __syncthreads();
        {
          const int j = tt & 63, q = tt >> 6; const size_t cb = row0 * 1024 + h * 64 + j;
          float cl = 0.f, clq[4] = {0.f, 0.f, 0.f, 0.f}, clm = 0.f;
#pragma unroll
          for (int t = 0; t < 16; ++t) { const float lw = __logf(RW[RS + cb + (size_t)t * 1024]); if (t == 4 * q) clm = cl; cl += lw; if ((t >> 2) == q) clq[t & 3] = cl; }
#pragma unroll
          for (int e = 0; e < 4; ++e) { const int t = 4 * q + e; const size_t o = cb + (size_t)t * 1024; const float cprev = e == 0 ? clm : clq[e - 1], cc = clq[e];
              const float rr = RW[o], kk = RW[2 * RS + o], vv = RW[3 * RS + o], aa = RW[4 * RS + o], bb = RW[5 * RS + o];
              XA[t * 65 + j] = aa * __expf(cprev); XR[t * 65 + j] = rr * __expf(cc); const float ei = __expf(-cc), ef = __expf(cl - cc);
              ZB[t * 65 + j] = bb * ei; ZK[t * 65 + j] = kk * ei; TB[t * 65 + j] = bb * ef; TK[t * 65 + j] = kk * ef; VV[t * 65 + j] = vv; }
          if (q == 0) ((float*)(rec + RC_P15))[j] = __expf(cl);
          { v2u gw; const size_t o = cb + (size_t)(4 * q) * 1024; gw.x = pk2(RW[6 * RS + o], RW[6 * RS + o + 1024]); gw.y = pk2(RW[6 * RS + o + 2048], RW[6 * RS + o + 3072]);
            *(v2u*)(rec + RC_GF + (((j >> 4) * 64 + 16 * q + (j & 15)) * 8)) = gw; } }
        __syncthreads();
        {
          const int t = tt >> 4, s = tt & 15; float ab = 0.f, ak = 0.f, rb = 0.f, rk = 0.f;
#pragma unroll 8
          for (int j = 0; j < 64; ++j) { const float xa = XA[t * 65 + j], xr = XR[t * 65 + j], zb = ZB[s * 65 + j], zk = ZK[s * 65 + j]; ab += xa * zb; ak += xa * zk; rb += xr * zb; rk += xr * zk; }
          Aab[t * 17 + s] = s < t ? ab : 0.f; Aak[t * 17 + s] = s < t ? ak : 0.f; Arb[t * 17 + s] = s <= t ? rb : 0.f; Ark[t * 17 + s] = s <= t ? rk : 0.f;
          if (tt < 16) { float bn = 0.f; const float* rkp = F.kin[I_RRK] + l * 1024 + h * 64;
#pragma unroll 8
              for (int j = 0; j < 64; ++j) bn += XR[tt * 65 + j] * ZK[tt * 65 + j] * rkp[j];
              ((float*)(rec + RC_BN))[tt] = bn; } }
        __syncthreads();
        {
          if (tt < 16) { float col[16];
#pragma unroll
              for (int t = 0; t < 16; ++t) { float acc = (t == tt) ? 1.f : 0.f;
#pragma unroll
                  for (int s = 0; s < 16; ++s) if (s < t) acc += Aab[t * 17 + s] * col[s];
                  col[t] = acc; TT[t * 17 + tt] = acc; } }
          const int i = tt & 63, tq = tt >> 6; float acc[4] = {0.f, 0.f, 0.f, 0.f};
#pragma unroll
          for (int s = 0; s < 16; ++s) { const float vv = VV[s * 65 + i];
#pragma unroll
              for (int e = 0; e < 4; ++e) acc[e] += Aak[(4 * tq + e) * 17 + s] * vv; }
#pragma unroll
          for (int e = 0; e < 4; ++e) W1[(4 * tq + e) * 65 + i] = acc[e]; }
        __syncthreads();
        {
          const int j = tt & 63, tq = tt >> 6; float a4[4] = {0.f, 0.f, 0.f, 0.f}, u4[4] = {0.f, 0.f, 0.f, 0.f};
#pragma unroll
          for (int s = 0; s < 16; ++s) { const float xa = XA[s * 65 + j], w1 = W1[s * 65 + j];
#pragma unroll
              for (int e = 0; e < 4; ++e) { const float tv = TT[(4 * tq + e) * 17 + s]; a4[e] += tv * xa; u4[e] += tv * w1; } }
#pragma unroll
          for (int e = 0; e < 4; ++e) { ATl[(4 * tq + e) * 65 + j] = a4[e]; U0l[(4 * tq + e) * 65 + j] = u4[e]; }
          *(f32x4*)(rec + RC_U0 + (((j >> 4) * 64 + 16 * tq + (j & 15)) * 16)) = (f32x4){u4[0], u4[1], u4[2], u4[3]}; }
        __syncthreads();
        {
          const int j = tt & 63, tq = tt >> 6; float r4[4], y4[4];
#pragma unroll
          for (int e = 0; e < 4; ++e) { r4[e] = XR[(4 * tq + e) * 65 + j]; y4[e] = 0.f; }
#pragma unroll
          for (int s = 0; s < 16; ++s) { const float at = ATl[s * 65 + j], u0 = U0l[s * 65 + j], vv = VV[s * 65 + j];
#pragma unroll
              for (int e = 0; e < 4; ++e) { const float arb = Arb[(4 * tq + e) * 17 + s], ark = Ark[(4 * tq + e) * 17 + s]; r4[e] += arb * at; y4[e] += arb * u0 + ark * vv; } }
          *(f32x4*)(rec + RC_Y0 + (((j >> 4) * 64 + 16 * tq + (j & 15)) * 16)) = (f32x4){y4[0], y4[1], y4[2], y4[3]};
#pragma unroll
          for (int e = 0; e < 4; ++e) W1[(4 * tq + e) * 65 + j] = r4[e]; }
        __syncthreads();
        { const int t = tt & 15, jq = tt >> 4, kk = jq >> 3, half = (jq & 7) >> 2, g = jq & 3, j0 = 4 * jq;
          v2u wa, wr; wa.x = pk2(ATl[t * 65 + j0], ATl[t * 65 + j0 + 1]); wa.y = pk2(ATl[t * 65 + j0 + 2], ATl[t * 65 + j0 + 3]); wr.x = pk2(W1[t * 65 + j0], W1[t * 65 + j0 + 1]); wr.y = pk2(W1[t * 65 + j0 + 2], W1[t * 65 + j0 + 3]);
          *(v2u*)(rec + RC_AT + kk * 1024 + (16 * g + t) * 16 + half * 8) = wa; *(v2u*)(rec + RC_RT + kk * 1024 + (16 * g + t) * 16 + half * 8) = wr;
          const int j = tt & 63, gg = tt >> 6; v4u bk; bk.x = pk2(TB[(4 * gg) * 65 + j], TB[(4 * gg + 1) * 65 + j]); bk.y = pk2(TB[(4 * gg + 2) * 65 + j], TB[(4 * gg + 3) * 65 + j]);
          bk.z = pk2(TK[(4 * gg) * 65 + j], TK[(4 * gg + 1) * 65 + j]); bk.w = pk2(TK[(4 * gg + 2) * 65 + j], TK[(4 * gg + 3) * 65 + j]);
          *(v4u*)(rec + RC_BK + (j >> 4) * 1024 + (16 * gg + (j & 15)) * 16) = bk;
          v2u vf; vf.x = pk2(VV[(4 * gg) * 65 + j], VV[(4 * gg + 1) * 65 + j]); vf.y = pk2(VV[(4 * gg + 2) * 65 + j], VV[(4 * gg + 3) * 65 + j]);
          *(v2u*)(rec + RC_VF + ((j >> 4) * 64 + 16 * gg + (j & 15)) * 8) = vf; }
    }
}
__device__ __forceinline__ void rwkv_scan_unit(Frame& F, int l, int b, int h) {
    LAS unsigned char* L = F.lds + RING_OFF;
    const unsigned char* recs = F.ws + WS_RWC + (size_t)((b * 16 + h) * 512) * RC_BYTES;
    const int lane = F.lane, n = lane & 15, g = lane >> 4;
    if (F.wave != 0) {
        const int li = F.tid - 64; const bool act0 = li < 1300, act1 = li + 448 < 1300, act2 = li + 896 < 1300;
        v4u p0[3], p1[3], p2[3];
#define RWL_ISSUE(P, CK) do { if ((CK) < 512) { const v4u* src_ = (const v4u*)(recs + (size_t)(CK) * RC_BYTES); if (act0) P[0] = src_[li]; if (act1) P[1] = src_[li + 448]; if (act2) P[2] = src_[li + 896]; } } while (0)
#define RWL_WRITE(P, CK) do { if ((CK) < 512) { LAS v4u* dst_ = (LAS v4u*)(L + ((CK) & 1) * RC_BYTES); if (act0) dst_[li] = P[0]; if (act1) dst_[li + 448] = P[1]; if (act2) dst_[li + 896] = P[2]; } } while (0)
        RWL_ISSUE(p0, 0); RWL_ISSUE(p1, 1); RWL_ISSUE(p2, 2);
        RWL_WRITE(p0, 0); RWL_ISSUE(p0, 3);
        __syncthreads();
#pragma unroll 1
        for (int ck = 0; ck < 512; ck += 3) {
            RWL_WRITE(p1, ck + 1); RWL_ISSUE(p1, ck + 4); __syncthreads();
            if (ck + 1 < 512) { RWL_WRITE(p2, ck + 2); RWL_ISSUE(p2, ck + 5); __syncthreads(); }
            if (ck + 2 < 512) { RWL_WRITE(p0, ck + 3); RWL_ISSUE(p0, ck + 6); __syncthreads(); }
        }
#undef RWL_ISSUE
#undef RWL_WRITE
        return;
    }
    f32x4v S[4][4];
#pragma unroll
    for (int jt = 0; jt < 4; ++jt)
#pragma unroll
        for (int it = 0; it < 4; ++it) S[jt][it] = (f32x4v){0.f, 0.f, 0.f, 0.f};
    float lnw[4], lnb[4];
#pragma unroll
    for (int it = 0; it < 4; ++it) { lnw[it] = F.kin[I_RLNW][l * 1024 + h * 64 + 16 * it + n]; lnb[it] = F.kin[I_RLNB][l * 1024 + h * 64 + 16 * it + n]; }
    bf16* MIX = WSP(bf16, WS_MIXED) + ((size_t)b * SEQ) * DM + 2048 + h * 64 + n;
    __syncthreads();
#pragma unroll 1
    for (int ck = 0; ck < 512; ++ck) {
        const LAS unsigned char* R = L + (ck & 1) * RC_BYTES;
        bf16x8 at[2], rt[2];
#pragma unroll
        for (int kk = 0; kk < 2; ++kk) { at[kk] = *(const LAS bf16x8*)(R + RC_AT + kk * 1024 + lane * 16); rt[kk] = *(const LAS bf16x8*)(R + RC_RT + kk * 1024 + lane * 16); }
        f32x4v U[4], Y[4];
#pragma unroll
        for (int it = 0; it < 4; ++it) { U[it] = *(const LAS f32x4v*)(R + RC_U0 + it * 1024 + lane * 16); Y[it] = *(const LAS f32x4v*)(R + RC_Y0 + it * 1024 + lane * 16); }
#pragma unroll
        for (int kk = 0; kk < 2; ++kk)
#pragma unroll
            for (int it = 0; it < 4; ++it) { v4u pw; pw.x = pg8::cvt_pk_bf16(S[2 * kk][it][0], S[2 * kk][it][1]); pw.y = pg8::cvt_pk_bf16(S[2 * kk][it][2], S[2 * kk][it][3]);
                pw.z = pg8::cvt_pk_bf16(S[2 * kk + 1][it][0], S[2 * kk + 1][it][1]); pw.w = pg8::cvt_pk_bf16(S[2 * kk + 1][it][2], S[2 * kk + 1][it][3]); const bf16x8 sf = __builtin_bit_cast(bf16x8, pw);
                U[it] = __builtin_amdgcn_mfma_f32_16x16x32_bf16(at[kk], sf, U[it], 0, 0, 0); Y[it] = __builtin_amdgcn_mfma_f32_16x16x32_bf16(rt[kk], sf, Y[it], 0, 0, 0); }
        bf16x8 uv[4]; v2u vfr[4];
#pragma unroll
        for (int it = 0; it < 4; ++it) { vfr[it] = *(const LAS v2u*)(R + RC_VF + it * 512 + lane * 8); v4u pw; pw.x = pg8::cvt_pk_bf16(U[it][0], U[it][1]); pw.y = pg8::cvt_pk_bf16(U[it][2], U[it][3]); pw.z = vfr[it].x; pw.w = vfr[it].y; uv[it] = __builtin_bit_cast(bf16x8, pw); }
#pragma unroll
        for (int jt = 0; jt < 4; ++jt) { const bf16x8 bk = *(const LAS bf16x8*)(R + RC_BK + jt * 1024 + lane * 16); const f32x4v p15 = *(const LAS f32x4v*)(R + RC_P15 + (16 * jt + 4 * g) * 4);
#pragma unroll
            for (int it = 0; it < 4; ++it) S[jt][it] = __builtin_amdgcn_mfma_f32_16x16x32_bf16(bk, uv[it], S[jt][it] * p15, 0, 0, 0); }
        const f32x4v bn = *(const LAS f32x4v*)(R + RC_BN + 16 * g);
        f32x4v sm = (Y[0] + Y[1]) + (Y[2] + Y[3]);
#pragma unroll
        for (int r = 0; r < 4; ++r) sm[r] = sum16(sm[r]) * (1.0f / 64.0f);
        f32x4v vr = (f32x4v){0.f, 0.f, 0.f, 0.f};
#pragma unroll
        for (int it = 0; it < 4; ++it) { Y[it] = Y[it] - sm; vr += Y[it] * Y[it]; }
#pragma unroll
        for (int r = 0; r < 4; ++r) vr[r] = rsqrtf(sum16(vr[r]) * (1.0f / 64.0f) + 64e-5f);
#pragma unroll
        for (int it = 0; it < 4; ++it) { const v2u gr = *(const LAS v2u*)(R + RC_GF + it * 512 + lane * 8); const float gt[4] = {bflo(gr.x), bfhi(gr.x), bflo(gr.y), bfhi(gr.y)}, vt[4] = {bflo(vfr[it].x), bfhi(vfr[it].x), bflo(vfr[it].y), bfhi(vfr[it].y)};
#pragma unroll
            for (int r = 0; r < 4; ++r) MIX[(size_t)(ck * 16 + 4 * g + r) * DM + 16 * it] = (bf16)f2bf((Y[it][r] * vr[r] * lnw[it] + lnb[it] + bn[r] * vt[r]) * gt[r]); }
        __syncthreads();
    }
}
__device__ __forceinline__ void mixers_v4(Frame& F, int l, int qi, int mask = 15) {
    gu32* ctr = F.ctl + CW_Q + 64 * qi;
    for (;;) {
        const int it = next_item(F, ctr); relaunder(F); relaunder_tid(F);
        if (it < 32) { if (mask & 1) rwkv_scan_unit(F, l, it >> 4, it & 15); }
        else if (it < 40) { const int j = it - 32; if (mask & 2) gla_scan_unit(F, l, j >> 2, j & 3); }
        else if (it < 40 + 1024) { const int j = it - 40, qb = 63 - (j >> 4), bh = j & 15; if (mask & 4) attn_unit<true>(F, l, bh >> 3, bh & 7, qb); }
        else if (it < 40 + 2048) { const int j = it - 1064, qb = j & 63, bh = j >> 6; if (mask & 8) attn_unit<false>(F, l, bh >> 3, bh & 7, qb); }
        else break;
    }
}
struct Args { const float* in[35]; float* out; unsigned char* ws; };
__device__ __forceinline__ void mk_frame(Frame& F, int wv) {
    extern __shared__ __attribute__((aligned(16))) unsigned char lds[];
    kargp kp = (kargp)__builtin_amdgcn_kernarg_segment_ptr(); asm volatile("" : "+s"(kp));
    F.kin = kp;
    F.lds = (LAS unsigned char*)lds;
    F.MISC = (volatile LAS unsigned*)(F.lds + MISC_OFF);
    { int w_ = wv; asm volatile("" : "+s"(w_)); int t_ = (int)__builtin_amdgcn_mbcnt_hi(~0u, __builtin_amdgcn_mbcnt_lo(~0u, (unsigned)w_ * 64u)); asm volatile("" : "+v"(t_)); F.tid = t_; } F.lane = F.tid & 63; F.wave = __builtin_amdgcn_readfirstlane(F.tid >> 6);
    F.G = gridDim.x; { int bx = blockIdx.x; asm volatile("" : "+s"(bx)); F.bx = bx; F.vcu = (F.G % 8 == 0) ? (bx % 8) * (F.G / 8) + bx / 8 : bx; }
    F.out = (float*)kp[35]; F.ws = (unsigned char*)kp[36]; F.ctl = (gu32*)(F.ws + WS_CTL);
}
__device__ __forceinline__ void grid_bar(int wv) {
    Frame F; mk_frame(F, wv);
    XcdBarrier bar; bar.bar = (unsigned*)(F.ctl + CW_BAR); bar.x = xb_xcc_id(); bar.st = F.MISC + 8;
    xcd_barrier(bar);
}
__global__ void __launch_bounds__(NWAVES * 64, 2) mega_fwd(Args args) {
    const int wv = __builtin_amdgcn_readfirstlane((int)threadIdx.x >> 6);
    { Frame F; mk_frame(F, wv);
      for (int u = F.tid; u < (LDS_BYTES - LDSCTL_OFF) / 4; u += NWAVES * 64) ((LAS unsigned*)(F.lds + LDSCTL_OFF))[u] = 0u;
      __syncthreads();
      (void)xcd_barrier_post((unsigned*)(F.ctl + CW_BAR), F.MISC + 8);
#ifndef NO_P0
      p0_prologue_a(F);
#endif
    }
    grid_bar(wv);
    { Frame F; mk_frame(F, wv); p0_prologue_b(F); }
    grid_bar(wv);
#pragma unroll 1
    for (int l = 0; l < NLAYER; ++l) {
#define LAYER_VARS const float* mod = WSP(float, WS_MOD) + (size_t)l * 2 * 24576; const float* xin = l == 0 ? F.kin[I_X] : F.out; (void)mod; (void)xin
#ifndef NO_RMS
        { Frame F; mk_frame(F, wv); LAYER_VARS; rms_phase(F, xin, mod + 0, mod + 4096); }
#endif
        grid_bar(wv);
#ifndef NO_G1
        { Frame F; mk_frame(F, wv);
          pg8::Gemm g{WSP(pg8::bf16_t, WS_XN), WSP(pg8::bf16_t, WS_WIN + l * WIN_L), M, NIN, DM}; pg8::StaticOrder S; S.init(M, NIN, F.G, F.bx);
          pg8::EpiCols E{WSP(pg8::bf16_t, WS_COLS), WSP(float, WS_LOWR)};
          pg8::gemm_phase<pg8::EpiCols, pg8::StaticOrder, true, true>(F.lds + RING_OFF, g, S, E, F.tid); }
#endif
#ifdef REP_IN
        grid_bar(wv);
        { Frame F; mk_frame(F, wv);
          pg8::Gemm g{WSP(pg8::bf16_t, WS_XN), WSP(pg8::bf16_t, WS_WIN + l * WIN_L), M, NIN, DM}; pg8::StaticOrder S; S.init(M, NIN, F.G, F.bx);
          pg8::EpiCols E{WSP(pg8::bf16_t, WS_COLS), WSP(float, WS_LOWR)};
          pg8::gemm_phase<pg8::EpiCols, pg8::StaticOrder, true, true>(F.lds + RING_OFF, g, S, E, F.tid); }
#endif
        grid_bar(wv);
#ifndef NO_PREP
        { Frame F; mk_frame(F, wv); prep_norm(F, l); }
        { Frame F; mk_frame(F, wv); prep_loga(F, l); }
        { Frame F; mk_frame(F, wv); prep_rwkv(F, l); }
        { Frame F; mk_frame(F, wv); prep_vt(F, 0); }
        { Frame F; mk_frame(F, wv); prep_vt(F, 1); }
        { Frame F; mk_frame(F, wv); prep_vt(F, 2); }
        { Frame F; mk_frame(F, wv); prep_gla(F); }
        grid_bar(wv);
        { Frame F; mk_frame(F, wv); prep_rwkv_chunks(F, l); }
#endif
#ifdef REP_PREP
        grid_bar(wv);
        { Frame F; mk_frame(F, wv); prep_norm(F, l); }
        { Frame F; mk_frame(F, wv); prep_loga(F, l); }
        { Frame F; mk_frame(F, wv); prep_rwkv(F, l); }
        { Frame F; mk_frame(F, wv); prep_vt(F, 0); }
        { Frame F; mk_frame(F, wv); prep_vt(F, 1); }
        { Frame F; mk_frame(F, wv); prep_vt(F, 2); }
        { Frame F; mk_frame(F, wv); prep_gla(F); }
        grid_bar(wv);
        { Frame F; mk_frame(F, wv); prep_rwkv_chunks(F, l); }
#endif
        grid_bar(wv);
#ifndef NO_MIX
        { Frame F; mk_frame(F, wv); mixers_v4(F, l, l); }
#ifdef REP_MIX
        grid_bar(wv);
        { Frame F; mk_frame(F, wv); mixers_v4(F, l, l + 2, REP_MIX); }
#endif
#endif
        grid_bar(wv);
#ifndef NO_G2
        { Frame F; mk_frame(F, wv); LAYER_VARS;
          pg8::Gemm g{WSP(pg8::bf16_t, WS_MIXED), WSP(pg8::bf16_t, WS_WOUT + l * WOUT_L), M, DM, DM}; pg8::StaticOrder S; S.init(M, DM, F.G, F.bx);
          pg8::EpiRes E{xin, F.out, mod + 2 * 4096};
          pg8::gemm_phase<pg8::EpiRes, pg8::StaticOrder, true, true>(F.lds + RING_OFF, g, S, E, F.tid); }
#endif
        grid_bar(wv);
        { Frame F; mk_frame(F, wv); LAYER_VARS; rms_phase(F, F.out, mod + 3 * 4096, mod + 4 * 4096); }
        grid_bar(wv);
#ifndef NO_G3
        { Frame F; mk_frame(F, wv);
          pg8::Gemm g{WSP(pg8::bf16_t, WS_XN), WSP(pg8::bf16_t, WS_W13 + l * W13_L), M, 2 * DFF, DM}; pg8::StaticOrder S; S.init(M, 2 * DFF, F.G, F.bx);
          pg8::EpiSwiglu E{WSP(pg8::bf16_t, WS_HID)};
          pg8::gemm_phase<pg8::EpiSwiglu, pg8::StaticOrder, true, true>(F.lds + RING_OFF, g, S, E, F.tid); }
#endif
#ifdef REP_UP
        grid_bar(wv);
        { Frame F; mk_frame(F, wv);
          pg8::Gemm g{WSP(pg8::bf16_t, WS_XN), WSP(pg8::bf16_t, WS_W13 + l * W13_L), M, 2 * DFF, DM}; pg8::StaticOrder S; S.init(M, 2 * DFF, F.G, F.bx);
          pg8::EpiSwiglu E{WSP(pg8::bf16_t, WS_HID)};
          pg8::gemm_phase<pg8::EpiSwiglu, pg8::StaticOrder, true, true>(F.lds + RING_OFF, g, S, E, F.tid); }
#endif
        grid_bar(wv);
#ifndef NO_G4
        { Frame F; mk_frame(F, wv); LAYER_VARS;
          pg8::Gemm g{WSP(pg8::bf16_t, WS_HID), WSP(pg8::bf16_t, WS_W2 + l * W2_L), M, DM, DFF}; pg8::StaticOrder S; S.init(M, DM, F.G, F.bx);
          pg8::EpiRes E{F.out, F.out, mod + 5 * 4096};
          pg8::gemm_phase<pg8::EpiRes, pg8::StaticOrder, true, true>(F.lds + RING_OFF, g, S, E, F.tid); }
#endif
        if (l + 1 < NLAYER) grid_bar(wv);
#undef LAYER_VARS
    }
}

extern "C" void kernel_launch(void* const* d_in, const int* in_sizes, int n_in, void* d_out, int out_size, void* d_ws, size_t ws_size, hipStream_t stream) {
    static int grid = 0;
    if (grid == 0) {
        if (n_in != 35 || in_sizes[0] != M * DM || out_size != M * DM || ws_size < WS_END) { fprintf(stderr, "kernel_launch: unexpected shapes: n_in %d in0 %d out %d ws %zu (need %zu)\n", n_in, n_in > 0 ? in_sizes[0] : -1, out_size, ws_size, (size_t)WS_END); grid = -1; return; }
        int dev = 0, cus = 0, per_cu = 0;
        if (hipGetDevice(&dev) != hipSuccess || hipDeviceGetAttribute(&cus, hipDeviceAttributeMultiprocessorCount, dev) != hipSuccess) { grid = -1; return; }
        if (hipFuncSetAttribute((const void*)mega_fwd, hipFuncAttributeMaxDynamicSharedMemorySize, LDS_BYTES) != hipSuccess) { fprintf(stderr, "kernel_launch: hipFuncSetAttribute failed\n"); grid = -1; return; }
        if (hipOccupancyMaxActiveBlocksPerMultiprocessor(&per_cu, (const void*)mega_fwd, NWAVES * 64, LDS_BYTES) != hipSuccess || per_cu < 1) fprintf(stderr, "kernel_launch: occupancy query says %d\n", per_cu);
        (void)hipGetLastError();
        grid = cus;
    }
    if (grid < 0) return;
    if (hipMemsetAsync((char*)d_ws + WS_CTL, 0, CTL_ZERO_BYTES, stream) != hipSuccess) return;
    Args a{};
    for (int i = 0; i < 35; ++i) a.in[i] = (const float*)d_in[i];
    a.out = (float*)d_out; a.ws = (unsigned char*)d_ws;
    hipLaunchKernelGGL(mega_fwd, dim3(grid), dim3(NWAVES * 64), LDS_BYTES, stream, a);
}
```

```cpp
#include <hip/hip_runtime.h>
#include <cstdio>
#include <cstdint>
namespace pg8 {
#define PG8_LAS __attribute__((address_space(3)))
typedef unsigned short bf16_t;
typedef short bf16x8 __attribute__((ext_vector_type(8)));
typedef float f32x4 __attribute__((ext_vector_type(4)));
typedef unsigned u32x4 __attribute__((ext_vector_type(4)));
constexpr int BM = 256, BK = 64, HALF = 128, HTB = HALF * BK * 2  , STAGE_BYTES = 8 * HTB, NXCD = 8, WGM = 8;

__host__ __device__ __forceinline__ int lds_byte(int r, int c) { const int st = (r >> 4) * 2 + (c >> 5), rr = r & 15, cc = c & 31, ob = rr * 64 + cc * 2; return st * 1024 + (ob ^ (((ob >> 9) & 1) << 5)); }
__host__ __device__ __forceinline__ void stage_rc(int b, int& R, int& C) { const int st = b / 1024, sb = b % 1024, swz = sb ^ (((sb >> 9) & 1) << 5); R = (st >> 1) * 16 + swz / 64; C = (st & 1) * 32 + (swz % 64) / 2; }
__host__ __device__ __forceinline__ int perm32(int rho) { const int n = rho >> 4, i = rho & 15; return 8 * (i >> 2) + 4 * n + (i & 3); }

struct Unit { int pm, pn; };
struct Gemm { const bf16_t* A; const bf16_t* Bt; int M, N, K; };

struct StaticOrder {
    int nM, nN, nwg, G, c;
    __host__ __device__ void init(int M, int N, int G_, int c_) { nM = M / BM; nN = N / BM; nwg = nM * nN; G = G_; c = c_; }
    __host__ __device__ bool next(int i, Unit& u) const {
        const long L = (long)i * G + c; if (L >= nwg) return false;
        int wgid = (int)L; { const int q = nwg / NXCD, r = nwg % NXCD, xcd = wgid % NXCD, off = wgid / NXCD; wgid = (xcd < r ? xcd * (q + 1) : r * (q + 1) + (xcd - r) * q) + off; }
        const int nig = WGM * nN, gid = wgid / nig, fm = gid * WGM, gsz = (nM - fm) < WGM ? (nM - fm) : WGM;
        u.pm = fm + ((wgid % nig) % gsz); u.pn = (wgid % nig) / gsz; return true;
    }
    __device__ __forceinline__ void a_ready(const Unit&) const {}
    __device__ __forceinline__ void done(const Unit&) const {}
};

typedef float f32x2c_t __attribute__((ext_vector_type(2))); typedef __bf16 bf16x2c_t __attribute__((ext_vector_type(2)));
__device__ __forceinline__ unsigned cvt_pk_bf16(float lo, float hi) { const f32x2c_t v = {lo, hi}; return __builtin_bit_cast(unsigned, __builtin_convertvector(v, bf16x2c_t)); }
typedef float f32x2 __attribute__((ext_vector_type(2)));
__device__ __forceinline__ float silu_f(float x) { return x * __builtin_amdgcn_rcpf(1.0f + __builtin_amdgcn_exp2f(-1.4426950408889634f * x)); }
struct EpiCols {
    static constexpr bool PERM = true, AFTER_DRAIN = false;
    bf16_t* O; float* L;
    __device__ __forceinline__ void operator()(const f32x4 (&acc)[2][2][4][2], const Unit& u, int wr, int wc, int fr, int fq) const {
        const int row0 = u.pm * BM + wr * 64 + fr;
        if (u.pn < 41) {
            const int col0 = u.pn * BM + wc * 32 + 8 * fq;
#pragma unroll
            for (int ai = 0; ai < 2; ++ai)
#pragma unroll
                for (int m = 0; m < 4; ++m) { bf16_t* rowp = O + (size_t)(row0 + ai * HALF + m * 16) * 10496 + col0;
#pragma unroll
                    for (int bj = 0; bj < 2; ++bj) { const f32x4 v0 = acc[ai][bj][m][0], v1 = acc[ai][bj][m][1];
                        u32x4 w; w.x = cvt_pk_bf16(v0[0], v0[1]); w.y = cvt_pk_bf16(v0[2], v0[3]); w.z = cvt_pk_bf16(v1[0], v1[1]); w.w = cvt_pk_bf16(v1[2], v1[3]);
                        *(u32x4*)(rowp + bj * HALF) = w; } }
        } else {
            const int col0 = wc * 32 + 8 * fq;
#pragma unroll
            for (int ai = 0; ai < 2; ++ai)
#pragma unroll
                for (int m = 0; m < 4; ++m) { float* rowp = L + (size_t)(row0 + ai * HALF + m * 16) * 256 + col0;
#pragma unroll
                    for (int bj = 0; bj < 2; ++bj) { *(f32x4*)(rowp + bj * HALF) = acc[ai][bj][m][0]; *(f32x4*)(rowp + bj * HALF + 4) = acc[ai][bj][m][1]; } }
        }
    }
};
struct EpiRes {
    static constexpr bool PERM = false, AFTER_DRAIN = false;
    const float* base; float* out; const float* gate;
    __device__ __forceinline__ void operator()(const f32x4 (&acc)[2][2][4][2], const Unit& u, int wr, int wc, int fr, int fq) const {
        const int row0 = u.pm * BM + wr * 64 + fr, col0 = u.pn * BM + wc * 32 + 4 * fq;
        const float* gp = gate + (size_t)(u.pm >> 5) * 24576 + col0;
        f32x4 gv[2][2];
#pragma unroll
        for (int bj = 0; bj < 2; ++bj)
#pragma unroll
            for (int n = 0; n < 2; ++n) gv[bj][n] = *(const f32x4*)(gp + bj * HALF + n * 16);
#pragma unroll
        for (int ai = 0; ai < 2; ++ai)
#pragma unroll
            for (int m = 0; m < 4; ++m) { const size_t off = (size_t)(row0 + ai * HALF + m * 16) * 4096 + col0;
#pragma unroll
                for (int bj = 0; bj < 2; ++bj)
#pragma unroll
                    for (int n = 0; n < 2; ++n) { const f32x4 bs = *(const f32x4*)(base + off + bj * HALF + n * 16); *(f32x4*)(out + off + bj * HALF + n * 16) = bs + gv[bj][n] * acc[ai][bj][m][n]; }
                if (m & 1) asm volatile("" ::: "memory"); }
    }
};
struct EpiSwiglu {
    static constexpr bool PERM = true, AFTER_DRAIN = false;
    bf16_t* H;
    __device__ __forceinline__ void operator()(const f32x4 (&acc)[2][2][4][2], const Unit& u, int wr, int wc, int fr, int fq) const {
        const int row0 = u.pm * BM + wr * 64 + fr, col0 = u.pn * HALF + wc * 32 + 8 * fq;
#pragma unroll
        for (int ai = 0; ai < 2; ++ai)
#pragma unroll
            for (int m = 0; m < 4; ++m) { bf16_t* rowp = H + (size_t)(row0 + ai * HALF + m * 16) * 11008 + col0;
                const f32x4 a0 = acc[ai][0][m][0], a1 = acc[ai][0][m][1], b0 = acc[ai][1][m][0], b1 = acc[ai][1][m][1];
                u32x4 w; w.x = cvt_pk_bf16(silu_f(a0[0]) * b0[0], silu_f(a0[1]) * b0[1]); w.y = cvt_pk_bf16(silu_f(a0[2]) * b0[2], silu_f(a0[3]) * b0[3]);
                w.z = cvt_pk_bf16(silu_f(a1[0]) * b1[0], silu_f(a1[1]) * b1[1]); w.w = cvt_pk_bf16(silu_f(a1[2]) * b1[2], silu_f(a1[3]) * b1[3]);
                *(u32x4*)rowp = w; }
    }
};
template <class Epi, class Sched, bool ALIGN_EPI = false, bool SP2 = false>
__device__ __forceinline__ void gemm_phase(PG8_LAS unsigned char* lds, const Gemm g, const Sched& S, const Epi& E, int tid_in) {
    int tid_ = tid_in; asm volatile("" : "+v"(tid_));
    const int tid = tid_, wid = __builtin_amdgcn_readfirstlane(tid >> 6), lane = tid & 63, wr = wid >> 2, wc = wid & 3, fr = lane & 15, fq = lane >> 4;
    const int K = g.K, nt = K / BK;
    unsigned voffA[2], voffB[2];
#pragma unroll
    for (int i = 0; i < 2; ++i) { int R, C; stage_rc(tid * 16 + i * 8192, R, C); const int Rb = Epi::PERM ? ((R & ~31) + perm32(R & 31)) : R;
        voffA[i] = (unsigned)(R * K + C) * 2u; voffB[i] = (unsigned)(Rb * K + C) * 2u; }
    const size_t kstep = (size_t)(BK * 2);
    const size_t hstep = (size_t)HALF * K * 2;
    const size_t tstep = 2 * hstep;
    const unsigned ldsw = (unsigned)wid * 1024u;
    const int aoff = lds_byte(wr * 64 + fr, fq * 8), boff = lds_byte(wc * 32 + fr, fq * 8);
#define PG8_SA(b, h) (((b) * 2 + (h)) * HTB)
#define PG8_SB(b, h) ((4 + (b) * 2 + (h)) * HTB)
#define PG8_STAGE(bufoff, gbase, voff) do { _Pragma("unroll") for (int _i = 0; _i < 2; ++_i) \
        __builtin_amdgcn_global_load_lds((const unsigned*)((const char*)(gbase) + (voff)[_i]), (PG8_LAS unsigned*)(lds + (bufoff) + ldsw + _i * 8192), 16, 0, 0); } while (0)
#define PG8_LDA(dst, b, h) do { _Pragma("unroll") for (int m = 0; m < 4; ++m) _Pragma("unroll") for (int k = 0; k < 2; ++k) dst[m][k] = *(const PG8_LAS bf16x8*)(lds + PG8_SA(b, h) + aoff + m * 2048 + k * 1024); } while (0)
#define PG8_LDB(dst, b, h) do { _Pragma("unroll") for (int n = 0; n < 2; ++n) _Pragma("unroll") for (int k = 0; k < 2; ++k) dst[n][k] = *(const PG8_LAS bf16x8*)(lds + PG8_SB(b, h) + boff + n * 2048 + k * 1024); } while (0)
#define PG8_MMA(ai, bj, At, Bt) do { __builtin_amdgcn_s_setprio(1); _Pragma("unroll") for (int m = 0; m < 4; ++m) _Pragma("unroll") for (int n = 0; n < 2; ++n) _Pragma("unroll") for (int k = 0; k < 2; ++k) \
        acc[ai][bj][m][n] = __builtin_amdgcn_mfma_f32_16x16x32_bf16(Bt[n][k], At[m][k], acc[ai][bj][m][n], 0, 0, 0); __builtin_amdgcn_s_setprio(0); } while (0)
#define PG8_WAIT_V(n) asm volatile("s_waitcnt vmcnt(" #n ")" ::: "memory")
#define PG8_WAIT_L(n) asm volatile("s_waitcnt lgkmcnt(" #n ")" ::: "memory")
#define PG8_BAR __builtin_amdgcn_s_barrier()
#define PG8_SCHED __builtin_amdgcn_sched_barrier(0)
    Unit cur, nxt; int ui = 0;
    if (!S.next(0, cur)) return;
    f32x4 acc[2][2][4][2];
#pragma unroll
    for (int a = 0; a < 2; ++a)
#pragma unroll
        for (int b = 0; b < 2; ++b)
#pragma unroll
            for (int m = 0; m < 4; ++m)
#pragma unroll
                for (int n = 0; n < 2; ++n) acc[a][b][m][n] = (f32x4){0.f, 0.f, 0.f, 0.f};
    bf16x8 At[4][2], B0[2][2], B1[2][2];
    const char* cA = (const char*)g.A + (size_t)cur.pm * tstep; const char* cB = (const char*)g.Bt + (size_t)cur.pn * tstep;
    S.a_ready(cur);
    if constexpr (SP2) {
        PG8_STAGE(PG8_SB(0, 0), cB, voffB); PG8_STAGE(PG8_SB(0, 1), cB + hstep, voffB); PG8_STAGE(PG8_SA(0, 0), cA, voffA); PG8_STAGE(PG8_SA(0, 1), cA + hstep, voffA);
        if (wr == 1) PG8_BAR;
        PG8_WAIT_V(2); PG8_BAR;
        PG8_STAGE(PG8_SB(1, 0), cB + kstep, voffB); PG8_STAGE(PG8_SA(1, 0), cA + kstep, voffA); PG8_STAGE(PG8_SB(1, 1), cB + hstep + kstep, voffB);
        PG8_WAIT_V(6); PG8_BAR;
    } else {
        PG8_STAGE(PG8_SB(0, 0), cB, voffB); PG8_STAGE(PG8_SA(0, 0), cA, voffA); PG8_STAGE(PG8_SB(0, 1), cB + hstep, voffB); PG8_STAGE(PG8_SA(0, 1), cA + hstep, voffA);
        if (wr == 1) PG8_BAR;
        PG8_WAIT_V(4); PG8_BAR;
        PG8_STAGE(PG8_SB(1, 0), cB + kstep, voffB); PG8_STAGE(PG8_SA(1, 0), cA + kstep, voffA); PG8_STAGE(PG8_SB(1, 1), cB + hstep + kstep, voffB);
        PG8_WAIT_V(6); PG8_BAR;
    }
    for (;;) {
        const bool has_next = S.next(ui + 1, nxt);
        const char* nA = has_next ? (const char*)g.A + (size_t)nxt.pm * tstep : cA; const char* nB = has_next ? (const char*)g.Bt + (size_t)nxt.pn * tstep : cB;
        for (int t = 0; t < nt; t += 2) {
            const bool last = (t == nt - 2);
            const char* a1 = cA + (size_t)(t + 1) * kstep;
            const char* a2 = last ? nA : cA + (size_t)(t + 2) * kstep; const char* b2 = last ? nB : cB + (size_t)(t + 2) * kstep;
            const char* a3 = a2 + kstep; const char* b3 = b2 + kstep;
            if (last && has_next) S.a_ready(nxt);
            if constexpr (SP2) {
            PG8_LDB(B0, 0, 0); PG8_LDB(B1, 0, 1); PG8_SCHED; PG8_LDA(At, 0, 0); PG8_STAGE(PG8_SA(1, 1), a1 + hstep, voffA);
            PG8_WAIT_V(8); PG8_WAIT_L(0); PG8_BAR; PG8_MMA(0, 0, At, B0); PG8_MMA(0, 1, At, B1); PG8_BAR; PG8_SCHED;
            PG8_LDA(At, 0, 1); PG8_STAGE(PG8_SB(0, 0), b2, voffB); PG8_STAGE(PG8_SB(0, 1), b2 + hstep, voffB); PG8_STAGE(PG8_SA(0, 0), a2, voffA);
            PG8_WAIT_V(8); PG8_WAIT_L(0); PG8_BAR; PG8_MMA(1, 0, At, B0); PG8_MMA(1, 1, At, B1); PG8_BAR; PG8_SCHED;
            PG8_LDB(B0, 1, 0); PG8_LDB(B1, 1, 1); PG8_SCHED; PG8_LDA(At, 1, 0); PG8_STAGE(PG8_SA(0, 1), a2 + hstep, voffA);
            PG8_WAIT_V(8); PG8_WAIT_L(0); PG8_BAR; PG8_MMA(0, 0, At, B0); PG8_MMA(0, 1, At, B1); PG8_BAR; PG8_SCHED;
            PG8_LDA(At, 1, 1); PG8_STAGE(PG8_SB(1, 0), b3, voffB); PG8_STAGE(PG8_SB(1, 1), b3 + hstep, voffB); PG8_STAGE(PG8_SA(1, 0), a3, voffA);
            PG8_WAIT_V(8); PG8_WAIT_L(0); PG8_BAR; PG8_MMA(1, 0, At, B0); PG8_MMA(1, 1, At, B1); PG8_BAR; PG8_SCHED;
            } else {
            PG8_LDB(B0, 0, 0); PG8_SCHED; PG8_LDA(At, 0, 0); PG8_STAGE(PG8_SA(1, 1), a1 + hstep, voffA);
            PG8_WAIT_L(8); PG8_BAR; PG8_WAIT_L(0); PG8_MMA(0, 0, At, B0); PG8_BAR; PG8_SCHED;
            PG8_LDB(B1, 0, 1); PG8_STAGE(PG8_SB(0, 0), b2, voffB);
            PG8_BAR; PG8_WAIT_L(0); PG8_MMA(0, 1, At, B1); PG8_BAR;
            PG8_LDA(At, 0, 1); PG8_STAGE(PG8_SA(0, 0), a2, voffA);
            PG8_BAR; PG8_WAIT_L(0); PG8_MMA(1, 0, At, B0); PG8_BAR; PG8_SCHED;
            PG8_STAGE(PG8_SB(0, 1), b2 + hstep, voffB);
            PG8_WAIT_V(6); PG8_BAR; PG8_MMA(1, 1, At, B1); PG8_BAR;
            PG8_LDB(B0, 1, 0); PG8_SCHED; PG8_LDA(At, 1, 0); PG8_STAGE(PG8_SA(0, 1), a2 + hstep, voffA);
            PG8_WAIT_L(8); PG8_BAR; PG8_WAIT_L(0); PG8_MMA(0, 0, At, B0); PG8_BAR; PG8_SCHED;
            PG8_LDB(B1, 1, 1); PG8_STAGE(PG8_SB(1, 0), b3, voffB);
            PG8_BAR; PG8_WAIT_L(0); PG8_MMA(0, 1, At, B1); PG8_BAR;
            PG8_LDA(At, 1, 1); PG8_STAGE(PG8_SA(1, 0), a3, voffA);
            PG8_BAR; PG8_WAIT_L(0); PG8_MMA(1, 0, At, B0); PG8_BAR; PG8_SCHED;
            PG8_STAGE(PG8_SB(1, 1), b3 + hstep, voffB);
            PG8_WAIT_V(6); PG8_BAR; PG8_MMA(1, 1, At, B1); PG8_BAR;
            }
        }
        if constexpr (ALIGN_EPI) { if (wr == 0) PG8_BAR; }
        if constexpr (!Epi::AFTER_DRAIN) { E(acc, cur, wr, wc, fr, fq); S.done(cur); }
        if (!has_next) break;
#pragma unroll
        for (int a = 0; a < 2; ++a)
#pragma unroll
            for (int b = 0; b < 2; ++b)
#pragma unroll
                for (int m = 0; m < 4; ++m)
#pragma unroll
                    for (int n = 0; n < 2; ++n) acc[a][b][m][n] = (f32x4){0.f, 0.f, 0.f, 0.f};
        cur = nxt; cA = nA; cB = nB; ++ui;
        if constexpr (ALIGN_EPI) { if (wr == 1) PG8_BAR; }
    }
    PG8_WAIT_V(0);
    if constexpr (!ALIGN_EPI) { if (wr == 0) PG8_BAR; }
    PG8_BAR;
    if constexpr (Epi::AFTER_DRAIN) { E.fused(acc, cur, wr, wc, fr, fq, lds, wid, lane); S.done(cur); }
#undef PG8_SA
#undef PG8_SB
#undef PG8_STAGE
#undef PG8_LDA
#undef PG8_LDB
#undef PG8_MMA
#undef PG8_WAIT_V
#undef PG8_WAIT_L
#undef PG8_BAR
#undef PG8_SCHED
}
}
constexpr int BATCH = 2, SEQ = 8192, DM = 4096, M = BATCH * SEQ, DFF = 11008, NLAYER = 2;
constexpr int P_IN = 10704, NIN = 10752, NMAIN = 10496;
constexpr int CA_Q = 0, CA_K = 1024, CA_V = 2048;
constexpr int CB_Q = 3072, CB_K = 3584, CB_V = 4096, CB_G = 5120;
constexpr int CC_R = 6144, CC_K = 7168, CC_V = 8192;
constexpr int CD_Q = 9216, CD_K = 10240, CD_V = 10368;
constexpr float LOG2E = 1.4426950408889634f;
constexpr float QSCALE = 0.125f * LOG2E;
constexpr int NWAVES = 8;

constexpr size_t MiB = 1u << 20;
constexpr size_t WS_CTL = 0, CTL_ZERO_BYTES = 1 * MiB;
constexpr size_t WS_MODP = 2 * MiB;
constexpr size_t WS_MOD = 14 * MiB;
constexpr size_t WS_TAB = 15 * MiB;
constexpr size_t WS_WIN = 16 * MiB, WIN_L = 84 * MiB;
constexpr size_t WS_WOUT = 184 * MiB, WOUT_L = 32 * MiB;
constexpr size_t WS_W13 = 248 * MiB, W13_L = 172 * MiB;
constexpr size_t WS_W2 = 592 * MiB, W2_L = 86 * MiB;
constexpr size_t WS_XN = 764 * MiB;
constexpr size_t WS_COLS = 892 * MiB;
constexpr size_t WS_LOWR = 1220 * MiB;
constexpr size_t WS_HID = 892 * MiB;
constexpr size_t WS_QKA = 1236 * MiB;
constexpr size_t WS_QKD = 1300 * MiB;
constexpr size_t WS_LOGA = 1336 * MiB;
constexpr size_t WS_RW = 1368 * MiB, RW_ONE = 64 * MiB;
constexpr size_t WS_VFIRST = 1816 * MiB;
constexpr size_t WS_MIXED = 1880 * MiB;
constexpr size_t WS_VTA = 2008 * MiB;
constexpr size_t WS_VTD = 2040 * MiB;
constexpr size_t WS_QDEC = 2044 * MiB, WS_KDT = 2060 * MiB, WS_AM = 2076 * MiB, WS_EBL = 2084 * MiB;
constexpr size_t WS_VTB = 2086 * MiB, WS_GTB = 2118 * MiB;
constexpr size_t WS_RWC = 2150 * MiB;
constexpr size_t WS_END = 2476 * MiB;
constexpr int CW_BAR = 4096;
constexpr int CW_Q = 16384;

constexpr int RING_OFF = 0, RING_BYTES = 131072;
constexpr int LDSCTL_OFF = RING_BYTES, MISC_OFF = LDSCTL_OFF + 320;
constexpr int LDS_BYTES = 147456;

#define GAS __attribute__((address_space(1)))
#define LAS __attribute__((address_space(3)))
typedef unsigned short bf16;
typedef unsigned v4u __attribute__((ext_vector_type(4)));
typedef unsigned v2u __attribute__((ext_vector_type(2)));
typedef float f32x4 __attribute__((ext_vector_type(4)));
typedef short bf16x8 __attribute__((ext_vector_type(8)));
typedef GAS unsigned gu32;
#define RLX_AGENT __ATOMIC_RELAXED, __HIP_MEMORY_SCOPE_AGENT
#define LDS_WAIT() asm volatile("s_waitcnt lgkmcnt(0)" ::: "memory")
#define VM_WAIT() asm volatile("s_waitcnt vmcnt(0)" ::: "memory")
typedef float f32x2_t __attribute__((ext_vector_type(2))); typedef __bf16 bf16x2_t __attribute__((ext_vector_type(2)));
__device__ __forceinline__ unsigned pk2(float lo, float hi) { const f32x2_t v = {lo, hi}; return __builtin_bit_cast(unsigned, __builtin_convertvector(v, bf16x2_t)); }
__device__ __forceinline__ unsigned f2bf(float f) { return pk2(f, f) & 0xffffu; }
__device__ __forceinline__ float bf2f(unsigned short h) { return __builtin_bit_cast(float, (unsigned)h << 16); }
__device__ __forceinline__ float bflo(unsigned w) { return __builtin_bit_cast(float, w << 16); }
__device__ __forceinline__ float bfhi(unsigned w) { return __builtin_bit_cast(float, w & 0xffff0000u); }
template <int CTRL> __device__ __forceinline__ float dpp_f(float v) { return __builtin_bit_cast(float, __builtin_amdgcn_update_dpp(0, __builtin_bit_cast(int, v), CTRL, 0xF, 0xF, true)); }
__device__ __forceinline__ float sum8(float v) {
    v += dpp_f<0xB1>(v); v += dpp_f<0x4E>(v); v += dpp_f<0x141>(v); return v; }
__device__ __forceinline__ float wave_sum(float v) {
    v = sum8(v); v += dpp_f<0x140>(v);
    v += __builtin_bit_cast(float, __builtin_amdgcn_ds_swizzle(__builtin_bit_cast(int, v), 0x401F));
    { const int u = __builtin_bit_cast(int, v); v = __builtin_bit_cast(float, __builtin_amdgcn_readlane(u, 0)) + __builtin_bit_cast(float, __builtin_amdgcn_readlane(u, 32)); }
    return v;
}
__device__ __forceinline__ float sigmoid_f(float x) { return __builtin_amdgcn_rcpf(1.0f + __builtin_amdgcn_exp2f(-LOG2E * x)); }
__device__ __forceinline__ float silu_g(float x) { return x * sigmoid_f(x); }

#define XB_TMO      128
#define XB_XCNT(j)  (256  + 64 * (j))
#define XB_XSUB(j)  (1280 + 64 * (j))
#define XB_XGEN(j)  (2304 + 64 * (j))
#define XB_TOP      3328
#define XB_TOPGEN   3392
#define XCD_BAR_WORDS 3456
#define XB_SPIN_CAP (1u << 23)

__device__ __forceinline__ unsigned xb_ld(unsigned* p)              { return __hip_atomic_load(p, __ATOMIC_RELAXED, __HIP_MEMORY_SCOPE_AGENT); }
__device__ __forceinline__ unsigned xb_add(unsigned* p, unsigned v) { return __hip_atomic_fetch_add(p, v, __ATOMIC_RELAXED, __HIP_MEMORY_SCOPE_AGENT); }
__device__ __forceinline__ unsigned xb_xcc_id() { return (unsigned)__builtin_amdgcn_s_getreg((3 << 11) | 20) & 0xFu; }
#define XB_SPIN(cond, bar) do { unsigned _sp = 0; while (cond) { __builtin_amdgcn_s_sleep(1); \
    if ((++_sp & 255u) == 0u) { if (xb_ld(&(bar)[XB_TMO])) break; if (_sp > XB_SPIN_CAP) { atomicAdd(&(bar)[XB_TMO], 1u); break; } } } } while (0)

struct XcdBarrier {
    unsigned* bar; unsigned x;
    volatile LAS unsigned* st;
};

__device__ __forceinline__ XcdBarrier xcd_barrier_post(unsigned* bar, volatile LAS unsigned* st) {
    XcdBarrier b; b.bar = bar; b.x = xb_xcc_id(); b.st = st;
    if (threadIdx.x == 0) (void)xb_add(&bar[XB_XCNT(b.x)], 1u);
    return b;
}
__device__ __forceinline__ void xcd_barrier_complete(unsigned* bar, unsigned x, unsigned& nloc, unsigned& nx) {
    const unsigned G = gridDim.x * gridDim.y * gridDim.z;
    unsigned sum, cnt, mine, sp = 0u;
    for (;;) {
        sum = 0u; cnt = 0u; mine = 0u;
#pragma unroll
        for (unsigned j = 0; j < 16; ++j) { const unsigned c = xb_ld(&bar[XB_XCNT(j)]); sum += c; cnt += (c > 0u) ? 1u : 0u; mine = (j == x) ? c : mine; }
        if (sum == G) break;
        __builtin_amdgcn_s_sleep(1);
        if ((++sp & 255u) == 0u) { if (xb_ld(&bar[XB_TMO])) break; if (sp > XB_SPIN_CAP) { atomicAdd(&bar[XB_TMO], 1u); break; } }
    }
    nloc = mine > 0u ? mine : 1u; nx = cnt > 0u ? cnt : 1u;
}

__device__ __forceinline__ void xcd_barrier(const XcdBarrier& b) {
    asm volatile("s_waitcnt vmcnt(0)" ::: "memory");
    __syncthreads();
    if (threadIdx.x == 0) {
        unsigned* bar = b.bar;
        __builtin_amdgcn_s_waitcnt(0);
        unsigned nloc = b.st[0], nx = b.st[1];
        if (nloc == 0u) { xcd_barrier_complete(bar, b.x, nloc, nx); b.st[0] = nloc; b.st[1] = nx; }
        const unsigned old = xb_add(&bar[XB_XSUB(b.x)], 1u);
        const unsigned gen = old / nloc;
        if (old + 1u == (gen + 1u) * nloc) {
            __builtin_amdgcn_fence(__ATOMIC_RELEASE, "agent");
            asm volatile("s_waitcnt vmcnt(0)" ::: "memory");
            const unsigned og = xb_add(&bar[XB_TOP], 1u);
            const unsigned tg = og / nx;
            if (og + 1u == (tg + 1u) * nx) xb_add(&bar[XB_TOPGEN], 1u);
            else XB_SPIN(xb_ld(&bar[XB_TOPGEN]) == tg, bar);
            __builtin_amdgcn_fence(__ATOMIC_ACQUIRE, "agent");
            xb_add(&bar[XB_XGEN(b.x)], 1u);
            asm volatile("s_waitcnt vmcnt(0)" ::: "memory");
        } else {
            XB_SPIN(xb_ld(&bar[XB_XGEN(b.x)]) == gen, bar);
            __builtin_amdgcn_fence(__ATOMIC_ACQUIRE, "agent");
            asm volatile("s_waitcnt vmcnt(0)" ::: "memory");
        }
    }
    __syncthreads();
}

typedef const float* const __attribute__((address_space(4)))* kargp;
struct Frame {
    LAS unsigned char* lds;
    volatile LAS unsigned* MISC;
    gu32* ctl;
    int tid, lane, wave;
    int vcu, G, bx;
    kargp kin;
    float* out;
    unsigned char* ws;
};
enum { I_X = 0, I_C, I_RELB, I_ADAW, I_ADAB, I_WIN, I_WOUT, I_DQN, I_DKN, I_DLAM, I_DSUB, I_GGU, I_GGB, I_GON, I_RMU, I_RWUP, I_RW0, I_RAUP, I_RA0, I_RGUP,
       I_RKK, I_RKA, I_RRK, I_RLNW, I_RLNB, I_VRD, I_VRMU, I_VRUP, I_VR0, I_SQN, I_SKN, I_SSINK, I_W1, I_W3, I_W2 };

#define WSP(T, off) ((T*)(F.ws + (off)))
__device__ __forceinline__ void relaunder_tid(Frame& F) { int t = F.tid; asm volatile("" : "+v"(t)); F.tid = t; F.lane = t & 63; F.wave = __builtin_amdgcn_readfirstlane(t >> 6); }
__device__ __forceinline__ void relaunder(Frame& F) { kargp p = F.kin; asm volatile("" : "+s"(p)); F.kin = p; }

__device__ __forceinline__ void conv_item(const float* src, int ld, int col0, int ncols, int K, bf16* WT, int row0, int kb, LAS float* scr, int lane) {
    const int k0 = 64 * kb;
    { const int n = lane & 31; const bool ok = src != nullptr && n < ncols; const float* sp = src + (size_t)(k0 + (lane >> 5)) * ld + col0 + n; float v[32];
#pragma unroll
      for (int i = 0; i < 32; ++i) v[i] = ok ? sp[(size_t)(2 * i) * ld] : 0.f;
#pragma unroll
      for (int i = 0; i < 32; ++i) scr[(2 * i + (lane >> 5)) * 33 + n] = v[i]; }
    LDS_WAIT(); asm volatile("" ::: "memory");
    const int c = lane & 7;
#pragma unroll
    for (int j = 0; j < 4; ++j) { const int n = (lane >> 3) + 8 * j; const LAS float* s = scr + (8 * c) * 33 + n;
        v4u o; o.x = pk2(s[0 * 33], s[1 * 33]); o.y = pk2(s[2 * 33], s[3 * 33]); o.z = pk2(s[4 * 33], s[5 * 33]); o.w = pk2(s[6 * 33], s[7 * 33]);
        if (n < ncols) *(GAS v4u*)(WT + (size_t)(row0 + n) * K + k0 + 8 * c) = o; }
    LDS_WAIT(); asm volatile("" ::: "memory");
}
__device__ __forceinline__ int t5_bucket(int d) {
    if (d < 16) return d;
    int v = 16 + (int)(logf((float)d * (1.0f / 16.0f)) / logf(8.0f) * 16.0f);
    return v < 31 ? v : 31;
}
__device__ __forceinline__ void p0_prologue_a(Frame& F) {
    const int gw = F.vcu * NWAVES + F.wave, NGW = F.G * NWAVES;
    LAS float* ldsf = (LAS float*)(F.lds + RING_OFF);
    for (int i = F.tid; i < 2 * DM; i += NWAVES * 64) ldsf[i] = silu_g(F.kin[I_C][i]);
    __syncthreads();
    float* MODP = WSP(float, WS_MODP);
    for (int it = gw; it < 6144; it += NGW) {
        const int l = it / 3072, rem = it % 3072, kc = rem / 96, ng = rem % 96, n0 = 256 * ng + 4 * F.lane;
        const float* w = F.kin[I_ADAW] + ((size_t)l * DM + kc * 128) * 24576 + n0;
        f32x4 a0 = {0.f, 0.f, 0.f, 0.f}, a1 = {0.f, 0.f, 0.f, 0.f};
#pragma unroll 16
        for (int k = 0; k < 128; ++k) { const f32x4 wv = *(const f32x4*)(w + (size_t)k * 24576); const float s0 = ldsf[kc * 128 + k], s1 = ldsf[DM + kc * 128 + k]; a0 += wv * s0; a1 += wv * s1; }
        *(f32x4*)(MODP + ((size_t)(l * 32 + kc) * 2 + 0) * 24576 + n0) = a0;
        *(f32x4*)(MODP + ((size_t)(l * 32 + kc) * 2 + 1) * 24576 + n0) = a1;
    }
    __syncthreads();
    LAS float* scr = (LAS float*)(F.lds + RING_OFF + F.wave * 16384);
    constexpr int I_IN = 337 * 64, I_OUT = 128 * 64, I_13 = 688 * 64, I_2 = 128 * 172, I_L = I_IN + I_OUT + I_13 + I_2;
    for (int it = gw; it < NLAYER * I_L; it += NGW) {
        const int l = it / I_L; int r = it % I_L;
        if (r < I_IN) {
            const int kb = r / 337, cb = r % 337; const float* src = F.kin[I_WIN] + (size_t)l * DM * P_IN; int ld = P_IN, col0, row0, nc = 32;
            if (cb < 192) { col0 = 32 * cb; row0 = 32 * cb; }
            else if (cb < 288) { col0 = 6160 + 32 * (cb - 192); row0 = 6144 + 32 * (cb - 192); }
            else if (cb < 328) { col0 = 9424 + 32 * (cb - 288); row0 = 9216 + 32 * (cb - 288); }
            else if (cb == 328) { col0 = 6144; row0 = 10496; nc = 16; }
            else if (cb < 335) { col0 = 9232 + 32 * (cb - 329); row0 = 10512 + 32 * (cb - 329); }
            else if (cb == 335) { src = l ? F.kin[I_VRD] + (size_t)(l - 1) * DM * 32 : nullptr; ld = 32; col0 = 0; row0 = 10704; }
            else { src = nullptr; col0 = 0; row0 = 10736; nc = 16; }
            conv_item(src, ld, col0, nc, DM, WSP(bf16, WS_WIN + l * WIN_L), row0, kb, scr, F.lane); continue; }
        r -= I_IN;
        if (r < I_OUT) { const int kb = r / 128, cb = r % 128; conv_item(F.kin[I_WOUT] + (size_t)l * DM * DM, DM, 32 * cb, 32, DM, WSP(bf16, WS_WOUT + l * WOUT_L), 32 * cb, kb, scr, F.lane); continue; }
        r -= I_OUT;
        if (r < I_13) { const int kb = r / 688, cb = r % 688, pn = cb >> 3, wi = cb & 7;
            const float* src = (wi < 4 ? F.kin[I_W1] : F.kin[I_W3]) + (size_t)l * DM * DFF;
            conv_item(src, DFF, 128 * pn + 32 * (wi & 3), 32, DM, WSP(bf16, WS_W13 + l * W13_L), 32 * cb, kb, scr, F.lane); continue; }
        r -= I_13;
        { const int kb = r / 128, cb = r % 128; conv_item(F.kin[I_W2] + (size_t)l * DFF * DM, DM, 32 * cb, 32, DFF, WSP(bf16, WS_W2 + l * W2_L), 32 * cb, kb, scr, F.lane); }
    }
}
__device__ __forceinline__ void p0_prologue_b(Frame& F) {
    const int gt = F.bx * (NWAVES * 64) + F.tid, NT = F.G * NWAVES * 64;
    const float* MODP = WSP(float, WS_MODP); float* MOD = WSP(float, WS_MOD);
    for (int idx = gt; idx < NLAYER * 2 * 24576; idx += NT) {
        const int l = idx / 49152, rem = idx % 49152, b = rem / 24576, n = rem % 24576;
        float s = F.kin[I_ADAB][l * 24576 + n];
#pragma unroll 8
        for (int kc = 0; kc < 32; ++kc) s += MODP[((size_t)(l * 32 + kc) * 2 + b) * 24576 + n];
        MOD[idx] = s;
    }
    if (F.bx == 0) { float* TAB = WSP(float, WS_TAB);
        for (int i = F.tid; i < 24 * 128; i += NWAVES * 64) { const int hh = i >> 7, d = i & 127; TAB[i] = F.kin[I_RELB][t5_bucket(d) * 24 + hh] * LOG2E; } }
}
__device__ __forceinline__ void rms_phase(Frame& F, const float* xin, const float* sh, const float* sc) {
    const int gw = F.vcu * NWAVES + F.wave, NGW = F.G * NWAVES;
    bf16* XN = WSP(bf16, WS_XN);
    for (int m = gw; m < M; m += NGW) {
        const int b = m >> 13;
        const f32x4* xr = (const f32x4*)(xin + (size_t)m * DM) + F.lane;
        f32x4 v[16]; float ss = 0.f;
#pragma unroll
        for (int j = 0; j < 16; ++j) { v[j] = xr[64 * j]; ss += (v[j].x * v[j].x + v[j].y * v[j].y) + (v[j].z * v[j].z + v[j].w * v[j].w); }
        const float rstd = rsqrtf(wave_sum(ss) * (1.0f / DM) + 1e-6f);
        const f32x4* scp = (const f32x4*)(sc + (size_t)b * 24576) + F.lane; const f32x4* shp = (const f32x4*)(sh + (size_t)b * 24576) + F.lane;
        v2u* o8 = (v2u*)(XN + (size_t)m * DM) + F.lane;
#pragma unroll
        for (int j = 0; j < 16; ++j) { const f32x4 s4 = scp[64 * j], h4 = shp[64 * j]; const f32x4 o = v[j] * rstd * (s4 + 1.0f) + h4;
            v2u w; w.x = pk2(o.x, o.y); w.y = pk2(o.z, o.w); o8[64 * j] = w; }
    }
}
__device__ __forceinline__ void unpack8(const v4u r, float (&f)[8]) { f[0] = bflo(r.x); f[1] = bfhi(r.x); f[2] = bflo(r.y); f[3] = bfhi(r.y); f[4] = bflo(r.z); f[5] = bfhi(r.z); f[6] = bflo(r.w); f[7] = bfhi(r.w); }
__device__ __forceinline__ v4u pack8(const float (&f)[8]) { v4u o; o.x = pk2(f[0], f[1]); o.y = pk2(f[2], f[3]); o.z = pk2(f[4], f[5]); o.w = pk2(f[6], f[7]); return o; }
__device__ __forceinline__ void prep_norm(Frame& F, int l) {
    const int gw = F.vcu * NWAVES + F.wave, NGW = F.G * NWAVES, lane = F.lane, sub = lane >> 3, ch = lane & 7;
    float gqa[8], gka[8], gqd[8], gkd[8];
#pragma unroll
    for (int e = 0; e < 8; ++e) { gqa[e] = F.kin[I_DQN][l * 64 + ch * 8 + e] * QSCALE; gka[e] = F.kin[I_DKN][l * 64 + ch * 8 + e];
                                  gqd[e] = F.kin[I_SQN][l * 64 + ch * 8 + e] * QSCALE; gkd[e] = F.kin[I_SKN][l * 64 + ch * 8 + e]; }
    const bf16* COLS = WSP(bf16, WS_COLS); bf16* QKA = WSP(bf16, WS_QKA); bf16* QKD = WSP(bf16, WS_QKD);
    for (int m = gw; m < M; m += NGW) {
        const bf16* src = COLS + (size_t)m * NMAIN;
#pragma unroll
        for (int i = 0; i < 4; ++i) { const int vec = i * 8 + sub, col = vec * 64 + ch * 8;
            float f[8]; unpack8(*(const v4u*)(src + CA_Q + col), f); float ss = 0.f;
#pragma unroll
            for (int e = 0; e < 8; ++e) ss += f[e] * f[e];
            ss = sum8(ss);
            const float rstd = rsqrtf(ss * (1.0f / 64.0f) + 1e-6f);
#pragma unroll
            for (int e = 0; e < 8; ++e) f[e] = f[e] * rstd * (i < 2 ? gqa[e] : gka[e]);
            *(v4u*)(QKA + (size_t)m * 2048 + col) = pack8(f); }
#pragma unroll
        for (int i = 0; i < 3; ++i) { const int vec = i * 8 + sub, col = vec * 64 + ch * 8;
            if (vec < 18) { float f[8]; unpack8(*(const v4u*)(src + CD_Q + col), f); float ss = 0.f;
#pragma unroll
                for (int e = 0; e < 8; ++e) ss += f[e] * f[e];
                ss = sum8(ss);
                const float rstd = rsqrtf(ss * (1.0f / 64.0f) + 1e-6f);
#pragma unroll
                for (int e = 0; e < 8; ++e) f[e] = f[e] * rstd * (vec < 16 ? gqd[e] : gkd[e]);
                *(v4u*)(QKD + (size_t)m * 1152 + col) = pack8(f); } }
    }
}
__device__ __forceinline__ void prep_loga(Frame& F, int l) {
    LAS float* gdl = (LAS float*)(F.lds + RING_OFF);
    float gu[16];
#pragma unroll
    for (int j = 0; j < 16; ++j) gu[j] = F.kin[I_GGU][((size_t)l * 16 + j) * 512 + F.tid];
    const float bias = F.kin[I_GGB][l * 512 + F.tid];
    const float* LOWR = WSP(float, WS_LOWR); float* LOGA = WSP(float, WS_LOGA);
    for (int tile = F.bx; tile < M / 64; tile += F.G) {
        const size_t row0 = (size_t)tile * 64;
        __syncthreads();
#pragma unroll
        for (int i = 0; i < 2; ++i) { const int idx = F.tid + 512 * i; gdl[idx] = LOWR[(row0 + (idx >> 4)) * 256 + (idx & 15)]; }
        __syncthreads();
#pragma unroll 4
        for (int t = 0; t < 64; ++t) { const LAS f32x4* gp = (const LAS f32x4*)(gdl + t * 16); const f32x4 g0 = gp[0], g1 = gp[1], g2 = gp[2], g3 = gp[3];
            float z = bias + g0.x * gu[0] + g0.y * gu[1] + g0.z * gu[2] + g0.w * gu[3] + g1.x * gu[4] + g1.y * gu[5] + g1.z * gu[6] + g1.w * gu[7]
                    + g2.x * gu[8] + g2.y * gu[9] + g2.z * gu[10] + g2.w * gu[11] + g3.x * gu[12] + g3.y * gu[13] + g3.z * gu[14] + g3.w * gu[15];
            LOGA[(row0 + t) * 512 + F.tid] = (fminf(z, 0.f) - __logf(1.0f + __expf(-fabsf(z)))) * (1.0f / 16.0f); }
    }
}
__device__ __forceinline__ void prep_rwkv(Frame& F, int l) {
    LAS float* wst = (LAS float*)(F.lds + RING_OFF) + 4096;
    LAS float* in = (LAS float*)(F.lds + RING_OFF);
    const float* mu = F.kin[I_RMU] + (size_t)l * 3264;
    const float* LOWR = WSP(float, WS_LOWR); const bf16* COLS = WSP(bf16, WS_COLS);
    float* RW = WSP(float, WS_RW); float* VF = WSP(float, WS_VFIRST);
    constexpr size_t RS = RW_ONE / 4;
    for (int tile = F.bx; tile < M / 16; tile += F.G) {
        const int row0 = tile * 16;
        __syncthreads();
        for (int idx = F.tid; idx < 16 * 224; idx += NWAVES * 64) { const int tt = idx / 224, j = idx % 224, row = row0 + tt, t = row & (SEQ - 1);
            const int col = j < 192 ? 16 + j : 208 + (j - 192);
            const float cur = LOWR[(size_t)row * 256 + col], prev = t > 0 ? LOWR[(size_t)(row - 1) * 256 + col] : 0.f;
            const float muv = j < 192 ? mu[3072 + j] : (l ? F.kin[I_VRMU][(l - 1) * 32 + (j - 192)] : 0.f);
            float x = cur + (prev - cur) * muv;
            if (j < 64) x = tanhf(x); else if (j >= 128 && j < 192) x = sigmoid_f(x);
            in[j * 16 + tt] = x; }
        __syncthreads();
#pragma unroll 1
        for (int pass = 0; pass < 2; ++pass) {
            const int c = pass * 512 + F.tid;
            float accw[16], acca[16], accg[16], accv[16];
            { const float bw = F.kin[I_RW0][l * 1024 + c], ba = F.kin[I_RA0][l * 1024 + c], bv = l ? F.kin[I_VR0][(l - 1) * 1024 + c] : 0.f;
#pragma unroll
              for (int tt = 0; tt < 16; ++tt) { accw[tt] = bw; acca[tt] = ba; accg[tt] = 0.f; accv[tt] = bv; } }
#define LOWRANK_ACC(ACC, WPTR, JOFF, NJ) do { const float* wp_ = (WPTR) + c; float nx_[16]; \
            _Pragma("unroll") for (int j_ = 0; j_ < 16; ++j_) nx_[j_] = wp_[(size_t)j_ * 1024]; \
            _Pragma("unroll 1") for (int jb = 0; jb < (NJ) / 16; ++jb) { LAS float* wl_ = wst + (jb & 1) * 8192 + F.tid; \
                _Pragma("unroll") for (int j_ = 0; j_ < 16; ++j_) wl_[j_ * 512] = nx_[j_]; \
                if (jb + 1 < (NJ) / 16) { _Pragma("unroll") for (int j_ = 0; j_ < 16; ++j_) nx_[j_] = wp_[(size_t)((jb + 1) * 16 + j_) * 1024]; } \
                _Pragma("unroll 2") for (int j_ = 0; j_ < 16; ++j_) { const float w_ = wl_[j_ * 512]; const LAS f32x4* ip_ = (const LAS f32x4*)(in + ((JOFF) + jb * 16 + j_) * 16); \
                    const f32x4 i0 = ip_[0], i1 = ip_[1], i2 = ip_[2], i3 = ip_[3]; \
                    ACC[0] += i0.x * w_; ACC[1] += i0.y * w_; ACC[2] += i0.z * w_; ACC[3] += i0.w * w_; ACC[4] += i1.x * w_; ACC[5] += i1.y * w_; ACC[6] += i1.z * w_; ACC[7] += i1.w * w_; \
                    ACC[8] += i2.x * w_; ACC[9] += i2.y * w_; ACC[10] += i2.z * w_; ACC[11] += i2.w * w_; ACC[12] += i3.x * w_; ACC[13] += i3.y * w_; ACC[14] += i3.z * w_; ACC[15] += i3.w * w_; } } } while (0)
            relaunder(F); LOWRANK_ACC(accw, F.kin[I_RWUP] + (size_t)l * 64 * 1024, 0, 64);
            relaunder(F); LOWRANK_ACC(acca, F.kin[I_RAUP] + (size_t)l * 64 * 1024, 64, 64);
            relaunder(F); LOWRANK_ACC(accg, F.kin[I_RGUP] + (size_t)l * 64 * 1024, 128, 64);
            relaunder(F); if (l) LOWRANK_ACC(accv, F.kin[I_VRUP] + (size_t)(l - 1) * 32 * 1024, 192, 32);
#undef LOWRANK_ACC
            relaunder(F);
            const float mur = F.kin[I_RMU][l * 3264 + c], muk = F.kin[I_RMU][l * 3264 + 1024 + c], muv = F.kin[I_RMU][l * 3264 + 2048 + c], kkv = F.kin[I_RKK][l * 1024 + c], kav = F.kin[I_RKA][l * 1024 + c];
            float pr = 0.f, pk = 0.f, pv = 0.f;
            if ((row0 & (SEQ - 1)) != 0) { const bf16* p = COLS + (size_t)(row0 - 1) * NMAIN + c; pr = bf2f(p[CC_R]); pk = bf2f(p[CC_K]); pv = bf2f(p[CC_V]); }
#pragma unroll
            for (int tt = 0; tt < 16; ++tt) { const int row = row0 + tt; const bf16* p = COLS + (size_t)row * NMAIN + c;
                const float cr = bf2f(p[CC_R]), ck = bf2f(p[CC_K]), cv = bf2f(p[CC_V]);
                const float r = cr + (pr - cr) * mur, k = ck + (pk - ck) * muk; float v = cv + (pv - cv) * muv;
                pr = cr; pk = ck; pv = cv;
                const size_t o = (size_t)row * 1024 + c;
                if (l == 0) VF[o] = v; else { const float vg = sigmoid_f(accv[tt]); v = v + (VF[o] - v) * vg; }
                const float dec = __expf(-0.6065306597126334f * sigmoid_f(accw[tt]));
                const float a = sigmoid_f(acca[tt]);
                float kk = k * kkv; const float ss = wave_sum(kk * kk); kk = kk / fmaxf(sqrtf(ss), 1e-12f);
                const float km = k * (1.0f + (a - 1.0f) * kav);
                RW[o] = r; RW[RS + o] = dec; RW[2 * RS + o] = km; RW[3 * RS + o] = v; RW[4 * RS + o] = -kk; RW[5 * RS + o] = kk * a; RW[6 * RS + o] = accg[tt]; }
        }
    }
}
__device__ __forceinline__ void diff_unit_v1(Frame& F, int l, int b, int h, int qt) {
    LAS float* ldsf = (LAS float*)(F.lds + RING_OFF);
    LAS float* Kt = ldsf; LAS float* Vt = ldsf + 8192; LAS float* Bt = ldsf + 16640;
    const int p = F.wave >> 2, dq = F.wave & 3, lane = F.lane, q0 = qt * 64, qpos = q0 + lane;
    const bf16* QKA = WSP(bf16, WS_QKA); const bf16* COLS = WSP(bf16, WS_COLS); const float* TAB = WSP(float, WS_TAB);
    float q[64];
    { const bf16* qp = QKA + (size_t)(b * SEQ + qpos) * 2048 + h * 128 + p * 64;
#pragma unroll
      for (int i = 0; i < 8; ++i) { float f[8]; unpack8(*(const v4u*)(qp + 8 * i), f);
#pragma unroll
          for (int e = 0; e < 8; ++e) q[8 * i + e] = f[e]; } }
    float lam_init = 0.8f - 0.6f * __expf(-0.3f * (float)l), lam_full;
    { const float* lm = F.kin[I_DLAM] + (size_t)l * 256; const float s1 = wave_sum(lm[lane] * lm[64 + lane]), s2 = wave_sum(lm[128 + lane] * lm[192 + lane]); lam_full = __expf(s1) - __expf(s2) + lam_init; }
    float o[32];
#pragma unroll
    for (int i = 0; i < 32; ++i) o[i] = 0.f;
    float mx = -1e30f, lsum = 0.f;
    if (F.tid < 128) Bt[F.tid] = TAB[h * 128 + F.tid];
    for (int kt = 0; kt <= qt; ++kt) {
        __syncthreads();
        { const int key = F.tid >> 3, chn = F.tid & 7; const size_t krow = (size_t)(b * SEQ + kt * 64 + key);
          const bf16* kp = QKA + krow * 2048 + 1024 + h * 128 + chn * 16; const bf16* vp = COLS + krow * NMAIN + CA_V + h * 128 + chn * 16;
          float f[8];
          unpack8(*(const v4u*)kp, f);
#pragma unroll
          for (int e = 0; e < 8; ++e) Kt[key * 128 + chn * 16 + e] = f[e];
          unpack8(*(const v4u*)(kp + 8), f);
#pragma unroll
          for (int e = 0; e < 8; ++e) Kt[key * 128 + chn * 16 + 8 + e] = f[e];
          unpack8(*(const v4u*)vp, f);
#pragma unroll
          for (int e = 0; e < 8; ++e) Vt[key * 128 + chn * 16 + e] = f[e];
          unpack8(*(const v4u*)(vp + 8), f);
#pragma unroll
          for (int e = 0; e < 8; ++e) Vt[key * 128 + chn * 16 + 8 + e] = f[e]; }
        __syncthreads();
        const int kbase = kt * 64;
#pragma unroll 2
        for (int j = 0; j < 64; ++j) {
            const int dist = qpos - (kbase + j);
            const LAS f32x4* kp = (const LAS f32x4*)(Kt + j * 128 + p * 64);
            float s0 = 0.f, s1 = 0.f;
#pragma unroll
            for (int d = 0; d < 16; d += 2) { const f32x4 k0 = kp[d], k1 = kp[d + 1];
                s0 += q[4 * d] * k0.x + q[4 * d + 1] * k0.y + q[4 * d + 2] * k0.z + q[4 * d + 3] * k0.w;
                s1 += q[4 * d + 4] * k1.x + q[4 * d + 5] * k1.y + q[4 * d + 6] * k1.z + q[4 * d + 7] * k1.w; }
            if (dist >= 0) {
                const float s = s0 + s1 + Bt[dist < 127 ? dist : 127];
                if (s > mx) { const float sc = __builtin_amdgcn_exp2f(mx - s); lsum *= sc;
#pragma unroll
                    for (int i = 0; i < 32; ++i) o[i] *= sc;
                    mx = s; }
                const float pw = __builtin_amdgcn_exp2f(s - mx); lsum += pw;
                const LAS f32x4* vp = (const LAS f32x4*)(Vt + j * 128 + dq * 32);
#pragma unroll
                for (int i = 0; i < 8; ++i) { const f32x4 v4 = vp[i]; o[4 * i] += pw * v4.x; o[4 * i + 1] += pw * v4.y; o[4 * i + 2] += pw * v4.z; o[4 * i + 3] += pw * v4.w; }
            }
        }
    }
    __syncthreads();
    LAS float* E = ldsf;
    { const float inv = 1.0f / lsum;
#pragma unroll
      for (int i = 0; i < 32; ++i) E[(p * 64 + lane) * 129 + dq * 32 + i] = o[i] * inv; }
    __syncthreads();
    { const int qq = F.tid >> 3, part = F.tid & 7; float dv[16]; float ss = 0.f;
#pragma unroll
      for (int i = 0; i < 16; ++i) { const int c = part * 16 + i; const float d = E[qq * 129 + c] - lam_full * E[(64 + qq) * 129 + c]; dv[i] = d; ss += d * d; }
      ss = sum8(ss);
      const float rstd = rsqrtf(ss * (1.0f / 128.0f) + 1e-6f) * (1.0f - lam_init);
      const float* sl = F.kin[I_DSUB] + l * 128 + part * 16;
      float f[8]; bf16* op = WSP(bf16, WS_MIXED) + (size_t)(b * SEQ + q0 + qq) * DM + h * 128 + part * 16;
#pragma unroll
      for (int e = 0; e < 8; ++e) f[e] = dv[e] * rstd * sl[e];
      *(v4u*)op = pack8(f);
#pragma unroll
      for (int e = 0; e < 8; ++e) f[e] = dv[8 + e] * rstd * sl[8 + e];
      *(v4u*)(op + 8) = pack8(f); }
}
__device__ __forceinline__ void swa_unit_v1(Frame& F, int l, int b, int kvh, int qt) {
    LAS float* ldsf = (LAS float*)(F.lds + RING_OFF);
    LAS float* Kt = ldsf; LAS float* Vt = ldsf + 192 * 68; LAS float* Bt = ldsf + 2 * 192 * 68;
    const int lane = F.lane, hd = kvh * 8 + F.wave, q0 = qt * 64, qpos = q0 + lane, kstart = q0 - 127;
    const bf16* QKD = WSP(bf16, WS_QKD); const bf16* COLS = WSP(bf16, WS_COLS); const float* TAB = WSP(float, WS_TAB);
    __syncthreads();
    for (int idx = F.tid; idx < 192 * 8; idx += NWAVES * 64) { const int r = idx >> 3, chn = idx & 7, key = kstart + r;
        float fk[8], fv[8];
        if (key >= 0 && r < 191) { const size_t krow = (size_t)(b * SEQ + key);
            unpack8(*(const v4u*)(QKD + krow * 1152 + 1024 + kvh * 64 + chn * 8), fk); unpack8(*(const v4u*)(COLS + krow * NMAIN + CD_V + kvh * 64 + chn * 8), fv); }
        else {
#pragma unroll
            for (int e = 0; e < 8; ++e) { fk[e] = 0.f; fv[e] = 0.f; } }
#pragma unroll
        for (int e = 0; e < 8; ++e) { Kt[r * 68 + chn * 8 + e] = fk[e]; Vt[r * 68 + chn * 8 + e] = fv[e]; } }
    for (int idx = F.tid; idx < 1024; idx += NWAVES * 64) Bt[idx] = TAB[(8 + kvh * 8 + (idx >> 7)) * 128 + (idx & 127)];
    float q[64];
    { const bf16* qp = QKD + (size_t)(b * SEQ + qpos) * 1152 + hd * 64;
#pragma unroll
      for (int i = 0; i < 8; ++i) { float f[8]; unpack8(*(const v4u*)(qp + 8 * i), f);
#pragma unroll
          for (int e = 0; e < 8; ++e) q[8 * i + e] = f[e]; } }
    __syncthreads();
    float o[64];
#pragma unroll
    for (int i = 0; i < 64; ++i) o[i] = 0.f;
    float mx = F.kin[I_SSINK][l * 16 + hd] * LOG2E, lsum = 1.0f;
#pragma unroll 1
    for (int jj = 0; jj < 128; ++jj) {
        const int key = qpos - 127 + jj;
        if (key >= 0) {
            const int r = lane + jj; const LAS f32x4* kp = (const LAS f32x4*)(Kt + r * 68);
            float s0 = 0.f, s1 = 0.f;
#pragma unroll
            for (int d = 0; d < 16; d += 2) { const f32x4 k0 = kp[d], k1 = kp[d + 1];
                s0 += q[4 * d] * k0.x + q[4 * d + 1] * k0.y + q[4 * d + 2] * k0.z + q[4 * d + 3] * k0.w;
                s1 += q[4 * d + 4] * k1.x + q[4 * d + 5] * k1.y + q[4 * d + 6] * k1.z + q[4 * d + 7] * k1.w; }
            const float s = s0 + s1 + Bt[F.wave * 128 + 127 - jj];
            if (s > mx) { const float sc = __builtin_amdgcn_exp2f(mx - s); lsum *= sc;
#pragma unroll
                for (int i = 0; i < 64; ++i) o[i] *= sc;
                mx = s; }
            const float pw = __builtin_amdgcn_exp2f(s - mx); lsum += pw;
            const LAS f32x4* vp = (const LAS f32x4*)(Vt + r * 68);
#pragma unroll
            for (int i = 0; i < 16; ++i) { const f32x4 v4 = vp[i]; o[4 * i] += pw * v4.x; o[4 * i + 1] += pw * v4.y; o[4 * i + 2] += pw * v4.z; o[4 * i + 3] += pw * v4.w; }
        }
    }
    { const float inv = 1.0f / lsum; bf16* op = WSP(bf16, WS_MIXED) + (size_t)(b * SEQ + qpos) * DM + 3072 + hd * 64;
#pragma unroll
      for (int i = 0; i < 8; ++i) { float f[8];
#pragma unroll
          for (int e = 0; e < 8; ++e) f[e] = o[8 * i + e] * inv;
          *(v4u*)(op + 8 * i) = pack8(f); } }
}
__device__ __forceinline__ void gla_unit_v1(Frame& F, int l, int b, int h) {
    LAS float* ldsf = (LAS float*)(F.lds + RING_OFF);
    LAS float* Ad = ldsf; LAS float* Kd = ldsf + 2048; LAS float* Qd = ldsf + 4096; LAS float* Vd = ldsf + 6144; LAS float* Ob = ldsf + 10240;
    const int dh = F.tid >> 8, vcol = F.tid & 255, lane = F.lane;
    const bf16* COLS = WSP(bf16, WS_COLS); const float* LOGA = WSP(float, WS_LOGA); bf16* MIX = WSP(bf16, WS_MIXED);
    float S[64];
#pragma unroll
    for (int d = 0; d < 64; ++d) S[d] = 0.f;
    float og[4];
#pragma unroll
    for (int e = 0; e < 4; ++e) og[e] = F.kin[I_GON][l * 256 + lane * 4 + e];
#pragma unroll 1
    for (int ck = 0; ck < SEQ / 16; ++ck) {
        const int row0 = b * SEQ + ck * 16;
        __syncthreads();
#pragma unroll 2
        for (int i = 0; i < 4; ++i) { const int idx = F.tid + 512 * i, tok = idx >> 7, c = idx & 127; const size_t row = (size_t)(row0 + tok);
            Ad[idx] = __expf(LOGA[row * 512 + h * 128 + c]); Kd[idx] = bf2f(COLS[row * NMAIN + CB_K + h * 128 + c]); Qd[idx] = bf2f(COLS[row * NMAIN + CB_Q + h * 128 + c]) * 0.08838834764831845f; }
#pragma unroll 4
        for (int i = 0; i < 8; ++i) { const int idx = F.tid + 512 * i, tok = idx >> 8, c = idx & 255; Vd[idx] = bf2f(COLS[(size_t)(row0 + tok) * NMAIN + CB_V + h * 256 + c]); }
        __syncthreads();
#pragma unroll 1
        for (int t = 0; t < 16; ++t) {
            const LAS f32x4* ap = (const LAS f32x4*)(Ad + t * 128 + dh * 64); const LAS f32x4* kp = (const LAS f32x4*)(Kd + t * 128 + dh * 64); const LAS f32x4* qp = (const LAS f32x4*)(Qd + t * 128 + dh * 64);
            float o0 = 0.f, o1 = 0.f; const float vt = Vd[t * 256 + vcol];
#pragma unroll
            for (int d = 0; d < 16; ++d) { const f32x4 a4 = ap[d], k4 = kp[d], q4 = qp[d];
                S[4 * d] = a4.x * S[4 * d] + k4.x * vt; S[4 * d + 1] = a4.y * S[4 * d + 1] + k4.y * vt; S[4 * d + 2] = a4.z * S[4 * d + 2] + k4.z * vt; S[4 * d + 3] = a4.w * S[4 * d + 3] + k4.w * vt;
                o0 += q4.x * S[4 * d] + q4.y * S[4 * d + 1]; o1 += q4.z * S[4 * d + 2] + q4.w * S[4 * d + 3];
                if ((d & 3) == 3) __builtin_amdgcn_sched_barrier(0); }
            Ob[t * 512 + F.tid] = o0 + o1;
        }
        __syncthreads();
#pragma unroll 1
        for (int i = 0; i < 2; ++i) { const int t = 2 * F.wave + i; const size_t row = (size_t)(row0 + t);
            const f32x4 xa = *(const LAS f32x4*)(Ob + t * 512 + lane * 4), xb = *(const LAS f32x4*)(Ob + t * 512 + 256 + lane * 4); const f32x4 x = xa + xb;
            const float ss = wave_sum(x.x * x.x + x.y * x.y + x.z * x.z + x.w * x.w); const float rstd = rsqrtf(ss * (1.0f / 256.0f) + 1e-6f);
            const v2u graw = *(const v2u*)(COLS + row * NMAIN + CB_G + h * 256 + lane * 4);
            const float g0 = bflo(graw.x), g1 = bfhi(graw.x), g2 = bflo(graw.y), g3 = bfhi(graw.y);
            v2u w; w.x = pk2(x.x * rstd * og[0] * silu_g(g0), x.y * rstd * og[1] * silu_g(g1)); w.y = pk2(x.z * rstd * og[2] * silu_g(g2), x.w * rstd * og[3] * silu_g(g3));
            *(v2u*)(MIX + row * DM + 1024 + h * 256 + lane * 4) = w; }
    }
}
__device__ __forceinline__ void rwkv_unit_v1(Frame& F, int l, int b, int hg) {
    const int lane = F.lane, h = hg * 8 + F.wave, c = h * 64 + lane;
    LAS float* st = (LAS float*)(F.lds + RING_OFF) + F.wave * 3584;
    const float* RW = WSP(float, WS_RW); bf16* MIX = WSP(bf16, WS_MIXED);
    constexpr size_t RS = RW_ONE / 4;
    float S[64];
#pragma unroll
    for (int j = 0; j < 64; ++j) S[j] = 0.f;
    const float lnw = F.kin[I_RLNW][l * 1024 + c], lnb = F.kin[I_RLNB][l * 1024 + c], rk = F.kin[I_RRK][l * 1024 + c];
#pragma unroll 1
    for (int ck = 0; ck < SEQ / 8; ++ck) {
        const size_t row0 = (size_t)b * SEQ + ck * 8;
#pragma unroll 2
        for (int s = 0; s < 8; ++s) { const size_t o = (row0 + s) * 1024 + c;
            st[(s * 7 + 0) * 64 + lane] = RW[o]; st[(s * 7 + 1) * 64 + lane] = RW[RS + o]; st[(s * 7 + 2) * 64 + lane] = RW[2 * RS + o];
            st[(s * 7 + 3) * 64 + lane] = RW[4 * RS + o]; st[(s * 7 + 4) * 64 + lane] = RW[5 * RS + o]; st[(s * 7 + 5) * 64 + lane] = RW[3 * RS + o]; st[(s * 7 + 6) * 64 + lane] = RW[6 * RS + o]; }
#pragma unroll 1
        for (int s = 0; s < 8; ++s) {
            const LAS f32x4* rp = (const LAS f32x4*)(st + (s * 7 + 0) * 64); const LAS f32x4* wp = (const LAS f32x4*)(st + (s * 7 + 1) * 64); const LAS f32x4* kp = (const LAS f32x4*)(st + (s * 7 + 2) * 64);
            const LAS f32x4* ap = (const LAS f32x4*)(st + (s * 7 + 3) * 64); const LAS f32x4* bp = (const LAS f32x4*)(st + (s * 7 + 4) * 64);
            float sa0 = 0.f, sa1 = 0.f;
#pragma unroll
            for (int j = 0; j < 16; ++j) { const f32x4 a4 = ap[j]; sa0 += S[4 * j] * a4.x + S[4 * j + 1] * a4.y; sa1 += S[4 * j + 2] * a4.z + S[4 * j + 3] * a4.w; }
            __builtin_amdgcn_sched_barrier(0);
            const float sa = sa0 + sa1, vs = st[(s * 7 + 5) * 64 + lane], gs = st[(s * 7 + 6) * 64 + lane]; float y0 = 0.f, y1 = 0.f;
#pragma unroll
            for (int j = 0; j < 16; ++j) { const f32x4 w4 = wp[j], b4 = bp[j], k4 = kp[j], r4 = rp[j];
                S[4 * j] = S[4 * j] * w4.x + sa * b4.x + vs * k4.x; S[4 * j + 1] = S[4 * j + 1] * w4.y + sa * b4.y + vs * k4.y;
                S[4 * j + 2] = S[4 * j + 2] * w4.z + sa * b4.z + vs * k4.z; S[4 * j + 3] = S[4 * j + 3] * w4.w + sa * b4.w + vs * k4.w;
                y0 += S[4 * j] * r4.x + S[4 * j + 1] * r4.y; y1 += S[4 * j + 2] * r4.z + S[4 * j + 3] * r4.w;
                if ((j & 3) == 3) __builtin_amdgcn_sched_barrier(0); }
            const float y = y0 + y1, mean = wave_sum(y) * (1.0f / 64.0f), dd = y - mean, var = wave_sum(dd * dd) * (1.0f / 64.0f);
            const float yl = dd * rsqrtf(var + 64e-5f) * lnw + lnb;
            const float bonus = wave_sum(st[(s * 7 + 0) * 64 + lane] * st[(s * 7 + 2) * 64 + lane] * rk) * vs;
            MIX[(row0 + s) * DM + 2048 + c] = (bf16)f2bf((yl + bonus) * gs);
        }
    }
}
__device__ __forceinline__ int next_item(Frame& F, gu32* ctr) {
    volatile LAS int* slot = (volatile LAS int*)(F.lds + LDSCTL_OFF + 64);
    __syncthreads();
    if (F.tid == 0) *slot = (int)__hip_atomic_fetch_add(ctr, 1u, RLX_AGENT);
    __syncthreads();
    return *slot;
}
__device__ __forceinline__ void mixers_v1(Frame& F, int l) {
    gu32* ctr = F.ctl + CW_Q + 64 * l;
    for (;;) {
        const int it = next_item(F, ctr); relaunder(F); relaunder_tid(F);
        if (it < 4) { rwkv_unit_v1(F, l, it >> 1, it & 1); }
        else if (it < 12) { const int j = it - 4; gla_unit_v1(F, l, j >> 2, j & 3); }
        else if (it < 12 + 2048) { const int j = it - 12, qt = 127 - (j >> 4), bh = j & 15; diff_unit_v1(F, l, bh >> 3, bh & 7, qt); }
        else if (it < 12 + 2048 + 512) { const int j = it - 2060, qt = j & 127, bk = j >> 7; swa_unit_v1(F, l, bk >> 1, bk & 1, qt); }
        else break;
    }
}
typedef float f32x16 __attribute__((ext_vector_type(16)));
__device__ __forceinline__ float xother32(float v) { unsigned a = __builtin_bit_cast(unsigned, v), b = a; asm volatile("" : "+v"(b)); auto rr = __builtin_amdgcn_permlane32_swap(a, b, false, false);
    const unsigned lo = rr[0], hi = rr[1]; return __builtin_bit_cast(float, (unsigned)((__builtin_amdgcn_mbcnt_hi(~0u, __builtin_amdgcn_mbcnt_lo(~0u, 0u)) & 32u) ? lo : hi)); }
__device__ __forceinline__ float xsum32(float v) { return v + xother32(v); }
__device__ __forceinline__ float xmax32(float v) { return fmaxf(v, xother32(v)); }
__device__ __forceinline__ int crow16(int r, int hi) { return (r & 3) + 8 * (r >> 2) + 4 * hi; }
template <bool ISA>
__device__ __forceinline__ void attn_unit(Frame& F, int l, int b, int hx, int qb) {
    constexpr int DV = ISA ? 128 : 64, NDV = DV / 32, KSTR = ISA ? 272 : 144, VSTR = 144, KBYTES = 64 * KSTR, VBYTES = DV * VSTR, BUFB = KBYTES + VBYTES, NCH = ISA ? 2 : 1;
    constexpr float NEG = -1e30f;
    LAS unsigned char* L = F.lds + RING_OFF;
    const int tid = F.tid, lane = F.lane, r32 = lane & 31, hi = lane >> 5, qs = F.wave & 3, grp = F.wave >> 2, q0 = qb * 128;
    const int kvh = hx >> 2, hd = kvh * 8 + (hx & 3) * 2 + grp;
    const bf16* Qp; const bf16* Kp; const bf16* VT; int ldq;
    if (ISA) { const bf16* QKA = WSP(bf16, WS_QKA); Qp = QKA + (size_t)b * SEQ * 2048 + hx * 128 + grp * 64; Kp = QKA + (size_t)b * SEQ * 2048 + 1024 + hx * 128; ldq = 2048; VT = WSP(bf16, WS_VTA) + (size_t)(b * 8 + hx) * 128 * SEQ; }
    else { const bf16* QKD = WSP(bf16, WS_QKD); Qp = QKD + (size_t)b * SEQ * 1152 + hd * 64; Kp = QKD + (size_t)b * SEQ * 1152 + 1024 + kvh * 64; ldq = 1152; VT = WSP(bf16, WS_VTD) + (size_t)(b * 2 + kvh) * 64 * SEQ; }
    const int qpos = q0 + 32 * qs + r32;
    bf16x8 qr[4];
#pragma unroll
    for (int d0 = 0; d0 < 4; ++d0) qr[d0] = *(const bf16x8*)(Qp + (size_t)qpos * ldq + d0 * 16 + hi * 8);
    LAS float* Bt = (LAS float*)(L + 2 * BUFB);
    { const float* TAB = WSP(float, WS_TAB);
      if (ISA) { if (tid < 128) Bt[tid] = TAB[hx * 128 + tid] - TAB[hx * 128 + 127]; }
      else { if (tid < 256) Bt[tid] = TAB[(8 + kvh * 8 + (hx & 3) * 2 + (tid >> 7)) * 128 + (tid & 127)]; } }
    const int TQ = q0 >> 6, T0 = ISA ? 0 : (TQ >= 2 ? TQ - 2 : 0), T1 = TQ + 1;
    v4u kreg[NCH], vreg[NCH];
#define AT_GLOAD(T) do { _Pragma("unroll") for (int i_ = 0; i_ < NCH; ++i_) { const int c_ = tid + 512 * i_; \
        const int kr_ = ISA ? (c_ >> 4) : (c_ >> 3), kc_ = ISA ? (c_ & 15) : (c_ & 7); kreg[i_] = *(const v4u*)(Kp + (size_t)((T) * 64 + kr_) * ldq + kc_ * 8); \
        const int vr_ = c_ >> 3, vc_ = c_ & 7; vreg[i_] = *(const v4u*)(VT + (size_t)vr_ * SEQ + (T) * 64 + vc_ * 8); } } while (0)
#define AT_LWRITE(buf) do { _Pragma("unroll") for (int i_ = 0; i_ < NCH; ++i_) { const int c_ = tid + 512 * i_; \
        const int kr_ = ISA ? (c_ >> 4) : (c_ >> 3), kc_ = ISA ? (c_ & 15) : (c_ & 7); *(LAS v4u*)(L + (buf) * BUFB + kr_ * KSTR + kc_ * 16) = kreg[i_]; \
        const int vr_ = c_ >> 3, vc_ = c_ & 7; *(LAS v4u*)(L + (buf) * BUFB + KBYTES + vr_ * VSTR + vc_ * 16) = vreg[i_]; } } while (0)
    f32x16 o[NDV];
#pragma unroll
    for (int i = 0; i < NDV; ++i) o[i] = (f32x16){0.f, 0.f, 0.f, 0.f, 0.f, 0.f, 0.f, 0.f, 0.f, 0.f, 0.f, 0.f, 0.f, 0.f, 0.f, 0.f};
    float m_run = ISA ? NEG : F.kin[I_SSINK][l * 16 + hd] * LOG2E, l_run = ISA ? 0.f : (hi == 0 ? 1.f : 0.f);
    const int krow = (r32 & 16) | (r32 & 3) | ((r32 & 4) << 1) | ((r32 & 8) >> 1);
    const int koff = krow * KSTR + (ISA ? grp * 128 : 0) + hi * 16, voff = KBYTES + r32 * VSTR + hi * 16;
    AT_GLOAD(T0); AT_LWRITE(0); __syncthreads();
#pragma unroll 1
    for (int T = T0; T <= T1; ++T) {
        const int cur = (T - T0) & 1;
        if (T < T1) AT_GLOAD(T + 1);
        LAS const unsigned char* Kb = L + cur * BUFB;
        f32x16 s[2];
#pragma unroll
        for (int blk = 0; blk < 2; ++blk) { s[blk] = (f32x16){0.f, 0.f, 0.f, 0.f, 0.f, 0.f, 0.f, 0.f, 0.f, 0.f, 0.f, 0.f, 0.f, 0.f, 0.f, 0.f};
#pragma unroll
            for (int d0 = 0; d0 < 4; ++d0) { const bf16x8 kf = *(const LAS bf16x8*)(Kb + koff + blk * 32 * KSTR + d0 * 32); s[blk] = __builtin_amdgcn_mfma_f32_32x32x16_bf16(kf, qr[d0], s[blk], 0, 0, 0); } }
        if (!ISA || T >= TQ - 2) {
#pragma unroll
            for (int blk = 0; blk < 2; ++blk)
#pragma unroll
                for (int r = 0; r < 16; ++r) { const int kvl = 32 * blk + 16 * (r >> 3) + 8 * hi + (r & 7), dist = qpos - (T * 64 + kvl);
                    const int di = dist < 0 ? 0 : (dist > 127 ? 127 : dist);
                    const float bv = Bt[(ISA ? 0 : grp * 128) + di];
                    if (ISA) s[blk][r] = dist < 0 ? NEG : (dist < 128 ? s[blk][r] + bv : s[blk][r]);
                    else s[blk][r] = (dist < 0 || dist > 127) ? NEG : s[blk][r] + bv; } }
        float mt = s[0][0];
#pragma unroll
        for (int r = 1; r < 16; ++r) mt = fmaxf(mt, s[0][r]);
#pragma unroll
        for (int r = 0; r < 16; ++r) mt = fmaxf(mt, s[1][r]);
        mt = xmax32(mt);
        const float m_new = fmaxf(m_run, mt);
        if (__any(m_new > m_run)) { const float alpha = __builtin_amdgcn_exp2f(m_run - m_new); l_run *= alpha;
#pragma unroll
            for (int i = 0; i < NDV; ++i)
#pragma unroll
                for (int r = 0; r < 16; ++r) o[i][r] *= alpha;
            m_run = m_new; }
        float ls = 0.f;
#pragma unroll
        for (int blk = 0; blk < 2; ++blk)
#pragma unroll
            for (int r = 0; r < 16; ++r) { const float pv_ = __builtin_amdgcn_exp2f(s[blk][r] - m_run); s[blk][r] = pv_; ls += pv_; }
        l_run += ls;
#pragma unroll
        for (int sl = 0; sl < 4; ++sl) { const int blk = sl >> 1, r0 = 8 * (sl & 1);
            v4u pw; pw.x = pg8::cvt_pk_bf16(s[blk][r0], s[blk][r0 + 1]); pw.y = pg8::cvt_pk_bf16(s[blk][r0 + 2], s[blk][r0 + 3]); pw.z = pg8::cvt_pk_bf16(s[blk][r0 + 4], s[blk][r0 + 5]); pw.w = pg8::cvt_pk_bf16(s[blk][r0 + 6], s[blk][r0 + 7]);
            const bf16x8 pf = __builtin_bit_cast(bf16x8, pw);
#pragma unroll
            for (int i = 0; i < NDV; ++i) { const bf16x8 vf = *(const LAS bf16x8*)(Kb + voff + i * 32 * VSTR + sl * 32); o[i] = __builtin_amdgcn_mfma_f32_32x32x16_bf16(vf, pf, o[i], 0, 0, 0); } }
        if (T < T1) AT_LWRITE(cur ^ 1);
        __syncthreads();
    }
#undef AT_GLOAD
#undef AT_LWRITE
    const float inv = 1.0f / xsum32(l_run);
    bf16* MIX = WSP(bf16, WS_MIXED);
    if (ISA) {
        int ll_ = l; asm volatile("" : "+s"(ll_)); const float lam_init = ll_ == 0 ? 0.2f : 0.35550906759f;     float lam_full;
        { const float* lm = F.kin[I_DLAM] + (size_t)l * 256; const float s1 = wave_sum(lm[lane] * lm[64 + lane]), s2 = wave_sum(lm[128 + lane] * lm[192 + lane]); lam_full = __expf(s1) - __expf(s2) + lam_init; }
        LAS float* R1 = (LAS float*)L;
        LAS bf16* R2 = (LAS bf16*)(L + 66048);
        const int ql = 32 * qs + r32;
        if (grp == 1) {
#pragma unroll
            for (int i = 0; i < NDV; ++i)
#pragma unroll
                for (int r = 0; r < 16; ++r) R1[ql * 129 + 32 * i + crow16(r, hi)] = lam_full * inv * o[i][r]; }
        __syncthreads();
        if (grp == 0) { float ss = 0.f;
#pragma unroll
            for (int i = 0; i < NDV; ++i)
#pragma unroll
                for (int r = 0; r < 16; ++r) { const float d = o[i][r] * inv - R1[ql * 129 + 32 * i + crow16(r, hi)]; o[i][r] = d; ss += d * d; }
            const float rstd = rsqrtf(xsum32(ss) * (1.0f / 128.0f) + 1e-6f) * (1.0f - lam_init);
            const float* sl = F.kin[I_DSUB] + l * 128;
#pragma unroll
            for (int i = 0; i < NDV; ++i)
#pragma unroll
                for (int r = 0; r < 16; ++r) { const int dv = 32 * i + crow16(r, hi); R2[ql * 132 + dv] = (bf16)f2bf(o[i][r] * rstd * sl[dv]); } }
        __syncthreads();
#pragma unroll
        for (int i = 0; i < 4; ++i) { const int c = tid + 512 * i, row = c >> 4, ch = c & 15; const LAS v2u* sp = (const LAS v2u*)(R2 + row * 132 + ch * 8); const v2u a = sp[0], bb = sp[1];
            *(v4u*)(MIX + (size_t)(b * SEQ + q0 + row) * DM + hx * 128 + ch * 8) = (v4u){a.x, a.y, bb.x, bb.y}; }
    } else {
        LAS bf16* R = (LAS bf16*)L + F.wave * 2176;
#pragma unroll
        for (int i = 0; i < NDV; ++i)
#pragma unroll
            for (int r = 0; r < 16; ++r) R[r32 * 68 + 32 * i + crow16(r, hi)] = (bf16)f2bf(o[i][r] * inv);
#pragma unroll
        for (int i = 0; i < 4; ++i) { const int c = lane + 64 * i, row = c >> 3, ch = c & 7; const LAS v2u* sp = (const LAS v2u*)(R + row * 68 + ch * 8); const v2u a = sp[0], bb = sp[1];
            *(v4u*)(MIX + (size_t)(b * SEQ + q0 + 32 * qs + row) * DM + 3072 + hd * 64 + ch * 8) = (v4u){a.x, a.y, bb.x, bb.y}; }
    }
}
__device__ __forceinline__ void prep_gla(Frame& F) {
    LAS float* Lb = (LAS float*)(F.lds + RING_OFF); LAS float* Qd = Lb + 64 * 129; LAS float* Ki = Qd + 64 * 129; LAS bf16* Kt = (LAS bf16*)(Ki + 64 * 129);
    const bf16* COLS = WSP(bf16, WS_COLS); const float* LOGA = WSP(float, WS_LOGA);
    bf16* QDEC = WSP(bf16, WS_QDEC); bf16* KDT = WSP(bf16, WS_KDT); bf16* AMg = WSP(bf16, WS_AM); float* EBL = WSP(float, WS_EBL);
    for (int u = F.bx; u < 1024; u += F.G) {
        const int b = u >> 9, h = (u >> 7) & 3, ck = u & 127; const size_t row0 = (size_t)b * SEQ + ck * 64;
        __syncthreads();
        for (int idx = F.tid; idx < 8192; idx += NWAVES * 64) { const int t = idx >> 7, d = idx & 127; Lb[t * 129 + d] = LOGA[(row0 + t) * 512 + h * 128 + d]; }
        __syncthreads();
        if (F.tid < 128) { float acc = 0.f;
#pragma unroll 8
            for (int t = 0; t < 64; ++t) { acc += Lb[t * 129 + F.tid]; Lb[t * 129 + F.tid] = acc; }
            EBL[(size_t)u * 128 + F.tid] = __expf(acc); }
        __syncthreads();
        for (int idx = F.tid; idx < 8192; idx += NWAVES * 64) { const int t = idx >> 7, d = idx & 127; const float bt = Lb[t * 129 + d], bl = Lb[63 * 129 + d];
            const float q = bf2f(COLS[(row0 + t) * NMAIN + CB_Q + h * 128 + d]) * 0.08838834764831845f, k = bf2f(COLS[(row0 + t) * NMAIN + CB_K + h * 128 + d]);
            const float qd = q * __expf(bt); Qd[t * 129 + d] = qd; Ki[t * 129 + d] = k * __expf(-bt); Kt[d * 72 + t] = (bf16)f2bf(k * __expf(bl - bt));
            QDEC[((size_t)u * 64 + t) * 128 + d] = (bf16)f2bf(qd); }
        __syncthreads();
#pragma unroll
        for (int i = 0; i < 2; ++i) { const int c_ = F.tid + 512 * i, row = c_ >> 3, ch = c_ & 7; const LAS v2u* sp = (const LAS v2u*)(Kt + row * 72 + ch * 8); const v2u a = sp[0], bb = sp[1];
            *(v4u*)(KDT + ((size_t)u * 128 + row) * 64 + ch * 8) = (v4u){a.x, a.y, bb.x, bb.y}; }
        { const int c = F.tid >> 3, sg = F.tid & 7; float acc[8];
#pragma unroll
          for (int e = 0; e < 8; ++e) acc[e] = 0.f;
#pragma unroll 4
          for (int d = 0; d < 128; ++d) { const float q = Qd[c * 129 + d];
#pragma unroll
              for (int e = 0; e < 8; ++e) acc[e] += q * Ki[(sg * 8 + e) * 129 + d]; }
#pragma unroll
          for (int e = 0; e < 8; ++e) if (sg * 8 + e > c) acc[e] = 0.f;
          *(v4u*)(AMg + ((size_t)u * 64 + c) * 64 + sg * 8) = pack8(acc); }
    }
}
__device__ __forceinline__ void prep_vt(Frame& F, int pass) {
    LAS bf16* T = (LAS bf16*)(F.lds + RING_OFF);
    const bf16* COLS = WSP(bf16, WS_COLS);
    const int nch = pass == 0 ? 144 : 128, nvr = nch * 8;
    for (int tile = F.bx; tile < M / 32; tile += F.G) {
        const int b = tile >> 8, t0 = (tile & 255) * 32;
        __syncthreads();
        for (int idx = F.tid; idx < 32 * nch; idx += NWAVES * 64) { const int tok = idx / nch, ch = idx % nch;
            const int col = pass == 0 ? (ch < 128 ? CA_V + ch * 8 : CD_V + (ch - 128) * 8) : (pass == 1 ? CB_V + ch * 8 : CB_G + ch * 8);
            const v4u v = *(const v4u*)(COLS + (size_t)(b * SEQ + t0 + tok) * NMAIN + col); LAS v2u* d = (LAS v2u*)(T + tok * 1160 + ch * 8); d[0] = (v2u){v.x, v.y}; d[1] = (v2u){v.z, v.w}; }
        __syncthreads();
        for (int idx = F.tid; idx < nvr * 4; idx += NWAVES * 64) { const int ch = idx / nvr, vrow = idx % nvr;
            unsigned e[8];
#pragma unroll
            for (int k = 0; k < 8; ++k) e[k] = T[(ch * 8 + k) * 1160 + vrow];
            v4u o; o.x = e[0] | (e[1] << 16); o.y = e[2] | (e[3] << 16); o.z = e[4] | (e[5] << 16); o.w = e[6] | (e[7] << 16);
            bf16* dst;
            if (pass == 0) dst = vrow < 1024 ? WSP(bf16, WS_VTA) + ((size_t)(b * 8 + (vrow >> 7)) * 128 + (vrow & 127)) * SEQ : WSP(bf16, WS_VTD) + ((size_t)(b * 2 + ((vrow - 1024) >> 6)) * 64 + ((vrow - 1024) & 63)) * SEQ;
            else dst = WSP(bf16, pass == 1 ? WS_VTB : WS_GTB) + ((size_t)b * 1024 + vrow) * SEQ;
            *(v4u*)(dst + t0 + ch * 8) = o; }
    }
}
typedef float f32x4v __attribute__((ext_vector_type(4)));
__device__ __forceinline__ float sum16(float v) { v = sum8(v); v += dpp_f<0x140>(v); return v; }
#define LDS_BARRIER() asm volatile("s_waitcnt lgkmcnt(0)\n\ts_barrier" ::: "memory")
template <int HACK = 0> __device__ __forceinline__ void gla_scan_unit(Frame& F, int l, int b, int h) {
    LAS unsigned char* L = F.lds + RING_OFF;
    constexpr int OQD = 0, OKT = 17408, OAM = 35840, OVT = 45056, OOT = 81920, OEB = 115712, OPS = 116224;
    const int tid = F.tid, lane = F.lane, n = lane & 15, g = lane >> 4, w = F.wave;
    const bf16* QDEC = WSP(bf16, WS_QDEC); const bf16* KDT = WSP(bf16, WS_KDT); const bf16* AMg = WSP(bf16, WS_AM); const float* EBL = WSP(float, WS_EBL);
    const bf16* VTB = WSP(bf16, WS_VTB) + (size_t)(b * 4 + h) * 256 * SEQ; const bf16* COLS = WSP(bf16, WS_COLS); bf16* MIX = WSP(bf16, WS_MIXED);
    f32x4v S[8][2];
#pragma unroll
    for (int dt = 0; dt < 8; ++dt)
#pragma unroll
        for (int vt = 0; vt < 2; ++vt) S[dt][vt] = (f32x4v){0.f, 0.f, 0.f, 0.f};
    float gain8[8];
#pragma unroll
    for (int e = 0; e < 8; ++e) gain8[e] = F.kin[I_GON][l * 256 + (tid & 31) * 8 + e];
    v4u pq[2], pk[2], pa, pv[4]; float pe = 0.f;
#define GL_ISSUE(CK) do { const size_t u_ = (size_t)(b * 4 + h) * 128 + (CK); \
        _Pragma("unroll") for (int i = 0; i < 2; ++i) { const int c_ = tid + 512 * i; pq[i] = *(const v4u*)(QDEC + (u_ * 64 + (c_ >> 4)) * 128 + (c_ & 15) * 8); pk[i] = *(const v4u*)(KDT + (u_ * 128 + (c_ >> 3)) * 64 + (c_ & 7) * 8); } \
        pa = *(const v4u*)(AMg + (u_ * 64 + (tid >> 3)) * 64 + (tid & 7) * 8); \
        _Pragma("unroll") for (int i = 0; i < 4; ++i) { const int c_ = tid + 512 * i; pv[i] = *(const v4u*)(VTB + (size_t)(c_ >> 3) * SEQ + (CK) * 64 + (c_ & 7) * 8); } \
        if (tid < 128) pe = EBL[u_ * 128 + tid]; } while (0)
#define GL_WRITE() do { _Pragma("unroll") for (int i = 0; i < 2; ++i) { const int c_ = tid + 512 * i; *(LAS v4u*)(L + OQD + (c_ >> 4) * 272 + (c_ & 15) * 16) = pq[i]; *(LAS v4u*)(L + OKT + (c_ >> 3) * 144 + (c_ & 7) * 16) = pk[i]; } \
        *(LAS v4u*)(L + OAM + (tid >> 3) * 144 + (tid & 7) * 16) = pa; \
        _Pragma("unroll") for (int i = 0; i < 4; ++i) { const int c_ = tid + 512 * i; *(LAS v4u*)(L + OVT + (c_ >> 3) * 144 + (c_ & 7) * 16) = pv[i]; } \
        if (tid < 128) ((LAS float*)(L + OEB))[tid] = pe; } while (0)
    GL_ISSUE(0); GL_WRITE();
    LDS_BARRIER();
#pragma unroll 1
    for (int ck = 0; ck < 128; ++ck) {
        const size_t row0 = (size_t)b * SEQ + ck * 64;
        v4u gq[4];
#pragma unroll
        for (int i = 0; i < 4; ++i) gq[i] = (HACK & 1) ? (v4u){0u, 0u, 0u, 0u} : *(const v4u*)(COLS + (row0 + (tid >> 5) + 16 * i) * NMAIN + CB_G + h * 256 + (tid & 31) * 8);
        if (ck + 1 < 128 && (!(HACK & 1) || ck < 2)) GL_ISSUE(ck + 1);
        bf16x8 vf[2][2];
#pragma unroll
        for (int vt = 0; vt < 2; ++vt)
#pragma unroll
            for (int ks = 0; ks < 2; ++ks) vf[vt][ks] = *(const LAS bf16x8*)(L + OVT + (32 * w + 16 * vt + n) * 144 + (32 * ks + 8 * g) * 2);
        f32x4v o[4][2];
#pragma unroll
        for (int ct = 0; ct < 4; ++ct)
#pragma unroll
            for (int vt = 0; vt < 2; ++vt) o[ct][vt] = (f32x4v){0.f, 0.f, 0.f, 0.f};
#pragma unroll
        for (int ct = 0; ct < 4; ++ct)
#pragma unroll
            for (int ks = 0; ks < 2; ++ks) { const bf16x8 af = *(const LAS bf16x8*)(L + OAM + (16 * ct + n) * 144 + (32 * ks + 8 * g) * 2);
#pragma unroll
                for (int vt = 0; vt < 2; ++vt) o[ct][vt] = __builtin_amdgcn_mfma_f32_16x16x32_bf16(af, vf[vt][ks], o[ct][vt], 0, 0, 0); }
#pragma unroll
        for (int kk = 0; kk < 4; ++kk) { bf16x8 sf[2];
#pragma unroll
            for (int vt = 0; vt < 2; ++vt) { v4u pw; pw.x = pg8::cvt_pk_bf16(S[2 * kk][vt][0], S[2 * kk][vt][1]); pw.y = pg8::cvt_pk_bf16(S[2 * kk][vt][2], S[2 * kk][vt][3]);
                pw.z = pg8::cvt_pk_bf16(S[2 * kk + 1][vt][0], S[2 * kk + 1][vt][1]); pw.w = pg8::cvt_pk_bf16(S[2 * kk + 1][vt][2], S[2 * kk + 1][vt][3]); sf[vt] = __builtin_bit_cast(bf16x8, pw); }
#pragma unroll
            for (int ct = 0; ct < 4; ++ct) { const LAS unsigned char* qp = L + OQD + (16 * ct + n) * 272 + (32 * kk + 4 * g) * 2; const v2u qa = *(const LAS v2u*)qp, qb = *(const LAS v2u*)(qp + 32);
                const bf16x8 qf = __builtin_bit_cast(bf16x8, (v4u){qa.x, qa.y, qb.x, qb.y});
#pragma unroll
                for (int vt = 0; vt < 2; ++vt) o[ct][vt] = __builtin_amdgcn_mfma_f32_16x16x32_bf16(qf, sf[vt], o[ct][vt], 0, 0, 0); } }
#pragma unroll
        for (int dt = 0; dt < 8; ++dt) { const f32x4v eb = *(const LAS f32x4v*)(L + OEB + (16 * dt + 4 * g) * 4);
#pragma unroll
            for (int vt = 0; vt < 2; ++vt) S[dt][vt] = S[dt][vt] * eb;
#pragma unroll
            for (int ks = 0; ks < 2; ++ks) { const bf16x8 kf = *(const LAS bf16x8*)(L + OKT + (16 * dt + n) * 144 + (32 * ks + 8 * g) * 2);
#pragma unroll
                for (int vt = 0; vt < 2; ++vt) S[dt][vt] = __builtin_amdgcn_mfma_f32_16x16x32_bf16(kf, vf[vt][ks], S[dt][vt], 0, 0, 0); } }
        LAS float* PS = (LAS float*)(L + OPS) + (ck & 1) * 512;
#pragma unroll
        for (int ct = 0; ct < 4; ++ct)
#pragma unroll
            for (int r = 0; r < 4; ++r) { const float ss = sum16(o[ct][0][r] * o[ct][0][r] + o[ct][1][r] * o[ct][1][r]); if (n == 0) PS[(16 * ct + 4 * g + r) * 8 + w] = ss; }
        LDS_BARRIER();
        if (ck + 1 < 128) GL_WRITE();
#pragma unroll
        for (int ct = 0; ct < 4; ++ct)
#pragma unroll
            for (int vt = 0; vt < 2; ++vt)
#pragma unroll
                for (int r = 0; r < 4; ++r) *(LAS bf16*)(L + OOT + (16 * ct + 4 * g + r) * 528 + (32 * w + 16 * vt + n) * 2) = (bf16)f2bf(o[ct][vt][r]);
        LDS_BARRIER();
#pragma unroll
        for (int i = 0; i < 4; ++i) { const int tok = (tid >> 5) + 16 * i; float ov[8], gv[8]; unpack8(*(const LAS v4u*)(L + OOT + tok * 528 + (tid & 31) * 16), ov); unpack8(gq[i], gv);
            const LAS f32x4v* pp = (const LAS f32x4v*)(PS + tok * 8); const f32x4v p0 = pp[0], p1 = pp[1];
            const float rstd = rsqrtf(((p0.x + p0.y) + (p0.z + p0.w) + (p1.x + p1.y) + (p1.z + p1.w)) * (1.0f / 256.0f) + 1e-6f);
#pragma unroll
            for (int e = 0; e < 8; ++e) ov[e] = ov[e] * (rstd * gain8[e]) * silu_g(gv[e]);
            if (!(HACK & 2)) *(v4u*)(MIX + (row0 + tok) * DM + 1024 + h * 256 + (tid & 31) * 8) = pack8(ov); }
    }
#undef GL_ISSUE
#undef GL_WRITE
}
constexpr int RC_AT = 0, RC_RT = 2048, RC_BK = 4096, RC_VF = 8192, RC_GF = 10240, RC_U0 = 12288, RC_Y0 = 16384, RC_P15 = 20480, RC_BN = 20736, RC_BYTES = 20800;
__device__ __forceinline__ void prep_rwkv_chunks(Frame& F, int l) {
    const int team = F.tid >> 8, tt = F.tid & 255;
    LAS float* Lt = (LAS float*)(F.lds + RING_OFF) + team * 12288;
    LAS float* XA = Lt; LAS float* XR = Lt + 1040; LAS float* ZB = Lt + 2080; LAS float* ZK = Lt + 3120; LAS float* TB = Lt + 4160; LAS float* TK = Lt + 5200; LAS float* VV = Lt + 6240;
    LAS float* ATl = Lt + 7280; LAS float* U0l = Lt + 8320; LAS float* W1 = Lt + 9360;
    LAS float* Aab = Lt + 10400; LAS float* Aak = Lt + 10672; LAS float* Arb = Lt + 10944; LAS float* Ark = Lt + 11216; LAS float* TT = Lt + 11488;
    const float* RW = WSP(float, WS_RW); constexpr size_t RS = RW_ONE / 4; unsigned char* RWC = F.ws + WS_RWC;
    float pw_[16], pr_[4], pk_[4], pv_[4], pa_[4], pb_[4], pg_[4];
#define RC_FETCH(PAIR) do { const int uc_ = (PAIR) * 2 + team; const size_t cb_ = ((size_t)(uc_ >> 13) * SEQ + (uc_ & 511) * 16) * 1024 + ((uc_ >> 9) & 15) * 64 + (tt & 63); \
        _Pragma("unroll") for (int t = 0; t < 16; ++t) pw_[t] = RW[RS + cb_ + (size_t)t * 1024]; \
        _Pragma("unroll") for (int e = 0; e < 4; ++e) { const size_t o_ = cb_ + (size_t)(4 * (tt >> 6) + e) * 1024; pr_[e] = RW[o_]; pk_[e] = RW[2 * RS + o_]; pv_[e] = RW[3 * RS + o_]; pa_[e] = RW[4 * RS + o_]; pb_[e] = RW[5 * RS + o_]; pg_[e] = RW[6 * RS + o_]; } } while (0)
    if (F.bx < 8192) RC_FETCH(F.bx);
    for (int pair = F.bx; pair < 8192; pair += F.G) {
        const int uc = pair * 2 + team, b = uc >> 13, h = (uc >> 9) & 15, ck = uc & 511; unsigned char* rec = RWC + (size_t)uc * RC_BYTES; (void)b; (void)ck;
        __syncthreads();
        {
          const int j = tt & 63, q = tt >> 6;
          float cl = 0.f, clq[4] = {0.f, 0.f, 0.f, 0.f}, clm = 0.f;
#pragma unroll
          for (int t = 0; t < 16; ++t) { const float lw = __logf(pw_[t]); if (t == 4 * q) clm = cl; cl += lw; if ((t >> 2) == q) clq[t & 3] = cl; }
#pragma unroll
          for (int e = 0; e < 4; ++e) { const int t = 4 * q + e; const float cprev = e == 0 ? clm : clq[e - 1], cc = clq[e];
              const float rr = pr_[e], kk = pk_[e], vv = pv_[e], aa = pa_[e], bb = pb_[e];
              XA[t * 65 + j] = aa * __expf(cprev); XR[t * 65 + j] = rr * __expf(cc); const float ei = __expf(-cc), ef = __expf(cl - cc);
              ZB[t * 65 + j] = bb * ei; ZK[t * 65 + j] = kk * ei; TB[t * 65 + j] = bb * ef; TK[t * 65 + j] = kk * ef; VV[t * 65 + j] = vv; }
          if (q == 0) ((float*)(rec + RC_P15))[j] = __expf(cl);
          { v2u gw; gw.x = pk2(pg_[0], pg_[1]); gw.y = pk2(pg_[2], pg_[3]); *(v2u*)(rec + RC_GF + (((j >> 4) * 64 + 16 * q + (j & 15)) * 8)) = gw; } }
        if (pair + F.G < 8192) RC_FETCH(pair + F.G);
        __syncthreads();
        {
          const int t = tt >> 4, s = tt & 15; float ab = 0.f, ak = 0.f, rb = 0.f, rk = 0.f;
#pragma unroll 8
          for (int j = 0; j < 64; ++j) { const float xa = XA[t * 65 + j], xr = XR[t * 65 + j], zb = ZB[s * 65 + j], zk = ZK[s * 65 + j]; ab += xa * zb; ak += xa * zk; rb += xr * zb; rk += xr * zk; }
          Aab[t * 17 + s] = s < t ? ab : 0.f; Aak[t * 17 + s] = s < t ? ak : 0.f; Arb[t * 17 + s] = s <= t ? rb : 0.f; Ark[t * 17 + s] = s <= t ? rk : 0.f;
          if (tt < 16) { float bn = 0.f; const float* rkp = F.kin[I_RRK] + l * 1024 + h * 64;
#pragma unroll 8
              for (int j = 0; j < 64; ++j) bn += XR[tt * 65 + j] * ZK[tt * 65 + j] * rkp[j];
              ((float*)(rec + RC_BN))[tt] = bn; } }
        __syncthreads();
        {
          if (tt < 16) { float col[16];
#pragma unroll
              for (int t = 0; t < 16; ++t) { float acc = (t == tt) ? 1.f : 0.f;
#pragma unroll
                  for (int s = 0; s < 16; ++s) if (s < t) acc += Aab[t * 17 + s] * col[s];
                  col[t] = acc; TT[t * 17 + tt] = acc; } }
          const int i = tt & 63, tq = tt >> 6; float acc[4] = {0.f, 0.f, 0.f, 0.f};
#pragma unroll
          for (int s = 0; s < 16; ++s) { const float vv = VV[s * 65 + i];
#pragma unroll
              for (int e = 0; e < 4; ++e) acc[e] += Aak[(4 * tq + e) * 17 + s] * vv; }
#pragma unroll
          for (int e = 0; e < 4; ++e) W1[(4 * tq + e) * 65 + i] = acc[e]; }
        __syncthreads();
        {
          const int j = tt & 63, tq = tt >> 6; float a4[4] = {0.f, 0.f, 0.f, 0.f}, u4[4] = {0.f, 0.f, 0.f, 0.f};
#pragma unroll
          for (int s = 0; s < 16; ++s) { const float xa = XA[s * 65 + j], w1 = W1[s * 65 + j];
#pragma unroll
              for (int e = 0; e < 4; ++e) { const float tv = TT[(4 * tq + e) * 17 + s]; a4[e] += tv * xa; u4[e] += tv * w1; } }
#pragma unroll
          for (int e = 0; e < 4; ++e) { ATl[(4 * tq + e) * 65 + j] = a4[e]; U0l[(4 * tq + e) * 65 + j] = u4[e]; }
          *(f32x4*)(rec + RC_U0 + (((j >> 4) * 64 + 16 * tq + (j & 15)) * 16)) = (f32x4){u4[0], u4[1], u4[2], u4[3]}; }
        __syncthreads();
        {
          const int j = tt & 63, tq = tt >> 6; float r4[4], y4[4];
#pragma unroll
          for (int e = 0; e < 4; ++e) { r4[e] = XR[(4 * tq + e) * 65 + j]; y4[e] = 0.f; }
#pragma unroll
          for (int s = 0; s < 16; ++s) { const float at = ATl[s * 65 + j], u0 = U0l[s * 65 + j], vv = VV[s * 65 + j];
#pragma unroll
              for (int e = 0; e < 4; ++e) { const float arb = Arb[(4 * tq + e) * 17 + s], ark = Ark[(4 * tq + e) * 17 + s]; r4[e] += arb * at; y4[e] += arb * u0 + ark * vv; } }
          *(f32x4*)(rec + RC_Y0 + (((j >> 4) * 64 + 16 * tq + (j & 15)) * 16)) = (f32x4){y4[0], y4[1], y4[2], y4[3]};
#pragma unroll
          for (int e = 0; e < 4; ++e) W1[(4 * tq + e) * 65 + j] = r4[e]; }
        __syncthreads();
        { const int t = tt & 15, jq = tt >> 4, kk = jq >> 3, half = (jq & 7) >> 2, g = jq & 3, j0 = 4 * jq;
          v2u wa, wr; wa.x = pk2(ATl[t * 65 + j0], ATl[t * 65 + j0 + 1]); wa.y = pk2(ATl[t * 65 + j0 + 2], ATl[t * 65 + j0 + 3]); wr.x = pk2(W1[t * 65 + j0], W1[t * 65 + j0 + 1]); wr.y = pk2(W1[t * 65 + j0 + 2], W1[t * 65 + j0 + 3]);
          *(v2u*)(rec + RC_AT + kk * 1024 + (16 * g + t) * 16 + half * 8) = wa; *(v2u*)(rec + RC_RT + kk * 1024 + (16 * g + t) * 16 + half * 8) = wr;
          const int j = tt & 63, gg = tt >> 6; v4u bk; bk.x = pk2(TB[(4 * gg) * 65 + j], TB[(4 * gg + 1) * 65 + j]); bk.y = pk2(TB[(4 * gg + 2) * 65 + j], TB[(4 * gg + 3) * 65 + j]);
          bk.z = pk2(TK[(4 * gg) * 65 + j], TK[(4 * gg + 1) * 65 + j]); bk.w = pk2(TK[(4 * gg + 2) * 65 + j], TK[(4 * gg + 3) * 65 + j]);
          *(v4u*)(rec + RC_BK + (j >> 4) * 1024 + (16 * gg + (j & 15)) * 16) = bk;
          v2u vf; vf.x = pk2(VV[(4 * gg) * 65 + j], VV[(4 * gg + 1) * 65 + j]); vf.y = pk2(VV[(4 * gg + 2) * 65 + j], VV[(4 * gg + 3) * 65 + j]);
          *(v2u*)(rec + RC_VF + ((j >> 4) * 64 + 16 * gg + (j & 15)) * 8) = vf; }
    }
}
#undef RC_FETCH
template <int HACK = 0> __device__ __forceinline__ void rwkv_scan_unit(Frame& F, int l, int b, int h) {
    LAS unsigned char* L = F.lds + RING_OFF;
    const unsigned char* recs = F.ws + WS_RWC + (size_t)((b * 16 + h) * 512) * RC_BYTES;
    const int lane = F.lane, n = lane & 15, g = lane >> 4;
    LAS float* XS = (LAS float*)(L + 2 * RC_BYTES);
    if (F.wave >= 2) {
        const int li = F.tid - 128; const bool act0 = li < 1300, act1 = li + 384 < 1300, act2 = li + 768 < 1300, act3 = li + 1152 < 1300;
        v4u p0[4], p1[4], p2[4], p3[4], p4[4], p5[4];
#define RWL_ISSUE(P, CK) do { if ((CK) < 512 && (!(HACK & 1) || (CK) < 4)) { const v4u* src_ = (const v4u*)(recs + (size_t)(CK) * RC_BYTES); if (act0) P[0] = src_[li]; if (act1) P[1] = src_[li + 384]; if (act2) P[2] = src_[li + 768]; if (act3) P[3] = src_[li + 1152]; } } while (0)
#define RWL_WRITE(P, CK) do { if ((CK) < 512) { LAS v4u* dst_ = (LAS v4u*)(L + ((CK) & 1) * RC_BYTES); if (act0) dst_[li] = P[0]; if (act1) dst_[li + 384] = P[1]; if (act2) dst_[li + 768] = P[2]; if (act3) dst_[li + 1152] = P[3]; } } while (0)
        RWL_ISSUE(p0, 0); RWL_ISSUE(p1, 1); RWL_ISSUE(p2, 2); RWL_ISSUE(p3, 3); RWL_ISSUE(p4, 4); RWL_ISSUE(p5, 5);
        RWL_WRITE(p0, 0); RWL_ISSUE(p0, 6);
        LDS_BARRIER();
#pragma unroll 1
        for (int ck = 0; ck < 512; ck += 6) {
            RWL_WRITE(p1, ck + 1); RWL_ISSUE(p1, ck + 7); LDS_BARRIER();
            if (ck + 1 < 512) { RWL_WRITE(p2, ck + 2); RWL_ISSUE(p2, ck + 8); LDS_BARRIER(); }
            if (ck + 2 < 512) { RWL_WRITE(p3, ck + 3); RWL_ISSUE(p3, ck + 9); LDS_BARRIER(); }
            if (ck + 3 < 512) { RWL_WRITE(p4, ck + 4); RWL_ISSUE(p4, ck + 10); LDS_BARRIER(); }
            if (ck + 4 < 512) { RWL_WRITE(p5, ck + 5); RWL_ISSUE(p5, ck + 11); LDS_BARRIER(); }
            if (ck + 5 < 512) { RWL_WRITE(p0, ck + 6); RWL_ISSUE(p0, ck + 12); LDS_BARRIER(); }
        }
#undef RWL_ISSUE
#undef RWL_WRITE
        return;
    }
    const int cw = F.wave;
    f32x4v S[4][2];
#pragma unroll
    for (int jt = 0; jt < 4; ++jt)
#pragma unroll
        for (int it = 0; it < 2; ++it) S[jt][it] = (f32x4v){0.f, 0.f, 0.f, 0.f};
    float lnw[2], lnb[2];
#pragma unroll
    for (int it = 0; it < 2; ++it) { lnw[it] = F.kin[I_RLNW][l * 1024 + h * 64 + 16 * (2 * cw + it) + n]; lnb[it] = F.kin[I_RLNB][l * 1024 + h * 64 + 16 * (2 * cw + it) + n]; }
    bf16* MIX = WSP(bf16, WS_MIXED) + ((size_t)b * SEQ) * DM + 2048 + h * 64 + 32 * cw + n;
    f32x4v Yp[2] = {(f32x4v){0.f, 0.f, 0.f, 0.f}, (f32x4v){0.f, 0.f, 0.f, 0.f}}, bnp = (f32x4v){0.f, 0.f, 0.f, 0.f}; v2u gfp[2] = {(v2u){0u, 0u}, (v2u){0u, 0u}}, vfp[2] = {(v2u){0u, 0u}, (v2u){0u, 0u}};
    LDS_BARRIER();
#pragma unroll 1
    for (int ck = 0; ck <= 512; ++ck) {
        if (ck > 0) {
            const LAS float* xs = XS + ((ck - 1) & 1) * 64; const f32x4v a0 = *(const LAS f32x4v*)(xs + 8 * g), a1 = *(const LAS f32x4v*)(xs + 8 * g + 4), b0 = *(const LAS f32x4v*)(xs + 32 + 8 * g), b1 = *(const LAS f32x4v*)(xs + 32 + 8 * g + 4);
            const float s1[4] = {a0[0] + b0[0], a0[2] + b0[2], a1[0] + b1[0], a1[2] + b1[2]}, s2[4] = {a0[1] + b0[1], a0[3] + b0[3], a1[1] + b1[1], a1[3] + b1[3]};
#pragma unroll
            for (int it = 0; it < 2; ++it) { const float gt[4] = {bflo(gfp[it].x), bfhi(gfp[it].x), bflo(gfp[it].y), bfhi(gfp[it].y)}, vt[4] = {bflo(vfp[it].x), bfhi(vfp[it].x), bflo(vfp[it].y), bfhi(vfp[it].y)};
#pragma unroll
                for (int r = 0; r < 4; ++r) { const float mean = s1[r] * (1.0f / 64.0f), var = fmaxf(s2[r] * (1.0f / 64.0f) - mean * mean, 0.f), rstd = rsqrtf(var + 64e-5f);
                    if (!(HACK & 2)) MIX[(size_t)((ck - 1) * 16 + 4 * g + r) * DM + 16 * it] = (bf16)f2bf(((Yp[it][r] - mean) * rstd * lnw[it] + lnb[it] + bnp[r] * vt[r]) * gt[r]); } }
            if (ck == 512) break;
        }
        const LAS unsigned char* R = L + (ck & 1) * RC_BYTES;
        bf16x8 at[2], rt[2];
#pragma unroll
        for (int kk = 0; kk < 2; ++kk) { at[kk] = *(const LAS bf16x8*)(R + RC_AT + kk * 1024 + lane * 16); rt[kk] = *(const LAS bf16x8*)(R + RC_RT + kk * 1024 + lane * 16); }
        f32x4v U[2], Y[2];
#pragma unroll
        for (int it = 0; it < 2; ++it) { U[it] = *(const LAS f32x4v*)(R + RC_U0 + (2 * cw + it) * 1024 + lane * 16); Y[it] = *(const LAS f32x4v*)(R + RC_Y0 + (2 * cw + it) * 1024 + lane * 16); }
#pragma unroll
        for (int kk = 0; kk < 2; ++kk)
#pragma unroll
            for (int it = 0; it < 2; ++it) { v4u pw; pw.x = pg8::cvt_pk_bf16(S[2 * kk][it][0], S[2 * kk][it][1]); pw.y = pg8::cvt_pk_bf16(S[2 * kk][it][2], S[2 * kk][it][3]);
                pw.z = pg8::cvt_pk_bf16(S[2 * kk + 1][it][0], S[2 * kk + 1][it][1]); pw.w = pg8::cvt_pk_bf16(S[2 * kk + 1][it][2], S[2 * kk + 1][it][3]); const bf16x8 sf = __builtin_bit_cast(bf16x8, pw);
                U[it] = __builtin_amdgcn_mfma_f32_16x16x32_bf16(at[kk], sf, U[it], 0, 0, 0); Y[it] = __builtin_amdgcn_mfma_f32_16x16x32_bf16(rt[kk], sf, Y[it], 0, 0, 0); }
        bf16x8 uv[2];
#pragma unroll
        for (int it = 0; it < 2; ++it) { vfp[it] = *(const LAS v2u*)(R + RC_VF + (2 * cw + it) * 512 + lane * 8); gfp[it] = *(const LAS v2u*)(R + RC_GF + (2 * cw + it) * 512 + lane * 8);
            v4u pw; pw.x = pg8::cvt_pk_bf16(U[it][0], U[it][1]); pw.y = pg8::cvt_pk_bf16(U[it][2], U[it][3]); pw.z = vfp[it].x; pw.w = vfp[it].y; uv[it] = __builtin_bit_cast(bf16x8, pw); }
#pragma unroll
        for (int jt = 0; jt < 4; ++jt) { const bf16x8 bk = *(const LAS bf16x8*)(R + RC_BK + jt * 1024 + lane * 16); const f32x4v p15 = *(const LAS f32x4v*)(R + RC_P15 + (16 * jt + 4 * g) * 4);
#pragma unroll
            for (int it = 0; it < 2; ++it) S[jt][it] = __builtin_amdgcn_mfma_f32_16x16x32_bf16(bk, uv[it], S[jt][it] * p15, 0, 0, 0); }
        bnp = *(const LAS f32x4v*)(R + RC_BN + 16 * g); Yp[0] = Y[0]; Yp[1] = Y[1];
        { LAS float* xo = XS + (ck & 1) * 64 + cw * 32; const f32x4v sm = Y[0] + Y[1], sq = Y[0] * Y[0] + Y[1] * Y[1];
#pragma unroll
          for (int r = 0; r < 4; ++r) { const float a = sum16(sm[r]), q = sum16(sq[r]); if (n == 0) { xo[(4 * g + r) * 2] = a; xo[(4 * g + r) * 2 + 1] = q; } } }
        LDS_BARRIER();
    }
}
template <int HACK = 0> __device__ __forceinline__ void mixers_v4(Frame& F, int l, int qi, int mask = 15) {
    gu32* ctr = F.ctl + CW_Q + 64 * qi;
    for (;;) {
        const int it = next_item(F, ctr); relaunder(F); relaunder_tid(F);
        if (it < 32) { if (mask & 1) rwkv_scan_unit<HACK>(F, l, it >> 4, it & 15); }
        else if (it < 40) { const int j = it - 32; if (mask & 2) gla_scan_unit<HACK>(F, l, j >> 2, j & 3); }
        else if (it < 40 + 1024) { const int j = it - 40, qb = 63 - (j >> 4), bh = j & 15; if (mask & 4) attn_unit<true>(F, l, bh >> 3, bh & 7, qb); }
        else if (it < 40 + 2048) { const int j = it - 1064, qb = j & 63, bh = j >> 6; if (mask & 8) attn_unit<false>(F, l, bh >> 3, bh & 7, qb); }
        else break;
    }
}
struct Args { const float* in[35]; float* out; unsigned char* ws; };
__device__ __forceinline__ void mk_frame(Frame& F, int wv) {
    extern __shared__ __attribute__((aligned(16))) unsigned char lds[];
    kargp kp = (kargp)__builtin_amdgcn_kernarg_segment_ptr(); asm volatile("" : "+s"(kp));
    F.kin = kp;
    F.lds = (LAS unsigned char*)lds;
    F.MISC = (volatile LAS unsigned*)(F.lds + MISC_OFF);
    { int w_ = wv; asm volatile("" : "+s"(w_)); int t_ = (int)__builtin_amdgcn_mbcnt_hi(~0u, __builtin_amdgcn_mbcnt_lo(~0u, (unsigned)w_ * 64u)); asm volatile("" : "+v"(t_)); F.tid = t_; } F.lane = F.tid & 63; F.wave = __builtin_amdgcn_readfirstlane(F.tid >> 6);
    F.G = gridDim.x; { int bx = blockIdx.x; asm volatile("" : "+s"(bx)); F.bx = bx; F.vcu = (F.G % 8 == 0) ? (bx % 8) * (F.G / 8) + bx / 8 : bx; }
    F.out = (float*)kp[35]; F.ws = (unsigned char*)kp[36]; F.ctl = (gu32*)(F.ws + WS_CTL);
}
__device__ __forceinline__ void grid_bar(int wv) {
    Frame F; mk_frame(F, wv);
    XcdBarrier bar; bar.bar = (unsigned*)(F.ctl + CW_BAR); bar.x = xb_xcc_id(); bar.st = F.MISC + 8;
    xcd_barrier(bar);
}
__global__ void __launch_bounds__(NWAVES * 64, 2) mega_fwd(Args args) {
    const int wv = __builtin_amdgcn_readfirstlane((int)threadIdx.x >> 6);
    { Frame F; mk_frame(F, wv);
      for (int u = F.tid; u < (LDS_BYTES - LDSCTL_OFF) / 4; u += NWAVES * 64) ((LAS unsigned*)(F.lds + LDSCTL_OFF))[u] = 0u;
      __syncthreads();
      (void)xcd_barrier_post((unsigned*)(F.ctl + CW_BAR), F.MISC + 8);
#ifndef NO_P0
      p0_prologue_a(F);
#endif
    }
    grid_bar(wv);
    { Frame F; mk_frame(F, wv); p0_prologue_b(F); }
    grid_bar(wv);
#pragma unroll 1
    for (int l = 0; l < NLAYER; ++l) {
#ifndef REP_HACK
#define REP_HACK 0
#endif
#define LAYER_VARS const float* mod = WSP(float, WS_MOD) + (size_t)l * 2 * 24576; const float* xin = l == 0 ? F.kin[I_X] : F.out; (void)mod; (void)xin
#ifndef NO_RMS
        { Frame F; mk_frame(F, wv); LAYER_VARS; rms_phase(F, xin, mod + 0, mod + 4096); }
#endif
        grid_bar(wv);
#ifndef NO_G1
        { Frame F; mk_frame(F, wv);
          pg8::Gemm g{WSP(pg8::bf16_t, WS_XN), WSP(pg8::bf16_t, WS_WIN + l * WIN_L), M, NIN, DM}; pg8::StaticOrder S; S.init(M, NIN, F.G, F.bx);
          pg8::EpiCols E{WSP(pg8::bf16_t, WS_COLS), WSP(float, WS_LOWR)};
          pg8::gemm_phase<pg8::EpiCols, pg8::StaticOrder, true, true>(F.lds + RING_OFF, g, S, E, F.tid); }
#endif
#ifdef REP_IN
        grid_bar(wv);
        { Frame F; mk_frame(F, wv);
          pg8::Gemm g{WSP(pg8::bf16_t, WS_XN), WSP(pg8::bf16_t, WS_WIN + l * WIN_L), M, NIN, DM}; pg8::StaticOrder S; S.init(M, NIN, F.G, F.bx);
          pg8::EpiCols E{WSP(pg8::bf16_t, WS_COLS), WSP(float, WS_LOWR)};
          pg8::gemm_phase<pg8::EpiCols, pg8::StaticOrder, true, true>(F.lds + RING_OFF, g, S, E, F.tid); }
#endif
        grid_bar(wv);
#ifndef NO_PREP
        { Frame F; mk_frame(F, wv); prep_norm(F, l); }
        { Frame F; mk_frame(F, wv); prep_loga(F, l); }
        { Frame F; mk_frame(F, wv); prep_rwkv(F, l); }
#ifdef REP_P2
        { Frame F; mk_frame(F, wv); prep_rwkv(F, l); }
#endif
        { Frame F; mk_frame(F, wv); prep_vt(F, 0); }
        { Frame F; mk_frame(F, wv); prep_vt(F, 1); }
        { Frame F; mk_frame(F, wv); prep_gla(F); }
#ifdef REP_P3
        { Frame F; mk_frame(F, wv); prep_vt(F, 0); }
        { Frame F; mk_frame(F, wv); prep_vt(F, 1); }
        { Frame F; mk_frame(F, wv); prep_gla(F); }
#endif
        grid_bar(wv);
        { Frame F; mk_frame(F, wv); prep_rwkv_chunks(F, l); }
#ifdef REP_P4
        { Frame F; mk_frame(F, wv); prep_rwkv_chunks(F, l); }
#endif
#endif
#ifdef REP_PREP
        grid_bar(wv);
        { Frame F; mk_frame(F, wv); prep_norm(F, l); }
        { Frame F; mk_frame(F, wv); prep_loga(F, l); }
        { Frame F; mk_frame(F, wv); prep_rwkv(F, l); }
        { Frame F; mk_frame(F, wv); prep_vt(F, 0); }
        { Frame F; mk_frame(F, wv); prep_vt(F, 1); }
        { Frame F; mk_frame(F, wv); prep_gla(F); }
        grid_bar(wv);
        { Frame F; mk_frame(F, wv); prep_rwkv_chunks(F, l); }
#endif
        grid_bar(wv);
#ifndef NO_MIX
#ifdef REP_MIX
        { Frame F; mk_frame(F, wv); mixers_v4<REP_HACK>(F, l, l + 2, REP_MIX); }
        grid_bar(wv);
#endif
        { Frame F; mk_frame(F, wv); mixers_v4(F, l, l); }
#endif
        grid_bar(wv);
#ifndef NO_G2
        { Frame F; mk_frame(F, wv); LAYER_VARS;
          pg8::Gemm g{WSP(pg8::bf16_t, WS_MIXED), WSP(pg8::bf16_t, WS_WOUT + l * WOUT_L), M, DM, DM}; pg8::StaticOrder S; S.init(M, DM, F.G, F.bx);
          pg8::EpiRes E{xin, F.out, mod + 2 * 4096};
          pg8::gemm_phase<pg8::EpiRes, pg8::StaticOrder, true, true>(F.lds + RING_OFF, g, S, E, F.tid); }
#endif
        grid_bar(wv);
        { Frame F; mk_frame(F, wv); LAYER_VARS; rms_phase(F, F.out, mod + 3 * 4096, mod + 4 * 4096); }
        grid_bar(wv);
#ifndef NO_G3
        { Frame F; mk_frame(F, wv);
          pg8::Gemm g{WSP(pg8::bf16_t, WS_XN), WSP(pg8::bf16_t, WS_W13 + l * W13_L), M, 2 * DFF, DM}; pg8::StaticOrder S; S.init(M, 2 * DFF, F.G, F.bx);
          pg8::EpiSwiglu E{WSP(pg8::bf16_t, WS_HID)};
          pg8::gemm_phase<pg8::EpiSwiglu, pg8::StaticOrder, true, true>(F.lds + RING_OFF, g, S, E, F.tid); }
#endif
#ifdef REP_UP
        grid_bar(wv);
        { Frame F; mk_frame(F, wv);
          pg8::Gemm g{WSP(pg8::bf16_t, WS_XN), WSP(pg8::bf16_t, WS_W13 + l * W13_L), M, 2 * DFF, DM}; pg8::StaticOrder S; S.init(M, 2 * DFF, F.G, F.bx);
          pg8::EpiSwiglu E{WSP(pg8::bf16_t, WS_HID)};
          pg8::gemm_phase<pg8::EpiSwiglu, pg8::StaticOrder, true, true>(F.lds + RING_OFF, g, S, E, F.tid); }
#endif
        grid_bar(wv);
#ifndef NO_G4
        { Frame F; mk_frame(F, wv); LAYER_VARS;
          pg8::Gemm g{WSP(pg8::bf16_t, WS_HID), WSP(pg8::bf16_t, WS_W2 + l * W2_L), M, DM, DFF}; pg8::StaticOrder S; S.init(M, DM, F.G, F.bx);
          pg8::EpiRes E{F.out, F.out, mod + 5 * 4096};
          pg8::gemm_phase<pg8::EpiRes, pg8::StaticOrder, true, true>(F.lds + RING_OFF, g, S, E, F.tid); }
#endif
        if (l + 1 < NLAYER) grid_bar(wv);
#undef LAYER_VARS
    }
}

extern "C" void kernel_launch(void* const* d_in, const int* in_sizes, int n_in, void* d_out, int out_size, void* d_ws, size_t ws_size, hipStream_t stream) {
    static int grid = 0;
    if (grid == 0) {
        if (n_in != 35 || in_sizes[0] != M * DM || out_size != M * DM || ws_size < WS_END) { fprintf(stderr, "kernel_launch: unexpected shapes: n_in %d in0 %d out %d ws %zu (need %zu)\n", n_in, n_in > 0 ? in_sizes[0] : -1, out_size, ws_size, (size_t)WS_END); grid = -1; return; }
        int dev = 0, cus = 0, per_cu = 0;
        if (hipGetDevice(&dev) != hipSuccess || hipDeviceGetAttribute(&cus, hipDeviceAttributeMultiprocessorCount, dev) != hipSuccess) { grid = -1; return; }
        if (hipFuncSetAttribute((const void*)mega_fwd, hipFuncAttributeMaxDynamicSharedMemorySize, LDS_BYTES) != hipSuccess) { fprintf(stderr, "kernel_launch: hipFuncSetAttribute failed\n"); grid = -1; return; }
        if (hipOccupancyMaxActiveBlocksPerMultiprocessor(&per_cu, (const void*)mega_fwd, NWAVES * 64, LDS_BYTES) != hipSuccess || per_cu < 1) fprintf(stderr, "kernel_launch: occupancy query says %d\n", per_cu);
        (void)hipGetLastError();
        grid = cus;
    }
    if (grid < 0) return;
    if (hipMemsetAsync((char*)d_ws + WS_CTL, 0, CTL_ZERO_BYTES, stream) != hipSuccess) return;
    Args a{};
    for (int i = 0; i < 35; ++i) a.in[i] = (const float*)d_in[i];
    a.out = (float*)d_out; a.ws = (unsigned char*)d_ws;
    hipLaunchKernelGGL(mega_fwd, dim3(grid), dim3(NWAVES * 64), LDS_BYTES, stream, a);
}
```

```cpp
#include <hip/hip_runtime.h>
#include <cstdio>
#include <cstdint>
namespace pg8 {
#define PG8_LAS __attribute__((address_space(3)))
typedef unsigned short bf16_t;
typedef short bf16x8 __attribute__((ext_vector_type(8)));
typedef float f32x4 __attribute__((ext_vector_type(4)));
typedef unsigned u32x4 __attribute__((ext_vector_type(4)));
constexpr int BM = 256, BK = 64, HALF = 128, HTB = HALF * BK * 2  , STAGE_BYTES = 8 * HTB, NXCD = 8, WGM = 8;

__host__ __device__ __forceinline__ int lds_byte(int r, int c) { const int st = (r >> 4) * 2 + (c >> 5), rr = r & 15, cc = c & 31, ob = rr * 64 + cc * 2; return st * 1024 + (ob ^ (((ob >> 9) & 1) << 5)); }
__host__ __device__ __forceinline__ void stage_rc(int b, int& R, int& C) { const int st = b / 1024, sb = b % 1024, swz = sb ^ (((sb >> 9) & 1) << 5); R = (st >> 1) * 16 + swz / 64; C = (st & 1) * 32 + (swz % 64) / 2; }
__host__ __device__ __forceinline__ int perm32(int rho) { const int n = rho >> 4, i = rho & 15; return 8 * (i >> 2) + 4 * n + (i & 3); }

struct Unit { int pm, pn; };
struct Gemm { const bf16_t* A; const bf16_t* Bt; int M, N, K; };

struct StaticOrder {
    int nM, nN, nwg, G, c;
    __host__ __device__ void init(int M, int N, int G_, int c_) { nM = M / BM; nN = N / BM; nwg = nM * nN; G = G_; c = c_; }
    __host__ __device__ bool next(int i, Unit& u) const {
        const long L = (long)i * G + c; if (L >= nwg) return false;
        int wgid = (int)L; { const int q = nwg / NXCD, r = nwg % NXCD, xcd = wgid % NXCD, off = wgid / NXCD; wgid = (xcd < r ? xcd * (q + 1) : r * (q + 1) + (xcd - r) * q) + off; }
        const int nig = WGM * nN, gid = wgid / nig, fm = gid * WGM, gsz = (nM - fm) < WGM ? (nM - fm) : WGM;
        u.pm = fm + ((wgid % nig) % gsz); u.pn = (wgid % nig) / gsz; return true;
    }
    __device__ __forceinline__ void a_ready(const Unit&) const {}
    __device__ __forceinline__ void done(const Unit&) const {}
};

typedef float f32x2c_t __attribute__((ext_vector_type(2))); typedef __bf16 bf16x2c_t __attribute__((ext_vector_type(2)));
__device__ __forceinline__ unsigned cvt_pk_bf16(float lo, float hi) { const f32x2c_t v = {lo, hi}; return __builtin_bit_cast(unsigned, __builtin_convertvector(v, bf16x2c_t)); }
typedef float f32x2 __attribute__((ext_vector_type(2)));
__device__ __forceinline__ float silu_f(float x) { return x * __builtin_amdgcn_rcpf(1.0f + __builtin_amdgcn_exp2f(-1.4426950408889634f * x)); }
struct EpiCols {
    static constexpr bool PERM = true, AFTER_DRAIN = false;
    bf16_t* O; float* L;
    __device__ __forceinline__ void operator()(const f32x4 (&acc)[2][2][4][2], const Unit& u, int wr, int wc, int fr, int fq) const {
        const int row0 = u.pm * BM + wr * 64 + fr;
        if (u.pn < 41) {
            const int col0 = u.pn * BM + wc * 32 + 8 * fq;
#pragma unroll
            for (int ai = 0; ai < 2; ++ai)
#pragma unroll
                for (int m = 0; m < 4; ++m) { bf16_t* rowp = O + (size_t)(row0 + ai * HALF + m * 16) * 10496 + col0;
#pragma unroll
                    for (int bj = 0; bj < 2; ++bj) { const f32x4 v0 = acc[ai][bj][m][0], v1 = acc[ai][bj][m][1];
                        u32x4 w; w.x = cvt_pk_bf16(v0[0], v0[1]); w.y = cvt_pk_bf16(v0[2], v0[3]); w.z = cvt_pk_bf16(v1[0], v1[1]); w.w = cvt_pk_bf16(v1[2], v1[3]);
                        *(u32x4*)(rowp + bj * HALF) = w; } }
        } else {
            const int col0 = wc * 32 + 8 * fq;
#pragma unroll
            for (int ai = 0; ai < 2; ++ai)
#pragma unroll
                for (int m = 0; m < 4; ++m) { float* rowp = L + (size_t)(row0 + ai * HALF + m * 16) * 256 + col0;
#pragma unroll
                    for (int bj = 0; bj < 2; ++bj) { *(f32x4*)(rowp + bj * HALF) = acc[ai][bj][m][0]; *(f32x4*)(rowp + bj * HALF + 4) = acc[ai][bj][m][1]; } }
        }
    }
};
struct EpiRes {
    static constexpr bool PERM = false, AFTER_DRAIN = false;
    const float* base; float* out; const float* gate;
    __device__ __forceinline__ void operator()(const f32x4 (&acc)[2][2][4][2], const Unit& u, int wr, int wc, int fr, int fq) const {
        const int row0 = u.pm * BM + wr * 64 + fr, col0 = u.pn * BM + wc * 32 + 4 * fq;
        const float* gp = gate + (size_t)(u.pm >> 5) * 24576 + col0;
        f32x4 gv[2][2];
#pragma unroll
        for (int bj = 0; bj < 2; ++bj)
#pragma unroll
            for (int n = 0; n < 2; ++n) gv[bj][n] = *(const f32x4*)(gp + bj * HALF + n * 16);
#pragma unroll
        for (int ai = 0; ai < 2; ++ai)
#pragma unroll
            for (int m = 0; m < 4; ++m) { const size_t off = (size_t)(row0 + ai * HALF + m * 16) * 4096 + col0;
#pragma unroll
                for (int bj = 0; bj < 2; ++bj)
#pragma unroll
                    for (int n = 0; n < 2; ++n) { const f32x4 bs = *(const f32x4*)(base + off + bj * HALF + n * 16); *(f32x4*)(out + off + bj * HALF + n * 16) = bs + gv[bj][n] * acc[ai][bj][m][n]; }
                if (m & 1) asm volatile("" ::: "memory"); }
    }
};
struct EpiSwiglu {
    static constexpr bool PERM = true, AFTER_DRAIN = false;
    bf16_t* H;
    __device__ __forceinline__ void operator()(const f32x4 (&acc)[2][2][4][2], const Unit& u, int wr, int wc, int fr, int fq) const {
        const int row0 = u.pm * BM + wr * 64 + fr, col0 = u.pn * HALF + wc * 32 + 8 * fq;
#pragma unroll
        for (int ai = 0; ai < 2; ++ai)
#pragma unroll
            for (int m = 0; m < 4; ++m) { bf16_t* rowp = H + (size_t)(row0 + ai * HALF + m * 16) * 11008 + col0;
                const f32x4 a0 = acc[ai][0][m][0], a1 = acc[ai][0][m][1], b0 = acc[ai][1][m][0], b1 = acc[ai][1][m][1];
                u32x4 w; w.x = cvt_pk_bf16(silu_f(a0[0]) * b0[0], silu_f(a0[1]) * b0[1]); w.y = cvt_pk_bf16(silu_f(a0[2]) * b0[2], silu_f(a0[3]) * b0[3]);
                w.z = cvt_pk_bf16(silu_f(a1[0]) * b1[0], silu_f(a1[1]) * b1[1]); w.w = cvt_pk_bf16(silu_f(a1[2]) * b1[2], silu_f(a1[3]) * b1[3]);
                *(u32x4*)rowp = w; }
    }
};
template <class Epi, class Sched, bool ALIGN_EPI = false, bool SP2 = false>
__device__ __forceinline__ void gemm_phase(PG8_LAS unsigned char* lds, const Gemm g, const Sched& S, const Epi& E, int tid_in) {
    int tid_ = tid_in; asm volatile("" : "+v"(tid_));
    const int tid = tid_, wid = __builtin_amdgcn_readfirstlane(tid >> 6), lane = tid & 63, wr = wid >> 2, wc = wid & 3, fr = lane & 15, fq = lane >> 4;
    const int K = g.K, nt = K / BK;
    unsigned voffA[2], voffB[2];
#pragma unroll
    for (int i = 0; i < 2; ++i) { int R, C; stage_rc(tid * 16 + i * 8192, R, C); const int Rb = Epi::PERM ? ((R & ~31) + perm32(R & 31)) : R;
        voffA[i] = (unsigned)(R * K + C) * 2u; voffB[i] = (unsigned)(Rb * K + C) * 2u; }
    const size_t kstep = (size_t)(BK * 2);
    const size_t hstep = (size_t)HALF * K * 2;
    const size_t tstep = 2 * hstep;
    const unsigned ldsw = (unsigned)wid * 1024u;
    const int aoff = lds_byte(wr * 64 + fr, fq * 8), boff = lds_byte(wc * 32 + fr, fq * 8);
#define PG8_SA(b, h) (((b) * 2 + (h)) * HTB)
#define PG8_SB(b, h) ((4 + (b) * 2 + (h)) * HTB)
#define PG8_STAGE(bufoff, gbase, voff) do { _Pragma("unroll") for (int _i = 0; _i < 2; ++_i) \
        __builtin_amdgcn_global_load_lds((const unsigned*)((const char*)(gbase) + (voff)[_i]), (PG8_LAS unsigned*)(lds + (bufoff) + ldsw + _i * 8192), 16, 0, 0); } while (0)
#define PG8_LDA(dst, b, h) do { _Pragma("unroll") for (int m = 0; m < 4; ++m) _Pragma("unroll") for (int k = 0; k < 2; ++k) dst[m][k] = *(const PG8_LAS bf16x8*)(lds + PG8_SA(b, h) + aoff + m * 2048 + k * 1024); } while (0)
#define PG8_LDB(dst, b, h) do { _Pragma("unroll") for (int n = 0; n < 2; ++n) _Pragma("unroll") for (int k = 0; k < 2; ++k) dst[n][k] = *(const PG8_LAS bf16x8*)(lds + PG8_SB(b, h) + boff + n * 2048 + k * 1024); } while (0)
#define PG8_MMA(ai, bj, At, Bt) do { __builtin_amdgcn_s_setprio(1); _Pragma("unroll") for (int m = 0; m < 4; ++m) _Pragma("unroll") for (int n = 0; n < 2; ++n) _Pragma("unroll") for (int k = 0; k < 2; ++k) \
        acc[ai][bj][m][n] = __builtin_amdgcn_mfma_f32_16x16x32_bf16(Bt[n][k], At[m][k], acc[ai][bj][m][n], 0, 0, 0); __builtin_amdgcn_s_setprio(0); } while (0)
#define PG8_WAIT_V(n) asm volatile("s_waitcnt vmcnt(" #n ")" ::: "memory")
#define PG8_WAIT_L(n) asm volatile("s_waitcnt lgkmcnt(" #n ")" ::: "memory")
#define PG8_BAR __builtin_amdgcn_s_barrier()
#define PG8_SCHED __builtin_amdgcn_sched_barrier(0)
    Unit cur, nxt; int ui = 0;
    if (!S.next(0, cur)) return;
    f32x4 acc[2][2][4][2];
#pragma unroll
    for (int a = 0; a < 2; ++a)
#pragma unroll
        for (int b = 0; b < 2; ++b)
#pragma unroll
            for (int m = 0; m < 4; ++m)
#pragma unroll
                for (int n = 0; n < 2; ++n) acc[a][b][m][n] = (f32x4){0.f, 0.f, 0.f, 0.f};
    bf16x8 At[4][2], B0[2][2], B1[2][2];
    const char* cA = (const char*)g.A + (size_t)cur.pm * tstep; const char* cB = (const char*)g.Bt + (size_t)cur.pn * tstep;
    S.a_ready(cur);
    if constexpr (SP2) {
        PG8_STAGE(PG8_SB(0, 0), cB, voffB); PG8_STAGE(PG8_SB(0, 1), cB + hstep, voffB); PG8_STAGE(PG8_SA(0, 0), cA, voffA); PG8_STAGE(PG8_SA(0, 1), cA + hstep, voffA);
        if (wr == 1) PG8_BAR;
        PG8_WAIT_V(2); PG8_BAR;
        PG8_STAGE(PG8_SB(1, 0), cB + kstep, voffB); PG8_STAGE(PG8_SA(1, 0), cA + kstep, voffA); PG8_STAGE(PG8_SB(1, 1), cB + hstep + kstep, voffB);
        PG8_WAIT_V(6); PG8_BAR;
    } else {
        PG8_STAGE(PG8_SB(0, 0), cB, voffB); PG8_STAGE(PG8_SA(0, 0), cA, voffA); PG8_STAGE(PG8_SB(0, 1), cB + hstep, voffB); PG8_STAGE(PG8_SA(0, 1), cA + hstep, voffA);
        if (wr == 1) PG8_BAR;
        PG8_WAIT_V(4); PG8_BAR;
        PG8_STAGE(PG8_SB(1, 0), cB + kstep, voffB); PG8_STAGE(PG8_SA(1, 0), cA + kstep, voffA); PG8_STAGE(PG8_SB(1, 1), cB + hstep + kstep, voffB);
        PG8_WAIT_V(6); PG8_BAR;
    }
    for (;;) {
        const bool has_next = S.next(ui + 1, nxt);
        const char* nA = has_next ? (const char*)g.A + (size_t)nxt.pm * tstep : cA; const char* nB = has_next ? (const char*)g.Bt + (size_t)nxt.pn * tstep : cB;
        for (int t = 0; t < nt; t += 2) {
            const bool last = (t == nt - 2);
            const char* a1 = cA + (size_t)(t + 1) * kstep;
            const char* a2 = last ? nA : cA + (size_t)(t + 2) * kstep; const char* b2 = last ? nB : cB + (size_t)(t + 2) * kstep;
            const char* a3 = a2 + kstep; const char* b3 = b2 + kstep;
            if (last && has_next) S.a_ready(nxt);
            if constexpr (SP2) {
            PG8_LDB(B0, 0, 0); PG8_LDB(B1, 0, 1); PG8_SCHED; PG8_LDA(At, 0, 0); PG8_STAGE(PG8_SA(1, 1), a1 + hstep, voffA);
            PG8_WAIT_V(8); PG8_WAIT_L(0); PG8_BAR; PG8_MMA(0, 0, At, B0); PG8_MMA(0, 1, At, B1); PG8_BAR; PG8_SCHED;
            PG8_LDA(At, 0, 1); PG8_STAGE(PG8_SB(0, 0), b2, voffB); PG8_STAGE(PG8_SB(0, 1), b2 + hstep, voffB); PG8_STAGE(PG8_SA(0, 0), a2, voffA);
            PG8_WAIT_V(8); PG8_WAIT_L(0); PG8_BAR; PG8_MMA(1, 0, At, B0); PG8_MMA(1, 1, At, B1); PG8_BAR; PG8_SCHED;
            PG8_LDB(B0, 1, 0); PG8_LDB(B1, 1, 1); PG8_SCHED; PG8_LDA(At, 1, 0); PG8_STAGE(PG8_SA(0, 1), a2 + hstep, voffA);
            PG8_WAIT_V(8); PG8_WAIT_L(0); PG8_BAR; PG8_MMA(0, 0, At, B0); PG8_MMA(0, 1, At, B1); PG8_BAR; PG8_SCHED;
            PG8_LDA(At, 1, 1); PG8_STAGE(PG8_SB(1, 0), b3, voffB); PG8_STAGE(PG8_SB(1, 1), b3 + hstep, voffB); PG8_STAGE(PG8_SA(1, 0), a3, voffA);
            PG8_WAIT_V(8); PG8_WAIT_L(0); PG8_BAR; PG8_MMA(1, 0, At, B0); PG8_MMA(1, 1, At, B1); PG8_BAR; PG8_SCHED;
            } else {
            PG8_LDB(B0, 0, 0); PG8_SCHED; PG8_LDA(At, 0, 0); PG8_STAGE(PG8_SA(1, 1), a1 + hstep, voffA);
            PG8_WAIT_L(8); PG8_BAR; PG8_WAIT_L(0); PG8_MMA(0, 0, At, B0); PG8_BAR; PG8_SCHED;
            PG8_LDB(B1, 0, 1); PG8_STAGE(PG8_SB(0, 0), b2, voffB);
            PG8_BAR; PG8_WAIT_L(0); PG8_MMA(0, 1, At, B1); PG8_BAR;
            PG8_LDA(At, 0, 1); PG8_STAGE(PG8_SA(0, 0), a2, voffA);
            PG8_BAR; PG8_WAIT_L(0); PG8_MMA(1, 0, At, B0); PG8_BAR; PG8_SCHED;
            PG8_STAGE(PG8_SB(0, 1), b2 + hstep, voffB);
            PG8_WAIT_V(6); PG8_BAR; PG8_MMA(1, 1, At, B1); PG8_BAR;
            PG8_LDB(B0, 1, 0); PG8_SCHED; PG8_LDA(At, 1, 0); PG8_STAGE(PG8_SA(0, 1), a2 + hstep, voffA);
            PG8_WAIT_L(8); PG8_BAR; PG8_WAIT_L(0); PG8_MMA(0, 0, At, B0); PG8_BAR; PG8_SCHED;
            PG8_LDB(B1, 1, 1); PG8_STAGE(PG8_SB(1, 0), b3, voffB);
            PG8_BAR; PG8_WAIT_L(0); PG8_MMA(0, 1, At, B1); PG8_BAR;
            PG8_LDA(At, 1, 1); PG8_STAGE(PG8_SA(1, 0), a3, voffA);
            PG8_BAR; PG8_WAIT_L(0); PG8_MMA(1, 0, At, B0); PG8_BAR; PG8_SCHED;
            PG8_STAGE(PG8_SB(1, 1), b3 + hstep, voffB);
            PG8_WAIT_V(6); PG8_BAR; PG8_MMA(1, 1, At, B1); PG8_BAR;
            }
        }
        if constexpr (ALIGN_EPI) { if (wr == 0) PG8_BAR; }
        if constexpr (!Epi::AFTER_DRAIN) { E(acc, cur, wr, wc, fr, fq); S.done(cur); }
        if (!has_next) break;
#pragma unroll
        for (int a = 0; a < 2; ++a)
#pragma unroll
            for (int b = 0; b < 2; ++b)
#pragma unroll
                for (int m = 0; m < 4; ++m)
#pragma unroll
                    for (int n = 0; n < 2; ++n) acc[a][b][m][n] = (f32x4){0.f, 0.f, 0.f, 0.f};
        cur = nxt; cA = nA; cB = nB; ++ui;
        if constexpr (ALIGN_EPI) { if (wr == 1) PG8_BAR; }
    }
    PG8_WAIT_V(0);
    if constexpr (!ALIGN_EPI) { if (wr == 0) PG8_BAR; }
    PG8_BAR;
    if constexpr (Epi::AFTER_DRAIN) { E.fused(acc, cur, wr, wc, fr, fq, lds, wid, lane); S.done(cur); }
#undef PG8_SA
#undef PG8_SB
#undef PG8_STAGE
#undef PG8_LDA
#undef PG8_LDB
#undef PG8_MMA
#undef PG8_WAIT_V
#undef PG8_WAIT_L
#undef PG8_BAR
#undef PG8_SCHED
}
}
constexpr int BATCH = 2, SEQ = 8192, DM = 4096, M = BATCH * SEQ, DFF = 11008, NLAYER = 2;
constexpr int P_IN = 10704, NIN = 10752, NMAIN = 10496;
constexpr int CA_Q = 0, CA_K = 1024, CA_V = 2048;
constexpr int CB_Q = 3072, CB_K = 3584, CB_V = 4096, CB_G = 5120;
constexpr int CC_R = 6144, CC_K = 7168, CC_V = 8192;
constexpr int CD_Q = 9216, CD_K = 10240, CD_V = 10368;
constexpr float LOG2E = 1.4426950408889634f;
constexpr float QSCALE = 0.125f * LOG2E;
constexpr int NWAVES = 8;

constexpr size_t MiB = 1u << 20;
constexpr size_t WS_CTL = 0, CTL_ZERO_BYTES = 1 * MiB;
constexpr size_t WS_MODP = 2 * MiB;
constexpr size_t WS_MOD = 14 * MiB;
constexpr size_t WS_TAB = 15 * MiB;
constexpr size_t WS_WIN = 16 * MiB, WIN_L = 84 * MiB;
constexpr size_t WS_WOUT = 184 * MiB, WOUT_L = 32 * MiB;
constexpr size_t WS_W13 = 248 * MiB, W13_L = 172 * MiB;
constexpr size_t WS_W2 = 592 * MiB, W2_L = 86 * MiB;
constexpr size_t WS_XN = 764 * MiB;
constexpr size_t WS_COLS = 892 * MiB;
constexpr size_t WS_LOWR = 1220 * MiB;
constexpr size_t WS_HID = 892 * MiB;
constexpr size_t WS_QKA = 1236 * MiB;
constexpr size_t WS_QKD = 1300 * MiB;
constexpr size_t WS_LOGA = 1336 * MiB;
constexpr size_t WS_RW = 1368 * MiB, RW_ONE = 64 * MiB;
constexpr size_t WS_VFIRST = 1816 * MiB;
constexpr size_t WS_MIXED = 1880 * MiB;
constexpr int VROW = SEQ + 64;
constexpr size_t WS_VTA = 2008 * MiB;
constexpr size_t WS_VTD = 2041 * MiB;
constexpr size_t WS_QDEC = 2046 * MiB, WS_KDT = 2062 * MiB, WS_AM = 2078 * MiB, WS_EBL = 2086 * MiB;
constexpr size_t WS_VTB = 2087 * MiB;
constexpr size_t WS_RWC = 2120 * MiB;
constexpr size_t WS_END = 2446 * MiB;
constexpr int CW_BAR = 4096;
constexpr int CW_Q = 16384;

constexpr int RING_OFF = 0, RING_BYTES = 131072;
constexpr int LDSCTL_OFF = RING_BYTES, MISC_OFF = LDSCTL_OFF + 320;
constexpr int LDS_BYTES = 147456;

#define GAS __attribute__((address_space(1)))
#define LAS __attribute__((address_space(3)))
typedef unsigned short bf16;
typedef unsigned v4u __attribute__((ext_vector_type(4)));
typedef unsigned v2u __attribute__((ext_vector_type(2)));
typedef float f32x4 __attribute__((ext_vector_type(4)));
typedef short bf16x8 __attribute__((ext_vector_type(8)));
typedef GAS unsigned gu32;
#define RLX_AGENT __ATOMIC_RELAXED, __HIP_MEMORY_SCOPE_AGENT
#define LDS_WAIT() asm volatile("s_waitcnt lgkmcnt(0)" ::: "memory")
#define VM_WAIT() asm volatile("s_waitcnt vmcnt(0)" ::: "memory")
typedef float f32x2_t __attribute__((ext_vector_type(2))); typedef __bf16 bf16x2_t __attribute__((ext_vector_type(2)));
__device__ __forceinline__ unsigned pk2(float lo, float hi) { const f32x2_t v = {lo, hi}; return __builtin_bit_cast(unsigned, __builtin_convertvector(v, bf16x2_t)); }
__device__ __forceinline__ unsigned f2bf(float f) { return pk2(f, f) & 0xffffu; }
__device__ __forceinline__ float bf2f(unsigned short h) { return __builtin_bit_cast(float, (unsigned)h << 16); }
__device__ __forceinline__ float bflo(unsigned w) { return __builtin_bit_cast(float, w << 16); }
__device__ __forceinline__ float bfhi(unsigned w) { return __builtin_bit_cast(float, w & 0xffff0000u); }
template <int CTRL> __device__ __forceinline__ float dpp_f(float v) { return __builtin_bit_cast(float, __builtin_amdgcn_update_dpp(0, __builtin_bit_cast(int, v), CTRL, 0xF, 0xF, true)); }
__device__ __forceinline__ float sum8(float v) {
    v += dpp_f<0xB1>(v); v += dpp_f<0x4E>(v); v += dpp_f<0x141>(v); return v; }
__device__ __forceinline__ float wave_sum(float v) {
    v = sum8(v); v += dpp_f<0x140>(v);
    v += __builtin_bit_cast(float, __builtin_amdgcn_ds_swizzle(__builtin_bit_cast(int, v), 0x401F));
    { const int u = __builtin_bit_cast(int, v); v = __builtin_bit_cast(float, __builtin_amdgcn_readlane(u, 0)) + __builtin_bit_cast(float, __builtin_amdgcn_readlane(u, 32)); }
    return v;
}
__device__ __forceinline__ float sigmoid_f(float x) { return __builtin_amdgcn_rcpf(1.0f + __builtin_amdgcn_exp2f(-LOG2E * x)); }
__device__ __forceinline__ float silu_g(float x) { return x * sigmoid_f(x); }

#define XB_TMO      128
#define XB_XCNT(j)  (256  + 64 * (j))
#define XB_XSUB(j)  (1280 + 64 * (j))
#define XB_XGEN(j)  (2304 + 64 * (j))
#define XB_TOP      3328
#define XB_TOPGEN   3392
#define XCD_BAR_WORDS 3456
#define XB_SPIN_CAP (1u << 23)

__device__ __forceinline__ unsigned xb_ld(unsigned* p)              { return __hip_atomic_load(p, __ATOMIC_RELAXED, __HIP_MEMORY_SCOPE_AGENT); }
__device__ __forceinline__ unsigned xb_add(unsigned* p, unsigned v) { return __hip_atomic_fetch_add(p, v, __ATOMIC_RELAXED, __HIP_MEMORY_SCOPE_AGENT); }
__device__ __forceinline__ unsigned xb_xcc_id() { return (unsigned)__builtin_amdgcn_s_getreg((3 << 11) | 20) & 0xFu; }
#define XB_SPIN(cond, bar) do { unsigned _sp = 0; while (cond) { __builtin_amdgcn_s_sleep(1); \
    if ((++_sp & 255u) == 0u) { if (xb_ld(&(bar)[XB_TMO])) break; if (_sp > XB_SPIN_CAP) { atomicAdd(&(bar)[XB_TMO], 1u); break; } } } } while (0)

struct XcdBarrier {
    unsigned* bar; unsigned x;
    volatile LAS unsigned* st;
};

__device__ __forceinline__ XcdBarrier xcd_barrier_post(unsigned* bar, volatile LAS unsigned* st) {
    XcdBarrier b; b.bar = bar; b.x = xb_xcc_id(); b.st = st;
    if (threadIdx.x == 0) (void)xb_add(&bar[XB_XCNT(b.x)], 1u);
    return b;
}
__device__ __forceinline__ void xcd_barrier_complete(unsigned* bar, unsigned x, unsigned& nloc, unsigned& nx) {
    const unsigned G = gridDim.x * gridDim.y * gridDim.z;
    unsigned sum, cnt, mine, sp = 0u;
    for (;;) {
        sum = 0u; cnt = 0u; mine = 0u;
#pragma unroll
        for (unsigned j = 0; j < 16; ++j) { const unsigned c = xb_ld(&bar[XB_XCNT(j)]); sum += c; cnt += (c > 0u) ? 1u : 0u; mine = (j == x) ? c : mine; }
        if (sum == G) break;
        __builtin_amdgcn_s_sleep(1);
        if ((++sp & 255u) == 0u) { if (xb_ld(&bar[XB_TMO])) break; if (sp > XB_SPIN_CAP) { atomicAdd(&bar[XB_TMO], 1u); break; } }
    }
    nloc = mine > 0u ? mine : 1u; nx = cnt > 0u ? cnt : 1u;
}

__device__ __forceinline__ void xcd_barrier(const XcdBarrier& b) {
    asm volatile("s_waitcnt vmcnt(0)" ::: "memory");
    __syncthreads();
    if (threadIdx.x == 0) {
        unsigned* bar = b.bar;
        __builtin_amdgcn_s_waitcnt(0);
        unsigned nloc = b.st[0], nx = b.st[1];
        if (nloc == 0u) { xcd_barrier_complete(bar, b.x, nloc, nx); b.st[0] = nloc; b.st[1] = nx; }
        const unsigned old = xb_add(&bar[XB_XSUB(b.x)], 1u);
        const unsigned gen = old / nloc;
        if (old + 1u == (gen + 1u) * nloc) {
            __builtin_amdgcn_fence(__ATOMIC_RELEASE, "agent");
            asm volatile("s_waitcnt vmcnt(0)" ::: "memory");
            const unsigned og = xb_add(&bar[XB_TOP], 1u);
            const unsigned tg = og / nx;
            if (og + 1u == (tg + 1u) * nx) xb_add(&bar[XB_TOPGEN], 1u);
            else XB_SPIN(xb_ld(&bar[XB_TOPGEN]) == tg, bar);
            __builtin_amdgcn_fence(__ATOMIC_ACQUIRE, "agent");
            xb_add(&bar[XB_XGEN(b.x)], 1u);
            asm volatile("s_waitcnt vmcnt(0)" ::: "memory");
        } else {
            XB_SPIN(xb_ld(&bar[XB_XGEN(b.x)]) == gen, bar);
            __builtin_amdgcn_fence(__ATOMIC_ACQUIRE, "agent");
            asm volatile("s_waitcnt vmcnt(0)" ::: "memory");
        }
    }
    __syncthreads();
}

typedef const float* const __attribute__((address_space(4)))* kargp;
struct Frame {
    LAS unsigned char* lds;
    volatile LAS unsigned* MISC;
    gu32* ctl;
    int tid, lane, wave;
    int vcu, G, bx;
    kargp kin;
    float* out;
    unsigned char* ws;
};
enum { I_X = 0, I_C, I_RELB, I_ADAW, I_ADAB, I_WIN, I_WOUT, I_DQN, I_DKN, I_DLAM, I_DSUB, I_GGU, I_GGB, I_GON, I_RMU, I_RWUP, I_RW0, I_RAUP, I_RA0, I_RGUP,
       I_RKK, I_RKA, I_RRK, I_RLNW, I_RLNB, I_VRD, I_VRMU, I_VRUP, I_VR0, I_SQN, I_SKN, I_SSINK, I_W1, I_W3, I_W2 };

#define WSP(T, off) ((T*)(F.ws + (off)))
__device__ __forceinline__ void relaunder_tid(Frame& F) { int t = F.tid; asm volatile("" : "+v"(t)); F.tid = t; F.lane = t & 63; F.wave = __builtin_amdgcn_readfirstlane(t >> 6); }
__device__ __forceinline__ void relaunder(Frame& F) { kargp p = F.kin; asm volatile("" : "+s"(p)); F.kin = p; }

__device__ __forceinline__ void conv_item(const float* src, int ld, int col0, int ncols, int K, bf16* WT, int row0, int kb, LAS float* scr, int lane) {
    const int k0 = 64 * kb;
    { const int n = lane & 31; const bool ok = src != nullptr && n < ncols; const float* sp = src + (size_t)(k0 + (lane >> 5)) * ld + col0 + n; float v[32];
#pragma unroll
      for (int i = 0; i < 32; ++i) v[i] = ok ? sp[(size_t)(2 * i) * ld] : 0.f;
#pragma unroll
      for (int i = 0; i < 32; ++i) scr[(2 * i + (lane >> 5)) * 33 + n] = v[i]; }
    LDS_WAIT(); asm volatile("" ::: "memory");
    const int c = lane & 7;
#pragma unroll
    for (int j = 0; j < 4; ++j) { const int n = (lane >> 3) + 8 * j; const LAS float* s = scr + (8 * c) * 33 + n;
        v4u o; o.x = pk2(s[0 * 33], s[1 * 33]); o.y = pk2(s[2 * 33], s[3 * 33]); o.z = pk2(s[4 * 33], s[5 * 33]); o.w = pk2(s[6 * 33], s[7 * 33]);
        if (n < ncols) *(GAS v4u*)(WT + (size_t)(row0 + n) * K + k0 + 8 * c) = o; }
    LDS_WAIT(); asm volatile("" ::: "memory");
}
__device__ __forceinline__ int t5_bucket(int d) {
    if (d < 16) return d;
    int v = 16 + (int)(logf((float)d * (1.0f / 16.0f)) / logf(8.0f) * 16.0f);
    return v < 31 ? v : 31;
}
__device__ __forceinline__ void p0_prologue_a(Frame& F) {
    const int gw = F.vcu * NWAVES + F.wave, NGW = F.G * NWAVES;
    LAS float* ldsf = (LAS float*)(F.lds + RING_OFF);
    for (int i = F.tid; i < 2 * DM; i += NWAVES * 64) ldsf[i] = silu_g(F.kin[I_C][i]);
    __syncthreads();
    float* MODP = WSP(float, WS_MODP);
    for (int it = gw; it < 6144; it += NGW) {
        const int l = it / 3072, rem = it % 3072, kc = rem / 96, ng = rem % 96, n0 = 256 * ng + 4 * F.lane;
        const float* w = F.kin[I_ADAW] + ((size_t)l * DM + kc * 128) * 24576 + n0;
        f32x4 a0 = {0.f, 0.f, 0.f, 0.f}, a1 = {0.f, 0.f, 0.f, 0.f};
#pragma unroll 16
        for (int k = 0; k < 128; ++k) { const f32x4 wv = *(const f32x4*)(w + (size_t)k * 24576); const float s0 = ldsf[kc * 128 + k], s1 = ldsf[DM + kc * 128 + k]; a0 += wv * s0; a1 += wv * s1; }
        *(f32x4*)(MODP + ((size_t)(l * 32 + kc) * 2 + 0) * 24576 + n0) = a0;
        *(f32x4*)(MODP + ((size_t)(l * 32 + kc) * 2 + 1) * 24576 + n0) = a1;
    }
    __syncthreads();
    LAS float* scr = (LAS float*)(F.lds + RING_OFF + F.wave * 16384);
    constexpr int I_IN = 337 * 64, I_OUT = 128 * 64, I_13 = 688 * 64, I_2 = 128 * 172, I_L = I_IN + I_OUT + I_13 + I_2;
    for (int it = gw; it < NLAYER * I_L; it += NGW) {
        const int l = it / I_L; int r = it % I_L;
        if (r < I_IN) {
            const int kb = r / 337, cb = r % 337; const float* src = F.kin[I_WIN] + (size_t)l * DM * P_IN; int ld = P_IN, col0, row0, nc = 32;
            if (cb < 192) { col0 = 32 * cb; row0 = 32 * cb; }
            else if (cb < 288) { col0 = 6160 + 32 * (cb - 192); row0 = 6144 + 32 * (cb - 192); }
            else if (cb < 328) { col0 = 9424 + 32 * (cb - 288); row0 = 9216 + 32 * (cb - 288); }
            else if (cb == 328) { col0 = 6144; row0 = 10496; nc = 16; }
            else if (cb < 335) { col0 = 9232 + 32 * (cb - 329); row0 = 10512 + 32 * (cb - 329); }
            else if (cb == 335) { src = l ? F.kin[I_VRD] + (size_t)(l - 1) * DM * 32 : nullptr; ld = 32; col0 = 0; row0 = 10704; }
            else { src = nullptr; col0 = 0; row0 = 10736; nc = 16; }
            conv_item(src, ld, col0, nc, DM, WSP(bf16, WS_WIN + l * WIN_L), row0, kb, scr, F.lane); continue; }
        r -= I_IN;
        if (r < I_OUT) { const int kb = r / 128, cb = r % 128; conv_item(F.kin[I_WOUT] + (size_t)l * DM * DM, DM, 32 * cb, 32, DM, WSP(bf16, WS_WOUT + l * WOUT_L), 32 * cb, kb, scr, F.lane); continue; }
        r -= I_OUT;
        if (r < I_13) { const int kb = r / 688, cb = r % 688, pn = cb >> 3, wi = cb & 7;
            const float* src = (wi < 4 ? F.kin[I_W1] : F.kin[I_W3]) + (size_t)l * DM * DFF;
            conv_item(src, DFF, 128 * pn + 32 * (wi & 3), 32, DM, WSP(bf16, WS_W13 + l * W13_L), 32 * cb, kb, scr, F.lane); continue; }
        r -= I_13;
        { const int kb = r / 128, cb = r % 128; conv_item(F.kin[I_W2] + (size_t)l * DFF * DM, DM, 32 * cb, 32, DFF, WSP(bf16, WS_W2 + l * W2_L), 32 * cb, kb, scr, F.lane); }
    }
}
__device__ __forceinline__ void p0_prologue_b(Frame& F) {
    const int gt = F.bx * (NWAVES * 64) + F.tid, NT = F.G * NWAVES * 64;
    const float* MODP = WSP(float, WS_MODP); float* MOD = WSP(float, WS_MOD);
    for (int idx = gt; idx < NLAYER * 2 * 24576; idx += NT) {
        const int l = idx / 49152, rem = idx % 49152, b = rem / 24576, n = rem % 24576;
        float s = F.kin[I_ADAB][l * 24576 + n];
#pragma unroll 8
        for (int kc = 0; kc < 32; ++kc) s += MODP[((size_t)(l * 32 + kc) * 2 + b) * 24576 + n];
        MOD[idx] = s;
    }
    if (F.bx == 0) { float* TAB = WSP(float, WS_TAB);
        for (int i = F.tid; i < 24 * 128; i += NWAVES * 64) { const int hh = i >> 7, d = i & 127; TAB[i] = F.kin[I_RELB][t5_bucket(d) * 24 + hh] * LOG2E; } }
}
__device__ __forceinline__ void rms_phase(Frame& F, const float* xin, const float* sh, const float* sc) {
    const int gw = F.vcu * NWAVES + F.wave, NGW = F.G * NWAVES;
    bf16* XN = WSP(bf16, WS_XN);
    for (int m = gw; m < M; m += NGW) {
        const int b = m >> 13;
        const f32x4* xr = (const f32x4*)(xin + (size_t)m * DM) + F.lane;
        f32x4 v[16]; float ss = 0.f;
#pragma unroll
        for (int j = 0; j < 16; ++j) { v[j] = xr[64 * j]; ss += (v[j].x * v[j].x + v[j].y * v[j].y) + (v[j].z * v[j].z + v[j].w * v[j].w); }
        const float rstd = rsqrtf(wave_sum(ss) * (1.0f / DM) + 1e-6f);
        const f32x4* scp = (const f32x4*)(sc + (size_t)b * 24576) + F.lane; const f32x4* shp = (const f32x4*)(sh + (size_t)b * 24576) + F.lane;
        v2u* o8 = (v2u*)(XN + (size_t)m * DM) + F.lane;
#pragma unroll
        for (int j = 0; j < 16; ++j) { const f32x4 s4 = scp[64 * j], h4 = shp[64 * j]; const f32x4 o = v[j] * rstd * (s4 + 1.0f) + h4;
            v2u w; w.x = pk2(o.x, o.y); w.y = pk2(o.z, o.w); o8[64 * j] = w; }
    }
}
__device__ __forceinline__ void unpack8(const v4u r, float (&f)[8]) { f[0] = bflo(r.x); f[1] = bfhi(r.x); f[2] = bflo(r.y); f[3] = bfhi(r.y); f[4] = bflo(r.z); f[5] = bfhi(r.z); f[6] = bflo(r.w); f[7] = bfhi(r.w); }
__device__ __forceinline__ v4u pack8(const float (&f)[8]) { v4u o; o.x = pk2(f[0], f[1]); o.y = pk2(f[2], f[3]); o.z = pk2(f[4], f[5]); o.w = pk2(f[6], f[7]); return o; }
__device__ __forceinline__ void prep_norm(Frame& F, int l) {
    const int gw = F.vcu * NWAVES + F.wave, NGW = F.G * NWAVES, lane = F.lane, sub = lane >> 3, ch = lane & 7;
    float gqa[8], gka[8], gqd[8], gkd[8];
#pragma unroll
    for (int e = 0; e < 8; ++e) { gqa[e] = F.kin[I_DQN][l * 64 + ch * 8 + e] * QSCALE; gka[e] = F.kin[I_DKN][l * 64 + ch * 8 + e];
                                  gqd[e] = F.kin[I_SQN][l * 64 + ch * 8 + e] * QSCALE; gkd[e] = F.kin[I_SKN][l * 64 + ch * 8 + e]; }
    const bf16* COLS = WSP(bf16, WS_COLS); bf16* QKA = WSP(bf16, WS_QKA); bf16* QKD = WSP(bf16, WS_QKD);
    for (int m = gw; m < M; m += NGW) {
        const bf16* src = COLS + (size_t)m * NMAIN;
#pragma unroll
        for (int i = 0; i < 4; ++i) { const int vec = i * 8 + sub, col = vec * 64 + ch * 8;
            float f[8]; unpack8(*(const v4u*)(src + CA_Q + col), f); float ss = 0.f;
#pragma unroll
            for (int e = 0; e < 8; ++e) ss += f[e] * f[e];
            ss = sum8(ss);
            const float rstd = rsqrtf(ss * (1.0f / 64.0f) + 1e-6f);
#pragma unroll
            for (int e = 0; e < 8; ++e) f[e] = f[e] * rstd * (i < 2 ? gqa[e] : gka[e]);
            *(v4u*)(QKA + (size_t)m * 2048 + col) = pack8(f); }
#pragma unroll
        for (int i = 0; i < 3; ++i) { const int vec = i * 8 + sub, col = vec * 64 + ch * 8;
            if (vec < 18) { float f[8]; unpack8(*(const v4u*)(src + CD_Q + col), f); float ss = 0.f;
#pragma unroll
                for (int e = 0; e < 8; ++e) ss += f[e] * f[e];
                ss = sum8(ss);
                const float rstd = rsqrtf(ss * (1.0f / 64.0f) + 1e-6f);
#pragma unroll
                for (int e = 0; e < 8; ++e) f[e] = f[e] * rstd * (vec < 16 ? gqd[e] : gkd[e]);
                *(v4u*)(QKD + (size_t)m * 1152 + col) = pack8(f); } }
    }
}
__device__ __forceinline__ void prep_loga(Frame& F, int l) {
    LAS float* gdl = (LAS float*)(F.lds + RING_OFF);
    float gu[16];
#pragma unroll
    for (int j = 0; j < 16; ++j) gu[j] = F.kin[I_GGU][((size_t)l * 16 + j) * 512 + F.tid];
    const float bias = F.kin[I_GGB][l * 512 + F.tid];
    const float* LOWR = WSP(float, WS_LOWR); float* LOGA = WSP(float, WS_LOGA);
    for (int tile = F.bx; tile < M / 64; tile += F.G) {
        const size_t row0 = (size_t)tile * 64;
        __syncthreads();
#pragma unroll
        for (int i = 0; i < 2; ++i) { const int idx = F.tid + 512 * i; gdl[idx] = LOWR[(row0 + (idx >> 4)) * 256 + (idx & 15)]; }
        __syncthreads();
#pragma unroll 4
        for (int t = 0; t < 64; ++t) { const LAS f32x4* gp = (const LAS f32x4*)(gdl + t * 16); const f32x4 g0 = gp[0], g1 = gp[1], g2 = gp[2], g3 = gp[3];
            float z = bias + g0.x * gu[0] + g0.y * gu[1] + g0.z * gu[2] + g0.w * gu[3] + g1.x * gu[4] + g1.y * gu[5] + g1.z * gu[6] + g1.w * gu[7]
                    + g2.x * gu[8] + g2.y * gu[9] + g2.z * gu[10] + g2.w * gu[11] + g3.x * gu[12] + g3.y * gu[13] + g3.z * gu[14] + g3.w * gu[15];
            LOGA[(row0 + t) * 512 + F.tid] = (fminf(z, 0.f) - __logf(1.0f + __expf(-fabsf(z)))) * (1.0f / 16.0f); }
    }
}
__device__ __forceinline__ void prep_rwkv(Frame& F, int l) {
    LAS float* wst = (LAS float*)(F.lds + RING_OFF) + 4096;
    LAS float* in = (LAS float*)(F.lds + RING_OFF);
    const float* mu = F.kin[I_RMU] + (size_t)l * 3264;
    const float* LOWR = WSP(float, WS_LOWR); const bf16* COLS = WSP(bf16, WS_COLS);
    float* RW = WSP(float, WS_RW); float* VF = WSP(float, WS_VFIRST);
    constexpr size_t RS = RW_ONE / 4;
    for (int tile = F.bx; tile < M / 16; tile += F.G) {
        const int row0 = tile * 16;
        __syncthreads();
        for (int idx = F.tid; idx < 16 * 224; idx += NWAVES * 64) { const int tt = idx / 224, j = idx % 224, row = row0 + tt, t = row & (SEQ - 1);
            const int col = j < 192 ? 16 + j : 208 + (j - 192);
            const float cur = LOWR[(size_t)row * 256 + col], prev = t > 0 ? LOWR[(size_t)(row - 1) * 256 + col] : 0.f;
            const float muv = j < 192 ? mu[3072 + j] : (l ? F.kin[I_VRMU][(l - 1) * 32 + (j - 192)] : 0.f);
            float x = cur + (prev - cur) * muv;
            if (j < 64) x = tanhf(x); else if (j >= 128 && j < 192) x = sigmoid_f(x);
            in[j * 16 + tt] = x; }
        __syncthreads();
#pragma unroll 1
        for (int pass = 0; pass < 2; ++pass) {
            const int c = pass * 512 + F.tid;
            float accw[16], acca[16], accg[16], accv[16];
            { const float bw = F.kin[I_RW0][l * 1024 + c], ba = F.kin[I_RA0][l * 1024 + c], bv = l ? F.kin[I_VR0][(l - 1) * 1024 + c] : 0.f;
#pragma unroll
              for (int tt = 0; tt < 16; ++tt) { accw[tt] = bw; acca[tt] = ba; accg[tt] = 0.f; accv[tt] = bv; } }
#define LOWRANK_ACC(ACC, WPTR, JOFF, NJ) do { const float* wp_ = (WPTR) + c; float nx_[16]; \
            _Pragma("unroll") for (int j_ = 0; j_ < 16; ++j_) nx_[j_] = wp_[(size_t)j_ * 1024]; \
            _Pragma("unroll 1") for (int jb = 0; jb < (NJ) / 16; ++jb) { LAS float* wl_ = wst + (jb & 1) * 8192 + F.tid; \
                _Pragma("unroll") for (int j_ = 0; j_ < 16; ++j_) wl_[j_ * 512] = nx_[j_]; \
                if (jb + 1 < (NJ) / 16) { _Pragma("unroll") for (int j_ = 0; j_ < 16; ++j_) nx_[j_] = wp_[(size_t)((jb + 1) * 16 + j_) * 1024]; } \
                _Pragma("unroll 2") for (int j_ = 0; j_ < 16; ++j_) { const float w_ = wl_[j_ * 512]; const LAS f32x4* ip_ = (const LAS f32x4*)(in + ((JOFF) + jb * 16 + j_) * 16); \
                    const f32x4 i0 = ip_[0], i1 = ip_[1], i2 = ip_[2], i3 = ip_[3]; \
                    ACC[0] += i0.x * w_; ACC[1] += i0.y * w_; ACC[2] += i0.z * w_; ACC[3] += i0.w * w_; ACC[4] += i1.x * w_; ACC[5] += i1.y * w_; ACC[6] += i1.z * w_; ACC[7] += i1.w * w_; \
                    ACC[8] += i2.x * w_; ACC[9] += i2.y * w_; ACC[10] += i2.z * w_; ACC[11] += i2.w * w_; ACC[12] += i3.x * w_; ACC[13] += i3.y * w_; ACC[14] += i3.z * w_; ACC[15] += i3.w * w_; } } } while (0)
            relaunder(F); LOWRANK_ACC(accw, F.kin[I_RWUP] + (size_t)l * 64 * 1024, 0, 64);
            relaunder(F); LOWRANK_ACC(acca, F.kin[I_RAUP] + (size_t)l * 64 * 1024, 64, 64);
            relaunder(F); LOWRANK_ACC(accg, F.kin[I_RGUP] + (size_t)l * 64 * 1024, 128, 64);
            relaunder(F); if (l) LOWRANK_ACC(accv, F.kin[I_VRUP] + (size_t)(l - 1) * 32 * 1024, 192, 32);
#undef LOWRANK_ACC
            relaunder(F);
            const float mur = F.kin[I_RMU][l * 3264 + c], muk = F.kin[I_RMU][l * 3264 + 1024 + c], muv = F.kin[I_RMU][l * 3264 + 2048 + c], kkv = F.kin[I_RKK][l * 1024 + c], kav = F.kin[I_RKA][l * 1024 + c];
            float pr = 0.f, pk = 0.f, pv = 0.f;
            if ((row0 & (SEQ - 1)) != 0) { const bf16* p = COLS + (size_t)(row0 - 1) * NMAIN + c; pr = bf2f(p[CC_R]); pk = bf2f(p[CC_K]); pv = bf2f(p[CC_V]); }
#pragma unroll
            for (int tt = 0; tt < 16; ++tt) { const int row = row0 + tt; const bf16* p = COLS + (size_t)row * NMAIN + c;
                const float cr = bf2f(p[CC_R]), ck = bf2f(p[CC_K]), cv = bf2f(p[CC_V]);
                const float r = cr + (pr - cr) * mur, k = ck + (pk - ck) * muk; float v = cv + (pv - cv) * muv;
                pr = cr; pk = ck; pv = cv;
                const size_t o = (size_t)row * 1024 + c;
                if (l == 0) VF[o] = v; else { const float vg = sigmoid_f(accv[tt]); v = v + (VF[o] - v) * vg; }
                const float dec = __expf(-0.6065306597126334f * sigmoid_f(accw[tt]));
                const float a = sigmoid_f(acca[tt]);
                float kk = k * kkv; const float ss = wave_sum(kk * kk); kk = kk / fmaxf(sqrtf(ss), 1e-12f);
                const float km = k * (1.0f + (a - 1.0f) * kav);
                RW[o] = r; RW[RS + o] = dec; RW[2 * RS + o] = km; RW[3 * RS + o] = v; RW[4 * RS + o] = -kk; RW[5 * RS + o] = kk * a; RW[6 * RS + o] = accg[tt]; }
        }
    }
}
__device__ __forceinline__ int next_item(Frame& F, gu32* ctr) {
    volatile LAS int* slot = (volatile LAS int*)(F.lds + LDSCTL_OFF + 64);
    __syncthreads();
    if (F.tid == 0) *slot = (int)__hip_atomic_fetch_add(ctr, 1u, RLX_AGENT);
    __syncthreads();
    return *slot;
}
typedef float f32x16 __attribute__((ext_vector_type(16)));
__device__ __forceinline__ float xother32(float v) { unsigned a = __builtin_bit_cast(unsigned, v), b = a; asm volatile("" : "+v"(b)); auto rr = __builtin_amdgcn_permlane32_swap(a, b, false, false);
    const unsigned lo = rr[0], hi = rr[1]; return __builtin_bit_cast(float, (unsigned)((__builtin_amdgcn_mbcnt_hi(~0u, __builtin_amdgcn_mbcnt_lo(~0u, 0u)) & 32u) ? lo : hi)); }
__device__ __forceinline__ float xsum32(float v) { return v + xother32(v); }
__device__ __forceinline__ float xmax32(float v) { return fmaxf(v, xother32(v)); }
__device__ __forceinline__ int crow16(int r, int hi) { return (r & 3) + 8 * (r >> 2) + 4 * hi; }
template <bool ISA>
__device__ __forceinline__ void attn_unit(Frame& F, int l, int b, int hx, int qb) {
    constexpr int DV = ISA ? 128 : 64, NDV = DV / 32, KSTR = ISA ? 272 : 144, VSTR = 144, KBYTES = 64 * KSTR, VBYTES = DV * VSTR, BUFB = KBYTES + VBYTES, NCH = ISA ? 2 : 1;
    constexpr float NEG = -1e30f;
    LAS unsigned char* L = F.lds + RING_OFF;
    const int tid = F.tid, lane = F.lane, r32 = lane & 31, hi = lane >> 5, qs = F.wave & 3, grp = F.wave >> 2, q0 = qb * 128;
    const int kvh = hx >> 2, hd = kvh * 8 + (hx & 3) * 2 + grp;
    const bf16* Qp; const bf16* Kp; const bf16* VT; int ldq;
    if (ISA) { const bf16* QKA = WSP(bf16, WS_QKA); Qp = QKA + (size_t)b * SEQ * 2048 + hx * 128 + grp * 64; Kp = QKA + (size_t)b * SEQ * 2048 + 1024 + hx * 128; ldq = 2048; VT = WSP(bf16, WS_VTA) + (size_t)(b * 8 + hx) * 128 * VROW; }
    else { const bf16* QKD = WSP(bf16, WS_QKD); Qp = QKD + (size_t)b * SEQ * 1152 + hd * 64; Kp = QKD + (size_t)b * SEQ * 1152 + 1024 + kvh * 64; ldq = 1152; VT = WSP(bf16, WS_VTD) + (size_t)(b * 2 + kvh) * 64 * VROW; }
    const int qpos = q0 + 32 * qs + r32;
    bf16x8 qr[4];
#pragma unroll
    for (int d0 = 0; d0 < 4; ++d0) qr[d0] = *(const bf16x8*)(Qp + (size_t)qpos * ldq + d0 * 16 + hi * 8);
    LAS float* Bt = (LAS float*)(L + 2 * BUFB);
    { const float* TAB = WSP(float, WS_TAB);
      if (ISA) { if (tid < 130) Bt[tid] = tid == 0 ? NEG : (tid == 129 ? 0.f : TAB[hx * 128 + tid - 1] - TAB[hx * 128 + 127]); }
      else { if (tid < 260) { const int gi = tid >= 130, t = tid - 130 * gi; Bt[tid] = (t == 0 || t == 129) ? NEG : TAB[(8 + kvh * 8 + (hx & 3) * 2 + gi) * 128 + t - 1]; } } }
    const int TQ = q0 >> 6, T0 = ISA ? 0 : (TQ >= 2 ? TQ - 2 : 0), T1 = TQ + 1;
    v4u kreg[NCH], vreg[NCH];
#define AT_GLOAD(T) do { _Pragma("unroll") for (int i_ = 0; i_ < NCH; ++i_) { const int c_ = tid + 512 * i_; \
        const int kr_ = ISA ? (c_ >> 4) : (c_ >> 3), kc_ = ISA ? (c_ & 15) : (c_ & 7); kreg[i_] = *(const v4u*)(Kp + (size_t)((T) * 64 + kr_) * ldq + kc_ * 8); \
        const int vr_ = c_ >> 3, vc_ = c_ & 7; vreg[i_] = *(const v4u*)(VT + (size_t)vr_ * VROW + (T) * 64 + vc_ * 8); } } while (0)
#define AT_LWRITE(buf) do { _Pragma("unroll") for (int i_ = 0; i_ < NCH; ++i_) { const int c_ = tid + 512 * i_; \
        const int kr_ = ISA ? (c_ >> 4) : (c_ >> 3), kc_ = ISA ? (c_ & 15) : (c_ & 7); *(LAS v4u*)(L + (buf) * BUFB + kr_ * KSTR + kc_ * 16) = kreg[i_]; \
        const int vr_ = c_ >> 3, vc_ = c_ & 7; *(LAS v4u*)(L + (buf) * BUFB + KBYTES + vr_ * VSTR + vc_ * 16) = vreg[i_]; } } while (0)
    f32x16 o[NDV];
#pragma unroll
    for (int i = 0; i < NDV; ++i) o[i] = (f32x16){0.f, 0.f, 0.f, 0.f, 0.f, 0.f, 0.f, 0.f, 0.f, 0.f, 0.f, 0.f, 0.f, 0.f, 0.f, 0.f};
    float m_run = ISA ? NEG : F.kin[I_SSINK][l * 16 + hd] * LOG2E, l_run = ISA ? 0.f : (hi == 0 ? 1.f : 0.f);
    const int krow = (r32 & 16) | (r32 & 3) | ((r32 & 4) << 1) | ((r32 & 8) >> 1);
    const int koff = krow * KSTR + (ISA ? grp * 128 : 0) + hi * 16, voff = KBYTES + r32 * VSTR + hi * 16;
    AT_GLOAD(T0); AT_LWRITE(0); __syncthreads();
#pragma unroll 1
    for (int T = T0; T <= T1; ++T) {
        const int cur = (T - T0) & 1;
        AT_GLOAD(T < T1 ? T + 1 : T1);
        LAS const unsigned char* Kb = L + cur * BUFB;
        f32x16 s[2];
#pragma unroll
        for (int blk = 0; blk < 2; ++blk) { s[blk] = (f32x16){0.f, 0.f, 0.f, 0.f, 0.f, 0.f, 0.f, 0.f, 0.f, 0.f, 0.f, 0.f, 0.f, 0.f, 0.f, 0.f};
#pragma unroll
            for (int d0 = 0; d0 < 4; ++d0) { const bf16x8 kf = *(const LAS bf16x8*)(Kb + koff + blk * 32 * KSTR + d0 * 32); s[blk] = __builtin_amdgcn_mfma_f32_32x32x16_bf16(kf, qr[d0], s[blk], 0, 0, 0); } }
        if (!ISA || T >= TQ - 2) {
            const LAS float* bt = Bt + (ISA ? 0 : grp * 130) + 1; const int d0 = qpos - T * 64 - 8 * hi;
#pragma unroll
            for (int blk = 0; blk < 2; ++blk)
#pragma unroll
                for (int r = 0; r < 16; ++r) { const int dist = d0 - (32 * blk + 16 * (r >> 3) + (r & 7)); const int di = dist < -1 ? -1 : (dist > 128 ? 128 : dist); s[blk][r] += bt[di]; } }
        float mt = s[0][0];
#pragma unroll
        for (int r = 1; r < 16; ++r) mt = fmaxf(mt, s[0][r]);
#pragma unroll
        for (int r = 0; r < 16; ++r) mt = fmaxf(mt, s[1][r]);
        mt = xmax32(mt);
        const float m_new = fmaxf(m_run, mt);
        if (__any(m_new > m_run)) { const float alpha = __builtin_amdgcn_exp2f(m_run - m_new); l_run *= alpha;
#pragma unroll
            for (int i = 0; i < NDV; ++i)
#pragma unroll
                for (int r = 0; r < 16; ++r) o[i][r] *= alpha;
            m_run = m_new; }
        float ls = 0.f;
#pragma unroll
        for (int blk = 0; blk < 2; ++blk)
#pragma unroll
            for (int r = 0; r < 16; ++r) { const float pv_ = __builtin_amdgcn_exp2f(s[blk][r] - m_run); s[blk][r] = pv_; ls += pv_; }
        l_run += ls;
#pragma unroll
        for (int sl = 0; sl < 4; ++sl) { const int blk = sl >> 1, r0 = 8 * (sl & 1);
            v4u pw; pw.x = pg8::cvt_pk_bf16(s[blk][r0], s[blk][r0 + 1]); pw.y = pg8::cvt_pk_bf16(s[blk][r0 + 2], s[blk][r0 + 3]); pw.z = pg8::cvt_pk_bf16(s[blk][r0 + 4], s[blk][r0 + 5]); pw.w = pg8::cvt_pk_bf16(s[blk][r0 + 6], s[blk][r0 + 7]);
            const bf16x8 pf = __builtin_bit_cast(bf16x8, pw);
#pragma unroll
            for (int i = 0; i < NDV; ++i) { const bf16x8 vf = *(const LAS bf16x8*)(Kb + voff + i * 32 * VSTR + sl * 32); o[i] = __builtin_amdgcn_mfma_f32_32x32x16_bf16(vf, pf, o[i], 0, 0, 0); } }
        AT_LWRITE(cur ^ 1);
        __syncthreads();
    }
#undef AT_GLOAD
#undef AT_LWRITE
    const float inv = 1.0f / xsum32(l_run);
    bf16* MIX = WSP(bf16, WS_MIXED);
    if (ISA) {
        int ll_ = l; asm volatile("" : "+s"(ll_)); const float lam_init = ll_ == 0 ? 0.2f : 0.35550906759f;     float lam_full;
        { const float* lm = F.kin[I_DLAM] + (size_t)l * 256; const float s1 = wave_sum(lm[lane] * lm[64 + lane]), s2 = wave_sum(lm[128 + lane] * lm[192 + lane]); lam_full = __expf(s1) - __expf(s2) + lam_init; }
        LAS float* R1 = (LAS float*)L;
        LAS bf16* R2 = (LAS bf16*)(L + 66048);
        const int ql = 32 * qs + r32;
        if (grp == 1) {
#pragma unroll
            for (int i = 0; i < NDV; ++i)
#pragma unroll
                for (int r = 0; r < 16; ++r) R1[ql * 129 + 32 * i + crow16(r, hi)] = lam_full * inv * o[i][r]; }
        __syncthreads();
        if (grp == 0) { float ss = 0.f;
#pragma unroll
            for (int i = 0; i < NDV; ++i)
#pragma unroll
                for (int r = 0; r < 16; ++r) { const float d = o[i][r] * inv - R1[ql * 129 + 32 * i + crow16(r, hi)]; o[i][r] = d; ss += d * d; }
            const float rstd = rsqrtf(xsum32(ss) * (1.0f / 128.0f) + 1e-6f) * (1.0f - lam_init);
            const float* sl = F.kin[I_DSUB] + l * 128;
#pragma unroll
            for (int i = 0; i < NDV; ++i)
#pragma unroll
                for (int r = 0; r < 16; ++r) { const int dv = 32 * i + crow16(r, hi); R2[ql * 132 + dv] = (bf16)f2bf(o[i][r] * rstd * sl[dv]); } }
        __syncthreads();
#pragma unroll
        for (int i = 0; i < 4; ++i) { const int c = tid + 512 * i, row = c >> 4, ch = c & 15; const LAS v2u* sp = (const LAS v2u*)(R2 + row * 132 + ch * 8); const v2u a = sp[0], bb = sp[1];
            *(v4u*)(MIX + (size_t)(b * SEQ + q0 + row) * DM + hx * 128 + ch * 8) = (v4u){a.x, a.y, bb.x, bb.y}; }
    } else {
        LAS bf16* R = (LAS bf16*)L + F.wave * 2176;
#pragma unroll
        for (int i = 0; i < NDV; ++i)
#pragma unroll
            for (int r = 0; r < 16; ++r) R[r32 * 68 + 32 * i + crow16(r, hi)] = (bf16)f2bf(o[i][r] * inv);
#pragma unroll
        for (int i = 0; i < 4; ++i) { const int c = lane + 64 * i, row = c >> 3, ch = c & 7; const LAS v2u* sp = (const LAS v2u*)(R + row * 68 + ch * 8); const v2u a = sp[0], bb = sp[1];
            *(v4u*)(MIX + (size_t)(b * SEQ + q0 + 32 * qs + row) * DM + 3072 + hd * 64 + ch * 8) = (v4u){a.x, a.y, bb.x, bb.y}; }
    }
}
__device__ __forceinline__ void prep_gla(Frame& F) {
    LAS float* Lb = (LAS float*)(F.lds + RING_OFF); LAS float* Qd = Lb + 64 * 129; LAS float* Ki = Qd + 64 * 129; LAS bf16* Kt = (LAS bf16*)(Ki + 64 * 129);
    const bf16* COLS = WSP(bf16, WS_COLS); const float* LOGA = WSP(float, WS_LOGA);
    bf16* QDEC = WSP(bf16, WS_QDEC); bf16* KDT = WSP(bf16, WS_KDT); bf16* AMg = WSP(bf16, WS_AM); float* EBL = WSP(float, WS_EBL);
    for (int u = F.bx; u < 1024; u += F.G) {
        const int b = u >> 9, h = (u >> 7) & 3, ck = u & 127; const size_t row0 = (size_t)b * SEQ + ck * 64;
        __syncthreads();
        for (int idx = F.tid; idx < 8192; idx += NWAVES * 64) { const int t = idx >> 7, d = idx & 127; Lb[t * 129 + d] = LOGA[(row0 + t) * 512 + h * 128 + d]; }
        __syncthreads();
        if (F.tid < 128) { float acc = 0.f;
#pragma unroll 8
            for (int t = 0; t < 64; ++t) { acc += Lb[t * 129 + F.tid]; Lb[t * 129 + F.tid] = acc; }
            EBL[(size_t)u * 128 + F.tid] = __expf(acc); }
        __syncthreads();
        for (int idx = F.tid; idx < 8192; idx += NWAVES * 64) { const int t = idx >> 7, d = idx & 127; const float bt = Lb[t * 129 + d], bl = Lb[63 * 129 + d];
            const float q = bf2f(COLS[(row0 + t) * NMAIN + CB_Q + h * 128 + d]) * 0.08838834764831845f, k = bf2f(COLS[(row0 + t) * NMAIN + CB_K + h * 128 + d]);
            const float qd = q * __expf(bt); Qd[t * 129 + d] = qd; Ki[t * 129 + d] = k * __expf(-bt); Kt[d * 72 + t] = (bf16)f2bf(k * __expf(bl - bt));
            QDEC[((size_t)u * 64 + t) * 128 + d] = (bf16)f2bf(qd); }
        __syncthreads();
#pragma unroll
        for (int i = 0; i < 2; ++i) { const int c_ = F.tid + 512 * i, row = c_ >> 3, ch = c_ & 7; const LAS v2u* sp = (const LAS v2u*)(Kt + row * 72 + ch * 8); const v2u a = sp[0], bb = sp[1];
            *(v4u*)(KDT + ((size_t)u * 128 + row) * 64 + ch * 8) = (v4u){a.x, a.y, bb.x, bb.y}; }
        { const int c = F.tid >> 3, sg = F.tid & 7; float acc[8];
#pragma unroll
          for (int e = 0; e < 8; ++e) acc[e] = 0.f;
#pragma unroll 4
          for (int d = 0; d < 128; ++d) { const float q = Qd[c * 129 + d];
#pragma unroll
              for (int e = 0; e < 8; ++e) acc[e] += q * Ki[(sg * 8 + e) * 129 + d]; }
#pragma unroll
          for (int e = 0; e < 8; ++e) if (sg * 8 + e > c) acc[e] = 0.f;
          *(v4u*)(AMg + ((size_t)u * 64 + c) * 64 + sg * 8) = pack8(acc); }
    }
}
__device__ __forceinline__ void prep_vt(Frame& F, int pass) {
    LAS bf16* T = (LAS bf16*)(F.lds + RING_OFF);
    const bf16* COLS = WSP(bf16, WS_COLS);
    const int nch = pass == 0 ? 144 : 128, nvr = nch * 8;
    for (int tile = F.bx; tile < M / 32; tile += F.G) {
        const int b = tile >> 8, t0 = (tile & 255) * 32;
        __syncthreads();
        for (int idx = F.tid; idx < 32 * nch; idx += NWAVES * 64) { const int tok = idx / nch, ch = idx % nch;
            const int col = pass == 0 ? (ch < 128 ? CA_V + ch * 8 : CD_V + (ch - 128) * 8) : (pass == 1 ? CB_V + ch * 8 : CB_G + ch * 8);
            const v4u v = *(const v4u*)(COLS + (size_t)(b * SEQ + t0 + tok) * NMAIN + col); LAS v2u* d = (LAS v2u*)(T + tok * 1160 + ch * 8); d[0] = (v2u){v.x, v.y}; d[1] = (v2u){v.z, v.w}; }
        __syncthreads();
        for (int idx = F.tid; idx < nvr * 4; idx += NWAVES * 64) { const int ch = idx / nvr, vrow = idx % nvr;
            unsigned e[8];
#pragma unroll
            for (int k = 0; k < 8; ++k) e[k] = T[(ch * 8 + k) * 1160 + vrow];
            v4u o; o.x = e[0] | (e[1] << 16); o.y = e[2] | (e[3] << 16); o.z = e[4] | (e[5] << 16); o.w = e[6] | (e[7] << 16);
            bf16* dst;
            if (pass == 0) dst = vrow < 1024 ? WSP(bf16, WS_VTA) + ((size_t)(b * 8 + (vrow >> 7)) * 128 + (vrow & 127)) * VROW : WSP(bf16, WS_VTD) + ((size_t)(b * 2 + ((vrow - 1024) >> 6)) * 64 + ((vrow - 1024) & 63)) * VROW;
            else dst = WSP(bf16, WS_VTB) + ((size_t)b * 1024 + vrow) * VROW;
            *(v4u*)(dst + t0 + ch * 8) = o; }
    }
}
typedef float f32x4v __attribute__((ext_vector_type(4)));
__device__ __forceinline__ float sum16(float v) { v = sum8(v); v += dpp_f<0x140>(v); return v; }
#define LDS_BARRIER() asm volatile("s_waitcnt lgkmcnt(0)\n\ts_barrier" ::: "memory")
template <int HACK = 0> __device__ __forceinline__ void gla_scan_unit(Frame& F, int l, int b, int h) {
    LAS unsigned char* L = F.lds + RING_OFF;
    constexpr int OQD = 0, OKT = 17408, OAM = 35840, OVT = 45056, OOT = 81920, OEB = 115712, OPS = 116224;
    const int tid = F.tid, lane = F.lane, n = lane & 15, g = lane >> 4, w = F.wave;
    const bf16* QDEC = WSP(bf16, WS_QDEC); const bf16* KDT = WSP(bf16, WS_KDT); const bf16* AMg = WSP(bf16, WS_AM); const float* EBL = WSP(float, WS_EBL);
    const bf16* VTB = WSP(bf16, WS_VTB) + (size_t)(b * 4 + h) * 256 * VROW; const bf16* COLS = WSP(bf16, WS_COLS); bf16* MIX = WSP(bf16, WS_MIXED);
    f32x4v S[8][2];
#pragma unroll
    for (int dt = 0; dt < 8; ++dt)
#pragma unroll
        for (int vt = 0; vt < 2; ++vt) S[dt][vt] = (f32x4v){0.f, 0.f, 0.f, 0.f};
    float gain8[8];
#pragma unroll
    for (int e = 0; e < 8; ++e) gain8[e] = F.kin[I_GON][l * 256 + (tid & 31) * 8 + e];
    v4u pq[2], pk[2], pa, pv[4]; float pe = 0.f;
#define GL_ISSUE(CK) do { const size_t u_ = (size_t)(b * 4 + h) * 128 + (CK); \
        _Pragma("unroll") for (int i = 0; i < 2; ++i) { const int c_ = tid + 512 * i; pq[i] = *(const v4u*)(QDEC + (u_ * 64 + (c_ >> 4)) * 128 + (c_ & 15) * 8); pk[i] = *(const v4u*)(KDT + (u_ * 128 + (c_ >> 3)) * 64 + (c_ & 7) * 8); } \
        pa = *(const v4u*)(AMg + (u_ * 64 + (tid >> 3)) * 64 + (tid & 7) * 8); \
        _Pragma("unroll") for (int i = 0; i < 4; ++i) { const int c_ = tid + 512 * i; pv[i] = *(const v4u*)(VTB + (size_t)(c_ >> 3) * VROW + (CK) * 64 + (c_ & 7) * 8); } \
        pe = EBL[u_ * 128 + (tid & 127)]; } while (0)
#define GL_WRITE() do { _Pragma("unroll") for (int i = 0; i < 2; ++i) { const int c_ = tid + 512 * i; *(LAS v4u*)(L + OQD + (c_ >> 4) * 272 + (c_ & 15) * 16) = pq[i]; *(LAS v4u*)(L + OKT + (c_ >> 3) * 144 + (c_ & 7) * 16) = pk[i]; } \
        *(LAS v4u*)(L + OAM + (tid >> 3) * 144 + (tid & 7) * 16) = pa; \
        _Pragma("unroll") for (int i = 0; i < 4; ++i) { const int c_ = tid + 512 * i; *(LAS v4u*)(L + OVT + (c_ >> 3) * 144 + (c_ & 7) * 16) = pv[i]; } \
        ((LAS float*)(L + OEB))[tid & 127] = pe; } while (0)
    GL_ISSUE(0); GL_WRITE();
    LDS_BARRIER();
#pragma unroll 1
    for (int ck = 0; ck < 128; ++ck) {
        const size_t row0 = (size_t)b * SEQ + ck * 64;
        v4u gq[4];
#pragma unroll
        for (int i = 0; i < 4; ++i) gq[i] = (HACK & 1) ? (v4u){0u, 0u, 0u, 0u} : *(const v4u*)(COLS + (row0 + (tid >> 5) + 16 * i) * NMAIN + CB_G + h * 256 + (tid & 31) * 8);
        GL_ISSUE((HACK & 1) && ck >= 2 ? 2 : (ck + 1 < 128 ? ck + 1 : 127));
        bf16x8 vf[2][2];
#pragma unroll
        for (int vt = 0; vt < 2; ++vt)
#pragma unroll
            for (int ks = 0; ks < 2; ++ks) vf[vt][ks] = *(const LAS bf16x8*)(L + OVT + (32 * w + 16 * vt + n) * 144 + (32 * ks + 8 * g) * 2);
        f32x4v o[4][2];
#pragma unroll
        for (int ct = 0; ct < 4; ++ct)
#pragma unroll
            for (int vt = 0; vt < 2; ++vt) o[ct][vt] = (f32x4v){0.f, 0.f, 0.f, 0.f};
#pragma unroll
        for (int ct = 0; ct < 4; ++ct)
#pragma unroll
            for (int ks = 0; ks < 2; ++ks) { const bf16x8 af = *(const LAS bf16x8*)(L + OAM + (16 * ct + n) * 144 + (32 * ks + 8 * g) * 2);
#pragma unroll
                for (int vt = 0; vt < 2; ++vt) o[ct][vt] = __builtin_amdgcn_mfma_f32_16x16x32_bf16(af, vf[vt][ks], o[ct][vt], 0, 0, 0); }
#pragma unroll
        for (int kk = 0; kk < 4; ++kk) { bf16x8 sf[2];
#pragma unroll
            for (int vt = 0; vt < 2; ++vt) { v4u pw; pw.x = pg8::cvt_pk_bf16(S[2 * kk][vt][0], S[2 * kk][vt][1]); pw.y = pg8::cvt_pk_bf16(S[2 * kk][vt][2], S[2 * kk][vt][3]);
                pw.z = pg8::cvt_pk_bf16(S[2 * kk + 1][vt][0], S[2 * kk + 1][vt][1]); pw.w = pg8::cvt_pk_bf16(S[2 * kk + 1][vt][2], S[2 * kk + 1][vt][3]); sf[vt] = __builtin_bit_cast(bf16x8, pw); }
#pragma unroll
            for (int ct = 0; ct < 4; ++ct) { const LAS unsigned char* qp = L + OQD + (16 * ct + n) * 272 + (32 * kk + 4 * g) * 2; const v2u qa = *(const LAS v2u*)qp, qb = *(const LAS v2u*)(qp + 32);
                const bf16x8 qf = __builtin_bit_cast(bf16x8, (v4u){qa.x, qa.y, qb.x, qb.y});
#pragma unroll
                for (int vt = 0; vt < 2; ++vt) o[ct][vt] = __builtin_amdgcn_mfma_f32_16x16x32_bf16(qf, sf[vt], o[ct][vt], 0, 0, 0); } }
#pragma unroll
        for (int dt = 0; dt < 8; ++dt) { const f32x4v eb = *(const LAS f32x4v*)(L + OEB + (16 * dt + 4 * g) * 4);
#pragma unroll
            for (int vt = 0; vt < 2; ++vt) S[dt][vt] = S[dt][vt] * eb;
#pragma unroll
            for (int ks = 0; ks < 2; ++ks) { const bf16x8 kf = *(const LAS bf16x8*)(L + OKT + (16 * dt + n) * 144 + (32 * ks + 8 * g) * 2);
#pragma unroll
                for (int vt = 0; vt < 2; ++vt) S[dt][vt] = __builtin_amdgcn_mfma_f32_16x16x32_bf16(kf, vf[vt][ks], S[dt][vt], 0, 0, 0); } }
        LAS float* PS = (LAS float*)(L + OPS) + (ck & 1) * 512;
#pragma unroll
        for (int ct = 0; ct < 4; ++ct)
#pragma unroll
            for (int r = 0; r < 4; ++r) { const float ss = sum16(o[ct][0][r] * o[ct][0][r] + o[ct][1][r] * o[ct][1][r]); if (n == 0) PS[(16 * ct + 4 * g + r) * 8 + w] = ss; }
        LDS_BARRIER();
        GL_WRITE();
#pragma unroll
        for (int ct = 0; ct < 4; ++ct)
#pragma unroll
            for (int vt = 0; vt < 2; ++vt)
#pragma unroll
                for (int r = 0; r < 4; ++r) *(LAS bf16*)(L + OOT + (16 * ct + 4 * g + r) * 528 + (32 * w + 16 * vt + n) * 2) = (bf16)f2bf(o[ct][vt][r]);
        LDS_BARRIER();
#pragma unroll
        for (int i = 0; i < 4; ++i) { const int tok = (tid >> 5) + 16 * i; float ov[8], gv[8]; unpack8(*(const LAS v4u*)(L + OOT + tok * 528 + (tid & 31) * 16), ov); unpack8(gq[i], gv);
            const LAS f32x4v* pp = (const LAS f32x4v*)(PS + tok * 8); const f32x4v p0 = pp[0], p1 = pp[1];
            const float rstd = rsqrtf(((p0.x + p0.y) + (p0.z + p0.w) + (p1.x + p1.y) + (p1.z + p1.w)) * (1.0f / 256.0f) + 1e-6f);
#pragma unroll
            for (int e = 0; e < 8; ++e) ov[e] = ov[e] * (rstd * gain8[e]) * silu_g(gv[e]);
            if (!(HACK & 2)) *(v4u*)(MIX + (row0 + tok) * DM + 1024 + h * 256 + (tid & 31) * 8) = pack8(ov); }
    }
#undef GL_ISSUE
#undef GL_WRITE
}
constexpr int RC_AT = 0, RC_RT = 2048, RC_BK = 4096, RC_VF = 8192, RC_GF = 10240, RC_U0 = 12288, RC_Y0 = 16384, RC_P15 = 20480, RC_BN = 20736, RC_BYTES = 20800;
__device__ __forceinline__ void prep_rwkv_chunks(Frame& F, int l) {
    const int team = F.tid >> 8, tt = F.tid & 255;
    LAS float* Lt = (LAS float*)(F.lds + RING_OFF) + team * 12288;
    LAS float* XA = Lt; LAS float* XR = Lt + 1040; LAS float* ZB = Lt + 2080; LAS float* ZK = Lt + 3120; LAS float* TB = Lt + 4160; LAS float* TK = Lt + 5200; LAS float* VV = Lt + 6240;
    LAS float* ATl = Lt + 7280; LAS float* U0l = Lt + 8320; LAS float* W1 = Lt + 9360;
    LAS float* Aab = Lt + 10400; LAS float* Aak = Lt + 10672; LAS float* Arb = Lt + 10944; LAS float* Ark = Lt + 11216; LAS float* TT = Lt + 11488;
    const float* RW = WSP(float, WS_RW); constexpr size_t RS = RW_ONE / 4; unsigned char* RWC = F.ws + WS_RWC;
    float pw_[16], pr_[4], pk_[4], pv_[4], pa_[4], pb_[4], pg_[4];
#define RC_FETCH(PAIR) do { const int uc_ = (PAIR) * 2 + team; const size_t cb_ = ((size_t)(uc_ >> 13) * SEQ + (uc_ & 511) * 16) * 1024 + ((uc_ >> 9) & 15) * 64 + (tt & 63); \
        _Pragma("unroll") for (int t = 0; t < 16; ++t) pw_[t] = RW[RS + cb_ + (size_t)t * 1024]; \
        _Pragma("unroll") for (int e = 0; e < 4; ++e) { const size_t o_ = cb_ + (size_t)(4 * (tt >> 6) + e) * 1024; pr_[e] = RW[o_]; pk_[e] = RW[2 * RS + o_]; pv_[e] = RW[3 * RS + o_]; pa_[e] = RW[4 * RS + o_]; pb_[e] = RW[5 * RS + o_]; pg_[e] = RW[6 * RS + o_]; } } while (0)
    if (F.bx < 8192) RC_FETCH(F.bx);
    for (int pair = F.bx; pair < 8192; pair += F.G) {
        const int uc = pair * 2 + team, b = uc >> 13, h = (uc >> 9) & 15, ck = uc & 511; unsigned char* rec = RWC + ((size_t)ck * 32 + (uc >> 9)) * RC_BYTES;     (void)b;
        __syncthreads();
        {
          const int j = tt & 63, q = tt >> 6;
          float cl = 0.f, clq[4] = {0.f, 0.f, 0.f, 0.f}, clm = 0.f;
#pragma unroll
          for (int t = 0; t < 16; ++t) { const float lw = __logf(pw_[t]); if (t == 4 * q) clm = cl; cl += lw; if ((t >> 2) == q) clq[t & 3] = cl; }
#pragma unroll
          for (int e = 0; e < 4; ++e) { const int t = 4 * q + e; const float cprev = e == 0 ? clm : clq[e - 1], cc = clq[e];
              const float rr = pr_[e], kk = pk_[e], vv = pv_[e], aa = pa_[e], bb = pb_[e];
              XA[t * 65 + j] = aa * __expf(cprev); XR[t * 65 + j] = rr * __expf(cc); const float ei = __expf(-cc), ef = __expf(cl - cc);
              ZB[t * 65 + j] = bb * ei; ZK[t * 65 + j] = kk * ei; TB[t * 65 + j] = bb * ef; TK[t * 65 + j] = kk * ef; VV[t * 65 + j] = vv; }
          if (q == 0) ((float*)(rec + RC_P15))[j] = __expf(cl);
          { v2u gw; gw.x = pk2(pg_[0], pg_[1]); gw.y = pk2(pg_[2], pg_[3]); *(v2u*)(rec + RC_GF + (((j >> 4) * 64 + 16 * q + (j & 15)) * 8)) = gw; } }
        if (pair + F.G < 8192) RC_FETCH(pair + F.G);
        __syncthreads();
        {
          const int t = tt >> 4, s = tt & 15; float ab = 0.f, ak = 0.f, rb = 0.f, rk = 0.f;
#pragma unroll 8
          for (int j = 0; j < 64; ++j) { const float xa = XA[t * 65 + j], xr = XR[t * 65 + j], zb = ZB[s * 65 + j], zk = ZK[s * 65 + j]; ab += xa * zb; ak += xa * zk; rb += xr * zb; rk += xr * zk; }
          Aab[t * 17 + s] = s < t ? ab : 0.f; Aak[t * 17 + s] = s < t ? ak : 0.f; Arb[t * 17 + s] = s <= t ? rb : 0.f; Ark[t * 17 + s] = s <= t ? rk : 0.f;
          if (tt < 16) { float bn = 0.f; const float* rkp = F.kin[I_RRK] + l * 1024 + h * 64;
#pragma unroll 8
              for (int j = 0; j < 64; ++j) bn += XR[tt * 65 + j] * ZK[tt * 65 + j] * rkp[j];
              ((float*)(rec + RC_BN))[tt] = bn; } }
        __syncthreads();
        {
          if (tt < 16) { float col[16];
#pragma unroll
              for (int t = 0; t < 16; ++t) { float acc = (t == tt) ? 1.f : 0.f;
#pragma unroll
                  for (int s = 0; s < 16; ++s) if (s < t) acc += Aab[t * 17 + s] * col[s];
                  col[t] = acc; TT[t * 17 + tt] = acc; } }
          const int i = tt & 63, tq = tt >> 6; float acc[4] = {0.f, 0.f, 0.f, 0.f};
#pragma unroll
          for (int s = 0; s < 16; ++s) { const float vv = VV[s * 65 + i];
#pragma unroll
              for (int e = 0; e < 4; ++e) acc[e] += Aak[(4 * tq + e) * 17 + s] * vv; }
#pragma unroll
          for (int e = 0; e < 4; ++e) W1[(4 * tq + e) * 65 + i] = acc[e]; }
        __syncthreads();
        {
          const int j = tt & 63, tq = tt >> 6; float a4[4] = {0.f, 0.f, 0.f, 0.f}, u4[4] = {0.f, 0.f, 0.f, 0.f};
#pragma unroll
          for (int s = 0; s < 16; ++s) { const float xa = XA[s * 65 + j], w1 = W1[s * 65 + j];
#pragma unroll
              for (int e = 0; e < 4; ++e) { const float tv = TT[(4 * tq + e) * 17 + s]; a4[e] += tv * xa; u4[e] += tv * w1; } }
#pragma unroll
          for (int e = 0; e < 4; ++e) { ATl[(4 * tq + e) * 65 + j] = a4[e]; U0l[(4 * tq + e) * 65 + j] = u4[e]; }
          *(f32x4*)(rec + RC_U0 + (((j >> 4) * 64 + 16 * tq + (j & 15)) * 16)) = (f32x4){u4[0], u4[1], u4[2], u4[3]}; }
        __syncthreads();
        {
          const int j = tt & 63, tq = tt >> 6; float r4[4], y4[4];
#pragma unroll
          for (int e = 0; e < 4; ++e) { r4[e] = XR[(4 * tq + e) * 65 + j]; y4[e] = 0.f; }
#pragma unroll
          for (int s = 0; s < 16; ++s) { const float at = ATl[s * 65 + j], u0 = U0l[s * 65 + j], vv = VV[s * 65 + j];
#pragma unroll
              for (int e = 0; e < 4; ++e) { const float arb = Arb[(4 * tq + e) * 17 + s], ark = Ark[(4 * tq + e) * 17 + s]; r4[e] += arb * at; y4[e] += arb * u0 + ark * vv; } }
          *(f32x4*)(rec + RC_Y0 + (((j >> 4) * 64 + 16 * tq + (j & 15)) * 16)) = (f32x4){y4[0], y4[1], y4[2], y4[3]};
#pragma unroll
          for (int e = 0; e < 4; ++e) W1[(4 * tq + e) * 65 + j] = r4[e]; }
        __syncthreads();
        { const int t = tt & 15, jq = tt >> 4, kk = jq >> 3, half = (jq & 7) >> 2, g = jq & 3, j0 = 4 * jq;
          v2u wa, wr; wa.x = pk2(ATl[t * 65 + j0], ATl[t * 65 + j0 + 1]); wa.y = pk2(ATl[t * 65 + j0 + 2], ATl[t * 65 + j0 + 3]); wr.x = pk2(W1[t * 65 + j0], W1[t * 65 + j0 + 1]); wr.y = pk2(W1[t * 65 + j0 + 2], W1[t * 65 + j0 + 3]);
          *(v2u*)(rec + RC_AT + kk * 1024 + (16 * g + t) * 16 + half * 8) = wa; *(v2u*)(rec + RC_RT + kk * 1024 + (16 * g + t) * 16 + half * 8) = wr;
          const int j = tt & 63, gg = tt >> 6; v4u bk; bk.x = pk2(TB[(4 * gg) * 65 + j], TB[(4 * gg + 1) * 65 + j]); bk.y = pk2(TB[(4 * gg + 2) * 65 + j], TB[(4 * gg + 3) * 65 + j]);
          bk.z = pk2(TK[(4 * gg) * 65 + j], TK[(4 * gg + 1) * 65 + j]); bk.w = pk2(TK[(4 * gg + 2) * 65 + j], TK[(4 * gg + 3) * 65 + j]);
          *(v4u*)(rec + RC_BK + (j >> 4) * 1024 + (16 * gg + (j & 15)) * 16) = bk;
          v2u vf; vf.x = pk2(VV[(4 * gg) * 65 + j], VV[(4 * gg + 1) * 65 + j]); vf.y = pk2(VV[(4 * gg + 2) * 65 + j], VV[(4 * gg + 3) * 65 + j]);
          *(v2u*)(rec + RC_VF + ((j >> 4) * 64 + 16 * gg + (j & 15)) * 8) = vf; }
    }
}
#undef RC_FETCH
template <int HACK = 0> __device__ __forceinline__ void rwkv_scan_unit(Frame& F, int l, int b, int h) {
    LAS unsigned char* L = F.lds + RING_OFF;
    const unsigned char* recs = F.ws + WS_RWC + (size_t)(b * 16 + h) * RC_BYTES;
    const int lane = F.lane, n = lane & 15, g = lane >> 4;
    LAS float* XS = (LAS float*)(L + 2 * RC_BYTES);
    if (F.wave >= 2) {
        const int li = F.tid - 128;
        int px[4];
#pragma unroll
        for (int k = 0; k < 4; ++k) { const int x = li + 384 * k; px[k] = x < 1300 ? x : 1299; }
        v4u p0[4], p1[4], p2[4], p3[4], p4[4], p5[4], p6[4], p7[4];
#define RWL_ISSUE(P, CK) do { const int ck_ = (CK) < 512 ? ((HACK & 1) && (CK) >= 4 ? 3 : (CK)) : 511; const v4u* src_ = (const v4u*)(recs + (size_t)ck_ * 32 * RC_BYTES); \
        _Pragma("unroll") for (int k = 0; k < 4; ++k) P[k] = src_[px[k]]; } while (0)
#define RWL_WRITE(P, CK) do { LAS v4u* dst_ = (LAS v4u*)(L + ((CK) & 1) * RC_BYTES); _Pragma("unroll") for (int k = 0; k < 4; ++k) dst_[px[k]] = P[k]; } while (0)
        RWL_ISSUE(p0, 0); RWL_ISSUE(p1, 1); RWL_ISSUE(p2, 2); RWL_ISSUE(p3, 3); RWL_ISSUE(p4, 4); RWL_ISSUE(p5, 5); RWL_ISSUE(p6, 6); RWL_ISSUE(p7, 7);
        RWL_WRITE(p0, 0); RWL_ISSUE(p0, 8);
        LDS_BARRIER();
#pragma unroll 1
        for (int ck = 0; ck < 512; ck += 8) {
            RWL_WRITE(p1, ck + 1); RWL_ISSUE(p1, ck + 9); LDS_BARRIER();
            RWL_WRITE(p2, ck + 2); RWL_ISSUE(p2, ck + 10); LDS_BARRIER();
            RWL_WRITE(p3, ck + 3); RWL_ISSUE(p3, ck + 11); LDS_BARRIER();
            RWL_WRITE(p4, ck + 4); RWL_ISSUE(p4, ck + 12); LDS_BARRIER();
            RWL_WRITE(p5, ck + 5); RWL_ISSUE(p5, ck + 13); LDS_BARRIER();
            RWL_WRITE(p6, ck + 6); RWL_ISSUE(p6, ck + 14); LDS_BARRIER();
            RWL_WRITE(p7, ck + 7); RWL_ISSUE(p7, ck + 15); LDS_BARRIER();
            RWL_WRITE(p0, ck + 8); RWL_ISSUE(p0, ck + 16); LDS_BARRIER();
        }
#undef RWL_ISSUE
#undef RWL_WRITE
        return;
    }
    const int cw = F.wave;
    f32x4v S[4][2];
#pragma unroll
    for (int jt = 0; jt < 4; ++jt)
#pragma unroll
        for (int it = 0; it < 2; ++it) S[jt][it] = (f32x4v){0.f, 0.f, 0.f, 0.f};
    float lnw[2], lnb[2];
#pragma unroll
    for (int it = 0; it < 2; ++it) { lnw[it] = F.kin[I_RLNW][l * 1024 + h * 64 + 16 * (2 * cw + it) + n]; lnb[it] = F.kin[I_RLNB][l * 1024 + h * 64 + 16 * (2 * cw + it) + n]; }
    bf16* MIX = WSP(bf16, WS_MIXED) + ((size_t)b * SEQ) * DM + 2048 + h * 64 + 32 * cw + n;
    f32x4v Yp[2] = {(f32x4v){0.f, 0.f, 0.f, 0.f}, (f32x4v){0.f, 0.f, 0.f, 0.f}}, bnp = (f32x4v){0.f, 0.f, 0.f, 0.f}; v2u gfp[2] = {(v2u){0u, 0u}, (v2u){0u, 0u}}, vfp[2] = {(v2u){0u, 0u}, (v2u){0u, 0u}};
    LDS_BARRIER();
#pragma unroll 1
    for (int ck = 0; ck <= 512; ++ck) {
        if (ck > 0) {
            const LAS float* xs = XS + ((ck - 1) & 1) * 64; const f32x4v a0 = *(const LAS f32x4v*)(xs + 8 * g), a1 = *(const LAS f32x4v*)(xs + 8 * g + 4), b0 = *(const LAS f32x4v*)(xs + 32 + 8 * g), b1 = *(const LAS f32x4v*)(xs + 32 + 8 * g + 4);
            const float s1[4] = {a0[0] + b0[0], a0[2] + b0[2], a1[0] + b1[0], a1[2] + b1[2]}, s2[4] = {a0[1] + b0[1], a0[3] + b0[3], a1[1] + b1[1], a1[3] + b1[3]};
#pragma unroll
            for (int it = 0; it < 2; ++it) { const float gt[4] = {bflo(gfp[it].x), bfhi(gfp[it].x), bflo(gfp[it].y), bfhi(gfp[it].y)}, vt[4] = {bflo(vfp[it].x), bfhi(vfp[it].x), bflo(vfp[it].y), bfhi(vfp[it].y)};
#pragma unroll
                for (int r = 0; r < 4; ++r) { const float mean = s1[r] * (1.0f / 64.0f), var = fmaxf(s2[r] * (1.0f / 64.0f) - mean * mean, 0.f), rstd = rsqrtf(var + 64e-5f);
                    if (!(HACK & 2)) MIX[(size_t)((ck - 1) * 16 + 4 * g + r) * DM + 16 * it] = (bf16)f2bf(((Yp[it][r] - mean) * rstd * lnw[it] + lnb[it] + bnp[r] * vt[r]) * gt[r]); } }
            if (ck == 512) break;
        }
        if (HACK & 4) { LDS_BARRIER(); continue; }
        const LAS unsigned char* R = L + (ck & 1) * RC_BYTES;
        bf16x8 at[2], rt[2];
#pragma unroll
        for (int kk = 0; kk < 2; ++kk) { at[kk] = *(const LAS bf16x8*)(R + RC_AT + kk * 1024 + lane * 16); rt[kk] = *(const LAS bf16x8*)(R + RC_RT + kk * 1024 + lane * 16); }
        f32x4v U[2], Y[2];
#pragma unroll
        for (int it = 0; it < 2; ++it) { U[it] = *(const LAS f32x4v*)(R + RC_U0 + (2 * cw + it) * 1024 + lane * 16); Y[it] = *(const LAS f32x4v*)(R + RC_Y0 + (2 * cw + it) * 1024 + lane * 16); }
#pragma unroll
        for (int kk = 0; kk < 2; ++kk)
#pragma unroll
            for (int it = 0; it < 2; ++it) { v4u pw; pw.x = pg8::cvt_pk_bf16(S[2 * kk][it][0], S[2 * kk][it][1]); pw.y = pg8::cvt_pk_bf16(S[2 * kk][it][2], S[2 * kk][it][3]);
                pw.z = pg8::cvt_pk_bf16(S[2 * kk + 1][it][0], S[2 * kk + 1][it][1]); pw.w = pg8::cvt_pk_bf16(S[2 * kk + 1][it][2], S[2 * kk + 1][it][3]); const bf16x8 sf = __builtin_bit_cast(bf16x8, pw);
                U[it] = __builtin_amdgcn_mfma_f32_16x16x32_bf16(at[kk], sf, U[it], 0, 0, 0); Y[it] = __builtin_amdgcn_mfma_f32_16x16x32_bf16(rt[kk], sf, Y[it], 0, 0, 0); }
        bf16x8 uv[2];
#pragma unroll
        for (int it = 0; it < 2; ++it) { vfp[it] = *(const LAS v2u*)(R + RC_VF + (2 * cw + it) * 512 + lane * 8); gfp[it] = *(const LAS v2u*)(R + RC_GF + (2 * cw + it) * 512 + lane * 8);
            v4u pw; pw.x = pg8::cvt_pk_bf16(U[it][0], U[it][1]); pw.y = pg8::cvt_pk_bf16(U[it][2], U[it][3]); pw.z = vfp[it].x; pw.w = vfp[it].y; uv[it] = __builtin_bit_cast(bf16x8, pw); }
#pragma unroll
        for (int jt = 0; jt < 4; ++jt) { const bf16x8 bk = *(const LAS bf16x8*)(R + RC_BK + jt * 1024 + lane * 16); const f32x4v p15 = *(const LAS f32x4v*)(R + RC_P15 + (16 * jt + 4 * g) * 4);
#pragma unroll
            for (int it = 0; it < 2; ++it) S[jt][it] = __builtin_amdgcn_mfma_f32_16x16x32_bf16(bk, uv[it], S[jt][it] * p15, 0, 0, 0); }
        bnp = *(const LAS f32x4v*)(R + RC_BN + 16 * g); Yp[0] = Y[0]; Yp[1] = Y[1];
        { LAS float* xo = XS + (ck & 1) * 64 + cw * 32; const f32x4v sm = Y[0] + Y[1], sq = Y[0] * Y[0] + Y[1] * Y[1];
#pragma unroll
          for (int r = 0; r < 4; ++r) { const float a = sum16(sm[r]), q = sum16(sq[r]); if (n == 0) { xo[(4 * g + r) * 2] = a; xo[(4 * g + r) * 2 + 1] = q; } } }
        LDS_BARRIER();
    }
}
template <int HACK = 0> __device__ __forceinline__ void mixers_v4(Frame& F, int l, int qi, int mask = 15) {
    gu32* ctr = F.ctl + CW_Q + 64 * qi;
    for (;;) {
        const int it = next_item(F, ctr); relaunder(F); relaunder_tid(F);
        if (it < 32) { if (mask & 1) rwkv_scan_unit<HACK>(F, l, it >> 4, it & 15); }
        else if (it < 40) { const int j = it - 32; if (mask & 2) gla_scan_unit<HACK>(F, l, j >> 2, j & 3); }
        else if (it < 40 + 1024) { const int j = it - 40, qb = 63 - (j >> 4), bh = j & 15; if (mask & 4) attn_unit<true>(F, l, bh >> 3, bh & 7, qb); }
        else if (it < 40 + 2048) { const int j = it - 1064, qb = j & 63, bh = j >> 6; if (mask & 8) attn_unit<false>(F, l, bh >> 3, bh & 7, qb); }
        else break;
    }
}
struct Args { const float* in[35]; float* out; unsigned char* ws; };
__device__ __forceinline__ void mk_frame(Frame& F, int wv) {
    extern __shared__ __attribute__((aligned(16))) unsigned char lds[];
    kargp kp = (kargp)__builtin_amdgcn_kernarg_segment_ptr(); asm volatile("" : "+s"(kp));
    F.kin = kp;
    F.lds = (LAS unsigned char*)lds;
    F.MISC = (volatile LAS unsigned*)(F.lds + MISC_OFF);
    { int w_ = wv; asm volatile("" : "+s"(w_)); int t_ = (int)__builtin_amdgcn_mbcnt_hi(~0u, __builtin_amdgcn_mbcnt_lo(~0u, (unsigned)w_ * 64u)); asm volatile("" : "+v"(t_)); F.tid = t_; } F.lane = F.tid & 63; F.wave = __builtin_amdgcn_readfirstlane(F.tid >> 6);
    F.G = gridDim.x; { int bx = blockIdx.x; asm volatile("" : "+s"(bx)); F.bx = bx; F.vcu = (F.G % 8 == 0) ? (bx % 8) * (F.G / 8) + bx / 8 : bx; }
    F.out = (float*)kp[35]; F.ws = (unsigned char*)kp[36]; F.ctl = (gu32*)(F.ws + WS_CTL);
}
__device__ __forceinline__ void grid_bar(int wv) {
    Frame F; mk_frame(F, wv);
    XcdBarrier bar; bar.bar = (unsigned*)(F.ctl + CW_BAR); bar.x = xb_xcc_id(); bar.st = F.MISC + 8;
    xcd_barrier(bar);
}
__global__ void __launch_bounds__(NWAVES * 64, 2) mega_fwd(Args args) {
    const int wv = __builtin_amdgcn_readfirstlane((int)threadIdx.x >> 6);
    { Frame F; mk_frame(F, wv);
      for (int u = F.tid; u < (LDS_BYTES - LDSCTL_OFF) / 4; u += NWAVES * 64) ((LAS unsigned*)(F.lds + LDSCTL_OFF))[u] = 0u;
      __syncthreads();
      (void)xcd_barrier_post((unsigned*)(F.ctl + CW_BAR), F.MISC + 8);
#ifndef NO_P0
      p0_prologue_a(F);
#endif
#ifdef REP_P0
      __syncthreads(); p0_prologue_a(F);
#endif
    }
    grid_bar(wv);
    { Frame F; mk_frame(F, wv); p0_prologue_b(F); }
    grid_bar(wv);
#pragma unroll 1
    for (int l = 0; l < NLAYER; ++l) {
#ifndef REP_HACK
#define REP_HACK 0
#endif
#define LAYER_VARS const float* mod = WSP(float, WS_MOD) + (size_t)l * 2 * 24576; const float* xin = l == 0 ? F.kin[I_X] : F.out; (void)mod; (void)xin
#ifndef NO_RMS
        { Frame F; mk_frame(F, wv); LAYER_VARS; rms_phase(F, xin, mod + 0, mod + 4096); }
#endif
        grid_bar(wv);
#ifndef NO_G1
        { Frame F; mk_frame(F, wv);
          pg8::Gemm g{WSP(pg8::bf16_t, WS_XN), WSP(pg8::bf16_t, WS_WIN + l * WIN_L), M, NIN, DM}; pg8::StaticOrder S; S.init(M, NIN, F.G, F.bx);
          pg8::EpiCols E{WSP(pg8::bf16_t, WS_COLS), WSP(float, WS_LOWR)};
          pg8::gemm_phase<pg8::EpiCols, pg8::StaticOrder, true, true>(F.lds + RING_OFF, g, S, E, F.tid); }
#endif
#ifdef REP_IN
        grid_bar(wv);
        { Frame F; mk_frame(F, wv);
          pg8::Gemm g{WSP(pg8::bf16_t, WS_XN), WSP(pg8::bf16_t, WS_WIN + l * WIN_L), M, NIN, DM}; pg8::StaticOrder S; S.init(M, NIN, F.G, F.bx);
          pg8::EpiCols E{WSP(pg8::bf16_t, WS_COLS), WSP(float, WS_LOWR)};
          pg8::gemm_phase<pg8::EpiCols, pg8::StaticOrder, true, true>(F.lds + RING_OFF, g, S, E, F.tid); }
#endif
        grid_bar(wv);
#ifndef NO_PREP
        { Frame F; mk_frame(F, wv); prep_norm(F, l); }
        { Frame F; mk_frame(F, wv); prep_loga(F, l); }
        { Frame F; mk_frame(F, wv); prep_rwkv(F, l); }
#ifdef REP_P2
        { Frame F; mk_frame(F, wv); prep_rwkv(F, l); }
#endif
        { Frame F; mk_frame(F, wv); prep_vt(F, 0); }
        { Frame F; mk_frame(F, wv); prep_vt(F, 1); }
        { Frame F; mk_frame(F, wv); prep_gla(F); }
#ifdef REP_P3
        { Frame F; mk_frame(F, wv); prep_vt(F, 0); }
        { Frame F; mk_frame(F, wv); prep_vt(F, 1); }
        { Frame F; mk_frame(F, wv); prep_gla(F); }
#endif
        grid_bar(wv);
        { Frame F; mk_frame(F, wv); prep_rwkv_chunks(F, l); }
#ifdef REP_P4
        { Frame F; mk_frame(F, wv); prep_rwkv_chunks(F, l); }
#endif
#endif
#ifdef REP_PREP
        grid_bar(wv);
        { Frame F; mk_frame(F, wv); prep_norm(F, l); }
        { Frame F; mk_frame(F, wv); prep_loga(F, l); }
        { Frame F; mk_frame(F, wv); prep_rwkv(F, l); }
        { Frame F; mk_frame(F, wv); prep_vt(F, 0); }
        { Frame F; mk_frame(F, wv); prep_vt(F, 1); }
        { Frame F; mk_frame(F, wv); prep_gla(F); }
        grid_bar(wv);
        { Frame F; mk_frame(F, wv); prep_rwkv_chunks(F, l); }
#endif
        grid_bar(wv);
#ifndef NO_MIX
#ifdef REP_MIX
        { Frame F; mk_frame(F, wv); mixers_v4<REP_HACK>(F, l, l + 2, REP_MIX); }
        grid_bar(wv);
#endif
        { Frame F; mk_frame(F, wv); mixers_v4(F, l, l); }
#endif
        grid_bar(wv);
#ifndef NO_G2
        { Frame F; mk_frame(F, wv); LAYER_VARS;
          pg8::Gemm g{WSP(pg8::bf16_t, WS_MIXED), WSP(pg8::bf16_t, WS_WOUT + l * WOUT_L), M, DM, DM}; pg8::StaticOrder S; S.init(M, DM, F.G, F.bx);
          pg8::EpiRes E{xin, F.out, mod + 2 * 4096};
          pg8::gemm_phase<pg8::EpiRes, pg8::StaticOrder, true, true>(F.lds + RING_OFF, g, S, E, F.tid); }
#endif
        grid_bar(wv);
        { Frame F; mk_frame(F, wv); LAYER_VARS; rms_phase(F, F.out, mod + 3 * 4096, mod + 4 * 4096); }
#ifdef REP_RMS
        { Frame F; mk_frame(F, wv); LAYER_VARS; rms_phase(F, F.out, mod + 3 * 4096, mod + 4 * 4096); }
#endif
        grid_bar(wv);
#ifndef NO_G3
        { Frame F; mk_frame(F, wv);
          pg8::Gemm g{WSP(pg8::bf16_t, WS_XN), WSP(pg8::bf16_t, WS_W13 + l * W13_L), M, 2 * DFF, DM}; pg8::StaticOrder S; S.init(M, 2 * DFF, F.G, F.bx);
          pg8::EpiSwiglu E{WSP(pg8::bf16_t, WS_HID)};
          pg8::gemm_phase<pg8::EpiSwiglu, pg8::StaticOrder, true, true>(F.lds + RING_OFF, g, S, E, F.tid); }
#endif
#ifdef REP_UP
        grid_bar(wv);
        { Frame F; mk_frame(F, wv);
          pg8::Gemm g{WSP(pg8::bf16_t, WS_XN), WSP(pg8::bf16_t, WS_W13 + l * W13_L), M, 2 * DFF, DM}; pg8::StaticOrder S; S.init(M, 2 * DFF, F.G, F.bx);
          pg8::EpiSwiglu E{WSP(pg8::bf16_t, WS_HID)};
          pg8::gemm_phase<pg8::EpiSwiglu, pg8::StaticOrder, true, true>(F.lds + RING_OFF, g, S, E, F.tid); }
#endif
        grid_bar(wv);
#ifndef NO_G4
        { Frame F; mk_frame(F, wv); LAYER_VARS;
          pg8::Gemm g{WSP(pg8::bf16_t, WS_HID), WSP(pg8::bf16_t, WS_W2 + l * W2_L), M, DM, DFF}; pg8::StaticOrder S; S.init(M, DM, F.G, F.bx);
          pg8::EpiRes E{F.out, F.out, mod + 5 * 4096};
          pg8::gemm_phase<pg8::EpiRes, pg8::StaticOrder, true, true>(F.lds + RING_OFF, g, S, E, F.tid); }
#endif
        if (l + 1 < NLAYER) grid_bar(wv);
#undef LAYER_VARS
    }
}

extern "C" void kernel_launch(void* const* d_in, const int* in_sizes, int n_in, void* d_out, int out_size, void* d_ws, size_t ws_size, hipStream_t stream) {
    static int grid = 0;
    if (grid == 0) {
        if (n_in != 35 || in_sizes[0] != M * DM || out_size != M * DM || ws_size < WS_END) { fprintf(stderr, "kernel_launch: unexpected shapes: n_in %d in0 %d out %d ws %zu (need %zu)\n", n_in, n_in > 0 ? in_sizes[0] : -1, out_size, ws_size, (size_t)WS_END); grid = -1; return; }
        int dev = 0, cus = 0, per_cu = 0;
        if (hipGetDevice(&dev) != hipSuccess || hipDeviceGetAttribute(&cus, hipDeviceAttributeMultiprocessorCount, dev) != hipSuccess) { grid = -1; return; }
        if (hipFuncSetAttribute((const void*)mega_fwd, hipFuncAttributeMaxDynamicSharedMemorySize, LDS_BYTES) != hipSuccess) { fprintf(stderr, "kernel_launch: hipFuncSetAttribute failed\n"); grid = -1; return; }
        if (hipOccupancyMaxActiveBlocksPerMultiprocessor(&per_cu, (const void*)mega_fwd, NWAVES * 64, LDS_BYTES) != hipSuccess || per_cu < 1) fprintf(stderr, "kernel_launch: occupancy query says %d\n", per_cu);
        (void)hipGetLastError();
        grid = cus;
    }
    if (grid < 0) return;
    if (hipMemsetAsync((char*)d_ws + WS_CTL, 0, CTL_ZERO_BYTES, stream) != hipSuccess) return;
    Args a{};
    for (int i = 0; i < 35; ++i) a.in[i] = (const float*)d_in[i];
    a.out = (float*)d_out; a.ws = (unsigned char*)d_ws;
    hipLaunchKernelGGL(mega_fwd, dim3(grid), dim3(NWAVES * 64), LDS_BYTES, stream, a);
}
```

```cpp
#include <hip/hip_runtime.h>
#include <cstdio>
#include <cstdint>
namespace pg8 {
#define PG8_LAS __attribute__((address_space(3)))
typedef unsigned short bf16_t;
typedef short bf16x8 __attribute__((ext_vector_type(8)));
typedef float f32x4 __attribute__((ext_vector_type(4)));
typedef unsigned u32x4 __attribute__((ext_vector_type(4)));
constexpr int BM = 256, BK = 64, HALF = 128, HTB = HALF * BK * 2  , STAGE_BYTES = 8 * HTB, NXCD = 8, WGM = 8;

__host__ __device__ __forceinline__ int lds_byte(int r, int c) { const int st = (r >> 4) * 2 + (c >> 5), rr = r & 15, cc = c & 31, ob = rr * 64 + cc * 2; return st * 1024 + (ob ^ (((ob >> 9) & 1) << 5)); }
__host__ __device__ __forceinline__ void stage_rc(int b, int& R, int& C) { const int st = b / 1024, sb = b % 1024, swz = sb ^ (((sb >> 9) & 1) << 5); R = (st >> 1) * 16 + swz / 64; C = (st & 1) * 32 + (swz % 64) / 2; }
__host__ __device__ __forceinline__ int perm32(int rho) { const int n = rho >> 4, i = rho & 15; return 8 * (i >> 2) + 4 * n + (i & 3); }

struct Unit { int pm, pn; };
struct Gemm { const bf16_t* A; const bf16_t* Bt; int M, N, K; };

struct StaticOrder {
    int nM, nN, nwg, G, c;
    __host__ __device__ void init(int M, int N, int G_, int c_) { nM = M / BM; nN = N / BM; nwg = nM * nN; G = G_; c = c_; }
    __host__ __device__ bool next(int i, Unit& u) const {
        const long L = (long)i * G + c; if (L >= nwg) return false;
        int wgid = (int)L; { const int q = nwg / NXCD, r = nwg % NXCD, xcd = wgid % NXCD, off = wgid / NXCD; wgid = (xcd < r ? xcd * (q + 1) : r * (q + 1) + (xcd - r) * q) + off; }
        const int nig = WGM * nN, gid = wgid / nig, fm = gid * WGM, gsz = (nM - fm) < WGM ? (nM - fm) : WGM;
        u.pm = fm + ((wgid % nig) % gsz); u.pn = (wgid % nig) / gsz; return true;
    }
    __device__ __forceinline__ void a_ready(const Unit&) const {}
    __device__ __forceinline__ void done(const Unit&) const {}
};

typedef float f32x2c_t __attribute__((ext_vector_type(2))); typedef __bf16 bf16x2c_t __attribute__((ext_vector_type(2)));
__device__ __forceinline__ unsigned cvt_pk_bf16(float lo, float hi) { const f32x2c_t v = {lo, hi}; return __builtin_bit_cast(unsigned, __builtin_convertvector(v, bf16x2c_t)); }
typedef float f32x2 __attribute__((ext_vector_type(2)));
__device__ __forceinline__ float silu_f(float x) { return x * __builtin_amdgcn_rcpf(1.0f + __builtin_amdgcn_exp2f(-1.4426950408889634f * x)); }
struct EpiCols {
    static constexpr bool PERM = true, AFTER_DRAIN = false;
    bf16_t* O; float* L;
    __device__ __forceinline__ void operator()(const f32x4 (&acc)[2][2][4][2], const Unit& u, int wr, int wc, int fr, int fq) const {
        const int row0 = u.pm * BM + wr * 64 + fr;
        if (u.pn < 41) {
            const int col0 = u.pn * BM + wc * 32 + 8 * fq;
#pragma unroll
            for (int ai = 0; ai < 2; ++ai)
#pragma unroll
                for (int m = 0; m < 4; ++m) { bf16_t* rowp = O + (size_t)(row0 + ai * HALF + m * 16) * 10496 + col0;
#pragma unroll
                    for (int bj = 0; bj < 2; ++bj) { const f32x4 v0 = acc[ai][bj][m][0], v1 = acc[ai][bj][m][1];
                        u32x4 w; w.x = cvt_pk_bf16(v0[0], v0[1]); w.y = cvt_pk_bf16(v0[2], v0[3]); w.z = cvt_pk_bf16(v1[0], v1[1]); w.w = cvt_pk_bf16(v1[2], v1[3]);
                        *(u32x4*)(rowp + bj * HALF) = w; } }
        } else {
            const int col0 = wc * 32 + 8 * fq;
#pragma unroll
            for (int ai = 0; ai < 2; ++ai)
#pragma unroll
                for (int m = 0; m < 4; ++m) { float* rowp = L + (size_t)(row0 + ai * HALF + m * 16) * 256 + col0;
#pragma unroll
                    for (int bj = 0; bj < 2; ++bj) { *(f32x4*)(rowp + bj * HALF) = acc[ai][bj][m][0]; *(f32x4*)(rowp + bj * HALF + 4) = acc[ai][bj][m][1]; } }
        }
    }
};
struct EpiRes {
    static constexpr bool PERM = false, AFTER_DRAIN = false;
    const float* base; float* out; const float* gate;
    __device__ __forceinline__ void operator()(const f32x4 (&acc)[2][2][4][2], const Unit& u, int wr, int wc, int fr, int fq) const {
        const int row0 = u.pm * BM + wr * 64 + fr, col0 = u.pn * BM + wc * 32 + 4 * fq;
        const float* gp = gate + (size_t)(u.pm >> 5) * 24576 + col0;
        f32x4 gv[2][2];
#pragma unroll
        for (int bj = 0; bj < 2; ++bj)
#pragma unroll
            for (int n = 0; n < 2; ++n) gv[bj][n] = *(const f32x4*)(gp + bj * HALF + n * 16);
#pragma unroll
        for (int ai = 0; ai < 2; ++ai)
#pragma unroll
            for (int m = 0; m < 4; ++m) { const size_t off = (size_t)(row0 + ai * HALF + m * 16) * 4096 + col0;
#pragma unroll
                for (int bj = 0; bj < 2; ++bj)
#pragma unroll
                    for (int n = 0; n < 2; ++n) { const f32x4 bs = *(const f32x4*)(base + off + bj * HALF + n * 16); *(f32x4*)(out + off + bj * HALF + n * 16) = bs + gv[bj][n] * acc[ai][bj][m][n]; }
                if (m & 1) asm volatile("" ::: "memory"); }
    }
};
struct EpiSwiglu {
    static constexpr bool PERM = true, AFTER_DRAIN = false;
    bf16_t* H;
    __device__ __forceinline__ void operator()(const f32x4 (&acc)[2][2][4][2], const Unit& u, int wr, int wc, int fr, int fq) const {
        const int row0 = u.pm * BM + wr * 64 + fr, col0 = u.pn * HALF + wc * 32 + 8 * fq;
#pragma unroll
        for (int ai = 0; ai < 2; ++ai)
#pragma unroll
            for (int m = 0; m < 4; ++m) { bf16_t* rowp = H + (size_t)(row0 + ai * HALF + m * 16) * 11008 + col0;
                const f32x4 a0 = acc[ai][0][m][0], a1 = acc[ai][0][m][1], b0 = acc[ai][1][m][0], b1 = acc[ai][1][m][1];
                u32x4 w; w.x = cvt_pk_bf16(silu_f(a0[0]) * b0[0], silu_f(a0[1]) * b0[1]); w.y = cvt_pk_bf16(silu_f(a0[2]) * b0[2], silu_f(a0[3]) * b0[3]);
                w.z = cvt_pk_bf16(silu_f(a1[0]) * b1[0], silu_f(a1[1]) * b1[1]); w.w = cvt_pk_bf16(silu_f(a1[2]) * b1[2], silu_f(a1[3]) * b1[3]);
                *(u32x4*)rowp = w; }
    }
};
template <class Epi, class Sched, bool ALIGN_EPI = false, bool SP2 = false>
__device__ __forceinline__ void gemm_phase(PG8_LAS unsigned char* lds, const Gemm g, const Sched& S, const Epi& E, int tid_in) {
    int tid_ = tid_in; asm volatile("" : "+v"(tid_));
    const int tid = tid_, wid = __builtin_amdgcn_readfirstlane(tid >> 6), lane = tid & 63, wr = wid >> 2, wc = wid & 3, fr = lane & 15, fq = lane >> 4;
    const int K = g.K, nt = K / BK;
    unsigned voffA[2], voffB[2];
#pragma unroll
    for (int i = 0; i < 2; ++i) { int R, C; stage_rc(tid * 16 + i * 8192, R, C); const int Rb = Epi::PERM ? ((R & ~31) + perm32(R & 31)) : R;
        voffA[i] = (unsigned)(R * K + C) * 2u; voffB[i] = (unsigned)(Rb * K + C) * 2u; }
    const size_t kstep = (size_t)(BK * 2);
    const size_t hstep = (size_t)HALF * K * 2;
    const size_t tstep = 2 * hstep;
    const unsigned ldsw = (unsigned)wid * 1024u;
    const int aoff = lds_byte(wr * 64 + fr, fq * 8), boff = lds_byte(wc * 32 + fr, fq * 8);
#define PG8_SA(b, h) (((b) * 2 + (h)) * HTB)
#define PG8_SB(b, h) ((4 + (b) * 2 + (h)) * HTB)
#define PG8_STAGE(bufoff, gbase, voff) do { _Pragma("unroll") for (int _i = 0; _i < 2; ++_i) \
        __builtin_amdgcn_global_load_lds((const unsigned*)((const char*)(gbase) + (voff)[_i]), (PG8_LAS unsigned*)(lds + (bufoff) + ldsw + _i * 8192), 16, 0, 0); } while (0)
#define PG8_LDA(dst, b, h) do { _Pragma("unroll") for (int m = 0; m < 4; ++m) _Pragma("unroll") for (int k = 0; k < 2; ++k) dst[m][k] = *(const PG8_LAS bf16x8*)(lds + PG8_SA(b, h) + aoff + m * 2048 + k * 1024); } while (0)
#define PG8_LDB(dst, b, h) do { _Pragma("unroll") for (int n = 0; n < 2; ++n) _Pragma("unroll") for (int k = 0; k < 2; ++k) dst[n][k] = *(const PG8_LAS bf16x8*)(lds + PG8_SB(b, h) + boff + n * 2048 + k * 1024); } while (0)
#define PG8_MMA(ai, bj, At, Bt) do { __builtin_amdgcn_s_setprio(1); _Pragma("unroll") for (int m = 0; m < 4; ++m) _Pragma("unroll") for (int n = 0; n < 2; ++n) _Pragma("unroll") for (int k = 0; k < 2; ++k) \
        acc[ai][bj][m][n] = __builtin_amdgcn_mfma_f32_16x16x32_bf16(Bt[n][k], At[m][k], acc[ai][bj][m][n], 0, 0, 0); __builtin_amdgcn_s_setprio(0); } while (0)
#define PG8_WAIT_V(n) asm volatile("s_waitcnt vmcnt(" #n ")" ::: "memory")
#define PG8_WAIT_L(n) asm volatile("s_waitcnt lgkmcnt(" #n ")" ::: "memory")
#define PG8_BAR __builtin_amdgcn_s_barrier()
#define PG8_SCHED __builtin_amdgcn_sched_barrier(0)
    Unit cur, nxt; int ui = 0;
    if (!S.next(0, cur)) return;
    f32x4 acc[2][2][4][2];
#pragma unroll
    for (int a = 0; a < 2; ++a)
#pragma unroll
        for (int b = 0; b < 2; ++b)
#pragma unroll
            for (int m = 0; m < 4; ++m)
#pragma unroll
                for (int n = 0; n < 2; ++n) acc[a][b][m][n] = (f32x4){0.f, 0.f, 0.f, 0.f};
    bf16x8 At[4][2], B0[2][2], B1[2][2];
    const char* cA = (const char*)g.A + (size_t)cur.pm * tstep; const char* cB = (const char*)g.Bt + (size_t)cur.pn * tstep;
    S.a_ready(cur);
    if constexpr (SP2) {
        PG8_STAGE(PG8_SB(0, 0), cB, voffB); PG8_STAGE(PG8_SB(0, 1), cB + hstep, voffB); PG8_STAGE(PG8_SA(0, 0), cA, voffA); PG8_STAGE(PG8_SA(0, 1), cA + hstep, voffA);
        if (wr == 1) PG8_BAR;
        PG8_WAIT_V(2); PG8_BAR;
        PG8_STAGE(PG8_SB(1, 0), cB + kstep, voffB); PG8_STAGE(PG8_SA(1, 0), cA + kstep, voffA); PG8_STAGE(PG8_SB(1, 1), cB + hstep + kstep, voffB);
        PG8_WAIT_V(6); PG8_BAR;
    } else {
        PG8_STAGE(PG8_SB(0, 0), cB, voffB); PG8_STAGE(PG8_SA(0, 0), cA, voffA); PG8_STAGE(PG8_SB(0, 1), cB + hstep, voffB); PG8_STAGE(PG8_SA(0, 1), cA + hstep, voffA);
        if (wr == 1) PG8_BAR;
        PG8_WAIT_V(4); PG8_BAR;
        PG8_STAGE(PG8_SB(1, 0), cB + kstep, voffB); PG8_STAGE(PG8_SA(1, 0), cA + kstep, voffA); PG8_STAGE(PG8_SB(1, 1), cB + hstep + kstep, voffB);
        PG8_WAIT_V(6); PG8_BAR;
    }
    for (;;) {
        const bool has_next = S.next(ui + 1, nxt);
        const char* nA = has_next ? (const char*)g.A + (size_t)nxt.pm * tstep : cA; const char* nB = has_next ? (const char*)g.Bt + (size_t)nxt.pn * tstep : cB;
        for (int t = 0; t < nt; t += 2) {
            const bool last = (t == nt - 2);
            const char* a1 = cA + (size_t)(t + 1) * kstep;
            const char* a2 = last ? nA : cA + (size_t)(t + 2) * kstep; const char* b2 = last ? nB : cB + (size_t)(t + 2) * kstep;
            const char* a3 = a2 + kstep; const char* b3 = b2 + kstep;
            if (last && has_next) S.a_ready(nxt);
            if constexpr (SP2) {
            PG8_LDB(B0, 0, 0); PG8_LDB(B1, 0, 1); PG8_SCHED; PG8_LDA(At, 0, 0); PG8_STAGE(PG8_SA(1, 1), a1 + hstep, voffA);
            PG8_WAIT_V(8); PG8_WAIT_L(0); PG8_BAR; PG8_MMA(0, 0, At, B0); PG8_MMA(0, 1, At, B1); PG8_BAR; PG8_SCHED;
            PG8_LDA(At, 0, 1); PG8_STAGE(PG8_SB(0, 0), b2, voffB); PG8_STAGE(PG8_SB(0, 1), b2 + hstep, voffB); PG8_STAGE(PG8_SA(0, 0), a2, voffA);
            PG8_WAIT_V(8); PG8_WAIT_L(0); PG8_BAR; PG8_MMA(1, 0, At, B0); PG8_MMA(1, 1, At, B1); PG8_BAR; PG8_SCHED;
            PG8_LDB(B0, 1, 0); PG8_LDB(B1, 1, 1); PG8_SCHED; PG8_LDA(At, 1, 0); PG8_STAGE(PG8_SA(0, 1), a2 + hstep, voffA);
            PG8_WAIT_V(8); PG8_WAIT_L(0); PG8_BAR; PG8_MMA(0, 0, At, B0); PG8_MMA(0, 1, At, B1); PG8_BAR; PG8_SCHED;
            PG8_LDA(At, 1, 1); PG8_STAGE(PG8_SB(1, 0), b3, voffB); PG8_STAGE(PG8_SB(1, 1), b3 + hstep, voffB); PG8_STAGE(PG8_SA(1, 0), a3, voffA);
            PG8_WAIT_V(8); PG8_WAIT_L(0); PG8_BAR; PG8_MMA(1, 0, At, B0); PG8_MMA(1, 1, At, B1); PG8_BAR; PG8_SCHED;
            } else {
            PG8_LDB(B0, 0, 0); PG8_SCHED; PG8_LDA(At, 0, 0); PG8_STAGE(PG8_SA(1, 1), a1 + hstep, voffA);
            PG8_WAIT_L(8); PG8_BAR; PG8_WAIT_L(0); PG8_MMA(0, 0, At, B0); PG8_BAR; PG8_SCHED;
            PG8_LDB(B1, 0, 1); PG8_STAGE(PG8_SB(0, 0), b2, voffB);
            PG8_BAR; PG8_WAIT_L(0); PG8_MMA(0, 1, At, B1); PG8_BAR;
            PG8_LDA(At, 0, 1); PG8_STAGE(PG8_SA(0, 0), a2, voffA);
            PG8_BAR; PG8_WAIT_L(0); PG8_MMA(1, 0, At, B0); PG8_BAR; PG8_SCHED;
            PG8_STAGE(PG8_SB(0, 1), b2 + hstep, voffB);
            PG8_WAIT_V(6); PG8_BAR; PG8_MMA(1, 1, At, B1); PG8_BAR;
            PG8_LDB(B0, 1, 0); PG8_SCHED; PG8_LDA(At, 1, 0); PG8_STAGE(PG8_SA(0, 1), a2 + hstep, voffA);
            PG8_WAIT_L(8); PG8_BAR; PG8_WAIT_L(0); PG8_MMA(0, 0, At, B0); PG8_BAR; PG8_SCHED;
            PG8_LDB(B1, 1, 1); PG8_STAGE(PG8_SB(1, 0), b3, voffB);
            PG8_BAR; PG8_WAIT_L(0); PG8_MMA(0, 1, At, B1); PG8_BAR;
            PG8_LDA(At, 1, 1); PG8_STAGE(PG8_SA(1, 0), a3, voffA);
            PG8_BAR; PG8_WAIT_L(0); PG8_MMA(1, 0, At, B0); PG8_BAR; PG8_SCHED;
            PG8_STAGE(PG8_SB(1, 1), b3 + hstep, voffB);
            PG8_WAIT_V(6); PG8_BAR; PG8_MMA(1, 1, At, B1); PG8_BAR;
            }
        }
        if constexpr (ALIGN_EPI) { if (wr == 0) PG8_BAR; }
        if constexpr (!Epi::AFTER_DRAIN) { E(acc, cur, wr, wc, fr, fq); S.done(cur); }
        if (!has_next) break;
#pragma unroll
        for (int a = 0; a < 2; ++a)
#pragma unroll
            for (int b = 0; b < 2; ++b)
#pragma unroll
                for (int m = 0; m < 4; ++m)
#pragma unroll
                    for (int n = 0; n < 2; ++n) acc[a][b][m][n] = (f32x4){0.f, 0.f, 0.f, 0.f};
        cur = nxt; cA = nA; cB = nB; ++ui;
        if constexpr (ALIGN_EPI) { if (wr == 1) PG8_BAR; }
    }
    PG8_WAIT_V(0);
    if constexpr (!ALIGN_EPI) { if (wr == 0) PG8_BAR; }
    PG8_BAR;
    if constexpr (Epi::AFTER_DRAIN) { E.fused(acc, cur, wr, wc, fr, fq, lds, wid, lane); S.done(cur); }
#undef PG8_SA
#undef PG8_SB
#undef PG8_STAGE
#undef PG8_LDA
#undef PG8_LDB
#undef PG8_MMA
#undef PG8_WAIT_V
#undef PG8_WAIT_L
#undef PG8_BAR
#undef PG8_SCHED
}
}
constexpr int BATCH = 2, SEQ = 8192, DM = 4096, M = BATCH * SEQ, DFF = 11008, NLAYER = 2;
constexpr int P_IN = 10704, NIN = 10752, NMAIN = 10496;
constexpr int CA_Q = 0, CA_K = 1024, CA_V = 2048;
constexpr int CB_Q = 3072, CB_K = 3584, CB_V = 4096, CB_G = 5120;
constexpr int CC_R = 6144, CC_K = 7168, CC_V = 8192;
constexpr int CD_Q = 9216, CD_K = 10240, CD_V = 10368;
constexpr float LOG2E = 1.4426950408889634f;
constexpr float QSCALE = 0.125f * LOG2E;
constexpr int NWAVES = 8;

constexpr size_t MiB = 1u << 20;
constexpr size_t WS_CTL = 0, CTL_ZERO_BYTES = 1 * MiB;
constexpr size_t WS_MODP = 2 * MiB;
constexpr size_t WS_MOD = 14 * MiB;
constexpr size_t WS_TAB = 15 * MiB;
constexpr size_t WS_WIN = 16 * MiB, WIN_L = 84 * MiB;
constexpr size_t WS_WOUT = 184 * MiB, WOUT_L = 32 * MiB;
constexpr size_t WS_W13 = 248 * MiB, W13_L = 172 * MiB;
constexpr size_t WS_W2 = 592 * MiB, W2_L = 86 * MiB;
constexpr size_t WS_XN = 764 * MiB;
constexpr size_t WS_COLS = 892 * MiB;
constexpr size_t WS_LOWR = 1220 * MiB;
constexpr size_t WS_HID = 892 * MiB;
constexpr size_t WS_QKA = 1236 * MiB;
constexpr size_t WS_QKD = 1300 * MiB;
constexpr size_t WS_LOGA = 1336 * MiB;
constexpr size_t WS_RW = 1368 * MiB, RW_ONE = 64 * MiB;
constexpr size_t WS_VFIRST = 1816 * MiB;
constexpr size_t WS_MIXED = 1880 * MiB;
constexpr int VROW = SEQ + 64;
constexpr size_t WS_VTA = 2008 * MiB;
constexpr size_t WS_VTD = 2041 * MiB;
constexpr size_t WS_QDEC = 2046 * MiB, WS_KDT = 2062 * MiB, WS_AM = 2078 * MiB, WS_EBL = 2086 * MiB;
constexpr size_t WS_VTB = 2087 * MiB;
constexpr size_t WS_RWC = 2120 * MiB;
constexpr size_t WS_END = 2446 * MiB;
constexpr int CW_BAR = 4096;
constexpr int CW_Q = 16384;

constexpr int RING_OFF = 0, RING_BYTES = 131072;
constexpr int LDSCTL_OFF = RING_BYTES, MISC_OFF = LDSCTL_OFF + 320;
constexpr int LDS_BYTES = 147456;

#define GAS __attribute__((address_space(1)))
#define LAS __attribute__((address_space(3)))
typedef unsigned short bf16;
typedef unsigned v4u __attribute__((ext_vector_type(4)));
typedef unsigned v2u __attribute__((ext_vector_type(2)));
typedef float f32x4 __attribute__((ext_vector_type(4)));
typedef short bf16x8 __attribute__((ext_vector_type(8)));
typedef GAS unsigned gu32;
#define RLX_AGENT __ATOMIC_RELAXED, __HIP_MEMORY_SCOPE_AGENT
#define LDS_WAIT() asm volatile("s_waitcnt lgkmcnt(0)" ::: "memory")
#define VM_WAIT() asm volatile("s_waitcnt vmcnt(0)" ::: "memory")
typedef float f32x2_t __attribute__((ext_vector_type(2))); typedef __bf16 bf16x2_t __attribute__((ext_vector_type(2)));
__device__ __forceinline__ unsigned pk2(float lo, float hi) { const f32x2_t v = {lo, hi}; return __builtin_bit_cast(unsigned, __builtin_convertvector(v, bf16x2_t)); }
__device__ __forceinline__ unsigned f2bf(float f) { return pk2(f, f) & 0xffffu; }
__device__ __forceinline__ float bf2f(unsigned short h) { return __builtin_bit_cast(float, (unsigned)h << 16); }
__device__ __forceinline__ float bflo(unsigned w) { return __builtin_bit_cast(float, w << 16); }
__device__ __forceinline__ float bfhi(unsigned w) { return __builtin_bit_cast(float, w & 0xffff0000u); }
template <int CTRL> __device__ __forceinline__ float dpp_f(float v) { return __builtin_bit_cast(float, __builtin_amdgcn_update_dpp(0, __builtin_bit_cast(int, v), CTRL, 0xF, 0xF, true)); }
__device__ __forceinline__ float sum8(float v) {
    v += dpp_f<0xB1>(v); v += dpp_f<0x4E>(v); v += dpp_f<0x141>(v); return v; }
__device__ __forceinline__ float wave_sum(float v) {
    v = sum8(v); v += dpp_f<0x140>(v);
    v += __builtin_bit_cast(float, __builtin_amdgcn_ds_swizzle(__builtin_bit_cast(int, v), 0x401F));
    { const int u = __builtin_bit_cast(int, v); v = __builtin_bit_cast(float, __builtin_amdgcn_readlane(u, 0)) + __builtin_bit_cast(float, __builtin_amdgcn_readlane(u, 32)); }
    return v;
}
__device__ __forceinline__ float sigmoid_f(float x) { return __builtin_amdgcn_rcpf(1.0f + __builtin_amdgcn_exp2f(-LOG2E * x)); }
__device__ __forceinline__ float silu_g(float x) { return x * sigmoid_f(x); }

#define XB_TMO      128
#define XB_XCNT(j)  (256  + 64 * (j))
#define XB_XSUB(j)  (1280 + 64 * (j))
#define XB_XGEN(j)  (2304 + 64 * (j))
#define XB_TOP      3328
#define XB_TOPGEN   3392
#define XCD_BAR_WORDS 3456
#define XB_SPIN_CAP (1u << 23)

__device__ __forceinline__ unsigned xb_ld(unsigned* p)              { return __hip_atomic_load(p, __ATOMIC_RELAXED, __HIP_MEMORY_SCOPE_AGENT); }
__device__ __forceinline__ unsigned xb_add(unsigned* p, unsigned v) { return __hip_atomic_fetch_add(p, v, __ATOMIC_RELAXED, __HIP_MEMORY_SCOPE_AGENT); }
__device__ __forceinline__ unsigned xb_xcc_id() { return (unsigned)__builtin_amdgcn_s_getreg((3 << 11) | 20) & 0xFu; }
#define XB_SPIN(cond, bar) do { unsigned _sp = 0; while (cond) { __builtin_amdgcn_s_sleep(1); \
    if ((++_sp & 255u) == 0u) { if (xb_ld(&(bar)[XB_TMO])) break; if (_sp > XB_SPIN_CAP) { atomicAdd(&(bar)[XB_TMO], 1u); break; } } } } while (0)

struct XcdBarrier {
    unsigned* bar; unsigned x;
    volatile LAS unsigned* st;
};

__device__ __forceinline__ XcdBarrier xcd_barrier_post(unsigned* bar, volatile LAS unsigned* st) {
    XcdBarrier b; b.bar = bar; b.x = xb_xcc_id(); b.st = st;
    if (threadIdx.x == 0) (void)xb_add(&bar[XB_XCNT(b.x)], 1u);
    return b;
}
__device__ __forceinline__ void xcd_barrier_complete(unsigned* bar, unsigned x, unsigned& nloc, unsigned& nx) {
    const unsigned G = gridDim.x * gridDim.y * gridDim.z;
    unsigned sum, cnt, mine, sp = 0u;
    for (;;) {
        sum = 0u; cnt = 0u; mine = 0u;
#pragma unroll
        for (unsigned j = 0; j < 16; ++j) { const unsigned c = xb_ld(&bar[XB_XCNT(j)]); sum += c; cnt += (c > 0u) ? 1u : 0u; mine = (j == x) ? c : mine; }
        if (sum == G) break;
        __builtin_amdgcn_s_sleep(1);
        if ((++sp & 255u) == 0u) { if (xb_ld(&bar[XB_TMO])) break; if (sp > XB_SPIN_CAP) { atomicAdd(&bar[XB_TMO], 1u); break; } }
    }
    nloc = mine > 0u ? mine : 1u; nx = cnt > 0u ? cnt : 1u;
}

__device__ __forceinline__ void xcd_barrier(const XcdBarrier& b) {
    asm volatile("s_waitcnt vmcnt(0)" ::: "memory");
    __syncthreads();
    if (threadIdx.x == 0) {
        unsigned* bar = b.bar;
        __builtin_amdgcn_s_waitcnt(0);
        unsigned nloc = b.st[0], nx = b.st[1];
        if (nloc == 0u) { xcd_barrier_complete(bar, b.x, nloc, nx); b.st[0] = nloc; b.st[1] = nx; }
        const unsigned old = xb_add(&bar[XB_XSUB(b.x)], 1u);
        const unsigned gen = old / nloc;
        if (old + 1u == (gen + 1u) * nloc) {
            __builtin_amdgcn_fence(__ATOMIC_RELEASE, "agent");
            asm volatile("s_waitcnt vmcnt(0)" ::: "memory");
            const unsigned og = xb_add(&bar[XB_TOP], 1u);
            const unsigned tg = og / nx;
            if (og + 1u == (tg + 1u) * nx) xb_add(&bar[XB_TOPGEN], 1u);
            else XB_SPIN(xb_ld(&bar[XB_TOPGEN]) == tg, bar);
            __builtin_amdgcn_fence(__ATOMIC_ACQUIRE, "agent");
            xb_add(&bar[XB_XGEN(b.x)], 1u);
            asm volatile("s_waitcnt vmcnt(0)" ::: "memory");
        } else {
            XB_SPIN(xb_ld(&bar[XB_XGEN(b.x)]) == gen, bar);
            __builtin_amdgcn_fence(__ATOMIC_ACQUIRE, "agent");
            asm volatile("s_waitcnt vmcnt(0)" ::: "memory");
        }
    }
    __syncthreads();
}

typedef const float* const __attribute__((address_space(4)))* kargp;
struct Frame {
    LAS unsigned char* lds;
    volatile LAS unsigned* MISC;
    gu32* ctl;
    int tid, lane, wave;
    int vcu, G, bx;
    kargp kin;
    float* out;
    unsigned char* ws;
};
enum { I_X = 0, I_C, I_RELB, I_ADAW, I_ADAB, I_WIN, I_WOUT, I_DQN, I_DKN, I_DLAM, I_DSUB, I_GGU, I_GGB, I_GON, I_RMU, I_RWUP, I_RW0, I_RAUP, I_RA0, I_RGUP,
       I_RKK, I_RKA, I_RRK, I_RLNW, I_RLNB, I_VRD, I_VRMU, I_VRUP, I_VR0, I_SQN, I_SKN, I_SSINK, I_W1, I_W3, I_W2 };

#define WSP(T, off) ((T*)(F.ws + (off)))
__device__ __forceinline__ void relaunder_tid(Frame& F) { int t = F.tid; asm volatile("" : "+v"(t)); F.tid = t; F.lane = t & 63; F.wave = __builtin_amdgcn_readfirstlane(t >> 6); }
__device__ __forceinline__ void relaunder(Frame& F) { kargp p = F.kin; asm volatile("" : "+s"(p)); F.kin = p; }

__device__ __forceinline__ void conv_item(const float* src, int ld, int col0, int ncols, int K, bf16* WT, int row0, int kb, LAS float* scr, int lane) {
    const int k0 = 64 * kb;
    { const int n = lane & 31; const bool ok = src != nullptr && n < ncols; const float* sp = src + (size_t)(k0 + (lane >> 5)) * ld + col0 + n; float v[32];
#pragma unroll
      for (int i = 0; i < 32; ++i) v[i] = ok ? sp[(size_t)(2 * i) * ld] : 0.f;
#pragma unroll
      for (int i = 0; i < 32; ++i) scr[(2 * i + (lane >> 5)) * 33 + n] = v[i]; }
    LDS_WAIT(); asm volatile("" ::: "memory");
    const int c = lane & 7;
#pragma unroll
    for (int j = 0; j < 4; ++j) { const int n = (lane >> 3) + 8 * j; const LAS float* s = scr + (8 * c) * 33 + n;
        v4u o; o.x = pk2(s[0 * 33], s[1 * 33]); o.y = pk2(s[2 * 33], s[3 * 33]); o.z = pk2(s[4 * 33], s[5 * 33]); o.w = pk2(s[6 * 33], s[7 * 33]);
        if (n < ncols) *(GAS v4u*)(WT + (size_t)(row0 + n) * K + k0 + 8 * c) = o; }
    LDS_WAIT(); asm volatile("" ::: "memory");
}
__device__ __forceinline__ int t5_bucket(int d) {
    if (d < 16) return d;
    int v = 16 + (int)(logf((float)d * (1.0f / 16.0f)) / logf(8.0f) * 16.0f);
    return v < 31 ? v : 31;
}
__device__ __forceinline__ void p0_prologue_a(Frame& F) {
    const int gw = F.vcu * NWAVES + F.wave, NGW = F.G * NWAVES;
    LAS float* ldsf = (LAS float*)(F.lds + RING_OFF);
    for (int i = F.tid; i < 2 * DM; i += NWAVES * 64) ldsf[i] = silu_g(F.kin[I_C][i]);
    __syncthreads();
    float* MODP = WSP(float, WS_MODP);
    for (int it = gw; it < 6144; it += NGW) {
        const int l = it / 3072, rem = it % 3072, kc = rem / 96, ng = rem % 96, n0 = 256 * ng + 4 * F.lane;
        const float* w = F.kin[I_ADAW] + ((size_t)l * DM + kc * 128) * 24576 + n0;
        f32x4 a0 = {0.f, 0.f, 0.f, 0.f}, a1 = {0.f, 0.f, 0.f, 0.f};
#pragma unroll 16
        for (int k = 0; k < 128; ++k) { const f32x4 wv = *(const f32x4*)(w + (size_t)k * 24576); const float s0 = ldsf[kc * 128 + k], s1 = ldsf[DM + kc * 128 + k]; a0 += wv * s0; a1 += wv * s1; }
        *(f32x4*)(MODP + ((size_t)(l * 32 + kc) * 2 + 0) * 24576 + n0) = a0;
        *(f32x4*)(MODP + ((size_t)(l * 32 + kc) * 2 + 1) * 24576 + n0) = a1;
    }
    __syncthreads();
    LAS float* scr = (LAS float*)(F.lds + RING_OFF + F.wave * 16384);
    constexpr int I_IN = 337 * 64, I_OUT = 128 * 64, I_13 = 688 * 64, I_2 = 128 * 172, I_L = I_IN + I_OUT + I_13 + I_2;
    for (int it = gw; it < NLAYER * I_L; it += NGW) {
        const int l = it / I_L; int r = it % I_L;
        if (r < I_IN) {
            const int kb = r / 337, cb = r % 337; const float* src = F.kin[I_WIN] + (size_t)l * DM * P_IN; int ld = P_IN, col0, row0, nc = 32;
            if (cb < 192) { col0 = 32 * cb; row0 = 32 * cb; }
            else if (cb < 288) { col0 = 6160 + 32 * (cb - 192); row0 = 6144 + 32 * (cb - 192); }
            else if (cb < 328) { col0 = 9424 + 32 * (cb - 288); row0 = 9216 + 32 * (cb - 288); }
            else if (cb == 328) { col0 = 6144; row0 = 10496; nc = 16; }
            else if (cb < 335) { col0 = 9232 + 32 * (cb - 329); row0 = 10512 + 32 * (cb - 329); }
            else if (cb == 335) { src = l ? F.kin[I_VRD] + (size_t)(l - 1) * DM * 32 : nullptr; ld = 32; col0 = 0; row0 = 10704; }
            else { src = nullptr; col0 = 0; row0 = 10736; nc = 16; }
            conv_item(src, ld, col0, nc, DM, WSP(bf16, WS_WIN + l * WIN_L), row0, kb, scr, F.lane); continue; }
        r -= I_IN;
        if (r < I_OUT) { const int kb = r / 128, cb = r % 128; conv_item(F.kin[I_WOUT] + (size_t)l * DM * DM, DM, 32 * cb, 32, DM, WSP(bf16, WS_WOUT + l * WOUT_L), 32 * cb, kb, scr, F.lane); continue; }
        r -= I_OUT;
        if (r < I_13) { const int kb = r / 688, cb = r % 688, pn = cb >> 3, wi = cb & 7;
            const float* src = (wi < 4 ? F.kin[I_W1] : F.kin[I_W3]) + (size_t)l * DM * DFF;
            conv_item(src, DFF, 128 * pn + 32 * (wi & 3), 32, DM, WSP(bf16, WS_W13 + l * W13_L), 32 * cb, kb, scr, F.lane); continue; }
        r -= I_13;
        { const int kb = r / 128, cb = r % 128; conv_item(F.kin[I_W2] + (size_t)l * DFF * DM, DM, 32 * cb, 32, DFF, WSP(bf16, WS_W2 + l * W2_L), 32 * cb, kb, scr, F.lane); }
    }
}
__device__ __forceinline__ void p0_prologue_b(Frame& F) {
    const int gt = F.bx * (NWAVES * 64) + F.tid, NT = F.G * NWAVES * 64;
    const float* MODP = WSP(float, WS_MODP); float* MOD = WSP(float, WS_MOD);
    for (int idx = gt; idx < NLAYER * 2 * 24576; idx += NT) {
        const int l = idx / 49152, rem = idx % 49152, b = rem / 24576, n = rem % 24576;
        float s = F.kin[I_ADAB][l * 24576 + n];
#pragma unroll 8
        for (int kc = 0; kc < 32; ++kc) s += MODP[((size_t)(l * 32 + kc) * 2 + b) * 24576 + n];
        MOD[idx] = s;
    }
    if (F.bx == 0) { float* TAB = WSP(float, WS_TAB);
        for (int i = F.tid; i < 24 * 128; i += NWAVES * 64) { const int hh = i >> 7, d = i & 127; TAB[i] = F.kin[I_RELB][t5_bucket(d) * 24 + hh] * LOG2E; } }
}
__device__ __forceinline__ void rms_phase(Frame& F, const float* xin, const float* sh, const float* sc) {
    const int gw = F.vcu * NWAVES + F.wave, NGW = F.G * NWAVES;
    bf16* XN = WSP(bf16, WS_XN);
    for (int m = gw; m < M; m += NGW) {
        const int b = m >> 13;
        const f32x4* xr = (const f32x4*)(xin + (size_t)m * DM) + F.lane;
        f32x4 v[16]; float ss = 0.f;
#pragma unroll
        for (int j = 0; j < 16; ++j) { v[j] = xr[64 * j]; ss += (v[j].x * v[j].x + v[j].y * v[j].y) + (v[j].z * v[j].z + v[j].w * v[j].w); }
        const float rstd = rsqrtf(wave_sum(ss) * (1.0f / DM) + 1e-6f);
        const f32x4* scp = (const f32x4*)(sc + (size_t)b * 24576) + F.lane; const f32x4* shp = (const f32x4*)(sh + (size_t)b * 24576) + F.lane;
        v2u* o8 = (v2u*)(XN + (size_t)m * DM) + F.lane;
#pragma unroll
        for (int j = 0; j < 16; ++j) { const f32x4 s4 = scp[64 * j], h4 = shp[64 * j]; const f32x4 o = v[j] * rstd * (s4 + 1.0f) + h4;
            v2u w; w.x = pk2(o.x, o.y); w.y = pk2(o.z, o.w); o8[64 * j] = w; }
    }
}
__device__ __forceinline__ void unpack8(const v4u r, float (&f)[8]) { f[0] = bflo(r.x); f[1] = bfhi(r.x); f[2] = bflo(r.y); f[3] = bfhi(r.y); f[4] = bflo(r.z); f[5] = bfhi(r.z); f[6] = bflo(r.w); f[7] = bfhi(r.w); }
__device__ __forceinline__ v4u pack8(const float (&f)[8]) { v4u o; o.x = pk2(f[0], f[1]); o.y = pk2(f[2], f[3]); o.z = pk2(f[4], f[5]); o.w = pk2(f[6], f[7]); return o; }
__device__ __forceinline__ void prep_norm(Frame& F, int l) {
    const int gw = F.vcu * NWAVES + F.wave, NGW = F.G * NWAVES, lane = F.lane, sub = lane >> 3, ch = lane & 7;
    float gqa[8], gka[8], gqd[8], gkd[8];
#pragma unroll
    for (int e = 0; e < 8; ++e) { gqa[e] = F.kin[I_DQN][l * 64 + ch * 8 + e] * QSCALE; gka[e] = F.kin[I_DKN][l * 64 + ch * 8 + e];
                                  gqd[e] = F.kin[I_SQN][l * 64 + ch * 8 + e] * QSCALE; gkd[e] = F.kin[I_SKN][l * 64 + ch * 8 + e]; }
    const bf16* COLS = WSP(bf16, WS_COLS); bf16* QKA = WSP(bf16, WS_QKA); bf16* QKD = WSP(bf16, WS_QKD);
    for (int m = gw; m < M; m += NGW) {
        const bf16* src = COLS + (size_t)m * NMAIN;
#pragma unroll
        for (int i = 0; i < 4; ++i) { const int vec = i * 8 + sub, col = vec * 64 + ch * 8;
            float f[8]; unpack8(*(const v4u*)(src + CA_Q + col), f); float ss = 0.f;
#pragma unroll
            for (int e = 0; e < 8; ++e) ss += f[e] * f[e];
            ss = sum8(ss);
            const float rstd = rsqrtf(ss * (1.0f / 64.0f) + 1e-6f);
#pragma unroll
            for (int e = 0; e < 8; ++e) f[e] = f[e] * rstd * (i < 2 ? gqa[e] : gka[e]);
            *(v4u*)(QKA + (size_t)m * 2048 + col) = pack8(f); }
#pragma unroll
        for (int i = 0; i < 3; ++i) { const int vec = i * 8 + sub, col = vec * 64 + ch * 8;
            if (vec < 18) { float f[8]; unpack8(*(const v4u*)(src + CD_Q + col), f); float ss = 0.f;
#pragma unroll
                for (int e = 0; e < 8; ++e) ss += f[e] * f[e];
                ss = sum8(ss);
                const float rstd = rsqrtf(ss * (1.0f / 64.0f) + 1e-6f);
#pragma unroll
                for (int e = 0; e < 8; ++e) f[e] = f[e] * rstd * (vec < 16 ? gqd[e] : gkd[e]);
                *(v4u*)(QKD + (size_t)m * 1152 + col) = pack8(f); } }
    }
}
__device__ __forceinline__ void prep_loga(Frame& F, int l) {
    LAS float* gdl = (LAS float*)(F.lds + RING_OFF);
    float gu[16];
#pragma unroll
    for (int j = 0; j < 16; ++j) gu[j] = F.kin[I_GGU][((size_t)l * 16 + j) * 512 + F.tid];
    const float bias = F.kin[I_GGB][l * 512 + F.tid];
    const float* LOWR = WSP(float, WS_LOWR); float* LOGA = WSP(float, WS_LOGA);
    for (int tile = F.bx; tile < M / 64; tile += F.G) {
        const size_t row0 = (size_t)tile * 64;
        __syncthreads();
#pragma unroll
        for (int i = 0; i < 2; ++i) { const int idx = F.tid + 512 * i; gdl[idx] = LOWR[(row0 + (idx >> 4)) * 256 + (idx & 15)]; }
        __syncthreads();
#pragma unroll 4
        for (int t = 0; t < 64; ++t) { const LAS f32x4* gp = (const LAS f32x4*)(gdl + t * 16); const f32x4 g0 = gp[0], g1 = gp[1], g2 = gp[2], g3 = gp[3];
            float z = bias + g0.x * gu[0] + g0.y * gu[1] + g0.z * gu[2] + g0.w * gu[3] + g1.x * gu[4] + g1.y * gu[5] + g1.z * gu[6] + g1.w * gu[7]
                    + g2.x * gu[8] + g2.y * gu[9] + g2.z * gu[10] + g2.w * gu[11] + g3.x * gu[12] + g3.y * gu[13] + g3.z * gu[14] + g3.w * gu[15];
            LOGA[(row0 + t) * 512 + F.tid] = (fminf(z, 0.f) - __logf(1.0f + __expf(-fabsf(z)))) * (1.0f / 16.0f); }
    }
}
__device__ __forceinline__ int next_item(Frame& F, gu32* ctr) {
    volatile LAS int* slot = (volatile LAS int*)(F.lds + LDSCTL_OFF + 64);
    __syncthreads();
    if (F.tid == 0) *slot = (int)__hip_atomic_fetch_add(ctr, 1u, RLX_AGENT);
    __syncthreads();
    return *slot;
}
typedef float f32x16 __attribute__((ext_vector_type(16)));
__device__ __forceinline__ float xother32(float v) { unsigned a = __builtin_bit_cast(unsigned, v), b = a; asm volatile("" : "+v"(b)); auto rr = __builtin_amdgcn_permlane32_swap(a, b, false, false);
    const unsigned lo = rr[0], hi = rr[1]; return __builtin_bit_cast(float, (unsigned)((__builtin_amdgcn_mbcnt_hi(~0u, __builtin_amdgcn_mbcnt_lo(~0u, 0u)) & 32u) ? lo : hi)); }
__device__ __forceinline__ float xsum32(float v) { return v + xother32(v); }
__device__ __forceinline__ float xmax32(float v) { return fmaxf(v, xother32(v)); }
__device__ __forceinline__ int crow16(int r, int hi) { return (r & 3) + 8 * (r >> 2) + 4 * hi; }
template <bool ISA>
__device__ __forceinline__ void attn_unit(Frame& F, int l, int b, int hx, int qb) {
    constexpr int DV = ISA ? 128 : 64, NDV = DV / 32, KSTR = ISA ? 272 : 144, VSTR = 144, KBYTES = 64 * KSTR, VBYTES = DV * VSTR, BUFB = KBYTES + VBYTES, NCH = ISA ? 2 : 1;
    constexpr float NEG = -1e30f;
    LAS unsigned char* L = F.lds + RING_OFF;
    const int tid = F.tid, lane = F.lane, r32 = lane & 31, hi = lane >> 5, qs = F.wave & 3, grp = F.wave >> 2, q0 = qb * 128;
    const int kvh = hx >> 2, hd = kvh * 8 + (hx & 3) * 2 + grp;
    const bf16* Qp; const bf16* Kp; const bf16* VT; int ldq;
    if (ISA) { const bf16* QKA = WSP(bf16, WS_QKA); Qp = QKA + (size_t)b * SEQ * 2048 + hx * 128 + grp * 64; Kp = QKA + (size_t)b * SEQ * 2048 + 1024 + hx * 128; ldq = 2048; VT = WSP(bf16, WS_VTA) + (size_t)(b * 8 + hx) * 128 * VROW; }
    else { const bf16* QKD = WSP(bf16, WS_QKD); Qp = QKD + (size_t)b * SEQ * 1152 + hd * 64; Kp = QKD + (size_t)b * SEQ * 1152 + 1024 + kvh * 64; ldq = 1152; VT = WSP(bf16, WS_VTD) + (size_t)(b * 2 + kvh) * 64 * VROW; }
    const int qpos = q0 + 32 * qs + r32;
    bf16x8 qr[4];
#pragma unroll
    for (int d0 = 0; d0 < 4; ++d0) qr[d0] = *(const bf16x8*)(Qp + (size_t)qpos * ldq + d0 * 16 + hi * 8);
    LAS float* Bt = (LAS float*)(L + 2 * BUFB);
    { const float* TAB = WSP(float, WS_TAB);
      if (ISA) { if (tid < 130) Bt[tid] = tid == 0 ? NEG : (tid == 129 ? 0.f : TAB[hx * 128 + tid - 1] - TAB[hx * 128 + 127]); }
      else { if (tid < 260) { const int gi = tid >= 130, t = tid - 130 * gi; Bt[tid] = (t == 0 || t == 129) ? NEG : TAB[(8 + kvh * 8 + (hx & 3) * 2 + gi) * 128 + t - 1]; } } }
    const int TQ = q0 >> 6, T0 = ISA ? 0 : (TQ >= 2 ? TQ - 2 : 0), T1 = TQ + 1;
    v4u kreg[NCH], vreg[NCH];
#define AT_GLOAD(T) do { _Pragma("unroll") for (int i_ = 0; i_ < NCH; ++i_) { const int c_ = tid + 512 * i_; \
        const int kr_ = ISA ? (c_ >> 4) : (c_ >> 3), kc_ = ISA ? (c_ & 15) : (c_ & 7); kreg[i_] = *(const v4u*)(Kp + (size_t)((T) * 64 + kr_) * ldq + kc_ * 8); \
        const int vr_ = c_ >> 3, vc_ = c_ & 7; vreg[i_] = *(const v4u*)(VT + (size_t)vr_ * VROW + (T) * 64 + vc_ * 8); } } while (0)
#define AT_LWRITE(buf) do { _Pragma("unroll") for (int i_ = 0; i_ < NCH; ++i_) { const int c_ = tid + 512 * i_; \
        const int kr_ = ISA ? (c_ >> 4) : (c_ >> 3), kc_ = ISA ? (c_ & 15) : (c_ & 7); *(LAS v4u*)(L + (buf) * BUFB + kr_ * KSTR + kc_ * 16) = kreg[i_]; \
        const int vr_ = c_ >> 3, vc_ = c_ & 7; *(LAS v4u*)(L + (buf) * BUFB + KBYTES + vr_ * VSTR + vc_ * 16) = vreg[i_]; } } while (0)
    f32x16 o[NDV];
#pragma unroll
    for (int i = 0; i < NDV; ++i) o[i] = (f32x16){0.f, 0.f, 0.f, 0.f, 0.f, 0.f, 0.f, 0.f, 0.f, 0.f, 0.f, 0.f, 0.f, 0.f, 0.f, 0.f};
    float m_run = ISA ? NEG : F.kin[I_SSINK][l * 16 + hd] * LOG2E, l_run = ISA ? 0.f : (hi == 0 ? 1.f : 0.f);
    const int krow = (r32 & 16) | (r32 & 3) | ((r32 & 4) << 1) | ((r32 & 8) >> 1);
    const int koff = krow * KSTR + (ISA ? grp * 128 : 0) + hi * 16, voff = KBYTES + r32 * VSTR + hi * 16;
    AT_GLOAD(T0); AT_LWRITE(0); __syncthreads();
#pragma unroll 1
    for (int T = T0; T <= T1; ++T) {
        const int cur = (T - T0) & 1;
        AT_GLOAD(T < T1 ? T + 1 : T1);
        LAS const unsigned char* Kb = L + cur * BUFB;
        f32x16 s[2];
#pragma unroll
        for (int blk = 0; blk < 2; ++blk) { s[blk] = (f32x16){0.f, 0.f, 0.f, 0.f, 0.f, 0.f, 0.f, 0.f, 0.f, 0.f, 0.f, 0.f, 0.f, 0.f, 0.f, 0.f};
#pragma unroll
            for (int d0 = 0; d0 < 4; ++d0) { const bf16x8 kf = *(const LAS bf16x8*)(Kb + koff + blk * 32 * KSTR + d0 * 32); s[blk] = __builtin_amdgcn_mfma_f32_32x32x16_bf16(kf, qr[d0], s[blk], 0, 0, 0); } }
        if (!ISA || T >= TQ - 2) {
            const LAS float* bt = Bt + (ISA ? 0 : grp * 130) + 1; const int d0 = qpos - T * 64 - 8 * hi;
#pragma unroll
            for (int blk = 0; blk < 2; ++blk)
#pragma unroll
                for (int r = 0; r < 16; ++r) { const int dist = d0 - (32 * blk + 16 * (r >> 3) + (r & 7)); const int di = dist < -1 ? -1 : (dist > 128 ? 128 : dist); s[blk][r] += bt[di]; } }
        float mt = s[0][0];
#pragma unroll
        for (int r = 1; r < 16; ++r) mt = fmaxf(mt, s[0][r]);
#pragma unroll
        for (int r = 0; r < 16; ++r) mt = fmaxf(mt, s[1][r]);
        mt = xmax32(mt);
        const float m_new = fmaxf(m_run, mt);
        if (__any(m_new > m_run)) { const float alpha = __builtin_amdgcn_exp2f(m_run - m_new); l_run *= alpha;
#pragma unroll
            for (int i = 0; i < NDV; ++i)
#pragma unroll
                for (int r = 0; r < 16; ++r) o[i][r] *= alpha;
            m_run = m_new; }
        float ls = 0.f;
#pragma unroll
        for (int blk = 0; blk < 2; ++blk)
#pragma unroll
            for (int r = 0; r < 16; ++r) { const float pv_ = __builtin_amdgcn_exp2f(s[blk][r] - m_run); s[blk][r] = pv_; ls += pv_; }
        l_run += ls;
#pragma unroll
        for (int sl = 0; sl < 4; ++sl) { const int blk = sl >> 1, r0 = 8 * (sl & 1);
            v4u pw; pw.x = pg8::cvt_pk_bf16(s[blk][r0], s[blk][r0 + 1]); pw.y = pg8::cvt_pk_bf16(s[blk][r0 + 2], s[blk][r0 + 3]); pw.z = pg8::cvt_pk_bf16(s[blk][r0 + 4], s[blk][r0 + 5]); pw.w = pg8::cvt_pk_bf16(s[blk][r0 + 6], s[blk][r0 + 7]);
            const bf16x8 pf = __builtin_bit_cast(bf16x8, pw);
#pragma unroll
            for (int i = 0; i < NDV; ++i) { const bf16x8 vf = *(const LAS bf16x8*)(Kb + voff + i * 32 * VSTR + sl * 32); o[i] = __builtin_amdgcn_mfma_f32_32x32x16_bf16(vf, pf, o[i], 0, 0, 0); } }
        AT_LWRITE(cur ^ 1);
        __syncthreads();
    }
#undef AT_GLOAD
#undef AT_LWRITE
    const float inv = 1.0f / xsum32(l_run);
    bf16* MIX = WSP(bf16, WS_MIXED);
    if (ISA) {
        int ll_ = l; asm volatile("" : "+s"(ll_)); const float lam_init = ll_ == 0 ? 0.2f : 0.35550906759f;     float lam_full;
        { const float* lm = F.kin[I_DLAM] + (size_t)l * 256; const float s1 = wave_sum(lm[lane] * lm[64 + lane]), s2 = wave_sum(lm[128 + lane] * lm[192 + lane]); lam_full = __expf(s1) - __expf(s2) + lam_init; }
        LAS float* R1 = (LAS float*)L;
        LAS bf16* R2 = (LAS bf16*)(L + 66048);
        const int ql = 32 * qs + r32;
        if (grp == 1) {
#pragma unroll
            for (int i = 0; i < NDV; ++i)
#pragma unroll
                for (int r = 0; r < 16; ++r) R1[ql * 129 + 32 * i + crow16(r, hi)] = lam_full * inv * o[i][r]; }
        __syncthreads();
        if (grp == 0) { float ss = 0.f;
#pragma unroll
            for (int i = 0; i < NDV; ++i)
#pragma unroll
                for (int r = 0; r < 16; ++r) { const float d = o[i][r] * inv - R1[ql * 129 + 32 * i + crow16(r, hi)]; o[i][r] = d; ss += d * d; }
            const float rstd = rsqrtf(xsum32(ss) * (1.0f / 128.0f) + 1e-6f) * (1.0f - lam_init);
            const float* sl = F.kin[I_DSUB] + l * 128;
#pragma unroll
            for (int i = 0; i < NDV; ++i)
#pragma unroll
                for (int r = 0; r < 16; ++r) { const int dv = 32 * i + crow16(r, hi); R2[ql * 132 + dv] = (bf16)f2bf(o[i][r] * rstd * sl[dv]); } }
        __syncthreads();
#pragma unroll
        for (int i = 0; i < 4; ++i) { const int c = tid + 512 * i, row = c >> 4, ch = c & 15; const LAS v2u* sp = (const LAS v2u*)(R2 + row * 132 + ch * 8); const v2u a = sp[0], bb = sp[1];
            *(v4u*)(MIX + (size_t)(b * SEQ + q0 + row) * DM + hx * 128 + ch * 8) = (v4u){a.x, a.y, bb.x, bb.y}; }
    } else {
        LAS bf16* R = (LAS bf16*)L + F.wave * 2176;
#pragma unroll
        for (int i = 0; i < NDV; ++i)
#pragma unroll
            for (int r = 0; r < 16; ++r) R[r32 * 68 + 32 * i + crow16(r, hi)] = (bf16)f2bf(o[i][r] * inv);
#pragma unroll
        for (int i = 0; i < 4; ++i) { const int c = lane + 64 * i, row = c >> 3, ch = c & 7; const LAS v2u* sp = (const LAS v2u*)(R + row * 68 + ch * 8); const v2u a = sp[0], bb = sp[1];
            *(v4u*)(MIX + (size_t)(b * SEQ + q0 + 32 * qs + row) * DM + 3072 + hd * 64 + ch * 8) = (v4u){a.x, a.y, bb.x, bb.y}; }
    }
}
__device__ __forceinline__ void prep_gla(Frame& F) {
    LAS float* Lb = (LAS float*)(F.lds + RING_OFF); LAS float* Qd = Lb + 64 * 129; LAS float* Ki = Qd + 64 * 129; LAS bf16* Kt = (LAS bf16*)(Ki + 64 * 129);
    const bf16* COLS = WSP(bf16, WS_COLS); const float* LOGA = WSP(float, WS_LOGA);
    bf16* QDEC = WSP(bf16, WS_QDEC); bf16* KDT = WSP(bf16, WS_KDT); bf16* AMg = WSP(bf16, WS_AM); float* EBL = WSP(float, WS_EBL);
    for (int u = F.bx; u < 1024; u += F.G) {
        const int b = u >> 9, h = (u >> 7) & 3, ck = u & 127; const size_t row0 = (size_t)b * SEQ + ck * 64;
        __syncthreads();
        for (int idx = F.tid; idx < 8192; idx += NWAVES * 64) { const int t = idx >> 7, d = idx & 127; Lb[t * 129 + d] = LOGA[(row0 + t) * 512 + h * 128 + d]; }
        __syncthreads();
        if (F.tid < 128) { float acc = 0.f;
#pragma unroll 8
            for (int t = 0; t < 64; ++t) { acc += Lb[t * 129 + F.tid]; Lb[t * 129 + F.tid] = acc; }
            EBL[(size_t)u * 128 + F.tid] = __expf(acc); }
        __syncthreads();
        for (int idx = F.tid; idx < 8192; idx += NWAVES * 64) { const int t = idx >> 7, d = idx & 127; const float bt = Lb[t * 129 + d], bl = Lb[63 * 129 + d];
            const float q = bf2f(COLS[(row0 + t) * NMAIN + CB_Q + h * 128 + d]) * 0.08838834764831845f, k = bf2f(COLS[(row0 + t) * NMAIN + CB_K + h * 128 + d]);
            const float qd = q * __expf(bt); Qd[t * 129 + d] = qd; Ki[t * 129 + d] = k * __expf(-bt); Kt[d * 72 + t] = (bf16)f2bf(k * __expf(bl - bt));
            QDEC[((size_t)u * 64 + t) * 128 + d] = (bf16)f2bf(qd); }
        __syncthreads();
#pragma unroll
        for (int i = 0; i < 2; ++i) { const int c_ = F.tid + 512 * i, row = c_ >> 3, ch = c_ & 7; const LAS v2u* sp = (const LAS v2u*)(Kt + row * 72 + ch * 8); const v2u a = sp[0], bb = sp[1];
            *(v4u*)(KDT + ((size_t)u * 128 + row) * 64 + ch * 8) = (v4u){a.x, a.y, bb.x, bb.y}; }
        { const int c = F.tid >> 3, sg = F.tid & 7; float acc[8];
#pragma unroll
          for (int e = 0; e < 8; ++e) acc[e] = 0.f;
#pragma unroll 4
          for (int d = 0; d < 128; ++d) { const float q = Qd[c * 129 + d];
#pragma unroll
              for (int e = 0; e < 8; ++e) acc[e] += q * Ki[(sg * 8 + e) * 129 + d]; }
#pragma unroll
          for (int e = 0; e < 8; ++e) if (sg * 8 + e > c) acc[e] = 0.f;
          *(v4u*)(AMg + ((size_t)u * 64 + c) * 64 + sg * 8) = pack8(acc); }
    }
}
__device__ __forceinline__ void prep_vt(Frame& F, int pass) {
    LAS bf16* T = (LAS bf16*)(F.lds + RING_OFF);
    const bf16* COLS = WSP(bf16, WS_COLS);
    const int nch = pass == 0 ? 144 : 128, nvr = nch * 8;
    for (int tile = F.bx; tile < M / 32; tile += F.G) {
        const int b = tile >> 8, t0 = (tile & 255) * 32;
        __syncthreads();
        for (int idx = F.tid; idx < 32 * nch; idx += NWAVES * 64) { const int tok = idx / nch, ch = idx % nch;
            const int col = pass == 0 ? (ch < 128 ? CA_V + ch * 8 : CD_V + (ch - 128) * 8) : (pass == 1 ? CB_V + ch * 8 : CB_G + ch * 8);
            const v4u v = *(const v4u*)(COLS + (size_t)(b * SEQ + t0 + tok) * NMAIN + col); LAS v2u* d = (LAS v2u*)(T + tok * 1160 + ch * 8); d[0] = (v2u){v.x, v.y}; d[1] = (v2u){v.z, v.w}; }
        __syncthreads();
        for (int idx = F.tid; idx < nvr * 4; idx += NWAVES * 64) { const int ch = idx / nvr, vrow = idx % nvr;
            unsigned e[8];
#pragma unroll
            for (int k = 0; k < 8; ++k) e[k] = T[(ch * 8 + k) * 1160 + vrow];
            v4u o; o.x = e[0] | (e[1] << 16); o.y = e[2] | (e[3] << 16); o.z = e[4] | (e[5] << 16); o.w = e[6] | (e[7] << 16);
            bf16* dst;
            if (pass == 0) dst = vrow < 1024 ? WSP(bf16, WS_VTA) + ((size_t)(b * 8 + (vrow >> 7)) * 128 + (vrow & 127)) * VROW : WSP(bf16, WS_VTD) + ((size_t)(b * 2 + ((vrow - 1024) >> 6)) * 64 + ((vrow - 1024) & 63)) * VROW;
            else dst = WSP(bf16, WS_VTB) + ((size_t)b * 1024 + vrow) * VROW;
            *(v4u*)(dst + t0 + ch * 8) = o; }
    }
}
typedef float f32x4v __attribute__((ext_vector_type(4)));
__device__ __forceinline__ float sum16(float v) { v = sum8(v); v += dpp_f<0x140>(v); return v; }
#define LDS_BARRIER() asm volatile("s_waitcnt lgkmcnt(0)\n\ts_barrier" ::: "memory")
template <int HACK = 0> __device__ __forceinline__ void gla_scan_unit(Frame& F, int l, int b, int h) {
    LAS unsigned char* L = F.lds + RING_OFF;
    constexpr int OQD = 0, OKT = 17408, OAM = 35840, OVT = 45056, OOT = 81920, OEB = 115712, OPS = 116224;
    const int tid = F.tid, lane = F.lane, n = lane & 15, g = lane >> 4, w = F.wave;
    const bf16* QDEC = WSP(bf16, WS_QDEC); const bf16* KDT = WSP(bf16, WS_KDT); const bf16* AMg = WSP(bf16, WS_AM); const float* EBL = WSP(float, WS_EBL);
    const bf16* VTB = WSP(bf16, WS_VTB) + (size_t)(b * 4 + h) * 256 * VROW; const bf16* COLS = WSP(bf16, WS_COLS); bf16* MIX = WSP(bf16, WS_MIXED);
    f32x4v S[8][2];
#pragma unroll
    for (int dt = 0; dt < 8; ++dt)
#pragma unroll
        for (int vt = 0; vt < 2; ++vt) S[dt][vt] = (f32x4v){0.f, 0.f, 0.f, 0.f};
    float gain8[8];
#pragma unroll
    for (int e = 0; e < 8; ++e) gain8[e] = F.kin[I_GON][l * 256 + (tid & 31) * 8 + e];
    v4u pq[2], pk[2], pa, pv[4]; float pe = 0.f;
#define GL_ISSUE(CK) do { const size_t u_ = (size_t)(b * 4 + h) * 128 + (CK); \
        _Pragma("unroll") for (int i = 0; i < 2; ++i) { const int c_ = tid + 512 * i; pq[i] = *(const v4u*)(QDEC + (u_ * 64 + (c_ >> 4)) * 128 + (c_ & 15) * 8); pk[i] = *(const v4u*)(KDT + (u_ * 128 + (c_ >> 3)) * 64 + (c_ & 7) * 8); } \
        pa = *(const v4u*)(AMg + (u_ * 64 + (tid >> 3)) * 64 + (tid & 7) * 8); \
        _Pragma("unroll") for (int i = 0; i < 4; ++i) { const int c_ = tid + 512 * i; pv[i] = *(const v4u*)(VTB + (size_t)(c_ >> 3) * VROW + (CK) * 64 + (c_ & 7) * 8); } \
        pe = EBL[u_ * 128 + (tid & 127)]; } while (0)
#define GL_WRITE() do { _Pragma("unroll") for (int i = 0; i < 2; ++i) { const int c_ = tid + 512 * i; *(LAS v4u*)(L + OQD + (c_ >> 4) * 272 + (c_ & 15) * 16) = pq[i]; *(LAS v4u*)(L + OKT + (c_ >> 3) * 144 + (c_ & 7) * 16) = pk[i]; } \
        *(LAS v4u*)(L + OAM + (tid >> 3) * 144 + (tid & 7) * 16) = pa; \
        _Pragma("unroll") for (int i = 0; i < 4; ++i) { const int c_ = tid + 512 * i; *(LAS v4u*)(L + OVT + (c_ >> 3) * 144 + (c_ & 7) * 16) = pv[i]; } \
        ((LAS float*)(L + OEB))[tid & 127] = pe; } while (0)
    GL_ISSUE(0); GL_WRITE();
    LDS_BARRIER();
#pragma unroll 1
    for (int ck = 0; ck < 128; ++ck) {
        const size_t row0 = (size_t)b * SEQ + ck * 64;
        v4u gq[4];
#pragma unroll
        for (int i = 0; i < 4; ++i) gq[i] = (HACK & 1) ? (v4u){0u, 0u, 0u, 0u} : *(const v4u*)(COLS + (row0 + (tid >> 5) + 16 * i) * NMAIN + CB_G + h * 256 + (tid & 31) * 8);
        GL_ISSUE((HACK & 1) && ck >= 2 ? 2 : (ck + 1 < 128 ? ck + 1 : 127));
        bf16x8 vf[2][2];
#pragma unroll
        for (int vt = 0; vt < 2; ++vt)
#pragma unroll
            for (int ks = 0; ks < 2; ++ks) vf[vt][ks] = *(const LAS bf16x8*)(L + OVT + (32 * w + 16 * vt + n) * 144 + (32 * ks + 8 * g) * 2);
        f32x4v o[4][2];
#pragma unroll
        for (int ct = 0; ct < 4; ++ct)
#pragma unroll
            for (int vt = 0; vt < 2; ++vt) o[ct][vt] = (f32x4v){0.f, 0.f, 0.f, 0.f};
#pragma unroll
        for (int ct = 0; ct < 4; ++ct)
#pragma unroll
            for (int ks = 0; ks < 2; ++ks) { const bf16x8 af = *(const LAS bf16x8*)(L + OAM + (16 * ct + n) * 144 + (32 * ks + 8 * g) * 2);
#pragma unroll
                for (int vt = 0; vt < 2; ++vt) o[ct][vt] = __builtin_amdgcn_mfma_f32_16x16x32_bf16(af, vf[vt][ks], o[ct][vt], 0, 0, 0); }
#pragma unroll
        for (int kk = 0; kk < 4; ++kk) { bf16x8 sf[2];
#pragma unroll
            for (int vt = 0; vt < 2; ++vt) { v4u pw; pw.x = pg8::cvt_pk_bf16(S[2 * kk][vt][0], S[2 * kk][vt][1]); pw.y = pg8::cvt_pk_bf16(S[2 * kk][vt][2], S[2 * kk][vt][3]);
                pw.z = pg8::cvt_pk_bf16(S[2 * kk + 1][vt][0], S[2 * kk + 1][vt][1]); pw.w = pg8::cvt_pk_bf16(S[2 * kk + 1][vt][2], S[2 * kk + 1][vt][3]); sf[vt] = __builtin_bit_cast(bf16x8, pw); }
#pragma unroll
            for (int ct = 0; ct < 4; ++ct) { const LAS unsigned char* qp = L + OQD + (16 * ct + n) * 272 + (32 * kk + 4 * g) * 2; const v2u qa = *(const LAS v2u*)qp, qb = *(const LAS v2u*)(qp + 32);
                const bf16x8 qf = __builtin_bit_cast(bf16x8, (v4u){qa.x, qa.y, qb.x, qb.y});
#pragma unroll
                for (int vt = 0; vt < 2; ++vt) o[ct][vt] = __builtin_amdgcn_mfma_f32_16x16x32_bf16(qf, sf[vt], o[ct][vt], 0, 0, 0); } }
#pragma unroll
        for (int dt = 0; dt < 8; ++dt) { const f32x4v eb = *(const LAS f32x4v*)(L + OEB + (16 * dt + 4 * g) * 4);
#pragma unroll
            for (int vt = 0; vt < 2; ++vt) S[dt][vt] = S[dt][vt] * eb;
#pragma unroll
            for (int ks = 0; ks < 2; ++ks) { const bf16x8 kf = *(const LAS bf16x8*)(L + OKT + (16 * dt + n) * 144 + (32 * ks + 8 * g) * 2);
#pragma unroll
                for (int vt = 0; vt < 2; ++vt) S[dt][vt] = __builtin_amdgcn_mfma_f32_16x16x32_bf16(kf, vf[vt][ks], S[dt][vt], 0, 0, 0); } }
        LAS float* PS = (LAS float*)(L + OPS) + (ck & 1) * 512;
#pragma unroll
        for (int ct = 0; ct < 4; ++ct)
#pragma unroll
            for (int r = 0; r < 4; ++r) { const float ss = sum16(o[ct][0][r] * o[ct][0][r] + o[ct][1][r] * o[ct][1][r]); if (n == 0) PS[(16 * ct + 4 * g + r) * 8 + w] = ss; }
        LDS_BARRIER();
        GL_WRITE();
#pragma unroll
        for (int ct = 0; ct < 4; ++ct)
#pragma unroll
            for (int vt = 0; vt < 2; ++vt)
#pragma unroll
                for (int r = 0; r < 4; ++r) *(LAS bf16*)(L + OOT + (16 * ct + 4 * g + r) * 528 + (32 * w + 16 * vt + n) * 2) = (bf16)f2bf(o[ct][vt][r]);
        LDS_BARRIER();
#pragma unroll
        for (int i = 0; i < 4; ++i) { const int tok = (tid >> 5) + 16 * i; float ov[8], gv[8]; unpack8(*(const LAS v4u*)(L + OOT + tok * 528 + (tid & 31) * 16), ov); unpack8(gq[i], gv);
            const LAS f32x4v* pp = (const LAS f32x4v*)(PS + tok * 8); const f32x4v p0 = pp[0], p1 = pp[1];
            const float rstd = rsqrtf(((p0.x + p0.y) + (p0.z + p0.w) + (p1.x + p1.y) + (p1.z + p1.w)) * (1.0f / 256.0f) + 1e-6f);
#pragma unroll
            for (int e = 0; e < 8; ++e) ov[e] = ov[e] * (rstd * gain8[e]) * silu_g(gv[e]);
            if (!(HACK & 2)) *(v4u*)(MIX + (row0 + tok) * DM + 1024 + h * 256 + (tid & 31) * 8) = pack8(ov); }
    }
#undef GL_ISSUE
#undef GL_WRITE
}
constexpr int RC_AT = 0, RC_RT = 2048, RC_BK = 4096, RC_VF = 8192, RC_GF = 10240, RC_U0 = 12288, RC_Y0 = 16384, RC_P15 = 20480, RC_BN = 20736, RC_BYTES = 20800;
__device__ __forceinline__ void rwkv_chunks_of_tile(Frame& F, int l, int tile) {
    const int team = F.tid >> 8, tt = F.tid & 255;
    LAS float* Lt = (LAS float*)(F.lds + RING_OFF) + team * 12288;
    LAS float* XA = Lt; LAS float* XR = Lt + 1040; LAS float* ZB = Lt + 2080; LAS float* ZK = Lt + 3120; LAS float* TB = Lt + 4160; LAS float* TK = Lt + 5200; LAS float* VV = Lt + 6240;
    LAS float* ATl = Lt + 7280; LAS float* U0l = Lt + 8320; LAS float* W1 = Lt + 9360;
    LAS float* Aab = Lt + 10400; LAS float* Aak = Lt + 10672; LAS float* Arb = Lt + 10944; LAS float* Ark = Lt + 11216; LAS float* TT = Lt + 11488;
    const float* RW = WSP(float, WS_RW); constexpr size_t RS = RW_ONE / 4; unsigned char* RWC = F.ws + WS_RWC;
    float pw_[16], pr_[4], pk_[4], pv_[4], pa_[4], pb_[4], pg_[4];
#define RC_FETCH(P) do { const int h_ = 2 * (P) + team; const size_t cb_ = (size_t)tile * 16 * 1024 + h_ * 64 + (tt & 63); \
        _Pragma("unroll") for (int t = 0; t < 16; ++t) pw_[t] = RW[RS + cb_ + (size_t)t * 1024]; \
        _Pragma("unroll") for (int e = 0; e < 4; ++e) { const size_t o_ = cb_ + (size_t)(4 * (tt >> 6) + e) * 1024; pr_[e] = RW[o_]; pk_[e] = RW[2 * RS + o_]; pv_[e] = RW[3 * RS + o_]; pa_[e] = RW[4 * RS + o_]; pb_[e] = RW[5 * RS + o_]; pg_[e] = RW[6 * RS + o_]; } } while (0)
    RC_FETCH(0);
#pragma unroll 1
    for (int pair = 0; pair < 8; ++pair) {
        const int uc = ((tile >> 9) * 16 + 2 * pair + team) * 512 + (tile & 511), b = uc >> 13, h = (uc >> 9) & 15, ck = uc & 511; unsigned char* rec = RWC + ((size_t)ck * 32 + (uc >> 9)) * RC_BYTES;     (void)b;
        __syncthreads();
        {
          const int j = tt & 63, q = tt >> 6;
          float cl = 0.f, clq[4] = {0.f, 0.f, 0.f, 0.f}, clm = 0.f;
#pragma unroll
          for (int t = 0; t < 16; ++t) { const float lw = __logf(pw_[t]); if (t == 4 * q) clm = cl; cl += lw; if ((t >> 2) == q) clq[t & 3] = cl; }
#pragma unroll
          for (int e = 0; e < 4; ++e) { const int t = 4 * q + e; const float cprev = e == 0 ? clm : clq[e - 1], cc = clq[e];
              const float rr = pr_[e], kk = pk_[e], vv = pv_[e], aa = pa_[e], bb = pb_[e];
              XA[t * 65 + j] = aa * __expf(cprev); XR[t * 65 + j] = rr * __expf(cc); const float ei = __expf(-cc), ef = __expf(cl - cc);
              ZB[t * 65 + j] = bb * ei; ZK[t * 65 + j] = kk * ei; TB[t * 65 + j] = bb * ef; TK[t * 65 + j] = kk * ef; VV[t * 65 + j] = vv; }
          if (q == 0) ((float*)(rec + RC_P15))[j] = __expf(cl);
          { v2u gw; gw.x = pk2(pg_[0], pg_[1]); gw.y = pk2(pg_[2], pg_[3]); *(v2u*)(rec + RC_GF + (((j >> 4) * 64 + 16 * q + (j & 15)) * 8)) = gw; } }
        RC_FETCH(pair < 7 ? pair + 1 : 7);
        __syncthreads();
        {
          const int q = tt >> 6, n = tt & 15, g = (tt >> 4) & 3; const LAS float* X = (q & 2) ? XR : XA; const LAS float* Z = (q & 1) ? ZK : ZB; LAS float* O = q == 0 ? Aab : (q == 1 ? Aak : (q == 2 ? Arb : Ark));
          f32x4v c = (f32x4v){0.f, 0.f, 0.f, 0.f};
#pragma unroll
          for (int ks = 0; ks < 16; ++ks) c = __builtin_amdgcn_mfma_f32_16x16x4f32(X[n * 65 + 4 * ks + g], Z[n * 65 + 4 * ks + g], c, 0, 0, 0);
#pragma unroll
          for (int rr = 0; rr < 4; ++rr) { const int t = 4 * g + rr; O[t * 17 + n] = ((q & 2) ? n <= t : n < t) ? c[rr] : 0.f; }
          { const int t = tt >> 4, jq = tt & 15; const float* rkp = F.kin[I_RRK] + l * 1024 + h * 64 + 4 * jq; float bn = 0.f;
#pragma unroll
            for (int e = 0; e < 4; ++e) bn += XR[t * 65 + 4 * jq + e] * ZK[t * 65 + 4 * jq + e] * rkp[e];
            bn = sum16(bn); if (jq == 0) ((float*)(rec + RC_BN))[t] = bn; } }
        __syncthreads();
        {
          if (tt < 16) { float col[16];
#pragma unroll
              for (int t = 0; t < 16; ++t) { float acc = (t == tt) ? 1.f : 0.f;
#pragma unroll
                  for (int s = 0; s < 16; ++s) if (s < t) acc += Aab[t * 17 + s] * col[s];
                  col[t] = acc; TT[t * 17 + tt] = acc; } }
          const int q = tt >> 6, n = tt & 15, g = (tt >> 4) & 3; f32x4v c = (f32x4v){0.f, 0.f, 0.f, 0.f};
#pragma unroll
          for (int ks = 0; ks < 4; ++ks) c = __builtin_amdgcn_mfma_f32_16x16x4f32(Aak[n * 17 + 4 * ks + g], VV[(4 * ks + g) * 65 + 16 * q + n], c, 0, 0, 0);
#pragma unroll
          for (int rr = 0; rr < 4; ++rr) W1[(4 * g + rr) * 65 + 16 * q + n] = c[rr]; }
        __syncthreads();
        {
          const int q = tt >> 6, n = tt & 15, g = (tt >> 4) & 3; f32x4v ca = (f32x4v){0.f, 0.f, 0.f, 0.f}, cu = (f32x4v){0.f, 0.f, 0.f, 0.f};
#pragma unroll
          for (int ks = 0; ks < 4; ++ks) { const float tv = TT[n * 17 + 4 * ks + g]; ca = __builtin_amdgcn_mfma_f32_16x16x4f32(tv, XA[(4 * ks + g) * 65 + 16 * q + n], ca, 0, 0, 0); cu = __builtin_amdgcn_mfma_f32_16x16x4f32(tv, W1[(4 * ks + g) * 65 + 16 * q + n], cu, 0, 0, 0); }
#pragma unroll
          for (int rr = 0; rr < 4; ++rr) { ATl[(4 * g + rr) * 65 + 16 * q + n] = ca[rr]; U0l[(4 * g + rr) * 65 + 16 * q + n] = cu[rr]; }
          *(f32x4v*)(rec + RC_U0 + ((q * 64 + 16 * g + n) * 16)) = cu; }
        __syncthreads();
        {
          const int q = tt >> 6, n = tt & 15, g = (tt >> 4) & 3; f32x4v cr, cy = (f32x4v){0.f, 0.f, 0.f, 0.f};
#pragma unroll
          for (int rr = 0; rr < 4; ++rr) cr[rr] = XR[(4 * g + rr) * 65 + 16 * q + n];
#pragma unroll
          for (int ks = 0; ks < 4; ++ks) { const float arb = Arb[n * 17 + 4 * ks + g], ark = Ark[n * 17 + 4 * ks + g];
              cr = __builtin_amdgcn_mfma_f32_16x16x4f32(arb, ATl[(4 * ks + g) * 65 + 16 * q + n], cr, 0, 0, 0);
              cy = __builtin_amdgcn_mfma_f32_16x16x4f32(arb, U0l[(4 * ks + g) * 65 + 16 * q + n], cy, 0, 0, 0);
              cy = __builtin_amdgcn_mfma_f32_16x16x4f32(ark, VV[(4 * ks + g) * 65 + 16 * q + n], cy, 0, 0, 0); }
          *(f32x4v*)(rec + RC_Y0 + ((q * 64 + 16 * g + n) * 16)) = cy;
#pragma unroll
          for (int rr = 0; rr < 4; ++rr) W1[(4 * g + rr) * 65 + 16 * q + n] = cr[rr]; }
        __syncthreads();
        { const int t = tt & 15, jq = tt >> 4, kk = jq >> 3, half = (jq & 7) >> 2, g = jq & 3, j0 = 4 * jq;
          v2u wa, wr; wa.x = pk2(ATl[t * 65 + j0], ATl[t * 65 + j0 + 1]); wa.y = pk2(ATl[t * 65 + j0 + 2], ATl[t * 65 + j0 + 3]); wr.x = pk2(W1[t * 65 + j0], W1[t * 65 + j0 + 1]); wr.y = pk2(W1[t * 65 + j0 + 2], W1[t * 65 + j0 + 3]);
          *(v2u*)(rec + RC_AT + kk * 1024 + (16 * g + t) * 16 + half * 8) = wa; *(v2u*)(rec + RC_RT + kk * 1024 + (16 * g + t) * 16 + half * 8) = wr;
          const int j = tt & 63, gg = tt >> 6; v4u bk; bk.x = pk2(TB[(4 * gg) * 65 + j], TB[(4 * gg + 1) * 65 + j]); bk.y = pk2(TB[(4 * gg + 2) * 65 + j], TB[(4 * gg + 3) * 65 + j]);
          bk.z = pk2(TK[(4 * gg) * 65 + j], TK[(4 * gg + 1) * 65 + j]); bk.w = pk2(TK[(4 * gg + 2) * 65 + j], TK[(4 * gg + 3) * 65 + j]);
          *(v4u*)(rec + RC_BK + (j >> 4) * 1024 + (16 * gg + (j & 15)) * 16) = bk;
          v2u vf; vf.x = pk2(VV[(4 * gg) * 65 + j], VV[(4 * gg + 1) * 65 + j]); vf.y = pk2(VV[(4 * gg + 2) * 65 + j], VV[(4 * gg + 3) * 65 + j]);
          *(v2u*)(rec + RC_VF + ((j >> 4) * 64 + 16 * gg + (j & 15)) * 8) = vf; }
    }
}
#undef RC_FETCH
template <int HACK = 0> __device__ __forceinline__ void rwkv_scan_unit(Frame& F, int l, int b, int h) {
    LAS unsigned char* L = F.lds + RING_OFF;
    const unsigned char* recs = F.ws + WS_RWC + (size_t)(b * 16 + h) * RC_BYTES;
    const int lane = F.lane, n = lane & 15, g = lane >> 4;
    LAS float* XS = (LAS float*)(L + 2 * RC_BYTES);
    if (F.wave >= 2) {
        const int li = F.tid - 128;
        int px[4];
#pragma unroll
        for (int k = 0; k < 4; ++k) { const int x = li + 384 * k; px[k] = x < 1300 ? x : 1299; }
        v4u p0[4], p1[4], p2[4], p3[4], p4[4], p5[4], p6[4], p7[4];
#define RWL_ISSUE(P, CK) do { const int ck_ = (CK) < 512 ? ((HACK & 1) && (CK) >= 4 ? 3 : (CK)) : 511; const v4u* src_ = (const v4u*)(recs + (size_t)ck_ * 32 * RC_BYTES); \
        _Pragma("unroll") for (int k = 0; k < 4; ++k) P[k] = src_[px[k]]; } while (0)
#define RWL_WRITE(P, CK) do { LAS v4u* dst_ = (LAS v4u*)(L + ((CK) & 1) * RC_BYTES); _Pragma("unroll") for (int k = 0; k < 4; ++k) dst_[px[k]] = P[k]; } while (0)
        RWL_ISSUE(p0, 0); RWL_ISSUE(p1, 1); RWL_ISSUE(p2, 2); RWL_ISSUE(p3, 3); RWL_ISSUE(p4, 4); RWL_ISSUE(p5, 5); RWL_ISSUE(p6, 6); RWL_ISSUE(p7, 7);
        RWL_WRITE(p0, 0); RWL_ISSUE(p0, 8);
        LDS_BARRIER();
#pragma unroll 1
        for (int ck = 0; ck < 512; ck += 8) {
            RWL_WRITE(p1, ck + 1); RWL_ISSUE(p1, ck + 9); LDS_BARRIER();
            RWL_WRITE(p2, ck + 2); RWL_ISSUE(p2, ck + 10); LDS_BARRIER();
            RWL_WRITE(p3, ck + 3); RWL_ISSUE(p3, ck + 11); LDS_BARRIER();
            RWL_WRITE(p4, ck + 4); RWL_ISSUE(p4, ck + 12); LDS_BARRIER();
            RWL_WRITE(p5, ck + 5); RWL_ISSUE(p5, ck + 13); LDS_BARRIER();
            RWL_WRITE(p6, ck + 6); RWL_ISSUE(p6, ck + 14); LDS_BARRIER();
            RWL_WRITE(p7, ck + 7); RWL_ISSUE(p7, ck + 15); LDS_BARRIER();
            RWL_WRITE(p0, ck + 8); RWL_ISSUE(p0, ck + 16); LDS_BARRIER();
        }
#undef RWL_ISSUE
#undef RWL_WRITE
        return;
    }
    const int cw = F.wave;
    f32x4v S[4][2];
#pragma unroll
    for (int jt = 0; jt < 4; ++jt)
#pragma unroll
        for (int it = 0; it < 2; ++it) S[jt][it] = (f32x4v){0.f, 0.f, 0.f, 0.f};
    float lnw[2], lnb[2];
#pragma unroll
    for (int it = 0; it < 2; ++it) { lnw[it] = F.kin[I_RLNW][l * 1024 + h * 64 + 16 * (2 * cw + it) + n]; lnb[it] = F.kin[I_RLNB][l * 1024 + h * 64 + 16 * (2 * cw + it) + n]; }
    bf16* MIX = WSP(bf16, WS_MIXED) + ((size_t)b * SEQ) * DM + 2048 + h * 64 + 32 * cw + n;
    f32x4v Yp[2] = {(f32x4v){0.f, 0.f, 0.f, 0.f}, (f32x4v){0.f, 0.f, 0.f, 0.f}}, bnp = (f32x4v){0.f, 0.f, 0.f, 0.f}; v2u gfp[2] = {(v2u){0u, 0u}, (v2u){0u, 0u}}, vfp[2] = {(v2u){0u, 0u}, (v2u){0u, 0u}};
    LDS_BARRIER();
#pragma unroll 1
    for (int ck = 0; ck <= 512; ++ck) {
        if (ck > 0) {
            const LAS float* xs = XS + ((ck - 1) & 1) * 64; const f32x4v a0 = *(const LAS f32x4v*)(xs + 8 * g), a1 = *(const LAS f32x4v*)(xs + 8 * g + 4), b0 = *(const LAS f32x4v*)(xs + 32 + 8 * g), b1 = *(const LAS f32x4v*)(xs + 32 + 8 * g + 4);
            const float s1[4] = {a0[0] + b0[0], a0[2] + b0[2], a1[0] + b1[0], a1[2] + b1[2]}, s2[4] = {a0[1] + b0[1], a0[3] + b0[3], a1[1] + b1[1], a1[3] + b1[3]};
#pragma unroll
            for (int it = 0; it < 2; ++it) { const float gt[4] = {bflo(gfp[it].x), bfhi(gfp[it].x), bflo(gfp[it].y), bfhi(gfp[it].y)}, vt[4] = {bflo(vfp[it].x), bfhi(vfp[it].x), bflo(vfp[it].y), bfhi(vfp[it].y)};
#pragma unroll
                for (int r = 0; r < 4; ++r) { const float mean = s1[r] * (1.0f / 64.0f), var = fmaxf(s2[r] * (1.0f / 64.0f) - mean * mean, 0.f), rstd = rsqrtf(var + 64e-5f);
                    if (!(HACK & 2)) MIX[(size_t)((ck - 1) * 16 + 4 * g + r) * DM + 16 * it] = (bf16)f2bf(((Yp[it][r] - mean) * rstd * lnw[it] + lnb[it] + bnp[r] * vt[r]) * gt[r]); } }
            if (ck == 512) break;
        }
        if (HACK & 4) { LDS_BARRIER(); continue; }
        const LAS unsigned char* R = L + (ck & 1) * RC_BYTES;
        bf16x8 at[2], rt[2];
#pragma unroll
        for (int kk = 0; kk < 2; ++kk) { at[kk] = *(const LAS bf16x8*)(R + RC_AT + kk * 1024 + lane * 16); rt[kk] = *(const LAS bf16x8*)(R + RC_RT + kk * 1024 + lane * 16); }
        f32x4v U[2], Y[2];
#pragma unroll
        for (int it = 0; it < 2; ++it) { U[it] = *(const LAS f32x4v*)(R + RC_U0 + (2 * cw + it) * 1024 + lane * 16); Y[it] = *(const LAS f32x4v*)(R + RC_Y0 + (2 * cw + it) * 1024 + lane * 16); }
#pragma unroll
        for (int kk = 0; kk < 2; ++kk)
#pragma unroll
            for (int it = 0; it < 2; ++it) { v4u pw; pw.x = pg8::cvt_pk_bf16(S[2 * kk][it][0], S[2 * kk][it][1]); pw.y = pg8::cvt_pk_bf16(S[2 * kk][it][2], S[2 * kk][it][3]);
                pw.z = pg8::cvt_pk_bf16(S[2 * kk + 1][it][0], S[2 * kk + 1][it][1]); pw.w = pg8::cvt_pk_bf16(S[2 * kk + 1][it][2], S[2 * kk + 1][it][3]); const bf16x8 sf = __builtin_bit_cast(bf16x8, pw);
                U[it] = __builtin_amdgcn_mfma_f32_16x16x32_bf16(at[kk], sf, U[it], 0, 0, 0); Y[it] = __builtin_amdgcn_mfma_f32_16x16x32_bf16(rt[kk], sf, Y[it], 0, 0, 0); }
        bf16x8 uv[2];
#pragma unroll
        for (int it = 0; it < 2; ++it) { vfp[it] = *(const LAS v2u*)(R + RC_VF + (2 * cw + it) * 512 + lane * 8); gfp[it] = *(const LAS v2u*)(R + RC_GF + (2 * cw + it) * 512 + lane * 8);
            v4u pw; pw.x = pg8::cvt_pk_bf16(U[it][0], U[it][1]); pw.y = pg8::cvt_pk_bf16(U[it][2], U[it][3]); pw.z = vfp[it].x; pw.w = vfp[it].y; uv[it] = __builtin_bit_cast(bf16x8, pw); }
#pragma unroll
        for (int jt = 0; jt < 4; ++jt) { const bf16x8 bk = *(const LAS bf16x8*)(R + RC_BK + jt * 1024 + lane * 16); const f32x4v p15 = *(const LAS f32x4v*)(R + RC_P15 + (16 * jt + 4 * g) * 4);
#pragma unroll
            for (int it = 0; it < 2; ++it) S[jt][it] = __builtin_amdgcn_mfma_f32_16x16x32_bf16(bk, uv[it], S[jt][it] * p15, 0, 0, 0); }
        bnp = *(const LAS f32x4v*)(R + RC_BN + 16 * g); Yp[0] = Y[0]; Yp[1] = Y[1];
        { LAS float* xo = XS + (ck & 1) * 64 + cw * 32; const f32x4v sm = Y[0] + Y[1], sq = Y[0] * Y[0] + Y[1] * Y[1];
#pragma unroll
          for (int r = 0; r < 4; ++r) { const float a = sum16(sm[r]), q = sum16(sq[r]); if (n == 0) { xo[(4 * g + r) * 2] = a; xo[(4 * g + r) * 2 + 1] = q; } } }
        LDS_BARRIER();
    }
}
template <int HACK = 0> __device__ __forceinline__ void mixers_v4(Frame& F, int l, int qi, int mask = 15) {
    gu32* ctr = F.ctl + CW_Q + 64 * qi;
    for (;;) {
        const int it = next_item(F, ctr); relaunder(F); relaunder_tid(F);
        if (it < 32) { if (mask & 1) rwkv_scan_unit<HACK>(F, l, it >> 4, it & 15); }
        else if (it < 40) { const int j = it - 32; if (mask & 2) gla_scan_unit<HACK>(F, l, j >> 2, j & 3); }
        else if (it < 40 + 1024) { const int j = it - 40, qb = 63 - (j >> 4), bh = j & 15; if (mask & 4) attn_unit<true>(F, l, bh >> 3, bh & 7, qb); }
        else if (it < 40 + 2048) { const int j = it - 1064, qb = j & 63, bh = j >> 6; if (mask & 8) attn_unit<false>(F, l, bh >> 3, bh & 7, qb); }
        else break;
    }
}
__device__ __forceinline__ void prep_rwkv(Frame& F, int l) {
    LAS float* wst = (LAS float*)(F.lds + RING_OFF) + 4096;
    LAS float* in = (LAS float*)(F.lds + RING_OFF);
    const float* mu = F.kin[I_RMU] + (size_t)l * 3264;
    const float* LOWR = WSP(float, WS_LOWR); const bf16* COLS = WSP(bf16, WS_COLS);
    float* RW = WSP(float, WS_RW); float* VF = WSP(float, WS_VFIRST);
    constexpr size_t RS = RW_ONE / 4;
    for (int tile = F.bx; tile < M / 16; tile += F.G) {
        const int row0 = tile * 16;
        __syncthreads();
        for (int idx = F.tid; idx < 16 * 224; idx += NWAVES * 64) { const int tt = idx / 224, j = idx % 224, row = row0 + tt, t = row & (SEQ - 1);
            const int col = j < 192 ? 16 + j : 208 + (j - 192);
            const float cur = LOWR[(size_t)row * 256 + col], prev = t > 0 ? LOWR[(size_t)(row - 1) * 256 + col] : 0.f;
            const float muv = j < 192 ? mu[3072 + j] : (l ? F.kin[I_VRMU][(l - 1) * 32 + (j - 192)] : 0.f);
            float x = cur + (prev - cur) * muv;
            if (j < 64) x = tanhf(x); else if (j >= 128 && j < 192) x = sigmoid_f(x);
            in[j * 16 + tt] = x; }
        __syncthreads();
#pragma unroll 1
        for (int pass = 0; pass < 2; ++pass) {
            const int c = pass * 512 + F.tid;
            float accw[16], acca[16], accg[16], accv[16];
            { const float bw = F.kin[I_RW0][l * 1024 + c], ba = F.kin[I_RA0][l * 1024 + c], bv = l ? F.kin[I_VR0][(l - 1) * 1024 + c] : 0.f;
#pragma unroll
              for (int tt = 0; tt < 16; ++tt) { accw[tt] = bw; acca[tt] = ba; accg[tt] = 0.f; accv[tt] = bv; } }
#define LOWRANK_ACC(ACC, WPTR, JOFF, NJ) do { const float* wp_ = (WPTR) + c; float nx_[16]; \
            _Pragma("unroll") for (int j_ = 0; j_ < 16; ++j_) nx_[j_] = wp_[(size_t)j_ * 1024]; \
            _Pragma("unroll 1") for (int jb = 0; jb < (NJ) / 16; ++jb) { LAS float* wl_ = wst + (jb & 1) * 8192 + F.tid; \
                _Pragma("unroll") for (int j_ = 0; j_ < 16; ++j_) wl_[j_ * 512] = nx_[j_]; \
                if (jb + 1 < (NJ) / 16) { _Pragma("unroll") for (int j_ = 0; j_ < 16; ++j_) nx_[j_] = wp_[(size_t)((jb + 1) * 16 + j_) * 1024]; } \
                _Pragma("unroll 2") for (int j_ = 0; j_ < 16; ++j_) { const float w_ = wl_[j_ * 512]; const LAS f32x4* ip_ = (const LAS f32x4*)(in + ((JOFF) + jb * 16 + j_) * 16); \
                    const f32x4 i0 = ip_[0], i1 = ip_[1], i2 = ip_[2], i3 = ip_[3]; \
                    ACC[0] += i0.x * w_; ACC[1] += i0.y * w_; ACC[2] += i0.z * w_; ACC[3] += i0.w * w_; ACC[4] += i1.x * w_; ACC[5] += i1.y * w_; ACC[6] += i1.z * w_; ACC[7] += i1.w * w_; \
                    ACC[8] += i2.x * w_; ACC[9] += i2.y * w_; ACC[10] += i2.z * w_; ACC[11] += i2.w * w_; ACC[12] += i3.x * w_; ACC[13] += i3.y * w_; ACC[14] += i3.z * w_; ACC[15] += i3.w * w_; } } } while (0)
            relaunder(F); LOWRANK_ACC(accw, F.kin[I_RWUP] + (size_t)l * 64 * 1024, 0, 64);
            relaunder(F); LOWRANK_ACC(acca, F.kin[I_RAUP] + (size_t)l * 64 * 1024, 64, 64);
            relaunder(F); LOWRANK_ACC(accg, F.kin[I_RGUP] + (size_t)l * 64 * 1024, 128, 64);
            relaunder(F); if (l) LOWRANK_ACC(accv, F.kin[I_VRUP] + (size_t)(l - 1) * 32 * 1024, 192, 32);
#undef LOWRANK_ACC
            relaunder(F);
            const float mur = F.kin[I_RMU][l * 3264 + c], muk = F.kin[I_RMU][l * 3264 + 1024 + c], muv = F.kin[I_RMU][l * 3264 + 2048 + c], kkv = F.kin[I_RKK][l * 1024 + c], kav = F.kin[I_RKA][l * 1024 + c];
            float pr = 0.f, pk = 0.f, pv = 0.f;
            if ((row0 & (SEQ - 1)) != 0) { const bf16* p = COLS + (size_t)(row0 - 1) * NMAIN + c; pr = bf2f(p[CC_R]); pk = bf2f(p[CC_K]); pv = bf2f(p[CC_V]); }
#pragma unroll
            for (int tt = 0; tt < 16; ++tt) { const int row = row0 + tt; const bf16* p = COLS + (size_t)row * NMAIN + c;
                const float cr = bf2f(p[CC_R]), ck = bf2f(p[CC_K]), cv = bf2f(p[CC_V]);
                const float r = cr + (pr - cr) * mur, k = ck + (pk - ck) * muk; float v = cv + (pv - cv) * muv;
                pr = cr; pk = ck; pv = cv;
                const size_t o = (size_t)row * 1024 + c;
                if (l == 0) VF[o] = v; else { const float vg = sigmoid_f(accv[tt]); v = v + (VF[o] - v) * vg; }
                const float dec = __expf(-0.6065306597126334f * sigmoid_f(accw[tt]));
                const float a = sigmoid_f(acca[tt]);
                float kk = k * kkv; const float ss = wave_sum(kk * kk); kk = kk / fmaxf(sqrtf(ss), 1e-12f);
                const float km = k * (1.0f + (a - 1.0f) * kav);
                RW[o] = r; RW[RS + o] = dec; RW[2 * RS + o] = km; RW[3 * RS + o] = v; RW[4 * RS + o] = -kk; RW[5 * RS + o] = kk * a; RW[6 * RS + o] = accg[tt]; }
        }
        asm volatile("s_waitcnt vmcnt(0)" ::: "memory"); __syncthreads();
        __builtin_amdgcn_fence(__ATOMIC_ACQUIRE, "agent"); asm volatile("s_waitcnt vmcnt(0)" ::: "memory");
        rwkv_chunks_of_tile(F, l, tile);
    }
}
struct Args { const float* in[35]; float* out; unsigned char* ws; };
__device__ __forceinline__ void mk_frame(Frame& F, int wv) {
    extern __shared__ __attribute__((aligned(16))) unsigned char lds[];
    kargp kp = (kargp)__builtin_amdgcn_kernarg_segment_ptr(); asm volatile("" : "+s"(kp));
    F.kin = kp;
    F.lds = (LAS unsigned char*)lds;
    F.MISC = (volatile LAS unsigned*)(F.lds + MISC_OFF);
    { int w_ = wv; asm volatile("" : "+s"(w_)); int t_ = (int)__builtin_amdgcn_mbcnt_hi(~0u, __builtin_amdgcn_mbcnt_lo(~0u, (unsigned)w_ * 64u)); asm volatile("" : "+v"(t_)); F.tid = t_; } F.lane = F.tid & 63; F.wave = __builtin_amdgcn_readfirstlane(F.tid >> 6);
    F.G = gridDim.x; { int bx = blockIdx.x; asm volatile("" : "+s"(bx)); F.bx = bx; F.vcu = (F.G % 8 == 0) ? (bx % 8) * (F.G / 8) + bx / 8 : bx; }
    F.out = (float*)kp[35]; F.ws = (unsigned char*)kp[36]; F.ctl = (gu32*)(F.ws + WS_CTL);
}
__device__ __forceinline__ void grid_bar(int wv) {
    Frame F; mk_frame(F, wv);
    XcdBarrier bar; bar.bar = (unsigned*)(F.ctl + CW_BAR); bar.x = xb_xcc_id(); bar.st = F.MISC + 8;
    xcd_barrier(bar);
#ifdef REP_BAR
    xcd_barrier(bar);
#endif
}
__global__ void __launch_bounds__(NWAVES * 64, 2) mega_fwd(Args args) {
    const int wv = __builtin_amdgcn_readfirstlane((int)threadIdx.x >> 6);
    { Frame F; mk_frame(F, wv);
      for (int u = F.tid; u < (LDS_BYTES - LDSCTL_OFF) / 4; u += NWAVES * 64) ((LAS unsigned*)(F.lds + LDSCTL_OFF))[u] = 0u;
      __syncthreads();
      (void)xcd_barrier_post((unsigned*)(F.ctl + CW_BAR), F.MISC + 8);
#ifndef NO_P0
      p0_prologue_a(F);
#endif
#ifdef REP_P0
      __syncthreads(); p0_prologue_a(F);
#endif
    }
    grid_bar(wv);
    { Frame F; mk_frame(F, wv); p0_prologue_b(F); }
    grid_bar(wv);
#pragma unroll 1
    for (int l = 0; l < NLAYER; ++l) {
#ifndef REP_HACK
#define REP_HACK 0
#endif
#define LAYER_VARS const float* mod = WSP(float, WS_MOD) + (size_t)l * 2 * 24576; const float* xin = l == 0 ? F.kin[I_X] : F.out; (void)mod; (void)xin
#ifndef NO_RMS
        { Frame F; mk_frame(F, wv); LAYER_VARS; rms_phase(F, xin, mod + 0, mod + 4096); }
#endif
        grid_bar(wv);
#ifndef NO_G1
        { Frame F; mk_frame(F, wv);
          pg8::Gemm g{WSP(pg8::bf16_t, WS_XN), WSP(pg8::bf16_t, WS_WIN + l * WIN_L), M, NIN, DM}; pg8::StaticOrder S; S.init(M, NIN, F.G, F.bx);
          pg8::EpiCols E{WSP(pg8::bf16_t, WS_COLS), WSP(float, WS_LOWR)};
          pg8::gemm_phase<pg8::EpiCols, pg8::StaticOrder, true, true>(F.lds + RING_OFF, g, S, E, F.tid); }
#endif
#ifdef REP_IN
        grid_bar(wv);
        { Frame F; mk_frame(F, wv);
          pg8::Gemm g{WSP(pg8::bf16_t, WS_XN), WSP(pg8::bf16_t, WS_WIN + l * WIN_L), M, NIN, DM}; pg8::StaticOrder S; S.init(M, NIN, F.G, F.bx);
          pg8::EpiCols E{WSP(pg8::bf16_t, WS_COLS), WSP(float, WS_LOWR)};
          pg8::gemm_phase<pg8::EpiCols, pg8::StaticOrder, true, true>(F.lds + RING_OFF, g, S, E, F.tid); }
#endif
        grid_bar(wv);
#ifndef NO_PREP
        { Frame F; mk_frame(F, wv); prep_norm(F, l); }
        { Frame F; mk_frame(F, wv); prep_loga(F, l); }
        { Frame F; mk_frame(F, wv); prep_rwkv(F, l); }
#ifdef REP_P2
        { Frame F; mk_frame(F, wv); prep_rwkv(F, l); }
#endif
        { Frame F; mk_frame(F, wv); prep_vt(F, 0); }
        { Frame F; mk_frame(F, wv); prep_vt(F, 1); }
        { Frame F; mk_frame(F, wv); prep_gla(F); }
#ifdef REP_P3
        { Frame F; mk_frame(F, wv); prep_vt(F, 0); }
        { Frame F; mk_frame(F, wv); prep_vt(F, 1); }
        { Frame F; mk_frame(F, wv); prep_gla(F); }
#endif
#ifdef REP_P4
#endif
#endif
#ifdef REP_PREP
        grid_bar(wv);
        { Frame F; mk_frame(F, wv); prep_norm(F, l); }
        { Frame F; mk_frame(F, wv); prep_loga(F, l); }
        { Frame F; mk_frame(F, wv); prep_rwkv(F, l); }
        { Frame F; mk_frame(F, wv); prep_vt(F, 0); }
        { Frame F; mk_frame(F, wv); prep_vt(F, 1); }
        { Frame F; mk_frame(F, wv); prep_gla(F); }
#endif
        grid_bar(wv);
#ifndef NO_MIX
#ifdef REP_MIX
        { Frame F; mk_frame(F, wv); mixers_v4<REP_HACK>(F, l, l + 2, REP_MIX); }
        grid_bar(wv);
#endif
        { Frame F; mk_frame(F, wv); mixers_v4(F, l, l); }
#endif
        grid_bar(wv);
#ifndef NO_G2
        { Frame F; mk_frame(F, wv); LAYER_VARS;
          pg8::Gemm g{WSP(pg8::bf16_t, WS_MIXED), WSP(pg8::bf16_t, WS_WOUT + l * WOUT_L), M, DM, DM}; pg8::StaticOrder S; S.init(M, DM, F.G, F.bx);
          pg8::EpiRes E{xin, F.out, mod + 2 * 4096};
          pg8::gemm_phase<pg8::EpiRes, pg8::StaticOrder, true, true>(F.lds + RING_OFF, g, S, E, F.tid); }
#endif
        grid_bar(wv);
        { Frame F; mk_frame(F, wv); LAYER_VARS; rms_phase(F, F.out, mod + 3 * 4096, mod + 4 * 4096); }
#ifdef REP_RMS
        { Frame F; mk_frame(F, wv); LAYER_VARS; rms_phase(F, F.out, mod + 3 * 4096, mod + 4 * 4096); }
#endif
        grid_bar(wv);
#ifndef NO_G3
        { Frame F; mk_frame(F, wv);
          pg8::Gemm g{WSP(pg8::bf16_t, WS_XN), WSP(pg8::bf16_t, WS_W13 + l * W13_L), M, 2 * DFF, DM}; pg8::StaticOrder S; S.init(M, 2 * DFF, F.G, F.bx);
          pg8::EpiSwiglu E{WSP(pg8::bf16_t, WS_HID)};
          pg8::gemm_phase<pg8::EpiSwiglu, pg8::StaticOrder, true, true>(F.lds + RING_OFF, g, S, E, F.tid); }
#endif
#ifdef REP_UP
        grid_bar(wv);
        { Frame F; mk_frame(F, wv);
          pg8::Gemm g{WSP(pg8::bf16_t, WS_XN), WSP(pg8::bf16_t, WS_W13 + l * W13_L), M, 2 * DFF, DM}; pg8::StaticOrder S; S.init(M, 2 * DFF, F.G, F.bx);
          pg8::EpiSwiglu E{WSP(pg8::bf16_t, WS_HID)};
          pg8::gemm_phase<pg8::EpiSwiglu, pg8::StaticOrder, true, true>(F.lds + RING_OFF, g, S, E, F.tid); }
#endif
        grid_bar(wv);
#ifndef NO_G4
        { Frame F; mk_frame(F, wv); LAYER_VARS;
          pg8::Gemm g{WSP(pg8::bf16_t, WS_HID), WSP(pg8::bf16_t, WS_W2 + l * W2_L), M, DM, DFF}; pg8::StaticOrder S; S.init(M, DM, F.G, F.bx);
          pg8::EpiRes E{F.out, F.out, mod + 5 * 4096};
          pg8::gemm_phase<pg8::EpiRes, pg8::StaticOrder, true, true>(F.lds + RING_OFF, g, S, E, F.tid); }
#endif
        if (l + 1 < NLAYER) grid_bar(wv);
#undef LAYER_VARS
    }
}

extern "C" void kernel_launch(void* const* d_in, const int* in_sizes, int n_in, void* d_out, int out_size, void* d_ws, size_t ws_size, hipStream_t stream) {
    static int grid = 0;
    if (grid == 0) {
        if (n_in != 35 || in_sizes[0] != M * DM || out_size != M * DM || ws_size < WS_END) { fprintf(stderr, "kernel_launch: unexpected shapes: n_in %d in0 %d out %d ws %zu (need %zu)\n", n_in, n_in > 0 ? in_sizes[0] : -1, out_size, ws_size, (size_t)WS_END); grid = -1; return; }
        int dev = 0, cus = 0, per_cu = 0;
        if (hipGetDevice(&dev) != hipSuccess || hipDeviceGetAttribute(&cus, hipDeviceAttributeMultiprocessorCount, dev) != hipSuccess) { grid = -1; return; }
        if (hipFuncSetAttribute((const void*)mega_fwd, hipFuncAttributeMaxDynamicSharedMemorySize, LDS_BYTES) != hipSuccess) { fprintf(stderr, "kernel_launch: hipFuncSetAttribute failed\n"); grid = -1; return; }
        if (hipOccupancyMaxActiveBlocksPerMultiprocessor(&per_cu, (const void*)mega_fwd, NWAVES * 64, LDS_BYTES) != hipSuccess || per_cu < 1) fprintf(stderr, "kernel_launch: occupancy query says %d\n", per_cu);
        (void)hipGetLastError();
        grid = cus;
    }
    if (grid < 0) return;
    if (hipMemsetAsync((char*)d_ws + WS_CTL, 0, CTL_ZERO_BYTES, stream) != hipSuccess) return;
    Args a{};
    for (int i = 0; i < 35; ++i) a.in[i] = (const float*)d_in[i];
    a.out = (float*)d_out; a.ws = (unsigned char*)d_ws;
    hipLaunchKernelGGL(mega_fwd, dim3(grid), dim3(NWAVES * 64), LDS_BYTES, stream, a);
}
```

```cpp
#include <hip/hip_runtime.h>
#include <cstdio>
#include <cstdint>
namespace pg8 {
#define PG8_LAS __attribute__((address_space(3)))
typedef unsigned short bf16_t;
typedef short bf16x8 __attribute__((ext_vector_type(8)));
typedef float f32x4 __attribute__((ext_vector_type(4)));
typedef unsigned u32x4 __attribute__((ext_vector_type(4)));
constexpr int BM = 256, BK = 64, HALF = 128, HTB = HALF * BK * 2  , STAGE_BYTES = 8 * HTB, NXCD = 8, WGM = 8;

__host__ __device__ __forceinline__ int lds_byte(int r, int c) { const int st = (r >> 4) * 2 + (c >> 5), rr = r & 15, cc = c & 31, ob = rr * 64 + cc * 2; return st * 1024 + (ob ^ (((ob >> 9) & 1) << 5)); }
__host__ __device__ __forceinline__ void stage_rc(int b, int& R, int& C) { const int st = b / 1024, sb = b % 1024, swz = sb ^ (((sb >> 9) & 1) << 5); R = (st >> 1) * 16 + swz / 64; C = (st & 1) * 32 + (swz % 64) / 2; }
__host__ __device__ __forceinline__ int perm32(int rho) { const int n = rho >> 4, i = rho & 15; return 8 * (i >> 2) + 4 * n + (i & 3); }

struct Unit { int pm, pn; };
struct Gemm { const bf16_t* A; const bf16_t* Bt; int M, N, K; };

struct StaticOrder {
    int nM, nN, nwg, G, c;
    __host__ __device__ void init(int M, int N, int G_, int c_) { nM = M / BM; nN = N / BM; nwg = nM * nN; G = G_; c = c_; }
    __host__ __device__ bool next(int i, Unit& u) const {
        const long L = (long)i * G + c; if (L >= nwg) return false;
        int wgid = (int)L; { const int q = nwg / NXCD, r = nwg % NXCD, xcd = wgid % NXCD, off = wgid / NXCD; wgid = (xcd < r ? xcd * (q + 1) : r * (q + 1) + (xcd - r) * q) + off; }
        const int nig = WGM * nN, gid = wgid / nig, fm = gid * WGM, gsz = (nM - fm) < WGM ? (nM - fm) : WGM;
        u.pm = fm + ((wgid % nig) % gsz); u.pn = (wgid % nig) / gsz; return true;
    }
    __device__ __forceinline__ void a_ready(const Unit&) const {}
    __device__ __forceinline__ void done(const Unit&) const {}
};

typedef float f32x2c_t __attribute__((ext_vector_type(2))); typedef __bf16 bf16x2c_t __attribute__((ext_vector_type(2)));
__device__ __forceinline__ unsigned cvt_pk_bf16(float lo, float hi) { const f32x2c_t v = {lo, hi}; return __builtin_bit_cast(unsigned, __builtin_convertvector(v, bf16x2c_t)); }
typedef float f32x2 __attribute__((ext_vector_type(2)));
__device__ __forceinline__ float silu_f(float x) { return x * __builtin_amdgcn_rcpf(1.0f + __builtin_amdgcn_exp2f(-1.4426950408889634f * x)); }
struct EpiCols {
    static constexpr bool PERM = true, AFTER_DRAIN = false;
    bf16_t* O; float* L;
    __device__ __forceinline__ void operator()(const f32x4 (&acc)[2][2][4][2], const Unit& u, int wr, int wc, int fr, int fq) const {
        const int row0 = u.pm * BM + wr * 64 + fr;
        if (u.pn < 41) {
            const int col0 = u.pn * BM + wc * 32 + 8 * fq;
#pragma unroll
            for (int ai = 0; ai < 2; ++ai)
#pragma unroll
                for (int m = 0; m < 4; ++m) { bf16_t* rowp = O + (size_t)(row0 + ai * HALF + m * 16) * 10496 + col0;
#pragma unroll
                    for (int bj = 0; bj < 2; ++bj) { const f32x4 v0 = acc[ai][bj][m][0], v1 = acc[ai][bj][m][1];
                        u32x4 w; w.x = cvt_pk_bf16(v0[0], v0[1]); w.y = cvt_pk_bf16(v0[2], v0[3]); w.z = cvt_pk_bf16(v1[0], v1[1]); w.w = cvt_pk_bf16(v1[2], v1[3]);
                        *(u32x4*)(rowp + bj * HALF) = w; } }
        } else {
            const int col0 = wc * 32 + 8 * fq;
#pragma unroll
            for (int ai = 0; ai < 2; ++ai)
#pragma unroll
                for (int m = 0; m < 4; ++m) { float* rowp = L + (size_t)(row0 + ai * HALF + m * 16) * 256 + col0;
#pragma unroll
                    for (int bj = 0; bj < 2; ++bj) { *(f32x4*)(rowp + bj * HALF) = acc[ai][bj][m][0]; *(f32x4*)(rowp + bj * HALF + 4) = acc[ai][bj][m][1]; } }
        }
    }
};
struct EpiRes {
    static constexpr bool PERM = false, AFTER_DRAIN = false;
    const float* base; float* out; const float* gate;
    __device__ __forceinline__ void operator()(const f32x4 (&acc)[2][2][4][2], const Unit& u, int wr, int wc, int fr, int fq) const {
        const int row0 = u.pm * BM + wr * 64 + fr, col0 = u.pn * BM + wc * 32 + 4 * fq;
        const float* gp = gate + (size_t)(u.pm >> 5) * 24576 + col0;
        f32x4 gv[2][2];
#pragma unroll
        for (int bj = 0; bj < 2; ++bj)
#pragma unroll
            for (int n = 0; n < 2; ++n) gv[bj][n] = *(const f32x4*)(gp + bj * HALF + n * 16);
#pragma unroll
        for (int ai = 0; ai < 2; ++ai)
#pragma unroll
            for (int m = 0; m < 4; ++m) { const size_t off = (size_t)(row0 + ai * HALF + m * 16) * 4096 + col0;
#pragma unroll
                for (int bj = 0; bj < 2; ++bj)
#pragma unroll
                    for (int n = 0; n < 2; ++n) { const f32x4 bs = *(const f32x4*)(base + off + bj * HALF + n * 16); *(f32x4*)(out + off + bj * HALF + n * 16) = bs + gv[bj][n] * acc[ai][bj][m][n]; }
                if (m == 3) asm volatile("" ::: "memory"); }
    }
};
struct EpiSwiglu {
    static constexpr bool PERM = true, AFTER_DRAIN = false;
    bf16_t* H;
    __device__ __forceinline__ void operator()(const f32x4 (&acc)[2][2][4][2], const Unit& u, int wr, int wc, int fr, int fq) const {
        const int row0 = u.pm * BM + wr * 64 + fr, col0 = u.pn * HALF + wc * 32 + 8 * fq;
#pragma unroll
        for (int ai = 0; ai < 2; ++ai)
#pragma unroll
            for (int m = 0; m < 4; ++m) { bf16_t* rowp = H + (size_t)(row0 + ai * HALF + m * 16) * 11008 + col0;
                const f32x4 a0 = acc[ai][0][m][0], a1 = acc[ai][0][m][1], b0 = acc[ai][1][m][0], b1 = acc[ai][1][m][1];
                u32x4 w; w.x = cvt_pk_bf16(silu_f(a0[0]) * b0[0], silu_f(a0[1]) * b0[1]); w.y = cvt_pk_bf16(silu_f(a0[2]) * b0[2], silu_f(a0[3]) * b0[3]);
                w.z = cvt_pk_bf16(silu_f(a1[0]) * b1[0], silu_f(a1[1]) * b1[1]); w.w = cvt_pk_bf16(silu_f(a1[2]) * b1[2], silu_f(a1[3]) * b1[3]);
                *(u32x4*)rowp = w; }
    }
};
template <class Epi, class Sched, bool ALIGN_EPI = false, bool SP2 = false>
__device__ __forceinline__ void gemm_phase(PG8_LAS unsigned char* lds, const Gemm g, const Sched& S, const Epi& E, int tid_in) {
    int tid_ = tid_in; asm volatile("" : "+v"(tid_));
    const int tid = tid_, wid = __builtin_amdgcn_readfirstlane(tid >> 6), lane = tid & 63, wr = wid >> 2, wc = wid & 3, fr = lane & 15, fq = lane >> 4;
    const int K = g.K, nt = K / BK;
    unsigned voffA[2], voffB[2];
#pragma unroll
    for (int i = 0; i < 2; ++i) { int R, C; stage_rc(tid * 16 + i * 8192, R, C); const int Rb = Epi::PERM ? ((R & ~31) + perm32(R & 31)) : R;
        voffA[i] = (unsigned)(R * K + C) * 2u; voffB[i] = (unsigned)(Rb * K + C) * 2u; }
    const size_t kstep = (size_t)(BK * 2);
    const size_t hstep = (size_t)HALF * K * 2;
    const size_t tstep = 2 * hstep;
    const unsigned ldsw = (unsigned)wid * 1024u;
    const int aoff = lds_byte(wr * 64 + fr, fq * 8), boff = lds_byte(wc * 32 + fr, fq * 8);
#define PG8_SA(b, h) (((b) * 2 + (h)) * HTB)
#define PG8_SB(b, h) ((4 + (b) * 2 + (h)) * HTB)
#define PG8_STAGE(bufoff, gbase, voff) do { _Pragma("unroll") for (int _i = 0; _i < 2; ++_i) \
        __builtin_amdgcn_global_load_lds((const unsigned*)((const char*)(gbase) + (voff)[_i]), (PG8_LAS unsigned*)(lds + (bufoff) + ldsw + _i * 8192), 16, 0, 0); } while (0)
#define PG8_LDA(dst, b, h) do { _Pragma("unroll") for (int m = 0; m < 4; ++m) _Pragma("unroll") for (int k = 0; k < 2; ++k) dst[m][k] = *(const PG8_LAS bf16x8*)(lds + PG8_SA(b, h) + aoff + m * 2048 + k * 1024); } while (0)
#define PG8_LDB(dst, b, h) do { _Pragma("unroll") for (int n = 0; n < 2; ++n) _Pragma("unroll") for (int k = 0; k < 2; ++k) dst[n][k] = *(const PG8_LAS bf16x8*)(lds + PG8_SB(b, h) + boff + n * 2048 + k * 1024); } while (0)
#define PG8_MMA(ai, bj, At, Bt) do { __builtin_amdgcn_s_setprio(1); _Pragma("unroll") for (int m = 0; m < 4; ++m) _Pragma("unroll") for (int n = 0; n < 2; ++n) _Pragma("unroll") for (int k = 0; k < 2; ++k) \
        acc[ai][bj][m][n] = __builtin_amdgcn_mfma_f32_16x16x32_bf16(Bt[n][k], At[m][k], acc[ai][bj][m][n], 0, 0, 0); __builtin_amdgcn_s_setprio(0); } while (0)
#define PG8_WAIT_V(n) asm volatile("s_waitcnt vmcnt(" #n ")" ::: "memory")
#define PG8_WAIT_L(n) asm volatile("s_waitcnt lgkmcnt(" #n ")" ::: "memory")
#define PG8_BAR __builtin_amdgcn_s_barrier()
#define PG8_SCHED __builtin_amdgcn_sched_barrier(0)
    Unit cur, nxt; int ui = 0;
    if (!S.next(0, cur)) return;
    f32x4 acc[2][2][4][2];
#pragma unroll
    for (int a = 0; a < 2; ++a)
#pragma unroll
        for (int b = 0; b < 2; ++b)
#pragma unroll
            for (int m = 0; m < 4; ++m)
#pragma unroll
                for (int n = 0; n < 2; ++n) acc[a][b][m][n] = (f32x4){0.f, 0.f, 0.f, 0.f};
    bf16x8 At[4][2], B0[2][2], B1[2][2];
    const char* cA = (const char*)g.A + (size_t)cur.pm * tstep; const char* cB = (const char*)g.Bt + (size_t)cur.pn * tstep;
    S.a_ready(cur);
    if constexpr (SP2) {
        PG8_STAGE(PG8_SB(0, 0), cB, voffB); PG8_STAGE(PG8_SB(0, 1), cB + hstep, voffB); PG8_STAGE(PG8_SA(0, 0), cA, voffA); PG8_STAGE(PG8_SA(0, 1), cA + hstep, voffA);
        if (wr == 1) PG8_BAR;
        PG8_WAIT_V(2); PG8_BAR;
        PG8_STAGE(PG8_SB(1, 0), cB + kstep, voffB); PG8_STAGE(PG8_SA(1, 0), cA + kstep, voffA); PG8_STAGE(PG8_SB(1, 1), cB + hstep + kstep, voffB);
        PG8_WAIT_V(6); PG8_BAR;
    } else {
        PG8_STAGE(PG8_SB(0, 0), cB, voffB); PG8_STAGE(PG8_SA(0, 0), cA, voffA); PG8_STAGE(PG8_SB(0, 1), cB + hstep, voffB); PG8_STAGE(PG8_SA(0, 1), cA + hstep, voffA);
        if (wr == 1) PG8_BAR;
        PG8_WAIT_V(4); PG8_BAR;
        PG8_STAGE(PG8_SB(1, 0), cB + kstep, voffB); PG8_STAGE(PG8_SA(1, 0), cA + kstep, voffA); PG8_STAGE(PG8_SB(1, 1), cB + hstep + kstep, voffB);
        PG8_WAIT_V(6); PG8_BAR;
    }
    for (;;) {
        const bool has_next = S.next(ui + 1, nxt);
        const char* nA = has_next ? (const char*)g.A + (size_t)nxt.pm * tstep : cA; const char* nB = has_next ? (const char*)g.Bt + (size_t)nxt.pn * tstep : cB;
        for (int t = 0; t < nt; t += 2) {
            const bool last = (t == nt - 2);
            const char* a1 = cA + (size_t)(t + 1) * kstep;
            const char* a2 = last ? nA : cA + (size_t)(t + 2) * kstep; const char* b2 = last ? nB : cB + (size_t)(t + 2) * kstep;
            const char* a3 = a2 + kstep; const char* b3 = b2 + kstep;
            if (last && has_next) S.a_ready(nxt);
            if constexpr (SP2) {
            PG8_LDB(B0, 0, 0); PG8_LDB(B1, 0, 1); PG8_SCHED; PG8_LDA(At, 0, 0); PG8_STAGE(PG8_SA(1, 1), a1 + hstep, voffA);
            PG8_WAIT_V(8); PG8_WAIT_L(0); PG8_BAR; PG8_MMA(0, 0, At, B0); PG8_MMA(0, 1, At, B1); PG8_BAR; PG8_SCHED;
            PG8_LDA(At, 0, 1); PG8_STAGE(PG8_SB(0, 0), b2, voffB); PG8_STAGE(PG8_SB(0, 1), b2 + hstep, voffB); PG8_STAGE(PG8_SA(0, 0), a2, voffA);
            PG8_WAIT_V(8); PG8_WAIT_L(0); PG8_BAR; PG8_MMA(1, 0, At, B0); PG8_MMA(1, 1, At, B1); PG8_BAR; PG8_SCHED;
            PG8_LDB(B0, 1, 0); PG8_LDB(B1, 1, 1); PG8_SCHED; PG8_LDA(At, 1, 0); PG8_STAGE(PG8_SA(0, 1), a2 + hstep, voffA);
            PG8_WAIT_V(8); PG8_WAIT_L(0); PG8_BAR; PG8_MMA(0, 0, At, B0); PG8_MMA(0, 1, At, B1); PG8_BAR; PG8_SCHED;
            PG8_LDA(At, 1, 1); PG8_STAGE(PG8_SB(1, 0), b3, voffB); PG8_STAGE(PG8_SB(1, 1), b3 + hstep, voffB); PG8_STAGE(PG8_SA(1, 0), a3, voffA);
            PG8_WAIT_V(8); PG8_WAIT_L(0); PG8_BAR; PG8_MMA(1, 0, At, B0); PG8_MMA(1, 1, At, B1); PG8_BAR; PG8_SCHED;
            } else {
            PG8_LDB(B0, 0, 0); PG8_SCHED; PG8_LDA(At, 0, 0); PG8_STAGE(PG8_SA(1, 1), a1 + hstep, voffA);
            PG8_WAIT_L(8); PG8_BAR; PG8_WAIT_L(0); PG8_MMA(0, 0, At, B0); PG8_BAR; PG8_SCHED;
            PG8_LDB(B1, 0, 1); PG8_STAGE(PG8_SB(0, 0), b2, voffB);
            PG8_BAR; PG8_WAIT_L(0); PG8_MMA(0, 1, At, B1); PG8_BAR;
            PG8_LDA(At, 0, 1); PG8_STAGE(PG8_SA(0, 0), a2, voffA);
            PG8_BAR; PG8_WAIT_L(0); PG8_MMA(1, 0, At, B0); PG8_BAR; PG8_SCHED;
            PG8_STAGE(PG8_SB(0, 1), b2 + hstep, voffB);
            PG8_WAIT_V(6); PG8_BAR; PG8_MMA(1, 1, At, B1); PG8_BAR;
            PG8_LDB(B0, 1, 0); PG8_SCHED; PG8_LDA(At, 1, 0); PG8_STAGE(PG8_SA(0, 1), a2 + hstep, voffA);
            PG8_WAIT_L(8); PG8_BAR; PG8_WAIT_L(0); PG8_MMA(0, 0, At, B0); PG8_BAR; PG8_SCHED;
            PG8_LDB(B1, 1, 1); PG8_STAGE(PG8_SB(1, 0), b3, voffB);
            PG8_BAR; PG8_WAIT_L(0); PG8_MMA(0, 1, At, B1); PG8_BAR;
            PG8_LDA(At, 1, 1); PG8_STAGE(PG8_SA(1, 0), a3, voffA);
            PG8_BAR; PG8_WAIT_L(0); PG8_MMA(1, 0, At, B0); PG8_BAR; PG8_SCHED;
            PG8_STAGE(PG8_SB(1, 1), b3 + hstep, voffB);
            PG8_WAIT_V(6); PG8_BAR; PG8_MMA(1, 1, At, B1); PG8_BAR;
            }
        }
        if constexpr (ALIGN_EPI) { if (wr == 0) PG8_BAR; }
        if constexpr (!Epi::AFTER_DRAIN) { E(acc, cur, wr, wc, fr, fq); S.done(cur); }
        if (!has_next) break;
#pragma unroll
        for (int a = 0; a < 2; ++a)
#pragma unroll
            for (int b = 0; b < 2; ++b)
#pragma unroll
                for (int m = 0; m < 4; ++m)
#pragma unroll
                    for (int n = 0; n < 2; ++n) acc[a][b][m][n] = (f32x4){0.f, 0.f, 0.f, 0.f};
        cur = nxt; cA = nA; cB = nB; ++ui;
        if constexpr (ALIGN_EPI) { if (wr == 1) PG8_BAR; }
    }
    PG8_WAIT_V(0);
    if constexpr (!ALIGN_EPI) { if (wr == 0) PG8_BAR; }
    PG8_BAR;
    if constexpr (Epi::AFTER_DRAIN) { E.fused(acc, cur, wr, wc, fr, fq, lds, wid, lane); S.done(cur); }
#undef PG8_SA
#undef PG8_SB
#undef PG8_STAGE
#undef PG8_LDA
#undef PG8_LDB
#undef PG8_MMA
#undef PG8_WAIT_V
#undef PG8_WAIT_L
#undef PG8_BAR
#undef PG8_SCHED
}
}
constexpr int BATCH = 2, SEQ = 8192, DM = 4096, M = BATCH * SEQ, DFF = 11008, NLAYER = 2;
constexpr int P_IN = 10704, NIN = 10752, NMAIN = 10496;
constexpr int CA_Q = 0, CA_K = 1024, CA_V = 2048;
constexpr int CB_Q = 3072, CB_K = 3584, CB_V = 4096, CB_G = 5120;
constexpr int CC_R = 6144, CC_K = 7168, CC_V = 8192;
constexpr int CD_Q = 9216, CD_K = 10240, CD_V = 10368;
constexpr float LOG2E = 1.4426950408889634f;
constexpr float QSCALE = 0.125f * LOG2E;
constexpr int NWAVES = 8;

constexpr size_t MiB = 1u << 20;
constexpr size_t WS_CTL = 0, CTL_ZERO_BYTES = 1 * MiB;
constexpr size_t WS_MODP = 2 * MiB;
constexpr size_t WS_MOD = 14 * MiB;
constexpr size_t WS_TAB = 15 * MiB;
constexpr size_t WS_WIN = 16 * MiB, WIN_L = 84 * MiB;
constexpr size_t WS_WOUT = 184 * MiB, WOUT_L = 32 * MiB;
constexpr size_t WS_W13 = 248 * MiB, W13_L = 172 * MiB;
constexpr size_t WS_W2 = 592 * MiB, W2_L = 86 * MiB;
constexpr size_t WS_XN = 764 * MiB;
constexpr size_t WS_COLS = 892 * MiB;
constexpr size_t WS_LOWR = 1220 * MiB;
constexpr size_t WS_HID = 892 * MiB;
constexpr size_t WS_QKA = 1236 * MiB;
constexpr size_t WS_QKD = 1300 * MiB;
constexpr size_t WS_LOGA = 1336 * MiB;
constexpr size_t WS_RW = 1368 * MiB, RW_ONE = 64 * MiB;
constexpr size_t WS_VFIRST = 1816 * MiB;
constexpr size_t WS_MIXED = 1880 * MiB;
constexpr int VROW = SEQ + 64;
constexpr size_t WS_VTA = 2008 * MiB;
constexpr size_t WS_VTD = 2041 * MiB;
constexpr size_t WS_QDEC = 2046 * MiB, WS_KDT = 2062 * MiB, WS_AM = 2078 * MiB, WS_EBL = 2086 * MiB;
constexpr size_t WS_VTB = 2087 * MiB;
constexpr size_t WS_RWC = 2120 * MiB;
constexpr size_t WS_END = 2446 * MiB;
constexpr int CW_BAR = 4096;
constexpr int CW_Q = 16384;

constexpr int RING_OFF = 0, RING_BYTES = 131072;
constexpr int LDSCTL_OFF = RING_BYTES, MISC_OFF = LDSCTL_OFF + 320;
constexpr int LDS_BYTES = 147456;

#define GAS __attribute__((address_space(1)))
#define LAS __attribute__((address_space(3)))
typedef unsigned short bf16;
typedef unsigned v4u __attribute__((ext_vector_type(4)));
typedef unsigned v2u __attribute__((ext_vector_type(2)));
typedef float f32x4 __attribute__((ext_vector_type(4)));
typedef short bf16x8 __attribute__((ext_vector_type(8)));
typedef GAS unsigned gu32;
#define RLX_AGENT __ATOMIC_RELAXED, __HIP_MEMORY_SCOPE_AGENT
#define LDS_WAIT() asm volatile("s_waitcnt lgkmcnt(0)" ::: "memory")
#define VM_WAIT() asm volatile("s_waitcnt vmcnt(0)" ::: "memory")
typedef float f32x2_t __attribute__((ext_vector_type(2))); typedef __bf16 bf16x2_t __attribute__((ext_vector_type(2)));
__device__ __forceinline__ unsigned pk2(float lo, float hi) { const f32x2_t v = {lo, hi}; return __builtin_bit_cast(unsigned, __builtin_convertvector(v, bf16x2_t)); }
__device__ __forceinline__ unsigned f2bf(float f) { return pk2(f, f) & 0xffffu; }
__device__ __forceinline__ float bf2f(unsigned short h) { return __builtin_bit_cast(float, (unsigned)h << 16); }
__device__ __forceinline__ float bflo(unsigned w) { return __builtin_bit_cast(float, w << 16); }
__device__ __forceinline__ float bfhi(unsigned w) { return __builtin_bit_cast(float, w & 0xffff0000u); }
template <int CTRL> __device__ __forceinline__ float dpp_f(float v) { return __builtin_bit_cast(float, __builtin_amdgcn_update_dpp(0, __builtin_bit_cast(int, v), CTRL, 0xF, 0xF, true)); }
__device__ __forceinline__ float sum8(float v) {
    v += dpp_f<0xB1>(v); v += dpp_f<0x4E>(v); v += dpp_f<0x141>(v); return v; }
__device__ __forceinline__ float wave_sum(float v) {
    v = sum8(v); v += dpp_f<0x140>(v);
    v += __builtin_bit_cast(float, __builtin_amdgcn_ds_swizzle(__builtin_bit_cast(int, v), 0x401F));
    { const int u = __builtin_bit_cast(int, v); v = __builtin_bit_cast(float, __builtin_amdgcn_readlane(u, 0)) + __builtin_bit_cast(float, __builtin_amdgcn_readlane(u, 32)); }
    return v;
}
__device__ __forceinline__ float sigmoid_f(float x) { return __builtin_amdgcn_rcpf(1.0f + __builtin_amdgcn_exp2f(-LOG2E * x)); }
__device__ __forceinline__ float silu_g(float x) { return x * sigmoid_f(x); }

#define XB_TMO      128
#define XB_XCNT(j)  (256  + 64 * (j))
#define XB_XSUB(j)  (1280 + 64 * (j))
#define XB_XGEN(j)  (2304 + 64 * (j))
#define XB_TOP      3328
#define XB_TOPGEN   3392
#define XCD_BAR_WORDS 3456
#define XB_SPIN_CAP (1u << 23)

__device__ __forceinline__ unsigned xb_ld(unsigned* p)              { return __hip_atomic_load(p, __ATOMIC_RELAXED, __HIP_MEMORY_SCOPE_AGENT); }
__device__ __forceinline__ unsigned xb_add(unsigned* p, unsigned v) { return __hip_atomic_fetch_add(p, v, __ATOMIC_RELAXED, __HIP_MEMORY_SCOPE_AGENT); }
__device__ __forceinline__ unsigned xb_xcc_id() { return (unsigned)__builtin_amdgcn_s_getreg((3 << 11) | 20) & 0xFu; }
#define XB_SPIN(cond, bar) do { unsigned _sp = 0; while (cond) { __builtin_amdgcn_s_sleep(1); \
    if ((++_sp & 255u) == 0u) { if (xb_ld(&(bar)[XB_TMO])) break; if (_sp > XB_SPIN_CAP) { atomicAdd(&(bar)[XB_TMO], 1u); break; } } } } while (0)

struct XcdBarrier {
    unsigned* bar; unsigned x;
    volatile LAS unsigned* st;
};

__device__ __forceinline__ XcdBarrier xcd_barrier_post(unsigned* bar, volatile LAS unsigned* st) {
    XcdBarrier b; b.bar = bar; b.x = xb_xcc_id(); b.st = st;
    if (threadIdx.x == 0) (void)xb_add(&bar[XB_XCNT(b.x)], 1u);
    return b;
}
__device__ __forceinline__ void xcd_barrier_complete(unsigned* bar, unsigned x, unsigned& nloc, unsigned& nx) {
    const unsigned G = gridDim.x * gridDim.y * gridDim.z;
    unsigned sum, cnt, mine, sp = 0u;
    for (;;) {
        sum = 0u; cnt = 0u; mine = 0u;
#pragma unroll
        for (unsigned j = 0; j < 16; ++j) { const unsigned c = xb_ld(&bar[XB_XCNT(j)]); sum += c; cnt += (c > 0u) ? 1u : 0u; mine = (j == x) ? c : mine; }
        if (sum == G) break;
        __builtin_amdgcn_s_sleep(1);
        if ((++sp & 255u) == 0u) { if (xb_ld(&bar[XB_TMO])) break; if (sp > XB_SPIN_CAP) { atomicAdd(&bar[XB_TMO], 1u); break; } }
    }
    nloc = mine > 0u ? mine : 1u; nx = cnt > 0u ? cnt : 1u;
}

__device__ __forceinline__ void xcd_barrier(const XcdBarrier& b) {
    asm volatile("s_waitcnt vmcnt(0)" ::: "memory");
    __syncthreads();
    if (threadIdx.x == 0) {
        unsigned* bar = b.bar;
        __builtin_amdgcn_s_waitcnt(0);
        unsigned nloc = b.st[0], nx = b.st[1];
        if (nloc == 0u) { xcd_barrier_complete(bar, b.x, nloc, nx); b.st[0] = nloc; b.st[1] = nx; }
        const unsigned old = xb_add(&bar[XB_XSUB(b.x)], 1u);
        const unsigned gen = old / nloc;
        if (old + 1u == (gen + 1u) * nloc) {
            __builtin_amdgcn_fence(__ATOMIC_RELEASE, "agent");
            asm volatile("s_waitcnt vmcnt(0)" ::: "memory");
            const unsigned og = xb_add(&bar[XB_TOP], 1u);
            const unsigned tg = og / nx;
            if (og + 1u == (tg + 1u) * nx) xb_add(&bar[XB_TOPGEN], 1u);
            else XB_SPIN(xb_ld(&bar[XB_TOPGEN]) == tg, bar);
            __builtin_amdgcn_fence(__ATOMIC_ACQUIRE, "agent");
            xb_add(&bar[XB_XGEN(b.x)], 1u);
            asm volatile("s_waitcnt vmcnt(0)" ::: "memory");
        } else {
            XB_SPIN(xb_ld(&bar[XB_XGEN(b.x)]) == gen, bar);
            __builtin_amdgcn_fence(__ATOMIC_ACQUIRE, "agent");
            asm volatile("s_waitcnt vmcnt(0)" ::: "memory");
        }
    }
    __syncthreads();
}

typedef const float* const __attribute__((address_space(4)))* kargp;
struct Frame {
    LAS unsigned char* lds;
    volatile LAS unsigned* MISC;
    gu32* ctl;
    int tid, lane, wave;
    int vcu, G, bx;
    kargp kin;
    float* out;
    unsigned char* ws;
};
enum { I_X = 0, I_C, I_RELB, I_ADAW, I_ADAB, I_WIN, I_WOUT, I_DQN, I_DKN, I_DLAM, I_DSUB, I_GGU, I_GGB, I_GON, I_RMU, I_RWUP, I_RW0, I_RAUP, I_RA0, I_RGUP,
       I_RKK, I_RKA, I_RRK, I_RLNW, I_RLNB, I_VRD, I_VRMU, I_VRUP, I_VR0, I_SQN, I_SKN, I_SSINK, I_W1, I_W3, I_W2 };

#define WSP(T, off) ((T*)(F.ws + (off)))
__device__ __forceinline__ void relaunder_tid(Frame& F) { int t = F.tid; asm volatile("" : "+v"(t)); F.tid = t; F.lane = t & 63; F.wave = __builtin_amdgcn_readfirstlane(t >> 6); }
__device__ __forceinline__ void relaunder(Frame& F) { kargp p = F.kin; asm volatile("" : "+s"(p)); F.kin = p; }

__device__ __forceinline__ void conv_item(const float* src, int ld, int col0, int ncols, int K, bf16* WT, int row0, int kb, LAS float* scr, int lane) {
    const int k0 = 64 * kb;
    { const int n = lane & 31; const bool ok = src != nullptr && n < ncols; const float* sp = src + (size_t)(k0 + (lane >> 5)) * ld + col0 + n; float v[32];
#pragma unroll
      for (int i = 0; i < 32; ++i) v[i] = ok ? sp[(size_t)(2 * i) * ld] : 0.f;
#pragma unroll
      for (int i = 0; i < 32; ++i) scr[(2 * i + (lane >> 5)) * 33 + n] = v[i]; }
    LDS_WAIT(); asm volatile("" ::: "memory");
    const int c = lane & 7;
#pragma unroll
    for (int j = 0; j < 4; ++j) { const int n = (lane >> 3) + 8 * j; const LAS float* s = scr + (8 * c) * 33 + n;
        v4u o; o.x = pk2(s[0 * 33], s[1 * 33]); o.y = pk2(s[2 * 33], s[3 * 33]); o.z = pk2(s[4 * 33], s[5 * 33]); o.w = pk2(s[6 * 33], s[7 * 33]);
        if (n < ncols) *(GAS v4u*)(WT + (size_t)(row0 + n) * K + k0 + 8 * c) = o; }
    LDS_WAIT(); asm volatile("" ::: "memory");
}
__device__ __forceinline__ int t5_bucket(int d) {
    if (d < 16) return d;
    int v = 16 + (int)(logf((float)d * (1.0f / 16.0f)) / logf(8.0f) * 16.0f);
    return v < 31 ? v : 31;
}
__device__ __forceinline__ void p0_prologue_a(Frame& F) {
    const int gw = F.vcu * NWAVES + F.wave, NGW = F.G * NWAVES;
    LAS float* ldsf = (LAS float*)(F.lds + RING_OFF);
    for (int i = F.tid; i < 2 * DM; i += NWAVES * 64) ldsf[i] = silu_g(F.kin[I_C][i]);
    __syncthreads();
    float* MODP = WSP(float, WS_MODP);
    for (int it = gw; it < 6144; it += NGW) {
        const int l = it / 3072, rem = it % 3072, kc = rem / 96, ng = rem % 96, n0 = 256 * ng + 4 * F.lane;
        const float* w = F.kin[I_ADAW] + ((size_t)l * DM + kc * 128) * 24576 + n0;
        f32x4 a0 = {0.f, 0.f, 0.f, 0.f}, a1 = {0.f, 0.f, 0.f, 0.f};
#pragma unroll 16
        for (int k = 0; k < 128; ++k) { const f32x4 wv = *(const f32x4*)(w + (size_t)k * 24576); const float s0 = ldsf[kc * 128 + k], s1 = ldsf[DM + kc * 128 + k]; a0 += wv * s0; a1 += wv * s1; }
        *(f32x4*)(MODP + ((size_t)(l * 32 + kc) * 2 + 0) * 24576 + n0) = a0;
        *(f32x4*)(MODP + ((size_t)(l * 32 + kc) * 2 + 1) * 24576 + n0) = a1;
    }
    __syncthreads();
    LAS float* scr = (LAS float*)(F.lds + RING_OFF + F.wave * 16384);
    constexpr int I_IN = 337 * 64, I_OUT = 128 * 64, I_13 = 688 * 64, I_2 = 128 * 172, I_L = I_IN + I_OUT + I_13 + I_2;
    for (int it = gw; it < NLAYER * I_L; it += NGW) {
        const int l = it / I_L; int r = it % I_L;
        if (r < I_IN) {
            const int kb = r / 337, cb = r % 337; const float* src = F.kin[I_WIN] + (size_t)l * DM * P_IN; int ld = P_IN, col0, row0, nc = 32;
            if (cb < 192) { col0 = 32 * cb; row0 = 32 * cb; }
            else if (cb < 288) { col0 = 6160 + 32 * (cb - 192); row0 = 6144 + 32 * (cb - 192); }
            else if (cb < 328) { col0 = 9424 + 32 * (cb - 288); row0 = 9216 + 32 * (cb - 288); }
            else if (cb == 328) { col0 = 6144; row0 = 10496; nc = 16; }
            else if (cb < 335) { col0 = 9232 + 32 * (cb - 329); row0 = 10512 + 32 * (cb - 329); }
            else if (cb == 335) { src = l ? F.kin[I_VRD] + (size_t)(l - 1) * DM * 32 : nullptr; ld = 32; col0 = 0; row0 = 10704; }
            else { src = nullptr; col0 = 0; row0 = 10736; nc = 16; }
            conv_item(src, ld, col0, nc, DM, WSP(bf16, WS_WIN + l * WIN_L), row0, kb, scr, F.lane); continue; }
        r -= I_IN;
        if (r < I_OUT) { const int kb = r / 128, cb = r % 128; conv_item(F.kin[I_WOUT] + (size_t)l * DM * DM, DM, 32 * cb, 32, DM, WSP(bf16, WS_WOUT + l * WOUT_L), 32 * cb, kb, scr, F.lane); continue; }
        r -= I_OUT;
        if (r < I_13) { const int kb = r / 688, cb = r % 688, pn = cb >> 3, wi = cb & 7;
            const float* src = (wi < 4 ? F.kin[I_W1] : F.kin[I_W3]) + (size_t)l * DM * DFF;
            conv_item(src, DFF, 128 * pn + 32 * (wi & 3), 32, DM, WSP(bf16, WS_W13 + l * W13_L), 32 * cb, kb, scr, F.lane); continue; }
        r -= I_13;
        { const int kb = r / 128, cb = r % 128; conv_item(F.kin[I_W2] + (size_t)l * DFF * DM, DM, 32 * cb, 32, DFF, WSP(bf16, WS_W2 + l * W2_L), 32 * cb, kb, scr, F.lane); }
    }
}
__device__ __forceinline__ void p0_prologue_b(Frame& F) {
    const int gt = F.bx * (NWAVES * 64) + F.tid, NT = F.G * NWAVES * 64;
    const float* MODP = WSP(float, WS_MODP); float* MOD = WSP(float, WS_MOD);
    for (int idx = gt; idx < NLAYER * 2 * 24576; idx += NT) {
        const int l = idx / 49152, rem = idx % 49152, b = rem / 24576, n = rem % 24576;
        float s = F.kin[I_ADAB][l * 24576 + n];
#pragma unroll 8
        for (int kc = 0; kc < 32; ++kc) s += MODP[((size_t)(l * 32 + kc) * 2 + b) * 24576 + n];
        MOD[idx] = s;
    }
    if (F.bx == 0) { float* TAB = WSP(float, WS_TAB);
        for (int i = F.tid; i < 24 * 128; i += NWAVES * 64) { const int hh = i >> 7, d = i & 127; TAB[i] = F.kin[I_RELB][t5_bucket(d) * 24 + hh] * LOG2E; } }
}
__device__ __forceinline__ void rms_phase(Frame& F, const float* xin, const float* sh, const float* sc) {
    const int gw = F.vcu * NWAVES + F.wave, NGW = F.G * NWAVES;
    bf16* XN = WSP(bf16, WS_XN);
    for (int m = gw; m < M; m += NGW) {
        const int b = m >> 13;
        const f32x4* xr = (const f32x4*)(xin + (size_t)m * DM) + F.lane;
        f32x4 v[16]; float ss = 0.f;
#pragma unroll
        for (int j = 0; j < 16; ++j) { v[j] = xr[64 * j]; ss += (v[j].x * v[j].x + v[j].y * v[j].y) + (v[j].z * v[j].z + v[j].w * v[j].w); }
        const float rstd = rsqrtf(wave_sum(ss) * (1.0f / DM) + 1e-6f);
        const f32x4* scp = (const f32x4*)(sc + (size_t)b * 24576) + F.lane; const f32x4* shp = (const f32x4*)(sh + (size_t)b * 24576) + F.lane;
        v2u* o8 = (v2u*)(XN + (size_t)m * DM) + F.lane;
#pragma unroll
        for (int j = 0; j < 16; ++j) { const f32x4 s4 = scp[64 * j], h4 = shp[64 * j]; const f32x4 o = v[j] * rstd * (s4 + 1.0f) + h4;
            v2u w; w.x = pk2(o.x, o.y); w.y = pk2(o.z, o.w); o8[64 * j] = w; }
    }
}
__device__ __forceinline__ void unpack8(const v4u r, float (&f)[8]) { f[0] = bflo(r.x); f[1] = bfhi(r.x); f[2] = bflo(r.y); f[3] = bfhi(r.y); f[4] = bflo(r.z); f[5] = bfhi(r.z); f[6] = bflo(r.w); f[7] = bfhi(r.w); }
__device__ __forceinline__ v4u pack8(const float (&f)[8]) { v4u o; o.x = pk2(f[0], f[1]); o.y = pk2(f[2], f[3]); o.z = pk2(f[4], f[5]); o.w = pk2(f[6], f[7]); return o; }
__device__ __forceinline__ void prep_norm(Frame& F, int l) {
    const int gw = F.vcu * NWAVES + F.wave, NGW = F.G * NWAVES, lane = F.lane, sub = lane >> 3, ch = lane & 7;
    float gqa[8], gka[8], gqd[8], gkd[8];
#pragma unroll
    for (int e = 0; e < 8; ++e) { gqa[e] = F.kin[I_DQN][l * 64 + ch * 8 + e] * QSCALE; gka[e] = F.kin[I_DKN][l * 64 + ch * 8 + e];
                                  gqd[e] = F.kin[I_SQN][l * 64 + ch * 8 + e] * QSCALE; gkd[e] = F.kin[I_SKN][l * 64 + ch * 8 + e]; }
    const bf16* COLS = WSP(bf16, WS_COLS); bf16* QKA = WSP(bf16, WS_QKA); bf16* QKD = WSP(bf16, WS_QKD);
    for (int m = gw; m < M; m += NGW) {
        const bf16* src = COLS + (size_t)m * NMAIN;
#pragma unroll
        for (int i = 0; i < 4; ++i) { const int vec = i * 8 + sub, col = vec * 64 + ch * 8;
            float f[8]; unpack8(*(const v4u*)(src + CA_Q + col), f); float ss = 0.f;
#pragma unroll
            for (int e = 0; e < 8; ++e) ss += f[e] * f[e];
            ss = sum8(ss);
            const float rstd = rsqrtf(ss * (1.0f / 64.0f) + 1e-6f);
#pragma unroll
            for (int e = 0; e < 8; ++e) f[e] = f[e] * rstd * (i < 2 ? gqa[e] : gka[e]);
            *(v4u*)(QKA + (size_t)m * 2048 + col) = pack8(f); }
#pragma unroll
        for (int i = 0; i < 3; ++i) { const int vec = i * 8 + sub, col = vec * 64 + ch * 8;
            if (vec < 18) { float f[8]; unpack8(*(const v4u*)(src + CD_Q + col), f); float ss = 0.f;
#pragma unroll
                for (int e = 0; e < 8; ++e) ss += f[e] * f[e];
                ss = sum8(ss);
                const float rstd = rsqrtf(ss * (1.0f / 64.0f) + 1e-6f);
#pragma unroll
                for (int e = 0; e < 8; ++e) f[e] = f[e] * rstd * (vec < 16 ? gqd[e] : gkd[e]);
                *(v4u*)(QKD + (size_t)m * 1152 + col) = pack8(f); } }
    }
}
__device__ __forceinline__ void prep_loga(Frame& F, int l) {
    LAS float* gdl = (LAS float*)(F.lds + RING_OFF);
    float gu[16];
#pragma unroll
    for (int j = 0; j < 16; ++j) gu[j] = F.kin[I_GGU][((size_t)l * 16 + j) * 512 + F.tid];
    const float bias = F.kin[I_GGB][l * 512 + F.tid];
    const float* LOWR = WSP(float, WS_LOWR); float* LOGA = WSP(float, WS_LOGA);
    for (int tile = F.bx; tile < M / 64; tile += F.G) {
        const size_t row0 = (size_t)tile * 64;
        __syncthreads();
#pragma unroll
        for (int i = 0; i < 2; ++i) { const int idx = F.tid + 512 * i; gdl[idx] = LOWR[(row0 + (idx >> 4)) * 256 + (idx & 15)]; }
        __syncthreads();
#pragma unroll 4
        for (int t = 0; t < 64; ++t) { const LAS f32x4* gp = (const LAS f32x4*)(gdl + t * 16); const f32x4 g0 = gp[0], g1 = gp[1], g2 = gp[2], g3 = gp[3];
            float z = bias + g0.x * gu[0] + g0.y * gu[1] + g0.z * gu[2] + g0.w * gu[3] + g1.x * gu[4] + g1.y * gu[5] + g1.z * gu[6] + g1.w * gu[7]
                    + g2.x * gu[8] + g2.y * gu[9] + g2.z * gu[10] + g2.w * gu[11] + g3.x * gu[12] + g3.y * gu[13] + g3.z * gu[14] + g3.w * gu[15];
            LOGA[(row0 + t) * 512 + F.tid] = (fminf(z, 0.f) - __logf(1.0f + __expf(-fabsf(z)))) * (1.0f / 16.0f); }
    }
}
__device__ __forceinline__ int next_item(Frame& F, gu32* ctr) {
    volatile LAS int* slot = (volatile LAS int*)(F.lds + LDSCTL_OFF + 64);
    __syncthreads();
    if (F.tid == 0) *slot = (int)__hip_atomic_fetch_add(ctr, 1u, RLX_AGENT);
    __syncthreads();
    return *slot;
}
typedef float f32x16 __attribute__((ext_vector_type(16)));
__device__ __forceinline__ float xother32(float v) { unsigned a = __builtin_bit_cast(unsigned, v), b = a; asm volatile("" : "+v"(b)); auto rr = __builtin_amdgcn_permlane32_swap(a, b, false, false);
    const unsigned lo = rr[0], hi = rr[1]; return __builtin_bit_cast(float, (unsigned)((__builtin_amdgcn_mbcnt_hi(~0u, __builtin_amdgcn_mbcnt_lo(~0u, 0u)) & 32u) ? lo : hi)); }
__device__ __forceinline__ float xsum32(float v) { return v + xother32(v); }
__device__ __forceinline__ float xmax32(float v) { return fmaxf(v, xother32(v)); }
__device__ __forceinline__ int crow16(int r, int hi) { return (r & 3) + 8 * (r >> 2) + 4 * hi; }
template <bool ISA>
__device__ __forceinline__ void attn_unit(Frame& F, int l, int b, int hx, int qb) {
    constexpr int DV = ISA ? 128 : 64, NDV = DV / 32, KSTR = ISA ? 272 : 144, VSTR = 144, KBYTES = 64 * KSTR, VBYTES = DV * VSTR, BUFB = KBYTES + VBYTES, NCH = ISA ? 2 : 1;
    constexpr float NEG = -1e30f;
    LAS unsigned char* L = F.lds + RING_OFF;
    const int tid = F.tid, lane = F.lane, r32 = lane & 31, hi = lane >> 5, qs = F.wave & 3, grp = F.wave >> 2, q0 = qb * 128;
    const int kvh = hx >> 2, hd = kvh * 8 + (hx & 3) * 2 + grp;
    const bf16* Qp; const bf16* Kp; const bf16* VT; int ldq;
    if (ISA) { const bf16* QKA = WSP(bf16, WS_QKA); Qp = QKA + (size_t)b * SEQ * 2048 + hx * 128 + grp * 64; Kp = QKA + (size_t)b * SEQ * 2048 + 1024 + hx * 128; ldq = 2048; VT = WSP(bf16, WS_VTA) + (size_t)(b * 8 + hx) * 128 * VROW; }
    else { const bf16* QKD = WSP(bf16, WS_QKD); Qp = QKD + (size_t)b * SEQ * 1152 + hd * 64; Kp = QKD + (size_t)b * SEQ * 1152 + 1024 + kvh * 64; ldq = 1152; VT = WSP(bf16, WS_VTD) + (size_t)(b * 2 + kvh) * 64 * VROW; }
    const int qpos = q0 + 32 * qs + r32;
    bf16x8 qr[4];
#pragma unroll
    for (int d0 = 0; d0 < 4; ++d0) qr[d0] = *(const bf16x8*)(Qp + (size_t)qpos * ldq + d0 * 16 + hi * 8);
    LAS float* Bt = (LAS float*)(L + 2 * BUFB);
    { const float* TAB = WSP(float, WS_TAB);
      if (ISA) { if (tid < 130) Bt[tid] = tid == 0 ? NEG : (tid == 129 ? 0.f : TAB[hx * 128 + tid - 1] - TAB[hx * 128 + 127]); }
      else { if (tid < 260) { const int gi = tid >= 130, t = tid - 130 * gi; Bt[tid] = (t == 0 || t == 129) ? NEG : TAB[(8 + kvh * 8 + (hx & 3) * 2 + gi) * 128 + t - 1]; } } }
    const int TQ = q0 >> 6, T0 = ISA ? 0 : (TQ >= 2 ? TQ - 2 : 0), T1 = TQ + 1;
    v4u kreg[NCH], vreg[NCH];
#define AT_GLOAD(T) do { _Pragma("unroll") for (int i_ = 0; i_ < NCH; ++i_) { const int c_ = tid + 512 * i_; \
        const int kr_ = ISA ? (c_ >> 4) : (c_ >> 3), kc_ = ISA ? (c_ & 15) : (c_ & 7); kreg[i_] = *(const v4u*)(Kp + (size_t)((T) * 64 + kr_) * ldq + kc_ * 8); \
        const int vr_ = c_ >> 3, vc_ = c_ & 7; vreg[i_] = *(const v4u*)(VT + (size_t)vr_ * VROW + (T) * 64 + vc_ * 8); } } while (0)
#define AT_LWRITE(buf) do { _Pragma("unroll") for (int i_ = 0; i_ < NCH; ++i_) { const int c_ = tid + 512 * i_; \
        const int kr_ = ISA ? (c_ >> 4) : (c_ >> 3), kc_ = ISA ? (c_ & 15) : (c_ & 7); *(LAS v4u*)(L + (buf) * BUFB + kr_ * KSTR + kc_ * 16) = kreg[i_]; \
        const int vr_ = c_ >> 3, vc_ = c_ & 7; *(LAS v4u*)(L + (buf) * BUFB + KBYTES + vr_ * VSTR + vc_ * 16) = vreg[i_]; } } while (0)
    f32x16 o[NDV];
#pragma unroll
    for (int i = 0; i < NDV; ++i) o[i] = (f32x16){0.f, 0.f, 0.f, 0.f, 0.f, 0.f, 0.f, 0.f, 0.f, 0.f, 0.f, 0.f, 0.f, 0.f, 0.f, 0.f};
    float m_run = ISA ? NEG : F.kin[I_SSINK][l * 16 + hd] * LOG2E, l_run = ISA ? 0.f : (hi == 0 ? 1.f : 0.f);
    const int krow = (r32 & 16) | (r32 & 3) | ((r32 & 4) << 1) | ((r32 & 8) >> 1);
    const int koff = krow * KSTR + (ISA ? grp * 128 : 0) + hi * 16, voff = KBYTES + r32 * VSTR + hi * 16;
    AT_GLOAD(T0); AT_LWRITE(0); __syncthreads();
#pragma unroll 1
    for (int T = T0; T <= T1; ++T) {
        const int cur = (T - T0) & 1;
        AT_GLOAD(T < T1 ? T + 1 : T1);
        LAS const unsigned char* Kb = L + cur * BUFB;
        f32x16 s[2];
#pragma unroll
        for (int blk = 0; blk < 2; ++blk) { s[blk] = (f32x16){0.f, 0.f, 0.f, 0.f, 0.f, 0.f, 0.f, 0.f, 0.f, 0.f, 0.f, 0.f, 0.f, 0.f, 0.f, 0.f};
#pragma unroll
            for (int d0 = 0; d0 < 4; ++d0) { const bf16x8 kf = *(const LAS bf16x8*)(Kb + koff + blk * 32 * KSTR + d0 * 32); s[blk] = __builtin_amdgcn_mfma_f32_32x32x16_bf16(kf, qr[d0], s[blk], 0, 0, 0); } }
        if (!ISA || T >= TQ - 2) {
            const LAS float* bt = Bt + (ISA ? 0 : grp * 130) + 1; const int d0 = qpos - T * 64 - 8 * hi;
#pragma unroll
            for (int blk = 0; blk < 2; ++blk)
#pragma unroll
                for (int r = 0; r < 16; ++r) { const int dist = d0 - (32 * blk + 16 * (r >> 3) + (r & 7)); const int di = dist < -1 ? -1 : (dist > 128 ? 128 : dist); s[blk][r] += bt[di]; } }
        float mt = s[0][0];
#pragma unroll
        for (int r = 1; r < 16; ++r) mt = fmaxf(mt, s[0][r]);
#pragma unroll
        for (int r = 0; r < 16; ++r) mt = fmaxf(mt, s[1][r]);
        mt = xmax32(mt);
        const float m_new = fmaxf(m_run, mt);
        if (__any(m_new > m_run)) { const float alpha = __builtin_amdgcn_exp2f(m_run - m_new); l_run *= alpha;
#pragma unroll
            for (int i = 0; i < NDV; ++i)
#pragma unroll
                for (int r = 0; r < 16; ++r) o[i][r] *= alpha;
            m_run = m_new; }
        float ls = 0.f;
#pragma unroll
        for (int blk = 0; blk < 2; ++blk)
#pragma unroll
            for (int r = 0; r < 16; ++r) { const float pv_ = __builtin_amdgcn_exp2f(s[blk][r] - m_run); s[blk][r] = pv_; ls += pv_; }
        l_run += ls;
#pragma unroll
        for (int sl = 0; sl < 4; ++sl) { const int blk = sl >> 1, r0 = 8 * (sl & 1);
            v4u pw; pw.x = pg8::cvt_pk_bf16(s[blk][r0], s[blk][r0 + 1]); pw.y = pg8::cvt_pk_bf16(s[blk][r0 + 2], s[blk][r0 + 3]); pw.z = pg8::cvt_pk_bf16(s[blk][r0 + 4], s[blk][r0 + 5]); pw.w = pg8::cvt_pk_bf16(s[blk][r0 + 6], s[blk][r0 + 7]);
            const bf16x8 pf = __builtin_bit_cast(bf16x8, pw);
#pragma unroll
            for (int i = 0; i < NDV; ++i) { const bf16x8 vf = *(const LAS bf16x8*)(Kb + voff + i * 32 * VSTR + sl * 32); o[i] = __builtin_amdgcn_mfma_f32_32x32x16_bf16(vf, pf, o[i], 0, 0, 0); } }
        AT_LWRITE(cur ^ 1);
        __syncthreads();
    }
#undef AT_GLOAD
#undef AT_LWRITE
    const float inv = 1.0f / xsum32(l_run);
    bf16* MIX = WSP(bf16, WS_MIXED);
    if (ISA) {
        int ll_ = l; asm volatile("" : "+s"(ll_)); const float lam_init = ll_ == 0 ? 0.2f : 0.35550906759f;     float lam_full;
        { const float* lm = F.kin[I_DLAM] + (size_t)l * 256; const float s1 = wave_sum(lm[lane] * lm[64 + lane]), s2 = wave_sum(lm[128 + lane] * lm[192 + lane]); lam_full = __expf(s1) - __expf(s2) + lam_init; }
        LAS float* R1 = (LAS float*)L;
        LAS bf16* R2 = (LAS bf16*)(L + 66048);
        const int ql = 32 * qs + r32;
        if (grp == 1) {
#pragma unroll
            for (int i = 0; i < NDV; ++i)
#pragma unroll
                for (int r = 0; r < 16; ++r) R1[ql * 129 + 32 * i + crow16(r, hi)] = lam_full * inv * o[i][r]; }
        __syncthreads();
        if (grp == 0) { float ss = 0.f;
#pragma unroll
            for (int i = 0; i < NDV; ++i)
#pragma unroll
                for (int r = 0; r < 16; ++r) { const float d = o[i][r] * inv - R1[ql * 129 + 32 * i + crow16(r, hi)]; o[i][r] = d; ss += d * d; }
            const float rstd = rsqrtf(xsum32(ss) * (1.0f / 128.0f) + 1e-6f) * (1.0f - lam_init);
            const float* sl = F.kin[I_DSUB] + l * 128;
#pragma unroll
            for (int i = 0; i < NDV; ++i)
#pragma unroll
                for (int r = 0; r < 16; ++r) { const int dv = 32 * i + crow16(r, hi); R2[ql * 132 + dv] = (bf16)f2bf(o[i][r] * rstd * sl[dv]); } }
        __syncthreads();
#pragma unroll
        for (int i = 0; i < 4; ++i) { const int c = tid + 512 * i, row = c >> 4, ch = c & 15; const LAS v2u* sp = (const LAS v2u*)(R2 + row * 132 + ch * 8); const v2u a = sp[0], bb = sp[1];
            *(v4u*)(MIX + (size_t)(b * SEQ + q0 + row) * DM + hx * 128 + ch * 8) = (v4u){a.x, a.y, bb.x, bb.y}; }
    } else {
        LAS bf16* R = (LAS bf16*)L + F.wave * 2176;
#pragma unroll
        for (int i = 0; i < NDV; ++i)
#pragma unroll
            for (int r = 0; r < 16; ++r) R[r32 * 68 + 32 * i + crow16(r, hi)] = (bf16)f2bf(o[i][r] * inv);
#pragma unroll
        for (int i = 0; i < 4; ++i) { const int c = lane + 64 * i, row = c >> 3, ch = c & 7; const LAS v2u* sp = (const LAS v2u*)(R + row * 68 + ch * 8); const v2u a = sp[0], bb = sp[1];
            *(v4u*)(MIX + (size_t)(b * SEQ + q0 + 32 * qs + row) * DM + 3072 + hd * 64 + ch * 8) = (v4u){a.x, a.y, bb.x, bb.y}; }
    }
}
__device__ __forceinline__ void prep_gla(Frame& F) {
    LAS float* Lb = (LAS float*)(F.lds + RING_OFF); LAS float* Qd = Lb + 64 * 129; LAS float* Ki = Qd + 64 * 129; LAS bf16* Kt = (LAS bf16*)(Ki + 64 * 129);
    const bf16* COLS = WSP(bf16, WS_COLS); const float* LOGA = WSP(float, WS_LOGA);
    bf16* QDEC = WSP(bf16, WS_QDEC); bf16* KDT = WSP(bf16, WS_KDT); bf16* AMg = WSP(bf16, WS_AM); float* EBL = WSP(float, WS_EBL);
    for (int u = F.bx; u < 1024; u += F.G) {
        const int b = u >> 9, h = (u >> 7) & 3, ck = u & 127; const size_t row0 = (size_t)b * SEQ + ck * 64;
        __syncthreads();
        for (int idx = F.tid; idx < 8192; idx += NWAVES * 64) { const int t = idx >> 7, d = idx & 127; Lb[t * 129 + d] = LOGA[(row0 + t) * 512 + h * 128 + d]; }
        __syncthreads();
        if (F.tid < 128) { float acc = 0.f;
#pragma unroll 8
            for (int t = 0; t < 64; ++t) { acc += Lb[t * 129 + F.tid]; Lb[t * 129 + F.tid] = acc; }
            EBL[(size_t)u * 128 + F.tid] = __expf(acc); }
        __syncthreads();
        for (int idx = F.tid; idx < 8192; idx += NWAVES * 64) { const int t = idx >> 7, d = idx & 127; const float bt = Lb[t * 129 + d], bl = Lb[63 * 129 + d];
            const float q = bf2f(COLS[(row0 + t) * NMAIN + CB_Q + h * 128 + d]) * 0.08838834764831845f, k = bf2f(COLS[(row0 + t) * NMAIN + CB_K + h * 128 + d]);
            const float qd = q * __expf(bt); Qd[t * 129 + d] = qd; Ki[t * 129 + d] = k * __expf(-bt); Kt[d * 72 + t] = (bf16)f2bf(k * __expf(bl - bt));
            QDEC[((size_t)u * 64 + t) * 128 + d] = (bf16)f2bf(qd); }
        __syncthreads();
#pragma unroll
        for (int i = 0; i < 2; ++i) { const int c_ = F.tid + 512 * i, row = c_ >> 3, ch = c_ & 7; const LAS v2u* sp = (const LAS v2u*)(Kt + row * 72 + ch * 8); const v2u a = sp[0], bb = sp[1];
            *(v4u*)(KDT + ((size_t)u * 128 + row) * 64 + ch * 8) = (v4u){a.x, a.y, bb.x, bb.y}; }
        { const int c = F.tid >> 3, sg = F.tid & 7; float acc[8];
#pragma unroll
          for (int e = 0; e < 8; ++e) acc[e] = 0.f;
#pragma unroll 4
          for (int d = 0; d < 128; ++d) { const float q = Qd[c * 129 + d];
#pragma unroll
              for (int e = 0; e < 8; ++e) acc[e] += q * Ki[(sg * 8 + e) * 129 + d]; }
#pragma unroll
          for (int e = 0; e < 8; ++e) if (sg * 8 + e > c) acc[e] = 0.f;
          *(v4u*)(AMg + ((size_t)u * 64 + c) * 64 + sg * 8) = pack8(acc); }
    }
}
__device__ __forceinline__ void prep_vt(Frame& F, int pass) {
    LAS bf16* T = (LAS bf16*)(F.lds + RING_OFF);
    const bf16* COLS = WSP(bf16, WS_COLS);
    const int nch = pass == 0 ? 144 : 128, nvr = nch * 8;
    for (int tile = F.bx; tile < M / 32; tile += F.G) {
        const int b = tile >> 8, t0 = (tile & 255) * 32;
        __syncthreads();
        for (int idx = F.tid; idx < 32 * nch; idx += NWAVES * 64) { const int tok = idx / nch, ch = idx % nch;
            const int col = pass == 0 ? (ch < 128 ? CA_V + ch * 8 : CD_V + (ch - 128) * 8) : (pass == 1 ? CB_V + ch * 8 : CB_G + ch * 8);
            const v4u v = *(const v4u*)(COLS + (size_t)(b * SEQ + t0 + tok) * NMAIN + col); LAS v2u* d = (LAS v2u*)(T + tok * 1160 + ch * 8); d[0] = (v2u){v.x, v.y}; d[1] = (v2u){v.z, v.w}; }
        __syncthreads();
        for (int idx = F.tid; idx < nvr * 4; idx += NWAVES * 64) { const int ch = idx / nvr, vrow = idx % nvr;
            unsigned e[8];
#pragma unroll
            for (int k = 0; k < 8; ++k) e[k] = T[(ch * 8 + k) * 1160 + vrow];
            v4u o; o.x = e[0] | (e[1] << 16); o.y = e[2] | (e[3] << 16); o.z = e[4] | (e[5] << 16); o.w = e[6] | (e[7] << 16);
            bf16* dst;
            if (pass == 0) dst = vrow < 1024 ? WSP(bf16, WS_VTA) + ((size_t)(b * 8 + (vrow >> 7)) * 128 + (vrow & 127)) * VROW : WSP(bf16, WS_VTD) + ((size_t)(b * 2 + ((vrow - 1024) >> 6)) * 64 + ((vrow - 1024) & 63)) * VROW;
            else dst = WSP(bf16, WS_VTB) + ((size_t)b * 1024 + vrow) * VROW;
            *(v4u*)(dst + t0 + ch * 8) = o; }
    }
}
typedef float f32x4v __attribute__((ext_vector_type(4)));
__device__ __forceinline__ float sum16(float v) { v = sum8(v); v += dpp_f<0x140>(v); return v; }
#define LDS_BARRIER() asm volatile("s_waitcnt lgkmcnt(0)\n\ts_barrier" ::: "memory")
template <int HACK = 0> __device__ __forceinline__ void gla_scan_unit(Frame& F, int l, int b, int h) {
    LAS unsigned char* L = F.lds + RING_OFF;
    constexpr int OQD = 0, OKT = 17408, OAM = 35840, OVT = 45056, OOT = 81920, OEB = 115712, OPS = 116224;
    const int tid = F.tid, lane = F.lane, n = lane & 15, g = lane >> 4, w = F.wave;
    const bf16* QDEC = WSP(bf16, WS_QDEC); const bf16* KDT = WSP(bf16, WS_KDT); const bf16* AMg = WSP(bf16, WS_AM); const float* EBL = WSP(float, WS_EBL);
    const bf16* VTB = WSP(bf16, WS_VTB) + (size_t)(b * 4 + h) * 256 * VROW; const bf16* COLS = WSP(bf16, WS_COLS); bf16* MIX = WSP(bf16, WS_MIXED);
    f32x4v S[8][2];
#pragma unroll
    for (int dt = 0; dt < 8; ++dt)
#pragma unroll
        for (int vt = 0; vt < 2; ++vt) S[dt][vt] = (f32x4v){0.f, 0.f, 0.f, 0.f};
    float gain8[8];
#pragma unroll
    for (int e = 0; e < 8; ++e) gain8[e] = F.kin[I_GON][l * 256 + (tid & 31) * 8 + e];
    v4u pq[2], pk[2], pa, pv[4]; float pe = 0.f;
#define GL_ISSUE(CK) do { const size_t u_ = (size_t)(b * 4 + h) * 128 + (CK); \
        _Pragma("unroll") for (int i = 0; i < 2; ++i) { const int c_ = tid + 512 * i; pq[i] = *(const v4u*)(QDEC + (u_ * 64 + (c_ >> 4)) * 128 + (c_ & 15) * 8); pk[i] = *(const v4u*)(KDT + (u_ * 128 + (c_ >> 3)) * 64 + (c_ & 7) * 8); } \
        pa = *(const v4u*)(AMg + (u_ * 64 + (tid >> 3)) * 64 + (tid & 7) * 8); \
        _Pragma("unroll") for (int i = 0; i < 4; ++i) { const int c_ = tid + 512 * i; pv[i] = *(const v4u*)(VTB + (size_t)(c_ >> 3) * VROW + (CK) * 64 + (c_ & 7) * 8); } \
        pe = EBL[u_ * 128 + (tid & 127)]; } while (0)
#define GL_WRITE() do { _Pragma("unroll") for (int i = 0; i < 2; ++i) { const int c_ = tid + 512 * i; *(LAS v4u*)(L + OQD + (c_ >> 4) * 272 + (c_ & 15) * 16) = pq[i]; *(LAS v4u*)(L + OKT + (c_ >> 3) * 144 + (c_ & 7) * 16) = pk[i]; } \
        *(LAS v4u*)(L + OAM + (tid >> 3) * 144 + (tid & 7) * 16) = pa; \
        _Pragma("unroll") for (int i = 0; i < 4; ++i) { const int c_ = tid + 512 * i; *(LAS v4u*)(L + OVT + (c_ >> 3) * 144 + (c_ & 7) * 16) = pv[i]; } \
        ((LAS float*)(L + OEB))[tid & 127] = pe; } while (0)
    GL_ISSUE(0); GL_WRITE();
    LDS_BARRIER();
#pragma unroll 1
    for (int ck = 0; ck < 128; ++ck) {
        const size_t row0 = (size_t)b * SEQ + ck * 64;
        v4u gq[4];
#pragma unroll
        for (int i = 0; i < 4; ++i) gq[i] = (HACK & 1) ? (v4u){0u, 0u, 0u, 0u} : *(const v4u*)(COLS + (row0 + (tid >> 5) + 16 * i) * NMAIN + CB_G + h * 256 + (tid & 31) * 8);
        GL_ISSUE((HACK & 1) && ck >= 2 ? 2 : (ck + 1 < 128 ? ck + 1 : 127));
        bf16x8 vf[2][2];
#pragma unroll
        for (int vt = 0; vt < 2; ++vt)
#pragma unroll
            for (int ks = 0; ks < 2; ++ks) vf[vt][ks] = *(const LAS bf16x8*)(L + OVT + (32 * w + 16 * vt + n) * 144 + (32 * ks + 8 * g) * 2);
        f32x4v o[4][2];
#pragma unroll
        for (int ct = 0; ct < 4; ++ct)
#pragma unroll
            for (int vt = 0; vt < 2; ++vt) o[ct][vt] = (f32x4v){0.f, 0.f, 0.f, 0.f};
#pragma unroll
        for (int ct = 0; ct < 4; ++ct)
#pragma unroll
            for (int ks = 0; ks < 2; ++ks) { const bf16x8 af = *(const LAS bf16x8*)(L + OAM + (16 * ct + n) * 144 + (32 * ks + 8 * g) * 2);
#pragma unroll
                for (int vt = 0; vt < 2; ++vt) o[ct][vt] = __builtin_amdgcn_mfma_f32_16x16x32_bf16(af, vf[vt][ks], o[ct][vt], 0, 0, 0); }
#pragma unroll
        for (int kk = 0; kk < 4; ++kk) { bf16x8 sf[2];
#pragma unroll
            for (int vt = 0; vt < 2; ++vt) { v4u pw; pw.x = pg8::cvt_pk_bf16(S[2 * kk][vt][0], S[2 * kk][vt][1]); pw.y = pg8::cvt_pk_bf16(S[2 * kk][vt][2], S[2 * kk][vt][3]);
                pw.z = pg8::cvt_pk_bf16(S[2 * kk + 1][vt][0], S[2 * kk + 1][vt][1]); pw.w = pg8::cvt_pk_bf16(S[2 * kk + 1][vt][2], S[2 * kk + 1][vt][3]); sf[vt] = __builtin_bit_cast(bf16x8, pw); }
#pragma unroll
            for (int ct = 0; ct < 4; ++ct) { const LAS unsigned char* qp = L + OQD + (16 * ct + n) * 272 + (32 * kk + 4 * g) * 2; const v2u qa = *(const LAS v2u*)qp, qb = *(const LAS v2u*)(qp + 32);
                const bf16x8 qf = __builtin_bit_cast(bf16x8, (v4u){qa.x, qa.y, qb.x, qb.y});
#pragma unroll
                for (int vt = 0; vt < 2; ++vt) o[ct][vt] = __builtin_amdgcn_mfma_f32_16x16x32_bf16(qf, sf[vt], o[ct][vt], 0, 0, 0); } }
#pragma unroll
        for (int dt = 0; dt < 8; ++dt) { const f32x4v eb = *(const LAS f32x4v*)(L + OEB + (16 * dt + 4 * g) * 4);
#pragma unroll
            for (int vt = 0; vt < 2; ++vt) S[dt][vt] = S[dt][vt] * eb;
#pragma unroll
            for (int ks = 0; ks < 2; ++ks) { const bf16x8 kf = *(const LAS bf16x8*)(L + OKT + (16 * dt + n) * 144 + (32 * ks + 8 * g) * 2);
#pragma unroll
                for (int vt = 0; vt < 2; ++vt) S[dt][vt] = __builtin_amdgcn_mfma_f32_16x16x32_bf16(kf, vf[vt][ks], S[dt][vt], 0, 0, 0); } }
        LAS float* PS = (LAS float*)(L + OPS) + (ck & 1) * 512;
#pragma unroll
        for (int ct = 0; ct < 4; ++ct)
#pragma unroll
            for (int r = 0; r < 4; ++r) { const float ss = sum16(o[ct][0][r] * o[ct][0][r] + o[ct][1][r] * o[ct][1][r]); if (n == 0) PS[(16 * ct + 4 * g + r) * 8 + w] = ss; }
        LDS_BARRIER();
        GL_WRITE();
#pragma unroll
        for (int ct = 0; ct < 4; ++ct)
#pragma unroll
            for (int vt = 0; vt < 2; ++vt)
#pragma unroll
                for (int r = 0; r < 4; ++r) *(LAS bf16*)(L + OOT + (16 * ct + 4 * g + r) * 528 + (32 * w + 16 * vt + n) * 2) = (bf16)f2bf(o[ct][vt][r]);
        LDS_BARRIER();
#pragma unroll
        for (int i = 0; i < 4; ++i) { const int tok = (tid >> 5) + 16 * i; float ov[8], gv[8]; unpack8(*(const LAS v4u*)(L + OOT + tok * 528 + (tid & 31) * 16), ov); unpack8(gq[i], gv);
            const LAS f32x4v* pp = (const LAS f32x4v*)(PS + tok * 8); const f32x4v p0 = pp[0], p1 = pp[1];
            const float rstd = rsqrtf(((p0.x + p0.y) + (p0.z + p0.w) + (p1.x + p1.y) + (p1.z + p1.w)) * (1.0f / 256.0f) + 1e-6f);
#pragma unroll
            for (int e = 0; e < 8; ++e) ov[e] = ov[e] * (rstd * gain8[e]) * silu_g(gv[e]);
            if (!(HACK & 2)) *(v4u*)(MIX + (row0 + tok) * DM + 1024 + h * 256 + (tid & 31) * 8) = pack8(ov); }
    }
#undef GL_ISSUE
#undef GL_WRITE
}
constexpr int RC_AT = 0, RC_RT = 2048, RC_BK = 4096, RC_VF = 8192, RC_GF = 10240, RC_U0 = 12288, RC_Y0 = 16384, RC_P15 = 20480, RC_BN = 20736, RC_BYTES = 20800;
__device__ __forceinline__ void rwkv_chunks_of_tile(Frame& F, int l, int tile) {
    const int team = F.tid >> 8, tt = F.tid & 255;
    LAS float* Lt = (LAS float*)(F.lds + RING_OFF) + team * 12288;
    LAS float* XA = Lt; LAS float* XR = Lt + 1040; LAS float* ZB = Lt + 2080; LAS float* ZK = Lt + 3120; LAS float* TB = Lt + 4160; LAS float* TK = Lt + 5200; LAS float* VV = Lt + 6240;
    LAS float* ATl = Lt + 7280; LAS float* U0l = Lt + 8320; LAS float* W1 = Lt + 9360;
    LAS float* Aab = Lt + 10400; LAS float* Aak = Lt + 10672; LAS float* Arb = Lt + 10944; LAS float* Ark = Lt + 11216; LAS float* TT = Lt + 11488;
    const float* RW = WSP(float, WS_RW); constexpr size_t RS = RW_ONE / 4; unsigned char* RWC = F.ws + WS_RWC;
    float pw_[16], pr_[4], pk_[4], pv_[4], pa_[4], pb_[4], pg_[4];
#define RC_FETCH(P) do { const int h_ = 2 * (P) + team; const size_t cb_ = (size_t)tile * 16 * 1024 + h_ * 64 + (tt & 63); \
        _Pragma("unroll") for (int t = 0; t < 16; ++t) pw_[t] = RW[RS + cb_ + (size_t)t * 1024]; \
        _Pragma("unroll") for (int e = 0; e < 4; ++e) { const size_t o_ = cb_ + (size_t)(4 * (tt >> 6) + e) * 1024; pr_[e] = RW[o_]; pk_[e] = RW[2 * RS + o_]; pv_[e] = RW[3 * RS + o_]; pa_[e] = RW[4 * RS + o_]; pb_[e] = RW[5 * RS + o_]; pg_[e] = RW[6 * RS + o_]; } } while (0)
    RC_FETCH(0);
#pragma unroll 1
    for (int pair = 0; pair < 8; ++pair) {
        const int uc = ((tile >> 9) * 16 + 2 * pair + team) * 512 + (tile & 511), b = uc >> 13, h = (uc >> 9) & 15, ck = uc & 511; unsigned char* rec = RWC + ((size_t)ck * 32 + (uc >> 9)) * RC_BYTES;     (void)b;
        __syncthreads();
        {
          const int j = tt & 63, q = tt >> 6;
          float cl = 0.f, clq[4] = {0.f, 0.f, 0.f, 0.f}, clm = 0.f;
#pragma unroll
          for (int t = 0; t < 16; ++t) { const float lw = __logf(pw_[t]); if (t == 4 * q) clm = cl; cl += lw; if ((t >> 2) == q) clq[t & 3] = cl; }
#pragma unroll
          for (int e = 0; e < 4; ++e) { const int t = 4 * q + e; const float cprev = e == 0 ? clm : clq[e - 1], cc = clq[e];
              const float rr = pr_[e], kk = pk_[e], vv = pv_[e], aa = pa_[e], bb = pb_[e];
              XA[t * 65 + j] = aa * __expf(cprev); XR[t * 65 + j] = rr * __expf(cc); const float ei = __expf(-cc), ef = __expf(cl - cc);
              ZB[t * 65 + j] = bb * ei; ZK[t * 65 + j] = kk * ei; TB[t * 65 + j] = bb * ef; TK[t * 65 + j] = kk * ef; VV[t * 65 + j] = vv; }
          if (q == 0) ((float*)(rec + RC_P15))[j] = __expf(cl);
          { v2u gw; gw.x = pk2(pg_[0], pg_[1]); gw.y = pk2(pg_[2], pg_[3]); *(v2u*)(rec + RC_GF + (((j >> 4) * 64 + 16 * q + (j & 15)) * 8)) = gw; } }
        RC_FETCH(pair < 7 ? pair + 1 : 7);
        __syncthreads();
        {
          const int q = tt >> 6, n = tt & 15, g = (tt >> 4) & 3; const LAS float* X = (q & 2) ? XR : XA; const LAS float* Z = (q & 1) ? ZK : ZB; LAS float* O = q == 0 ? Aab : (q == 1 ? Aak : (q == 2 ? Arb : Ark));
          f32x4v c = (f32x4v){0.f, 0.f, 0.f, 0.f};
#pragma unroll
          for (int ks = 0; ks < 16; ++ks) c = __builtin_amdgcn_mfma_f32_16x16x4f32(X[n * 65 + 4 * ks + g], Z[n * 65 + 4 * ks + g], c, 0, 0, 0);
#pragma unroll
          for (int rr = 0; rr < 4; ++rr) { const int t = 4 * g + rr; O[t * 17 + n] = ((q & 2) ? n <= t : n < t) ? c[rr] : 0.f; }
          { const int t = tt >> 4, jq = tt & 15; const float* rkp = F.kin[I_RRK] + l * 1024 + h * 64 + 4 * jq; float bn = 0.f;
#pragma unroll
            for (int e = 0; e < 4; ++e) bn += XR[t * 65 + 4 * jq + e] * ZK[t * 65 + 4 * jq + e] * rkp[e];
            bn = sum16(bn); if (jq == 0) ((float*)(rec + RC_BN))[t] = bn; } }
        __syncthreads();
        {
          if (tt < 16) { float col[16];
#pragma unroll
              for (int t = 0; t < 16; ++t) { float acc = (t == tt) ? 1.f : 0.f;
#pragma unroll
                  for (int s = 0; s < 16; ++s) if (s < t) acc += Aab[t * 17 + s] * col[s];
                  col[t] = acc; TT[t * 17 + tt] = acc; } }
          const int q = tt >> 6, n = tt & 15, g = (tt >> 4) & 3; f32x4v c = (f32x4v){0.f, 0.f, 0.f, 0.f};
#pragma unroll
          for (int ks = 0; ks < 4; ++ks) c = __builtin_amdgcn_mfma_f32_16x16x4f32(Aak[n * 17 + 4 * ks + g], VV[(4 * ks + g) * 65 + 16 * q + n], c, 0, 0, 0);
#pragma unroll
          for (int rr = 0; rr < 4; ++rr) W1[(4 * g + rr) * 65 + 16 * q + n] = c[rr]; }
        __syncthreads();
        {
          const int q = tt >> 6, n = tt & 15, g = (tt >> 4) & 3; f32x4v ca = (f32x4v){0.f, 0.f, 0.f, 0.f}, cu = (f32x4v){0.f, 0.f, 0.f, 0.f};
#pragma unroll
          for (int ks = 0; ks < 4; ++ks) { const float tv = TT[n * 17 + 4 * ks + g]; ca = __builtin_amdgcn_mfma_f32_16x16x4f32(tv, XA[(4 * ks + g) * 65 + 16 * q + n], ca, 0, 0, 0); cu = __builtin_amdgcn_mfma_f32_16x16x4f32(tv, W1[(4 * ks + g) * 65 + 16 * q + n], cu, 0, 0, 0); }
#pragma unroll
          for (int rr = 0; rr < 4; ++rr) { ATl[(4 * g + rr) * 65 + 16 * q + n] = ca[rr]; U0l[(4 * g + rr) * 65 + 16 * q + n] = cu[rr]; }
          *(f32x4v*)(rec + RC_U0 + ((q * 64 + 16 * g + n) * 16)) = cu; }
        __syncthreads();
        {
          const int q = tt >> 6, n = tt & 15, g = (tt >> 4) & 3; f32x4v cr, cy = (f32x4v){0.f, 0.f, 0.f, 0.f};
#pragma unroll
          for (int rr = 0; rr < 4; ++rr) cr[rr] = XR[(4 * g + rr) * 65 + 16 * q + n];
#pragma unroll
          for (int ks = 0; ks < 4; ++ks) { const float arb = Arb[n * 17 + 4 * ks + g], ark = Ark[n * 17 + 4 * ks + g];
              cr = __builtin_amdgcn_mfma_f32_16x16x4f32(arb, ATl[(4 * ks + g) * 65 + 16 * q + n], cr, 0, 0, 0);
              cy = __builtin_amdgcn_mfma_f32_16x16x4f32(arb, U0l[(4 * ks + g) * 65 + 16 * q + n], cy, 0, 0, 0);
              cy = __builtin_amdgcn_mfma_f32_16x16x4f32(ark, VV[(4 * ks + g) * 65 + 16 * q + n], cy, 0, 0, 0); }
          *(f32x4v*)(rec + RC_Y0 + ((q * 64 + 16 * g + n) * 16)) = cy;
#pragma unroll
          for (int rr = 0; rr < 4; ++rr) W1[(4 * g + rr) * 65 + 16 * q + n] = cr[rr]; }
        __syncthreads();
        { const int t = tt & 15, jq = tt >> 4, kk = jq >> 3, half = (jq & 7) >> 2, g = jq & 3, j0 = 4 * jq;
          v2u wa, wr; wa.x = pk2(ATl[t * 65 + j0], ATl[t * 65 + j0 + 1]); wa.y = pk2(ATl[t * 65 + j0 + 2], ATl[t * 65 + j0 + 3]); wr.x = pk2(W1[t * 65 + j0], W1[t * 65 + j0 + 1]); wr.y = pk2(W1[t * 65 + j0 + 2], W1[t * 65 + j0 + 3]);
          *(v2u*)(rec + RC_AT + kk * 1024 + (16 * g + t) * 16 + half * 8) = wa; *(v2u*)(rec + RC_RT + kk * 1024 + (16 * g + t) * 16 + half * 8) = wr;
          const int j = tt & 63, gg = tt >> 6; v4u bk; bk.x = pk2(TB[(4 * gg) * 65 + j], TB[(4 * gg + 1) * 65 + j]); bk.y = pk2(TB[(4 * gg + 2) * 65 + j], TB[(4 * gg + 3) * 65 + j]);
          bk.z = pk2(TK[(4 * gg) * 65 + j], TK[(4 * gg + 1) * 65 + j]); bk.w = pk2(TK[(4 * gg + 2) * 65 + j], TK[(4 * gg + 3) * 65 + j]);
          *(v4u*)(rec + RC_BK + (j >> 4) * 1024 + (16 * gg + (j & 15)) * 16) = bk;
          v2u vf; vf.x = pk2(VV[(4 * gg) * 65 + j], VV[(4 * gg + 1) * 65 + j]); vf.y = pk2(VV[(4 * gg + 2) * 65 + j], VV[(4 * gg + 3) * 65 + j]);
          *(v2u*)(rec + RC_VF + ((j >> 4) * 64 + 16 * gg + (j & 15)) * 8) = vf; }
    }
}
#undef RC_FETCH
template <int HACK = 0> __device__ __forceinline__ void rwkv_scan_unit(Frame& F, int l, int b, int h) {
    LAS unsigned char* L = F.lds + RING_OFF;
    const unsigned char* recs = F.ws + WS_RWC + (size_t)(b * 16 + h) * RC_BYTES;
    const int lane = F.lane, n = lane & 15, g = lane >> 4;
    LAS float* XS = (LAS float*)(L + 2 * RC_BYTES);
    if (F.wave >= 2) {
        const int li = F.tid - 128;
        int px[4];
#pragma unroll
        for (int k = 0; k < 4; ++k) { const int x = li + 384 * k; px[k] = x < 1300 ? x : 1299; }
        v4u p0[4], p1[4], p2[4], p3[4], p4[4], p5[4], p6[4], p7[4];
#define RWL_ISSUE(P, CK) do { const int ck_ = (CK) < 512 ? ((HACK & 1) && (CK) >= 4 ? 3 : (CK)) : 511; const v4u* src_ = (const v4u*)(recs + (size_t)ck_ * 32 * RC_BYTES); \
        _Pragma("unroll") for (int k = 0; k < 4; ++k) P[k] = src_[px[k]]; } while (0)
#define RWL_WRITE(P, CK) do { LAS v4u* dst_ = (LAS v4u*)(L + ((CK) & 1) * RC_BYTES); _Pragma("unroll") for (int k = 0; k < 4; ++k) dst_[px[k]] = P[k]; } while (0)
        RWL_ISSUE(p0, 0); RWL_ISSUE(p1, 1); RWL_ISSUE(p2, 2); RWL_ISSUE(p3, 3); RWL_ISSUE(p4, 4); RWL_ISSUE(p5, 5); RWL_ISSUE(p6, 6); RWL_ISSUE(p7, 7);
        RWL_WRITE(p0, 0); RWL_ISSUE(p0, 8);
        LDS_BARRIER();
#pragma unroll 1
        for (int ck = 0; ck < 512; ck += 8) {
            RWL_WRITE(p1, ck + 1); RWL_ISSUE(p1, ck + 9); LDS_BARRIER();
            RWL_WRITE(p2, ck + 2); RWL_ISSUE(p2, ck + 10); LDS_BARRIER();
            RWL_WRITE(p3, ck + 3); RWL_ISSUE(p3, ck + 11); LDS_BARRIER();
            RWL_WRITE(p4, ck + 4); RWL_ISSUE(p4, ck + 12); LDS_BARRIER();
            RWL_WRITE(p5, ck + 5); RWL_ISSUE(p5, ck + 13); LDS_BARRIER();
            RWL_WRITE(p6, ck + 6); RWL_ISSUE(p6, ck + 14); LDS_BARRIER();
            RWL_WRITE(p7, ck + 7); RWL_ISSUE(p7, ck + 15); LDS_BARRIER();
            RWL_WRITE(p0, ck + 8); RWL_ISSUE(p0, ck + 16); LDS_BARRIER();
        }
#undef RWL_ISSUE
#undef RWL_WRITE
        return;
    }
    const int cw = F.wave;
    f32x4v S[4][2];
#pragma unroll
    for (int jt = 0; jt < 4; ++jt)
#pragma unroll
        for (int it = 0; it < 2; ++it) S[jt][it] = (f32x4v){0.f, 0.f, 0.f, 0.f};
    float lnw[2], lnb[2];
#pragma unroll
    for (int it = 0; it < 2; ++it) { lnw[it] = F.kin[I_RLNW][l * 1024 + h * 64 + 16 * (2 * cw + it) + n]; lnb[it] = F.kin[I_RLNB][l * 1024 + h * 64 + 16 * (2 * cw + it) + n]; }
    bf16* MIX = WSP(bf16, WS_MIXED) + ((size_t)b * SEQ) * DM + 2048 + h * 64 + 32 * cw + n;
    f32x4v Yp[2] = {(f32x4v){0.f, 0.f, 0.f, 0.f}, (f32x4v){0.f, 0.f, 0.f, 0.f}}, bnp = (f32x4v){0.f, 0.f, 0.f, 0.f}; v2u gfp[2] = {(v2u){0u, 0u}, (v2u){0u, 0u}}, vfp[2] = {(v2u){0u, 0u}, (v2u){0u, 0u}};
    LDS_BARRIER();
#pragma unroll 1
    for (int ck = 0; ck <= 512; ++ck) {
        if (ck > 0) {
            const LAS float* xs = XS + ((ck - 1) & 1) * 64; const f32x4v a0 = *(const LAS f32x4v*)(xs + 8 * g), a1 = *(const LAS f32x4v*)(xs + 8 * g + 4), b0 = *(const LAS f32x4v*)(xs + 32 + 8 * g), b1 = *(const LAS f32x4v*)(xs + 32 + 8 * g + 4);
            const float s1[4] = {a0[0] + b0[0], a0[2] + b0[2], a1[0] + b1[0], a1[2] + b1[2]}, s2[4] = {a0[1] + b0[1], a0[3] + b0[3], a1[1] + b1[1], a1[3] + b1[3]};
#pragma unroll
            for (int it = 0; it < 2; ++it) { const float gt[4] = {bflo(gfp[it].x), bfhi(gfp[it].x), bflo(gfp[it].y), bfhi(gfp[it].y)}, vt[4] = {bflo(vfp[it].x), bfhi(vfp[it].x), bflo(vfp[it].y), bfhi(vfp[it].y)};
#pragma unroll
                for (int r = 0; r < 4; ++r) { const float mean = s1[r] * (1.0f / 64.0f), var = fmaxf(s2[r] * (1.0f / 64.0f) - mean * mean, 0.f), rstd = rsqrtf(var + 64e-5f);
                    if (!(HACK & 2)) MIX[(size_t)((ck - 1) * 16 + 4 * g + r) * DM + 16 * it] = (bf16)f2bf(((Yp[it][r] - mean) * rstd * lnw[it] + lnb[it] + bnp[r] * vt[r]) * gt[r]); } }
            if (ck == 512) break;
        }
        if (HACK & 4) { LDS_BARRIER(); continue; }
        const LAS unsigned char* R = L + (ck & 1) * RC_BYTES;
        bf16x8 at[2], rt[2];
#pragma unroll
        for (int kk = 0; kk < 2; ++kk) { at[kk] = *(const LAS bf16x8*)(R + RC_AT + kk * 1024 + lane * 16); rt[kk] = *(const LAS bf16x8*)(R + RC_RT + kk * 1024 + lane * 16); }
        f32x4v U[2], Y[2];
#pragma unroll
        for (int it = 0; it < 2; ++it) { U[it] = *(const LAS f32x4v*)(R + RC_U0 + (2 * cw + it) * 1024 + lane * 16); Y[it] = *(const LAS f32x4v*)(R + RC_Y0 + (2 * cw + it) * 1024 + lane * 16); }
#pragma unroll
        for (int kk = 0; kk < 2; ++kk)
#pragma unroll
            for (int it = 0; it < 2; ++it) { v4u pw; pw.x = pg8::cvt_pk_bf16(S[2 * kk][it][0], S[2 * kk][it][1]); pw.y = pg8::cvt_pk_bf16(S[2 * kk][it][2], S[2 * kk][it][3]);
                pw.z = pg8::cvt_pk_bf16(S[2 * kk + 1][it][0], S[2 * kk + 1][it][1]); pw.w = pg8::cvt_pk_bf16(S[2 * kk + 1][it][2], S[2 * kk + 1][it][3]); const bf16x8 sf = __builtin_bit_cast(bf16x8, pw);
                U[it] = __builtin_amdgcn_mfma_f32_16x16x32_bf16(at[kk], sf, U[it], 0, 0, 0); Y[it] = __builtin_amdgcn_mfma_f32_16x16x32_bf16(rt[kk], sf, Y[it], 0, 0, 0); }
        bf16x8 uv[2];
#pragma unroll
        for (int it = 0; it < 2; ++it) { vfp[it] = *(const LAS v2u*)(R + RC_VF + (2 * cw + it) * 512 + lane * 8); gfp[it] = *(const LAS v2u*)(R + RC_GF + (2 * cw + it) * 512 + lane * 8);
            v4u pw; pw.x = pg8::cvt_pk_bf16(U[it][0], U[it][1]); pw.y = pg8::cvt_pk_bf16(U[it][2], U[it][3]); pw.z = vfp[it].x; pw.w = vfp[it].y; uv[it] = __builtin_bit_cast(bf16x8, pw); }
#pragma unroll
        for (int jt = 0; jt < 4; ++jt) { const bf16x8 bk = *(const LAS bf16x8*)(R + RC_BK + jt * 1024 + lane * 16); const f32x4v p15 = *(const LAS f32x4v*)(R + RC_P15 + (16 * jt + 4 * g) * 4);
#pragma unroll
            for (int it = 0; it < 2; ++it) S[jt][it] = __builtin_amdgcn_mfma_f32_16x16x32_bf16(bk, uv[it], S[jt][it] * p15, 0, 0, 0); }
        bnp = *(const LAS f32x4v*)(R + RC_BN + 16 * g); Yp[0] = Y[0]; Yp[1] = Y[1];
        { LAS float* xo = XS + (ck & 1) * 64 + cw * 32; const f32x4v sm = Y[0] + Y[1], sq = Y[0] * Y[0] + Y[1] * Y[1];
#pragma unroll
          for (int r = 0; r < 4; ++r) { const float a = sum16(sm[r]), q = sum16(sq[r]); if (n == 0) { xo[(4 * g + r) * 2] = a; xo[(4 * g + r) * 2 + 1] = q; } } }
        LDS_BARRIER();
    }
}
template <int HACK = 0> __device__ __forceinline__ void mixers_v4(Frame& F, int l, int qi, int mask = 15) {
    gu32* ctr = F.ctl + CW_Q + 64 * qi;
    for (;;) {
        const int it = next_item(F, ctr); relaunder(F); relaunder_tid(F);
        if (it < 32) { if (mask & 1) rwkv_scan_unit<HACK>(F, l, it >> 4, it & 15); }
        else if (it < 40) { const int j = it - 32; if (mask & 2) gla_scan_unit<HACK>(F, l, j >> 2, j & 3); }
        else if (it < 40 + 1024) { const int j = it - 40, qb = 63 - (j >> 4), bh = j & 15; if (mask & 4) attn_unit<true>(F, l, bh >> 3, bh & 7, qb); }
        else if (it < 40 + 2048) { const int j = it - 1064, qb = j & 63, bh = j >> 6; if (mask & 8) attn_unit<false>(F, l, bh >> 3, bh & 7, qb); }
        else break;
    }
}
template <int HACK = 0> __device__ __forceinline__ void prep_rwkv(Frame& F, int l) {
    LAS float* wst = (LAS float*)(F.lds + RING_OFF) + 4096;
    LAS float* in = (LAS float*)(F.lds + RING_OFF);
    const float* mu = F.kin[I_RMU] + (size_t)l * 3264;
    const float* LOWR = WSP(float, WS_LOWR); const bf16* COLS = WSP(bf16, WS_COLS);
    float* RW = WSP(float, WS_RW); float* VF = WSP(float, WS_VFIRST);
    constexpr size_t RS = RW_ONE / 4;
    for (int tile = F.bx; tile < M / 16; tile += F.G) {
        const int row0 = tile * 16;
        __syncthreads();
        for (int idx = F.tid; idx < 16 * 224; idx += NWAVES * 64) { const int tt = idx / 224, j = idx % 224, row = row0 + tt, t = row & (SEQ - 1);
            const int col = j < 192 ? 16 + j : 208 + (j - 192);
            const float cur = LOWR[(size_t)row * 256 + col], prev = t > 0 ? LOWR[(size_t)(row - 1) * 256 + col] : 0.f;
            const float muv = j < 192 ? mu[3072 + j] : (l ? F.kin[I_VRMU][(l - 1) * 32 + (j - 192)] : 0.f);
            float x = cur + (prev - cur) * muv;
            if (j < 64) x = tanhf(x); else if (j >= 128 && j < 192) x = sigmoid_f(x);
            in[j * 16 + tt] = x; }
        __syncthreads();
#pragma unroll 1
        for (int pass = 0; pass < 2; ++pass) {
            const int c = pass * 512 + F.tid;
            float accw[16], acca[16], accg[16], accv[16];
            { const float bw = F.kin[I_RW0][l * 1024 + c], ba = F.kin[I_RA0][l * 1024 + c], bv = l ? F.kin[I_VR0][(l - 1) * 1024 + c] : 0.f;
#pragma unroll
              for (int tt = 0; tt < 16; ++tt) { accw[tt] = bw; acca[tt] = ba; accg[tt] = 0.f; accv[tt] = bv; } }
#define LOWRANK_ACC(ACC, WPTR, JOFF, NJ) do { const float* wp_ = (WPTR) + c; float nx_[16]; \
            _Pragma("unroll") for (int j_ = 0; j_ < 16; ++j_) nx_[j_] = wp_[(size_t)j_ * 1024]; \
            _Pragma("unroll 1") for (int jb = 0; jb < (NJ) / 16; ++jb) { LAS float* wl_ = wst + (jb & 1) * 8192 + F.tid; \
                _Pragma("unroll") for (int j_ = 0; j_ < 16; ++j_) wl_[j_ * 512] = nx_[j_]; \
                if (jb + 1 < (NJ) / 16) { _Pragma("unroll") for (int j_ = 0; j_ < 16; ++j_) nx_[j_] = wp_[(size_t)((jb + 1) * 16 + j_) * 1024]; } \
                _Pragma("unroll 4") for (int j_ = 0; j_ < 16; ++j_) { const float w_ = wl_[j_ * 512]; const LAS f32x4* ip_ = (const LAS f32x4*)(in + ((JOFF) + jb * 16 + j_) * 16); \
                    const f32x4 i0 = ip_[0], i1 = ip_[1], i2 = ip_[2], i3 = ip_[3]; \
                    ACC[0] += i0.x * w_; ACC[1] += i0.y * w_; ACC[2] += i0.z * w_; ACC[3] += i0.w * w_; ACC[4] += i1.x * w_; ACC[5] += i1.y * w_; ACC[6] += i1.z * w_; ACC[7] += i1.w * w_; \
                    ACC[8] += i2.x * w_; ACC[9] += i2.y * w_; ACC[10] += i2.z * w_; ACC[11] += i2.w * w_; ACC[12] += i3.x * w_; ACC[13] += i3.y * w_; ACC[14] += i3.z * w_; ACC[15] += i3.w * w_; } } } while (0)
            if (!(HACK & 1)) { relaunder(F); LOWRANK_ACC(accw, F.kin[I_RWUP] + (size_t)l * 64 * 1024, 0, 64);
            relaunder(F); LOWRANK_ACC(acca, F.kin[I_RAUP] + (size_t)l * 64 * 1024, 64, 64);
            relaunder(F); LOWRANK_ACC(accg, F.kin[I_RGUP] + (size_t)l * 64 * 1024, 128, 64);
            relaunder(F); if (l) LOWRANK_ACC(accv, F.kin[I_VRUP] + (size_t)(l - 1) * 32 * 1024, 192, 32); }
#undef LOWRANK_ACC
            relaunder(F);
            const float mur = F.kin[I_RMU][l * 3264 + c], muk = F.kin[I_RMU][l * 3264 + 1024 + c], muv = F.kin[I_RMU][l * 3264 + 2048 + c], kkv = F.kin[I_RKK][l * 1024 + c], kav = F.kin[I_RKA][l * 1024 + c];
            float pr = 0.f, pk = 0.f, pv = 0.f;
            if ((row0 & (SEQ - 1)) != 0) { const bf16* p = COLS + (size_t)(row0 - 1) * NMAIN + c; pr = bf2f(p[CC_R]); pk = bf2f(p[CC_K]); pv = bf2f(p[CC_V]); }
            if (!(HACK & 4))
#pragma unroll
            for (int tt = 0; tt < 16; ++tt) { const int row = row0 + tt; const bf16* p = COLS + (size_t)row * NMAIN + c;
                const float cr = bf2f(p[CC_R]), ck = bf2f(p[CC_K]), cv = bf2f(p[CC_V]);
                const float r = cr + (pr - cr) * mur, k = ck + (pk - ck) * muk; float v = cv + (pv - cv) * muv;
                pr = cr; pk = ck; pv = cv;
                const size_t o = (size_t)row * 1024 + c;
                if (l == 0) VF[o] = v; else { const float vg = sigmoid_f(accv[tt]); v = v + (VF[o] - v) * vg; }
                const float dec = __expf(-0.6065306597126334f * sigmoid_f(accw[tt]));
                const float a = sigmoid_f(acca[tt]);
                float kk = k * kkv; const float ss = wave_sum(kk * kk); kk = kk * rsqrtf(fmaxf(ss, 1e-24f));
                const float km = k * (1.0f + (a - 1.0f) * kav);
                RW[o] = r; RW[RS + o] = dec; RW[2 * RS + o] = km; RW[3 * RS + o] = v; RW[4 * RS + o] = -kk; RW[5 * RS + o] = kk * a; RW[6 * RS + o] = accg[tt]; }
        }
        asm volatile("s_waitcnt vmcnt(0)" ::: "memory"); __syncthreads();
        __builtin_amdgcn_fence(__ATOMIC_ACQUIRE, "agent"); asm volatile("s_waitcnt vmcnt(0)" ::: "memory");
        if (!(HACK & 2)) rwkv_chunks_of_tile(F, l, tile);
    }
}
struct Args { const float* in[35]; float* out; unsigned char* ws; };
__device__ __forceinline__ void mk_frame(Frame& F, int wv) {
    extern __shared__ __attribute__((aligned(16))) unsigned char lds[];
    kargp kp = (kargp)__builtin_amdgcn_kernarg_segment_ptr(); asm volatile("" : "+s"(kp));
    F.kin = kp;
    F.lds = (LAS unsigned char*)lds;
    F.MISC = (volatile LAS unsigned*)(F.lds + MISC_OFF);
    { int w_ = wv; asm volatile("" : "+s"(w_)); int t_ = (int)__builtin_amdgcn_mbcnt_hi(~0u, __builtin_amdgcn_mbcnt_lo(~0u, (unsigned)w_ * 64u)); asm volatile("" : "+v"(t_)); F.tid = t_; } F.lane = F.tid & 63; F.wave = __builtin_amdgcn_readfirstlane(F.tid >> 6);
    F.G = gridDim.x; { int bx = blockIdx.x; asm volatile("" : "+s"(bx)); F.bx = bx; F.vcu = (F.G % 8 == 0) ? (bx % 8) * (F.G / 8) + bx / 8 : bx; }
    F.out = (float*)kp[35]; F.ws = (unsigned char*)kp[36]; F.ctl = (gu32*)(F.ws + WS_CTL);
}
__device__ __forceinline__ void grid_bar(int wv) {
    Frame F; mk_frame(F, wv);
    XcdBarrier bar; bar.bar = (unsigned*)(F.ctl + CW_BAR); bar.x = xb_xcc_id(); bar.st = F.MISC + 8;
    xcd_barrier(bar);
#ifdef REP_BAR
    xcd_barrier(bar);
#endif
}
__global__ void __launch_bounds__(NWAVES * 64, 2) mega_fwd(Args args) {
    const int wv = __builtin_amdgcn_readfirstlane((int)threadIdx.x >> 6);
    { Frame F; mk_frame(F, wv);
      for (int u = F.tid; u < (LDS_BYTES - LDSCTL_OFF) / 4; u += NWAVES * 64) ((LAS unsigned*)(F.lds + LDSCTL_OFF))[u] = 0u;
      __syncthreads();
      (void)xcd_barrier_post((unsigned*)(F.ctl + CW_BAR), F.MISC + 8);
#ifndef NO_P0
      p0_prologue_a(F);
#endif
#ifdef REP_P0
      __syncthreads(); p0_prologue_a(F);
#endif
    }
    grid_bar(wv);
    { Frame F; mk_frame(F, wv); p0_prologue_b(F); }
    grid_bar(wv);
#pragma unroll 1
    for (int l = 0; l < NLAYER; ++l) {
#ifndef REP_HACK
#define REP_HACK 0
#endif
#define LAYER_VARS const float* mod = WSP(float, WS_MOD) + (size_t)l * 2 * 24576; const float* xin = l == 0 ? F.kin[I_X] : F.out; (void)mod; (void)xin
#ifndef NO_RMS
        { Frame F; mk_frame(F, wv); LAYER_VARS; rms_phase(F, xin, mod + 0, mod + 4096); }
#endif
        grid_bar(wv);
#ifndef NO_G1
        { Frame F; mk_frame(F, wv);
          pg8::Gemm g{WSP(pg8::bf16_t, WS_XN), WSP(pg8::bf16_t, WS_WIN + l * WIN_L), M, NIN, DM}; pg8::StaticOrder S; S.init(M, NIN, F.G, F.bx);
          pg8::EpiCols E{WSP(pg8::bf16_t, WS_COLS), WSP(float, WS_LOWR)};
          pg8::gemm_phase<pg8::EpiCols, pg8::StaticOrder, true, true>(F.lds + RING_OFF, g, S, E, F.tid); }
#endif
#ifdef REP_IN
        grid_bar(wv);
        { Frame F; mk_frame(F, wv);
          pg8::Gemm g{WSP(pg8::bf16_t, WS_XN), WSP(pg8::bf16_t, WS_WIN + l * WIN_L), M, NIN, DM}; pg8::StaticOrder S; S.init(M, NIN, F.G, F.bx);
          pg8::EpiCols E{WSP(pg8::bf16_t, WS_COLS), WSP(float, WS_LOWR)};
          pg8::gemm_phase<pg8::EpiCols, pg8::StaticOrder, true, true>(F.lds + RING_OFF, g, S, E, F.tid); }
#endif
        grid_bar(wv);
#ifndef NO_PREP
        { Frame F; mk_frame(F, wv); prep_norm(F, l); }
        { Frame F; mk_frame(F, wv); prep_loga(F, l); }
#ifdef REP_P2
        { Frame F; mk_frame(F, wv); prep_rwkv<REP_P2>(F, l); }
#endif
        { Frame F; mk_frame(F, wv); prep_rwkv(F, l); }
        { Frame F; mk_frame(F, wv); prep_vt(F, 0); }
        { Frame F; mk_frame(F, wv); prep_vt(F, 1); }
        { Frame F; mk_frame(F, wv); prep_gla(F); }
#ifdef REP_P3
        { Frame F; mk_frame(F, wv); prep_vt(F, 0); }
        { Frame F; mk_frame(F, wv); prep_vt(F, 1); }
        { Frame F; mk_frame(F, wv); prep_gla(F); }
#endif
#ifdef REP_P4
#endif
#endif
#ifdef REP_PREP
        grid_bar(wv);
        { Frame F; mk_frame(F, wv); prep_norm(F, l); }
        { Frame F; mk_frame(F, wv); prep_loga(F, l); }
        { Frame F; mk_frame(F, wv); prep_rwkv(F, l); }
        { Frame F; mk_frame(F, wv); prep_vt(F, 0); }
        { Frame F; mk_frame(F, wv); prep_vt(F, 1); }
        { Frame F; mk_frame(F, wv); prep_gla(F); }
#endif
        grid_bar(wv);
#ifndef NO_MIX
#ifdef REP_MIX
        { Frame F; mk_frame(F, wv); mixers_v4<REP_HACK>(F, l, l + 2, REP_MIX); }
        grid_bar(wv);
#endif
        { Frame F; mk_frame(F, wv); mixers_v4(F, l, l); }
#endif
        grid_bar(wv);
#ifndef NO_G2
        { Frame F; mk_frame(F, wv); LAYER_VARS;
          pg8::Gemm g{WSP(pg8::bf16_t, WS_MIXED), WSP(pg8::bf16_t, WS_WOUT + l * WOUT_L), M, DM, DM}; pg8::StaticOrder S; S.init(M, DM, F.G, F.bx);
          pg8::EpiRes E{xin, F.out, mod + 2 * 4096};
          pg8::gemm_phase<pg8::EpiRes, pg8::StaticOrder, true, true>(F.lds + RING_OFF, g, S, E, F.tid); }
#endif
        grid_bar(wv);
        { Frame F; mk_frame(F, wv); LAYER_VARS; rms_phase(F, F.out, mod + 3 * 4096, mod + 4 * 4096); }
#ifdef REP_RMS
        { Frame F; mk_frame(F, wv); LAYER_VARS; rms_phase(F, F.out, mod + 3 * 4096, mod + 4 * 4096); }
#endif
        grid_bar(wv);
#ifndef NO_G3
        { Frame F; mk_frame(F, wv);
          pg8::Gemm g{WSP(pg8::bf16_t, WS_XN), WSP(pg8::bf16_t, WS_W13 + l * W13_L), M, 2 * DFF, DM}; pg8::StaticOrder S; S.init(M, 2 * DFF, F.G, F.bx);
          pg8::EpiSwiglu E{WSP(pg8::bf16_t, WS_HID)};
          pg8::gemm_phase<pg8::EpiSwiglu, pg8::StaticOrder, true, true>(F.lds + RING_OFF, g, S, E, F.tid); }
#endif
#ifdef REP_UP
        grid_bar(wv);
        { Frame F; mk_frame(F, wv);
          pg8::Gemm g{WSP(pg8::bf16_t, WS_XN), WSP(pg8::bf16_t, WS_W13 + l * W13_L), M, 2 * DFF, DM}; pg8::StaticOrder S; S.init(M, 2 * DFF, F.G, F.bx);
          pg8::EpiSwiglu E{WSP(pg8::bf16_t, WS_HID)};
          pg8::gemm_phase<pg8::EpiSwiglu, pg8::StaticOrder, true, true>(F.lds + RING_OFF, g, S, E, F.tid); }
#endif
        grid_bar(wv);
#ifndef NO_G4
        { Frame F; mk_frame(F, wv); LAYER_VARS;
          pg8::Gemm g{WSP(pg8::bf16_t, WS_HID), WSP(pg8::bf16_t, WS_W2 + l * W2_L), M, DM, DFF}; pg8::StaticOrder S; S.init(M, DM, F.G, F.bx);
          pg8::EpiRes E{F.out, F.out, mod + 5 * 4096};
          pg8::gemm_phase<pg8::EpiRes, pg8::StaticOrder, true, true>(F.lds + RING_OFF, g, S, E, F.tid); }
#endif
        if (l + 1 < NLAYER) grid_bar(wv);
#undef LAYER_VARS
    }
}

extern "C" void kernel_launch(void* const* d_in, const int* in_sizes, int n_in, void* d_out, int out_size, void* d_ws, size_t ws_size, hipStream_t stream) {
    static int grid = 0;
    if (grid == 0) {
        if (n_in != 35 || in_sizes[0] != M * DM || out_size != M * DM || ws_size < WS_END) { fprintf(stderr, "kernel_launch: unexpected shapes: n_in %d in0 %d out %d ws %zu (need %zu)\n", n_in, n_in > 0 ? in_sizes[0] : -1, out_size, ws_size, (size_t)WS_END); grid = -1; return; }
        int dev = 0, cus = 0, per_cu = 0;
        if (hipGetDevice(&dev) != hipSuccess || hipDeviceGetAttribute(&cus, hipDeviceAttributeMultiprocessorCount, dev) != hipSuccess) { grid = -1; return; }
        if (hipFuncSetAttribute((const void*)mega_fwd, hipFuncAttributeMaxDynamicSharedMemorySize, LDS_BYTES) != hipSuccess) { fprintf(stderr, "kernel_launch: hipFuncSetAttribute failed\n"); grid = -1; return; }
        if (hipOccupancyMaxActiveBlocksPerMultiprocessor(&per_cu, (const void*)mega_fwd, NWAVES * 64, LDS_BYTES) != hipSuccess || per_cu < 1) fprintf(stderr, "kernel_launch: occupancy query says %d\n", per_cu);
        (void)hipGetLastError();
        grid = cus;
    }
    if (grid < 0) return;
    if (hipMemsetAsync((char*)d_ws + WS_CTL, 0, CTL_ZERO_BYTES, stream) != hipSuccess) return;
    Args a{};
    for (int i = 0; i < 35; ++i) a.in[i] = (const float*)d_in[i];
    a.out = (float*)d_out; a.ws = (unsigned char*)d_ws;
    hipLaunchKernelGGL(mega_fwd, dim3(grid), dim3(NWAVES * 64), LDS_BYTES, stream, a);
}
```

```cpp
#include <hip/hip_runtime.h>
#include <cstdio>
#include <cstdint>
namespace pg8 {
#define PG8_LAS __attribute__((address_space(3)))
typedef unsigned short bf16_t;
typedef short bf16x8 __attribute__((ext_vector_type(8)));
typedef float f32x4 __attribute__((ext_vector_type(4)));
typedef unsigned u32x4 __attribute__((ext_vector_type(4)));
constexpr int BM = 256, BK = 64, HALF = 128, HTB = HALF * BK * 2  , STAGE_BYTES = 8 * HTB, NXCD = 8, WGM = 8;

__host__ __device__ __forceinline__ int lds_byte(int r, int c) { const int st = (r >> 4) * 2 + (c >> 5), rr = r & 15, cc = c & 31, ob = rr * 64 + cc * 2; return st * 1024 + (ob ^ (((ob >> 9) & 1) << 5)); }
__host__ __device__ __forceinline__ void stage_rc(int b, int& R, int& C) { const int st = b / 1024, sb = b % 1024, swz = sb ^ (((sb >> 9) & 1) << 5); R = (st >> 1) * 16 + swz / 64; C = (st & 1) * 32 + (swz % 64) / 2; }
__host__ __device__ __forceinline__ int perm32(int rho) { const int n = rho >> 4, i = rho & 15; return 8 * (i >> 2) + 4 * n + (i & 3); }

struct Unit { int pm, pn; };
struct Gemm { const bf16_t* A; const bf16_t* Bt; int M, N, K; };

struct StaticOrder {
    int nM, nN, nwg, G, c;
    __host__ __device__ void init(int M, int N, int G_, int c_) { nM = M / BM; nN = N / BM; nwg = nM * nN; G = G_; c = c_; }
    __host__ __device__ bool next(int i, Unit& u) const {
        const long L = (long)i * G + c; if (L >= nwg) return false;
        int wgid = (int)L; { const int q = nwg / NXCD, r = nwg % NXCD, xcd = wgid % NXCD, off = wgid / NXCD; wgid = (xcd < r ? xcd * (q + 1) : r * (q + 1) + (xcd - r) * q) + off; }
        const int nig = WGM * nN, gid = wgid / nig, fm = gid * WGM, gsz = (nM - fm) < WGM ? (nM - fm) : WGM;
        u.pm = fm + ((wgid % nig) % gsz); u.pn = (wgid % nig) / gsz; return true;
    }
    __device__ __forceinline__ void a_ready(const Unit&) const {}
    __device__ __forceinline__ void done(const Unit&) const {}
};

typedef float f32x2c_t __attribute__((ext_vector_type(2))); typedef __bf16 bf16x2c_t __attribute__((ext_vector_type(2)));
__device__ __forceinline__ unsigned cvt_pk_bf16(float lo, float hi) { const f32x2c_t v = {lo, hi}; return __builtin_bit_cast(unsigned, __builtin_convertvector(v, bf16x2c_t)); }
typedef float f32x2 __attribute__((ext_vector_type(2)));
__device__ __forceinline__ float silu_f(float x) { return x * __builtin_amdgcn_rcpf(1.0f + __builtin_amdgcn_exp2f(-1.4426950408889634f * x)); }
struct EpiCols {
    static constexpr bool PERM = true, AFTER_DRAIN = false;
    bf16_t* O; float* L;
    __device__ __forceinline__ void operator()(const f32x4 (&acc)[2][2][4][2], const Unit& u, int wr, int wc, int fr, int fq) const {
        const int row0 = u.pm * BM + wr * 64 + fr;
        if (u.pn < 41) {
            const int col0 = u.pn * BM + wc * 32 + 8 * fq;
#pragma unroll
            for (int ai = 0; ai < 2; ++ai)
#pragma unroll
                for (int m = 0; m < 4; ++m) { bf16_t* rowp = O + (size_t)(row0 + ai * HALF + m * 16) * 10496 + col0;
#pragma unroll
                    for (int bj = 0; bj < 2; ++bj) { const f32x4 v0 = acc[ai][bj][m][0], v1 = acc[ai][bj][m][1];
                        u32x4 w; w.x = cvt_pk_bf16(v0[0], v0[1]); w.y = cvt_pk_bf16(v0[2], v0[3]); w.z = cvt_pk_bf16(v1[0], v1[1]); w.w = cvt_pk_bf16(v1[2], v1[3]);
                        *(u32x4*)(rowp + bj * HALF) = w; } }
        } else {
            const int col0 = wc * 32 + 8 * fq;
#pragma unroll
            for (int ai = 0; ai < 2; ++ai)
#pragma unroll
                for (int m = 0; m < 4; ++m) { float* rowp = L + (size_t)(row0 + ai * HALF + m * 16) * 256 + col0;
#pragma unroll
                    for (int bj = 0; bj < 2; ++bj) { *(f32x4*)(rowp + bj * HALF) = acc[ai][bj][m][0]; *(f32x4*)(rowp + bj * HALF + 4) = acc[ai][bj][m][1]; } }
        }
    }
};
struct EpiRes {
    static constexpr bool PERM = false, AFTER_DRAIN = false;
    const float* base; float* out; const float* gate;
    __device__ __forceinline__ void operator()(const f32x4 (&acc)[2][2][4][2], const Unit& u, int wr, int wc, int fr, int fq) const {
        const int row0 = u.pm * BM + wr * 64 + fr, col0 = u.pn * BM + wc * 32 + 4 * fq;
        const float* gp = gate + (size_t)(u.pm >> 5) * 24576 + col0;
        f32x4 gv[2][2];
#pragma unroll
        for (int bj = 0; bj < 2; ++bj)
#pragma unroll
            for (int n = 0; n < 2; ++n) gv[bj][n] = *(const f32x4*)(gp + bj * HALF + n * 16);
#pragma unroll
        for (int ai = 0; ai < 2; ++ai)
#pragma unroll
            for (int m = 0; m < 4; ++m) { const size_t off = (size_t)(row0 + ai * HALF + m * 16) * 4096 + col0;
#pragma unroll
                for (int bj = 0; bj < 2; ++bj)
#pragma unroll
                    for (int n = 0; n < 2; ++n) { const f32x4 bs = *(const f32x4*)(base + off + bj * HALF + n * 16); *(f32x4*)(out + off + bj * HALF + n * 16) = bs + gv[bj][n] * acc[ai][bj][m][n]; }
                if (m == 3) asm volatile("" ::: "memory"); }
    }
};
struct EpiSwiglu {
    static constexpr bool PERM = true, AFTER_DRAIN = false;
    bf16_t* H;
    __device__ __forceinline__ void operator()(const f32x4 (&acc)[2][2][4][2], const Unit& u, int wr, int wc, int fr, int fq) const {
        const int row0 = u.pm * BM + wr * 64 + fr, col0 = u.pn * HALF + wc * 32 + 8 * fq;
#pragma unroll
        for (int ai = 0; ai < 2; ++ai)
#pragma unroll
            for (int m = 0; m < 4; ++m) { bf16_t* rowp = H + (size_t)(row0 + ai * HALF + m * 16) * 11008 + col0;
                const f32x4 a0 = acc[ai][0][m][0], a1 = acc[ai][0][m][1], b0 = acc[ai][1][m][0], b1 = acc[ai][1][m][1];
                u32x4 w; w.x = cvt_pk_bf16(silu_f(a0[0]) * b0[0], silu_f(a0[1]) * b0[1]); w.y = cvt_pk_bf16(silu_f(a0[2]) * b0[2], silu_f(a0[3]) * b0[3]);
                w.z = cvt_pk_bf16(silu_f(a1[0]) * b1[0], silu_f(a1[1]) * b1[1]); w.w = cvt_pk_bf16(silu_f(a1[2]) * b1[2], silu_f(a1[3]) * b1[3]);
                *(u32x4*)rowp = w; }
    }
};
template <class Epi, class Sched, bool ALIGN_EPI = false, bool SP2 = false>
__device__ __forceinline__ void gemm_phase(PG8_LAS unsigned char* lds, const Gemm g, const Sched& S, const Epi& E, int tid_in) {
    int tid_ = tid_in; asm volatile("" : "+v"(tid_));
    const int tid = tid_, wid = __builtin_amdgcn_readfirstlane(tid >> 6), lane = tid & 63, wr = wid >> 2, wc = wid & 3, fr = lane & 15, fq = lane >> 4;
    const int K = g.K, nt = K / BK;
    unsigned voffA[2], voffB[2];
#pragma unroll
    for (int i = 0; i < 2; ++i) { int R, C; stage_rc(tid * 16 + i * 8192, R, C); const int Rb = Epi::PERM ? ((R & ~31) + perm32(R & 31)) : R;
        voffA[i] = (unsigned)(R * K + C) * 2u; voffB[i] = (unsigned)(Rb * K + C) * 2u; }
    const size_t kstep = (size_t)(BK * 2);
    const size_t hstep = (size_t)HALF * K * 2;
    const size_t tstep = 2 * hstep;
    const unsigned ldsw = (unsigned)wid * 1024u;
    const int aoff = lds_byte(wr * 64 + fr, fq * 8), boff = lds_byte(wc * 32 + fr, fq * 8);
#define PG8_SA(b, h) (((b) * 2 + (h)) * HTB)
#define PG8_SB(b, h) ((4 + (b) * 2 + (h)) * HTB)
#define PG8_STAGE(bufoff, gbase, voff) do { _Pragma("unroll") for (int _i = 0; _i < 2; ++_i) \
        __builtin_amdgcn_global_load_lds((const unsigned*)((const char*)(gbase) + (voff)[_i]), (PG8_LAS unsigned*)(lds + (bufoff) + ldsw + _i * 8192), 16, 0, 0); } while (0)
#define PG8_LDA(dst, b, h) do { _Pragma("unroll") for (int m = 0; m < 4; ++m) _Pragma("unroll") for (int k = 0; k < 2; ++k) dst[m][k] = *(const PG8_LAS bf16x8*)(lds + PG8_SA(b, h) + aoff + m * 2048 + k * 1024); } while (0)
#define PG8_LDB(dst, b, h) do { _Pragma("unroll") for (int n = 0; n < 2; ++n) _Pragma("unroll") for (int k = 0; k < 2; ++k) dst[n][k] = *(const PG8_LAS bf16x8*)(lds + PG8_SB(b, h) + boff + n * 2048 + k * 1024); } while (0)
#define PG8_MMA(ai, bj, At, Bt) do { __builtin_amdgcn_s_setprio(1); _Pragma("unroll") for (int m = 0; m < 4; ++m) _Pragma("unroll") for (int n = 0; n < 2; ++n) _Pragma("unroll") for (int k = 0; k < 2; ++k) \
        acc[ai][bj][m][n] = __builtin_amdgcn_mfma_f32_16x16x32_bf16(Bt[n][k], At[m][k], acc[ai][bj][m][n], 0, 0, 0); __builtin_amdgcn_s_setprio(0); } while (0)
#define PG8_WAIT_V(n) asm volatile("s_waitcnt vmcnt(" #n ")" ::: "memory")
#define PG8_WAIT_L(n) asm volatile("s_waitcnt lgkmcnt(" #n ")" ::: "memory")
#define PG8_BAR __builtin_amdgcn_s_barrier()
#define PG8_SCHED __builtin_amdgcn_sched_barrier(0)
    Unit cur, nxt; int ui = 0;
    if (!S.next(0, cur)) return;
    f32x4 acc[2][2][4][2];
#pragma unroll
    for (int a = 0; a < 2; ++a)
#pragma unroll
        for (int b = 0; b < 2; ++b)
#pragma unroll
            for (int m = 0; m < 4; ++m)
#pragma unroll
                for (int n = 0; n < 2; ++n) acc[a][b][m][n] = (f32x4){0.f, 0.f, 0.f, 0.f};
    bf16x8 At[4][2], B0[2][2], B1[2][2];
    const char* cA = (const char*)g.A + (size_t)cur.pm * tstep; const char* cB = (const char*)g.Bt + (size_t)cur.pn * tstep;
    S.a_ready(cur);
    if constexpr (SP2) {
        PG8_STAGE(PG8_SB(0, 0), cB, voffB); PG8_STAGE(PG8_SB(0, 1), cB + hstep, voffB); PG8_STAGE(PG8_SA(0, 0), cA, voffA); PG8_STAGE(PG8_SA(0, 1), cA + hstep, voffA);
        if (wr == 1) PG8_BAR;
        PG8_WAIT_V(2); PG8_BAR;
        PG8_STAGE(PG8_SB(1, 0), cB + kstep, voffB); PG8_STAGE(PG8_SA(1, 0), cA + kstep, voffA); PG8_STAGE(PG8_SB(1, 1), cB + hstep + kstep, voffB);
        PG8_WAIT_V(6); PG8_BAR;
    } else {
        PG8_STAGE(PG8_SB(0, 0), cB, voffB); PG8_STAGE(PG8_SA(0, 0), cA, voffA); PG8_STAGE(PG8_SB(0, 1), cB + hstep, voffB); PG8_STAGE(PG8_SA(0, 1), cA + hstep, voffA);
        if (wr == 1) PG8_BAR;
        PG8_WAIT_V(4); PG8_BAR;
        PG8_STAGE(PG8_SB(1, 0), cB + kstep, voffB); PG8_STAGE(PG8_SA(1, 0), cA + kstep, voffA); PG8_STAGE(PG8_SB(1, 1), cB + hstep + kstep, voffB);
        PG8_WAIT_V(6); PG8_BAR;
    }
    for (;;) {
        const bool has_next = S.next(ui + 1, nxt);
        const char* nA = has_next ? (const char*)g.A + (size_t)nxt.pm * tstep : cA; const char* nB = has_next ? (const char*)g.Bt + (size_t)nxt.pn * tstep : cB;
        for (int t = 0; t < nt; t += 2) {
            const bool last = (t == nt - 2);
            const char* a1 = cA + (size_t)(t + 1) * kstep;
            const char* a2 = last ? nA : cA + (size_t)(t + 2) * kstep; const char* b2 = last ? nB : cB + (size_t)(t + 2) * kstep;
            const char* a3 = a2 + kstep; const char* b3 = b2 + kstep;
            if (last && has_next) S.a_ready(nxt);
            if constexpr (SP2) {
            PG8_LDB(B0, 0, 0); PG8_LDB(B1, 0, 1); PG8_SCHED; PG8_LDA(At, 0, 0); PG8_STAGE(PG8_SA(1, 1), a1 + hstep, voffA);
            PG8_WAIT_V(8); PG8_WAIT_L(0); PG8_BAR; PG8_MMA(0, 0, At, B0); PG8_MMA(0, 1, At, B1); PG8_BAR; PG8_SCHED;
            PG8_LDA(At, 0, 1); PG8_STAGE(PG8_SB(0, 0), b2, voffB); PG8_STAGE(PG8_SB(0, 1), b2 + hstep, voffB); PG8_STAGE(PG8_SA(0, 0), a2, voffA);
            PG8_WAIT_V(8); PG8_WAIT_L(0); PG8_BAR; PG8_MMA(1, 0, At, B0); PG8_MMA(1, 1, At, B1); PG8_BAR; PG8_SCHED;
            PG8_LDB(B0, 1, 0); PG8_LDB(B1, 1, 1); PG8_SCHED; PG8_LDA(At, 1, 0); PG8_STAGE(PG8_SA(0, 1), a2 + hstep, voffA);
            PG8_WAIT_V(8); PG8_WAIT_L(0); PG8_BAR; PG8_MMA(0, 0, At, B0); PG8_MMA(0, 1, At, B1); PG8_BAR; PG8_SCHED;
            PG8_LDA(At, 1, 1); PG8_STAGE(PG8_SB(1, 0), b3, voffB); PG8_STAGE(PG8_SB(1, 1), b3 + hstep, voffB); PG8_STAGE(PG8_SA(1, 0), a3, voffA);
            PG8_WAIT_V(8); PG8_WAIT_L(0); PG8_BAR; PG8_MMA(1, 0, At, B0); PG8_MMA(1, 1, At, B1); PG8_BAR; PG8_SCHED;
            } else {
            PG8_LDB(B0, 0, 0); PG8_SCHED; PG8_LDA(At, 0, 0); PG8_STAGE(PG8_SA(1, 1), a1 + hstep, voffA);
            PG8_WAIT_L(8); PG8_BAR; PG8_WAIT_L(0); PG8_MMA(0, 0, At, B0); PG8_BAR; PG8_SCHED;
            PG8_LDB(B1, 0, 1); PG8_STAGE(PG8_SB(0, 0), b2, voffB);
            PG8_BAR; PG8_WAIT_L(0); PG8_MMA(0, 1, At, B1); PG8_BAR;
            PG8_LDA(At, 0, 1); PG8_STAGE(PG8_SA(0, 0), a2, voffA);
            PG8_BAR; PG8_WAIT_L(0); PG8_MMA(1, 0, At, B0); PG8_BAR; PG8_SCHED;
            PG8_STAGE(PG8_SB(0, 1), b2 + hstep, voffB);
            PG8_WAIT_V(6); PG8_BAR; PG8_MMA(1, 1, At, B1); PG8_BAR;
            PG8_LDB(B0, 1, 0); PG8_SCHED; PG8_LDA(At, 1, 0); PG8_STAGE(PG8_SA(0, 1), a2 + hstep, voffA);
            PG8_WAIT_L(8); PG8_BAR; PG8_WAIT_L(0); PG8_MMA(0, 0, At, B0); PG8_BAR; PG8_SCHED;
            PG8_LDB(B1, 1, 1); PG8_STAGE(PG8_SB(1, 0), b3, voffB);
            PG8_BAR; PG8_WAIT_L(0); PG8_MMA(0, 1, At, B1); PG8_BAR;
            PG8_LDA(At, 1, 1); PG8_STAGE(PG8_SA(1, 0), a3, voffA);
            PG8_BAR; PG8_WAIT_L(0); PG8_MMA(1, 0, At, B0); PG8_BAR; PG8_SCHED;
            PG8_STAGE(PG8_SB(1, 1), b3 + hstep, voffB);
            PG8_WAIT_V(6); PG8_BAR; PG8_MMA(1, 1, At, B1); PG8_BAR;
            }
        }
        if constexpr (ALIGN_EPI) { if (wr == 0) PG8_BAR; }
        if constexpr (!Epi::AFTER_DRAIN) { E(acc, cur, wr, wc, fr, fq); S.done(cur); }
        if (!has_next) break;
#pragma unroll
        for (int a = 0; a < 2; ++a)
#pragma unroll
            for (int b = 0; b < 2; ++b)
#pragma unroll
                for (int m = 0; m < 4; ++m)
#pragma unroll
                    for (int n = 0; n < 2; ++n) acc[a][b][m][n] = (f32x4){0.f, 0.f, 0.f, 0.f};
        cur = nxt; cA = nA; cB = nB; ++ui;
        if constexpr (ALIGN_EPI) { if (wr == 1) PG8_BAR; }
    }
    PG8_WAIT_V(0);
    if constexpr (!ALIGN_EPI) { if (wr == 0) PG8_BAR; }
    PG8_BAR;
    if constexpr (Epi::AFTER_DRAIN) { E.fused(acc, cur, wr, wc, fr, fq, lds, wid, lane); S.done(cur); }
#undef PG8_SA
#undef PG8_SB
#undef PG8_STAGE
#undef PG8_LDA
#undef PG8_LDB
#undef PG8_MMA
#undef PG8_WAIT_V
#undef PG8_WAIT_L
#undef PG8_BAR
#undef PG8_SCHED
}
}
constexpr int BATCH = 2, SEQ = 8192, DM = 4096, M = BATCH * SEQ, DFF = 11008, NLAYER = 2;
constexpr int P_IN = 10704, NIN = 10752, NMAIN = 10496;
constexpr int CA_Q = 0, CA_K = 1024, CA_V = 2048;
constexpr int CB_Q = 3072, CB_K = 3584, CB_V = 4096, CB_G = 5120;
constexpr int CC_R = 6144, CC_K = 7168, CC_V = 8192;
constexpr int CD_Q = 9216, CD_K = 10240, CD_V = 10368;
constexpr float LOG2E = 1.4426950408889634f;
constexpr float QSCALE = 0.125f * LOG2E;
constexpr int NWAVES = 8;

constexpr size_t MiB = 1u << 20;
constexpr size_t WS_CTL = 0, CTL_ZERO_BYTES = 1 * MiB;
constexpr size_t WS_MODP = 2 * MiB;
constexpr size_t WS_MOD = 14 * MiB;
constexpr size_t WS_TAB = 15 * MiB;
constexpr size_t WS_WIN = 16 * MiB, WIN_L = 84 * MiB;
constexpr size_t WS_WOUT = 184 * MiB, WOUT_L = 32 * MiB;
constexpr size_t WS_W13 = 248 * MiB, W13_L = 172 * MiB;
constexpr size_t WS_W2 = 592 * MiB, W2_L = 86 * MiB;
constexpr size_t WS_XN = 764 * MiB;
constexpr size_t WS_COLS = 892 * MiB;
constexpr size_t WS_LOWR = 1220 * MiB;
constexpr size_t WS_HID = 892 * MiB;
constexpr size_t WS_QKA = 1236 * MiB;
constexpr size_t WS_QKD = 1300 * MiB;
constexpr size_t WS_LOGA = 1336 * MiB;
constexpr size_t WS_RW = 1368 * MiB, RW_ONE = 64 * MiB;
constexpr size_t WS_VFIRST = 1816 * MiB;
constexpr size_t WS_MIXED = 1880 * MiB;
constexpr int VROW = SEQ + 64;
constexpr size_t WS_VTA = 2008 * MiB;
constexpr size_t WS_VTD = 2041 * MiB;
constexpr size_t WS_QDEC = 2046 * MiB, WS_KDT = 2062 * MiB, WS_AM = 2078 * MiB, WS_EBL = 2086 * MiB;
constexpr size_t WS_VTB = 2087 * MiB;
constexpr size_t WS_RWC = 2120 * MiB;
constexpr size_t WS_END = 2446 * MiB;
constexpr int CW_BAR = 4096;
constexpr int CW_Q = 16384;

constexpr int RING_OFF = 0, RING_BYTES = 131072;
constexpr int LDSCTL_OFF = RING_BYTES, MISC_OFF = LDSCTL_OFF + 320;
constexpr int LDS_BYTES = 147456;

#define GAS __attribute__((address_space(1)))
#define LAS __attribute__((address_space(3)))
typedef unsigned short bf16;
typedef unsigned v4u __attribute__((ext_vector_type(4)));
typedef unsigned v2u __attribute__((ext_vector_type(2)));
typedef float f32x4 __attribute__((ext_vector_type(4)));
typedef short bf16x8 __attribute__((ext_vector_type(8)));
typedef GAS unsigned gu32;
#define RLX_AGENT __ATOMIC_RELAXED, __HIP_MEMORY_SCOPE_AGENT
#define LDS_WAIT() asm volatile("s_waitcnt lgkmcnt(0)" ::: "memory")
#define VM_WAIT() asm volatile("s_waitcnt vmcnt(0)" ::: "memory")
typedef float f32x2_t __attribute__((ext_vector_type(2))); typedef __bf16 bf16x2_t __attribute__((ext_vector_type(2)));
__device__ __forceinline__ unsigned pk2(float lo, float hi) { const f32x2_t v = {lo, hi}; return __builtin_bit_cast(unsigned, __builtin_convertvector(v, bf16x2_t)); }
__device__ __forceinline__ unsigned f2bf(float f) { return pk2(f, f) & 0xffffu; }
__device__ __forceinline__ float bf2f(unsigned short h) { return __builtin_bit_cast(float, (unsigned)h << 16); }
__device__ __forceinline__ float bflo(unsigned w) { return __builtin_bit_cast(float, w << 16); }
__device__ __forceinline__ float bfhi(unsigned w) { return __builtin_bit_cast(float, w & 0xffff0000u); }
template <int CTRL> __device__ __forceinline__ float dpp_f(float v) { return __builtin_bit_cast(float, __builtin_amdgcn_update_dpp(0, __builtin_bit_cast(int, v), CTRL, 0xF, 0xF, true)); }
__device__ __forceinline__ float sum8(float v) {
    v += dpp_f<0xB1>(v); v += dpp_f<0x4E>(v); v += dpp_f<0x141>(v); return v; }
__device__ __forceinline__ float sum32(float v) {
    v = sum8(v); v += dpp_f<0x140>(v); v += __builtin_bit_cast(float, __builtin_amdgcn_ds_swizzle(__builtin_bit_cast(int, v), 0x401F)); return v; }
__device__ __forceinline__ float wave_sum(float v) {
    v = sum8(v); v += dpp_f<0x140>(v);
    v += __builtin_bit_cast(float, __builtin_amdgcn_ds_swizzle(__builtin_bit_cast(int, v), 0x401F));
    { const int u = __builtin_bit_cast(int, v); v = __builtin_bit_cast(float, __builtin_amdgcn_readlane(u, 0)) + __builtin_bit_cast(float, __builtin_amdgcn_readlane(u, 32)); }
    return v;
}
__device__ __forceinline__ float sigmoid_f(float x) { return __builtin_amdgcn_rcpf(1.0f + __builtin_amdgcn_exp2f(-LOG2E * x)); }
__device__ __forceinline__ float silu_g(float x) { return x * sigmoid_f(x); }

#define XB_TMO      128
#define XB_XCNT(j)  (256  + 64 * (j))
#define XB_XSUB(j)  (1280 + 64 * (j))
#define XB_XGEN(j)  (2304 + 64 * (j))
#define XB_TOP      3328
#define XB_TOPGEN   3392
#define XCD_BAR_WORDS 3456
#define XB_SPIN_CAP (1u << 23)

__device__ __forceinline__ unsigned xb_ld(unsigned* p)              { return __hip_atomic_load(p, __ATOMIC_RELAXED, __HIP_MEMORY_SCOPE_AGENT); }
__device__ __forceinline__ unsigned xb_add(unsigned* p, unsigned v) { return __hip_atomic_fetch_add(p, v, __ATOMIC_RELAXED, __HIP_MEMORY_SCOPE_AGENT); }
__device__ __forceinline__ unsigned xb_xcc_id() { return (unsigned)__builtin_amdgcn_s_getreg((3 << 11) | 20) & 0xFu; }
#define XB_SPIN(cond, bar) do { unsigned _sp = 0; while (cond) { __builtin_amdgcn_s_sleep(1); \
    if ((++_sp & 255u) == 0u) { if (xb_ld(&(bar)[XB_TMO])) break; if (_sp > XB_SPIN_CAP) { atomicAdd(&(bar)[XB_TMO], 1u); break; } } } } while (0)

struct XcdBarrier {
    unsigned* bar; unsigned x;
    volatile LAS unsigned* st;
};

__device__ __forceinline__ XcdBarrier xcd_barrier_post(unsigned* bar, volatile LAS unsigned* st) {
    XcdBarrier b; b.bar = bar; b.x = xb_xcc_id(); b.st = st;
    if (threadIdx.x == 0) (void)xb_add(&bar[XB_XCNT(b.x)], 1u);
    return b;
}
__device__ __forceinline__ void xcd_barrier_complete(unsigned* bar, unsigned x, unsigned& nloc, unsigned& nx) {
    const unsigned G = gridDim.x * gridDim.y * gridDim.z;
    unsigned sum, cnt, mine, sp = 0u;
    for (;;) {
        sum = 0u; cnt = 0u; mine = 0u;
#pragma unroll
        for (unsigned j = 0; j < 16; ++j) { const unsigned c = xb_ld(&bar[XB_XCNT(j)]); sum += c; cnt += (c > 0u) ? 1u : 0u; mine = (j == x) ? c : mine; }
        if (sum == G) break;
        __builtin_amdgcn_s_sleep(1);
        if ((++sp & 255u) == 0u) { if (xb_ld(&bar[XB_TMO])) break; if (sp > XB_SPIN_CAP) { atomicAdd(&bar[XB_TMO], 1u); break; } }
    }
    nloc = mine > 0u ? mine : 1u; nx = cnt > 0u ? cnt : 1u;
}

__device__ __forceinline__ void xcd_barrier(const XcdBarrier& b) {
    asm volatile("s_waitcnt vmcnt(0)" ::: "memory");
    __syncthreads();
    if (threadIdx.x == 0) {
        unsigned* bar = b.bar;
        __builtin_amdgcn_s_waitcnt(0);
        unsigned nloc = b.st[0], nx = b.st[1];
        if (nloc == 0u) { xcd_barrier_complete(bar, b.x, nloc, nx); b.st[0] = nloc; b.st[1] = nx; }
        const unsigned old = xb_add(&bar[XB_XSUB(b.x)], 1u);
        const unsigned gen = old / nloc;
        if (old + 1u == (gen + 1u) * nloc) {
            __builtin_amdgcn_fence(__ATOMIC_RELEASE, "agent");
            asm volatile("s_waitcnt vmcnt(0)" ::: "memory");
            const unsigned og = xb_add(&bar[XB_TOP], 1u);
            const unsigned tg = og / nx;
            if (og + 1u == (tg + 1u) * nx) xb_add(&bar[XB_TOPGEN], 1u);
            else XB_SPIN(xb_ld(&bar[XB_TOPGEN]) == tg, bar);
            __builtin_amdgcn_fence(__ATOMIC_ACQUIRE, "agent");
            xb_add(&bar[XB_XGEN(b.x)], 1u);
            asm volatile("s_waitcnt vmcnt(0)" ::: "memory");
        } else {
            XB_SPIN(xb_ld(&bar[XB_XGEN(b.x)]) == gen, bar);
            __builtin_amdgcn_fence(__ATOMIC_ACQUIRE, "agent");
            asm volatile("s_waitcnt vmcnt(0)" ::: "memory");
        }
    }
    __syncthreads();
}

typedef const float* const __attribute__((address_space(4)))* kargp;
struct Frame {
    LAS unsigned char* lds;
    volatile LAS unsigned* MISC;
    gu32* ctl;
    int tid, lane, wave;
    int vcu, G, bx;
    kargp kin;
    float* out;
    unsigned char* ws;
};
enum { I_X = 0, I_C, I_RELB, I_ADAW, I_ADAB, I_WIN, I_WOUT, I_DQN, I_DKN, I_DLAM, I_DSUB, I_GGU, I_GGB, I_GON, I_RMU, I_RWUP, I_RW0, I_RAUP, I_RA0, I_RGUP,
       I_RKK, I_RKA, I_RRK, I_RLNW, I_RLNB, I_VRD, I_VRMU, I_VRUP, I_VR0, I_SQN, I_SKN, I_SSINK, I_W1, I_W3, I_W2 };

#define WSP(T, off) ((T*)(F.ws + (off)))
__device__ __forceinline__ void relaunder_tid(Frame& F) { int t = F.tid; asm volatile("" : "+v"(t)); F.tid = t; F.lane = t & 63; F.wave = __builtin_amdgcn_readfirstlane(t >> 6); }
__device__ __forceinline__ void relaunder(Frame& F) { kargp p = F.kin; asm volatile("" : "+s"(p)); F.kin = p; }

__device__ __forceinline__ void conv_item(const float* src, int ld, int col0, int ncols, int K, bf16* WT, int row0, int kb, LAS float* scr, int lane) {
    const int k0 = 64 * kb;
    { const int n = lane & 31; const bool ok = src != nullptr && n < ncols; const float* sp = src + (size_t)(k0 + (lane >> 5)) * ld + col0 + n; float v[32];
#pragma unroll
      for (int i = 0; i < 32; ++i) v[i] = ok ? sp[(size_t)(2 * i) * ld] : 0.f;
#pragma unroll
      for (int i = 0; i < 32; ++i) scr[(2 * i + (lane >> 5)) * 33 + n] = v[i]; }
    LDS_WAIT(); asm volatile("" ::: "memory");
    const int c = lane & 7;
#pragma unroll
    for (int j = 0; j < 4; ++j) { const int n = (lane >> 3) + 8 * j; const LAS float* s = scr + (8 * c) * 33 + n;
        v4u o; o.x = pk2(s[0 * 33], s[1 * 33]); o.y = pk2(s[2 * 33], s[3 * 33]); o.z = pk2(s[4 * 33], s[5 * 33]); o.w = pk2(s[6 * 33], s[7 * 33]);
        if (n < ncols) *(GAS v4u*)(WT + (size_t)(row0 + n) * K + k0 + 8 * c) = o; }
    LDS_WAIT(); asm volatile("" ::: "memory");
}
__device__ __forceinline__ int t5_bucket(int d) {
    if (d < 16) return d;
    int v = 16 + (int)(logf((float)d * (1.0f / 16.0f)) / logf(8.0f) * 16.0f);
    return v < 31 ? v : 31;
}
__device__ __forceinline__ void p0_prologue_a(Frame& F) {
    const int gw = F.vcu * NWAVES + F.wave, NGW = F.G * NWAVES;
    LAS float* ldsf = (LAS float*)(F.lds + RING_OFF);
    for (int i = F.tid; i < 2 * DM; i += NWAVES * 64) ldsf[i] = silu_g(F.kin[I_C][i]);
    __syncthreads();
    float* MODP = WSP(float, WS_MODP);
    for (int it = gw; it < 6144; it += NGW) {
        const int l = it / 3072, rem = it % 3072, kc = rem / 96, ng = rem % 96, n0 = 256 * ng + 4 * F.lane;
        const float* w = F.kin[I_ADAW] + ((size_t)l * DM + kc * 128) * 24576 + n0;
        f32x4 a0 = {0.f, 0.f, 0.f, 0.f}, a1 = {0.f, 0.f, 0.f, 0.f};
#pragma unroll 16
        for (int k = 0; k < 128; ++k) { const f32x4 wv = *(const f32x4*)(w + (size_t)k * 24576); const float s0 = ldsf[kc * 128 + k], s1 = ldsf[DM + kc * 128 + k]; a0 += wv * s0; a1 += wv * s1; }
        *(f32x4*)(MODP + ((size_t)(l * 32 + kc) * 2 + 0) * 24576 + n0) = a0;
        *(f32x4*)(MODP + ((size_t)(l * 32 + kc) * 2 + 1) * 24576 + n0) = a1;
    }
    __syncthreads();
    LAS float* scr = (LAS float*)(F.lds + RING_OFF + F.wave * 16384);
    constexpr int I_IN = 337 * 64, I_OUT = 128 * 64, I_13 = 688 * 64, I_2 = 128 * 172, I_L = I_IN + I_OUT + I_13 + I_2;
    for (int it = gw; it < NLAYER * I_L; it += NGW) {
        const int l = it / I_L; int r = it % I_L;
        if (r < I_IN) {
            const int kb = r / 337, cb = r % 337; const float* src = F.kin[I_WIN] + (size_t)l * DM * P_IN; int ld = P_IN, col0, row0, nc = 32;
            if (cb < 192) { col0 = 32 * cb; row0 = 32 * cb; }
            else if (cb < 288) { col0 = 6160 + 32 * (cb - 192); row0 = 6144 + 32 * (cb - 192); }
            else if (cb < 328) { col0 = 9424 + 32 * (cb - 288); row0 = 9216 + 32 * (cb - 288); }
            else if (cb == 328) { col0 = 6144; row0 = 10496; nc = 16; }
            else if (cb < 335) { col0 = 9232 + 32 * (cb - 329); row0 = 10512 + 32 * (cb - 329); }
            else if (cb == 335) { src = l ? F.kin[I_VRD] + (size_t)(l - 1) * DM * 32 : nullptr; ld = 32; col0 = 0; row0 = 10704; }
            else { src = nullptr; col0 = 0; row0 = 10736; nc = 16; }
            conv_item(src, ld, col0, nc, DM, WSP(bf16, WS_WIN + l * WIN_L), row0, kb, scr, F.lane); continue; }
        r -= I_IN;
        if (r < I_OUT) { const int kb = r / 128, cb = r % 128; conv_item(F.kin[I_WOUT] + (size_t)l * DM * DM, DM, 32 * cb, 32, DM, WSP(bf16, WS_WOUT + l * WOUT_L), 32 * cb, kb, scr, F.lane); continue; }
        r -= I_OUT;
        if (r < I_13) { const int kb = r / 688, cb = r % 688, pn = cb >> 3, wi = cb & 7;
            const float* src = (wi < 4 ? F.kin[I_W1] : F.kin[I_W3]) + (size_t)l * DM * DFF;
            conv_item(src, DFF, 128 * pn + 32 * (wi & 3), 32, DM, WSP(bf16, WS_W13 + l * W13_L), 32 * cb, kb, scr, F.lane); continue; }
        r -= I_13;
        { const int kb = r / 128, cb = r % 128; conv_item(F.kin[I_W2] + (size_t)l * DFF * DM, DM, 32 * cb, 32, DFF, WSP(bf16, WS_W2 + l * W2_L), 32 * cb, kb, scr, F.lane); }
    }
}
__device__ __forceinline__ void p0_prologue_b(Frame& F) {
    const int gt = F.bx * (NWAVES * 64) + F.tid, NT = F.G * NWAVES * 64;
    const float* MODP = WSP(float, WS_MODP); float* MOD = WSP(float, WS_MOD);
    for (int idx = gt; idx < NLAYER * 2 * 24576; idx += NT) {
        const int l = idx / 49152, rem = idx % 49152, b = rem / 24576, n = rem % 24576;
        float s = F.kin[I_ADAB][l * 24576 + n];
#pragma unroll 8
        for (int kc = 0; kc < 32; ++kc) s += MODP[((size_t)(l * 32 + kc) * 2 + b) * 24576 + n];
        MOD[idx] = s;
    }
    if (F.bx == 0) { float* TAB = WSP(float, WS_TAB);
        for (int i = F.tid; i < 24 * 128; i += NWAVES * 64) { const int hh = i >> 7, d = i & 127; TAB[i] = F.kin[I_RELB][t5_bucket(d) * 24 + hh] * LOG2E; } }
}
__device__ __forceinline__ void rms_phase(Frame& F, const float* xin, const float* sh, const float* sc) {
    const int gw = F.vcu * NWAVES + F.wave, NGW = F.G * NWAVES;
    bf16* XN = WSP(bf16, WS_XN);
    for (int m = gw; m < M; m += NGW) {
        const int b = m >> 13;
        const f32x4* xr = (const f32x4*)(xin + (size_t)m * DM) + F.lane;
        f32x4 v[16]; float ss = 0.f;
#pragma unroll
        for (int j = 0; j < 16; ++j) { v[j] = xr[64 * j]; ss += (v[j].x * v[j].x + v[j].y * v[j].y) + (v[j].z * v[j].z + v[j].w * v[j].w); }
        const float rstd = rsqrtf(wave_sum(ss) * (1.0f / DM) + 1e-6f);
        const f32x4* scp = (const f32x4*)(sc + (size_t)b * 24576) + F.lane; const f32x4* shp = (const f32x4*)(sh + (size_t)b * 24576) + F.lane;
        v2u* o8 = (v2u*)(XN + (size_t)m * DM) + F.lane;
#pragma unroll
        for (int j = 0; j < 16; ++j) { const f32x4 s4 = scp[64 * j], h4 = shp[64 * j]; const f32x4 o = v[j] * rstd * (s4 + 1.0f) + h4;
            v2u w; w.x = pk2(o.x, o.y); w.y = pk2(o.z, o.w); o8[64 * j] = w; }
    }
}
__device__ __forceinline__ void unpack8(const v4u r, float (&f)[8]) { f[0] = bflo(r.x); f[1] = bfhi(r.x); f[2] = bflo(r.y); f[3] = bfhi(r.y); f[4] = bflo(r.z); f[5] = bfhi(r.z); f[6] = bflo(r.w); f[7] = bfhi(r.w); }
__device__ __forceinline__ v4u pack8(const float (&f)[8]) { v4u o; o.x = pk2(f[0], f[1]); o.y = pk2(f[2], f[3]); o.z = pk2(f[4], f[5]); o.w = pk2(f[6], f[7]); return o; }
__device__ __forceinline__ void prep_norm(Frame& F, int l) {
    const int gw = F.vcu * NWAVES + F.wave, NGW = F.G * NWAVES, lane = F.lane, sub = lane >> 3, ch = lane & 7;
    float gqa[8], gka[8], gqd[8], gkd[8];
#pragma unroll
    for (int e = 0; e < 8; ++e) { gqa[e] = F.kin[I_DQN][l * 64 + ch * 8 + e] * QSCALE; gka[e] = F.kin[I_DKN][l * 64 + ch * 8 + e];
                                  gqd[e] = F.kin[I_SQN][l * 64 + ch * 8 + e] * QSCALE; gkd[e] = F.kin[I_SKN][l * 64 + ch * 8 + e]; }
    const bf16* COLS = WSP(bf16, WS_COLS); bf16* QKA = WSP(bf16, WS_QKA); bf16* QKD = WSP(bf16, WS_QKD);
    for (int m = gw; m < M; m += NGW) {
        const bf16* src = COLS + (size_t)m * NMAIN;
#pragma unroll
        for (int i = 0; i < 4; ++i) { const int vec = i * 8 + sub, col = vec * 64 + ch * 8;
            float f[8]; unpack8(*(const v4u*)(src + CA_Q + col), f); float ss = 0.f;
#pragma unroll
            for (int e = 0; e < 8; ++e) ss += f[e] * f[e];
            ss = sum8(ss);
            const float rstd = rsqrtf(ss * (1.0f / 64.0f) + 1e-6f);
#pragma unroll
            for (int e = 0; e < 8; ++e) f[e] = f[e] * rstd * (i < 2 ? gqa[e] : gka[e]);
            *(v4u*)(QKA + (size_t)m * 2048 + col) = pack8(f); }
#pragma unroll
        for (int i = 0; i < 3; ++i) { const int vec = i * 8 + sub, col = vec * 64 + ch * 8;
            if (vec < 18) { float f[8]; unpack8(*(const v4u*)(src + CD_Q + col), f); float ss = 0.f;
#pragma unroll
                for (int e = 0; e < 8; ++e) ss += f[e] * f[e];
                ss = sum8(ss);
                const float rstd = rsqrtf(ss * (1.0f / 64.0f) + 1e-6f);
#pragma unroll
                for (int e = 0; e < 8; ++e) f[e] = f[e] * rstd * (vec < 16 ? gqd[e] : gkd[e]);
                *(v4u*)(QKD + (size_t)m * 1152 + col) = pack8(f); } }
    }
}
__device__ __forceinline__ void prep_loga(Frame& F, int l) {
    LAS float* gdl = (LAS float*)(F.lds + RING_OFF);
    float gu[16];
#pragma unroll
    for (int j = 0; j < 16; ++j) gu[j] = F.kin[I_GGU][((size_t)l * 16 + j) * 512 + F.tid];
    const float bias = F.kin[I_GGB][l * 512 + F.tid];
    const float* LOWR = WSP(float, WS_LOWR); float* LOGA = WSP(float, WS_LOGA);
    for (int tile = F.bx; tile < M / 64; tile += F.G) {
        const size_t row0 = (size_t)tile * 64;
        __syncthreads();
#pragma unroll
        for (int i = 0; i < 2; ++i) { const int idx = F.tid + 512 * i; gdl[idx] = LOWR[(row0 + (idx >> 4)) * 256 + (idx & 15)]; }
        __syncthreads();
#pragma unroll 4
        for (int t = 0; t < 64; ++t) { const LAS f32x4* gp = (const LAS f32x4*)(gdl + t * 16); const f32x4 g0 = gp[0], g1 = gp[1], g2 = gp[2], g3 = gp[3];
            float z = bias + g0.x * gu[0] + g0.y * gu[1] + g0.z * gu[2] + g0.w * gu[3] + g1.x * gu[4] + g1.y * gu[5] + g1.z * gu[6] + g1.w * gu[7]
                    + g2.x * gu[8] + g2.y * gu[9] + g2.z * gu[10] + g2.w * gu[11] + g3.x * gu[12] + g3.y * gu[13] + g3.z * gu[14] + g3.w * gu[15];
            LOGA[(row0 + t) * 512 + F.tid] = (fminf(z, 0.f) - __logf(1.0f + __expf(-fabsf(z)))) * (1.0f / 16.0f); }
    }
}
__device__ __forceinline__ int next_item(Frame& F, gu32* ctr) {
    volatile LAS int* slot = (volatile LAS int*)(F.lds + LDSCTL_OFF + 64);
    __syncthreads();
    if (F.tid == 0) *slot = (int)__hip_atomic_fetch_add(ctr, 1u, RLX_AGENT);
    __syncthreads();
    return *slot;
}
typedef float f32x16 __attribute__((ext_vector_type(16)));
__device__ __forceinline__ float xother32(float v) { unsigned a = __builtin_bit_cast(unsigned, v), b = a; asm volatile("" : "+v"(b)); auto rr = __builtin_amdgcn_permlane32_swap(a, b, false, false);
    const unsigned lo = rr[0], hi = rr[1]; return __builtin_bit_cast(float, (unsigned)((__builtin_amdgcn_mbcnt_hi(~0u, __builtin_amdgcn_mbcnt_lo(~0u, 0u)) & 32u) ? lo : hi)); }
__device__ __forceinline__ float xsum32(float v) { return v + xother32(v); }
__device__ __forceinline__ float xmax32(float v) { return fmaxf(v, xother32(v)); }
__device__ __forceinline__ int crow16(int r, int hi) { return (r & 3) + 8 * (r >> 2) + 4 * hi; }
template <bool ISA>
__device__ __forceinline__ void attn_unit(Frame& F, int l, int b, int hx, int qb) {
    constexpr int DV = ISA ? 128 : 64, NDV = DV / 32, KSTR = ISA ? 272 : 144, VSTR = 144, KBYTES = 64 * KSTR, VBYTES = DV * VSTR, BUFB = KBYTES + VBYTES, NCH = ISA ? 2 : 1;
    constexpr float NEG = -1e30f;
    LAS unsigned char* L = F.lds + RING_OFF;
    const int tid = F.tid, lane = F.lane, r32 = lane & 31, hi = lane >> 5, qs = F.wave & 3, grp = F.wave >> 2, q0 = qb * 128;
    const int kvh = hx >> 2, hd = kvh * 8 + (hx & 3) * 2 + grp;
    const bf16* Qp; const bf16* Kp; const bf16* VT; int ldq;
    if (ISA) { const bf16* QKA = WSP(bf16, WS_QKA); Qp = QKA + (size_t)b * SEQ * 2048 + hx * 128 + grp * 64; Kp = QKA + (size_t)b * SEQ * 2048 + 1024 + hx * 128; ldq = 2048; VT = WSP(bf16, WS_VTA) + (size_t)(b * 8 + hx) * 128 * VROW; }
    else { const bf16* QKD = WSP(bf16, WS_QKD); Qp = QKD + (size_t)b * SEQ * 1152 + hd * 64; Kp = QKD + (size_t)b * SEQ * 1152 + 1024 + kvh * 64; ldq = 1152; VT = WSP(bf16, WS_VTD) + (size_t)(b * 2 + kvh) * 64 * VROW; }
    const int qpos = q0 + 32 * qs + r32;
    bf16x8 qr[4];
#pragma unroll
    for (int d0 = 0; d0 < 4; ++d0) qr[d0] = *(const bf16x8*)(Qp + (size_t)qpos * ldq + d0 * 16 + hi * 8);
    LAS float* Bt = (LAS float*)(L + 2 * BUFB);
    { const float* TAB = WSP(float, WS_TAB);
      if (ISA) { if (tid < 130) Bt[tid] = tid == 0 ? NEG : (tid == 129 ? 0.f : TAB[hx * 128 + tid - 1] - TAB[hx * 128 + 127]); }
      else { if (tid < 260) { const int gi = tid >= 130, t = tid - 130 * gi; Bt[tid] = (t == 0 || t == 129) ? NEG : TAB[(8 + kvh * 8 + (hx & 3) * 2 + gi) * 128 + t - 1]; } } }
    const int TQ = q0 >> 6, T0 = ISA ? 0 : (TQ >= 2 ? TQ - 2 : 0), T1 = TQ + 1;
    v4u kreg[NCH], vreg[NCH];
#define AT_GLOAD(T) do { _Pragma("unroll") for (int i_ = 0; i_ < NCH; ++i_) { const int c_ = tid + 512 * i_; \
        const int kr_ = ISA ? (c_ >> 4) : (c_ >> 3), kc_ = ISA ? (c_ & 15) : (c_ & 7); kreg[i_] = *(const v4u*)(Kp + (size_t)((T) * 64 + kr_) * ldq + kc_ * 8); \
        const int vr_ = c_ >> 3, vc_ = c_ & 7; vreg[i_] = *(const v4u*)(VT + (size_t)vr_ * VROW + (T) * 64 + vc_ * 8); } } while (0)
#define AT_LWRITE(buf) do { _Pragma("unroll") for (int i_ = 0; i_ < NCH; ++i_) { const int c_ = tid + 512 * i_; \
        const int kr_ = ISA ? (c_ >> 4) : (c_ >> 3), kc_ = ISA ? (c_ & 15) : (c_ & 7); *(LAS v4u*)(L + (buf) * BUFB + kr_ * KSTR + kc_ * 16) = kreg[i_]; \
        const int vr_ = c_ >> 3, vc_ = c_ & 7; *(LAS v4u*)(L + (buf) * BUFB + KBYTES + vr_ * VSTR + vc_ * 16) = vreg[i_]; } } while (0)
    f32x16 o[NDV];
#pragma unroll
    for (int i = 0; i < NDV; ++i) o[i] = (f32x16){0.f, 0.f, 0.f, 0.f, 0.f, 0.f, 0.f, 0.f, 0.f, 0.f, 0.f, 0.f, 0.f, 0.f, 0.f, 0.f};
    float m_run = ISA ? NEG : F.kin[I_SSINK][l * 16 + hd] * LOG2E, l_run = ISA ? 0.f : (hi == 0 ? 1.f : 0.f);
    const int krow = (r32 & 16) | (r32 & 3) | ((r32 & 4) << 1) | ((r32 & 8) >> 1);
    const int koff = krow * KSTR + (ISA ? grp * 128 : 0) + hi * 16, voff = KBYTES + r32 * VSTR + hi * 16;
    AT_GLOAD(T0); AT_LWRITE(0); __syncthreads();
#pragma unroll 1
    for (int T = T0; T <= T1; ++T) {
        const int cur = (T - T0) & 1;
        AT_GLOAD(T < T1 ? T + 1 : T1);
        LAS const unsigned char* Kb = L + cur * BUFB;
        f32x16 s[2];
#pragma unroll
        for (int blk = 0; blk < 2; ++blk) { s[blk] = (f32x16){0.f, 0.f, 0.f, 0.f, 0.f, 0.f, 0.f, 0.f, 0.f, 0.f, 0.f, 0.f, 0.f, 0.f, 0.f, 0.f};
#pragma unroll
            for (int d0 = 0; d0 < 4; ++d0) { const bf16x8 kf = *(const LAS bf16x8*)(Kb + koff + blk * 32 * KSTR + d0 * 32); s[blk] = __builtin_amdgcn_mfma_f32_32x32x16_bf16(kf, qr[d0], s[blk], 0, 0, 0); } }
        if (!ISA || T >= TQ - 2) {
            const LAS float* bt = Bt + (ISA ? 0 : grp * 130) + 1; const int d0 = qpos - T * 64 - 8 * hi;
#pragma unroll
            for (int blk = 0; blk < 2; ++blk)
#pragma unroll
                for (int r = 0; r < 16; ++r) { const int dist = d0 - (32 * blk + 16 * (r >> 3) + (r & 7)); const int di = dist < -1 ? -1 : (dist > 128 ? 128 : dist); s[blk][r] += bt[di]; } }
        float mt = s[0][0];
#pragma unroll
        for (int r = 1; r < 16; ++r) mt = fmaxf(mt, s[0][r]);
#pragma unroll
        for (int r = 0; r < 16; ++r) mt = fmaxf(mt, s[1][r]);
        mt = xmax32(mt);
        const float m_new = fmaxf(m_run, mt);
        if (__any(m_new > m_run)) { const float alpha = __builtin_amdgcn_exp2f(m_run - m_new); l_run *= alpha;
#pragma unroll
            for (int i = 0; i < NDV; ++i)
#pragma unroll
                for (int r = 0; r < 16; ++r) o[i][r] *= alpha;
            m_run = m_new; }
        float ls = 0.f;
#pragma unroll
        for (int blk = 0; blk < 2; ++blk)
#pragma unroll
            for (int r = 0; r < 16; ++r) { const float pv_ = __builtin_amdgcn_exp2f(s[blk][r] - m_run); s[blk][r] = pv_; ls += pv_; }
        l_run += ls;
#pragma unroll
        for (int sl = 0; sl < 4; ++sl) { const int blk = sl >> 1, r0 = 8 * (sl & 1);
            v4u pw; pw.x = pg8::cvt_pk_bf16(s[blk][r0], s[blk][r0 + 1]); pw.y = pg8::cvt_pk_bf16(s[blk][r0 + 2], s[blk][r0 + 3]); pw.z = pg8::cvt_pk_bf16(s[blk][r0 + 4], s[blk][r0 + 5]); pw.w = pg8::cvt_pk_bf16(s[blk][r0 + 6], s[blk][r0 + 7]);
            const bf16x8 pf = __builtin_bit_cast(bf16x8, pw);
#pragma unroll
            for (int i = 0; i < NDV; ++i) { const bf16x8 vf = *(const LAS bf16x8*)(Kb + voff + i * 32 * VSTR + sl * 32); o[i] = __builtin_amdgcn_mfma_f32_32x32x16_bf16(vf, pf, o[i], 0, 0, 0); } }
        AT_LWRITE(cur ^ 1);
        __syncthreads();
    }
#undef AT_GLOAD
#undef AT_LWRITE
    const float inv = 1.0f / xsum32(l_run);
    bf16* MIX = WSP(bf16, WS_MIXED);
    if (ISA) {
        int ll_ = l; asm volatile("" : "+s"(ll_)); const float lam_init = ll_ == 0 ? 0.2f : 0.35550906759f;     float lam_full;
        { const float* lm = F.kin[I_DLAM] + (size_t)l * 256; const float s1 = wave_sum(lm[lane] * lm[64 + lane]), s2 = wave_sum(lm[128 + lane] * lm[192 + lane]); lam_full = __expf(s1) - __expf(s2) + lam_init; }
        LAS float* R1 = (LAS float*)L;
        LAS bf16* R2 = (LAS bf16*)(L + 66048);
        const int ql = 32 * qs + r32;
        if (grp == 1) {
#pragma unroll
            for (int i = 0; i < NDV; ++i)
#pragma unroll
                for (int r = 0; r < 16; ++r) R1[ql * 129 + 32 * i + crow16(r, hi)] = lam_full * inv * o[i][r]; }
        __syncthreads();
        if (grp == 0) { float ss = 0.f;
#pragma unroll
            for (int i = 0; i < NDV; ++i)
#pragma unroll
                for (int r = 0; r < 16; ++r) { const float d = o[i][r] * inv - R1[ql * 129 + 32 * i + crow16(r, hi)]; o[i][r] = d; ss += d * d; }
            const float rstd = rsqrtf(xsum32(ss) * (1.0f / 128.0f) + 1e-6f) * (1.0f - lam_init);
            const float* sl = F.kin[I_DSUB] + l * 128;
#pragma unroll
            for (int i = 0; i < NDV; ++i)
#pragma unroll
                for (int r = 0; r < 16; ++r) { const int dv = 32 * i + crow16(r, hi); R2[ql * 132 + dv] = (bf16)f2bf(o[i][r] * rstd * sl[dv]); } }
        __syncthreads();
#pragma unroll
        for (int i = 0; i < 4; ++i) { const int c = tid + 512 * i, row = c >> 4, ch = c & 15; const LAS v2u* sp = (const LAS v2u*)(R2 + row * 132 + ch * 8); const v2u a = sp[0], bb = sp[1];
            *(v4u*)(MIX + (size_t)(b * SEQ + q0 + row) * DM + hx * 128 + ch * 8) = (v4u){a.x, a.y, bb.x, bb.y}; }
    } else {
        LAS bf16* R = (LAS bf16*)L + F.wave * 2176;
#pragma unroll
        for (int i = 0; i < NDV; ++i)
#pragma unroll
            for (int r = 0; r < 16; ++r) R[r32 * 68 + 32 * i + crow16(r, hi)] = (bf16)f2bf(o[i][r] * inv);
#pragma unroll
        for (int i = 0; i < 4; ++i) { const int c = lane + 64 * i, row = c >> 3, ch = c & 7; const LAS v2u* sp = (const LAS v2u*)(R + row * 68 + ch * 8); const v2u a = sp[0], bb = sp[1];
            *(v4u*)(MIX + (size_t)(b * SEQ + q0 + 32 * qs + row) * DM + 3072 + hd * 64 + ch * 8) = (v4u){a.x, a.y, bb.x, bb.y}; }
    }
}
__device__ __forceinline__ void prep_gla(Frame& F) {
    LAS float* Lb = (LAS float*)(F.lds + RING_OFF); LAS float* Qd = Lb + 64 * 129; LAS float* Ki = Qd + 64 * 129; LAS bf16* Kt = (LAS bf16*)(Ki + 64 * 129);
    const bf16* COLS = WSP(bf16, WS_COLS); const float* LOGA = WSP(float, WS_LOGA);
    bf16* QDEC = WSP(bf16, WS_QDEC); bf16* KDT = WSP(bf16, WS_KDT); bf16* AMg = WSP(bf16, WS_AM); float* EBL = WSP(float, WS_EBL);
    for (int u = F.bx; u < 1024; u += F.G) {
        const int b = u >> 9, h = (u >> 7) & 3, ck = u & 127; const size_t row0 = (size_t)b * SEQ + ck * 64;
        __syncthreads();
        for (int idx = F.tid; idx < 8192; idx += NWAVES * 64) { const int t = idx >> 7, d = idx & 127; Lb[t * 129 + d] = LOGA[(row0 + t) * 512 + h * 128 + d]; }
        __syncthreads();
        if (F.tid < 128) { float acc = 0.f;
#pragma unroll 8
            for (int t = 0; t < 64; ++t) { acc += Lb[t * 129 + F.tid]; Lb[t * 129 + F.tid] = acc; }
            EBL[(size_t)u * 128 + F.tid] = __expf(acc); }
        __syncthreads();
        for (int idx = F.tid; idx < 8192; idx += NWAVES * 64) { const int t = idx >> 7, d = idx & 127; const float bt = Lb[t * 129 + d], bl = Lb[63 * 129 + d];
            const float q = bf2f(COLS[(row0 + t) * NMAIN + CB_Q + h * 128 + d]) * 0.08838834764831845f, k = bf2f(COLS[(row0 + t) * NMAIN + CB_K + h * 128 + d]);
            const float qd = q * __expf(bt); Qd[t * 129 + d] = qd; Ki[t * 129 + d] = k * __expf(-bt); Kt[d * 72 + t] = (bf16)f2bf(k * __expf(bl - bt));
            QDEC[((size_t)u * 64 + t) * 128 + d] = (bf16)f2bf(qd); }
        __syncthreads();
#pragma unroll
        for (int i = 0; i < 2; ++i) { const int c_ = F.tid + 512 * i, row = c_ >> 3, ch = c_ & 7; const LAS v2u* sp = (const LAS v2u*)(Kt + row * 72 + ch * 8); const v2u a = sp[0], bb = sp[1];
            *(v4u*)(KDT + ((size_t)u * 128 + row) * 64 + ch * 8) = (v4u){a.x, a.y, bb.x, bb.y}; }
        { const int c = F.tid >> 3, sg = F.tid & 7; float acc[8];
#pragma unroll
          for (int e = 0; e < 8; ++e) acc[e] = 0.f;
#pragma unroll 4
          for (int d = 0; d < 128; ++d) { const float q = Qd[c * 129 + d];
#pragma unroll
              for (int e = 0; e < 8; ++e) acc[e] += q * Ki[(sg * 8 + e) * 129 + d]; }
#pragma unroll
          for (int e = 0; e < 8; ++e) if (sg * 8 + e > c) acc[e] = 0.f;
          *(v4u*)(AMg + ((size_t)u * 64 + c) * 64 + sg * 8) = pack8(acc); }
    }
}
__device__ __forceinline__ void prep_vt(Frame& F, int pass) {
    LAS bf16* T = (LAS bf16*)(F.lds + RING_OFF);
    const bf16* COLS = WSP(bf16, WS_COLS);
    const int nch = pass == 0 ? 144 : 128, nvr = nch * 8;
    for (int tile = F.bx; tile < M / 32; tile += F.G) {
        const int b = tile >> 8, t0 = (tile & 255) * 32;
        __syncthreads();
        for (int idx = F.tid; idx < 32 * nch; idx += NWAVES * 64) { const int tok = idx / nch, ch = idx % nch;
            const int col = pass == 0 ? (ch < 128 ? CA_V + ch * 8 : CD_V + (ch - 128) * 8) : (pass == 1 ? CB_V + ch * 8 : CB_G + ch * 8);
            const v4u v = *(const v4u*)(COLS + (size_t)(b * SEQ + t0 + tok) * NMAIN + col); LAS v2u* d = (LAS v2u*)(T + tok * 1160 + ch * 8); d[0] = (v2u){v.x, v.y}; d[1] = (v2u){v.z, v.w}; }
        __syncthreads();
        for (int idx = F.tid; idx < nvr * 4; idx += NWAVES * 64) { const int ch = idx / nvr, vrow = idx % nvr;
            unsigned e[8];
#pragma unroll
            for (int k = 0; k < 8; ++k) e[k] = T[(ch * 8 + k) * 1160 + vrow];
            v4u o; o.x = e[0] | (e[1] << 16); o.y = e[2] | (e[3] << 16); o.z = e[4] | (e[5] << 16); o.w = e[6] | (e[7] << 16);
            bf16* dst;
            if (pass == 0) dst = vrow < 1024 ? WSP(bf16, WS_VTA) + ((size_t)(b * 8 + (vrow >> 7)) * 128 + (vrow & 127)) * VROW : WSP(bf16, WS_VTD) + ((size_t)(b * 2 + ((vrow - 1024) >> 6)) * 64 + ((vrow - 1024) & 63)) * VROW;
            else dst = WSP(bf16, WS_VTB) + ((size_t)b * 1024 + vrow) * VROW;
            *(v4u*)(dst + t0 + ch * 8) = o; }
    }
}
typedef float f32x4v __attribute__((ext_vector_type(4)));
__device__ __forceinline__ float sum16(float v) { v = sum8(v); v += dpp_f<0x140>(v); return v; }
#define LDS_BARRIER() asm volatile("s_waitcnt lgkmcnt(0)\n\ts_barrier" ::: "memory")
template <int HACK = 0> __device__ __forceinline__ void gla_scan_unit(Frame& F, int l, int b, int h) {
    LAS unsigned char* L = F.lds + RING_OFF;
    constexpr int OQD = 0, OKT = 17408, OAM = 35840, OVT = 45056, OOT = 81920, OEB = 115712, OPS = 116224;
    const int tid = F.tid, lane = F.lane, n = lane & 15, g = lane >> 4, w = F.wave;
    const bf16* QDEC = WSP(bf16, WS_QDEC); const bf16* KDT = WSP(bf16, WS_KDT); const bf16* AMg = WSP(bf16, WS_AM); const float* EBL = WSP(float, WS_EBL);
    const bf16* VTB = WSP(bf16, WS_VTB) + (size_t)(b * 4 + h) * 256 * VROW; const bf16* COLS = WSP(bf16, WS_COLS); bf16* MIX = WSP(bf16, WS_MIXED);
    f32x4v S[8][2];
#pragma unroll
    for (int dt = 0; dt < 8; ++dt)
#pragma unroll
        for (int vt = 0; vt < 2; ++vt) S[dt][vt] = (f32x4v){0.f, 0.f, 0.f, 0.f};
    float gain8[8];
#pragma unroll
    for (int e = 0; e < 8; ++e) gain8[e] = F.kin[I_GON][l * 256 + (tid & 31) * 8 + e];
    v4u pq[2], pk[2], pa, pv[4]; float pe = 0.f;
#define GL_ISSUE(CK) do { const size_t u_ = (size_t)(b * 4 + h) * 128 + (CK); \
        _Pragma("unroll") for (int i = 0; i < 2; ++i) { const int c_ = tid + 512 * i; pq[i] = *(const v4u*)(QDEC + (u_ * 64 + (c_ >> 4)) * 128 + (c_ & 15) * 8); pk[i] = *(const v4u*)(KDT + (u_ * 128 + (c_ >> 3)) * 64 + (c_ & 7) * 8); } \
        pa = *(const v4u*)(AMg + (u_ * 64 + (tid >> 3)) * 64 + (tid & 7) * 8); \
        _Pragma("unroll") for (int i = 0; i < 4; ++i) { const int c_ = tid + 512 * i; pv[i] = *(const v4u*)(VTB + (size_t)(c_ >> 3) * VROW + (CK) * 64 + (c_ & 7) * 8); } \
        pe = EBL[u_ * 128 + (tid & 127)]; } while (0)
#define GL_WRITE() do { _Pragma("unroll") for (int i = 0; i < 2; ++i) { const int c_ = tid + 512 * i; *(LAS v4u*)(L + OQD + (c_ >> 4) * 272 + (c_ & 15) * 16) = pq[i]; *(LAS v4u*)(L + OKT + (c_ >> 3) * 144 + (c_ & 7) * 16) = pk[i]; } \
        *(LAS v4u*)(L + OAM + (tid >> 3) * 144 + (tid & 7) * 16) = pa; \
        _Pragma("unroll") for (int i = 0; i < 4; ++i) { const int c_ = tid + 512 * i; *(LAS v4u*)(L + OVT + (c_ >> 3) * 144 + (c_ & 7) * 16) = pv[i]; } \
        ((LAS float*)(L + OEB))[tid & 127] = pe; } while (0)
    GL_ISSUE(0); GL_WRITE();
    LDS_BARRIER();
#pragma unroll 1
    for (int ck = 0; ck < 128; ++ck) {
        const size_t row0 = (size_t)b * SEQ + ck * 64;
        v4u gq[4];
#pragma unroll
        for (int i = 0; i < 4; ++i) gq[i] = (HACK & 1) ? (v4u){0u, 0u, 0u, 0u} : *(const v4u*)(COLS + (row0 + (tid >> 5) + 16 * i) * NMAIN + CB_G + h * 256 + (tid & 31) * 8);
        GL_ISSUE((HACK & 1) && ck >= 2 ? 2 : (ck + 1 < 128 ? ck + 1 : 127));
        bf16x8 vf[2][2];
#pragma unroll
        for (int vt = 0; vt < 2; ++vt)
#pragma unroll
            for (int ks = 0; ks < 2; ++ks) vf[vt][ks] = *(const LAS bf16x8*)(L + OVT + (32 * w + 16 * vt + n) * 144 + (32 * ks + 8 * g) * 2);
        f32x4v o[4][2];
#pragma unroll
        for (int ct = 0; ct < 4; ++ct)
#pragma unroll
            for (int vt = 0; vt < 2; ++vt) o[ct][vt] = (f32x4v){0.f, 0.f, 0.f, 0.f};
#pragma unroll
        for (int ct = 0; ct < 4; ++ct)
#pragma unroll
            for (int ks = 0; ks < 2; ++ks) { const bf16x8 af = *(const LAS bf16x8*)(L + OAM + (16 * ct + n) * 144 + (32 * ks + 8 * g) * 2);
#pragma unroll
                for (int vt = 0; vt < 2; ++vt) o[ct][vt] = __builtin_amdgcn_mfma_f32_16x16x32_bf16(af, vf[vt][ks], o[ct][vt], 0, 0, 0); }
#pragma unroll
        for (int kk = 0; kk < 4; ++kk) { bf16x8 sf[2];
#pragma unroll
            for (int vt = 0; vt < 2; ++vt) { v4u pw; pw.x = pg8::cvt_pk_bf16(S[2 * kk][vt][0], S[2 * kk][vt][1]); pw.y = pg8::cvt_pk_bf16(S[2 * kk][vt][2], S[2 * kk][vt][3]);
                pw.z = pg8::cvt_pk_bf16(S[2 * kk + 1][vt][0], S[2 * kk + 1][vt][1]); pw.w = pg8::cvt_pk_bf16(S[2 * kk + 1][vt][2], S[2 * kk + 1][vt][3]); sf[vt] = __builtin_bit_cast(bf16x8, pw); }
#pragma unroll
            for (int ct = 0; ct < 4; ++ct) { const LAS unsigned char* qp = L + OQD + (16 * ct + n) * 272 + (32 * kk + 4 * g) * 2; const v2u qa = *(const LAS v2u*)qp, qb = *(const LAS v2u*)(qp + 32);
                const bf16x8 qf = __builtin_bit_cast(bf16x8, (v4u){qa.x, qa.y, qb.x, qb.y});
#pragma unroll
                for (int vt = 0; vt < 2; ++vt) o[ct][vt] = __builtin_amdgcn_mfma_f32_16x16x32_bf16(qf, sf[vt], o[ct][vt], 0, 0, 0); } }
#pragma unroll
        for (int dt = 0; dt < 8; ++dt) { const f32x4v eb = *(const LAS f32x4v*)(L + OEB + (16 * dt + 4 * g) * 4);
#pragma unroll
            for (int vt = 0; vt < 2; ++vt) S[dt][vt] = S[dt][vt] * eb;
#pragma unroll
            for (int ks = 0; ks < 2; ++ks) { const bf16x8 kf = *(const LAS bf16x8*)(L + OKT + (16 * dt + n) * 144 + (32 * ks + 8 * g) * 2);
#pragma unroll
                for (int vt = 0; vt < 2; ++vt) S[dt][vt] = __builtin_amdgcn_mfma_f32_16x16x32_bf16(kf, vf[vt][ks], S[dt][vt], 0, 0, 0); } }
        LAS float* PS = (LAS float*)(L + OPS) + (ck & 1) * 512;
#pragma unroll
        for (int ct = 0; ct < 4; ++ct)
#pragma unroll
            for (int r = 0; r < 4; ++r) { const float ss = sum16(o[ct][0][r] * o[ct][0][r] + o[ct][1][r] * o[ct][1][r]); if (n == 0) PS[(16 * ct + 4 * g + r) * 8 + w] = ss; }
        LDS_BARRIER();
        GL_WRITE();
#pragma unroll
        for (int ct = 0; ct < 4; ++ct)
#pragma unroll
            for (int vt = 0; vt < 2; ++vt)
#pragma unroll
                for (int r = 0; r < 4; ++r) *(LAS bf16*)(L + OOT + (16 * ct + 4 * g + r) * 528 + (32 * w + 16 * vt + n) * 2) = (bf16)f2bf(o[ct][vt][r]);
        LDS_BARRIER();
#pragma unroll
        for (int i = 0; i < 4; ++i) { const int tok = (tid >> 5) + 16 * i; float ov[8], gv[8]; unpack8(*(const LAS v4u*)(L + OOT + tok * 528 + (tid & 31) * 16), ov); unpack8(gq[i], gv);
            const LAS f32x4v* pp = (const LAS f32x4v*)(PS + tok * 8); const f32x4v p0 = pp[0], p1 = pp[1];
            const float rstd = rsqrtf(((p0.x + p0.y) + (p0.z + p0.w) + (p1.x + p1.y) + (p1.z + p1.w)) * (1.0f / 256.0f) + 1e-6f);
#pragma unroll
            for (int e = 0; e < 8; ++e) ov[e] = ov[e] * (rstd * gain8[e]) * silu_g(gv[e]);
            if (!(HACK & 2)) *(v4u*)(MIX + (row0 + tok) * DM + 1024 + h * 256 + (tid & 31) * 8) = pack8(ov); }
    }
#undef GL_ISSUE
#undef GL_WRITE
}
constexpr int RC_AT = 0, RC_RT = 2048, RC_BK = 4096, RC_VF = 8192, RC_GF = 10240, RC_U0 = 12288, RC_Y0 = 16384, RC_P15 = 20480, RC_BN = 20736, RC_BYTES = 20800;
__device__ __forceinline__ void rwkv_chunks_of_tile(Frame& F, int l, int tile) {
    const int team = F.tid >> 8, tt = F.tid & 255;
    LAS float* Lt = (LAS float*)(F.lds + RING_OFF) + team * 12288;
    LAS float* XA = Lt; LAS float* XR = Lt + 1040; LAS float* ZB = Lt + 2080; LAS float* ZK = Lt + 3120; LAS float* TB = Lt + 4160; LAS float* TK = Lt + 5200; LAS float* VV = Lt + 6240;
    LAS float* ATl = Lt + 7280; LAS float* U0l = Lt + 8320; LAS float* W1 = Lt + 9360;
    LAS float* Aab = Lt + 10400; LAS float* Aak = Lt + 10672; LAS float* Arb = Lt + 10944; LAS float* Ark = Lt + 11216; LAS float* TT = Lt + 11488;
    const float* RW = WSP(float, WS_RW); const unsigned* RWU = WSP(unsigned, WS_RW); constexpr size_t RS = RW_ONE / 4; unsigned char* RWC = F.ws + WS_RWC;
    float pw_[16], pr_[4], pk_[4], pv_[4], pa_[4], pb_[4], pg_[4];
#define RC_FETCH(P) do { const int h_ = 2 * (P) + team; const size_t cb_ = (size_t)tile * 16 * 1024 + h_ * 64 + (tt & 63); \
        _Pragma("unroll") for (int t = 0; t < 16; ++t) pw_[t] = RW[RS + cb_ + (size_t)t * 1024]; \
        _Pragma("unroll") for (int e = 0; e < 4; ++e) { const size_t o_ = cb_ + (size_t)(4 * (tt >> 6) + e) * 1024; const unsigned u0 = RWU[o_], u2 = RWU[2 * RS + o_], u3 = RWU[3 * RS + o_]; \
            pr_[e] = bflo(u0); pk_[e] = bfhi(u0); pv_[e] = bflo(u2); pg_[e] = bfhi(u2); pa_[e] = bflo(u3); pb_[e] = bfhi(u3); } } while (0)
    RC_FETCH(0);
#pragma unroll 1
    for (int pair = 0; pair < 8; ++pair) {
        const int uc = ((tile >> 9) * 16 + 2 * pair + team) * 512 + (tile & 511), b = uc >> 13, h = (uc >> 9) & 15, ck = uc & 511; unsigned char* rec = RWC + ((size_t)ck * 32 + (uc >> 9)) * RC_BYTES;     (void)b;
        __syncthreads();
        {
          const int j = tt & 63, q = tt >> 6;
          float cl = 0.f, clq[4] = {0.f, 0.f, 0.f, 0.f}, clm = 0.f;
#pragma unroll
          for (int t = 0; t < 16; ++t) { const float lw = __logf(pw_[t]); if (t == 4 * q) clm = cl; cl += lw; if ((t >> 2) == q) clq[t & 3] = cl; }
#pragma unroll
          for (int e = 0; e < 4; ++e) { const int t = 4 * q + e; const float cprev = e == 0 ? clm : clq[e - 1], cc = clq[e];
              const float rr = pr_[e], kk = pk_[e], vv = pv_[e], aa = pa_[e], bb = pb_[e];
              XA[t * 65 + j] = aa * __expf(cprev); XR[t * 65 + j] = rr * __expf(cc); const float ei = __expf(-cc), ef = __expf(cl - cc);
              ZB[t * 65 + j] = bb * ei; ZK[t * 65 + j] = kk * ei; TB[t * 65 + j] = bb * ef; TK[t * 65 + j] = kk * ef; VV[t * 65 + j] = vv; }
          if (q == 0) ((float*)(rec + RC_P15))[j] = __expf(cl);
          { v2u gw; gw.x = pk2(pg_[0], pg_[1]); gw.y = pk2(pg_[2], pg_[3]); *(v2u*)(rec + RC_GF + (((j >> 4) * 64 + 16 * q + (j & 15)) * 8)) = gw; } }
        RC_FETCH(pair < 7 ? pair + 1 : 7);
        __syncthreads();
        {
          const int q = tt >> 6, n = tt & 15, g = (tt >> 4) & 3; const LAS float* X = (q & 2) ? XR : XA; const LAS float* Z = (q & 1) ? ZK : ZB; LAS float* O = q == 0 ? Aab : (q == 1 ? Aak : (q == 2 ? Arb : Ark));
          f32x4v c = (f32x4v){0.f, 0.f, 0.f, 0.f};
#pragma unroll
          for (int ks = 0; ks < 16; ++ks) c = __builtin_amdgcn_mfma_f32_16x16x4f32(X[n * 65 + 4 * ks + g], Z[n * 65 + 4 * ks + g], c, 0, 0, 0);
#pragma unroll
          for (int rr = 0; rr < 4; ++rr) { const int t = 4 * g + rr; O[t * 17 + n] = ((q & 2) ? n <= t : n < t) ? c[rr] : 0.f; }
          { const int t = tt >> 4, jq = tt & 15; const float* rkp = F.kin[I_RRK] + l * 1024 + h * 64 + 4 * jq; float bn = 0.f;
#pragma unroll
            for (int e = 0; e < 4; ++e) bn += XR[t * 65 + 4 * jq + e] * ZK[t * 65 + 4 * jq + e] * rkp[e];
            bn = sum16(bn); if (jq == 0) ((float*)(rec + RC_BN))[t] = bn; } }
        __syncthreads();
        {
          if (tt < 16) { float col[16];
#pragma unroll
              for (int t = 0; t < 16; ++t) { float acc = (t == tt) ? 1.f : 0.f;
#pragma unroll
                  for (int s = 0; s < 16; ++s) if (s < t) acc += Aab[t * 17 + s] * col[s];
                  col[t] = acc; TT[t * 17 + tt] = acc; } }
          const int q = tt >> 6, n = tt & 15, g = (tt >> 4) & 3; f32x4v c = (f32x4v){0.f, 0.f, 0.f, 0.f};
#pragma unroll
          for (int ks = 0; ks < 4; ++ks) c = __builtin_amdgcn_mfma_f32_16x16x4f32(Aak[n * 17 + 4 * ks + g], VV[(4 * ks + g) * 65 + 16 * q + n], c, 0, 0, 0);
#pragma unroll
          for (int rr = 0; rr < 4; ++rr) W1[(4 * g + rr) * 65 + 16 * q + n] = c[rr]; }
        __syncthreads();
        {
          const int q = tt >> 6, n = tt & 15, g = (tt >> 4) & 3; f32x4v ca = (f32x4v){0.f, 0.f, 0.f, 0.f}, cu = (f32x4v){0.f, 0.f, 0.f, 0.f};
#pragma unroll
          for (int ks = 0; ks < 4; ++ks) { const float tv = TT[n * 17 + 4 * ks + g]; ca = __builtin_amdgcn_mfma_f32_16x16x4f32(tv, XA[(4 * ks + g) * 65 + 16 * q + n], ca, 0, 0, 0); cu = __builtin_amdgcn_mfma_f32_16x16x4f32(tv, W1[(4 * ks + g) * 65 + 16 * q + n], cu, 0, 0, 0); }
#pragma unroll
          for (int rr = 0; rr < 4; ++rr) { ATl[(4 * g + rr) * 65 + 16 * q + n] = ca[rr]; U0l[(4 * g + rr) * 65 + 16 * q + n] = cu[rr]; }
          *(f32x4v*)(rec + RC_U0 + ((q * 64 + 16 * g + n) * 16)) = cu; }
        __syncthreads();
        {
          const int q = tt >> 6, n = tt & 15, g = (tt >> 4) & 3; f32x4v cr, cy = (f32x4v){0.f, 0.f, 0.f, 0.f};
#pragma unroll
          for (int rr = 0; rr < 4; ++rr) cr[rr] = XR[(4 * g + rr) * 65 + 16 * q + n];
#pragma unroll
          for (int ks = 0; ks < 4; ++ks) { const float arb = Arb[n * 17 + 4 * ks + g], ark = Ark[n * 17 + 4 * ks + g];
              cr = __builtin_amdgcn_mfma_f32_16x16x4f32(arb, ATl[(4 * ks + g) * 65 + 16 * q + n], cr, 0, 0, 0);
              cy = __builtin_amdgcn_mfma_f32_16x16x4f32(arb, U0l[(4 * ks + g) * 65 + 16 * q + n], cy, 0, 0, 0);
              cy = __builtin_amdgcn_mfma_f32_16x16x4f32(ark, VV[(4 * ks + g) * 65 + 16 * q + n], cy, 0, 0, 0); }
          *(f32x4v*)(rec + RC_Y0 + ((q * 64 + 16 * g + n) * 16)) = cy;
#pragma unroll
          for (int rr = 0; rr < 4; ++rr) W1[(4 * g + rr) * 65 + 16 * q + n] = cr[rr]; }
        __syncthreads();
        { const int t = tt & 15, jq = tt >> 4, kk = jq >> 3, half = (jq & 7) >> 2, g = jq & 3, j0 = 4 * jq;
          v2u wa, wr; wa.x = pk2(ATl[t * 65 + j0], ATl[t * 65 + j0 + 1]); wa.y = pk2(ATl[t * 65 + j0 + 2], ATl[t * 65 + j0 + 3]); wr.x = pk2(W1[t * 65 + j0], W1[t * 65 + j0 + 1]); wr.y = pk2(W1[t * 65 + j0 + 2], W1[t * 65 + j0 + 3]);
          *(v2u*)(rec + RC_AT + kk * 1024 + (16 * g + t) * 16 + half * 8) = wa; *(v2u*)(rec + RC_RT + kk * 1024 + (16 * g + t) * 16 + half * 8) = wr;
          const int j = tt & 63, gg = tt >> 6; v4u bk; bk.x = pk2(TB[(4 * gg) * 65 + j], TB[(4 * gg + 1) * 65 + j]); bk.y = pk2(TB[(4 * gg + 2) * 65 + j], TB[(4 * gg + 3) * 65 + j]);
          bk.z = pk2(TK[(4 * gg) * 65 + j], TK[(4 * gg + 1) * 65 + j]); bk.w = pk2(TK[(4 * gg + 2) * 65 + j], TK[(4 * gg + 3) * 65 + j]);
          *(v4u*)(rec + RC_BK + (j >> 4) * 1024 + (16 * gg + (j & 15)) * 16) = bk;
          v2u vf; vf.x = pk2(VV[(4 * gg) * 65 + j], VV[(4 * gg + 1) * 65 + j]); vf.y = pk2(VV[(4 * gg + 2) * 65 + j], VV[(4 * gg + 3) * 65 + j]);
          *(v2u*)(rec + RC_VF + ((j >> 4) * 64 + 16 * gg + (j & 15)) * 8) = vf; }
    }
}
#undef RC_FETCH
template <int HACK = 0> __device__ __forceinline__ void rwkv_scan_unit(Frame& F, int l, int b, int h) {
    LAS unsigned char* L = F.lds + RING_OFF;
    const unsigned char* recs = F.ws + WS_RWC + (size_t)(b * 16 + h) * RC_BYTES;
    const int lane = F.lane, n = lane & 15, g = lane >> 4;
    LAS float* XS = (LAS float*)(L + 2 * RC_BYTES);
    if (F.wave >= 2) {
        const int li = F.tid - 128;
        int px[4];
#pragma unroll
        for (int k = 0; k < 4; ++k) { const int x = li + 384 * k; px[k] = x < 1300 ? x : 1299; }
        v4u p0[4], p1[4], p2[4], p3[4], p4[4], p5[4], p6[4], p7[4];
#define RWL_ISSUE(P, CK) do { const int ck_ = (CK) < 512 ? ((HACK & 1) && (CK) >= 4 ? 3 : (CK)) : 511; const v4u* src_ = (const v4u*)(recs + (size_t)ck_ * 32 * RC_BYTES); \
        _Pragma("unroll") for (int k = 0; k < 4; ++k) P[k] = src_[px[k]]; } while (0)
#define RWL_WRITE(P, CK) do { LAS v4u* dst_ = (LAS v4u*)(L + ((CK) & 1) * RC_BYTES); _Pragma("unroll") for (int k = 0; k < 4; ++k) dst_[px[k]] = P[k]; } while (0)
        RWL_ISSUE(p0, 0); RWL_ISSUE(p1, 1); RWL_ISSUE(p2, 2); RWL_ISSUE(p3, 3); RWL_ISSUE(p4, 4); RWL_ISSUE(p5, 5); RWL_ISSUE(p6, 6); RWL_ISSUE(p7, 7);
        RWL_WRITE(p0, 0); RWL_ISSUE(p0, 8);
        LDS_BARRIER();
#pragma unroll 1
        for (int ck = 0; ck < 512; ck += 8) {
            RWL_WRITE(p1, ck + 1); RWL_ISSUE(p1, ck + 9); LDS_BARRIER();
            RWL_WRITE(p2, ck + 2); RWL_ISSUE(p2, ck + 10); LDS_BARRIER();
            RWL_WRITE(p3, ck + 3); RWL_ISSUE(p3, ck + 11); LDS_BARRIER();
            RWL_WRITE(p4, ck + 4); RWL_ISSUE(p4, ck + 12); LDS_BARRIER();
            RWL_WRITE(p5, ck + 5); RWL_ISSUE(p5, ck + 13); LDS_BARRIER();
            RWL_WRITE(p6, ck + 6); RWL_ISSUE(p6, ck + 14); LDS_BARRIER();
            RWL_WRITE(p7, ck + 7); RWL_ISSUE(p7, ck + 15); LDS_BARRIER();
            RWL_WRITE(p0, ck + 8); RWL_ISSUE(p0, ck + 16); LDS_BARRIER();
        }
#undef RWL_ISSUE
#undef RWL_WRITE
        return;
    }
    const int cw = F.wave;
    f32x4v S[4][2];
#pragma unroll
    for (int jt = 0; jt < 4; ++jt)
#pragma unroll
        for (int it = 0; it < 2; ++it) S[jt][it] = (f32x4v){0.f, 0.f, 0.f, 0.f};
    float lnw[2], lnb[2];
#pragma unroll
    for (int it = 0; it < 2; ++it) { lnw[it] = F.kin[I_RLNW][l * 1024 + h * 64 + 16 * (2 * cw + it) + n]; lnb[it] = F.kin[I_RLNB][l * 1024 + h * 64 + 16 * (2 * cw + it) + n]; }
    bf16* MIX = WSP(bf16, WS_MIXED) + ((size_t)b * SEQ) * DM + 2048 + h * 64 + 32 * cw + n;
    f32x4v Yp[2] = {(f32x4v){0.f, 0.f, 0.f, 0.f}, (f32x4v){0.f, 0.f, 0.f, 0.f}}, bnp = (f32x4v){0.f, 0.f, 0.f, 0.f}; v2u gfp[2] = {(v2u){0u, 0u}, (v2u){0u, 0u}}, vfp[2] = {(v2u){0u, 0u}, (v2u){0u, 0u}};
    LDS_BARRIER();
#pragma unroll 1
    for (int ck = 0; ck <= 512; ++ck) {
        if (ck > 0) {
            const LAS float* xs = XS + ((ck - 1) & 1) * 64; const f32x4v a0 = *(const LAS f32x4v*)(xs + 8 * g), a1 = *(const LAS f32x4v*)(xs + 8 * g + 4), b0 = *(const LAS f32x4v*)(xs + 32 + 8 * g), b1 = *(const LAS f32x4v*)(xs + 32 + 8 * g + 4);
            const float s1[4] = {a0[0] + b0[0], a0[2] + b0[2], a1[0] + b1[0], a1[2] + b1[2]}, s2[4] = {a0[1] + b0[1], a0[3] + b0[3], a1[1] + b1[1], a1[3] + b1[3]};
#pragma unroll
            for (int it = 0; it < 2; ++it) { const float gt[4] = {bflo(gfp[it].x), bfhi(gfp[it].x), bflo(gfp[it].y), bfhi(gfp[it].y)}, vt[4] = {bflo(vfp[it].x), bfhi(vfp[it].x), bflo(vfp[it].y), bfhi(vfp[it].y)};
#pragma unroll
                for (int r = 0; r < 4; ++r) { const float mean = s1[r] * (1.0f / 64.0f), var = fmaxf(s2[r] * (1.0f / 64.0f) - mean * mean, 0.f), rstd = rsqrtf(var + 64e-5f);
                    if (!(HACK & 2)) MIX[(size_t)((ck - 1) * 16 + 4 * g + r) * DM + 16 * it] = (bf16)f2bf(((Yp[it][r] - mean) * rstd * lnw[it] + lnb[it] + bnp[r] * vt[r]) * gt[r]); } }
            if (ck == 512) break;
        }
        if (HACK & 4) { LDS_BARRIER(); continue; }
        const LAS unsigned char* R = L + (ck & 1) * RC_BYTES;
        bf16x8 at[2], rt[2];
#pragma unroll
        for (int kk = 0; kk < 2; ++kk) { at[kk] = *(const LAS bf16x8*)(R + RC_AT + kk * 1024 + lane * 16); rt[kk] = *(const LAS bf16x8*)(R + RC_RT + kk * 1024 + lane * 16); }
        f32x4v U[2], Y[2];
#pragma unroll
        for (int it = 0; it < 2; ++it) { U[it] = *(const LAS f32x4v*)(R + RC_U0 + (2 * cw + it) * 1024 + lane * 16); Y[it] = *(const LAS f32x4v*)(R + RC_Y0 + (2 * cw + it) * 1024 + lane * 16); }
#pragma unroll
        for (int kk = 0; kk < 2; ++kk)
#pragma unroll
            for (int it = 0; it < 2; ++it) { v4u pw; pw.x = pg8::cvt_pk_bf16(S[2 * kk][it][0], S[2 * kk][it][1]); pw.y = pg8::cvt_pk_bf16(S[2 * kk][it][2], S[2 * kk][it][3]);
                pw.z = pg8::cvt_pk_bf16(S[2 * kk + 1][it][0], S[2 * kk + 1][it][1]); pw.w = pg8::cvt_pk_bf16(S[2 * kk + 1][it][2], S[2 * kk + 1][it][3]); const bf16x8 sf = __builtin_bit_cast(bf16x8, pw);
                U[it] = __builtin_amdgcn_mfma_f32_16x16x32_bf16(at[kk], sf, U[it], 0, 0, 0); Y[it] = __builtin_amdgcn_mfma_f32_16x16x32_bf16(rt[kk], sf, Y[it], 0, 0, 0); }
        bf16x8 uv[2];
#pragma unroll
        for (int it = 0; it < 2; ++it) { vfp[it] = *(const LAS v2u*)(R + RC_VF + (2 * cw + it) * 512 + lane * 8); gfp[it] = *(const LAS v2u*)(R + RC_GF + (2 * cw + it) * 512 + lane * 8);
            v4u pw; pw.x = pg8::cvt_pk_bf16(U[it][0], U[it][1]); pw.y = pg8::cvt_pk_bf16(U[it][2], U[it][3]); pw.z = vfp[it].x; pw.w = vfp[it].y; uv[it] = __builtin_bit_cast(bf16x8, pw); }
#pragma unroll
        for (int jt = 0; jt < 4; ++jt) { const bf16x8 bk = *(const LAS bf16x8*)(R + RC_BK + jt * 1024 + lane * 16); const f32x4v p15 = *(const LAS f32x4v*)(R + RC_P15 + (16 * jt + 4 * g) * 4);
#pragma unroll
            for (int it = 0; it < 2; ++it) S[jt][it] = __builtin_amdgcn_mfma_f32_16x16x32_bf16(bk, uv[it], S[jt][it] * p15, 0, 0, 0); }
        bnp = *(const LAS f32x4v*)(R + RC_BN + 16 * g); Yp[0] = Y[0]; Yp[1] = Y[1];
        { LAS float* xo = XS + (ck & 1) * 64 + cw * 32; const f32x4v sm = Y[0] + Y[1], sq = Y[0] * Y[0] + Y[1] * Y[1];
#pragma unroll
          for (int r = 0; r < 4; ++r) { const float a = sum16(sm[r]), q = sum16(sq[r]); if (n == 0) { xo[(4 * g + r) * 2] = a; xo[(4 * g + r) * 2 + 1] = q; } } }
        LDS_BARRIER();
    }
}
template <int HACK = 0> __device__ __forceinline__ void mixers_v4(Frame& F, int l, int qi, int mask = 15) {
    gu32* ctr = F.ctl + CW_Q + 64 * qi;
    for (;;) {
        const int it = next_item(F, ctr); relaunder(F); relaunder_tid(F);
        if (it < 32) { if (mask & 1) rwkv_scan_unit<HACK>(F, l, it >> 4, it & 15); }
        else if (it < 40) { const int j = it - 32; if (mask & 2) gla_scan_unit<HACK>(F, l, j >> 2, j & 3); }
        else if (it < 40 + 1024) { const int j = it - 40, qb = 63 - (j >> 4), bh = j & 15; if (mask & 4) attn_unit<true>(F, l, bh >> 3, bh & 7, qb); }
        else if (it < 40 + 2048) { const int j = it - 1064, qb = j & 63, bh = j >> 6; if (mask & 8) attn_unit<false>(F, l, bh >> 3, bh & 7, qb); }
        else break;
    }
}
template <int HACK = 0> __device__ __forceinline__ void prep_rwkv(Frame& F, int l) {
    LAS float* zl = (LAS float*)(F.lds + RING_OFF) + 4096;
    LAS float* in = (LAS float*)(F.lds + RING_OFF);
    const float* mu = F.kin[I_RMU] + (size_t)l * 3264;
    const float* LOWR = WSP(float, WS_LOWR); const bf16* COLS = WSP(bf16, WS_COLS);
    float* RW = WSP(float, WS_RW); unsigned* RWU = WSP(unsigned, WS_RW); float* VF = WSP(float, WS_VFIRST);
    constexpr size_t RS = RW_ONE / 4;
    for (int tile = F.bx; tile < M / 16; tile += F.G) {
        const int row0 = tile * 16;
        __syncthreads();
        for (int idx = F.tid; idx < 16 * 224; idx += NWAVES * 64) { const int tt = idx / 224, j = idx % 224, row = row0 + tt, t = row & (SEQ - 1);
            const int col = j < 192 ? 16 + j : 208 + (j - 192);
            const float cur = LOWR[(size_t)row * 256 + col], prev = t > 0 ? LOWR[(size_t)(row - 1) * 256 + col] : 0.f;
            const float muv = j < 192 ? mu[3072 + j] : (l ? F.kin[I_VRMU][(l - 1) * 32 + (j - 192)] : 0.f);
            float x = cur + (prev - cur) * muv;
            if (j < 64) x = tanhf(x); else if (j >= 128 && j < 192) x = sigmoid_f(x);
            in[j * 16 + tt] = x; }
        __syncthreads();
        {
            const int c = 2 * F.tid;
            float accw[2][16], acca[2][16], accg[2][16], accv[2][16];
#pragma unroll
            for (int e = 0; e < 2; ++e) { const float bw = F.kin[I_RW0][l * 1024 + c + e], ba = F.kin[I_RA0][l * 1024 + c + e], bv = l ? F.kin[I_VR0][(l - 1) * 1024 + c + e] : 0.f;
#pragma unroll
              for (int tt = 0; tt < 16; ++tt) { accw[e][tt] = bw; acca[e][tt] = ba; accg[e][tt] = 0.f; accv[e][tt] = bv; } }
#define LOWRANK_MFMA(ACC, WPTR, JOFF, NJ) do { const float* wq_ = (WPTR) + 128 * F.wave + (F.lane & 15) + (size_t)(F.lane >> 4) * 1024; \
            _Pragma("unroll 2") for (int nt = 0; nt < 8; ++nt) { f32x4 c4 = {0.f, 0.f, 0.f, 0.f}; \
                _Pragma("unroll") for (int ks = 0; ks < (NJ) / 4; ++ks) c4 = __builtin_amdgcn_mfma_f32_16x16x4f32(in[((JOFF) + 4 * ks + (F.lane >> 4)) * 16 + (F.lane & 15)], wq_[(size_t)ks * 4096 + 16 * nt], c4, 0, 0, 0); \
                _Pragma("unroll") for (int rr = 0; rr < 4; ++rr) zl[(4 * (F.lane >> 4) + rr) * 1028 + 128 * F.wave + 16 * nt + (F.lane & 15)] = c4[rr]; } \
            __syncthreads(); \
            _Pragma("unroll") for (int tt = 0; tt < 16; ++tt) { const f32x2_t z2 = *(const LAS f32x2_t*)(zl + tt * 1028 + c); ACC[0][tt] += z2.x; ACC[1][tt] += z2.y; } \
            __syncthreads(); } while (0)
            if (!(HACK & 1)) { LOWRANK_MFMA(accw, F.kin[I_RWUP] + (size_t)l * 64 * 1024, 0, 64); relaunder(F);
            LOWRANK_MFMA(acca, F.kin[I_RAUP] + (size_t)l * 64 * 1024, 64, 64); relaunder(F);
            LOWRANK_MFMA(accg, F.kin[I_RGUP] + (size_t)l * 64 * 1024, 128, 64); relaunder(F);
            if (l) LOWRANK_MFMA(accv, F.kin[I_VRUP] + (size_t)(l - 1) * 32 * 1024, 192, 32); }
#undef LOWRANK_MFMA
            relaunder(F);
            float mur[2], muk[2], muv[2], kkv[2], kav[2], pr[2] = {0.f, 0.f}, pk[2] = {0.f, 0.f}, pv[2] = {0.f, 0.f};
#pragma unroll
            for (int e = 0; e < 2; ++e) { mur[e] = F.kin[I_RMU][l * 3264 + c + e]; muk[e] = F.kin[I_RMU][l * 3264 + 1024 + c + e]; muv[e] = F.kin[I_RMU][l * 3264 + 2048 + c + e]; kkv[e] = F.kin[I_RKK][l * 1024 + c + e]; kav[e] = F.kin[I_RKA][l * 1024 + c + e]; }
            if ((row0 & (SEQ - 1)) != 0) { const bf16* p = COLS + (size_t)(row0 - 1) * NMAIN + c; const unsigned ur = *(const unsigned*)(p + CC_R), uk = *(const unsigned*)(p + CC_K), uv = *(const unsigned*)(p + CC_V);
                pr[0] = bflo(ur); pr[1] = bfhi(ur); pk[0] = bflo(uk); pk[1] = bfhi(uk); pv[0] = bflo(uv); pv[1] = bfhi(uv); }
            if (!(HACK & 4))
#pragma unroll
            for (int tt = 0; tt < 16; ++tt) { const int row = row0 + tt; const bf16* p = COLS + (size_t)row * NMAIN + c; const size_t o = (size_t)row * 1024 + c;
                const unsigned ur = *(const unsigned*)(p + CC_R), uk = *(const unsigned*)(p + CC_K), uv = *(const unsigned*)(p + CC_V);
                const float cr[2] = {bflo(ur), bfhi(ur)}, ck[2] = {bflo(uk), bfhi(uk)}, cv[2] = {bflo(uv), bfhi(uv)};
                f32x2_t vf2 = {0.f, 0.f}; if (l != 0) vf2 = *(const f32x2_t*)(VF + o);
                float r[2], k[2], v[2], dec[2], av[2], kk[2], km[2];
#pragma unroll
                for (int e = 0; e < 2; ++e) { r[e] = cr[e] + (pr[e] - cr[e]) * mur[e]; k[e] = ck[e] + (pk[e] - ck[e]) * muk[e]; v[e] = cv[e] + (pv[e] - cv[e]) * muv[e]; pr[e] = cr[e]; pk[e] = ck[e]; pv[e] = cv[e];
                    if (l == 0) vf2[e] = v[e]; else { const float vg = sigmoid_f(accv[e][tt]); v[e] = v[e] + (vf2[e] - v[e]) * vg; }
                    dec[e] = __expf(-0.6065306597126334f * sigmoid_f(accw[e][tt])); av[e] = sigmoid_f(acca[e][tt]); kk[e] = k[e] * kkv[e]; km[e] = k[e] * (1.0f + (av[e] - 1.0f) * kav[e]); }
                const float ss = sum32(kk[0] * kk[0] + kk[1] * kk[1]), rn = rsqrtf(fmaxf(ss, 1e-24f)); kk[0] *= rn; kk[1] *= rn;
                if (l == 0) *(f32x2_t*)(VF + o) = vf2;
                *(f32x2_t*)(RW + RS + o) = (f32x2_t){dec[0], dec[1]};
                *(v2u*)(RWU + o) = (v2u){pk2(r[0], km[0]), pk2(r[1], km[1])}; *(v2u*)(RWU + 2 * RS + o) = (v2u){pk2(v[0], accg[0][tt]), pk2(v[1], accg[1][tt])};
                *(v2u*)(RWU + 3 * RS + o) = (v2u){pk2(-kk[0], kk[0] * av[0]), pk2(-kk[1], kk[1] * av[1])}; }
        }
        asm volatile("s_waitcnt vmcnt(0)" ::: "memory"); __syncthreads();
        __builtin_amdgcn_fence(__ATOMIC_ACQUIRE, "agent"); asm volatile("s_waitcnt vmcnt(0)" ::: "memory");
        if (!(HACK & 2)) rwkv_chunks_of_tile(F, l, tile);
    }
}
struct Args { const float* in[35]; float* out; unsigned char* ws; };
__device__ __forceinline__ void mk_frame(Frame& F, int wv) {
    extern __shared__ __attribute__((aligned(16))) unsigned char lds[];
    kargp kp = (kargp)__builtin_amdgcn_kernarg_segment_ptr(); asm volatile("" : "+s"(kp));
    F.kin = kp;
    F.lds = (LAS unsigned char*)lds;
    F.MISC = (volatile LAS unsigned*)(F.lds + MISC_OFF);
    { int w_ = wv; asm volatile("" : "+s"(w_)); int t_ = (int)__builtin_amdgcn_mbcnt_hi(~0u, __builtin_amdgcn_mbcnt_lo(~0u, (unsigned)w_ * 64u)); asm volatile("" : "+v"(t_)); F.tid = t_; } F.lane = F.tid & 63; F.wave = __builtin_amdgcn_readfirstlane(F.tid >> 6);
    F.G = gridDim.x; { int bx = blockIdx.x; asm volatile("" : "+s"(bx)); F.bx = bx; F.vcu = (F.G % 8 == 0) ? (bx % 8) * (F.G / 8) + bx / 8 : bx; }
    F.out = (float*)kp[35]; F.ws = (unsigned char*)kp[36]; F.ctl = (gu32*)(F.ws + WS_CTL);
}
__device__ __forceinline__ void grid_bar(int wv) {
    Frame F; mk_frame(F, wv);
    XcdBarrier bar; bar.bar = (unsigned*)(F.ctl + CW_BAR); bar.x = xb_xcc_id(); bar.st = F.MISC + 8;
    xcd_barrier(bar);
#ifdef REP_BAR
    xcd_barrier(bar);
#endif
}
__global__ void __launch_bounds__(NWAVES * 64, 2) mega_fwd(Args args) {
    const int wv = __builtin_amdgcn_readfirstlane((int)threadIdx.x >> 6);
    { Frame F; mk_frame(F, wv);
      for (int u = F.tid; u < (LDS_BYTES - LDSCTL_OFF) / 4; u += NWAVES * 64) ((LAS unsigned*)(F.lds + LDSCTL_OFF))[u] = 0u;
      __syncthreads();
      (void)xcd_barrier_post((unsigned*)(F.ctl + CW_BAR), F.MISC + 8);
#ifndef NO_P0
      p0_prologue_a(F);
#endif
#ifdef REP_P0
      __syncthreads(); p0_prologue_a(F);
#endif
    }
    grid_bar(wv);
    { Frame F; mk_frame(F, wv); p0_prologue_b(F); }
    grid_bar(wv);
#pragma unroll 1
    for (int l = 0; l < NLAYER; ++l) {
#ifndef REP_HACK
#define REP_HACK 0
#endif
#define LAYER_VARS const float* mod = WSP(float, WS_MOD) + (size_t)l * 2 * 24576; const float* xin = l == 0 ? F.kin[I_X] : F.out; (void)mod; (void)xin
#ifndef NO_RMS
        { Frame F; mk_frame(F, wv); LAYER_VARS; rms_phase(F, xin, mod + 0, mod + 4096); }
#endif
        grid_bar(wv);
#ifndef NO_G1
        { Frame F; mk_frame(F, wv);
          pg8::Gemm g{WSP(pg8::bf16_t, WS_XN), WSP(pg8::bf16_t, WS_WIN + l * WIN_L), M, NIN, DM}; pg8::StaticOrder S; S.init(M, NIN, F.G, F.bx);
          pg8::EpiCols E{WSP(pg8::bf16_t, WS_COLS), WSP(float, WS_LOWR)};
          pg8::gemm_phase<pg8::EpiCols, pg8::StaticOrder, true, true>(F.lds + RING_OFF, g, S, E, F.tid); }
#endif
#ifdef REP_IN
        grid_bar(wv);
        { Frame F; mk_frame(F, wv);
          pg8::Gemm g{WSP(pg8::bf16_t, WS_XN), WSP(pg8::bf16_t, WS_WIN + l * WIN_L), M, NIN, DM}; pg8::StaticOrder S; S.init(M, NIN, F.G, F.bx);
          pg8::EpiCols E{WSP(pg8::bf16_t, WS_COLS), WSP(float, WS_LOWR)};
          pg8::gemm_phase<pg8::EpiCols, pg8::StaticOrder, true, true>(F.lds + RING_OFF, g, S, E, F.tid); }
#endif
        grid_bar(wv);
#ifndef NO_PREP
        { Frame F; mk_frame(F, wv); prep_norm(F, l); }
        { Frame F; mk_frame(F, wv); prep_loga(F, l); }
#ifdef REP_P2
        { Frame F; mk_frame(F, wv); prep_rwkv<REP_P2>(F, l); }
#endif
        { Frame F; mk_frame(F, wv); prep_rwkv(F, l); }
        { Frame F; mk_frame(F, wv); prep_vt(F, 0); }
        { Frame F; mk_frame(F, wv); prep_vt(F, 1); }
        { Frame F; mk_frame(F, wv); prep_gla(F); }
#ifdef REP_P3
        { Frame F; mk_frame(F, wv); prep_vt(F, 0); }
        { Frame F; mk_frame(F, wv); prep_vt(F, 1); }
        { Frame F; mk_frame(F, wv); prep_gla(F); }
#endif
#ifdef REP_P4
#endif
#endif
#ifdef REP_PREP
        grid_bar(wv);
        { Frame F; mk_frame(F, wv); prep_norm(F, l); }
        { Frame F; mk_frame(F, wv); prep_loga(F, l); }
        { Frame F; mk_frame(F, wv); prep_rwkv(F, l); }
        { Frame F; mk_frame(F, wv); prep_vt(F, 0); }
        { Frame F; mk_frame(F, wv); prep_vt(F, 1); }
        { Frame F; mk_frame(F, wv); prep_gla(F); }
#endif
        grid_bar(wv);
#ifndef NO_MIX
#ifdef REP_MIX
        { Frame F; mk_frame(F, wv); mixers_v4<REP_HACK>(F, l, l + 2, REP_MIX); }
        grid_bar(wv);
#endif
        { Frame F; mk_frame(F, wv); mixers_v4(F, l, l); }
#endif
        grid_bar(wv);
#ifndef NO_G2
        { Frame F; mk_frame(F, wv); LAYER_VARS;
          pg8::Gemm g{WSP(pg8::bf16_t, WS_MIXED), WSP(pg8::bf16_t, WS_WOUT + l * WOUT_L), M, DM, DM}; pg8::StaticOrder S; S.init(M, DM, F.G, F.bx);
          pg8::EpiRes E{xin, F.out, mod + 2 * 4096};
          pg8::gemm_phase<pg8::EpiRes, pg8::StaticOrder, true, true>(F.lds + RING_OFF, g, S, E, F.tid); }
#endif
        grid_bar(wv);
        { Frame F; mk_frame(F, wv); LAYER_VARS; rms_phase(F, F.out, mod + 3 * 4096, mod + 4 * 4096); }
#ifdef REP_RMS
        { Frame F; mk_frame(F, wv); LAYER_VARS; rms_phase(F, F.out, mod + 3 * 4096, mod + 4 * 4096); }
#endif
        grid_bar(wv);
#ifndef NO_G3
        { Frame F; mk_frame(F, wv);
          pg8::Gemm g{WSP(pg8::bf16_t, WS_XN), WSP(pg8::bf16_t, WS_W13 + l * W13_L), M, 2 * DFF, DM}; pg8::StaticOrder S; S.init(M, 2 * DFF, F.G, F.bx);
          pg8::EpiSwiglu E{WSP(pg8::bf16_t, WS_HID)};
          pg8::gemm_phase<pg8::EpiSwiglu, pg8::StaticOrder, true, true>(F.lds + RING_OFF, g, S, E, F.tid); }
#endif
#ifdef REP_UP
        grid_bar(wv);
        { Frame F; mk_frame(F, wv);
          pg8::Gemm g{WSP(pg8::bf16_t, WS_XN), WSP(pg8::bf16_t, WS_W13 + l * W13_L), M, 2 * DFF, DM}; pg8::StaticOrder S; S.init(M, 2 * DFF, F.G, F.bx);
          pg8::EpiSwiglu E{WSP(pg8::bf16_t, WS_HID)};
          pg8::gemm_phase<pg8::EpiSwiglu, pg8::StaticOrder, true, true>(F.lds + RING_OFF, g, S, E, F.tid); }
#endif
        grid_bar(wv);
#ifndef NO_G4
        { Frame F; mk_frame(F, wv); LAYER_VARS;
          pg8::Gemm g{WSP(pg8::bf16_t, WS_HID), WSP(pg8::bf16_t, WS_W2 + l * W2_L), M, DM, DFF}; pg8::StaticOrder S; S.init(M, DM, F.G, F.bx);
          pg8::EpiRes E{F.out, F.out, mod + 5 * 4096};
          pg8::gemm_phase<pg8::EpiRes, pg8::StaticOrder, true, true>(F.lds + RING_OFF, g, S, E, F.tid); }
#endif
        if (l + 1 < NLAYER) grid_bar(wv);
#undef LAYER_VARS
    }
}

extern "C" void kernel_launch(void* const* d_in, const int* in_sizes, int n_in, void* d_out, int out_size, void* d_ws, size_t ws_size, hipStream_t stream) {
    static int grid = 0;
    if (grid == 0) {
        if (n_in != 35 || in_sizes[0] != M * DM || out_size != M * DM || ws_size < WS_END) { fprintf(stderr, "kernel_launch: unexpected shapes: n_in %d in0 %d out %d ws %zu (need %zu)\n", n_in, n_in > 0 ? in_sizes[0] : -1, out_size, ws_size, (size_t)WS_END); grid = -1; return; }
        int dev = 0, cus = 0, per_cu = 0;
        if (hipGetDevice(&dev) != hipSuccess || hipDeviceGetAttribute(&cus, hipDeviceAttributeMultiprocessorCount, dev) != hipSuccess) { grid = -1; return; }
        if (hipFuncSetAttribute((const void*)mega_fwd, hipFuncAttributeMaxDynamicSharedMemorySize, LDS_BYTES) != hipSuccess) { fprintf(stderr, "kernel_launch: hipFuncSetAttribute failed\n"); grid = -1; return; }
        if (hipOccupancyMaxActiveBlocksPerMultiprocessor(&per_cu, (const void*)mega_fwd, NWAVES * 64, LDS_BYTES) != hipSuccess || per_cu < 1) fprintf(stderr, "kernel_launch: occupancy query says %d\n", per_cu);
        (void)hipGetLastError();
        grid = cus;
    }
    if (grid < 0) return;
    if (hipMemsetAsync((char*)d_ws + WS_CTL, 0, CTL_ZERO_BYTES, stream) != hipSuccess) return;
    Args a{};
    for (int i = 0; i < 35; ++i) a.in[i] = (const float*)d_in[i];
    a.out = (float*)d_out; a.ws = (unsigned char*)d_ws;
    hipLaunchKernelGGL(mega_fwd, dim3(grid), dim3(NWAVES * 64), LDS_BYTES, stream, a);
}
```

```cpp
#include <hip/hip_runtime.h>
#include <cstdio>
#include <cstdint>
namespace pg8 {
#define PG8_LAS __attribute__((address_space(3)))
typedef unsigned short bf16_t;
typedef short bf16x8 __attribute__((ext_vector_type(8)));
typedef float f32x4 __attribute__((ext_vector_type(4)));
typedef unsigned u32x4 __attribute__((ext_vector_type(4)));
constexpr int BM = 256, BK = 64, HALF = 128, HTB = HALF * BK * 2  , STAGE_BYTES = 8 * HTB, NXCD = 8, WGM = 8;

__host__ __device__ __forceinline__ int lds_byte(int r, int c) { const int st = (r >> 4) * 2 + (c >> 5), rr = r & 15, cc = c & 31, ob = rr * 64 + cc * 2; return st * 1024 + (ob ^ (((ob >> 9) & 1) << 5)); }
__host__ __device__ __forceinline__ void stage_rc(int b, int& R, int& C) { const int st = b / 1024, sb = b % 1024, swz = sb ^ (((sb >> 9) & 1) << 5); R = (st >> 1) * 16 + swz / 64; C = (st & 1) * 32 + (swz % 64) / 2; }
__host__ __device__ __forceinline__ int perm32(int rho) { const int n = rho >> 4, i = rho & 15; return 8 * (i >> 2) + 4 * n + (i & 3); }

struct Unit { int pm, pn; };
struct Gemm { const bf16_t* A; const bf16_t* Bt; int M, N, K; };

struct StaticOrder {
    int nM, nN, nwg, G, c;
    __host__ __device__ void init(int M, int N, int G_, int c_) { nM = M / BM; nN = N / BM; nwg = nM * nN; G = G_; c = c_; }
    __host__ __device__ bool next(int i, Unit& u) const {
        const long L = (long)i * G + c; if (L >= nwg) return false;
        int wgid = (int)L; { const int q = nwg / NXCD, r = nwg % NXCD, xcd = wgid % NXCD, off = wgid / NXCD; wgid = (xcd < r ? xcd * (q + 1) : r * (q + 1) + (xcd - r) * q) + off; }
        const int nig = WGM * nN, gid = wgid / nig, fm = gid * WGM, gsz = (nM - fm) < WGM ? (nM - fm) : WGM;
        u.pm = fm + ((wgid % nig) % gsz); u.pn = (wgid % nig) / gsz; return true;
    }
    __device__ __forceinline__ void a_ready(const Unit&) const {}
    __device__ __forceinline__ void done(const Unit&) const {}
};

typedef float f32x2c_t __attribute__((ext_vector_type(2))); typedef __bf16 bf16x2c_t __attribute__((ext_vector_type(2)));
__device__ __forceinline__ unsigned cvt_pk_bf16(float lo, float hi) { const f32x2c_t v = {lo, hi}; return __builtin_bit_cast(unsigned, __builtin_convertvector(v, bf16x2c_t)); }
typedef float f32x2 __attribute__((ext_vector_type(2)));
__device__ __forceinline__ float silu_f(float x) { return x * __builtin_amdgcn_rcpf(1.0f + __builtin_amdgcn_exp2f(-1.4426950408889634f * x)); }
struct EpiCols {
    static constexpr bool PERM = true, AFTER_DRAIN = false;
    bf16_t* O; float* L;
    __device__ __forceinline__ void operator()(const f32x4 (&acc)[2][2][4][2], const Unit& u, int wr, int wc, int fr, int fq) const {
        const int row0 = u.pm * BM + wr * 64 + fr;
        if (u.pn < 41) {
            const int col0 = u.pn * BM + wc * 32 + 8 * fq;
#pragma unroll
            for (int ai = 0; ai < 2; ++ai)
#pragma unroll
                for (int m = 0; m < 4; ++m) { bf16_t* rowp = O + (size_t)(row0 + ai * HALF + m * 16) * 10496 + col0;
#pragma unroll
                    for (int bj = 0; bj < 2; ++bj) { const f32x4 v0 = acc[ai][bj][m][0], v1 = acc[ai][bj][m][1];
                        u32x4 w; w.x = cvt_pk_bf16(v0[0], v0[1]); w.y = cvt_pk_bf16(v0[2], v0[3]); w.z = cvt_pk_bf16(v1[0], v1[1]); w.w = cvt_pk_bf16(v1[2], v1[3]);
                        *(u32x4*)(rowp + bj * HALF) = w; } }
        } else {
            const int col0 = wc * 32 + 8 * fq;
#pragma unroll
            for (int ai = 0; ai < 2; ++ai)
#pragma unroll
                for (int m = 0; m < 4; ++m) { float* rowp = L + (size_t)(row0 + ai * HALF + m * 16) * 256 + col0;
#pragma unroll
                    for (int bj = 0; bj < 2; ++bj) { *(f32x4*)(rowp + bj * HALF) = acc[ai][bj][m][0]; *(f32x4*)(rowp + bj * HALF + 4) = acc[ai][bj][m][1]; } }
        }
    }
};
struct EpiRes {
    static constexpr bool PERM = false, AFTER_DRAIN = false;
    const float* base; float* out; const float* gate;
    __device__ __forceinline__ void operator()(const f32x4 (&acc)[2][2][4][2], const Unit& u, int wr, int wc, int fr, int fq) const {
        const int row0 = u.pm * BM + wr * 64 + fr, col0 = u.pn * BM + wc * 32 + 4 * fq;
        const float* gp = gate + (size_t)(u.pm >> 5) * 24576 + col0;
        f32x4 gv[2][2];
#pragma unroll
        for (int bj = 0; bj < 2; ++bj)
#pragma unroll
            for (int n = 0; n < 2; ++n) gv[bj][n] = *(const f32x4*)(gp + bj * HALF + n * 16);
#pragma unroll
        for (int ai = 0; ai < 2; ++ai)
#pragma unroll
            for (int m = 0; m < 4; ++m) { const size_t off = (size_t)(row0 + ai * HALF + m * 16) * 4096 + col0;
#pragma unroll
                for (int bj = 0; bj < 2; ++bj)
#pragma unroll
                    for (int n = 0; n < 2; ++n) { const f32x4 bs = *(const f32x4*)(base + off + bj * HALF + n * 16); *(f32x4*)(out + off + bj * HALF + n * 16) = bs + gv[bj][n] * acc[ai][bj][m][n]; }
                if (m == 3) asm volatile("" ::: "memory"); }
    }
};
struct EpiSwiglu {
    static constexpr bool PERM = true, AFTER_DRAIN = false;
    bf16_t* H;
    __device__ __forceinline__ void operator()(const f32x4 (&acc)[2][2][4][2], const Unit& u, int wr, int wc, int fr, int fq) const {
        const int row0 = u.pm * BM + wr * 64 + fr, col0 = u.pn * HALF + wc * 32 + 8 * fq;
#pragma unroll
        for (int ai = 0; ai < 2; ++ai)
#pragma unroll
            for (int m = 0; m < 4; ++m) { bf16_t* rowp = H + (size_t)(row0 + ai * HALF + m * 16) * 11008 + col0;
                const f32x4 a0 = acc[ai][0][m][0], a1 = acc[ai][0][m][1], b0 = acc[ai][1][m][0], b1 = acc[ai][1][m][1];
                u32x4 w; w.x = cvt_pk_bf16(silu_f(a0[0]) * b0[0], silu_f(a0[1]) * b0[1]); w.y = cvt_pk_bf16(silu_f(a0[2]) * b0[2], silu_f(a0[3]) * b0[3]);
                w.z = cvt_pk_bf16(silu_f(a1[0]) * b1[0], silu_f(a1[1]) * b1[1]); w.w = cvt_pk_bf16(silu_f(a1[2]) * b1[2], silu_f(a1[3]) * b1[3]);
                *(u32x4*)rowp = w; }
    }
};
template <class Epi, class Sched, bool ALIGN_EPI = false, bool SP2 = false>
__device__ __forceinline__ void gemm_phase(PG8_LAS unsigned char* lds, const Gemm g, const Sched& S, const Epi& E, int tid_in) {
    int tid_ = tid_in; asm volatile("" : "+v"(tid_));
    const int tid = tid_, wid = __builtin_amdgcn_readfirstlane(tid >> 6), lane = tid & 63, wr = wid >> 2, wc = wid & 3, fr = lane & 15, fq = lane >> 4;
    const int K = g.K, nt = K / BK;
    unsigned voffA[2], voffB[2];
#pragma unroll
    for (int i = 0; i < 2; ++i) { int R, C; stage_rc(tid * 16 + i * 8192, R, C); const int Rb = Epi::PERM ? ((R & ~31) + perm32(R & 31)) : R;
        voffA[i] = (unsigned)(R * K + C) * 2u; voffB[i] = (unsigned)(Rb * K + C) * 2u; }
    const size_t kstep = (size_t)(BK * 2);
    const size_t hstep = (size_t)HALF * K * 2;
    const size_t tstep = 2 * hstep;
    const unsigned ldsw = (unsigned)wid * 1024u;
    const int aoff = lds_byte(wr * 64 + fr, fq * 8), boff = lds_byte(wc * 32 + fr, fq * 8);
#define PG8_SA(b, h) (((b) * 2 + (h)) * HTB)
#define PG8_SB(b, h) ((4 + (b) * 2 + (h)) * HTB)
#define PG8_STAGE(bufoff, gbase, voff) do { _Pragma("unroll") for (int _i = 0; _i < 2; ++_i) \
        __builtin_amdgcn_global_load_lds((const unsigned*)((const char*)(gbase) + (voff)[_i]), (PG8_LAS unsigned*)(lds + (bufoff) + ldsw + _i * 8192), 16, 0, 0); } while (0)
#define PG8_LDA(dst, b, h) do { _Pragma("unroll") for (int m = 0; m < 4; ++m) _Pragma("unroll") for (int k = 0; k < 2; ++k) dst[m][k] = *(const PG8_LAS bf16x8*)(lds + PG8_SA(b, h) + aoff + m * 2048 + k * 1024); } while (0)
#define PG8_LDB(dst, b, h) do { _Pragma("unroll") for (int n = 0; n < 2; ++n) _Pragma("unroll") for (int k = 0; k < 2; ++k) dst[n][k] = *(const PG8_LAS bf16x8*)(lds + PG8_SB(b, h) + boff + n * 2048 + k * 1024); } while (0)
#define PG8_MMA(ai, bj, At, Bt) do { __builtin_amdgcn_s_setprio(1); _Pragma("unroll") for (int m = 0; m < 4; ++m) _Pragma("unroll") for (int n = 0; n < 2; ++n) _Pragma("unroll") for (int k = 0; k < 2; ++k) \
        acc[ai][bj][m][n] = __builtin_amdgcn_mfma_f32_16x16x32_bf16(Bt[n][k], At[m][k], acc[ai][bj][m][n], 0, 0, 0); __builtin_amdgcn_s_setprio(0); } while (0)
#define PG8_WAIT_V(n) asm volatile("s_waitcnt vmcnt(" #n ")" ::: "memory")
#define PG8_WAIT_L(n) asm volatile("s_waitcnt lgkmcnt(" #n ")" ::: "memory")
#define PG8_BAR __builtin_amdgcn_s_barrier()
#define PG8_SCHED __builtin_amdgcn_sched_barrier(0)
    Unit cur, nxt; int ui = 0;
    if (!S.next(0, cur)) return;
    f32x4 acc[2][2][4][2];
#pragma unroll
    for (int a = 0; a < 2; ++a)
#pragma unroll
        for (int b = 0; b < 2; ++b)
#pragma unroll
            for (int m = 0; m < 4; ++m)
#pragma unroll
                for (int n = 0; n < 2; ++n) acc[a][b][m][n] = (f32x4){0.f, 0.f, 0.f, 0.f};
    bf16x8 At[4][2], B0[2][2], B1[2][2];
    const char* cA = (const char*)g.A + (size_t)cur.pm * tstep; const char* cB = (const char*)g.Bt + (size_t)cur.pn * tstep;
    S.a_ready(cur);
    if constexpr (SP2) {
        PG8_STAGE(PG8_SB(0, 0), cB, voffB); PG8_STAGE(PG8_SB(0, 1), cB + hstep, voffB); PG8_STAGE(PG8_SA(0, 0), cA, voffA); PG8_STAGE(PG8_SA(0, 1), cA + hstep, voffA);
        if (wr == 1) PG8_BAR;
        PG8_WAIT_V(2); PG8_BAR;
        PG8_STAGE(PG8_SB(1, 0), cB + kstep, voffB); PG8_STAGE(PG8_SA(1, 0), cA + kstep, voffA); PG8_STAGE(PG8_SB(1, 1), cB + hstep + kstep, voffB);
        PG8_WAIT_V(6); PG8_BAR;
    } else {
        PG8_STAGE(PG8_SB(0, 0), cB, voffB); PG8_STAGE(PG8_SA(0, 0), cA, voffA); PG8_STAGE(PG8_SB(0, 1), cB + hstep, voffB); PG8_STAGE(PG8_SA(0, 1), cA + hstep, voffA);
        if (wr == 1) PG8_BAR;
        PG8_WAIT_V(4); PG8_BAR;
        PG8_STAGE(PG8_SB(1, 0), cB + kstep, voffB); PG8_STAGE(PG8_SA(1, 0), cA + kstep, voffA); PG8_STAGE(PG8_SB(1, 1), cB + hstep + kstep, voffB);
        PG8_WAIT_V(6); PG8_BAR;
    }
    for (;;) {
        const bool has_next = S.next(ui + 1, nxt);
        const char* nA = has_next ? (const char*)g.A + (size_t)nxt.pm * tstep : cA; const char* nB = has_next ? (const char*)g.Bt + (size_t)nxt.pn * tstep : cB;
        for (int t = 0; t < nt; t += 2) {
            const bool last = (t == nt - 2);
            const char* a1 = cA + (size_t)(t + 1) * kstep;
            const char* a2 = last ? nA : cA + (size_t)(t + 2) * kstep; const char* b2 = last ? nB : cB + (size_t)(t + 2) * kstep;
            const char* a3 = a2 + kstep; const char* b3 = b2 + kstep;
            if (last && has_next) S.a_ready(nxt);
            if constexpr (SP2) {
            PG8_LDB(B0, 0, 0); PG8_LDB(B1, 0, 1); PG8_SCHED; PG8_LDA(At, 0, 0); PG8_STAGE(PG8_SA(1, 1), a1 + hstep, voffA);
            PG8_WAIT_V(8); PG8_WAIT_L(0); PG8_BAR; PG8_MMA(0, 0, At, B0); PG8_MMA(0, 1, At, B1); PG8_BAR; PG8_SCHED;
            PG8_LDA(At, 0, 1); PG8_STAGE(PG8_SB(0, 0), b2, voffB); PG8_STAGE(PG8_SB(0, 1), b2 + hstep, voffB); PG8_STAGE(PG8_SA(0, 0), a2, voffA);
            PG8_WAIT_V(8); PG8_WAIT_L(0); PG8_BAR; PG8_MMA(1, 0, At, B0); PG8_MMA(1, 1, At, B1); PG8_BAR; PG8_SCHED;
            PG8_LDB(B0, 1, 0); PG8_LDB(B1, 1, 1); PG8_SCHED; PG8_LDA(At, 1, 0); PG8_STAGE(PG8_SA(0, 1), a2 + hstep, voffA);
            PG8_WAIT_V(8); PG8_WAIT_L(0); PG8_BAR; PG8_MMA(0, 0, At, B0); PG8_MMA(0, 1, At, B1); PG8_BAR; PG8_SCHED;
            PG8_LDA(At, 1, 1); PG8_STAGE(PG8_SB(1, 0), b3, voffB); PG8_STAGE(PG8_SB(1, 1), b3 + hstep, voffB); PG8_STAGE(PG8_SA(1, 0), a3, voffA);
            PG8_WAIT_V(8); PG8_WAIT_L(0); PG8_BAR; PG8_MMA(1, 0, At, B0); PG8_MMA(1, 1, At, B1); PG8_BAR; PG8_SCHED;
            } else {
            PG8_LDB(B0, 0, 0); PG8_SCHED; PG8_LDA(At, 0, 0); PG8_STAGE(PG8_SA(1, 1), a1 + hstep, voffA);
            PG8_WAIT_L(8); PG8_BAR; PG8_WAIT_L(0); PG8_MMA(0, 0, At, B0); PG8_BAR; PG8_SCHED;
            PG8_LDB(B1, 0, 1); PG8_STAGE(PG8_SB(0, 0), b2, voffB);
            PG8_BAR; PG8_WAIT_L(0); PG8_MMA(0, 1, At, B1); PG8_BAR;
            PG8_LDA(At, 0, 1); PG8_STAGE(PG8_SA(0, 0), a2, voffA);
            PG8_BAR; PG8_WAIT_L(0); PG8_MMA(1, 0, At, B0); PG8_BAR; PG8_SCHED;
            PG8_STAGE(PG8_SB(0, 1), b2 + hstep, voffB);
            PG8_WAIT_V(6); PG8_BAR; PG8_MMA(1, 1, At, B1); PG8_BAR;
            PG8_LDB(B0, 1, 0); PG8_SCHED; PG8_LDA(At, 1, 0); PG8_STAGE(PG8_SA(0, 1), a2 + hstep, voffA);
            PG8_WAIT_L(8); PG8_BAR; PG8_WAIT_L(0); PG8_MMA(0, 0, At, B0); PG8_BAR; PG8_SCHED;
            PG8_LDB(B1, 1, 1); PG8_STAGE(PG8_SB(1, 0), b3, voffB);
            PG8_BAR; PG8_WAIT_L(0); PG8_MMA(0, 1, At, B1); PG8_BAR;
            PG8_LDA(At, 1, 1); PG8_STAGE(PG8_SA(1, 0), a3, voffA);
            PG8_BAR; PG8_WAIT_L(0); PG8_MMA(1, 0, At, B0); PG8_BAR; PG8_SCHED;
            PG8_STAGE(PG8_SB(1, 1), b3 + hstep, voffB);
            PG8_WAIT_V(6); PG8_BAR; PG8_MMA(1, 1, At, B1); PG8_BAR;
            }
        }
        if constexpr (ALIGN_EPI) { if (wr == 0) PG8_BAR; }
        if constexpr (!Epi::AFTER_DRAIN) { E(acc, cur, wr, wc, fr, fq); S.done(cur); }
        if (!has_next) break;
#pragma unroll
        for (int a = 0; a < 2; ++a)
#pragma unroll
            for (int b = 0; b < 2; ++b)
#pragma unroll
                for (int m = 0; m < 4; ++m)
#pragma unroll
                    for (int n = 0; n < 2; ++n) acc[a][b][m][n] = (f32x4){0.f, 0.f, 0.f, 0.f};
        cur = nxt; cA = nA; cB = nB; ++ui;
        if constexpr (ALIGN_EPI) { if (wr == 1) PG8_BAR; }
    }
    PG8_WAIT_V(0);
    if constexpr (!ALIGN_EPI) { if (wr == 0) PG8_BAR; }
    PG8_BAR;
    if constexpr (Epi::AFTER_DRAIN) { E.fused(acc, cur, wr, wc, fr, fq, lds, wid, lane); S.done(cur); }
#undef PG8_SA
#undef PG8_SB
#undef PG8_STAGE
#undef PG8_LDA
#undef PG8_LDB
#undef PG8_MMA
#undef PG8_WAIT_V
#undef PG8_WAIT_L
#undef PG8_BAR
#undef PG8_SCHED
}
}
constexpr int BATCH = 2, SEQ = 8192, DM = 4096, M = BATCH * SEQ, DFF = 11008, NLAYER = 2;
constexpr int P_IN = 10704, NIN = 10752, NMAIN = 10496;
constexpr int CA_Q = 0, CA_K = 1024, CA_V = 2048;
constexpr int CB_Q = 3072, CB_K = 3584, CB_V = 4096, CB_G = 5120;
constexpr int CC_R = 6144, CC_K = 7168, CC_V = 8192;
constexpr int CD_Q = 9216, CD_K = 10240, CD_V = 10368;
constexpr float LOG2E = 1.4426950408889634f;
constexpr float QSCALE = 0.125f * LOG2E;
constexpr int NWAVES = 8;

constexpr size_t MiB = 1u << 20;
constexpr size_t WS_CTL = 0, CTL_ZERO_BYTES = 1 * MiB;
constexpr size_t WS_MODP = 2 * MiB;
constexpr size_t WS_MOD = 14 * MiB;
constexpr size_t WS_TAB = 15 * MiB;
constexpr size_t WS_WIN = 16 * MiB, WIN_L = 84 * MiB;
constexpr size_t WS_WOUT = 184 * MiB, WOUT_L = 32 * MiB;
constexpr size_t WS_W13 = 248 * MiB, W13_L = 172 * MiB;
constexpr size_t WS_W2 = 592 * MiB, W2_L = 86 * MiB;
constexpr size_t WS_XN = 764 * MiB;
constexpr size_t WS_COLS = 892 * MiB;
constexpr size_t WS_LOWR = 1220 * MiB;
constexpr size_t WS_HID = 892 * MiB;
constexpr size_t WS_QKA = 1236 * MiB;
constexpr size_t WS_QKD = 1300 * MiB;
constexpr size_t WS_LOGA = 1336 * MiB;
constexpr size_t WS_RW = 1368 * MiB, RW_ONE = 64 * MiB;
constexpr size_t WS_VFIRST = 1816 * MiB;
constexpr size_t WS_MIXED = 1880 * MiB;
constexpr int VROW = SEQ + 64;
constexpr size_t WS_VTA = 2008 * MiB;
constexpr size_t WS_VTD = 2041 * MiB;
constexpr size_t WS_QDEC = 2046 * MiB, WS_KDT = 2062 * MiB, WS_AM = 2078 * MiB, WS_EBL = 2086 * MiB;
constexpr size_t WS_VTB = 2087 * MiB;
constexpr size_t WS_RWC = 2120 * MiB;
constexpr size_t WS_END = 2446 * MiB;
constexpr int CW_BAR = 4096;
constexpr int CW_Q = 16384;

constexpr int RING_OFF = 0, RING_BYTES = 131072;
constexpr int LDSCTL_OFF = RING_BYTES, MISC_OFF = LDSCTL_OFF + 320;
constexpr int LDS_BYTES = 147456;

#define GAS __attribute__((address_space(1)))
#define LAS __attribute__((address_space(3)))
typedef unsigned short bf16;
typedef unsigned v4u __attribute__((ext_vector_type(4)));
typedef unsigned v2u __attribute__((ext_vector_type(2)));
typedef float f32x4 __attribute__((ext_vector_type(4)));
typedef short bf16x8 __attribute__((ext_vector_type(8)));
typedef GAS unsigned gu32;
#define RLX_AGENT __ATOMIC_RELAXED, __HIP_MEMORY_SCOPE_AGENT
#define LDS_WAIT() asm volatile("s_waitcnt lgkmcnt(0)" ::: "memory")
#define VM_WAIT() asm volatile("s_waitcnt vmcnt(0)" ::: "memory")
typedef float f32x2_t __attribute__((ext_vector_type(2))); typedef __bf16 bf16x2_t __attribute__((ext_vector_type(2)));
__device__ __forceinline__ unsigned pk2(float lo, float hi) { const f32x2_t v = {lo, hi}; return __builtin_bit_cast(unsigned, __builtin_convertvector(v, bf16x2_t)); }
__device__ __forceinline__ unsigned f2bf(float f) { return pk2(f, f) & 0xffffu; }
__device__ __forceinline__ float bf2f(unsigned short h) { return __builtin_bit_cast(float, (unsigned)h << 16); }
__device__ __forceinline__ float bflo(unsigned w) { return __builtin_bit_cast(float, w << 16); }
__device__ __forceinline__ float bfhi(unsigned w) { return __builtin_bit_cast(float, w & 0xffff0000u); }
template <int CTRL> __device__ __forceinline__ float dpp_f(float v) { return __builtin_bit_cast(float, __builtin_amdgcn_update_dpp(0, __builtin_bit_cast(int, v), CTRL, 0xF, 0xF, true)); }
__device__ __forceinline__ float sum8(float v) {
    v += dpp_f<0xB1>(v); v += dpp_f<0x4E>(v); v += dpp_f<0x141>(v); return v; }
__device__ __forceinline__ float sum32(float v) {
    v = sum8(v); v += dpp_f<0x140>(v); v += __builtin_bit_cast(float, __builtin_amdgcn_ds_swizzle(__builtin_bit_cast(int, v), 0x401F)); return v; }
__device__ __forceinline__ float wave_sum(float v) {
    v = sum8(v); v += dpp_f<0x140>(v);
    v += __builtin_bit_cast(float, __builtin_amdgcn_ds_swizzle(__builtin_bit_cast(int, v), 0x401F));
    { const int u = __builtin_bit_cast(int, v); v = __builtin_bit_cast(float, __builtin_amdgcn_readlane(u, 0)) + __builtin_bit_cast(float, __builtin_amdgcn_readlane(u, 32)); }
    return v;
}
__device__ __forceinline__ float sigmoid_f(float x) { return __builtin_amdgcn_rcpf(1.0f + __builtin_amdgcn_exp2f(-LOG2E * x)); }
__device__ __forceinline__ float silu_g(float x) { return x * sigmoid_f(x); }

#define XB_TMO      128
#define XB_XCNT(j)  (256  + 64 * (j))
#define XB_XSUB(j)  (1280 + 64 * (j))
#define XB_XGEN(j)  (2304 + 64 * (j))
#define XB_TOP      3328
#define XB_TOPGEN   3392
#define XCD_BAR_WORDS 3456
#define XB_SPIN_CAP (1u << 23)

__device__ __forceinline__ unsigned xb_ld(unsigned* p)              { return __hip_atomic_load(p, __ATOMIC_RELAXED, __HIP_MEMORY_SCOPE_AGENT); }
__device__ __forceinline__ unsigned xb_add(unsigned* p, unsigned v) { return __hip_atomic_fetch_add(p, v, __ATOMIC_RELAXED, __HIP_MEMORY_SCOPE_AGENT); }
__device__ __forceinline__ unsigned xb_xcc_id() { return (unsigned)__builtin_amdgcn_s_getreg((3 << 11) | 20) & 0xFu; }
#define XB_SPIN(cond, bar) do { unsigned _sp = 0; while (cond) { __builtin_amdgcn_s_sleep(1); \
    if ((++_sp & 255u) == 0u) { if (xb_ld(&(bar)[XB_TMO])) break; if (_sp > XB_SPIN_CAP) { atomicAdd(&(bar)[XB_TMO], 1u); break; } } } } while (0)

struct XcdBarrier {
    unsigned* bar; unsigned x;
    volatile LAS unsigned* st;
};

__device__ __forceinline__ XcdBarrier xcd_barrier_post(unsigned* bar, volatile LAS unsigned* st) {
    XcdBarrier b; b.bar = bar; b.x = xb_xcc_id(); b.st = st;
    if (threadIdx.x == 0) (void)xb_add(&bar[XB_XCNT(b.x)], 1u);
    return b;
}
__device__ __forceinline__ void xcd_barrier_complete(unsigned* bar, unsigned x, unsigned& nloc, unsigned& nx) {
    const unsigned G = gridDim.x * gridDim.y * gridDim.z;
    unsigned sum, cnt, mine, sp = 0u;
    for (;;) {
        sum = 0u; cnt = 0u; mine = 0u;
#pragma unroll
        for (unsigned j = 0; j < 16; ++j) { const unsigned c = xb_ld(&bar[XB_XCNT(j)]); sum += c; cnt += (c > 0u) ? 1u : 0u; mine = (j == x) ? c : mine; }
        if (sum == G) break;
        __builtin_amdgcn_s_sleep(1);
        if ((++sp & 255u) == 0u) { if (xb_ld(&bar[XB_TMO])) break; if (sp > XB_SPIN_CAP) { atomicAdd(&bar[XB_TMO], 1u); break; } }
    }
    nloc = mine > 0u ? mine : 1u; nx = cnt > 0u ? cnt : 1u;
}

__device__ __forceinline__ void xcd_barrier(const XcdBarrier& b) {
    asm volatile("s_waitcnt vmcnt(0)" ::: "memory");
    __syncthreads();
    if (threadIdx.x == 0) {
        unsigned* bar = b.bar;
        __builtin_amdgcn_s_waitcnt(0);
        unsigned nloc = b.st[0], nx = b.st[1];
        if (nloc == 0u) { xcd_barrier_complete(bar, b.x, nloc, nx); b.st[0] = nloc; b.st[1] = nx; }
        const unsigned old = xb_add(&bar[XB_XSUB(b.x)], 1u);
        const unsigned gen = old / nloc;
        if (old + 1u == (gen + 1u) * nloc) {
            __builtin_amdgcn_fence(__ATOMIC_RELEASE, "agent");
            asm volatile("s_waitcnt vmcnt(0)" ::: "memory");
            const unsigned og = xb_add(&bar[XB_TOP], 1u);
            const unsigned tg = og / nx;
            if (og + 1u == (tg + 1u) * nx) xb_add(&bar[XB_TOPGEN], 1u);
            else XB_SPIN(xb_ld(&bar[XB_TOPGEN]) == tg, bar);
            __builtin_amdgcn_fence(__ATOMIC_ACQUIRE, "agent");
            xb_add(&bar[XB_XGEN(b.x)], 1u);
            asm volatile("s_waitcnt vmcnt(0)" ::: "memory");
        } else {
            XB_SPIN(xb_ld(&bar[XB_XGEN(b.x)]) == gen, bar);
            __builtin_amdgcn_fence(__ATOMIC_ACQUIRE, "agent");
            asm volatile("s_waitcnt vmcnt(0)" ::: "memory");
        }
    }
    __syncthreads();
}

typedef const float* const __attribute__((address_space(4)))* kargp;
struct Frame {
    LAS unsigned char* lds;
    volatile LAS unsigned* MISC;
    gu32* ctl;
    int tid, lane, wave;
    int vcu, G, bx;
    kargp kin;
    float* out;
    unsigned char* ws;
};
enum { I_X = 0, I_C, I_RELB, I_ADAW, I_ADAB, I_WIN, I_WOUT, I_DQN, I_DKN, I_DLAM, I_DSUB, I_GGU, I_GGB, I_GON, I_RMU, I_RWUP, I_RW0, I_RAUP, I_RA0, I_RGUP,
       I_RKK, I_RKA, I_RRK, I_RLNW, I_RLNB, I_VRD, I_VRMU, I_VRUP, I_VR0, I_SQN, I_SKN, I_SSINK, I_W1, I_W3, I_W2 };

#define WSP(T, off) ((T*)(F.ws + (off)))
__device__ __forceinline__ void relaunder_tid(Frame& F) { int t = F.tid; asm volatile("" : "+v"(t)); F.tid = t; F.lane = t & 63; F.wave = __builtin_amdgcn_readfirstlane(t >> 6); }
__device__ __forceinline__ void relaunder(Frame& F) { kargp p = F.kin; asm volatile("" : "+s"(p)); F.kin = p; }

__device__ __forceinline__ void conv_item(const float* src, int ld, int col0, int ncols, int K, bf16* WT, int row0, int kb, LAS float* scr, int lane) {
    const int k0 = 64 * kb;
    { const int n = lane & 31; const bool ok = src != nullptr && n < ncols; const float* sp = src + (size_t)(k0 + (lane >> 5)) * ld + col0 + n; float v[32];
#pragma unroll
      for (int i = 0; i < 32; ++i) v[i] = ok ? sp[(size_t)(2 * i) * ld] : 0.f;
#pragma unroll
      for (int i = 0; i < 32; ++i) scr[(2 * i + (lane >> 5)) * 33 + n] = v[i]; }
    LDS_WAIT(); asm volatile("" ::: "memory");
    const int c = lane & 7;
#pragma unroll
    for (int j = 0; j < 4; ++j) { const int n = (lane >> 3) + 8 * j; const LAS float* s = scr + (8 * c) * 33 + n;
        v4u o; o.x = pk2(s[0 * 33], s[1 * 33]); o.y = pk2(s[2 * 33], s[3 * 33]); o.z = pk2(s[4 * 33], s[5 * 33]); o.w = pk2(s[6 * 33], s[7 * 33]);
        if (n < ncols) *(GAS v4u*)(WT + (size_t)(row0 + n) * K + k0 + 8 * c) = o; }
    LDS_WAIT(); asm volatile("" ::: "memory");
}
__device__ __forceinline__ int t5_bucket(int d) {
    if (d < 16) return d;
    int v = 16 + (int)(logf((float)d * (1.0f / 16.0f)) / logf(8.0f) * 16.0f);
    return v < 31 ? v : 31;
}
__device__ __forceinline__ void p0_prologue_a(Frame& F) {
    const int gw = F.vcu * NWAVES + F.wave, NGW = F.G * NWAVES;
    LAS float* ldsf = (LAS float*)(F.lds + RING_OFF);
    for (int i = F.tid; i < 2 * DM; i += NWAVES * 64) ldsf[i] = silu_g(F.kin[I_C][i]);
    __syncthreads();
    float* MODP = WSP(float, WS_MODP);
    for (int it = gw; it < 6144; it += NGW) {
        const int l = it / 3072, rem = it % 3072, kc = rem / 96, ng = rem % 96, n0 = 256 * ng + 4 * F.lane;
        const float* w = F.kin[I_ADAW] + ((size_t)l * DM + kc * 128) * 24576 + n0;
        f32x4 a0 = {0.f, 0.f, 0.f, 0.f}, a1 = {0.f, 0.f, 0.f, 0.f};
#pragma unroll 16
        for (int k = 0; k < 128; ++k) { const f32x4 wv = *(const f32x4*)(w + (size_t)k * 24576); const float s0 = ldsf[kc * 128 + k], s1 = ldsf[DM + kc * 128 + k]; a0 += wv * s0; a1 += wv * s1; }
        *(f32x4*)(MODP + ((size_t)(l * 32 + kc) * 2 + 0) * 24576 + n0) = a0;
        *(f32x4*)(MODP + ((size_t)(l * 32 + kc) * 2 + 1) * 24576 + n0) = a1;
    }
    __syncthreads();
    LAS float* scr = (LAS float*)(F.lds + RING_OFF + F.wave * 16384);
    constexpr int I_IN = 337 * 64, I_OUT = 128 * 64, I_13 = 688 * 64, I_2 = 128 * 172, I_L = I_IN + I_OUT + I_13 + I_2;
    for (int it = gw; it < NLAYER * I_L; it += NGW) {
        const int l = it / I_L; int r = it % I_L;
        if (r < I_IN) {
            const int kb = r / 337, cb = r % 337; const float* src = F.kin[I_WIN] + (size_t)l * DM * P_IN; int ld = P_IN, col0, row0, nc = 32;
            if (cb < 192) { col0 = 32 * cb; row0 = 32 * cb; }
            else if (cb < 288) { col0 = 6160 + 32 * (cb - 192); row0 = 6144 + 32 * (cb - 192); }
            else if (cb < 328) { col0 = 9424 + 32 * (cb - 288); row0 = 9216 + 32 * (cb - 288); }
            else if (cb == 328) { col0 = 6144; row0 = 10496; nc = 16; }
            else if (cb < 335) { col0 = 9232 + 32 * (cb - 329); row0 = 10512 + 32 * (cb - 329); }
            else if (cb == 335) { src = l ? F.kin[I_VRD] + (size_t)(l - 1) * DM * 32 : nullptr; ld = 32; col0 = 0; row0 = 10704; }
            else { src = nullptr; col0 = 0; row0 = 10736; nc = 16; }
            conv_item(src, ld, col0, nc, DM, WSP(bf16, WS_WIN + l * WIN_L), row0, kb, scr, F.lane); continue; }
        r -= I_IN;
        if (r < I_OUT) { const int kb = r / 128, cb = r % 128; conv_item(F.kin[I_WOUT] + (size_t)l * DM * DM, DM, 32 * cb, 32, DM, WSP(bf16, WS_WOUT + l * WOUT_L), 32 * cb, kb, scr, F.lane); continue; }
        r -= I_OUT;
        if (r < I_13) { const int kb = r / 688, cb = r % 688, pn = cb >> 3, wi = cb & 7;
            const float* src = (wi < 4 ? F.kin[I_W1] : F.kin[I_W3]) + (size_t)l * DM * DFF;
            conv_item(src, DFF, 128 * pn + 32 * (wi & 3), 32, DM, WSP(bf16, WS_W13 + l * W13_L), 32 * cb, kb, scr, F.lane); continue; }
        r -= I_13;
        { const int kb = r / 128, cb = r % 128; conv_item(F.kin[I_W2] + (size_t)l * DFF * DM, DM, 32 * cb, 32, DFF, WSP(bf16, WS_W2 + l * W2_L), 32 * cb, kb, scr, F.lane); }
    }
}
__device__ __forceinline__ void p0_prologue_b(Frame& F) {
    const int gt = F.bx * (NWAVES * 64) + F.tid, NT = F.G * NWAVES * 64;
    const float* MODP = WSP(float, WS_MODP); float* MOD = WSP(float, WS_MOD);
    for (int idx = gt; idx < NLAYER * 2 * 24576; idx += NT) {
        const int l = idx / 49152, rem = idx % 49152, b = rem / 24576, n = rem % 24576;
        float s = F.kin[I_ADAB][l * 24576 + n];
#pragma unroll 8
        for (int kc = 0; kc < 32; ++kc) s += MODP[((size_t)(l * 32 + kc) * 2 + b) * 24576 + n];
        MOD[idx] = s;
    }
    if (F.bx == 0) { float* TAB = WSP(float, WS_TAB);
        for (int i = F.tid; i < 24 * 128; i += NWAVES * 64) { const int hh = i >> 7, d = i & 127; TAB[i] = F.kin[I_RELB][t5_bucket(d) * 24 + hh] * LOG2E; } }
}
__device__ __forceinline__ void rms_phase(Frame& F, const float* xin, const float* sh, const float* sc) {
    const int gw = F.vcu * NWAVES + F.wave, NGW = F.G * NWAVES;
    bf16* XN = WSP(bf16, WS_XN);
    for (int m = gw; m < M; m += NGW) {
        const int b = m >> 13;
        const f32x4* xr = (const f32x4*)(xin + (size_t)m * DM) + F.lane;
        f32x4 v[16]; float ss = 0.f;
#pragma unroll
        for (int j = 0; j < 16; ++j) { v[j] = xr[64 * j]; ss += (v[j].x * v[j].x + v[j].y * v[j].y) + (v[j].z * v[j].z + v[j].w * v[j].w); }
        const float rstd = rsqrtf(wave_sum(ss) * (1.0f / DM) + 1e-6f);
        const f32x4* scp = (const f32x4*)(sc + (size_t)b * 24576) + F.lane; const f32x4* shp = (const f32x4*)(sh + (size_t)b * 24576) + F.lane;
        v2u* o8 = (v2u*)(XN + (size_t)m * DM) + F.lane;
#pragma unroll
        for (int j = 0; j < 16; ++j) { const f32x4 s4 = scp[64 * j], h4 = shp[64 * j]; const f32x4 o = v[j] * rstd * (s4 + 1.0f) + h4;
            v2u w; w.x = pk2(o.x, o.y); w.y = pk2(o.z, o.w); o8[64 * j] = w; }
    }
}
__device__ __forceinline__ void unpack8(const v4u r, float (&f)[8]) { f[0] = bflo(r.x); f[1] = bfhi(r.x); f[2] = bflo(r.y); f[3] = bfhi(r.y); f[4] = bflo(r.z); f[5] = bfhi(r.z); f[6] = bflo(r.w); f[7] = bfhi(r.w); }
__device__ __forceinline__ v4u pack8(const float (&f)[8]) { v4u o; o.x = pk2(f[0], f[1]); o.y = pk2(f[2], f[3]); o.z = pk2(f[4], f[5]); o.w = pk2(f[6], f[7]); return o; }
__device__ __forceinline__ void prep_norm(Frame& F, int l) {
    const int gw = F.vcu * NWAVES + F.wave, NGW = F.G * NWAVES, lane = F.lane, sub = lane >> 3, ch = lane & 7;
    float gqa[8], gka[8], gqd[8], gkd[8];
#pragma unroll
    for (int e = 0; e < 8; ++e) { gqa[e] = F.kin[I_DQN][l * 64 + ch * 8 + e] * QSCALE; gka[e] = F.kin[I_DKN][l * 64 + ch * 8 + e];
                                  gqd[e] = F.kin[I_SQN][l * 64 + ch * 8 + e] * QSCALE; gkd[e] = F.kin[I_SKN][l * 64 + ch * 8 + e]; }
    const bf16* COLS = WSP(bf16, WS_COLS); bf16* QKA = WSP(bf16, WS_QKA); bf16* QKD = WSP(bf16, WS_QKD);
    for (int m = gw; m < M; m += NGW) {
        const bf16* src = COLS + (size_t)m * NMAIN;
#pragma unroll
        for (int i = 0; i < 4; ++i) { const int vec = i * 8 + sub, col = vec * 64 + ch * 8;
            float f[8]; unpack8(*(const v4u*)(src + CA_Q + col), f); float ss = 0.f;
#pragma unroll
            for (int e = 0; e < 8; ++e) ss += f[e] * f[e];
            ss = sum8(ss);
            const float rstd = rsqrtf(ss * (1.0f / 64.0f) + 1e-6f);
#pragma unroll
            for (int e = 0; e < 8; ++e) f[e] = f[e] * rstd * (i < 2 ? gqa[e] : gka[e]);
            *(v4u*)(QKA + (size_t)m * 2048 + col) = pack8(f); }
#pragma unroll
        for (int i = 0; i < 3; ++i) { const int vec = i * 8 + sub, col = vec * 64 + ch * 8;
            if (vec < 18) { float f[8]; unpack8(*(const v4u*)(src + CD_Q + col), f); float ss = 0.f;
#pragma unroll
                for (int e = 0; e < 8; ++e) ss += f[e] * f[e];
                ss = sum8(ss);
                const float rstd = rsqrtf(ss * (1.0f / 64.0f) + 1e-6f);
#pragma unroll
                for (int e = 0; e < 8; ++e) f[e] = f[e] * rstd * (vec < 16 ? gqd[e] : gkd[e]);
                *(v4u*)(QKD + (size_t)m * 1152 + col) = pack8(f); } }
    }
}
__device__ __forceinline__ void prep_loga(Frame& F, int l) {
    LAS float* gdl = (LAS float*)(F.lds + RING_OFF);
    float gu[16];
#pragma unroll
    for (int j = 0; j < 16; ++j) gu[j] = F.kin[I_GGU][((size_t)l * 16 + j) * 512 + F.tid];
    const float bias = F.kin[I_GGB][l * 512 + F.tid];
    const float* LOWR = WSP(float, WS_LOWR); float* LOGA = WSP(float, WS_LOGA);
    for (int tile = F.bx; tile < M / 64; tile += F.G) {
        const size_t row0 = (size_t)tile * 64;
        __syncthreads();
#pragma unroll
        for (int i = 0; i < 2; ++i) { const int idx = F.tid + 512 * i; gdl[idx] = LOWR[(row0 + (idx >> 4)) * 256 + (idx & 15)]; }
        __syncthreads();
#pragma unroll 4
        for (int t = 0; t < 64; ++t) { const LAS f32x4* gp = (const LAS f32x4*)(gdl + t * 16); const f32x4 g0 = gp[0], g1 = gp[1], g2 = gp[2], g3 = gp[3];
            float z = bias + g0.x * gu[0] + g0.y * gu[1] + g0.z * gu[2] + g0.w * gu[3] + g1.x * gu[4] + g1.y * gu[5] + g1.z * gu[6] + g1.w * gu[7]
                    + g2.x * gu[8] + g2.y * gu[9] + g2.z * gu[10] + g2.w * gu[11] + g3.x * gu[12] + g3.y * gu[13] + g3.z * gu[14] + g3.w * gu[15];
            LOGA[(row0 + t) * 512 + F.tid] = (fminf(z, 0.f) - __logf(1.0f + __expf(-fabsf(z)))) * (1.0f / 16.0f); }
    }
}
__device__ __forceinline__ int next_item(Frame& F, gu32* ctr) {
    volatile LAS int* slot = (volatile LAS int*)(F.lds + LDSCTL_OFF + 64);
    __syncthreads();
    if (F.tid == 0) *slot = (int)__hip_atomic_fetch_add(ctr, 1u, RLX_AGENT);
    __syncthreads();
    return *slot;
}
typedef float f32x16 __attribute__((ext_vector_type(16)));
__device__ __forceinline__ float xother32(float v) { unsigned a = __builtin_bit_cast(unsigned, v), b = a; asm volatile("" : "+v"(b)); auto rr = __builtin_amdgcn_permlane32_swap(a, b, false, false);
    const unsigned lo = rr[0], hi = rr[1]; return __builtin_bit_cast(float, (unsigned)((__builtin_amdgcn_mbcnt_hi(~0u, __builtin_amdgcn_mbcnt_lo(~0u, 0u)) & 32u) ? lo : hi)); }
__device__ __forceinline__ float xsum32(float v) { return v + xother32(v); }
__device__ __forceinline__ float xmax32(float v) { return fmaxf(v, xother32(v)); }
__device__ __forceinline__ int crow16(int r, int hi) { return (r & 3) + 8 * (r >> 2) + 4 * hi; }
template <bool ISA>
__device__ __forceinline__ void attn_unit(Frame& F, int l, int b, int hx, int qb) {
    constexpr int DV = ISA ? 128 : 64, NDV = DV / 32, KSTR = ISA ? 272 : 144, VSTR = 144, KBYTES = 64 * KSTR, VBYTES = DV * VSTR, BUFB = KBYTES + VBYTES, NCH = ISA ? 2 : 1;
    constexpr float NEG = -1e30f;
    LAS unsigned char* L = F.lds + RING_OFF;
    const int tid = F.tid, lane = F.lane, r32 = lane & 31, hi = lane >> 5, qs = F.wave & 3, grp = F.wave >> 2, q0 = qb * 128;
    const int kvh = hx >> 2, hd = kvh * 8 + (hx & 3) * 2 + grp;
    const bf16* Qp; const bf16* Kp; const bf16* VT; int ldq;
    if (ISA) { const bf16* QKA = WSP(bf16, WS_QKA); Qp = QKA + (size_t)b * SEQ * 2048 + hx * 128 + grp * 64; Kp = QKA + (size_t)b * SEQ * 2048 + 1024 + hx * 128; ldq = 2048; VT = WSP(bf16, WS_VTA) + (size_t)(b * 8 + hx) * 128 * VROW; }
    else { const bf16* QKD = WSP(bf16, WS_QKD); Qp = QKD + (size_t)b * SEQ * 1152 + hd * 64; Kp = QKD + (size_t)b * SEQ * 1152 + 1024 + kvh * 64; ldq = 1152; VT = WSP(bf16, WS_VTD) + (size_t)(b * 2 + kvh) * 64 * VROW; }
    const int qpos = q0 + 32 * qs + r32;
    bf16x8 qr[4];
#pragma unroll
    for (int d0 = 0; d0 < 4; ++d0) qr[d0] = *(const bf16x8*)(Qp + (size_t)qpos * ldq + d0 * 16 + hi * 8);
    LAS float* Bt = (LAS float*)(L + 2 * BUFB);
    { const float* TAB = WSP(float, WS_TAB);
      if (ISA) { if (tid < 130) Bt[tid] = tid == 0 ? NEG : (tid == 129 ? 0.f : TAB[hx * 128 + tid - 1] - TAB[hx * 128 + 127]); }
      else { if (tid < 260) { const int gi = tid >= 130, t = tid - 130 * gi; Bt[tid] = (t == 0 || t == 129) ? NEG : TAB[(8 + kvh * 8 + (hx & 3) * 2 + gi) * 128 + t - 1]; } } }
    const int TQ = q0 >> 6, T0 = ISA ? 0 : (TQ >= 2 ? TQ - 2 : 0), T1 = TQ + 1;
    v4u kreg[NCH], vreg[NCH];
#define AT_GLOAD(T) do { _Pragma("unroll") for (int i_ = 0; i_ < NCH; ++i_) { const int c_ = tid + 512 * i_; \
        const int kr_ = ISA ? (c_ >> 4) : (c_ >> 3), kc_ = ISA ? (c_ & 15) : (c_ & 7); kreg[i_] = *(const v4u*)(Kp + (size_t)((T) * 64 + kr_) * ldq + kc_ * 8); \
        const int vr_ = c_ >> 3, vc_ = c_ & 7; vreg[i_] = *(const v4u*)(VT + (size_t)vr_ * VROW + (T) * 64 + vc_ * 8); } } while (0)
#define AT_LWRITE(buf) do { _Pragma("unroll") for (int i_ = 0; i_ < NCH; ++i_) { const int c_ = tid + 512 * i_; \
        const int kr_ = ISA ? (c_ >> 4) : (c_ >> 3), kc_ = ISA ? (c_ & 15) : (c_ & 7); *(LAS v4u*)(L + (buf) * BUFB + kr_ * KSTR + kc_ * 16) = kreg[i_]; \
        const int vr_ = c_ >> 3, vc_ = c_ & 7; *(LAS v4u*)(L + (buf) * BUFB + KBYTES + vr_ * VSTR + vc_ * 16) = vreg[i_]; } } while (0)
    f32x16 o[NDV];
#pragma unroll
    for (int i = 0; i < NDV; ++i) o[i] = (f32x16){0.f, 0.f, 0.f, 0.f, 0.f, 0.f, 0.f, 0.f, 0.f, 0.f, 0.f, 0.f, 0.f, 0.f, 0.f, 0.f};
    float m_run = ISA ? NEG : F.kin[I_SSINK][l * 16 + hd] * LOG2E, l_run = ISA ? 0.f : (hi == 0 ? 1.f : 0.f);
    const int krow = (r32 & 16) | (r32 & 3) | ((r32 & 4) << 1) | ((r32 & 8) >> 1);
    const int koff = krow * KSTR + (ISA ? grp * 128 : 0) + hi * 16, voff = KBYTES + r32 * VSTR + hi * 16;
    AT_GLOAD(T0); AT_LWRITE(0); __syncthreads();
#pragma unroll 1
    for (int T = T0; T <= T1; ++T) {
        const int cur = (T - T0) & 1;
        AT_GLOAD(T < T1 ? T + 1 : T1);
        LAS const unsigned char* Kb = L + cur * BUFB;
        f32x16 s[2];
#pragma unroll
        for (int blk = 0; blk < 2; ++blk) { s[blk] = (f32x16){0.f, 0.f, 0.f, 0.f, 0.f, 0.f, 0.f, 0.f, 0.f, 0.f, 0.f, 0.f, 0.f, 0.f, 0.f, 0.f};
#pragma unroll
            for (int d0 = 0; d0 < 4; ++d0) { const bf16x8 kf = *(const LAS bf16x8*)(Kb + koff + blk * 32 * KSTR + d0 * 32); s[blk] = __builtin_amdgcn_mfma_f32_32x32x16_bf16(kf, qr[d0], s[blk], 0, 0, 0); } }
        if (!ISA || T >= TQ - 2) {
            const LAS float* bt = Bt + (ISA ? 0 : grp * 130) + 1; const int d0 = qpos - T * 64 - 8 * hi;
#pragma unroll
            for (int blk = 0; blk < 2; ++blk)
#pragma unroll
                for (int r = 0; r < 16; ++r) { const int dist = d0 - (32 * blk + 16 * (r >> 3) + (r & 7)); const int di = dist < -1 ? -1 : (dist > 128 ? 128 : dist); s[blk][r] += bt[di]; } }
        float mt = s[0][0];
#pragma unroll
        for (int r = 1; r < 16; ++r) mt = fmaxf(mt, s[0][r]);
#pragma unroll
        for (int r = 0; r < 16; ++r) mt = fmaxf(mt, s[1][r]);
        mt = xmax32(mt);
        const float m_new = fmaxf(m_run, mt);
        if (__any(m_new > m_run)) { const float alpha = __builtin_amdgcn_exp2f(m_run - m_new); l_run *= alpha;
#pragma unroll
            for (int i = 0; i < NDV; ++i)
#pragma unroll
                for (int r = 0; r < 16; ++r) o[i][r] *= alpha;
            m_run = m_new; }
        float ls = 0.f;
#pragma unroll
        for (int blk = 0; blk < 2; ++blk)
#pragma unroll
            for (int r = 0; r < 16; ++r) { const float pv_ = __builtin_amdgcn_exp2f(s[blk][r] - m_run); s[blk][r] = pv_; ls += pv_; }
        l_run += ls;
#pragma unroll
        for (int sl = 0; sl < 4; ++sl) { const int blk = sl >> 1, r0 = 8 * (sl & 1);
            v4u pw; pw.x = pg8::cvt_pk_bf16(s[blk][r0], s[blk][r0 + 1]); pw.y = pg8::cvt_pk_bf16(s[blk][r0 + 2], s[blk][r0 + 3]); pw.z = pg8::cvt_pk_bf16(s[blk][r0 + 4], s[blk][r0 + 5]); pw.w = pg8::cvt_pk_bf16(s[blk][r0 + 6], s[blk][r0 + 7]);
            const bf16x8 pf = __builtin_bit_cast(bf16x8, pw);
#pragma unroll
            for (int i = 0; i < NDV; ++i) { const bf16x8 vf = *(const LAS bf16x8*)(Kb + voff + i * 32 * VSTR + sl * 32); o[i] = __builtin_amdgcn_mfma_f32_32x32x16_bf16(vf, pf, o[i], 0, 0, 0); } }
        AT_LWRITE(cur ^ 1);
        __syncthreads();
    }
#undef AT_GLOAD
#undef AT_LWRITE
    const float inv = 1.0f / xsum32(l_run);
    bf16* MIX = WSP(bf16, WS_MIXED);
    if (ISA) {
        int ll_ = l; asm volatile("" : "+s"(ll_)); const float lam_init = ll_ == 0 ? 0.2f : 0.35550906759f;     float lam_full;
        { const float* lm = F.kin[I_DLAM] + (size_t)l * 256; const float s1 = wave_sum(lm[lane] * lm[64 + lane]), s2 = wave_sum(lm[128 + lane] * lm[192 + lane]); lam_full = __expf(s1) - __expf(s2) + lam_init; }
        LAS float* R1 = (LAS float*)L;
        LAS bf16* R2 = (LAS bf16*)(L + 66048);
        const int ql = 32 * qs + r32;
        if (grp == 1) {
#pragma unroll
            for (int i = 0; i < NDV; ++i)
#pragma unroll
                for (int r = 0; r < 16; ++r) R1[ql * 129 + 32 * i + crow16(r, hi)] = lam_full * inv * o[i][r]; }
        __syncthreads();
        if (grp == 0) { float ss = 0.f;
#pragma unroll
            for (int i = 0; i < NDV; ++i)
#pragma unroll
                for (int r = 0; r < 16; ++r) { const float d = o[i][r] * inv - R1[ql * 129 + 32 * i + crow16(r, hi)]; o[i][r] = d; ss += d * d; }
            const float rstd = rsqrtf(xsum32(ss) * (1.0f / 128.0f) + 1e-6f) * (1.0f - lam_init);
            const float* sl = F.kin[I_DSUB] + l * 128;
#pragma unroll
            for (int i = 0; i < NDV; ++i)
#pragma unroll
                for (int r = 0; r < 16; ++r) { const int dv = 32 * i + crow16(r, hi); R2[ql * 132 + dv] = (bf16)f2bf(o[i][r] * rstd * sl[dv]); } }
        __syncthreads();
#pragma unroll
        for (int i = 0; i < 4; ++i) { const int c = tid + 512 * i, row = c >> 4, ch = c & 15; const LAS v2u* sp = (const LAS v2u*)(R2 + row * 132 + ch * 8); const v2u a = sp[0], bb = sp[1];
            *(v4u*)(MIX + (size_t)(b * SEQ + q0 + row) * DM + hx * 128 + ch * 8) = (v4u){a.x, a.y, bb.x, bb.y}; }
    } else {
        LAS bf16* R = (LAS bf16*)L + F.wave * 2176;
#pragma unroll
        for (int i = 0; i < NDV; ++i)
#pragma unroll
            for (int r = 0; r < 16; ++r) R[r32 * 68 + 32 * i + crow16(r, hi)] = (bf16)f2bf(o[i][r] * inv);
#pragma unroll
        for (int i = 0; i < 4; ++i) { const int c = lane + 64 * i, row = c >> 3, ch = c & 7; const LAS v2u* sp = (const LAS v2u*)(R + row * 68 + ch * 8); const v2u a = sp[0], bb = sp[1];
            *(v4u*)(MIX + (size_t)(b * SEQ + q0 + 32 * qs + row) * DM + 3072 + hd * 64 + ch * 8) = (v4u){a.x, a.y, bb.x, bb.y}; }
    }
}
__device__ __forceinline__ void prep_gla(Frame& F) {
    LAS float* Lb = (LAS float*)(F.lds + RING_OFF); LAS float* Qd = Lb + 64 * 129; LAS float* Ki = Qd + 64 * 129; LAS bf16* Kt = (LAS bf16*)(Ki + 64 * 129);
    const bf16* COLS = WSP(bf16, WS_COLS); const float* LOGA = WSP(float, WS_LOGA);
    bf16* QDEC = WSP(bf16, WS_QDEC); bf16* KDT = WSP(bf16, WS_KDT); bf16* AMg = WSP(bf16, WS_AM); float* EBL = WSP(float, WS_EBL);
    for (int u = F.bx; u < 1024; u += F.G) {
        const int b = u >> 9, h = (u >> 7) & 3, ck = u & 127; const size_t row0 = (size_t)b * SEQ + ck * 64;
        __syncthreads();
        for (int idx = F.tid; idx < 8192; idx += NWAVES * 64) { const int t = idx >> 7, d = idx & 127; Lb[t * 129 + d] = LOGA[(row0 + t) * 512 + h * 128 + d]; }
        __syncthreads();
        if (F.tid < 128) { float acc = 0.f;
#pragma unroll 8
            for (int t = 0; t < 64; ++t) { acc += Lb[t * 129 + F.tid]; Lb[t * 129 + F.tid] = acc; }
            EBL[(size_t)u * 128 + F.tid] = __expf(acc); }
        __syncthreads();
        for (int idx = F.tid; idx < 8192; idx += NWAVES * 64) { const int t = idx >> 7, d = idx & 127; const float bt = Lb[t * 129 + d], bl = Lb[63 * 129 + d];
            const float q = bf2f(COLS[(row0 + t) * NMAIN + CB_Q + h * 128 + d]) * 0.08838834764831845f, k = bf2f(COLS[(row0 + t) * NMAIN + CB_K + h * 128 + d]);
            const float qd = q * __expf(bt); Qd[t * 129 + d] = qd; Ki[t * 129 + d] = k * __expf(-bt); Kt[d * 72 + t] = (bf16)f2bf(k * __expf(bl - bt));
            QDEC[((size_t)u * 64 + t) * 128 + d] = (bf16)f2bf(qd); }
        __syncthreads();
#pragma unroll
        for (int i = 0; i < 2; ++i) { const int c_ = F.tid + 512 * i, row = c_ >> 3, ch = c_ & 7; const LAS v2u* sp = (const LAS v2u*)(Kt + row * 72 + ch * 8); const v2u a = sp[0], bb = sp[1];
            *(v4u*)(KDT + ((size_t)u * 128 + row) * 64 + ch * 8) = (v4u){a.x, a.y, bb.x, bb.y}; }
        { const int c = F.tid >> 3, sg = F.tid & 7; float acc[8];
#pragma unroll
          for (int e = 0; e < 8; ++e) acc[e] = 0.f;
#pragma unroll 4
          for (int d = 0; d < 128; ++d) { const float q = Qd[c * 129 + d];
#pragma unroll
              for (int e = 0; e < 8; ++e) acc[e] += q * Ki[(sg * 8 + e) * 129 + d]; }
#pragma unroll
          for (int e = 0; e < 8; ++e) if (sg * 8 + e > c) acc[e] = 0.f;
          *(v4u*)(AMg + ((size_t)u * 64 + c) * 64 + sg * 8) = pack8(acc); }
    }
}
__device__ __forceinline__ void prep_vt(Frame& F, int pass) {
    LAS bf16* T = (LAS bf16*)(F.lds + RING_OFF);
    const bf16* COLS = WSP(bf16, WS_COLS);
    const int nch = pass == 0 ? 144 : 128, nvr = nch * 8;
    for (int tile = F.bx; tile < M / 32; tile += F.G) {
        const int b = tile >> 8, t0 = (tile & 255) * 32;
        __syncthreads();
        for (int idx = F.tid; idx < 32 * nch; idx += NWAVES * 64) { const int tok = idx / nch, ch = idx % nch;
            const int col = pass == 0 ? (ch < 128 ? CA_V + ch * 8 : CD_V + (ch - 128) * 8) : (pass == 1 ? CB_V + ch * 8 : CB_G + ch * 8);
            const v4u v = *(const v4u*)(COLS + (size_t)(b * SEQ + t0 + tok) * NMAIN + col); LAS v2u* d = (LAS v2u*)(T + tok * 1160 + ch * 8); d[0] = (v2u){v.x, v.y}; d[1] = (v2u){v.z, v.w}; }
        __syncthreads();
        for (int idx = F.tid; idx < nvr * 4; idx += NWAVES * 64) { const int ch = idx / nvr, vrow = idx % nvr;
            unsigned e[8];
#pragma unroll
            for (int k = 0; k < 8; ++k) e[k] = T[(ch * 8 + k) * 1160 + vrow];
            v4u o; o.x = e[0] | (e[1] << 16); o.y = e[2] | (e[3] << 16); o.z = e[4] | (e[5] << 16); o.w = e[6] | (e[7] << 16);
            bf16* dst;
            if (pass == 0) dst = vrow < 1024 ? WSP(bf16, WS_VTA) + ((size_t)(b * 8 + (vrow >> 7)) * 128 + (vrow & 127)) * VROW : WSP(bf16, WS_VTD) + ((size_t)(b * 2 + ((vrow - 1024) >> 6)) * 64 + ((vrow - 1024) & 63)) * VROW;
            else dst = WSP(bf16, WS_VTB) + ((size_t)b * 1024 + vrow) * VROW;
            *(v4u*)(dst + t0 + ch * 8) = o; }
    }
}
typedef float f32x4v __attribute__((ext_vector_type(4)));
__device__ __forceinline__ float sum16(float v) { v = sum8(v); v += dpp_f<0x140>(v); return v; }
#define LDS_BARRIER() asm volatile("s_waitcnt lgkmcnt(0)\n\ts_barrier" ::: "memory")
template <int HACK = 0> __device__ __forceinline__ void gla_scan_unit(Frame& F, int l, int b, int h) {
    LAS unsigned char* L = F.lds + RING_OFF;
    constexpr int OQD = 0, OKT = 17408, OAM = 35840, OVT = 45056, OOT = 81920, OEB = 115712, OPS = 116224;
    const int tid = F.tid, lane = F.lane, n = lane & 15, g = lane >> 4, w = F.wave;
    const bf16* QDEC = WSP(bf16, WS_QDEC); const bf16* KDT = WSP(bf16, WS_KDT); const bf16* AMg = WSP(bf16, WS_AM); const float* EBL = WSP(float, WS_EBL);
    const bf16* VTB = WSP(bf16, WS_VTB) + (size_t)(b * 4 + h) * 256 * VROW; const bf16* COLS = WSP(bf16, WS_COLS); bf16* MIX = WSP(bf16, WS_MIXED);
    f32x4v S[8][2];
#pragma unroll
    for (int dt = 0; dt < 8; ++dt)
#pragma unroll
        for (int vt = 0; vt < 2; ++vt) S[dt][vt] = (f32x4v){0.f, 0.f, 0.f, 0.f};
    float gain8[8];
#pragma unroll
    for (int e = 0; e < 8; ++e) gain8[e] = F.kin[I_GON][l * 256 + (tid & 31) * 8 + e];
    v4u pq[2], pk[2], pa, pv[4]; float pe = 0.f;
#define GL_ISSUE(CK) do { const size_t u_ = (size_t)(b * 4 + h) * 128 + (CK); \
        _Pragma("unroll") for (int i = 0; i < 2; ++i) { const int c_ = tid + 512 * i; pq[i] = *(const v4u*)(QDEC + (u_ * 64 + (c_ >> 4)) * 128 + (c_ & 15) * 8); pk[i] = *(const v4u*)(KDT + (u_ * 128 + (c_ >> 3)) * 64 + (c_ & 7) * 8); } \
        pa = *(const v4u*)(AMg + (u_ * 64 + (tid >> 3)) * 64 + (tid & 7) * 8); \
        _Pragma("unroll") for (int i = 0; i < 4; ++i) { const int c_ = tid + 512 * i; pv[i] = *(const v4u*)(VTB + (size_t)(c_ >> 3) * VROW + (CK) * 64 + (c_ & 7) * 8); } \
        pe = EBL[u_ * 128 + (tid & 127)]; } while (0)
#define GL_WRITE() do { _Pragma("unroll") for (int i = 0; i < 2; ++i) { const int c_ = tid + 512 * i; *(LAS v4u*)(L + OQD + (c_ >> 4) * 272 + (c_ & 15) * 16) = pq[i]; *(LAS v4u*)(L + OKT + (c_ >> 3) * 144 + (c_ & 7) * 16) = pk[i]; } \
        *(LAS v4u*)(L + OAM + (tid >> 3) * 144 + (tid & 7) * 16) = pa; \
        _Pragma("unroll") for (int i = 0; i < 4; ++i) { const int c_ = tid + 512 * i; *(LAS v4u*)(L + OVT + (c_ >> 3) * 144 + (c_ & 7) * 16) = pv[i]; } \
        ((LAS float*)(L + OEB))[tid & 127] = pe; } while (0)
    GL_ISSUE(0); GL_WRITE();
    LDS_BARRIER();
#pragma unroll 1
    for (int ck = 0; ck < 128; ++ck) {
        const size_t row0 = (size_t)b * SEQ + ck * 64;
        v4u gq[4];
#pragma unroll
        for (int i = 0; i < 4; ++i) gq[i] = (HACK & 1) ? (v4u){0u, 0u, 0u, 0u} : *(const v4u*)(COLS + (row0 + (tid >> 5) + 16 * i) * NMAIN + CB_G + h * 256 + (tid & 31) * 8);
        GL_ISSUE((HACK & 1) && ck >= 2 ? 2 : (ck + 1 < 128 ? ck + 1 : 127));
        bf16x8 vf[2][2];
#pragma unroll
        for (int vt = 0; vt < 2; ++vt)
#pragma unroll
            for (int ks = 0; ks < 2; ++ks) vf[vt][ks] = *(const LAS bf16x8*)(L + OVT + (32 * w + 16 * vt + n) * 144 + (32 * ks + 8 * g) * 2);
        f32x4v o[4][2];
#pragma unroll
        for (int ct = 0; ct < 4; ++ct)
#pragma unroll
            for (int vt = 0; vt < 2; ++vt) o[ct][vt] = (f32x4v){0.f, 0.f, 0.f, 0.f};
#pragma unroll
        for (int ct = 0; ct < 4; ++ct)
#pragma unroll
            for (int ks = 0; ks < 2; ++ks) { const bf16x8 af = *(const LAS bf16x8*)(L + OAM + (16 * ct + n) * 144 + (32 * ks + 8 * g) * 2);
#pragma unroll
                for (int vt = 0; vt < 2; ++vt) o[ct][vt] = __builtin_amdgcn_mfma_f32_16x16x32_bf16(af, vf[vt][ks], o[ct][vt], 0, 0, 0); }
#pragma unroll
        for (int kk = 0; kk < 4; ++kk) { bf16x8 sf[2];
#pragma unroll
            for (int vt = 0; vt < 2; ++vt) { v4u pw; pw.x = pg8::cvt_pk_bf16(S[2 * kk][vt][0], S[2 * kk][vt][1]); pw.y = pg8::cvt_pk_bf16(S[2 * kk][vt][2], S[2 * kk][vt][3]);
                pw.z = pg8::cvt_pk_bf16(S[2 * kk + 1][vt][0], S[2 * kk + 1][vt][1]); pw.w = pg8::cvt_pk_bf16(S[2 * kk + 1][vt][2], S[2 * kk + 1][vt][3]); sf[vt] = __builtin_bit_cast(bf16x8, pw); }
#pragma unroll
            for (int ct = 0; ct < 4; ++ct) { const LAS unsigned char* qp = L + OQD + (16 * ct + n) * 272 + (32 * kk + 4 * g) * 2; const v2u qa = *(const LAS v2u*)qp, qb = *(const LAS v2u*)(qp + 32);
                const bf16x8 qf = __builtin_bit_cast(bf16x8, (v4u){qa.x, qa.y, qb.x, qb.y});
#pragma unroll
                for (int vt = 0; vt < 2; ++vt) o[ct][vt] = __builtin_amdgcn_mfma_f32_16x16x32_bf16(qf, sf[vt], o[ct][vt], 0, 0, 0); } }
#pragma unroll
        for (int dt = 0; dt < 8; ++dt) { const f32x4v eb = *(const LAS f32x4v*)(L + OEB + (16 * dt + 4 * g) * 4);
#pragma unroll
            for (int vt = 0; vt < 2; ++vt) S[dt][vt] = S[dt][vt] * eb;
#pragma unroll
            for (int ks = 0; ks < 2; ++ks) { const bf16x8 kf = *(const LAS bf16x8*)(L + OKT + (16 * dt + n) * 144 + (32 * ks + 8 * g) * 2);
#pragma unroll
                for (int vt = 0; vt < 2; ++vt) S[dt][vt] = __builtin_amdgcn_mfma_f32_16x16x32_bf16(kf, vf[vt][ks], S[dt][vt], 0, 0, 0); } }
        LAS float* PS = (LAS float*)(L + OPS) + (ck & 1) * 512;
#pragma unroll
        for (int ct = 0; ct < 4; ++ct)
#pragma unroll
            for (int r = 0; r < 4; ++r) { const float ss = sum16(o[ct][0][r] * o[ct][0][r] + o[ct][1][r] * o[ct][1][r]); if (n == 0) PS[(16 * ct + 4 * g + r) * 8 + w] = ss; }
        LDS_BARRIER();
        GL_WRITE();
#pragma unroll
        for (int ct = 0; ct < 4; ++ct)
#pragma unroll
            for (int vt = 0; vt < 2; ++vt)
#pragma unroll
                for (int r = 0; r < 4; ++r) *(LAS bf16*)(L + OOT + (16 * ct + 4 * g + r) * 528 + (32 * w + 16 * vt + n) * 2) = (bf16)f2bf(o[ct][vt][r]);
        LDS_BARRIER();
#pragma unroll
        for (int i = 0; i < 4; ++i) { const int tok = (tid >> 5) + 16 * i; float ov[8], gv[8]; unpack8(*(const LAS v4u*)(L + OOT + tok * 528 + (tid & 31) * 16), ov); unpack8(gq[i], gv);
            const LAS f32x4v* pp = (const LAS f32x4v*)(PS + tok * 8); const f32x4v p0 = pp[0], p1 = pp[1];
            const float rstd = rsqrtf(((p0.x + p0.y) + (p0.z + p0.w) + (p1.x + p1.y) + (p1.z + p1.w)) * (1.0f / 256.0f) + 1e-6f);
#pragma unroll
            for (int e = 0; e < 8; ++e) ov[e] = ov[e] * (rstd * gain8[e]) * silu_g(gv[e]);
            if (!(HACK & 2)) *(v4u*)(MIX + (row0 + tok) * DM + 1024 + h * 256 + (tid & 31) * 8) = pack8(ov); }
    }
#undef GL_ISSUE
#undef GL_WRITE
}
constexpr int RC_AT = 0, RC_RT = 2048, RC_BK = 4096, RC_VF = 8192, RC_GF = 10240, RC_U0 = 12288, RC_Y0 = 16384, RC_P15 = 20480, RC_BN = 20736, RC_BYTES = 20800;
__device__ __forceinline__ void rwkv_chunks_of_tile(Frame& F, int l, int tile) {
    const int team = F.tid >> 8, tt = F.tid & 255;
    LAS float* Lt = (LAS float*)(F.lds + RING_OFF) + team * 12288;
    LAS float* XA = Lt; LAS float* XR = Lt + 1040; LAS float* ZB = Lt + 2080; LAS float* ZK = Lt + 3120; LAS float* TB = Lt + 4160; LAS float* TK = Lt + 5200; LAS float* VV = Lt + 6240;
    LAS float* ATl = Lt + 7280; LAS float* U0l = Lt + 8320; LAS float* W1 = Lt + 9360;
    LAS float* Aab = Lt + 10400; LAS float* Aak = Lt + 10672; LAS float* Arb = Lt + 10944; LAS float* Ark = Lt + 11216; LAS float* TT = Lt + 11488;
    const float* RW = WSP(float, WS_RW); const unsigned* RWU = WSP(unsigned, WS_RW); constexpr size_t RS = RW_ONE / 4; unsigned char* RWC = F.ws + WS_RWC;
    float pw_[6], pr_[4], pk_[4], pv_[4], pa_[4], pb_[4], pg_[4];
#define RC_FETCH(P) do { const int h_ = 2 * (P) + team; const size_t cb_ = (size_t)tile * 16 * 1024 + h_ * 64 + (tt & 63); const int q_ = tt >> 6; \
        pw_[4] = RW[RS + cb_ + (size_t)(q_ ? 4 * q_ - 1 : 0) * 1024]; pw_[5] = RW[RS + cb_ + (size_t)15 * 1024];            \
        _Pragma("unroll") for (int e = 0; e < 4; ++e) { const size_t o_ = cb_ + (size_t)(4 * q_ + e) * 1024; pw_[e] = RW[RS + o_]; const unsigned u0 = RWU[o_], u2 = RWU[2 * RS + o_], u3 = RWU[3 * RS + o_]; \
            pr_[e] = bflo(u0); pk_[e] = bfhi(u0); pv_[e] = bflo(u2); pg_[e] = bfhi(u2); pa_[e] = bflo(u3); pb_[e] = bfhi(u3); } } while (0)
    RC_FETCH(0);
#pragma unroll 1
    for (int pair = 0; pair < 8; ++pair) {
        const int uc = ((tile >> 9) * 16 + 2 * pair + team) * 512 + (tile & 511), b = uc >> 13, h = (uc >> 9) & 15, ck = uc & 511; unsigned char* rec = RWC + ((size_t)ck * 32 + (uc >> 9)) * RC_BYTES;     (void)b;
        __syncthreads();
        {
          const int j = tt & 63, q = tt >> 6;
          const float cl = pw_[5], clm = q ? pw_[4] : 0.f; const float clq[4] = {pw_[0], pw_[1], pw_[2], pw_[3]};
#pragma unroll
          for (int e = 0; e < 4; ++e) { const int t = 4 * q + e; const float cprev = e == 0 ? clm : clq[e - 1], cc = clq[e];
              const float rr = pr_[e], kk = pk_[e], vv = pv_[e], aa = pa_[e], bb = pb_[e];
              XA[t * 65 + j] = aa * __expf(cprev); XR[t * 65 + j] = rr * __expf(cc); const float ei = __expf(-cc), ef = __expf(cl - cc);
              ZB[t * 65 + j] = bb * ei; ZK[t * 65 + j] = kk * ei; TB[t * 65 + j] = bb * ef; TK[t * 65 + j] = kk * ef; VV[t * 65 + j] = vv; }
          if (q == 0) ((float*)(rec + RC_P15))[j] = __expf(cl);
          { v2u gw; gw.x = pk2(pg_[0], pg_[1]); gw.y = pk2(pg_[2], pg_[3]); *(v2u*)(rec + RC_GF + (((j >> 4) * 64 + 16 * q + (j & 15)) * 8)) = gw; } }
        RC_FETCH(pair < 7 ? pair + 1 : 7);
        __syncthreads();
        {
          const int q = tt >> 6, n = tt & 15, g = (tt >> 4) & 3; const LAS float* X = (q & 2) ? XR : XA; const LAS float* Z = (q & 1) ? ZK : ZB; LAS float* O = q == 0 ? Aab : (q == 1 ? Aak : (q == 2 ? Arb : Ark));
          f32x4v c = (f32x4v){0.f, 0.f, 0.f, 0.f};
#pragma unroll
          for (int ks = 0; ks < 16; ++ks) c = __builtin_amdgcn_mfma_f32_16x16x4f32(X[n * 65 + 4 * ks + g], Z[n * 65 + 4 * ks + g], c, 0, 0, 0);
#pragma unroll
          for (int rr = 0; rr < 4; ++rr) { const int t = 4 * g + rr; O[t * 17 + n] = ((q & 2) ? n <= t : n < t) ? c[rr] : 0.f; }
          { const int t = tt >> 4, jq = tt & 15; const float* rkp = F.kin[I_RRK] + l * 1024 + h * 64 + 4 * jq; float bn = 0.f;
#pragma unroll
            for (int e = 0; e < 4; ++e) bn += XR[t * 65 + 4 * jq + e] * ZK[t * 65 + 4 * jq + e] * rkp[e];
            bn = sum16(bn); if (jq == 0) ((float*)(rec + RC_BN))[t] = bn; } }
        __syncthreads();
        {
          if (tt < 16) { float col[16];
#pragma unroll
              for (int t = 0; t < 16; ++t) { float acc = (t == tt) ? 1.f : 0.f;
#pragma unroll
                  for (int s = 0; s < 16; ++s) if (s < t) acc += Aab[t * 17 + s] * col[s];
                  col[t] = acc; TT[t * 17 + tt] = acc; } }
          const int q = tt >> 6, n = tt & 15, g = (tt >> 4) & 3; f32x4v c = (f32x4v){0.f, 0.f, 0.f, 0.f};
#pragma unroll
          for (int ks = 0; ks < 4; ++ks) c = __builtin_amdgcn_mfma_f32_16x16x4f32(Aak[n * 17 + 4 * ks + g], VV[(4 * ks + g) * 65 + 16 * q + n], c, 0, 0, 0);
#pragma unroll
          for (int rr = 0; rr < 4; ++rr) W1[(4 * g + rr) * 65 + 16 * q + n] = c[rr]; }
        __syncthreads();
        {
          const int q = tt >> 6, n = tt & 15, g = (tt >> 4) & 3; f32x4v ca = (f32x4v){0.f, 0.f, 0.f, 0.f}, cu = (f32x4v){0.f, 0.f, 0.f, 0.f};
#pragma unroll
          for (int ks = 0; ks < 4; ++ks) { const float tv = TT[n * 17 + 4 * ks + g]; ca = __builtin_amdgcn_mfma_f32_16x16x4f32(tv, XA[(4 * ks + g) * 65 + 16 * q + n], ca, 0, 0, 0); cu = __builtin_amdgcn_mfma_f32_16x16x4f32(tv, W1[(4 * ks + g) * 65 + 16 * q + n], cu, 0, 0, 0); }
#pragma unroll
          for (int rr = 0; rr < 4; ++rr) { ATl[(4 * g + rr) * 65 + 16 * q + n] = ca[rr]; U0l[(4 * g + rr) * 65 + 16 * q + n] = cu[rr]; }
          *(f32x4v*)(rec + RC_U0 + ((q * 64 + 16 * g + n) * 16)) = cu; }
        __syncthreads();
        {
          const int q = tt >> 6, n = tt & 15, g = (tt >> 4) & 3; f32x4v cr, cy = (f32x4v){0.f, 0.f, 0.f, 0.f};
#pragma unroll
          for (int rr = 0; rr < 4; ++rr) cr[rr] = XR[(4 * g + rr) * 65 + 16 * q + n];
#pragma unroll
          for (int ks = 0; ks < 4; ++ks) { const float arb = Arb[n * 17 + 4 * ks + g], ark = Ark[n * 17 + 4 * ks + g];
              cr = __builtin_amdgcn_mfma_f32_16x16x4f32(arb, ATl[(4 * ks + g) * 65 + 16 * q + n], cr, 0, 0, 0);
              cy = __builtin_amdgcn_mfma_f32_16x16x4f32(arb, U0l[(4 * ks + g) * 65 + 16 * q + n], cy, 0, 0, 0);
              cy = __builtin_amdgcn_mfma_f32_16x16x4f32(ark, VV[(4 * ks + g) * 65 + 16 * q + n], cy, 0, 0, 0); }
          *(f32x4v*)(rec + RC_Y0 + ((q * 64 + 16 * g + n) * 16)) = cy;
#pragma unroll
          for (int rr = 0; rr < 4; ++rr) W1[(4 * g + rr) * 65 + 16 * q + n] = cr[rr]; }
        __syncthreads();
        { const int t = tt & 15, jq = tt >> 4, kk = jq >> 3, half = (jq & 7) >> 2, g = jq & 3, j0 = 4 * jq;
          v2u wa, wr; wa.x = pk2(ATl[t * 65 + j0], ATl[t * 65 + j0 + 1]); wa.y = pk2(ATl[t * 65 + j0 + 2], ATl[t * 65 + j0 + 3]); wr.x = pk2(W1[t * 65 + j0], W1[t * 65 + j0 + 1]); wr.y = pk2(W1[t * 65 + j0 + 2], W1[t * 65 + j0 + 3]);
          *(v2u*)(rec + RC_AT + kk * 1024 + (16 * g + t) * 16 + half * 8) = wa; *(v2u*)(rec + RC_RT + kk * 1024 + (16 * g + t) * 16 + half * 8) = wr;
          const int j = tt & 63, gg = tt >> 6; v4u bk; bk.x = pk2(TB[(4 * gg) * 65 + j], TB[(4 * gg + 1) * 65 + j]); bk.y = pk2(TB[(4 * gg + 2) * 65 + j], TB[(4 * gg + 3) * 65 + j]);
          bk.z = pk2(TK[(4 * gg) * 65 + j], TK[(4 * gg + 1) * 65 + j]); bk.w = pk2(TK[(4 * gg + 2) * 65 + j], TK[(4 * gg + 3) * 65 + j]);
          *(v4u*)(rec + RC_BK + (j >> 4) * 1024 + (16 * gg + (j & 15)) * 16) = bk;
          v2u vf; vf.x = pk2(VV[(4 * gg) * 65 + j], VV[(4 * gg + 1) * 65 + j]); vf.y = pk2(VV[(4 * gg + 2) * 65 + j], VV[(4 * gg + 3) * 65 + j]);
          *(v2u*)(rec + RC_VF + ((j >> 4) * 64 + 16 * gg + (j & 15)) * 8) = vf; }
    }
}
#undef RC_FETCH
template <int HACK = 0> __device__ __forceinline__ void rwkv_scan_unit(Frame& F, int l, int b, int h) {
    LAS unsigned char* L = F.lds + RING_OFF;
    const unsigned char* recs = F.ws + WS_RWC + (size_t)(b * 16 + h) * RC_BYTES;
    const int lane = F.lane, n = lane & 15, g = lane >> 4;
    LAS float* XS = (LAS float*)(L + 2 * RC_BYTES);
    if (F.wave >= 2) {
        const int li = F.tid - 128;
        int px[4];
#pragma unroll
        for (int k = 0; k < 4; ++k) { const int x = li + 384 * k; px[k] = x < 1300 ? x : 1299; }
        v4u p0[4], p1[4], p2[4], p3[4], p4[4], p5[4], p6[4], p7[4];
#define RWL_ISSUE(P, CK) do { const int ck_ = (CK) < 512 ? ((HACK & 1) && (CK) >= 4 ? 3 : (CK)) : 511; const v4u* src_ = (const v4u*)(recs + (size_t)ck_ * 32 * RC_BYTES); \
        _Pragma("unroll") for (int k = 0; k < 4; ++k) P[k] = src_[px[k]]; } while (0)
#define RWL_WRITE(P, CK) do { LAS v4u* dst_ = (LAS v4u*)(L + ((CK) & 1) * RC_BYTES); _Pragma("unroll") for (int k = 0; k < 4; ++k) dst_[px[k]] = P[k]; } while (0)
        RWL_ISSUE(p0, 0); RWL_ISSUE(p1, 1); RWL_ISSUE(p2, 2); RWL_ISSUE(p3, 3); RWL_ISSUE(p4, 4); RWL_ISSUE(p5, 5); RWL_ISSUE(p6, 6); RWL_ISSUE(p7, 7);
        RWL_WRITE(p0, 0); RWL_ISSUE(p0, 8);
        LDS_BARRIER();
#pragma unroll 1
        for (int ck = 0; ck < 512; ck += 8) {
            RWL_WRITE(p1, ck + 1); RWL_ISSUE(p1, ck + 9); LDS_BARRIER();
            RWL_WRITE(p2, ck + 2); RWL_ISSUE(p2, ck + 10); LDS_BARRIER();
            RWL_WRITE(p3, ck + 3); RWL_ISSUE(p3, ck + 11); LDS_BARRIER();
            RWL_WRITE(p4, ck + 4); RWL_ISSUE(p4, ck + 12); LDS_BARRIER();
            RWL_WRITE(p5, ck + 5); RWL_ISSUE(p5, ck + 13); LDS_BARRIER();
            RWL_WRITE(p6, ck + 6); RWL_ISSUE(p6, ck + 14); LDS_BARRIER();
            RWL_WRITE(p7, ck + 7); RWL_ISSUE(p7, ck + 15); LDS_BARRIER();
            RWL_WRITE(p0, ck + 8); RWL_ISSUE(p0, ck + 16); LDS_BARRIER();
        }
#undef RWL_ISSUE
#undef RWL_WRITE
        return;
    }
    const int cw = F.wave;
    f32x4v S[4][2];
#pragma unroll
    for (int jt = 0; jt < 4; ++jt)
#pragma unroll
        for (int it = 0; it < 2; ++it) S[jt][it] = (f32x4v){0.f, 0.f, 0.f, 0.f};
    float lnw[2], lnb[2];
#pragma unroll
    for (int it = 0; it < 2; ++it) { lnw[it] = F.kin[I_RLNW][l * 1024 + h * 64 + 16 * (2 * cw + it) + n]; lnb[it] = F.kin[I_RLNB][l * 1024 + h * 64 + 16 * (2 * cw + it) + n]; }
    bf16* MIX = WSP(bf16, WS_MIXED) + ((size_t)b * SEQ) * DM + 2048 + h * 64 + 32 * cw + n;
    f32x4v Yp[2] = {(f32x4v){0.f, 0.f, 0.f, 0.f}, (f32x4v){0.f, 0.f, 0.f, 0.f}}, bnp = (f32x4v){0.f, 0.f, 0.f, 0.f}; v2u gfp[2] = {(v2u){0u, 0u}, (v2u){0u, 0u}}, vfp[2] = {(v2u){0u, 0u}, (v2u){0u, 0u}};
    LDS_BARRIER();
#pragma unroll 1
    for (int ck = 0; ck <= 512; ++ck) {
        if (ck > 0) {
            const LAS float* xs = XS + ((ck - 1) & 1) * 64; const f32x4v a0 = *(const LAS f32x4v*)(xs + 8 * g), a1 = *(const LAS f32x4v*)(xs + 8 * g + 4), b0 = *(const LAS f32x4v*)(xs + 32 + 8 * g), b1 = *(const LAS f32x4v*)(xs + 32 + 8 * g + 4);
            const float s1[4] = {a0[0] + b0[0], a0[2] + b0[2], a1[0] + b1[0], a1[2] + b1[2]}, s2[4] = {a0[1] + b0[1], a0[3] + b0[3], a1[1] + b1[1], a1[3] + b1[3]};
#pragma unroll
            for (int it = 0; it < 2; ++it) { const float gt[4] = {bflo(gfp[it].x), bfhi(gfp[it].x), bflo(gfp[it].y), bfhi(gfp[it].y)}, vt[4] = {bflo(vfp[it].x), bfhi(vfp[it].x), bflo(vfp[it].y), bfhi(vfp[it].y)};
#pragma unroll
                for (int r = 0; r < 4; ++r) { const float mean = s1[r] * (1.0f / 64.0f), var = fmaxf(s2[r] * (1.0f / 64.0f) - mean * mean, 0.f), rstd = rsqrtf(var + 64e-5f);
                    if (!(HACK & 2)) MIX[(size_t)((ck - 1) * 16 + 4 * g + r) * DM + 16 * it] = (bf16)f2bf(((Yp[it][r] - mean) * rstd * lnw[it] + lnb[it] + bnp[r] * vt[r]) * gt[r]); } }
            if (ck == 512) break;
        }
        if (HACK & 4) { LDS_BARRIER(); continue; }
        const LAS unsigned char* R = L + (ck & 1) * RC_BYTES;
        bf16x8 at[2], rt[2];
#pragma unroll
        for (int kk = 0; kk < 2; ++kk) { at[kk] = *(const LAS bf16x8*)(R + RC_AT + kk * 1024 + lane * 16); rt[kk] = *(const LAS bf16x8*)(R + RC_RT + kk * 1024 + lane * 16); }
        f32x4v U[2], Y[2];
#pragma unroll
        for (int it = 0; it < 2; ++it) { U[it] = *(const LAS f32x4v*)(R + RC_U0 + (2 * cw + it) * 1024 + lane * 16); Y[it] = *(const LAS f32x4v*)(R + RC_Y0 + (2 * cw + it) * 1024 + lane * 16); }
#pragma unroll
        for (int kk = 0; kk < 2; ++kk)
#pragma unroll
            for (int it = 0; it < 2; ++it) { v4u pw; pw.x = pg8::cvt_pk_bf16(S[2 * kk][it][0], S[2 * kk][it][1]); pw.y = pg8::cvt_pk_bf16(S[2 * kk][it][2], S[2 * kk][it][3]);
                pw.z = pg8::cvt_pk_bf16(S[2 * kk + 1][it][0], S[2 * kk + 1][it][1]); pw.w = pg8::cvt_pk_bf16(S[2 * kk + 1][it][2], S[2 * kk + 1][it][3]); const bf16x8 sf = __builtin_bit_cast(bf16x8, pw);
                U[it] = __builtin_amdgcn_mfma_f32_16x16x32_bf16(at[kk], sf, U[it], 0, 0, 0); Y[it] = __builtin_amdgcn_mfma_f32_16x16x32_bf16(rt[kk], sf, Y[it], 0, 0, 0); }
        bf16x8 uv[2];
#pragma unroll
        for (int it = 0; it < 2; ++it) { vfp[it] = *(const LAS v2u*)(R + RC_VF + (2 * cw + it) * 512 + lane * 8); gfp[it] = *(const LAS v2u*)(R + RC_GF + (2 * cw + it) * 512 + lane * 8);
            v4u pw; pw.x = pg8::cvt_pk_bf16(U[it][0], U[it][1]); pw.y = pg8::cvt_pk_bf16(U[it][2], U[it][3]); pw.z = vfp[it].x; pw.w = vfp[it].y; uv[it] = __builtin_bit_cast(bf16x8, pw); }
#pragma unroll
        for (int jt = 0; jt < 4; ++jt) { const bf16x8 bk = *(const LAS bf16x8*)(R + RC_BK + jt * 1024 + lane * 16); const f32x4v p15 = *(const LAS f32x4v*)(R + RC_P15 + (16 * jt + 4 * g) * 4);
#pragma unroll
            for (int it = 0; it < 2; ++it) S[jt][it] = __builtin_amdgcn_mfma_f32_16x16x32_bf16(bk, uv[it], S[jt][it] * p15, 0, 0, 0); }
        bnp = *(const LAS f32x4v*)(R + RC_BN + 16 * g); Yp[0] = Y[0]; Yp[1] = Y[1];
        { LAS float* xo = XS + (ck & 1) * 64 + cw * 32; const f32x4v sm = Y[0] + Y[1], sq = Y[0] * Y[0] + Y[1] * Y[1];
#pragma unroll
          for (int r = 0; r < 4; ++r) { const float a = sum16(sm[r]), q = sum16(sq[r]); if (n == 0) { xo[(4 * g + r) * 2] = a; xo[(4 * g + r) * 2 + 1] = q; } } }
        LDS_BARRIER();
    }
}
template <int HACK = 0> __device__ __forceinline__ void mixers_v4(Frame& F, int l, int qi, int mask = 15) {
    gu32* ctr = F.ctl + CW_Q + 64 * qi;
    for (;;) {
        const int it = next_item(F, ctr); relaunder(F); relaunder_tid(F);
        if (it < 32) { if (mask & 1) rwkv_scan_unit<HACK>(F, l, it >> 4, it & 15); }
        else if (it < 40) { const int j = it - 32; if (mask & 2) gla_scan_unit<HACK>(F, l, j >> 2, j & 3); }
        else if (it < 40 + 1024) { const int j = it - 40, qb = 63 - (j >> 4), bh = j & 15; if (mask & 4) attn_unit<true>(F, l, bh >> 3, bh & 7, qb); }
        else if (it < 40 + 2048) { const int j = it - 1064, qb = j & 63, bh = j >> 6; if (mask & 8) attn_unit<false>(F, l, bh >> 3, bh & 7, qb); }
        else break;
    }
}
template <int HACK = 0> __device__ __forceinline__ void prep_rwkv(Frame& F, int l) {
    LAS float* zl = (LAS float*)(F.lds + RING_OFF) + 4096;
    LAS float* in = (LAS float*)(F.lds + RING_OFF);
    const float* mu = F.kin[I_RMU] + (size_t)l * 3264;
    const float* LOWR = WSP(float, WS_LOWR); const bf16* COLS = WSP(bf16, WS_COLS);
    float* RW = WSP(float, WS_RW); unsigned* RWU = WSP(unsigned, WS_RW); float* VF = WSP(float, WS_VFIRST);
    constexpr size_t RS = RW_ONE / 4;
    for (int tile = F.bx; tile < M / 16; tile += F.G) {
        const int row0 = tile * 16;
        relaunder(F); relaunder_tid(F);
        __syncthreads();
        for (int idx = F.tid; idx < 16 * 224; idx += NWAVES * 64) { const int tt = idx / 224, j = idx % 224, row = row0 + tt, t = row & (SEQ - 1);
            const int col = j < 192 ? 16 + j : 208 + (j - 192);
            const float cur = LOWR[(size_t)row * 256 + col], prev = t > 0 ? LOWR[(size_t)(row - 1) * 256 + col] : 0.f;
            const float muv = j < 192 ? mu[3072 + j] : (l ? F.kin[I_VRMU][(l - 1) * 32 + (j - 192)] : 0.f);
            float x = cur + (prev - cur) * muv;
            if (j < 64) x = tanhf(x); else if (j >= 128 && j < 192) x = sigmoid_f(x);
            in[j * 16 + tt] = x; }
        __syncthreads();
        {
            const int c = 2 * F.tid;
            float accw[2][16], acca[2][16], accg[2][16], accv[2][16];
#pragma unroll
            for (int e = 0; e < 2; ++e) { const float bw = F.kin[I_RW0][l * 1024 + c + e], ba = F.kin[I_RA0][l * 1024 + c + e], bv = l ? F.kin[I_VR0][(l - 1) * 1024 + c + e] : 0.f;
#pragma unroll
              for (int tt = 0; tt < 16; ++tt) { accw[e][tt] = bw; acca[e][tt] = ba; accg[e][tt] = 0.f; accv[e][tt] = bv; } }
#define LOWRANK_MFMA(ACC, WPTR, JOFF, NJ) do { const float* wq_ = (WPTR) + 128 * F.wave + (F.lane & 15) + (size_t)(F.lane >> 4) * 1024; \
            _Pragma("unroll 2") for (int nt = 0; nt < 8; ++nt) { f32x4 c4 = {0.f, 0.f, 0.f, 0.f}; \
                _Pragma("unroll") for (int ks = 0; ks < (NJ) / 4; ++ks) c4 = __builtin_amdgcn_mfma_f32_16x16x4f32(in[((JOFF) + 4 * ks + (F.lane >> 4)) * 16 + (F.lane & 15)], wq_[(size_t)ks * 4096 + 16 * nt], c4, 0, 0, 0); \
                _Pragma("unroll") for (int rr = 0; rr < 4; ++rr) zl[(4 * (F.lane >> 4) + rr) * 1028 + 128 * F.wave + 16 * nt + (F.lane & 15)] = c4[rr]; } \
            __syncthreads(); \
            _Pragma("unroll") for (int tt = 0; tt < 16; ++tt) { const f32x2_t z2 = *(const LAS f32x2_t*)(zl + tt * 1028 + c); ACC[0][tt] += z2.x; ACC[1][tt] += z2.y; } \
            __syncthreads(); } while (0)
            if (!(HACK & 1)) { LOWRANK_MFMA(accw, F.kin[I_RWUP] + (size_t)l * 64 * 1024, 0, 64); relaunder(F);
            LOWRANK_MFMA(acca, F.kin[I_RAUP] + (size_t)l * 64 * 1024, 64, 64); relaunder(F);
            LOWRANK_MFMA(accg, F.kin[I_RGUP] + (size_t)l * 64 * 1024, 128, 64); relaunder(F);
            if (l) LOWRANK_MFMA(accv, F.kin[I_VRUP] + (size_t)(l - 1) * 32 * 1024, 192, 32); }
#undef LOWRANK_MFMA
            relaunder(F);
            float mur[2], muk[2], muv[2], kkv[2], kav[2], pr[2] = {0.f, 0.f}, pk[2] = {0.f, 0.f}, pv[2] = {0.f, 0.f}; float cl[2] = {0.f, 0.f};
#pragma unroll
            for (int e = 0; e < 2; ++e) { mur[e] = F.kin[I_RMU][l * 3264 + c + e]; muk[e] = F.kin[I_RMU][l * 3264 + 1024 + c + e]; muv[e] = F.kin[I_RMU][l * 3264 + 2048 + c + e]; kkv[e] = F.kin[I_RKK][l * 1024 + c + e]; kav[e] = F.kin[I_RKA][l * 1024 + c + e]; }
            if ((row0 & (SEQ - 1)) != 0) { const bf16* p = COLS + (size_t)(row0 - 1) * NMAIN + c; const unsigned ur = *(const unsigned*)(p + CC_R), uk = *(const unsigned*)(p + CC_K), uv = *(const unsigned*)(p + CC_V);
                pr[0] = bflo(ur); pr[1] = bfhi(ur); pk[0] = bflo(uk); pk[1] = bfhi(uk); pv[0] = bflo(uv); pv[1] = bfhi(uv); }
            if (!(HACK & 4))
#pragma unroll
            for (int tt = 0; tt < 16; ++tt) { const int row = row0 + tt; const bf16* p = COLS + (size_t)row * NMAIN + c; const size_t o = (size_t)row * 1024 + c;
                const unsigned ur = *(const unsigned*)(p + CC_R), uk = *(const unsigned*)(p + CC_K), uv = *(const unsigned*)(p + CC_V);
                const float cr[2] = {bflo(ur), bfhi(ur)}, ck[2] = {bflo(uk), bfhi(uk)}, cv[2] = {bflo(uv), bfhi(uv)};
                f32x2_t vf2 = {0.f, 0.f}; if (l != 0) vf2 = *(const f32x2_t*)(VF + o);
                float r[2], k[2], v[2], dec[2], av[2], kk[2], km[2];
#pragma unroll
                for (int e = 0; e < 2; ++e) { r[e] = cr[e] + (pr[e] - cr[e]) * mur[e]; k[e] = ck[e] + (pk[e] - ck[e]) * muk[e]; v[e] = cv[e] + (pv[e] - cv[e]) * muv[e]; pr[e] = cr[e]; pk[e] = ck[e]; pv[e] = cv[e];
                    if (l == 0) vf2[e] = v[e]; else { const float vg = sigmoid_f(accv[e][tt]); v[e] = v[e] + (vf2[e] - v[e]) * vg; }
                    cl[e] += -0.6065306597126334f * sigmoid_f(accw[e][tt]); dec[e] = cl[e]; av[e] = sigmoid_f(acca[e][tt]); kk[e] = k[e] * kkv[e]; km[e] = k[e] * (1.0f + (av[e] - 1.0f) * kav[e]); }
                const float ss = sum32(kk[0] * kk[0] + kk[1] * kk[1]), rn = rsqrtf(fmaxf(ss, 1e-24f)); kk[0] *= rn; kk[1] *= rn;
                if (l == 0) *(f32x2_t*)(VF + o) = vf2;
                *(f32x2_t*)(RW + RS + o) = (f32x2_t){dec[0], dec[1]};
                *(v2u*)(RWU + o) = (v2u){pk2(r[0], km[0]), pk2(r[1], km[1])}; *(v2u*)(RWU + 2 * RS + o) = (v2u){pk2(v[0], accg[0][tt]), pk2(v[1], accg[1][tt])};
                *(v2u*)(RWU + 3 * RS + o) = (v2u){pk2(-kk[0], kk[0] * av[0]), pk2(-kk[1], kk[1] * av[1])}; }
        }
        asm volatile("s_waitcnt vmcnt(0)" ::: "memory"); __syncthreads();
        __builtin_amdgcn_fence(__ATOMIC_ACQUIRE, "agent"); asm volatile("s_waitcnt vmcnt(0)" ::: "memory");
        if (!(HACK & 2)) rwkv_chunks_of_tile(F, l, tile);
    }
}
struct Args { const float* in[35]; float* out; unsigned char* ws; };
__device__ __forceinline__ void mk_frame(Frame& F, int wv) {
    extern __shared__ __attribute__((aligned(16))) unsigned char lds[];
    kargp kp = (kargp)__builtin_amdgcn_kernarg_segment_ptr(); asm volatile("" : "+s"(kp));
    F.kin = kp;
    F.lds = (LAS unsigned char*)lds;
    F.MISC = (volatile LAS unsigned*)(F.lds + MISC_OFF);
    { int w_ = wv; asm volatile("" : "+s"(w_)); int t_ = (int)__builtin_amdgcn_mbcnt_hi(~0u, __builtin_amdgcn_mbcnt_lo(~0u, (unsigned)w_ * 64u)); asm volatile("" : "+v"(t_)); F.tid = t_; } F.lane = F.tid & 63; F.wave = __builtin_amdgcn_readfirstlane(F.tid >> 6);
    F.G = gridDim.x; { int bx = blockIdx.x; asm volatile("" : "+s"(bx)); F.bx = bx; F.vcu = (F.G % 8 == 0) ? (bx % 8) * (F.G / 8) + bx / 8 : bx; }
    F.out = (float*)kp[35]; F.ws = (unsigned char*)kp[36]; F.ctl = (gu32*)(F.ws + WS_CTL);
}
__device__ __forceinline__ void grid_bar(int wv) {
    Frame F; mk_frame(F, wv);
    XcdBarrier bar; bar.bar = (unsigned*)(F.ctl + CW_BAR); bar.x = xb_xcc_id(); bar.st = F.MISC + 8;
    xcd_barrier(bar);
}
__global__ void __launch_bounds__(NWAVES * 64, 2) mega_fwd(Args args) {
    const int wv = __builtin_amdgcn_readfirstlane((int)threadIdx.x >> 6);
    { Frame F; mk_frame(F, wv);
      for (int u = F.tid; u < (LDS_BYTES - LDSCTL_OFF) / 4; u += NWAVES * 64) ((LAS unsigned*)(F.lds + LDSCTL_OFF))[u] = 0u;
      __syncthreads();
      (void)xcd_barrier_post((unsigned*)(F.ctl + CW_BAR), F.MISC + 8);
      p0_prologue_a(F);
    }
    grid_bar(wv);
    { Frame F; mk_frame(F, wv); p0_prologue_b(F); }
    grid_bar(wv);
#pragma unroll 1
    for (int l = 0; l < NLAYER; ++l) {
#define LAYER_VARS const float* mod = WSP(float, WS_MOD) + (size_t)l * 2 * 24576; const float* xin = l == 0 ? F.kin[I_X] : F.out; (void)mod; (void)xin
        { Frame F; mk_frame(F, wv); LAYER_VARS; rms_phase(F, xin, mod + 0, mod + 4096); }
        grid_bar(wv);
        { Frame F; mk_frame(F, wv);
          pg8::Gemm g{WSP(pg8::bf16_t, WS_XN), WSP(pg8::bf16_t, WS_WIN + l * WIN_L), M, NIN, DM}; pg8::StaticOrder S; S.init(M, NIN, F.G, F.bx);
          pg8::EpiCols E{WSP(pg8::bf16_t, WS_COLS), WSP(float, WS_LOWR)};
          pg8::gemm_phase<pg8::EpiCols, pg8::StaticOrder, true, true>(F.lds + RING_OFF, g, S, E, F.tid); }
        grid_bar(wv);
        { Frame F; mk_frame(F, wv); prep_norm(F, l); }
        { Frame F; mk_frame(F, wv); prep_loga(F, l); }
        { Frame F; mk_frame(F, wv); prep_rwkv(F, l); }
        { Frame F; mk_frame(F, wv); prep_vt(F, 0); }
        { Frame F; mk_frame(F, wv); prep_vt(F, 1); }
        { Frame F; mk_frame(F, wv); prep_gla(F); }
        grid_bar(wv);
        { Frame F; mk_frame(F, wv); mixers_v4(F, l, l); }
        grid_bar(wv);
        { Frame F; mk_frame(F, wv); LAYER_VARS;
          pg8::Gemm g{WSP(pg8::bf16_t, WS_MIXED), WSP(pg8::bf16_t, WS_WOUT + l * WOUT_L), M, DM, DM}; pg8::StaticOrder S; S.init(M, DM, F.G, F.bx);
          pg8::EpiRes E{xin, F.out, mod + 2 * 4096};
          pg8::gemm_phase<pg8::EpiRes, pg8::StaticOrder, true, true>(F.lds + RING_OFF, g, S, E, F.tid); }
        grid_bar(wv);
        { Frame F; mk_frame(F, wv); LAYER_VARS; rms_phase(F, F.out, mod + 3 * 4096, mod + 4 * 4096); }
        grid_bar(wv);
        { Frame F; mk_frame(F, wv);
          pg8::Gemm g{WSP(pg8::bf16_t, WS_XN), WSP(pg8::bf16_t, WS_W13 + l * W13_L), M, 2 * DFF, DM}; pg8::StaticOrder S; S.init(M, 2 * DFF, F.G, F.bx);
          pg8::EpiSwiglu E{WSP(pg8::bf16_t, WS_HID)};
          pg8::gemm_phase<pg8::EpiSwiglu, pg8::StaticOrder, true, true>(F.lds + RING_OFF, g, S, E, F.tid); }
        grid_bar(wv);
        { Frame F; mk_frame(F, wv); LAYER_VARS;
          pg8::Gemm g{WSP(pg8::bf16_t, WS_HID), WSP(pg8::bf16_t, WS_W2 + l * W2_L), M, DM, DFF}; pg8::StaticOrder S; S.init(M, DM, F.G, F.bx);
          pg8::EpiRes E{F.out, F.out, mod + 5 * 4096};
          pg8::gemm_phase<pg8::EpiRes, pg8::StaticOrder, true, true>(F.lds + RING_OFF, g, S, E, F.tid); }
        if (l + 1 < NLAYER) grid_bar(wv);
#undef LAYER_VARS
    }
}

extern "C" void kernel_launch(void* const* d_in, const int* in_sizes, int n_in, void* d_out, int out_size, void* d_ws, size_t ws_size, hipStream_t stream) {
    static int grid = 0;
    if (grid == 0) {
        if (n_in != 35 || in_sizes[0] != M * DM || out_size != M * DM || ws_size < WS_END) { fprintf(stderr, "kernel_launch: unexpected shapes: n_in %d in0 %d out %d ws %zu (need %zu)\n", n_in, n_in > 0 ? in_sizes[0] : -1, out_size, ws_size, (size_t)WS_END); grid = -1; return; }
        int dev = 0, cus = 0, per_cu = 0;
        if (hipGetDevice(&dev) != hipSuccess || hipDeviceGetAttribute(&cus, hipDeviceAttributeMultiprocessorCount, dev) != hipSuccess) { grid = -1; return; }
        if (hipFuncSetAttribute((const void*)mega_fwd, hipFuncAttributeMaxDynamicSharedMemorySize, LDS_BYTES) != hipSuccess) { fprintf(stderr, "kernel_launch: hipFuncSetAttribute failed\n"); grid = -1; return; }
        if (hipOccupancyMaxActiveBlocksPerMultiprocessor(&per_cu, (const void*)mega_fwd, NWAVES * 64, LDS_BYTES) != hipSuccess || per_cu < 1) fprintf(stderr, "kernel_launch: occupancy query says %d\n", per_cu);
        (void)hipGetLastError();
        grid = cus;
    }
    if (grid < 0) return;
    if (hipMemsetAsync((char*)d_ws + WS_CTL, 0, CTL_ZERO_BYTES, stream) != hipSuccess) return;
    Args a{};
    for (int i = 0; i < 35; ++i) a.in[i] = (const float*)d_in[i];
    a.out = (float*)d_out; a.ws = (unsigned char*)d_ws;
    hipLaunchKernelGGL(mega_fwd, dim3(grid), dim3(NWAVES * 64), LDS_BYTES, stream, a);
}
```

```cpp
#include <hip/hip_runtime.h>
#include <cstdio>
#include <cstdint>
namespace pg8 {
#define PG8_LAS __attribute__((address_space(3)))
typedef unsigned short bf16_t;
typedef short bf16x8 __attribute__((ext_vector_type(8)));
typedef float f32x4 __attribute__((ext_vector_type(4)));
typedef unsigned u32x4 __attribute__((ext_vector_type(4)));
constexpr int BM = 256, BK = 64, HALF = 128, HTB = HALF * BK * 2  , STAGE_BYTES = 8 * HTB, NXCD = 8, WGM = 8;

__host__ __device__ __forceinline__ int lds_byte(int r, int c) { const int st = (r >> 4) * 2 + (c >> 5), rr = r & 15, cc = c & 31, ob = rr * 64 + cc * 2; return st * 1024 + (ob ^ (((ob >> 9) & 1) << 5)); }
__host__ __device__ __forceinline__ void stage_rc(int b, int& R, int& C) { const int st = b / 1024, sb = b % 1024, swz = sb ^ (((sb >> 9) & 1) << 5); R = (st >> 1) * 16 + swz / 64; C = (st & 1) * 32 + (swz % 64) / 2; }
__host__ __device__ __forceinline__ int perm32(int rho) { const int n = rho >> 4, i = rho & 15; return 8 * (i >> 2) + 4 * n + (i & 3); }

struct Unit { int pm, pn; };
struct Gemm { const bf16_t* A; const bf16_t* Bt; int M, N, K; };

struct StaticOrder {
    int nM, nN, nwg, G, c;
    __host__ __device__ void init(int M, int N, int G_, int c_) { nM = M / BM; nN = N / BM; nwg = nM * nN; G = G_; c = c_; }
    __host__ __device__ bool next(int i, Unit& u) const {
        const long L = (long)i * G + c; if (L >= nwg) return false;
        int wgid = (int)L; { const int q = nwg / NXCD, r = nwg % NXCD, xcd = wgid % NXCD, off = wgid / NXCD; wgid = (xcd < r ? xcd * (q + 1) : r * (q + 1) + (xcd - r) * q) + off; }
        const int nig = WGM * nN, gid = wgid / nig, fm = gid * WGM, gsz = (nM - fm) < WGM ? (nM - fm) : WGM;
        u.pm = fm + ((wgid % nig) % gsz); u.pn = (wgid % nig) / gsz; return true;
    }
    __device__ __forceinline__ void a_ready(const Unit&) const {}
    __device__ __forceinline__ void done(const Unit&) const {}
};

typedef float f32x2c_t __attribute__((ext_vector_type(2))); typedef __bf16 bf16x2c_t __attribute__((ext_vector_type(2)));
__device__ __forceinline__ unsigned cvt_pk_bf16(float lo, float hi) { const f32x2c_t v = {lo, hi}; return __builtin_bit_cast(unsigned, __builtin_convertvector(v, bf16x2c_t)); }
typedef float f32x2 __attribute__((ext_vector_type(2)));
__device__ __forceinline__ float silu_f(float x) { return x * __builtin_amdgcn_rcpf(1.0f + __builtin_amdgcn_exp2f(-1.4426950408889634f * x)); }
struct EpiCols {
    static constexpr bool PERM = true, AFTER_DRAIN = false;
    bf16_t* O; float* L;
    __device__ __forceinline__ void operator()(const f32x4 (&acc)[2][2][4][2], const Unit& u, int wr, int wc, int fr, int fq) const {
        const int row0 = u.pm * BM + wr * 64 + fr;
        if (u.pn < 41) {
            const int col0 = u.pn * BM + wc * 32 + 8 * fq;
#pragma unroll
            for (int ai = 0; ai < 2; ++ai)
#pragma unroll
                for (int m = 0; m < 4; ++m) { bf16_t* rowp = O + (size_t)(row0 + ai * HALF + m * 16) * 10496 + col0;
#pragma unroll
                    for (int bj = 0; bj < 2; ++bj) { const f32x4 v0 = acc[ai][bj][m][0], v1 = acc[ai][bj][m][1];
                        u32x4 w; w.x = cvt_pk_bf16(v0[0], v0[1]); w.y = cvt_pk_bf16(v0[2], v0[3]); w.z = cvt_pk_bf16(v1[0], v1[1]); w.w = cvt_pk_bf16(v1[2], v1[3]);
                        *(u32x4*)(rowp + bj * HALF) = w; } }
        } else {
            const int col0 = wc * 32 + 8 * fq;
#pragma unroll
            for (int ai = 0; ai < 2; ++ai)
#pragma unroll
                for (int m = 0; m < 4; ++m) { float* rowp = L + (size_t)(row0 + ai * HALF + m * 16) * 256 + col0;
#pragma unroll
                    for (int bj = 0; bj < 2; ++bj) { *(f32x4*)(rowp + bj * HALF) = acc[ai][bj][m][0]; *(f32x4*)(rowp + bj * HALF + 4) = acc[ai][bj][m][1]; } }
        }
    }
};
struct EpiRes {
    static constexpr bool PERM = false, AFTER_DRAIN = false;
    const float* base; float* out; const float* gate;
    __device__ __forceinline__ void operator()(const f32x4 (&acc)[2][2][4][2], const Unit& u, int wr, int wc, int fr, int fq) const {
        const int row0 = u.pm * BM + wr * 64 + fr, col0 = u.pn * BM + wc * 32 + 4 * fq;
        const float* gp = gate + (size_t)(u.pm >> 5) * 24576 + col0;
        f32x4 gv[2][2];
#pragma unroll
        for (int bj = 0; bj < 2; ++bj)
#pragma unroll
            for (int n = 0; n < 2; ++n) gv[bj][n] = *(const f32x4*)(gp + bj * HALF + n * 16);
#pragma unroll
        for (int ai = 0; ai < 2; ++ai)
#pragma unroll
            for (int m = 0; m < 4; ++m) { const size_t off = (size_t)(row0 + ai * HALF + m * 16) * 4096 + col0;
#pragma unroll
                for (int bj = 0; bj < 2; ++bj)
#pragma unroll
                    for (int n = 0; n < 2; ++n) { const f32x4 bs = *(const f32x4*)(base + off + bj * HALF + n * 16); *(f32x4*)(out + off + bj * HALF + n * 16) = bs + gv[bj][n] * acc[ai][bj][m][n]; }
                if (m == 3) asm volatile("" ::: "memory"); }
    }
};
struct EpiSwiglu {
    static constexpr bool PERM = true, AFTER_DRAIN = false;
    bf16_t* H;
    __device__ __forceinline__ void operator()(const f32x4 (&acc)[2][2][4][2], const Unit& u, int wr, int wc, int fr, int fq) const {
        const int row0 = u.pm * BM + wr * 64 + fr, col0 = u.pn * HALF + wc * 32 + 8 * fq;
#pragma unroll
        for (int ai = 0; ai < 2; ++ai)
#pragma unroll
            for (int m = 0; m < 4; ++m) { bf16_t* rowp = H + (size_t)(row0 + ai * HALF + m * 16) * 11008 + col0;
                const f32x4 a0 = acc[ai][0][m][0], a1 = acc[ai][0][m][1], b0 = acc[ai][1][m][0], b1 = acc[ai][1][m][1];
                u32x4 w; w.x = cvt_pk_bf16(silu_f(a0[0]) * b0[0], silu_f(a0[1]) * b0[1]); w.y = cvt_pk_bf16(silu_f(a0[2]) * b0[2], silu_f(a0[3]) * b0[3]);
                w.z = cvt_pk_bf16(silu_f(a1[0]) * b1[0], silu_f(a1[1]) * b1[1]); w.w = cvt_pk_bf16(silu_f(a1[2]) * b1[2], silu_f(a1[3]) * b1[3]);
                *(u32x4*)rowp = w; }
    }
};
template <class Epi, class Sched, bool ALIGN_EPI = false, bool SP2 = false>
__device__ __forceinline__ void gemm_phase(PG8_LAS unsigned char* lds, const Gemm g, const Sched& S, const Epi& E, int tid_in) {
    int tid_ = tid_in; asm volatile("" : "+v"(tid_));
    const int tid = tid_, wid = __builtin_amdgcn_readfirstlane(tid >> 6), lane = tid & 63, wr = wid >> 2, wc = wid & 3, fr = lane & 15, fq = lane >> 4;
    const int K = g.K, nt = K / BK;
    unsigned voffA[2], voffB[2];
#pragma unroll
    for (int i = 0; i < 2; ++i) { int R, C; stage_rc(tid * 16 + i * 8192, R, C); const int Rb = Epi::PERM ? ((R & ~31) + perm32(R & 31)) : R;
        voffA[i] = (unsigned)(R * K + C) * 2u; voffB[i] = (unsigned)(Rb * K + C) * 2u; }
    const size_t kstep = (size_t)(BK * 2);
    const size_t hstep = (size_t)HALF * K * 2;
    const size_t tstep = 2 * hstep;
    const unsigned ldsw = (unsigned)wid * 1024u;
    const int aoff = lds_byte(wr * 64 + fr, fq * 8), boff = lds_byte(wc * 32 + fr, fq * 8);
#define PG8_SA(b, h) (((b) * 2 + (h)) * HTB)
#define PG8_SB(b, h) ((4 + (b) * 2 + (h)) * HTB)
#define PG8_STAGE(bufoff, gbase, voff) do { _Pragma("unroll") for (int _i = 0; _i < 2; ++_i) \
        __builtin_amdgcn_global_load_lds((const unsigned*)((const char*)(gbase) + (voff)[_i]), (PG8_LAS unsigned*)(lds + (bufoff) + ldsw + _i * 8192), 16, 0, 0); } while (0)
#define PG8_LDA(dst, b, h) do { _Pragma("unroll") for (int m = 0; m < 4; ++m) _Pragma("unroll") for (int k = 0; k < 2; ++k) dst[m][k] = *(const PG8_LAS bf16x8*)(lds + PG8_SA(b, h) + aoff + m * 2048 + k * 1024); } while (0)
#define PG8_LDB(dst, b, h) do { _Pragma("unroll") for (int n = 0; n < 2; ++n) _Pragma("unroll") for (int k = 0; k < 2; ++k) dst[n][k] = *(const PG8_LAS bf16x8*)(lds + PG8_SB(b, h) + boff + n * 2048 + k * 1024); } while (0)
#define PG8_MMA(ai, bj, At, Bt) do { __builtin_amdgcn_s_setprio(1); _Pragma("unroll") for (int m = 0; m < 4; ++m) _Pragma("unroll") for (int n = 0; n < 2; ++n) _Pragma("unroll") for (int k = 0; k < 2; ++k) \
        acc[ai][bj][m][n] = __builtin_amdgcn_mfma_f32_16x16x32_bf16(Bt[n][k], At[m][k], acc[ai][bj][m][n], 0, 0, 0); __builtin_amdgcn_s_setprio(0); } while (0)
#define PG8_WAIT_V(n) asm volatile("s_waitcnt vmcnt(" #n ")" ::: "memory")
#define PG8_WAIT_L(n) asm volatile("s_waitcnt lgkmcnt(" #n ")" ::: "memory")
#define PG8_BAR __builtin_amdgcn_s_barrier()
#define PG8_SCHED __builtin_amdgcn_sched_barrier(0)
    Unit cur, nxt; int ui = 0;
    if (!S.next(0, cur)) return;
    f32x4 acc[2][2][4][2];
#pragma unroll
    for (int a = 0; a < 2; ++a)
#pragma unroll
        for (int b = 0; b < 2; ++b)
#pragma unroll
            for (int m = 0; m < 4; ++m)
#pragma unroll
                for (int n = 0; n < 2; ++n) acc[a][b][m][n] = (f32x4){0.f, 0.f, 0.f, 0.f};
    bf16x8 At[4][2], B0[2][2], B1[2][2];
    const char* cA = (const char*)g.A + (size_t)cur.pm * tstep; const char* cB = (const char*)g.Bt + (size_t)cur.pn * tstep;
    S.a_ready(cur);
    if constexpr (SP2) {
        PG8_STAGE(PG8_SB(0, 0), cB, voffB); PG8_STAGE(PG8_SB(0, 1), cB + hstep, voffB); PG8_STAGE(PG8_SA(0, 0), cA, voffA); PG8_STAGE(PG8_SA(0, 1), cA + hstep, voffA);
        if (wr == 1) PG8_BAR;
        PG8_WAIT_V(2); PG8_BAR;
        PG8_STAGE(PG8_SB(1, 0), cB + kstep, voffB); PG8_STAGE(PG8_SA(1, 0), cA + kstep, voffA); PG8_STAGE(PG8_SB(1, 1), cB + hstep + kstep, voffB);
        PG8_WAIT_V(6); PG8_BAR;
    } else {
        PG8_STAGE(PG8_SB(0, 0), cB, voffB); PG8_STAGE(PG8_SA(0, 0), cA, voffA); PG8_STAGE(PG8_SB(0, 1), cB + hstep, voffB); PG8_STAGE(PG8_SA(0, 1), cA + hstep, voffA);
        if (wr == 1) PG8_BAR;
        PG8_WAIT_V(4); PG8_BAR;
        PG8_STAGE(PG8_SB(1, 0), cB + kstep, voffB); PG8_STAGE(PG8_SA(1, 0), cA + kstep, voffA); PG8_STAGE(PG8_SB(1, 1), cB + hstep + kstep, voffB);
        PG8_WAIT_V(6); PG8_BAR;
    }
    for (;;) {
        const bool has_next = S.next(ui + 1, nxt);
        const char* nA = has_next ? (const char*)g.A + (size_t)nxt.pm * tstep : cA; const char* nB = has_next ? (const char*)g.Bt + (size_t)nxt.pn * tstep : cB;
        for (int t = 0; t < nt; t += 2) {
            const bool last = (t == nt - 2);
            const char* a1 = cA + (size_t)(t + 1) * kstep;
            const char* a2 = last ? nA : cA + (size_t)(t + 2) * kstep; const char* b2 = last ? nB : cB + (size_t)(t + 2) * kstep;
            const char* a3 = a2 + kstep; const char* b3 = b2 + kstep;
            if (last && has_next) S.a_ready(nxt);
            if constexpr (SP2) {
            PG8_LDB(B0, 0, 0); PG8_LDB(B1, 0, 1); PG8_SCHED; PG8_LDA(At, 0, 0); PG8_STAGE(PG8_SA(1, 1), a1 + hstep, voffA);
            PG8_WAIT_V(8); PG8_WAIT_L(0); PG8_BAR; PG8_MMA(0, 0, At, B0); PG8_MMA(0, 1, At, B1); PG8_BAR; PG8_SCHED;
            PG8_LDA(At, 0, 1); PG8_STAGE(PG8_SB(0, 0), b2, voffB); PG8_STAGE(PG8_SB(0, 1), b2 + hstep, voffB); PG8_STAGE(PG8_SA(0, 0), a2, voffA);
            PG8_WAIT_V(8); PG8_WAIT_L(0); PG8_BAR; PG8_MMA(1, 0, At, B0); PG8_MMA(1, 1, At, B1); PG8_BAR; PG8_SCHED;
            PG8_LDB(B0, 1, 0); PG8_LDB(B1, 1, 1); PG8_SCHED; PG8_LDA(At, 1, 0); PG8_STAGE(PG8_SA(0, 1), a2 + hstep, voffA);
            PG8_WAIT_V(8); PG8_WAIT_L(0); PG8_BAR; PG8_MMA(0, 0, At, B0); PG8_MMA(0, 1, At, B1); PG8_BAR; PG8_SCHED;
            PG8_LDA(At, 1, 1); PG8_STAGE(PG8_SB(1, 0), b3, voffB); PG8_STAGE(PG8_SB(1, 1), b3 + hstep, voffB); PG8_STAGE(PG8_SA(1, 0), a3, voffA);
            PG8_WAIT_V(8); PG8_WAIT_L(0); PG8_BAR; PG8_MMA(1, 0, At, B0); PG8_MMA(1, 1, At, B1); PG8_BAR; PG8_SCHED;
            } else {
            PG8_LDB(B0, 0, 0); PG8_SCHED; PG8_LDA(At, 0, 0); PG8_STAGE(PG8_SA(1, 1), a1 + hstep, voffA);
            PG8_WAIT_L(8); PG8_BAR; PG8_WAIT_L(0); PG8_MMA(0, 0, At, B0); PG8_BAR; PG8_SCHED;
            PG8_LDB(B1, 0, 1); PG8_STAGE(PG8_SB(0, 0), b2, voffB);
            PG8_BAR; PG8_WAIT_L(0); PG8_MMA(0, 1, At, B1); PG8_BAR;
            PG8_LDA(At, 0, 1); PG8_STAGE(PG8_SA(0, 0), a2, voffA);
            PG8_BAR; PG8_WAIT_L(0); PG8_MMA(1, 0, At, B0); PG8_BAR; PG8_SCHED;
            PG8_STAGE(PG8_SB(0, 1), b2 + hstep, voffB);
            PG8_WAIT_V(6); PG8_BAR; PG8_MMA(1, 1, At, B1); PG8_BAR;
            PG8_LDB(B0, 1, 0); PG8_SCHED; PG8_LDA(At, 1, 0); PG8_STAGE(PG8_SA(0, 1), a2 + hstep, voffA);
            PG8_WAIT_L(8); PG8_BAR; PG8_WAIT_L(0); PG8_MMA(0, 0, At, B0); PG8_BAR; PG8_SCHED;
            PG8_LDB(B1, 1, 1); PG8_STAGE(PG8_SB(1, 0), b3, voffB);
            PG8_BAR; PG8_WAIT_L(0); PG8_MMA(0, 1, At, B1); PG8_BAR;
            PG8_LDA(At, 1, 1); PG8_STAGE(PG8_SA(1, 0), a3, voffA);
            PG8_BAR; PG8_WAIT_L(0); PG8_MMA(1, 0, At, B0); PG8_BAR; PG8_SCHED;
            PG8_STAGE(PG8_SB(1, 1), b3 + hstep, voffB);
            PG8_WAIT_V(6); PG8_BAR; PG8_MMA(1, 1, At, B1); PG8_BAR;
            }
        }
        if constexpr (ALIGN_EPI) { if (wr == 0) PG8_BAR; }
        if constexpr (!Epi::AFTER_DRAIN) { E(acc, cur, wr, wc, fr, fq); S.done(cur); }
        if (!has_next) break;
#pragma unroll
        for (int a = 0; a < 2; ++a)
#pragma unroll
            for (int b = 0; b < 2; ++b)
#pragma unroll
                for (int m = 0; m < 4; ++m)
#pragma unroll
                    for (int n = 0; n < 2; ++n) acc[a][b][m][n] = (f32x4){0.f, 0.f, 0.f, 0.f};
        cur = nxt; cA = nA; cB = nB; ++ui;
        if constexpr (ALIGN_EPI) { if (wr == 1) PG8_BAR; }
    }
    PG8_WAIT_V(0);
    if constexpr (!ALIGN_EPI) { if (wr == 0) PG8_BAR; }
    PG8_BAR;
    if constexpr (Epi::AFTER_DRAIN) { E.fused(acc, cur, wr, wc, fr, fq, lds, wid, lane); S.done(cur); }
#undef PG8_SA
#undef PG8_SB
#undef PG8_STAGE
#undef PG8_LDA
#undef PG8_LDB
#undef PG8_MMA
#undef PG8_WAIT_V
#undef PG8_WAIT_L
#undef PG8_BAR
#undef PG8_SCHED
}
}
constexpr int BATCH = 2, SEQ = 8192, DM = 4096, M = BATCH * SEQ, DFF = 11008, NLAYER = 2;
constexpr int P_IN = 10704, NIN = 10752, NMAIN = 10496;
constexpr int CA_Q = 0, CA_K = 1024, CA_V = 2048;
constexpr int CB_Q = 3072, CB_K = 3584, CB_V = 4096, CB_G = 5120;
constexpr int CC_R = 6144, CC_K = 7168, CC_V = 8192;
constexpr int CD_Q = 9216, CD_K = 10240, CD_V = 10368;
constexpr float LOG2E = 1.4426950408889634f;
constexpr float QSCALE = 0.125f * LOG2E;
constexpr int NWAVES = 8;

constexpr size_t MiB = 1u << 20;
constexpr size_t WS_CTL = 0, CTL_ZERO_BYTES = 1 * MiB;
constexpr size_t WS_MODP = 2 * MiB;
constexpr size_t WS_MOD = 14 * MiB;
constexpr size_t WS_TAB = 15 * MiB;
constexpr size_t WS_WIN = 16 * MiB, WIN_L = 84 * MiB;
constexpr size_t WS_WOUT = 184 * MiB, WOUT_L = 32 * MiB;
constexpr size_t WS_W13 = 248 * MiB, W13_L = 172 * MiB;
constexpr size_t WS_W2 = 592 * MiB, W2_L = 86 * MiB;
constexpr size_t WS_XN = 764 * MiB;
constexpr size_t WS_COLS = 892 * MiB;
constexpr size_t WS_LOWR = 1220 * MiB;
constexpr size_t WS_HID = 892 * MiB;
constexpr size_t WS_QKA = 1236 * MiB;
constexpr size_t WS_QKD = 1300 * MiB;
constexpr size_t WS_LOGA = 1336 * MiB;
constexpr size_t WS_RW = 1368 * MiB, RW_ONE = 64 * MiB;
constexpr size_t WS_VFIRST = 1816 * MiB;
constexpr size_t WS_MIXED = 1880 * MiB;
constexpr int VROW = SEQ + 64;
constexpr size_t WS_VTA = 2008 * MiB;
constexpr size_t WS_VTD = 2041 * MiB;
constexpr size_t WS_QDEC = 2046 * MiB, WS_KDT = 2062 * MiB, WS_AM = 2078 * MiB, WS_EBL = 2086 * MiB;
constexpr size_t WS_VTB = 2087 * MiB;
constexpr size_t WS_RWC = 2120 * MiB;
constexpr size_t WS_OB = 2446 * MiB;
constexpr size_t WS_PSG = 2478 * MiB;
constexpr size_t WS_END = 2479 * MiB;
constexpr int CW_BAR = 4096;
constexpr int CW_Q = 16384;

constexpr int RING_OFF = 0, RING_BYTES = 131072;
constexpr int LDSCTL_OFF = RING_BYTES, MISC_OFF = LDSCTL_OFF + 320;
constexpr int LDS_BYTES = 147456;

#define GAS __attribute__((address_space(1)))
#define LAS __attribute__((address_space(3)))
typedef unsigned short bf16;
typedef unsigned v4u __attribute__((ext_vector_type(4)));
typedef unsigned v2u __attribute__((ext_vector_type(2)));
typedef float f32x4 __attribute__((ext_vector_type(4)));
typedef short bf16x8 __attribute__((ext_vector_type(8)));
typedef GAS unsigned gu32;
#define RLX_AGENT __ATOMIC_RELAXED, __HIP_MEMORY_SCOPE_AGENT
#define LDS_WAIT() asm volatile("s_waitcnt lgkmcnt(0)" ::: "memory")
#define VM_WAIT() asm volatile("s_waitcnt vmcnt(0)" ::: "memory")
typedef float f32x2_t __attribute__((ext_vector_type(2))); typedef __bf16 bf16x2_t __attribute__((ext_vector_type(2)));
__device__ __forceinline__ unsigned pk2(float lo, float hi) { const f32x2_t v = {lo, hi}; return __builtin_bit_cast(unsigned, __builtin_convertvector(v, bf16x2_t)); }
__device__ __forceinline__ unsigned f2bf(float f) { return pk2(f, f) & 0xffffu; }
__device__ __forceinline__ float bf2f(unsigned short h) { return __builtin_bit_cast(float, (unsigned)h << 16); }
__device__ __forceinline__ float bflo(unsigned w) { return __builtin_bit_cast(float, w << 16); }
__device__ __forceinline__ float bfhi(unsigned w) { return __builtin_bit_cast(float, w & 0xffff0000u); }
template <int CTRL> __device__ __forceinline__ float dpp_f(float v) { return __builtin_bit_cast(float, __builtin_amdgcn_update_dpp(0, __builtin_bit_cast(int, v), CTRL, 0xF, 0xF, true)); }
__device__ __forceinline__ float sum8(float v) {
    v += dpp_f<0xB1>(v); v += dpp_f<0x4E>(v); v += dpp_f<0x141>(v); return v; }
__device__ __forceinline__ float sum32(float v) {
    v = sum8(v); v += dpp_f<0x140>(v); v += __builtin_bit_cast(float, __builtin_amdgcn_ds_swizzle(__builtin_bit_cast(int, v), 0x401F)); return v; }
__device__ __forceinline__ float wave_sum(float v) {
    v = sum8(v); v += dpp_f<0x140>(v);
    v += __builtin_bit_cast(float, __builtin_amdgcn_ds_swizzle(__builtin_bit_cast(int, v), 0x401F));
    { const int u = __builtin_bit_cast(int, v); v = __builtin_bit_cast(float, __builtin_amdgcn_readlane(u, 0)) + __builtin_bit_cast(float, __builtin_amdgcn_readlane(u, 32)); }
    return v;
}
__device__ __forceinline__ float sigmoid_f(float x) { return __builtin_amdgcn_rcpf(1.0f + __builtin_amdgcn_exp2f(-LOG2E * x)); }
__device__ __forceinline__ float silu_g(float x) { return x * sigmoid_f(x); }

#define XB_TMO      128
#define XB_XCNT(j)  (256  + 64 * (j))
#define XB_XSUB(j)  (1280 + 64 * (j))
#define XB_XGEN(j)  (2304 + 64 * (j))
#define XB_TOP      3328
#define XB_TOPGEN   3392
#define XCD_BAR_WORDS 3456
#define XB_SPIN_CAP (1u << 23)

__device__ __forceinline__ unsigned xb_ld(unsigned* p)              { return __hip_atomic_load(p, __ATOMIC_RELAXED, __HIP_MEMORY_SCOPE_AGENT); }
__device__ __forceinline__ unsigned xb_add(unsigned* p, unsigned v) { return __hip_atomic_fetch_add(p, v, __ATOMIC_RELAXED, __HIP_MEMORY_SCOPE_AGENT); }
__device__ __forceinline__ unsigned xb_xcc_id() { return (unsigned)__builtin_amdgcn_s_getreg((3 << 11) | 20) & 0xFu; }
#define XB_SPIN(cond, bar) do { unsigned _sp = 0; while (cond) { __builtin_amdgcn_s_sleep(1); \
    if ((++_sp & 255u) == 0u) { if (xb_ld(&(bar)[XB_TMO])) break; if (_sp > XB_SPIN_CAP) { atomicAdd(&(bar)[XB_TMO], 1u); break; } } } } while (0)

struct XcdBarrier {
    unsigned* bar; unsigned x;
    volatile LAS unsigned* st;
};

__device__ __forceinline__ XcdBarrier xcd_barrier_post(unsigned* bar, volatile LAS unsigned* st) {
    XcdBarrier b; b.bar = bar; b.x = xb_xcc_id(); b.st = st;
    if (threadIdx.x == 0) (void)xb_add(&bar[XB_XCNT(b.x)], 1u);
    return b;
}
__device__ __forceinline__ void xcd_barrier_complete(unsigned* bar, unsigned x, unsigned& nloc, unsigned& nx) {
    const unsigned G = gridDim.x * gridDim.y * gridDim.z;
    unsigned sum, cnt, mine, sp = 0u;
    for (;;) {
        sum = 0u; cnt = 0u; mine = 0u;
#pragma unroll
        for (unsigned j = 0; j < 16; ++j) { const unsigned c = xb_ld(&bar[XB_XCNT(j)]); sum += c; cnt += (c > 0u) ? 1u : 0u; mine = (j == x) ? c : mine; }
        if (sum == G) break;
        __builtin_amdgcn_s_sleep(1);
        if ((++sp & 255u) == 0u) { if (xb_ld(&bar[XB_TMO])) break; if (sp > XB_SPIN_CAP) { atomicAdd(&bar[XB_TMO], 1u); break; } }
    }
    nloc = mine > 0u ? mine : 1u; nx = cnt > 0u ? cnt : 1u;
}

__device__ __forceinline__ void xcd_barrier(const XcdBarrier& b) {
    asm volatile("s_waitcnt vmcnt(0)" ::: "memory");
    __syncthreads();
    if (threadIdx.x == 0) {
        unsigned* bar = b.bar;
        __builtin_amdgcn_s_waitcnt(0);
        unsigned nloc = b.st[0], nx = b.st[1];
        if (nloc == 0u) { xcd_barrier_complete(bar, b.x, nloc, nx); b.st[0] = nloc; b.st[1] = nx; }
        const unsigned old = xb_add(&bar[XB_XSUB(b.x)], 1u);
        const unsigned gen = old / nloc;
        if (old + 1u == (gen + 1u) * nloc) {
            __builtin_amdgcn_fence(__ATOMIC_RELEASE, "agent");
            asm volatile("s_waitcnt vmcnt(0)" ::: "memory");
            const unsigned og = xb_add(&bar[XB_TOP], 1u);
            const unsigned tg = og / nx;
            if (og + 1u == (tg + 1u) * nx) xb_add(&bar[XB_TOPGEN], 1u);
            else XB_SPIN(xb_ld(&bar[XB_TOPGEN]) == tg, bar);
            __builtin_amdgcn_fence(__ATOMIC_ACQUIRE, "agent");
            xb_add(&bar[XB_XGEN(b.x)], 1u);
            asm volatile("s_waitcnt vmcnt(0)" ::: "memory");
        } else {
            XB_SPIN(xb_ld(&bar[XB_XGEN(b.x)]) == gen, bar);
            __builtin_amdgcn_fence(__ATOMIC_ACQUIRE, "agent");
            asm volatile("s_waitcnt vmcnt(0)" ::: "memory");
        }
    }
    __syncthreads();
}

typedef const float* const __attribute__((address_space(4)))* kargp;
struct Frame {
    LAS unsigned char* lds;
    volatile LAS unsigned* MISC;
    gu32* ctl;
    int tid, lane, wave;
    int vcu, G, bx;
    kargp kin;
    float* out;
    unsigned char* ws;
};
enum { I_X = 0, I_C, I_RELB, I_ADAW, I_ADAB, I_WIN, I_WOUT, I_DQN, I_DKN, I_DLAM, I_DSUB, I_GGU, I_GGB, I_GON, I_RMU, I_RWUP, I_RW0, I_RAUP, I_RA0, I_RGUP,
       I_RKK, I_RKA, I_RRK, I_RLNW, I_RLNB, I_VRD, I_VRMU, I_VRUP, I_VR0, I_SQN, I_SKN, I_SSINK, I_W1, I_W3, I_W2 };

#define WSP(T, off) ((T*)(F.ws + (off)))
__device__ __forceinline__ void relaunder_tid(Frame& F) { int t = F.tid; asm volatile("" : "+v"(t)); F.tid = t; F.lane = t & 63; F.wave = __builtin_amdgcn_readfirstlane(t >> 6); }
__device__ __forceinline__ void relaunder(Frame& F) { kargp p = F.kin; asm volatile("" : "+s"(p)); F.kin = p; }

__device__ __forceinline__ void conv_item(const float* src, int ld, int col0, int ncols, int K, bf16* WT, int row0, int kb, LAS float* scr, int lane) {
    const int k0 = 64 * kb;
    { const int n = lane & 31; const bool ok = src != nullptr && n < ncols; const float* sp = src + (size_t)(k0 + (lane >> 5)) * ld + col0 + n; float v[32];
#pragma unroll
      for (int i = 0; i < 32; ++i) v[i] = ok ? sp[(size_t)(2 * i) * ld] : 0.f;
#pragma unroll
      for (int i = 0; i < 32; ++i) scr[(2 * i + (lane >> 5)) * 33 + n] = v[i]; }
    LDS_WAIT(); asm volatile("" ::: "memory");
    const int c = lane & 7;
#pragma unroll
    for (int j = 0; j < 4; ++j) { const int n = (lane >> 3) + 8 * j; const LAS float* s = scr + (8 * c) * 33 + n;
        v4u o; o.x = pk2(s[0 * 33], s[1 * 33]); o.y = pk2(s[2 * 33], s[3 * 33]); o.z = pk2(s[4 * 33], s[5 * 33]); o.w = pk2(s[6 * 33], s[7 * 33]);
        if (n < ncols) *(GAS v4u*)(WT + (size_t)(row0 + n) * K + k0 + 8 * c) = o; }
    LDS_WAIT(); asm volatile("" ::: "memory");
}
__device__ __forceinline__ int t5_bucket(int d) {
    if (d < 16) return d;
    int v = 16 + (int)(logf((float)d * (1.0f / 16.0f)) / logf(8.0f) * 16.0f);
    return v < 31 ? v : 31;
}
__device__ __forceinline__ void p0_prologue_a(Frame& F) {
    const int gw = F.vcu * NWAVES + F.wave, NGW = F.G * NWAVES;
    LAS float* ldsf = (LAS float*)(F.lds + RING_OFF);
    for (int i = F.tid; i < 2 * DM; i += NWAVES * 64) ldsf[i] = silu_g(F.kin[I_C][i]);
    __syncthreads();
    float* MODP = WSP(float, WS_MODP);
    for (int it = gw; it < 6144; it += NGW) {
        const int l = it / 3072, rem = it % 3072, kc = rem / 96, ng = rem % 96, n0 = 256 * ng + 4 * F.lane;
        const float* w = F.kin[I_ADAW] + ((size_t)l * DM + kc * 128) * 24576 + n0;
        f32x4 a0 = {0.f, 0.f, 0.f, 0.f}, a1 = {0.f, 0.f, 0.f, 0.f};
#pragma unroll 16
        for (int k = 0; k < 128; ++k) { const f32x4 wv = *(const f32x4*)(w + (size_t)k * 24576); const float s0 = ldsf[kc * 128 + k], s1 = ldsf[DM + kc * 128 + k]; a0 += wv * s0; a1 += wv * s1; }
        *(f32x4*)(MODP + ((size_t)(l * 32 + kc) * 2 + 0) * 24576 + n0) = a0;
        *(f32x4*)(MODP + ((size_t)(l * 32 + kc) * 2 + 1) * 24576 + n0) = a1;
    }
    __syncthreads();
    LAS float* scr = (LAS float*)(F.lds + RING_OFF + F.wave * 16384);
    constexpr int I_IN = 337 * 64, I_OUT = 128 * 64, I_13 = 688 * 64, I_2 = 128 * 172, I_L = I_IN + I_OUT + I_13 + I_2;
    for (int it = gw; it < NLAYER * I_L; it += NGW) {
        const int l = it / I_L; int r = it % I_L;
        if (r < I_IN) {
            const int kb = r / 337, cb = r % 337; const float* src = F.kin[I_WIN] + (size_t)l * DM * P_IN; int ld = P_IN, col0, row0, nc = 32;
            if (cb < 192) { col0 = 32 * cb; row0 = 32 * cb; }
            else if (cb < 288) { col0 = 6160 + 32 * (cb - 192); row0 = 6144 + 32 * (cb - 192); }
            else if (cb < 328) { col0 = 9424 + 32 * (cb - 288); row0 = 9216 + 32 * (cb - 288); }
            else if (cb == 328) { col0 = 6144; row0 = 10496; nc = 16; }
            else if (cb < 335) { col0 = 9232 + 32 * (cb - 329); row0 = 10512 + 32 * (cb - 329); }
            else if (cb == 335) { src = l ? F.kin[I_VRD] + (size_t)(l - 1) * DM * 32 : nullptr; ld = 32; col0 = 0; row0 = 10704; }
            else { src = nullptr; col0 = 0; row0 = 10736; nc = 16; }
            conv_item(src, ld, col0, nc, DM, WSP(bf16, WS_WIN + l * WIN_L), row0, kb, scr, F.lane); continue; }
        r -= I_IN;
        if (r < I_OUT) { const int kb = r / 128, cb = r % 128; conv_item(F.kin[I_WOUT] + (size_t)l * DM * DM, DM, 32 * cb, 32, DM, WSP(bf16, WS_WOUT + l * WOUT_L), 32 * cb, kb, scr, F.lane); continue; }
        r -= I_OUT;
        if (r < I_13) { const int kb = r / 688, cb = r % 688, pn = cb >> 3, wi = cb & 7;
            const float* src = (wi < 4 ? F.kin[I_W1] : F.kin[I_W3]) + (size_t)l * DM * DFF;
            conv_item(src, DFF, 128 * pn + 32 * (wi & 3), 32, DM, WSP(bf16, WS_W13 + l * W13_L), 32 * cb, kb, scr, F.lane); continue; }
        r -= I_13;
        { const int kb = r / 128, cb = r % 128; conv_item(F.kin[I_W2] + (size_t)l * DFF * DM, DM, 32 * cb, 32, DFF, WSP(bf16, WS_W2 + l * W2_L), 32 * cb, kb, scr, F.lane); }
    }
}
__device__ __forceinline__ void p0_prologue_b(Frame& F) {
    const int gt = F.bx * (NWAVES * 64) + F.tid, NT = F.G * NWAVES * 64;
    const float* MODP = WSP(float, WS_MODP); float* MOD = WSP(float, WS_MOD);
    for (int idx = gt; idx < NLAYER * 2 * 24576; idx += NT) {
        const int l = idx / 49152, rem = idx % 49152, b = rem / 24576, n = rem % 24576;
        float s = F.kin[I_ADAB][l * 24576 + n];
#pragma unroll 8
        for (int kc = 0; kc < 32; ++kc) s += MODP[((size_t)(l * 32 + kc) * 2 + b) * 24576 + n];
        MOD[idx] = s;
    }
    if (F.bx == 0) { float* TAB = WSP(float, WS_TAB);
        for (int i = F.tid; i < 24 * 128; i += NWAVES * 64) { const int hh = i >> 7, d = i & 127; TAB[i] = F.kin[I_RELB][t5_bucket(d) * 24 + hh] * LOG2E; } }
}
__device__ __forceinline__ void rms_phase(Frame& F, const float* xin, const float* sh, const float* sc) {
    const int gw = F.vcu * NWAVES + F.wave, NGW = F.G * NWAVES;
    bf16* XN = WSP(bf16, WS_XN);
    for (int m = gw; m < M; m += NGW) {
        const int b = m >> 13;
        const f32x4* xr = (const f32x4*)(xin + (size_t)m * DM) + F.lane;
        f32x4 v[16]; float ss = 0.f;
#pragma unroll
        for (int j = 0; j < 16; ++j) { v[j] = xr[64 * j]; ss += (v[j].x * v[j].x + v[j].y * v[j].y) + (v[j].z * v[j].z + v[j].w * v[j].w); }
        const float rstd = rsqrtf(wave_sum(ss) * (1.0f / DM) + 1e-6f);
        const f32x4* scp = (const f32x4*)(sc + (size_t)b * 24576) + F.lane; const f32x4* shp = (const f32x4*)(sh + (size_t)b * 24576) + F.lane;
        v2u* o8 = (v2u*)(XN + (size_t)m * DM) + F.lane;
#pragma unroll
        for (int j = 0; j < 16; ++j) { const f32x4 s4 = scp[64 * j], h4 = shp[64 * j]; const f32x4 o = v[j] * rstd * (s4 + 1.0f) + h4;
            v2u w; w.x = pk2(o.x, o.y); w.y = pk2(o.z, o.w); o8[64 * j] = w; }
    }
}
__device__ __forceinline__ void unpack8(const v4u r, float (&f)[8]) { f[0] = bflo(r.x); f[1] = bfhi(r.x); f[2] = bflo(r.y); f[3] = bfhi(r.y); f[4] = bflo(r.z); f[5] = bfhi(r.z); f[6] = bflo(r.w); f[7] = bfhi(r.w); }
__device__ __forceinline__ v4u pack8(const float (&f)[8]) { v4u o; o.x = pk2(f[0], f[1]); o.y = pk2(f[2], f[3]); o.z = pk2(f[4], f[5]); o.w = pk2(f[6], f[7]); return o; }
__device__ __forceinline__ void prep_norm(Frame& F, int l) {
    const int gw = F.vcu * NWAVES + F.wave, NGW = F.G * NWAVES, lane = F.lane, sub = lane >> 3, ch = lane & 7;
    float gqa[8], gka[8], gqd[8], gkd[8];
#pragma unroll
    for (int e = 0; e < 8; ++e) { gqa[e] = F.kin[I_DQN][l * 64 + ch * 8 + e] * QSCALE; gka[e] = F.kin[I_DKN][l * 64 + ch * 8 + e];
                                  gqd[e] = F.kin[I_SQN][l * 64 + ch * 8 + e] * QSCALE; gkd[e] = F.kin[I_SKN][l * 64 + ch * 8 + e]; }
    const bf16* COLS = WSP(bf16, WS_COLS); bf16* QKA = WSP(bf16, WS_QKA); bf16* QKD = WSP(bf16, WS_QKD);
    for (int m = gw; m < M; m += NGW) {
        const bf16* src = COLS + (size_t)m * NMAIN;
#pragma unroll
        for (int i = 0; i < 4; ++i) { const int vec = i * 8 + sub, col = vec * 64 + ch * 8;
            float f[8]; unpack8(*(const v4u*)(src + CA_Q + col), f); float ss = 0.f;
#pragma unroll
            for (int e = 0; e < 8; ++e) ss += f[e] * f[e];
            ss = sum8(ss);
            const float rstd = rsqrtf(ss * (1.0f / 64.0f) + 1e-6f);
#pragma unroll
            for (int e = 0; e < 8; ++e) f[e] = f[e] * rstd * (i < 2 ? gqa[e] : gka[e]);
            *(v4u*)(QKA + (size_t)m * 2048 + col) = pack8(f); }
#pragma unroll
        for (int i = 0; i < 3; ++i) { const int vec = i * 8 + sub, col = vec * 64 + ch * 8;
            if (vec < 18) { float f[8]; unpack8(*(const v4u*)(src + CD_Q + col), f); float ss = 0.f;
#pragma unroll
                for (int e = 0; e < 8; ++e) ss += f[e] * f[e];
                ss = sum8(ss);
                const float rstd = rsqrtf(ss * (1.0f / 64.0f) + 1e-6f);
#pragma unroll
                for (int e = 0; e < 8; ++e) f[e] = f[e] * rstd * (vec < 16 ? gqd[e] : gkd[e]);
                *(v4u*)(QKD + (size_t)m * 1152 + col) = pack8(f); } }
    }
}
__device__ __forceinline__ void prep_loga(Frame& F, int l) {
    LAS float* gdl = (LAS float*)(F.lds + RING_OFF);
    float gu[16];
#pragma unroll
    for (int j = 0; j < 16; ++j) gu[j] = F.kin[I_GGU][((size_t)l * 16 + j) * 512 + F.tid];
    const float bias = F.kin[I_GGB][l * 512 + F.tid];
    const float* LOWR = WSP(float, WS_LOWR); float* LOGA = WSP(float, WS_LOGA);
    for (int tile = F.bx; tile < M / 64; tile += F.G) {
        const size_t row0 = (size_t)tile * 64;
        __syncthreads();
#pragma unroll
        for (int i = 0; i < 2; ++i) { const int idx = F.tid + 512 * i; gdl[idx] = LOWR[(row0 + (idx >> 4)) * 256 + (idx & 15)]; }
        __syncthreads();
#pragma unroll 4
        for (int t = 0; t < 64; ++t) { const LAS f32x4* gp = (const LAS f32x4*)(gdl + t * 16); const f32x4 g0 = gp[0], g1 = gp[1], g2 = gp[2], g3 = gp[3];
            float z = bias + g0.x * gu[0] + g0.y * gu[1] + g0.z * gu[2] + g0.w * gu[3] + g1.x * gu[4] + g1.y * gu[5] + g1.z * gu[6] + g1.w * gu[7]
                    + g2.x * gu[8] + g2.y * gu[9] + g2.z * gu[10] + g2.w * gu[11] + g3.x * gu[12] + g3.y * gu[13] + g3.z * gu[14] + g3.w * gu[15];
            LOGA[(row0 + t) * 512 + F.tid] = (fminf(z, 0.f) - __logf(1.0f + __expf(-fabsf(z)))) * (1.0f / 16.0f); }
    }
}
__device__ __forceinline__ int next_item(Frame& F, gu32* ctr) {
    volatile LAS int* slot = (volatile LAS int*)(F.lds + LDSCTL_OFF + 64);
    __syncthreads();
    if (F.tid == 0) *slot = (int)__hip_atomic_fetch_add(ctr, 1u, RLX_AGENT);
    __syncthreads();
    return *slot;
}
typedef float f32x16 __attribute__((ext_vector_type(16)));
__device__ __forceinline__ float xother32(float v) { unsigned a = __builtin_bit_cast(unsigned, v), b = a; asm volatile("" : "+v"(b)); auto rr = __builtin_amdgcn_permlane32_swap(a, b, false, false);
    const unsigned lo = rr[0], hi = rr[1]; return __builtin_bit_cast(float, (unsigned)((__builtin_amdgcn_mbcnt_hi(~0u, __builtin_amdgcn_mbcnt_lo(~0u, 0u)) & 32u) ? lo : hi)); }
__device__ __forceinline__ float xsum32(float v) { return v + xother32(v); }
__device__ __forceinline__ float xmax32(float v) { return fmaxf(v, xother32(v)); }
__device__ __forceinline__ int crow16(int r, int hi) { return (r & 3) + 8 * (r >> 2) + 4 * hi; }
template <bool ISA>
__device__ __forceinline__ void attn_unit(Frame& F, int l, int b, int hx, int qb) {
    constexpr int DV = ISA ? 128 : 64, NDV = DV / 32, KSTR = ISA ? 272 : 144, VSTR = 144, KBYTES = 64 * KSTR, VBYTES = DV * VSTR, BUFB = KBYTES + VBYTES, NCH = ISA ? 2 : 1;
    constexpr float NEG = -1e30f;
    LAS unsigned char* L = F.lds + RING_OFF;
    const int tid = F.tid, lane = F.lane, r32 = lane & 31, hi = lane >> 5, qs = F.wave & 3, grp = F.wave >> 2, q0 = qb * 128;
    const int kvh = hx >> 2, hd = kvh * 8 + (hx & 3) * 2 + grp;
    const bf16* Qp; const bf16* Kp; const bf16* VT; int ldq;
    if (ISA) { const bf16* QKA = WSP(bf16, WS_QKA); Qp = QKA + (size_t)b * SEQ * 2048 + hx * 128 + grp * 64; Kp = QKA + (size_t)b * SEQ * 2048 + 1024 + hx * 128; ldq = 2048; VT = WSP(bf16, WS_VTA) + (size_t)(b * 8 + hx) * 128 * VROW; }
    else { const bf16* QKD = WSP(bf16, WS_QKD); Qp = QKD + (size_t)b * SEQ * 1152 + hd * 64; Kp = QKD + (size_t)b * SEQ * 1152 + 1024 + kvh * 64; ldq = 1152; VT = WSP(bf16, WS_VTD) + (size_t)(b * 2 + kvh) * 64 * VROW; }
    const int qpos = q0 + 32 * qs + r32;
    bf16x8 qr[4];
#pragma unroll
    for (int d0 = 0; d0 < 4; ++d0) qr[d0] = *(const bf16x8*)(Qp + (size_t)qpos * ldq + d0 * 16 + hi * 8);
    LAS float* Bt = (LAS float*)(L + 2 * BUFB);
    { const float* TAB = WSP(float, WS_TAB);
      if (ISA) { if (tid < 130) Bt[tid] = tid == 0 ? NEG : (tid == 129 ? 0.f : TAB[hx * 128 + tid - 1] - TAB[hx * 128 + 127]); }
      else { if (tid < 260) { const int gi = tid >= 130, t = tid - 130 * gi; Bt[tid] = (t == 0 || t == 129) ? NEG : TAB[(8 + kvh * 8 + (hx & 3) * 2 + gi) * 128 + t - 1]; } } }
    const int TQ = q0 >> 6, T0 = ISA ? 0 : (TQ >= 2 ? TQ - 2 : 0), T1 = TQ + 1;
    v4u kreg[NCH], vreg[NCH];
#define AT_GLOAD(T) do { _Pragma("unroll") for (int i_ = 0; i_ < NCH; ++i_) { const int c_ = tid + 512 * i_; \
        const int kr_ = ISA ? (c_ >> 4) : (c_ >> 3), kc_ = ISA ? (c_ & 15) : (c_ & 7); kreg[i_] = *(const v4u*)(Kp + (size_t)((T) * 64 + kr_) * ldq + kc_ * 8); \
        const int vr_ = c_ >> 3, vc_ = c_ & 7; vreg[i_] = *(const v4u*)(VT + (size_t)vr_ * VROW + (T) * 64 + vc_ * 8); } } while (0)
#define AT_LWRITE(buf) do { _Pragma("unroll") for (int i_ = 0; i_ < NCH; ++i_) { const int c_ = tid + 512 * i_; \
        const int kr_ = ISA ? (c_ >> 4) : (c_ >> 3), kc_ = ISA ? (c_ & 15) : (c_ & 7); *(LAS v4u*)(L + (buf) * BUFB + kr_ * KSTR + kc_ * 16) = kreg[i_]; \
        const int vr_ = c_ >> 3, vc_ = c_ & 7; *(LAS v4u*)(L + (buf) * BUFB + KBYTES + vr_ * VSTR + vc_ * 16) = vreg[i_]; } } while (0)
    f32x16 o[NDV];
#pragma unroll
    for (int i = 0; i < NDV; ++i) o[i] = (f32x16){0.f, 0.f, 0.f, 0.f, 0.f, 0.f, 0.f, 0.f, 0.f, 0.f, 0.f, 0.f, 0.f, 0.f, 0.f, 0.f};
    float m_run = ISA ? NEG : F.kin[I_SSINK][l * 16 + hd] * LOG2E, l_run = ISA ? 0.f : (hi == 0 ? 1.f : 0.f);
    const int krow = (r32 & 16) | (r32 & 3) | ((r32 & 4) << 1) | ((r32 & 8) >> 1);
    const int koff = krow * KSTR + (ISA ? grp * 128 : 0) + hi * 16, voff = KBYTES + r32 * VSTR + hi * 16;
    AT_GLOAD(T0); AT_LWRITE(0); __syncthreads();
#pragma unroll 1
    for (int T = T0; T <= T1; ++T) {
        const int cur = (T - T0) & 1;
        AT_GLOAD(T < T1 ? T + 1 : T1);
        LAS const unsigned char* Kb = L + cur * BUFB;
        f32x16 s[2];
#pragma unroll
        for (int blk = 0; blk < 2; ++blk) { s[blk] = (f32x16){0.f, 0.f, 0.f, 0.f, 0.f, 0.f, 0.f, 0.f, 0.f, 0.f, 0.f, 0.f, 0.f, 0.f, 0.f, 0.f};
#pragma unroll
            for (int d0 = 0; d0 < 4; ++d0) { const bf16x8 kf = *(const LAS bf16x8*)(Kb + koff + blk * 32 * KSTR + d0 * 32); s[blk] = __builtin_amdgcn_mfma_f32_32x32x16_bf16(kf, qr[d0], s[blk], 0, 0, 0); } }
        bf16x8 vfc[NDV], vfn[NDV];
#pragma unroll
        for (int i = 0; i < NDV; ++i) vfc[i] = *(const LAS bf16x8*)(Kb + voff + i * 32 * VSTR);
        if (!ISA || T >= TQ - 2) {
            const LAS float* bt = Bt + (ISA ? 0 : grp * 130) + 1; const int d0 = qpos - T * 64 - 8 * hi;
#pragma unroll
            for (int blk = 0; blk < 2; ++blk)
#pragma unroll
                for (int r = 0; r < 16; ++r) { const int dist = d0 - (32 * blk + 16 * (r >> 3) + (r & 7)); const int di = dist < -1 ? -1 : (dist > 128 ? 128 : dist); s[blk][r] += bt[di]; } }
        float mt = s[0][0];
#pragma unroll
        for (int r = 1; r < 16; ++r) mt = fmaxf(mt, s[0][r]);
#pragma unroll
        for (int r = 0; r < 16; ++r) mt = fmaxf(mt, s[1][r]);
        mt = xmax32(mt);
        const float m_new = fmaxf(m_run, mt);
        if (__any(m_new > m_run)) { const float alpha = __builtin_amdgcn_exp2f(m_run - m_new); l_run *= alpha;
#pragma unroll
            for (int i = 0; i < NDV; ++i)
#pragma unroll
                for (int r = 0; r < 16; ++r) o[i][r] *= alpha;
            m_run = m_new; }
        float ls = 0.f;
#pragma unroll
        for (int blk = 0; blk < 2; ++blk)
#pragma unroll
            for (int r = 0; r < 16; ++r) { const float pv_ = __builtin_amdgcn_exp2f(s[blk][r] - m_run); s[blk][r] = pv_; ls += pv_; }
        l_run += ls;
#pragma unroll
        for (int sl = 0; sl < 4; ++sl) { const int blk = sl >> 1, r0 = 8 * (sl & 1);
            v4u pw; pw.x = pg8::cvt_pk_bf16(s[blk][r0], s[blk][r0 + 1]); pw.y = pg8::cvt_pk_bf16(s[blk][r0 + 2], s[blk][r0 + 3]); pw.z = pg8::cvt_pk_bf16(s[blk][r0 + 4], s[blk][r0 + 5]); pw.w = pg8::cvt_pk_bf16(s[blk][r0 + 6], s[blk][r0 + 7]);
            const bf16x8 pf = __builtin_bit_cast(bf16x8, pw);
#pragma unroll
            for (int i = 0; i < NDV; ++i) { if (sl < 3) vfn[i] = *(const LAS bf16x8*)(Kb + voff + i * 32 * VSTR + (sl + 1) * 32); o[i] = __builtin_amdgcn_mfma_f32_32x32x16_bf16(vfc[i], pf, o[i], 0, 0, 0); }
#pragma unroll
            for (int i = 0; i < NDV; ++i) vfc[i] = vfn[i]; }
        AT_LWRITE(cur ^ 1);
        __syncthreads();
    }
#undef AT_GLOAD
#undef AT_LWRITE
    const float inv = 1.0f / xsum32(l_run);
    bf16* MIX = WSP(bf16, WS_MIXED);
    if (ISA) {
        int ll_ = l; asm volatile("" : "+s"(ll_)); const float lam_init = ll_ == 0 ? 0.2f : 0.35550906759f;     float lam_full;
        { const float* lm = F.kin[I_DLAM] + (size_t)l * 256; const float s1 = wave_sum(lm[lane] * lm[64 + lane]), s2 = wave_sum(lm[128 + lane] * lm[192 + lane]); lam_full = __expf(s1) - __expf(s2) + lam_init; }
        LAS float* R1 = (LAS float*)L;
        LAS bf16* R2 = (LAS bf16*)(L + 66048);
        const int ql = 32 * qs + r32;
        if (grp == 1) {
#pragma unroll
            for (int i = 0; i < NDV; ++i)
#pragma unroll
                for (int r = 0; r < 16; ++r) R1[ql * 129 + 32 * i + crow16(r, hi)] = lam_full * inv * o[i][r]; }
        __syncthreads();
        if (grp == 0) { float ss = 0.f;
#pragma unroll
            for (int i = 0; i < NDV; ++i)
#pragma unroll
                for (int r = 0; r < 16; ++r) { const float d = o[i][r] * inv - R1[ql * 129 + 32 * i + crow16(r, hi)]; o[i][r] = d; ss += d * d; }
            const float rstd = rsqrtf(xsum32(ss) * (1.0f / 128.0f) + 1e-6f) * (1.0f - lam_init);
            const float* sl = F.kin[I_DSUB] + l * 128;
#pragma unroll
            for (int i = 0; i < NDV; ++i)
#pragma unroll
                for (int r = 0; r < 16; ++r) { const int dv = 32 * i + crow16(r, hi); R2[ql * 132 + dv] = (bf16)f2bf(o[i][r] * rstd * sl[dv]); } }
        __syncthreads();
#pragma unroll
        for (int i = 0; i < 4; ++i) { const int c = tid + 512 * i, row = c >> 4, ch = c & 15; const LAS v2u* sp = (const LAS v2u*)(R2 + row * 132 + ch * 8); const v2u a = sp[0], bb = sp[1];
            *(v4u*)(MIX + (size_t)(b * SEQ + q0 + row) * DM + hx * 128 + ch * 8) = (v4u){a.x, a.y, bb.x, bb.y}; }
    } else {
        LAS bf16* R = (LAS bf16*)L + F.wave * 2176;
#pragma unroll
        for (int i = 0; i < NDV; ++i)
#pragma unroll
            for (int r = 0; r < 16; ++r) R[r32 * 68 + 32 * i + crow16(r, hi)] = (bf16)f2bf(o[i][r] * inv);
#pragma unroll
        for (int i = 0; i < 4; ++i) { const int c = lane + 64 * i, row = c >> 3, ch = c & 7; const LAS v2u* sp = (const LAS v2u*)(R + row * 68 + ch * 8); const v2u a = sp[0], bb = sp[1];
            *(v4u*)(MIX + (size_t)(b * SEQ + q0 + 32 * qs + row) * DM + 3072 + hd * 64 + ch * 8) = (v4u){a.x, a.y, bb.x, bb.y}; }
    }
}
__device__ __forceinline__ void prep_gla(Frame& F) {
    LAS float* Lb = (LAS float*)(F.lds + RING_OFF); LAS float* Qd = Lb + 64 * 129; LAS float* Ki = Qd + 64 * 129; LAS bf16* Kt = (LAS bf16*)(Ki + 64 * 129);
    const bf16* COLS = WSP(bf16, WS_COLS); const float* LOGA = WSP(float, WS_LOGA);
    bf16* QDEC = WSP(bf16, WS_QDEC); bf16* KDT = WSP(bf16, WS_KDT); bf16* AMg = WSP(bf16, WS_AM); float* EBL = WSP(float, WS_EBL);
    for (int u = F.bx; u < 1024; u += F.G) {
        const int b = u >> 9, h = (u >> 7) & 3, ck = u & 127; const size_t row0 = (size_t)b * SEQ + ck * 64;
        __syncthreads();
        for (int idx = F.tid; idx < 8192; idx += NWAVES * 64) { const int t = idx >> 7, d = idx & 127; Lb[t * 129 + d] = LOGA[(row0 + t) * 512 + h * 128 + d]; }
        __syncthreads();
        if (F.tid < 128) { float acc = 0.f;
#pragma unroll 8
            for (int t = 0; t < 64; ++t) { acc += Lb[t * 129 + F.tid]; Lb[t * 129 + F.tid] = acc; }
            EBL[(size_t)u * 128 + F.tid] = __expf(acc); }
        __syncthreads();
        for (int idx = F.tid; idx < 8192; idx += NWAVES * 64) { const int t = idx >> 7, d = idx & 127; const float bt = Lb[t * 129 + d], bl = Lb[63 * 129 + d];
            const float q = bf2f(COLS[(row0 + t) * NMAIN + CB_Q + h * 128 + d]) * 0.08838834764831845f, k = bf2f(COLS[(row0 + t) * NMAIN + CB_K + h * 128 + d]);
            const float qd = q * __expf(bt); Qd[t * 129 + d] = qd; Ki[t * 129 + d] = k * __expf(-bt); Kt[d * 72 + t] = (bf16)f2bf(k * __expf(bl - bt));
            QDEC[((size_t)u * 64 + t) * 128 + d] = (bf16)f2bf(qd); }
        __syncthreads();
#pragma unroll
        for (int i = 0; i < 2; ++i) { const int c_ = F.tid + 512 * i, row = c_ >> 3, ch = c_ & 7; const LAS v2u* sp = (const LAS v2u*)(Kt + row * 72 + ch * 8); const v2u a = sp[0], bb = sp[1];
            *(v4u*)(KDT + ((size_t)u * 128 + row) * 64 + ch * 8) = (v4u){a.x, a.y, bb.x, bb.y}; }
        { const int c = F.tid >> 3, sg = F.tid & 7; float acc[8];
#pragma unroll
          for (int e = 0; e < 8; ++e) acc[e] = 0.f;
#pragma unroll 4
          for (int d = 0; d < 128; ++d) { const float q = Qd[c * 129 + d];
#pragma unroll
              for (int e = 0; e < 8; ++e) acc[e] += q * Ki[(sg * 8 + e) * 129 + d]; }
#pragma unroll
          for (int e = 0; e < 8; ++e) if (sg * 8 + e > c) acc[e] = 0.f;
          *(v4u*)(AMg + ((size_t)u * 64 + c) * 64 + sg * 8) = pack8(acc); }
    }
}
__device__ __forceinline__ void prep_vt(Frame& F, int pass) {
    LAS bf16* T = (LAS bf16*)(F.lds + RING_OFF);
    const bf16* COLS = WSP(bf16, WS_COLS);
    const int nch = pass == 0 ? 144 : 128, nvr = nch * 8;
    for (int tile = F.bx; tile < M / 32; tile += F.G) {
        const int b = tile >> 8, t0 = (tile & 255) * 32;
        __syncthreads();
        for (int idx = F.tid; idx < 32 * nch; idx += NWAVES * 64) { const int tok = idx / nch, ch = idx % nch;
            const int col = pass == 0 ? (ch < 128 ? CA_V + ch * 8 : CD_V + (ch - 128) * 8) : (pass == 1 ? CB_V + ch * 8 : CB_G + ch * 8);
            const v4u v = *(const v4u*)(COLS + (size_t)(b * SEQ + t0 + tok) * NMAIN + col); LAS v2u* d = (LAS v2u*)(T + tok * 1160 + ch * 8); d[0] = (v2u){v.x, v.y}; d[1] = (v2u){v.z, v.w}; }
        __syncthreads();
        for (int idx = F.tid; idx < nvr * 4; idx += NWAVES * 64) { const int ch = idx / nvr, vrow = idx % nvr;
            unsigned e[8];
#pragma unroll
            for (int k = 0; k < 8; ++k) e[k] = T[(ch * 8 + k) * 1160 + vrow];
            v4u o; o.x = e[0] | (e[1] << 16); o.y = e[2] | (e[3] << 16); o.z = e[4] | (e[5] << 16); o.w = e[6] | (e[7] << 16);
            bf16* dst;
            if (pass == 0) dst = vrow < 1024 ? WSP(bf16, WS_VTA) + ((size_t)(b * 8 + (vrow >> 7)) * 128 + (vrow & 127)) * VROW : WSP(bf16, WS_VTD) + ((size_t)(b * 2 + ((vrow - 1024) >> 6)) * 64 + ((vrow - 1024) & 63)) * VROW;
            else dst = WSP(bf16, WS_VTB) + ((size_t)b * 1024 + vrow) * VROW;
            *(v4u*)(dst + t0 + ch * 8) = o; }
    }
}
typedef float f32x4v __attribute__((ext_vector_type(4)));
__device__ __forceinline__ float sum16(float v) { v = sum8(v); v += dpp_f<0x140>(v); return v; }
#define LDS_BARRIER() asm volatile("s_waitcnt lgkmcnt(0)\n\ts_barrier" ::: "memory")
template <int HACK = 0> __device__ __forceinline__ void gla_scan_unit(Frame& F, int l, int b, int h, int vh) {
    LAS unsigned char* L = F.lds + RING_OFF;
    constexpr int OQD = 0, OKT = 17408, OAM = 35840, OVT = 45056, OOT = 63488, OEB = 80896, OPS = 81408;
    const int tid = F.tid, lane = F.lane, n = lane & 15, g = lane >> 4, w = F.wave;
    const bf16* QDEC = WSP(bf16, WS_QDEC); const bf16* KDT = WSP(bf16, WS_KDT); const bf16* AMg = WSP(bf16, WS_AM); const float* EBL = WSP(float, WS_EBL);
    const bf16* VTB = WSP(bf16, WS_VTB) + (size_t)((b * 4 + h) * 256 + 128 * vh) * VROW; bf16* OB = WSP(bf16, WS_OB); float* PSG = WSP(float, WS_PSG);
    f32x4v S[8];
#pragma unroll
    for (int dt = 0; dt < 8; ++dt) S[dt] = (f32x4v){0.f, 0.f, 0.f, 0.f};
    v4u pq[2], pk[2], pa, pv[2]; float pe = 0.f;
#define GL_ISSUE(CK) do { const size_t u_ = (size_t)(b * 4 + h) * 128 + (CK); \
        _Pragma("unroll") for (int i = 0; i < 2; ++i) { const int c_ = tid + 512 * i; pq[i] = *(const v4u*)(QDEC + (u_ * 64 + (c_ >> 4)) * 128 + (c_ & 15) * 8); pk[i] = *(const v4u*)(KDT + (u_ * 128 + (c_ >> 3)) * 64 + (c_ & 7) * 8); \
            pv[i] = *(const v4u*)(VTB + (size_t)(c_ >> 3) * VROW + (CK) * 64 + (c_ & 7) * 8); } \
        pa = *(const v4u*)(AMg + (u_ * 64 + (tid >> 3)) * 64 + (tid & 7) * 8); \
        pe = EBL[u_ * 128 + (tid & 127)]; } while (0)
#define GL_WRITE() do { _Pragma("unroll") for (int i = 0; i < 2; ++i) { const int c_ = tid + 512 * i; *(LAS v4u*)(L + OQD + (c_ >> 4) * 272 + (c_ & 15) * 16) = pq[i]; *(LAS v4u*)(L + OKT + (c_ >> 3) * 144 + (c_ & 7) * 16) = pk[i]; \
            *(LAS v4u*)(L + OVT + (c_ >> 3) * 144 + (c_ & 7) * 16) = pv[i]; } \
        *(LAS v4u*)(L + OAM + (tid >> 3) * 144 + (tid & 7) * 16) = pa; \
        ((LAS float*)(L + OEB))[tid & 127] = pe; } while (0)
    GL_ISSUE(0); GL_WRITE();
    LDS_BARRIER();
#pragma unroll 1
    for (int ck = 0; ck < 128; ++ck) {
        const size_t row0 = (size_t)b * SEQ + ck * 64;
        GL_ISSUE((HACK & 1) && ck >= 2 ? 2 : (ck + 1 < 128 ? ck + 1 : 127));
        bf16x8 vf[2];
#pragma unroll
        for (int ks = 0; ks < 2; ++ks) vf[ks] = *(const LAS bf16x8*)(L + OVT + (16 * w + n) * 144 + (32 * ks + 8 * g) * 2);
        f32x4v o[4];
#pragma unroll
        for (int ct = 0; ct < 4; ++ct) o[ct] = (f32x4v){0.f, 0.f, 0.f, 0.f};
#pragma unroll
        for (int ct = 0; ct < 4; ++ct)
#pragma unroll
            for (int ks = 0; ks < 2; ++ks) { const bf16x8 af = *(const LAS bf16x8*)(L + OAM + (16 * ct + n) * 144 + (32 * ks + 8 * g) * 2); o[ct] = __builtin_amdgcn_mfma_f32_16x16x32_bf16(af, vf[ks], o[ct], 0, 0, 0); }
#pragma unroll
        for (int kk = 0; kk < 4; ++kk) { v4u pw; pw.x = pg8::cvt_pk_bf16(S[2 * kk][0], S[2 * kk][1]); pw.y = pg8::cvt_pk_bf16(S[2 * kk][2], S[2 * kk][3]);
            pw.z = pg8::cvt_pk_bf16(S[2 * kk + 1][0], S[2 * kk + 1][1]); pw.w = pg8::cvt_pk_bf16(S[2 * kk + 1][2], S[2 * kk + 1][3]); const bf16x8 sf = __builtin_bit_cast(bf16x8, pw);
#pragma unroll
            for (int ct = 0; ct < 4; ++ct) { const LAS unsigned char* qp = L + OQD + (16 * ct + n) * 272 + (32 * kk + 4 * g) * 2; const v2u qa = *(const LAS v2u*)qp, qb = *(const LAS v2u*)(qp + 32);
                o[ct] = __builtin_amdgcn_mfma_f32_16x16x32_bf16(__builtin_bit_cast(bf16x8, (v4u){qa.x, qa.y, qb.x, qb.y}), sf, o[ct], 0, 0, 0); } }
#pragma unroll
        for (int dt = 0; dt < 8; ++dt) { const f32x4v eb = *(const LAS f32x4v*)(L + OEB + (16 * dt + 4 * g) * 4); S[dt] = S[dt] * eb;
#pragma unroll
            for (int ks = 0; ks < 2; ++ks) { const bf16x8 kf = *(const LAS bf16x8*)(L + OKT + (16 * dt + n) * 144 + (32 * ks + 8 * g) * 2); S[dt] = __builtin_amdgcn_mfma_f32_16x16x32_bf16(kf, vf[ks], S[dt], 0, 0, 0); } }
        LAS float* PS = (LAS float*)(L + OPS) + (ck & 1) * 512;
#pragma unroll
        for (int ct = 0; ct < 4; ++ct)
#pragma unroll
            for (int r = 0; r < 4; ++r) { const float ss = sum16(o[ct][r] * o[ct][r]); if (n == 0) PS[(16 * ct + 4 * g + r) * 8 + w] = ss;
                *(LAS bf16*)(L + OOT + (16 * ct + 4 * g + r) * 272 + (16 * w + n) * 2) = (bf16)f2bf(o[ct][r]); }
        LDS_BARRIER();
        GL_WRITE();
        if (!(HACK & 2)) {
#pragma unroll
        for (int i = 0; i < 2; ++i) { const int c_ = tid + 512 * i, tok = c_ >> 4, ch = c_ & 15; *(v4u*)(OB + (row0 + tok) * 1024 + h * 256 + 128 * vh + ch * 8) = *(const LAS v4u*)(L + OOT + tok * 272 + ch * 16); }
        if (tid < 64) { const LAS f32x4v* pp = (const LAS f32x4v*)(PS + tid * 8); const f32x4v p0 = pp[0], p1 = pp[1]; PSG[(row0 + tid) * 8 + h * 2 + vh] = ((p0.x + p0.y) + (p0.z + p0.w)) + ((p1.x + p1.y) + (p1.z + p1.w)); } }
        LDS_BARRIER();
    }
#undef GL_ISSUE
#undef GL_WRITE
}
__device__ __forceinline__ void gla_post(Frame& F, int l) {
    const bf16* OB = WSP(bf16, WS_OB); const float* PSG = WSP(float, WS_PSG); const bf16* COLS = WSP(bf16, WS_COLS); bf16* MIX = WSP(bf16, WS_MIXED);
    const int ch = F.tid & 127, h = ch >> 5; float gain8[8];
#pragma unroll
    for (int e = 0; e < 8; ++e) gain8[e] = F.kin[I_GON][l * 256 + (ch & 31) * 8 + e];
    for (int row = F.bx * 4 + (F.tid >> 7); row < M; row += F.G * 4) {
        float ov[8], gv[8]; unpack8(*(const v4u*)(OB + (size_t)row * 1024 + ch * 8), ov); unpack8(*(const v4u*)(COLS + (size_t)row * NMAIN + CB_G + ch * 8), gv);
        const f32x2_t ps = *(const f32x2_t*)(PSG + (size_t)row * 8 + h * 2); const float rstd = rsqrtf((ps.x + ps.y) * (1.0f / 256.0f) + 1e-6f);
#pragma unroll
        for (int e = 0; e < 8; ++e) ov[e] = ov[e] * (rstd * gain8[e]) * silu_g(gv[e]);
        *(v4u*)(MIX + (size_t)row * DM + 1024 + ch * 8) = pack8(ov);
    }
}
constexpr int RC_AT = 0, RC_RT = 2048, RC_BK = 4096, RC_VF = 8192, RC_GF = 10240, RC_U0 = 12288, RC_Y0 = 16384, RC_P15 = 20480, RC_BN = 20736, RC_BYTES = 20800;
__device__ __forceinline__ void rwkv_chunks_of_tile(Frame& F, int l, int tile) {
    const int team = F.tid >> 8, tt = F.tid & 255;
    LAS float* Lt = (LAS float*)(F.lds + RING_OFF) + team * 12288;
    LAS float* XA = Lt; LAS float* XR = Lt + 1040; LAS float* ZB = Lt + 2080; LAS float* ZK = Lt + 3120; LAS float* TB = Lt + 4160; LAS float* TK = Lt + 5200; LAS float* VV = Lt + 6240;
    LAS float* ATl = Lt + 7280; LAS float* U0l = Lt + 8320; LAS float* W1 = Lt + 9360;
    LAS float* Aab = Lt + 10400; LAS float* Aak = Lt + 10672; LAS float* Arb = Lt + 10944; LAS float* Ark = Lt + 11216; LAS float* TT = Lt + 11488;
    const float* RW = WSP(float, WS_RW); const unsigned* RWU = WSP(unsigned, WS_RW); constexpr size_t RS = RW_ONE / 4; unsigned char* RWC = F.ws + WS_RWC;
    float pw_[6], pr_[4], pk_[4], pv_[4], pa_[4], pb_[4], pg_[4];
#define RC_FETCH(P) do { const int h_ = 2 * (P) + team; const size_t cb_ = (size_t)tile * 16 * 1024 + h_ * 64 + (tt & 63); const int q_ = tt >> 6; \
        pw_[4] = RW[RS + cb_ + (size_t)(q_ ? 4 * q_ - 1 : 0) * 1024]; pw_[5] = RW[RS + cb_ + (size_t)15 * 1024];            \
        _Pragma("unroll") for (int e = 0; e < 4; ++e) { const size_t o_ = cb_ + (size_t)(4 * q_ + e) * 1024; pw_[e] = RW[RS + o_]; const unsigned u0 = RWU[o_], u2 = RWU[2 * RS + o_], u3 = RWU[3 * RS + o_]; \
            pr_[e] = bflo(u0); pk_[e] = bfhi(u0); pv_[e] = bflo(u2); pg_[e] = bfhi(u2); pa_[e] = bflo(u3); pb_[e] = bfhi(u3); } } while (0)
    RC_FETCH(0);
#pragma unroll 1
    for (int pair = 0; pair < 8; ++pair) {
        const int uc = ((tile >> 9) * 16 + 2 * pair + team) * 512 + (tile & 511), b = uc >> 13, h = (uc >> 9) & 15, ck = uc & 511; unsigned char* rec = RWC + ((size_t)ck * 32 + (uc >> 9)) * RC_BYTES;     (void)b;
        __syncthreads();
        {
          const int j = tt & 63, q = tt >> 6;
          const float cl = pw_[5], clm = q ? pw_[4] : 0.f; const float clq[4] = {pw_[0], pw_[1], pw_[2], pw_[3]};
#pragma unroll
          for (int e = 0; e < 4; ++e) { const int t = 4 * q + e; const float cprev = e == 0 ? clm : clq[e - 1], cc = clq[e];
              const float rr = pr_[e], kk = pk_[e], vv = pv_[e], aa = pa_[e], bb = pb_[e];
              XA[t * 65 + j] = aa * __expf(cprev); XR[t * 65 + j] = rr * __expf(cc); const float ei = __expf(-cc), ef = __expf(cl - cc);
              ZB[t * 65 + j] = bb * ei; ZK[t * 65 + j] = kk * ei; TB[t * 65 + j] = bb * ef; TK[t * 65 + j] = kk * ef; VV[t * 65 + j] = vv; }
          if (q == 0) ((float*)(rec + RC_P15))[j] = __expf(cl);
          { v2u gw; gw.x = pk2(pg_[0], pg_[1]); gw.y = pk2(pg_[2], pg_[3]); *(v2u*)(rec + RC_GF + (((j >> 4) * 64 + 16 * q + (j & 15)) * 8)) = gw; } }
        RC_FETCH(pair < 7 ? pair + 1 : 7);
        __syncthreads();
        {
          const int q = tt >> 6, n = tt & 15, g = (tt >> 4) & 3; const LAS float* X = (q & 2) ? XR : XA; const LAS float* Z = (q & 1) ? ZK : ZB; LAS float* O = q == 0 ? Aab : (q == 1 ? Aak : (q == 2 ? Arb : Ark));
          f32x4v c = (f32x4v){0.f, 0.f, 0.f, 0.f};
#pragma unroll
          for (int ks = 0; ks < 16; ++ks) c = __builtin_amdgcn_mfma_f32_16x16x4f32(X[n * 65 + 4 * ks + g], Z[n * 65 + 4 * ks + g], c, 0, 0, 0);
#pragma unroll
          for (int rr = 0; rr < 4; ++rr) { const int t = 4 * g + rr; O[t * 17 + n] = ((q & 2) ? n <= t : n < t) ? c[rr] : 0.f; }
          { const int t = tt >> 4, jq = tt & 15; const float* rkp = F.kin[I_RRK] + l * 1024 + h * 64 + 4 * jq; float bn = 0.f;
#pragma unroll
            for (int e = 0; e < 4; ++e) bn += XR[t * 65 + 4 * jq + e] * ZK[t * 65 + 4 * jq + e] * rkp[e];
            bn = sum16(bn); if (jq == 0) ((float*)(rec + RC_BN))[t] = bn; } }
        __syncthreads();
        {
          if (tt < 16) { float col[16];
#pragma unroll
              for (int t = 0; t < 16; ++t) { float acc = (t == tt) ? 1.f : 0.f;
#pragma unroll
                  for (int s = 0; s < 16; ++s) if (s < t) acc += Aab[t * 17 + s] * col[s];
                  col[t] = acc; TT[t * 17 + tt] = acc; } }
          const int q = tt >> 6, n = tt & 15, g = (tt >> 4) & 3; f32x4v c = (f32x4v){0.f, 0.f, 0.f, 0.f};
#pragma unroll
          for (int ks = 0; ks < 4; ++ks) c = __builtin_amdgcn_mfma_f32_16x16x4f32(Aak[n * 17 + 4 * ks + g], VV[(4 * ks + g) * 65 + 16 * q + n], c, 0, 0, 0);
#pragma unroll
          for (int rr = 0; rr < 4; ++rr) W1[(4 * g + rr) * 65 + 16 * q + n] = c[rr]; }
        __syncthreads();
        {
          const int q = tt >> 6, n = tt & 15, g = (tt >> 4) & 3; f32x4v ca = (f32x4v){0.f, 0.f, 0.f, 0.f}, cu = (f32x4v){0.f, 0.f, 0.f, 0.f};
#pragma unroll
          for (int ks = 0; ks < 4; ++ks) { const float tv = TT[n * 17 + 4 * ks + g]; ca = __builtin_amdgcn_mfma_f32_16x16x4f32(tv, XA[(4 * ks + g) * 65 + 16 * q + n], ca, 0, 0, 0); cu = __builtin_amdgcn_mfma_f32_16x16x4f32(tv, W1[(4 * ks + g) * 65 + 16 * q + n], cu, 0, 0, 0); }
#pragma unroll
          for (int rr = 0; rr < 4; ++rr) { ATl[(4 * g + rr) * 65 + 16 * q + n] = ca[rr]; U0l[(4 * g + rr) * 65 + 16 * q + n] = cu[rr]; }
          *(f32x4v*)(rec + RC_U0 + ((q * 64 + 16 * g + n) * 16)) = cu; }
        __syncthreads();
        {
          const int q = tt >> 6, n = tt & 15, g = (tt >> 4) & 3; f32x4v cr, cy = (f32x4v){0.f, 0.f, 0.f, 0.f};
#pragma unroll
          for (int rr = 0; rr < 4; ++rr) cr[rr] = XR[(4 * g + rr) * 65 + 16 * q + n];
#pragma unroll
          for (int ks = 0; ks < 4; ++ks) { const float arb = Arb[n * 17 + 4 * ks + g], ark = Ark[n * 17 + 4 * ks + g];
              cr = __builtin_amdgcn_mfma_f32_16x16x4f32(arb, ATl[(4 * ks + g) * 65 + 16 * q + n], cr, 0, 0, 0);
              cy = __builtin_amdgcn_mfma_f32_16x16x4f32(arb, U0l[(4 * ks + g) * 65 + 16 * q + n], cy, 0, 0, 0);
              cy = __builtin_amdgcn_mfma_f32_16x16x4f32(ark, VV[(4 * ks + g) * 65 + 16 * q + n], cy, 0, 0, 0); }
          *(f32x4v*)(rec + RC_Y0 + ((q * 64 + 16 * g + n) * 16)) = cy;
#pragma unroll
          for (int rr = 0; rr < 4; ++rr) W1[(4 * g + rr) * 65 + 16 * q + n] = cr[rr]; }
        __syncthreads();
        { const int t = tt & 15, jq = tt >> 4, kk = jq >> 3, half = (jq & 7) >> 2, g = jq & 3, j0 = 4 * jq;
          v2u wa, wr; wa.x = pk2(ATl[t * 65 + j0], ATl[t * 65 + j0 + 1]); wa.y = pk2(ATl[t * 65 + j0 + 2], ATl[t * 65 + j0 + 3]); wr.x = pk2(W1[t * 65 + j0], W1[t * 65 + j0 + 1]); wr.y = pk2(W1[t * 65 + j0 + 2], W1[t * 65 + j0 + 3]);
          *(v2u*)(rec + RC_AT + kk * 1024 + (16 * g + t) * 16 + half * 8) = wa; *(v2u*)(rec + RC_RT + kk * 1024 + (16 * g + t) * 16 + half * 8) = wr;
          const int j = tt & 63, gg = tt >> 6; v4u bk; bk.x = pk2(TB[(4 * gg) * 65 + j], TB[(4 * gg + 1) * 65 + j]); bk.y = pk2(TB[(4 * gg + 2) * 65 + j], TB[(4 * gg + 3) * 65 + j]);
          bk.z = pk2(TK[(4 * gg) * 65 + j], TK[(4 * gg + 1) * 65 + j]); bk.w = pk2(TK[(4 * gg + 2) * 65 + j], TK[(4 * gg + 3) * 65 + j]);
          *(v4u*)(rec + RC_BK + (j >> 4) * 1024 + (16 * gg + (j & 15)) * 16) = bk;
          v2u vf; vf.x = pk2(VV[(4 * gg) * 65 + j], VV[(4 * gg + 1) * 65 + j]); vf.y = pk2(VV[(4 * gg + 2) * 65 + j], VV[(4 * gg + 3) * 65 + j]);
          *(v2u*)(rec + RC_VF + ((j >> 4) * 64 + 16 * gg + (j & 15)) * 8) = vf; }
    }
}
#undef RC_FETCH
template <int HACK = 0> __device__ __forceinline__ void rwkv_scan_unit(Frame& F, int l, int b, int h) {
    LAS unsigned char* L = F.lds + RING_OFF;
    const unsigned char* recs = F.ws + WS_RWC + (size_t)(b * 16 + h) * RC_BYTES;
    const int lane = F.lane, n = lane & 15, g = lane >> 4;
    LAS float* XS = (LAS float*)(L + 2 * RC_BYTES);
    if (F.wave >= 2) {
        const int li = F.tid - 128;
        int px[4];
#pragma unroll
        for (int k = 0; k < 4; ++k) { const int x = li + 384 * k; px[k] = x < 1300 ? x : 1299; }
        v4u p0[4], p1[4], p2[4], p3[4], p4[4], p5[4], p6[4], p7[4];
#define RWL_ISSUE(P, CK) do { const int ck_ = (CK) < 512 ? ((HACK & 1) && (CK) >= 4 ? 3 : (CK)) : 511; const v4u* src_ = (const v4u*)(recs + (size_t)ck_ * 32 * RC_BYTES); \
        _Pragma("unroll") for (int k = 0; k < 4; ++k) P[k] = src_[px[k]]; } while (0)
#define RWL_WRITE(P, CK) do { LAS v4u* dst_ = (LAS v4u*)(L + ((CK) & 1) * RC_BYTES); _Pragma("unroll") for (int k = 0; k < 4; ++k) dst_[px[k]] = P[k]; } while (0)
        RWL_ISSUE(p0, 0); RWL_ISSUE(p1, 1); RWL_ISSUE(p2, 2); RWL_ISSUE(p3, 3); RWL_ISSUE(p4, 4); RWL_ISSUE(p5, 5); RWL_ISSUE(p6, 6); RWL_ISSUE(p7, 7);
        RWL_WRITE(p0, 0); RWL_ISSUE(p0, 8);
        LDS_BARRIER();
#pragma unroll 1
        for (int ck = 0; ck < 512; ck += 8) {
            RWL_WRITE(p1, ck + 1); RWL_ISSUE(p1, ck + 9); LDS_BARRIER();
            RWL_WRITE(p2, ck + 2); RWL_ISSUE(p2, ck + 10); LDS_BARRIER();
            RWL_WRITE(p3, ck + 3); RWL_ISSUE(p3, ck + 11); LDS_BARRIER();
            RWL_WRITE(p4, ck + 4); RWL_ISSUE(p4, ck + 12); LDS_BARRIER();
            RWL_WRITE(p5, ck + 5); RWL_ISSUE(p5, ck + 13); LDS_BARRIER();
            RWL_WRITE(p6, ck + 6); RWL_ISSUE(p6, ck + 14); LDS_BARRIER();
            RWL_WRITE(p7, ck + 7); RWL_ISSUE(p7, ck + 15); LDS_BARRIER();
            RWL_WRITE(p0, ck + 8); RWL_ISSUE(p0, ck + 16); LDS_BARRIER();
        }
#undef RWL_ISSUE
#undef RWL_WRITE
        return;
    }
    const int cw = F.wave;
    f32x4v S[4][2];
#pragma unroll
    for (int jt = 0; jt < 4; ++jt)
#pragma unroll
        for (int it = 0; it < 2; ++it) S[jt][it] = (f32x4v){0.f, 0.f, 0.f, 0.f};
    float lnw[2], lnb[2];
#pragma unroll
    for (int it = 0; it < 2; ++it) { lnw[it] = F.kin[I_RLNW][l * 1024 + h * 64 + 16 * (2 * cw + it) + n]; lnb[it] = F.kin[I_RLNB][l * 1024 + h * 64 + 16 * (2 * cw + it) + n]; }
    bf16* MIX = WSP(bf16, WS_MIXED) + ((size_t)b * SEQ) * DM + 2048 + h * 64 + 32 * cw + n;
    f32x4v Yp[2] = {(f32x4v){0.f, 0.f, 0.f, 0.f}, (f32x4v){0.f, 0.f, 0.f, 0.f}}, bnp = (f32x4v){0.f, 0.f, 0.f, 0.f}; v2u gfp[2] = {(v2u){0u, 0u}, (v2u){0u, 0u}}, vfp[2] = {(v2u){0u, 0u}, (v2u){0u, 0u}};
    LDS_BARRIER();
#pragma unroll 1
    for (int ck = 0; ck <= 512; ++ck) {
        if (ck > 0) {
            const LAS float* xs = XS + ((ck - 1) & 1) * 64; const f32x4v a0 = *(const LAS f32x4v*)(xs + 8 * g), a1 = *(const LAS f32x4v*)(xs + 8 * g + 4), b0 = *(const LAS f32x4v*)(xs + 32 + 8 * g), b1 = *(const LAS f32x4v*)(xs + 32 + 8 * g + 4);
            const float s1[4] = {a0[0] + b0[0], a0[2] + b0[2], a1[0] + b1[0], a1[2] + b1[2]}, s2[4] = {a0[1] + b0[1], a0[3] + b0[3], a1[1] + b1[1], a1[3] + b1[3]};
#pragma unroll
            for (int it = 0; it < 2; ++it) { const float gt[4] = {bflo(gfp[it].x), bfhi(gfp[it].x), bflo(gfp[it].y), bfhi(gfp[it].y)}, vt[4] = {bflo(vfp[it].x), bfhi(vfp[it].x), bflo(vfp[it].y), bfhi(vfp[it].y)};
#pragma unroll
                for (int r = 0; r < 4; ++r) { const float mean = s1[r] * (1.0f / 64.0f), var = fmaxf(s2[r] * (1.0f / 64.0f) - mean * mean, 0.f), rstd = rsqrtf(var + 64e-5f);
                    if (!(HACK & 2)) MIX[(size_t)((ck - 1) * 16 + 4 * g + r) * DM + 16 * it] = (bf16)f2bf(((Yp[it][r] - mean) * rstd * lnw[it] + lnb[it] + bnp[r] * vt[r]) * gt[r]); } }
            if (ck == 512) break;
        }
        if (HACK & 4) { LDS_BARRIER(); continue; }
        const LAS unsigned char* R = L + (ck & 1) * RC_BYTES;
        bf16x8 at[2], rt[2];
#pragma unroll
        for (int kk = 0; kk < 2; ++kk) { at[kk] = *(const LAS bf16x8*)(R + RC_AT + kk * 1024 + lane * 16); rt[kk] = *(const LAS bf16x8*)(R + RC_RT + kk * 1024 + lane * 16); }
        f32x4v U[2], Y[2];
#pragma unroll
        for (int it = 0; it < 2; ++it) { U[it] = *(const LAS f32x4v*)(R + RC_U0 + (2 * cw + it) * 1024 + lane * 16); Y[it] = *(const LAS f32x4v*)(R + RC_Y0 + (2 * cw + it) * 1024 + lane * 16); }
#pragma unroll
        for (int kk = 0; kk < 2; ++kk)
#pragma unroll
            for (int it = 0; it < 2; ++it) { v4u pw; pw.x = pg8::cvt_pk_bf16(S[2 * kk][it][0], S[2 * kk][it][1]); pw.y = pg8::cvt_pk_bf16(S[2 * kk][it][2], S[2 * kk][it][3]);
                pw.z = pg8::cvt_pk_bf16(S[2 * kk + 1][it][0], S[2 * kk + 1][it][1]); pw.w = pg8::cvt_pk_bf16(S[2 * kk + 1][it][2], S[2 * kk + 1][it][3]); const bf16x8 sf = __builtin_bit_cast(bf16x8, pw);
                U[it] = __builtin_amdgcn_mfma_f32_16x16x32_bf16(at[kk], sf, U[it], 0, 0, 0); Y[it] = __builtin_amdgcn_mfma_f32_16x16x32_bf16(rt[kk], sf, Y[it], 0, 0, 0); }
        bf16x8 uv[2];
#pragma unroll
        for (int it = 0; it < 2; ++it) { vfp[it] = *(const LAS v2u*)(R + RC_VF + (2 * cw + it) * 512 + lane * 8); gfp[it] = *(const LAS v2u*)(R + RC_GF + (2 * cw + it) * 512 + lane * 8);
            v4u pw; pw.x = pg8::cvt_pk_bf16(U[it][0], U[it][1]); pw.y = pg8::cvt_pk_bf16(U[it][2], U[it][3]); pw.z = vfp[it].x; pw.w = vfp[it].y; uv[it] = __builtin_bit_cast(bf16x8, pw); }
#pragma unroll
        for (int jt = 0; jt < 4; ++jt) { const bf16x8 bk = *(const LAS bf16x8*)(R + RC_BK + jt * 1024 + lane * 16); const f32x4v p15 = *(const LAS f32x4v*)(R + RC_P15 + (16 * jt + 4 * g) * 4);
#pragma unroll
            for (int it = 0; it < 2; ++it) S[jt][it] = __builtin_amdgcn_mfma_f32_16x16x32_bf16(bk, uv[it], S[jt][it] * p15, 0, 0, 0); }
        bnp = *(const LAS f32x4v*)(R + RC_BN + 16 * g); Yp[0] = Y[0]; Yp[1] = Y[1];
        { LAS float* xo = XS + (ck & 1) * 64 + cw * 32; const f32x4v sm = Y[0] + Y[1], sq = Y[0] * Y[0] + Y[1] * Y[1];
#pragma unroll
          for (int r = 0; r < 4; ++r) { const float a = sum16(sm[r]), q = sum16(sq[r]); if (n == 0) { xo[(4 * g + r) * 2] = a; xo[(4 * g + r) * 2 + 1] = q; } } }
        LDS_BARRIER();
    }
}
template <int HACK = 0> __device__ __forceinline__ void mixers_v4(Frame& F, int l, int qi, int mask = 15) {
    gu32* ctr = F.ctl + CW_Q + 64 * qi;
    for (;;) {
        const int it = next_item(F, ctr); relaunder(F); relaunder_tid(F);
        if (it < 32) { if (mask & 1) rwkv_scan_unit<HACK>(F, l, it >> 4, it & 15); }
        else if (it < 48) { const int j = it - 32; if (mask & 2) gla_scan_unit<HACK>(F, l, j >> 3, (j >> 1) & 3, j & 1); }
        else if (it < 48 + 1024) { const int j = it - 48, qb = 63 - (j >> 4), bh = j & 15; if (mask & 4) attn_unit<true>(F, l, bh >> 3, bh & 7, qb); }
        else if (it < 48 + 2048) { const int j = it - 1072, qb = j & 63, bh = j >> 6; if (mask & 8) attn_unit<false>(F, l, bh >> 3, bh & 7, qb); }
        else break;
    }
}
template <int HACK = 0> __device__ __forceinline__ void prep_rwkv(Frame& F, int l) {
    LAS float* zl = (LAS float*)(F.lds + RING_OFF) + 4096;
    LAS float* in = (LAS float*)(F.lds + RING_OFF);
    const float* mu = F.kin[I_RMU] + (size_t)l * 3264;
    const float* LOWR = WSP(float, WS_LOWR); const bf16* COLS = WSP(bf16, WS_COLS);
    float* RW = WSP(float, WS_RW); unsigned* RWU = WSP(unsigned, WS_RW); float* VF = WSP(float, WS_VFIRST);
    constexpr size_t RS = RW_ONE / 4;
    for (int tile = F.bx; tile < M / 16; tile += F.G) {
        const int row0 = tile * 16;
        relaunder(F); relaunder_tid(F);
        __syncthreads();
        for (int idx = F.tid; idx < 16 * 224; idx += NWAVES * 64) { const int tt = idx / 224, j = idx % 224, row = row0 + tt, t = row & (SEQ - 1);
            const int col = j < 192 ? 16 + j : 208 + (j - 192);
            const float cur = LOWR[(size_t)row * 256 + col], prev = t > 0 ? LOWR[(size_t)(row - 1) * 256 + col] : 0.f;
            const float muv = j < 192 ? mu[3072 + j] : (l ? F.kin[I_VRMU][(l - 1) * 32 + (j - 192)] : 0.f);
            float x = cur + (prev - cur) * muv;
            if (j < 64) x = tanhf(x); else if (j >= 128 && j < 192) x = sigmoid_f(x);
            in[j * 16 + tt] = x; }
        __syncthreads();
        {
            const int c = 2 * F.tid;
            float accw[2][16], acca[2][16], accg[2][16], accv[2][16];
#pragma unroll
            for (int e = 0; e < 2; ++e) { const float bw = F.kin[I_RW0][l * 1024 + c + e], ba = F.kin[I_RA0][l * 1024 + c + e], bv = l ? F.kin[I_VR0][(l - 1) * 1024 + c + e] : 0.f;
#pragma unroll
              for (int tt = 0; tt < 16; ++tt) { accw[e][tt] = bw; acca[e][tt] = ba; accg[e][tt] = 0.f; accv[e][tt] = bv; } }
#define LOWRANK_MFMA(ACC, WPTR, JOFF, NJ) do { const float* wq_ = (WPTR) + 128 * F.wave + (F.lane & 15) + (size_t)(F.lane >> 4) * 1024; \
            _Pragma("unroll 2") for (int nt = 0; nt < 8; ++nt) { f32x4 c4 = {0.f, 0.f, 0.f, 0.f}; \
                _Pragma("unroll") for (int ks = 0; ks < (NJ) / 4; ++ks) c4 = __builtin_amdgcn_mfma_f32_16x16x4f32(in[((JOFF) + 4 * ks + (F.lane >> 4)) * 16 + (F.lane & 15)], wq_[(size_t)ks * 4096 + 16 * nt], c4, 0, 0, 0); \
                _Pragma("unroll") for (int rr = 0; rr < 4; ++rr) zl[(4 * (F.lane >> 4) + rr) * 1028 + 128 * F.wave + 16 * nt + (F.lane & 15)] = c4[rr]; } \
            __syncthreads(); \
            _Pragma("unroll") for (int tt = 0; tt < 16; ++tt) { const f32x2_t z2 = *(const LAS f32x2_t*)(zl + tt * 1028 + c); ACC[0][tt] += z2.x; ACC[1][tt] += z2.y; } \
            __syncthreads(); } while (0)
            if (!(HACK & 1)) { LOWRANK_MFMA(accw, F.kin[I_RWUP] + (size_t)l * 64 * 1024, 0, 64); relaunder(F);
            LOWRANK_MFMA(acca, F.kin[I_RAUP] + (size_t)l * 64 * 1024, 64, 64); relaunder(F);
            LOWRANK_MFMA(accg, F.kin[I_RGUP] + (size_t)l * 64 * 1024, 128, 64); relaunder(F);
            if (l) LOWRANK_MFMA(accv, F.kin[I_VRUP] + (size_t)(l - 1) * 32 * 1024, 192, 32); }
#undef LOWRANK_MFMA
            relaunder(F);
            float mur[2], muk[2], muv[2], kkv[2], kav[2], pr[2] = {0.f, 0.f}, pk[2] = {0.f, 0.f}, pv[2] = {0.f, 0.f}; float cl[2] = {0.f, 0.f};
#pragma unroll
            for (int e = 0; e < 2; ++e) { mur[e] = F.kin[I_RMU][l * 3264 + c + e]; muk[e] = F.kin[I_RMU][l * 3264 + 1024 + c + e]; muv[e] = F.kin[I_RMU][l * 3264 + 2048 + c + e]; kkv[e] = F.kin[I_RKK][l * 1024 + c + e]; kav[e] = F.kin[I_RKA][l * 1024 + c + e]; }
            if ((row0 & (SEQ - 1)) != 0) { const bf16* p = COLS + (size_t)(row0 - 1) * NMAIN + c; const unsigned ur = *(const unsigned*)(p + CC_R), uk = *(const unsigned*)(p + CC_K), uv = *(const unsigned*)(p + CC_V);
                pr[0] = bflo(ur); pr[1] = bfhi(ur); pk[0] = bflo(uk); pk[1] = bfhi(uk); pv[0] = bflo(uv); pv[1] = bfhi(uv); }
            if (!(HACK & 4))
#pragma unroll
            for (int tt = 0; tt < 16; ++tt) { const int row = row0 + tt; const bf16* p = COLS + (size_t)row * NMAIN + c; const size_t o = (size_t)row * 1024 + c;
                const unsigned ur = *(const unsigned*)(p + CC_R), uk = *(const unsigned*)(p + CC_K), uv = *(const unsigned*)(p + CC_V);
                const float cr[2] = {bflo(ur), bfhi(ur)}, ck[2] = {bflo(uk), bfhi(uk)}, cv[2] = {bflo(uv), bfhi(uv)};
                f32x2_t vf2 = {0.f, 0.f}; if (l != 0) vf2 = *(const f32x2_t*)(VF + o);
                float r[2], k[2], v[2], dec[2], av[2], kk[2], km[2];
#pragma unroll
                for (int e = 0; e < 2; ++e) { r[e] = cr[e] + (pr[e] - cr[e]) * mur[e]; k[e] = ck[e] + (pk[e] - ck[e]) * muk[e]; v[e] = cv[e] + (pv[e] - cv[e]) * muv[e]; pr[e] = cr[e]; pk[e] = ck[e]; pv[e] = cv[e];
                    if (l == 0) vf2[e] = v[e]; else { const float vg = sigmoid_f(accv[e][tt]); v[e] = v[e] + (vf2[e] - v[e]) * vg; }
                    cl[e] += -0.6065306597126334f * sigmoid_f(accw[e][tt]); dec[e] = cl[e]; av[e] = sigmoid_f(acca[e][tt]); kk[e] = k[e] * kkv[e]; km[e] = k[e] * (1.0f + (av[e] - 1.0f) * kav[e]); }
                const float ss = sum32(kk[0] * kk[0] + kk[1] * kk[1]), rn = rsqrtf(fmaxf(ss, 1e-24f)); kk[0] *= rn; kk[1] *= rn;
                if (l == 0) *(f32x2_t*)(VF + o) = vf2;
                *(f32x2_t*)(RW + RS + o) = (f32x2_t){dec[0], dec[1]};
                *(v2u*)(RWU + o) = (v2u){pk2(r[0], km[0]), pk2(r[1], km[1])}; *(v2u*)(RWU + 2 * RS + o) = (v2u){pk2(v[0], accg[0][tt]), pk2(v[1], accg[1][tt])};
                *(v2u*)(RWU + 3 * RS + o) = (v2u){pk2(-kk[0], kk[0] * av[0]), pk2(-kk[1], kk[1] * av[1])}; }
        }
        asm volatile("s_waitcnt vmcnt(0)" ::: "memory"); __syncthreads();
        __builtin_amdgcn_fence(__ATOMIC_ACQUIRE, "agent"); asm volatile("s_waitcnt vmcnt(0)" ::: "memory");
        if (!(HACK & 2)) rwkv_chunks_of_tile(F, l, tile);
    }
}
struct Args { const float* in[35]; float* out; unsigned char* ws; };
__device__ __forceinline__ void mk_frame(Frame& F, int wv) {
    extern __shared__ __attribute__((aligned(16))) unsigned char lds[];
    kargp kp = (kargp)__builtin_amdgcn_kernarg_segment_ptr(); asm volatile("" : "+s"(kp));
    F.kin = kp;
    F.lds = (LAS unsigned char*)lds;
    F.MISC = (volatile LAS unsigned*)(F.lds + MISC_OFF);
    { int w_ = wv; asm volatile("" : "+s"(w_)); int t_ = (int)__builtin_amdgcn_mbcnt_hi(~0u, __builtin_amdgcn_mbcnt_lo(~0u, (unsigned)w_ * 64u)); asm volatile("" : "+v"(t_)); F.tid = t_; } F.lane = F.tid & 63; F.wave = __builtin_amdgcn_readfirstlane(F.tid >> 6);
    F.G = gridDim.x; { int bx = blockIdx.x; asm volatile("" : "+s"(bx)); F.bx = bx; F.vcu = (F.G % 8 == 0) ? (bx % 8) * (F.G / 8) + bx / 8 : bx; }
    F.out = (float*)kp[35]; F.ws = (unsigned char*)kp[36]; F.ctl = (gu32*)(F.ws + WS_CTL);
}
__device__ __forceinline__ void grid_bar(int wv) {
    Frame F; mk_frame(F, wv);
    XcdBarrier bar; bar.bar = (unsigned*)(F.ctl + CW_BAR); bar.x = xb_xcc_id(); bar.st = F.MISC + 8;
    xcd_barrier(bar);
}
__global__ void __launch_bounds__(NWAVES * 64, 2) mega_fwd(Args args) {
    const int wv = __builtin_amdgcn_readfirstlane((int)threadIdx.x >> 6);
    { Frame F; mk_frame(F, wv);
      for (int u = F.tid; u < (LDS_BYTES - LDSCTL_OFF) / 4; u += NWAVES * 64) ((LAS unsigned*)(F.lds + LDSCTL_OFF))[u] = 0u;
      __syncthreads();
      (void)xcd_barrier_post((unsigned*)(F.ctl + CW_BAR), F.MISC + 8);
      p0_prologue_a(F);
    }
    grid_bar(wv);
    { Frame F; mk_frame(F, wv); p0_prologue_b(F); }
    grid_bar(wv);
#pragma unroll 1
    for (int l = 0; l < NLAYER; ++l) {
#define LAYER_VARS const float* mod = WSP(float, WS_MOD) + (size_t)l * 2 * 24576; const float* xin = l == 0 ? F.kin[I_X] : F.out; (void)mod; (void)xin
        { Frame F; mk_frame(F, wv); LAYER_VARS; rms_phase(F, xin, mod + 0, mod + 4096); }
        grid_bar(wv);
        { Frame F; mk_frame(F, wv);
          pg8::Gemm g{WSP(pg8::bf16_t, WS_XN), WSP(pg8::bf16_t, WS_WIN + l * WIN_L), M, NIN, DM}; pg8::StaticOrder S; S.init(M, NIN, F.G, F.bx);
          pg8::EpiCols E{WSP(pg8::bf16_t, WS_COLS), WSP(float, WS_LOWR)};
          pg8::gemm_phase<pg8::EpiCols, pg8::StaticOrder, true, true>(F.lds + RING_OFF, g, S, E, F.tid); }
        grid_bar(wv);
        { Frame F; mk_frame(F, wv); prep_norm(F, l); }
        { Frame F; mk_frame(F, wv); prep_loga(F, l); }
        { Frame F; mk_frame(F, wv); prep_rwkv(F, l); }
        { Frame F; mk_frame(F, wv); prep_vt(F, 0); }
        { Frame F; mk_frame(F, wv); prep_vt(F, 1); }
        { Frame F; mk_frame(F, wv); prep_gla(F); }
        grid_bar(wv);
        { Frame F; mk_frame(F, wv); mixers_v4(F, l, l); }
        grid_bar(wv);
        { Frame F; mk_frame(F, wv); gla_post(F, l); }
        grid_bar(wv);
        { Frame F; mk_frame(F, wv); LAYER_VARS;
          pg8::Gemm g{WSP(pg8::bf16_t, WS_MIXED), WSP(pg8::bf16_t, WS_WOUT + l * WOUT_L), M, DM, DM}; pg8::StaticOrder S; S.init(M, DM, F.G, F.bx);
          pg8::EpiRes E{xin, F.out, mod + 2 * 4096};
          pg8::gemm_phase<pg8::EpiRes, pg8::StaticOrder, true, true>(F.lds + RING_OFF, g, S, E, F.tid); }
        grid_bar(wv);
        { Frame F; mk_frame(F, wv); LAYER_VARS; rms_phase(F, F.out, mod + 3 * 4096, mod + 4 * 4096); }
        grid_bar(wv);
        { Frame F; mk_frame(F, wv);
          pg8::Gemm g{WSP(pg8::bf16_t, WS_XN), WSP(pg8::bf16_t, WS_W13 + l * W13_L), M, 2 * DFF, DM}; pg8::StaticOrder S; S.init(M, 2 * DFF, F.G, F.bx);
          pg8::EpiSwiglu E{WSP(pg8::bf16_t, WS_HID)};
          pg8::gemm_phase<pg8::EpiSwiglu, pg8::StaticOrder, true, true>(F.lds + RING_OFF, g, S, E, F.tid); }
        grid_bar(wv);
        { Frame F; mk_frame(F, wv); LAYER_VARS;
          pg8::Gemm g{WSP(pg8::bf16_t, WS_HID), WSP(pg8::bf16_t, WS_W2 + l * W2_L), M, DM, DFF}; pg8::StaticOrder S; S.init(M, DM, F.G, F.bx);
          pg8::EpiRes E{F.out, F.out, mod + 5 * 4096};
          pg8::gemm_phase<pg8::EpiRes, pg8::StaticOrder, true, true>(F.lds + RING_OFF, g, S, E, F.tid); }
        if (l + 1 < NLAYER) grid_bar(wv);
#undef LAYER_VARS
    }
}

extern "C" void kernel_launch(void* const* d_in, const int* in_sizes, int n_in, void* d_out, int out_size, void* d_ws, size_t ws_size, hipStream_t stream) {
    static int grid = 0;
    if (grid == 0) {
        if (n_in != 35 || in_sizes[0] != M * DM || out_size != M * DM || ws_size < WS_END) { fprintf(stderr, "kernel_launch: unexpected shapes: n_in %d in0 %d out %d ws %zu (need %zu)\n", n_in, n_in > 0 ? in_sizes[0] : -1, out_size, ws_size, (size_t)WS_END); grid = -1; return; }
        int dev = 0, cus = 0, per_cu = 0;
        if (hipGetDevice(&dev) != hipSuccess || hipDeviceGetAttribute(&cus, hipDeviceAttributeMultiprocessorCount, dev) != hipSuccess) { grid = -1; return; }
        if (hipFuncSetAttribute((const void*)mega_fwd, hipFuncAttributeMaxDynamicSharedMemorySize, LDS_BYTES) != hipSuccess) { fprintf(stderr, "kernel_launch: hipFuncSetAttribute failed\n"); grid = -1; return; }
        if (hipOccupancyMaxActiveBlocksPerMultiprocessor(&per_cu, (const void*)mega_fwd, NWAVES * 64, LDS_BYTES) != hipSuccess || per_cu < 1) fprintf(stderr, "kernel_launch: occupancy query says %d\n", per_cu);
        (void)hipGetLastError();
        grid = cus;
    }
    if (grid < 0) return;
    if (hipMemsetAsync((char*)d_ws + WS_CTL, 0, CTL_ZERO_BYTES, stream) != hipSuccess) return;
    Args a{};
    for (int i = 0; i < 35; ++i) a.in[i] = (const float*)d_in[i];
    a.out = (float*)d_out; a.ws = (unsigned char*)d_ws;
    hipLaunchKernelGGL(mega_fwd, dim3(grid), dim3(NWAVES * 64), LDS_BYTES, stream, a);
}
```

```cpp
#include <hip/hip_runtime.h>
#include <cstdio>
#include <cstdint>
namespace pg8 {
#define PG8_LAS __attribute__((address_space(3)))
typedef unsigned short bf16_t;
typedef short bf16x8 __attribute__((ext_vector_type(8)));
typedef float f32x4 __attribute__((ext_vector_type(4)));
typedef unsigned u32x4 __attribute__((ext_vector_type(4)));
constexpr int BM = 256, BK = 64, HALF = 128, HTB = HALF * BK * 2  , STAGE_BYTES = 8 * HTB, NXCD = 8, WGM = 8;

__host__ __device__ __forceinline__ int lds_byte(int r, int c) { const int st = (r >> 4) * 2 + (c >> 5), rr = r & 15, cc = c & 31, ob = rr * 64 + cc * 2; return st * 1024 + (ob ^ (((ob >> 9) & 1) << 5)); }
__host__ __device__ __forceinline__ void stage_rc(int b, int& R, int& C) { const int st = b / 1024, sb = b % 1024, swz = sb ^ (((sb >> 9) & 1) << 5); R = (st >> 1) * 16 + swz / 64; C = (st & 1) * 32 + (swz % 64) / 2; }
__host__ __device__ __forceinline__ int perm32(int rho) { const int n = rho >> 4, i = rho & 15; return 8 * (i >> 2) + 4 * n + (i & 3); }

struct Unit { int pm, pn; };
struct Gemm { const bf16_t* A; const bf16_t* Bt; int M, N, K; };

struct StaticOrder {
    int nM, nN, nwg, G, c;
    __host__ __device__ void init(int M, int N, int G_, int c_) { nM = M / BM; nN = N / BM; nwg = nM * nN; G = G_; c = c_; }
    __host__ __device__ bool next(int i, Unit& u) const {
        const long L = (long)i * G + c; if (L >= nwg) return false;
        int wgid = (int)L; { const int q = nwg / NXCD, r = nwg % NXCD, xcd = wgid % NXCD, off = wgid / NXCD; wgid = (xcd < r ? xcd * (q + 1) : r * (q + 1) + (xcd - r) * q) + off; }
        const int nig = WGM * nN, gid = wgid / nig, fm = gid * WGM, gsz = (nM - fm) < WGM ? (nM - fm) : WGM;
        u.pm = fm + ((wgid % nig) % gsz); u.pn = (wgid % nig) / gsz; return true;
    }
    __device__ __forceinline__ void a_ready(const Unit&) const {}
    __device__ __forceinline__ void done(const Unit&) const {}
};

typedef float f32x2c_t __attribute__((ext_vector_type(2))); typedef __bf16 bf16x2c_t __attribute__((ext_vector_type(2)));
__device__ __forceinline__ unsigned cvt_pk_bf16(float lo, float hi) { const f32x2c_t v = {lo, hi}; return __builtin_bit_cast(unsigned, __builtin_convertvector(v, bf16x2c_t)); }
typedef float f32x2 __attribute__((ext_vector_type(2)));
__device__ __forceinline__ float silu_f(float x) { return x * __builtin_amdgcn_rcpf(1.0f + __builtin_amdgcn_exp2f(-1.4426950408889634f * x)); }
struct EpiCols {
    static constexpr bool PERM = true, AFTER_DRAIN = false;
    bf16_t* O; float* L;
    __device__ __forceinline__ void operator()(const f32x4 (&acc)[2][2][4][2], const Unit& u, int wr, int wc, int fr, int fq) const {
        const int row0 = u.pm * BM + wr * 64 + fr;
        if (u.pn < 41) {
            const int col0 = u.pn * BM + wc * 32 + 8 * fq;
#pragma unroll
            for (int ai = 0; ai < 2; ++ai)
#pragma unroll
                for (int m = 0; m < 4; ++m) { bf16_t* rowp = O + (size_t)(row0 + ai * HALF + m * 16) * 10496 + col0;
#pragma unroll
                    for (int bj = 0; bj < 2; ++bj) { const f32x4 v0 = acc[ai][bj][m][0], v1 = acc[ai][bj][m][1];
                        u32x4 w; w.x = cvt_pk_bf16(v0[0], v0[1]); w.y = cvt_pk_bf16(v0[2], v0[3]); w.z = cvt_pk_bf16(v1[0], v1[1]); w.w = cvt_pk_bf16(v1[2], v1[3]);
                        *(u32x4*)(rowp + bj * HALF) = w; } }
        } else {
            const int col0 = wc * 32 + 8 * fq;
#pragma unroll
            for (int ai = 0; ai < 2; ++ai)
#pragma unroll
                for (int m = 0; m < 4; ++m) { float* rowp = L + (size_t)(row0 + ai * HALF + m * 16) * 256 + col0;
#pragma unroll
                    for (int bj = 0; bj < 2; ++bj) { *(f32x4*)(rowp + bj * HALF) = acc[ai][bj][m][0]; *(f32x4*)(rowp + bj * HALF + 4) = acc[ai][bj][m][1]; } }
        }
    }
};
struct EpiRes {
    static constexpr bool PERM = false, AFTER_DRAIN = false;
    const float* base; float* out; const float* gate;
    __device__ __forceinline__ void operator()(const f32x4 (&acc)[2][2][4][2], const Unit& u, int wr, int wc, int fr, int fq) const {
        const int row0 = u.pm * BM + wr * 64 + fr, col0 = u.pn * BM + wc * 32 + 4 * fq;
        const float* gp = gate + (size_t)(u.pm >> 5) * 24576 + col0;
        f32x4 gv[2][2];
#pragma unroll
        for (int bj = 0; bj < 2; ++bj)
#pragma unroll
            for (int n = 0; n < 2; ++n) gv[bj][n] = *(const f32x4*)(gp + bj * HALF + n * 16);
#pragma unroll
        for (int ai = 0; ai < 2; ++ai)
#pragma unroll
            for (int m = 0; m < 4; ++m) { const size_t off = (size_t)(row0 + ai * HALF + m * 16) * 4096 + col0;
#pragma unroll
                for (int bj = 0; bj < 2; ++bj)
#pragma unroll
                    for (int n = 0; n < 2; ++n) { const f32x4 bs = *(const f32x4*)(base + off + bj * HALF + n * 16); *(f32x4*)(out + off + bj * HALF + n * 16) = bs + gv[bj][n] * acc[ai][bj][m][n]; }
                if (m == 3) asm volatile("" ::: "memory"); }
    }
};
struct EpiSwiglu {
    static constexpr bool PERM = true, AFTER_DRAIN = false;
    bf16_t* H;
    __device__ __forceinline__ void operator()(const f32x4 (&acc)[2][2][4][2], const Unit& u, int wr, int wc, int fr, int fq) const {
        const int row0 = u.pm * BM + wr * 64 + fr, col0 = u.pn * HALF + wc * 32 + 8 * fq;
#pragma unroll
        for (int ai = 0; ai < 2; ++ai)
#pragma unroll
            for (int m = 0; m < 4; ++m) { bf16_t* rowp = H + (size_t)(row0 + ai * HALF + m * 16) * 11008 + col0;
                const f32x4 a0 = acc[ai][0][m][0], a1 = acc[ai][0][m][1], b0 = acc[ai][1][m][0], b1 = acc[ai][1][m][1];
                u32x4 w; w.x = cvt_pk_bf16(silu_f(a0[0]) * b0[0], silu_f(a0[1]) * b0[1]); w.y = cvt_pk_bf16(silu_f(a0[2]) * b0[2], silu_f(a0[3]) * b0[3]);
                w.z = cvt_pk_bf16(silu_f(a1[0]) * b1[0], silu_f(a1[1]) * b1[1]); w.w = cvt_pk_bf16(silu_f(a1[2]) * b1[2], silu_f(a1[3]) * b1[3]);
                *(u32x4*)rowp = w; }
    }
};
template <class Epi, class Sched, bool ALIGN_EPI = false, bool SP2 = false>
__device__ __forceinline__ void gemm_phase(PG8_LAS unsigned char* lds, const Gemm g, const Sched& S, const Epi& E, int tid_in) {
    int tid_ = tid_in; asm volatile("" : "+v"(tid_));
    const int tid = tid_, wid = __builtin_amdgcn_readfirstlane(tid >> 6), lane = tid & 63, wr = wid >> 2, wc = wid & 3, fr = lane & 15, fq = lane >> 4;
    const int K = g.K, nt = K / BK;
    unsigned voffA[2], voffB[2];
#pragma unroll
    for (int i = 0; i < 2; ++i) { int R, C; stage_rc(tid * 16 + i * 8192, R, C); const int Rb = Epi::PERM ? ((R & ~31) + perm32(R & 31)) : R;
        voffA[i] = (unsigned)(R * K + C) * 2u; voffB[i] = (unsigned)(Rb * K + C) * 2u; }
    const size_t kstep = (size_t)(BK * 2);
    const size_t hstep = (size_t)HALF * K * 2;
    const size_t tstep = 2 * hstep;
    const unsigned ldsw = (unsigned)wid * 1024u;
    const int aoff = lds_byte(wr * 64 + fr, fq * 8), boff = lds_byte(wc * 32 + fr, fq * 8);
#define PG8_SA(b, h) (((b) * 2 + (h)) * HTB)
#define PG8_SB(b, h) ((4 + (b) * 2 + (h)) * HTB)
#define PG8_STAGE(bufoff, gbase, voff) do { _Pragma("unroll") for (int _i = 0; _i < 2; ++_i) \
        __builtin_amdgcn_global_load_lds((const unsigned*)((const char*)(gbase) + (voff)[_i]), (PG8_LAS unsigned*)(lds + (bufoff) + ldsw + _i * 8192), 16, 0, 0); } while (0)
#define PG8_LDA(dst, b, h) do { _Pragma("unroll") for (int m = 0; m < 4; ++m) _Pragma("unroll") for (int k = 0; k < 2; ++k) dst[m][k] = *(const PG8_LAS bf16x8*)(lds + PG8_SA(b, h) + aoff + m * 2048 + k * 1024); } while (0)
#define PG8_LDB(dst, b, h) do { _Pragma("unroll") for (int n = 0; n < 2; ++n) _Pragma("unroll") for (int k = 0; k < 2; ++k) dst[n][k] = *(const PG8_LAS bf16x8*)(lds + PG8_SB(b, h) + boff + n * 2048 + k * 1024); } while (0)
#define PG8_MMA(ai, bj, At, Bt) do { __builtin_amdgcn_s_setprio(1); _Pragma("unroll") for (int m = 0; m < 4; ++m) _Pragma("unroll") for (int n = 0; n < 2; ++n) _Pragma("unroll") for (int k = 0; k < 2; ++k) \
        acc[ai][bj][m][n] = __builtin_amdgcn_mfma_f32_16x16x32_bf16(Bt[n][k], At[m][k], acc[ai][bj][m][n], 0, 0, 0); __builtin_amdgcn_s_setprio(0); } while (0)
#define PG8_WAIT_V(n) asm volatile("s_waitcnt vmcnt(" #n ")" ::: "memory")
#define PG8_WAIT_L(n) asm volatile("s_waitcnt lgkmcnt(" #n ")" ::: "memory")
#define PG8_BAR __builtin_amdgcn_s_barrier()
#define PG8_SCHED __builtin_amdgcn_sched_barrier(0)
    Unit cur, nxt; int ui = 0;
    if (!S.next(0, cur)) return;
    f32x4 acc[2][2][4][2];
#pragma unroll
    for (int a = 0; a < 2; ++a)
#pragma unroll
        for (int b = 0; b < 2; ++b)
#pragma unroll
            for (int m = 0; m < 4; ++m)
#pragma unroll
                for (int n = 0; n < 2; ++n) acc[a][b][m][n] = (f32x4){0.f, 0.f, 0.f, 0.f};
    bf16x8 At[4][2], B0[2][2], B1[2][2];
    const char* cA = (const char*)g.A + (size_t)cur.pm * tstep; const char* cB = (const char*)g.Bt + (size_t)cur.pn * tstep;
    S.a_ready(cur);
    if constexpr (SP2) {
        PG8_STAGE(PG8_SB(0, 0), cB, voffB); PG8_STAGE(PG8_SB(0, 1), cB + hstep, voffB); PG8_STAGE(PG8_SA(0, 0), cA, voffA); PG8_STAGE(PG8_SA(0, 1), cA + hstep, voffA);
        if (wr == 1) PG8_BAR;
        PG8_WAIT_V(2); PG8_BAR;
        PG8_STAGE(PG8_SB(1, 0), cB + kstep, voffB); PG8_STAGE(PG8_SA(1, 0), cA + kstep, voffA); PG8_STAGE(PG8_SB(1, 1), cB + hstep + kstep, voffB);
        PG8_WAIT_V(6); PG8_BAR;
    } else {
        PG8_STAGE(PG8_SB(0, 0), cB, voffB); PG8_STAGE(PG8_SA(0, 0), cA, voffA); PG8_STAGE(PG8_SB(0, 1), cB + hstep, voffB); PG8_STAGE(PG8_SA(0, 1), cA + hstep, voffA);
        if (wr == 1) PG8_BAR;
        PG8_WAIT_V(4); PG8_BAR;
        PG8_STAGE(PG8_SB(1, 0), cB + kstep, voffB); PG8_STAGE(PG8_SA(1, 0), cA + kstep, voffA); PG8_STAGE(PG8_SB(1, 1), cB + hstep + kstep, voffB);
        PG8_WAIT_V(6); PG8_BAR;
    }
    for (;;) {
        const bool has_next = S.next(ui + 1, nxt);
        const char* nA = has_next ? (const char*)g.A + (size_t)nxt.pm * tstep : cA; const char* nB = has_next ? (const char*)g.Bt + (size_t)nxt.pn * tstep : cB;
        for (int t = 0; t < nt; t += 2) {
            const bool last = (t == nt - 2);
            const char* a1 = cA + (size_t)(t + 1) * kstep;
            const char* a2 = last ? nA : cA + (size_t)(t + 2) * kstep; const char* b2 = last ? nB : cB + (size_t)(t + 2) * kstep;
            const char* a3 = a2 + kstep; const char* b3 = b2 + kstep;
            if (last && has_next) S.a_ready(nxt);
            if constexpr (SP2) {
            PG8_LDB(B0, 0, 0); PG8_LDB(B1, 0, 1); PG8_SCHED; PG8_LDA(At, 0, 0); PG8_STAGE(PG8_SA(1, 1), a1 + hstep, voffA);
            PG8_WAIT_V(8); PG8_WAIT_L(0); PG8_BAR; PG8_MMA(0, 0, At, B0); PG8_MMA(0, 1, At, B1); PG8_BAR; PG8_SCHED;
            PG8_LDA(At, 0, 1); PG8_STAGE(PG8_SB(0, 0), b2, voffB); PG8_STAGE(PG8_SB(0, 1), b2 + hstep, voffB); PG8_STAGE(PG8_SA(0, 0), a2, voffA);
            PG8_WAIT_V(8); PG8_WAIT_L(0); PG8_BAR; PG8_MMA(1, 0, At, B0); PG8_MMA(1, 1, At, B1); PG8_BAR; PG8_SCHED;
            PG8_LDB(B0, 1, 0); PG8_LDB(B1, 1, 1); PG8_SCHED; PG8_LDA(At, 1, 0); PG8_STAGE(PG8_SA(0, 1), a2 + hstep, voffA);
            PG8_WAIT_V(8); PG8_WAIT_L(0); PG8_BAR; PG8_MMA(0, 0, At, B0); PG8_MMA(0, 1, At, B1); PG8_BAR; PG8_SCHED;
            PG8_LDA(At, 1, 1); PG8_STAGE(PG8_SB(1, 0), b3, voffB); PG8_STAGE(PG8_SB(1, 1), b3 + hstep, voffB); PG8_STAGE(PG8_SA(1, 0), a3, voffA);
            PG8_WAIT_V(8); PG8_WAIT_L(0); PG8_BAR; PG8_MMA(1, 0, At, B0); PG8_MMA(1, 1, At, B1); PG8_BAR; PG8_SCHED;
            } else {
            PG8_LDB(B0, 0, 0); PG8_SCHED; PG8_LDA(At, 0, 0); PG8_STAGE(PG8_SA(1, 1), a1 + hstep, voffA);
            PG8_WAIT_L(8); PG8_BAR; PG8_WAIT_L(0); PG8_MMA(0, 0, At, B0); PG8_BAR; PG8_SCHED;
            PG8_LDB(B1, 0, 1); PG8_STAGE(PG8_SB(0, 0), b2, voffB);
            PG8_BAR; PG8_WAIT_L(0); PG8_MMA(0, 1, At, B1); PG8_BAR;
            PG8_LDA(At, 0, 1); PG8_STAGE(PG8_SA(0, 0), a2, voffA);
            PG8_BAR; PG8_WAIT_L(0); PG8_MMA(1, 0, At, B0); PG8_BAR; PG8_SCHED;
            PG8_STAGE(PG8_SB(0, 1), b2 + hstep, voffB);
            PG8_WAIT_V(6); PG8_BAR; PG8_MMA(1, 1, At, B1); PG8_BAR;
            PG8_LDB(B0, 1, 0); PG8_SCHED; PG8_LDA(At, 1, 0); PG8_STAGE(PG8_SA(0, 1), a2 + hstep, voffA);
            PG8_WAIT_L(8); PG8_BAR; PG8_WAIT_L(0); PG8_MMA(0, 0, At, B0); PG8_BAR; PG8_SCHED;
            PG8_LDB(B1, 1, 1); PG8_STAGE(PG8_SB(1, 0), b3, voffB);
            PG8_BAR; PG8_WAIT_L(0); PG8_MMA(0, 1, At, B1); PG8_BAR;
            PG8_LDA(At, 1, 1); PG8_STAGE(PG8_SA(1, 0), a3, voffA);
            PG8_BAR; PG8_WAIT_L(0); PG8_MMA(1, 0, At, B0); PG8_BAR; PG8_SCHED;
            PG8_STAGE(PG8_SB(1, 1), b3 + hstep, voffB);
            PG8_WAIT_V(6); PG8_BAR; PG8_MMA(1, 1, At, B1); PG8_BAR;
            }
        }
        if constexpr (ALIGN_EPI) { if (wr == 0) PG8_BAR; }
        if constexpr (!Epi::AFTER_DRAIN) { E(acc, cur, wr, wc, fr, fq); S.done(cur); }
        if (!has_next) break;
#pragma unroll
        for (int a = 0; a < 2; ++a)
#pragma unroll
            for (int b = 0; b < 2; ++b)
#pragma unroll
                for (int m = 0; m < 4; ++m)
#pragma unroll
                    for (int n = 0; n < 2; ++n) acc[a][b][m][n] = (f32x4){0.f, 0.f, 0.f, 0.f};
        cur = nxt; cA = nA; cB = nB; ++ui;
        if constexpr (ALIGN_EPI) { if (wr == 1) PG8_BAR; }
    }
    PG8_WAIT_V(0);
    if constexpr (!ALIGN_EPI) { if (wr == 0) PG8_BAR; }
    PG8_BAR;
    if constexpr (Epi::AFTER_DRAIN) { E.fused(acc, cur, wr, wc, fr, fq, lds, wid, lane); S.done(cur); }
#undef PG8_SA
#undef PG8_SB
#undef PG8_STAGE
#undef PG8_LDA
#undef PG8_LDB
#undef PG8_MMA
#undef PG8_WAIT_V
#undef PG8_WAIT_L
#undef PG8_BAR
#undef PG8_SCHED
}
}
constexpr int BATCH = 2, SEQ = 8192, DM = 4096, M = BATCH * SEQ, DFF = 11008, NLAYER = 2;
constexpr int P_IN = 10704, NIN = 10752, NMAIN = 10496;
constexpr int CA_Q = 0, CA_K = 1024, CA_V = 2048;
constexpr int CB_Q = 3072, CB_K = 3584, CB_V = 4096, CB_G = 5120;
constexpr int CC_R = 6144, CC_K = 7168, CC_V = 8192;
constexpr int CD_Q = 9216, CD_K = 10240, CD_V = 10368;
constexpr float LOG2E = 1.4426950408889634f;
constexpr float QSCALE = 0.125f * LOG2E;
constexpr int NWAVES = 8;

constexpr size_t MiB = 1u << 20;
constexpr size_t WS_CTL = 0, CTL_ZERO_BYTES = 1 * MiB;
constexpr size_t WS_MODP = 2 * MiB;
constexpr size_t WS_MOD = 14 * MiB;
constexpr size_t WS_TAB = 15 * MiB;
constexpr size_t WS_WIN = 16 * MiB, WIN_L = 84 * MiB;
constexpr size_t WS_WOUT = 184 * MiB, WOUT_L = 32 * MiB;
constexpr size_t WS_W13 = 248 * MiB, W13_L = 172 * MiB;
constexpr size_t WS_W2 = 592 * MiB, W2_L = 86 * MiB;
constexpr size_t WS_XN = 764 * MiB;
constexpr size_t WS_COLS = 892 * MiB;
constexpr size_t WS_LOWR = 1220 * MiB;
constexpr size_t WS_HID = 892 * MiB;
constexpr size_t WS_QKA = 1236 * MiB;
constexpr size_t WS_QKD = 1300 * MiB;
constexpr size_t WS_LOGA = 1336 * MiB;
constexpr size_t WS_RW = 1368 * MiB, RW_ONE = 64 * MiB;
constexpr size_t WS_VFIRST = 1816 * MiB;
constexpr size_t WS_MIXED = 1880 * MiB;
constexpr int VROW = SEQ + 64;
constexpr size_t WS_VTA = 2008 * MiB;
constexpr size_t WS_VTD = 2041 * MiB;
constexpr size_t WS_QDEC = 2046 * MiB, WS_KDT = 2062 * MiB, WS_AM = 2078 * MiB, WS_EBL = 2086 * MiB;
constexpr size_t WS_VTB = 2087 * MiB;
constexpr size_t WS_RWC = 2120 * MiB;
constexpr size_t WS_OB = 2446 * MiB;
constexpr size_t WS_PSG = 2478 * MiB;
constexpr size_t WS_WF = 2479 * MiB;
constexpr size_t WS_END = 2480 * MiB;
constexpr int CW_BAR = 4096;
constexpr int CW_Q = 16384;

constexpr int RING_OFF = 0, RING_BYTES = 131072;
constexpr int LDSCTL_OFF = RING_BYTES, MISC_OFF = LDSCTL_OFF + 320;
constexpr int LDS_BYTES = 147456;

#define GAS __attribute__((address_space(1)))
#define LAS __attribute__((address_space(3)))
typedef unsigned short bf16;
typedef unsigned v4u __attribute__((ext_vector_type(4)));
typedef unsigned v2u __attribute__((ext_vector_type(2)));
typedef float f32x4 __attribute__((ext_vector_type(4)));
typedef short bf16x8 __attribute__((ext_vector_type(8)));
typedef GAS unsigned gu32;
#define RLX_AGENT __ATOMIC_RELAXED, __HIP_MEMORY_SCOPE_AGENT
#define LDS_WAIT() asm volatile("s_waitcnt lgkmcnt(0)" ::: "memory")
#define VM_WAIT() asm volatile("s_waitcnt vmcnt(0)" ::: "memory")
typedef float f32x2_t __attribute__((ext_vector_type(2))); typedef __bf16 bf16x2_t __attribute__((ext_vector_type(2)));
__device__ __forceinline__ unsigned pk2(float lo, float hi) { const f32x2_t v = {lo, hi}; return __builtin_bit_cast(unsigned, __builtin_convertvector(v, bf16x2_t)); }
__device__ __forceinline__ unsigned f2bf(float f) { return pk2(f, f) & 0xffffu; }
__device__ __forceinline__ float bf2f(unsigned short h) { return __builtin_bit_cast(float, (unsigned)h << 16); }
__device__ __forceinline__ float bflo(unsigned w) { return __builtin_bit_cast(float, w << 16); }
__device__ __forceinline__ float bfhi(unsigned w) { return __builtin_bit_cast(float, w & 0xffff0000u); }
template <int CTRL> __device__ __forceinline__ float dpp_f(float v) { return __builtin_bit_cast(float, __builtin_amdgcn_update_dpp(0, __builtin_bit_cast(int, v), CTRL, 0xF, 0xF, true)); }
__device__ __forceinline__ float sum8(float v) {
    v += dpp_f<0xB1>(v); v += dpp_f<0x4E>(v); v += dpp_f<0x141>(v); return v; }
__device__ __forceinline__ float sum32(float v) {
    v = sum8(v); v += dpp_f<0x140>(v); v += __builtin_bit_cast(float, __builtin_amdgcn_ds_swizzle(__builtin_bit_cast(int, v), 0x401F)); return v; }
__device__ __forceinline__ float wave_sum(float v) {
    v = sum8(v); v += dpp_f<0x140>(v);
    v += __builtin_bit_cast(float, __builtin_amdgcn_ds_swizzle(__builtin_bit_cast(int, v), 0x401F));
    { const int u = __builtin_bit_cast(int, v); v = __builtin_bit_cast(float, __builtin_amdgcn_readlane(u, 0)) + __builtin_bit_cast(float, __builtin_amdgcn_readlane(u, 32)); }
    return v;
}
__device__ __forceinline__ float sigmoid_f(float x) { return __builtin_amdgcn_rcpf(1.0f + __builtin_amdgcn_exp2f(-LOG2E * x)); }
__device__ __forceinline__ float silu_g(float x) { return x * sigmoid_f(x); }
__device__ __forceinline__ void unpack8(const v4u r, float (&f)[8]) { f[0] = bflo(r.x); f[1] = bfhi(r.x); f[2] = bflo(r.y); f[3] = bfhi(r.y); f[4] = bflo(r.z); f[5] = bfhi(r.z); f[6] = bflo(r.w); f[7] = bfhi(r.w); }
__device__ __forceinline__ v4u pack8(const float (&f)[8]) { v4u o; o.x = pk2(f[0], f[1]); o.y = pk2(f[2], f[3]); o.z = pk2(f[4], f[5]); o.w = pk2(f[6], f[7]); return o; }

#define XB_TMO      128
#define XB_XCNT(j)  (256  + 64 * (j))
#define XB_XSUB(j)  (1280 + 64 * (j))
#define XB_XGEN(j)  (2304 + 64 * (j))
#define XB_TOP      3328
#define XB_TOPGEN   3392
#define XCD_BAR_WORDS 3456
#define XB_SPIN_CAP (1u << 23)

__device__ __forceinline__ unsigned xb_ld(unsigned* p)              { return __hip_atomic_load(p, __ATOMIC_RELAXED, __HIP_MEMORY_SCOPE_AGENT); }
__device__ __forceinline__ unsigned xb_add(unsigned* p, unsigned v) { return __hip_atomic_fetch_add(p, v, __ATOMIC_RELAXED, __HIP_MEMORY_SCOPE_AGENT); }
__device__ __forceinline__ unsigned xb_xcc_id() { return (unsigned)__builtin_amdgcn_s_getreg((3 << 11) | 20) & 0xFu; }
#define XB_SPIN(cond, bar) do { unsigned _sp = 0; while (cond) { __builtin_amdgcn_s_sleep(1); \
    if ((++_sp & 255u) == 0u) { if (xb_ld(&(bar)[XB_TMO])) break; if (_sp > XB_SPIN_CAP) { atomicAdd(&(bar)[XB_TMO], 1u); break; } } } } while (0)

struct XcdBarrier {
    unsigned* bar; unsigned x;
    volatile LAS unsigned* st;
};

__device__ __forceinline__ XcdBarrier xcd_barrier_post(unsigned* bar, volatile LAS unsigned* st) {
    XcdBarrier b; b.bar = bar; b.x = xb_xcc_id(); b.st = st;
    if (threadIdx.x == 0) (void)xb_add(&bar[XB_XCNT(b.x)], 1u);
    return b;
}
__device__ __forceinline__ void xcd_barrier_complete(unsigned* bar, unsigned x, unsigned& nloc, unsigned& nx) {
    const unsigned G = gridDim.x * gridDim.y * gridDim.z;
    unsigned sum, cnt, mine, sp = 0u;
    for (;;) {
        sum = 0u; cnt = 0u; mine = 0u;
#pragma unroll
        for (unsigned j = 0; j < 16; ++j) { const unsigned c = xb_ld(&bar[XB_XCNT(j)]); sum += c; cnt += (c > 0u) ? 1u : 0u; mine = (j == x) ? c : mine; }
        if (sum == G) break;
        __builtin_amdgcn_s_sleep(1);
        if ((++sp & 255u) == 0u) { if (xb_ld(&bar[XB_TMO])) break; if (sp > XB_SPIN_CAP) { atomicAdd(&bar[XB_TMO], 1u); break; } }
    }
    nloc = mine > 0u ? mine : 1u; nx = cnt > 0u ? cnt : 1u;
}

__device__ __forceinline__ void xcd_barrier(const XcdBarrier& b) {
    asm volatile("s_waitcnt vmcnt(0)" ::: "memory");
    __syncthreads();
    if (threadIdx.x == 0) {
        unsigned* bar = b.bar;
        __builtin_amdgcn_s_waitcnt(0);
        unsigned nloc = b.st[0], nx = b.st[1];
        if (nloc == 0u) { xcd_barrier_complete(bar, b.x, nloc, nx); b.st[0] = nloc; b.st[1] = nx; }
        const unsigned old = xb_add(&bar[XB_XSUB(b.x)], 1u);
        const unsigned gen = old / nloc;
        if (old + 1u == (gen + 1u) * nloc) {
            __builtin_amdgcn_fence(__ATOMIC_RELEASE, "agent");
            asm volatile("s_waitcnt vmcnt(0)" ::: "memory");
            const unsigned og = xb_add(&bar[XB_TOP], 1u);
            const unsigned tg = og / nx;
            if (og + 1u == (tg + 1u) * nx) xb_add(&bar[XB_TOPGEN], 1u);
            else XB_SPIN(xb_ld(&bar[XB_TOPGEN]) == tg, bar);
            __builtin_amdgcn_fence(__ATOMIC_ACQUIRE, "agent");
            xb_add(&bar[XB_XGEN(b.x)], 1u);
            asm volatile("s_waitcnt vmcnt(0)" ::: "memory");
        } else {
            XB_SPIN(xb_ld(&bar[XB_XGEN(b.x)]) == gen, bar);
            __builtin_amdgcn_fence(__ATOMIC_ACQUIRE, "agent");
            asm volatile("s_waitcnt vmcnt(0)" ::: "memory");
        }
    }
    __syncthreads();
}

typedef const float* const __attribute__((address_space(4)))* kargp;
struct Frame {
    LAS unsigned char* lds;
    volatile LAS unsigned* MISC;
    gu32* ctl;
    int tid, lane, wave;
    int vcu, G, bx;
    kargp kin;
    float* out;
    unsigned char* ws;
};
enum { I_X = 0, I_C, I_RELB, I_ADAW, I_ADAB, I_WIN, I_WOUT, I_DQN, I_DKN, I_DLAM, I_DSUB, I_GGU, I_GGB, I_GON, I_RMU, I_RWUP, I_RW0, I_RAUP, I_RA0, I_RGUP,
       I_RKK, I_RKA, I_RRK, I_RLNW, I_RLNB, I_VRD, I_VRMU, I_VRUP, I_VR0, I_SQN, I_SKN, I_SSINK, I_W1, I_W3, I_W2 };

#define WSP(T, off) ((T*)(F.ws + (off)))
__device__ __forceinline__ void relaunder_tid(Frame& F) { int t = F.tid; asm volatile("" : "+v"(t)); F.tid = t; F.lane = t & 63; F.wave = __builtin_amdgcn_readfirstlane(t >> 6); }
__device__ __forceinline__ void relaunder(Frame& F) { kargp p = F.kin; asm volatile("" : "+s"(p)); F.kin = p; }

__device__ __forceinline__ void conv_item(const float* src, int ld, int col0, int ncols, int K, bf16* WT, int row0, int kb, LAS float* scr, int lane) {
    const int k0 = 64 * kb;
    { const int n = lane & 31; const bool ok = src != nullptr && n < ncols; const float* sp = src + (size_t)(k0 + (lane >> 5)) * ld + col0 + n; float v[32];
#pragma unroll
      for (int i = 0; i < 32; ++i) v[i] = ok ? sp[(size_t)(2 * i) * ld] : 0.f;
#pragma unroll
      for (int i = 0; i < 32; ++i) scr[(2 * i + (lane >> 5)) * 33 + n] = v[i]; }
    LDS_WAIT(); asm volatile("" ::: "memory");
    const int c = lane & 7;
#pragma unroll
    for (int j = 0; j < 4; ++j) { const int n = (lane >> 3) + 8 * j; const LAS float* s = scr + (8 * c) * 33 + n;
        v4u o; o.x = pk2(s[0 * 33], s[1 * 33]); o.y = pk2(s[2 * 33], s[3 * 33]); o.z = pk2(s[4 * 33], s[5 * 33]); o.w = pk2(s[6 * 33], s[7 * 33]);
        if (n < ncols) *(GAS v4u*)(WT + (size_t)(row0 + n) * K + k0 + 8 * c) = o; }
    LDS_WAIT(); asm volatile("" ::: "memory");
}
__device__ __forceinline__ int t5_bucket(int d) {
    if (d < 16) return d;
    int v = 16 + (int)(logf((float)d * (1.0f / 16.0f)) / logf(8.0f) * 16.0f);
    return v < 31 ? v : 31;
}
__device__ __forceinline__ void p0_prologue_a(Frame& F) {
    const int gw = F.vcu * NWAVES + F.wave, NGW = F.G * NWAVES;
    LAS float* ldsf = (LAS float*)(F.lds + RING_OFF);
    for (int i = F.tid; i < 2 * DM; i += NWAVES * 64) ldsf[i] = silu_g(F.kin[I_C][i]);
    __syncthreads();
    float* MODP = WSP(float, WS_MODP);
    for (int it = gw; it < 6144; it += NGW) {
        const int l = it / 3072, rem = it % 3072, kc = rem / 96, ng = rem % 96, n0 = 256 * ng + 4 * F.lane;
        const float* w = F.kin[I_ADAW] + ((size_t)l * DM + kc * 128) * 24576 + n0;
        f32x4 a0 = {0.f, 0.f, 0.f, 0.f}, a1 = {0.f, 0.f, 0.f, 0.f};
#pragma unroll 16
        for (int k = 0; k < 128; ++k) { const f32x4 wv = *(const f32x4*)(w + (size_t)k * 24576); const float s0 = ldsf[kc * 128 + k], s1 = ldsf[DM + kc * 128 + k]; a0 += wv * s0; a1 += wv * s1; }
        *(f32x4*)(MODP + ((size_t)(l * 32 + kc) * 2 + 0) * 24576 + n0) = a0;
        *(f32x4*)(MODP + ((size_t)(l * 32 + kc) * 2 + 1) * 24576 + n0) = a1;
    }
    for (int idx = F.bx * (NWAVES * 64) + F.tid; idx < NLAYER * 448 * 64; idx += F.G * NWAVES * 64) {
        const int l = idx / (448 * 64), rem = idx % (448 * 64), blk = rem >> 6, ln = rem & 63, n = ln & 15, g = ln >> 4;
        const int m = blk < 384 ? blk >> 7 : 3, nt = blk < 384 ? (blk & 127) >> 1 : blk - 384, ks = blk < 384 ? (blk & 1) : 0;
        const float* W = m == 0 ? F.kin[I_RWUP] + (size_t)l * 65536 : (m == 1 ? F.kin[I_RAUP] + (size_t)l * 65536 : (m == 2 ? F.kin[I_RGUP] + (size_t)l * 65536 : (l ? F.kin[I_VRUP] + (size_t)(l - 1) * 32768 : nullptr)));
        float f[8];
#pragma unroll
        for (int e = 0; e < 8; ++e) f[e] = W != nullptr ? W[(size_t)(32 * ks + 8 * g + e) * 1024 + 16 * nt + n] : 0.f;
        *(v4u*)(WSP(bf16, WS_WF) + ((size_t)(l * 448 + blk) * 64 + ln) * 8) = pack8(f);
    }
    __syncthreads();
    LAS float* scr = (LAS float*)(F.lds + RING_OFF + F.wave * 16384);
    constexpr int I_IN = 337 * 64, I_OUT = 128 * 64, I_13 = 688 * 64, I_2 = 128 * 172, I_L = I_IN + I_OUT + I_13 + I_2;
    for (int it = gw; it < NLAYER * I_L; it += NGW) {
        const int l = it / I_L; int r = it % I_L;
        if (r < I_IN) {
            const int kb = r / 337, cb = r % 337; const float* src = F.kin[I_WIN] + (size_t)l * DM * P_IN; int ld = P_IN, col0, row0, nc = 32;
            if (cb < 192) { col0 = 32 * cb; row0 = 32 * cb; }
            else if (cb < 288) { col0 = 6160 + 32 * (cb - 192); row0 = 6144 + 32 * (cb - 192); }
            else if (cb < 328) { col0 = 9424 + 32 * (cb - 288); row0 = 9216 + 32 * (cb - 288); }
            else if (cb == 328) { col0 = 6144; row0 = 10496; nc = 16; }
            else if (cb < 335) { col0 = 9232 + 32 * (cb - 329); row0 = 10512 + 32 * (cb - 329); }
            else if (cb == 335) { src = l ? F.kin[I_VRD] + (size_t)(l - 1) * DM * 32 : nullptr; ld = 32; col0 = 0; row0 = 10704; }
            else { src = nullptr; col0 = 0; row0 = 10736; nc = 16; }
            conv_item(src, ld, col0, nc, DM, WSP(bf16, WS_WIN + l * WIN_L), row0, kb, scr, F.lane); continue; }
        r -= I_IN;
        if (r < I_OUT) { const int kb = r / 128, cb = r % 128; conv_item(F.kin[I_WOUT] + (size_t)l * DM * DM, DM, 32 * cb, 32, DM, WSP(bf16, WS_WOUT + l * WOUT_L), 32 * cb, kb, scr, F.lane); continue; }
        r -= I_OUT;
        if (r < I_13) { const int kb = r / 688, cb = r % 688, pn = cb >> 3, wi = cb & 7;
            const float* src = (wi < 4 ? F.kin[I_W1] : F.kin[I_W3]) + (size_t)l * DM * DFF;
            conv_item(src, DFF, 128 * pn + 32 * (wi & 3), 32, DM, WSP(bf16, WS_W13 + l * W13_L), 32 * cb, kb, scr, F.lane); continue; }
        r -= I_13;
        { const int kb = r / 128, cb = r % 128; conv_item(F.kin[I_W2] + (size_t)l * DFF * DM, DM, 32 * cb, 32, DFF, WSP(bf16, WS_W2 + l * W2_L), 32 * cb, kb, scr, F.lane); }
    }
}
__device__ __forceinline__ void p0_prologue_b(Frame& F) {
    const int gt = F.bx * (NWAVES * 64) + F.tid, NT = F.G * NWAVES * 64;
    const float* MODP = WSP(float, WS_MODP); float* MOD = WSP(float, WS_MOD);
    for (int idx = gt; idx < NLAYER * 2 * 24576; idx += NT) {
        const int l = idx / 49152, rem = idx % 49152, b = rem / 24576, n = rem % 24576;
        float s = F.kin[I_ADAB][l * 24576 + n];
#pragma unroll 8
        for (int kc = 0; kc < 32; ++kc) s += MODP[((size_t)(l * 32 + kc) * 2 + b) * 24576 + n];
        MOD[idx] = s;
    }
    if (F.bx == 0) { float* TAB = WSP(float, WS_TAB);
        for (int i = F.tid; i < 24 * 128; i += NWAVES * 64) { const int hh = i >> 7, d = i & 127; TAB[i] = F.kin[I_RELB][t5_bucket(d) * 24 + hh] * LOG2E; } }
}
__device__ __forceinline__ void rms_phase(Frame& F, const float* xin, const float* sh, const float* sc) {
    const int gw = F.vcu * NWAVES + F.wave, NGW = F.G * NWAVES;
    bf16* XN = WSP(bf16, WS_XN);
    for (int m = gw; m < M; m += NGW) {
        const int b = m >> 13;
        const f32x4* xr = (const f32x4*)(xin + (size_t)m * DM) + F.lane;
        f32x4 v[16]; float ss = 0.f;
#pragma unroll
        for (int j = 0; j < 16; ++j) { v[j] = xr[64 * j]; ss += (v[j].x * v[j].x + v[j].y * v[j].y) + (v[j].z * v[j].z + v[j].w * v[j].w); }
        const float rstd = rsqrtf(wave_sum(ss) * (1.0f / DM) + 1e-6f);
        const f32x4* scp = (const f32x4*)(sc + (size_t)b * 24576) + F.lane; const f32x4* shp = (const f32x4*)(sh + (size_t)b * 24576) + F.lane;
        v2u* o8 = (v2u*)(XN + (size_t)m * DM) + F.lane;
#pragma unroll
        for (int j = 0; j < 16; ++j) { const f32x4 s4 = scp[64 * j], h4 = shp[64 * j]; const f32x4 o = v[j] * rstd * (s4 + 1.0f) + h4;
            v2u w; w.x = pk2(o.x, o.y); w.y = pk2(o.z, o.w); o8[64 * j] = w; }
    }
}
__device__ __forceinline__ void prep_norm(Frame& F, int l) {
    const int gw = F.vcu * NWAVES + F.wave, NGW = F.G * NWAVES, lane = F.lane, sub = lane >> 3, ch = lane & 7;
    float gqa[8], gka[8], gqd[8], gkd[8];
#pragma unroll
    for (int e = 0; e < 8; ++e) { gqa[e] = F.kin[I_DQN][l * 64 + ch * 8 + e] * QSCALE; gka[e] = F.kin[I_DKN][l * 64 + ch * 8 + e];
                                  gqd[e] = F.kin[I_SQN][l * 64 + ch * 8 + e] * QSCALE; gkd[e] = F.kin[I_SKN][l * 64 + ch * 8 + e]; }
    const bf16* COLS = WSP(bf16, WS_COLS); bf16* QKA = WSP(bf16, WS_QKA); bf16* QKD = WSP(bf16, WS_QKD);
    for (int m = gw; m < M; m += NGW) {
        const bf16* src = COLS + (size_t)m * NMAIN;
#pragma unroll
        for (int i = 0; i < 4; ++i) { const int vec = i * 8 + sub, col = vec * 64 + ch * 8;
            float f[8]; unpack8(*(const v4u*)(src + CA_Q + col), f); float ss = 0.f;
#pragma unroll
            for (int e = 0; e < 8; ++e) ss += f[e] * f[e];
            ss = sum8(ss);
            const float rstd = rsqrtf(ss * (1.0f / 64.0f) + 1e-6f);
#pragma unroll
            for (int e = 0; e < 8; ++e) f[e] = f[e] * rstd * (i < 2 ? gqa[e] : gka[e]);
            *(v4u*)(QKA + (size_t)m * 2048 + col) = pack8(f); }
#pragma unroll
        for (int i = 0; i < 3; ++i) { const int vec = i * 8 + sub, col = vec * 64 + ch * 8;
            if (vec < 18) { float f[8]; unpack8(*(const v4u*)(src + CD_Q + col), f); float ss = 0.f;
#pragma unroll
                for (int e = 0; e < 8; ++e) ss += f[e] * f[e];
                ss = sum8(ss);
                const float rstd = rsqrtf(ss * (1.0f / 64.0f) + 1e-6f);
#pragma unroll
                for (int e = 0; e < 8; ++e) f[e] = f[e] * rstd * (vec < 16 ? gqd[e] : gkd[e]);
                *(v4u*)(QKD + (size_t)m * 1152 + col) = pack8(f); } }
    }
}
__device__ __forceinline__ void prep_loga(Frame& F, int l) {
    LAS float* gdl = (LAS float*)(F.lds + RING_OFF);
    float gu[16];
#pragma unroll
    for (int j = 0; j < 16; ++j) gu[j] = F.kin[I_GGU][((size_t)l * 16 + j) * 512 + F.tid];
    const float bias = F.kin[I_GGB][l * 512 + F.tid];
    const float* LOWR = WSP(float, WS_LOWR); float* LOGA = WSP(float, WS_LOGA);
    for (int tile = F.bx; tile < M / 64; tile += F.G) {
        const size_t row0 = (size_t)tile * 64;
        __syncthreads();
#pragma unroll
        for (int i = 0; i < 2; ++i) { const int idx = F.tid + 512 * i; gdl[idx] = LOWR[(row0 + (idx >> 4)) * 256 + (idx & 15)]; }
        __syncthreads();
#pragma unroll 4
        for (int t = 0; t < 64; ++t) { const LAS f32x4* gp = (const LAS f32x4*)(gdl + t * 16); const f32x4 g0 = gp[0], g1 = gp[1], g2 = gp[2], g3 = gp[3];
            float z = bias + g0.x * gu[0] + g0.y * gu[1] + g0.z * gu[2] + g0.w * gu[3] + g1.x * gu[4] + g1.y * gu[5] + g1.z * gu[6] + g1.w * gu[7]
                    + g2.x * gu[8] + g2.y * gu[9] + g2.z * gu[10] + g2.w * gu[11] + g3.x * gu[12] + g3.y * gu[13] + g3.z * gu[14] + g3.w * gu[15];
            LOGA[(row0 + t) * 512 + F.tid] = (fminf(z, 0.f) - __logf(1.0f + __expf(-fabsf(z)))) * (1.0f / 16.0f); }
    }
}
__device__ __forceinline__ int next_item(Frame& F, gu32* ctr) {
    volatile LAS int* slot = (volatile LAS int*)(F.lds + LDSCTL_OFF + 64);
    __syncthreads();
    if (F.tid == 0) *slot = (int)__hip_atomic_fetch_add(ctr, 1u, RLX_AGENT);
    __syncthreads();
    return *slot;
}
typedef float f32x16 __attribute__((ext_vector_type(16)));
__device__ __forceinline__ float xother32(float v) { unsigned a = __builtin_bit_cast(unsigned, v), b = a; asm volatile("" : "+v"(b)); auto rr = __builtin_amdgcn_permlane32_swap(a, b, false, false);
    const unsigned lo = rr[0], hi = rr[1]; return __builtin_bit_cast(float, (unsigned)((__builtin_amdgcn_mbcnt_hi(~0u, __builtin_amdgcn_mbcnt_lo(~0u, 0u)) & 32u) ? lo : hi)); }
__device__ __forceinline__ float xsum32(float v) { return v + xother32(v); }
__device__ __forceinline__ float xmax32(float v) { return fmaxf(v, xother32(v)); }
__device__ __forceinline__ int crow16(int r, int hi) { return (r & 3) + 8 * (r >> 2) + 4 * hi; }
template <bool ISA>
__device__ __forceinline__ void attn_unit(Frame& F, int l, int b, int hx, int qb) {
    constexpr int DV = ISA ? 128 : 64, NDV = DV / 32, KSTR = ISA ? 272 : 144, VSTR = 144, KBYTES = 64 * KSTR, VBYTES = DV * VSTR, BUFB = KBYTES + VBYTES, NCH = ISA ? 2 : 1;
    constexpr float NEG = -1e30f;
    LAS unsigned char* L = F.lds + RING_OFF;
    const int tid = F.tid, lane = F.lane, r32 = lane & 31, hi = lane >> 5, qs = F.wave & 3, grp = F.wave >> 2, q0 = qb * 128;
    const int kvh = hx >> 2, hd = kvh * 8 + (hx & 3) * 2 + grp;
    const bf16* Qp; const bf16* Kp; const bf16* VT; int ldq;
    if (ISA) { const bf16* QKA = WSP(bf16, WS_QKA); Qp = QKA + (size_t)b * SEQ * 2048 + hx * 128 + grp * 64; Kp = QKA + (size_t)b * SEQ * 2048 + 1024 + hx * 128; ldq = 2048; VT = WSP(bf16, WS_VTA) + (size_t)(b * 8 + hx) * 128 * VROW; }
    else { const bf16* QKD = WSP(bf16, WS_QKD); Qp = QKD + (size_t)b * SEQ * 1152 + hd * 64; Kp = QKD + (size_t)b * SEQ * 1152 + 1024 + kvh * 64; ldq = 1152; VT = WSP(bf16, WS_VTD) + (size_t)(b * 2 + kvh) * 64 * VROW; }
    const int qpos = q0 + 32 * qs + r32;
    bf16x8 qr[4];
#pragma unroll
    for (int d0 = 0; d0 < 4; ++d0) qr[d0] = *(const bf16x8*)(Qp + (size_t)qpos * ldq + d0 * 16 + hi * 8);
    LAS float* Bt = (LAS float*)(L + 2 * BUFB);
    { const float* TAB = WSP(float, WS_TAB);
      if (ISA) { if (tid < 130) Bt[tid] = tid == 0 ? NEG : (tid == 129 ? 0.f : TAB[hx * 128 + tid - 1] - TAB[hx * 128 + 127]); }
      else { if (tid < 260) { const int gi = tid >= 130, t = tid - 130 * gi; Bt[tid] = (t == 0 || t == 129) ? NEG : TAB[(8 + kvh * 8 + (hx & 3) * 2 + gi) * 128 + t - 1]; } } }
    const int TQ = q0 >> 6, T0 = ISA ? 0 : (TQ >= 2 ? TQ - 2 : 0), T1 = TQ + 1;
    v4u kreg[NCH], vreg[NCH];
#define AT_GLOAD(T) do { _Pragma("unroll") for (int i_ = 0; i_ < NCH; ++i_) { const int c_ = tid + 512 * i_; \
        const int kr_ = ISA ? (c_ >> 4) : (c_ >> 3), kc_ = ISA ? (c_ & 15) : (c_ & 7); kreg[i_] = *(const v4u*)(Kp + (size_t)((T) * 64 + kr_) * ldq + kc_ * 8); \
        const int vr_ = c_ >> 3, vc_ = c_ & 7; vreg[i_] = *(const v4u*)(VT + (size_t)vr_ * VROW + (T) * 64 + vc_ * 8); } } while (0)
#define AT_LWRITE(buf) do { _Pragma("unroll") for (int i_ = 0; i_ < NCH; ++i_) { const int c_ = tid + 512 * i_; \
        const int kr_ = ISA ? (c_ >> 4) : (c_ >> 3), kc_ = ISA ? (c_ & 15) : (c_ & 7); *(LAS v4u*)(L + (buf) * BUFB + kr_ * KSTR + kc_ * 16) = kreg[i_]; \
        const int vr_ = c_ >> 3, vc_ = c_ & 7; *(LAS v4u*)(L + (buf) * BUFB + KBYTES + vr_ * VSTR + vc_ * 16) = vreg[i_]; } } while (0)
    f32x16 o[NDV];
#pragma unroll
    for (int i = 0; i < NDV; ++i) o[i] = (f32x16){0.f, 0.f, 0.f, 0.f, 0.f, 0.f, 0.f, 0.f, 0.f, 0.f, 0.f, 0.f, 0.f, 0.f, 0.f, 0.f};
    float m_run = ISA ? NEG : F.kin[I_SSINK][l * 16 + hd] * LOG2E, l_run = ISA ? 0.f : (hi == 0 ? 1.f : 0.f);
    const int krow = (r32 & 16) | (r32 & 3) | ((r32 & 4) << 1) | ((r32 & 8) >> 1);
    const int koff = krow * KSTR + (ISA ? grp * 128 : 0) + hi * 16, voff = KBYTES + r32 * VSTR + hi * 16;
    AT_GLOAD(T0); AT_LWRITE(0); __syncthreads();
#pragma unroll 1
    for (int T = T0; T <= T1; ++T) {
        const int cur = (T - T0) & 1;
        AT_GLOAD(T < T1 ? T + 1 : T1);
        LAS const unsigned char* Kb = L + cur * BUFB;
        f32x16 s[2];
#pragma unroll
        for (int blk = 0; blk < 2; ++blk) { s[blk] = (f32x16){0.f, 0.f, 0.f, 0.f, 0.f, 0.f, 0.f, 0.f, 0.f, 0.f, 0.f, 0.f, 0.f, 0.f, 0.f, 0.f};
#pragma unroll
            for (int d0 = 0; d0 < 4; ++d0) { const bf16x8 kf = *(const LAS bf16x8*)(Kb + koff + blk * 32 * KSTR + d0 * 32); s[blk] = __builtin_amdgcn_mfma_f32_32x32x16_bf16(kf, qr[d0], s[blk], 0, 0, 0); } }
        bf16x8 vfc[NDV], vfn[NDV];
#pragma unroll
        for (int i = 0; i < NDV; ++i) vfc[i] = *(const LAS bf16x8*)(Kb + voff + i * 32 * VSTR);
        if (!ISA || T >= TQ - 2) {
            const LAS float* bt = Bt + (ISA ? 0 : grp * 130) + 1; const int d0 = qpos - T * 64 - 8 * hi;
#pragma unroll
            for (int blk = 0; blk < 2; ++blk)
#pragma unroll
                for (int r = 0; r < 16; ++r) { const int dist = d0 - (32 * blk + 16 * (r >> 3) + (r & 7)); const int di = dist < -1 ? -1 : (dist > 128 ? 128 : dist); s[blk][r] += bt[di]; } }
        float mt = s[0][0];
#pragma unroll
        for (int r = 1; r < 16; ++r) mt = fmaxf(mt, s[0][r]);
#pragma unroll
        for (int r = 0; r < 16; ++r) mt = fmaxf(mt, s[1][r]);
        mt = xmax32(mt);
        const float m_new = fmaxf(m_run, mt);
        if (__any(m_new > m_run)) { const float alpha = __builtin_amdgcn_exp2f(m_run - m_new); l_run *= alpha;
#pragma unroll
            for (int i = 0; i < NDV; ++i)
#pragma unroll
                for (int r = 0; r < 16; ++r) o[i][r] *= alpha;
            m_run = m_new; }
        float ls = 0.f;
#pragma unroll
        for (int blk = 0; blk < 2; ++blk)
#pragma unroll
            for (int r = 0; r < 16; ++r) { const float pv_ = __builtin_amdgcn_exp2f(s[blk][r] - m_run); s[blk][r] = pv_; ls += pv_; }
        l_run += ls;
#pragma unroll
        for (int sl = 0; sl < 4; ++sl) { const int blk = sl >> 1, r0 = 8 * (sl & 1);
            v4u pw; pw.x = pg8::cvt_pk_bf16(s[blk][r0], s[blk][r0 + 1]); pw.y = pg8::cvt_pk_bf16(s[blk][r0 + 2], s[blk][r0 + 3]); pw.z = pg8::cvt_pk_bf16(s[blk][r0 + 4], s[blk][r0 + 5]); pw.w = pg8::cvt_pk_bf16(s[blk][r0 + 6], s[blk][r0 + 7]);
            const bf16x8 pf = __builtin_bit_cast(bf16x8, pw);
#pragma unroll
            for (int i = 0; i < NDV; ++i) { if (sl < 3) vfn[i] = *(const LAS bf16x8*)(Kb + voff + i * 32 * VSTR + (sl + 1) * 32); o[i] = __builtin_amdgcn_mfma_f32_32x32x16_bf16(vfc[i], pf, o[i], 0, 0, 0); }
#pragma unroll
            for (int i = 0; i < NDV; ++i) vfc[i] = vfn[i]; }
        AT_LWRITE(cur ^ 1);
        __syncthreads();
    }
#undef AT_GLOAD
#undef AT_LWRITE
    const float inv = 1.0f / xsum32(l_run);
    bf16* MIX = WSP(bf16, WS_MIXED);
    if (ISA) {
        int ll_ = l; asm volatile("" : "+s"(ll_)); const float lam_init = ll_ == 0 ? 0.2f : 0.35550906759f;     float lam_full;
        { const float* lm = F.kin[I_DLAM] + (size_t)l * 256; const float s1 = wave_sum(lm[lane] * lm[64 + lane]), s2 = wave_sum(lm[128 + lane] * lm[192 + lane]); lam_full = __expf(s1) - __expf(s2) + lam_init; }
        LAS float* R1 = (LAS float*)L;
        LAS bf16* R2 = (LAS bf16*)(L + 66048);
        const int ql = 32 * qs + r32;
        if (grp == 1) {
#pragma unroll
            for (int i = 0; i < NDV; ++i)
#pragma unroll
                for (int r = 0; r < 16; ++r) R1[ql * 129 + 32 * i + crow16(r, hi)] = lam_full * inv * o[i][r]; }
        __syncthreads();
        if (grp == 0) { float ss = 0.f;
#pragma unroll
            for (int i = 0; i < NDV; ++i)
#pragma unroll
                for (int r = 0; r < 16; ++r) { const float d = o[i][r] * inv - R1[ql * 129 + 32 * i + crow16(r, hi)]; o[i][r] = d; ss += d * d; }
            const float rstd = rsqrtf(xsum32(ss) * (1.0f / 128.0f) + 1e-6f) * (1.0f - lam_init);
            const float* sl = F.kin[I_DSUB] + l * 128;
#pragma unroll
            for (int i = 0; i < NDV; ++i)
#pragma unroll
                for (int r = 0; r < 16; ++r) { const int dv = 32 * i + crow16(r, hi); R2[ql * 132 + dv] = (bf16)f2bf(o[i][r] * rstd * sl[dv]); } }
        __syncthreads();
#pragma unroll
        for (int i = 0; i < 4; ++i) { const int c = tid + 512 * i, row = c >> 4, ch = c & 15; const LAS v2u* sp = (const LAS v2u*)(R2 + row * 132 + ch * 8); const v2u a = sp[0], bb = sp[1];
            *(v4u*)(MIX + (size_t)(b * SEQ + q0 + row) * DM + hx * 128 + ch * 8) = (v4u){a.x, a.y, bb.x, bb.y}; }
    } else {
        LAS bf16* R = (LAS bf16*)L + F.wave * 2176;
#pragma unroll
        for (int i = 0; i < NDV; ++i)
#pragma unroll
            for (int r = 0; r < 16; ++r) R[r32 * 68 + 32 * i + crow16(r, hi)] = (bf16)f2bf(o[i][r] * inv);
#pragma unroll
        for (int i = 0; i < 4; ++i) { const int c = lane + 64 * i, row = c >> 3, ch = c & 7; const LAS v2u* sp = (const LAS v2u*)(R + row * 68 + ch * 8); const v2u a = sp[0], bb = sp[1];
            *(v4u*)(MIX + (size_t)(b * SEQ + q0 + 32 * qs + row) * DM + 3072 + hd * 64 + ch * 8) = (v4u){a.x, a.y, bb.x, bb.y}; }
    }
}
__device__ __forceinline__ void prep_gla(Frame& F) {
    LAS float* Lb = (LAS float*)(F.lds + RING_OFF); LAS float* Qd = Lb + 64 * 129; LAS float* Ki = Qd + 64 * 129; LAS bf16* Kt = (LAS bf16*)(Ki + 64 * 129);
    const bf16* COLS = WSP(bf16, WS_COLS); const float* LOGA = WSP(float, WS_LOGA);
    bf16* QDEC = WSP(bf16, WS_QDEC); bf16* KDT = WSP(bf16, WS_KDT); bf16* AMg = WSP(bf16, WS_AM); float* EBL = WSP(float, WS_EBL);
    for (int u = F.bx; u < 1024; u += F.G) {
        const int b = u >> 9, h = (u >> 7) & 3, ck = u & 127; const size_t row0 = (size_t)b * SEQ + ck * 64;
        __syncthreads();
        for (int idx = F.tid; idx < 8192; idx += NWAVES * 64) { const int t = idx >> 7, d = idx & 127; Lb[t * 129 + d] = LOGA[(row0 + t) * 512 + h * 128 + d]; }
        __syncthreads();
        if (F.tid < 128) { float acc = 0.f;
#pragma unroll 8
            for (int t = 0; t < 64; ++t) { acc += Lb[t * 129 + F.tid]; Lb[t * 129 + F.tid] = acc; }
            EBL[(size_t)u * 128 + F.tid] = __expf(acc); }
        __syncthreads();
        for (int idx = F.tid; idx < 8192; idx += NWAVES * 64) { const int t = idx >> 7, d = idx & 127; const float bt = Lb[t * 129 + d], bl = Lb[63 * 129 + d];
            const float q = bf2f(COLS[(row0 + t) * NMAIN + CB_Q + h * 128 + d]) * 0.08838834764831845f, k = bf2f(COLS[(row0 + t) * NMAIN + CB_K + h * 128 + d]);
            const float qd = q * __expf(bt); Qd[t * 129 + d] = qd; Ki[t * 129 + d] = k * __expf(-bt); Kt[d * 72 + t] = (bf16)f2bf(k * __expf(bl - bt));
            QDEC[((size_t)u * 64 + t) * 128 + d] = (bf16)f2bf(qd); }
        __syncthreads();
#pragma unroll
        for (int i = 0; i < 2; ++i) { const int c_ = F.tid + 512 * i, row = c_ >> 3, ch = c_ & 7; const LAS v2u* sp = (const LAS v2u*)(Kt + row * 72 + ch * 8); const v2u a = sp[0], bb = sp[1];
            *(v4u*)(KDT + ((size_t)u * 128 + row) * 64 + ch * 8) = (v4u){a.x, a.y, bb.x, bb.y}; }
        { const int c = F.tid >> 3, sg = F.tid & 7; float acc[8];
#pragma unroll
          for (int e = 0; e < 8; ++e) acc[e] = 0.f;
#pragma unroll 4
          for (int d = 0; d < 128; ++d) { const float q = Qd[c * 129 + d];
#pragma unroll
              for (int e = 0; e < 8; ++e) acc[e] += q * Ki[(sg * 8 + e) * 129 + d]; }
#pragma unroll
          for (int e = 0; e < 8; ++e) if (sg * 8 + e > c) acc[e] = 0.f;
          *(v4u*)(AMg + ((size_t)u * 64 + c) * 64 + sg * 8) = pack8(acc); }
    }
}
__device__ __forceinline__ void prep_vt(Frame& F, int pass) {
    LAS bf16* T = (LAS bf16*)(F.lds + RING_OFF);
    const bf16* COLS = WSP(bf16, WS_COLS);
    const int nch = pass == 0 ? 144 : 128, nvr = nch * 8;
    for (int tile = F.bx; tile < M / 32; tile += F.G) {
        const int b = tile >> 8, t0 = (tile & 255) * 32;
        __syncthreads();
        for (int idx = F.tid; idx < 32 * nch; idx += NWAVES * 64) { const int tok = idx / nch, ch = idx % nch;
            const int col = pass == 0 ? (ch < 128 ? CA_V + ch * 8 : CD_V + (ch - 128) * 8) : (pass == 1 ? CB_V + ch * 8 : CB_G + ch * 8);
            const v4u v = *(const v4u*)(COLS + (size_t)(b * SEQ + t0 + tok) * NMAIN + col); LAS v2u* d = (LAS v2u*)(T + tok * 1160 + ch * 8); d[0] = (v2u){v.x, v.y}; d[1] = (v2u){v.z, v.w}; }
        __syncthreads();
        for (int idx = F.tid; idx < nvr * 4; idx += NWAVES * 64) { const int ch = idx / nvr, vrow = idx % nvr;
            unsigned e[8];
#pragma unroll
            for (int k = 0; k < 8; ++k) e[k] = T[(ch * 8 + k) * 1160 + vrow];
            v4u o; o.x = e[0] | (e[1] << 16); o.y = e[2] | (e[3] << 16); o.z = e[4] | (e[5] << 16); o.w = e[6] | (e[7] << 16);
            bf16* dst;
            if (pass == 0) dst = vrow < 1024 ? WSP(bf16, WS_VTA) + ((size_t)(b * 8 + (vrow >> 7)) * 128 + (vrow & 127)) * VROW : WSP(bf16, WS_VTD) + ((size_t)(b * 2 + ((vrow - 1024) >> 6)) * 64 + ((vrow - 1024) & 63)) * VROW;
            else dst = WSP(bf16, WS_VTB) + ((size_t)b * 1024 + vrow) * VROW;
            *(v4u*)(dst + t0 + ch * 8) = o; }
    }
}
typedef float f32x4v __attribute__((ext_vector_type(4)));
__device__ __forceinline__ float sum16(float v) { v = sum8(v); v += dpp_f<0x140>(v); return v; }
#define LDS_BARRIER() asm volatile("s_waitcnt lgkmcnt(0)\n\ts_barrier" ::: "memory")
template <int HACK = 0> __device__ __forceinline__ void gla_scan_unit(Frame& F, int l, int b, int h, int vh) {
    LAS unsigned char* L = F.lds + RING_OFF;
    constexpr int OQD = 0, OKT = 17408, OAM = 35840, OVT = 45056, OOT = 63488, OEB = 80896, OPS = 81408;
    const int tid = F.tid, lane = F.lane, n = lane & 15, g = lane >> 4, w = F.wave;
    const bf16* QDEC = WSP(bf16, WS_QDEC); const bf16* KDT = WSP(bf16, WS_KDT); const bf16* AMg = WSP(bf16, WS_AM); const float* EBL = WSP(float, WS_EBL);
    const bf16* VTB = WSP(bf16, WS_VTB) + (size_t)((b * 4 + h) * 256 + 128 * vh) * VROW; bf16* OB = WSP(bf16, WS_OB); float* PSG = WSP(float, WS_PSG);
    f32x4v S[8];
#pragma unroll
    for (int dt = 0; dt < 8; ++dt) S[dt] = (f32x4v){0.f, 0.f, 0.f, 0.f};
    v4u pq[2], pk[2], pa, pv[2]; float pe = 0.f;
#define GL_ISSUE(CK) do { const size_t u_ = (size_t)(b * 4 + h) * 128 + (CK); \
        _Pragma("unroll") for (int i = 0; i < 2; ++i) { const int c_ = tid + 512 * i; pq[i] = *(const v4u*)(QDEC + (u_ * 64 + (c_ >> 4)) * 128 + (c_ & 15) * 8); pk[i] = *(const v4u*)(KDT + (u_ * 128 + (c_ >> 3)) * 64 + (c_ & 7) * 8); \
            pv[i] = *(const v4u*)(VTB + (size_t)(c_ >> 3) * VROW + (CK) * 64 + (c_ & 7) * 8); } \
        pa = *(const v4u*)(AMg + (u_ * 64 + (tid >> 3)) * 64 + (tid & 7) * 8); \
        pe = EBL[u_ * 128 + (tid & 127)]; } while (0)
#define GL_WRITE() do { _Pragma("unroll") for (int i = 0; i < 2; ++i) { const int c_ = tid + 512 * i; *(LAS v4u*)(L + OQD + (c_ >> 4) * 272 + (c_ & 15) * 16) = pq[i]; *(LAS v4u*)(L + OKT + (c_ >> 3) * 144 + (c_ & 7) * 16) = pk[i]; \
            *(LAS v4u*)(L + OVT + (c_ >> 3) * 144 + (c_ & 7) * 16) = pv[i]; } \
        *(LAS v4u*)(L + OAM + (tid >> 3) * 144 + (tid & 7) * 16) = pa; \
        ((LAS float*)(L + OEB))[tid & 127] = pe; } while (0)
    GL_ISSUE(0); GL_WRITE();
    LDS_BARRIER();
#pragma unroll 1
    for (int ck = 0; ck < 128; ++ck) {
        const size_t row0 = (size_t)b * SEQ + ck * 64;
        GL_ISSUE((HACK & 1) && ck >= 2 ? 2 : (ck + 1 < 128 ? ck + 1 : 127));
        bf16x8 vf[2];
#pragma unroll
        for (int ks = 0; ks < 2; ++ks) vf[ks] = *(const LAS bf16x8*)(L + OVT + (16 * w + n) * 144 + (32 * ks + 8 * g) * 2);
        f32x4v o[4];
#pragma unroll
        for (int ct = 0; ct < 4; ++ct) o[ct] = (f32x4v){0.f, 0.f, 0.f, 0.f};
#pragma unroll
        for (int ct = 0; ct < 4; ++ct)
#pragma unroll
            for (int ks = 0; ks < 2; ++ks) { const bf16x8 af = *(const LAS bf16x8*)(L + OAM + (16 * ct + n) * 144 + (32 * ks + 8 * g) * 2); o[ct] = __builtin_amdgcn_mfma_f32_16x16x32_bf16(af, vf[ks], o[ct], 0, 0, 0); }
#pragma unroll
        for (int kk = 0; kk < 4; ++kk) { v4u pw; pw.x = pg8::cvt_pk_bf16(S[2 * kk][0], S[2 * kk][1]); pw.y = pg8::cvt_pk_bf16(S[2 * kk][2], S[2 * kk][3]);
            pw.z = pg8::cvt_pk_bf16(S[2 * kk + 1][0], S[2 * kk + 1][1]); pw.w = pg8::cvt_pk_bf16(S[2 * kk + 1][2], S[2 * kk + 1][3]); const bf16x8 sf = __builtin_bit_cast(bf16x8, pw);
#pragma unroll
            for (int ct = 0; ct < 4; ++ct) { const LAS unsigned char* qp = L + OQD + (16 * ct + n) * 272 + (32 * kk + 4 * g) * 2; const v2u qa = *(const LAS v2u*)qp, qb = *(const LAS v2u*)(qp + 32);
                o[ct] = __builtin_amdgcn_mfma_f32_16x16x32_bf16(__builtin_bit_cast(bf16x8, (v4u){qa.x, qa.y, qb.x, qb.y}), sf, o[ct], 0, 0, 0); } }
#pragma unroll
        for (int dt = 0; dt < 8; ++dt) { const f32x4v eb = *(const LAS f32x4v*)(L + OEB + (16 * dt + 4 * g) * 4); S[dt] = S[dt] * eb;
#pragma unroll
            for (int ks = 0; ks < 2; ++ks) { const bf16x8 kf = *(const LAS bf16x8*)(L + OKT + (16 * dt + n) * 144 + (32 * ks + 8 * g) * 2); S[dt] = __builtin_amdgcn_mfma_f32_16x16x32_bf16(kf, vf[ks], S[dt], 0, 0, 0); } }
        LAS float* PS = (LAS float*)(L + OPS) + (ck & 1) * 512;
#pragma unroll
        for (int ct = 0; ct < 4; ++ct)
#pragma unroll
            for (int r = 0; r < 4; ++r) { const float ss = sum16(o[ct][r] * o[ct][r]); if (n == 0) PS[(16 * ct + 4 * g + r) * 8 + w] = ss;
                *(LAS bf16*)(L + OOT + (16 * ct + 4 * g + r) * 272 + (16 * w + n) * 2) = (bf16)f2bf(o[ct][r]); }
        LDS_BARRIER();
        GL_WRITE();
        if (!(HACK & 2)) {
#pragma unroll
        for (int i = 0; i < 2; ++i) { const int c_ = tid + 512 * i, tok = c_ >> 4, ch = c_ & 15; *(v4u*)(OB + (row0 + tok) * 1024 + h * 256 + 128 * vh + ch * 8) = *(const LAS v4u*)(L + OOT + tok * 272 + ch * 16); }
        if (tid < 64) { const LAS f32x4v* pp = (const LAS f32x4v*)(PS + tid * 8); const f32x4v p0 = pp[0], p1 = pp[1]; PSG[(row0 + tid) * 8 + h * 2 + vh] = ((p0.x + p0.y) + (p0.z + p0.w)) + ((p1.x + p1.y) + (p1.z + p1.w)); } }
        LDS_BARRIER();
    }
#undef GL_ISSUE
#undef GL_WRITE
}
__device__ __forceinline__ void gla_post(Frame& F, int l) {
    const bf16* OB = WSP(bf16, WS_OB); const float* PSG = WSP(float, WS_PSG); const bf16* COLS = WSP(bf16, WS_COLS); bf16* MIX = WSP(bf16, WS_MIXED);
    const int ch = F.tid & 127, h = ch >> 5; float gain8[8];
#pragma unroll
    for (int e = 0; e < 8; ++e) gain8[e] = F.kin[I_GON][l * 256 + (ch & 31) * 8 + e];
    for (int row = F.bx * 4 + (F.tid >> 7); row < M; row += F.G * 4) {
        float ov[8], gv[8]; unpack8(*(const v4u*)(OB + (size_t)row * 1024 + ch * 8), ov); unpack8(*(const v4u*)(COLS + (size_t)row * NMAIN + CB_G + ch * 8), gv);
        const f32x2_t ps = *(const f32x2_t*)(PSG + (size_t)row * 8 + h * 2); const float rstd = rsqrtf((ps.x + ps.y) * (1.0f / 256.0f) + 1e-6f);
#pragma unroll
        for (int e = 0; e < 8; ++e) ov[e] = ov[e] * (rstd * gain8[e]) * silu_g(gv[e]);
        *(v4u*)(MIX + (size_t)row * DM + 1024 + ch * 8) = pack8(ov);
    }
}
constexpr int RC_AT = 0, RC_RT = 2048, RC_BK = 4096, RC_VF = 8192, RC_GF = 10240, RC_U0 = 12288, RC_Y0 = 16384, RC_P15 = 20480, RC_BN = 20736, RC_BYTES = 20800;
__device__ __forceinline__ void rwkv_chunks_of_tile(Frame& F, int l, int tile) {
    const int team = F.tid >> 8, tt = F.tid & 255;
    LAS float* Lt = (LAS float*)(F.lds + RING_OFF) + team * 12288;
    LAS float* XA = Lt; LAS float* XR = Lt + 1040; LAS float* ZB = Lt + 2080; LAS float* ZK = Lt + 3120; LAS float* TB = Lt + 4160; LAS float* TK = Lt + 5200; LAS float* VV = Lt + 6240;
    LAS float* ATl = Lt + 7280; LAS float* U0l = Lt + 8320; LAS float* W1 = Lt + 9360;
    LAS float* Aab = Lt + 10400; LAS float* Aak = Lt + 10672; LAS float* Arb = Lt + 10944; LAS float* Ark = Lt + 11216; LAS float* TT = Lt + 11488;
    const float* RW = WSP(float, WS_RW); const unsigned* RWU = WSP(unsigned, WS_RW); constexpr size_t RS = RW_ONE / 4; unsigned char* RWC = F.ws + WS_RWC;
    float pw_[6], pr_[4], pk_[4], pv_[4], pa_[4], pb_[4], pg_[4];
#define RC_FETCH(P) do { const int h_ = 2 * (P) + team; const size_t cb_ = (size_t)tile * 16 * 1024 + h_ * 64 + (tt & 63); const int q_ = tt >> 6; \
        pw_[4] = RW[RS + cb_ + (size_t)(q_ ? 4 * q_ - 1 : 0) * 1024]; pw_[5] = RW[RS + cb_ + (size_t)15 * 1024];            \
        _Pragma("unroll") for (int e = 0; e < 4; ++e) { const size_t o_ = cb_ + (size_t)(4 * q_ + e) * 1024; pw_[e] = RW[RS + o_]; const unsigned u0 = RWU[o_], u2 = RWU[2 * RS + o_], u3 = RWU[3 * RS + o_]; \
            pr_[e] = bflo(u0); pk_[e] = bfhi(u0); pv_[e] = bflo(u2); pg_[e] = bfhi(u2); pa_[e] = bflo(u3); pb_[e] = bfhi(u3); } } while (0)
    RC_FETCH(0);
#pragma unroll 1
    for (int pair = 0; pair < 8; ++pair) {
        const int uc = ((tile >> 9) * 16 + 2 * pair + team) * 512 + (tile & 511), b = uc >> 13, h = (uc >> 9) & 15, ck = uc & 511; unsigned char* rec = RWC + ((size_t)ck * 32 + (uc >> 9)) * RC_BYTES;     (void)b;
        __syncthreads();
        {
          const int j = tt & 63, q = tt >> 6;
          const float cl = pw_[5], clm = q ? pw_[4] : 0.f; const float clq[4] = {pw_[0], pw_[1], pw_[2], pw_[3]};
#pragma unroll
          for (int e = 0; e < 4; ++e) { const int t = 4 * q + e; const float cprev = e == 0 ? clm : clq[e - 1], cc = clq[e];
              const float rr = pr_[e], kk = pk_[e], vv = pv_[e], aa = pa_[e], bb = pb_[e];
              XA[t * 65 + j] = aa * __expf(cprev); XR[t * 65 + j] = rr * __expf(cc); const float ei = __expf(-cc), ef = __expf(cl - cc);
              ZB[t * 65 + j] = bb * ei; ZK[t * 65 + j] = kk * ei; TB[t * 65 + j] = bb * ef; TK[t * 65 + j] = kk * ef; VV[t * 65 + j] = vv; }
          if (q == 0) ((float*)(rec + RC_P15))[j] = __expf(cl);
          { v2u gw; gw.x = pk2(pg_[0], pg_[1]); gw.y = pk2(pg_[2], pg_[3]); *(v2u*)(rec + RC_GF + (((j >> 4) * 64 + 16 * q + (j & 15)) * 8)) = gw; } }
        RC_FETCH(pair < 7 ? pair + 1 : 7);
        __syncthreads();
        {
          const int q = tt >> 6, n = tt & 15, g = (tt >> 4) & 3; const LAS float* X = (q & 2) ? XR : XA; const LAS float* Z = (q & 1) ? ZK : ZB; LAS float* O = q == 0 ? Aab : (q == 1 ? Aak : (q == 2 ? Arb : Ark));
          f32x4v c = (f32x4v){0.f, 0.f, 0.f, 0.f};
#pragma unroll
          for (int ks = 0; ks < 16; ++ks) c = __builtin_amdgcn_mfma_f32_16x16x4f32(X[n * 65 + 4 * ks + g], Z[n * 65 + 4 * ks + g], c, 0, 0, 0);
#pragma unroll
          for (int rr = 0; rr < 4; ++rr) { const int t = 4 * g + rr; O[t * 17 + n] = ((q & 2) ? n <= t : n < t) ? c[rr] : 0.f; }
          { const int t = tt >> 4, jq = tt & 15; const float* rkp = F.kin[I_RRK] + l * 1024 + h * 64 + 4 * jq; float bn = 0.f;
#pragma unroll
            for (int e = 0; e < 4; ++e) bn += XR[t * 65 + 4 * jq + e] * ZK[t * 65 + 4 * jq + e] * rkp[e];
            bn = sum16(bn); if (jq == 0) ((float*)(rec + RC_BN))[t] = bn; } }
        __syncthreads();
        {
          if (tt < 16) { float col[16];
#pragma unroll
              for (int t = 0; t < 16; ++t) { float acc = (t == tt) ? 1.f : 0.f;
#pragma unroll
                  for (int s = 0; s < 16; ++s) if (s < t) acc += Aab[t * 17 + s] * col[s];
                  col[t] = acc; TT[t * 17 + tt] = acc; } }
          const int q = tt >> 6, n = tt & 15, g = (tt >> 4) & 3; f32x4v c = (f32x4v){0.f, 0.f, 0.f, 0.f};
#pragma unroll
          for (int ks = 0; ks < 4; ++ks) c = __builtin_amdgcn_mfma_f32_16x16x4f32(Aak[n * 17 + 4 * ks + g], VV[(4 * ks + g) * 65 + 16 * q + n], c, 0, 0, 0);
#pragma unroll
          for (int rr = 0; rr < 4; ++rr) W1[(4 * g + rr) * 65 + 16 * q + n] = c[rr]; }
        __syncthreads();
        {
          const int q = tt >> 6, n = tt & 15, g = (tt >> 4) & 3; f32x4v ca = (f32x4v){0.f, 0.f, 0.f, 0.f}, cu = (f32x4v){0.f, 0.f, 0.f, 0.f};
#pragma unroll
          for (int ks = 0; ks < 4; ++ks) { const float tv = TT[n * 17 + 4 * ks + g]; ca = __builtin_amdgcn_mfma_f32_16x16x4f32(tv, XA[(4 * ks + g) * 65 + 16 * q + n], ca, 0, 0, 0); cu = __builtin_amdgcn_mfma_f32_16x16x4f32(tv, W1[(4 * ks + g) * 65 + 16 * q + n], cu, 0, 0, 0); }
#pragma unroll
          for (int rr = 0; rr < 4; ++rr) { ATl[(4 * g + rr) * 65 + 16 * q + n] = ca[rr]; U0l[(4 * g + rr) * 65 + 16 * q + n] = cu[rr]; }
          *(f32x4v*)(rec + RC_U0 + ((q * 64 + 16 * g + n) * 16)) = cu; }
        __syncthreads();
        {
          const int q = tt >> 6, n = tt & 15, g = (tt >> 4) & 3; f32x4v cr, cy = (f32x4v){0.f, 0.f, 0.f, 0.f};
#pragma unroll
          for (int rr = 0; rr < 4; ++rr) cr[rr] = XR[(4 * g + rr) * 65 + 16 * q + n];
#pragma unroll
          for (int ks = 0; ks < 4; ++ks) { const float arb = Arb[n * 17 + 4 * ks + g], ark = Ark[n * 17 + 4 * ks + g];
              cr = __builtin_amdgcn_mfma_f32_16x16x4f32(arb, ATl[(4 * ks + g) * 65 + 16 * q + n], cr, 0, 0, 0);
              cy = __builtin_amdgcn_mfma_f32_16x16x4f32(arb, U0l[(4 * ks + g) * 65 + 16 * q + n], cy, 0, 0, 0);
              cy = __builtin_amdgcn_mfma_f32_16x16x4f32(ark, VV[(4 * ks + g) * 65 + 16 * q + n], cy, 0, 0, 0); }
          *(f32x4v*)(rec + RC_Y0 + ((q * 64 + 16 * g + n) * 16)) = cy;
#pragma unroll
          for (int rr = 0; rr < 4; ++rr) W1[(4 * g + rr) * 65 + 16 * q + n] = cr[rr]; }
        __syncthreads();
        { const int t = tt & 15, jq = tt >> 4, kk = jq >> 3, half = (jq & 7) >> 2, g = jq & 3, j0 = 4 * jq;
          v2u wa, wr; wa.x = pk2(ATl[t * 65 + j0], ATl[t * 65 + j0 + 1]); wa.y = pk2(ATl[t * 65 + j0 + 2], ATl[t * 65 + j0 + 3]); wr.x = pk2(W1[t * 65 + j0], W1[t * 65 + j0 + 1]); wr.y = pk2(W1[t * 65 + j0 + 2], W1[t * 65 + j0 + 3]);
          *(v2u*)(rec + RC_AT + kk * 1024 + (16 * g + t) * 16 + half * 8) = wa; *(v2u*)(rec + RC_RT + kk * 1024 + (16 * g + t) * 16 + half * 8) = wr;
          const int j = tt & 63, gg = tt >> 6; v4u bk; bk.x = pk2(TB[(4 * gg) * 65 + j], TB[(4 * gg + 1) * 65 + j]); bk.y = pk2(TB[(4 * gg + 2) * 65 + j], TB[(4 * gg + 3) * 65 + j]);
          bk.z = pk2(TK[(4 * gg) * 65 + j], TK[(4 * gg + 1) * 65 + j]); bk.w = pk2(TK[(4 * gg + 2) * 65 + j], TK[(4 * gg + 3) * 65 + j]);
          *(v4u*)(rec + RC_BK + (j >> 4) * 1024 + (16 * gg + (j & 15)) * 16) = bk;
          v2u vf; vf.x = pk2(VV[(4 * gg) * 65 + j], VV[(4 * gg + 1) * 65 + j]); vf.y = pk2(VV[(4 * gg + 2) * 65 + j], VV[(4 * gg + 3) * 65 + j]);
          *(v2u*)(rec + RC_VF + ((j >> 4) * 64 + 16 * gg + (j & 15)) * 8) = vf; }
    }
}
#undef RC_FETCH
template <int HACK = 0> __device__ __forceinline__ void rwkv_scan_unit(Frame& F, int l, int b, int h) {
    LAS unsigned char* L = F.lds + RING_OFF;
    const unsigned char* recs = F.ws + WS_RWC + (size_t)(b * 16 + h) * RC_BYTES;
    const int lane = F.lane, n = lane & 15, g = lane >> 4;
    LAS float* XS = (LAS float*)(L + 2 * RC_BYTES);
    if (F.wave >= 2) {
        const int li = F.tid - 128;
        int px[4];
#pragma unroll
        for (int k = 0; k < 4; ++k) { const int x = li + 384 * k; px[k] = x < 1300 ? x : 1299; }
        v4u p0[4], p1[4], p2[4], p3[4], p4[4], p5[4], p6[4], p7[4];
#define RWL_ISSUE(P, CK) do { const int ck_ = (CK) < 512 ? ((HACK & 1) && (CK) >= 4 ? 3 : (CK)) : 511; const v4u* src_ = (const v4u*)(recs + (size_t)ck_ * 32 * RC_BYTES); \
        _Pragma("unroll") for (int k = 0; k < 4; ++k) P[k] = src_[px[k]]; } while (0)
#define RWL_WRITE(P, CK) do { LAS v4u* dst_ = (LAS v4u*)(L + ((CK) & 1) * RC_BYTES); _Pragma("unroll") for (int k = 0; k < 4; ++k) dst_[px[k]] = P[k]; } while (0)
        RWL_ISSUE(p0, 0); RWL_ISSUE(p1, 1); RWL_ISSUE(p2, 2); RWL_ISSUE(p3, 3); RWL_ISSUE(p4, 4); RWL_ISSUE(p5, 5); RWL_ISSUE(p6, 6); RWL_ISSUE(p7, 7);
        RWL_WRITE(p0, 0); RWL_ISSUE(p0, 8);
        LDS_BARRIER();
#pragma unroll 1
        for (int ck = 0; ck < 512; ck += 8) {
            RWL_WRITE(p1, ck + 1); RWL_ISSUE(p1, ck + 9); LDS_BARRIER();
            RWL_WRITE(p2, ck + 2); RWL_ISSUE(p2, ck + 10); LDS_BARRIER();
            RWL_WRITE(p3, ck + 3); RWL_ISSUE(p3, ck + 11); LDS_BARRIER();
            RWL_WRITE(p4, ck + 4); RWL_ISSUE(p4, ck + 12); LDS_BARRIER();
            RWL_WRITE(p5, ck + 5); RWL_ISSUE(p5, ck + 13); LDS_BARRIER();
            RWL_WRITE(p6, ck + 6); RWL_ISSUE(p6, ck + 14); LDS_BARRIER();
            RWL_WRITE(p7, ck + 7); RWL_ISSUE(p7, ck + 15); LDS_BARRIER();
            RWL_WRITE(p0, ck + 8); RWL_ISSUE(p0, ck + 16); LDS_BARRIER();
        }
#undef RWL_ISSUE
#undef RWL_WRITE
        return;
    }
    const int cw = F.wave;
    f32x4v S[4][2];
#pragma unroll
    for (int jt = 0; jt < 4; ++jt)
#pragma unroll
        for (int it = 0; it < 2; ++it) S[jt][it] = (f32x4v){0.f, 0.f, 0.f, 0.f};
    float lnw[2], lnb[2];
#pragma unroll
    for (int it = 0; it < 2; ++it) { lnw[it] = F.kin[I_RLNW][l * 1024 + h * 64 + 16 * (2 * cw + it) + n]; lnb[it] = F.kin[I_RLNB][l * 1024 + h * 64 + 16 * (2 * cw + it) + n]; }
    bf16* MIX = WSP(bf16, WS_MIXED) + ((size_t)b * SEQ) * DM + 2048 + h * 64 + 32 * cw + n;
    f32x4v Yp[2] = {(f32x4v){0.f, 0.f, 0.f, 0.f}, (f32x4v){0.f, 0.f, 0.f, 0.f}}, bnp = (f32x4v){0.f, 0.f, 0.f, 0.f}; v2u gfp[2] = {(v2u){0u, 0u}, (v2u){0u, 0u}}, vfp[2] = {(v2u){0u, 0u}, (v2u){0u, 0u}};
    LDS_BARRIER();
#pragma unroll 1
    for (int ck = 0; ck <= 512; ++ck) {
        if (ck > 0) {
            const LAS float* xs = XS + ((ck - 1) & 1) * 64; const f32x4v a0 = *(const LAS f32x4v*)(xs + 8 * g), a1 = *(const LAS f32x4v*)(xs + 8 * g + 4), b0 = *(const LAS f32x4v*)(xs + 32 + 8 * g), b1 = *(const LAS f32x4v*)(xs + 32 + 8 * g + 4);
            const float s1[4] = {a0[0] + b0[0], a0[2] + b0[2], a1[0] + b1[0], a1[2] + b1[2]}, s2[4] = {a0[1] + b0[1], a0[3] + b0[3], a1[1] + b1[1], a1[3] + b1[3]};
#pragma unroll
            for (int it = 0; it < 2; ++it) { const float gt[4] = {bflo(gfp[it].x), bfhi(gfp[it].x), bflo(gfp[it].y), bfhi(gfp[it].y)}, vt[4] = {bflo(vfp[it].x), bfhi(vfp[it].x), bflo(vfp[it].y), bfhi(vfp[it].y)};
#pragma unroll
                for (int r = 0; r < 4; ++r) { const float mean = s1[r] * (1.0f / 64.0f), var = fmaxf(s2[r] * (1.0f / 64.0f) - mean * mean, 0.f), rstd = rsqrtf(var + 64e-5f);
                    if (!(HACK & 2)) MIX[(size_t)((ck - 1) * 16 + 4 * g + r) * DM + 16 * it] = (bf16)f2bf(((Yp[it][r] - mean) * rstd * lnw[it] + lnb[it] + bnp[r] * vt[r]) * gt[r]); } }
            if (ck == 512) break;
        }
        if (HACK & 4) { LDS_BARRIER(); continue; }
        const LAS unsigned char* R = L + (ck & 1) * RC_BYTES;
        bf16x8 at[2], rt[2];
#pragma unroll
        for (int kk = 0; kk < 2; ++kk) { at[kk] = *(const LAS bf16x8*)(R + RC_AT + kk * 1024 + lane * 16); rt[kk] = *(const LAS bf16x8*)(R + RC_RT + kk * 1024 + lane * 16); }
        f32x4v U[2], Y[2];
#pragma unroll
        for (int it = 0; it < 2; ++it) { U[it] = *(const LAS f32x4v*)(R + RC_U0 + (2 * cw + it) * 1024 + lane * 16); Y[it] = *(const LAS f32x4v*)(R + RC_Y0 + (2 * cw + it) * 1024 + lane * 16); }
#pragma unroll
        for (int kk = 0; kk < 2; ++kk)
#pragma unroll
            for (int it = 0; it < 2; ++it) { v4u pw; pw.x = pg8::cvt_pk_bf16(S[2 * kk][it][0], S[2 * kk][it][1]); pw.y = pg8::cvt_pk_bf16(S[2 * kk][it][2], S[2 * kk][it][3]);
                pw.z = pg8::cvt_pk_bf16(S[2 * kk + 1][it][0], S[2 * kk + 1][it][1]); pw.w = pg8::cvt_pk_bf16(S[2 * kk + 1][it][2], S[2 * kk + 1][it][3]); const bf16x8 sf = __builtin_bit_cast(bf16x8, pw);
                U[it] = __builtin_amdgcn_mfma_f32_16x16x32_bf16(at[kk], sf, U[it], 0, 0, 0); Y[it] = __builtin_amdgcn_mfma_f32_16x16x32_bf16(rt[kk], sf, Y[it], 0, 0, 0); }
        bf16x8 uv[2];
#pragma unroll
        for (int it = 0; it < 2; ++it) { vfp[it] = *(const LAS v2u*)(R + RC_VF + (2 * cw + it) * 512 + lane * 8); gfp[it] = *(const LAS v2u*)(R + RC_GF + (2 * cw + it) * 512 + lane * 8);
            v4u pw; pw.x = pg8::cvt_pk_bf16(U[it][0], U[it][1]); pw.y = pg8::cvt_pk_bf16(U[it][2], U[it][3]); pw.z = vfp[it].x; pw.w = vfp[it].y; uv[it] = __builtin_bit_cast(bf16x8, pw); }
#pragma unroll
        for (int jt = 0; jt < 4; ++jt) { const bf16x8 bk = *(const LAS bf16x8*)(R + RC_BK + jt * 1024 + lane * 16); const f32x4v p15 = *(const LAS f32x4v*)(R + RC_P15 + (16 * jt + 4 * g) * 4);
#pragma unroll
            for (int it = 0; it < 2; ++it) S[jt][it] = __builtin_amdgcn_mfma_f32_16x16x32_bf16(bk, uv[it], S[jt][it] * p15, 0, 0, 0); }
        bnp = *(const LAS f32x4v*)(R + RC_BN + 16 * g); Yp[0] = Y[0]; Yp[1] = Y[1];
        { LAS float* xo = XS + (ck & 1) * 64 + cw * 32; const f32x4v sm = Y[0] + Y[1], sq = Y[0] * Y[0] + Y[1] * Y[1];
#pragma unroll
          for (int r = 0; r < 4; ++r) { const float a = sum16(sm[r]), q = sum16(sq[r]); if (n == 0) { xo[(4 * g + r) * 2] = a; xo[(4 * g + r) * 2 + 1] = q; } } }
        LDS_BARRIER();
    }
}
template <int HACK = 0> __device__ __forceinline__ void mixers_v4(Frame& F, int l, int qi, int mask = 15) {
    gu32* ctr = F.ctl + CW_Q + 64 * qi;
    for (;;) {
        const int it = next_item(F, ctr); relaunder(F); relaunder_tid(F);
        if (it < 32) { if (mask & 1) rwkv_scan_unit<HACK>(F, l, it >> 4, it & 15); }
        else if (it < 48) { const int j = it - 32; if (mask & 2) gla_scan_unit<HACK>(F, l, j >> 3, (j >> 1) & 3, j & 1); }
        else if (it < 48 + 1024) { const int j = it - 48, qb = 63 - (j >> 4), bh = j & 15; if (mask & 4) attn_unit<true>(F, l, bh >> 3, bh & 7, qb); }
        else if (it < 48 + 2048) { const int j = it - 1072, qb = j & 63, bh = j >> 6; if (mask & 8) attn_unit<false>(F, l, bh >> 3, bh & 7, qb); }
        else break;
    }
}
template <int HACK = 0> __device__ __forceinline__ void prep_rwkv(Frame& F, int l) {
    LAS float* zl = (LAS float*)(F.lds + RING_OFF) + 4096;
    LAS bf16* inb = (LAS bf16*)(F.lds + RING_OFF);
    const float* mu = F.kin[I_RMU] + (size_t)l * 3264;
    const float* LOWR = WSP(float, WS_LOWR); const bf16* COLS = WSP(bf16, WS_COLS);
    float* RW = WSP(float, WS_RW); unsigned* RWU = WSP(unsigned, WS_RW); float* VF = WSP(float, WS_VFIRST);
    constexpr size_t RS = RW_ONE / 4;
    for (int tile = F.bx; tile < M / 16; tile += F.G) {
        const int row0 = tile * 16;
        relaunder(F); relaunder_tid(F);
        __syncthreads();
        for (int idx = F.tid; idx < 16 * 224; idx += NWAVES * 64) { const int tt = idx / 224, j = idx % 224, row = row0 + tt, t = row & (SEQ - 1);
            const int col = j < 192 ? 16 + j : 208 + (j - 192);
            const float cur = LOWR[(size_t)row * 256 + col], prev = t > 0 ? LOWR[(size_t)(row - 1) * 256 + col] : 0.f;
            const float muv = j < 192 ? mu[3072 + j] : (l ? F.kin[I_VRMU][(l - 1) * 32 + (j - 192)] : 0.f);
            float x = cur + (prev - cur) * muv;
            if (j < 64) x = tanhf(x); else if (j >= 128 && j < 192) x = sigmoid_f(x);
            inb[tt * 232 + j] = (bf16)f2bf(x); }
        __syncthreads();
        {
            const int c = 2 * F.tid;
            float accw[2][16], acca[2][16], accg[2][16], accv[2][16];
#pragma unroll
            for (int e = 0; e < 2; ++e) { const float bw = F.kin[I_RW0][l * 1024 + c + e], ba = F.kin[I_RA0][l * 1024 + c + e], bv = l ? F.kin[I_VR0][(l - 1) * 1024 + c + e] : 0.f;
#pragma unroll
              for (int tt = 0; tt < 16; ++tt) { accw[e][tt] = bw; acca[e][tt] = ba; accg[e][tt] = 0.f; accv[e][tt] = bv; } }
#define LOWRANK_MFMA(ACC, MI, JOFF, NKS) do { const bf16* wf_ = WSP(bf16, WS_WF) + ((size_t)(l * 448 + ((MI) < 3 ? (MI) * 128 + 16 * (NKS) / 2 * F.wave : 384 + 8 * F.wave)) * 64 + F.lane) * 8; \
            bf16x8 af_[NKS], bf_[8][NKS]; \
            _Pragma("unroll") for (int ks = 0; ks < (NKS); ++ks) af_[ks] = *(const LAS bf16x8*)(inb + (F.lane & 15) * 232 + (JOFF) + 32 * ks + 8 * (F.lane >> 4)); \
            _Pragma("unroll") for (int nt = 0; nt < 8; ++nt) _Pragma("unroll") for (int ks = 0; ks < (NKS); ++ks) bf_[nt][ks] = *(const bf16x8*)(wf_ + (size_t)(nt * (NKS) + ks) * 512); \
            _Pragma("unroll") for (int nt = 0; nt < 8; ++nt) { f32x4 c4 = {0.f, 0.f, 0.f, 0.f}; \
                _Pragma("unroll") for (int ks = 0; ks < (NKS); ++ks) c4 = __builtin_amdgcn_mfma_f32_16x16x32_bf16(af_[ks], bf_[nt][ks], c4, 0, 0, 0); \
                _Pragma("unroll") for (int rr = 0; rr < 4; ++rr) zl[(4 * (F.lane >> 4) + rr) * 1028 + 128 * F.wave + 16 * nt + (F.lane & 15)] = c4[rr]; } \
            __syncthreads(); \
            _Pragma("unroll") for (int tt = 0; tt < 16; ++tt) { const f32x2_t z2 = *(const LAS f32x2_t*)(zl + tt * 1028 + c); ACC[0][tt] += z2.x; ACC[1][tt] += z2.y; } \
            __syncthreads(); } while (0)
            if (!(HACK & 1)) { LOWRANK_MFMA(accw, 0, 0, 2); relaunder(F);
            LOWRANK_MFMA(acca, 1, 64, 2); relaunder(F);
            LOWRANK_MFMA(accg, 2, 128, 2); relaunder(F);
            if (l) LOWRANK_MFMA(accv, 3, 192, 1); }
#undef LOWRANK_MFMA
            relaunder(F);
            float mur[2], muk[2], muv[2], kkv[2], kav[2], pr[2] = {0.f, 0.f}, pk[2] = {0.f, 0.f}, pv[2] = {0.f, 0.f}; float cl[2] = {0.f, 0.f};
#pragma unroll
            for (int e = 0; e < 2; ++e) { mur[e] = F.kin[I_RMU][l * 3264 + c + e]; muk[e] = F.kin[I_RMU][l * 3264 + 1024 + c + e]; muv[e] = F.kin[I_RMU][l * 3264 + 2048 + c + e]; kkv[e] = F.kin[I_RKK][l * 1024 + c + e]; kav[e] = F.kin[I_RKA][l * 1024 + c + e]; }
            if ((row0 & (SEQ - 1)) != 0) { const bf16* p = COLS + (size_t)(row0 - 1) * NMAIN + c; const unsigned ur = *(const unsigned*)(p + CC_R), uk = *(const unsigned*)(p + CC_K), uv = *(const unsigned*)(p + CC_V);
                pr[0] = bflo(ur); pr[1] = bfhi(ur); pk[0] = bflo(uk); pk[1] = bfhi(uk); pv[0] = bflo(uv); pv[1] = bfhi(uv); }
            if (!(HACK & 4))
#pragma unroll
            for (int tt = 0; tt < 16; ++tt) { const int row = row0 + tt; const bf16* p = COLS + (size_t)row * NMAIN + c; const size_t o = (size_t)row * 1024 + c;
                const unsigned ur = *(const unsigned*)(p + CC_R), uk = *(const unsigned*)(p + CC_K), uv = *(const unsigned*)(p + CC_V);
                const float cr[2] = {bflo(ur), bfhi(ur)}, ck[2] = {bflo(uk), bfhi(uk)}, cv[2] = {bflo(uv), bfhi(uv)};
                f32x2_t vf2 = {0.f, 0.f}; if (l != 0) vf2 = *(const f32x2_t*)(VF + o);
                float r[2], k[2], v[2], dec[2], av[2], kk[2], km[2];
#pragma unroll
                for (int e = 0; e < 2; ++e) { r[e] = cr[e] + (pr[e] - cr[e]) * mur[e]; k[e] = ck[e] + (pk[e] - ck[e]) * muk[e]; v[e] = cv[e] + (pv[e] - cv[e]) * muv[e]; pr[e] = cr[e]; pk[e] = ck[e]; pv[e] = cv[e];
                    if (l == 0) vf2[e] = v[e]; else { const float vg = sigmoid_f(accv[e][tt]); v[e] = v[e] + (vf2[e] - v[e]) * vg; }
                    cl[e] += -0.6065306597126334f * sigmoid_f(accw[e][tt]); dec[e] = cl[e]; av[e] = sigmoid_f(acca[e][tt]); kk[e] = k[e] * kkv[e]; km[e] = k[e] * (1.0f + (av[e] - 1.0f) * kav[e]); }
                const float ss = sum32(kk[0] * kk[0] + kk[1] * kk[1]), rn = rsqrtf(fmaxf(ss, 1e-24f)); kk[0] *= rn; kk[1] *= rn;
                if (l == 0) *(f32x2_t*)(VF + o) = vf2;
                *(f32x2_t*)(RW + RS + o) = (f32x2_t){dec[0], dec[1]};
                *(v2u*)(RWU + o) = (v2u){pk2(r[0], km[0]), pk2(r[1], km[1])}; *(v2u*)(RWU + 2 * RS + o) = (v2u){pk2(v[0], accg[0][tt]), pk2(v[1], accg[1][tt])};
                *(v2u*)(RWU + 3 * RS + o) = (v2u){pk2(-kk[0], kk[0] * av[0]), pk2(-kk[1], kk[1] * av[1])}; }
        }
        asm volatile("s_waitcnt vmcnt(0)" ::: "memory"); __syncthreads();
        __builtin_amdgcn_fence(__ATOMIC_ACQUIRE, "agent"); asm volatile("s_waitcnt vmcnt(0)" ::: "memory");
        if (!(HACK & 2)) rwkv_chunks_of_tile(F, l, tile);
    }
}
struct Args { const float* in[35]; float* out; unsigned char* ws; };
__device__ __forceinline__ void mk_frame(Frame& F, int wv) {
    extern __shared__ __attribute__((aligned(16))) unsigned char lds[];
    kargp kp = (kargp)__builtin_amdgcn_kernarg_segment_ptr(); asm volatile("" : "+s"(kp));
    F.kin = kp;
    F.lds = (LAS unsigned char*)lds;
    F.MISC = (volatile LAS unsigned*)(F.lds + MISC_OFF);
    { int w_ = wv; asm volatile("" : "+s"(w_)); int t_ = (int)__builtin_amdgcn_mbcnt_hi(~0u, __builtin_amdgcn_mbcnt_lo(~0u, (unsigned)w_ * 64u)); asm volatile("" : "+v"(t_)); F.tid = t_; } F.lane = F.tid & 63; F.wave = __builtin_amdgcn_readfirstlane(F.tid >> 6);
    F.G = gridDim.x; { int bx = blockIdx.x; asm volatile("" : "+s"(bx)); F.bx = bx; F.vcu = (F.G % 8 == 0) ? (bx % 8) * (F.G / 8) + bx / 8 : bx; }
    F.out = (float*)kp[35]; F.ws = (unsigned char*)kp[36]; F.ctl = (gu32*)(F.ws + WS_CTL);
}
__device__ __forceinline__ void grid_bar(int wv) {
    Frame F; mk_frame(F, wv);
    XcdBarrier bar; bar.bar = (unsigned*)(F.ctl + CW_BAR); bar.x = xb_xcc_id(); bar.st = F.MISC + 8;
    xcd_barrier(bar);
}
__global__ void __launch_bounds__(NWAVES * 64, 2) mega_fwd(Args args) {
    const int wv = __builtin_amdgcn_readfirstlane((int)threadIdx.x >> 6);
    { Frame F; mk_frame(F, wv);
      for (int u = F.tid; u < (LDS_BYTES - LDSCTL_OFF) / 4; u += NWAVES * 64) ((LAS unsigned*)(F.lds + LDSCTL_OFF))[u] = 0u;
      __syncthreads();
      (void)xcd_barrier_post((unsigned*)(F.ctl + CW_BAR), F.MISC + 8);
      p0_prologue_a(F);
    }
    grid_bar(wv);
    { Frame F; mk_frame(F, wv); p0_prologue_b(F); }
    grid_bar(wv);
#pragma unroll 1
    for (int l = 0; l < NLAYER; ++l) {
#define LAYER_VARS const float* mod = WSP(float, WS_MOD) + (size_t)l * 2 * 24576; const float* xin = l == 0 ? F.kin[I_X] : F.out; (void)mod; (void)xin
        { Frame F; mk_frame(F, wv); LAYER_VARS; rms_phase(F, xin, mod + 0, mod + 4096); }
        grid_bar(wv);
        { Frame F; mk_frame(F, wv);
          pg8::Gemm g{WSP(pg8::bf16_t, WS_XN), WSP(pg8::bf16_t, WS_WIN + l * WIN_L), M, NIN, DM}; pg8::StaticOrder S; S.init(M, NIN, F.G, F.bx);
          pg8::EpiCols E{WSP(pg8::bf16_t, WS_COLS), WSP(float, WS_LOWR)};
          pg8::gemm_phase<pg8::EpiCols, pg8::StaticOrder, true, true>(F.lds + RING_OFF, g, S, E, F.tid); }
        grid_bar(wv);
        { Frame F; mk_frame(F, wv); prep_norm(F, l); }
        { Frame F; mk_frame(F, wv); prep_loga(F, l); }
        { Frame F; mk_frame(F, wv); prep_rwkv(F, l); }
        { Frame F; mk_frame(F, wv); prep_vt(F, 0); }
        { Frame F; mk_frame(F, wv); prep_vt(F, 1); }
        { Frame F; mk_frame(F, wv); prep_gla(F); }
        grid_bar(wv);
        { Frame F; mk_frame(F, wv); mixers_v4(F, l, l); }
        grid_bar(wv);
        { Frame F; mk_frame(F, wv); gla_post(F, l); }
        grid_bar(wv);
        { Frame F; mk_frame(F, wv); LAYER_VARS;
          pg8::Gemm g{WSP(pg8::bf16_t, WS_MIXED), WSP(pg8::bf16_t, WS_WOUT + l * WOUT_L), M, DM, DM}; pg8::StaticOrder S; S.init(M, DM, F.G, F.bx);
          pg8::EpiRes E{xin, F.out, mod + 2 * 4096};
          pg8::gemm_phase<pg8::EpiRes, pg8::StaticOrder, true, true>(F.lds + RING_OFF, g, S, E, F.tid); }
        grid_bar(wv);
        { Frame F; mk_frame(F, wv); LAYER_VARS; rms_phase(F, F.out, mod + 3 * 4096, mod + 4 * 4096); }
        grid_bar(wv);
        { Frame F; mk_frame(F, wv);
          pg8::Gemm g{WSP(pg8::bf16_t, WS_XN), WSP(pg8::bf16_t, WS_W13 + l * W13_L), M, 2 * DFF, DM}; pg8::StaticOrder S; S.init(M, 2 * DFF, F.G, F.bx);
          pg8::EpiSwiglu E{WSP(pg8::bf16_t, WS_HID)};
          pg8::gemm_phase<pg8::EpiSwiglu, pg8::StaticOrder, true, true>(F.lds + RING_OFF, g, S, E, F.tid); }
        grid_bar(wv);
        { Frame F; mk_frame(F, wv); LAYER_VARS;
          pg8::Gemm g{WSP(pg8::bf16_t, WS_HID), WSP(pg8::bf16_t, WS_W2 + l * W2_L), M, DM, DFF}; pg8::StaticOrder S; S.init(M, DM, F.G, F.bx);
          pg8::EpiRes E{F.out, F.out, mod + 5 * 4096};
          pg8::gemm_phase<pg8::EpiRes, pg8::StaticOrder, true, true>(F.lds + RING_OFF, g, S, E, F.tid); }
        if (l + 1 < NLAYER) grid_bar(wv);
#undef LAYER_VARS
    }
}

extern "C" void kernel_launch(void* const* d_in, const int* in_sizes, int n_in, void* d_out, int out_size, void* d_ws, size_t ws_size, hipStream_t stream) {
    static int grid = 0;
    if (grid == 0) {
        if (n_in != 35 || in_sizes[0] != M * DM || out_size != M * DM || ws_size < WS_END) { fprintf(stderr, "kernel_launch: unexpected shapes: n_in %d in0 %d out %d ws %zu (need %zu)\n", n_in, n_in > 0 ? in_sizes[0] : -1, out_size, ws_size, (size_t)WS_END); grid = -1; return; }
        int dev = 0, cus = 0, per_cu = 0;
        if (hipGetDevice(&dev) != hipSuccess || hipDeviceGetAttribute(&cus, hipDeviceAttributeMultiprocessorCount, dev) != hipSuccess) { grid = -1; return; }
        if (hipFuncSetAttribute((const void*)mega_fwd, hipFuncAttributeMaxDynamicSharedMemorySize, LDS_BYTES) != hipSuccess) { fprintf(stderr, "kernel_launch: hipFuncSetAttribute failed\n"); grid = -1; return; }
        if (hipOccupancyMaxActiveBlocksPerMultiprocessor(&per_cu, (const void*)mega_fwd, NWAVES * 64, LDS_BYTES) != hipSuccess || per_cu < 1) fprintf(stderr, "kernel_launch: occupancy query says %d\n", per_cu);
        (void)hipGetLastError();
        grid = cus;
    }
    if (grid < 0) return;
    if (hipMemsetAsync((char*)d_ws + WS_CTL, 0, CTL_ZERO_BYTES, stream) != hipSuccess) return;
    Args a{};
    for (int i = 0; i < 35; ++i) a.in[i] = (const float*)d_in[i];
    a.out = (float*)d_out; a.ws = (unsigned char*)d_ws;
    hipLaunchKernelGGL(mega_fwd, dim3(grid), dim3(NWAVES * 64), LDS_BYTES, stream, a);
}
```

```cpp
#include <hip/hip_runtime.h>
#include <cstdio>
#include <cstdint>
namespace pg8 {
#define PG8_LAS __attribute__((address_space(3)))
typedef unsigned short bf16_t;
typedef short bf16x8 __attribute__((ext_vector_type(8)));
typedef float f32x4 __attribute__((ext_vector_type(4)));
typedef unsigned u32x4 __attribute__((ext_vector_type(4)));
constexpr int BM = 256, BK = 64, HALF = 128, HTB = HALF * BK * 2  , STAGE_BYTES = 8 * HTB, NXCD = 8, WGM = 8;

__host__ __device__ __forceinline__ int lds_byte(int r, int c) { const int st = (r >> 4) * 2 + (c >> 5), rr = r & 15, cc = c & 31, ob = rr * 64 + cc * 2; return st * 1024 + (ob ^ (((ob >> 9) & 1) << 5)); }
__host__ __device__ __forceinline__ void stage_rc(int b, int& R, int& C) { const int st = b / 1024, sb = b % 1024, swz = sb ^ (((sb >> 9) & 1) << 5); R = (st >> 1) * 16 + swz / 64; C = (st & 1) * 32 + (swz % 64) / 2; }
__host__ __device__ __forceinline__ int perm32(int rho) { const int n = rho >> 4, i = rho & 15; return 8 * (i >> 2) + 4 * n + (i & 3); }

struct Unit { int pm, pn; };
struct Gemm { const bf16_t* A; const bf16_t* Bt; int M, N, K; };

struct StaticOrder {
    int nM, nN, nwg, G, c;
    __host__ __device__ void init(int M, int N, int G_, int c_) { nM = M / BM; nN = N / BM; nwg = nM * nN; G = G_; c = c_; }
    __host__ __device__ bool next(int i, Unit& u) const {
        const long L = (long)i * G + c; if (L >= nwg) return false;
        int wgid = (int)L; { const int q = nwg / NXCD, r = nwg % NXCD, xcd = wgid % NXCD, off = wgid / NXCD; wgid = (xcd < r ? xcd * (q + 1) : r * (q + 1) + (xcd - r) * q) + off; }
        const int nig = WGM * nN, gid = wgid / nig, fm = gid * WGM, gsz = (nM - fm) < WGM ? (nM - fm) : WGM;
        u.pm = fm + ((wgid % nig) % gsz); u.pn = (wgid % nig) / gsz; return true;
    }
    __device__ __forceinline__ void a_ready(const Unit&) const {}
    __device__ __forceinline__ void done(const Unit&) const {}
};

typedef float f32x2c_t __attribute__((ext_vector_type(2))); typedef __bf16 bf16x2c_t __attribute__((ext_vector_type(2)));
__device__ __forceinline__ unsigned cvt_pk_bf16(float lo, float hi) { const f32x2c_t v = {lo, hi}; return __builtin_bit_cast(unsigned, __builtin_convertvector(v, bf16x2c_t)); }
typedef float f32x2 __attribute__((ext_vector_type(2)));
__device__ __forceinline__ float silu_f(float x) { return x * __builtin_amdgcn_rcpf(1.0f + __builtin_amdgcn_exp2f(-1.4426950408889634f * x)); }
struct EpiCols {
    static constexpr bool PERM = true, AFTER_DRAIN = false;
    bf16_t* O; float* L;
    __device__ __forceinline__ void operator()(const f32x4 (&acc)[2][2][4][2], const Unit& u, int wr, int wc, int fr, int fq) const {
        const int row0 = u.pm * BM + wr * 64 + fr;
        if (u.pn < 41) {
            const int col0 = u.pn * BM + wc * 32 + 8 * fq;
#pragma unroll
            for (int ai = 0; ai < 2; ++ai)
#pragma unroll
                for (int m = 0; m < 4; ++m) { bf16_t* rowp = O + (size_t)(row0 + ai * HALF + m * 16) * 10496 + col0;
#pragma unroll
                    for (int bj = 0; bj < 2; ++bj) { const f32x4 v0 = acc[ai][bj][m][0], v1 = acc[ai][bj][m][1];
                        u32x4 w; w.x = cvt_pk_bf16(v0[0], v0[1]); w.y = cvt_pk_bf16(v0[2], v0[3]); w.z = cvt_pk_bf16(v1[0], v1[1]); w.w = cvt_pk_bf16(v1[2], v1[3]);
                        *(u32x4*)(rowp + bj * HALF) = w; } }
        } else {
            const int col0 = wc * 32 + 8 * fq;
#pragma unroll
            for (int ai = 0; ai < 2; ++ai)
#pragma unroll
                for (int m = 0; m < 4; ++m) { float* rowp = L + (size_t)(row0 + ai * HALF + m * 16) * 256 + col0;
#pragma unroll
                    for (int bj = 0; bj < 2; ++bj) { *(f32x4*)(rowp + bj * HALF) = acc[ai][bj][m][0]; *(f32x4*)(rowp + bj * HALF + 4) = acc[ai][bj][m][1]; } }
        }
    }
};
struct EpiRes {
    static constexpr bool PERM = false, AFTER_DRAIN = false;
    const float* base; float* out; const float* gate;
    __device__ __forceinline__ void operator()(const f32x4 (&acc)[2][2][4][2], const Unit& u, int wr, int wc, int fr, int fq) const {
        const int row0 = u.pm * BM + wr * 64 + fr, col0 = u.pn * BM + wc * 32 + 4 * fq;
        const float* gp = gate + (size_t)(u.pm >> 5) * 24576 + col0;
        f32x4 gv[2][2];
#pragma unroll
        for (int bj = 0; bj < 2; ++bj)
#pragma unroll
            for (int n = 0; n < 2; ++n) gv[bj][n] = *(const f32x4*)(gp + bj * HALF + n * 16);
#pragma unroll
        for (int ai = 0; ai < 2; ++ai)
#pragma unroll
            for (int m = 0; m < 4; ++m) { const size_t off = (size_t)(row0 + ai * HALF + m * 16) * 4096 + col0;
#pragma unroll
                for (int bj = 0; bj < 2; ++bj)
#pragma unroll
                    for (int n = 0; n < 2; ++n) { const f32x4 bs = *(const f32x4*)(base + off + bj * HALF + n * 16); *(f32x4*)(out + off + bj * HALF + n * 16) = bs + gv[bj][n] * acc[ai][bj][m][n]; }
                if (m == 3) asm volatile("" ::: "memory"); }
    }
};
struct EpiSwiglu {
    static constexpr bool PERM = true, AFTER_DRAIN = false;
    bf16_t* H;
    __device__ __forceinline__ void operator()(const f32x4 (&acc)[2][2][4][2], const Unit& u, int wr, int wc, int fr, int fq) const {
        const int row0 = u.pm * BM + wr * 64 + fr, col0 = u.pn * HALF + wc * 32 + 8 * fq;
#pragma unroll
        for (int ai = 0; ai < 2; ++ai)
#pragma unroll
            for (int m = 0; m < 4; ++m) { bf16_t* rowp = H + (size_t)(row0 + ai * HALF + m * 16) * 11008 + col0;
                const f32x4 a0 = acc[ai][0][m][0], a1 = acc[ai][0][m][1], b0 = acc[ai][1][m][0], b1 = acc[ai][1][m][1];
                u32x4 w; w.x = cvt_pk_bf16(silu_f(a0[0]) * b0[0], silu_f(a0[1]) * b0[1]); w.y = cvt_pk_bf16(silu_f(a0[2]) * b0[2], silu_f(a0[3]) * b0[3]);
                w.z = cvt_pk_bf16(silu_f(a1[0]) * b1[0], silu_f(a1[1]) * b1[1]); w.w = cvt_pk_bf16(silu_f(a1[2]) * b1[2], silu_f(a1[3]) * b1[3]);
                *(u32x4*)rowp = w; }
    }
};
template <class Epi, class Sched, bool ALIGN_EPI = false, bool SP2 = false>
__device__ __forceinline__ void gemm_phase(PG8_LAS unsigned char* lds, const Gemm g, const Sched& S, const Epi& E, int tid_in) {
    int tid_ = tid_in; asm volatile("" : "+v"(tid_));
    const int tid = tid_, wid = __builtin_amdgcn_readfirstlane(tid >> 6), lane = tid & 63, wr = wid >> 2, wc = wid & 3, fr = lane & 15, fq = lane >> 4;
    const int K = g.K, nt = K / BK;
    unsigned voffA[2], voffB[2];
#pragma unroll
    for (int i = 0; i < 2; ++i) { int R, C; stage_rc(tid * 16 + i * 8192, R, C); const int Rb = Epi::PERM ? ((R & ~31) + perm32(R & 31)) : R;
        voffA[i] = (unsigned)(R * K + C) * 2u; voffB[i] = (unsigned)(Rb * K + C) * 2u; }
    const size_t kstep = (size_t)(BK * 2);
    const size_t hstep = (size_t)HALF * K * 2;
    const size_t tstep = 2 * hstep;
    const unsigned ldsw = (unsigned)wid * 1024u;
    const int aoff = lds_byte(wr * 64 + fr, fq * 8), boff = lds_byte(wc * 32 + fr, fq * 8);
#define PG8_SA(b, h) (((b) * 2 + (h)) * HTB)
#define PG8_SB(b, h) ((4 + (b) * 2 + (h)) * HTB)
#define PG8_STAGE(bufoff, gbase, voff) do { _Pragma("unroll") for (int _i = 0; _i < 2; ++_i) \
        __builtin_amdgcn_global_load_lds((const unsigned*)((const char*)(gbase) + (voff)[_i]), (PG8_LAS unsigned*)(lds + (bufoff) + ldsw + _i * 8192), 16, 0, 0); } while (0)
#define PG8_LDA(dst, b, h) do { _Pragma("unroll") for (int m = 0; m < 4; ++m) _Pragma("unroll") for (int k = 0; k < 2; ++k) dst[m][k] = *(const PG8_LAS bf16x8*)(lds + PG8_SA(b, h) + aoff + m * 2048 + k * 1024); } while (0)
#define PG8_LDB(dst, b, h) do { _Pragma("unroll") for (int n = 0; n < 2; ++n) _Pragma("unroll") for (int k = 0; k < 2; ++k) dst[n][k] = *(const PG8_LAS bf16x8*)(lds + PG8_SB(b, h) + boff + n * 2048 + k * 1024); } while (0)
#define PG8_MMA(ai, bj, At, Bt) do { __builtin_amdgcn_s_setprio(1); _Pragma("unroll") for (int m = 0; m < 4; ++m) _Pragma("unroll") for (int n = 0; n < 2; ++n) _Pragma("unroll") for (int k = 0; k < 2; ++k) \
        acc[ai][bj][m][n] = __builtin_amdgcn_mfma_f32_16x16x32_bf16(Bt[n][k], At[m][k], acc[ai][bj][m][n], 0, 0, 0); __builtin_amdgcn_s_setprio(0); } while (0)
#define PG8_WAIT_V(n) asm volatile("s_waitcnt vmcnt(" #n ")" ::: "memory")
#define PG8_WAIT_L(n) asm volatile("s_waitcnt lgkmcnt(" #n ")" ::: "memory")
#define PG8_BAR __builtin_amdgcn_s_barrier()
#define PG8_SCHED __builtin_amdgcn_sched_barrier(0)
    Unit cur, nxt; int ui = 0;
    if (!S.next(0, cur)) return;
    f32x4 acc[2][2][4][2];
#pragma unroll
    for (int a = 0; a < 2; ++a)
#pragma unroll
        for (int b = 0; b < 2; ++b)
#pragma unroll
            for (int m = 0; m < 4; ++m)
#pragma unroll
                for (int n = 0; n < 2; ++n) acc[a][b][m][n] = (f32x4){0.f, 0.f, 0.f, 0.f};
    bf16x8 At[4][2], B0[2][2], B1[2][2];
    const char* cA = (const char*)g.A + (size_t)cur.pm * tstep; const char* cB = (const char*)g.Bt + (size_t)cur.pn * tstep;
    S.a_ready(cur);
    if constexpr (SP2) {
        PG8_STAGE(PG8_SB(0, 0), cB, voffB); PG8_STAGE(PG8_SB(0, 1), cB + hstep, voffB); PG8_STAGE(PG8_SA(0, 0), cA, voffA); PG8_STAGE(PG8_SA(0, 1), cA + hstep, voffA);
        if (wr == 1) PG8_BAR;
        PG8_WAIT_V(2); PG8_BAR;
        PG8_STAGE(PG8_SB(1, 0), cB + kstep, voffB); PG8_STAGE(PG8_SA(1, 0), cA + kstep, voffA); PG8_STAGE(PG8_SB(1, 1), cB + hstep + kstep, voffB);
        PG8_WAIT_V(6); PG8_BAR;
    } else {
        PG8_STAGE(PG8_SB(0, 0), cB, voffB); PG8_STAGE(PG8_SA(0, 0), cA, voffA); PG8_STAGE(PG8_SB(0, 1), cB + hstep, voffB); PG8_STAGE(PG8_SA(0, 1), cA + hstep, voffA);
        if (wr == 1) PG8_BAR;
        PG8_WAIT_V(4); PG8_BAR;
        PG8_STAGE(PG8_SB(1, 0), cB + kstep, voffB); PG8_STAGE(PG8_SA(1, 0), cA + kstep, voffA); PG8_STAGE(PG8_SB(1, 1), cB + hstep + kstep, voffB);
        PG8_WAIT_V(6); PG8_BAR;
    }
    for (;;) {
        const bool has_next = S.next(ui + 1, nxt);
        const char* nA = has_next ? (const char*)g.A + (size_t)nxt.pm * tstep : cA; const char* nB = has_next ? (const char*)g.Bt + (size_t)nxt.pn * tstep : cB;
        for (int t = 0; t < nt; t += 2) {
            const bool last = (t == nt - 2);
            const char* a1 = cA + (size_t)(t + 1) * kstep;
            const char* a2 = last ? nA : cA + (size_t)(t + 2) * kstep; const char* b2 = last ? nB : cB + (size_t)(t + 2) * kstep;
            const char* a3 = a2 + kstep; const char* b3 = b2 + kstep;
            if (last && has_next) S.a_ready(nxt);
            if constexpr (SP2) {
            PG8_LDB(B0, 0, 0); PG8_LDB(B1, 0, 1); PG8_SCHED; PG8_LDA(At, 0, 0); PG8_STAGE(PG8_SA(1, 1), a1 + hstep, voffA);
            PG8_WAIT_V(8); PG8_WAIT_L(0); PG8_BAR; PG8_MMA(0, 0, At, B0); PG8_MMA(0, 1, At, B1); PG8_BAR; PG8_SCHED;
            PG8_LDA(At, 0, 1); PG8_STAGE(PG8_SB(0, 0), b2, voffB); PG8_STAGE(PG8_SB(0, 1), b2 + hstep, voffB); PG8_STAGE(PG8_SA(0, 0), a2, voffA);
            PG8_WAIT_V(8); PG8_WAIT_L(0); PG8_BAR; PG8_MMA(1, 0, At, B0); PG8_MMA(1, 1, At, B1); PG8_BAR; PG8_SCHED;
            PG8_LDB(B0, 1, 0); PG8_LDB(B1, 1, 1); PG8_SCHED; PG8_LDA(At, 1, 0); PG8_STAGE(PG8_SA(0, 1), a2 + hstep, voffA);
            PG8_WAIT_V(8); PG8_WAIT_L(0); PG8_BAR; PG8_MMA(0, 0, At, B0); PG8_MMA(0, 1, At, B1); PG8_BAR; PG8_SCHED;
            PG8_LDA(At, 1, 1); PG8_STAGE(PG8_SB(1, 0), b3, voffB); PG8_STAGE(PG8_SB(1, 1), b3 + hstep, voffB); PG8_STAGE(PG8_SA(1, 0), a3, voffA);
            PG8_WAIT_V(8); PG8_WAIT_L(0); PG8_BAR; PG8_MMA(1, 0, At, B0); PG8_MMA(1, 1, At, B1); PG8_BAR; PG8_SCHED;
            } else {
            PG8_LDB(B0, 0, 0); PG8_SCHED; PG8_LDA(At, 0, 0); PG8_STAGE(PG8_SA(1, 1), a1 + hstep, voffA);
            PG8_WAIT_L(8); PG8_BAR; PG8_WAIT_L(0); PG8_MMA(0, 0, At, B0); PG8_BAR; PG8_SCHED;
            PG8_LDB(B1, 0, 1); PG8_STAGE(PG8_SB(0, 0), b2, voffB);
            PG8_BAR; PG8_WAIT_L(0); PG8_MMA(0, 1, At, B1); PG8_BAR;
            PG8_LDA(At, 0, 1); PG8_STAGE(PG8_SA(0, 0), a2, voffA);
            PG8_BAR; PG8_WAIT_L(0); PG8_MMA(1, 0, At, B0); PG8_BAR; PG8_SCHED;
            PG8_STAGE(PG8_SB(0, 1), b2 + hstep, voffB);
            PG8_WAIT_V(6); PG8_BAR; PG8_MMA(1, 1, At, B1); PG8_BAR;
            PG8_LDB(B0, 1, 0); PG8_SCHED; PG8_LDA(At, 1, 0); PG8_STAGE(PG8_SA(0, 1), a2 + hstep, voffA);
            PG8_WAIT_L(8); PG8_BAR; PG8_WAIT_L(0); PG8_MMA(0, 0, At, B0); PG8_BAR; PG8_SCHED;
            PG8_LDB(B1, 1, 1); PG8_STAGE(PG8_SB(1, 0), b3, voffB);
            PG8_BAR; PG8_WAIT_L(0); PG8_MMA(0, 1, At, B1); PG8_BAR;
            PG8_LDA(At, 1, 1); PG8_STAGE(PG8_SA(1, 0), a3, voffA);
            PG8_BAR; PG8_WAIT_L(0); PG8_MMA(1, 0, At, B0); PG8_BAR; PG8_SCHED;
            PG8_STAGE(PG8_SB(1, 1), b3 + hstep, voffB);
            PG8_WAIT_V(6); PG8_BAR; PG8_MMA(1, 1, At, B1); PG8_BAR;
            }
        }
        if constexpr (ALIGN_EPI) { if (wr == 0) PG8_BAR; }
        if constexpr (!Epi::AFTER_DRAIN) { E(acc, cur, wr, wc, fr, fq); S.done(cur); }
        if (!has_next) break;
#pragma unroll
        for (int a = 0; a < 2; ++a)
#pragma unroll
            for (int b = 0; b < 2; ++b)
#pragma unroll
                for (int m = 0; m < 4; ++m)
#pragma unroll
                    for (int n = 0; n < 2; ++n) acc[a][b][m][n] = (f32x4){0.f, 0.f, 0.f, 0.f};
        cur = nxt; cA = nA; cB = nB; ++ui;
        if constexpr (ALIGN_EPI) { if (wr == 1) PG8_BAR; }
    }
    PG8_WAIT_V(0);
    if constexpr (!ALIGN_EPI) { if (wr == 0) PG8_BAR; }
    PG8_BAR;
    if constexpr (Epi::AFTER_DRAIN) { E.fused(acc, cur, wr, wc, fr, fq, lds, wid, lane); S.done(cur); }
#undef PG8_SA
#undef PG8_SB
#undef PG8_STAGE
#undef PG8_LDA
#undef PG8_LDB
#undef PG8_MMA
#undef PG8_WAIT_V
#undef PG8_WAIT_L
#undef PG8_BAR
#undef PG8_SCHED
}
}
constexpr int BATCH = 2, SEQ = 8192, DM = 4096, M = BATCH * SEQ, DFF = 11008, NLAYER = 2;
constexpr int P_IN = 10704, NIN = 10752, NMAIN = 10496;
constexpr int CA_Q = 0, CA_K = 1024, CA_V = 2048;
constexpr int CB_Q = 3072, CB_K = 3584, CB_V = 4096, CB_G = 5120;
constexpr int CC_R = 6144, CC_K = 7168, CC_V = 8192;
constexpr int CD_Q = 9216, CD_K = 10240, CD_V = 10368;
constexpr float LOG2E = 1.4426950408889634f;
constexpr float QSCALE = 0.125f * LOG2E;
constexpr int NWAVES = 8;

constexpr size_t MiB = 1u << 20;
constexpr size_t WS_CTL = 0, CTL_ZERO_BYTES = 1 * MiB;
constexpr size_t WS_MODP = 2 * MiB;
constexpr size_t WS_MOD = 14 * MiB;
constexpr size_t WS_TAB = 15 * MiB;
constexpr size_t WS_WIN = 16 * MiB, WIN_L = 84 * MiB;
constexpr size_t WS_WOUT = 184 * MiB, WOUT_L = 32 * MiB;
constexpr size_t WS_W13 = 248 * MiB, W13_L = 172 * MiB;
constexpr size_t WS_W2 = 592 * MiB, W2_L = 86 * MiB;
constexpr size_t WS_XN = 764 * MiB;
constexpr size_t WS_COLS = 892 * MiB;
constexpr size_t WS_LOWR = 1220 * MiB;
constexpr size_t WS_HID = 892 * MiB;
constexpr size_t WS_QKA = 1236 * MiB;
constexpr size_t WS_QKD = 1300 * MiB;
constexpr size_t WS_LOGA = 1336 * MiB;
constexpr size_t WS_RW = 1368 * MiB, RW_ONE = 64 * MiB;
constexpr size_t WS_VFIRST = 1816 * MiB;
constexpr size_t WS_MIXED = 1880 * MiB;
constexpr int VROW = SEQ + 64;
constexpr size_t WS_VTA = 2008 * MiB;
constexpr size_t WS_VTD = 2041 * MiB;
constexpr size_t WS_QDEC = 2046 * MiB, WS_KDT = 2062 * MiB, WS_AM = 2078 * MiB, WS_EBL = 2086 * MiB;
constexpr size_t WS_VTB = 2087 * MiB;
constexpr size_t WS_RWC = 2120 * MiB;
constexpr size_t WS_OB = 2446 * MiB;
constexpr size_t WS_PSG = 2478 * MiB;
constexpr size_t WS_WF = 2479 * MiB;
constexpr size_t WS_END = 2480 * MiB;
constexpr int CW_BAR = 4096;
constexpr int CW_Q = 16384;

constexpr int RING_OFF = 0, RING_BYTES = 131072;
constexpr int LDSCTL_OFF = RING_BYTES, MISC_OFF = LDSCTL_OFF + 320;
constexpr int LDS_BYTES = 147456;

#define GAS __attribute__((address_space(1)))
#define LAS __attribute__((address_space(3)))
typedef unsigned short bf16;
typedef unsigned v4u __attribute__((ext_vector_type(4)));
typedef unsigned v2u __attribute__((ext_vector_type(2)));
typedef float f32x4 __attribute__((ext_vector_type(4)));
typedef short bf16x8 __attribute__((ext_vector_type(8)));
typedef GAS unsigned gu32;
#define RLX_AGENT __ATOMIC_RELAXED, __HIP_MEMORY_SCOPE_AGENT
#define LDS_WAIT() asm volatile("s_waitcnt lgkmcnt(0)" ::: "memory")
#define VM_WAIT() asm volatile("s_waitcnt vmcnt(0)" ::: "memory")
typedef float f32x2_t __attribute__((ext_vector_type(2))); typedef __bf16 bf16x2_t __attribute__((ext_vector_type(2)));
__device__ __forceinline__ unsigned pk2(float lo, float hi) { const f32x2_t v = {lo, hi}; return __builtin_bit_cast(unsigned, __builtin_convertvector(v, bf16x2_t)); }
__device__ __forceinline__ unsigned f2bf(float f) { return pk2(f, f) & 0xffffu; }
__device__ __forceinline__ float bf2f(unsigned short h) { return __builtin_bit_cast(float, (unsigned)h << 16); }
__device__ __forceinline__ float bflo(unsigned w) { return __builtin_bit_cast(float, w << 16); }
__device__ __forceinline__ float bfhi(unsigned w) { return __builtin_bit_cast(float, w & 0xffff0000u); }
template <int CTRL> __device__ __forceinline__ float dpp_f(float v) { return __builtin_bit_cast(float, __builtin_amdgcn_update_dpp(0, __builtin_bit_cast(int, v), CTRL, 0xF, 0xF, true)); }
__device__ __forceinline__ float sum8(float v) {
    v += dpp_f<0xB1>(v); v += dpp_f<0x4E>(v); v += dpp_f<0x141>(v); return v; }
__device__ __forceinline__ float sum32(float v) {
    v = sum8(v); v += dpp_f<0x140>(v); v += __builtin_bit_cast(float, __builtin_amdgcn_ds_swizzle(__builtin_bit_cast(int, v), 0x401F)); return v; }
__device__ __forceinline__ float wave_sum(float v) {
    v = sum8(v); v += dpp_f<0x140>(v);
    v += __builtin_bit_cast(float, __builtin_amdgcn_ds_swizzle(__builtin_bit_cast(int, v), 0x401F));
    { const int u = __builtin_bit_cast(int, v); v = __builtin_bit_cast(float, __builtin_amdgcn_readlane(u, 0)) + __builtin_bit_cast(float, __builtin_amdgcn_readlane(u, 32)); }
    return v;
}
__device__ __forceinline__ float sigmoid_f(float x) { return __builtin_amdgcn_rcpf(1.0f + __builtin_amdgcn_exp2f(-LOG2E * x)); }
__device__ __forceinline__ float silu_g(float x) { return x * sigmoid_f(x); }
__device__ __forceinline__ void unpack8(const v4u r, float (&f)[8]) { f[0] = bflo(r.x); f[1] = bfhi(r.x); f[2] = bflo(r.y); f[3] = bfhi(r.y); f[4] = bflo(r.z); f[5] = bfhi(r.z); f[6] = bflo(r.w); f[7] = bfhi(r.w); }
__device__ __forceinline__ v4u pack8(const float (&f)[8]) { v4u o; o.x = pk2(f[0], f[1]); o.y = pk2(f[2], f[3]); o.z = pk2(f[4], f[5]); o.w = pk2(f[6], f[7]); return o; }

#define XB_TMO      128
#define XB_XCNT(j)  (256  + 64 * (j))
#define XB_XSUB(j)  (1280 + 64 * (j))
#define XB_XGEN(j)  (2304 + 64 * (j))
#define XB_TOP      3328
#define XB_TOPGEN   3392
#define XCD_BAR_WORDS 3456
#define XB_SPIN_CAP (1u << 23)

__device__ __forceinline__ unsigned xb_ld(unsigned* p)              { return __hip_atomic_load(p, __ATOMIC_RELAXED, __HIP_MEMORY_SCOPE_AGENT); }
__device__ __forceinline__ unsigned xb_add(unsigned* p, unsigned v) { return __hip_atomic_fetch_add(p, v, __ATOMIC_RELAXED, __HIP_MEMORY_SCOPE_AGENT); }
__device__ __forceinline__ unsigned xb_xcc_id() { return (unsigned)__builtin_amdgcn_s_getreg((3 << 11) | 20) & 0xFu; }
#define XB_SPIN(cond, bar) do { unsigned _sp = 0; while (cond) { __builtin_amdgcn_s_sleep(1); \
    if ((++_sp & 255u) == 0u) { if (xb_ld(&(bar)[XB_TMO])) break; if (_sp > XB_SPIN_CAP) { atomicAdd(&(bar)[XB_TMO], 1u); break; } } } } while (0)

struct XcdBarrier {
    unsigned* bar; unsigned x;
    volatile LAS unsigned* st;
};

__device__ __forceinline__ XcdBarrier xcd_barrier_post(unsigned* bar, volatile LAS unsigned* st) {
    XcdBarrier b; b.bar = bar; b.x = xb_xcc_id(); b.st = st;
    if (threadIdx.x == 0) (void)xb_add(&bar[XB_XCNT(b.x)], 1u);
    return b;
}
__device__ __forceinline__ void xcd_barrier_complete(unsigned* bar, unsigned x, unsigned& nloc, unsigned& nx) {
    const unsigned G = gridDim.x * gridDim.y * gridDim.z;
    unsigned sum, cnt, mine, sp = 0u;
    for (;;) {
        sum = 0u; cnt = 0u; mine = 0u;
#pragma unroll
        for (unsigned j = 0; j < 16; ++j) { const unsigned c = xb_ld(&bar[XB_XCNT(j)]); sum += c; cnt += (c > 0u) ? 1u : 0u; mine = (j == x) ? c : mine; }
        if (sum == G) break;
        __builtin_amdgcn_s_sleep(1);
        if ((++sp & 255u) == 0u) { if (xb_ld(&bar[XB_TMO])) break; if (sp > XB_SPIN_CAP) { atomicAdd(&bar[XB_TMO], 1u); break; } }
    }
    nloc = mine > 0u ? mine : 1u; nx = cnt > 0u ? cnt : 1u;
}

__device__ __forceinline__ void xcd_barrier(const XcdBarrier& b) {
    asm volatile("s_waitcnt vmcnt(0)" ::: "memory");
    __syncthreads();
    if (threadIdx.x == 0) {
        unsigned* bar = b.bar;
        __builtin_amdgcn_s_waitcnt(0);
        unsigned nloc = b.st[0], nx = b.st[1];
        if (nloc == 0u) { xcd_barrier_complete(bar, b.x, nloc, nx); b.st[0] = nloc; b.st[1] = nx; }
        const unsigned old = xb_add(&bar[XB_XSUB(b.x)], 1u);
        const unsigned gen = old / nloc;
        if (old + 1u == (gen + 1u) * nloc) {
            __builtin_amdgcn_fence(__ATOMIC_RELEASE, "agent");
            asm volatile("s_waitcnt vmcnt(0)" ::: "memory");
            const unsigned og = xb_add(&bar[XB_TOP], 1u);
            const unsigned tg = og / nx;
            if (og + 1u == (tg + 1u) * nx) xb_add(&bar[XB_TOPGEN], 1u);
            else XB_SPIN(xb_ld(&bar[XB_TOPGEN]) == tg, bar);
            __builtin_amdgcn_fence(__ATOMIC_ACQUIRE, "agent");
            xb_add(&bar[XB_XGEN(b.x)], 1u);
            asm volatile("s_waitcnt vmcnt(0)" ::: "memory");
        } else {
            XB_SPIN(xb_ld(&bar[XB_XGEN(b.x)]) == gen, bar);
            __builtin_amdgcn_fence(__ATOMIC_ACQUIRE, "agent");
            asm volatile("s_waitcnt vmcnt(0)" ::: "memory");
        }
    }
    __syncthreads();
}

typedef const float* const __attribute__((address_space(4)))* kargp;
struct Frame {
    LAS unsigned char* lds;
    volatile LAS unsigned* MISC;
    gu32* ctl;
    int tid, lane, wave;
    int vcu, G, bx;
    kargp kin;
    float* out;
    unsigned char* ws;
};
enum { I_X = 0, I_C, I_RELB, I_ADAW, I_ADAB, I_WIN, I_WOUT, I_DQN, I_DKN, I_DLAM, I_DSUB, I_GGU, I_GGB, I_GON, I_RMU, I_RWUP, I_RW0, I_RAUP, I_RA0, I_RGUP,
       I_RKK, I_RKA, I_RRK, I_RLNW, I_RLNB, I_VRD, I_VRMU, I_VRUP, I_VR0, I_SQN, I_SKN, I_SSINK, I_W1, I_W3, I_W2 };

#define WSP(T, off) ((T*)(F.ws + (off)))
__device__ __forceinline__ void relaunder_tid(Frame& F) { int t = F.tid; asm volatile("" : "+v"(t)); F.tid = t; F.lane = t & 63; F.wave = __builtin_amdgcn_readfirstlane(t >> 6); }
__device__ __forceinline__ void relaunder(Frame& F) { kargp p = F.kin; asm volatile("" : "+s"(p)); F.kin = p; }

__device__ __forceinline__ void conv_item(const float* src, int ld, int col0, int ncols, int K, bf16* WT, int row0, int kb, LAS float* scr, int lane) {
    const int k0 = 64 * kb;
    { const int n = lane & 31; const bool ok = src != nullptr && n < ncols; const float* sp = src + (size_t)(k0 + (lane >> 5)) * ld + col0 + n; float v[32];
#pragma unroll
      for (int i = 0; i < 32; ++i) v[i] = ok ? sp[(size_t)(2 * i) * ld] : 0.f;
#pragma unroll
      for (int i = 0; i < 32; ++i) scr[(2 * i + (lane >> 5)) * 33 + n] = v[i]; }
    LDS_WAIT(); asm volatile("" ::: "memory");
    const int c = lane & 7;
#pragma unroll
    for (int j = 0; j < 4; ++j) { const int n = (lane >> 3) + 8 * j; const LAS float* s = scr + (8 * c) * 33 + n;
        v4u o; o.x = pk2(s[0 * 33], s[1 * 33]); o.y = pk2(s[2 * 33], s[3 * 33]); o.z = pk2(s[4 * 33], s[5 * 33]); o.w = pk2(s[6 * 33], s[7 * 33]);
        if (n < ncols) *(GAS v4u*)(WT + (size_t)(row0 + n) * K + k0 + 8 * c) = o; }
    LDS_WAIT(); asm volatile("" ::: "memory");
}
__device__ __forceinline__ int t5_bucket(int d) {
    if (d < 16) return d;
    int v = 16 + (int)(logf((float)d * (1.0f / 16.0f)) / logf(8.0f) * 16.0f);
    return v < 31 ? v : 31;
}
__device__ __forceinline__ void p0_prologue_a(Frame& F) {
    const int gw = F.vcu * NWAVES + F.wave, NGW = F.G * NWAVES;
    LAS float* ldsf = (LAS float*)(F.lds + RING_OFF);
    for (int i = F.tid; i < 2 * DM; i += NWAVES * 64) ldsf[i] = silu_g(F.kin[I_C][i]);
    __syncthreads();
    float* MODP = WSP(float, WS_MODP);
    for (int it = gw; it < 6144; it += NGW) {
        const int l = it / 3072, rem = it % 3072, kc = rem / 96, ng = rem % 96, n0 = 256 * ng + 4 * F.lane;
        const float* w = F.kin[I_ADAW] + ((size_t)l * DM + kc * 128) * 24576 + n0;
        f32x4 a0 = {0.f, 0.f, 0.f, 0.f}, a1 = {0.f, 0.f, 0.f, 0.f};
#pragma unroll 16
        for (int k = 0; k < 128; ++k) { const f32x4 wv = *(const f32x4*)(w + (size_t)k * 24576); const float s0 = ldsf[kc * 128 + k], s1 = ldsf[DM + kc * 128 + k]; a0 += wv * s0; a1 += wv * s1; }
        *(f32x4*)(MODP + ((size_t)(l * 32 + kc) * 2 + 0) * 24576 + n0) = a0;
        *(f32x4*)(MODP + ((size_t)(l * 32 + kc) * 2 + 1) * 24576 + n0) = a1;
    }
    for (int idx = F.bx * (NWAVES * 64) + F.tid; idx < NLAYER * 448 * 64; idx += F.G * NWAVES * 64) {
        const int l = idx / (448 * 64), rem = idx % (448 * 64), blk = rem >> 6, ln = rem & 63, n = ln & 15, g = ln >> 4;
        const int m = blk < 384 ? blk >> 7 : 3, nt = blk < 384 ? (blk & 127) >> 1 : blk - 384, ks = blk < 384 ? (blk & 1) : 0;
        const float* W = m == 0 ? F.kin[I_RWUP] + (size_t)l * 65536 : (m == 1 ? F.kin[I_RAUP] + (size_t)l * 65536 : (m == 2 ? F.kin[I_RGUP] + (size_t)l * 65536 : (l ? F.kin[I_VRUP] + (size_t)(l - 1) * 32768 : nullptr)));
        float f[8];
#pragma unroll
        for (int e = 0; e < 8; ++e) f[e] = W != nullptr ? W[(size_t)(32 * ks + 8 * g + e) * 1024 + 16 * nt + n] : 0.f;
        *(v4u*)(WSP(bf16, WS_WF) + ((size_t)(l * 448 + blk) * 64 + ln) * 8) = pack8(f);
    }
    __syncthreads();
    LAS float* scr = (LAS float*)(F.lds + RING_OFF + F.wave * 16384);
    constexpr int I_IN = 337 * 64, I_OUT = 128 * 64, I_13 = 688 * 64, I_2 = 128 * 172, I_L = I_IN + I_OUT + I_13 + I_2;
    for (int it = gw; it < NLAYER * I_L; it += NGW) {
        const int l = it / I_L; int r = it % I_L;
        if (r < I_IN) {
            const int kb = r / 337, cb = r % 337; const float* src = F.kin[I_WIN] + (size_t)l * DM * P_IN; int ld = P_IN, col0, row0, nc = 32;
            if (cb < 192) { col0 = 32 * cb; row0 = 32 * cb; }
            else if (cb < 288) { col0 = 6160 + 32 * (cb - 192); row0 = 6144 + 32 * (cb - 192); }
            else if (cb < 328) { col0 = 9424 + 32 * (cb - 288); row0 = 9216 + 32 * (cb - 288); }
            else if (cb == 328) { col0 = 6144; row0 = 10496; nc = 16; }
            else if (cb < 335) { col0 = 9232 + 32 * (cb - 329); row0 = 10512 + 32 * (cb - 329); }
            else if (cb == 335) { src = l ? F.kin[I_VRD] + (size_t)(l - 1) * DM * 32 : nullptr; ld = 32; col0 = 0; row0 = 10704; }
            else { src = nullptr; col0 = 0; row0 = 10736; nc = 16; }
            conv_item(src, ld, col0, nc, DM, WSP(bf16, WS_WIN + l * WIN_L), row0, kb, scr, F.lane); continue; }
        r -= I_IN;
        if (r < I_OUT) { const int kb = r / 128, cb = r % 128; conv_item(F.kin[I_WOUT] + (size_t)l * DM * DM, DM, 32 * cb, 32, DM, WSP(bf16, WS_WOUT + l * WOUT_L), 32 * cb, kb, scr, F.lane); continue; }
        r -= I_OUT;
        if (r < I_13) { const int kb = r / 688, cb = r % 688, pn = cb >> 3, wi = cb & 7;
            const float* src = (wi < 4 ? F.kin[I_W1] : F.kin[I_W3]) + (size_t)l * DM * DFF;
            conv_item(src, DFF, 128 * pn + 32 * (wi & 3), 32, DM, WSP(bf16, WS_W13 + l * W13_L), 32 * cb, kb, scr, F.lane); continue; }
        r -= I_13;
        { const int kb = r / 128, cb = r % 128; conv_item(F.kin[I_W2] + (size_t)l * DFF * DM, DM, 32 * cb, 32, DFF, WSP(bf16, WS_W2 + l * W2_L), 32 * cb, kb, scr, F.lane); }
    }
}
__device__ __forceinline__ void p0_prologue_b(Frame& F) {
    const int gt = F.bx * (NWAVES * 64) + F.tid, NT = F.G * NWAVES * 64;
    const float* MODP = WSP(float, WS_MODP); float* MOD = WSP(float, WS_MOD);
    for (int idx = gt; idx < NLAYER * 2 * 24576; idx += NT) {
        const int l = idx / 49152, rem = idx % 49152, b = rem / 24576, n = rem % 24576;
        float s = F.kin[I_ADAB][l * 24576 + n];
#pragma unroll 8
        for (int kc = 0; kc < 32; ++kc) s += MODP[((size_t)(l * 32 + kc) * 2 + b) * 24576 + n];
        MOD[idx] = s;
    }
    if (F.bx == 0) { float* TAB = WSP(float, WS_TAB);
        for (int i = F.tid; i < 24 * 128; i += NWAVES * 64) { const int hh = i >> 7, d = i & 127; TAB[i] = F.kin[I_RELB][t5_bucket(d) * 24 + hh] * LOG2E; } }
}
__device__ __forceinline__ void rms_phase(Frame& F, const float* xin, const float* sh, const float* sc) {
    const int gw = F.vcu * NWAVES + F.wave, NGW = F.G * NWAVES;
    bf16* XN = WSP(bf16, WS_XN);
    for (int m = gw; m < M; m += NGW) {
        const int b = m >> 13;
        const f32x4* xr = (const f32x4*)(xin + (size_t)m * DM) + F.lane;
        f32x4 v[16]; float ss = 0.f;
#pragma unroll
        for (int j = 0; j < 16; ++j) { v[j] = xr[64 * j]; ss += (v[j].x * v[j].x + v[j].y * v[j].y) + (v[j].z * v[j].z + v[j].w * v[j].w); }
        const float rstd = rsqrtf(wave_sum(ss) * (1.0f / DM) + 1e-6f);
        const f32x4* scp = (const f32x4*)(sc + (size_t)b * 24576) + F.lane; const f32x4* shp = (const f32x4*)(sh + (size_t)b * 24576) + F.lane;
        v2u* o8 = (v2u*)(XN + (size_t)m * DM) + F.lane;
#pragma unroll
        for (int j = 0; j < 16; ++j) { const f32x4 s4 = scp[64 * j], h4 = shp[64 * j]; const f32x4 o = v[j] * rstd * (s4 + 1.0f) + h4;
            v2u w; w.x = pk2(o.x, o.y); w.y = pk2(o.z, o.w); o8[64 * j] = w; }
    }
}
__device__ __forceinline__ void prep_norm(Frame& F, int l) {
    const int gw = F.vcu * NWAVES + F.wave, NGW = F.G * NWAVES, lane = F.lane, sub = lane >> 3, ch = lane & 7;
    float gqa[8], gka[8], gqd[8], gkd[8];
#pragma unroll
    for (int e = 0; e < 8; ++e) { gqa[e] = F.kin[I_DQN][l * 64 + ch * 8 + e] * QSCALE; gka[e] = F.kin[I_DKN][l * 64 + ch * 8 + e];
                                  gqd[e] = F.kin[I_SQN][l * 64 + ch * 8 + e] * QSCALE; gkd[e] = F.kin[I_SKN][l * 64 + ch * 8 + e]; }
    const bf16* COLS = WSP(bf16, WS_COLS); bf16* QKA = WSP(bf16, WS_QKA); bf16* QKD = WSP(bf16, WS_QKD);
    for (int m = gw; m < M; m += NGW) {
        const bf16* src = COLS + (size_t)m * NMAIN;
#pragma unroll
        for (int i = 0; i < 4; ++i) { const int vec = i * 8 + sub, col = vec * 64 + ch * 8;
            float f[8]; unpack8(*(const v4u*)(src + CA_Q + col), f); float ss = 0.f;
#pragma unroll
            for (int e = 0; e < 8; ++e) ss += f[e] * f[e];
            ss = sum8(ss);
            const float rstd = rsqrtf(ss * (1.0f / 64.0f) + 1e-6f);
#pragma unroll
            for (int e = 0; e < 8; ++e) f[e] = f[e] * rstd * (i < 2 ? gqa[e] : gka[e]);
            *(v4u*)(QKA + (size_t)m * 2048 + col) = pack8(f); }
#pragma unroll
        for (int i = 0; i < 3; ++i) { const int vec = i * 8 + sub, col = vec * 64 + ch * 8;
            if (vec < 18) { float f[8]; unpack8(*(const v4u*)(src + CD_Q + col), f); float ss = 0.f;
#pragma unroll
                for (int e = 0; e < 8; ++e) ss += f[e] * f[e];
                ss = sum8(ss);
                const float rstd = rsqrtf(ss * (1.0f / 64.0f) + 1e-6f);
#pragma unroll
                for (int e = 0; e < 8; ++e) f[e] = f[e] * rstd * (vec < 16 ? gqd[e] : gkd[e]);
                *(v4u*)(QKD + (size_t)m * 1152 + col) = pack8(f); } }
    }
}
__device__ __forceinline__ void prep_loga(Frame& F, int l) {
    LAS float* gdl = (LAS float*)(F.lds + RING_OFF);
    float gu[16];
#pragma unroll
    for (int j = 0; j < 16; ++j) gu[j] = F.kin[I_GGU][((size_t)l * 16 + j) * 512 + F.tid];
    const float bias = F.kin[I_GGB][l * 512 + F.tid];
    const float* LOWR = WSP(float, WS_LOWR); float* LOGA = WSP(float, WS_LOGA);
    for (int tile = F.bx; tile < M / 64; tile += F.G) {
        const size_t row0 = (size_t)tile * 64;
        __syncthreads();
#pragma unroll
        for (int i = 0; i < 2; ++i) { const int idx = F.tid + 512 * i; gdl[idx] = LOWR[(row0 + (idx >> 4)) * 256 + (idx & 15)]; }
        __syncthreads();
#pragma unroll 4
        for (int t = 0; t < 64; ++t) { const LAS f32x4* gp = (const LAS f32x4*)(gdl + t * 16); const f32x4 g0 = gp[0], g1 = gp[1], g2 = gp[2], g3 = gp[3];
            float z = bias + g0.x * gu[0] + g0.y * gu[1] + g0.z * gu[2] + g0.w * gu[3] + g1.x * gu[4] + g1.y * gu[5] + g1.z * gu[6] + g1.w * gu[7]
                    + g2.x * gu[8] + g2.y * gu[9] + g2.z * gu[10] + g2.w * gu[11] + g3.x * gu[12] + g3.y * gu[13] + g3.z * gu[14] + g3.w * gu[15];
            LOGA[(row0 + t) * 512 + F.tid] = (fminf(z, 0.f) - __logf(1.0f + __expf(-fabsf(z)))) * (1.0f / 16.0f); }
    }
}
__device__ __forceinline__ int next_item(Frame& F, gu32* ctr) {
    volatile LAS int* slot = (volatile LAS int*)(F.lds + LDSCTL_OFF + 64);
    __syncthreads();
    if (F.tid == 0) *slot = (int)__hip_atomic_fetch_add(ctr, 1u, RLX_AGENT);
    __syncthreads();
    return *slot;
}
typedef float f32x16 __attribute__((ext_vector_type(16)));
__device__ __forceinline__ float xother32(float v) { unsigned a = __builtin_bit_cast(unsigned, v), b = a; asm volatile("" : "+v"(b)); auto rr = __builtin_amdgcn_permlane32_swap(a, b, false, false);
    const unsigned lo = rr[0], hi = rr[1]; return __builtin_bit_cast(float, (unsigned)((__builtin_amdgcn_mbcnt_hi(~0u, __builtin_amdgcn_mbcnt_lo(~0u, 0u)) & 32u) ? lo : hi)); }
__device__ __forceinline__ float xsum32(float v) { return v + xother32(v); }
__device__ __forceinline__ float xmax32(float v) { return fmaxf(v, xother32(v)); }
__device__ __forceinline__ int crow16(int r, int hi) { return (r & 3) + 8 * (r >> 2) + 4 * hi; }
template <bool ISA>
__device__ __forceinline__ void attn_unit(Frame& F, int l, int b, int hx, int qb) {
    constexpr int DV = ISA ? 128 : 64, NDV = DV / 32, KSTR = ISA ? 272 : 144, VSTR = 144, KBYTES = 64 * KSTR, VBYTES = DV * VSTR, BUFB = KBYTES + VBYTES, NCH = ISA ? 2 : 1;
    constexpr float NEG = -1e30f;
    LAS unsigned char* L = F.lds + RING_OFF;
    const int tid = F.tid, lane = F.lane, r32 = lane & 31, hi = lane >> 5, qs = F.wave & 3, grp = F.wave >> 2, q0 = qb * 128;
    const int kvh = hx >> 2, hd = kvh * 8 + (hx & 3) * 2 + grp;
    const bf16* Qp; const bf16* Kp; const bf16* VT; int ldq;
    if (ISA) { const bf16* QKA = WSP(bf16, WS_QKA); Qp = QKA + (size_t)b * SEQ * 2048 + hx * 128 + grp * 64; Kp = QKA + (size_t)b * SEQ * 2048 + 1024 + hx * 128; ldq = 2048; VT = WSP(bf16, WS_VTA) + (size_t)(b * 8 + hx) * 128 * VROW; }
    else { const bf16* QKD = WSP(bf16, WS_QKD); Qp = QKD + (size_t)b * SEQ * 1152 + hd * 64; Kp = QKD + (size_t)b * SEQ * 1152 + 1024 + kvh * 64; ldq = 1152; VT = WSP(bf16, WS_VTD) + (size_t)(b * 2 + kvh) * 64 * VROW; }
    const int qpos = q0 + 32 * qs + r32;
    bf16x8 qr[4];
#pragma unroll
    for (int d0 = 0; d0 < 4; ++d0) qr[d0] = *(const bf16x8*)(Qp + (size_t)qpos * ldq + d0 * 16 + hi * 8);
    LAS float* Bt = (LAS float*)(L + 2 * BUFB);
    { const float* TAB = WSP(float, WS_TAB);
      if (ISA) { if (tid < 130) Bt[tid] = tid == 0 ? NEG : (tid == 129 ? 0.f : TAB[hx * 128 + tid - 1] - TAB[hx * 128 + 127]); }
      else { if (tid < 260) { const int gi = tid >= 130, t = tid - 130 * gi; Bt[tid] = (t == 0 || t == 129) ? NEG : TAB[(8 + kvh * 8 + (hx & 3) * 2 + gi) * 128 + t - 1]; } } }
    const int TQ = q0 >> 6, T0 = ISA ? 0 : (TQ >= 2 ? TQ - 2 : 0), T1 = TQ + 1;
    v4u kreg[NCH], vreg[NCH];
#define AT_GLOAD(T) do { _Pragma("unroll") for (int i_ = 0; i_ < NCH; ++i_) { const int c_ = tid + 512 * i_; \
        const int kr_ = ISA ? (c_ >> 4) : (c_ >> 3), kc_ = ISA ? (c_ & 15) : (c_ & 7); kreg[i_] = *(const v4u*)(Kp + (size_t)((T) * 64 + kr_) * ldq + kc_ * 8); \
        const int vr_ = c_ >> 3, vc_ = c_ & 7; vreg[i_] = *(const v4u*)(VT + (size_t)vr_ * VROW + (T) * 64 + vc_ * 8); } } while (0)
#define AT_LWRITE(buf) do { _Pragma("unroll") for (int i_ = 0; i_ < NCH; ++i_) { const int c_ = tid + 512 * i_; \
        const int kr_ = ISA ? (c_ >> 4) : (c_ >> 3), kc_ = ISA ? (c_ & 15) : (c_ & 7); *(LAS v4u*)(L + (buf) * BUFB + kr_ * KSTR + kc_ * 16) = kreg[i_]; \
        const int vr_ = c_ >> 3, vc_ = c_ & 7; *(LAS v4u*)(L + (buf) * BUFB + KBYTES + vr_ * VSTR + vc_ * 16) = vreg[i_]; } } while (0)
    f32x16 o[NDV];
#pragma unroll
    for (int i = 0; i < NDV; ++i) o[i] = (f32x16){0.f, 0.f, 0.f, 0.f, 0.f, 0.f, 0.f, 0.f, 0.f, 0.f, 0.f, 0.f, 0.f, 0.f, 0.f, 0.f};
    float m_run = ISA ? NEG : F.kin[I_SSINK][l * 16 + hd] * LOG2E, l_run = ISA ? 0.f : (hi == 0 ? 1.f : 0.f);
    const int krow = (r32 & 16) | (r32 & 3) | ((r32 & 4) << 1) | ((r32 & 8) >> 1);
    const int koff = krow * KSTR + (ISA ? grp * 128 : 0) + hi * 16, voff = KBYTES + r32 * VSTR + hi * 16;
    AT_GLOAD(T0); AT_LWRITE(0); __syncthreads();
#pragma unroll 1
    for (int T = T0; T <= T1; ++T) {
        const int cur = (T - T0) & 1;
        AT_GLOAD(T < T1 ? T + 1 : T1);
        LAS const unsigned char* Kb = L + cur * BUFB;
        f32x16 s[2];
#pragma unroll
        for (int blk = 0; blk < 2; ++blk) { s[blk] = (f32x16){0.f, 0.f, 0.f, 0.f, 0.f, 0.f, 0.f, 0.f, 0.f, 0.f, 0.f, 0.f, 0.f, 0.f, 0.f, 0.f};
#pragma unroll
            for (int d0 = 0; d0 < 4; ++d0) { const bf16x8 kf = *(const LAS bf16x8*)(Kb + koff + blk * 32 * KSTR + d0 * 32); s[blk] = __builtin_amdgcn_mfma_f32_32x32x16_bf16(kf, qr[d0], s[blk], 0, 0, 0); } }
        bf16x8 vfc[NDV], vfn[NDV];
#pragma unroll
        for (int i = 0; i < NDV; ++i) vfc[i] = *(const LAS bf16x8*)(Kb + voff + i * 32 * VSTR);
        if (!ISA || T >= TQ - 2) {
            const LAS float* bt = Bt + (ISA ? 0 : grp * 130) + 1; const int d0 = qpos - T * 64 - 8 * hi;
#pragma unroll
            for (int blk = 0; blk < 2; ++blk)
#pragma unroll
                for (int r = 0; r < 16; ++r) { const int dist = d0 - (32 * blk + 16 * (r >> 3) + (r & 7)); const int di = dist < -1 ? -1 : (dist > 128 ? 128 : dist); s[blk][r] += bt[di]; } }
        float mt = s[0][0];
#pragma unroll
        for (int r = 1; r < 16; ++r) mt = fmaxf(mt, s[0][r]);
#pragma unroll
        for (int r = 0; r < 16; ++r) mt = fmaxf(mt, s[1][r]);
        mt = xmax32(mt);
        const float m_new = fmaxf(m_run, mt);
        if (__any(m_new > m_run)) { const float alpha = __builtin_amdgcn_exp2f(m_run - m_new); l_run *= alpha;
#pragma unroll
            for (int i = 0; i < NDV; ++i)
#pragma unroll
                for (int r = 0; r < 16; ++r) o[i][r] *= alpha;
            m_run = m_new; }
        float ls = 0.f;
#pragma unroll
        for (int blk = 0; blk < 2; ++blk)
#pragma unroll
            for (int r = 0; r < 16; ++r) { const float pv_ = __builtin_amdgcn_exp2f(s[blk][r] - m_run); s[blk][r] = pv_; ls += pv_; }
        l_run += ls;
#pragma unroll
        for (int sl = 0; sl < 4; ++sl) { const int blk = sl >> 1, r0 = 8 * (sl & 1);
            v4u pw; pw.x = pg8::cvt_pk_bf16(s[blk][r0], s[blk][r0 + 1]); pw.y = pg8::cvt_pk_bf16(s[blk][r0 + 2], s[blk][r0 + 3]); pw.z = pg8::cvt_pk_bf16(s[blk][r0 + 4], s[blk][r0 + 5]); pw.w = pg8::cvt_pk_bf16(s[blk][r0 + 6], s[blk][r0 + 7]);
            const bf16x8 pf = __builtin_bit_cast(bf16x8, pw);
#pragma unroll
            for (int i = 0; i < NDV; ++i) { if (sl < 3) vfn[i] = *(const LAS bf16x8*)(Kb + voff + i * 32 * VSTR + (sl + 1) * 32); o[i] = __builtin_amdgcn_mfma_f32_32x32x16_bf16(vfc[i], pf, o[i], 0, 0, 0); }
#pragma unroll
            for (int i = 0; i < NDV; ++i) vfc[i] = vfn[i]; }
        AT_LWRITE(cur ^ 1);
        __syncthreads();
    }
#undef AT_GLOAD
#undef AT_LWRITE
    const float inv = 1.0f / xsum32(l_run);
    bf16* MIX = WSP(bf16, WS_MIXED);
    if (ISA) {
        int ll_ = l; asm volatile("" : "+s"(ll_)); const float lam_init = ll_ == 0 ? 0.2f : 0.35550906759f;     float lam_full;
        { const float* lm = F.kin[I_DLAM] + (size_t)l * 256; const float s1 = wave_sum(lm[lane] * lm[64 + lane]), s2 = wave_sum(lm[128 + lane] * lm[192 + lane]); lam_full = __expf(s1) - __expf(s2) + lam_init; }
        LAS float* R1 = (LAS float*)L;
        LAS bf16* R2 = (LAS bf16*)(L + 66048);
        const int ql = 32 * qs + r32;
        if (grp == 1) {
#pragma unroll
            for (int i = 0; i < NDV; ++i)
#pragma unroll
                for (int r = 0; r < 16; ++r) R1[ql * 129 + 32 * i + crow16(r, hi)] = lam_full * inv * o[i][r]; }
        __syncthreads();
        if (grp == 0) { float ss = 0.f;
#pragma unroll
            for (int i = 0; i < NDV; ++i)
#pragma unroll
                for (int r = 0; r < 16; ++r) { const float d = o[i][r] * inv - R1[ql * 129 + 32 * i + crow16(r, hi)]; o[i][r] = d; ss += d * d; }
            const float rstd = rsqrtf(xsum32(ss) * (1.0f / 128.0f) + 1e-6f) * (1.0f - lam_init);
            const float* sl = F.kin[I_DSUB] + l * 128;
#pragma unroll
            for (int i = 0; i < NDV; ++i)
#pragma unroll
                for (int r = 0; r < 16; ++r) { const int dv = 32 * i + crow16(r, hi); R2[ql * 132 + dv] = (bf16)f2bf(o[i][r] * rstd * sl[dv]); } }
        __syncthreads();
#pragma unroll
        for (int i = 0; i < 4; ++i) { const int c = tid + 512 * i, row = c >> 4, ch = c & 15; const LAS v2u* sp = (const LAS v2u*)(R2 + row * 132 + ch * 8); const v2u a = sp[0], bb = sp[1];
            *(v4u*)(MIX + (size_t)(b * SEQ + q0 + row) * DM + hx * 128 + ch * 8) = (v4u){a.x, a.y, bb.x, bb.y}; }
    } else {
        LAS bf16* R = (LAS bf16*)L + F.wave * 2176;
#pragma unroll
        for (int i = 0; i < NDV; ++i)
#pragma unroll
            for (int r = 0; r < 16; ++r) R[r32 * 68 + 32 * i + crow16(r, hi)] = (bf16)f2bf(o[i][r] * inv);
#pragma unroll
        for (int i = 0; i < 4; ++i) { const int c = lane + 64 * i, row = c >> 3, ch = c & 7; const LAS v2u* sp = (const LAS v2u*)(R + row * 68 + ch * 8); const v2u a = sp[0], bb = sp[1];
            *(v4u*)(MIX + (size_t)(b * SEQ + q0 + 32 * qs + row) * DM + 3072 + hd * 64 + ch * 8) = (v4u){a.x, a.y, bb.x, bb.y}; }
    }
}
__device__ __forceinline__ void prep_gla(Frame& F) {
    LAS float* Lb = (LAS float*)(F.lds + RING_OFF); LAS float* Qd = Lb + 64 * 129; LAS float* Ki = Qd + 64 * 129; LAS bf16* Kt = (LAS bf16*)(Ki + 64 * 129);
    const bf16* COLS = WSP(bf16, WS_COLS); const float* LOGA = WSP(float, WS_LOGA);
    bf16* QDEC = WSP(bf16, WS_QDEC); bf16* KDT = WSP(bf16, WS_KDT); bf16* AMg = WSP(bf16, WS_AM); float* EBL = WSP(float, WS_EBL);
    for (int u = F.bx; u < 1024; u += F.G) {
        const int b = u >> 9, h = (u >> 7) & 3, ck = u & 127; const size_t row0 = (size_t)b * SEQ + ck * 64;
        __syncthreads();
        for (int idx = F.tid; idx < 8192; idx += NWAVES * 64) { const int t = idx >> 7, d = idx & 127; Lb[t * 129 + d] = LOGA[(row0 + t) * 512 + h * 128 + d]; }
        __syncthreads();
        if (F.tid < 128) { float acc = 0.f;
#pragma unroll 8
            for (int t = 0; t < 64; ++t) { acc += Lb[t * 129 + F.tid]; Lb[t * 129 + F.tid] = acc; }
            EBL[(size_t)u * 128 + F.tid] = __expf(acc); }
        __syncthreads();
        for (int idx = F.tid; idx < 8192; idx += NWAVES * 64) { const int t = idx >> 7, d = idx & 127; const float bt = Lb[t * 129 + d], bl = Lb[63 * 129 + d];
            const float q = bf2f(COLS[(row0 + t) * NMAIN + CB_Q + h * 128 + d]) * 0.08838834764831845f, k = bf2f(COLS[(row0 + t) * NMAIN + CB_K + h * 128 + d]);
            const float qd = q * __expf(bt); Qd[t * 129 + d] = qd; Ki[t * 129 + d] = k * __expf(-bt); Kt[d * 72 + t] = (bf16)f2bf(k * __expf(bl - bt));
            QDEC[((size_t)u * 64 + t) * 128 + d] = (bf16)f2bf(qd); }
        __syncthreads();
#pragma unroll
        for (int i = 0; i < 2; ++i) { const int c_ = F.tid + 512 * i, row = c_ >> 3, ch = c_ & 7; const LAS v2u* sp = (const LAS v2u*)(Kt + row * 72 + ch * 8); const v2u a = sp[0], bb = sp[1];
            *(v4u*)(KDT + ((size_t)u * 128 + row) * 64 + ch * 8) = (v4u){a.x, a.y, bb.x, bb.y}; }
        { const int c = F.tid >> 3, sg = F.tid & 7; float acc[8];
#pragma unroll
          for (int e = 0; e < 8; ++e) acc[e] = 0.f;
#pragma unroll 4
          for (int d = 0; d < 128; ++d) { const float q = Qd[c * 129 + d];
#pragma unroll
              for (int e = 0; e < 8; ++e) acc[e] += q * Ki[(sg * 8 + e) * 129 + d]; }
#pragma unroll
          for (int e = 0; e < 8; ++e) if (sg * 8 + e > c) acc[e] = 0.f;
          *(v4u*)(AMg + ((size_t)u * 64 + c) * 64 + sg * 8) = pack8(acc); }
    }
}
__device__ __forceinline__ void prep_vt(Frame& F, int pass) {
    LAS bf16* T = (LAS bf16*)(F.lds + RING_OFF);
    const bf16* COLS = WSP(bf16, WS_COLS);
    const int ncol = pass == 4 ? 128 : 512, nch = ncol >> 3;
    const int col0 = pass < 2 ? CA_V + 512 * pass : (pass < 4 ? CB_V + 512 * (pass - 2) : CD_V);
    bf16* dst0 = pass < 2 ? WSP(bf16, WS_VTA) + (size_t)(512 * pass) * VROW : (pass < 4 ? WSP(bf16, WS_VTB) + (size_t)(512 * (pass - 2)) * VROW : WSP(bf16, WS_VTD));
    const int rows_b = pass == 4 ? 128 : 1024;
    for (int tile = F.bx; tile < M / 64; tile += F.G) {
        const int b = tile >> 7, t0 = (tile & 127) * 64;
        __syncthreads();
        for (int idx = F.tid; idx < 64 * nch; idx += NWAVES * 64) { const int tok = idx / nch, ch = idx % nch;
            const v4u v = *(const v4u*)(COLS + (size_t)(b * SEQ + t0 + tok) * NMAIN + col0 + ch * 8); LAS unsigned* d = (LAS unsigned*)(T + tok * 522 + ch * 8); d[0] = v.x; d[1] = v.y; d[2] = v.z; d[3] = v.w; }
        __syncthreads();
        for (int idx = F.tid; idx < ncol * 8; idx += NWAVES * 64) { const int vrow = idx >> 3, ch = idx & 7;
            unsigned e[8];
#pragma unroll
            for (int k = 0; k < 8; ++k) e[k] = T[(ch * 8 + k) * 522 + vrow];
            v4u o; o.x = e[0] | (e[1] << 16); o.y = e[2] | (e[3] << 16); o.z = e[4] | (e[5] << 16); o.w = e[6] | (e[7] << 16);
            *(v4u*)(dst0 + ((size_t)b * rows_b + vrow) * VROW + t0 + ch * 8) = o; }
    }
}
typedef float f32x4v __attribute__((ext_vector_type(4)));
__device__ __forceinline__ float sum16(float v) { v = sum8(v); v += dpp_f<0x140>(v); return v; }
#define LDS_BARRIER() asm volatile("s_waitcnt lgkmcnt(0)\n\ts_barrier" ::: "memory")
template <int HACK = 0> __device__ __forceinline__ void gla_scan_unit(Frame& F, int l, int b, int h, int vh) {
    LAS unsigned char* L = F.lds + RING_OFF;
    constexpr int OQD = 0, OKT = 17408, OAM = 35840, OVT = 45056, OOT = 63488, OEB = 80896, OPS = 81408;
    const int tid = F.tid, lane = F.lane, n = lane & 15, g = lane >> 4, w = F.wave;
    const bf16* QDEC = WSP(bf16, WS_QDEC); const bf16* KDT = WSP(bf16, WS_KDT); const bf16* AMg = WSP(bf16, WS_AM); const float* EBL = WSP(float, WS_EBL);
    const bf16* VTB = WSP(bf16, WS_VTB) + (size_t)((b * 4 + h) * 256 + 128 * vh) * VROW; bf16* OB = WSP(bf16, WS_OB); float* PSG = WSP(float, WS_PSG);
    f32x4v S[8];
#pragma unroll
    for (int dt = 0; dt < 8; ++dt) S[dt] = (f32x4v){0.f, 0.f, 0.f, 0.f};
    v4u pq[2], pk[2], pa, pv[2]; float pe = 0.f;
#define GL_ISSUE(CK) do { const size_t u_ = (size_t)(b * 4 + h) * 128 + (CK); \
        _Pragma("unroll") for (int i = 0; i < 2; ++i) { const int c_ = tid + 512 * i; pq[i] = *(const v4u*)(QDEC + (u_ * 64 + (c_ >> 4)) * 128 + (c_ & 15) * 8); pk[i] = *(const v4u*)(KDT + (u_ * 128 + (c_ >> 3)) * 64 + (c_ & 7) * 8); \
            pv[i] = *(const v4u*)(VTB + (size_t)(c_ >> 3) * VROW + (CK) * 64 + (c_ & 7) * 8); } \
        pa = *(const v4u*)(AMg + (u_ * 64 + (tid >> 3)) * 64 + (tid & 7) * 8); \
        pe = EBL[u_ * 128 + (tid & 127)]; } while (0)
#define GL_WRITE() do { _Pragma("unroll") for (int i = 0; i < 2; ++i) { const int c_ = tid + 512 * i; *(LAS v4u*)(L + OQD + (c_ >> 4) * 272 + (c_ & 15) * 16) = pq[i]; *(LAS v4u*)(L + OKT + (c_ >> 3) * 144 + (c_ & 7) * 16) = pk[i]; \
            *(LAS v4u*)(L + OVT + (c_ >> 3) * 144 + (c_ & 7) * 16) = pv[i]; } \
        *(LAS v4u*)(L + OAM + (tid >> 3) * 144 + (tid & 7) * 16) = pa; \
        ((LAS float*)(L + OEB))[tid & 127] = pe; } while (0)
    GL_ISSUE(0); GL_WRITE();
    LDS_BARRIER();
#pragma unroll 1
    for (int ck = 0; ck < 128; ++ck) {
        const size_t row0 = (size_t)b * SEQ + ck * 64;
        GL_ISSUE((HACK & 1) && ck >= 2 ? 2 : (ck + 1 < 128 ? ck + 1 : 127));
        bf16x8 vf[2];
#pragma unroll
        for (int ks = 0; ks < 2; ++ks) vf[ks] = *(const LAS bf16x8*)(L + OVT + (16 * w + n) * 144 + (32 * ks + 8 * g) * 2);
        f32x4v o[4];
#pragma unroll
        for (int ct = 0; ct < 4; ++ct) o[ct] = (f32x4v){0.f, 0.f, 0.f, 0.f};
#pragma unroll
        for (int ct = 0; ct < 4; ++ct)
#pragma unroll
            for (int ks = 0; ks < 2; ++ks) { const bf16x8 af = *(const LAS bf16x8*)(L + OAM + (16 * ct + n) * 144 + (32 * ks + 8 * g) * 2); o[ct] = __builtin_amdgcn_mfma_f32_16x16x32_bf16(af, vf[ks], o[ct], 0, 0, 0); }
#pragma unroll
        for (int kk = 0; kk < 4; ++kk) { v4u pw; pw.x = pg8::cvt_pk_bf16(S[2 * kk][0], S[2 * kk][1]); pw.y = pg8::cvt_pk_bf16(S[2 * kk][2], S[2 * kk][3]);
            pw.z = pg8::cvt_pk_bf16(S[2 * kk + 1][0], S[2 * kk + 1][1]); pw.w = pg8::cvt_pk_bf16(S[2 * kk + 1][2], S[2 * kk + 1][3]); const bf16x8 sf = __builtin_bit_cast(bf16x8, pw);
#pragma unroll
            for (int ct = 0; ct < 4; ++ct) { const LAS unsigned char* qp = L + OQD + (16 * ct + n) * 272 + (32 * kk + 4 * g) * 2; const v2u qa = *(const LAS v2u*)qp, qb = *(const LAS v2u*)(qp + 32);
                o[ct] = __builtin_amdgcn_mfma_f32_16x16x32_bf16(__builtin_bit_cast(bf16x8, (v4u){qa.x, qa.y, qb.x, qb.y}), sf, o[ct], 0, 0, 0); } }
#pragma unroll
        for (int dt = 0; dt < 8; ++dt) { const f32x4v eb = *(const LAS f32x4v*)(L + OEB + (16 * dt + 4 * g) * 4); S[dt] = S[dt] * eb;
#pragma unroll
            for (int ks = 0; ks < 2; ++ks) { const bf16x8 kf = *(const LAS bf16x8*)(L + OKT + (16 * dt + n) * 144 + (32 * ks + 8 * g) * 2); S[dt] = __builtin_amdgcn_mfma_f32_16x16x32_bf16(kf, vf[ks], S[dt], 0, 0, 0); } }
        LAS float* PS = (LAS float*)(L + OPS) + (ck & 1) * 512;
#pragma unroll
        for (int ct = 0; ct < 4; ++ct)
#pragma unroll
            for (int r = 0; r < 4; ++r) { const float ss = sum16(o[ct][r] * o[ct][r]); if (n == 0) PS[(16 * ct + 4 * g + r) * 8 + w] = ss;
                *(LAS bf16*)(L + OOT + (16 * ct + 4 * g + r) * 272 + (16 * w + n) * 2) = (bf16)f2bf(o[ct][r]); }
        LDS_BARRIER();
        GL_WRITE();
        if (!(HACK & 2)) {
#pragma unroll
        for (int i = 0; i < 2; ++i) { const int c_ = tid + 512 * i, tok = c_ >> 4, ch = c_ & 15; *(v4u*)(OB + (row0 + tok) * 1024 + h * 256 + 128 * vh + ch * 8) = *(const LAS v4u*)(L + OOT + tok * 272 + ch * 16); }
        if (tid < 64) { const LAS f32x4v* pp = (const LAS f32x4v*)(PS + tid * 8); const f32x4v p0 = pp[0], p1 = pp[1]; PSG[(row0 + tid) * 8 + h * 2 + vh] = ((p0.x + p0.y) + (p0.z + p0.w)) + ((p1.x + p1.y) + (p1.z + p1.w)); } }
        LDS_BARRIER();
    }
#undef GL_ISSUE
#undef GL_WRITE
}
__device__ __forceinline__ void gla_post(Frame& F, int l) {
    const bf16* OB = WSP(bf16, WS_OB); const float* PSG = WSP(float, WS_PSG); const bf16* COLS = WSP(bf16, WS_COLS); bf16* MIX = WSP(bf16, WS_MIXED);
    const int ch = F.tid & 127, h = ch >> 5; float gain8[8];
#pragma unroll
    for (int e = 0; e < 8; ++e) gain8[e] = F.kin[I_GON][l * 256 + (ch & 31) * 8 + e];
    for (int row = F.bx * 4 + (F.tid >> 7); row < M; row += F.G * 4) {
        float ov[8], gv[8]; unpack8(*(const v4u*)(OB + (size_t)row * 1024 + ch * 8), ov); unpack8(*(const v4u*)(COLS + (size_t)row * NMAIN + CB_G + ch * 8), gv);
        const f32x2_t ps = *(const f32x2_t*)(PSG + (size_t)row * 8 + h * 2); const float rstd = rsqrtf((ps.x + ps.y) * (1.0f / 256.0f) + 1e-6f);
#pragma unroll
        for (int e = 0; e < 8; ++e) ov[e] = ov[e] * (rstd * gain8[e]) * silu_g(gv[e]);
        *(v4u*)(MIX + (size_t)row * DM + 1024 + ch * 8) = pack8(ov);
    }
}
constexpr int RC_AT = 0, RC_RT = 2048, RC_BK = 4096, RC_VF = 8192, RC_GF = 10240, RC_U0 = 12288, RC_Y0 = 16384, RC_P15 = 20480, RC_BN = 20736, RC_BYTES = 20800;
__device__ __forceinline__ void rwkv_chunks_of_tile(Frame& F, int l, int tile) {
    const int team = F.tid >> 8, tt = F.tid & 255;
    LAS float* Lt = (LAS float*)(F.lds + RING_OFF) + team * 12288;
    LAS float* XA = Lt; LAS float* XR = Lt + 1040; LAS float* ZB = Lt + 2080; LAS float* ZK = Lt + 3120; LAS float* TB = Lt + 4160; LAS float* TK = Lt + 5200; LAS float* VV = Lt + 6240;
    LAS float* ATl = Lt + 7280; LAS float* U0l = Lt + 8320; LAS float* W1 = Lt + 9360;
    LAS float* Aab = Lt + 10400; LAS float* Aak = Lt + 10672; LAS float* Arb = Lt + 10944; LAS float* Ark = Lt + 11216; LAS float* TT = Lt + 11488;
    const float* RW = WSP(float, WS_RW); const unsigned* RWU = WSP(unsigned, WS_RW); constexpr size_t RS = RW_ONE / 4; unsigned char* RWC = F.ws + WS_RWC;
    float pw_[6], pr_[4], pk_[4], pv_[4], pa_[4], pb_[4], pg_[4];
#define RC_FETCH(P) do { const int h_ = 2 * (P) + team; const size_t cb_ = (size_t)tile * 16 * 1024 + h_ * 64 + (tt & 63); const int q_ = tt >> 6; \
        pw_[4] = RW[RS + cb_ + (size_t)(q_ ? 4 * q_ - 1 : 0) * 1024]; pw_[5] = RW[RS + cb_ + (size_t)15 * 1024];            \
        _Pragma("unroll") for (int e = 0; e < 4; ++e) { const size_t o_ = cb_ + (size_t)(4 * q_ + e) * 1024; pw_[e] = RW[RS + o_]; const unsigned u0 = RWU[o_], u2 = RWU[2 * RS + o_], u3 = RWU[3 * RS + o_]; \
            pr_[e] = bflo(u0); pk_[e] = bfhi(u0); pv_[e] = bflo(u2); pg_[e] = bfhi(u2); pa_[e] = bflo(u3); pb_[e] = bfhi(u3); } } while (0)
    RC_FETCH(0);
#pragma unroll 1
    for (int pair = 0; pair < 8; ++pair) {
        const int uc = ((tile >> 9) * 16 + 2 * pair + team) * 512 + (tile & 511), b = uc >> 13, h = (uc >> 9) & 15, ck = uc & 511; unsigned char* rec = RWC + ((size_t)ck * 32 + (uc >> 9)) * RC_BYTES;     (void)b;
        __syncthreads();
        {
          const int j = tt & 63, q = tt >> 6;
          const float cl = pw_[5], clm = q ? pw_[4] : 0.f; const float clq[4] = {pw_[0], pw_[1], pw_[2], pw_[3]};
#pragma unroll
          for (int e = 0; e < 4; ++e) { const int t = 4 * q + e; const float cprev = e == 0 ? clm : clq[e - 1], cc = clq[e];
              const float rr = pr_[e], kk = pk_[e], vv = pv_[e], aa = pa_[e], bb = pb_[e];
              XA[t * 65 + j] = aa * __expf(cprev); XR[t * 65 + j] = rr * __expf(cc); const float ei = __expf(-cc), ef = __expf(cl - cc);
              ZB[t * 65 + j] = bb * ei; ZK[t * 65 + j] = kk * ei; TB[t * 65 + j] = bb * ef; TK[t * 65 + j] = kk * ef; VV[t * 65 + j] = vv; }
          if (q == 0) ((float*)(rec + RC_P15))[j] = __expf(cl);
          { v2u gw; gw.x = pk2(pg_[0], pg_[1]); gw.y = pk2(pg_[2], pg_[3]); *(v2u*)(rec + RC_GF + (((j >> 4) * 64 + 16 * q + (j & 15)) * 8)) = gw; } }
        RC_FETCH(pair < 7 ? pair + 1 : 7);
        __syncthreads();
        {
          const int q = tt >> 6, n = tt & 15, g = (tt >> 4) & 3; const LAS float* X = (q & 2) ? XR : XA; const LAS float* Z = (q & 1) ? ZK : ZB; LAS float* O = q == 0 ? Aab : (q == 1 ? Aak : (q == 2 ? Arb : Ark));
          f32x4v c = (f32x4v){0.f, 0.f, 0.f, 0.f};
#pragma unroll
          for (int ks = 0; ks < 16; ++ks) c = __builtin_amdgcn_mfma_f32_16x16x4f32(X[n * 65 + 4 * ks + g], Z[n * 65 + 4 * ks + g], c, 0, 0, 0);
#pragma unroll
          for (int rr = 0; rr < 4; ++rr) { const int t = 4 * g + rr; O[t * 17 + n] = ((q & 2) ? n <= t : n < t) ? c[rr] : 0.f; }
          { const int t = tt >> 4, jq = tt & 15; const float* rkp = F.kin[I_RRK] + l * 1024 + h * 64 + 4 * jq; float bn = 0.f;
#pragma unroll
            for (int e = 0; e < 4; ++e) bn += XR[t * 65 + 4 * jq + e] * ZK[t * 65 + 4 * jq + e] * rkp[e];
            bn = sum16(bn); if (jq == 0) ((float*)(rec + RC_BN))[t] = bn; } }
        __syncthreads();
        {
          if (tt < 16) { float col[16];
#pragma unroll
              for (int t = 0; t < 16; ++t) { float acc = (t == tt) ? 1.f : 0.f;
#pragma unroll
                  for (int s = 0; s < 16; ++s) if (s < t) acc += Aab[t * 17 + s] * col[s];
                  col[t] = acc; TT[t * 17 + tt] = acc; } }
          const int q = tt >> 6, n = tt & 15, g = (tt >> 4) & 3; f32x4v c = (f32x4v){0.f, 0.f, 0.f, 0.f};
#pragma unroll
          for (int ks = 0; ks < 4; ++ks) c = __builtin_amdgcn_mfma_f32_16x16x4f32(Aak[n * 17 + 4 * ks + g], VV[(4 * ks + g) * 65 + 16 * q + n], c, 0, 0, 0);
#pragma unroll
          for (int rr = 0; rr < 4; ++rr) W1[(4 * g + rr) * 65 + 16 * q + n] = c[rr]; }
        __syncthreads();
        {
          const int q = tt >> 6, n = tt & 15, g = (tt >> 4) & 3; f32x4v ca = (f32x4v){0.f, 0.f, 0.f, 0.f}, cu = (f32x4v){0.f, 0.f, 0.f, 0.f};
#pragma unroll
          for (int ks = 0; ks < 4; ++ks) { const float tv = TT[n * 17 + 4 * ks + g]; ca = __builtin_amdgcn_mfma_f32_16x16x4f32(tv, XA[(4 * ks + g) * 65 + 16 * q + n], ca, 0, 0, 0); cu = __builtin_amdgcn_mfma_f32_16x16x4f32(tv, W1[(4 * ks + g) * 65 + 16 * q + n], cu, 0, 0, 0); }
#pragma unroll
          for (int rr = 0; rr < 4; ++rr) { ATl[(4 * g + rr) * 65 + 16 * q + n] = ca[rr]; U0l[(4 * g + rr) * 65 + 16 * q + n] = cu[rr]; }
          *(f32x4v*)(rec + RC_U0 + ((q * 64 + 16 * g + n) * 16)) = cu; }
        __syncthreads();
        {
          const int q = tt >> 6, n = tt & 15, g = (tt >> 4) & 3; f32x4v cr, cy = (f32x4v){0.f, 0.f, 0.f, 0.f};
#pragma unroll
          for (int rr = 0; rr < 4; ++rr) cr[rr] = XR[(4 * g + rr) * 65 + 16 * q + n];
#pragma unroll
          for (int ks = 0; ks < 4; ++ks) { const float arb = Arb[n * 17 + 4 * ks + g], ark = Ark[n * 17 + 4 * ks + g];
              cr = __builtin_amdgcn_mfma_f32_16x16x4f32(arb, ATl[(4 * ks + g) * 65 + 16 * q + n], cr, 0, 0, 0);
              cy = __builtin_amdgcn_mfma_f32_16x16x4f32(arb, U0l[(4 * ks + g) * 65 + 16 * q + n], cy, 0, 0, 0);
              cy = __builtin_amdgcn_mfma_f32_16x16x4f32(ark, VV[(4 * ks + g) * 65 + 16 * q + n], cy, 0, 0, 0); }
          *(f32x4v*)(rec + RC_Y0 + ((q * 64 + 16 * g + n) * 16)) = cy;
#pragma unroll
          for (int rr = 0; rr < 4; ++rr) W1[(4 * g + rr) * 65 + 16 * q + n] = cr[rr]; }
        __syncthreads();
        { const int t = tt & 15, jq = tt >> 4, kk = jq >> 3, half = (jq & 7) >> 2, g = jq & 3, j0 = 4 * jq;
          v2u wa, wr; wa.x = pk2(ATl[t * 65 + j0], ATl[t * 65 + j0 + 1]); wa.y = pk2(ATl[t * 65 + j0 + 2], ATl[t * 65 + j0 + 3]); wr.x = pk2(W1[t * 65 + j0], W1[t * 65 + j0 + 1]); wr.y = pk2(W1[t * 65 + j0 + 2], W1[t * 65 + j0 + 3]);
          *(v2u*)(rec + RC_AT + kk * 1024 + (16 * g + t) * 16 + half * 8) = wa; *(v2u*)(rec + RC_RT + kk * 1024 + (16 * g + t) * 16 + half * 8) = wr;
          const int j = tt & 63, gg = tt >> 6; v4u bk; bk.x = pk2(TB[(4 * gg) * 65 + j], TB[(4 * gg + 1) * 65 + j]); bk.y = pk2(TB[(4 * gg + 2) * 65 + j], TB[(4 * gg + 3) * 65 + j]);
          bk.z = pk2(TK[(4 * gg) * 65 + j], TK[(4 * gg + 1) * 65 + j]); bk.w = pk2(TK[(4 * gg + 2) * 65 + j], TK[(4 * gg + 3) * 65 + j]);
          *(v4u*)(rec + RC_BK + (j >> 4) * 1024 + (16 * gg + (j & 15)) * 16) = bk;
          v2u vf; vf.x = pk2(VV[(4 * gg) * 65 + j], VV[(4 * gg + 1) * 65 + j]); vf.y = pk2(VV[(4 * gg + 2) * 65 + j], VV[(4 * gg + 3) * 65 + j]);
          *(v2u*)(rec + RC_VF + ((j >> 4) * 64 + 16 * gg + (j & 15)) * 8) = vf; }
    }
}
#undef RC_FETCH
template <int HACK = 0> __device__ __forceinline__ void rwkv_scan_unit(Frame& F, int l, int b, int h) {
    LAS unsigned char* L = F.lds + RING_OFF;
    const unsigned char* recs = F.ws + WS_RWC + (size_t)(b * 16 + h) * RC_BYTES;
    const int lane = F.lane, n = lane & 15, g = lane >> 4;
    LAS float* XS = (LAS float*)(L + 2 * RC_BYTES);
    if (F.wave >= 2) {
        const int li = F.tid - 128;
        int px[4];
#pragma unroll
        for (int k = 0; k < 4; ++k) { const int x = li + 384 * k; px[k] = x < 1300 ? x : 1299; }
        v4u p0[4], p1[4], p2[4], p3[4], p4[4], p5[4], p6[4], p7[4];
#define RWL_ISSUE(P, CK) do { const int ck_ = (CK) < 512 ? ((HACK & 1) && (CK) >= 4 ? 3 : (CK)) : 511; const v4u* src_ = (const v4u*)(recs + (size_t)ck_ * 32 * RC_BYTES); \
        _Pragma("unroll") for (int k = 0; k < 4; ++k) P[k] = src_[px[k]]; } while (0)
#define RWL_WRITE(P, CK) do { LAS v4u* dst_ = (LAS v4u*)(L + ((CK) & 1) * RC_BYTES); _Pragma("unroll") for (int k = 0; k < 4; ++k) dst_[px[k]] = P[k]; } while (0)
        RWL_ISSUE(p0, 0); RWL_ISSUE(p1, 1); RWL_ISSUE(p2, 2); RWL_ISSUE(p3, 3); RWL_ISSUE(p4, 4); RWL_ISSUE(p5, 5); RWL_ISSUE(p6, 6); RWL_ISSUE(p7, 7);
        RWL_WRITE(p0, 0); RWL_ISSUE(p0, 8);
        LDS_BARRIER();
#pragma unroll 1
        for (int ck = 0; ck < 512; ck += 8) {
            RWL_WRITE(p1, ck + 1); RWL_ISSUE(p1, ck + 9); LDS_BARRIER();
            RWL_WRITE(p2, ck + 2); RWL_ISSUE(p2, ck + 10); LDS_BARRIER();
            RWL_WRITE(p3, ck + 3); RWL_ISSUE(p3, ck + 11); LDS_BARRIER();
            RWL_WRITE(p4, ck + 4); RWL_ISSUE(p4, ck + 12); LDS_BARRIER();
            RWL_WRITE(p5, ck + 5); RWL_ISSUE(p5, ck + 13); LDS_BARRIER();
            RWL_WRITE(p6, ck + 6); RWL_ISSUE(p6, ck + 14); LDS_BARRIER();
            RWL_WRITE(p7, ck + 7); RWL_ISSUE(p7, ck + 15); LDS_BARRIER();
            RWL_WRITE(p0, ck + 8); RWL_ISSUE(p0, ck + 16); LDS_BARRIER();
        }
#undef RWL_ISSUE
#undef RWL_WRITE
        return;
    }
    const int cw = F.wave;
    f32x4v S[4][2];
#pragma unroll
    for (int jt = 0; jt < 4; ++jt)
#pragma unroll
        for (int it = 0; it < 2; ++it) S[jt][it] = (f32x4v){0.f, 0.f, 0.f, 0.f};
    float lnw[2], lnb[2];
#pragma unroll
    for (int it = 0; it < 2; ++it) { lnw[it] = F.kin[I_RLNW][l * 1024 + h * 64 + 16 * (2 * cw + it) + n]; lnb[it] = F.kin[I_RLNB][l * 1024 + h * 64 + 16 * (2 * cw + it) + n]; }
    bf16* MIX = WSP(bf16, WS_MIXED) + ((size_t)b * SEQ) * DM + 2048 + h * 64 + 32 * cw + n;
    f32x4v Yp[2] = {(f32x4v){0.f, 0.f, 0.f, 0.f}, (f32x4v){0.f, 0.f, 0.f, 0.f}}, bnp = (f32x4v){0.f, 0.f, 0.f, 0.f}; v2u gfp[2] = {(v2u){0u, 0u}, (v2u){0u, 0u}}, vfp[2] = {(v2u){0u, 0u}, (v2u){0u, 0u}};
    LDS_BARRIER();
#pragma unroll 1
    for (int ck = 0; ck <= 512; ++ck) {
        if (ck > 0) {
            const LAS float* xs = XS + ((ck - 1) & 1) * 64; const f32x4v a0 = *(const LAS f32x4v*)(xs + 8 * g), a1 = *(const LAS f32x4v*)(xs + 8 * g + 4), b0 = *(const LAS f32x4v*)(xs + 32 + 8 * g), b1 = *(const LAS f32x4v*)(xs + 32 + 8 * g + 4);
            const float s1[4] = {a0[0] + b0[0], a0[2] + b0[2], a1[0] + b1[0], a1[2] + b1[2]}, s2[4] = {a0[1] + b0[1], a0[3] + b0[3], a1[1] + b1[1], a1[3] + b1[3]};
#pragma unroll
            for (int it = 0; it < 2; ++it) { const float gt[4] = {bflo(gfp[it].x), bfhi(gfp[it].x), bflo(gfp[it].y), bfhi(gfp[it].y)}, vt[4] = {bflo(vfp[it].x), bfhi(vfp[it].x), bflo(vfp[it].y), bfhi(vfp[it].y)};
#pragma unroll
                for (int r = 0; r < 4; ++r) { const float mean = s1[r] * (1.0f / 64.0f), var = fmaxf(s2[r] * (1.0f / 64.0f) - mean * mean, 0.f), rstd = rsqrtf(var + 64e-5f);
                    if (!(HACK & 2)) MIX[(size_t)((ck - 1) * 16 + 4 * g + r) * DM + 16 * it] = (bf16)f2bf(((Yp[it][r] - mean) * rstd * lnw[it] + lnb[it] + bnp[r] * vt[r]) * gt[r]); } }
            if (ck == 512) break;
        }
        if (HACK & 4) { LDS_BARRIER(); continue; }
        const LAS unsigned char* R = L + (ck & 1) * RC_BYTES;
        bf16x8 at[2], rt[2];
#pragma unroll
        for (int kk = 0; kk < 2; ++kk) { at[kk] = *(const LAS bf16x8*)(R + RC_AT + kk * 1024 + lane * 16); rt[kk] = *(const LAS bf16x8*)(R + RC_RT + kk * 1024 + lane * 16); }
        f32x4v U[2], Y[2];
#pragma unroll
        for (int it = 0; it < 2; ++it) { U[it] = *(const LAS f32x4v*)(R + RC_U0 + (2 * cw + it) * 1024 + lane * 16); Y[it] = *(const LAS f32x4v*)(R + RC_Y0 + (2 * cw + it) * 1024 + lane * 16); }
#pragma unroll
        for (int kk = 0; kk < 2; ++kk)
#pragma unroll
            for (int it = 0; it < 2; ++it) { v4u pw; pw.x = pg8::cvt_pk_bf16(S[2 * kk][it][0], S[2 * kk][it][1]); pw.y = pg8::cvt_pk_bf16(S[2 * kk][it][2], S[2 * kk][it][3]);
                pw.z = pg8::cvt_pk_bf16(S[2 * kk + 1][it][0], S[2 * kk + 1][it][1]); pw.w = pg8::cvt_pk_bf16(S[2 * kk + 1][it][2], S[2 * kk + 1][it][3]); const bf16x8 sf = __builtin_bit_cast(bf16x8, pw);
                U[it] = __builtin_amdgcn_mfma_f32_16x16x32_bf16(at[kk], sf, U[it], 0, 0, 0); Y[it] = __builtin_amdgcn_mfma_f32_16x16x32_bf16(rt[kk], sf, Y[it], 0, 0, 0); }
        bf16x8 uv[2];
#pragma unroll
        for (int it = 0; it < 2; ++it) { vfp[it] = *(const LAS v2u*)(R + RC_VF + (2 * cw + it) * 512 + lane * 8); gfp[it] = *(const LAS v2u*)(R + RC_GF + (2 * cw + it) * 512 + lane * 8);
            v4u pw; pw.x = pg8::cvt_pk_bf16(U[it][0], U[it][1]); pw.y = pg8::cvt_pk_bf16(U[it][2], U[it][3]); pw.z = vfp[it].x; pw.w = vfp[it].y; uv[it] = __builtin_bit_cast(bf16x8, pw); }
#pragma unroll
        for (int jt = 0; jt < 4; ++jt) { const bf16x8 bk = *(const LAS bf16x8*)(R + RC_BK + jt * 1024 + lane * 16); const f32x4v p15 = *(const LAS f32x4v*)(R + RC_P15 + (16 * jt + 4 * g) * 4);
#pragma unroll
            for (int it = 0; it < 2; ++it) S[jt][it] = __builtin_amdgcn_mfma_f32_16x16x32_bf16(bk, uv[it], S[jt][it] * p15, 0, 0, 0); }
        bnp = *(const LAS f32x4v*)(R + RC_BN + 16 * g); Yp[0] = Y[0]; Yp[1] = Y[1];
        { LAS float* xo = XS + (ck & 1) * 64 + cw * 32; const f32x4v sm = Y[0] + Y[1], sq = Y[0] * Y[0] + Y[1] * Y[1];
#pragma unroll
          for (int r = 0; r < 4; ++r) { const float a = sum16(sm[r]), q = sum16(sq[r]); if (n == 0) { xo[(4 * g + r) * 2] = a; xo[(4 * g + r) * 2 + 1] = q; } } }
        LDS_BARRIER();
    }
}
template <int HACK = 0> __device__ __forceinline__ void mixers_v4(Frame& F, int l, int qi, int mask = 15) {
    gu32* ctr = F.ctl + CW_Q + 64 * qi;
    for (;;) {
        const int it = next_item(F, ctr); relaunder(F); relaunder_tid(F);
        if (it < 32) { if (mask & 1) rwkv_scan_unit<HACK>(F, l, it >> 4, it & 15); }
        else if (it < 48) { const int j = it - 32; if (mask & 2) gla_scan_unit<HACK>(F, l, j >> 3, (j >> 1) & 3, j & 1); }
        else if (it < 48 + 1024) { const int j = it - 48, qb = 63 - (j >> 4), bh = j & 15; if (mask & 4) attn_unit<true>(F, l, bh >> 3, bh & 7, qb); }
        else if (it < 48 + 2048) { const int j = it - 1072, qb = j & 63, bh = j >> 6; if (mask & 8) attn_unit<false>(F, l, bh >> 3, bh & 7, qb); }
        else break;
    }
}
template <int HACK = 0> __device__ __forceinline__ void prep_rwkv(Frame& F, int l) {
    LAS float* zl = (LAS float*)(F.lds + RING_OFF) + 4096;
    LAS bf16* inb = (LAS bf16*)(F.lds + RING_OFF);
    const float* mu = F.kin[I_RMU] + (size_t)l * 3264;
    const float* LOWR = WSP(float, WS_LOWR); const bf16* COLS = WSP(bf16, WS_COLS);
    float* RW = WSP(float, WS_RW); unsigned* RWU = WSP(unsigned, WS_RW); float* VF = WSP(float, WS_VFIRST);
    constexpr size_t RS = RW_ONE / 4;
    for (int tile = F.bx; tile < M / 16; tile += F.G) {
        const int row0 = tile * 16;
        relaunder(F); relaunder_tid(F);
        __syncthreads();
        for (int idx = F.tid; idx < 16 * 224; idx += NWAVES * 64) { const int tt = idx / 224, j = idx % 224, row = row0 + tt, t = row & (SEQ - 1);
            const int col = j < 192 ? 16 + j : 208 + (j - 192);
            const float cur = LOWR[(size_t)row * 256 + col], prev = t > 0 ? LOWR[(size_t)(row - 1) * 256 + col] : 0.f;
            const float muv = j < 192 ? mu[3072 + j] : (l ? F.kin[I_VRMU][(l - 1) * 32 + (j - 192)] : 0.f);
            float x = cur + (prev - cur) * muv;
            if (j < 64) x = tanhf(x); else if (j >= 128 && j < 192) x = sigmoid_f(x);
            inb[tt * 232 + j] = (bf16)f2bf(x); }
        __syncthreads();
        {
            const int c = 2 * F.tid;
            float accw[2][16], acca[2][16], accg[2][16], accv[2][16];
#pragma unroll
            for (int e = 0; e < 2; ++e) { const float bw = F.kin[I_RW0][l * 1024 + c + e], ba = F.kin[I_RA0][l * 1024 + c + e], bv = l ? F.kin[I_VR0][(l - 1) * 1024 + c + e] : 0.f;
#pragma unroll
              for (int tt = 0; tt < 16; ++tt) { accw[e][tt] = bw; acca[e][tt] = ba; accg[e][tt] = 0.f; accv[e][tt] = bv; } }
#define LOWRANK_MFMA(ACC, MI, JOFF, NKS) do { const bf16* wf_ = WSP(bf16, WS_WF) + ((size_t)(l * 448 + ((MI) < 3 ? (MI) * 128 + 16 * (NKS) / 2 * F.wave : 384 + 8 * F.wave)) * 64 + F.lane) * 8; \
            bf16x8 af_[NKS], bf_[8][NKS]; \
            _Pragma("unroll") for (int ks = 0; ks < (NKS); ++ks) af_[ks] = *(const LAS bf16x8*)(inb + (F.lane & 15) * 232 + (JOFF) + 32 * ks + 8 * (F.lane >> 4)); \
            _Pragma("unroll") for (int nt = 0; nt < 8; ++nt) _Pragma("unroll") for (int ks = 0; ks < (NKS); ++ks) bf_[nt][ks] = *(const bf16x8*)(wf_ + (size_t)(nt * (NKS) + ks) * 512); \
            _Pragma("unroll") for (int nt = 0; nt < 8; ++nt) { f32x4 c4 = {0.f, 0.f, 0.f, 0.f}; \
                _Pragma("unroll") for (int ks = 0; ks < (NKS); ++ks) c4 = __builtin_amdgcn_mfma_f32_16x16x32_bf16(af_[ks], bf_[nt][ks], c4, 0, 0, 0); \
                _Pragma("unroll") for (int rr = 0; rr < 4; ++rr) zl[(4 * (F.lane >> 4) + rr) * 1028 + 128 * F.wave + 16 * nt + (F.lane & 15)] = c4[rr]; } \
            __syncthreads(); \
            _Pragma("unroll") for (int tt = 0; tt < 16; ++tt) { const f32x2_t z2 = *(const LAS f32x2_t*)(zl + tt * 1028 + c); ACC[0][tt] += z2.x; ACC[1][tt] += z2.y; } \
            __syncthreads(); } while (0)
            if (!(HACK & 1)) { LOWRANK_MFMA(accw, 0, 0, 2); relaunder(F);
            LOWRANK_MFMA(acca, 1, 64, 2); relaunder(F);
            LOWRANK_MFMA(accg, 2, 128, 2); relaunder(F);
            if (l) LOWRANK_MFMA(accv, 3, 192, 1); }
#undef LOWRANK_MFMA
            relaunder(F);
            float mur[2], muk[2], muv[2], kkv[2], kav[2], pr[2] = {0.f, 0.f}, pk[2] = {0.f, 0.f}, pv[2] = {0.f, 0.f}; float cl[2] = {0.f, 0.f};
#pragma unroll
            for (int e = 0; e < 2; ++e) { mur[e] = F.kin[I_RMU][l * 3264 + c + e]; muk[e] = F.kin[I_RMU][l * 3264 + 1024 + c + e]; muv[e] = F.kin[I_RMU][l * 3264 + 2048 + c + e]; kkv[e] = F.kin[I_RKK][l * 1024 + c + e]; kav[e] = F.kin[I_RKA][l * 1024 + c + e]; }
            if ((row0 & (SEQ - 1)) != 0) { const bf16* p = COLS + (size_t)(row0 - 1) * NMAIN + c; const unsigned ur = *(const unsigned*)(p + CC_R), uk = *(const unsigned*)(p + CC_K), uv = *(const unsigned*)(p + CC_V);
                pr[0] = bflo(ur); pr[1] = bfhi(ur); pk[0] = bflo(uk); pk[1] = bfhi(uk); pv[0] = bflo(uv); pv[1] = bfhi(uv); }
            if (!(HACK & 4))
#pragma unroll
            for (int tt = 0; tt < 16; ++tt) { const int row = row0 + tt; const bf16* p = COLS + (size_t)row * NMAIN + c; const size_t o = (size_t)row * 1024 + c;
                const unsigned ur = *(const unsigned*)(p + CC_R), uk = *(const unsigned*)(p + CC_K), uv = *(const unsigned*)(p + CC_V);
                const float cr[2] = {bflo(ur), bfhi(ur)}, ck[2] = {bflo(uk), bfhi(uk)}, cv[2] = {bflo(uv), bfhi(uv)};
                f32x2_t vf2 = {0.f, 0.f}; if (l != 0) vf2 = *(const f32x2_t*)(VF + o);
                float r[2], k[2], v[2], dec[2], av[2], kk[2], km[2];
#pragma unroll
                for (int e = 0; e < 2; ++e) { r[e] = cr[e] + (pr[e] - cr[e]) * mur[e]; k[e] = ck[e] + (pk[e] - ck[e]) * muk[e]; v[e] = cv[e] + (pv[e] - cv[e]) * muv[e]; pr[e] = cr[e]; pk[e] = ck[e]; pv[e] = cv[e];
                    if (l == 0) vf2[e] = v[e]; else { const float vg = sigmoid_f(accv[e][tt]); v[e] = v[e] + (vf2[e] - v[e]) * vg; }
                    cl[e] += -0.6065306597126334f * sigmoid_f(accw[e][tt]); dec[e] = cl[e]; av[e] = sigmoid_f(acca[e][tt]); kk[e] = k[e] * kkv[e]; km[e] = k[e] * (1.0f + (av[e] - 1.0f) * kav[e]); }
                const float ss = sum32(kk[0] * kk[0] + kk[1] * kk[1]), rn = rsqrtf(fmaxf(ss, 1e-24f)); kk[0] *= rn; kk[1] *= rn;
                if (l == 0) *(f32x2_t*)(VF + o) = vf2;
                *(f32x2_t*)(RW + RS + o) = (f32x2_t){dec[0], dec[1]};
                *(v2u*)(RWU + o) = (v2u){pk2(r[0], km[0]), pk2(r[1], km[1])}; *(v2u*)(RWU + 2 * RS + o) = (v2u){pk2(v[0], accg[0][tt]), pk2(v[1], accg[1][tt])};
                *(v2u*)(RWU + 3 * RS + o) = (v2u){pk2(-kk[0], kk[0] * av[0]), pk2(-kk[1], kk[1] * av[1])}; }
        }
        asm volatile("s_waitcnt vmcnt(0)" ::: "memory"); __syncthreads();
        __builtin_amdgcn_fence(__ATOMIC_ACQUIRE, "agent"); asm volatile("s_waitcnt vmcnt(0)" ::: "memory");
        if (!(HACK & 2)) rwkv_chunks_of_tile(F, l, tile);
    }
}
struct Args { const float* in[35]; float* out; unsigned char* ws; };
__device__ __forceinline__ void mk_frame(Frame& F, int wv) {
    extern __shared__ __attribute__((aligned(16))) unsigned char lds[];
    kargp kp = (kargp)__builtin_amdgcn_kernarg_segment_ptr(); asm volatile("" : "+s"(kp));
    F.kin = kp;
    F.lds = (LAS unsigned char*)lds;
    F.MISC = (volatile LAS unsigned*)(F.lds + MISC_OFF);
    { int w_ = wv; asm volatile("" : "+s"(w_)); int t_ = (int)__builtin_amdgcn_mbcnt_hi(~0u, __builtin_amdgcn_mbcnt_lo(~0u, (unsigned)w_ * 64u)); asm volatile("" : "+v"(t_)); F.tid = t_; } F.lane = F.tid & 63; F.wave = __builtin_amdgcn_readfirstlane(F.tid >> 6);
    F.G = gridDim.x; { int bx = blockIdx.x; asm volatile("" : "+s"(bx)); F.bx = bx; F.vcu = (F.G % 8 == 0) ? (bx % 8) * (F.G / 8) + bx / 8 : bx; }
    F.out = (float*)kp[35]; F.ws = (unsigned char*)kp[36]; F.ctl = (gu32*)(F.ws + WS_CTL);
}
__device__ __forceinline__ void grid_bar(int wv) {
    Frame F; mk_frame(F, wv);
    XcdBarrier bar; bar.bar = (unsigned*)(F.ctl + CW_BAR); bar.x = xb_xcc_id(); bar.st = F.MISC + 8;
    xcd_barrier(bar);
}
__global__ void __launch_bounds__(NWAVES * 64, 2) mega_fwd(Args args) {
    const int wv = __builtin_amdgcn_readfirstlane((int)threadIdx.x >> 6);
    { Frame F; mk_frame(F, wv);
      for (int u = F.tid; u < (LDS_BYTES - LDSCTL_OFF) / 4; u += NWAVES * 64) ((LAS unsigned*)(F.lds + LDSCTL_OFF))[u] = 0u;
      __syncthreads();
      (void)xcd_barrier_post((unsigned*)(F.ctl + CW_BAR), F.MISC + 8);
      p0_prologue_a(F);
    }
    grid_bar(wv);
    { Frame F; mk_frame(F, wv); p0_prologue_b(F); }
    grid_bar(wv);
#pragma unroll 1
    for (int l = 0; l < NLAYER; ++l) {
#define LAYER_VARS const float* mod = WSP(float, WS_MOD) + (size_t)l * 2 * 24576; const float* xin = l == 0 ? F.kin[I_X] : F.out; (void)mod; (void)xin
        { Frame F; mk_frame(F, wv); LAYER_VARS; rms_phase(F, xin, mod + 0, mod + 4096); }
        grid_bar(wv);
        { Frame F; mk_frame(F, wv);
          pg8::Gemm g{WSP(pg8::bf16_t, WS_XN), WSP(pg8::bf16_t, WS_WIN + l * WIN_L), M, NIN, DM}; pg8::StaticOrder S; S.init(M, NIN, F.G, F.bx);
          pg8::EpiCols E{WSP(pg8::bf16_t, WS_COLS), WSP(float, WS_LOWR)};
          pg8::gemm_phase<pg8::EpiCols, pg8::StaticOrder, true, true>(F.lds + RING_OFF, g, S, E, F.tid); }
        grid_bar(wv);
        { Frame F; mk_frame(F, wv); prep_norm(F, l); }
        { Frame F; mk_frame(F, wv); prep_loga(F, l); }
        { Frame F; mk_frame(F, wv); prep_rwkv(F, l); }
        { Frame F; mk_frame(F, wv); prep_vt(F, 0); }
        { Frame F; mk_frame(F, wv); prep_vt(F, 1); }
        { Frame F; mk_frame(F, wv); prep_vt(F, 2); }
        { Frame F; mk_frame(F, wv); prep_vt(F, 3); }
        { Frame F; mk_frame(F, wv); prep_vt(F, 4); }
        { Frame F; mk_frame(F, wv); prep_gla(F); }
        grid_bar(wv);
        { Frame F; mk_frame(F, wv); mixers_v4(F, l, l); }
        grid_bar(wv);
        { Frame F; mk_frame(F, wv); gla_post(F, l); }
        grid_bar(wv);
        { Frame F; mk_frame(F, wv); LAYER_VARS;
          pg8::Gemm g{WSP(pg8::bf16_t, WS_MIXED), WSP(pg8::bf16_t, WS_WOUT + l * WOUT_L), M, DM, DM}; pg8::StaticOrder S; S.init(M, DM, F.G, F.bx);
          pg8::EpiRes E{xin, F.out, mod + 2 * 4096};
          pg8::gemm_phase<pg8::EpiRes, pg8::StaticOrder, true, true>(F.lds + RING_OFF, g, S, E, F.tid); }
        grid_bar(wv);
        { Frame F; mk_frame(F, wv); LAYER_VARS; rms_phase(F, F.out, mod + 3 * 4096, mod + 4 * 4096); }
        grid_bar(wv);
        { Frame F; mk_frame(F, wv);
          pg8::Gemm g{WSP(pg8::bf16_t, WS_XN), WSP(pg8::bf16_t, WS_W13 + l * W13_L), M, 2 * DFF, DM}; pg8::StaticOrder S; S.init(M, 2 * DFF, F.G, F.bx);
          pg8::EpiSwiglu E{WSP(pg8::bf16_t, WS_HID)};
          pg8::gemm_phase<pg8::EpiSwiglu, pg8::StaticOrder, true, true>(F.lds + RING_OFF, g, S, E, F.tid); }
        grid_bar(wv);
        { Frame F; mk_frame(F, wv); LAYER_VARS;
          pg8::Gemm g{WSP(pg8::bf16_t, WS_HID), WSP(pg8::bf16_t, WS_W2 + l * W2_L), M, DM, DFF}; pg8::StaticOrder S; S.init(M, DM, F.G, F.bx);
          pg8::EpiRes E{F.out, F.out, mod + 5 * 4096};
          pg8::gemm_phase<pg8::EpiRes, pg8::StaticOrder, true, true>(F.lds + RING_OFF, g, S, E, F.tid); }
        if (l + 1 < NLAYER) grid_bar(wv);
#undef LAYER_VARS
    }
}

extern "C" void kernel_launch(void* const* d_in, const int* in_sizes, int n_in, void* d_out, int out_size, void* d_ws, size_t ws_size, hipStream_t stream) {
    static int grid = 0;
    if (grid == 0) {
        if (n_in != 35 || in_sizes[0] != M * DM || out_size != M * DM || ws_size < WS_END) { fprintf(stderr, "kernel_launch: unexpected shapes: n_in %d in0 %d out %d ws %zu (need %zu)\n", n_in, n_in > 0 ? in_sizes[0] : -1, out_size, ws_size, (size_t)WS_END); grid = -1; return; }
        int dev = 0, cus = 0, per_cu = 0;
        if (hipGetDevice(&dev) != hipSuccess || hipDeviceGetAttribute(&cus, hipDeviceAttributeMultiprocessorCount, dev) != hipSuccess) { grid = -1; return; }
        if (hipFuncSetAttribute((const void*)mega_fwd, hipFuncAttributeMaxDynamicSharedMemorySize, LDS_BYTES) != hipSuccess) { fprintf(stderr, "kernel_launch: hipFuncSetAttribute failed\n"); grid = -1; return; }
        if (hipOccupancyMaxActiveBlocksPerMultiprocessor(&per_cu, (const void*)mega_fwd, NWAVES * 64, LDS_BYTES) != hipSuccess || per_cu < 1) fprintf(stderr, "kernel_launch: occupancy query says %d\n", per_cu);
        (void)hipGetLastError();
        grid = cus;
    }
    if (grid < 0) return;
    if (hipMemsetAsync((char*)d_ws + WS_CTL, 0, CTL_ZERO_BYTES, stream) != hipSuccess) return;
    Args a{};
    for (int i = 0; i < 35; ++i) a.in[i] = (const float*)d_in[i];
    a.out = (float*)d_out; a.ws = (unsigned char*)d_ws;
    hipLaunchKernelGGL(mega_fwd, dim3(grid), dim3(NWAVES * 64), LDS_BYTES, stream, a);
}
```

```cpp
#include <hip/hip_runtime.h>
#include <cstdio>
#include <cstdint>
namespace pg8 {
#define PG8_LAS __attribute__((address_space(3)))
typedef unsigned short bf16_t;
typedef short bf16x8 __attribute__((ext_vector_type(8)));
typedef float f32x4 __attribute__((ext_vector_type(4)));
typedef unsigned u32x4 __attribute__((ext_vector_type(4)));
constexpr int BM = 256, BK = 64, HALF = 128, HTB = HALF * BK * 2  , STAGE_BYTES = 8 * HTB, NXCD = 8, WGM = 8;

__host__ __device__ __forceinline__ int lds_byte(int r, int c) { const int st = (r >> 4) * 2 + (c >> 5), rr = r & 15, cc = c & 31, ob = rr * 64 + cc * 2; return st * 1024 + (ob ^ (((ob >> 9) & 1) << 5)); }
__host__ __device__ __forceinline__ void stage_rc(int b, int& R, int& C) { const int st = b / 1024, sb = b % 1024, swz = sb ^ (((sb >> 9) & 1) << 5); R = (st >> 1) * 16 + swz / 64; C = (st & 1) * 32 + (swz % 64) / 2; }
__host__ __device__ __forceinline__ int perm32(int rho) { const int n = rho >> 4, i = rho & 15; return 8 * (i >> 2) + 4 * n + (i & 3); }

struct Unit { int pm, pn; };
struct Gemm { const bf16_t* A; const bf16_t* Bt; int M, N, K; };

struct StaticOrder {
    int nM, nN, nwg, G, c;
    __host__ __device__ void init(int M, int N, int G_, int c_) { nM = M / BM; nN = N / BM; nwg = nM * nN; G = G_; c = c_; }
    __host__ __device__ bool next(int i, Unit& u) const {
        const long L = (long)i * G + c; if (L >= nwg) return false;
        int wgid = (int)L; { const int q = nwg / NXCD, r = nwg % NXCD, xcd = wgid % NXCD, off = wgid / NXCD; wgid = (xcd < r ? xcd * (q + 1) : r * (q + 1) + (xcd - r) * q) + off; }
        const int nig = WGM * nN, gid = wgid / nig, fm = gid * WGM, gsz = (nM - fm) < WGM ? (nM - fm) : WGM;
        u.pm = fm + ((wgid % nig) % gsz); u.pn = (wgid % nig) / gsz; return true;
    }
    __device__ __forceinline__ void a_ready(const Unit&) const {}
    __device__ __forceinline__ void done(const Unit&) const {}
};

typedef float f32x2c_t __attribute__((ext_vector_type(2))); typedef __bf16 bf16x2c_t __attribute__((ext_vector_type(2)));
__device__ __forceinline__ unsigned cvt_pk_bf16(float lo, float hi) { const f32x2c_t v = {lo, hi}; return __builtin_bit_cast(unsigned, __builtin_convertvector(v, bf16x2c_t)); }
typedef float f32x2 __attribute__((ext_vector_type(2)));
__device__ __forceinline__ float silu_f(float x) { return x * __builtin_amdgcn_rcpf(1.0f + __builtin_amdgcn_exp2f(-1.4426950408889634f * x)); }
struct EpiCols {
    static constexpr bool PERM = true, AFTER_DRAIN = false;
    bf16_t* O; float* L;
    __device__ __forceinline__ void operator()(const f32x4 (&acc)[2][2][4][2], const Unit& u, int wr, int wc, int fr, int fq) const {
        const int row0 = u.pm * BM + wr * 64 + fr;
        if (u.pn < 41) {
            const int col0 = u.pn * BM + wc * 32 + 8 * fq;
#pragma unroll
            for (int ai = 0; ai < 2; ++ai)
#pragma unroll
                for (int m = 0; m < 4; ++m) { bf16_t* rowp = O + (size_t)(row0 + ai * HALF + m * 16) * 10496 + col0;
#pragma unroll
                    for (int bj = 0; bj < 2; ++bj) { const f32x4 v0 = acc[ai][bj][m][0], v1 = acc[ai][bj][m][1];
                        u32x4 w; w.x = cvt_pk_bf16(v0[0], v0[1]); w.y = cvt_pk_bf16(v0[2], v0[3]); w.z = cvt_pk_bf16(v1[0], v1[1]); w.w = cvt_pk_bf16(v1[2], v1[3]);
                        *(u32x4*)(rowp + bj * HALF) = w; } }
        } else {
            const int col0 = wc * 32 + 8 * fq;
#pragma unroll
            for (int ai = 0; ai < 2; ++ai)
#pragma unroll
                for (int m = 0; m < 4; ++m) { float* rowp = L + (size_t)(row0 + ai * HALF + m * 16) * 256 + col0;
#pragma unroll
                    for (int bj = 0; bj < 2; ++bj) { *(f32x4*)(rowp + bj * HALF) = acc[ai][bj][m][0]; *(f32x4*)(rowp + bj * HALF + 4) = acc[ai][bj][m][1]; } }
        }
    }
};
struct EpiRes {
    static constexpr bool PERM = true, AFTER_DRAIN = false;
    const void* base; void* out; const float* gate; bool base_bf, out_bf;
    __device__ __forceinline__ void operator()(const f32x4 (&acc)[2][2][4][2], const Unit& u, int wr, int wc, int fr, int fq) const {
        const int row0 = u.pm * BM + wr * 64 + fr, col0 = u.pn * BM + wc * 32 + 8 * fq;
        const float* gp = gate + (size_t)(u.pm >> 5) * 24576 + col0;
        f32x4 gv[2][2];
#pragma unroll
        for (int bj = 0; bj < 2; ++bj)
#pragma unroll
            for (int n = 0; n < 2; ++n) gv[bj][n] = *(const f32x4*)(gp + bj * HALF + n * 4);
#pragma unroll
        for (int ai = 0; ai < 2; ++ai) {
            f32x4 r[4][2][2];
            if (base_bf) {
#pragma unroll
                for (int m = 0; m < 4; ++m)
#pragma unroll
                    for (int bj = 0; bj < 2; ++bj) { const u32x4 w = *(const u32x4*)((const bf16_t*)base + (size_t)(row0 + ai * HALF + m * 16) * 4096 + col0 + bj * HALF);
                        r[m][bj][0] = (f32x4){__builtin_bit_cast(float, w.x << 16), __builtin_bit_cast(float, w.x & 0xffff0000u), __builtin_bit_cast(float, w.y << 16), __builtin_bit_cast(float, w.y & 0xffff0000u)};
                        r[m][bj][1] = (f32x4){__builtin_bit_cast(float, w.z << 16), __builtin_bit_cast(float, w.z & 0xffff0000u), __builtin_bit_cast(float, w.w << 16), __builtin_bit_cast(float, w.w & 0xffff0000u)}; }
            } else {
#pragma unroll
                for (int m = 0; m < 4; ++m)
#pragma unroll
                    for (int bj = 0; bj < 2; ++bj)
#pragma unroll
                        for (int n = 0; n < 2; ++n) r[m][bj][n] = *(const f32x4*)((const float*)base + (size_t)(row0 + ai * HALF + m * 16) * 4096 + col0 + bj * HALF + n * 4);
            }
#pragma unroll
            for (int m = 0; m < 4; ++m)
#pragma unroll
                for (int bj = 0; bj < 2; ++bj)
#pragma unroll
                    for (int n = 0; n < 2; ++n) r[m][bj][n] = r[m][bj][n] + gv[bj][n] * acc[ai][bj][m][n];
            if (out_bf) {
#pragma unroll
                for (int m = 0; m < 4; ++m)
#pragma unroll
                    for (int bj = 0; bj < 2; ++bj) { const f32x4 v0 = r[m][bj][0], v1 = r[m][bj][1];
                        u32x4 w; w.x = cvt_pk_bf16(v0[0], v0[1]); w.y = cvt_pk_bf16(v0[2], v0[3]); w.z = cvt_pk_bf16(v1[0], v1[1]); w.w = cvt_pk_bf16(v1[2], v1[3]);
                        *(u32x4*)((bf16_t*)out + (size_t)(row0 + ai * HALF + m * 16) * 4096 + col0 + bj * HALF) = w; }
            } else {
#pragma unroll
                for (int m = 0; m < 4; ++m)
#pragma unroll
                    for (int bj = 0; bj < 2; ++bj)
#pragma unroll
                        for (int n = 0; n < 2; ++n) *(f32x4*)((float*)out + (size_t)(row0 + ai * HALF + m * 16) * 4096 + col0 + bj * HALF + n * 4) = r[m][bj][n];
            }
            asm volatile("" ::: "memory");
        }
    }
};
struct EpiSwiglu {
    static constexpr bool PERM = true, AFTER_DRAIN = false;
    bf16_t* H;
    __device__ __forceinline__ void operator()(const f32x4 (&acc)[2][2][4][2], const Unit& u, int wr, int wc, int fr, int fq) const {
        const int row0 = u.pm * BM + wr * 64 + fr, col0 = u.pn * HALF + wc * 32 + 8 * fq;
#pragma unroll
        for (int ai = 0; ai < 2; ++ai)
#pragma unroll
            for (int m = 0; m < 4; ++m) { bf16_t* rowp = H + (size_t)(row0 + ai * HALF + m * 16) * 11008 + col0;
                const f32x4 a0 = acc[ai][0][m][0], a1 = acc[ai][0][m][1], b0 = acc[ai][1][m][0], b1 = acc[ai][1][m][1];
                u32x4 w; w.x = cvt_pk_bf16(silu_f(a0[0]) * b0[0], silu_f(a0[1]) * b0[1]); w.y = cvt_pk_bf16(silu_f(a0[2]) * b0[2], silu_f(a0[3]) * b0[3]);
                w.z = cvt_pk_bf16(silu_f(a1[0]) * b1[0], silu_f(a1[1]) * b1[1]); w.w = cvt_pk_bf16(silu_f(a1[2]) * b1[2], silu_f(a1[3]) * b1[3]);
                *(u32x4*)rowp = w; }
    }
};
template <class Epi, class Sched, bool ALIGN_EPI = false, bool SP2 = false>
__device__ __forceinline__ void gemm_phase(PG8_LAS unsigned char* lds, const Gemm g, const Sched& S, const Epi& E, int tid_in) {
    int tid_ = tid_in; asm volatile("" : "+v"(tid_));
    const int tid = tid_, wid = __builtin_amdgcn_readfirstlane(tid >> 6), lane = tid & 63, wr = wid >> 2, wc = wid & 3, fr = lane & 15, fq = lane >> 4;
    const int K = g.K, nt = K / BK;
    unsigned voffA[2], voffB[2];
#pragma unroll
    for (int i = 0; i < 2; ++i) { int R, C; stage_rc(tid * 16 + i * 8192, R, C); const int Rb = Epi::PERM ? ((R & ~31) + perm32(R & 31)) : R;
        voffA[i] = (unsigned)(R * K + C) * 2u; voffB[i] = (unsigned)(Rb * K + C) * 2u; }
    const size_t kstep = (size_t)(BK * 2);
    const size_t hstep = (size_t)HALF * K * 2;
    const size_t tstep = 2 * hstep;
    const unsigned ldsw = (unsigned)wid * 1024u;
    const int aoff = lds_byte(wr * 64 + fr, fq * 8), boff = lds_byte(wc * 32 + fr, fq * 8);
#define PG8_SA(b, h) (((b) * 2 + (h)) * HTB)
#define PG8_SB(b, h) ((4 + (b) * 2 + (h)) * HTB)
#define PG8_STAGE(bufoff, gbase, voff) do { _Pragma("unroll") for (int _i = 0; _i < 2; ++_i) \
        __builtin_amdgcn_global_load_lds((const unsigned*)((const char*)(gbase) + (voff)[_i]), (PG8_LAS unsigned*)(lds + (bufoff) + ldsw + _i * 8192), 16, 0, 0); } while (0)
#define PG8_LDA(dst, b, h) do { _Pragma("unroll") for (int m = 0; m < 4; ++m) _Pragma("unroll") for (int k = 0; k < 2; ++k) dst[m][k] = *(const PG8_LAS bf16x8*)(lds + PG8_SA(b, h) + aoff + m * 2048 + k * 1024); } while (0)
#define PG8_LDB(dst, b, h) do { _Pragma("unroll") for (int n = 0; n < 2; ++n) _Pragma("unroll") for (int k = 0; k < 2; ++k) dst[n][k] = *(const PG8_LAS bf16x8*)(lds + PG8_SB(b, h) + boff + n * 2048 + k * 1024); } while (0)
#define PG8_MMA(ai, bj, At, Bt) do { __builtin_amdgcn_s_setprio(1); _Pragma("unroll") for (int m = 0; m < 4; ++m) _Pragma("unroll") for (int n = 0; n < 2; ++n) _Pragma("unroll") for (int k = 0; k < 2; ++k) \
        acc[ai][bj][m][n] = __builtin_amdgcn_mfma_f32_16x16x32_bf16(Bt[n][k], At[m][k], acc[ai][bj][m][n], 0, 0, 0); __builtin_amdgcn_s_setprio(0); } while (0)
#define PG8_WAIT_V(n) asm volatile("s_waitcnt vmcnt(" #n ")" ::: "memory")
#define PG8_WAIT_L(n) asm volatile("s_waitcnt lgkmcnt(" #n ")" ::: "memory")
#define PG8_BAR __builtin_amdgcn_s_barrier()
#define PG8_SCHED __builtin_amdgcn_sched_barrier(0)
    Unit cur, nxt; int ui = 0;
    if (!S.next(0, cur)) return;
    f32x4 acc[2][2][4][2];
#pragma unroll
    for (int a = 0; a < 2; ++a)
#pragma unroll
        for (int b = 0; b < 2; ++b)
#pragma unroll
            for (int m = 0; m < 4; ++m)
#pragma unroll
                for (int n = 0; n < 2; ++n) acc[a][b][m][n] = (f32x4){0.f, 0.f, 0.f, 0.f};
    bf16x8 At[4][2], B0[2][2], B1[2][2];
    const char* cA = (const char*)g.A + (size_t)cur.pm * tstep; const char* cB = (const char*)g.Bt + (size_t)cur.pn * tstep;
    S.a_ready(cur);
    if constexpr (SP2) {
        PG8_STAGE(PG8_SB(0, 0), cB, voffB); PG8_STAGE(PG8_SB(0, 1), cB + hstep, voffB); PG8_STAGE(PG8_SA(0, 0), cA, voffA); PG8_STAGE(PG8_SA(0, 1), cA + hstep, voffA);
        if (wr == 1) PG8_BAR;
        PG8_WAIT_V(2); PG8_BAR;
        PG8_STAGE(PG8_SB(1, 0), cB + kstep, voffB); PG8_STAGE(PG8_SA(1, 0), cA + kstep, voffA); PG8_STAGE(PG8_SB(1, 1), cB + hstep + kstep, voffB);
        PG8_WAIT_V(6); PG8_BAR;
    } else {
        PG8_STAGE(PG8_SB(0, 0), cB, voffB); PG8_STAGE(PG8_SA(0, 0), cA, voffA); PG8_STAGE(PG8_SB(0, 1), cB + hstep, voffB); PG8_STAGE(PG8_SA(0, 1), cA + hstep, voffA);
        if (wr == 1) PG8_BAR;
        PG8_WAIT_V(4); PG8_BAR;
        PG8_STAGE(PG8_SB(1, 0), cB + kstep, voffB); PG8_STAGE(PG8_SA(1, 0), cA + kstep, voffA); PG8_STAGE(PG8_SB(1, 1), cB + hstep + kstep, voffB);
        PG8_WAIT_V(6); PG8_BAR;
    }
    for (;;) {
        const bool has_next = S.next(ui + 1, nxt);
        const char* nA = has_next ? (const char*)g.A + (size_t)nxt.pm * tstep : cA; const char* nB = has_next ? (const char*)g.Bt + (size_t)nxt.pn * tstep : cB;
        for (int t = 0; t < nt; t += 2) {
            const bool last = (t == nt - 2);
            const char* a1 = cA + (size_t)(t + 1) * kstep;
            const char* a2 = last ? nA : cA + (size_t)(t + 2) * kstep; const char* b2 = last ? nB : cB + (size_t)(t + 2) * kstep;
            const char* a3 = a2 + kstep; const char* b3 = b2 + kstep;
            if (last && has_next) S.a_ready(nxt);
            if constexpr (SP2) {
            PG8_LDB(B0, 0, 0); PG8_LDB(B1, 0, 1); PG8_SCHED; PG8_LDA(At, 0, 0); PG8_STAGE(PG8_SA(1, 1), a1 + hstep, voffA);
            PG8_WAIT_V(8); PG8_WAIT_L(0); PG8_BAR; PG8_MMA(0, 0, At, B0); PG8_MMA(0, 1, At, B1); PG8_BAR; PG8_SCHED;
            PG8_LDA(At, 0, 1); PG8_STAGE(PG8_SB(0, 0), b2, voffB); PG8_STAGE(PG8_SB(0, 1), b2 + hstep, voffB); PG8_STAGE(PG8_SA(0, 0), a2, voffA);
            PG8_WAIT_V(8); PG8_WAIT_L(0); PG8_BAR; PG8_MMA(1, 0, At, B0); PG8_MMA(1, 1, At, B1); PG8_BAR; PG8_SCHED;
            PG8_LDB(B0, 1, 0); PG8_LDB(B1, 1, 1); PG8_SCHED; PG8_LDA(At, 1, 0); PG8_STAGE(PG8_SA(0, 1), a2 + hstep, voffA);
            PG8_WAIT_V(8); PG8_WAIT_L(0); PG8_BAR; PG8_MMA(0, 0, At, B0); PG8_MMA(0, 1, At, B1); PG8_BAR; PG8_SCHED;
            PG8_LDA(At, 1, 1); PG8_STAGE(PG8_SB(1, 0), b3, voffB); PG8_STAGE(PG8_SB(1, 1), b3 + hstep, voffB); PG8_STAGE(PG8_SA(1, 0), a3, voffA);
            PG8_WAIT_V(8); PG8_WAIT_L(0); PG8_BAR; PG8_MMA(1, 0, At, B0); PG8_MMA(1, 1, At, B1); PG8_BAR; PG8_SCHED;
            } else {
            PG8_LDB(B0, 0, 0); PG8_SCHED; PG8_LDA(At, 0, 0); PG8_STAGE(PG8_SA(1, 1), a1 + hstep, voffA);
            PG8_WAIT_L(8); PG8_BAR; PG8_WAIT_L(0); PG8_MMA(0, 0, At, B0); PG8_BAR; PG8_SCHED;
            PG8_LDB(B1, 0, 1); PG8_STAGE(PG8_SB(0, 0), b2, voffB);
            PG8_BAR; PG8_WAIT_L(0); PG8_MMA(0, 1, At, B1); PG8_BAR;
            PG8_LDA(At, 0, 1); PG8_STAGE(PG8_SA(0, 0), a2, voffA);
            PG8_BAR; PG8_WAIT_L(0); PG8_MMA(1, 0, At, B0); PG8_BAR; PG8_SCHED;
            PG8_STAGE(PG8_SB(0, 1), b2 + hstep, voffB);
            PG8_WAIT_V(6); PG8_BAR; PG8_MMA(1, 1, At, B1); PG8_BAR;
            PG8_LDB(B0, 1, 0); PG8_SCHED; PG8_LDA(At, 1, 0); PG8_STAGE(PG8_SA(0, 1), a2 + hstep, voffA);
            PG8_WAIT_L(8); PG8_BAR; PG8_WAIT_L(0); PG8_MMA(0, 0, At, B0); PG8_BAR; PG8_SCHED;
            PG8_LDB(B1, 1, 1); PG8_STAGE(PG8_SB(1, 0), b3, voffB);
            PG8_BAR; PG8_WAIT_L(0); PG8_MMA(0, 1, At, B1); PG8_BAR;
            PG8_LDA(At, 1, 1); PG8_STAGE(PG8_SA(1, 0), a3, voffA);
            PG8_BAR; PG8_WAIT_L(0); PG8_MMA(1, 0, At, B0); PG8_BAR; PG8_SCHED;
            PG8_STAGE(PG8_SB(1, 1), b3 + hstep, voffB);
            PG8_WAIT_V(6); PG8_BAR; PG8_MMA(1, 1, At, B1); PG8_BAR;
            }
        }
        if constexpr (ALIGN_EPI) { if (wr == 0) PG8_BAR; }
        if constexpr (!Epi::AFTER_DRAIN) { E(acc, cur, wr, wc, fr, fq); S.done(cur); }
        if (!has_next) break;
#pragma unroll
        for (int a = 0; a < 2; ++a)
#pragma unroll
            for (int b = 0; b < 2; ++b)
#pragma unroll
                for (int m = 0; m < 4; ++m)
#pragma unroll
                    for (int n = 0; n < 2; ++n) acc[a][b][m][n] = (f32x4){0.f, 0.f, 0.f, 0.f};
        cur = nxt; cA = nA; cB = nB; ++ui;
        if constexpr (ALIGN_EPI) { if (wr == 1) PG8_BAR; }
    }
    PG8_WAIT_V(0);
    if constexpr (!ALIGN_EPI) { if (wr == 0) PG8_BAR; }
    PG8_BAR;
    if constexpr (Epi::AFTER_DRAIN) { E.fused(acc, cur, wr, wc, fr, fq, lds, wid, lane); S.done(cur); }
#undef PG8_SA
#undef PG8_SB
#undef PG8_STAGE
#undef PG8_LDA
#undef PG8_LDB
#undef PG8_MMA
#undef PG8_WAIT_V
#undef PG8_WAIT_L
#undef PG8_BAR
#undef PG8_SCHED
}
}
constexpr int BATCH = 2, SEQ = 8192, DM = 4096, M = BATCH * SEQ, DFF = 11008, NLAYER = 2;
constexpr int P_IN = 10704, NIN = 10752, NMAIN = 10496;
constexpr int CA_Q = 0, CA_K = 1024, CA_V = 2048;
constexpr int CB_Q = 3072, CB_K = 3584, CB_V = 4096, CB_G = 5120;
constexpr int CC_R = 6144, CC_K = 7168, CC_V = 8192;
constexpr int CD_Q = 9216, CD_K = 10240, CD_V = 10368;
constexpr float LOG2E = 1.4426950408889634f;
constexpr float QSCALE = 0.125f * LOG2E;
constexpr int NWAVES = 8;

constexpr size_t MiB = 1u << 20;
constexpr size_t WS_CTL = 0, CTL_ZERO_BYTES = 1 * MiB;
constexpr size_t WS_MODP = 2 * MiB;
constexpr size_t WS_MOD = 14 * MiB;
constexpr size_t WS_TAB = 15 * MiB;
constexpr size_t WS_WIN = 16 * MiB, WIN_L = 84 * MiB;
constexpr size_t WS_WOUT = 184 * MiB, WOUT_L = 32 * MiB;
constexpr size_t WS_W13 = 248 * MiB, W13_L = 172 * MiB;
constexpr size_t WS_W2 = 592 * MiB, W2_L = 86 * MiB;
constexpr size_t WS_XN = 764 * MiB;
constexpr size_t WS_COLS = 892 * MiB;
constexpr size_t WS_LOWR = 1220 * MiB;
constexpr size_t WS_HID = 892 * MiB;
constexpr size_t WS_QKA = 1236 * MiB;
constexpr size_t WS_QKD = 1300 * MiB;
constexpr size_t WS_LOGA = 1336 * MiB;
constexpr size_t WS_RW = 1368 * MiB, RW_ONE = 64 * MiB;
constexpr size_t WS_VFIRST = 1816 * MiB;
constexpr size_t WS_MIXED = 1880 * MiB;
constexpr int VROW = SEQ + 64;
constexpr size_t WS_VTA = 2008 * MiB;
constexpr size_t WS_VTD = 2041 * MiB;
constexpr size_t WS_QDEC = 2046 * MiB, WS_KDT = 2062 * MiB, WS_AM = 2078 * MiB, WS_EBL = 2086 * MiB;
constexpr size_t WS_VTB = 2087 * MiB;
constexpr size_t WS_RWC = 2120 * MiB;
constexpr size_t WS_OB = 2446 * MiB;
constexpr size_t WS_PSG = 2478 * MiB;
constexpr size_t WS_WF = 2479 * MiB;
constexpr size_t WS_XR = 2480 * MiB;
constexpr size_t WS_END = 2608 * MiB;
constexpr int CW_BAR = 4096;
constexpr int CW_Q = 16384;

constexpr int RING_OFF = 0, RING_BYTES = 131072;
constexpr int LDSCTL_OFF = RING_BYTES, MISC_OFF = LDSCTL_OFF + 320;
constexpr int LDS_BYTES = 147456;

#define GAS __attribute__((address_space(1)))
#define LAS __attribute__((address_space(3)))
typedef unsigned short bf16;
typedef unsigned v4u __attribute__((ext_vector_type(4)));
typedef unsigned v2u __attribute__((ext_vector_type(2)));
typedef float f32x4 __attribute__((ext_vector_type(4)));
typedef short bf16x8 __attribute__((ext_vector_type(8)));
typedef GAS unsigned gu32;
#define RLX_AGENT __ATOMIC_RELAXED, __HIP_MEMORY_SCOPE_AGENT
#define LDS_WAIT() asm volatile("s_waitcnt lgkmcnt(0)" ::: "memory")
#define VM_WAIT() asm volatile("s_waitcnt vmcnt(0)" ::: "memory")
typedef float f32x2_t __attribute__((ext_vector_type(2))); typedef __bf16 bf16x2_t __attribute__((ext_vector_type(2)));
__device__ __forceinline__ unsigned pk2(float lo, float hi) { const f32x2_t v = {lo, hi}; return __builtin_bit_cast(unsigned, __builtin_convertvector(v, bf16x2_t)); }
__device__ __forceinline__ unsigned f2bf(float f) { return pk2(f, f) & 0xffffu; }
__device__ __forceinline__ float bf2f(unsigned short h) { return __builtin_bit_cast(float, (unsigned)h << 16); }
__device__ __forceinline__ float bflo(unsigned w) { return __builtin_bit_cast(float, w << 16); }
__device__ __forceinline__ float bfhi(unsigned w) { return __builtin_bit_cast(float, w & 0xffff0000u); }
template <int CTRL> __device__ __forceinline__ float dpp_f(float v) { return __builtin_bit_cast(float, __builtin_amdgcn_update_dpp(0, __builtin_bit_cast(int, v), CTRL, 0xF, 0xF, true)); }
__device__ __forceinline__ float sum8(float v) {
    v += dpp_f<0xB1>(v); v += dpp_f<0x4E>(v); v += dpp_f<0x141>(v); return v; }
__device__ __forceinline__ float sum32(float v) {
    v = sum8(v); v += dpp_f<0x140>(v); v += __builtin_bit_cast(float, __builtin_amdgcn_ds_swizzle(__builtin_bit_cast(int, v), 0x401F)); return v; }
__device__ __forceinline__ float wave_sum(float v) {
    v = sum8(v); v += dpp_f<0x140>(v);
    v += __builtin_bit_cast(float, __builtin_amdgcn_ds_swizzle(__builtin_bit_cast(int, v), 0x401F));
    { const int u = __builtin_bit_cast(int, v); v = __builtin_bit_cast(float, __builtin_amdgcn_readlane(u, 0)) + __builtin_bit_cast(float, __builtin_amdgcn_readlane(u, 32)); }
    return v;
}
__device__ __forceinline__ float sigmoid_f(float x) { return __builtin_amdgcn_rcpf(1.0f + __builtin_amdgcn_exp2f(-LOG2E * x)); }
__device__ __forceinline__ float silu_g(float x) { return x * sigmoid_f(x); }
__device__ __forceinline__ void unpack8(const v4u r, float (&f)[8]) { f[0] = bflo(r.x); f[1] = bfhi(r.x); f[2] = bflo(r.y); f[3] = bfhi(r.y); f[4] = bflo(r.z); f[5] = bfhi(r.z); f[6] = bflo(r.w); f[7] = bfhi(r.w); }
__device__ __forceinline__ v4u pack8(const float (&f)[8]) { v4u o; o.x = pk2(f[0], f[1]); o.y = pk2(f[2], f[3]); o.z = pk2(f[4], f[5]); o.w = pk2(f[6], f[7]); return o; }

#define XB_TMO      128
#define XB_XCNT(j)  (256  + 64 * (j))
#define XB_XSUB(j)  (1280 + 64 * (j))
#define XB_XGEN(j)  (2304 + 64 * (j))
#define XB_TOP      3328
#define XB_TOPGEN   3392
#define XCD_BAR_WORDS 3456
#define XB_SPIN_CAP (1u << 23)

__device__ __forceinline__ unsigned xb_ld(unsigned* p)              { return __hip_atomic_load(p, __ATOMIC_RELAXED, __HIP_MEMORY_SCOPE_AGENT); }
__device__ __forceinline__ unsigned xb_add(unsigned* p, unsigned v) { return __hip_atomic_fetch_add(p, v, __ATOMIC_RELAXED, __HIP_MEMORY_SCOPE_AGENT); }
__device__ __forceinline__ unsigned xb_xcc_id() { return (unsigned)__builtin_amdgcn_s_getreg((3 << 11) | 20) & 0xFu; }
#define XB_SPIN(cond, bar) do { unsigned _sp = 0; while (cond) { __builtin_amdgcn_s_sleep(1); \
    if ((++_sp & 255u) == 0u) { if (xb_ld(&(bar)[XB_TMO])) break; if (_sp > XB_SPIN_CAP) { atomicAdd(&(bar)[XB_TMO], 1u); break; } } } } while (0)

struct XcdBarrier {
    unsigned* bar; unsigned x;
    volatile LAS unsigned* st;
};

__device__ __forceinline__ XcdBarrier xcd_barrier_post(unsigned* bar, volatile LAS unsigned* st) {
    XcdBarrier b; b.bar = bar; b.x = xb_xcc_id(); b.st = st;
    if (threadIdx.x == 0) (void)xb_add(&bar[XB_XCNT(b.x)], 1u);
    return b;
}
__device__ __forceinline__ void xcd_barrier_complete(unsigned* bar, unsigned x, unsigned& nloc, unsigned& nx) {
    const unsigned G = gridDim.x * gridDim.y * gridDim.z;
    unsigned sum, cnt, mine, sp = 0u;
    for (;;) {
        sum = 0u; cnt = 0u; mine = 0u;
#pragma unroll
        for (unsigned j = 0; j < 16; ++j) { const unsigned c = xb_ld(&bar[XB_XCNT(j)]); sum += c; cnt += (c > 0u) ? 1u : 0u; mine = (j == x) ? c : mine; }
        if (sum == G) break;
        __builtin_amdgcn_s_sleep(1);
        if ((++sp & 255u) == 0u) { if (xb_ld(&bar[XB_TMO])) break; if (sp > XB_SPIN_CAP) { atomicAdd(&bar[XB_TMO], 1u); break; } }
    }
    nloc = mine > 0u ? mine : 1u; nx = cnt > 0u ? cnt : 1u;
}

__device__ __forceinline__ void xcd_barrier(const XcdBarrier& b) {
    asm volatile("s_waitcnt vmcnt(0)" ::: "memory");
    __syncthreads();
    if (threadIdx.x == 0) {
        unsigned* bar = b.bar;
        __builtin_amdgcn_s_waitcnt(0);
        unsigned nloc = b.st[0], nx = b.st[1];
        if (nloc == 0u) { xcd_barrier_complete(bar, b.x, nloc, nx); b.st[0] = nloc; b.st[1] = nx; }
        const unsigned old = xb_add(&bar[XB_XSUB(b.x)], 1u);
        const unsigned gen = old / nloc;
        if (old + 1u == (gen + 1u) * nloc) {
            __builtin_amdgcn_fence(__ATOMIC_RELEASE, "agent");
            asm volatile("s_waitcnt vmcnt(0)" ::: "memory");
            const unsigned og = xb_add(&bar[XB_TOP], 1u);
            const unsigned tg = og / nx;
            if (og + 1u == (tg + 1u) * nx) xb_add(&bar[XB_TOPGEN], 1u);
            else XB_SPIN(xb_ld(&bar[XB_TOPGEN]) == tg, bar);
            __builtin_amdgcn_fence(__ATOMIC_ACQUIRE, "agent");
            xb_add(&bar[XB_XGEN(b.x)], 1u);
            asm volatile("s_waitcnt vmcnt(0)" ::: "memory");
        } else {
            XB_SPIN(xb_ld(&bar[XB_XGEN(b.x)]) == gen, bar);
            __builtin_amdgcn_fence(__ATOMIC_ACQUIRE, "agent");
            asm volatile("s_waitcnt vmcnt(0)" ::: "memory");
        }
    }
    __syncthreads();
}

typedef const float* const __attribute__((address_space(4)))* kargp;
struct Frame {
    LAS unsigned char* lds;
    volatile LAS unsigned* MISC;
    gu32* ctl;
    int tid, lane, wave;
    int vcu, G, bx;
    kargp kin;
    float* out;
    unsigned char* ws;
};
enum { I_X = 0, I_C, I_RELB, I_ADAW, I_ADAB, I_WIN, I_WOUT, I_DQN, I_DKN, I_DLAM, I_DSUB, I_GGU, I_GGB, I_GON, I_RMU, I_RWUP, I_RW0, I_RAUP, I_RA0, I_RGUP,
       I_RKK, I_RKA, I_RRK, I_RLNW, I_RLNB, I_VRD, I_VRMU, I_VRUP, I_VR0, I_SQN, I_SKN, I_SSINK, I_W1, I_W3, I_W2 };

#define WSP(T, off) ((T*)(F.ws + (off)))
__device__ __forceinline__ void relaunder_tid(Frame& F) { int t = F.tid; asm volatile("" : "+v"(t)); F.tid = t; F.lane = t & 63; F.wave = __builtin_amdgcn_readfirstlane(t >> 6); }
__device__ __forceinline__ void relaunder(Frame& F) { kargp p = F.kin; asm volatile("" : "+s"(p)); F.kin = p; }

__device__ __forceinline__ void conv_item(const float* src, int ld, int col0, int ncols, int K, bf16* WT, int row0, int kb, LAS float* scr, int lane) {
    const int k0 = 64 * kb;
    { const int n = lane & 31; const bool ok = src != nullptr && n < ncols; const float* sp = src + (size_t)(k0 + (lane >> 5)) * ld + col0 + n; float v[32];
#pragma unroll
      for (int i = 0; i < 32; ++i) v[i] = ok ? sp[(size_t)(2 * i) * ld] : 0.f;
#pragma unroll
      for (int i = 0; i < 32; ++i) scr[(2 * i + (lane >> 5)) * 33 + n] = v[i]; }
    LDS_WAIT(); asm volatile("" ::: "memory");
    const int c = lane & 7;
#pragma unroll
    for (int j = 0; j < 4; ++j) { const int n = (lane >> 3) + 8 * j; const LAS float* s = scr + (8 * c) * 33 + n;
        v4u o; o.x = pk2(s[0 * 33], s[1 * 33]); o.y = pk2(s[2 * 33], s[3 * 33]); o.z = pk2(s[4 * 33], s[5 * 33]); o.w = pk2(s[6 * 33], s[7 * 33]);
        if (n < ncols) *(GAS v4u*)(WT + (size_t)(row0 + n) * K + k0 + 8 * c) = o; }
    LDS_WAIT(); asm volatile("" ::: "memory");
}
__device__ __forceinline__ int t5_bucket(int d) {
    if (d < 16) return d;
    int v = 16 + (int)(logf((float)d * (1.0f / 16.0f)) / logf(8.0f) * 16.0f);
    return v < 31 ? v : 31;
}
__device__ __forceinline__ void p0_prologue_a(Frame& F) {
    const int gw = F.vcu * NWAVES + F.wave, NGW = F.G * NWAVES;
    LAS float* ldsf = (LAS float*)(F.lds + RING_OFF);
    for (int i = F.tid; i < 2 * DM; i += NWAVES * 64) ldsf[i] = silu_g(F.kin[I_C][i]);
    __syncthreads();
    float* MODP = WSP(float, WS_MODP);
    for (int it = gw; it < 6144; it += NGW) {
        const int l = it / 3072, rem = it % 3072, kc = rem / 96, ng = rem % 96, n0 = 256 * ng + 4 * F.lane;
        const float* w = F.kin[I_ADAW] + ((size_t)l * DM + kc * 128) * 24576 + n0;
        f32x4 a0 = {0.f, 0.f, 0.f, 0.f}, a1 = {0.f, 0.f, 0.f, 0.f};
#pragma unroll 16
        for (int k = 0; k < 128; ++k) { const f32x4 wv = *(const f32x4*)(w + (size_t)k * 24576); const float s0 = ldsf[kc * 128 + k], s1 = ldsf[DM + kc * 128 + k]; a0 += wv * s0; a1 += wv * s1; }
        *(f32x4*)(MODP + ((size_t)(l * 32 + kc) * 2 + 0) * 24576 + n0) = a0;
        *(f32x4*)(MODP + ((size_t)(l * 32 + kc) * 2 + 1) * 24576 + n0) = a1;
    }
    for (int idx = F.bx * (NWAVES * 64) + F.tid; idx < NLAYER * 448 * 64; idx += F.G * NWAVES * 64) {
        const int l = idx / (448 * 64), rem = idx % (448 * 64), blk = rem >> 6, ln = rem & 63, n = ln & 15, g = ln >> 4;
        const int m = blk < 384 ? blk >> 7 : 3, nt = blk < 384 ? (blk & 127) >> 1 : blk - 384, ks = blk < 384 ? (blk & 1) : 0;
        const float* W = m == 0 ? F.kin[I_RWUP] + (size_t)l * 65536 : (m == 1 ? F.kin[I_RAUP] + (size_t)l * 65536 : (m == 2 ? F.kin[I_RGUP] + (size_t)l * 65536 : (l ? F.kin[I_VRUP] + (size_t)(l - 1) * 32768 : nullptr)));
        float f[8];
#pragma unroll
        for (int e = 0; e < 8; ++e) f[e] = W != nullptr ? W[(size_t)(32 * ks + 8 * g + e) * 1024 + 16 * nt + n] : 0.f;
        *(v4u*)(WSP(bf16, WS_WF) + ((size_t)(l * 448 + blk) * 64 + ln) * 8) = pack8(f);
    }
    __syncthreads();
    LAS float* scr = (LAS float*)(F.lds + RING_OFF + F.wave * 16384);
    constexpr int I_IN = 337 * 64, I_OUT = 128 * 64, I_13 = 688 * 64, I_2 = 128 * 172, I_L = I_IN + I_OUT + I_13 + I_2;
    for (int it = gw; it < NLAYER * I_L; it += NGW) {
        const int l = it / I_L; int r = it % I_L;
        if (r < I_IN) {
            const int kb = r / 337, cb = r % 337; const float* src = F.kin[I_WIN] + (size_t)l * DM * P_IN; int ld = P_IN, col0, row0, nc = 32;
            if (cb < 192) { col0 = 32 * cb; row0 = 32 * cb; }
            else if (cb < 288) { col0 = 6160 + 32 * (cb - 192); row0 = 6144 + 32 * (cb - 192); }
            else if (cb < 328) { col0 = 9424 + 32 * (cb - 288); row0 = 9216 + 32 * (cb - 288); }
            else if (cb == 328) { col0 = 6144; row0 = 10496; nc = 16; }
            else if (cb < 335) { col0 = 9232 + 32 * (cb - 329); row0 = 10512 + 32 * (cb - 329); }
            else if (cb == 335) { src = l ? F.kin[I_VRD] + (size_t)(l - 1) * DM * 32 : nullptr; ld = 32; col0 = 0; row0 = 10704; }
            else { src = nullptr; col0 = 0; row0 = 10736; nc = 16; }
            conv_item(src, ld, col0, nc, DM, WSP(bf16, WS_WIN + l * WIN_L), row0, kb, scr, F.lane); continue; }
        r -= I_IN;
        if (r < I_OUT) { const int kb = r / 128, cb = r % 128; conv_item(F.kin[I_WOUT] + (size_t)l * DM * DM, DM, 32 * cb, 32, DM, WSP(bf16, WS_WOUT + l * WOUT_L), 32 * cb, kb, scr, F.lane); continue; }
        r -= I_OUT;
        if (r < I_13) { const int kb = r / 688, cb = r % 688, pn = cb >> 3, wi = cb & 7;
            const float* src = (wi < 4 ? F.kin[I_W1] : F.kin[I_W3]) + (size_t)l * DM * DFF;
            conv_item(src, DFF, 128 * pn + 32 * (wi & 3), 32, DM, WSP(bf16, WS_W13 + l * W13_L), 32 * cb, kb, scr, F.lane); continue; }
        r -= I_13;
        { const int kb = r / 128, cb = r % 128; conv_item(F.kin[I_W2] + (size_t)l * DFF * DM, DM, 32 * cb, 32, DFF, WSP(bf16, WS_W2 + l * W2_L), 32 * cb, kb, scr, F.lane); }
    }
}
__device__ __forceinline__ void p0_prologue_b(Frame& F) {
    const int gt = F.bx * (NWAVES * 64) + F.tid, NT = F.G * NWAVES * 64;
    const float* MODP = WSP(float, WS_MODP); float* MOD = WSP(float, WS_MOD);
    for (int idx = gt; idx < NLAYER * 2 * 24576; idx += NT) {
        const int l = idx / 49152, rem = idx % 49152, b = rem / 24576, n = rem % 24576;
        float s = F.kin[I_ADAB][l * 24576 + n];
#pragma unroll 8
        for (int kc = 0; kc < 32; ++kc) s += MODP[((size_t)(l * 32 + kc) * 2 + b) * 24576 + n];
        MOD[idx] = s;
    }
    if (F.bx == 0) { float* TAB = WSP(float, WS_TAB);
        for (int i = F.tid; i < 24 * 128; i += NWAVES * 64) { const int hh = i >> 7, d = i & 127; TAB[i] = F.kin[I_RELB][t5_bucket(d) * 24 + hh] * LOG2E; } }
}
__device__ __forceinline__ void rms_phase(Frame& F, const float* xin, const float* sh, const float* sc) {
    const int gw = F.vcu * NWAVES + F.wave, NGW = F.G * NWAVES;
    bf16* XN = WSP(bf16, WS_XN);
    for (int m = gw; m < M; m += NGW) {
        const int b = m >> 13;
        const f32x4* xr = (const f32x4*)(xin + (size_t)m * DM) + F.lane;
        f32x4 v[16]; float ss = 0.f;
#pragma unroll
        for (int j = 0; j < 16; ++j) { v[j] = xr[64 * j]; ss += (v[j].x * v[j].x + v[j].y * v[j].y) + (v[j].z * v[j].z + v[j].w * v[j].w); }
        const float rstd = rsqrtf(wave_sum(ss) * (1.0f / DM) + 1e-6f);
        const f32x4* scp = (const f32x4*)(sc + (size_t)b * 24576) + F.lane; const f32x4* shp = (const f32x4*)(sh + (size_t)b * 24576) + F.lane;
        v2u* o8 = (v2u*)(XN + (size_t)m * DM) + F.lane;
#pragma unroll
        for (int j = 0; j < 16; ++j) { const f32x4 s4 = scp[64 * j], h4 = shp[64 * j]; const f32x4 o = v[j] * rstd * (s4 + 1.0f) + h4;
            v2u w; w.x = pk2(o.x, o.y); w.y = pk2(o.z, o.w); o8[64 * j] = w; }
    }
}
__device__ __forceinline__ void rms_phase_bf(Frame& F, const float* sh, const float* sc) {
    const int gw = F.vcu * NWAVES + F.wave, NGW = F.G * NWAVES;
    bf16* XN = WSP(bf16, WS_XN); const bf16* XR = WSP(bf16, WS_XR);
    for (int m = gw; m < M; m += NGW) {
        const int b = m >> 13;
        const v4u* xr = (const v4u*)(XR + (size_t)m * DM) + F.lane;
        v4u raw[8]; float ss = 0.f;
#pragma unroll
        for (int j = 0; j < 8; ++j) raw[j] = xr[64 * j];
#pragma unroll
        for (int j = 0; j < 8; ++j) { float f[8]; unpack8(raw[j], f);
#pragma unroll
            for (int e = 0; e < 8; ++e) ss += f[e] * f[e]; }
        const float rstd = rsqrtf(wave_sum(ss) * (1.0f / DM) + 1e-6f);
        const float* scp = sc + (size_t)b * 24576 + 8 * F.lane; const float* shp = sh + (size_t)b * 24576 + 8 * F.lane;
        v4u* o16 = (v4u*)(XN + (size_t)m * DM) + F.lane;
#pragma unroll
        for (int j = 0; j < 8; ++j) { float f[8]; unpack8(raw[j], f);
            const f32x4 s0 = *(const f32x4*)(scp + 512 * j), s1 = *(const f32x4*)(scp + 512 * j + 4), h0 = *(const f32x4*)(shp + 512 * j), h1 = *(const f32x4*)(shp + 512 * j + 4);
            float o[8];
#pragma unroll
            for (int e = 0; e < 4; ++e) { o[e] = f[e] * rstd * (s0[e] + 1.0f) + h0[e]; o[4 + e] = f[4 + e] * rstd * (s1[e] + 1.0f) + h1[e]; }
            o16[64 * j] = pack8(o); }
    }
}
__device__ __forceinline__ void prep_norm(Frame& F, int l) {
    const int gw = F.vcu * NWAVES + F.wave, NGW = F.G * NWAVES, lane = F.lane, sub = lane >> 3, ch = lane & 7;
    float gqa[8], gka[8], gqd[8], gkd[8];
#pragma unroll
    for (int e = 0; e < 8; ++e) { gqa[e] = F.kin[I_DQN][l * 64 + ch * 8 + e] * QSCALE; gka[e] = F.kin[I_DKN][l * 64 + ch * 8 + e];
                                  gqd[e] = F.kin[I_SQN][l * 64 + ch * 8 + e] * QSCALE; gkd[e] = F.kin[I_SKN][l * 64 + ch * 8 + e]; }
    const bf16* COLS = WSP(bf16, WS_COLS); bf16* QKA = WSP(bf16, WS_QKA); bf16* QKD = WSP(bf16, WS_QKD);
    for (int m = gw; m < M; m += NGW) {
        const bf16* src = COLS + (size_t)m * NMAIN;
#pragma unroll
        for (int i = 0; i < 4; ++i) { const int vec = i * 8 + sub, col = vec * 64 + ch * 8;
            float f[8]; unpack8(*(const v4u*)(src + CA_Q + col), f); float ss = 0.f;
#pragma unroll
            for (int e = 0; e < 8; ++e) ss += f[e] * f[e];
            ss = sum8(ss);
            const float rstd = rsqrtf(ss * (1.0f / 64.0f) + 1e-6f);
#pragma unroll
            for (int e = 0; e < 8; ++e) f[e] = f[e] * rstd * (i < 2 ? gqa[e] : gka[e]);
            *(v4u*)(QKA + (size_t)m * 2048 + col) = pack8(f); }
#pragma unroll
        for (int i = 0; i < 3; ++i) { const int vec = i * 8 + sub, col = vec * 64 + ch * 8;
            if (vec < 18) { float f[8]; unpack8(*(const v4u*)(src + CD_Q + col), f); float ss = 0.f;
#pragma unroll
                for (int e = 0; e < 8; ++e) ss += f[e] * f[e];
                ss = sum8(ss);
                const float rstd = rsqrtf(ss * (1.0f / 64.0f) + 1e-6f);
#pragma unroll
                for (int e = 0; e < 8; ++e) f[e] = f[e] * rstd * (vec < 16 ? gqd[e] : gkd[e]);
                *(v4u*)(QKD + (size_t)m * 1152 + col) = pack8(f); } }
    }
}
__device__ __forceinline__ void prep_loga(Frame& F, int l) {
    LAS float* gdl = (LAS float*)(F.lds + RING_OFF);
    float gu[16];
#pragma unroll
    for (int j = 0; j < 16; ++j) gu[j] = F.kin[I_GGU][((size_t)l * 16 + j) * 512 + F.tid];
    const float bias = F.kin[I_GGB][l * 512 + F.tid];
    const float* LOWR = WSP(float, WS_LOWR); float* LOGA = WSP(float, WS_LOGA);
    for (int tile = F.bx; tile < M / 64; tile += F.G) {
        const size_t row0 = (size_t)tile * 64;
        __syncthreads();
#pragma unroll
        for (int i = 0; i < 2; ++i) { const int idx = F.tid + 512 * i; gdl[idx] = LOWR[(row0 + (idx >> 4)) * 256 + (idx & 15)]; }
        __syncthreads();
#pragma unroll 4
        for (int t = 0; t < 64; ++t) { const LAS f32x4* gp = (const LAS f32x4*)(gdl + t * 16); const f32x4 g0 = gp[0], g1 = gp[1], g2 = gp[2], g3 = gp[3];
            float z = bias + g0.x * gu[0] + g0.y * gu[1] + g0.z * gu[2] + g0.w * gu[3] + g1.x * gu[4] + g1.y * gu[5] + g1.z * gu[6] + g1.w * gu[7]
                    + g2.x * gu[8] + g2.y * gu[9] + g2.z * gu[10] + g2.w * gu[11] + g3.x * gu[12] + g3.y * gu[13] + g3.z * gu[14] + g3.w * gu[15];
            LOGA[(row0 + t) * 512 + F.tid] = (fminf(z, 0.f) - __logf(1.0f + __expf(-fabsf(z)))) * (1.0f / 16.0f); }
    }
}
__device__ __forceinline__ int next_item(Frame& F, gu32* ctr) {
    volatile LAS int* slot = (volatile LAS int*)(F.lds + LDSCTL_OFF + 64);
    __syncthreads();
    if (F.tid == 0) *slot = (int)__hip_atomic_fetch_add(ctr, 1u, RLX_AGENT);
    __syncthreads();
    return *slot;
}
typedef float f32x16 __attribute__((ext_vector_type(16)));
__device__ __forceinline__ float xother32(float v) { unsigned a = __builtin_bit_cast(unsigned, v), b = a; asm volatile("" : "+v"(b)); auto rr = __builtin_amdgcn_permlane32_swap(a, b, false, false);
    const unsigned lo = rr[0], hi = rr[1]; return __builtin_bit_cast(float, (unsigned)((__builtin_amdgcn_mbcnt_hi(~0u, __builtin_amdgcn_mbcnt_lo(~0u, 0u)) & 32u) ? lo : hi)); }
__device__ __forceinline__ float xsum32(float v) { return v + xother32(v); }
__device__ __forceinline__ float xmax32(float v) { return fmaxf(v, xother32(v)); }
__device__ __forceinline__ int crow16(int r, int hi) { return (r & 3) + 8 * (r >> 2) + 4 * hi; }
template <bool ISA>
__device__ __forceinline__ void attn_unit(Frame& F, int l, int b, int hx, int qb) {
    constexpr int DV = ISA ? 128 : 64, NDV = DV / 32, KSTR = ISA ? 272 : 144, VSTR = 144, KBYTES = 64 * KSTR, VBYTES = DV * VSTR, BUFB = KBYTES + VBYTES, NCH = ISA ? 2 : 1;
    constexpr float NEG = -1e30f;
    LAS unsigned char* L = F.lds + RING_OFF;
    const int tid = F.tid, lane = F.lane, r32 = lane & 31, hi = lane >> 5, qs = F.wave & 3, grp = F.wave >> 2, q0 = qb * 128;
    const int kvh = hx >> 2, hd = kvh * 8 + (hx & 3) * 2 + grp;
    const bf16* Qp; const bf16* Kp; const bf16* VT; int ldq;
    if (ISA) { const bf16* QKA = WSP(bf16, WS_QKA); Qp = QKA + (size_t)b * SEQ * 2048 + hx * 128 + grp * 64; Kp = QKA + (size_t)b * SEQ * 2048 + 1024 + hx * 128; ldq = 2048; VT = WSP(bf16, WS_VTA) + (size_t)(b * 8 + hx) * 128 * VROW; }
    else { const bf16* QKD = WSP(bf16, WS_QKD); Qp = QKD + (size_t)b * SEQ * 1152 + hd * 64; Kp = QKD + (size_t)b * SEQ * 1152 + 1024 + kvh * 64; ldq = 1152; VT = WSP(bf16, WS_VTD) + (size_t)(b * 2 + kvh) * 64 * VROW; }
    const int qpos = q0 + 32 * qs + r32;
    bf16x8 qr[4];
#pragma unroll
    for (int d0 = 0; d0 < 4; ++d0) qr[d0] = *(const bf16x8*)(Qp + (size_t)qpos * ldq + d0 * 16 + hi * 8);
    LAS float* Bt = (LAS float*)(L + 2 * BUFB);
    { const float* TAB = WSP(float, WS_TAB);
      if (ISA) { if (tid < 130) Bt[tid] = tid == 0 ? NEG : (tid == 129 ? 0.f : TAB[hx * 128 + tid - 1] - TAB[hx * 128 + 127]); }
      else { if (tid < 260) { const int gi = tid >= 130, t = tid - 130 * gi; Bt[tid] = (t == 0 || t == 129) ? NEG : TAB[(8 + kvh * 8 + (hx & 3) * 2 + gi) * 128 + t - 1]; } } }
    const int TQ = q0 >> 6, T0 = ISA ? 0 : (TQ >= 2 ? TQ - 2 : 0), T1 = TQ + 1;
    v4u kreg[NCH], vreg[NCH];
#define AT_GLOAD(T) do { _Pragma("unroll") for (int i_ = 0; i_ < NCH; ++i_) { const int c_ = tid + 512 * i_; \
        const int kr_ = ISA ? (c_ >> 4) : (c_ >> 3), kc_ = ISA ? (c_ & 15) : (c_ & 7); kreg[i_] = *(const v4u*)(Kp + (size_t)((T) * 64 + kr_) * ldq + kc_ * 8); \
        const int vr_ = c_ >> 3, vc_ = c_ & 7; vreg[i_] = *(const v4u*)(VT + (size_t)vr_ * VROW + (T) * 64 + vc_ * 8); } } while (0)
#define AT_LWRITE(buf) do { _Pragma("unroll") for (int i_ = 0; i_ < NCH; ++i_) { const int c_ = tid + 512 * i_; \
        const int kr_ = ISA ? (c_ >> 4) : (c_ >> 3), kc_ = ISA ? (c_ & 15) : (c_ & 7); *(LAS v4u*)(L + (buf) * BUFB + kr_ * KSTR + kc_ * 16) = kreg[i_]; \
        const int vr_ = c_ >> 3, vc_ = c_ & 7; *(LAS v4u*)(L + (buf) * BUFB + KBYTES + vr_ * VSTR + vc_ * 16) = vreg[i_]; } } while (0)
    f32x16 o[NDV];
#pragma unroll
    for (int i = 0; i < NDV; ++i) o[i] = (f32x16){0.f, 0.f, 0.f, 0.f, 0.f, 0.f, 0.f, 0.f, 0.f, 0.f, 0.f, 0.f, 0.f, 0.f, 0.f, 0.f};
    float m_run = ISA ? NEG : F.kin[I_SSINK][l * 16 + hd] * LOG2E, l_run = ISA ? 0.f : (hi == 0 ? 1.f : 0.f);
    const int krow = (r32 & 16) | (r32 & 3) | ((r32 & 4) << 1) | ((r32 & 8) >> 1);
    const int koff = krow * KSTR + (ISA ? grp * 128 : 0) + hi * 16, voff = KBYTES + r32 * VSTR + hi * 16;
    AT_GLOAD(T0); AT_LWRITE(0); __syncthreads();
#pragma unroll 1
    for (int T = T0; T <= T1; ++T) {
        const int cur = (T - T0) & 1;
        AT_GLOAD(T < T1 ? T + 1 : T1);
        LAS const unsigned char* Kb = L + cur * BUFB;
        f32x16 s[2];
#pragma unroll
        for (int blk = 0; blk < 2; ++blk) { s[blk] = (f32x16){0.f, 0.f, 0.f, 0.f, 0.f, 0.f, 0.f, 0.f, 0.f, 0.f, 0.f, 0.f, 0.f, 0.f, 0.f, 0.f};
#pragma unroll
            for (int d0 = 0; d0 < 4; ++d0) { const bf16x8 kf = *(const LAS bf16x8*)(Kb + koff + blk * 32 * KSTR + d0 * 32); s[blk] = __builtin_amdgcn_mfma_f32_32x32x16_bf16(kf, qr[d0], s[blk], 0, 0, 0); } }
        bf16x8 vfc[NDV], vfn[NDV];
#pragma unroll
        for (int i = 0; i < NDV; ++i) vfc[i] = *(const LAS bf16x8*)(Kb + voff + i * 32 * VSTR);
        if (!ISA || T >= TQ - 2) {
            const LAS float* bt = Bt + (ISA ? 0 : grp * 130) + 1; const int d0 = qpos - T * 64 - 8 * hi;
#pragma unroll
            for (int blk = 0; blk < 2; ++blk)
#pragma unroll
                for (int r = 0; r < 16; ++r) { const int dist = d0 - (32 * blk + 16 * (r >> 3) + (r & 7)); const int di = dist < -1 ? -1 : (dist > 128 ? 128 : dist); s[blk][r] += bt[di]; } }
        float mt = s[0][0];
#pragma unroll
        for (int r = 1; r < 16; ++r) mt = fmaxf(mt, s[0][r]);
#pragma unroll
        for (int r = 0; r < 16; ++r) mt = fmaxf(mt, s[1][r]);
        mt = xmax32(mt);
        const float m_new = fmaxf(m_run, mt);
        if (__any(m_new > m_run)) { const float alpha = __builtin_amdgcn_exp2f(m_run - m_new); l_run *= alpha;
#pragma unroll
            for (int i = 0; i < NDV; ++i)
#pragma unroll
                for (int r = 0; r < 16; ++r) o[i][r] *= alpha;
            m_run = m_new; }
        float ls = 0.f;
#pragma unroll
        for (int blk = 0; blk < 2; ++blk)
#pragma unroll
            for (int r = 0; r < 16; ++r) { const float pv_ = __builtin_amdgcn_exp2f(s[blk][r] - m_run); s[blk][r] = pv_; ls += pv_; }
        l_run += ls;
#pragma unroll
        for (int sl = 0; sl < 4; ++sl) { const int blk = sl >> 1, r0 = 8 * (sl & 1);
            v4u pw; pw.x = pg8::cvt_pk_bf16(s[blk][r0], s[blk][r0 + 1]); pw.y = pg8::cvt_pk_bf16(s[blk][r0 + 2], s[blk][r0 + 3]); pw.z = pg8::cvt_pk_bf16(s[blk][r0 + 4], s[blk][r0 + 5]); pw.w = pg8::cvt_pk_bf16(s[blk][r0 + 6], s[blk][r0 + 7]);
            const bf16x8 pf = __builtin_bit_cast(bf16x8, pw);
#pragma unroll
            for (int i = 0; i < NDV; ++i) { if (sl < 3) vfn[i] = *(const LAS bf16x8*)(Kb + voff + i * 32 * VSTR + (sl + 1) * 32); o[i] = __builtin_amdgcn_mfma_f32_32x32x16_bf16(vfc[i], pf, o[i], 0, 0, 0); }
#pragma unroll
            for (int i = 0; i < NDV; ++i) vfc[i] = vfn[i]; }
        AT_LWRITE(cur ^ 1);
        __syncthreads();
    }
#undef AT_GLOAD
#undef AT_LWRITE
    const float inv = 1.0f / xsum32(l_run);
    bf16* MIX = WSP(bf16, WS_MIXED);
    if (ISA) {
        int ll_ = l; asm volatile("" : "+s"(ll_)); const float lam_init = ll_ == 0 ? 0.2f : 0.35550906759f;     float lam_full;
        { const float* lm = F.kin[I_DLAM] + (size_t)l * 256; const float s1 = wave_sum(lm[lane] * lm[64 + lane]), s2 = wave_sum(lm[128 + lane] * lm[192 + lane]); lam_full = __expf(s1) - __expf(s2) + lam_init; }
        LAS float* R1 = (LAS float*)L;
        LAS bf16* R2 = (LAS bf16*)(L + 66048);
        const int ql = 32 * qs + r32;
        if (grp == 1) {
#pragma unroll
            for (int i = 0; i < NDV; ++i)
#pragma unroll
                for (int r = 0; r < 16; ++r) R1[ql * 129 + 32 * i + crow16(r, hi)] = lam_full * inv * o[i][r]; }
        __syncthreads();
        if (grp == 0) { float ss = 0.f;
#pragma unroll
            for (int i = 0; i < NDV; ++i)
#pragma unroll
                for (int r = 0; r < 16; ++r) { const float d = o[i][r] * inv - R1[ql * 129 + 32 * i + crow16(r, hi)]; o[i][r] = d; ss += d * d; }
            const float rstd = rsqrtf(xsum32(ss) * (1.0f / 128.0f) + 1e-6f) * (1.0f - lam_init);
            const float* sl = F.kin[I_DSUB] + l * 128;
#pragma unroll
            for (int i = 0; i < NDV; ++i)
#pragma unroll
                for (int r = 0; r < 16; ++r) { const int dv = 32 * i + crow16(r, hi); R2[ql * 132 + dv] = (bf16)f2bf(o[i][r] * rstd * sl[dv]); } }
        __syncthreads();
#pragma unroll
        for (int i = 0; i < 4; ++i) { const int c = tid + 512 * i, row = c >> 4, ch = c & 15; const LAS v2u* sp = (const LAS v2u*)(R2 + row * 132 + ch * 8); const v2u a = sp[0], bb = sp[1];
            *(v4u*)(MIX + (size_t)(b * SEQ + q0 + row) * DM + hx * 128 + ch * 8) = (v4u){a.x, a.y, bb.x, bb.y}; }
    } else {
        LAS bf16* R = (LAS bf16*)L + F.wave * 2176;
#pragma unroll
        for (int i = 0; i < NDV; ++i)
#pragma unroll
            for (int r = 0; r < 16; ++r) R[r32 * 68 + 32 * i + crow16(r, hi)] = (bf16)f2bf(o[i][r] * inv);
#pragma unroll
        for (int i = 0; i < 4; ++i) { const int c = lane + 64 * i, row = c >> 3, ch = c & 7; const LAS v2u* sp = (const LAS v2u*)(R + row * 68 + ch * 8); const v2u a = sp[0], bb = sp[1];
            *(v4u*)(MIX + (size_t)(b * SEQ + q0 + 32 * qs + row) * DM + 3072 + hd * 64 + ch * 8) = (v4u){a.x, a.y, bb.x, bb.y}; }
    }
}
__device__ __forceinline__ void prep_gla(Frame& F) {
    LAS float* Lb = (LAS float*)(F.lds + RING_OFF); LAS float* Qd = Lb + 64 * 129; LAS float* Ki = Qd + 64 * 129; LAS bf16* Kt = (LAS bf16*)(Ki + 64 * 129);
    const bf16* COLS = WSP(bf16, WS_COLS); const float* LOGA = WSP(float, WS_LOGA);
    bf16* QDEC = WSP(bf16, WS_QDEC); bf16* KDT = WSP(bf16, WS_KDT); bf16* AMg = WSP(bf16, WS_AM); float* EBL = WSP(float, WS_EBL);
    for (int u = F.bx; u < 1024; u += F.G) {
        const int b = u >> 9, h = (u >> 7) & 3, ck = u & 127; const size_t row0 = (size_t)b * SEQ + ck * 64;
        __syncthreads();
        for (int idx = F.tid; idx < 8192; idx += NWAVES * 64) { const int t = idx >> 7, d = idx & 127; Lb[t * 129 + d] = LOGA[(row0 + t) * 512 + h * 128 + d]; }
        __syncthreads();
        if (F.tid < 128) { float acc = 0.f;
#pragma unroll 8
            for (int t = 0; t < 64; ++t) { acc += Lb[t * 129 + F.tid]; Lb[t * 129 + F.tid] = acc; }
            EBL[(size_t)u * 128 + F.tid] = __expf(acc); }
        __syncthreads();
        for (int idx = F.tid; idx < 8192; idx += NWAVES * 64) { const int t = idx >> 7, d = idx & 127; const float bt = Lb[t * 129 + d], bl = Lb[63 * 129 + d];
            const float q = bf2f(COLS[(row0 + t) * NMAIN + CB_Q + h * 128 + d]) * 0.08838834764831845f, k = bf2f(COLS[(row0 + t) * NMAIN + CB_K + h * 128 + d]);
            const float qd = q * __expf(bt); Qd[t * 129 + d] = qd; Ki[t * 129 + d] = k * __expf(-bt); Kt[d * 72 + t] = (bf16)f2bf(k * __expf(bl - bt));
            QDEC[((size_t)u * 64 + t) * 128 + d] = (bf16)f2bf(qd); }
        __syncthreads();
#pragma unroll
        for (int i = 0; i < 2; ++i) { const int c_ = F.tid + 512 * i, row = c_ >> 3, ch = c_ & 7; const LAS v2u* sp = (const LAS v2u*)(Kt + row * 72 + ch * 8); const v2u a = sp[0], bb = sp[1];
            *(v4u*)(KDT + ((size_t)u * 128 + row) * 64 + ch * 8) = (v4u){a.x, a.y, bb.x, bb.y}; }
        { const int c = F.tid >> 3, sg = F.tid & 7; float acc[8];
#pragma unroll
          for (int e = 0; e < 8; ++e) acc[e] = 0.f;
#pragma unroll 4
          for (int d = 0; d < 128; ++d) { const float q = Qd[c * 129 + d];
#pragma unroll
              for (int e = 0; e < 8; ++e) acc[e] += q * Ki[(sg * 8 + e) * 129 + d]; }
#pragma unroll
          for (int e = 0; e < 8; ++e) if (sg * 8 + e > c) acc[e] = 0.f;
          *(v4u*)(AMg + ((size_t)u * 64 + c) * 64 + sg * 8) = pack8(acc); }
    }
}
__device__ __forceinline__ void prep_vt(Frame& F, int pass) {
    LAS bf16* T = (LAS bf16*)(F.lds + RING_OFF);
    const bf16* COLS = WSP(bf16, WS_COLS);
    const int ncol = pass == 4 ? 128 : 512, nch = ncol >> 3;
    const int col0 = pass < 2 ? CA_V + 512 * pass : (pass < 4 ? CB_V + 512 * (pass - 2) : CD_V);
    bf16* dst0 = pass < 2 ? WSP(bf16, WS_VTA) + (size_t)(512 * pass) * VROW : (pass < 4 ? WSP(bf16, WS_VTB) + (size_t)(512 * (pass - 2)) * VROW : WSP(bf16, WS_VTD));
    const int rows_b = pass == 4 ? 128 : 1024;
    for (int tile = F.bx; tile < M / 64; tile += F.G) {
        const int b = tile >> 7, t0 = (tile & 127) * 64;
        __syncthreads();
        for (int idx = F.tid; idx < 64 * nch; idx += NWAVES * 64) { const int tok = idx / nch, ch = idx % nch;
            const v4u v = *(const v4u*)(COLS + (size_t)(b * SEQ + t0 + tok) * NMAIN + col0 + ch * 8); LAS unsigned* d = (LAS unsigned*)(T + tok * 522 + ch * 8); d[0] = v.x; d[1] = v.y; d[2] = v.z; d[3] = v.w; }
        __syncthreads();
        for (int idx = F.tid; idx < ncol * 8; idx += NWAVES * 64) { const int vrow = idx >> 3, ch = idx & 7;
            unsigned e[8];
#pragma unroll
            for (int k = 0; k < 8; ++k) e[k] = T[(ch * 8 + k) * 522 + vrow];
            v4u o; o.x = e[0] | (e[1] << 16); o.y = e[2] | (e[3] << 16); o.z = e[4] | (e[5] << 16); o.w = e[6] | (e[7] << 16);
            *(v4u*)(dst0 + ((size_t)b * rows_b + vrow) * VROW + t0 + ch * 8) = o; }
    }
}
typedef float f32x4v __attribute__((ext_vector_type(4)));
__device__ __forceinline__ float sum16(float v) { v = sum8(v); v += dpp_f<0x140>(v); return v; }
#define LDS_BARRIER() asm volatile("s_waitcnt lgkmcnt(0)\n\ts_barrier" ::: "memory")
template <int HACK = 0> __device__ __forceinline__ void gla_scan_unit(Frame& F, int l, int b, int h, int vh) {
    LAS unsigned char* L = F.lds + RING_OFF;
    constexpr int OQD = 0, OKT = 17408, OAM = 35840, OVT = 45056, OOT = 63488, OEB = 80896, OPS = 81408;
    const int tid = F.tid, lane = F.lane, n = lane & 15, g = lane >> 4, w = F.wave;
    const bf16* QDEC = WSP(bf16, WS_QDEC); const bf16* KDT = WSP(bf16, WS_KDT); const bf16* AMg = WSP(bf16, WS_AM); const float* EBL = WSP(float, WS_EBL);
    const bf16* VTB = WSP(bf16, WS_VTB) + (size_t)((b * 4 + h) * 256 + 128 * vh) * VROW; bf16* OB = WSP(bf16, WS_OB); float* PSG = WSP(float, WS_PSG);
    f32x4v S[8];
#pragma unroll
    for (int dt = 0; dt < 8; ++dt) S[dt] = (f32x4v){0.f, 0.f, 0.f, 0.f};
    v4u pq[2], pk[2], pa, pv[2]; float pe = 0.f;
#define GL_ISSUE(CK) do { const size_t u_ = (size_t)(b * 4 + h) * 128 + (CK); \
        _Pragma("unroll") for (int i = 0; i < 2; ++i) { const int c_ = tid + 512 * i; pq[i] = *(const v4u*)(QDEC + (u_ * 64 + (c_ >> 4)) * 128 + (c_ & 15) * 8); pk[i] = *(const v4u*)(KDT + (u_ * 128 + (c_ >> 3)) * 64 + (c_ & 7) * 8); \
            pv[i] = *(const v4u*)(VTB + (size_t)(c_ >> 3) * VROW + (CK) * 64 + (c_ & 7) * 8); } \
        pa = *(const v4u*)(AMg + (u_ * 64 + (tid >> 3)) * 64 + (tid & 7) * 8); \
        pe = EBL[u_ * 128 + (tid & 127)]; } while (0)
#define GL_WRITE() do { _Pragma("unroll") for (int i = 0; i < 2; ++i) { const int c_ = tid + 512 * i; *(LAS v4u*)(L + OQD + (c_ >> 4) * 272 + (c_ & 15) * 16) = pq[i]; *(LAS v4u*)(L + OKT + (c_ >> 3) * 144 + (c_ & 7) * 16) = pk[i]; \
            *(LAS v4u*)(L + OVT + (c_ >> 3) * 144 + (c_ & 7) * 16) = pv[i]; } \
        *(LAS v4u*)(L + OAM + (tid >> 3) * 144 + (tid & 7) * 16) = pa; \
        ((LAS float*)(L + OEB))[tid & 127] = pe; } while (0)
    GL_ISSUE(0); GL_WRITE();
    LDS_BARRIER();
#pragma unroll 1
    for (int ck = 0; ck < 128; ++ck) {
        const size_t row0 = (size_t)b * SEQ + ck * 64;
        GL_ISSUE((HACK & 1) && ck >= 2 ? 2 : (ck + 1 < 128 ? ck + 1 : 127));
        bf16x8 vf[2];
#pragma unroll
        for (int ks = 0; ks < 2; ++ks) vf[ks] = *(const LAS bf16x8*)(L + OVT + (16 * w + n) * 144 + (32 * ks + 8 * g) * 2);
        f32x4v o[4];
#pragma unroll
        for (int ct = 0; ct < 4; ++ct) o[ct] = (f32x4v){0.f, 0.f, 0.f, 0.f};
#pragma unroll
        for (int ct = 0; ct < 4; ++ct)
#pragma unroll
            for (int ks = 0; ks < 2; ++ks) { const bf16x8 af = *(const LAS bf16x8*)(L + OAM + (16 * ct + n) * 144 + (32 * ks + 8 * g) * 2); o[ct] = __builtin_amdgcn_mfma_f32_16x16x32_bf16(af, vf[ks], o[ct], 0, 0, 0); }
#pragma unroll
        for (int kk = 0; kk < 4; ++kk) { v4u pw; pw.x = pg8::cvt_pk_bf16(S[2 * kk][0], S[2 * kk][1]); pw.y = pg8::cvt_pk_bf16(S[2 * kk][2], S[2 * kk][3]);
            pw.z = pg8::cvt_pk_bf16(S[2 * kk + 1][0], S[2 * kk + 1][1]); pw.w = pg8::cvt_pk_bf16(S[2 * kk + 1][2], S[2 * kk + 1][3]); const bf16x8 sf = __builtin_bit_cast(bf16x8, pw);
#pragma unroll
            for (int ct = 0; ct < 4; ++ct) { const LAS unsigned char* qp = L + OQD + (16 * ct + n) * 272 + (32 * kk + 4 * g) * 2; const v2u qa = *(const LAS v2u*)qp, qb = *(const LAS v2u*)(qp + 32);
                o[ct] = __builtin_amdgcn_mfma_f32_16x16x32_bf16(__builtin_bit_cast(bf16x8, (v4u){qa.x, qa.y, qb.x, qb.y}), sf, o[ct], 0, 0, 0); } }
#pragma unroll
        for (int dt = 0; dt < 8; ++dt) { const f32x4v eb = *(const LAS f32x4v*)(L + OEB + (16 * dt + 4 * g) * 4); S[dt] = S[dt] * eb;
#pragma unroll
            for (int ks = 0; ks < 2; ++ks) { const bf16x8 kf = *(const LAS bf16x8*)(L + OKT + (16 * dt + n) * 144 + (32 * ks + 8 * g) * 2); S[dt] = __builtin_amdgcn_mfma_f32_16x16x32_bf16(kf, vf[ks], S[dt], 0, 0, 0); } }
        LAS float* PS = (LAS float*)(L + OPS) + (ck & 1) * 512;
#pragma unroll
        for (int ct = 0; ct < 4; ++ct)
#pragma unroll
            for (int r = 0; r < 4; ++r) { const float ss = sum16(o[ct][r] * o[ct][r]); if (n == 0) PS[(16 * ct + 4 * g + r) * 8 + w] = ss;
                *(LAS bf16*)(L + OOT + (16 * ct + 4 * g + r) * 272 + (16 * w + n) * 2) = (bf16)f2bf(o[ct][r]); }
        LDS_BARRIER();
        GL_WRITE();
        if (!(HACK & 2)) {
#pragma unroll
        for (int i = 0; i < 2; ++i) { const int c_ = tid + 512 * i, tok = c_ >> 4, ch = c_ & 15; *(v4u*)(OB + (row0 + tok) * 1024 + h * 256 + 128 * vh + ch * 8) = *(const LAS v4u*)(L + OOT + tok * 272 + ch * 16); }
        if (tid < 64) { const LAS f32x4v* pp = (const LAS f32x4v*)(PS + tid * 8); const f32x4v p0 = pp[0], p1 = pp[1]; PSG[(row0 + tid) * 8 + h * 2 + vh] = ((p0.x + p0.y) + (p0.z + p0.w)) + ((p1.x + p1.y) + (p1.z + p1.w)); } }
        LDS_BARRIER();
    }
#undef GL_ISSUE
#undef GL_WRITE
}
__device__ __forceinline__ void gla_post(Frame& F, int l) {
    const bf16* OB = WSP(bf16, WS_OB); const float* PSG = WSP(float, WS_PSG); const bf16* COLS = WSP(bf16, WS_COLS); bf16* MIX = WSP(bf16, WS_MIXED);
    const int ch = F.tid & 127, h = ch >> 5; float gain8[8];
#pragma unroll
    for (int e = 0; e < 8; ++e) gain8[e] = F.kin[I_GON][l * 256 + (ch & 31) * 8 + e];
    for (int row = F.bx * 4 + (F.tid >> 7); row < M; row += F.G * 4) {
        float ov[8], gv[8]; unpack8(*(const v4u*)(OB + (size_t)row * 1024 + ch * 8), ov); unpack8(*(const v4u*)(COLS + (size_t)row * NMAIN + CB_G + ch * 8), gv);
        const f32x2_t ps = *(const f32x2_t*)(PSG + (size_t)row * 8 + h * 2); const float rstd = rsqrtf((ps.x + ps.y) * (1.0f / 256.0f) + 1e-6f);
#pragma unroll
        for (int e = 0; e < 8; ++e) ov[e] = ov[e] * (rstd * gain8[e]) * silu_g(gv[e]);
        *(v4u*)(MIX + (size_t)row * DM + 1024 + ch * 8) = pack8(ov);
    }
}
constexpr int RC_AT = 0, RC_RT = 2048, RC_BK = 4096, RC_VF = 8192, RC_GF = 10240, RC_U0 = 12288, RC_Y0 = 16384, RC_P15 = 20480, RC_BN = 20736, RC_BYTES = 20800;
__device__ __forceinline__ void rwkv_chunks_of_tile(Frame& F, int l, int tile) {
    const int team = F.tid >> 8, tt = F.tid & 255;
    LAS float* Lt = (LAS float*)(F.lds + RING_OFF) + team * 12288;
    LAS float* XA = Lt; LAS float* XR = Lt + 1040; LAS float* ZB = Lt + 2080; LAS float* ZK = Lt + 3120; LAS float* TB = Lt + 4160; LAS float* TK = Lt + 5200; LAS float* VV = Lt + 6240;
    LAS float* ATl = Lt + 7280; LAS float* U0l = Lt + 8320; LAS float* W1 = Lt + 9360;
    LAS float* Aab = Lt + 10400; LAS float* Aak = Lt + 10672; LAS float* Arb = Lt + 10944; LAS float* Ark = Lt + 11216; LAS float* TT = Lt + 11488;
    const float* RW = WSP(float, WS_RW); const unsigned* RWU = WSP(unsigned, WS_RW); constexpr size_t RS = RW_ONE / 4; unsigned char* RWC = F.ws + WS_RWC;
    float pw_[6], pr_[4], pk_[4], pv_[4], pa_[4], pb_[4], pg_[4];
#define RC_FETCH(P) do { const int h_ = 2 * (P) + team; const size_t cb_ = (size_t)tile * 16 * 1024 + h_ * 64 + (tt & 63); const int q_ = tt >> 6; \
        pw_[4] = RW[RS + cb_ + (size_t)(q_ ? 4 * q_ - 1 : 0) * 1024]; pw_[5] = RW[RS + cb_ + (size_t)15 * 1024];            \
        _Pragma("unroll") for (int e = 0; e < 4; ++e) { const size_t o_ = cb_ + (size_t)(4 * q_ + e) * 1024; pw_[e] = RW[RS + o_]; const unsigned u0 = RWU[o_], u2 = RWU[2 * RS + o_], u3 = RWU[3 * RS + o_]; \
            pr_[e] = bflo(u0); pk_[e] = bfhi(u0); pv_[e] = bflo(u2); pg_[e] = bfhi(u2); pa_[e] = bflo(u3); pb_[e] = bfhi(u3); } } while (0)
    RC_FETCH(0);
#pragma unroll 1
    for (int pair = 0; pair < 8; ++pair) {
        const int uc = ((tile >> 9) * 16 + 2 * pair + team) * 512 + (tile & 511), b = uc >> 13, h = (uc >> 9) & 15, ck = uc & 511; unsigned char* rec = RWC + ((size_t)ck * 32 + (uc >> 9)) * RC_BYTES;     (void)b;
        __syncthreads();
        {
          const int j = tt & 63, q = tt >> 6;
          const float cl = pw_[5], clm = q ? pw_[4] : 0.f; const float clq[4] = {pw_[0], pw_[1], pw_[2], pw_[3]};
#pragma unroll
          for (int e = 0; e < 4; ++e) { const int t = 4 * q + e; const float cprev = e == 0 ? clm : clq[e - 1], cc = clq[e];
              const float rr = pr_[e], kk = pk_[e], vv = pv_[e], aa = pa_[e], bb = pb_[e];
              XA[t * 65 + j] = aa * __expf(cprev); XR[t * 65 + j] = rr * __expf(cc); const float ei = __expf(-cc), ef = __expf(cl - cc);
              ZB[t * 65 + j] = bb * ei; ZK[t * 65 + j] = kk * ei; TB[t * 65 + j] = bb * ef; TK[t * 65 + j] = kk * ef; VV[t * 65 + j] = vv; }
          if (q == 0) ((float*)(rec + RC_P15))[j] = __expf(cl);
          { v2u gw; gw.x = pk2(pg_[0], pg_[1]); gw.y = pk2(pg_[2], pg_[3]); *(v2u*)(rec + RC_GF + (((j >> 4) * 64 + 16 * q + (j & 15)) * 8)) = gw; } }
        RC_FETCH(pair < 7 ? pair + 1 : 7);
        __syncthreads();
        {
          const int q = tt >> 6, n = tt & 15, g = (tt >> 4) & 3; const LAS float* X = (q & 2) ? XR : XA; const LAS float* Z = (q & 1) ? ZK : ZB; LAS float* O = q == 0 ? Aab : (q == 1 ? Aak : (q == 2 ? Arb : Ark));
          f32x4v c = (f32x4v){0.f, 0.f, 0.f, 0.f};
#pragma unroll
          for (int ks = 0; ks < 16; ++ks) c = __builtin_amdgcn_mfma_f32_16x16x4f32(X[n * 65 + 4 * ks + g], Z[n * 65 + 4 * ks + g], c, 0, 0, 0);
#pragma unroll
          for (int rr = 0; rr < 4; ++rr) { const int t = 4 * g + rr; O[t * 17 + n] = ((q & 2) ? n <= t : n < t) ? c[rr] : 0.f; }
          { const int t = tt >> 4, jq = tt & 15; const float* rkp = F.kin[I_RRK] + l * 1024 + h * 64 + 4 * jq; float bn = 0.f;
#pragma unroll
            for (int e = 0; e < 4; ++e) bn += XR[t * 65 + 4 * jq + e] * ZK[t * 65 + 4 * jq + e] * rkp[e];
            bn = sum16(bn); if (jq == 0) ((float*)(rec + RC_BN))[t] = bn; } }
        __syncthreads();
        {
          if (tt < 16) { float col[16];
#pragma unroll
              for (int t = 0; t < 16; ++t) { float acc = (t == tt) ? 1.f : 0.f;
#pragma unroll
                  for (int s = 0; s < 16; ++s) if (s < t) acc += Aab[t * 17 + s] * col[s];
                  col[t] = acc; TT[t * 17 + tt] = acc; } }
          const int q = tt >> 6, n = tt & 15, g = (tt >> 4) & 3; f32x4v c = (f32x4v){0.f, 0.f, 0.f, 0.f};
#pragma unroll
          for (int ks = 0; ks < 4; ++ks) c = __builtin_amdgcn_mfma_f32_16x16x4f32(Aak[n * 17 + 4 * ks + g], VV[(4 * ks + g) * 65 + 16 * q + n], c, 0, 0, 0);
#pragma unroll
          for (int rr = 0; rr < 4; ++rr) W1[(4 * g + rr) * 65 + 16 * q + n] = c[rr]; }
        __syncthreads();
        {
          const int q = tt >> 6, n = tt & 15, g = (tt >> 4) & 3; f32x4v ca = (f32x4v){0.f, 0.f, 0.f, 0.f}, cu = (f32x4v){0.f, 0.f, 0.f, 0.f};
#pragma unroll
          for (int ks = 0; ks < 4; ++ks) { const float tv = TT[n * 17 + 4 * ks + g]; ca = __builtin_amdgcn_mfma_f32_16x16x4f32(tv, XA[(4 * ks + g) * 65 + 16 * q + n], ca, 0, 0, 0); cu = __builtin_amdgcn_mfma_f32_16x16x4f32(tv, W1[(4 * ks + g) * 65 + 16 * q + n], cu, 0, 0, 0); }
#pragma unroll
          for (int rr = 0; rr < 4; ++rr) { ATl[(4 * g + rr) * 65 + 16 * q + n] = ca[rr]; U0l[(4 * g + rr) * 65 + 16 * q + n] = cu[rr]; }
          *(f32x4v*)(rec + RC_U0 + ((q * 64 + 16 * g + n) * 16)) = cu; }
        __syncthreads();
        {
          const int q = tt >> 6, n = tt & 15, g = (tt >> 4) & 3; f32x4v cr, cy = (f32x4v){0.f, 0.f, 0.f, 0.f};
#pragma unroll
          for (int rr = 0; rr < 4; ++rr) cr[rr] = XR[(4 * g + rr) * 65 + 16 * q + n];
#pragma unroll
          for (int ks = 0; ks < 4; ++ks) { const float arb = Arb[n * 17 + 4 * ks + g], ark = Ark[n * 17 + 4 * ks + g];
              cr = __builtin_amdgcn_mfma_f32_16x16x4f32(arb, ATl[(4 * ks + g) * 65 + 16 * q + n], cr, 0, 0, 0);
              cy = __builtin_amdgcn_mfma_f32_16x16x4f32(arb, U0l[(4 * ks + g) * 65 + 16 * q + n], cy, 0, 0, 0);
              cy = __builtin_amdgcn_mfma_f32_16x16x4f32(ark, VV[(4 * ks + g) * 65 + 16 * q + n], cy, 0, 0, 0); }
          *(f32x4v*)(rec + RC_Y0 + ((q * 64 + 16 * g + n) * 16)) = cy;
#pragma unroll
          for (int rr = 0; rr < 4; ++rr) W1[(4 * g + rr) * 65 + 16 * q + n] = cr[rr]; }
        __syncthreads();
        { const int t = tt & 15, jq = tt >> 4, kk = jq >> 3, half = (jq & 7) >> 2, g = jq & 3, j0 = 4 * jq;
          v2u wa, wr; wa.x = pk2(ATl[t * 65 + j0], ATl[t * 65 + j0 + 1]); wa.y = pk2(ATl[t * 65 + j0 + 2], ATl[t * 65 + j0 + 3]); wr.x = pk2(W1[t * 65 + j0], W1[t * 65 + j0 + 1]); wr.y = pk2(W1[t * 65 + j0 + 2], W1[t * 65 + j0 + 3]);
          *(v2u*)(rec + RC_AT + kk * 1024 + (16 * g + t) * 16 + half * 8) = wa; *(v2u*)(rec + RC_RT + kk * 1024 + (16 * g + t) * 16 + half * 8) = wr;
          const int j = tt & 63, gg = tt >> 6; v4u bk; bk.x = pk2(TB[(4 * gg) * 65 + j], TB[(4 * gg + 1) * 65 + j]); bk.y = pk2(TB[(4 * gg + 2) * 65 + j], TB[(4 * gg + 3) * 65 + j]);
          bk.z = pk2(TK[(4 * gg) * 65 + j], TK[(4 * gg + 1) * 65 + j]); bk.w = pk2(TK[(4 * gg + 2) * 65 + j], TK[(4 * gg + 3) * 65 + j]);
          *(v4u*)(rec + RC_BK + (j >> 4) * 1024 + (16 * gg + (j & 15)) * 16) = bk;
          v2u vf; vf.x = pk2(VV[(4 * gg) * 65 + j], VV[(4 * gg + 1) * 65 + j]); vf.y = pk2(VV[(4 * gg + 2) * 65 + j], VV[(4 * gg + 3) * 65 + j]);
          *(v2u*)(rec + RC_VF + ((j >> 4) * 64 + 16 * gg + (j & 15)) * 8) = vf; }
    }
}
#undef RC_FETCH
template <int HACK = 0> __device__ __forceinline__ void rwkv_scan_unit(Frame& F, int l, int b, int h) {
    LAS unsigned char* L = F.lds + RING_OFF;
    const unsigned char* recs = F.ws + WS_RWC + (size_t)(b * 16 + h) * RC_BYTES;
    const int lane = F.lane, n = lane & 15, g = lane >> 4;
    LAS float* XS = (LAS float*)(L + 2 * RC_BYTES);
    if (F.wave >= 2) {
        const int li = F.tid - 128;
        int px[4];
#pragma unroll
        for (int k = 0; k < 4; ++k) { const int x = li + 384 * k; px[k] = x < 1300 ? x : 1299; }
        v4u p0[4], p1[4], p2[4], p3[4], p4[4], p5[4], p6[4], p7[4];
#define RWL_ISSUE(P, CK) do { const int ck_ = (CK) < 512 ? ((HACK & 1) && (CK) >= 4 ? 3 : (CK)) : 511; const v4u* src_ = (const v4u*)(recs + (size_t)ck_ * 32 * RC_BYTES); \
        _Pragma("unroll") for (int k = 0; k < 4; ++k) P[k] = src_[px[k]]; } while (0)
#define RWL_WRITE(P, CK) do { LAS v4u* dst_ = (LAS v4u*)(L + ((CK) & 1) * RC_BYTES); _Pragma("unroll") for (int k = 0; k < 4; ++k) dst_[px[k]] = P[k]; } while (0)
        RWL_ISSUE(p0, 0); RWL_ISSUE(p1, 1); RWL_ISSUE(p2, 2); RWL_ISSUE(p3, 3); RWL_ISSUE(p4, 4); RWL_ISSUE(p5, 5); RWL_ISSUE(p6, 6); RWL_ISSUE(p7, 7);
        RWL_WRITE(p0, 0); RWL_ISSUE(p0, 8);
        LDS_BARRIER();
#pragma unroll 1
        for (int ck = 0; ck < 512; ck += 8) {
            RWL_WRITE(p1, ck + 1); RWL_ISSUE(p1, ck + 9); LDS_BARRIER();
            RWL_WRITE(p2, ck + 2); RWL_ISSUE(p2, ck + 10); LDS_BARRIER();
            RWL_WRITE(p3, ck + 3); RWL_ISSUE(p3, ck + 11); LDS_BARRIER();
            RWL_WRITE(p4, ck + 4); RWL_ISSUE(p4, ck + 12); LDS_BARRIER();
            RWL_WRITE(p5, ck + 5); RWL_ISSUE(p5, ck + 13); LDS_BARRIER();
            RWL_WRITE(p6, ck + 6); RWL_ISSUE(p6, ck + 14); LDS_BARRIER();
            RWL_WRITE(p7, ck + 7); RWL_ISSUE(p7, ck + 15); LDS_BARRIER();
            RWL_WRITE(p0, ck + 8); RWL_ISSUE(p0, ck + 16); LDS_BARRIER();
        }
#undef RWL_ISSUE
#undef RWL_WRITE
        return;
    }
    const int cw = F.wave;
    f32x4v S[4][2];
#pragma unroll
    for (int jt = 0; jt < 4; ++jt)
#pragma unroll
        for (int it = 0; it < 2; ++it) S[jt][it] = (f32x4v){0.f, 0.f, 0.f, 0.f};
    float lnw[2], lnb[2];
#pragma unroll
    for (int it = 0; it < 2; ++it) { lnw[it] = F.kin[I_RLNW][l * 1024 + h * 64 + 16 * (2 * cw + it) + n]; lnb[it] = F.kin[I_RLNB][l * 1024 + h * 64 + 16 * (2 * cw + it) + n]; }
    bf16* MIX = WSP(bf16, WS_MIXED) + ((size_t)b * SEQ) * DM + 2048 + h * 64 + 32 * cw + n;
    f32x4v Yp[2] = {(f32x4v){0.f, 0.f, 0.f, 0.f}, (f32x4v){0.f, 0.f, 0.f, 0.f}}, bnp = (f32x4v){0.f, 0.f, 0.f, 0.f}; v2u gfp[2] = {(v2u){0u, 0u}, (v2u){0u, 0u}}, vfp[2] = {(v2u){0u, 0u}, (v2u){0u, 0u}};
    LDS_BARRIER();
#pragma unroll 1
    for (int ck = 0; ck <= 512; ++ck) {
        if (ck > 0) {
            const LAS float* xs = XS + ((ck - 1) & 1) * 64; const f32x4v a0 = *(const LAS f32x4v*)(xs + 8 * g), a1 = *(const LAS f32x4v*)(xs + 8 * g + 4), b0 = *(const LAS f32x4v*)(xs + 32 + 8 * g), b1 = *(const LAS f32x4v*)(xs + 32 + 8 * g + 4);
            const float s1[4] = {a0[0] + b0[0], a0[2] + b0[2], a1[0] + b1[0], a1[2] + b1[2]}, s2[4] = {a0[1] + b0[1], a0[3] + b0[3], a1[1] + b1[1], a1[3] + b1[3]};
#pragma unroll
            for (int it = 0; it < 2; ++it) { const float gt[4] = {bflo(gfp[it].x), bfhi(gfp[it].x), bflo(gfp[it].y), bfhi(gfp[it].y)}, vt[4] = {bflo(vfp[it].x), bfhi(vfp[it].x), bflo(vfp[it].y), bfhi(vfp[it].y)};
#pragma unroll
                for (int r = 0; r < 4; ++r) { const float mean = s1[r] * (1.0f / 64.0f), var = fmaxf(s2[r] * (1.0f / 64.0f) - mean * mean, 0.f), rstd = rsqrtf(var + 64e-5f);
                    if (!(HACK & 2)) MIX[(size_t)((ck - 1) * 16 + 4 * g + r) * DM + 16 * it] = (bf16)f2bf(((Yp[it][r] - mean) * rstd * lnw[it] + lnb[it] + bnp[r] * vt[r]) * gt[r]); } }
            if (ck == 512) break;
        }
        if (HACK & 4) { LDS_BARRIER(); continue; }
        const LAS unsigned char* R = L + (ck & 1) * RC_BYTES;
        bf16x8 at[2], rt[2];
#pragma unroll
        for (int kk = 0; kk < 2; ++kk) { at[kk] = *(const LAS bf16x8*)(R + RC_AT + kk * 1024 + lane * 16); rt[kk] = *(const LAS bf16x8*)(R + RC_RT + kk * 1024 + lane * 16); }
        f32x4v U[2], Y[2];
#pragma unroll
        for (int it = 0; it < 2; ++it) { U[it] = *(const LAS f32x4v*)(R + RC_U0 + (2 * cw + it) * 1024 + lane * 16); Y[it] = *(const LAS f32x4v*)(R + RC_Y0 + (2 * cw + it) * 1024 + lane * 16); }
#pragma unroll
        for (int kk = 0; kk < 2; ++kk)
#pragma unroll
            for (int it = 0; it < 2; ++it) { v4u pw; pw.x = pg8::cvt_pk_bf16(S[2 * kk][it][0], S[2 * kk][it][1]); pw.y = pg8::cvt_pk_bf16(S[2 * kk][it][2], S[2 * kk][it][3]);
                pw.z = pg8::cvt_pk_bf16(S[2 * kk + 1][it][0], S[2 * kk + 1][it][1]); pw.w = pg8::cvt_pk_bf16(S[2 * kk + 1][it][2], S[2 * kk + 1][it][3]); const bf16x8 sf = __builtin_bit_cast(bf16x8, pw);
                U[it] = __builtin_amdgcn_mfma_f32_16x16x32_bf16(at[kk], sf, U[it], 0, 0, 0); Y[it] = __builtin_amdgcn_mfma_f32_16x16x32_bf16(rt[kk], sf, Y[it], 0, 0, 0); }
        bf16x8 uv[2];
#pragma unroll
        for (int it = 0; it < 2; ++it) { vfp[it] = *(const LAS v2u*)(R + RC_VF + (2 * cw + it) * 512 + lane * 8); gfp[it] = *(const LAS v2u*)(R + RC_GF + (2 * cw + it) * 512 + lane * 8);
            v4u pw; pw.x = pg8::cvt_pk_bf16(U[it][0], U[it][1]); pw.y = pg8::cvt_pk_bf16(U[it][2], U[it][3]); pw.z = vfp[it].x; pw.w = vfp[it].y; uv[it] = __builtin_bit_cast(bf16x8, pw); }
#pragma unroll
        for (int jt = 0; jt < 4; ++jt) { const bf16x8 bk = *(const LAS bf16x8*)(R + RC_BK + jt * 1024 + lane * 16); const f32x4v p15 = *(const LAS f32x4v*)(R + RC_P15 + (16 * jt + 4 * g) * 4);
#pragma unroll
            for (int it = 0; it < 2; ++it) S[jt][it] = __builtin_amdgcn_mfma_f32_16x16x32_bf16(bk, uv[it], S[jt][it] * p15, 0, 0, 0); }
        bnp = *(const LAS f32x4v*)(R + RC_BN + 16 * g); Yp[0] = Y[0]; Yp[1] = Y[1];
        { LAS float* xo = XS + (ck & 1) * 64 + cw * 32; const f32x4v sm = Y[0] + Y[1], sq = Y[0] * Y[0] + Y[1] * Y[1];
#pragma unroll
          for (int r = 0; r < 4; ++r) { const float a = sum16(sm[r]), q = sum16(sq[r]); if (n == 0) { xo[(4 * g + r) * 2] = a; xo[(4 * g + r) * 2 + 1] = q; } } }
        LDS_BARRIER();
    }
}
template <int HACK = 0> __device__ __forceinline__ void mixers_v4(Frame& F, int l, int qi, int mask = 15) {
    gu32* ctr = F.ctl + CW_Q + 64 * qi;
    for (;;) {
        const int it = next_item(F, ctr); relaunder(F); relaunder_tid(F);
        if (it < 32) { if (mask & 1) rwkv_scan_unit<HACK>(F, l, it >> 4, it & 15); }
        else if (it < 48) { const int j = it - 32; if (mask & 2) gla_scan_unit<HACK>(F, l, j >> 3, (j >> 1) & 3, j & 1); }
        else if (it < 48 + 1024) { const int j = it - 48, qb = 63 - (j >> 4), bh = j & 15; if (mask & 4) attn_unit<true>(F, l, bh >> 3, bh & 7, qb); }
        else if (it < 48 + 2048) { const int j = it - 1072, qb = j & 63, bh = j >> 6; if (mask & 8) attn_unit<false>(F, l, bh >> 3, bh & 7, qb); }
        else break;
    }
}
template <int HACK = 0> __device__ __forceinline__ void prep_rwkv(Frame& F, int l) {
    LAS float* zl = (LAS float*)(F.lds + RING_OFF) + 4096;
    LAS bf16* inb = (LAS bf16*)(F.lds + RING_OFF);
    const float* mu = F.kin[I_RMU] + (size_t)l * 3264;
    const float* LOWR = WSP(float, WS_LOWR); const bf16* COLS = WSP(bf16, WS_COLS);
    float* RW = WSP(float, WS_RW); unsigned* RWU = WSP(unsigned, WS_RW); float* VF = WSP(float, WS_VFIRST);
    constexpr size_t RS = RW_ONE / 4;
    for (int tile = F.bx; tile < M / 16; tile += F.G) {
        const int row0 = tile * 16;
        relaunder(F); relaunder_tid(F);
        __syncthreads();
        for (int idx = F.tid; idx < 16 * 224; idx += NWAVES * 64) { const int tt = idx / 224, j = idx % 224, row = row0 + tt, t = row & (SEQ - 1);
            const int col = j < 192 ? 16 + j : 208 + (j - 192);
            const float cur = LOWR[(size_t)row * 256 + col], prev = t > 0 ? LOWR[(size_t)(row - 1) * 256 + col] : 0.f;
            const float muv = j < 192 ? mu[3072 + j] : (l ? F.kin[I_VRMU][(l - 1) * 32 + (j - 192)] : 0.f);
            float x = cur + (prev - cur) * muv;
            if (j < 64) x = tanhf(x); else if (j >= 128 && j < 192) x = sigmoid_f(x);
            inb[tt * 232 + j] = (bf16)f2bf(x); }
        __syncthreads();
        {
            const int c = 2 * F.tid;
            float accw[2][16], acca[2][16], accg[2][16], accv[2][16];
#pragma unroll
            for (int e = 0; e < 2; ++e) { const float bw = F.kin[I_RW0][l * 1024 + c + e], ba = F.kin[I_RA0][l * 1024 + c + e], bv = l ? F.kin[I_VR0][(l - 1) * 1024 + c + e] : 0.f;
#pragma unroll
              for (int tt = 0; tt < 16; ++tt) { accw[e][tt] = bw; acca[e][tt] = ba; accg[e][tt] = 0.f; accv[e][tt] = bv; } }
#define LOWRANK_MFMA(ACC, MI, JOFF, NKS) do { const bf16* wf_ = WSP(bf16, WS_WF) + ((size_t)(l * 448 + ((MI) < 3 ? (MI) * 128 + 16 * (NKS) / 2 * F.wave : 384 + 8 * F.wave)) * 64 + F.lane) * 8; \
            bf16x8 af_[NKS], bf_[8][NKS]; \
            _Pragma("unroll") for (int ks = 0; ks < (NKS); ++ks) af_[ks] = *(const LAS bf16x8*)(inb + (F.lane & 15) * 232 + (JOFF) + 32 * ks + 8 * (F.lane >> 4)); \
            _Pragma("unroll") for (int nt = 0; nt < 8; ++nt) _Pragma("unroll") for (int ks = 0; ks < (NKS); ++ks) bf_[nt][ks] = *(const bf16x8*)(wf_ + (size_t)(nt * (NKS) + ks) * 512); \
            _Pragma("unroll") for (int nt = 0; nt < 8; ++nt) { f32x4 c4 = {0.f, 0.f, 0.f, 0.f}; \
                _Pragma("unroll") for (int ks = 0; ks < (NKS); ++ks) c4 = __builtin_amdgcn_mfma_f32_16x16x32_bf16(af_[ks], bf_[nt][ks], c4, 0, 0, 0); \
                _Pragma("unroll") for (int rr = 0; rr < 4; ++rr) zl[(4 * (F.lane >> 4) + rr) * 1028 + 128 * F.wave + 16 * nt + (F.lane & 15)] = c4[rr]; } \
            __syncthreads(); \
            _Pragma("unroll") for (int tt = 0; tt < 16; ++tt) { const f32x2_t z2 = *(const LAS f32x2_t*)(zl + tt * 1028 + c); ACC[0][tt] += z2.x; ACC[1][tt] += z2.y; } \
            __syncthreads(); } while (0)
            if (!(HACK & 1)) { LOWRANK_MFMA(accw, 0, 0, 2); relaunder(F);
            LOWRANK_MFMA(acca, 1, 64, 2); relaunder(F);
            LOWRANK_MFMA(accg, 2, 128, 2); relaunder(F);
            if (l) LOWRANK_MFMA(accv, 3, 192, 1); }
#undef LOWRANK_MFMA
            relaunder(F);
            float mur[2], muk[2], muv[2], kkv[2], kav[2], pr[2] = {0.f, 0.f}, pk[2] = {0.f, 0.f}, pv[2] = {0.f, 0.f}; float cl[2] = {0.f, 0.f};
#pragma unroll
            for (int e = 0; e < 2; ++e) { mur[e] = F.kin[I_RMU][l * 3264 + c + e]; muk[e] = F.kin[I_RMU][l * 3264 + 1024 + c + e]; muv[e] = F.kin[I_RMU][l * 3264 + 2048 + c + e]; kkv[e] = F.kin[I_RKK][l * 1024 + c + e]; kav[e] = F.kin[I_RKA][l * 1024 + c + e]; }
            if ((row0 & (SEQ - 1)) != 0) { const bf16* p = COLS + (size_t)(row0 - 1) * NMAIN + c; const unsigned ur = *(const unsigned*)(p + CC_R), uk = *(const unsigned*)(p + CC_K), uv = *(const unsigned*)(p + CC_V);
                pr[0] = bflo(ur); pr[1] = bfhi(ur); pk[0] = bflo(uk); pk[1] = bfhi(uk); pv[0] = bflo(uv); pv[1] = bfhi(uv); }
            if (!(HACK & 4))
#pragma unroll
            for (int tt = 0; tt < 16; ++tt) { const int row = row0 + tt; const bf16* p = COLS + (size_t)row * NMAIN + c; const size_t o = (size_t)row * 1024 + c;
                const unsigned ur = *(const unsigned*)(p + CC_R), uk = *(const unsigned*)(p + CC_K), uv = *(const unsigned*)(p + CC_V);
                const float cr[2] = {bflo(ur), bfhi(ur)}, ck[2] = {bflo(uk), bfhi(uk)}, cv[2] = {bflo(uv), bfhi(uv)};
                f32x2_t vf2 = {0.f, 0.f}; if (l != 0) vf2 = *(const f32x2_t*)(VF + o);
                float r[2], k[2], v[2], dec[2], av[2], kk[2], km[2];
#pragma unroll
                for (int e = 0; e < 2; ++e) { r[e] = cr[e] + (pr[e] - cr[e]) * mur[e]; k[e] = ck[e] + (pk[e] - ck[e]) * muk[e]; v[e] = cv[e] + (pv[e] - cv[e]) * muv[e]; pr[e] = cr[e]; pk[e] = ck[e]; pv[e] = cv[e];
                    if (l == 0) vf2[e] = v[e]; else { const float vg = sigmoid_f(accv[e][tt]); v[e] = v[e] + (vf2[e] - v[e]) * vg; }
                    cl[e] += -0.6065306597126334f * sigmoid_f(accw[e][tt]); dec[e] = cl[e]; av[e] = sigmoid_f(acca[e][tt]); kk[e] = k[e] * kkv[e]; km[e] = k[e] * (1.0f + (av[e] - 1.0f) * kav[e]); }
                const float ss = sum32(kk[0] * kk[0] + kk[1] * kk[1]), rn = rsqrtf(fmaxf(ss, 1e-24f)); kk[0] *= rn; kk[1] *= rn;
                if (l == 0) *(f32x2_t*)(VF + o) = vf2;
                *(f32x2_t*)(RW + RS + o) = (f32x2_t){dec[0], dec[1]};
                *(v2u*)(RWU + o) = (v2u){pk2(r[0], km[0]), pk2(r[1], km[1])}; *(v2u*)(RWU + 2 * RS + o) = (v2u){pk2(v[0], accg[0][tt]), pk2(v[1], accg[1][tt])};
                *(v2u*)(RWU + 3 * RS + o) = (v2u){pk2(-kk[0], kk[0] * av[0]), pk2(-kk[1], kk[1] * av[1])}; }
        }
        asm volatile("s_waitcnt vmcnt(0)" ::: "memory"); __syncthreads();
        __builtin_amdgcn_fence(__ATOMIC_ACQUIRE, "agent"); asm volatile("s_waitcnt vmcnt(0)" ::: "memory");
        if (!(HACK & 2)) rwkv_chunks_of_tile(F, l, tile);
    }
}
struct Args { const float* in[35]; float* out; unsigned char* ws; };
__device__ __forceinline__ void mk_frame(Frame& F, int wv) {
    extern __shared__ __attribute__((aligned(16))) unsigned char lds[];
    kargp kp = (kargp)__builtin_amdgcn_kernarg_segment_ptr(); asm volatile("" : "+s"(kp));
    F.kin = kp;
    F.lds = (LAS unsigned char*)lds;
    F.MISC = (volatile LAS unsigned*)(F.lds + MISC_OFF);
    { int w_ = wv; asm volatile("" : "+s"(w_)); int t_ = (int)__builtin_amdgcn_mbcnt_hi(~0u, __builtin_amdgcn_mbcnt_lo(~0u, (unsigned)w_ * 64u)); asm volatile("" : "+v"(t_)); F.tid = t_; } F.lane = F.tid & 63; F.wave = __builtin_amdgcn_readfirstlane(F.tid >> 6);
    F.G = gridDim.x; { int bx = blockIdx.x; asm volatile("" : "+s"(bx)); F.bx = bx; F.vcu = (F.G % 8 == 0) ? (bx % 8) * (F.G / 8) + bx / 8 : bx; }
    F.out = (float*)kp[35]; F.ws = (unsigned char*)kp[36]; F.ctl = (gu32*)(F.ws + WS_CTL);
}
__device__ __forceinline__ void grid_bar(int wv) {
    Frame F; mk_frame(F, wv);
    XcdBarrier bar; bar.bar = (unsigned*)(F.ctl + CW_BAR); bar.x = xb_xcc_id(); bar.st = F.MISC + 8;
    xcd_barrier(bar);
}
__global__ void __launch_bounds__(NWAVES * 64, 2) mega_fwd(Args args) {
    const int wv = __builtin_amdgcn_readfirstlane((int)threadIdx.x >> 6);
    { Frame F; mk_frame(F, wv);
      for (int u = F.tid; u < (LDS_BYTES - LDSCTL_OFF) / 4; u += NWAVES * 64) ((LAS unsigned*)(F.lds + LDSCTL_OFF))[u] = 0u;
      __syncthreads();
      (void)xcd_barrier_post((unsigned*)(F.ctl + CW_BAR), F.MISC + 8);
      p0_prologue_a(F);
    }
    grid_bar(wv);
    { Frame F; mk_frame(F, wv); p0_prologue_b(F); }
    grid_bar(wv);
#pragma unroll 1
    for (int l = 0; l < NLAYER; ++l) {
#define LAYER_VARS const float* mod = WSP(float, WS_MOD) + (size_t)l * 2 * 24576; const float* xin = l == 0 ? F.kin[I_X] : F.out; (void)mod; (void)xin
        { Frame F; mk_frame(F, wv); LAYER_VARS; if (l == 0) rms_phase(F, F.kin[I_X], mod + 0, mod + 4096); else rms_phase_bf(F, mod + 0, mod + 4096); }
        grid_bar(wv);
        { Frame F; mk_frame(F, wv);
          pg8::Gemm g{WSP(pg8::bf16_t, WS_XN), WSP(pg8::bf16_t, WS_WIN + l * WIN_L), M, NIN, DM}; pg8::StaticOrder S; S.init(M, NIN, F.G, F.bx);
          pg8::EpiCols E{WSP(pg8::bf16_t, WS_COLS), WSP(float, WS_LOWR)};
          pg8::gemm_phase<pg8::EpiCols, pg8::StaticOrder, true, true>(F.lds + RING_OFF, g, S, E, F.tid); }
        grid_bar(wv);
        { Frame F; mk_frame(F, wv); prep_norm(F, l); }
        { Frame F; mk_frame(F, wv); prep_loga(F, l); }
        { Frame F; mk_frame(F, wv); prep_rwkv(F, l); }
        { Frame F; mk_frame(F, wv); prep_vt(F, 0); }
        { Frame F; mk_frame(F, wv); prep_vt(F, 1); }
        { Frame F; mk_frame(F, wv); prep_vt(F, 2); }
        { Frame F; mk_frame(F, wv); prep_vt(F, 3); }
        { Frame F; mk_frame(F, wv); prep_vt(F, 4); }
        { Frame F; mk_frame(F, wv); prep_gla(F); }
        grid_bar(wv);
        { Frame F; mk_frame(F, wv); mixers_v4(F, l, l); }
        grid_bar(wv);
        { Frame F; mk_frame(F, wv); gla_post(F, l); }
        grid_bar(wv);
        { Frame F; mk_frame(F, wv); LAYER_VARS;
          pg8::Gemm g{WSP(pg8::bf16_t, WS_MIXED), WSP(pg8::bf16_t, WS_WOUT + l * WOUT_L), M, DM, DM}; pg8::StaticOrder S; S.init(M, DM, F.G, F.bx);
          pg8::EpiRes E{l == 0 ? (const void*)F.kin[I_X] : (const void*)WSP(bf16, WS_XR), (void*)WSP(bf16, WS_XR), mod + 2 * 4096, l != 0, true};
          pg8::gemm_phase<pg8::EpiRes, pg8::StaticOrder, true, true>(F.lds + RING_OFF, g, S, E, F.tid); }
        grid_bar(wv);
        { Frame F; mk_frame(F, wv); LAYER_VARS; rms_phase_bf(F, mod + 3 * 4096, mod + 4 * 4096); }
        grid_bar(wv);
        { Frame F; mk_frame(F, wv);
          pg8::Gemm g{WSP(pg8::bf16_t, WS_XN), WSP(pg8::bf16_t, WS_W13 + l * W13_L), M, 2 * DFF, DM}; pg8::StaticOrder S; S.init(M, 2 * DFF, F.G, F.bx);
          pg8::EpiSwiglu E{WSP(pg8::bf16_t, WS_HID)};
          pg8::gemm_phase<pg8::EpiSwiglu, pg8::StaticOrder, true, true>(F.lds + RING_OFF, g, S, E, F.tid); }
        grid_bar(wv);
        { Frame F; mk_frame(F, wv); LAYER_VARS;
          pg8::Gemm g{WSP(pg8::bf16_t, WS_HID), WSP(pg8::bf16_t, WS_W2 + l * W2_L), M, DM, DFF}; pg8::StaticOrder S; S.init(M, DM, F.G, F.bx);
          pg8::EpiRes E{(const void*)WSP(bf16, WS_XR), l + 1 < NLAYER ? (void*)WSP(bf16, WS_XR) : (void*)F.out, mod + 5 * 4096, true, l + 1 < NLAYER};
          pg8::gemm_phase<pg8::EpiRes, pg8::StaticOrder, true, true>(F.lds + RING_OFF, g, S, E, F.tid); }
        if (l + 1 < NLAYER) grid_bar(wv);
#undef LAYER_VARS
    }
}

extern "C" void kernel_launch(void* const* d_in, const int* in_sizes, int n_in, void* d_out, int out_size, void* d_ws, size_t ws_size, hipStream_t stream) {
    static int grid = 0;
    if (grid == 0) {
        if (n_in != 35 || in_sizes[0] != M * DM || out_size != M * DM || ws_size < WS_END) { fprintf(stderr, "kernel_launch: unexpected shapes: n_in %d in0 %d out %d ws %zu (need %zu)\n", n_in, n_in > 0 ? in_sizes[0] : -1, out_size, ws_size, (size_t)WS_END); grid = -1; return; }
        int dev = 0, cus = 0, per_cu = 0;
        if (hipGetDevice(&dev) != hipSuccess || hipDeviceGetAttribute(&cus, hipDeviceAttributeMultiprocessorCount, dev) != hipSuccess) { grid = -1; return; }
        if (hipFuncSetAttribute((const void*)mega_fwd, hipFuncAttributeMaxDynamicSharedMemorySize, LDS_BYTES) != hipSuccess) { fprintf(stderr, "kernel_launch: hipFuncSetAttribute failed\n"); grid = -1; return; }
        if (hipOccupancyMaxActiveBlocksPerMultiprocessor(&per_cu, (const void*)mega_fwd, NWAVES * 64, LDS_BYTES) != hipSuccess || per_cu < 1) fprintf(stderr, "kernel_launch: occupancy query says %d\n", per_cu);
        (void)hipGetLastError();
        grid = cus;
    }
    if (grid < 0) return;
    if (hipMemsetAsync((char*)d_ws + WS_CTL, 0, CTL_ZERO_BYTES, stream) != hipSuccess) return;
    Args a{};
    for (int i = 0; i < 35; ++i) a.in[i] = (const float*)d_in[i];
    a.out = (float*)d_out; a.ws = (unsigned char*)d_ws;
    hipLaunchKernelGGL(mega_fwd, dim3(grid), dim3(NWAVES * 64), LDS_BYTES, stream, a);
}
```

```cpp
#include <hip/hip_runtime.h>
#include <cstdio>
#include <cstdint>
namespace pg8 {
#define PG8_LAS __attribute__((address_space(3)))
typedef unsigned short bf16_t;
typedef short bf16x8 __attribute__((ext_vector_type(8)));
typedef float f32x4 __attribute__((ext_vector_type(4)));
typedef unsigned u32x4 __attribute__((ext_vector_type(4)));
constexpr int BM = 256, BK = 64, HALF = 128, HTB = HALF * BK * 2  , STAGE_BYTES = 8 * HTB, NXCD = 8, WGM = 8;

__host__ __device__ __forceinline__ int lds_byte(int r, int c) { const int st = (r >> 4) * 2 + (c >> 5), rr = r & 15, cc = c & 31, ob = rr * 64 + cc * 2; return st * 1024 + (ob ^ (((ob >> 9) & 1) << 5)); }
__host__ __device__ __forceinline__ void stage_rc(int b, int& R, int& C) { const int st = b / 1024, sb = b % 1024, swz = sb ^ (((sb >> 9) & 1) << 5); R = (st >> 1) * 16 + swz / 64; C = (st & 1) * 32 + (swz % 64) / 2; }
__host__ __device__ __forceinline__ int perm32(int rho) { const int n = rho >> 4, i = rho & 15; return 8 * (i >> 2) + 4 * n + (i & 3); }

struct Unit { int pm, pn; };
struct Gemm { const bf16_t* A; const bf16_t* Bt; int M, N, K; };

struct StaticOrder {
    int nM, nN, nwg, G, c;
    __host__ __device__ void init(int M, int N, int G_, int c_) { nM = M / BM; nN = N / BM; nwg = nM * nN; G = G_; c = c_; }
    __host__ __device__ bool next(int i, Unit& u) const {
        const long L = (long)i * G + c; if (L >= nwg) return false;
        int wgid = (int)L; { const int q = nwg / NXCD, r = nwg % NXCD, xcd = wgid % NXCD, off = wgid / NXCD; wgid = (xcd < r ? xcd * (q + 1) : r * (q + 1) + (xcd - r) * q) + off; }
        const int nig = WGM * nN, gid = wgid / nig, fm = gid * WGM, gsz = (nM - fm) < WGM ? (nM - fm) : WGM;
        u.pm = fm + ((wgid % nig) % gsz); u.pn = (wgid % nig) / gsz; return true;
    }
    __device__ __forceinline__ void a_ready(const Unit&) const {}
    __device__ __forceinline__ void done(const Unit&) const {}
};

typedef float f32x2c_t __attribute__((ext_vector_type(2))); typedef __bf16 bf16x2c_t __attribute__((ext_vector_type(2)));
__device__ __forceinline__ unsigned cvt_pk_bf16(float lo, float hi) { const f32x2c_t v = {lo, hi}; return __builtin_bit_cast(unsigned, __builtin_convertvector(v, bf16x2c_t)); }
typedef float f32x2 __attribute__((ext_vector_type(2)));
__device__ __forceinline__ float silu_f(float x) { return x * __builtin_amdgcn_rcpf(1.0f + __builtin_amdgcn_exp2f(-1.4426950408889634f * x)); }
struct EpiCols {
    static constexpr bool PERM = true, AFTER_DRAIN = false;
    bf16_t* O; float* L;
    __device__ __forceinline__ void operator()(const f32x4 (&acc)[2][2][4][2], const Unit& u, int wr, int wc, int fr, int fq) const {
        const int row0 = u.pm * BM + wr * 64 + fr;
        if (u.pn < 41) {
            const int col0 = u.pn * BM + wc * 32 + 8 * fq;
#pragma unroll
            for (int ai = 0; ai < 2; ++ai)
#pragma unroll
                for (int m = 0; m < 4; ++m) { bf16_t* rowp = O + (size_t)(row0 + ai * HALF + m * 16) * 10496 + col0;
#pragma unroll
                    for (int bj = 0; bj < 2; ++bj) { const f32x4 v0 = acc[ai][bj][m][0], v1 = acc[ai][bj][m][1];
                        u32x4 w; w.x = cvt_pk_bf16(v0[0], v0[1]); w.y = cvt_pk_bf16(v0[2], v0[3]); w.z = cvt_pk_bf16(v1[0], v1[1]); w.w = cvt_pk_bf16(v1[2], v1[3]);
                        *(u32x4*)(rowp + bj * HALF) = w; } }
        } else {
            const int col0 = wc * 32 + 8 * fq;
#pragma unroll
            for (int ai = 0; ai < 2; ++ai)
#pragma unroll
                for (int m = 0; m < 4; ++m) { float* rowp = L + (size_t)(row0 + ai * HALF + m * 16) * 256 + col0;
#pragma unroll
                    for (int bj = 0; bj < 2; ++bj) { *(f32x4*)(rowp + bj * HALF) = acc[ai][bj][m][0]; *(f32x4*)(rowp + bj * HALF + 4) = acc[ai][bj][m][1]; } }
        }
    }
};
struct EpiRes {
    static constexpr bool PERM = true, AFTER_DRAIN = false;
    const void* base; void* out; const float* gate; bool base_bf, out_bf;
    __device__ __forceinline__ void operator()(const f32x4 (&acc)[2][2][4][2], const Unit& u, int wr, int wc, int fr, int fq) const {
        const int row0 = u.pm * BM + wr * 64 + fr, col0 = u.pn * BM + wc * 32 + 8 * fq;
        const float* gp = gate + (size_t)(u.pm >> 5) * 24576 + col0;
        f32x4 gv[2][2];
#pragma unroll
        for (int bj = 0; bj < 2; ++bj)
#pragma unroll
            for (int n = 0; n < 2; ++n) gv[bj][n] = *(const f32x4*)(gp + bj * HALF + n * 4);
#pragma unroll
        for (int ai = 0; ai < 2; ++ai) {
            f32x4 r[4][2][2];
            if (base_bf) {
#pragma unroll
                for (int m = 0; m < 4; ++m)
#pragma unroll
                    for (int bj = 0; bj < 2; ++bj) { const u32x4 w = *(const u32x4*)((const bf16_t*)base + (size_t)(row0 + ai * HALF + m * 16) * 4096 + col0 + bj * HALF);
                        r[m][bj][0] = (f32x4){__builtin_bit_cast(float, w.x << 16), __builtin_bit_cast(float, w.x & 0xffff0000u), __builtin_bit_cast(float, w.y << 16), __builtin_bit_cast(float, w.y & 0xffff0000u)};
                        r[m][bj][1] = (f32x4){__builtin_bit_cast(float, w.z << 16), __builtin_bit_cast(float, w.z & 0xffff0000u), __builtin_bit_cast(float, w.w << 16), __builtin_bit_cast(float, w.w & 0xffff0000u)}; }
            } else {
#pragma unroll
                for (int m = 0; m < 4; ++m)
#pragma unroll
                    for (int bj = 0; bj < 2; ++bj)
#pragma unroll
                        for (int n = 0; n < 2; ++n) r[m][bj][n] = *(const f32x4*)((const float*)base + (size_t)(row0 + ai * HALF + m * 16) * 4096 + col0 + bj * HALF + n * 4);
            }
#pragma unroll
            for (int m = 0; m < 4; ++m)
#pragma unroll
                for (int bj = 0; bj < 2; ++bj)
#pragma unroll
                    for (int n = 0; n < 2; ++n) r[m][bj][n] = r[m][bj][n] + gv[bj][n] * acc[ai][bj][m][n];
            if (out_bf) {
#pragma unroll
                for (int m = 0; m < 4; ++m)
#pragma unroll
                    for (int bj = 0; bj < 2; ++bj) { const f32x4 v0 = r[m][bj][0], v1 = r[m][bj][1];
                        u32x4 w; w.x = cvt_pk_bf16(v0[0], v0[1]); w.y = cvt_pk_bf16(v0[2], v0[3]); w.z = cvt_pk_bf16(v1[0], v1[1]); w.w = cvt_pk_bf16(v1[2], v1[3]);
                        *(u32x4*)((bf16_t*)out + (size_t)(row0 + ai * HALF + m * 16) * 4096 + col0 + bj * HALF) = w; }
            } else {
#pragma unroll
                for (int m = 0; m < 4; ++m)
#pragma unroll
                    for (int bj = 0; bj < 2; ++bj)
#pragma unroll
                        for (int n = 0; n < 2; ++n) *(f32x4*)((float*)out + (size_t)(row0 + ai * HALF + m * 16) * 4096 + col0 + bj * HALF + n * 4) = r[m][bj][n];
            }
            asm volatile("" ::: "memory");
        }
    }
};
struct EpiSwiglu {
    static constexpr bool PERM = true, AFTER_DRAIN = false;
    bf16_t* H;
    __device__ __forceinline__ void operator()(const f32x4 (&acc)[2][2][4][2], const Unit& u, int wr, int wc, int fr, int fq) const {
        const int row0 = u.pm * BM + wr * 64 + fr, col0 = u.pn * HALF + wc * 32 + 8 * fq;
#pragma unroll
        for (int ai = 0; ai < 2; ++ai)
#pragma unroll
            for (int m = 0; m < 4; ++m) { bf16_t* rowp = H + (size_t)(row0 + ai * HALF + m * 16) * 11008 + col0;
                const f32x4 a0 = acc[ai][0][m][0], a1 = acc[ai][0][m][1], b0 = acc[ai][1][m][0], b1 = acc[ai][1][m][1];
                u32x4 w; w.x = cvt_pk_bf16(silu_f(a0[0]) * b0[0], silu_f(a0[1]) * b0[1]); w.y = cvt_pk_bf16(silu_f(a0[2]) * b0[2], silu_f(a0[3]) * b0[3]);
                w.z = cvt_pk_bf16(silu_f(a1[0]) * b1[0], silu_f(a1[1]) * b1[1]); w.w = cvt_pk_bf16(silu_f(a1[2]) * b1[2], silu_f(a1[3]) * b1[3]);
                *(u32x4*)rowp = w; }
    }
};
template <class Epi, class Sched, bool ALIGN_EPI = false, bool SP2 = false>
__device__ __forceinline__ void gemm_phase(PG8_LAS unsigned char* lds, const Gemm g, const Sched& S, const Epi& E, int tid_in) {
    int tid_ = tid_in; asm volatile("" : "+v"(tid_));
    const int tid = tid_, wid = __builtin_amdgcn_readfirstlane(tid >> 6), lane = tid & 63, wr = wid >> 2, wc = wid & 3, fr = lane & 15, fq = lane >> 4;
    const int K = g.K, nt = K / BK;
    unsigned voffA[2], voffB[2];
#pragma unroll
    for (int i = 0; i < 2; ++i) { int R, C; stage_rc(tid * 16 + i * 8192, R, C); const int Rb = Epi::PERM ? ((R & ~31) + perm32(R & 31)) : R;
        voffA[i] = (unsigned)(R * K + C) * 2u; voffB[i] = (unsigned)(Rb * K + C) * 2u; }
    const size_t kstep = (size_t)(BK * 2);
    const size_t hstep = (size_t)HALF * K * 2;
    const size_t tstep = 2 * hstep;
    const unsigned ldsw = (unsigned)wid * 1024u;
    const int aoff = lds_byte(wr * 64 + fr, fq * 8), boff = lds_byte(wc * 32 + fr, fq * 8);
#define PG8_SA(b, h) (((b) * 2 + (h)) * HTB)
#define PG8_SB(b, h) ((4 + (b) * 2 + (h)) * HTB)
#define PG8_STAGE(bufoff, gbase, voff) do { _Pragma("unroll") for (int _i = 0; _i < 2; ++_i) \
        __builtin_amdgcn_global_load_lds((const unsigned*)((const char*)(gbase) + (voff)[_i]), (PG8_LAS unsigned*)(lds + (bufoff) + ldsw + _i * 8192), 16, 0, 0); } while (0)
#define PG8_LDA(dst, b, h) do { _Pragma("unroll") for (int m = 0; m < 4; ++m) _Pragma("unroll") for (int k = 0; k < 2; ++k) dst[m][k] = *(const PG8_LAS bf16x8*)(lds + PG8_SA(b, h) + aoff + m * 2048 + k * 1024); } while (0)
#define PG8_LDB(dst, b, h) do { _Pragma("unroll") for (int n = 0; n < 2; ++n) _Pragma("unroll") for (int k = 0; k < 2; ++k) dst[n][k] = *(const PG8_LAS bf16x8*)(lds + PG8_SB(b, h) + boff + n * 2048 + k * 1024); } while (0)
#define PG8_MMA(ai, bj, At, Bt) do { __builtin_amdgcn_s_setprio(1); _Pragma("unroll") for (int m = 0; m < 4; ++m) _Pragma("unroll") for (int n = 0; n < 2; ++n) _Pragma("unroll") for (int k = 0; k < 2; ++k) \
        acc[ai][bj][m][n] = __builtin_amdgcn_mfma_f32_16x16x32_bf16(Bt[n][k], At[m][k], acc[ai][bj][m][n], 0, 0, 0); __builtin_amdgcn_s_setprio(0); } while (0)
#define PG8_WAIT_V(n) asm volatile("s_waitcnt vmcnt(" #n ")" ::: "memory")
#define PG8_WAIT_L(n) asm volatile("s_waitcnt lgkmcnt(" #n ")" ::: "memory")
#define PG8_BAR __builtin_amdgcn_s_barrier()
#define PG8_SCHED __builtin_amdgcn_sched_barrier(0)
    Unit cur, nxt; int ui = 0;
    if (!S.next(0, cur)) return;
    f32x4 acc[2][2][4][2];
#pragma unroll
    for (int a = 0; a < 2; ++a)
#pragma unroll
        for (int b = 0; b < 2; ++b)
#pragma unroll
            for (int m = 0; m < 4; ++m)
#pragma unroll
                for (int n = 0; n < 2; ++n) acc[a][b][m][n] = (f32x4){0.f, 0.f, 0.f, 0.f};
    bf16x8 At[4][2], B0[2][2], B1[2][2];
    const char* cA = (const char*)g.A + (size_t)cur.pm * tstep; const char* cB = (const char*)g.Bt + (size_t)cur.pn * tstep;
    S.a_ready(cur);
    if constexpr (SP2) {
        PG8_STAGE(PG8_SB(0, 0), cB, voffB); PG8_STAGE(PG8_SB(0, 1), cB + hstep, voffB); PG8_STAGE(PG8_SA(0, 0), cA, voffA); PG8_STAGE(PG8_SA(0, 1), cA + hstep, voffA);
        if (wr == 1) PG8_BAR;
        PG8_WAIT_V(2); PG8_BAR;
        PG8_STAGE(PG8_SB(1, 0), cB + kstep, voffB); PG8_STAGE(PG8_SA(1, 0), cA + kstep, voffA); PG8_STAGE(PG8_SB(1, 1), cB + hstep + kstep, voffB);
        PG8_WAIT_V(6); PG8_BAR;
    } else {
        PG8_STAGE(PG8_SB(0, 0), cB, voffB); PG8_STAGE(PG8_SA(0, 0), cA, voffA); PG8_STAGE(PG8_SB(0, 1), cB + hstep, voffB); PG8_STAGE(PG8_SA(0, 1), cA + hstep, voffA);
        if (wr == 1) PG8_BAR;
        PG8_WAIT_V(4); PG8_BAR;
        PG8_STAGE(PG8_SB(1, 0), cB + kstep, voffB); PG8_STAGE(PG8_SA(1, 0), cA + kstep, voffA); PG8_STAGE(PG8_SB(1, 1), cB + hstep + kstep, voffB);
        PG8_WAIT_V(6); PG8_BAR;
    }
    for (;;) {
        const bool has_next = S.next(ui + 1, nxt);
        const char* nA = has_next ? (const char*)g.A + (size_t)nxt.pm * tstep : cA; const char* nB = has_next ? (const char*)g.Bt + (size_t)nxt.pn * tstep : cB;
        for (int t = 0; t < nt; t += 2) {
            const bool last = (t == nt - 2);
            const char* a1 = cA + (size_t)(t + 1) * kstep;
            const char* a2 = last ? nA : cA + (size_t)(t + 2) * kstep; const char* b2 = last ? nB : cB + (size_t)(t + 2) * kstep;
            const char* a3 = a2 + kstep; const char* b3 = b2 + kstep;
            if (last && has_next) S.a_ready(nxt);
            if constexpr (SP2) {
            PG8_LDB(B0, 0, 0); PG8_LDB(B1, 0, 1); PG8_SCHED; PG8_LDA(At, 0, 0); PG8_STAGE(PG8_SA(1, 1), a1 + hstep, voffA);
            PG8_WAIT_V(8); PG8_WAIT_L(0); PG8_BAR; PG8_MMA(0, 0, At, B0); PG8_MMA(0, 1, At, B1); PG8_BAR; PG8_SCHED;
            PG8_LDA(At, 0, 1); PG8_STAGE(PG8_SB(0, 0), b2, voffB); PG8_STAGE(PG8_SB(0, 1), b2 + hstep, voffB); PG8_STAGE(PG8_SA(0, 0), a2, voffA);
            PG8_WAIT_V(8); PG8_WAIT_L(0); PG8_BAR; PG8_MMA(1, 0, At, B0); PG8_MMA(1, 1, At, B1); PG8_BAR; PG8_SCHED;
            PG8_LDB(B0, 1, 0); PG8_LDB(B1, 1, 1); PG8_SCHED; PG8_LDA(At, 1, 0); PG8_STAGE(PG8_SA(0, 1), a2 + hstep, voffA);
            PG8_WAIT_V(8); PG8_WAIT_L(0); PG8_BAR; PG8_MMA(0, 0, At, B0); PG8_MMA(0, 1, At, B1); PG8_BAR; PG8_SCHED;
            PG8_LDA(At, 1, 1); PG8_STAGE(PG8_SB(1, 0), b3, voffB); PG8_STAGE(PG8_SB(1, 1), b3 + hstep, voffB); PG8_STAGE(PG8_SA(1, 0), a3, voffA);
            PG8_WAIT_V(8); PG8_WAIT_L(0); PG8_BAR; PG8_MMA(1, 0, At, B0); PG8_MMA(1, 1, At, B1); PG8_BAR; PG8_SCHED;
            } else {
            PG8_LDB(B0, 0, 0); PG8_SCHED; PG8_LDA(At, 0, 0); PG8_STAGE(PG8_SA(1, 1), a1 + hstep, voffA);
            PG8_WAIT_L(8); PG8_BAR; PG8_WAIT_L(0); PG8_MMA(0, 0, At, B0); PG8_BAR; PG8_SCHED;
            PG8_LDB(B1, 0, 1); PG8_STAGE(PG8_SB(0, 0), b2, voffB);
            PG8_BAR; PG8_WAIT_L(0); PG8_MMA(0, 1, At, B1); PG8_BAR;
            PG8_LDA(At, 0, 1); PG8_STAGE(PG8_SA(0, 0), a2, voffA);
            PG8_BAR; PG8_WAIT_L(0); PG8_MMA(1, 0, At, B0); PG8_BAR; PG8_SCHED;
            PG8_STAGE(PG8_SB(0, 1), b2 + hstep, voffB);
            PG8_WAIT_V(6); PG8_BAR; PG8_MMA(1, 1, At, B1); PG8_BAR;
            PG8_LDB(B0, 1, 0); PG8_SCHED; PG8_LDA(At, 1, 0); PG8_STAGE(PG8_SA(0, 1), a2 + hstep, voffA);
            PG8_WAIT_L(8); PG8_BAR; PG8_WAIT_L(0); PG8_MMA(0, 0, At, B0); PG8_BAR; PG8_SCHED;
            PG8_LDB(B1, 1, 1); PG8_STAGE(PG8_SB(1, 0), b3, voffB);
            PG8_BAR; PG8_WAIT_L(0); PG8_MMA(0, 1, At, B1); PG8_BAR;
            PG8_LDA(At, 1, 1); PG8_STAGE(PG8_SA(1, 0), a3, voffA);
            PG8_BAR; PG8_WAIT_L(0); PG8_MMA(1, 0, At, B0); PG8_BAR; PG8_SCHED;
            PG8_STAGE(PG8_SB(1, 1), b3 + hstep, voffB);
            PG8_WAIT_V(6); PG8_BAR; PG8_MMA(1, 1, At, B1); PG8_BAR;
            }
        }
        if constexpr (ALIGN_EPI) { if (wr == 0) PG8_BAR; }
        if constexpr (!Epi::AFTER_DRAIN) { E(acc, cur, wr, wc, fr, fq); S.done(cur); }
        if (!has_next) break;
#pragma unroll
        for (int a = 0; a < 2; ++a)
#pragma unroll
            for (int b = 0; b < 2; ++b)
#pragma unroll
                for (int m = 0; m < 4; ++m)
#pragma unroll
                    for (int n = 0; n < 2; ++n) acc[a][b][m][n] = (f32x4){0.f, 0.f, 0.f, 0.f};
        cur = nxt; cA = nA; cB = nB; ++ui;
        if constexpr (ALIGN_EPI) { if (wr == 1) PG8_BAR; }
    }
    PG8_WAIT_V(0);
    if constexpr (!ALIGN_EPI) { if (wr == 0) PG8_BAR; }
    PG8_BAR;
    if constexpr (Epi::AFTER_DRAIN) { E.fused(acc, cur, wr, wc, fr, fq, lds, wid, lane); S.done(cur); }
#undef PG8_SA
#undef PG8_SB
#undef PG8_STAGE
#undef PG8_LDA
#undef PG8_LDB
#undef PG8_MMA
#undef PG8_WAIT_V
#undef PG8_WAIT_L
#undef PG8_BAR
#undef PG8_SCHED
}
}
constexpr int BATCH = 2, SEQ = 8192, DM = 4096, M = BATCH * SEQ, DFF = 11008, NLAYER = 2;
constexpr int P_IN = 10704, NIN = 10752, NMAIN = 10496;
constexpr int CA_Q = 0, CA_K = 1024, CA_V = 2048;
constexpr int CB_Q = 3072, CB_K = 3584, CB_V = 4096, CB_G = 5120;
constexpr int CC_R = 6144, CC_K = 7168, CC_V = 8192;
constexpr int CD_Q = 9216, CD_K = 10240, CD_V = 10368;
constexpr float LOG2E = 1.4426950408889634f;
constexpr float QSCALE = 0.125f * LOG2E;
constexpr int NWAVES = 8;

constexpr size_t MiB = 1u << 20;
constexpr size_t WS_CTL = 0, CTL_ZERO_BYTES = 1 * MiB;
constexpr size_t WS_MODP = 2 * MiB;
constexpr size_t WS_MOD = 14 * MiB;
constexpr size_t WS_TAB = 15 * MiB;
constexpr size_t WS_WIN = 16 * MiB, WIN_L = 84 * MiB;
constexpr size_t WS_WOUT = 184 * MiB, WOUT_L = 32 * MiB;
constexpr size_t WS_W13 = 248 * MiB, W13_L = 172 * MiB;
constexpr size_t WS_W2 = 592 * MiB, W2_L = 86 * MiB;
constexpr size_t WS_XN = 764 * MiB;
constexpr size_t WS_COLS = 892 * MiB;
constexpr size_t WS_LOWR = 1220 * MiB;
constexpr size_t WS_HID = 892 * MiB;
constexpr size_t WS_QKA = 1236 * MiB;
constexpr size_t WS_QKD = 1300 * MiB;
constexpr size_t WS_LOGA = 1336 * MiB;
constexpr size_t WS_RW = 1368 * MiB, RW_ONE = 64 * MiB;
constexpr size_t WS_VFIRST = 1816 * MiB;
constexpr size_t WS_MIXED = 1880 * MiB;
constexpr int VROW = SEQ + 64;
constexpr size_t WS_VTA = 2008 * MiB;
constexpr size_t WS_VTD = 2041 * MiB;
constexpr size_t WS_QDEC = 2046 * MiB, WS_KDT = 2062 * MiB, WS_AM = 2078 * MiB, WS_EBL = 2086 * MiB;
constexpr size_t WS_VTB = 2087 * MiB;
constexpr size_t WS_RWC = 2120 * MiB;
constexpr size_t WS_OB = 2446 * MiB;
constexpr size_t WS_PSG = 2478 * MiB;
constexpr size_t WS_WF = 2479 * MiB;
constexpr size_t WS_XR = 2480 * MiB;
constexpr size_t WS_END = 2608 * MiB;
constexpr int CW_BAR = 4096;
constexpr int CW_Q = 16384;

constexpr int RING_OFF = 0, RING_BYTES = 131072;
constexpr int LDSCTL_OFF = RING_BYTES, MISC_OFF = LDSCTL_OFF + 320;
constexpr int LDS_BYTES = 147456;

#define GAS __attribute__((address_space(1)))
#define LAS __attribute__((address_space(3)))
typedef unsigned short bf16;
typedef unsigned v4u __attribute__((ext_vector_type(4)));
typedef unsigned v2u __attribute__((ext_vector_type(2)));
typedef float f32x4 __attribute__((ext_vector_type(4)));
typedef short bf16x8 __attribute__((ext_vector_type(8)));
typedef GAS unsigned gu32;
#define RLX_AGENT __ATOMIC_RELAXED, __HIP_MEMORY_SCOPE_AGENT
#define LDS_WAIT() asm volatile("s_waitcnt lgkmcnt(0)" ::: "memory")
#define VM_WAIT() asm volatile("s_waitcnt vmcnt(0)" ::: "memory")
typedef float f32x2_t __attribute__((ext_vector_type(2))); typedef __bf16 bf16x2_t __attribute__((ext_vector_type(2)));
__device__ __forceinline__ unsigned pk2(float lo, float hi) { const f32x2_t v = {lo, hi}; return __builtin_bit_cast(unsigned, __builtin_convertvector(v, bf16x2_t)); }
__device__ __forceinline__ unsigned f2bf(float f) { return pk2(f, f) & 0xffffu; }
__device__ __forceinline__ float bf2f(unsigned short h) { return __builtin_bit_cast(float, (unsigned)h << 16); }
__device__ __forceinline__ float bflo(unsigned w) { return __builtin_bit_cast(float, w << 16); }
__device__ __forceinline__ float bfhi(unsigned w) { return __builtin_bit_cast(float, w & 0xffff0000u); }
template <int CTRL> __device__ __forceinline__ float dpp_f(float v) { return __builtin_bit_cast(float, __builtin_amdgcn_update_dpp(0, __builtin_bit_cast(int, v), CTRL, 0xF, 0xF, true)); }
__device__ __forceinline__ float sum8(float v) {
    v += dpp_f<0xB1>(v); v += dpp_f<0x4E>(v); v += dpp_f<0x141>(v); return v; }
__device__ __forceinline__ float sum32(float v) {
    v = sum8(v); v += dpp_f<0x140>(v); v += __builtin_bit_cast(float, __builtin_amdgcn_ds_swizzle(__builtin_bit_cast(int, v), 0x401F)); return v; }
__device__ __forceinline__ float wave_sum(float v) {
    v = sum8(v); v += dpp_f<0x140>(v);
    v += __builtin_bit_cast(float, __builtin_amdgcn_ds_swizzle(__builtin_bit_cast(int, v), 0x401F));
    { const int u = __builtin_bit_cast(int, v); v = __builtin_bit_cast(float, __builtin_amdgcn_readlane(u, 0)) + __builtin_bit_cast(float, __builtin_amdgcn_readlane(u, 32)); }
    return v;
}
__device__ __forceinline__ float sigmoid_f(float x) { return __builtin_amdgcn_rcpf(1.0f + __builtin_amdgcn_exp2f(-LOG2E * x)); }
__device__ __forceinline__ float silu_g(float x) { return x * sigmoid_f(x); }
__device__ __forceinline__ void unpack8(const v4u r, float (&f)[8]) { f[0] = bflo(r.x); f[1] = bfhi(r.x); f[2] = bflo(r.y); f[3] = bfhi(r.y); f[4] = bflo(r.z); f[5] = bfhi(r.z); f[6] = bflo(r.w); f[7] = bfhi(r.w); }
__device__ __forceinline__ v4u pack8(const float (&f)[8]) { v4u o; o.x = pk2(f[0], f[1]); o.y = pk2(f[2], f[3]); o.z = pk2(f[4], f[5]); o.w = pk2(f[6], f[7]); return o; }

#define XB_TMO      128
#define XB_XCNT(j)  (256  + 64 * (j))
#define XB_XSUB(j)  (1280 + 64 * (j))
#define XB_XGEN(j)  (2304 + 64 * (j))
#define XB_TOP      3328
#define XB_TOPGEN   3392
#define XCD_BAR_WORDS 3456
#define XB_SPIN_CAP (1u << 23)

__device__ __forceinline__ unsigned xb_ld(unsigned* p)              { return __hip_atomic_load(p, __ATOMIC_RELAXED, __HIP_MEMORY_SCOPE_AGENT); }
__device__ __forceinline__ unsigned xb_add(unsigned* p, unsigned v) { return __hip_atomic_fetch_add(p, v, __ATOMIC_RELAXED, __HIP_MEMORY_SCOPE_AGENT); }
__device__ __forceinline__ unsigned xb_xcc_id() { return (unsigned)__builtin_amdgcn_s_getreg((3 << 11) | 20) & 0xFu; }
#define XB_SPIN(cond, bar) do { unsigned _sp = 0; while (cond) { __builtin_amdgcn_s_sleep(1); \
    if ((++_sp & 255u) == 0u) { if (xb_ld(&(bar)[XB_TMO])) break; if (_sp > XB_SPIN_CAP) { atomicAdd(&(bar)[XB_TMO], 1u); break; } } } } while (0)

struct XcdBarrier {
    unsigned* bar; unsigned x;
    volatile LAS unsigned* st;
};

__device__ __forceinline__ XcdBarrier xcd_barrier_post(unsigned* bar, volatile LAS unsigned* st) {
    XcdBarrier b; b.bar = bar; b.x = xb_xcc_id(); b.st = st;
    if (threadIdx.x == 0) (void)xb_add(&bar[XB_XCNT(b.x)], 1u);
    return b;
}
__device__ __forceinline__ void xcd_barrier_complete(unsigned* bar, unsigned x, unsigned& nloc, unsigned& nx) {
    const unsigned G = gridDim.x * gridDim.y * gridDim.z;
    unsigned sum, cnt, mine, sp = 0u;
    for (;;) {
        sum = 0u; cnt = 0u; mine = 0u;
#pragma unroll
        for (unsigned j = 0; j < 16; ++j) { const unsigned c = xb_ld(&bar[XB_XCNT(j)]); sum += c; cnt += (c > 0u) ? 1u : 0u; mine = (j == x) ? c : mine; }
        if (sum == G) break;
        __builtin_amdgcn_s_sleep(1);
        if ((++sp & 255u) == 0u) { if (xb_ld(&bar[XB_TMO])) break; if (sp > XB_SPIN_CAP) { atomicAdd(&bar[XB_TMO], 1u); break; } }
    }
    nloc = mine > 0u ? mine : 1u; nx = cnt > 0u ? cnt : 1u;
}

__device__ __forceinline__ void xcd_barrier(const XcdBarrier& b) {
    asm volatile("s_waitcnt vmcnt(0)" ::: "memory");
    __syncthreads();
    if (threadIdx.x == 0) {
        unsigned* bar = b.bar;
        __builtin_amdgcn_s_waitcnt(0);
        unsigned nloc = b.st[0], nx = b.st[1];
        if (nloc == 0u) { xcd_barrier_complete(bar, b.x, nloc, nx); b.st[0] = nloc; b.st[1] = nx; }
        const unsigned old = xb_add(&bar[XB_XSUB(b.x)], 1u);
        const unsigned gen = old / nloc;
        if (old + 1u == (gen + 1u) * nloc) {
            __builtin_amdgcn_fence(__ATOMIC_RELEASE, "agent");
            asm volatile("s_waitcnt vmcnt(0)" ::: "memory");
            const unsigned og = xb_add(&bar[XB_TOP], 1u);
            const unsigned tg = og / nx;
            if (og + 1u == (tg + 1u) * nx) xb_add(&bar[XB_TOPGEN], 1u);
            else XB_SPIN(xb_ld(&bar[XB_TOPGEN]) == tg, bar);
            __builtin_amdgcn_fence(__ATOMIC_ACQUIRE, "agent");
            xb_add(&bar[XB_XGEN(b.x)], 1u);
            asm volatile("s_waitcnt vmcnt(0)" ::: "memory");
        } else {
            XB_SPIN(xb_ld(&bar[XB_XGEN(b.x)]) == gen, bar);
            __builtin_amdgcn_fence(__ATOMIC_ACQUIRE, "agent");
            asm volatile("s_waitcnt vmcnt(0)" ::: "memory");
        }
    }
    __syncthreads();
}

typedef const float* const __attribute__((address_space(4)))* kargp;
struct Frame {
    LAS unsigned char* lds;
    volatile LAS unsigned* MISC;
    gu32* ctl;
    int tid, lane, wave;
    int vcu, G, bx;
    kargp kin;
    float* out;
    unsigned char* ws;
};
enum { I_X = 0, I_C, I_RELB, I_ADAW, I_ADAB, I_WIN, I_WOUT, I_DQN, I_DKN, I_DLAM, I_DSUB, I_GGU, I_GGB, I_GON, I_RMU, I_RWUP, I_RW0, I_RAUP, I_RA0, I_RGUP,
       I_RKK, I_RKA, I_RRK, I_RLNW, I_RLNB, I_VRD, I_VRMU, I_VRUP, I_VR0, I_SQN, I_SKN, I_SSINK, I_W1, I_W3, I_W2 };

#define WSP(T, off) ((T*)(F.ws + (off)))
__device__ __forceinline__ void relaunder_tid(Frame& F) { int t = F.tid; asm volatile("" : "+v"(t)); F.tid = t; F.lane = t & 63; F.wave = __builtin_amdgcn_readfirstlane(t >> 6); }
__device__ __forceinline__ void relaunder(Frame& F) { kargp p = F.kin; asm volatile("" : "+s"(p)); F.kin = p; }

__device__ __forceinline__ void conv_item(const float* src, int ld, int col0, int ncols, int K, bf16* WT, int row0, int kb, LAS float* scr, int lane) {
    const int k0 = 64 * kb;
    { const int n = lane & 31; const bool ok = src != nullptr && n < ncols; const float* sp = src + (size_t)(k0 + (lane >> 5)) * ld + col0 + n; float v[32];
#pragma unroll
      for (int i = 0; i < 32; ++i) v[i] = ok ? sp[(size_t)(2 * i) * ld] : 0.f;
#pragma unroll
      for (int i = 0; i < 32; ++i) scr[(2 * i + (lane >> 5)) * 33 + n] = v[i]; }
    LDS_WAIT(); asm volatile("" ::: "memory");
    const int c = lane & 7;
#pragma unroll
    for (int j = 0; j < 4; ++j) { const int n = (lane >> 3) + 8 * j; const LAS float* s = scr + (8 * c) * 33 + n;
        v4u o; o.x = pk2(s[0 * 33], s[1 * 33]); o.y = pk2(s[2 * 33], s[3 * 33]); o.z = pk2(s[4 * 33], s[5 * 33]); o.w = pk2(s[6 * 33], s[7 * 33]);
        if (n < ncols) *(GAS v4u*)(WT + (size_t)(row0 + n) * K + k0 + 8 * c) = o; }
    LDS_WAIT(); asm volatile("" ::: "memory");
}
__device__ __forceinline__ int t5_bucket(int d) {
    if (d < 16) return d;
    int v = 16 + (int)(logf((float)d * (1.0f / 16.0f)) / logf(8.0f) * 16.0f);
    return v < 31 ? v : 31;
}
__device__ __forceinline__ void p0_prologue_a(Frame& F) {
    const int gw = F.vcu * NWAVES + F.wave, NGW = F.G * NWAVES;
    LAS float* ldsf = (LAS float*)(F.lds + RING_OFF);
    for (int i = F.tid; i < 2 * DM; i += NWAVES * 64) ldsf[i] = silu_g(F.kin[I_C][i]);
    __syncthreads();
    float* MODP = WSP(float, WS_MODP);
    for (int it = gw; it < 6144; it += NGW) {
        const int l = it / 3072, rem = it % 3072, kc = rem / 96, ng = rem % 96, n0 = 256 * ng + 4 * F.lane;
        const float* w = F.kin[I_ADAW] + ((size_t)l * DM + kc * 128) * 24576 + n0;
        f32x4 a0 = {0.f, 0.f, 0.f, 0.f}, a1 = {0.f, 0.f, 0.f, 0.f};
#pragma unroll 16
        for (int k = 0; k < 128; ++k) { const f32x4 wv = *(const f32x4*)(w + (size_t)k * 24576); const float s0 = ldsf[kc * 128 + k], s1 = ldsf[DM + kc * 128 + k]; a0 += wv * s0; a1 += wv * s1; }
        *(f32x4*)(MODP + ((size_t)(l * 32 + kc) * 2 + 0) * 24576 + n0) = a0;
        *(f32x4*)(MODP + ((size_t)(l * 32 + kc) * 2 + 1) * 24576 + n0) = a1;
    }
    for (int idx = F.bx * (NWAVES * 64) + F.tid; idx < NLAYER * 448 * 64; idx += F.G * NWAVES * 64) {
        const int l = idx / (448 * 64), rem = idx % (448 * 64), blk = rem >> 6, ln = rem & 63, n = ln & 15, g = ln >> 4;
        const int m = blk < 384 ? blk >> 7 : 3, nt = blk < 384 ? (blk & 127) >> 1 : blk - 384, ks = blk < 384 ? (blk & 1) : 0;
        const float* W = m == 0 ? F.kin[I_RWUP] + (size_t)l * 65536 : (m == 1 ? F.kin[I_RAUP] + (size_t)l * 65536 : (m == 2 ? F.kin[I_RGUP] + (size_t)l * 65536 : (l ? F.kin[I_VRUP] + (size_t)(l - 1) * 32768 : nullptr)));
        float f[8];
#pragma unroll
        for (int e = 0; e < 8; ++e) f[e] = W != nullptr ? W[(size_t)(32 * ks + 8 * g + e) * 1024 + 16 * nt + n] : 0.f;
        *(v4u*)(WSP(bf16, WS_WF) + ((size_t)(l * 448 + blk) * 64 + ln) * 8) = pack8(f);
    }
    __syncthreads();
    LAS float* scr = (LAS float*)(F.lds + RING_OFF + F.wave * 16384);
    constexpr int I_IN = 337 * 64, I_OUT = 128 * 64, I_13 = 688 * 64, I_2 = 128 * 172, I_L = I_IN + I_OUT + I_13 + I_2;
    for (int it = gw; it < NLAYER * I_L; it += NGW) {
        const int l = it / I_L; int r = it % I_L;
        if (r < I_IN) {
            const int kb = r / 337, cb = r % 337; const float* src = F.kin[I_WIN] + (size_t)l * DM * P_IN; int ld = P_IN, col0, row0, nc = 32;
            if (cb < 192) { col0 = 32 * cb; row0 = 32 * cb; }
            else if (cb < 288) { col0 = 6160 + 32 * (cb - 192); row0 = 6144 + 32 * (cb - 192); }
            else if (cb < 328) { col0 = 9424 + 32 * (cb - 288); row0 = 9216 + 32 * (cb - 288); }
            else if (cb == 328) { col0 = 6144; row0 = 10496; nc = 16; }
            else if (cb < 335) { col0 = 9232 + 32 * (cb - 329); row0 = 10512 + 32 * (cb - 329); }
            else if (cb == 335) { src = l ? F.kin[I_VRD] + (size_t)(l - 1) * DM * 32 : nullptr; ld = 32; col0 = 0; row0 = 10704; }
            else { src = nullptr; col0 = 0; row0 = 10736; nc = 16; }
            conv_item(src, ld, col0, nc, DM, WSP(bf16, WS_WIN + l * WIN_L), row0, kb, scr, F.lane); continue; }
        r -= I_IN;
        if (r < I_OUT) { const int kb = r / 128, cb = r % 128; conv_item(F.kin[I_WOUT] + (size_t)l * DM * DM, DM, 32 * cb, 32, DM, WSP(bf16, WS_WOUT + l * WOUT_L), 32 * cb, kb, scr, F.lane); continue; }
        r -= I_OUT;
        if (r < I_13) { const int kb = r / 688, cb = r % 688, pn = cb >> 3, wi = cb & 7;
            const float* src = (wi < 4 ? F.kin[I_W1] : F.kin[I_W3]) + (size_t)l * DM * DFF;
            conv_item(src, DFF, 128 * pn + 32 * (wi & 3), 32, DM, WSP(bf16, WS_W13 + l * W13_L), 32 * cb, kb, scr, F.lane); continue; }
        r -= I_13;
        { const int kb = r / 128, cb = r % 128; conv_item(F.kin[I_W2] + (size_t)l * DFF * DM, DM, 32 * cb, 32, DFF, WSP(bf16, WS_W2 + l * W2_L), 32 * cb, kb, scr, F.lane); }
    }
}
__device__ __forceinline__ void p0_prologue_b(Frame& F) {
    const int gt = F.bx * (NWAVES * 64) + F.tid, NT = F.G * NWAVES * 64;
    const float* MODP = WSP(float, WS_MODP); float* MOD = WSP(float, WS_MOD);
    for (int idx = gt; idx < NLAYER * 2 * 24576; idx += NT) {
        const int l = idx / 49152, rem = idx % 49152, b = rem / 24576, n = rem % 24576;
        float s = F.kin[I_ADAB][l * 24576 + n];
#pragma unroll 8
        for (int kc = 0; kc < 32; ++kc) s += MODP[((size_t)(l * 32 + kc) * 2 + b) * 24576 + n];
        MOD[idx] = s;
    }
    if (F.bx == 0) { float* TAB = WSP(float, WS_TAB);
        for (int i = F.tid; i < 24 * 128; i += NWAVES * 64) { const int hh = i >> 7, d = i & 127; TAB[i] = F.kin[I_RELB][t5_bucket(d) * 24 + hh] * LOG2E; } }
}
__device__ __forceinline__ void rms_phase(Frame& F, const float* xin, const float* sh, const float* sc) {
    const int gw = F.vcu * NWAVES + F.wave, NGW = F.G * NWAVES;
    bf16* XN = WSP(bf16, WS_XN);
    for (int m = gw; m < M; m += NGW) {
        const int b = m >> 13;
        const f32x4* xr = (const f32x4*)(xin + (size_t)m * DM) + F.lane;
        f32x4 v[16]; float ss = 0.f;
#pragma unroll
        for (int j = 0; j < 16; ++j) { v[j] = xr[64 * j]; ss += (v[j].x * v[j].x + v[j].y * v[j].y) + (v[j].z * v[j].z + v[j].w * v[j].w); }
        const float rstd = rsqrtf(wave_sum(ss) * (1.0f / DM) + 1e-6f);
        const f32x4* scp = (const f32x4*)(sc + (size_t)b * 24576) + F.lane; const f32x4* shp = (const f32x4*)(sh + (size_t)b * 24576) + F.lane;
        v2u* o8 = (v2u*)(XN + (size_t)m * DM) + F.lane;
#pragma unroll
        for (int j = 0; j < 16; ++j) { const f32x4 s4 = scp[64 * j], h4 = shp[64 * j]; const f32x4 o = v[j] * rstd * (s4 + 1.0f) + h4;
            v2u w; w.x = pk2(o.x, o.y); w.y = pk2(o.z, o.w); o8[64 * j] = w; }
    }
}
__device__ __forceinline__ void rms_phase_bf(Frame& F, const float* sh, const float* sc) {
    const int gw = F.vcu * NWAVES + F.wave, NGW = F.G * NWAVES;
    bf16* XN = WSP(bf16, WS_XN); const bf16* XR = WSP(bf16, WS_XR);
    for (int m = gw; m < M; m += NGW) {
        const int b = m >> 13;
        const v4u* xr = (const v4u*)(XR + (size_t)m * DM) + F.lane;
        v4u raw[8]; float ss = 0.f;
#pragma unroll
        for (int j = 0; j < 8; ++j) raw[j] = xr[64 * j];
#pragma unroll
        for (int j = 0; j < 8; ++j) { float f[8]; unpack8(raw[j], f);
#pragma unroll
            for (int e = 0; e < 8; ++e) ss += f[e] * f[e]; }
        const float rstd = rsqrtf(wave_sum(ss) * (1.0f / DM) + 1e-6f);
        const float* scp = sc + (size_t)b * 24576 + 8 * F.lane; const float* shp = sh + (size_t)b * 24576 + 8 * F.lane;
        v4u* o16 = (v4u*)(XN + (size_t)m * DM) + F.lane;
#pragma unroll
        for (int j = 0; j < 8; ++j) { float f[8]; unpack8(raw[j], f);
            const f32x4 s0 = *(const f32x4*)(scp + 512 * j), s1 = *(const f32x4*)(scp + 512 * j + 4), h0 = *(const f32x4*)(shp + 512 * j), h1 = *(const f32x4*)(shp + 512 * j + 4);
            float o[8];
#pragma unroll
            for (int e = 0; e < 4; ++e) { o[e] = f[e] * rstd * (s0[e] + 1.0f) + h0[e]; o[4 + e] = f[4 + e] * rstd * (s1[e] + 1.0f) + h1[e]; }
            o16[64 * j] = pack8(o); }
    }
}
__device__ __forceinline__ void prep_norm(Frame& F, int l) {
    const int gw = F.vcu * NWAVES + F.wave, NGW = F.G * NWAVES, lane = F.lane, sub = lane >> 3, ch = lane & 7;
    float gqa[8], gka[8], gqd[8], gkd[8];
#pragma unroll
    for (int e = 0; e < 8; ++e) { gqa[e] = F.kin[I_DQN][l * 64 + ch * 8 + e] * QSCALE; gka[e] = F.kin[I_DKN][l * 64 + ch * 8 + e];
                                  gqd[e] = F.kin[I_SQN][l * 64 + ch * 8 + e] * QSCALE; gkd[e] = F.kin[I_SKN][l * 64 + ch * 8 + e]; }
    const bf16* COLS = WSP(bf16, WS_COLS); bf16* QKA = WSP(bf16, WS_QKA); bf16* QKD = WSP(bf16, WS_QKD);
    for (int m = gw; m < M; m += NGW) {
        const bf16* src = COLS + (size_t)m * NMAIN;
#pragma unroll
        for (int i = 0; i < 4; ++i) { const int vec = i * 8 + sub, col = vec * 64 + ch * 8;
            float f[8]; unpack8(*(const v4u*)(src + CA_Q + col), f); float ss = 0.f;
#pragma unroll
            for (int e = 0; e < 8; ++e) ss += f[e] * f[e];
            ss = sum8(ss);
            const float rstd = rsqrtf(ss * (1.0f / 64.0f) + 1e-6f);
#pragma unroll
            for (int e = 0; e < 8; ++e) f[e] = f[e] * rstd * (i < 2 ? gqa[e] : gka[e]);
            *(v4u*)(QKA + (size_t)m * 2048 + col) = pack8(f); }
#pragma unroll
        for (int i = 0; i < 3; ++i) { const int vec = i * 8 + sub, col = vec * 64 + ch * 8;
            if (vec < 18) { float f[8]; unpack8(*(const v4u*)(src + CD_Q + col), f); float ss = 0.f;
#pragma unroll
                for (int e = 0; e < 8; ++e) ss += f[e] * f[e];
                ss = sum8(ss);
                const float rstd = rsqrtf(ss * (1.0f / 64.0f) + 1e-6f);
#pragma unroll
                for (int e = 0; e < 8; ++e) f[e] = f[e] * rstd * (vec < 16 ? gqd[e] : gkd[e]);
                *(v4u*)(QKD + (size_t)m * 1152 + col) = pack8(f); } }
    }
}
__device__ __forceinline__ void prep_loga(Frame& F, int l) {
    LAS float* gdl = (LAS float*)(F.lds + RING_OFF);
    float gu[16];
#pragma unroll
    for (int j = 0; j < 16; ++j) gu[j] = F.kin[I_GGU][((size_t)l * 16 + j) * 512 + F.tid];
    const float bias = F.kin[I_GGB][l * 512 + F.tid];
    const float* LOWR = WSP(float, WS_LOWR); float* LOGA = WSP(float, WS_LOGA);
    for (int tile = F.bx; tile < M / 64; tile += F.G) {
        const size_t row0 = (size_t)tile * 64;
        __syncthreads();
#pragma unroll
        for (int i = 0; i < 2; ++i) { const int idx = F.tid + 512 * i; gdl[idx] = LOWR[(row0 + (idx >> 4)) * 256 + (idx & 15)]; }
        __syncthreads();
#pragma unroll 4
        for (int t = 0; t < 64; ++t) { const LAS f32x4* gp = (const LAS f32x4*)(gdl + t * 16); const f32x4 g0 = gp[0], g1 = gp[1], g2 = gp[2], g3 = gp[3];
            float z = bias + g0.x * gu[0] + g0.y * gu[1] + g0.z * gu[2] + g0.w * gu[3] + g1.x * gu[4] + g1.y * gu[5] + g1.z * gu[6] + g1.w * gu[7]
                    + g2.x * gu[8] + g2.y * gu[9] + g2.z * gu[10] + g2.w * gu[11] + g3.x * gu[12] + g3.y * gu[13] + g3.z * gu[14] + g3.w * gu[15];
            LOGA[(row0 + t) * 512 + F.tid] = (fminf(z, 0.f) - __logf(1.0f + __expf(-fabsf(z)))) * (1.0f / 16.0f); }
    }
}
__device__ __forceinline__ int next_item(Frame& F, gu32* ctr) {
    volatile LAS int* slot = (volatile LAS int*)(F.lds + LDSCTL_OFF + 64);
    __syncthreads();
    if (F.tid == 0) *slot = (int)__hip_atomic_fetch_add(ctr, 1u, RLX_AGENT);
    __syncthreads();
    return *slot;
}
typedef float f32x16 __attribute__((ext_vector_type(16)));
__device__ __forceinline__ float xother32(float v) { unsigned a = __builtin_bit_cast(unsigned, v), b = a; asm volatile("" : "+v"(b)); auto rr = __builtin_amdgcn_permlane32_swap(a, b, false, false);
    const unsigned lo = rr[0], hi = rr[1]; return __builtin_bit_cast(float, (unsigned)((__builtin_amdgcn_mbcnt_hi(~0u, __builtin_amdgcn_mbcnt_lo(~0u, 0u)) & 32u) ? lo : hi)); }
__device__ __forceinline__ float xsum32(float v) { return v + xother32(v); }
__device__ __forceinline__ float xmax32(float v) { return fmaxf(v, xother32(v)); }
__device__ __forceinline__ int crow16(int r, int hi) { return (r & 3) + 8 * (r >> 2) + 4 * hi; }
template <bool ISA>
__device__ __forceinline__ void attn_unit(Frame& F, int l, int b, int hx, int qb) {
    constexpr int DV = ISA ? 128 : 64, NDV = DV / 32, KSTR = ISA ? 272 : 144, VSTR = 144, KBYTES = 64 * KSTR, VBYTES = DV * VSTR, BUFB = KBYTES + VBYTES, NCH = ISA ? 2 : 1;
    constexpr float NEG = -1e30f;
    LAS unsigned char* L = F.lds + RING_OFF;
    const int tid = F.tid, lane = F.lane, r32 = lane & 31, hi = lane >> 5, qs = F.wave & 3, grp = F.wave >> 2, q0 = qb * 128;
    const int kvh = hx >> 2, hd = kvh * 8 + (hx & 3) * 2 + grp;
    const bf16* Qp; const bf16* Kp; const bf16* VT; int ldq;
    if (ISA) { const bf16* QKA = WSP(bf16, WS_QKA); Qp = QKA + (size_t)b * SEQ * 2048 + hx * 128 + grp * 64; Kp = QKA + (size_t)b * SEQ * 2048 + 1024 + hx * 128; ldq = 2048; VT = WSP(bf16, WS_VTA) + (size_t)(b * 8 + hx) * 128 * VROW; }
    else { const bf16* QKD = WSP(bf16, WS_QKD); Qp = QKD + (size_t)b * SEQ * 1152 + hd * 64; Kp = QKD + (size_t)b * SEQ * 1152 + 1024 + kvh * 64; ldq = 1152; VT = WSP(bf16, WS_VTD) + (size_t)(b * 2 + kvh) * 64 * VROW; }
    const int qpos = q0 + 32 * qs + r32;
    bf16x8 qr[4];
#pragma unroll
    for (int d0 = 0; d0 < 4; ++d0) qr[d0] = *(const bf16x8*)(Qp + (size_t)qpos * ldq + d0 * 16 + hi * 8);
    LAS float* Bt = (LAS float*)(L + 2 * BUFB);
    { const float* TAB = WSP(float, WS_TAB);
      if (ISA) { if (tid < 130) Bt[tid] = tid == 0 ? NEG : (tid == 129 ? 0.f : TAB[hx * 128 + tid - 1] - TAB[hx * 128 + 127]); }
      else { if (tid < 260) { const int gi = tid >= 130, t = tid - 130 * gi; Bt[tid] = (t == 0 || t == 129) ? NEG : TAB[(8 + kvh * 8 + (hx & 3) * 2 + gi) * 128 + t - 1]; } } }
    const int TQ = q0 >> 6, T0 = ISA ? 0 : (TQ >= 2 ? TQ - 2 : 0), T1 = TQ + 1;
    v4u kreg[NCH], vreg[NCH];
#define AT_GLOAD(T) do { _Pragma("unroll") for (int i_ = 0; i_ < NCH; ++i_) { const int c_ = tid + 512 * i_; \
        const int kr_ = ISA ? (c_ >> 4) : (c_ >> 3), kc_ = ISA ? (c_ & 15) : (c_ & 7); kreg[i_] = *(const v4u*)(Kp + (size_t)((T) * 64 + kr_) * ldq + kc_ * 8); \
        const int vr_ = c_ >> 3, vc_ = c_ & 7; vreg[i_] = *(const v4u*)(VT + (size_t)vr_ * VROW + (T) * 64 + vc_ * 8); } } while (0)
#define AT_LWRITE(buf) do { _Pragma("unroll") for (int i_ = 0; i_ < NCH; ++i_) { const int c_ = tid + 512 * i_; \
        const int kr_ = ISA ? (c_ >> 4) : (c_ >> 3), kc_ = ISA ? (c_ & 15) : (c_ & 7); *(LAS v4u*)(L + (buf) * BUFB + kr_ * KSTR + kc_ * 16) = kreg[i_]; \
        const int vr_ = c_ >> 3, vc_ = c_ & 7; *(LAS v4u*)(L + (buf) * BUFB + KBYTES + vr_ * VSTR + vc_ * 16) = vreg[i_]; } } while (0)
    f32x16 o[NDV];
#pragma unroll
    for (int i = 0; i < NDV; ++i) o[i] = (f32x16){0.f, 0.f, 0.f, 0.f, 0.f, 0.f, 0.f, 0.f, 0.f, 0.f, 0.f, 0.f, 0.f, 0.f, 0.f, 0.f};
    float m_run = ISA ? NEG : F.kin[I_SSINK][l * 16 + hd] * LOG2E, l_run = ISA ? 0.f : (hi == 0 ? 1.f : 0.f);
    const int krow = (r32 & 16) | (r32 & 3) | ((r32 & 4) << 1) | ((r32 & 8) >> 1);
    const int koff = krow * KSTR + (ISA ? grp * 128 : 0) + hi * 16, voff = KBYTES + r32 * VSTR + hi * 16;
    AT_GLOAD(T0); AT_LWRITE(0); __syncthreads();
#pragma unroll 1
    for (int T = T0; T <= T1; ++T) {
        const int cur = (T - T0) & 1;
        AT_GLOAD(T < T1 ? T + 1 : T1);
        LAS const unsigned char* Kb = L + cur * BUFB;
        f32x16 s[2];
#pragma unroll
        for (int blk = 0; blk < 2; ++blk) { s[blk] = (f32x16){0.f, 0.f, 0.f, 0.f, 0.f, 0.f, 0.f, 0.f, 0.f, 0.f, 0.f, 0.f, 0.f, 0.f, 0.f, 0.f};
#pragma unroll
            for (int d0 = 0; d0 < 4; ++d0) { const bf16x8 kf = *(const LAS bf16x8*)(Kb + koff + blk * 32 * KSTR + d0 * 32); s[blk] = __builtin_amdgcn_mfma_f32_32x32x16_bf16(kf, qr[d0], s[blk], 0, 0, 0); } }
        bf16x8 vfc[NDV], vfn[NDV];
#pragma unroll
        for (int i = 0; i < NDV; ++i) vfc[i] = *(const LAS bf16x8*)(Kb + voff + i * 32 * VSTR);
        if (!ISA || T >= TQ - 2) {
            const LAS float* bt = Bt + (ISA ? 0 : grp * 130) + 1; const int d0 = qpos - T * 64 - 8 * hi;
#pragma unroll
            for (int blk = 0; blk < 2; ++blk)
#pragma unroll
                for (int r = 0; r < 16; ++r) { const int dist = d0 - (32 * blk + 16 * (r >> 3) + (r & 7)); const int di = dist < -1 ? -1 : (dist > 128 ? 128 : dist); s[blk][r] += bt[di]; } }
        float mt = s[0][0];
#pragma unroll
        for (int r = 1; r < 16; ++r) mt = fmaxf(mt, s[0][r]);
#pragma unroll
        for (int r = 0; r < 16; ++r) mt = fmaxf(mt, s[1][r]);
        mt = xmax32(mt);
        const float m_new = fmaxf(m_run, mt);
        if (__any(m_new > m_run)) { const float alpha = __builtin_amdgcn_exp2f(m_run - m_new); l_run *= alpha;
#pragma unroll
            for (int i = 0; i < NDV; ++i)
#pragma unroll
                for (int r = 0; r < 16; ++r) o[i][r] *= alpha;
            m_run = m_new; }
        float ls = 0.f;
#pragma unroll
        for (int blk = 0; blk < 2; ++blk)
#pragma unroll
            for (int r = 0; r < 16; ++r) { const float pv_ = __builtin_amdgcn_exp2f(s[blk][r] - m_run); s[blk][r] = pv_; ls += pv_; }
        l_run += ls;
#pragma unroll
        for (int sl = 0; sl < 4; ++sl) { const int blk = sl >> 1, r0 = 8 * (sl & 1);
            v4u pw; pw.x = pg8::cvt_pk_bf16(s[blk][r0], s[blk][r0 + 1]); pw.y = pg8::cvt_pk_bf16(s[blk][r0 + 2], s[blk][r0 + 3]); pw.z = pg8::cvt_pk_bf16(s[blk][r0 + 4], s[blk][r0 + 5]); pw.w = pg8::cvt_pk_bf16(s[blk][r0 + 6], s[blk][r0 + 7]);
            const bf16x8 pf = __builtin_bit_cast(bf16x8, pw);
#pragma unroll
            for (int i = 0; i < NDV; ++i) { if (sl < 3) vfn[i] = *(const LAS bf16x8*)(Kb + voff + i * 32 * VSTR + (sl + 1) * 32); o[i] = __builtin_amdgcn_mfma_f32_32x32x16_bf16(vfc[i], pf, o[i], 0, 0, 0); }
#pragma unroll
            for (int i = 0; i < NDV; ++i) vfc[i] = vfn[i]; }
        AT_LWRITE(cur ^ 1);
        __syncthreads();
    }
#undef AT_GLOAD
#undef AT_LWRITE
    const float inv = 1.0f / xsum32(l_run);
    bf16* MIX = WSP(bf16, WS_MIXED);
    if (ISA) {
        int ll_ = l; asm volatile("" : "+s"(ll_)); const float lam_init = ll_ == 0 ? 0.2f : 0.35550906759f;     float lam_full;
        { const float* lm = F.kin[I_DLAM] + (size_t)l * 256; const float s1 = wave_sum(lm[lane] * lm[64 + lane]), s2 = wave_sum(lm[128 + lane] * lm[192 + lane]); lam_full = __expf(s1) - __expf(s2) + lam_init; }
        LAS float* R1 = (LAS float*)L;
        LAS bf16* R2 = (LAS bf16*)(L + 66048);
        const int ql = 32 * qs + r32;
        if (grp == 1) {
#pragma unroll
            for (int i = 0; i < NDV; ++i)
#pragma unroll
                for (int r = 0; r < 16; ++r) R1[ql * 129 + 32 * i + crow16(r, hi)] = lam_full * inv * o[i][r]; }
        __syncthreads();
        if (grp == 0) { float ss = 0.f;
#pragma unroll
            for (int i = 0; i < NDV; ++i)
#pragma unroll
                for (int r = 0; r < 16; ++r) { const float d = o[i][r] * inv - R1[ql * 129 + 32 * i + crow16(r, hi)]; o[i][r] = d; ss += d * d; }
            const float rstd = rsqrtf(xsum32(ss) * (1.0f / 128.0f) + 1e-6f) * (1.0f - lam_init);
            const float* sl = F.kin[I_DSUB] + l * 128;
#pragma unroll
            for (int i = 0; i < NDV; ++i)
#pragma unroll
                for (int r = 0; r < 16; ++r) { const int dv = 32 * i + crow16(r, hi); R2[ql * 132 + dv] = (bf16)f2bf(o[i][r] * rstd * sl[dv]); } }
        __syncthreads();
#pragma unroll
        for (int i = 0; i < 4; ++i) { const int c = tid + 512 * i, row = c >> 4, ch = c & 15; const LAS v2u* sp = (const LAS v2u*)(R2 + row * 132 + ch * 8); const v2u a = sp[0], bb = sp[1];
            *(v4u*)(MIX + (size_t)(b * SEQ + q0 + row) * DM + hx * 128 + ch * 8) = (v4u){a.x, a.y, bb.x, bb.y}; }
    } else {
        LAS bf16* R = (LAS bf16*)L + F.wave * 2176;
#pragma unroll
        for (int i = 0; i < NDV; ++i)
#pragma unroll
            for (int r = 0; r < 16; ++r) R[r32 * 68 + 32 * i + crow16(r, hi)] = (bf16)f2bf(o[i][r] * inv);
#pragma unroll
        for (int i = 0; i < 4; ++i) { const int c = lane + 64 * i, row = c >> 3, ch = c & 7; const LAS v2u* sp = (const LAS v2u*)(R + row * 68 + ch * 8); const v2u a = sp[0], bb = sp[1];
            *(v4u*)(MIX + (size_t)(b * SEQ + q0 + 32 * qs + row) * DM + 3072 + hd * 64 + ch * 8) = (v4u){a.x, a.y, bb.x, bb.y}; }
    }
}
__device__ __forceinline__ void prep_gla(Frame& F) {
    LAS float* Lb = (LAS float*)(F.lds + RING_OFF); LAS float* Qd = Lb + 64 * 129; LAS float* Ki = Qd + 64 * 129; LAS bf16* Kt = (LAS bf16*)(Ki + 64 * 129);
    const bf16* COLS = WSP(bf16, WS_COLS); const float* LOGA = WSP(float, WS_LOGA);
    bf16* QDEC = WSP(bf16, WS_QDEC); bf16* KDT = WSP(bf16, WS_KDT); bf16* AMg = WSP(bf16, WS_AM); float* EBL = WSP(float, WS_EBL);
    for (int u = F.bx; u < 1024; u += F.G) {
        const int b = u >> 9, h = (u >> 7) & 3, ck = u & 127; const size_t row0 = (size_t)b * SEQ + ck * 64;
        __syncthreads();
        for (int idx = F.tid; idx < 8192; idx += NWAVES * 64) { const int t = idx >> 7, d = idx & 127; Lb[t * 129 + d] = LOGA[(row0 + t) * 512 + h * 128 + d]; }
        __syncthreads();
        if (F.tid < 128) { float acc = 0.f;
#pragma unroll 8
            for (int t = 0; t < 64; ++t) { acc += Lb[t * 129 + F.tid]; Lb[t * 129 + F.tid] = acc; }
            EBL[(size_t)u * 128 + F.tid] = __expf(acc); }
        __syncthreads();
        for (int idx = F.tid; idx < 8192; idx += NWAVES * 64) { const int t = idx >> 7, d = idx & 127; const float bt = Lb[t * 129 + d], bl = Lb[63 * 129 + d];
            const float q = bf2f(COLS[(row0 + t) * NMAIN + CB_Q + h * 128 + d]) * 0.08838834764831845f, k = bf2f(COLS[(row0 + t) * NMAIN + CB_K + h * 128 + d]);
            const float qd = q * __expf(bt); Qd[t * 129 + d] = qd; Ki[t * 129 + d] = k * __expf(-bt); Kt[d * 72 + t] = (bf16)f2bf(k * __expf(bl - bt));
            QDEC[((size_t)u * 64 + t) * 128 + d] = (bf16)f2bf(qd); }
        __syncthreads();
#pragma unroll
        for (int i = 0; i < 2; ++i) { const int c_ = F.tid + 512 * i, row = c_ >> 3, ch = c_ & 7; const LAS v2u* sp = (const LAS v2u*)(Kt + row * 72 + ch * 8); const v2u a = sp[0], bb = sp[1];
            *(v4u*)(KDT + ((size_t)u * 128 + row) * 64 + ch * 8) = (v4u){a.x, a.y, bb.x, bb.y}; }
        { const int c = F.tid >> 3, sg = F.tid & 7; float acc[8];
#pragma unroll
          for (int e = 0; e < 8; ++e) acc[e] = 0.f;
#pragma unroll 4
          for (int d = 0; d < 128; ++d) { const float q = Qd[c * 129 + d];
#pragma unroll
              for (int e = 0; e < 8; ++e) acc[e] += q * Ki[(sg * 8 + e) * 129 + d]; }
#pragma unroll
          for (int e = 0; e < 8; ++e) if (sg * 8 + e > c) acc[e] = 0.f;
          *(v4u*)(AMg + ((size_t)u * 64 + c) * 64 + sg * 8) = pack8(acc); }
    }
}
__device__ __forceinline__ void prep_vt(Frame& F, int pass) {
    LAS bf16* T = (LAS bf16*)(F.lds + RING_OFF);
    const bf16* COLS = WSP(bf16, WS_COLS);
    const int ncol = pass == 4 ? 128 : 512, nch = ncol >> 3;
    const int col0 = pass < 2 ? CA_V + 512 * pass : (pass < 4 ? CB_V + 512 * (pass - 2) : CD_V);
    bf16* dst0 = pass < 2 ? WSP(bf16, WS_VTA) + (size_t)(512 * pass) * VROW : (pass < 4 ? WSP(bf16, WS_VTB) + (size_t)(512 * (pass - 2)) * VROW : WSP(bf16, WS_VTD));
    const int rows_b = pass == 4 ? 128 : 1024;
    for (int tile = F.bx; tile < M / 64; tile += F.G) {
        const int b = tile >> 7, t0 = (tile & 127) * 64;
        __syncthreads();
        for (int idx = F.tid; idx < 64 * nch; idx += NWAVES * 64) { const int tok = idx / nch, ch = idx % nch;
            const v4u v = *(const v4u*)(COLS + (size_t)(b * SEQ + t0 + tok) * NMAIN + col0 + ch * 8); LAS unsigned* d = (LAS unsigned*)(T + tok * 522 + ch * 8); d[0] = v.x; d[1] = v.y; d[2] = v.z; d[3] = v.w; }
        __syncthreads();
        for (int idx = F.tid; idx < ncol * 8; idx += NWAVES * 64) { const int vrow = idx >> 3, ch = idx & 7;
            unsigned e[8];
#pragma unroll
            for (int k = 0; k < 8; ++k) e[k] = T[(ch * 8 + k) * 522 + vrow];
            v4u o; o.x = e[0] | (e[1] << 16); o.y = e[2] | (e[3] << 16); o.z = e[4] | (e[5] << 16); o.w = e[6] | (e[7] << 16);
            *(v4u*)(dst0 + ((size_t)b * rows_b + vrow) * VROW + t0 + ch * 8) = o; }
    }
}
typedef float f32x4v __attribute__((ext_vector_type(4)));
__device__ __forceinline__ float sum16(float v) { v = sum8(v); v += dpp_f<0x140>(v); return v; }
#define LDS_BARRIER() asm volatile("s_waitcnt lgkmcnt(0)\n\ts_barrier" ::: "memory")
template <int HACK = 0> __device__ __forceinline__ void gla_scan_unit(Frame& F, int l, int b, int h, int vh) {
    LAS unsigned char* L = F.lds + RING_OFF;
    constexpr int OQD = 0, OKT = 17408, OAM = 35840, OVT = 45056, OOT = 63488, OEB = 80896, OPS = 81408;
    const int tid = F.tid, lane = F.lane, n = lane & 15, g = lane >> 4, w = F.wave;
    const bf16* QDEC = WSP(bf16, WS_QDEC); const bf16* KDT = WSP(bf16, WS_KDT); const bf16* AMg = WSP(bf16, WS_AM); const float* EBL = WSP(float, WS_EBL);
    const bf16* VTB = WSP(bf16, WS_VTB) + (size_t)((b * 4 + h) * 256 + 128 * vh) * VROW; bf16* OB = WSP(bf16, WS_OB); float* PSG = WSP(float, WS_PSG);
    f32x4v S[8];
#pragma unroll
    for (int dt = 0; dt < 8; ++dt) S[dt] = (f32x4v){0.f, 0.f, 0.f, 0.f};
    v4u pq[2], pk[2], pa, pv[2]; float pe = 0.f;
#define GL_ISSUE(CK) do { const size_t u_ = (size_t)(b * 4 + h) * 128 + (CK); \
        _Pragma("unroll") for (int i = 0; i < 2; ++i) { const int c_ = tid + 512 * i; pq[i] = *(const v4u*)(QDEC + (u_ * 64 + (c_ >> 4)) * 128 + (c_ & 15) * 8); pk[i] = *(const v4u*)(KDT + (u_ * 128 + (c_ >> 3)) * 64 + (c_ & 7) * 8); \
            pv[i] = *(const v4u*)(VTB + (size_t)(c_ >> 3) * VROW + (CK) * 64 + (c_ & 7) * 8); } \
        pa = *(const v4u*)(AMg + (u_ * 64 + (tid >> 3)) * 64 + (tid & 7) * 8); \
        pe = EBL[u_ * 128 + (tid & 127)]; } while (0)
#define GL_WRITE() do { _Pragma("unroll") for (int i = 0; i < 2; ++i) { const int c_ = tid + 512 * i; *(LAS v4u*)(L + OQD + (c_ >> 4) * 272 + (c_ & 15) * 16) = pq[i]; *(LAS v4u*)(L + OKT + (c_ >> 3) * 144 + (c_ & 7) * 16) = pk[i]; \
            *(LAS v4u*)(L + OVT + (c_ >> 3) * 144 + (c_ & 7) * 16) = pv[i]; } \
        *(LAS v4u*)(L + OAM + (tid >> 3) * 144 + (tid & 7) * 16) = pa; \
        ((LAS float*)(L + OEB))[tid & 127] = pe; } while (0)
    GL_ISSUE(0); GL_WRITE();
    LDS_BARRIER();
#pragma unroll 1
    for (int ck = 0; ck < 128; ++ck) {
        const size_t row0 = (size_t)b * SEQ + ck * 64;
        GL_ISSUE((HACK & 1) && ck >= 2 ? 2 : (ck + 1 < 128 ? ck + 1 : 127));
        bf16x8 vf[2];
#pragma unroll
        for (int ks = 0; ks < 2; ++ks) vf[ks] = *(const LAS bf16x8*)(L + OVT + (16 * w + n) * 144 + (32 * ks + 8 * g) * 2);
        f32x4v o[4];
#pragma unroll
        for (int ct = 0; ct < 4; ++ct) o[ct] = (f32x4v){0.f, 0.f, 0.f, 0.f};
#pragma unroll
        for (int ct = 0; ct < 4; ++ct)
#pragma unroll
            for (int ks = 0; ks < 2; ++ks) { const bf16x8 af = *(const LAS bf16x8*)(L + OAM + (16 * ct + n) * 144 + (32 * ks + 8 * g) * 2); o[ct] = __builtin_amdgcn_mfma_f32_16x16x32_bf16(af, vf[ks], o[ct], 0, 0, 0); }
#pragma unroll
        for (int kk = 0; kk < 4; ++kk) { v4u pw; pw.x = pg8::cvt_pk_bf16(S[2 * kk][0], S[2 * kk][1]); pw.y = pg8::cvt_pk_bf16(S[2 * kk][2], S[2 * kk][3]);
            pw.z = pg8::cvt_pk_bf16(S[2 * kk + 1][0], S[2 * kk + 1][1]); pw.w = pg8::cvt_pk_bf16(S[2 * kk + 1][2], S[2 * kk + 1][3]); const bf16x8 sf = __builtin_bit_cast(bf16x8, pw);
#pragma unroll
            for (int ct = 0; ct < 4; ++ct) { const LAS unsigned char* qp = L + OQD + (16 * ct + n) * 272 + (32 * kk + 4 * g) * 2; const v2u qa = *(const LAS v2u*)qp, qb = *(const LAS v2u*)(qp + 32);
                o[ct] = __builtin_amdgcn_mfma_f32_16x16x32_bf16(__builtin_bit_cast(bf16x8, (v4u){qa.x, qa.y, qb.x, qb.y}), sf, o[ct], 0, 0, 0); } }
#pragma unroll
        for (int dt = 0; dt < 8; ++dt) { const f32x4v eb = *(const LAS f32x4v*)(L + OEB + (16 * dt + 4 * g) * 4); S[dt] = S[dt] * eb;
#pragma unroll
            for (int ks = 0; ks < 2; ++ks) { const bf16x8 kf = *(const LAS bf16x8*)(L + OKT + (16 * dt + n) * 144 + (32 * ks + 8 * g) * 2); S[dt] = __builtin_amdgcn_mfma_f32_16x16x32_bf16(kf, vf[ks], S[dt], 0, 0, 0); } }
        LAS float* PS = (LAS float*)(L + OPS) + (ck & 1) * 512;
#pragma unroll
        for (int ct = 0; ct < 4; ++ct)
#pragma unroll
            for (int r = 0; r < 4; ++r) { const float ss = sum16(o[ct][r] * o[ct][r]); if (n == 0) PS[(16 * ct + 4 * g + r) * 8 + w] = ss;
                *(LAS bf16*)(L + OOT + (16 * ct + 4 * g + r) * 272 + (16 * w + n) * 2) = (bf16)f2bf(o[ct][r]); }
        LDS_BARRIER();
        GL_WRITE();
        if (!(HACK & 2)) {
#pragma unroll
        for (int i = 0; i < 2; ++i) { const int c_ = tid + 512 * i, tok = c_ >> 4, ch = c_ & 15; *(v4u*)(OB + (row0 + tok) * 1024 + h * 256 + 128 * vh + ch * 8) = *(const LAS v4u*)(L + OOT + tok * 272 + ch * 16); }
        if (tid < 64) { const LAS f32x4v* pp = (const LAS f32x4v*)(PS + tid * 8); const f32x4v p0 = pp[0], p1 = pp[1]; PSG[(row0 + tid) * 8 + h * 2 + vh] = ((p0.x + p0.y) + (p0.z + p0.w)) + ((p1.x + p1.y) + (p1.z + p1.w)); } }
        LDS_BARRIER();
    }
#undef GL_ISSUE
#undef GL_WRITE
}
__device__ __forceinline__ void gla_post(Frame& F, int l) {
    const bf16* OB = WSP(bf16, WS_OB); const float* PSG = WSP(float, WS_PSG); const bf16* COLS = WSP(bf16, WS_COLS); bf16* MIX = WSP(bf16, WS_MIXED);
    const int ch = F.tid & 127, h = ch >> 5; float gain8[8];
#pragma unroll
    for (int e = 0; e < 8; ++e) gain8[e] = F.kin[I_GON][l * 256 + (ch & 31) * 8 + e];
    for (int row = F.bx * 4 + (F.tid >> 7); row < M; row += F.G * 4) {
        float ov[8], gv[8]; unpack8(*(const v4u*)(OB + (size_t)row * 1024 + ch * 8), ov); unpack8(*(const v4u*)(COLS + (size_t)row * NMAIN + CB_G + ch * 8), gv);
        const f32x2_t ps = *(const f32x2_t*)(PSG + (size_t)row * 8 + h * 2); const float rstd = rsqrtf((ps.x + ps.y) * (1.0f / 256.0f) + 1e-6f);
#pragma unroll
        for (int e = 0; e < 8; ++e) ov[e] = ov[e] * (rstd * gain8[e]) * silu_g(gv[e]);
        *(v4u*)(MIX + (size_t)row * DM + 1024 + ch * 8) = pack8(ov);
    }
}
constexpr int RC_AT = 0, RC_RT = 2048, RC_BK = 4096, RC_VF = 8192, RC_GF = 10240, RC_U0 = 12288, RC_Y0 = 16384, RC_P15 = 20480, RC_BN = 20736, RC_BYTES = 20800;
__device__ __forceinline__ void rwkv_chunks_of_tile(Frame& F, int l, int tile) {
    const int team = F.tid >> 8, tt = F.tid & 255;
    LAS float* Lt = (LAS float*)(F.lds + RING_OFF) + team * 12288;
    LAS float* XA = Lt; LAS float* XR = Lt + 1040; LAS float* ZB = Lt + 2080; LAS float* ZK = Lt + 3120; LAS float* TB = Lt + 4160; LAS float* TK = Lt + 5200; LAS float* VV = Lt + 6240;
    LAS float* ATl = Lt + 7280; LAS float* U0l = Lt + 8320; LAS float* W1 = Lt + 9360;
    LAS float* Aab = Lt + 10400; LAS float* Aak = Lt + 10672; LAS float* Arb = Lt + 10944; LAS float* Ark = Lt + 11216; LAS float* TT = Lt + 11488;
    const float* RW = WSP(float, WS_RW); const unsigned* RWU = WSP(unsigned, WS_RW); constexpr size_t RS = RW_ONE / 4; unsigned char* RWC = F.ws + WS_RWC;
    float pw_[6], pr_[4], pk_[4], pv_[4], pa_[4], pb_[4], pg_[4];
#define RC_FETCH(P) do { const int h_ = 2 * (P) + team; const size_t cb_ = (size_t)tile * 16 * 1024 + h_ * 64 + (tt & 63); const int q_ = tt >> 6; \
        pw_[4] = RW[RS + cb_ + (size_t)(q_ ? 4 * q_ - 1 : 0) * 1024]; pw_[5] = RW[RS + cb_ + (size_t)15 * 1024];            \
        _Pragma("unroll") for (int e = 0; e < 4; ++e) { const size_t o_ = cb_ + (size_t)(4 * q_ + e) * 1024; pw_[e] = RW[RS + o_]; const unsigned u0 = RWU[o_], u2 = RWU[2 * RS + o_], u3 = RWU[3 * RS + o_]; \
            pr_[e] = bflo(u0); pk_[e] = bfhi(u0); pv_[e] = bflo(u2); pg_[e] = bfhi(u2); pa_[e] = bflo(u3); pb_[e] = bfhi(u3); } } while (0)
    RC_FETCH(0);
#pragma unroll 1
    for (int pair = 0; pair < 8; ++pair) {
        const int uc = ((tile >> 9) * 16 + 2 * pair + team) * 512 + (tile & 511), b = uc >> 13, h = (uc >> 9) & 15, ck = uc & 511; unsigned char* rec = RWC + ((size_t)ck * 32 + (uc >> 9)) * RC_BYTES;     (void)b;
        __syncthreads();
        {
          const int j = tt & 63, q = tt >> 6;
          const float cl = pw_[5], clm = q ? pw_[4] : 0.f; const float clq[4] = {pw_[0], pw_[1], pw_[2], pw_[3]};
#pragma unroll
          for (int e = 0; e < 4; ++e) { const int t = 4 * q + e; const float cprev = e == 0 ? clm : clq[e - 1], cc = clq[e];
              const float rr = pr_[e], kk = pk_[e], vv = pv_[e], aa = pa_[e], bb = pb_[e];
              XA[t * 65 + j] = aa * __expf(cprev); XR[t * 65 + j] = rr * __expf(cc); const float ei = __expf(-cc), ef = __expf(cl - cc);
              ZB[t * 65 + j] = bb * ei; ZK[t * 65 + j] = kk * ei; TB[t * 65 + j] = bb * ef; TK[t * 65 + j] = kk * ef; VV[t * 65 + j] = vv; }
          if (q == 0) ((float*)(rec + RC_P15))[j] = __expf(cl);
          { v2u gw; gw.x = pk2(pg_[0], pg_[1]); gw.y = pk2(pg_[2], pg_[3]); *(v2u*)(rec + RC_GF + (((j >> 4) * 64 + 16 * q + (j & 15)) * 8)) = gw; } }
        RC_FETCH(pair < 7 ? pair + 1 : 7);
        __syncthreads();
        {
          const int q = tt >> 6, n = tt & 15, g = (tt >> 4) & 3; const LAS float* X = (q & 2) ? XR : XA; const LAS float* Z = (q & 1) ? ZK : ZB; LAS float* O = q == 0 ? Aab : (q == 1 ? Aak : (q == 2 ? Arb : Ark));
          f32x4v c = (f32x4v){0.f, 0.f, 0.f, 0.f};
#pragma unroll
          for (int ks = 0; ks < 16; ++ks) c = __builtin_amdgcn_mfma_f32_16x16x4f32(X[n * 65 + 4 * ks + g], Z[n * 65 + 4 * ks + g], c, 0, 0, 0);
#pragma unroll
          for (int rr = 0; rr < 4; ++rr) { const int t = 4 * g + rr; O[t * 17 + n] = ((q & 2) ? n <= t : n < t) ? c[rr] : 0.f; }
          { const int t = tt >> 4, jq = tt & 15; const float* rkp = F.kin[I_RRK] + l * 1024 + h * 64 + 4 * jq; float bn = 0.f;
#pragma unroll
            for (int e = 0; e < 4; ++e) bn += XR[t * 65 + 4 * jq + e] * ZK[t * 65 + 4 * jq + e] * rkp[e];
            bn = sum16(bn); if (jq == 0) ((float*)(rec + RC_BN))[t] = bn; } }
        __syncthreads();
        {
          if (tt < 16) { float col[16];
#pragma unroll
              for (int t = 0; t < 16; ++t) { float acc = (t == tt) ? 1.f : 0.f;
#pragma unroll
                  for (int s = 0; s < 16; ++s) if (s < t) acc += Aab[t * 17 + s] * col[s];
                  col[t] = acc; TT[t * 17 + tt] = acc; } }
          const int q = tt >> 6, n = tt & 15, g = (tt >> 4) & 3; f32x4v c = (f32x4v){0.f, 0.f, 0.f, 0.f};
#pragma unroll
          for (int ks = 0; ks < 4; ++ks) c = __builtin_amdgcn_mfma_f32_16x16x4f32(Aak[n * 17 + 4 * ks + g], VV[(4 * ks + g) * 65 + 16 * q + n], c, 0, 0, 0);
#pragma unroll
          for (int rr = 0; rr < 4; ++rr) W1[(4 * g + rr) * 65 + 16 * q + n] = c[rr]; }
        __syncthreads();
        {
          const int q = tt >> 6, n = tt & 15, g = (tt >> 4) & 3; f32x4v ca = (f32x4v){0.f, 0.f, 0.f, 0.f}, cu = (f32x4v){0.f, 0.f, 0.f, 0.f};
#pragma unroll
          for (int ks = 0; ks < 4; ++ks) { const float tv = TT[n * 17 + 4 * ks + g]; ca = __builtin_amdgcn_mfma_f32_16x16x4f32(tv, XA[(4 * ks + g) * 65 + 16 * q + n], ca, 0, 0, 0); cu = __builtin_amdgcn_mfma_f32_16x16x4f32(tv, W1[(4 * ks + g) * 65 + 16 * q + n], cu, 0, 0, 0); }
#pragma unroll
          for (int rr = 0; rr < 4; ++rr) { ATl[(4 * g + rr) * 65 + 16 * q + n] = ca[rr]; U0l[(4 * g + rr) * 65 + 16 * q + n] = cu[rr]; }
          *(f32x4v*)(rec + RC_U0 + ((q * 64 + 16 * g + n) * 16)) = cu; }
        __syncthreads();
        {
          const int q = tt >> 6, n = tt & 15, g = (tt >> 4) & 3; f32x4v cr, cy = (f32x4v){0.f, 0.f, 0.f, 0.f};
#pragma unroll
          for (int rr = 0; rr < 4; ++rr) cr[rr] = XR[(4 * g + rr) * 65 + 16 * q + n];
#pragma unroll
          for (int ks = 0; ks < 4; ++ks) { const float arb = Arb[n * 17 + 4 * ks + g], ark = Ark[n * 17 + 4 * ks + g];
              cr = __builtin_amdgcn_mfma_f32_16x16x4f32(arb, ATl[(4 * ks + g) * 65 + 16 * q + n], cr, 0, 0, 0);
              cy = __builtin_amdgcn_mfma_f32_16x16x4f32(arb, U0l[(4 * ks + g) * 65 + 16 * q + n], cy, 0, 0, 0);
              cy = __builtin_amdgcn_mfma_f32_16x16x4f32(ark, VV[(4 * ks + g) * 65 + 16 * q + n], cy, 0, 0, 0); }
          *(f32x4v*)(rec + RC_Y0 + ((q * 64 + 16 * g + n) * 16)) = cy;
#pragma unroll
          for (int rr = 0; rr < 4; ++rr) W1[(4 * g + rr) * 65 + 16 * q + n] = cr[rr]; }
        __syncthreads();
        { const int t = tt & 15, jq = tt >> 4, kk = jq >> 3, half = (jq & 7) >> 2, g = jq & 3, j0 = 4 * jq;
          v2u wa, wr; wa.x = pk2(ATl[t * 65 + j0], ATl[t * 65 + j0 + 1]); wa.y = pk2(ATl[t * 65 + j0 + 2], ATl[t * 65 + j0 + 3]); wr.x = pk2(W1[t * 65 + j0], W1[t * 65 + j0 + 1]); wr.y = pk2(W1[t * 65 + j0 + 2], W1[t * 65 + j0 + 3]);
          *(v2u*)(rec + RC_AT + kk * 1024 + (16 * g + t) * 16 + half * 8) = wa; *(v2u*)(rec + RC_RT + kk * 1024 + (16 * g + t) * 16 + half * 8) = wr;
          const int j = tt & 63, gg = tt >> 6; v4u bk; bk.x = pk2(TB[(4 * gg) * 65 + j], TB[(4 * gg + 1) * 65 + j]); bk.y = pk2(TB[(4 * gg + 2) * 65 + j], TB[(4 * gg + 3) * 65 + j]);
          bk.z = pk2(TK[(4 * gg) * 65 + j], TK[(4 * gg + 1) * 65 + j]); bk.w = pk2(TK[(4 * gg + 2) * 65 + j], TK[(4 * gg + 3) * 65 + j]);
          *(v4u*)(rec + RC_BK + (j >> 4) * 1024 + (16 * gg + (j & 15)) * 16) = bk;
          v2u vf; vf.x = pk2(VV[(4 * gg) * 65 + j], VV[(4 * gg + 1) * 65 + j]); vf.y = pk2(VV[(4 * gg + 2) * 65 + j], VV[(4 * gg + 3) * 65 + j]);
          *(v2u*)(rec + RC_VF + ((j >> 4) * 64 + 16 * gg + (j & 15)) * 8) = vf; }
    }
}
#undef RC_FETCH
template <int HACK = 0> __device__ __forceinline__ void rwkv_scan_unit(Frame& F, int l, int b, int h) {
    LAS unsigned char* L = F.lds + RING_OFF;
    const unsigned char* recs = F.ws + WS_RWC + (size_t)(b * 16 + h) * RC_BYTES;
    const int lane = F.lane, n = lane & 15, g = lane >> 4;
    LAS float* XS = (LAS float*)(L + 2 * RC_BYTES);
    if (F.wave >= 2) {
        const int li = F.tid - 128;
        int px[4];
#pragma unroll
        for (int k = 0; k < 4; ++k) { const int x = li + 384 * k; px[k] = x < 1300 ? x : 1299; }
        v4u p0[4], p1[4], p2[4], p3[4], p4[4], p5[4], p6[4], p7[4];
#define RWL_ISSUE(P, CK) do { const int ck_ = (CK) < 512 ? ((HACK & 1) && (CK) >= 4 ? 3 : (CK)) : 511; const v4u* src_ = (const v4u*)(recs + (size_t)ck_ * 32 * RC_BYTES); \
        _Pragma("unroll") for (int k = 0; k < 4; ++k) P[k] = src_[px[k]]; } while (0)
#define RWL_WRITE(P, CK) do { LAS v4u* dst_ = (LAS v4u*)(L + ((CK) & 1) * RC_BYTES); _Pragma("unroll") for (int k = 0; k < 4; ++k) dst_[px[k]] = P[k]; } while (0)
        RWL_ISSUE(p0, 0); RWL_ISSUE(p1, 1); RWL_ISSUE(p2, 2); RWL_ISSUE(p3, 3); RWL_ISSUE(p4, 4); RWL_ISSUE(p5, 5); RWL_ISSUE(p6, 6); RWL_ISSUE(p7, 7);
        RWL_WRITE(p0, 0); RWL_ISSUE(p0, 8);
        LDS_BARRIER();
#pragma unroll 1
        for (int ck = 0; ck < 512; ck += 8) {
            RWL_WRITE(p1, ck + 1); RWL_ISSUE(p1, ck + 9); LDS_BARRIER();
            RWL_WRITE(p2, ck + 2); RWL_ISSUE(p2, ck + 10); LDS_BARRIER();
            RWL_WRITE(p3, ck + 3); RWL_ISSUE(p3, ck + 11); LDS_BARRIER();
            RWL_WRITE(p4, ck + 4); RWL_ISSUE(p4, ck + 12); LDS_BARRIER();
            RWL_WRITE(p5, ck + 5); RWL_ISSUE(p5, ck + 13); LDS_BARRIER();
            RWL_WRITE(p6, ck + 6); RWL_ISSUE(p6, ck + 14); LDS_BARRIER();
            RWL_WRITE(p7, ck + 7); RWL_ISSUE(p7, ck + 15); LDS_BARRIER();
            RWL_WRITE(p0, ck + 8); RWL_ISSUE(p0, ck + 16); LDS_BARRIER();
        }
#undef RWL_ISSUE
#undef RWL_WRITE
        return;
    }
    const int cw = F.wave;
    f32x4v S[4][2];
#pragma unroll
    for (int jt = 0; jt < 4; ++jt)
#pragma unroll
        for (int it = 0; it < 2; ++it) S[jt][it] = (f32x4v){0.f, 0.f, 0.f, 0.f};
    float lnw[2], lnb[2];
#pragma unroll
    for (int it = 0; it < 2; ++it) { lnw[it] = F.kin[I_RLNW][l * 1024 + h * 64 + 16 * (2 * cw + it) + n]; lnb[it] = F.kin[I_RLNB][l * 1024 + h * 64 + 16 * (2 * cw + it) + n]; }
    bf16* MIX = WSP(bf16, WS_MIXED) + ((size_t)b * SEQ) * DM + 2048 + h * 64 + 32 * cw + n;
    f32x4v Yp[2] = {(f32x4v){0.f, 0.f, 0.f, 0.f}, (f32x4v){0.f, 0.f, 0.f, 0.f}}, bnp = (f32x4v){0.f, 0.f, 0.f, 0.f}; v2u gfp[2] = {(v2u){0u, 0u}, (v2u){0u, 0u}}, vfp[2] = {(v2u){0u, 0u}, (v2u){0u, 0u}};
    LDS_BARRIER();
#pragma unroll 1
    for (int ck = 0; ck <= 512; ++ck) {
        if (ck > 0) {
            const LAS float* xs = XS + ((ck - 1) & 1) * 64; const f32x4v a0 = *(const LAS f32x4v*)(xs + 8 * g), a1 = *(const LAS f32x4v*)(xs + 8 * g + 4), b0 = *(const LAS f32x4v*)(xs + 32 + 8 * g), b1 = *(const LAS f32x4v*)(xs + 32 + 8 * g + 4);
            const float s1[4] = {a0[0] + b0[0], a0[2] + b0[2], a1[0] + b1[0], a1[2] + b1[2]}, s2[4] = {a0[1] + b0[1], a0[3] + b0[3], a1[1] + b1[1], a1[3] + b1[3]};
#pragma unroll
            for (int it = 0; it < 2; ++it) { const float gt[4] = {bflo(gfp[it].x), bfhi(gfp[it].x), bflo(gfp[it].y), bfhi(gfp[it].y)}, vt[4] = {bflo(vfp[it].x), bfhi(vfp[it].x), bflo(vfp[it].y), bfhi(vfp[it].y)};
#pragma unroll
                for (int r = 0; r < 4; ++r) { const float mean = s1[r] * (1.0f / 64.0f), var = fmaxf(s2[r] * (1.0f / 64.0f) - mean * mean, 0.f), rstd = rsqrtf(var + 64e-5f);
                    if (!(HACK & 2)) MIX[(size_t)((ck - 1) * 16 + 4 * g + r) * DM + 16 * it] = (bf16)f2bf(((Yp[it][r] - mean) * rstd * lnw[it] + lnb[it] + bnp[r] * vt[r]) * gt[r]); } }
            if (ck == 512) break;
        }
        if (HACK & 4) { LDS_BARRIER(); continue; }
        const LAS unsigned char* R = L + (ck & 1) * RC_BYTES;
        bf16x8 at[2], rt[2];
#pragma unroll
        for (int kk = 0; kk < 2; ++kk) { at[kk] = *(const LAS bf16x8*)(R + RC_AT + kk * 1024 + lane * 16); rt[kk] = *(const LAS bf16x8*)(R + RC_RT + kk * 1024 + lane * 16); }
        f32x4v U[2], Y[2];
#pragma unroll
        for (int it = 0; it < 2; ++it) { U[it] = *(const LAS f32x4v*)(R + RC_U0 + (2 * cw + it) * 1024 + lane * 16); Y[it] = *(const LAS f32x4v*)(R + RC_Y0 + (2 * cw + it) * 1024 + lane * 16); }
#pragma unroll
        for (int kk = 0; kk < 2; ++kk)
#pragma unroll
            for (int it = 0; it < 2; ++it) { v4u pw; pw.x = pg8::cvt_pk_bf16(S[2 * kk][it][0], S[2 * kk][it][1]); pw.y = pg8::cvt_pk_bf16(S[2 * kk][it][2], S[2 * kk][it][3]);
                pw.z = pg8::cvt_pk_bf16(S[2 * kk + 1][it][0], S[2 * kk + 1][it][1]); pw.w = pg8::cvt_pk_bf16(S[2 * kk + 1][it][2], S[2 * kk + 1][it][3]); const bf16x8 sf = __builtin_bit_cast(bf16x8, pw);
                U[it] = __builtin_amdgcn_mfma_f32_16x16x32_bf16(at[kk], sf, U[it], 0, 0, 0); Y[it] = __builtin_amdgcn_mfma_f32_16x16x32_bf16(rt[kk], sf, Y[it], 0, 0, 0); }
        bf16x8 uv[2];
#pragma unroll
        for (int it = 0; it < 2; ++it) { vfp[it] = *(const LAS v2u*)(R + RC_VF + (2 * cw + it) * 512 + lane * 8); gfp[it] = *(const LAS v2u*)(R + RC_GF + (2 * cw + it) * 512 + lane * 8);
            v4u pw; pw.x = pg8::cvt_pk_bf16(U[it][0], U[it][1]); pw.y = pg8::cvt_pk_bf16(U[it][2], U[it][3]); pw.z = vfp[it].x; pw.w = vfp[it].y; uv[it] = __builtin_bit_cast(bf16x8, pw); }
#pragma unroll
        for (int jt = 0; jt < 4; ++jt) { const bf16x8 bk = *(const LAS bf16x8*)(R + RC_BK + jt * 1024 + lane * 16); const f32x4v p15 = *(const LAS f32x4v*)(R + RC_P15 + (16 * jt + 4 * g) * 4);
#pragma unroll
            for (int it = 0; it < 2; ++it) S[jt][it] = __builtin_amdgcn_mfma_f32_16x16x32_bf16(bk, uv[it], S[jt][it] * p15, 0, 0, 0); }
        bnp = *(const LAS f32x4v*)(R + RC_BN + 16 * g); Yp[0] = Y[0]; Yp[1] = Y[1];
        { LAS float* xo = XS + (ck & 1) * 64 + cw * 32; const f32x4v sm = Y[0] + Y[1], sq = Y[0] * Y[0] + Y[1] * Y[1];
#pragma unroll
          for (int r = 0; r < 4; ++r) { const float a = sum16(sm[r]), q = sum16(sq[r]); if (n == 0) { xo[(4 * g + r) * 2] = a; xo[(4 * g + r) * 2 + 1] = q; } } }
        LDS_BARRIER();
    }
}
template <int HACK = 0> __device__ __forceinline__ void mixers_v4(Frame& F, int l, int qi, int mask = 15) {
    gu32* ctr = F.ctl + CW_Q + 64 * qi;
    for (;;) {
        const int it = next_item(F, ctr); relaunder(F); relaunder_tid(F);
        if (it < 32) { if (mask & 1) rwkv_scan_unit<HACK>(F, l, it >> 4, it & 15); }
        else if (it < 48) { const int j = it - 32; if (mask & 2) gla_scan_unit<HACK>(F, l, j >> 3, (j >> 1) & 3, j & 1); }
        else if (it < 48 + 1024) { const int j = it - 48, qb = 63 - (j >> 4), bh = j & 15; if (mask & 4) attn_unit<true>(F, l, bh >> 3, bh & 7, qb); }
        else if (it < 48 + 2048) { const int j = it - 1072, qb = j & 63, bh = j >> 6; if (mask & 8) attn_unit<false>(F, l, bh >> 3, bh & 7, qb); }
        else break;
    }
}
template <int HACK = 0> __device__ __forceinline__ void prep_rwkv(Frame& F, int l) {
    LAS float* zl = (LAS float*)(F.lds + RING_OFF) + 4096;
    LAS bf16* inb = (LAS bf16*)(F.lds + RING_OFF);
    const float* mu = F.kin[I_RMU] + (size_t)l * 3264;
    const float* LOWR = WSP(float, WS_LOWR); const bf16* COLS = WSP(bf16, WS_COLS);
    float* RW = WSP(float, WS_RW); unsigned* RWU = WSP(unsigned, WS_RW); float* VF = WSP(float, WS_VFIRST);
    constexpr size_t RS = RW_ONE / 4;
    for (int tile = F.bx; tile < M / 16; tile += F.G) {
        const int row0 = tile * 16;
        relaunder(F); relaunder_tid(F);
        __syncthreads();
        for (int idx = F.tid; idx < 16 * 224; idx += NWAVES * 64) { const int tt = idx / 224, j = idx % 224, row = row0 + tt, t = row & (SEQ - 1);
            const int col = j < 192 ? 16 + j : 208 + (j - 192);
            const float cur = LOWR[(size_t)row * 256 + col], prev = t > 0 ? LOWR[(size_t)(row - 1) * 256 + col] : 0.f;
            const float muv = j < 192 ? mu[3072 + j] : (l ? F.kin[I_VRMU][(l - 1) * 32 + (j - 192)] : 0.f);
            float x = cur + (prev - cur) * muv;
            if (j < 64) x = tanhf(x); else if (j >= 128 && j < 192) x = sigmoid_f(x);
            inb[tt * 232 + j] = (bf16)f2bf(x); }
        __syncthreads();
        {
            const int c = 2 * F.tid;
            float accw[2][16], acca[2][16], accg[2][16], accv[2][16];
#pragma unroll
            for (int e = 0; e < 2; ++e) { const float bw = F.kin[I_RW0][l * 1024 + c + e], ba = F.kin[I_RA0][l * 1024 + c + e], bv = l ? F.kin[I_VR0][(l - 1) * 1024 + c + e] : 0.f;
#pragma unroll
              for (int tt = 0; tt < 16; ++tt) { accw[e][tt] = bw; acca[e][tt] = ba; accg[e][tt] = 0.f; accv[e][tt] = bv; } }
#define LOWRANK_MFMA(ACC, MI, JOFF, NKS) do { const bf16* wf_ = WSP(bf16, WS_WF) + ((size_t)(l * 448 + ((MI) < 3 ? (MI) * 128 + 16 * (NKS) / 2 * F.wave : 384 + 8 * F.wave)) * 64 + F.lane) * 8; \
            bf16x8 af_[NKS], bf_[8][NKS]; \
            _Pragma("unroll") for (int ks = 0; ks < (NKS); ++ks) af_[ks] = *(const LAS bf16x8*)(inb + (F.lane & 15) * 232 + (JOFF) + 32 * ks + 8 * (F.lane >> 4)); \
            _Pragma("unroll") for (int nt = 0; nt < 8; ++nt) _Pragma("unroll") for (int ks = 0; ks < (NKS); ++ks) bf_[nt][ks] = *(const bf16x8*)(wf_ + (size_t)(nt * (NKS) + ks) * 512); \
            _Pragma("unroll") for (int nt = 0; nt < 8; ++nt) { f32x4 c4 = {0.f, 0.f, 0.f, 0.f}; \
                _Pragma("unroll") for (int ks = 0; ks < (NKS); ++ks) c4 = __builtin_amdgcn_mfma_f32_16x16x32_bf16(af_[ks], bf_[nt][ks], c4, 0, 0, 0); \
                _Pragma("unroll") for (int rr = 0; rr < 4; ++rr) zl[(4 * (F.lane >> 4) + rr) * 1028 + 128 * F.wave + 16 * nt + (F.lane & 15)] = c4[rr]; } \
            __syncthreads(); \
            _Pragma("unroll") for (int tt = 0; tt < 16; ++tt) { const f32x2_t z2 = *(const LAS f32x2_t*)(zl + tt * 1028 + c); ACC[0][tt] += z2.x; ACC[1][tt] += z2.y; } \
            __syncthreads(); } while (0)
            if (!(HACK & 1)) { LOWRANK_MFMA(accw, 0, 0, 2); relaunder(F);
            LOWRANK_MFMA(acca, 1, 64, 2); relaunder(F);
            LOWRANK_MFMA(accg, 2, 128, 2); relaunder(F);
            if (l) LOWRANK_MFMA(accv, 3, 192, 1); }
#undef LOWRANK_MFMA
            relaunder(F);
            float mur[2], muk[2], muv[2], kkv[2], kav[2], pr[2] = {0.f, 0.f}, pk[2] = {0.f, 0.f}, pv[2] = {0.f, 0.f}; float cl[2] = {0.f, 0.f};
#pragma unroll
            for (int e = 0; e < 2; ++e) { mur[e] = F.kin[I_RMU][l * 3264 + c + e]; muk[e] = F.kin[I_RMU][l * 3264 + 1024 + c + e]; muv[e] = F.kin[I_RMU][l * 3264 + 2048 + c + e]; kkv[e] = F.kin[I_RKK][l * 1024 + c + e]; kav[e] = F.kin[I_RKA][l * 1024 + c + e]; }
            if ((row0 & (SEQ - 1)) != 0) { const bf16* p = COLS + (size_t)(row0 - 1) * NMAIN + c; const unsigned ur = *(const unsigned*)(p + CC_R), uk = *(const unsigned*)(p + CC_K), uv = *(const unsigned*)(p + CC_V);
                pr[0] = bflo(ur); pr[1] = bfhi(ur); pk[0] = bflo(uk); pk[1] = bfhi(uk); pv[0] = bflo(uv); pv[1] = bfhi(uv); }
            constexpr int PFD = 4;
            unsigned pur[16], puk[16], puv[16]; f32x2_t pvf[16];
#define PF_TOK(T) do { const bf16* p_ = COLS + (size_t)(row0 + (T)) * NMAIN + c; pur[T] = *(const unsigned*)(p_ + CC_R); puk[T] = *(const unsigned*)(p_ + CC_K); puv[T] = *(const unsigned*)(p_ + CC_V); \
                pvf[T] = *(const f32x2_t*)(VF + (size_t)(row0 + (T)) * 1024 + c); } while (0)
#pragma unroll
            for (int tt = 0; tt < PFD; ++tt) PF_TOK(tt);
            asm volatile("" ::: "memory");
            if (!(HACK & 4))
#pragma unroll
            for (int tt = 0; tt < 16; ++tt) { const int row = row0 + tt; const size_t o = (size_t)row * 1024 + c;
                if (tt + PFD < 16) { PF_TOK(tt + PFD < 16 ? tt + PFD : 15); }
                asm volatile("" ::: "memory");
                const unsigned ur = pur[tt], uk = puk[tt], uv = puv[tt];
                const float cr[2] = {bflo(ur), bfhi(ur)}, ck[2] = {bflo(uk), bfhi(uk)}, cv[2] = {bflo(uv), bfhi(uv)};
                f32x2_t vf2 = pvf[tt];
                float r[2], k[2], v[2], dec[2], av[2], kk[2], km[2];
#pragma unroll
                for (int e = 0; e < 2; ++e) { r[e] = cr[e] + (pr[e] - cr[e]) * mur[e]; k[e] = ck[e] + (pk[e] - ck[e]) * muk[e]; v[e] = cv[e] + (pv[e] - cv[e]) * muv[e]; pr[e] = cr[e]; pk[e] = ck[e]; pv[e] = cv[e];
                    if (l == 0) vf2[e] = v[e]; else { const float vg = sigmoid_f(accv[e][tt]); v[e] = v[e] + (vf2[e] - v[e]) * vg; }
                    cl[e] += -0.6065306597126334f * sigmoid_f(accw[e][tt]); dec[e] = cl[e]; av[e] = sigmoid_f(acca[e][tt]); kk[e] = k[e] * kkv[e]; km[e] = k[e] * (1.0f + (av[e] - 1.0f) * kav[e]); }
                const float ss = sum32(kk[0] * kk[0] + kk[1] * kk[1]), rn = rsqrtf(fmaxf(ss, 1e-24f)); kk[0] *= rn; kk[1] *= rn;
                if (l == 0) *(f32x2_t*)(VF + o) = vf2;
                *(f32x2_t*)(RW + RS + o) = (f32x2_t){dec[0], dec[1]};
                *(v2u*)(RWU + o) = (v2u){pk2(r[0], km[0]), pk2(r[1], km[1])}; *(v2u*)(RWU + 2 * RS + o) = (v2u){pk2(v[0], accg[0][tt]), pk2(v[1], accg[1][tt])};
                *(v2u*)(RWU + 3 * RS + o) = (v2u){pk2(-kk[0], kk[0] * av[0]), pk2(-kk[1], kk[1] * av[1])}; }
#undef PF_TOK
        }
        asm volatile("s_waitcnt vmcnt(0)" ::: "memory"); __syncthreads();
        __builtin_amdgcn_fence(__ATOMIC_ACQUIRE, "agent"); asm volatile("s_waitcnt vmcnt(0)" ::: "memory");
        if (!(HACK & 2)) rwkv_chunks_of_tile(F, l, tile);
    }
}
struct Args { const float* in[35]; float* out; unsigned char* ws; };
__device__ __forceinline__ void mk_frame(Frame& F, int wv) {
    extern __shared__ __attribute__((aligned(16))) unsigned char lds[];
    kargp kp = (kargp)__builtin_amdgcn_kernarg_segment_ptr(); asm volatile("" : "+s"(kp));
    F.kin = kp;
    F.lds = (LAS unsigned char*)lds;
    F.MISC = (volatile LAS unsigned*)(F.lds + MISC_OFF);
    { int w_ = wv; asm volatile("" : "+s"(w_)); int t_ = (int)__builtin_amdgcn_mbcnt_hi(~0u, __builtin_amdgcn_mbcnt_lo(~0u, (unsigned)w_ * 64u)); asm volatile("" : "+v"(t_)); F.tid = t_; } F.lane = F.tid & 63; F.wave = __builtin_amdgcn_readfirstlane(F.tid >> 6);
    F.G = gridDim.x; { int bx = blockIdx.x; asm volatile("" : "+s"(bx)); F.bx = bx; F.vcu = (F.G % 8 == 0) ? (bx % 8) * (F.G / 8) + bx / 8 : bx; }
    F.out = (float*)kp[35]; F.ws = (unsigned char*)kp[36]; F.ctl = (gu32*)(F.ws + WS_CTL);
}
__device__ __forceinline__ void grid_bar(int wv) {
    Frame F; mk_frame(F, wv);
    XcdBarrier bar; bar.bar = (unsigned*)(F.ctl + CW_BAR); bar.x = xb_xcc_id(); bar.st = F.MISC + 8;
    xcd_barrier(bar);
}
__global__ void __launch_bounds__(NWAVES * 64, 2) mega_fwd(Args args) {
    const int wv = __builtin_amdgcn_readfirstlane((int)threadIdx.x >> 6);
    { Frame F; mk_frame(F, wv);
      for (int u = F.tid; u < (LDS_BYTES - LDSCTL_OFF) / 4; u += NWAVES * 64) ((LAS unsigned*)(F.lds + LDSCTL_OFF))[u] = 0u;
      __syncthreads();
      (void)xcd_barrier_post((unsigned*)(F.ctl + CW_BAR), F.MISC + 8);
      p0_prologue_a(F);
    }
    grid_bar(wv);
    { Frame F; mk_frame(F, wv); p0_prologue_b(F); }
    grid_bar(wv);
#pragma unroll 1
    for (int l = 0; l < NLAYER; ++l) {
#define LAYER_VARS const float* mod = WSP(float, WS_MOD) + (size_t)l * 2 * 24576; const float* xin = l == 0 ? F.kin[I_X] : F.out; (void)mod; (void)xin
        { Frame F; mk_frame(F, wv); LAYER_VARS; if (l == 0) rms_phase(F, F.kin[I_X], mod + 0, mod + 4096); else rms_phase_bf(F, mod + 0, mod + 4096); }
        grid_bar(wv);
        { Frame F; mk_frame(F, wv);
          pg8::Gemm g{WSP(pg8::bf16_t, WS_XN), WSP(pg8::bf16_t, WS_WIN + l * WIN_L), M, NIN, DM}; pg8::StaticOrder S; S.init(M, NIN, F.G, F.bx);
          pg8::EpiCols E{WSP(pg8::bf16_t, WS_COLS), WSP(float, WS_LOWR)};
          pg8::gemm_phase<pg8::EpiCols, pg8::StaticOrder, true, true>(F.lds + RING_OFF, g, S, E, F.tid); }
        grid_bar(wv);
        { Frame F; mk_frame(F, wv); prep_norm(F, l); }
        { Frame F; mk_frame(F, wv); prep_loga(F, l); }
        { Frame F; mk_frame(F, wv); prep_rwkv(F, l); }
        { Frame F; mk_frame(F, wv); prep_vt(F, 0); }
        { Frame F; mk_frame(F, wv); prep_vt(F, 1); }
        { Frame F; mk_frame(F, wv); prep_vt(F, 2); }
        { Frame F; mk_frame(F, wv); prep_vt(F, 3); }
        { Frame F; mk_frame(F, wv); prep_vt(F, 4); }
        { Frame F; mk_frame(F, wv); prep_gla(F); }
        grid_bar(wv);
        { Frame F; mk_frame(F, wv); mixers_v4(F, l, l); }
        grid_bar(wv);
        { Frame F; mk_frame(F, wv); gla_post(F, l); }
        grid_bar(wv);
        { Frame F; mk_frame(F, wv); LAYER_VARS;
          pg8::Gemm g{WSP(pg8::bf16_t, WS_MIXED), WSP(pg8::bf16_t, WS_WOUT + l * WOUT_L), M, DM, DM}; pg8::StaticOrder S; S.init(M, DM, F.G, F.bx);
          pg8::EpiRes E{l == 0 ? (const void*)F.kin[I_X] : (const void*)WSP(bf16, WS_XR), (void*)WSP(bf16, WS_XR), mod + 2 * 4096, l != 0, true};
          pg8::gemm_phase<pg8::EpiRes, pg8::StaticOrder, true, true>(F.lds + RING_OFF, g, S, E, F.tid); }
        grid_bar(wv);
        { Frame F; mk_frame(F, wv); LAYER_VARS; rms_phase_bf(F, mod + 3 * 4096, mod + 4 * 4096); }
        grid_bar(wv);
        { Frame F; mk_frame(F, wv);
          pg8::Gemm g{WSP(pg8::bf16_t, WS_XN), WSP(pg8::bf16_t, WS_W13 + l * W13_L), M, 2 * DFF, DM}; pg8::StaticOrder S; S.init(M, 2 * DFF, F.G, F.bx);
          pg8::EpiSwiglu E{WSP(pg8::bf16_t, WS_HID)};
          pg8::gemm_phase<pg8::EpiSwiglu, pg8::StaticOrder, true, true>(F.lds + RING_OFF, g, S, E, F.tid); }
        grid_bar(wv);
        { Frame F; mk_frame(F, wv); LAYER_VARS;
          pg8::Gemm g{WSP(pg8::bf16_t, WS_HID), WSP(pg8::bf16_t, WS_W2 + l * W2_L), M, DM, DFF}; pg8::StaticOrder S; S.init(M, DM, F.G, F.bx);
          pg8::EpiRes E{(const void*)WSP(bf16, WS_XR), l + 1 < NLAYER ? (void*)WSP(bf16, WS_XR) : (void*)F.out, mod + 5 * 4096, true, l + 1 < NLAYER};
          pg8::gemm_phase<pg8::EpiRes, pg8::StaticOrder, true, true>(F.lds + RING_OFF, g, S, E, F.tid); }
        if (l + 1 < NLAYER) grid_bar(wv);
#undef LAYER_VARS
    }
}

extern "C" void kernel_launch(void* const* d_in, const int* in_sizes, int n_in, void* d_out, int out_size, void* d_ws, size_t ws_size, hipStream_t stream) {
    static int grid = 0;
    if (grid == 0) {
        if (n_in != 35 || in_sizes[0] != M * DM || out_size != M * DM || ws_size < WS_END) { fprintf(stderr, "kernel_launch: unexpected shapes: n_in %d in0 %d out %d ws %zu (need %zu)\n", n_in, n_in > 0 ? in_sizes[0] : -1, out_size, ws_size, (size_t)WS_END); grid = -1; return; }
        int dev = 0, cus = 0, per_cu = 0;
        if (hipGetDevice(&dev) != hipSuccess || hipDeviceGetAttribute(&cus, hipDeviceAttributeMultiprocessorCount, dev) != hipSuccess) { grid = -1; return; }
        if (hipFuncSetAttribute((const void*)mega_fwd, hipFuncAttributeMaxDynamicSharedMemorySize, LDS_BYTES) != hipSuccess) { fprintf(stderr, "kernel_launch: hipFuncSetAttribute failed\n"); grid = -1; return; }
        if (hipOccupancyMaxActiveBlocksPerMultiprocessor(&per_cu, (const void*)mega_fwd, NWAVES * 64, LDS_BYTES) != hipSuccess || per_cu < 1) fprintf(stderr, "kernel_launch: occupancy query says %d\n", per_cu);
        (void)hipGetLastError();
        grid = cus;
    }
    if (grid < 0) return;
    if (hipMemsetAsync((char*)d_ws + WS_CTL, 0, CTL_ZERO_BYTES, stream) != hipSuccess) return;
    Args a{};
    for (int i = 0; i < 35; ++i) a.in[i] = (const float*)d_in[i];
    a.out = (float*)d_out; a.ws = (unsigned char*)d_ws;
    hipLaunchKernelGGL(mega_fwd, dim3(grid), dim3(NWAVES * 64), LDS_BYTES, stream, a);
}
```

```cpp
#include <hip/hip_runtime.h>
#include <cstdio>
#include <cstdint>
namespace pg8 {
#define PG8_LAS __attribute__((address_space(3)))
typedef unsigned short bf16_t;
typedef short bf16x8 __attribute__((ext_vector_type(8)));
typedef float f32x4 __attribute__((ext_vector_type(4)));
typedef unsigned u32x4 __attribute__((ext_vector_type(4)));
constexpr int BM = 256, BK = 64, HALF = 128, HTB = HALF * BK * 2  , STAGE_BYTES = 8 * HTB, NXCD = 8, WGM = 8;

__host__ __device__ __forceinline__ int lds_byte(int r, int c) { const int st = (r >> 4) * 2 + (c >> 5), rr = r & 15, cc = c & 31, ob = rr * 64 + cc * 2; return st * 1024 + (ob ^ (((ob >> 9) & 1) << 5)); }
__host__ __device__ __forceinline__ void stage_rc(int b, int& R, int& C) { const int st = b / 1024, sb = b % 1024, swz = sb ^ (((sb >> 9) & 1) << 5); R = (st >> 1) * 16 + swz / 64; C = (st & 1) * 32 + (swz % 64) / 2; }
__host__ __device__ __forceinline__ int perm32(int rho) { const int n = rho >> 4, i = rho & 15; return 8 * (i >> 2) + 4 * n + (i & 3); }

struct Unit { int pm, pn; };
struct Gemm { const bf16_t* A; const bf16_t* Bt; int M, N, K; };

struct StaticOrder {
    int nM, nN, nwg, G, c;
    __host__ __device__ void init(int M, int N, int G_, int c_) { nM = M / BM; nN = N / BM; nwg = nM * nN; G = G_; c = c_; }
    __host__ __device__ bool next(int i, Unit& u) const {
        const long L = (long)i * G + c; if (L >= nwg) return false;
        int wgid = (int)L; { const int q = nwg / NXCD, r = nwg % NXCD, xcd = wgid % NXCD, off = wgid / NXCD; wgid = (xcd < r ? xcd * (q + 1) : r * (q + 1) + (xcd - r) * q) + off; }
        const int nig = WGM * nN, gid = wgid / nig, fm = gid * WGM, gsz = (nM - fm) < WGM ? (nM - fm) : WGM;
        u.pm = fm + ((wgid % nig) % gsz); u.pn = (wgid % nig) / gsz; return true;
    }
    __device__ __forceinline__ void a_ready(const Unit&) const {}
    __device__ __forceinline__ void done(const Unit&) const {}
};

typedef float f32x2c_t __attribute__((ext_vector_type(2))); typedef __bf16 bf16x2c_t __attribute__((ext_vector_type(2)));
__device__ __forceinline__ unsigned cvt_pk_bf16(float lo, float hi) { const f32x2c_t v = {lo, hi}; return __builtin_bit_cast(unsigned, __builtin_convertvector(v, bf16x2c_t)); }
typedef float f32x2 __attribute__((ext_vector_type(2)));
__device__ __forceinline__ float silu_f(float x) { return x * __builtin_amdgcn_rcpf(1.0f + __builtin_amdgcn_exp2f(-1.4426950408889634f * x)); }
struct EpiCols {
    static constexpr bool PERM = true, AFTER_DRAIN = false;
    bf16_t* O; float* L;
    __device__ __forceinline__ void operator()(const f32x4 (&acc)[2][2][4][2], const Unit& u, int wr, int wc, int fr, int fq) const {
        const int row0 = u.pm * BM + wr * 64 + fr;
        if (u.pn < 41) {
            const int col0 = u.pn * BM + wc * 32 + 8 * fq;
#pragma unroll
            for (int ai = 0; ai < 2; ++ai)
#pragma unroll
                for (int m = 0; m < 4; ++m) { bf16_t* rowp = O + (size_t)(row0 + ai * HALF + m * 16) * 10496 + col0;
#pragma unroll
                    for (int bj = 0; bj < 2; ++bj) { const f32x4 v0 = acc[ai][bj][m][0], v1 = acc[ai][bj][m][1];
                        u32x4 w; w.x = cvt_pk_bf16(v0[0], v0[1]); w.y = cvt_pk_bf16(v0[2], v0[3]); w.z = cvt_pk_bf16(v1[0], v1[1]); w.w = cvt_pk_bf16(v1[2], v1[3]);
                        *(u32x4*)(rowp + bj * HALF) = w; } }
        } else {
            const int col0 = wc * 32 + 8 * fq;
#pragma unroll
            for (int ai = 0; ai < 2; ++ai)
#pragma unroll
                for (int m = 0; m < 4; ++m) { float* rowp = L + (size_t)(row0 + ai * HALF + m * 16) * 256 + col0;
#pragma unroll
                    for (int bj = 0; bj < 2; ++bj) { *(f32x4*)(rowp + bj * HALF) = acc[ai][bj][m][0]; *(f32x4*)(rowp + bj * HALF + 4) = acc[ai][bj][m][1]; } }
        }
    }
};
struct EpiRes {
    static constexpr bool PERM = true, AFTER_DRAIN = false;
    const void* base; void* out; const float* gate; bool base_bf, out_bf;
    __device__ __forceinline__ void operator()(const f32x4 (&acc)[2][2][4][2], const Unit& u, int wr, int wc, int fr, int fq) const {
        const int row0 = u.pm * BM + wr * 64 + fr, col0 = u.pn * BM + wc * 32 + 8 * fq;
        const float* gp = gate + (size_t)(u.pm >> 5) * 24576 + col0;
        f32x4 gv[2][2];
#pragma unroll
        for (int bj = 0; bj < 2; ++bj)
#pragma unroll
            for (int n = 0; n < 2; ++n) gv[bj][n] = *(const f32x4*)(gp + bj * HALF + n * 4);
#pragma unroll
        for (int ai = 0; ai < 2; ++ai) {
            f32x4 r[4][2][2];
            if (base_bf) {
#pragma unroll
                for (int m = 0; m < 4; ++m)
#pragma unroll
                    for (int bj = 0; bj < 2; ++bj) { const u32x4 w = *(const u32x4*)((const bf16_t*)base + (size_t)(row0 + ai * HALF + m * 16) * 4096 + col0 + bj * HALF);
                        r[m][bj][0] = (f32x4){__builtin_bit_cast(float, w.x << 16), __builtin_bit_cast(float, w.x & 0xffff0000u), __builtin_bit_cast(float, w.y << 16), __builtin_bit_cast(float, w.y & 0xffff0000u)};
                        r[m][bj][1] = (f32x4){__builtin_bit_cast(float, w.z << 16), __builtin_bit_cast(float, w.z & 0xffff0000u), __builtin_bit_cast(float, w.w << 16), __builtin_bit_cast(float, w.w & 0xffff0000u)}; }
            } else {
#pragma unroll
                for (int m = 0; m < 4; ++m)
#pragma unroll
                    for (int bj = 0; bj < 2; ++bj)
#pragma unroll
                        for (int n = 0; n < 2; ++n) r[m][bj][n] = *(const f32x4*)((const float*)base + (size_t)(row0 + ai * HALF + m * 16) * 4096 + col0 + bj * HALF + n * 4);
            }
#pragma unroll
            for (int m = 0; m < 4; ++m)
#pragma unroll
                for (int bj = 0; bj < 2; ++bj)
#pragma unroll
                    for (int n = 0; n < 2; ++n) r[m][bj][n] = r[m][bj][n] + gv[bj][n] * acc[ai][bj][m][n];
            if (out_bf) {
#pragma unroll
                for (int m = 0; m < 4; ++m)
#pragma unroll
                    for (int bj = 0; bj < 2; ++bj) { const f32x4 v0 = r[m][bj][0], v1 = r[m][bj][1];
                        u32x4 w; w.x = cvt_pk_bf16(v0[0], v0[1]); w.y = cvt_pk_bf16(v0[2], v0[3]); w.z = cvt_pk_bf16(v1[0], v1[1]); w.w = cvt_pk_bf16(v1[2], v1[3]);
                        *(u32x4*)((bf16_t*)out + (size_t)(row0 + ai * HALF + m * 16) * 4096 + col0 + bj * HALF) = w; }
            } else {
#pragma unroll
                for (int m = 0; m < 4; ++m)
#pragma unroll
                    for (int bj = 0; bj < 2; ++bj)
#pragma unroll
                        for (int n = 0; n < 2; ++n) *(f32x4*)((float*)out + (size_t)(row0 + ai * HALF + m * 16) * 4096 + col0 + bj * HALF + n * 4) = r[m][bj][n];
            }
            asm volatile("" ::: "memory");
        }
    }
};
struct EpiSwiglu {
    static constexpr bool PERM = true, AFTER_DRAIN = false;
    bf16_t* H;
    __device__ __forceinline__ void operator()(const f32x4 (&acc)[2][2][4][2], const Unit& u, int wr, int wc, int fr, int fq) const {
        const int row0 = u.pm * BM + wr * 64 + fr, col0 = u.pn * HALF + wc * 32 + 8 * fq;
#pragma unroll
        for (int ai = 0; ai < 2; ++ai)
#pragma unroll
            for (int m = 0; m < 4; ++m) { bf16_t* rowp = H + (size_t)(row0 + ai * HALF + m * 16) * 11008 + col0;
                const f32x4 a0 = acc[ai][0][m][0], a1 = acc[ai][0][m][1], b0 = acc[ai][1][m][0], b1 = acc[ai][1][m][1];
                u32x4 w; w.x = cvt_pk_bf16(silu_f(a0[0]) * b0[0], silu_f(a0[1]) * b0[1]); w.y = cvt_pk_bf16(silu_f(a0[2]) * b0[2], silu_f(a0[3]) * b0[3]);
                w.z = cvt_pk_bf16(silu_f(a1[0]) * b1[0], silu_f(a1[1]) * b1[1]); w.w = cvt_pk_bf16(silu_f(a1[2]) * b1[2], silu_f(a1[3]) * b1[3]);
                *(u32x4*)rowp = w; }
    }
};
template <class Epi, class Sched, bool ALIGN_EPI = false, bool SP2 = false>
__device__ __forceinline__ void gemm_phase(PG8_LAS unsigned char* lds, const Gemm g, const Sched& S, const Epi& E, int tid_in) {
    int tid_ = tid_in; asm volatile("" : "+v"(tid_));
    const int tid = tid_, wid = __builtin_amdgcn_readfirstlane(tid >> 6), lane = tid & 63, wr = wid >> 2, wc = wid & 3, fr = lane & 15, fq = lane >> 4;
    const int K = g.K, nt = K / BK;
    unsigned voffA[2], voffB[2];
#pragma unroll
    for (int i = 0; i < 2; ++i) { int R, C; stage_rc(tid * 16 + i * 8192, R, C); const int Rb = Epi::PERM ? ((R & ~31) + perm32(R & 31)) : R;
        voffA[i] = (unsigned)(R * K + C) * 2u; voffB[i] = (unsigned)(Rb * K + C) * 2u; }
    const size_t kstep = (size_t)(BK * 2);
    const size_t hstep = (size_t)HALF * K * 2;
    const size_t tstep = 2 * hstep;
    const unsigned ldsw = (unsigned)wid * 1024u;
    const int aoff = lds_byte(wr * 64 + fr, fq * 8), boff = lds_byte(wc * 32 + fr, fq * 8);
#define PG8_SA(b, h) (((b) * 2 + (h)) * HTB)
#define PG8_SB(b, h) ((4 + (b) * 2 + (h)) * HTB)
#define PG8_STAGE(bufoff, gbase, voff) do { _Pragma("unroll") for (int _i = 0; _i < 2; ++_i) \
        __builtin_amdgcn_global_load_lds((const unsigned*)((const char*)(gbase) + (voff)[_i]), (PG8_LAS unsigned*)(lds + (bufoff) + ldsw + _i * 8192), 16, 0, 0); } while (0)
#define PG8_LDA(dst, b, h) do { _Pragma("unroll") for (int m = 0; m < 4; ++m) _Pragma("unroll") for (int k = 0; k < 2; ++k) dst[m][k] = *(const PG8_LAS bf16x8*)(lds + PG8_SA(b, h) + aoff + m * 2048 + k * 1024); } while (0)
#define PG8_LDB(dst, b, h) do { _Pragma("unroll") for (int n = 0; n < 2; ++n) _Pragma("unroll") for (int k = 0; k < 2; ++k) dst[n][k] = *(const PG8_LAS bf16x8*)(lds + PG8_SB(b, h) + boff + n * 2048 + k * 1024); } while (0)
#define PG8_MMA(ai, bj, At, Bt) do { __builtin_amdgcn_s_setprio(1); _Pragma("unroll") for (int m = 0; m < 4; ++m) _Pragma("unroll") for (int n = 0; n < 2; ++n) _Pragma("unroll") for (int k = 0; k < 2; ++k) \
        acc[ai][bj][m][n] = __builtin_amdgcn_mfma_f32_16x16x32_bf16(Bt[n][k], At[m][k], acc[ai][bj][m][n], 0, 0, 0); __builtin_amdgcn_s_setprio(0); } while (0)
#define PG8_WAIT_V(n) asm volatile("s_waitcnt vmcnt(" #n ")" ::: "memory")
#define PG8_WAIT_L(n) asm volatile("s_waitcnt lgkmcnt(" #n ")" ::: "memory")
#define PG8_BAR __builtin_amdgcn_s_barrier()
#define PG8_SCHED __builtin_amdgcn_sched_barrier(0)
    Unit cur, nxt; int ui = 0;
    if (!S.next(0, cur)) return;
    f32x4 acc[2][2][4][2];
#pragma unroll
    for (int a = 0; a < 2; ++a)
#pragma unroll
        for (int b = 0; b < 2; ++b)
#pragma unroll
            for (int m = 0; m < 4; ++m)
#pragma unroll
                for (int n = 0; n < 2; ++n) acc[a][b][m][n] = (f32x4){0.f, 0.f, 0.f, 0.f};
    bf16x8 At[4][2], B0[2][2], B1[2][2];
    const char* cA = (const char*)g.A + (size_t)cur.pm * tstep; const char* cB = (const char*)g.Bt + (size_t)cur.pn * tstep;
    S.a_ready(cur);
    if constexpr (SP2) {
        PG8_STAGE(PG8_SB(0, 0), cB, voffB); PG8_STAGE(PG8_SB(0, 1), cB + hstep, voffB); PG8_STAGE(PG8_SA(0, 0), cA, voffA); PG8_STAGE(PG8_SA(0, 1), cA + hstep, voffA);
        if (wr == 1) PG8_BAR;
        PG8_WAIT_V(2); PG8_BAR;
        PG8_STAGE(PG8_SB(1, 0), cB + kstep, voffB); PG8_STAGE(PG8_SA(1, 0), cA + kstep, voffA); PG8_STAGE(PG8_SB(1, 1), cB + hstep + kstep, voffB);
        PG8_WAIT_V(6); PG8_BAR;
    } else {
        PG8_STAGE(PG8_SB(0, 0), cB, voffB); PG8_STAGE(PG8_SA(0, 0), cA, voffA); PG8_STAGE(PG8_SB(0, 1), cB + hstep, voffB); PG8_STAGE(PG8_SA(0, 1), cA + hstep, voffA);
        if (wr == 1) PG8_BAR;
        PG8_WAIT_V(4); PG8_BAR;
        PG8_STAGE(PG8_SB(1, 0), cB + kstep, voffB); PG8_STAGE(PG8_SA(1, 0), cA + kstep, voffA); PG8_STAGE(PG8_SB(1, 1), cB + hstep + kstep, voffB);
        PG8_WAIT_V(6); PG8_BAR;
    }
    for (;;) {
        const bool has_next = S.next(ui + 1, nxt);
        const char* nA = has_next ? (const char*)g.A + (size_t)nxt.pm * tstep : cA; const char* nB = has_next ? (const char*)g.Bt + (size_t)nxt.pn * tstep : cB;
        for (int t = 0; t < nt; t += 2) {
            const bool last = (t == nt - 2);
            const char* a1 = cA + (size_t)(t + 1) * kstep;
            const char* a2 = last ? nA : cA + (size_t)(t + 2) * kstep; const char* b2 = last ? nB : cB + (size_t)(t + 2) * kstep;
            const char* a3 = a2 + kstep; const char* b3 = b2 + kstep;
            if (last && has_next) S.a_ready(nxt);
            if constexpr (SP2) {
            PG8_LDB(B0, 0, 0); PG8_LDB(B1, 0, 1); PG8_SCHED; PG8_LDA(At, 0, 0); PG8_STAGE(PG8_SA(1, 1), a1 + hstep, voffA);
            PG8_WAIT_V(8); PG8_WAIT_L(0); PG8_BAR; PG8_MMA(0, 0, At, B0); PG8_MMA(0, 1, At, B1); PG8_BAR; PG8_SCHED;
            PG8_LDA(At, 0, 1); PG8_STAGE(PG8_SB(0, 0), b2, voffB); PG8_STAGE(PG8_SB(0, 1), b2 + hstep, voffB); PG8_STAGE(PG8_SA(0, 0), a2, voffA);
            PG8_WAIT_V(8); PG8_WAIT_L(0); PG8_BAR; PG8_MMA(1, 0, At, B0); PG8_MMA(1, 1, At, B1); PG8_BAR; PG8_SCHED;
            PG8_LDB(B0, 1, 0); PG8_LDB(B1, 1, 1); PG8_SCHED; PG8_LDA(At, 1, 0); PG8_STAGE(PG8_SA(0, 1), a2 + hstep, voffA);
            PG8_WAIT_V(8); PG8_WAIT_L(0); PG8_BAR; PG8_MMA(0, 0, At, B0); PG8_MMA(0, 1, At, B1); PG8_BAR; PG8_SCHED;
            PG8_LDA(At, 1, 1); PG8_STAGE(PG8_SB(1, 0), b3, voffB); PG8_STAGE(PG8_SB(1, 1), b3 + hstep, voffB); PG8_STAGE(PG8_SA(1, 0), a3, voffA);
            PG8_WAIT_V(8); PG8_WAIT_L(0); PG8_BAR; PG8_MMA(1, 0, At, B0); PG8_MMA(1, 1, At, B1); PG8_BAR; PG8_SCHED;
            } else {
            PG8_LDB(B0, 0, 0); PG8_SCHED; PG8_LDA(At, 0, 0); PG8_STAGE(PG8_SA(1, 1), a1 + hstep, voffA);
            PG8_WAIT_L(8); PG8_BAR; PG8_WAIT_L(0); PG8_MMA(0, 0, At, B0); PG8_BAR; PG8_SCHED;
            PG8_LDB(B1, 0, 1); PG8_STAGE(PG8_SB(0, 0), b2, voffB);
            PG8_BAR; PG8_WAIT_L(0); PG8_MMA(0, 1, At, B1); PG8_BAR;
            PG8_LDA(At, 0, 1); PG8_STAGE(PG8_SA(0, 0), a2, voffA);
            PG8_BAR; PG8_WAIT_L(0); PG8_MMA(1, 0, At, B0); PG8_BAR; PG8_SCHED;
            PG8_STAGE(PG8_SB(0, 1), b2 + hstep, voffB);
            PG8_WAIT_V(6); PG8_BAR; PG8_MMA(1, 1, At, B1); PG8_BAR;
            PG8_LDB(B0, 1, 0); PG8_SCHED; PG8_LDA(At, 1, 0); PG8_STAGE(PG8_SA(0, 1), a2 + hstep, voffA);
            PG8_WAIT_L(8); PG8_BAR; PG8_WAIT_L(0); PG8_MMA(0, 0, At, B0); PG8_BAR; PG8_SCHED;
            PG8_LDB(B1, 1, 1); PG8_STAGE(PG8_SB(1, 0), b3, voffB);
            PG8_BAR; PG8_WAIT_L(0); PG8_MMA(0, 1, At, B1); PG8_BAR;
            PG8_LDA(At, 1, 1); PG8_STAGE(PG8_SA(1, 0), a3, voffA);
            PG8_BAR; PG8_WAIT_L(0); PG8_MMA(1, 0, At, B0); PG8_BAR; PG8_SCHED;
            PG8_STAGE(PG8_SB(1, 1), b3 + hstep, voffB);
            PG8_WAIT_V(6); PG8_BAR; PG8_MMA(1, 1, At, B1); PG8_BAR;
            }
        }
        if constexpr (ALIGN_EPI) { if (wr == 0) PG8_BAR; }
        if constexpr (!Epi::AFTER_DRAIN) { E(acc, cur, wr, wc, fr, fq); S.done(cur); }
        if (!has_next) break;
#pragma unroll
        for (int a = 0; a < 2; ++a)
#pragma unroll
            for (int b = 0; b < 2; ++b)
#pragma unroll
                for (int m = 0; m < 4; ++m)
#pragma unroll
                    for (int n = 0; n < 2; ++n) acc[a][b][m][n] = (f32x4){0.f, 0.f, 0.f, 0.f};
        cur = nxt; cA = nA; cB = nB; ++ui;
        if constexpr (ALIGN_EPI) { if (wr == 1) PG8_BAR; }
    }
    PG8_WAIT_V(0);
    if constexpr (!ALIGN_EPI) { if (wr == 0) PG8_BAR; }
    PG8_BAR;
    if constexpr (Epi::AFTER_DRAIN) { E.fused(acc, cur, wr, wc, fr, fq, lds, wid, lane); S.done(cur); }
#undef PG8_SA
#undef PG8_SB
#undef PG8_STAGE
#undef PG8_LDA
#undef PG8_LDB
#undef PG8_MMA
#undef PG8_WAIT_V
#undef PG8_WAIT_L
#undef PG8_BAR
#undef PG8_SCHED
}
}
constexpr int BATCH = 2, SEQ = 8192, DM = 4096, M = BATCH * SEQ, DFF = 11008, NLAYER = 2;
constexpr int P_IN = 10704, NIN = 10752, NMAIN = 10496;
constexpr int CA_Q = 0, CA_K = 1024, CA_V = 2048;
constexpr int CB_Q = 3072, CB_K = 3584, CB_V = 4096, CB_G = 5120;
constexpr int CC_R = 6144, CC_K = 7168, CC_V = 8192;
constexpr int CD_Q = 9216, CD_K = 10240, CD_V = 10368;
constexpr float LOG2E = 1.4426950408889634f;
constexpr float QSCALE = 0.125f * LOG2E;
constexpr int NWAVES = 8;

constexpr size_t MiB = 1u << 20;
constexpr size_t WS_CTL = 0, CTL_ZERO_BYTES = 1 * MiB;
constexpr size_t WS_MODP = 2 * MiB;
constexpr size_t WS_MOD = 14 * MiB;
constexpr size_t WS_TAB = 15 * MiB;
constexpr size_t WS_WIN = 16 * MiB, WIN_L = 84 * MiB;
constexpr size_t WS_WOUT = 184 * MiB, WOUT_L = 32 * MiB;
constexpr size_t WS_W13 = 248 * MiB, W13_L = 172 * MiB;
constexpr size_t WS_W2 = 592 * MiB, W2_L = 86 * MiB;
constexpr size_t WS_XN = 764 * MiB;
constexpr size_t WS_COLS = 892 * MiB;
constexpr size_t WS_LOWR = 1220 * MiB;
constexpr size_t WS_HID = 892 * MiB;
constexpr size_t WS_QKA = 1236 * MiB;
constexpr size_t WS_QKD = 1300 * MiB;
constexpr size_t WS_LOGA = 1336 * MiB;
constexpr size_t WS_RW = 1368 * MiB, RW_ONE = 64 * MiB;
constexpr size_t WS_VFIRST = 1816 * MiB;
constexpr size_t WS_MIXED = 1880 * MiB;
constexpr int VROW = SEQ + 64;
constexpr size_t WS_VTA = 2008 * MiB;
constexpr size_t WS_VTD = 2041 * MiB;
constexpr size_t WS_QDEC = 2046 * MiB, WS_KDT = 2062 * MiB, WS_AM = 2078 * MiB, WS_EBL = 2086 * MiB;
constexpr size_t WS_VTB = 2087 * MiB;
constexpr size_t WS_RWC = 2120 * MiB;
constexpr size_t WS_OB = 2446 * MiB;
constexpr size_t WS_PSG = 2478 * MiB;
constexpr size_t WS_WF = 2479 * MiB;
constexpr size_t WS_XR = 2480 * MiB;
constexpr size_t WS_END = 2608 * MiB;
constexpr int CW_BAR = 4096;
constexpr int CW_Q = 16384;

constexpr int RING_OFF = 0, RING_BYTES = 131072;
constexpr int LDSCTL_OFF = RING_BYTES, MISC_OFF = LDSCTL_OFF + 320;
constexpr int LDS_BYTES = 147456;

#define GAS __attribute__((address_space(1)))
#define LAS __attribute__((address_space(3)))
typedef unsigned short bf16;
typedef unsigned v4u __attribute__((ext_vector_type(4)));
typedef unsigned v2u __attribute__((ext_vector_type(2)));
typedef float f32x4 __attribute__((ext_vector_type(4)));
typedef short bf16x8 __attribute__((ext_vector_type(8)));
typedef GAS unsigned gu32;
#define RLX_AGENT __ATOMIC_RELAXED, __HIP_MEMORY_SCOPE_AGENT
#define LDS_WAIT() asm volatile("s_waitcnt lgkmcnt(0)" ::: "memory")
#define VM_WAIT() asm volatile("s_waitcnt vmcnt(0)" ::: "memory")
typedef float f32x2_t __attribute__((ext_vector_type(2))); typedef __bf16 bf16x2_t __attribute__((ext_vector_type(2)));
__device__ __forceinline__ unsigned pk2(float lo, float hi) { const f32x2_t v = {lo, hi}; return __builtin_bit_cast(unsigned, __builtin_convertvector(v, bf16x2_t)); }
__device__ __forceinline__ unsigned f2bf(float f) { return pk2(f, f) & 0xffffu; }
__device__ __forceinline__ float bf2f(unsigned short h) { return __builtin_bit_cast(float, (unsigned)h << 16); }
__device__ __forceinline__ float bflo(unsigned w) { return __builtin_bit_cast(float, w << 16); }
__device__ __forceinline__ float bfhi(unsigned w) { return __builtin_bit_cast(float, w & 0xffff0000u); }
template <int CTRL> __device__ __forceinline__ float dpp_f(float v) { return __builtin_bit_cast(float, __builtin_amdgcn_update_dpp(0, __builtin_bit_cast(int, v), CTRL, 0xF, 0xF, true)); }
__device__ __forceinline__ float sum8(float v) {
    v += dpp_f<0xB1>(v); v += dpp_f<0x4E>(v); v += dpp_f<0x141>(v); return v; }
__device__ __forceinline__ float sum32(float v) {
    v = sum8(v); v += dpp_f<0x140>(v); v += __builtin_bit_cast(float, __builtin_amdgcn_ds_swizzle(__builtin_bit_cast(int, v), 0x401F)); return v; }
__device__ __forceinline__ float wave_sum(float v) {
    v = sum8(v); v += dpp_f<0x140>(v);
    v += __builtin_bit_cast(float, __builtin_amdgcn_ds_swizzle(__builtin_bit_cast(int, v), 0x401F));
    { const int u = __builtin_bit_cast(int, v); v = __builtin_bit_cast(float, __builtin_amdgcn_readlane(u, 0)) + __builtin_bit_cast(float, __builtin_amdgcn_readlane(u, 32)); }
    return v;
}
__device__ __forceinline__ float sigmoid_f(float x) { return __builtin_amdgcn_rcpf(1.0f + __builtin_amdgcn_exp2f(-LOG2E * x)); }
__device__ __forceinline__ float silu_g(float x) { return x * sigmoid_f(x); }
__device__ __forceinline__ void unpack8(const v4u r, float (&f)[8]) { f[0] = bflo(r.x); f[1] = bfhi(r.x); f[2] = bflo(r.y); f[3] = bfhi(r.y); f[4] = bflo(r.z); f[5] = bfhi(r.z); f[6] = bflo(r.w); f[7] = bfhi(r.w); }
__device__ __forceinline__ v4u pack8(const float (&f)[8]) { v4u o; o.x = pk2(f[0], f[1]); o.y = pk2(f[2], f[3]); o.z = pk2(f[4], f[5]); o.w = pk2(f[6], f[7]); return o; }

#define XB_TMO      128
#define XB_XCNT(j)  (256  + 64 * (j))
#define XB_XSUB(j)  (1280 + 64 * (j))
#define XB_XGEN(j)  (2304 + 64 * (j))
#define XB_TOP      3328
#define XB_TOPGEN   3392
#define XCD_BAR_WORDS 3456
#define XB_SPIN_CAP (1u << 23)

__device__ __forceinline__ unsigned xb_ld(unsigned* p)              { return __hip_atomic_load(p, __ATOMIC_RELAXED, __HIP_MEMORY_SCOPE_AGENT); }
__device__ __forceinline__ unsigned xb_add(unsigned* p, unsigned v) { return __hip_atomic_fetch_add(p, v, __ATOMIC_RELAXED, __HIP_MEMORY_SCOPE_AGENT); }
__device__ __forceinline__ unsigned xb_xcc_id() { return (unsigned)__builtin_amdgcn_s_getreg((3 << 11) | 20) & 0xFu; }
#define XB_SPIN(cond, bar) do { unsigned _sp = 0; while (cond) { __builtin_amdgcn_s_sleep(1); \
    if ((++_sp & 255u) == 0u) { if (xb_ld(&(bar)[XB_TMO])) break; if (_sp > XB_SPIN_CAP) { atomicAdd(&(bar)[XB_TMO], 1u); break; } } } } while (0)

struct XcdBarrier {
    unsigned* bar; unsigned x;
    volatile LAS unsigned* st;
};

__device__ __forceinline__ XcdBarrier xcd_barrier_post(unsigned* bar, volatile LAS unsigned* st) {
    XcdBarrier b; b.bar = bar; b.x = xb_xcc_id(); b.st = st;
    if (threadIdx.x == 0) (void)xb_add(&bar[XB_XCNT(b.x)], 1u);
    return b;
}
__device__ __forceinline__ void xcd_barrier_complete(unsigned* bar, unsigned x, unsigned& nloc, unsigned& nx) {
    const unsigned G = gridDim.x * gridDim.y * gridDim.z;
    unsigned sum, cnt, mine, sp = 0u;
    for (;;) {
        sum = 0u; cnt = 0u; mine = 0u;
#pragma unroll
        for (unsigned j = 0; j < 16; ++j) { const unsigned c = xb_ld(&bar[XB_XCNT(j)]); sum += c; cnt += (c > 0u) ? 1u : 0u; mine = (j == x) ? c : mine; }
        if (sum == G) break;
        __builtin_amdgcn_s_sleep(1);
        if ((++sp & 255u) == 0u) { if (xb_ld(&bar[XB_TMO])) break; if (sp > XB_SPIN_CAP) { atomicAdd(&bar[XB_TMO], 1u); break; } }
    }
    nloc = mine > 0u ? mine : 1u; nx = cnt > 0u ? cnt : 1u;
}

__device__ __forceinline__ void xcd_barrier(const XcdBarrier& b) {
    asm volatile("s_waitcnt vmcnt(0)" ::: "memory");
    __syncthreads();
    if (threadIdx.x == 0) {
        unsigned* bar = b.bar;
        __builtin_amdgcn_s_waitcnt(0);
        unsigned nloc = b.st[0], nx = b.st[1];
        if (nloc == 0u) { xcd_barrier_complete(bar, b.x, nloc, nx); b.st[0] = nloc; b.st[1] = nx; }
        const unsigned old = xb_add(&bar[XB_XSUB(b.x)], 1u);
        const unsigned gen = old / nloc;
        if (old + 1u == (gen + 1u) * nloc) {
            __builtin_amdgcn_fence(__ATOMIC_RELEASE, "agent");
            asm volatile("s_waitcnt vmcnt(0)" ::: "memory");
            const unsigned og = xb_add(&bar[XB_TOP], 1u);
            const unsigned tg = og / nx;
            if (og + 1u == (tg + 1u) * nx) xb_add(&bar[XB_TOPGEN], 1u);
            else XB_SPIN(xb_ld(&bar[XB_TOPGEN]) == tg, bar);
            __builtin_amdgcn_fence(__ATOMIC_ACQUIRE, "agent");
            xb_add(&bar[XB_XGEN(b.x)], 1u);
            asm volatile("s_waitcnt vmcnt(0)" ::: "memory");
        } else {
            XB_SPIN(xb_ld(&bar[XB_XGEN(b.x)]) == gen, bar);
            __builtin_amdgcn_fence(__ATOMIC_ACQUIRE, "agent");
            asm volatile("s_waitcnt vmcnt(0)" ::: "memory");
        }
    }
    __syncthreads();
}

typedef const float* const __attribute__((address_space(4)))* kargp;
struct Frame {
    LAS unsigned char* lds;
    volatile LAS unsigned* MISC;
    gu32* ctl;
    int tid, lane, wave;
    int vcu, G, bx;
    kargp kin;
    float* out;
    unsigned char* ws;
};
enum { I_X = 0, I_C, I_RELB, I_ADAW, I_ADAB, I_WIN, I_WOUT, I_DQN, I_DKN, I_DLAM, I_DSUB, I_GGU, I_GGB, I_GON, I_RMU, I_RWUP, I_RW0, I_RAUP, I_RA0, I_RGUP,
       I_RKK, I_RKA, I_RRK, I_RLNW, I_RLNB, I_VRD, I_VRMU, I_VRUP, I_VR0, I_SQN, I_SKN, I_SSINK, I_W1, I_W3, I_W2 };

#define WSP(T, off) ((T*)(F.ws + (off)))
__device__ __forceinline__ void relaunder_tid(Frame& F) { int t = F.tid; asm volatile("" : "+v"(t)); F.tid = t; F.lane = t & 63; F.wave = __builtin_amdgcn_readfirstlane(t >> 6); }
__device__ __forceinline__ void relaunder(Frame& F) { kargp p = F.kin; asm volatile("" : "+s"(p)); F.kin = p; }

__device__ __forceinline__ void conv_item(const float* src, int ld, int col0, int ncols, int K, bf16* WT, int row0, int kb, LAS float* scr, int lane) {
    const int k0 = 64 * kb;
    { const int n = lane & 31; const bool ok = src != nullptr && n < ncols; const float* sp = src + (size_t)(k0 + (lane >> 5)) * ld + col0 + n; float v[32];
#pragma unroll
      for (int i = 0; i < 32; ++i) v[i] = ok ? sp[(size_t)(2 * i) * ld] : 0.f;
#pragma unroll
      for (int i = 0; i < 32; ++i) scr[(2 * i + (lane >> 5)) * 33 + n] = v[i]; }
    LDS_WAIT(); asm volatile("" ::: "memory");
    const int c = lane & 7;
#pragma unroll
    for (int j = 0; j < 4; ++j) { const int n = (lane >> 3) + 8 * j; const LAS float* s = scr + (8 * c) * 33 + n;
        v4u o; o.x = pk2(s[0 * 33], s[1 * 33]); o.y = pk2(s[2 * 33], s[3 * 33]); o.z = pk2(s[4 * 33], s[5 * 33]); o.w = pk2(s[6 * 33], s[7 * 33]);
        if (n < ncols) *(GAS v4u*)(WT + (size_t)(row0 + n) * K + k0 + 8 * c) = o; }
    LDS_WAIT(); asm volatile("" ::: "memory");
}
__device__ __forceinline__ int t5_bucket(int d) {
    if (d < 16) return d;
    int v = 16 + (int)(logf((float)d * (1.0f / 16.0f)) / logf(8.0f) * 16.0f);
    return v < 31 ? v : 31;
}
__device__ __forceinline__ void p0_prologue_a(Frame& F) {
    const int gw = F.vcu * NWAVES + F.wave, NGW = F.G * NWAVES;
    LAS float* ldsf = (LAS float*)(F.lds + RING_OFF);
    for (int i = F.tid; i < 2 * DM; i += NWAVES * 64) ldsf[i] = silu_g(F.kin[I_C][i]);
    __syncthreads();
    float* MODP = WSP(float, WS_MODP);
    for (int it = gw; it < 6144; it += NGW) {
        const int l = it / 3072, rem = it % 3072, kc = rem / 96, ng = rem % 96, n0 = 256 * ng + 4 * F.lane;
        const float* w = F.kin[I_ADAW] + ((size_t)l * DM + kc * 128) * 24576 + n0;
        f32x4 a0 = {0.f, 0.f, 0.f, 0.f}, a1 = {0.f, 0.f, 0.f, 0.f};
#pragma unroll 16
        for (int k = 0; k < 128; ++k) { const f32x4 wv = *(const f32x4*)(w + (size_t)k * 24576); const float s0 = ldsf[kc * 128 + k], s1 = ldsf[DM + kc * 128 + k]; a0 += wv * s0; a1 += wv * s1; }
        *(f32x4*)(MODP + ((size_t)(l * 32 + kc) * 2 + 0) * 24576 + n0) = a0;
        *(f32x4*)(MODP + ((size_t)(l * 32 + kc) * 2 + 1) * 24576 + n0) = a1;
    }
    for (int idx = F.bx * (NWAVES * 64) + F.tid; idx < NLAYER * 448 * 64; idx += F.G * NWAVES * 64) {
        const int l = idx / (448 * 64), rem = idx % (448 * 64), blk = rem >> 6, ln = rem & 63, n = ln & 15, g = ln >> 4;
        const int m = blk < 384 ? blk >> 7 : 3, nt = blk < 384 ? (blk & 127) >> 1 : blk - 384, ks = blk < 384 ? (blk & 1) : 0;
        const float* W = m == 0 ? F.kin[I_RWUP] + (size_t)l * 65536 : (m == 1 ? F.kin[I_RAUP] + (size_t)l * 65536 : (m == 2 ? F.kin[I_RGUP] + (size_t)l * 65536 : (l ? F.kin[I_VRUP] + (size_t)(l - 1) * 32768 : nullptr)));
        float f[8];
#pragma unroll
        for (int e = 0; e < 8; ++e) f[e] = W != nullptr ? W[(size_t)(32 * ks + 8 * g + e) * 1024 + 16 * nt + n] : 0.f;
        *(v4u*)(WSP(bf16, WS_WF) + ((size_t)(l * 448 + blk) * 64 + ln) * 8) = pack8(f);
    }
    __syncthreads();
    LAS float* scr = (LAS float*)(F.lds + RING_OFF + F.wave * 16384);
    constexpr int I_IN = 337 * 64, I_OUT = 128 * 64, I_13 = 688 * 64, I_2 = 128 * 172, I_L = I_IN + I_OUT + I_13 + I_2;
    for (int it = gw; it < NLAYER * I_L; it += NGW) {
        const int l = it / I_L; int r = it % I_L;
        if (r < I_IN) {
            const int kb = r / 337, cb = r % 337; const float* src = F.kin[I_WIN] + (size_t)l * DM * P_IN; int ld = P_IN, col0, row0, nc = 32;
            if (cb < 192) { col0 = 32 * cb; row0 = 32 * cb; }
            else if (cb < 288) { col0 = 6160 + 32 * (cb - 192); row0 = 6144 + 32 * (cb - 192); }
            else if (cb < 328) { col0 = 9424 + 32 * (cb - 288); row0 = 9216 + 32 * (cb - 288); }
            else if (cb == 328) { col0 = 6144; row0 = 10496; nc = 16; }
            else if (cb < 335) { col0 = 9232 + 32 * (cb - 329); row0 = 10512 + 32 * (cb - 329); }
            else if (cb == 335) { src = l ? F.kin[I_VRD] + (size_t)(l - 1) * DM * 32 : nullptr; ld = 32; col0 = 0; row0 = 10704; }
            else { src = nullptr; col0 = 0; row0 = 10736; nc = 16; }
            conv_item(src, ld, col0, nc, DM, WSP(bf16, WS_WIN + l * WIN_L), row0, kb, scr, F.lane); continue; }
        r -= I_IN;
        if (r < I_OUT) { const int kb = r / 128, cb = r % 128; conv_item(F.kin[I_WOUT] + (size_t)l * DM * DM, DM, 32 * cb, 32, DM, WSP(bf16, WS_WOUT + l * WOUT_L), 32 * cb, kb, scr, F.lane); continue; }
        r -= I_OUT;
        if (r < I_13) { const int kb = r / 688, cb = r % 688, pn = cb >> 3, wi = cb & 7;
            const float* src = (wi < 4 ? F.kin[I_W1] : F.kin[I_W3]) + (size_t)l * DM * DFF;
            conv_item(src, DFF, 128 * pn + 32 * (wi & 3), 32, DM, WSP(bf16, WS_W13 + l * W13_L), 32 * cb, kb, scr, F.lane); continue; }
        r -= I_13;
        { const int kb = r / 128, cb = r % 128; conv_item(F.kin[I_W2] + (size_t)l * DFF * DM, DM, 32 * cb, 32, DFF, WSP(bf16, WS_W2 + l * W2_L), 32 * cb, kb, scr, F.lane); }
    }
}
__device__ __forceinline__ void p0_prologue_b(Frame& F) {
    const int gt = F.bx * (NWAVES * 64) + F.tid, NT = F.G * NWAVES * 64;
    const float* MODP = WSP(float, WS_MODP); float* MOD = WSP(float, WS_MOD);
    for (int idx = gt; idx < NLAYER * 2 * 24576; idx += NT) {
        const int l = idx / 49152, rem = idx % 49152, b = rem / 24576, n = rem % 24576;
        float s = F.kin[I_ADAB][l * 24576 + n];
#pragma unroll 8
        for (int kc = 0; kc < 32; ++kc) s += MODP[((size_t)(l * 32 + kc) * 2 + b) * 24576 + n];
        MOD[idx] = s;
    }
    if (F.bx == 0) { float* TAB = WSP(float, WS_TAB);
        for (int i = F.tid; i < 24 * 128; i += NWAVES * 64) { const int hh = i >> 7, d = i & 127; TAB[i] = F.kin[I_RELB][t5_bucket(d) * 24 + hh] * LOG2E; } }
}
__device__ __forceinline__ void rms_phase(Frame& F, const float* xin, const float* sh, const float* sc) {
    const int gw = F.vcu * NWAVES + F.wave, NGW = F.G * NWAVES;
    bf16* XN = WSP(bf16, WS_XN);
    for (int m = gw; m < M; m += NGW) {
        const int b = m >> 13;
        const f32x4* xr = (const f32x4*)(xin + (size_t)m * DM) + F.lane;
        f32x4 v[16]; float ss = 0.f;
#pragma unroll
        for (int j = 0; j < 16; ++j) { v[j] = xr[64 * j]; ss += (v[j].x * v[j].x + v[j].y * v[j].y) + (v[j].z * v[j].z + v[j].w * v[j].w); }
        const float rstd = rsqrtf(wave_sum(ss) * (1.0f / DM) + 1e-6f);
        const f32x4* scp = (const f32x4*)(sc + (size_t)b * 24576) + F.lane; const f32x4* shp = (const f32x4*)(sh + (size_t)b * 24576) + F.lane;
        v2u* o8 = (v2u*)(XN + (size_t)m * DM) + F.lane;
#pragma unroll
        for (int j = 0; j < 16; ++j) { const f32x4 s4 = scp[64 * j], h4 = shp[64 * j]; const f32x4 o = v[j] * rstd * (s4 + 1.0f) + h4;
            v2u w; w.x = pk2(o.x, o.y); w.y = pk2(o.z, o.w); o8[64 * j] = w; }
    }
}
__device__ __forceinline__ void rms_phase_bf(Frame& F, const float* sh, const float* sc) {
    const int gw = F.vcu * NWAVES + F.wave, NGW = F.G * NWAVES;
    bf16* XN = WSP(bf16, WS_XN); const bf16* XR = WSP(bf16, WS_XR);
    for (int m = gw; m < M; m += NGW) {
        const int b = m >> 13;
        const v4u* xr = (const v4u*)(XR + (size_t)m * DM) + F.lane;
        v4u raw[8]; float ss = 0.f;
#pragma unroll
        for (int j = 0; j < 8; ++j) raw[j] = xr[64 * j];
#pragma unroll
        for (int j = 0; j < 8; ++j) { float f[8]; unpack8(raw[j], f);
#pragma unroll
            for (int e = 0; e < 8; ++e) ss += f[e] * f[e]; }
        const float rstd = rsqrtf(wave_sum(ss) * (1.0f / DM) + 1e-6f);
        const float* scp = sc + (size_t)b * 24576 + 8 * F.lane; const float* shp = sh + (size_t)b * 24576 + 8 * F.lane;
        v4u* o16 = (v4u*)(XN + (size_t)m * DM) + F.lane;
#pragma unroll
        for (int j = 0; j < 8; ++j) { float f[8]; unpack8(raw[j], f);
            const f32x4 s0 = *(const f32x4*)(scp + 512 * j), s1 = *(const f32x4*)(scp + 512 * j + 4), h0 = *(const f32x4*)(shp + 512 * j), h1 = *(const f32x4*)(shp + 512 * j + 4);
            float o[8];
#pragma unroll
            for (int e = 0; e < 4; ++e) { o[e] = f[e] * rstd * (s0[e] + 1.0f) + h0[e]; o[4 + e] = f[4 + e] * rstd * (s1[e] + 1.0f) + h1[e]; }
            o16[64 * j] = pack8(o); }
    }
}
__device__ __forceinline__ void prep_norm(Frame& F, int l) {
    const int gw = F.vcu * NWAVES + F.wave, NGW = F.G * NWAVES, lane = F.lane, sub = lane >> 3, ch = lane & 7;
    float gqa[8], gka[8], gqd[8], gkd[8];
#pragma unroll
    for (int e = 0; e < 8; ++e) { gqa[e] = F.kin[I_DQN][l * 64 + ch * 8 + e] * QSCALE; gka[e] = F.kin[I_DKN][l * 64 + ch * 8 + e];
                                  gqd[e] = F.kin[I_SQN][l * 64 + ch * 8 + e] * QSCALE; gkd[e] = F.kin[I_SKN][l * 64 + ch * 8 + e]; }
    const bf16* COLS = WSP(bf16, WS_COLS); bf16* QKA = WSP(bf16, WS_QKA); bf16* QKD = WSP(bf16, WS_QKD);
    for (int m = gw; m < M; m += NGW) {
        const bf16* src = COLS + (size_t)m * NMAIN;
#pragma unroll
        for (int i = 0; i < 4; ++i) { const int vec = i * 8 + sub, col = vec * 64 + ch * 8;
            float f[8]; unpack8(*(const v4u*)(src + CA_Q + col), f); float ss = 0.f;
#pragma unroll
            for (int e = 0; e < 8; ++e) ss += f[e] * f[e];
            ss = sum8(ss);
            const float rstd = rsqrtf(ss * (1.0f / 64.0f) + 1e-6f);
#pragma unroll
            for (int e = 0; e < 8; ++e) f[e] = f[e] * rstd * (i < 2 ? gqa[e] : gka[e]);
            *(v4u*)(QKA + (size_t)m * 2048 + col) = pack8(f); }
#pragma unroll
        for (int i = 0; i < 3; ++i) { const int vec = i * 8 + sub, col = vec * 64 + ch * 8;
            if (vec < 18) { float f[8]; unpack8(*(const v4u*)(src + CD_Q + col), f); float ss = 0.f;
#pragma unroll
                for (int e = 0; e < 8; ++e) ss += f[e] * f[e];
                ss = sum8(ss);
                const float rstd = rsqrtf(ss * (1.0f / 64.0f) + 1e-6f);
#pragma unroll
                for (int e = 0; e < 8; ++e) f[e] = f[e] * rstd * (vec < 16 ? gqd[e] : gkd[e]);
                *(v4u*)(QKD + (size_t)m * 1152 + col) = pack8(f); } }
    }
}
__device__ __forceinline__ void prep_loga(Frame& F, int l) {
    LAS float* gdl = (LAS float*)(F.lds + RING_OFF);
    float gu[16];
#pragma unroll
    for (int j = 0; j < 16; ++j) gu[j] = F.kin[I_GGU][((size_t)l * 16 + j) * 512 + F.tid];
    const float bias = F.kin[I_GGB][l * 512 + F.tid];
    const float* LOWR = WSP(float, WS_LOWR); float* LOGA = WSP(float, WS_LOGA);
    for (int tile = F.bx; tile < M / 64; tile += F.G) {
        const size_t row0 = (size_t)tile * 64;
        __syncthreads();
#pragma unroll
        for (int i = 0; i < 2; ++i) { const int idx = F.tid + 512 * i; gdl[idx] = LOWR[(row0 + (idx >> 4)) * 256 + (idx & 15)]; }
        __syncthreads();
#pragma unroll 4
        for (int t = 0; t < 64; ++t) { const LAS f32x4* gp = (const LAS f32x4*)(gdl + t * 16); const f32x4 g0 = gp[0], g1 = gp[1], g2 = gp[2], g3 = gp[3];
            float z = bias + g0.x * gu[0] + g0.y * gu[1] + g0.z * gu[2] + g0.w * gu[3] + g1.x * gu[4] + g1.y * gu[5] + g1.z * gu[6] + g1.w * gu[7]
                    + g2.x * gu[8] + g2.y * gu[9] + g2.z * gu[10] + g2.w * gu[11] + g3.x * gu[12] + g3.y * gu[13] + g3.z * gu[14] + g3.w * gu[15];
            LOGA[(row0 + t) * 512 + F.tid] = (fminf(z, 0.f) - __logf(1.0f + __expf(-fabsf(z)))) * (1.0f / 16.0f); }
    }
}
__device__ __forceinline__ int next_item(Frame& F, gu32* ctr) {
    volatile LAS int* slot = (volatile LAS int*)(F.lds + LDSCTL_OFF + 64);
    __syncthreads();
    if (F.tid == 0) *slot = (int)__hip_atomic_fetch_add(ctr, 1u, RLX_AGENT);
    __syncthreads();
    return *slot;
}
typedef float f32x16 __attribute__((ext_vector_type(16)));
__device__ __forceinline__ float xother32(float v) { unsigned a = __builtin_bit_cast(unsigned, v), b = a; asm volatile("" : "+v"(b)); auto rr = __builtin_amdgcn_permlane32_swap(a, b, false, false);
    const unsigned lo = rr[0], hi = rr[1]; return __builtin_bit_cast(float, (unsigned)((__builtin_amdgcn_mbcnt_hi(~0u, __builtin_amdgcn_mbcnt_lo(~0u, 0u)) & 32u) ? lo : hi)); }
__device__ __forceinline__ float xsum32(float v) { return v + xother32(v); }
__device__ __forceinline__ float xmax32(float v) { return fmaxf(v, xother32(v)); }
__device__ __forceinline__ int crow16(int r, int hi) { return (r & 3) + 8 * (r >> 2) + 4 * hi; }
template <bool ISA>
__device__ __forceinline__ void attn_unit(Frame& F, int l, int b, int hx, int qb) {
    constexpr int DV = ISA ? 128 : 64, NDV = DV / 32, KSTR = ISA ? 272 : 144, VSTR = 144, KBYTES = 64 * KSTR, VBYTES = DV * VSTR, BUFB = KBYTES + VBYTES, NCH = ISA ? 2 : 1;
    constexpr float NEG = -1e30f;
    LAS unsigned char* L = F.lds + RING_OFF;
    const int tid = F.tid, lane = F.lane, r32 = lane & 31, hi = lane >> 5, qs = F.wave & 3, grp = F.wave >> 2, q0 = qb * 128;
    const int kvh = hx >> 2, hd = kvh * 8 + (hx & 3) * 2 + grp;
    const bf16* Qp; const bf16* Kp; const bf16* VT; int ldq;
    if (ISA) { const bf16* QKA = WSP(bf16, WS_QKA); Qp = QKA + (size_t)b * SEQ * 2048 + hx * 128 + grp * 64; Kp = QKA + (size_t)b * SEQ * 2048 + 1024 + hx * 128; ldq = 2048; VT = WSP(bf16, WS_VTA) + (size_t)(b * 8 + hx) * 128 * VROW; }
    else { const bf16* QKD = WSP(bf16, WS_QKD); Qp = QKD + (size_t)b * SEQ * 1152 + hd * 64; Kp = QKD + (size_t)b * SEQ * 1152 + 1024 + kvh * 64; ldq = 1152; VT = WSP(bf16, WS_VTD) + (size_t)(b * 2 + kvh) * 64 * VROW; }
    const int qpos = q0 + 32 * qs + r32;
    bf16x8 qr[4];
#pragma unroll
    for (int d0 = 0; d0 < 4; ++d0) qr[d0] = *(const bf16x8*)(Qp + (size_t)qpos * ldq + d0 * 16 + hi * 8);
    LAS float* Bt = (LAS float*)(L + 2 * BUFB);
    { const float* TAB = WSP(float, WS_TAB);
      if (ISA) { if (tid < 130) Bt[tid] = tid == 0 ? NEG : (tid == 129 ? 0.f : TAB[hx * 128 + tid - 1] - TAB[hx * 128 + 127]); }
      else { if (tid < 260) { const int gi = tid >= 130, t = tid - 130 * gi; Bt[tid] = (t == 0 || t == 129) ? NEG : TAB[(8 + kvh * 8 + (hx & 3) * 2 + gi) * 128 + t - 1]; } } }
    const int TQ = q0 >> 6, T0 = ISA ? 0 : (TQ >= 2 ? TQ - 2 : 0), T1 = TQ + 1;
    v4u kreg[NCH], vreg[NCH];
#define AT_GLOAD(T) do { _Pragma("unroll") for (int i_ = 0; i_ < NCH; ++i_) { const int c_ = tid + 512 * i_; \
        const int kr_ = ISA ? (c_ >> 4) : (c_ >> 3), kc_ = ISA ? (c_ & 15) : (c_ & 7); kreg[i_] = *(const v4u*)(Kp + (size_t)((T) * 64 + kr_) * ldq + kc_ * 8); \
        const int vr_ = c_ >> 3, vc_ = c_ & 7; vreg[i_] = *(const v4u*)(VT + (size_t)vr_ * VROW + (T) * 64 + vc_ * 8); } } while (0)
#define AT_LWRITE(buf) do { _Pragma("unroll") for (int i_ = 0; i_ < NCH; ++i_) { const int c_ = tid + 512 * i_; \
        const int kr_ = ISA ? (c_ >> 4) : (c_ >> 3), kc_ = ISA ? (c_ & 15) : (c_ & 7); *(LAS v4u*)(L + (buf) * BUFB + kr_ * KSTR + kc_ * 16) = kreg[i_]; \
        const int vr_ = c_ >> 3, vc_ = c_ & 7; *(LAS v4u*)(L + (buf) * BUFB + KBYTES + vr_ * VSTR + vc_ * 16) = vreg[i_]; } } while (0)
    f32x16 o[NDV];
#pragma unroll
    for (int i = 0; i < NDV; ++i) o[i] = (f32x16){0.f, 0.f, 0.f, 0.f, 0.f, 0.f, 0.f, 0.f, 0.f, 0.f, 0.f, 0.f, 0.f, 0.f, 0.f, 0.f};
    float m_run = ISA ? NEG : F.kin[I_SSINK][l * 16 + hd] * LOG2E, l_run = ISA ? 0.f : (hi == 0 ? 1.f : 0.f);
    const int krow = (r32 & 16) | (r32 & 3) | ((r32 & 4) << 1) | ((r32 & 8) >> 1);
    const int koff = krow * KSTR + (ISA ? grp * 128 : 0) + hi * 16, voff = KBYTES + r32 * VSTR + hi * 16;
    AT_GLOAD(T0); AT_LWRITE(0); __syncthreads();
#pragma unroll 1
    for (int T = T0; T <= T1; ++T) {
        const int cur = (T - T0) & 1;
        AT_GLOAD(T < T1 ? T + 1 : T1);
        LAS const unsigned char* Kb = L + cur * BUFB;
        f32x16 s[2];
#pragma unroll
        for (int blk = 0; blk < 2; ++blk) { s[blk] = (f32x16){0.f, 0.f, 0.f, 0.f, 0.f, 0.f, 0.f, 0.f, 0.f, 0.f, 0.f, 0.f, 0.f, 0.f, 0.f, 0.f};
#pragma unroll
            for (int d0 = 0; d0 < 4; ++d0) { const bf16x8 kf = *(const LAS bf16x8*)(Kb + koff + blk * 32 * KSTR + d0 * 32); s[blk] = __builtin_amdgcn_mfma_f32_32x32x16_bf16(kf, qr[d0], s[blk], 0, 0, 0); } }
        bf16x8 vfc[NDV], vfn[NDV];
#pragma unroll
        for (int i = 0; i < NDV; ++i) vfc[i] = *(const LAS bf16x8*)(Kb + voff + i * 32 * VSTR);
        if (!ISA || T >= TQ - 2) {
            const LAS float* bt = Bt + (ISA ? 0 : grp * 130) + 1; const int d0 = qpos - T * 64 - 8 * hi;
#pragma unroll
            for (int blk = 0; blk < 2; ++blk)
#pragma unroll
                for (int r = 0; r < 16; ++r) { const int dist = d0 - (32 * blk + 16 * (r >> 3) + (r & 7)); const int di = dist < -1 ? -1 : (dist > 128 ? 128 : dist); s[blk][r] += bt[di]; } }
        float mt = s[0][0];
#pragma unroll
        for (int r = 1; r < 16; ++r) mt = fmaxf(mt, s[0][r]);
#pragma unroll
        for (int r = 0; r < 16; ++r) mt = fmaxf(mt, s[1][r]);
        mt = xmax32(mt);
        const float m_new = fmaxf(m_run, mt);
        if (__any(m_new > m_run)) { const float alpha = __builtin_amdgcn_exp2f(m_run - m_new); l_run *= alpha;
#pragma unroll
            for (int i = 0; i < NDV; ++i)
#pragma unroll
                for (int r = 0; r < 16; ++r) o[i][r] *= alpha;
            m_run = m_new; }
        float ls = 0.f;
#pragma unroll
        for (int blk = 0; blk < 2; ++blk)
#pragma unroll
            for (int r = 0; r < 16; ++r) { const float pv_ = __builtin_amdgcn_exp2f(s[blk][r] - m_run); s[blk][r] = pv_; ls += pv_; }
        l_run += ls;
#pragma unroll
        for (int sl = 0; sl < 4; ++sl) { const int blk = sl >> 1, r0 = 8 * (sl & 1);
            v4u pw; pw.x = pg8::cvt_pk_bf16(s[blk][r0], s[blk][r0 + 1]); pw.y = pg8::cvt_pk_bf16(s[blk][r0 + 2], s[blk][r0 + 3]); pw.z = pg8::cvt_pk_bf16(s[blk][r0 + 4], s[blk][r0 + 5]); pw.w = pg8::cvt_pk_bf16(s[blk][r0 + 6], s[blk][r0 + 7]);
            const bf16x8 pf = __builtin_bit_cast(bf16x8, pw);
#pragma unroll
            for (int i = 0; i < NDV; ++i) { if (sl < 3) vfn[i] = *(const LAS bf16x8*)(Kb + voff + i * 32 * VSTR + (sl + 1) * 32); o[i] = __builtin_amdgcn_mfma_f32_32x32x16_bf16(vfc[i], pf, o[i], 0, 0, 0); }
#pragma unroll
            for (int i = 0; i < NDV; ++i) vfc[i] = vfn[i]; }
        AT_LWRITE(cur ^ 1);
        __syncthreads();
    }
#undef AT_GLOAD
#undef AT_LWRITE
    const float inv = 1.0f / xsum32(l_run);
    bf16* MIX = WSP(bf16, WS_MIXED);
    if (ISA) {
        int ll_ = l; asm volatile("" : "+s"(ll_)); const float lam_init = ll_ == 0 ? 0.2f : 0.35550906759f;     float lam_full;
        { const float* lm = F.kin[I_DLAM] + (size_t)l * 256; const float s1 = wave_sum(lm[lane] * lm[64 + lane]), s2 = wave_sum(lm[128 + lane] * lm[192 + lane]); lam_full = __expf(s1) - __expf(s2) + lam_init; }
        LAS float* R1 = (LAS float*)L;
        LAS bf16* R2 = (LAS bf16*)(L + 66048);
        const int ql = 32 * qs + r32;
        if (grp == 1) {
#pragma unroll
            for (int i = 0; i < NDV; ++i)
#pragma unroll
                for (int r = 0; r < 16; ++r) R1[ql * 129 + 32 * i + crow16(r, hi)] = lam_full * inv * o[i][r]; }
        __syncthreads();
        if (grp == 0) { float ss = 0.f;
#pragma unroll
            for (int i = 0; i < NDV; ++i)
#pragma unroll
                for (int r = 0; r < 16; ++r) { const float d = o[i][r] * inv - R1[ql * 129 + 32 * i + crow16(r, hi)]; o[i][r] = d; ss += d * d; }
            const float rstd = rsqrtf(xsum32(ss) * (1.0f / 128.0f) + 1e-6f) * (1.0f - lam_init);
            const float* sl = F.kin[I_DSUB] + l * 128;
#pragma unroll
            for (int i = 0; i < NDV; ++i)
#pragma unroll
                for (int r = 0; r < 16; ++r) { const int dv = 32 * i + crow16(r, hi); R2[ql * 132 + dv] = (bf16)f2bf(o[i][r] * rstd * sl[dv]); } }
        __syncthreads();
#pragma unroll
        for (int i = 0; i < 4; ++i) { const int c = tid + 512 * i, row = c >> 4, ch = c & 15; const LAS v2u* sp = (const LAS v2u*)(R2 + row * 132 + ch * 8); const v2u a = sp[0], bb = sp[1];
            *(v4u*)(MIX + (size_t)(b * SEQ + q0 + row) * DM + hx * 128 + ch * 8) = (v4u){a.x, a.y, bb.x, bb.y}; }
    } else {
        LAS bf16* R = (LAS bf16*)L + F.wave * 2176;
#pragma unroll
        for (int i = 0; i < NDV; ++i)
#pragma unroll
            for (int r = 0; r < 16; ++r) R[r32 * 68 + 32 * i + crow16(r, hi)] = (bf16)f2bf(o[i][r] * inv);
#pragma unroll
        for (int i = 0; i < 4; ++i) { const int c = lane + 64 * i, row = c >> 3, ch = c & 7; const LAS v2u* sp = (const LAS v2u*)(R + row * 68 + ch * 8); const v2u a = sp[0], bb = sp[1];
            *(v4u*)(MIX + (size_t)(b * SEQ + q0 + 32 * qs + row) * DM + 3072 + hd * 64 + ch * 8) = (v4u){a.x, a.y, bb.x, bb.y}; }
    }
}
__device__ __forceinline__ void prep_gla(Frame& F) {
    LAS float* Lb = (LAS float*)(F.lds + RING_OFF); LAS float* Qd = Lb + 64 * 129; LAS float* Ki = Qd + 64 * 129; LAS bf16* Kt = (LAS bf16*)(Ki + 64 * 129);
    const bf16* COLS = WSP(bf16, WS_COLS); const float* LOGA = WSP(float, WS_LOGA);
    bf16* QDEC = WSP(bf16, WS_QDEC); bf16* KDT = WSP(bf16, WS_KDT); bf16* AMg = WSP(bf16, WS_AM); float* EBL = WSP(float, WS_EBL);
    for (int u = F.bx; u < 1024; u += F.G) {
        const int b = u >> 9, h = (u >> 7) & 3, ck = u & 127; const size_t row0 = (size_t)b * SEQ + ck * 64;
        __syncthreads();
        for (int idx = F.tid; idx < 8192; idx += NWAVES * 64) { const int t = idx >> 7, d = idx & 127; Lb[t * 129 + d] = LOGA[(row0 + t) * 512 + h * 128 + d]; }
        __syncthreads();
        if (F.tid < 128) { float acc = 0.f;
#pragma unroll 8
            for (int t = 0; t < 64; ++t) { acc += Lb[t * 129 + F.tid]; Lb[t * 129 + F.tid] = acc; }
            EBL[(size_t)u * 128 + F.tid] = __expf(acc); }
        __syncthreads();
        for (int idx = F.tid; idx < 8192; idx += NWAVES * 64) { const int t = idx >> 7, d = idx & 127; const float bt = Lb[t * 129 + d], bl = Lb[63 * 129 + d];
            const float q = bf2f(COLS[(row0 + t) * NMAIN + CB_Q + h * 128 + d]) * 0.08838834764831845f, k = bf2f(COLS[(row0 + t) * NMAIN + CB_K + h * 128 + d]);
            const float qd = q * __expf(bt); Qd[t * 129 + d] = qd; Ki[t * 129 + d] = k * __expf(-bt); Kt[d * 72 + t] = (bf16)f2bf(k * __expf(bl - bt));
            QDEC[((size_t)u * 64 + t) * 128 + d] = (bf16)f2bf(qd); }
        __syncthreads();
#pragma unroll
        for (int i = 0; i < 2; ++i) { const int c_ = F.tid + 512 * i, row = c_ >> 3, ch = c_ & 7; const LAS v2u* sp = (const LAS v2u*)(Kt + row * 72 + ch * 8); const v2u a = sp[0], bb = sp[1];
            *(v4u*)(KDT + ((size_t)u * 128 + row) * 64 + ch * 8) = (v4u){a.x, a.y, bb.x, bb.y}; }
        { const int c = F.tid >> 3, sg = F.tid & 7; float acc[8];
#pragma unroll
          for (int e = 0; e < 8; ++e) acc[e] = 0.f;
#pragma unroll 4
          for (int d = 0; d < 128; ++d) { const float q = Qd[c * 129 + d];
#pragma unroll
              for (int e = 0; e < 8; ++e) acc[e] += q * Ki[(sg * 8 + e) * 129 + d]; }
#pragma unroll
          for (int e = 0; e < 8; ++e) if (sg * 8 + e > c) acc[e] = 0.f;
          *(v4u*)(AMg + ((size_t)u * 64 + c) * 64 + sg * 8) = pack8(acc); }
    }
}
__device__ __forceinline__ void prep_vt(Frame& F, int pass) {
    LAS bf16* T = (LAS bf16*)(F.lds + RING_OFF);
    const bf16* COLS = WSP(bf16, WS_COLS);
    const int ncol = pass == 4 ? 128 : 512, nch = ncol >> 3;
    const int col0 = pass < 2 ? CA_V + 512 * pass : (pass < 4 ? CB_V + 512 * (pass - 2) : CD_V);
    bf16* dst0 = pass < 2 ? WSP(bf16, WS_VTA) + (size_t)(512 * pass) * VROW : (pass < 4 ? WSP(bf16, WS_VTB) + (size_t)(512 * (pass - 2)) * VROW : WSP(bf16, WS_VTD));
    const int rows_b = pass == 4 ? 128 : 1024;
    for (int tile = F.bx; tile < M / 64; tile += F.G) {
        const int b = tile >> 7, t0 = (tile & 127) * 64;
        __syncthreads();
        for (int idx = F.tid; idx < 64 * nch; idx += NWAVES * 64) { const int tok = idx / nch, ch = idx % nch;
            const v4u v = *(const v4u*)(COLS + (size_t)(b * SEQ + t0 + tok) * NMAIN + col0 + ch * 8); LAS unsigned* d = (LAS unsigned*)(T + tok * 522 + ch * 8); d[0] = v.x; d[1] = v.y; d[2] = v.z; d[3] = v.w; }
        __syncthreads();
        for (int idx = F.tid; idx < ncol * 8; idx += NWAVES * 64) { const int vrow = idx >> 3, ch = idx & 7;
            unsigned e[8];
#pragma unroll
            for (int k = 0; k < 8; ++k) e[k] = T[(ch * 8 + k) * 522 + vrow];
            v4u o; o.x = e[0] | (e[1] << 16); o.y = e[2] | (e[3] << 16); o.z = e[4] | (e[5] << 16); o.w = e[6] | (e[7] << 16);
            *(v4u*)(dst0 + ((size_t)b * rows_b + vrow) * VROW + t0 + ch * 8) = o; }
    }
}
typedef float f32x4v __attribute__((ext_vector_type(4)));
__device__ __forceinline__ float sum16(float v) { v = sum8(v); v += dpp_f<0x140>(v); return v; }
#define LDS_BARRIER() asm volatile("s_waitcnt lgkmcnt(0)\n\ts_barrier" ::: "memory")
template <int HACK = 0> __device__ __forceinline__ void gla_scan_unit(Frame& F, int l, int b, int h, int vh) {
    LAS unsigned char* L = F.lds + RING_OFF;
    constexpr int OQD = 0, OKT = 17408, OAM = 35840, OVT = 45056, OOT = 63488, OEB = 80896, OPS = 81408;
    const int tid = F.tid, lane = F.lane, n = lane & 15, g = lane >> 4, w = F.wave;
    const bf16* QDEC = WSP(bf16, WS_QDEC); const bf16* KDT = WSP(bf16, WS_KDT); const bf16* AMg = WSP(bf16, WS_AM); const float* EBL = WSP(float, WS_EBL);
    const bf16* VTB = WSP(bf16, WS_VTB) + (size_t)((b * 4 + h) * 256 + 128 * vh) * VROW; bf16* OB = WSP(bf16, WS_OB); float* PSG = WSP(float, WS_PSG);
    f32x4v S[8];
#pragma unroll
    for (int dt = 0; dt < 8; ++dt) S[dt] = (f32x4v){0.f, 0.f, 0.f, 0.f};
    v4u pq[2], pk[2], pa, pv[2]; float pe = 0.f;
#define GL_ISSUE(CK) do { const size_t u_ = (size_t)(b * 4 + h) * 128 + (CK); \
        _Pragma("unroll") for (int i = 0; i < 2; ++i) { const int c_ = tid + 512 * i; pq[i] = *(const v4u*)(QDEC + (u_ * 64 + (c_ >> 4)) * 128 + (c_ & 15) * 8); pk[i] = *(const v4u*)(KDT + (u_ * 128 + (c_ >> 3)) * 64 + (c_ & 7) * 8); \
            pv[i] = *(const v4u*)(VTB + (size_t)(c_ >> 3) * VROW + (CK) * 64 + (c_ & 7) * 8); } \
        pa = *(const v4u*)(AMg + (u_ * 64 + (tid >> 3)) * 64 + (tid & 7) * 8); \
        pe = EBL[u_ * 128 + (tid & 127)]; } while (0)
#define GL_WRITE() do { _Pragma("unroll") for (int i = 0; i < 2; ++i) { const int c_ = tid + 512 * i; *(LAS v4u*)(L + OQD + (c_ >> 4) * 272 + (c_ & 15) * 16) = pq[i]; *(LAS v4u*)(L + OKT + (c_ >> 3) * 144 + (c_ & 7) * 16) = pk[i]; \
            *(LAS v4u*)(L + OVT + (c_ >> 3) * 144 + (c_ & 7) * 16) = pv[i]; } \
        *(LAS v4u*)(L + OAM + (tid >> 3) * 144 + (tid & 7) * 16) = pa; \
        ((LAS float*)(L + OEB))[tid & 127] = pe; } while (0)
    GL_ISSUE(0); GL_WRITE();
    LDS_BARRIER();
#pragma unroll 1
    for (int ck = 0; ck < 128; ++ck) {
        const size_t row0 = (size_t)b * SEQ + ck * 64;
        GL_ISSUE((HACK & 1) && ck >= 2 ? 2 : (ck + 1 < 128 ? ck + 1 : 127));
        bf16x8 vf[2];
#pragma unroll
        for (int ks = 0; ks < 2; ++ks) vf[ks] = *(const LAS bf16x8*)(L + OVT + (16 * w + n) * 144 + (32 * ks + 8 * g) * 2);
        f32x4v o[4];
#pragma unroll
        for (int ct = 0; ct < 4; ++ct) o[ct] = (f32x4v){0.f, 0.f, 0.f, 0.f};
#pragma unroll
        for (int ct = 0; ct < 4; ++ct)
#pragma unroll
            for (int ks = 0; ks < 2; ++ks) { const bf16x8 af = *(const LAS bf16x8*)(L + OAM + (16 * ct + n) * 144 + (32 * ks + 8 * g) * 2); o[ct] = __builtin_amdgcn_mfma_f32_16x16x32_bf16(af, vf[ks], o[ct], 0, 0, 0); }
#pragma unroll
        for (int kk = 0; kk < 4; ++kk) { v4u pw; pw.x = pg8::cvt_pk_bf16(S[2 * kk][0], S[2 * kk][1]); pw.y = pg8::cvt_pk_bf16(S[2 * kk][2], S[2 * kk][3]);
            pw.z = pg8::cvt_pk_bf16(S[2 * kk + 1][0], S[2 * kk + 1][1]); pw.w = pg8::cvt_pk_bf16(S[2 * kk + 1][2], S[2 * kk + 1][3]); const bf16x8 sf = __builtin_bit_cast(bf16x8, pw);
#pragma unroll
            for (int ct = 0; ct < 4; ++ct) { const LAS unsigned char* qp = L + OQD + (16 * ct + n) * 272 + (32 * kk + 4 * g) * 2; const v2u qa = *(const LAS v2u*)qp, qb = *(const LAS v2u*)(qp + 32);
                o[ct] = __builtin_amdgcn_mfma_f32_16x16x32_bf16(__builtin_bit_cast(bf16x8, (v4u){qa.x, qa.y, qb.x, qb.y}), sf, o[ct], 0, 0, 0); } }
#pragma unroll
        for (int dt = 0; dt < 8; ++dt) { const f32x4v eb = *(const LAS f32x4v*)(L + OEB + (16 * dt + 4 * g) * 4); S[dt] = S[dt] * eb;
#pragma unroll
            for (int ks = 0; ks < 2; ++ks) { const bf16x8 kf = *(const LAS bf16x8*)(L + OKT + (16 * dt + n) * 144 + (32 * ks + 8 * g) * 2); S[dt] = __builtin_amdgcn_mfma_f32_16x16x32_bf16(kf, vf[ks], S[dt], 0, 0, 0); } }
        LAS float* PS = (LAS float*)(L + OPS) + (ck & 1) * 512;
#pragma unroll
        for (int ct = 0; ct < 4; ++ct)
#pragma unroll
            for (int r = 0; r < 4; ++r) { const float ss = sum16(o[ct][r] * o[ct][r]); if (n == 0) PS[(16 * ct + 4 * g + r) * 8 + w] = ss;
                *(LAS bf16*)(L + OOT + (16 * ct + 4 * g + r) * 272 + (16 * w + n) * 2) = (bf16)f2bf(o[ct][r]); }
        LDS_BARRIER();
        GL_WRITE();
        if (!(HACK & 2)) {
#pragma unroll
        for (int i = 0; i < 2; ++i) { const int c_ = tid + 512 * i, tok = c_ >> 4, ch = c_ & 15; *(v4u*)(OB + (row0 + tok) * 1024 + h * 256 + 128 * vh + ch * 8) = *(const LAS v4u*)(L + OOT + tok * 272 + ch * 16); }
        if (tid < 64) { const LAS f32x4v* pp = (const LAS f32x4v*)(PS + tid * 8); const f32x4v p0 = pp[0], p1 = pp[1]; PSG[(row0 + tid) * 8 + h * 2 + vh] = ((p0.x + p0.y) + (p0.z + p0.w)) + ((p1.x + p1.y) + (p1.z + p1.w)); } }
        LDS_BARRIER();
    }
#undef GL_ISSUE
#undef GL_WRITE
}
__device__ __forceinline__ void gla_post(Frame& F, int l) {
    const bf16* OB = WSP(bf16, WS_OB); const float* PSG = WSP(float, WS_PSG); const bf16* COLS = WSP(bf16, WS_COLS); bf16* MIX = WSP(bf16, WS_MIXED);
    const int ch = F.tid & 127, h = ch >> 5; float gain8[8];
#pragma unroll
    for (int e = 0; e < 8; ++e) gain8[e] = F.kin[I_GON][l * 256 + (ch & 31) * 8 + e];
    for (int row = F.bx * 4 + (F.tid >> 7); row < M; row += F.G * 4) {
        float ov[8], gv[8]; unpack8(*(const v4u*)(OB + (size_t)row * 1024 + ch * 8), ov); unpack8(*(const v4u*)(COLS + (size_t)row * NMAIN + CB_G + ch * 8), gv);
        const f32x2_t ps = *(const f32x2_t*)(PSG + (size_t)row * 8 + h * 2); const float rstd = rsqrtf((ps.x + ps.y) * (1.0f / 256.0f) + 1e-6f);
#pragma unroll
        for (int e = 0; e < 8; ++e) ov[e] = ov[e] * (rstd * gain8[e]) * silu_g(gv[e]);
        *(v4u*)(MIX + (size_t)row * DM + 1024 + ch * 8) = pack8(ov);
    }
}
constexpr int RC_AT = 0, RC_RT = 2048, RC_BK = 4096, RC_VF = 8192, RC_GF = 10240, RC_U0 = 12288, RC_Y0 = 16384, RC_P15 = 20480, RC_BN = 20736, RC_BYTES = 20800;
__device__ __forceinline__ void rwkv_chunks_of_tile(Frame& F, int l, int tile) {
    const int team = F.tid >> 8, tt = F.tid & 255;
    LAS float* Lt = (LAS float*)(F.lds + RING_OFF) + team * 12288;
    LAS float* XA = Lt; LAS float* XR = Lt + 1040; LAS float* ZB = Lt + 2080; LAS float* ZK = Lt + 3120; LAS float* TB = Lt + 4160; LAS float* TK = Lt + 5200; LAS float* VV = Lt + 6240;
    LAS float* ATl = Lt + 7280; LAS float* U0l = Lt + 8320; LAS float* W1 = Lt + 9360;
    LAS float* Aab = Lt + 10400; LAS float* Aak = Lt + 10672; LAS float* Arb = Lt + 10944; LAS float* Ark = Lt + 11216; LAS float* TT = Lt + 11488;
    const float* RW = WSP(float, WS_RW); const unsigned* RWU = WSP(unsigned, WS_RW); constexpr size_t RS = RW_ONE / 4; unsigned char* RWC = F.ws + WS_RWC;
    float pw_[6], pr_[4], pk_[4], pv_[4], pa_[4], pb_[4], pg_[4];
#define RC_FETCH(P) do { const int h_ = 2 * (P) + team; const size_t cb_ = (size_t)tile * 16 * 1024 + h_ * 64 + (tt & 63); const int q_ = tt >> 6; \
        pw_[4] = RW[RS + cb_ + (size_t)(q_ ? 4 * q_ - 1 : 0) * 1024]; pw_[5] = RW[RS + cb_ + (size_t)15 * 1024];            \
        _Pragma("unroll") for (int e = 0; e < 4; ++e) { const size_t o_ = cb_ + (size_t)(4 * q_ + e) * 1024; pw_[e] = RW[RS + o_]; const unsigned u0 = RWU[o_], u2 = RWU[2 * RS + o_], u3 = RWU[3 * RS + o_]; \
            pr_[e] = bflo(u0); pk_[e] = bfhi(u0); pv_[e] = bflo(u2); pg_[e] = bfhi(u2); pa_[e] = bflo(u3); pb_[e] = bfhi(u3); } } while (0)
    RC_FETCH(0);
#pragma unroll 1
    for (int pair = 0; pair < 8; ++pair) {
        const int uc = ((tile >> 9) * 16 + 2 * pair + team) * 512 + (tile & 511), b = uc >> 13, h = (uc >> 9) & 15, ck = uc & 511; unsigned char* rec = RWC + ((size_t)ck * 32 + (uc >> 9)) * RC_BYTES;     (void)b;
        __syncthreads();
        {
          const int j = tt & 63, q = tt >> 6;
          const float cl = pw_[5], clm = q ? pw_[4] : 0.f; const float clq[4] = {pw_[0], pw_[1], pw_[2], pw_[3]};
#pragma unroll
          for (int e = 0; e < 4; ++e) { const int t = 4 * q + e; const float cprev = e == 0 ? clm : clq[e - 1], cc = clq[e];
              const float rr = pr_[e], kk = pk_[e], vv = pv_[e], aa = pa_[e], bb = pb_[e];
              XA[t * 65 + j] = aa * __expf(cprev); XR[t * 65 + j] = rr * __expf(cc); const float ei = __expf(-cc), ef = __expf(cl - cc);
              ZB[t * 65 + j] = bb * ei; ZK[t * 65 + j] = kk * ei; TB[t * 65 + j] = bb * ef; TK[t * 65 + j] = kk * ef; VV[t * 65 + j] = vv; }
          if (q == 0) ((float*)(rec + RC_P15))[j] = __expf(cl);
          { v2u gw; gw.x = pk2(pg_[0], pg_[1]); gw.y = pk2(pg_[2], pg_[3]); *(v2u*)(rec + RC_GF + (((j >> 4) * 64 + 16 * q + (j & 15)) * 8)) = gw; } }
        RC_FETCH(pair < 7 ? pair + 1 : 7);
        __syncthreads();
        {
          const int q = tt >> 6, n = tt & 15, g = (tt >> 4) & 3; const LAS float* X = (q & 2) ? XR : XA; const LAS float* Z = (q & 1) ? ZK : ZB; LAS float* O = q == 0 ? Aab : (q == 1 ? Aak : (q == 2 ? Arb : Ark));
          f32x4v c = (f32x4v){0.f, 0.f, 0.f, 0.f};
#pragma unroll
          for (int ks = 0; ks < 16; ++ks) c = __builtin_amdgcn_mfma_f32_16x16x4f32(X[n * 65 + 4 * ks + g], Z[n * 65 + 4 * ks + g], c, 0, 0, 0);
#pragma unroll
          for (int rr = 0; rr < 4; ++rr) { const int t = 4 * g + rr; O[t * 17 + n] = ((q & 2) ? n <= t : n < t) ? c[rr] : 0.f; }
          { const int t = tt >> 4, jq = tt & 15; const float* rkp = F.kin[I_RRK] + l * 1024 + h * 64 + 4 * jq; float bn = 0.f;
#pragma unroll
            for (int e = 0; e < 4; ++e) bn += XR[t * 65 + 4 * jq + e] * ZK[t * 65 + 4 * jq + e] * rkp[e];
            bn = sum16(bn); if (jq == 0) ((float*)(rec + RC_BN))[t] = bn; } }
        __syncthreads();
        {
          if (tt < 16) { float col[16];
#pragma unroll
              for (int t = 0; t < 16; ++t) { float acc = (t == tt) ? 1.f : 0.f;
#pragma unroll
                  for (int s = 0; s < 16; ++s) if (s < t) acc += Aab[t * 17 + s] * col[s];
                  col[t] = acc; TT[t * 17 + tt] = acc; } }
          const int q = tt >> 6, n = tt & 15, g = (tt >> 4) & 3; f32x4v c = (f32x4v){0.f, 0.f, 0.f, 0.f};
#pragma unroll
          for (int ks = 0; ks < 4; ++ks) c = __builtin_amdgcn_mfma_f32_16x16x4f32(Aak[n * 17 + 4 * ks + g], VV[(4 * ks + g) * 65 + 16 * q + n], c, 0, 0, 0);
#pragma unroll
          for (int rr = 0; rr < 4; ++rr) W1[(4 * g + rr) * 65 + 16 * q + n] = c[rr]; }
        __syncthreads();
        {
          const int q = tt >> 6, n = tt & 15, g = (tt >> 4) & 3; f32x4v ca = (f32x4v){0.f, 0.f, 0.f, 0.f}, cu = (f32x4v){0.f, 0.f, 0.f, 0.f};
#pragma unroll
          for (int ks = 0; ks < 4; ++ks) { const float tv = TT[n * 17 + 4 * ks + g]; ca = __builtin_amdgcn_mfma_f32_16x16x4f32(tv, XA[(4 * ks + g) * 65 + 16 * q + n], ca, 0, 0, 0); cu = __builtin_amdgcn_mfma_f32_16x16x4f32(tv, W1[(4 * ks + g) * 65 + 16 * q + n], cu, 0, 0, 0); }
#pragma unroll
          for (int rr = 0; rr < 4; ++rr) { ATl[(4 * g + rr) * 65 + 16 * q + n] = ca[rr]; U0l[(4 * g + rr) * 65 + 16 * q + n] = cu[rr]; }
          *(f32x4v*)(rec + RC_U0 + ((q * 64 + 16 * g + n) * 16)) = cu; }
        __syncthreads();
        {
          const int q = tt >> 6, n = tt & 15, g = (tt >> 4) & 3; f32x4v cr, cy = (f32x4v){0.f, 0.f, 0.f, 0.f};
#pragma unroll
          for (int rr = 0; rr < 4; ++rr) cr[rr] = XR[(4 * g + rr) * 65 + 16 * q + n];
#pragma unroll
          for (int ks = 0; ks < 4; ++ks) { const float arb = Arb[n * 17 + 4 * ks + g], ark = Ark[n * 17 + 4 * ks + g];
              cr = __builtin_amdgcn_mfma_f32_16x16x4f32(arb, ATl[(4 * ks + g) * 65 + 16 * q + n], cr, 0, 0, 0);
              cy = __builtin_amdgcn_mfma_f32_16x16x4f32(arb, U0l[(4 * ks + g) * 65 + 16 * q + n], cy, 0, 0, 0);
              cy = __builtin_amdgcn_mfma_f32_16x16x4f32(ark, VV[(4 * ks + g) * 65 + 16 * q + n], cy, 0, 0, 0); }
          *(f32x4v*)(rec + RC_Y0 + ((q * 64 + 16 * g + n) * 16)) = cy;
#pragma unroll
          for (int rr = 0; rr < 4; ++rr) W1[(4 * g + rr) * 65 + 16 * q + n] = cr[rr]; }
        __syncthreads();
        { const int t = tt & 15, jq = tt >> 4, kk = jq >> 3, half = (jq & 7) >> 2, g = jq & 3, j0 = 4 * jq;
          v2u wa, wr; wa.x = pk2(ATl[t * 65 + j0], ATl[t * 65 + j0 + 1]); wa.y = pk2(ATl[t * 65 + j0 + 2], ATl[t * 65 + j0 + 3]); wr.x = pk2(W1[t * 65 + j0], W1[t * 65 + j0 + 1]); wr.y = pk2(W1[t * 65 + j0 + 2], W1[t * 65 + j0 + 3]);
          *(v2u*)(rec + RC_AT + kk * 1024 + (16 * g + t) * 16 + half * 8) = wa; *(v2u*)(rec + RC_RT + kk * 1024 + (16 * g + t) * 16 + half * 8) = wr;
          const int j = tt & 63, gg = tt >> 6; v4u bk; bk.x = pk2(TB[(4 * gg) * 65 + j], TB[(4 * gg + 1) * 65 + j]); bk.y = pk2(TB[(4 * gg + 2) * 65 + j], TB[(4 * gg + 3) * 65 + j]);
          bk.z = pk2(TK[(4 * gg) * 65 + j], TK[(4 * gg + 1) * 65 + j]); bk.w = pk2(TK[(4 * gg + 2) * 65 + j], TK[(4 * gg + 3) * 65 + j]);
          *(v4u*)(rec + RC_BK + (j >> 4) * 1024 + (16 * gg + (j & 15)) * 16) = bk;
          v2u vf; vf.x = pk2(VV[(4 * gg) * 65 + j], VV[(4 * gg + 1) * 65 + j]); vf.y = pk2(VV[(4 * gg + 2) * 65 + j], VV[(4 * gg + 3) * 65 + j]);
          *(v2u*)(rec + RC_VF + ((j >> 4) * 64 + 16 * gg + (j & 15)) * 8) = vf; }
    }
}
#undef RC_FETCH
template <int HACK = 0> __device__ __forceinline__ void rwkv_scan_unit(Frame& F, int l, int b, int h) {
    LAS unsigned char* L = F.lds + RING_OFF;
    const unsigned char* recs = F.ws + WS_RWC + (size_t)(b * 16 + h) * RC_BYTES;
    const int lane = F.lane, n = lane & 15, g = lane >> 4;
    LAS float* XS = (LAS float*)(L + 2 * RC_BYTES);
    if (F.wave >= 2) {
        const int li = F.tid - 128;
        int px[4];
#pragma unroll
        for (int k = 0; k < 4; ++k) { const int x = li + 384 * k; px[k] = x < 1300 ? x : 1299; }
        v4u p0[4], p1[4], p2[4], p3[4], p4[4], p5[4], p6[4], p7[4];
#define RWL_ISSUE(P, CK) do { const int ck_ = (CK) < 512 ? ((HACK & 1) && (CK) >= 4 ? 3 : (CK)) : 511; const v4u* src_ = (const v4u*)(recs + (size_t)ck_ * 32 * RC_BYTES); \
        _Pragma("unroll") for (int k = 0; k < 4; ++k) P[k] = src_[px[k]]; } while (0)
#define RWL_WRITE(P, CK) do { LAS v4u* dst_ = (LAS v4u*)(L + ((CK) & 1) * RC_BYTES); _Pragma("unroll") for (int k = 0; k < 4; ++k) dst_[px[k]] = P[k]; } while (0)
        RWL_ISSUE(p0, 0); RWL_ISSUE(p1, 1); RWL_ISSUE(p2, 2); RWL_ISSUE(p3, 3); RWL_ISSUE(p4, 4); RWL_ISSUE(p5, 5); RWL_ISSUE(p6, 6); RWL_ISSUE(p7, 7);
        RWL_WRITE(p0, 0); RWL_ISSUE(p0, 8);
        LDS_BARRIER();
#pragma unroll 1
        for (int ck = 0; ck < 512; ck += 8) {
            RWL_WRITE(p1, ck + 1); RWL_ISSUE(p1, ck + 9); LDS_BARRIER();
            RWL_WRITE(p2, ck + 2); RWL_ISSUE(p2, ck + 10); LDS_BARRIER();
            RWL_WRITE(p3, ck + 3); RWL_ISSUE(p3, ck + 11); LDS_BARRIER();
            RWL_WRITE(p4, ck + 4); RWL_ISSUE(p4, ck + 12); LDS_BARRIER();
            RWL_WRITE(p5, ck + 5); RWL_ISSUE(p5, ck + 13); LDS_BARRIER();
            RWL_WRITE(p6, ck + 6); RWL_ISSUE(p6, ck + 14); LDS_BARRIER();
            RWL_WRITE(p7, ck + 7); RWL_ISSUE(p7, ck + 15); LDS_BARRIER();
            RWL_WRITE(p0, ck + 8); RWL_ISSUE(p0, ck + 16); LDS_BARRIER();
        }
#undef RWL_ISSUE
#undef RWL_WRITE
        return;
    }
    const int cw = F.wave;
    f32x4v S[4][2];
#pragma unroll
    for (int jt = 0; jt < 4; ++jt)
#pragma unroll
        for (int it = 0; it < 2; ++it) S[jt][it] = (f32x4v){0.f, 0.f, 0.f, 0.f};
    float lnw[2], lnb[2];
#pragma unroll
    for (int it = 0; it < 2; ++it) { lnw[it] = F.kin[I_RLNW][l * 1024 + h * 64 + 16 * (2 * cw + it) + n]; lnb[it] = F.kin[I_RLNB][l * 1024 + h * 64 + 16 * (2 * cw + it) + n]; }
    bf16* MIX = WSP(bf16, WS_MIXED) + ((size_t)b * SEQ) * DM + 2048 + h * 64 + 32 * cw + n;
    f32x4v Yp[2] = {(f32x4v){0.f, 0.f, 0.f, 0.f}, (f32x4v){0.f, 0.f, 0.f, 0.f}}, bnp = (f32x4v){0.f, 0.f, 0.f, 0.f}; v2u gfp[2] = {(v2u){0u, 0u}, (v2u){0u, 0u}}, vfp[2] = {(v2u){0u, 0u}, (v2u){0u, 0u}};
    LDS_BARRIER();
#pragma unroll 1
    for (int ck = 0; ck <= 512; ++ck) {
        if (ck > 0) {
            const LAS float* xs = XS + ((ck - 1) & 1) * 64; const f32x4v a0 = *(const LAS f32x4v*)(xs + 8 * g), a1 = *(const LAS f32x4v*)(xs + 8 * g + 4), b0 = *(const LAS f32x4v*)(xs + 32 + 8 * g), b1 = *(const LAS f32x4v*)(xs + 32 + 8 * g + 4);
            const float s1[4] = {a0[0] + b0[0], a0[2] + b0[2], a1[0] + b1[0], a1[2] + b1[2]}, s2[4] = {a0[1] + b0[1], a0[3] + b0[3], a1[1] + b1[1], a1[3] + b1[3]};
#pragma unroll
            for (int it = 0; it < 2; ++it) { const float gt[4] = {bflo(gfp[it].x), bfhi(gfp[it].x), bflo(gfp[it].y), bfhi(gfp[it].y)}, vt[4] = {bflo(vfp[it].x), bfhi(vfp[it].x), bflo(vfp[it].y), bfhi(vfp[it].y)};
#pragma unroll
                for (int r = 0; r < 4; ++r) { const float mean = s1[r] * (1.0f / 64.0f), var = fmaxf(s2[r] * (1.0f / 64.0f) - mean * mean, 0.f), rstd = rsqrtf(var + 64e-5f);
                    if (!(HACK & 2)) MIX[(size_t)((ck - 1) * 16 + 4 * g + r) * DM + 16 * it] = (bf16)f2bf(((Yp[it][r] - mean) * rstd * lnw[it] + lnb[it] + bnp[r] * vt[r]) * gt[r]); } }
            if (ck == 512) break;
        }
        if (HACK & 4) { LDS_BARRIER(); continue; }
        const LAS unsigned char* R = L + (ck & 1) * RC_BYTES;
        bf16x8 at[2], rt[2];
#pragma unroll
        for (int kk = 0; kk < 2; ++kk) { at[kk] = *(const LAS bf16x8*)(R + RC_AT + kk * 1024 + lane * 16); rt[kk] = *(const LAS bf16x8*)(R + RC_RT + kk * 1024 + lane * 16); }
        f32x4v U[2], Y[2];
#pragma unroll
        for (int it = 0; it < 2; ++it) { U[it] = *(const LAS f32x4v*)(R + RC_U0 + (2 * cw + it) * 1024 + lane * 16); Y[it] = *(const LAS f32x4v*)(R + RC_Y0 + (2 * cw + it) * 1024 + lane * 16); }
#pragma unroll
        for (int kk = 0; kk < 2; ++kk)
#pragma unroll
            for (int it = 0; it < 2; ++it) { v4u pw; pw.x = pg8::cvt_pk_bf16(S[2 * kk][it][0], S[2 * kk][it][1]); pw.y = pg8::cvt_pk_bf16(S[2 * kk][it][2], S[2 * kk][it][3]);
                pw.z = pg8::cvt_pk_bf16(S[2 * kk + 1][it][0], S[2 * kk + 1][it][1]); pw.w = pg8::cvt_pk_bf16(S[2 * kk + 1][it][2], S[2 * kk + 1][it][3]); const bf16x8 sf = __builtin_bit_cast(bf16x8, pw);
                U[it] = __builtin_amdgcn_mfma_f32_16x16x32_bf16(at[kk], sf, U[it], 0, 0, 0); Y[it] = __builtin_amdgcn_mfma_f32_16x16x32_bf16(rt[kk], sf, Y[it], 0, 0, 0); }
        bf16x8 uv[2];
#pragma unroll
        for (int it = 0; it < 2; ++it) { vfp[it] = *(const LAS v2u*)(R + RC_VF + (2 * cw + it) * 512 + lane * 8); gfp[it] = *(const LAS v2u*)(R + RC_GF + (2 * cw + it) * 512 + lane * 8);
            v4u pw; pw.x = pg8::cvt_pk_bf16(U[it][0], U[it][1]); pw.y = pg8::cvt_pk_bf16(U[it][2], U[it][3]); pw.z = vfp[it].x; pw.w = vfp[it].y; uv[it] = __builtin_bit_cast(bf16x8, pw); }
#pragma unroll
        for (int jt = 0; jt < 4; ++jt) { const bf16x8 bk = *(const LAS bf16x8*)(R + RC_BK + jt * 1024 + lane * 16); const f32x4v p15 = *(const LAS f32x4v*)(R + RC_P15 + (16 * jt + 4 * g) * 4);
#pragma unroll
            for (int it = 0; it < 2; ++it) S[jt][it] = __builtin_amdgcn_mfma_f32_16x16x32_bf16(bk, uv[it], S[jt][it] * p15, 0, 0, 0); }
        bnp = *(const LAS f32x4v*)(R + RC_BN + 16 * g); Yp[0] = Y[0]; Yp[1] = Y[1];
        { LAS float* xo = XS + (ck & 1) * 64 + cw * 32; const f32x4v sm = Y[0] + Y[1], sq = Y[0] * Y[0] + Y[1] * Y[1];
#pragma unroll
          for (int r = 0; r < 4; ++r) { const float a = sum16(sm[r]), q = sum16(sq[r]); if (n == 0) { xo[(4 * g + r) * 2] = a; xo[(4 * g + r) * 2 + 1] = q; } } }
        LDS_BARRIER();
    }
}
template <int HACK = 0> __device__ __forceinline__ void mixers_v4(Frame& F, int l, int qi, int mask = 15) {
    gu32* ctr = F.ctl + CW_Q + 64 * qi;
    for (;;) {
        const int it = next_item(F, ctr); relaunder(F); relaunder_tid(F);
        if (it < 32) { if (mask & 1) rwkv_scan_unit<HACK>(F, l, it >> 4, it & 15); }
        else if (it < 48) { const int j = it - 32; if (mask & 2) gla_scan_unit<HACK>(F, l, j >> 3, (j >> 1) & 3, j & 1); }
        else if (it < 48 + 1024) { const int j = it - 48, qb = 63 - (j >> 4), bh = j & 15; if (mask & 4) attn_unit<true>(F, l, bh >> 3, bh & 7, qb); }
        else if (it < 48 + 2048) { const int j = it - 1072, qb = j & 63, bh = j >> 6; if (mask & 8) attn_unit<false>(F, l, bh >> 3, bh & 7, qb); }
        else break;
    }
}
template <int HACK = 0> __device__ __forceinline__ void prep_rwkv(Frame& F, int l) {
    LAS float* zl = (LAS float*)(F.lds + RING_OFF) + 4096;
    LAS bf16* inb = (LAS bf16*)(F.lds + RING_OFF);
    const float* mu = F.kin[I_RMU] + (size_t)l * 3264;
    const float* LOWR = WSP(float, WS_LOWR); const bf16* COLS = WSP(bf16, WS_COLS);
    float* RW = WSP(float, WS_RW); unsigned* RWU = WSP(unsigned, WS_RW); float* VF = WSP(float, WS_VFIRST);
    constexpr size_t RS = RW_ONE / 4;
    for (int tile = F.bx; tile < M / 16; tile += F.G) {
        const int row0 = tile * 16;
        relaunder(F); relaunder_tid(F);
        __syncthreads();
        {
            float cur_[7], prv_[7], mu_[7];
#pragma unroll
            for (int q = 0; q < 7; ++q) { const int idx = F.tid + NWAVES * 64 * q, tt = idx / 224, j = idx % 224, row = row0 + tt;
                const int col = j < 192 ? 16 + j : 208 + (j - 192);
                const float* mp = j < 192 ? mu + 3072 + j : F.kin[I_VRMU] + (l ? (l - 1) * 32 : 0) + (j - 192);
                cur_[q] = LOWR[(size_t)row * 256 + col]; prv_[q] = LOWR[(size_t)((row & (SEQ - 1)) ? row - 1 : row) * 256 + col]; mu_[q] = *mp; }
#pragma unroll
            for (int q = 0; q < 7; ++q) { const int idx = F.tid + NWAVES * 64 * q, tt = idx / 224, j = idx % 224, row = row0 + tt;
                const float prev = (row & (SEQ - 1)) ? prv_[q] : 0.f, muv = (j >= 192 && l == 0) ? 0.f : mu_[q];
                float x = cur_[q] + (prev - cur_[q]) * muv;
                if (j < 64) x = tanhf(x); else if (j >= 128 && j < 192) x = sigmoid_f(x);
                inb[tt * 232 + j] = (bf16)f2bf(x); } }
        __syncthreads();
        {
            const int c = 2 * F.tid;
            float accw[2][16], acca[2][16], accg[2][16], accv[2][16];
#pragma unroll
            for (int e = 0; e < 2; ++e) { const float bw = F.kin[I_RW0][l * 1024 + c + e], ba = F.kin[I_RA0][l * 1024 + c + e], bv = l ? F.kin[I_VR0][(l - 1) * 1024 + c + e] : 0.f;
#pragma unroll
              for (int tt = 0; tt < 16; ++tt) { accw[e][tt] = bw; acca[e][tt] = ba; accg[e][tt] = 0.f; accv[e][tt] = bv; } }
#define LOWRANK_MFMA(ACC, MI, JOFF, NKS) do { const bf16* wf_ = WSP(bf16, WS_WF) + ((size_t)(l * 448 + ((MI) < 3 ? (MI) * 128 + 16 * (NKS) / 2 * F.wave : 384 + 8 * F.wave)) * 64 + F.lane) * 8; \
            bf16x8 af_[NKS], bf_[8][NKS]; \
            _Pragma("unroll") for (int ks = 0; ks < (NKS); ++ks) af_[ks] = *(const LAS bf16x8*)(inb + (F.lane & 15) * 232 + (JOFF) + 32 * ks + 8 * (F.lane >> 4)); \
            _Pragma("unroll") for (int nt = 0; nt < 8; ++nt) _Pragma("unroll") for (int ks = 0; ks < (NKS); ++ks) bf_[nt][ks] = *(const bf16x8*)(wf_ + (size_t)(nt * (NKS) + ks) * 512); \
            _Pragma("unroll") for (int nt = 0; nt < 8; ++nt) { f32x4 c4 = {0.f, 0.f, 0.f, 0.f}; \
                _Pragma("unroll") for (int ks = 0; ks < (NKS); ++ks) c4 = __builtin_amdgcn_mfma_f32_16x16x32_bf16(af_[ks], bf_[nt][ks], c4, 0, 0, 0); \
                _Pragma("unroll") for (int rr = 0; rr < 4; ++rr) zl[(4 * (F.lane >> 4) + rr) * 1028 + 128 * F.wave + 16 * nt + (F.lane & 15)] = c4[rr]; } \
            __syncthreads(); \
            _Pragma("unroll") for (int tt = 0; tt < 16; ++tt) { const f32x2_t z2 = *(const LAS f32x2_t*)(zl + tt * 1028 + c); ACC[0][tt] += z2.x; ACC[1][tt] += z2.y; } \
            __syncthreads(); } while (0)
            if (!(HACK & 1)) { LOWRANK_MFMA(accw, 0, 0, 2); relaunder(F);
            LOWRANK_MFMA(acca, 1, 64, 2); relaunder(F);
            LOWRANK_MFMA(accg, 2, 128, 2); relaunder(F);
            if (l) LOWRANK_MFMA(accv, 3, 192, 1); }
#undef LOWRANK_MFMA
            relaunder(F);
            float mur[2], muk[2], muv[2], kkv[2], kav[2], pr[2] = {0.f, 0.f}, pk[2] = {0.f, 0.f}, pv[2] = {0.f, 0.f}; float cl[2] = {0.f, 0.f};
#pragma unroll
            for (int e = 0; e < 2; ++e) { mur[e] = F.kin[I_RMU][l * 3264 + c + e]; muk[e] = F.kin[I_RMU][l * 3264 + 1024 + c + e]; muv[e] = F.kin[I_RMU][l * 3264 + 2048 + c + e]; kkv[e] = F.kin[I_RKK][l * 1024 + c + e]; kav[e] = F.kin[I_RKA][l * 1024 + c + e]; }
            if ((row0 & (SEQ - 1)) != 0) { const bf16* p = COLS + (size_t)(row0 - 1) * NMAIN + c; const unsigned ur = *(const unsigned*)(p + CC_R), uk = *(const unsigned*)(p + CC_K), uv = *(const unsigned*)(p + CC_V);
                pr[0] = bflo(ur); pr[1] = bfhi(ur); pk[0] = bflo(uk); pk[1] = bfhi(uk); pv[0] = bflo(uv); pv[1] = bfhi(uv); }
            constexpr int PFD = 4;
            unsigned pur[16], puk[16], puv[16]; f32x2_t pvf[16];
#define PF_TOK(T) do { const bf16* p_ = COLS + (size_t)(row0 + (T)) * NMAIN + c; pur[T] = *(const unsigned*)(p_ + CC_R); puk[T] = *(const unsigned*)(p_ + CC_K); puv[T] = *(const unsigned*)(p_ + CC_V); \
                pvf[T] = *(const f32x2_t*)(VF + (size_t)(row0 + (T)) * 1024 + c); } while (0)
#pragma unroll
            for (int tt = 0; tt < PFD; ++tt) PF_TOK(tt);
            asm volatile("" ::: "memory");
            if (!(HACK & 4))
#pragma unroll
            for (int tt = 0; tt < 16; ++tt) { const int row = row0 + tt; const size_t o = (size_t)row * 1024 + c;
                if (tt + PFD < 16) { PF_TOK(tt + PFD < 16 ? tt + PFD : 15); }
                asm volatile("" ::: "memory");
                const unsigned ur = pur[tt], uk = puk[tt], uv = puv[tt];
                const float cr[2] = {bflo(ur), bfhi(ur)}, ck[2] = {bflo(uk), bfhi(uk)}, cv[2] = {bflo(uv), bfhi(uv)};
                f32x2_t vf2 = pvf[tt];
                float r[2], k[2], v[2], dec[2], av[2], kk[2], km[2];
#pragma unroll
                for (int e = 0; e < 2; ++e) { r[e] = cr[e] + (pr[e] - cr[e]) * mur[e]; k[e] = ck[e] + (pk[e] - ck[e]) * muk[e]; v[e] = cv[e] + (pv[e] - cv[e]) * muv[e]; pr[e] = cr[e]; pk[e] = ck[e]; pv[e] = cv[e];
                    if (l == 0) vf2[e] = v[e]; else { const float vg = sigmoid_f(accv[e][tt]); v[e] = v[e] + (vf2[e] - v[e]) * vg; }
                    cl[e] += -0.6065306597126334f * sigmoid_f(accw[e][tt]); dec[e] = cl[e]; av[e] = sigmoid_f(acca[e][tt]); kk[e] = k[e] * kkv[e]; km[e] = k[e] * (1.0f + (av[e] - 1.0f) * kav[e]); }
                const float ss = sum32(kk[0] * kk[0] + kk[1] * kk[1]), rn = rsqrtf(fmaxf(ss, 1e-24f)); kk[0] *= rn; kk[1] *= rn;
                if (l == 0) *(f32x2_t*)(VF + o) = vf2;
                *(f32x2_t*)(RW + RS + o) = (f32x2_t){dec[0], dec[1]};
                *(v2u*)(RWU + o) = (v2u){pk2(r[0], km[0]), pk2(r[1], km[1])}; *(v2u*)(RWU + 2 * RS + o) = (v2u){pk2(v[0], accg[0][tt]), pk2(v[1], accg[1][tt])};
                *(v2u*)(RWU + 3 * RS + o) = (v2u){pk2(-kk[0], kk[0] * av[0]), pk2(-kk[1], kk[1] * av[1])}; }
#undef PF_TOK
        }
        asm volatile("s_waitcnt vmcnt(0)" ::: "memory"); __syncthreads();
        __builtin_amdgcn_fence(__ATOMIC_ACQUIRE, "agent"); asm volatile("s_waitcnt vmcnt(0)" ::: "memory");
        if (!(HACK & 2)) rwkv_chunks_of_tile(F, l, tile);
    }
}
struct Args { const float* in[35]; float* out; unsigned char* ws; };
__device__ __forceinline__ void mk_frame(Frame& F, int wv) {
    extern __shared__ __attribute__((aligned(16))) unsigned char lds[];
    kargp kp = (kargp)__builtin_amdgcn_kernarg_segment_ptr(); asm volatile("" : "+s"(kp));
    F.kin = kp;
    F.lds = (LAS unsigned char*)lds;
    F.MISC = (volatile LAS unsigned*)(F.lds + MISC_OFF);
    { int w_ = wv; asm volatile("" : "+s"(w_)); int t_ = (int)__builtin_amdgcn_mbcnt_hi(~0u, __builtin_amdgcn_mbcnt_lo(~0u, (unsigned)w_ * 64u)); asm volatile("" : "+v"(t_)); F.tid = t_; } F.lane = F.tid & 63; F.wave = __builtin_amdgcn_readfirstlane(F.tid >> 6);
    F.G = gridDim.x; { int bx = blockIdx.x; asm volatile("" : "+s"(bx)); F.bx = bx; F.vcu = (F.G % 8 == 0) ? (bx % 8) * (F.G / 8) + bx / 8 : bx; }
    F.out = (float*)kp[35]; F.ws = (unsigned char*)kp[36]; F.ctl = (gu32*)(F.ws + WS_CTL);
}
__device__ __forceinline__ void grid_bar(int wv) {
    Frame F; mk_frame(F, wv);
    XcdBarrier bar; bar.bar = (unsigned*)(F.ctl + CW_BAR); bar.x = xb_xcc_id(); bar.st = F.MISC + 8;
    xcd_barrier(bar);
}
__global__ void __launch_bounds__(NWAVES * 64, 2) mega_fwd(Args args) {
    const int wv = __builtin_amdgcn_readfirstlane((int)threadIdx.x >> 6);
    { Frame F; mk_frame(F, wv);
      for (int u = F.tid; u < (LDS_BYTES - LDSCTL_OFF) / 4; u += NWAVES * 64) ((LAS unsigned*)(F.lds + LDSCTL_OFF))[u] = 0u;
      __syncthreads();
      (void)xcd_barrier_post((unsigned*)(F.ctl + CW_BAR), F.MISC + 8);
      p0_prologue_a(F);
    }
    grid_bar(wv);
    { Frame F; mk_frame(F, wv); p0_prologue_b(F); }
    grid_bar(wv);
#pragma unroll 1
    for (int l = 0; l < NLAYER; ++l) {
#define LAYER_VARS const float* mod = WSP(float, WS_MOD) + (size_t)l * 2 * 24576; const float* xin = l == 0 ? F.kin[I_X] : F.out; (void)mod; (void)xin
        { Frame F; mk_frame(F, wv); LAYER_VARS; if (l == 0) rms_phase(F, F.kin[I_X], mod + 0, mod + 4096); else rms_phase_bf(F, mod + 0, mod + 4096); }
        grid_bar(wv);
        { Frame F; mk_frame(F, wv);
          pg8::Gemm g{WSP(pg8::bf16_t, WS_XN), WSP(pg8::bf16_t, WS_WIN + l * WIN_L), M, NIN, DM}; pg8::StaticOrder S; S.init(M, NIN, F.G, F.bx);
          pg8::EpiCols E{WSP(pg8::bf16_t, WS_COLS), WSP(float, WS_LOWR)};
          pg8::gemm_phase<pg8::EpiCols, pg8::StaticOrder, true, true>(F.lds + RING_OFF, g, S, E, F.tid); }
        grid_bar(wv);
        { Frame F; mk_frame(F, wv); prep_norm(F, l); }
        { Frame F; mk_frame(F, wv); prep_loga(F, l); }
        { Frame F; mk_frame(F, wv); prep_rwkv(F, l); }
        { Frame F; mk_frame(F, wv); prep_vt(F, 0); }
        { Frame F; mk_frame(F, wv); prep_vt(F, 1); }
        { Frame F; mk_frame(F, wv); prep_vt(F, 2); }
        { Frame F; mk_frame(F, wv); prep_vt(F, 3); }
        { Frame F; mk_frame(F, wv); prep_vt(F, 4); }
        { Frame F; mk_frame(F, wv); prep_gla(F); }
        grid_bar(wv);
        { Frame F; mk_frame(F, wv); mixers_v4(F, l, l); }
        grid_bar(wv);
        { Frame F; mk_frame(F, wv); gla_post(F, l); }
        grid_bar(wv);
        { Frame F; mk_frame(F, wv); LAYER_VARS;
          pg8::Gemm g{WSP(pg8::bf16_t, WS_MIXED), WSP(pg8::bf16_t, WS_WOUT + l * WOUT_L), M, DM, DM}; pg8::StaticOrder S; S.init(M, DM, F.G, F.bx);
          pg8::EpiRes E{l == 0 ? (const void*)F.kin[I_X] : (const void*)WSP(bf16, WS_XR), (void*)WSP(bf16, WS_XR), mod + 2 * 4096, l != 0, true};
          pg8::gemm_phase<pg8::EpiRes, pg8::StaticOrder, true, true>(F.lds + RING_OFF, g, S, E, F.tid); }
        grid_bar(wv);
        { Frame F; mk_frame(F, wv); LAYER_VARS; rms_phase_bf(F, mod + 3 * 4096, mod + 4 * 4096); }
        grid_bar(wv);
        { Frame F; mk_frame(F, wv);
          pg8::Gemm g{WSP(pg8::bf16_t, WS_XN), WSP(pg8::bf16_t, WS_W13 + l * W13_L), M, 2 * DFF, DM}; pg8::StaticOrder S; S.init(M, 2 * DFF, F.G, F.bx);
          pg8::EpiSwiglu E{WSP(pg8::bf16_t, WS_HID)};
          pg8::gemm_phase<pg8::EpiSwiglu, pg8::StaticOrder, true, true>(F.lds + RING_OFF, g, S, E, F.tid); }
        grid_bar(wv);
        { Frame F; mk_frame(F, wv); LAYER_VARS;
          pg8::Gemm g{WSP(pg8::bf16_t, WS_HID), WSP(pg8::bf16_t, WS_W2 + l * W2_L), M, DM, DFF}; pg8::StaticOrder S; S.init(M, DM, F.G, F.bx);
          pg8::EpiRes E{(const void*)WSP(bf16, WS_XR), l + 1 < NLAYER ? (void*)WSP(bf16, WS_XR) : (void*)F.out, mod + 5 * 4096, true, l + 1 < NLAYER};
          pg8::gemm_phase<pg8::EpiRes, pg8::StaticOrder, true, true>(F.lds + RING_OFF, g, S, E, F.tid); }
        if (l + 1 < NLAYER) grid_bar(wv);
#undef LAYER_VARS
    }
}

extern "C" void kernel_launch(void* const* d_in, const int* in_sizes, int n_in, void* d_out, int out_size, void* d_ws, size_t ws_size, hipStream_t stream) {
    static int grid = 0;
    if (grid == 0) {
        if (n_in != 35 || in_sizes[0] != M * DM || out_size != M * DM || ws_size < WS_END) { fprintf(stderr, "kernel_launch: unexpected shapes: n_in %d in0 %d out %d ws %zu (need %zu)\n", n_in, n_in > 0 ? in_sizes[0] : -1, out_size, ws_size, (size_t)WS_END); grid = -1; return; }
        int dev = 0, cus = 0, per_cu = 0;
        if (hipGetDevice(&dev) != hipSuccess || hipDeviceGetAttribute(&cus, hipDeviceAttributeMultiprocessorCount, dev) != hipSuccess) { grid = -1; return; }
        if (hipFuncSetAttribute((const void*)mega_fwd, hipFuncAttributeMaxDynamicSharedMemorySize, LDS_BYTES) != hipSuccess) { fprintf(stderr, "kernel_launch: hipFuncSetAttribute failed\n"); grid = -1; return; }
        if (hipOccupancyMaxActiveBlocksPerMultiprocessor(&per_cu, (const void*)mega_fwd, NWAVES * 64, LDS_BYTES) != hipSuccess || per_cu < 1) fprintf(stderr, "kernel_launch: occupancy query says %d\n", per_cu);
        (void)hipGetLastError();
        grid = cus;
    }
    if (grid < 0) return;
    if (hipMemsetAsync((char*)d_ws + WS_CTL, 0, CTL_ZERO_BYTES, stream) != hipSuccess) return;
    Args a{};
    for (int i = 0; i < 35; ++i) a.in[i] = (const float*)d_in[i];
    a.out = (float*)d_out; a.ws = (unsigned char*)d_ws;
    hipLaunchKernelGGL(mega_fwd, dim3(grid), dim3(NWAVES * 64), LDS_BYTES, stream, a);
}
```

```cpp
#include <hip/hip_runtime.h>
#include <cstdio>
#include <cstdint>
namespace pg8 {
#define PG8_LAS __attribute__((address_space(3)))
typedef unsigned short bf16_t;
typedef short bf16x8 __attribute__((ext_vector_type(8)));
typedef float f32x4 __attribute__((ext_vector_type(4)));
typedef unsigned u32x4 __attribute__((ext_vector_type(4)));
constexpr int BM = 256, BK = 64, HALF = 128, HTB = HALF * BK * 2  , STAGE_BYTES = 8 * HTB, NXCD = 8, WGM = 8;

__host__ __device__ __forceinline__ int lds_byte(int r, int c) { const int st = (r >> 4) * 2 + (c >> 5), rr = r & 15, cc = c & 31, ob = rr * 64 + cc * 2; return st * 1024 + (ob ^ (((ob >> 9) & 1) << 5)); }
__host__ __device__ __forceinline__ void stage_rc(int b, int& R, int& C) { const int st = b / 1024, sb = b % 1024, swz = sb ^ (((sb >> 9) & 1) << 5); R = (st >> 1) * 16 + swz / 64; C = (st & 1) * 32 + (swz % 64) / 2; }
__host__ __device__ __forceinline__ int perm32(int rho) { const int n = rho >> 4, i = rho & 15; return 8 * (i >> 2) + 4 * n + (i & 3); }

struct Unit { int pm, pn; };
struct Gemm { const bf16_t* A; const bf16_t* Bt; int M, N, K; };

struct StaticOrder {
    int nM, nN, nwg, G, c;
    __host__ __device__ void init(int M, int N, int G_, int c_) { nM = M / BM; nN = N / BM; nwg = nM * nN; G = G_; c = c_; }
    __host__ __device__ bool next(int i, Unit& u) const {
        const long L = (long)i * G + c; if (L >= nwg) return false;
        int wgid = (int)L; { const int q = nwg / NXCD, r = nwg % NXCD, xcd = wgid % NXCD, off = wgid / NXCD; wgid = (xcd < r ? xcd * (q + 1) : r * (q + 1) + (xcd - r) * q) + off; }
        const int nig = WGM * nN, gid = wgid / nig, fm = gid * WGM, gsz = (nM - fm) < WGM ? (nM - fm) : WGM;
        u.pm = fm + ((wgid % nig) % gsz); u.pn = (wgid % nig) / gsz; return true;
    }
    __device__ __forceinline__ void a_ready(const Unit&) const {}
    __device__ __forceinline__ void done(const Unit&) const {}
};

typedef float f32x2c_t __attribute__((ext_vector_type(2))); typedef __bf16 bf16x2c_t __attribute__((ext_vector_type(2)));
__device__ __forceinline__ unsigned cvt_pk_bf16(float lo, float hi) { const f32x2c_t v = {lo, hi}; return __builtin_bit_cast(unsigned, __builtin_convertvector(v, bf16x2c_t)); }
typedef float f32x2 __attribute__((ext_vector_type(2)));
__device__ __forceinline__ float silu_f(float x) { return x * __builtin_amdgcn_rcpf(1.0f + __builtin_amdgcn_exp2f(-1.4426950408889634f * x)); }
struct EpiCols {
    static constexpr bool PERM = true, AFTER_DRAIN = false;
    bf16_t* O; float* L;
    __device__ __forceinline__ void operator()(const f32x4 (&acc)[2][2][4][2], const Unit& u, int wr, int wc, int fr, int fq) const {
        const int row0 = u.pm * BM + wr * 64 + fr;
        if (u.pn < 41) {
            const int col0 = u.pn * BM + wc * 32 + 8 * fq;
#pragma unroll
            for (int ai = 0; ai < 2; ++ai)
#pragma unroll
                for (int m = 0; m < 4; ++m) { bf16_t* rowp = O + (size_t)(row0 + ai * HALF + m * 16) * 10496 + col0;
#pragma unroll
                    for (int bj = 0; bj < 2; ++bj) { const f32x4 v0 = acc[ai][bj][m][0], v1 = acc[ai][bj][m][1];
                        u32x4 w; w.x = cvt_pk_bf16(v0[0], v0[1]); w.y = cvt_pk_bf16(v0[2], v0[3]); w.z = cvt_pk_bf16(v1[0], v1[1]); w.w = cvt_pk_bf16(v1[2], v1[3]);
                        *(u32x4*)(rowp + bj * HALF) = w; } }
        } else {
            const int col0 = wc * 32 + 8 * fq;
#pragma unroll
            for (int ai = 0; ai < 2; ++ai)
#pragma unroll
                for (int m = 0; m < 4; ++m) { float* rowp = L + (size_t)(row0 + ai * HALF + m * 16) * 256 + col0;
#pragma unroll
                    for (int bj = 0; bj < 2; ++bj) { *(f32x4*)(rowp + bj * HALF) = acc[ai][bj][m][0]; *(f32x4*)(rowp + bj * HALF + 4) = acc[ai][bj][m][1]; } }
        }
    }
};
struct EpiRes {
    static constexpr bool PERM = true, AFTER_DRAIN = false;
    const void* base; void* out; const float* gate; bool base_bf, out_bf;
    __device__ __forceinline__ void operator()(const f32x4 (&acc)[2][2][4][2], const Unit& u, int wr, int wc, int fr, int fq) const {
        const int row0 = u.pm * BM + wr * 64 + fr, col0 = u.pn * BM + wc * 32 + 8 * fq;
        const float* gp = gate + (size_t)(u.pm >> 5) * 24576 + col0;
        f32x4 gv[2][2];
#pragma unroll
        for (int bj = 0; bj < 2; ++bj)
#pragma unroll
            for (int n = 0; n < 2; ++n) gv[bj][n] = *(const f32x4*)(gp + bj * HALF + n * 4);
#pragma unroll
        for (int ai = 0; ai < 2; ++ai) {
            f32x4 r[4][2][2];
            if (base_bf) {
#pragma unroll
                for (int m = 0; m < 4; ++m)
#pragma unroll
                    for (int bj = 0; bj < 2; ++bj) { const u32x4 w = *(const u32x4*)((const bf16_t*)base + (size_t)(row0 + ai * HALF + m * 16) * 4096 + col0 + bj * HALF);
                        r[m][bj][0] = (f32x4){__builtin_bit_cast(float, w.x << 16), __builtin_bit_cast(float, w.x & 0xffff0000u), __builtin_bit_cast(float, w.y << 16), __builtin_bit_cast(float, w.y & 0xffff0000u)};
                        r[m][bj][1] = (f32x4){__builtin_bit_cast(float, w.z << 16), __builtin_bit_cast(float, w.z & 0xffff0000u), __builtin_bit_cast(float, w.w << 16), __builtin_bit_cast(float, w.w & 0xffff0000u)}; }
            } else {
#pragma unroll
                for (int m = 0; m < 4; ++m)
#pragma unroll
                    for (int bj = 0; bj < 2; ++bj)
#pragma unroll
                        for (int n = 0; n < 2; ++n) r[m][bj][n] = *(const f32x4*)((const float*)base + (size_t)(row0 + ai * HALF + m * 16) * 4096 + col0 + bj * HALF + n * 4);
            }
#pragma unroll
            for (int m = 0; m < 4; ++m)
#pragma unroll
                for (int bj = 0; bj < 2; ++bj)
#pragma unroll
                    for (int n = 0; n < 2; ++n) r[m][bj][n] = r[m][bj][n] + gv[bj][n] * acc[ai][bj][m][n];
            if (out_bf) {
#pragma unroll
                for (int m = 0; m < 4; ++m)
#pragma unroll
                    for (int bj = 0; bj < 2; ++bj) { const f32x4 v0 = r[m][bj][0], v1 = r[m][bj][1];
                        u32x4 w; w.x = cvt_pk_bf16(v0[0], v0[1]); w.y = cvt_pk_bf16(v0[2], v0[3]); w.z = cvt_pk_bf16(v1[0], v1[1]); w.w = cvt_pk_bf16(v1[2], v1[3]);
                        *(u32x4*)((bf16_t*)out + (size_t)(row0 + ai * HALF + m * 16) * 4096 + col0 + bj * HALF) = w; }
            } else {
#pragma unroll
                for (int m = 0; m < 4; ++m)
#pragma unroll
                    for (int bj = 0; bj < 2; ++bj)
#pragma unroll
                        for (int n = 0; n < 2; ++n) *(f32x4*)((float*)out + (size_t)(row0 + ai * HALF + m * 16) * 4096 + col0 + bj * HALF + n * 4) = r[m][bj][n];
            }
            asm volatile("" ::: "memory");
        }
    }
};
struct EpiSwiglu {
    static constexpr bool PERM = true, AFTER_DRAIN = false;
    bf16_t* H;
    __device__ __forceinline__ void operator()(const f32x4 (&acc)[2][2][4][2], const Unit& u, int wr, int wc, int fr, int fq) const {
        const int row0 = u.pm * BM + wr * 64 + fr, col0 = u.pn * HALF + wc * 32 + 8 * fq;
#pragma unroll
        for (int ai = 0; ai < 2; ++ai)
#pragma unroll
            for (int m = 0; m < 4; ++m) { bf16_t* rowp = H + (size_t)(row0 + ai * HALF + m * 16) * 11008 + col0;
                const f32x4 a0 = acc[ai][0][m][0], a1 = acc[ai][0][m][1], b0 = acc[ai][1][m][0], b1 = acc[ai][1][m][1];
                u32x4 w; w.x = cvt_pk_bf16(silu_f(a0[0]) * b0[0], silu_f(a0[1]) * b0[1]); w.y = cvt_pk_bf16(silu_f(a0[2]) * b0[2], silu_f(a0[3]) * b0[3]);
                w.z = cvt_pk_bf16(silu_f(a1[0]) * b1[0], silu_f(a1[1]) * b1[1]); w.w = cvt_pk_bf16(silu_f(a1[2]) * b1[2], silu_f(a1[3]) * b1[3]);
                *(u32x4*)rowp = w; }
    }
};
template <class Epi, class Sched, bool ALIGN_EPI = false, bool SP2 = false>
__device__ __forceinline__ void gemm_phase(PG8_LAS unsigned char* lds, const Gemm g, const Sched& S, const Epi& E, int tid_in) {
    int tid_ = tid_in; asm volatile("" : "+v"(tid_));
    const int tid = tid_, wid = __builtin_amdgcn_readfirstlane(tid >> 6), lane = tid & 63, wr = wid >> 2, wc = wid & 3, fr = lane & 15, fq = lane >> 4;
    const int K = g.K, nt = K / BK;
    unsigned voffA[2], voffB[2];
#pragma unroll
    for (int i = 0; i < 2; ++i) { int R, C; stage_rc(tid * 16 + i * 8192, R, C); const int Rb = Epi::PERM ? ((R & ~31) + perm32(R & 31)) : R;
        voffA[i] = (unsigned)(R * K + C) * 2u; voffB[i] = (unsigned)(Rb * K + C) * 2u; }
    const size_t kstep = (size_t)(BK * 2);
    const size_t hstep = (size_t)HALF * K * 2;
    const size_t tstep = 2 * hstep;
    const unsigned ldsw = (unsigned)wid * 1024u;
    const int aoff = lds_byte(wr * 64 + fr, fq * 8), boff = lds_byte(wc * 32 + fr, fq * 8);
#define PG8_SA(b, h) (((b) * 2 + (h)) * HTB)
#define PG8_SB(b, h) ((4 + (b) * 2 + (h)) * HTB)
#define PG8_STAGE(bufoff, gbase, voff) do { _Pragma("unroll") for (int _i = 0; _i < 2; ++_i) \
        __builtin_amdgcn_global_load_lds((const unsigned*)((const char*)(gbase) + (voff)[_i]), (PG8_LAS unsigned*)(lds + (bufoff) + ldsw + _i * 8192), 16, 0, 0); } while (0)
#define PG8_LDA(dst, b, h) do { _Pragma("unroll") for (int m = 0; m < 4; ++m) _Pragma("unroll") for (int k = 0; k < 2; ++k) dst[m][k] = *(const PG8_LAS bf16x8*)(lds + PG8_SA(b, h) + aoff + m * 2048 + k * 1024); } while (0)
#define PG8_LDB(dst, b, h) do { _Pragma("unroll") for (int n = 0; n < 2; ++n) _Pragma("unroll") for (int k = 0; k < 2; ++k) dst[n][k] = *(const PG8_LAS bf16x8*)(lds + PG8_SB(b, h) + boff + n * 2048 + k * 1024); } while (0)
#define PG8_MMA(ai, bj, At, Bt) do { __builtin_amdgcn_s_setprio(1); _Pragma("unroll") for (int m = 0; m < 4; ++m) _Pragma("unroll") for (int n = 0; n < 2; ++n) _Pragma("unroll") for (int k = 0; k < 2; ++k) \
        acc[ai][bj][m][n] = __builtin_amdgcn_mfma_f32_16x16x32_bf16(Bt[n][k], At[m][k], acc[ai][bj][m][n], 0, 0, 0); __builtin_amdgcn_s_setprio(0); } while (0)
#define PG8_WAIT_V(n) asm volatile("s_waitcnt vmcnt(" #n ")" ::: "memory")
#define PG8_WAIT_L(n) asm volatile("s_waitcnt lgkmcnt(" #n ")" ::: "memory")
#define PG8_BAR __builtin_amdgcn_s_barrier()
#define PG8_SCHED __builtin_amdgcn_sched_barrier(0)
    Unit cur, nxt; int ui = 0;
    if (!S.next(0, cur)) return;
    f32x4 acc[2][2][4][2];
#pragma unroll
    for (int a = 0; a < 2; ++a)
#pragma unroll
        for (int b = 0; b < 2; ++b)
#pragma unroll
            for (int m = 0; m < 4; ++m)
#pragma unroll
                for (int n = 0; n < 2; ++n) acc[a][b][m][n] = (f32x4){0.f, 0.f, 0.f, 0.f};
    bf16x8 At[4][2], B0[2][2], B1[2][2];
    const char* cA = (const char*)g.A + (size_t)cur.pm * tstep; const char* cB = (const char*)g.Bt + (size_t)cur.pn * tstep;
    S.a_ready(cur);
    if constexpr (SP2) {
        PG8_STAGE(PG8_SB(0, 0), cB, voffB); PG8_STAGE(PG8_SB(0, 1), cB + hstep, voffB); PG8_STAGE(PG8_SA(0, 0), cA, voffA); PG8_STAGE(PG8_SA(0, 1), cA + hstep, voffA);
        if (wr == 1) PG8_BAR;
        PG8_WAIT_V(2); PG8_BAR;
        PG8_STAGE(PG8_SB(1, 0), cB + kstep, voffB); PG8_STAGE(PG8_SA(1, 0), cA + kstep, voffA); PG8_STAGE(PG8_SB(1, 1), cB + hstep + kstep, voffB);
        PG8_WAIT_V(6); PG8_BAR;
    } else {
        PG8_STAGE(PG8_SB(0, 0), cB, voffB); PG8_STAGE(PG8_SA(0, 0), cA, voffA); PG8_STAGE(PG8_SB(0, 1), cB + hstep, voffB); PG8_STAGE(PG8_SA(0, 1), cA + hstep, voffA);
        if (wr == 1) PG8_BAR;
        PG8_WAIT_V(4); PG8_BAR;
        PG8_STAGE(PG8_SB(1, 0), cB + kstep, voffB); PG8_STAGE(PG8_SA(1, 0), cA + kstep, voffA); PG8_STAGE(PG8_SB(1, 1), cB + hstep + kstep, voffB);
        PG8_WAIT_V(6); PG8_BAR;
    }
    for (;;) {
        const bool has_next = S.next(ui + 1, nxt);
        const char* nA = has_next ? (const char*)g.A + (size_t)nxt.pm * tstep : cA; const char* nB = has_next ? (const char*)g.Bt + (size_t)nxt.pn * tstep : cB;
        for (int t = 0; t < nt; t += 2) {
            const bool last = (t == nt - 2);
            const char* a1 = cA + (size_t)(t + 1) * kstep;
            const char* a2 = last ? nA : cA + (size_t)(t + 2) * kstep; const char* b2 = last ? nB : cB + (size_t)(t + 2) * kstep;
            const char* a3 = a2 + kstep; const char* b3 = b2 + kstep;
            if (last && has_next) S.a_ready(nxt);
            if constexpr (SP2) {
            PG8_LDB(B0, 0, 0); PG8_LDB(B1, 0, 1); PG8_SCHED; PG8_LDA(At, 0, 0); PG8_STAGE(PG8_SA(1, 1), a1 + hstep, voffA);
            PG8_WAIT_V(8); PG8_WAIT_L(0); PG8_BAR; PG8_MMA(0, 0, At, B0); PG8_MMA(0, 1, At, B1); PG8_BAR; PG8_SCHED;
            PG8_LDA(At, 0, 1); PG8_STAGE(PG8_SB(0, 0), b2, voffB); PG8_STAGE(PG8_SB(0, 1), b2 + hstep, voffB); PG8_STAGE(PG8_SA(0, 0), a2, voffA);
            PG8_WAIT_V(8); PG8_WAIT_L(0); PG8_BAR; PG8_MMA(1, 0, At, B0); PG8_MMA(1, 1, At, B1); PG8_BAR; PG8_SCHED;
            PG8_LDB(B0, 1, 0); PG8_LDB(B1, 1, 1); PG8_SCHED; PG8_LDA(At, 1, 0); PG8_STAGE(PG8_SA(0, 1), a2 + hstep, voffA);
            PG8_WAIT_V(8); PG8_WAIT_L(0); PG8_BAR; PG8_MMA(0, 0, At, B0); PG8_MMA(0, 1, At, B1); PG8_BAR; PG8_SCHED;
            PG8_LDA(At, 1, 1); PG8_STAGE(PG8_SB(1, 0), b3, voffB); PG8_STAGE(PG8_SB(1, 1), b3 + hstep, voffB); PG8_STAGE(PG8_SA(1, 0), a3, voffA);
            PG8_WAIT_V(8); PG8_WAIT_L(0); PG8_BAR; PG8_MMA(1, 0, At, B0); PG8_MMA(1, 1, At, B1); PG8_BAR; PG8_SCHED;
            } else {
            PG8_LDB(B0, 0, 0); PG8_SCHED; PG8_LDA(At, 0, 0); PG8_STAGE(PG8_SA(1, 1), a1 + hstep, voffA);
            PG8_WAIT_L(8); PG8_BAR; PG8_WAIT_L(0); PG8_MMA(0, 0, At, B0); PG8_BAR; PG8_SCHED;
            PG8_LDB(B1, 0, 1); PG8_STAGE(PG8_SB(0, 0), b2, voffB);
            PG8_BAR; PG8_WAIT_L(0); PG8_MMA(0, 1, At, B1); PG8_BAR;
            PG8_LDA(At, 0, 1); PG8_STAGE(PG8_SA(0, 0), a2, voffA);
            PG8_BAR; PG8_WAIT_L(0); PG8_MMA(1, 0, At, B0); PG8_BAR; PG8_SCHED;
            PG8_STAGE(PG8_SB(0, 1), b2 + hstep, voffB);
            PG8_WAIT_V(6); PG8_BAR; PG8_MMA(1, 1, At, B1); PG8_BAR;
            PG8_LDB(B0, 1, 0); PG8_SCHED; PG8_LDA(At, 1, 0); PG8_STAGE(PG8_SA(0, 1), a2 + hstep, voffA);
            PG8_WAIT_L(8); PG8_BAR; PG8_WAIT_L(0); PG8_MMA(0, 0, At, B0); PG8_BAR; PG8_SCHED;
            PG8_LDB(B1, 1, 1); PG8_STAGE(PG8_SB(1, 0), b3, voffB);
            PG8_BAR; PG8_WAIT_L(0); PG8_MMA(0, 1, At, B1); PG8_BAR;
            PG8_LDA(At, 1, 1); PG8_STAGE(PG8_SA(1, 0), a3, voffA);
            PG8_BAR; PG8_WAIT_L(0); PG8_MMA(1, 0, At, B0); PG8_BAR; PG8_SCHED;
            PG8_STAGE(PG8_SB(1, 1), b3 + hstep, voffB);
            PG8_WAIT_V(6); PG8_BAR; PG8_MMA(1, 1, At, B1); PG8_BAR;
            }
        }
        if constexpr (ALIGN_EPI) { if (wr == 0) PG8_BAR; }
        if constexpr (!Epi::AFTER_DRAIN) { E(acc, cur, wr, wc, fr, fq); S.done(cur); }
        if (!has_next) break;
#pragma unroll
        for (int a = 0; a < 2; ++a)
#pragma unroll
            for (int b = 0; b < 2; ++b)
#pragma unroll
                for (int m = 0; m < 4; ++m)
#pragma unroll
                    for (int n = 0; n < 2; ++n) acc[a][b][m][n] = (f32x4){0.f, 0.f, 0.f, 0.f};
        cur = nxt; cA = nA; cB = nB; ++ui;
        if constexpr (ALIGN_EPI) { if (wr == 1) PG8_BAR; }
    }
    PG8_WAIT_V(0);
    if constexpr (!ALIGN_EPI) { if (wr == 0) PG8_BAR; }
    PG8_BAR;
    if constexpr (Epi::AFTER_DRAIN) { E.fused(acc, cur, wr, wc, fr, fq, lds, wid, lane); S.done(cur); }
#undef PG8_SA
#undef PG8_SB
#undef PG8_STAGE
#undef PG8_LDA
#undef PG8_LDB
#undef PG8_MMA
#undef PG8_WAIT_V
#undef PG8_WAIT_L
#undef PG8_BAR
#undef PG8_SCHED
}
}
constexpr int BATCH = 2, SEQ = 8192, DM = 4096, M = BATCH * SEQ, DFF = 11008, NLAYER = 2;
constexpr int P_IN = 10704, NIN = 10752, NMAIN = 10496;
constexpr int CA_Q = 0, CA_K = 1024, CA_V = 2048;
constexpr int CB_Q = 3072, CB_K = 3584, CB_V = 4096, CB_G = 5120;
constexpr int CC_R = 6144, CC_K = 7168, CC_V = 8192;
constexpr int CD_Q = 9216, CD_K = 10240, CD_V = 10368;
constexpr float LOG2E = 1.4426950408889634f;
constexpr float QSCALE = 0.125f * LOG2E;
constexpr int NWAVES = 8;

constexpr size_t MiB = 1u << 20;
constexpr size_t WS_CTL = 0, CTL_ZERO_BYTES = 1 * MiB;
constexpr size_t WS_MODP = 2 * MiB;
constexpr size_t WS_MOD = 14 * MiB;
constexpr size_t WS_TAB = 15 * MiB;
constexpr size_t WS_WIN = 16 * MiB, WIN_L = 84 * MiB;
constexpr size_t WS_WOUT = 184 * MiB, WOUT_L = 32 * MiB;
constexpr size_t WS_W13 = 248 * MiB, W13_L = 172 * MiB;
constexpr size_t WS_W2 = 592 * MiB, W2_L = 86 * MiB;
constexpr size_t WS_XN = 764 * MiB;
constexpr size_t WS_COLS = 892 * MiB;
constexpr size_t WS_LOWR = 1220 * MiB;
constexpr size_t WS_HID = 892 * MiB;
constexpr size_t WS_QKA = 1236 * MiB;
constexpr size_t WS_QKD = 1300 * MiB;
constexpr size_t WS_LOGA = 1336 * MiB;
constexpr size_t WS_RW = 1368 * MiB, RW_ONE = 64 * MiB;
constexpr size_t WS_VFIRST = 1816 * MiB;
constexpr size_t WS_MIXED = 1880 * MiB;
constexpr int VROW = SEQ + 64;
constexpr size_t WS_VTA = 2008 * MiB;
constexpr size_t WS_VTD = 2041 * MiB;
constexpr size_t WS_QDEC = 2046 * MiB, WS_KDT = 2062 * MiB, WS_AM = 2078 * MiB, WS_EBL = 2086 * MiB;
constexpr size_t WS_VTB = 2087 * MiB;
constexpr size_t WS_RWC = 2120 * MiB;
constexpr size_t WS_OB = 2446 * MiB;
constexpr size_t WS_PSG = 2478 * MiB;
constexpr size_t WS_WF = 2479 * MiB;
constexpr size_t WS_XR = 2480 * MiB;
constexpr size_t WS_END = 2608 * MiB;
constexpr int CW_BAR = 4096;
constexpr int CW_Q = 16384;

constexpr int RING_OFF = 0, RING_BYTES = 131072;
constexpr int LDSCTL_OFF = RING_BYTES, MISC_OFF = LDSCTL_OFF + 320;
constexpr int LDS_BYTES = 147456;

#define GAS __attribute__((address_space(1)))
#define LAS __attribute__((address_space(3)))
typedef unsigned short bf16;
typedef unsigned v4u __attribute__((ext_vector_type(4)));
typedef unsigned v2u __attribute__((ext_vector_type(2)));
typedef float f32x4 __attribute__((ext_vector_type(4)));
typedef short bf16x8 __attribute__((ext_vector_type(8)));
typedef GAS unsigned gu32;
#define RLX_AGENT __ATOMIC_RELAXED, __HIP_MEMORY_SCOPE_AGENT
#define LDS_WAIT() asm volatile("s_waitcnt lgkmcnt(0)" ::: "memory")
#define VM_WAIT() asm volatile("s_waitcnt vmcnt(0)" ::: "memory")
typedef float f32x2_t __attribute__((ext_vector_type(2))); typedef __bf16 bf16x2_t __attribute__((ext_vector_type(2)));
__device__ __forceinline__ unsigned pk2(float lo, float hi) { const f32x2_t v = {lo, hi}; return __builtin_bit_cast(unsigned, __builtin_convertvector(v, bf16x2_t)); }
__device__ __forceinline__ unsigned f2bf(float f) { return pk2(f, f) & 0xffffu; }
__device__ __forceinline__ float bf2f(unsigned short h) { return __builtin_bit_cast(float, (unsigned)h << 16); }
__device__ __forceinline__ float bflo(unsigned w) { return __builtin_bit_cast(float, w << 16); }
__device__ __forceinline__ float bfhi(unsigned w) { return __builtin_bit_cast(float, w & 0xffff0000u); }
template <int CTRL> __device__ __forceinline__ float dpp_f(float v) { return __builtin_bit_cast(float, __builtin_amdgcn_update_dpp(0, __builtin_bit_cast(int, v), CTRL, 0xF, 0xF, true)); }
__device__ __forceinline__ float sum8(float v) {
    v += dpp_f<0xB1>(v); v += dpp_f<0x4E>(v); v += dpp_f<0x141>(v); return v; }
__device__ __forceinline__ float sum32(float v) {
    v = sum8(v); v += dpp_f<0x140>(v); v += __builtin_bit_cast(float, __builtin_amdgcn_ds_swizzle(__builtin_bit_cast(int, v), 0x401F)); return v; }
__device__ __forceinline__ float wave_sum(float v) {
    v = sum8(v); v += dpp_f<0x140>(v);
    v += __builtin_bit_cast(float, __builtin_amdgcn_ds_swizzle(__builtin_bit_cast(int, v), 0x401F));
    { const int u = __builtin_bit_cast(int, v); v = __builtin_bit_cast(float, __builtin_amdgcn_readlane(u, 0)) + __builtin_bit_cast(float, __builtin_amdgcn_readlane(u, 32)); }
    return v;
}
__device__ __forceinline__ float sigmoid_f(float x) { return __builtin_amdgcn_rcpf(1.0f + __builtin_amdgcn_exp2f(-LOG2E * x)); }
__device__ __forceinline__ float silu_g(float x) { return x * sigmoid_f(x); }
__device__ __forceinline__ void unpack8(const v4u r, float (&f)[8]) { f[0] = bflo(r.x); f[1] = bfhi(r.x); f[2] = bflo(r.y); f[3] = bfhi(r.y); f[4] = bflo(r.z); f[5] = bfhi(r.z); f[6] = bflo(r.w); f[7] = bfhi(r.w); }
__device__ __forceinline__ v4u pack8(const float (&f)[8]) { v4u o; o.x = pk2(f[0], f[1]); o.y = pk2(f[2], f[3]); o.z = pk2(f[4], f[5]); o.w = pk2(f[6], f[7]); return o; }

#define XB_TMO      128
#define XB_XCNT(j)  (256  + 64 * (j))
#define XB_XSUB(j)  (1280 + 64 * (j))
#define XB_XGEN(j)  (2304 + 64 * (j))
#define XB_TOP      3328
#define XB_TOPGEN   3392
#define XCD_BAR_WORDS 3456
#define XB_SPIN_CAP (1u << 23)

__device__ __forceinline__ unsigned xb_ld(unsigned* p)              { return __hip_atomic_load(p, __ATOMIC_RELAXED, __HIP_MEMORY_SCOPE_AGENT); }
__device__ __forceinline__ unsigned xb_add(unsigned* p, unsigned v) { return __hip_atomic_fetch_add(p, v, __ATOMIC_RELAXED, __HIP_MEMORY_SCOPE_AGENT); }
__device__ __forceinline__ unsigned xb_xcc_id() { return (unsigned)__builtin_amdgcn_s_getreg((3 << 11) | 20) & 0xFu; }
#define XB_SPIN(cond, bar) do { unsigned _sp = 0; while (cond) { __builtin_amdgcn_s_sleep(1); \
    if ((++_sp & 255u) == 0u) { if (xb_ld(&(bar)[XB_TMO])) break; if (_sp > XB_SPIN_CAP) { atomicAdd(&(bar)[XB_TMO], 1u); break; } } } } while (0)

struct XcdBarrier {
    unsigned* bar; unsigned x;
    volatile LAS unsigned* st;
};

__device__ __forceinline__ XcdBarrier xcd_barrier_post(unsigned* bar, volatile LAS unsigned* st) {
    XcdBarrier b; b.bar = bar; b.x = xb_xcc_id(); b.st = st;
    if (threadIdx.x == 0) (void)xb_add(&bar[XB_XCNT(b.x)], 1u);
    return b;
}
__device__ __forceinline__ void xcd_barrier_complete(unsigned* bar, unsigned x, unsigned& nloc, unsigned& nx) {
    const unsigned G = gridDim.x * gridDim.y * gridDim.z;
    unsigned sum, cnt, mine, sp = 0u;
    for (;;) {
        sum = 0u; cnt = 0u; mine = 0u;
#pragma unroll
        for (unsigned j = 0; j < 16; ++j) { const unsigned c = xb_ld(&bar[XB_XCNT(j)]); sum += c; cnt += (c > 0u) ? 1u : 0u; mine = (j == x) ? c : mine; }
        if (sum == G) break;
        __builtin_amdgcn_s_sleep(1);
        if ((++sp & 255u) == 0u) { if (xb_ld(&bar[XB_TMO])) break; if (sp > XB_SPIN_CAP) { atomicAdd(&bar[XB_TMO], 1u); break; } }
    }
    nloc = mine > 0u ? mine : 1u; nx = cnt > 0u ? cnt : 1u;
}

__device__ __forceinline__ void xcd_barrier(const XcdBarrier& b) {
    asm volatile("s_waitcnt vmcnt(0)" ::: "memory");
    __syncthreads();
    if (threadIdx.x == 0) {
        unsigned* bar = b.bar;
        __builtin_amdgcn_s_waitcnt(0);
        unsigned nloc = b.st[0], nx = b.st[1];
        if (nloc == 0u) { xcd_barrier_complete(bar, b.x, nloc, nx); b.st[0] = nloc; b.st[1] = nx; }
        const unsigned old = xb_add(&bar[XB_XSUB(b.x)], 1u);
        const unsigned gen = old / nloc;
        if (old + 1u == (gen + 1u) * nloc) {
            __builtin_amdgcn_fence(__ATOMIC_RELEASE, "agent");
            asm volatile("s_waitcnt vmcnt(0)" ::: "memory");
            const unsigned og = xb_add(&bar[XB_TOP], 1u);
            const unsigned tg = og / nx;
            if (og + 1u == (tg + 1u) * nx) xb_add(&bar[XB_TOPGEN], 1u);
            else XB_SPIN(xb_ld(&bar[XB_TOPGEN]) == tg, bar);
            __builtin_amdgcn_fence(__ATOMIC_ACQUIRE, "agent");
            xb_add(&bar[XB_XGEN(b.x)], 1u);
            asm volatile("s_waitcnt vmcnt(0)" ::: "memory");
        } else {
            XB_SPIN(xb_ld(&bar[XB_XGEN(b.x)]) == gen, bar);
            __builtin_amdgcn_fence(__ATOMIC_ACQUIRE, "agent");
            asm volatile("s_waitcnt vmcnt(0)" ::: "memory");
        }
    }
    __syncthreads();
}

typedef const float* const __attribute__((address_space(4)))* kargp;
struct Frame {
    LAS unsigned char* lds;
    volatile LAS unsigned* MISC;
    gu32* ctl;
    int tid, lane, wave;
    int vcu, G, bx;
    kargp kin;
    float* out;
    unsigned char* ws;
};
enum { I_X = 0, I_C, I_RELB, I_ADAW, I_ADAB, I_WIN, I_WOUT, I_DQN, I_DKN, I_DLAM, I_DSUB, I_GGU, I_GGB, I_GON, I_RMU, I_RWUP, I_RW0, I_RAUP, I_RA0, I_RGUP,
       I_RKK, I_RKA, I_RRK, I_RLNW, I_RLNB, I_VRD, I_VRMU, I_VRUP, I_VR0, I_SQN, I_SKN, I_SSINK, I_W1, I_W3, I_W2 };

#define WSP(T, off) ((T*)(F.ws + (off)))
__device__ __forceinline__ void relaunder_tid(Frame& F) { int t = F.tid; asm volatile("" : "+v"(t)); F.tid = t; F.lane = t & 63; F.wave = __builtin_amdgcn_readfirstlane(t >> 6); }
__device__ __forceinline__ void relaunder(Frame& F) { kargp p = F.kin; asm volatile("" : "+s"(p)); F.kin = p; }

__device__ __forceinline__ void conv_item(const float* src, int ld, int col0, int ncols, int K, bf16* WT, int row0, int kb, LAS float* scr, int lane) {
    const int k0 = 64 * kb;
    { const int n = lane & 31; const bool ok = src != nullptr && n < ncols; const float* sp = src + (size_t)(k0 + (lane >> 5)) * ld + col0 + n; float v[32];
#pragma unroll
      for (int i = 0; i < 32; ++i) v[i] = ok ? sp[(size_t)(2 * i) * ld] : 0.f;
#pragma unroll
      for (int i = 0; i < 32; ++i) scr[(2 * i + (lane >> 5)) * 33 + n] = v[i]; }
    LDS_WAIT(); asm volatile("" ::: "memory");
    const int c = lane & 7;
#pragma unroll
    for (int j = 0; j < 4; ++j) { const int n = (lane >> 3) + 8 * j; const LAS float* s = scr + (8 * c) * 33 + n;
        v4u o; o.x = pk2(s[0 * 33], s[1 * 33]); o.y = pk2(s[2 * 33], s[3 * 33]); o.z = pk2(s[4 * 33], s[5 * 33]); o.w = pk2(s[6 * 33], s[7 * 33]);
        if (n < ncols) *(GAS v4u*)(WT + (size_t)(row0 + n) * K + k0 + 8 * c) = o; }
    LDS_WAIT(); asm volatile("" ::: "memory");
}
__device__ __forceinline__ int t5_bucket(int d) {
    if (d < 16) return d;
    int v = 16 + (int)(logf((float)d * (1.0f / 16.0f)) / logf(8.0f) * 16.0f);
    return v < 31 ? v : 31;
}
__device__ __forceinline__ void p0_prologue_a(Frame& F) {
    const int gw = F.vcu * NWAVES + F.wave, NGW = F.G * NWAVES;
    LAS float* ldsf = (LAS float*)(F.lds + RING_OFF);
    for (int i = F.tid; i < 2 * DM; i += NWAVES * 64) ldsf[i] = silu_g(F.kin[I_C][i]);
    __syncthreads();
    float* MODP = WSP(float, WS_MODP);
    for (int it = gw; it < 6144; it += NGW) {
        const int l = it / 3072, rem = it % 3072, kc = rem / 96, ng = rem % 96, n0 = 256 * ng + 4 * F.lane;
        const float* w = F.kin[I_ADAW] + ((size_t)l * DM + kc * 128) * 24576 + n0;
        f32x4 a0 = {0.f, 0.f, 0.f, 0.f}, a1 = {0.f, 0.f, 0.f, 0.f};
#pragma unroll 16
        for (int k = 0; k < 128; ++k) { const f32x4 wv = *(const f32x4*)(w + (size_t)k * 24576); const float s0 = ldsf[kc * 128 + k], s1 = ldsf[DM + kc * 128 + k]; a0 += wv * s0; a1 += wv * s1; }
        *(f32x4*)(MODP + ((size_t)(l * 32 + kc) * 2 + 0) * 24576 + n0) = a0;
        *(f32x4*)(MODP + ((size_t)(l * 32 + kc) * 2 + 1) * 24576 + n0) = a1;
    }
    for (int idx = F.bx * (NWAVES * 64) + F.tid; idx < NLAYER * 448 * 64; idx += F.G * NWAVES * 64) {
        const int l = idx / (448 * 64), rem = idx % (448 * 64), blk = rem >> 6, ln = rem & 63, n = ln & 15, g = ln >> 4;
        const int m = blk < 384 ? blk >> 7 : 3, nt = blk < 384 ? (blk & 127) >> 1 : blk - 384, ks = blk < 384 ? (blk & 1) : 0;
        const float* W = m == 0 ? F.kin[I_RWUP] + (size_t)l * 65536 : (m == 1 ? F.kin[I_RAUP] + (size_t)l * 65536 : (m == 2 ? F.kin[I_RGUP] + (size_t)l * 65536 : (l ? F.kin[I_VRUP] + (size_t)(l - 1) * 32768 : nullptr)));
        float f[8];
#pragma unroll
        for (int e = 0; e < 8; ++e) f[e] = W != nullptr ? W[(size_t)(32 * ks + 8 * g + e) * 1024 + 16 * nt + n] : 0.f;
        *(v4u*)(WSP(bf16, WS_WF) + ((size_t)(l * 448 + blk) * 64 + ln) * 8) = pack8(f);
    }
    __syncthreads();
    LAS float* scr = (LAS float*)(F.lds + RING_OFF + F.wave * 16384);
    constexpr int I_IN = 337 * 64, I_OUT = 128 * 64, I_13 = 688 * 64, I_2 = 128 * 172, I_L = I_IN + I_OUT + I_13 + I_2;
    for (int it = gw; it < NLAYER * I_L; it += NGW) {
        const int l = it / I_L; int r = it % I_L;
        if (r < I_IN) {
            const int kb = r / 337, cb = r % 337; const float* src = F.kin[I_WIN] + (size_t)l * DM * P_IN; int ld = P_IN, col0, row0, nc = 32;
            if (cb < 192) { col0 = 32 * cb; row0 = 32 * cb; }
            else if (cb < 288) { col0 = 6160 + 32 * (cb - 192); row0 = 6144 + 32 * (cb - 192); }
            else if (cb < 328) { col0 = 9424 + 32 * (cb - 288); row0 = 9216 + 32 * (cb - 288); }
            else if (cb == 328) { col0 = 6144; row0 = 10496; nc = 16; }
            else if (cb < 335) { col0 = 9232 + 32 * (cb - 329); row0 = 10512 + 32 * (cb - 329); }
            else if (cb == 335) { src = l ? F.kin[I_VRD] + (size_t)(l - 1) * DM * 32 : nullptr; ld = 32; col0 = 0; row0 = 10704; }
            else { src = nullptr; col0 = 0; row0 = 10736; nc = 16; }
            conv_item(src, ld, col0, nc, DM, WSP(bf16, WS_WIN + l * WIN_L), row0, kb, scr, F.lane); continue; }
        r -= I_IN;
        if (r < I_OUT) { const int kb = r / 128, cb = r % 128; conv_item(F.kin[I_WOUT] + (size_t)l * DM * DM, DM, 32 * cb, 32, DM, WSP(bf16, WS_WOUT + l * WOUT_L), 32 * cb, kb, scr, F.lane); continue; }
        r -= I_OUT;
        if (r < I_13) { const int kb = r / 688, cb = r % 688, pn = cb >> 3, wi = cb & 7;
            const float* src = (wi < 4 ? F.kin[I_W1] : F.kin[I_W3]) + (size_t)l * DM * DFF;
            conv_item(src, DFF, 128 * pn + 32 * (wi & 3), 32, DM, WSP(bf16, WS_W13 + l * W13_L), 32 * cb, kb, scr, F.lane); continue; }
        r -= I_13;
        { const int kb = r / 128, cb = r % 128; conv_item(F.kin[I_W2] + (size_t)l * DFF * DM, DM, 32 * cb, 32, DFF, WSP(bf16, WS_W2 + l * W2_L), 32 * cb, kb, scr, F.lane); }
    }
}
__device__ __forceinline__ void p0_prologue_b(Frame& F) {
    const int gt = F.bx * (NWAVES * 64) + F.tid, NT = F.G * NWAVES * 64;
    const float* MODP = WSP(float, WS_MODP); float* MOD = WSP(float, WS_MOD);
    for (int idx = gt; idx < NLAYER * 2 * 24576; idx += NT) {
        const int l = idx / 49152, rem = idx % 49152, b = rem / 24576, n = rem % 24576;
        float s = F.kin[I_ADAB][l * 24576 + n];
#pragma unroll 8
        for (int kc = 0; kc < 32; ++kc) s += MODP[((size_t)(l * 32 + kc) * 2 + b) * 24576 + n];
        MOD[idx] = s;
    }
    if (F.bx == 0) { float* TAB = WSP(float, WS_TAB);
        for (int i = F.tid; i < 24 * 128; i += NWAVES * 64) { const int hh = i >> 7, d = i & 127; TAB[i] = F.kin[I_RELB][t5_bucket(d) * 24 + hh] * LOG2E; } }
}
__device__ __forceinline__ void rms_phase(Frame& F, const float* xin, const float* sh, const float* sc) {
    const int gw = F.vcu * NWAVES + F.wave, NGW = F.G * NWAVES;
    bf16* XN = WSP(bf16, WS_XN);
    for (int m = gw; m < M; m += NGW) {
        const int b = m >> 13;
        const f32x4* xr = (const f32x4*)(xin + (size_t)m * DM) + F.lane;
        f32x4 v[16]; float ss = 0.f;
#pragma unroll
        for (int j = 0; j < 16; ++j) { v[j] = xr[64 * j]; ss += (v[j].x * v[j].x + v[j].y * v[j].y) + (v[j].z * v[j].z + v[j].w * v[j].w); }
        const float rstd = rsqrtf(wave_sum(ss) * (1.0f / DM) + 1e-6f);
        const f32x4* scp = (const f32x4*)(sc + (size_t)b * 24576) + F.lane; const f32x4* shp = (const f32x4*)(sh + (size_t)b * 24576) + F.lane;
        v2u* o8 = (v2u*)(XN + (size_t)m * DM) + F.lane;
#pragma unroll
        for (int j = 0; j < 16; ++j) { const f32x4 s4 = scp[64 * j], h4 = shp[64 * j]; const f32x4 o = v[j] * rstd * (s4 + 1.0f) + h4;
            v2u w; w.x = pk2(o.x, o.y); w.y = pk2(o.z, o.w); o8[64 * j] = w; }
    }
}
__device__ __forceinline__ void rms_phase_bf(Frame& F, const float* sh, const float* sc) {
    const int gw = F.vcu * NWAVES + F.wave, NGW = F.G * NWAVES;
    bf16* XN = WSP(bf16, WS_XN); const bf16* XR = WSP(bf16, WS_XR);
    for (int m = gw; m < M; m += NGW) {
        const int b = m >> 13;
        const v4u* xr = (const v4u*)(XR + (size_t)m * DM) + F.lane;
        v4u raw[8]; float ss = 0.f;
#pragma unroll
        for (int j = 0; j < 8; ++j) raw[j] = xr[64 * j];
#pragma unroll
        for (int j = 0; j < 8; ++j) { float f[8]; unpack8(raw[j], f);
#pragma unroll
            for (int e = 0; e < 8; ++e) ss += f[e] * f[e]; }
        const float rstd = rsqrtf(wave_sum(ss) * (1.0f / DM) + 1e-6f);
        const float* scp = sc + (size_t)b * 24576 + 8 * F.lane; const float* shp = sh + (size_t)b * 24576 + 8 * F.lane;
        v4u* o16 = (v4u*)(XN + (size_t)m * DM) + F.lane;
#pragma unroll
        for (int j = 0; j < 8; ++j) { float f[8]; unpack8(raw[j], f);
            const f32x4 s0 = *(const f32x4*)(scp + 512 * j), s1 = *(const f32x4*)(scp + 512 * j + 4), h0 = *(const f32x4*)(shp + 512 * j), h1 = *(const f32x4*)(shp + 512 * j + 4);
            float o[8];
#pragma unroll
            for (int e = 0; e < 4; ++e) { o[e] = f[e] * rstd * (s0[e] + 1.0f) + h0[e]; o[4 + e] = f[4 + e] * rstd * (s1[e] + 1.0f) + h1[e]; }
            o16[64 * j] = pack8(o); }
    }
}
__device__ __forceinline__ void prep_norm(Frame& F, int l) {
    const int gw = F.vcu * NWAVES + F.wave, NGW = F.G * NWAVES, lane = F.lane, sub = lane >> 3, ch = lane & 7;
    float gqa[8], gka[8], gqd[8], gkd[8];
#pragma unroll
    for (int e = 0; e < 8; ++e) { gqa[e] = F.kin[I_DQN][l * 64 + ch * 8 + e] * QSCALE; gka[e] = F.kin[I_DKN][l * 64 + ch * 8 + e];
                                  gqd[e] = F.kin[I_SQN][l * 64 + ch * 8 + e] * QSCALE; gkd[e] = F.kin[I_SKN][l * 64 + ch * 8 + e]; }
    const bf16* COLS = WSP(bf16, WS_COLS); bf16* QKA = WSP(bf16, WS_QKA); bf16* QKD = WSP(bf16, WS_QKD);
    for (int m = gw; m < M; m += NGW) {
        const bf16* src = COLS + (size_t)m * NMAIN;
#pragma unroll
        for (int i = 0; i < 4; ++i) { const int vec = i * 8 + sub, col = vec * 64 + ch * 8;
            float f[8]; unpack8(*(const v4u*)(src + CA_Q + col), f); float ss = 0.f;
#pragma unroll
            for (int e = 0; e < 8; ++e) ss += f[e] * f[e];
            ss = sum8(ss);
            const float rstd = rsqrtf(ss * (1.0f / 64.0f) + 1e-6f);
#pragma unroll
            for (int e = 0; e < 8; ++e) f[e] = f[e] * rstd * (i < 2 ? gqa[e] : gka[e]);
            *(v4u*)(QKA + (size_t)m * 2048 + col) = pack8(f); }
#pragma unroll
        for (int i = 0; i < 3; ++i) { const int vec = i * 8 + sub, col = vec * 64 + ch * 8;
            if (vec < 18) { float f[8]; unpack8(*(const v4u*)(src + CD_Q + col), f); float ss = 0.f;
#pragma unroll
                for (int e = 0; e < 8; ++e) ss += f[e] * f[e];
                ss = sum8(ss);
                const float rstd = rsqrtf(ss * (1.0f / 64.0f) + 1e-6f);
#pragma unroll
                for (int e = 0; e < 8; ++e) f[e] = f[e] * rstd * (vec < 16 ? gqd[e] : gkd[e]);
                *(v4u*)(QKD + (size_t)m * 1152 + col) = pack8(f); } }
    }
}
__device__ __forceinline__ void prep_loga(Frame& F, int l) {
    LAS float* gdl = (LAS float*)(F.lds + RING_OFF);
    float gu[16];
#pragma unroll
    for (int j = 0; j < 16; ++j) gu[j] = F.kin[I_GGU][((size_t)l * 16 + j) * 512 + F.tid];
    const float bias = F.kin[I_GGB][l * 512 + F.tid];
    const float* LOWR = WSP(float, WS_LOWR); float* LOGA = WSP(float, WS_LOGA);
    for (int tile = F.bx; tile < M / 64; tile += F.G) {
        const size_t row0 = (size_t)tile * 64;
        __syncthreads();
#pragma unroll
        for (int i = 0; i < 2; ++i) { const int idx = F.tid + 512 * i; gdl[idx] = LOWR[(row0 + (idx >> 4)) * 256 + (idx & 15)]; }
        __syncthreads();
#pragma unroll 4
        for (int t = 0; t < 64; ++t) { const LAS f32x4* gp = (const LAS f32x4*)(gdl + t * 16); const f32x4 g0 = gp[0], g1 = gp[1], g2 = gp[2], g3 = gp[3];
            float z = bias + g0.x * gu[0] + g0.y * gu[1] + g0.z * gu[2] + g0.w * gu[3] + g1.x * gu[4] + g1.y * gu[5] + g1.z * gu[6] + g1.w * gu[7]
                    + g2.x * gu[8] + g2.y * gu[9] + g2.z * gu[10] + g2.w * gu[11] + g3.x * gu[12] + g3.y * gu[13] + g3.z * gu[14] + g3.w * gu[15];
            LOGA[(row0 + t) * 512 + F.tid] = (fminf(z, 0.f) - __logf(1.0f + __expf(-fabsf(z)))) * (1.0f / 16.0f); }
    }
}
__device__ __forceinline__ int next_item(Frame& F, gu32* ctr) {
    volatile LAS int* slot = (volatile LAS int*)(F.lds + LDSCTL_OFF + 64);
    __syncthreads();
    if (F.tid == 0) *slot = (int)__hip_atomic_fetch_add(ctr, 1u, RLX_AGENT);
    __syncthreads();
    return *slot;
}
typedef float f32x16 __attribute__((ext_vector_type(16)));
__device__ __forceinline__ float xother32(float v) { unsigned a = __builtin_bit_cast(unsigned, v), b = a; asm volatile("" : "+v"(b)); auto rr = __builtin_amdgcn_permlane32_swap(a, b, false, false);
    const unsigned lo = rr[0], hi = rr[1]; return __builtin_bit_cast(float, (unsigned)((__builtin_amdgcn_mbcnt_hi(~0u, __builtin_amdgcn_mbcnt_lo(~0u, 0u)) & 32u) ? lo : hi)); }
__device__ __forceinline__ float xsum32(float v) { return v + xother32(v); }
__device__ __forceinline__ float xmax32(float v) { return fmaxf(v, xother32(v)); }
__device__ __forceinline__ int crow16(int r, int hi) { return (r & 3) + 8 * (r >> 2) + 4 * hi; }
template <bool ISA>
__device__ __forceinline__ void attn_unit(Frame& F, int l, int b, int hx, int qb) {
    constexpr int DV = ISA ? 128 : 64, NDV = DV / 32, KSTR = ISA ? 272 : 144, VSTR = 144, KBYTES = 64 * KSTR, VBYTES = DV * VSTR, BUFB = KBYTES + VBYTES, NCH = ISA ? 2 : 1;
    constexpr float NEG = -1e30f;
    LAS unsigned char* L = F.lds + RING_OFF;
    const int tid = F.tid, lane = F.lane, r32 = lane & 31, hi = lane >> 5, qs = F.wave & 3, grp = F.wave >> 2, q0 = qb * 128;
    const int kvh = hx >> 2, hd = kvh * 8 + (hx & 3) * 2 + grp;
    const bf16* Qp; const bf16* Kp; const bf16* VT; int ldq;
    if (ISA) { const bf16* QKA = WSP(bf16, WS_QKA); Qp = QKA + (size_t)b * SEQ * 2048 + hx * 128 + grp * 64; Kp = QKA + (size_t)b * SEQ * 2048 + 1024 + hx * 128; ldq = 2048; VT = WSP(bf16, WS_VTA) + (size_t)(b * 8 + hx) * 128 * VROW; }
    else { const bf16* QKD = WSP(bf16, WS_QKD); Qp = QKD + (size_t)b * SEQ * 1152 + hd * 64; Kp = QKD + (size_t)b * SEQ * 1152 + 1024 + kvh * 64; ldq = 1152; VT = WSP(bf16, WS_VTD) + (size_t)(b * 2 + kvh) * 64 * VROW; }
    const int qpos = q0 + 32 * qs + r32;
    bf16x8 qr[4];
#pragma unroll
    for (int d0 = 0; d0 < 4; ++d0) qr[d0] = *(const bf16x8*)(Qp + (size_t)qpos * ldq + d0 * 16 + hi * 8);
    LAS float* Bt = (LAS float*)(L + 2 * BUFB);
    { const float* TAB = WSP(float, WS_TAB);
      if (ISA) { if (tid < 130) Bt[tid] = tid == 0 ? NEG : (tid == 129 ? 0.f : TAB[hx * 128 + tid - 1] - TAB[hx * 128 + 127]); }
      else { if (tid < 260) { const int gi = tid >= 130, t = tid - 130 * gi; Bt[tid] = (t == 0 || t == 129) ? NEG : TAB[(8 + kvh * 8 + (hx & 3) * 2 + gi) * 128 + t - 1]; } } }
    const int TQ = q0 >> 6, T0 = ISA ? 0 : (TQ >= 2 ? TQ - 2 : 0), T1 = TQ + 1;
    v4u kreg[NCH], vreg[NCH];
#define AT_GLOAD(T) do { _Pragma("unroll") for (int i_ = 0; i_ < NCH; ++i_) { const int c_ = tid + 512 * i_; \
        const int kr_ = ISA ? (c_ >> 4) : (c_ >> 3), kc_ = ISA ? (c_ & 15) : (c_ & 7); kreg[i_] = *(const v4u*)(Kp + (size_t)((T) * 64 + kr_) * ldq + kc_ * 8); \
        const int vr_ = c_ >> 3, vc_ = c_ & 7; vreg[i_] = *(const v4u*)(VT + (size_t)vr_ * VROW + (T) * 64 + vc_ * 8); } } while (0)
#define AT_LWRITE(buf) do { _Pragma("unroll") for (int i_ = 0; i_ < NCH; ++i_) { const int c_ = tid + 512 * i_; \
        const int kr_ = ISA ? (c_ >> 4) : (c_ >> 3), kc_ = ISA ? (c_ & 15) : (c_ & 7); *(LAS v4u*)(L + (buf) * BUFB + kr_ * KSTR + kc_ * 16) = kreg[i_]; \
        const int vr_ = c_ >> 3, vc_ = c_ & 7; *(LAS v4u*)(L + (buf) * BUFB + KBYTES + vr_ * VSTR + vc_ * 16) = vreg[i_]; } } while (0)
    f32x16 o[NDV];
#pragma unroll
    for (int i = 0; i < NDV; ++i) o[i] = (f32x16){0.f, 0.f, 0.f, 0.f, 0.f, 0.f, 0.f, 0.f, 0.f, 0.f, 0.f, 0.f, 0.f, 0.f, 0.f, 0.f};
    float m_run = ISA ? NEG : F.kin[I_SSINK][l * 16 + hd] * LOG2E, l_run = ISA ? 0.f : (hi == 0 ? 1.f : 0.f);
    const int krow = (r32 & 16) | (r32 & 3) | ((r32 & 4) << 1) | ((r32 & 8) >> 1);
    const int koff = krow * KSTR + (ISA ? grp * 128 : 0) + hi * 16, voff = KBYTES + r32 * VSTR + hi * 16;
    AT_GLOAD(T0); AT_LWRITE(0); __syncthreads();
#pragma unroll 1
    for (int T = T0; T <= T1; ++T) {
        const int cur = (T - T0) & 1;
        AT_GLOAD(T < T1 ? T + 1 : T1);
        LAS const unsigned char* Kb = L + cur * BUFB;
        f32x16 s[2];
#pragma unroll
        for (int blk = 0; blk < 2; ++blk) { s[blk] = (f32x16){0.f, 0.f, 0.f, 0.f, 0.f, 0.f, 0.f, 0.f, 0.f, 0.f, 0.f, 0.f, 0.f, 0.f, 0.f, 0.f};
#pragma unroll
            for (int d0 = 0; d0 < 4; ++d0) { const bf16x8 kf = *(const LAS bf16x8*)(Kb + koff + blk * 32 * KSTR + d0 * 32); s[blk] = __builtin_amdgcn_mfma_f32_32x32x16_bf16(kf, qr[d0], s[blk], 0, 0, 0); } }
        bf16x8 vfc[NDV], vfn[NDV];
#pragma unroll
        for (int i = 0; i < NDV; ++i) vfc[i] = *(const LAS bf16x8*)(Kb + voff + i * 32 * VSTR);
        if (!ISA || T >= TQ - 2) {
            const LAS float* bt = Bt + (ISA ? 0 : grp * 130) + 1; const int d0 = qpos - T * 64 - 8 * hi;
#pragma unroll
            for (int blk = 0; blk < 2; ++blk)
#pragma unroll
                for (int r = 0; r < 16; ++r) { const int dist = d0 - (32 * blk + 16 * (r >> 3) + (r & 7)); const int di = dist < -1 ? -1 : (dist > 128 ? 128 : dist); s[blk][r] += bt[di]; } }
        float mt = s[0][0];
#pragma unroll
        for (int r = 1; r < 16; ++r) mt = fmaxf(mt, s[0][r]);
#pragma unroll
        for (int r = 0; r < 16; ++r) mt = fmaxf(mt, s[1][r]);
        mt = xmax32(mt);
        const float m_new = fmaxf(m_run, mt);
        if (__any(m_new > m_run)) { const float alpha = __builtin_amdgcn_exp2f(m_run - m_new); l_run *= alpha;
#pragma unroll
            for (int i = 0; i < NDV; ++i)
#pragma unroll
                for (int r = 0; r < 16; ++r) o[i][r] *= alpha;
            m_run = m_new; }
        float ls = 0.f;
#pragma unroll
        for (int blk = 0; blk < 2; ++blk)
#pragma unroll
            for (int r = 0; r < 16; ++r) { const float pv_ = __builtin_amdgcn_exp2f(s[blk][r] - m_run); s[blk][r] = pv_; ls += pv_; }
        l_run += ls;
#pragma unroll
        for (int sl = 0; sl < 4; ++sl) { const int blk = sl >> 1, r0 = 8 * (sl & 1);
            v4u pw; pw.x = pg8::cvt_pk_bf16(s[blk][r0], s[blk][r0 + 1]); pw.y = pg8::cvt_pk_bf16(s[blk][r0 + 2], s[blk][r0 + 3]); pw.z = pg8::cvt_pk_bf16(s[blk][r0 + 4], s[blk][r0 + 5]); pw.w = pg8::cvt_pk_bf16(s[blk][r0 + 6], s[blk][r0 + 7]);
            const bf16x8 pf = __builtin_bit_cast(bf16x8, pw);
#pragma unroll
            for (int i = 0; i < NDV; ++i) { if (sl < 3) vfn[i] = *(const LAS bf16x8*)(Kb + voff + i * 32 * VSTR + (sl + 1) * 32); o[i] = __builtin_amdgcn_mfma_f32_32x32x16_bf16(vfc[i], pf, o[i], 0, 0, 0); }
#pragma unroll
            for (int i = 0; i < NDV; ++i) vfc[i] = vfn[i]; }
        AT_LWRITE(cur ^ 1);
        __syncthreads();
    }
#undef AT_GLOAD
#undef AT_LWRITE
    const float inv = 1.0f / xsum32(l_run);
    bf16* MIX = WSP(bf16, WS_MIXED);
    if (ISA) {
        int ll_ = l; asm volatile("" : "+s"(ll_)); const float lam_init = ll_ == 0 ? 0.2f : 0.35550906759f;     float lam_full;
        { const float* lm = F.kin[I_DLAM] + (size_t)l * 256; const float s1 = wave_sum(lm[lane] * lm[64 + lane]), s2 = wave_sum(lm[128 + lane] * lm[192 + lane]); lam_full = __expf(s1) - __expf(s2) + lam_init; }
        LAS float* R1 = (LAS float*)L;
        LAS bf16* R2 = (LAS bf16*)(L + 66048);
        const int ql = 32 * qs + r32;
        if (grp == 1) {
#pragma unroll
            for (int i = 0; i < NDV; ++i)
#pragma unroll
                for (int r = 0; r < 16; ++r) R1[ql * 129 + 32 * i + crow16(r, hi)] = lam_full * inv * o[i][r]; }
        __syncthreads();
        if (grp == 0) { float ss = 0.f;
#pragma unroll
            for (int i = 0; i < NDV; ++i)
#pragma unroll
                for (int r = 0; r < 16; ++r) { const float d = o[i][r] * inv - R1[ql * 129 + 32 * i + crow16(r, hi)]; o[i][r] = d; ss += d * d; }
            const float rstd = rsqrtf(xsum32(ss) * (1.0f / 128.0f) + 1e-6f) * (1.0f - lam_init);
            const float* sl = F.kin[I_DSUB] + l * 128;
#pragma unroll
            for (int i = 0; i < NDV; ++i)
#pragma unroll
                for (int r = 0; r < 16; ++r) { const int dv = 32 * i + crow16(r, hi); R2[ql * 132 + dv] = (bf16)f2bf(o[i][r] * rstd * sl[dv]); } }
        __syncthreads();
#pragma unroll
        for (int i = 0; i < 4; ++i) { const int c = tid + 512 * i, row = c >> 4, ch = c & 15; const LAS v2u* sp = (const LAS v2u*)(R2 + row * 132 + ch * 8); const v2u a = sp[0], bb = sp[1];
            *(v4u*)(MIX + (size_t)(b * SEQ + q0 + row) * DM + hx * 128 + ch * 8) = (v4u){a.x, a.y, bb.x, bb.y}; }
    } else {
        LAS bf16* R = (LAS bf16*)L + F.wave * 2176;
#pragma unroll
        for (int i = 0; i < NDV; ++i)
#pragma unroll
            for (int r = 0; r < 16; ++r) R[r32 * 68 + 32 * i + crow16(r, hi)] = (bf16)f2bf(o[i][r] * inv);
#pragma unroll
        for (int i = 0; i < 4; ++i) { const int c = lane + 64 * i, row = c >> 3, ch = c & 7; const LAS v2u* sp = (const LAS v2u*)(R + row * 68 + ch * 8); const v2u a = sp[0], bb = sp[1];
            *(v4u*)(MIX + (size_t)(b * SEQ + q0 + 32 * qs + row) * DM + 3072 + hd * 64 + ch * 8) = (v4u){a.x, a.y, bb.x, bb.y}; }
    }
}
__device__ __forceinline__ void prep_gla(Frame& F) {
    LAS float* Lb = (LAS float*)(F.lds + RING_OFF); LAS float* Qd = Lb + 64 * 129; LAS float* Ki = Qd + 64 * 129; LAS bf16* Kt = (LAS bf16*)(Ki + 64 * 129);
    const bf16* COLS = WSP(bf16, WS_COLS); const float* LOGA = WSP(float, WS_LOGA);
    bf16* QDEC = WSP(bf16, WS_QDEC); bf16* KDT = WSP(bf16, WS_KDT); bf16* AMg = WSP(bf16, WS_AM); float* EBL = WSP(float, WS_EBL);
    for (int u = F.bx; u < 1024; u += F.G) {
        const int b = u >> 9, h = (u >> 7) & 3, ck = u & 127; const size_t row0 = (size_t)b * SEQ + ck * 64;
        __syncthreads();
        f32x4 lg[4]; v4u qv[2], kv[2];
#pragma unroll
        for (int i = 0; i < 4; ++i) { const int i4 = F.tid + 512 * i, t = i4 >> 5, d4 = (i4 & 31) * 4; lg[i] = *(const f32x4*)(LOGA + (row0 + t) * 512 + h * 128 + d4); }
#pragma unroll
        for (int i = 0; i < 2; ++i) { const int i8 = F.tid + 512 * i, t = i8 >> 4, d8 = (i8 & 15) * 8; const bf16* p = COLS + (row0 + t) * NMAIN + h * 128 + d8; qv[i] = *(const v4u*)(p + CB_Q); kv[i] = *(const v4u*)(p + CB_K); }
#pragma unroll
        for (int i = 0; i < 4; ++i) { const int i4 = F.tid + 512 * i, t = i4 >> 5, d4 = (i4 & 31) * 4;
#pragma unroll
            for (int e = 0; e < 4; ++e) Lb[t * 129 + d4 + e] = lg[i][e]; }
        __syncthreads();
        if (F.tid < 128) { float a[64];
#pragma unroll
            for (int t = 0; t < 64; ++t) a[t] = Lb[t * 129 + F.tid];
#pragma unroll
            for (int t = 1; t < 64; ++t) a[t] += a[t - 1];
#pragma unroll
            for (int t = 0; t < 64; ++t) Lb[t * 129 + F.tid] = a[t];
            EBL[(size_t)u * 128 + F.tid] = __expf(a[63]); }
        __syncthreads();
#pragma unroll
        for (int i = 0; i < 2; ++i) { const int i8 = F.tid + 512 * i, t = i8 >> 4, d8 = (i8 & 15) * 8; float q[8], k[8], qo[8]; unpack8(qv[i], q); unpack8(kv[i], k);
#pragma unroll
            for (int e = 0; e < 8; ++e) { const int d = d8 + e; const float bt = Lb[t * 129 + d], bl = Lb[63 * 129 + d];
                const float qd = q[e] * 0.08838834764831845f * __expf(bt); Qd[t * 129 + d] = qd; Ki[t * 129 + d] = k[e] * __expf(-bt); Kt[d * 72 + t] = (bf16)f2bf(k[e] * __expf(bl - bt)); qo[e] = qd; }
            *(v4u*)(QDEC + ((size_t)u * 64 + t) * 128 + d8) = pack8(qo); }
        __syncthreads();
#pragma unroll
        for (int i = 0; i < 2; ++i) { const int c_ = F.tid + 512 * i, row = c_ >> 3, ch = c_ & 7; const LAS v2u* sp = (const LAS v2u*)(Kt + row * 72 + ch * 8); const v2u a = sp[0], bb = sp[1];
            *(v4u*)(KDT + ((size_t)u * 128 + row) * 64 + ch * 8) = (v4u){a.x, a.y, bb.x, bb.y}; }
        {
          const int n = F.lane & 15, gq = F.lane >> 4, ct = F.wave >> 1, st0 = 2 * (F.wave & 1);
          f32x4 c0 = (f32x4){0.f, 0.f, 0.f, 0.f}, c1 = (f32x4){0.f, 0.f, 0.f, 0.f};
          if (st0 <= ct) {
              const LAS float* ap = Qd + (16 * ct + n) * 129 + gq; const LAS float* bp0 = Ki + (16 * st0 + n) * 129 + gq; const LAS float* bp1 = bp0 + 16 * 129;
#pragma unroll 8
              for (int ks = 0; ks < 32; ++ks) { const float av = ap[4 * ks]; c0 = __builtin_amdgcn_mfma_f32_16x16x4f32(av, bp0[4 * ks], c0, 0, 0, 0); c1 = __builtin_amdgcn_mfma_f32_16x16x4f32(av, bp1[4 * ks], c1, 0, 0, 0); } }
#pragma unroll
          for (int rr = 0; rr < 4; ++rr) { const int c = 16 * ct + 4 * gq + rr, s0 = 16 * st0 + n, s1 = s0 + 16;
              bf16* op = AMg + ((size_t)u * 64 + c) * 64; op[s0] = (bf16)f2bf(s0 <= c ? c0[rr] : 0.f); op[s1] = (bf16)f2bf(s1 <= c ? c1[rr] : 0.f); } }
    }
}
__device__ __forceinline__ void prep_vt(Frame& F, int pass) {
    LAS bf16* T = (LAS bf16*)(F.lds + RING_OFF);
    const bf16* COLS = WSP(bf16, WS_COLS);
    const int ncol = pass == 4 ? 128 : 512, nch = ncol >> 3;
    const int col0 = pass < 2 ? CA_V + 512 * pass : (pass < 4 ? CB_V + 512 * (pass - 2) : CD_V);
    bf16* dst0 = pass < 2 ? WSP(bf16, WS_VTA) + (size_t)(512 * pass) * VROW : (pass < 4 ? WSP(bf16, WS_VTB) + (size_t)(512 * (pass - 2)) * VROW : WSP(bf16, WS_VTD));
    const int rows_b = pass == 4 ? 128 : 1024;
    for (int tile = F.bx; tile < M / 64; tile += F.G) {
        const int b = tile >> 7, t0 = (tile & 127) * 64;
        __syncthreads();
        for (int idx = F.tid; idx < 64 * nch; idx += NWAVES * 64) { const int tok = idx / nch, ch = idx % nch;
            const v4u v = *(const v4u*)(COLS + (size_t)(b * SEQ + t0 + tok) * NMAIN + col0 + ch * 8); LAS unsigned* d = (LAS unsigned*)(T + tok * 522 + ch * 8); d[0] = v.x; d[1] = v.y; d[2] = v.z; d[3] = v.w; }
        __syncthreads();
        for (int idx = F.tid; idx < ncol * 8; idx += NWAVES * 64) { const int vrow = idx >> 3, ch = idx & 7;
            unsigned e[8];
#pragma unroll
            for (int k = 0; k < 8; ++k) e[k] = T[(ch * 8 + k) * 522 + vrow];
            v4u o; o.x = e[0] | (e[1] << 16); o.y = e[2] | (e[3] << 16); o.z = e[4] | (e[5] << 16); o.w = e[6] | (e[7] << 16);
            *(v4u*)(dst0 + ((size_t)b * rows_b + vrow) * VROW + t0 + ch * 8) = o; }
    }
}
typedef float f32x4v __attribute__((ext_vector_type(4)));
__device__ __forceinline__ float sum16(float v) { v = sum8(v); v += dpp_f<0x140>(v); return v; }
#define LDS_BARRIER() asm volatile("s_waitcnt lgkmcnt(0)\n\ts_barrier" ::: "memory")
template <int HACK = 0> __device__ __forceinline__ void gla_scan_unit(Frame& F, int l, int b, int h, int vh) {
    LAS unsigned char* L = F.lds + RING_OFF;
    constexpr int OQD = 0, OKT = 17408, OAM = 35840, OVT = 45056, OOT = 63488, OEB = 80896, OPS = 81408;
    const int tid = F.tid, lane = F.lane, n = lane & 15, g = lane >> 4, w = F.wave;
    const bf16* QDEC = WSP(bf16, WS_QDEC); const bf16* KDT = WSP(bf16, WS_KDT); const bf16* AMg = WSP(bf16, WS_AM); const float* EBL = WSP(float, WS_EBL);
    const bf16* VTB = WSP(bf16, WS_VTB) + (size_t)((b * 4 + h) * 256 + 128 * vh) * VROW; bf16* OB = WSP(bf16, WS_OB); float* PSG = WSP(float, WS_PSG);
    f32x4v S[8];
#pragma unroll
    for (int dt = 0; dt < 8; ++dt) S[dt] = (f32x4v){0.f, 0.f, 0.f, 0.f};
    v4u pq[2], pk[2], pa, pv[2]; float pe = 0.f;
#define GL_ISSUE(CK) do { const size_t u_ = (size_t)(b * 4 + h) * 128 + (CK); \
        _Pragma("unroll") for (int i = 0; i < 2; ++i) { const int c_ = tid + 512 * i; pq[i] = *(const v4u*)(QDEC + (u_ * 64 + (c_ >> 4)) * 128 + (c_ & 15) * 8); pk[i] = *(const v4u*)(KDT + (u_ * 128 + (c_ >> 3)) * 64 + (c_ & 7) * 8); \
            pv[i] = *(const v4u*)(VTB + (size_t)(c_ >> 3) * VROW + (CK) * 64 + (c_ & 7) * 8); } \
        pa = *(const v4u*)(AMg + (u_ * 64 + (tid >> 3)) * 64 + (tid & 7) * 8); \
        pe = EBL[u_ * 128 + (tid & 127)]; } while (0)
#define GL_WRITE() do { _Pragma("unroll") for (int i = 0; i < 2; ++i) { const int c_ = tid + 512 * i; *(LAS v4u*)(L + OQD + (c_ >> 4) * 272 + (c_ & 15) * 16) = pq[i]; *(LAS v4u*)(L + OKT + (c_ >> 3) * 144 + (c_ & 7) * 16) = pk[i]; \
            *(LAS v4u*)(L + OVT + (c_ >> 3) * 144 + (c_ & 7) * 16) = pv[i]; } \
        *(LAS v4u*)(L + OAM + (tid >> 3) * 144 + (tid & 7) * 16) = pa; \
        ((LAS float*)(L + OEB))[tid & 127] = pe; } while (0)
    GL_ISSUE(0); GL_WRITE();
    LDS_BARRIER();
#pragma unroll 1
    for (int ck = 0; ck < 128; ++ck) {
        const size_t row0 = (size_t)b * SEQ + ck * 64;
        GL_ISSUE((HACK & 1) && ck >= 2 ? 2 : (ck + 1 < 128 ? ck + 1 : 127));
        bf16x8 vf[2];
#pragma unroll
        for (int ks = 0; ks < 2; ++ks) vf[ks] = *(const LAS bf16x8*)(L + OVT + (16 * w + n) * 144 + (32 * ks + 8 * g) * 2);
        f32x4v o[4];
#pragma unroll
        for (int ct = 0; ct < 4; ++ct) o[ct] = (f32x4v){0.f, 0.f, 0.f, 0.f};
#pragma unroll
        for (int ct = 0; ct < 4; ++ct)
#pragma unroll
            for (int ks = 0; ks < 2; ++ks) { const bf16x8 af = *(const LAS bf16x8*)(L + OAM + (16 * ct + n) * 144 + (32 * ks + 8 * g) * 2); o[ct] = __builtin_amdgcn_mfma_f32_16x16x32_bf16(af, vf[ks], o[ct], 0, 0, 0); }
#pragma unroll
        for (int kk = 0; kk < 4; ++kk) { v4u pw; pw.x = pg8::cvt_pk_bf16(S[2 * kk][0], S[2 * kk][1]); pw.y = pg8::cvt_pk_bf16(S[2 * kk][2], S[2 * kk][3]);
            pw.z = pg8::cvt_pk_bf16(S[2 * kk + 1][0], S[2 * kk + 1][1]); pw.w = pg8::cvt_pk_bf16(S[2 * kk + 1][2], S[2 * kk + 1][3]); const bf16x8 sf = __builtin_bit_cast(bf16x8, pw);
#pragma unroll
            for (int ct = 0; ct < 4; ++ct) { const LAS unsigned char* qp = L + OQD + (16 * ct + n) * 272 + (32 * kk + 4 * g) * 2; const v2u qa = *(const LAS v2u*)qp, qb = *(const LAS v2u*)(qp + 32);
                o[ct] = __builtin_amdgcn_mfma_f32_16x16x32_bf16(__builtin_bit_cast(bf16x8, (v4u){qa.x, qa.y, qb.x, qb.y}), sf, o[ct], 0, 0, 0); } }
#pragma unroll
        for (int dt = 0; dt < 8; ++dt) { const f32x4v eb = *(const LAS f32x4v*)(L + OEB + (16 * dt + 4 * g) * 4); S[dt] = S[dt] * eb;
#pragma unroll
            for (int ks = 0; ks < 2; ++ks) { const bf16x8 kf = *(const LAS bf16x8*)(L + OKT + (16 * dt + n) * 144 + (32 * ks + 8 * g) * 2); S[dt] = __builtin_amdgcn_mfma_f32_16x16x32_bf16(kf, vf[ks], S[dt], 0, 0, 0); } }
        LAS float* PS = (LAS float*)(L + OPS) + (ck & 1) * 512;
#pragma unroll
        for (int ct = 0; ct < 4; ++ct)
#pragma unroll
            for (int r = 0; r < 4; ++r) { const float ss = sum16(o[ct][r] * o[ct][r]); if (n == 0) PS[(16 * ct + 4 * g + r) * 8 + w] = ss;
                *(LAS bf16*)(L + OOT + (16 * ct + 4 * g + r) * 272 + (16 * w + n) * 2) = (bf16)f2bf(o[ct][r]); }
        LDS_BARRIER();
        GL_WRITE();
        if (!(HACK & 2)) {
#pragma unroll
        for (int i = 0; i < 2; ++i) { const int c_ = tid + 512 * i, tok = c_ >> 4, ch = c_ & 15; *(v4u*)(OB + (row0 + tok) * 1024 + h * 256 + 128 * vh + ch * 8) = *(const LAS v4u*)(L + OOT + tok * 272 + ch * 16); }
        if (tid < 64) { const LAS f32x4v* pp = (const LAS f32x4v*)(PS + tid * 8); const f32x4v p0 = pp[0], p1 = pp[1]; PSG[(row0 + tid) * 8 + h * 2 + vh] = ((p0.x + p0.y) + (p0.z + p0.w)) + ((p1.x + p1.y) + (p1.z + p1.w)); } }
        LDS_BARRIER();
    }
#undef GL_ISSUE
#undef GL_WRITE
}
__device__ __forceinline__ void gla_post(Frame& F, int l) {
    const bf16* OB = WSP(bf16, WS_OB); const float* PSG = WSP(float, WS_PSG); const bf16* COLS = WSP(bf16, WS_COLS); bf16* MIX = WSP(bf16, WS_MIXED);
    const int ch = F.tid & 127, h = ch >> 5; float gain8[8];
#pragma unroll
    for (int e = 0; e < 8; ++e) gain8[e] = F.kin[I_GON][l * 256 + (ch & 31) * 8 + e];
    for (int row = F.bx * 4 + (F.tid >> 7); row < M; row += F.G * 4) {
        float ov[8], gv[8]; unpack8(*(const v4u*)(OB + (size_t)row * 1024 + ch * 8), ov); unpack8(*(const v4u*)(COLS + (size_t)row * NMAIN + CB_G + ch * 8), gv);
        const f32x2_t ps = *(const f32x2_t*)(PSG + (size_t)row * 8 + h * 2); const float rstd = rsqrtf((ps.x + ps.y) * (1.0f / 256.0f) + 1e-6f);
#pragma unroll
        for (int e = 0; e < 8; ++e) ov[e] = ov[e] * (rstd * gain8[e]) * silu_g(gv[e]);
        *(v4u*)(MIX + (size_t)row * DM + 1024 + ch * 8) = pack8(ov);
    }
}
constexpr int RC_AT = 0, RC_RT = 2048, RC_BK = 4096, RC_VF = 8192, RC_GF = 10240, RC_U0 = 12288, RC_Y0 = 16384, RC_P15 = 20480, RC_BN = 20736, RC_BYTES = 20800;
__device__ __forceinline__ void rwkv_chunks_of_tile(Frame& F, int l, int tile) {
    const int team = F.tid >> 8, tt = F.tid & 255;
    LAS float* Lt = (LAS float*)(F.lds + RING_OFF) + team * 12288;
    LAS float* XA = Lt; LAS float* XR = Lt + 1040; LAS float* ZB = Lt + 2080; LAS float* ZK = Lt + 3120; LAS float* TB = Lt + 4160; LAS float* TK = Lt + 5200; LAS float* VV = Lt + 6240;
    LAS float* ATl = Lt + 7280; LAS float* U0l = Lt + 8320; LAS float* W1 = Lt + 9360;
    LAS float* Aab = Lt + 10400; LAS float* Aak = Lt + 10672; LAS float* Arb = Lt + 10944; LAS float* Ark = Lt + 11216; LAS float* TT = Lt + 11488;
    const float* RW = WSP(float, WS_RW); const unsigned* RWU = WSP(unsigned, WS_RW); constexpr size_t RS = RW_ONE / 4; unsigned char* RWC = F.ws + WS_RWC;
    float pw_[6], pr_[4], pk_[4], pv_[4], pa_[4], pb_[4], pg_[4];
#define RC_FETCH(P) do { const int h_ = 2 * (P) + team; const size_t cb_ = (size_t)tile * 16 * 1024 + h_ * 64 + (tt & 63); const int q_ = tt >> 6; \
        pw_[4] = RW[RS + cb_ + (size_t)(q_ ? 4 * q_ - 1 : 0) * 1024]; pw_[5] = RW[RS + cb_ + (size_t)15 * 1024];            \
        _Pragma("unroll") for (int e = 0; e < 4; ++e) { const size_t o_ = cb_ + (size_t)(4 * q_ + e) * 1024; pw_[e] = RW[RS + o_]; const unsigned u0 = RWU[o_], u2 = RWU[2 * RS + o_], u3 = RWU[3 * RS + o_]; \
            pr_[e] = bflo(u0); pk_[e] = bfhi(u0); pv_[e] = bflo(u2); pg_[e] = bfhi(u2); pa_[e] = bflo(u3); pb_[e] = bfhi(u3); } } while (0)
    RC_FETCH(0);
#pragma unroll 1
    for (int pair = 0; pair < 8; ++pair) {
        const int uc = ((tile >> 9) * 16 + 2 * pair + team) * 512 + (tile & 511), b = uc >> 13, h = (uc >> 9) & 15, ck = uc & 511; unsigned char* rec = RWC + ((size_t)ck * 32 + (uc >> 9)) * RC_BYTES;     (void)b;
        __syncthreads();
        {
          const int j = tt & 63, q = tt >> 6;
          const float cl = pw_[5], clm = q ? pw_[4] : 0.f; const float clq[4] = {pw_[0], pw_[1], pw_[2], pw_[3]};
#pragma unroll
          for (int e = 0; e < 4; ++e) { const int t = 4 * q + e; const float cprev = e == 0 ? clm : clq[e - 1], cc = clq[e];
              const float rr = pr_[e], kk = pk_[e], vv = pv_[e], aa = pa_[e], bb = pb_[e];
              XA[t * 65 + j] = aa * __expf(cprev); XR[t * 65 + j] = rr * __expf(cc); const float ei = __expf(-cc), ef = __expf(cl - cc);
              ZB[t * 65 + j] = bb * ei; ZK[t * 65 + j] = kk * ei; TB[t * 65 + j] = bb * ef; TK[t * 65 + j] = kk * ef; VV[t * 65 + j] = vv; }
          if (q == 0) ((float*)(rec + RC_P15))[j] = __expf(cl);
          { v2u gw; gw.x = pk2(pg_[0], pg_[1]); gw.y = pk2(pg_[2], pg_[3]); *(v2u*)(rec + RC_GF + (((j >> 4) * 64 + 16 * q + (j & 15)) * 8)) = gw; } }
        RC_FETCH(pair < 7 ? pair + 1 : 7);
        __syncthreads();
        {
          const int q = tt >> 6, n = tt & 15, g = (tt >> 4) & 3; const LAS float* X = (q & 2) ? XR : XA; const LAS float* Z = (q & 1) ? ZK : ZB; LAS float* O = q == 0 ? Aab : (q == 1 ? Aak : (q == 2 ? Arb : Ark));
          f32x4v c = (f32x4v){0.f, 0.f, 0.f, 0.f};
#pragma unroll
          for (int ks = 0; ks < 16; ++ks) c = __builtin_amdgcn_mfma_f32_16x16x4f32(X[n * 65 + 4 * ks + g], Z[n * 65 + 4 * ks + g], c, 0, 0, 0);
#pragma unroll
          for (int rr = 0; rr < 4; ++rr) { const int t = 4 * g + rr; O[t * 17 + n] = ((q & 2) ? n <= t : n < t) ? c[rr] : 0.f; }
          { const int t = tt >> 4, jq = tt & 15; const float* rkp = F.kin[I_RRK] + l * 1024 + h * 64 + 4 * jq; float bn = 0.f;
#pragma unroll
            for (int e = 0; e < 4; ++e) bn += XR[t * 65 + 4 * jq + e] * ZK[t * 65 + 4 * jq + e] * rkp[e];
            bn = sum16(bn); if (jq == 0) ((float*)(rec + RC_BN))[t] = bn; } }
        __syncthreads();
        {
          if (tt < 16) { float col[16];
#pragma unroll
              for (int t = 0; t < 16; ++t) { float acc = (t == tt) ? 1.f : 0.f;
#pragma unroll
                  for (int s = 0; s < 16; ++s) if (s < t) acc += Aab[t * 17 + s] * col[s];
                  col[t] = acc; TT[t * 17 + tt] = acc; } }
          const int q = tt >> 6, n = tt & 15, g = (tt >> 4) & 3; f32x4v c = (f32x4v){0.f, 0.f, 0.f, 0.f};
#pragma unroll
          for (int ks = 0; ks < 4; ++ks) c = __builtin_amdgcn_mfma_f32_16x16x4f32(Aak[n * 17 + 4 * ks + g], VV[(4 * ks + g) * 65 + 16 * q + n], c, 0, 0, 0);
#pragma unroll
          for (int rr = 0; rr < 4; ++rr) W1[(4 * g + rr) * 65 + 16 * q + n] = c[rr]; }
        __syncthreads();
        {
          const int q = tt >> 6, n = tt & 15, g = (tt >> 4) & 3; f32x4v ca = (f32x4v){0.f, 0.f, 0.f, 0.f}, cu = (f32x4v){0.f, 0.f, 0.f, 0.f};
#pragma unroll
          for (int ks = 0; ks < 4; ++ks) { const float tv = TT[n * 17 + 4 * ks + g]; ca = __builtin_amdgcn_mfma_f32_16x16x4f32(tv, XA[(4 * ks + g) * 65 + 16 * q + n], ca, 0, 0, 0); cu = __builtin_amdgcn_mfma_f32_16x16x4f32(tv, W1[(4 * ks + g) * 65 + 16 * q + n], cu, 0, 0, 0); }
#pragma unroll
          for (int rr = 0; rr < 4; ++rr) { ATl[(4 * g + rr) * 65 + 16 * q + n] = ca[rr]; U0l[(4 * g + rr) * 65 + 16 * q + n] = cu[rr]; }
          *(f32x4v*)(rec + RC_U0 + ((q * 64 + 16 * g + n) * 16)) = cu; }
        __syncthreads();
        {
          const int q = tt >> 6, n = tt & 15, g = (tt >> 4) & 3; f32x4v cr, cy = (f32x4v){0.f, 0.f, 0.f, 0.f};
#pragma unroll
          for (int rr = 0; rr < 4; ++rr) cr[rr] = XR[(4 * g + rr) * 65 + 16 * q + n];
#pragma unroll
          for (int ks = 0; ks < 4; ++ks) { const float arb = Arb[n * 17 + 4 * ks + g], ark = Ark[n * 17 + 4 * ks + g];
              cr = __builtin_amdgcn_mfma_f32_16x16x4f32(arb, ATl[(4 * ks + g) * 65 + 16 * q + n], cr, 0, 0, 0);
              cy = __builtin_amdgcn_mfma_f32_16x16x4f32(arb, U0l[(4 * ks + g) * 65 + 16 * q + n], cy, 0, 0, 0);
              cy = __builtin_amdgcn_mfma_f32_16x16x4f32(ark, VV[(4 * ks + g) * 65 + 16 * q + n], cy, 0, 0, 0); }
          *(f32x4v*)(rec + RC_Y0 + ((q * 64 + 16 * g + n) * 16)) = cy;
#pragma unroll
          for (int rr = 0; rr < 4; ++rr) W1[(4 * g + rr) * 65 + 16 * q + n] = cr[rr]; }
        __syncthreads();
        { const int t = tt & 15, jq = tt >> 4, kk = jq >> 3, half = (jq & 7) >> 2, g = jq & 3, j0 = 4 * jq;
          v2u wa, wr; wa.x = pk2(ATl[t * 65 + j0], ATl[t * 65 + j0 + 1]); wa.y = pk2(ATl[t * 65 + j0 + 2], ATl[t * 65 + j0 + 3]); wr.x = pk2(W1[t * 65 + j0], W1[t * 65 + j0 + 1]); wr.y = pk2(W1[t * 65 + j0 + 2], W1[t * 65 + j0 + 3]);
          *(v2u*)(rec + RC_AT + kk * 1024 + (16 * g + t) * 16 + half * 8) = wa; *(v2u*)(rec + RC_RT + kk * 1024 + (16 * g + t) * 16 + half * 8) = wr;
          const int j = tt & 63, gg = tt >> 6; v4u bk; bk.x = pk2(TB[(4 * gg) * 65 + j], TB[(4 * gg + 1) * 65 + j]); bk.y = pk2(TB[(4 * gg + 2) * 65 + j], TB[(4 * gg + 3) * 65 + j]);
          bk.z = pk2(TK[(4 * gg) * 65 + j], TK[(4 * gg + 1) * 65 + j]); bk.w = pk2(TK[(4 * gg + 2) * 65 + j], TK[(4 * gg + 3) * 65 + j]);
          *(v4u*)(rec + RC_BK + (j >> 4) * 1024 + (16 * gg + (j & 15)) * 16) = bk;
          v2u vf; vf.x = pk2(VV[(4 * gg) * 65 + j], VV[(4 * gg + 1) * 65 + j]); vf.y = pk2(VV[(4 * gg + 2) * 65 + j], VV[(4 * gg + 3) * 65 + j]);
          *(v2u*)(rec + RC_VF + ((j >> 4) * 64 + 16 * gg + (j & 15)) * 8) = vf; }
    }
}
#undef RC_FETCH
template <int HACK = 0> __device__ __forceinline__ void rwkv_scan_unit(Frame& F, int l, int b, int h) {
    LAS unsigned char* L = F.lds + RING_OFF;
    const unsigned char* recs = F.ws + WS_RWC + (size_t)(b * 16 + h) * RC_BYTES;
    const int lane = F.lane, n = lane & 15, g = lane >> 4;
    LAS float* XS = (LAS float*)(L + 2 * RC_BYTES);
    if (F.wave >= 2) {
        const int li = F.tid - 128;
        int px[4];
#pragma unroll
        for (int k = 0; k < 4; ++k) { const int x = li + 384 * k; px[k] = x < 1300 ? x : 1299; }
        v4u p0[4], p1[4], p2[4], p3[4], p4[4], p5[4], p6[4], p7[4];
#define RWL_ISSUE(P, CK) do { const int ck_ = (CK) < 512 ? ((HACK & 1) && (CK) >= 4 ? 3 : (CK)) : 511; const v4u* src_ = (const v4u*)(recs + (size_t)ck_ * 32 * RC_BYTES); \
        _Pragma("unroll") for (int k = 0; k < 4; ++k) P[k] = src_[px[k]]; } while (0)
#define RWL_WRITE(P, CK) do { LAS v4u* dst_ = (LAS v4u*)(L + ((CK) & 1) * RC_BYTES); _Pragma("unroll") for (int k = 0; k < 4; ++k) dst_[px[k]] = P[k]; } while (0)
        RWL_ISSUE(p0, 0); RWL_ISSUE(p1, 1); RWL_ISSUE(p2, 2); RWL_ISSUE(p3, 3); RWL_ISSUE(p4, 4); RWL_ISSUE(p5, 5); RWL_ISSUE(p6, 6); RWL_ISSUE(p7, 7);
        RWL_WRITE(p0, 0); RWL_ISSUE(p0, 8);
        LDS_BARRIER();
#pragma unroll 1
        for (int ck = 0; ck < 512; ck += 8) {
            RWL_WRITE(p1, ck + 1); RWL_ISSUE(p1, ck + 9); LDS_BARRIER();
            RWL_WRITE(p2, ck + 2); RWL_ISSUE(p2, ck + 10); LDS_BARRIER();
            RWL_WRITE(p3, ck + 3); RWL_ISSUE(p3, ck + 11); LDS_BARRIER();
            RWL_WRITE(p4, ck + 4); RWL_ISSUE(p4, ck + 12); LDS_BARRIER();
            RWL_WRITE(p5, ck + 5); RWL_ISSUE(p5, ck + 13); LDS_BARRIER();
            RWL_WRITE(p6, ck + 6); RWL_ISSUE(p6, ck + 14); LDS_BARRIER();
            RWL_WRITE(p7, ck + 7); RWL_ISSUE(p7, ck + 15); LDS_BARRIER();
            RWL_WRITE(p0, ck + 8); RWL_ISSUE(p0, ck + 16); LDS_BARRIER();
        }
#undef RWL_ISSUE
#undef RWL_WRITE
        return;
    }
    const int cw = F.wave;
    f32x4v S[4][2];
#pragma unroll
    for (int jt = 0; jt < 4; ++jt)
#pragma unroll
        for (int it = 0; it < 2; ++it) S[jt][it] = (f32x4v){0.f, 0.f, 0.f, 0.f};
    float lnw[2], lnb[2];
#pragma unroll
    for (int it = 0; it < 2; ++it) { lnw[it] = F.kin[I_RLNW][l * 1024 + h * 64 + 16 * (2 * cw + it) + n]; lnb[it] = F.kin[I_RLNB][l * 1024 + h * 64 + 16 * (2 * cw + it) + n]; }
    bf16* MIX = WSP(bf16, WS_MIXED) + ((size_t)b * SEQ) * DM + 2048 + h * 64 + 32 * cw + n;
    f32x4v Yp[2] = {(f32x4v){0.f, 0.f, 0.f, 0.f}, (f32x4v){0.f, 0.f, 0.f, 0.f}}, bnp = (f32x4v){0.f, 0.f, 0.f, 0.f}; v2u gfp[2] = {(v2u){0u, 0u}, (v2u){0u, 0u}}, vfp[2] = {(v2u){0u, 0u}, (v2u){0u, 0u}};
    LDS_BARRIER();
#pragma unroll 1
    for (int ck = 0; ck <= 512; ++ck) {
        if (ck > 0) {
            const LAS float* xs = XS + ((ck - 1) & 1) * 64; const f32x4v a0 = *(const LAS f32x4v*)(xs + 8 * g), a1 = *(const LAS f32x4v*)(xs + 8 * g + 4), b0 = *(const LAS f32x4v*)(xs + 32 + 8 * g), b1 = *(const LAS f32x4v*)(xs + 32 + 8 * g + 4);
            const float s1[4] = {a0[0] + b0[0], a0[2] + b0[2], a1[0] + b1[0], a1[2] + b1[2]}, s2[4] = {a0[1] + b0[1], a0[3] + b0[3], a1[1] + b1[1], a1[3] + b1[3]};
#pragma unroll
            for (int it = 0; it < 2; ++it) { const float gt[4] = {bflo(gfp[it].x), bfhi(gfp[it].x), bflo(gfp[it].y), bfhi(gfp[it].y)}, vt[4] = {bflo(vfp[it].x), bfhi(vfp[it].x), bflo(vfp[it].y), bfhi(vfp[it].y)};
#pragma unroll
                for (int r = 0; r < 4; ++r) { const float mean = s1[r] * (1.0f / 64.0f), var = fmaxf(s2[r] * (1.0f / 64.0f) - mean * mean, 0.f), rstd = rsqrtf(var + 64e-5f);
                    if (!(HACK & 2)) MIX[(size_t)((ck - 1) * 16 + 4 * g + r) * DM + 16 * it] = (bf16)f2bf(((Yp[it][r] - mean) * rstd * lnw[it] + lnb[it] + bnp[r] * vt[r]) * gt[r]); } }
            if (ck == 512) break;
        }
        if (HACK & 4) { LDS_BARRIER(); continue; }
        const LAS unsigned char* R = L + (ck & 1) * RC_BYTES;
        bf16x8 at[2], rt[2];
#pragma unroll
        for (int kk = 0; kk < 2; ++kk) { at[kk] = *(const LAS bf16x8*)(R + RC_AT + kk * 1024 + lane * 16); rt[kk] = *(const LAS bf16x8*)(R + RC_RT + kk * 1024 + lane * 16); }
        f32x4v U[2], Y[2];
#pragma unroll
        for (int it = 0; it < 2; ++it) { U[it] = *(const LAS f32x4v*)(R + RC_U0 + (2 * cw + it) * 1024 + lane * 16); Y[it] = *(const LAS f32x4v*)(R + RC_Y0 + (2 * cw + it) * 1024 + lane * 16); }
#pragma unroll
        for (int kk = 0; kk < 2; ++kk)
#pragma unroll
            for (int it = 0; it < 2; ++it) { v4u pw; pw.x = pg8::cvt_pk_bf16(S[2 * kk][it][0], S[2 * kk][it][1]); pw.y = pg8::cvt_pk_bf16(S[2 * kk][it][2], S[2 * kk][it][3]);
                pw.z = pg8::cvt_pk_bf16(S[2 * kk + 1][it][0], S[2 * kk + 1][it][1]); pw.w = pg8::cvt_pk_bf16(S[2 * kk + 1][it][2], S[2 * kk + 1][it][3]); const bf16x8 sf = __builtin_bit_cast(bf16x8, pw);
                U[it] = __builtin_amdgcn_mfma_f32_16x16x32_bf16(at[kk], sf, U[it], 0, 0, 0); Y[it] = __builtin_amdgcn_mfma_f32_16x16x32_bf16(rt[kk], sf, Y[it], 0, 0, 0); }
        bf16x8 uv[2];
#pragma unroll
        for (int it = 0; it < 2; ++it) { vfp[it] = *(const LAS v2u*)(R + RC_VF + (2 * cw + it) * 512 + lane * 8); gfp[it] = *(const LAS v2u*)(R + RC_GF + (2 * cw + it) * 512 + lane * 8);
            v4u pw; pw.x = pg8::cvt_pk_bf16(U[it][0], U[it][1]); pw.y = pg8::cvt_pk_bf16(U[it][2], U[it][3]); pw.z = vfp[it].x; pw.w = vfp[it].y; uv[it] = __builtin_bit_cast(bf16x8, pw); }
#pragma unroll
        for (int jt = 0; jt < 4; ++jt) { const bf16x8 bk = *(const LAS bf16x8*)(R + RC_BK + jt * 1024 + lane * 16); const f32x4v p15 = *(const LAS f32x4v*)(R + RC_P15 + (16 * jt + 4 * g) * 4);
#pragma unroll
            for (int it = 0; it < 2; ++it) S[jt][it] = __builtin_amdgcn_mfma_f32_16x16x32_bf16(bk, uv[it], S[jt][it] * p15, 0, 0, 0); }
        bnp = *(const LAS f32x4v*)(R + RC_BN + 16 * g); Yp[0] = Y[0]; Yp[1] = Y[1];
        { LAS float* xo = XS + (ck & 1) * 64 + cw * 32; const f32x4v sm = Y[0] + Y[1], sq = Y[0] * Y[0] + Y[1] * Y[1];
#pragma unroll
          for (int r = 0; r < 4; ++r) { const float a = sum16(sm[r]), q = sum16(sq[r]); if (n == 0) { xo[(4 * g + r) * 2] = a; xo[(4 * g + r) * 2 + 1] = q; } } }
        LDS_BARRIER();
    }
}
template <int HACK = 0> __device__ __forceinline__ void mixers_v4(Frame& F, int l, int qi, int mask = 15) {
    gu32* ctr = F.ctl + CW_Q + 64 * qi;
    for (;;) {
        const int it = next_item(F, ctr); relaunder(F); relaunder_tid(F);
        if (it < 32) { if (mask & 1) rwkv_scan_unit<HACK>(F, l, it >> 4, it & 15); }
        else if (it < 48) { const int j = it - 32; if (mask & 2) gla_scan_unit<HACK>(F, l, j >> 3, (j >> 1) & 3, j & 1); }
        else if (it < 48 + 1024) { const int j = it - 48, qb = 63 - (j >> 4), bh = j & 15; if (mask & 4) attn_unit<true>(F, l, bh >> 3, bh & 7, qb); }
        else if (it < 48 + 2048) { const int j = it - 1072, qb = j & 63, bh = j >> 6; if (mask & 8) attn_unit<false>(F, l, bh >> 3, bh & 7, qb); }
        else break;
    }
}
template <int HACK = 0> __device__ __forceinline__ void prep_rwkv(Frame& F, int l) {
    LAS float* zl = (LAS float*)(F.lds + RING_OFF) + 4096;
    LAS bf16* inb = (LAS bf16*)(F.lds + RING_OFF);
    const float* mu = F.kin[I_RMU] + (size_t)l * 3264;
    const float* LOWR = WSP(float, WS_LOWR); const bf16* COLS = WSP(bf16, WS_COLS);
    float* RW = WSP(float, WS_RW); unsigned* RWU = WSP(unsigned, WS_RW); float* VF = WSP(float, WS_VFIRST);
    constexpr size_t RS = RW_ONE / 4;
    for (int tile = F.bx; tile < M / 16; tile += F.G) {
        const int row0 = tile * 16;
        relaunder(F); relaunder_tid(F);
        __syncthreads();
        {
            float cur_[7], prv_[7], mu_[7];
#pragma unroll
            for (int q = 0; q < 7; ++q) { const int idx = F.tid + NWAVES * 64 * q, tt = idx / 224, j = idx % 224, row = row0 + tt;
                const int col = j < 192 ? 16 + j : 208 + (j - 192);
                const float* mp = j < 192 ? mu + 3072 + j : F.kin[I_VRMU] + (l ? (l - 1) * 32 : 0) + (j - 192);
                cur_[q] = LOWR[(size_t)row * 256 + col]; prv_[q] = LOWR[(size_t)((row & (SEQ - 1)) ? row - 1 : row) * 256 + col]; mu_[q] = *mp; }
#pragma unroll
            for (int q = 0; q < 7; ++q) { const int idx = F.tid + NWAVES * 64 * q, tt = idx / 224, j = idx % 224, row = row0 + tt;
                const float prev = (row & (SEQ - 1)) ? prv_[q] : 0.f, muv = (j >= 192 && l == 0) ? 0.f : mu_[q];
                float x = cur_[q] + (prev - cur_[q]) * muv;
                if (j < 64) x = tanhf(x); else if (j >= 128 && j < 192) x = sigmoid_f(x);
                inb[tt * 232 + j] = (bf16)f2bf(x); } }
        __syncthreads();
        {
            const int c = 2 * F.tid;
            float accw[2][16], acca[2][16], accg[2][16], accv[2][16];
#pragma unroll
            for (int e = 0; e < 2; ++e) { const float bw = F.kin[I_RW0][l * 1024 + c + e], ba = F.kin[I_RA0][l * 1024 + c + e], bv = l ? F.kin[I_VR0][(l - 1) * 1024 + c + e] : 0.f;
#pragma unroll
              for (int tt = 0; tt < 16; ++tt) { accw[e][tt] = bw; acca[e][tt] = ba; accg[e][tt] = 0.f; accv[e][tt] = bv; } }
#define LOWRANK_MFMA(ACC, MI, JOFF, NKS) do { const bf16* wf_ = WSP(bf16, WS_WF) + ((size_t)(l * 448 + ((MI) < 3 ? (MI) * 128 + 16 * (NKS) / 2 * F.wave : 384 + 8 * F.wave)) * 64 + F.lane) * 8; \
            bf16x8 af_[NKS], bf_[8][NKS]; \
            _Pragma("unroll") for (int ks = 0; ks < (NKS); ++ks) af_[ks] = *(const LAS bf16x8*)(inb + (F.lane & 15) * 232 + (JOFF) + 32 * ks + 8 * (F.lane >> 4)); \
            _Pragma("unroll") for (int nt = 0; nt < 8; ++nt) _Pragma("unroll") for (int ks = 0; ks < (NKS); ++ks) bf_[nt][ks] = *(const bf16x8*)(wf_ + (size_t)(nt * (NKS) + ks) * 512); \
            _Pragma("unroll") for (int nt = 0; nt < 8; ++nt) { f32x4 c4 = {0.f, 0.f, 0.f, 0.f}; \
                _Pragma("unroll") for (int ks = 0; ks < (NKS); ++ks) c4 = __builtin_amdgcn_mfma_f32_16x16x32_bf16(af_[ks], bf_[nt][ks], c4, 0, 0, 0); \
                _Pragma("unroll") for (int rr = 0; rr < 4; ++rr) zl[(4 * (F.lane >> 4) + rr) * 1028 + 128 * F.wave + 16 * nt + (F.lane & 15)] = c4[rr]; } \
            __syncthreads(); \
            _Pragma("unroll") for (int tt = 0; tt < 16; ++tt) { const f32x2_t z2 = *(const LAS f32x2_t*)(zl + tt * 1028 + c); ACC[0][tt] += z2.x; ACC[1][tt] += z2.y; } \
            __syncthreads(); } while (0)
            if (!(HACK & 1)) { LOWRANK_MFMA(accw, 0, 0, 2); relaunder(F);
            LOWRANK_MFMA(acca, 1, 64, 2); relaunder(F);
            LOWRANK_MFMA(accg, 2, 128, 2); relaunder(F);
            if (l) LOWRANK_MFMA(accv, 3, 192, 1); }
#undef LOWRANK_MFMA
            relaunder(F);
            float mur[2], muk[2], muv[2], kkv[2], kav[2], pr[2] = {0.f, 0.f}, pk[2] = {0.f, 0.f}, pv[2] = {0.f, 0.f}; float cl[2] = {0.f, 0.f};
#pragma unroll
            for (int e = 0; e < 2; ++e) { mur[e] = F.kin[I_RMU][l * 3264 + c + e]; muk[e] = F.kin[I_RMU][l * 3264 + 1024 + c + e]; muv[e] = F.kin[I_RMU][l * 3264 + 2048 + c + e]; kkv[e] = F.kin[I_RKK][l * 1024 + c + e]; kav[e] = F.kin[I_RKA][l * 1024 + c + e]; }
            if ((row0 & (SEQ - 1)) != 0) { const bf16* p = COLS + (size_t)(row0 - 1) * NMAIN + c; const unsigned ur = *(const unsigned*)(p + CC_R), uk = *(const unsigned*)(p + CC_K), uv = *(const unsigned*)(p + CC_V);
                pr[0] = bflo(ur); pr[1] = bfhi(ur); pk[0] = bflo(uk); pk[1] = bfhi(uk); pv[0] = bflo(uv); pv[1] = bfhi(uv); }
            constexpr int PFD = 4;
            unsigned pur[16], puk[16], puv[16]; f32x2_t pvf[16];
#define PF_TOK(T) do { const bf16* p_ = COLS + (size_t)(row0 + (T)) * NMAIN + c; pur[T] = *(const unsigned*)(p_ + CC_R); puk[T] = *(const unsigned*)(p_ + CC_K); puv[T] = *(const unsigned*)(p_ + CC_V); \
                pvf[T] = *(const f32x2_t*)(VF + (size_t)(row0 + (T)) * 1024 + c); } while (0)
#pragma unroll
            for (int tt = 0; tt < PFD; ++tt) PF_TOK(tt);
            asm volatile("" ::: "memory");
            if (!(HACK & 4))
#pragma unroll
            for (int tt = 0; tt < 16; ++tt) { const int row = row0 + tt; const size_t o = (size_t)row * 1024 + c;
                if (tt + PFD < 16) { PF_TOK(tt + PFD < 16 ? tt + PFD : 15); }
                asm volatile("" ::: "memory");
                const unsigned ur = pur[tt], uk = puk[tt], uv = puv[tt];
                const float cr[2] = {bflo(ur), bfhi(ur)}, ck[2] = {bflo(uk), bfhi(uk)}, cv[2] = {bflo(uv), bfhi(uv)};
                f32x2_t vf2 = pvf[tt];
                float r[2], k[2], v[2], dec[2], av[2], kk[2], km[2];
#pragma unroll
                for (int e = 0; e < 2; ++e) { r[e] = cr[e] + (pr[e] - cr[e]) * mur[e]; k[e] = ck[e] + (pk[e] - ck[e]) * muk[e]; v[e] = cv[e] + (pv[e] - cv[e]) * muv[e]; pr[e] = cr[e]; pk[e] = ck[e]; pv[e] = cv[e];
                    if (l == 0) vf2[e] = v[e]; else { const float vg = sigmoid_f(accv[e][tt]); v[e] = v[e] + (vf2[e] - v[e]) * vg; }
                    cl[e] += -0.6065306597126334f * sigmoid_f(accw[e][tt]); dec[e] = cl[e]; av[e] = sigmoid_f(acca[e][tt]); kk[e] = k[e] * kkv[e]; km[e] = k[e] * (1.0f + (av[e] - 1.0f) * kav[e]); }
                const float ss = sum32(kk[0] * kk[0] + kk[1] * kk[1]), rn = rsqrtf(fmaxf(ss, 1e-24f)); kk[0] *= rn; kk[1] *= rn;
                if (l == 0) *(f32x2_t*)(VF + o) = vf2;
                *(f32x2_t*)(RW + RS + o) = (f32x2_t){dec[0], dec[1]};
                *(v2u*)(RWU + o) = (v2u){pk2(r[0], km[0]), pk2(r[1], km[1])}; *(v2u*)(RWU + 2 * RS + o) = (v2u){pk2(v[0], accg[0][tt]), pk2(v[1], accg[1][tt])};
                *(v2u*)(RWU + 3 * RS + o) = (v2u){pk2(-kk[0], kk[0] * av[0]), pk2(-kk[1], kk[1] * av[1])}; }
#undef PF_TOK
        }
        asm volatile("s_waitcnt vmcnt(0)" ::: "memory"); __syncthreads();
        __builtin_amdgcn_fence(__ATOMIC_ACQUIRE, "agent"); asm volatile("s_waitcnt vmcnt(0)" ::: "memory");
        if (!(HACK & 2)) rwkv_chunks_of_tile(F, l, tile);
    }
}
struct Args { const float* in[35]; float* out; unsigned char* ws; };
__device__ __forceinline__ void mk_frame(Frame& F, int wv) {
    extern __shared__ __attribute__((aligned(16))) unsigned char lds[];
    kargp kp = (kargp)__builtin_amdgcn_kernarg_segment_ptr(); asm volatile("" : "+s"(kp));
    F.kin = kp;
    F.lds = (LAS unsigned char*)lds;
    F.MISC = (volatile LAS unsigned*)(F.lds + MISC_OFF);
    { int w_ = wv; asm volatile("" : "+s"(w_)); int t_ = (int)__builtin_amdgcn_mbcnt_hi(~0u, __builtin_amdgcn_mbcnt_lo(~0u, (unsigned)w_ * 64u)); asm volatile("" : "+v"(t_)); F.tid = t_; } F.lane = F.tid & 63; F.wave = __builtin_amdgcn_readfirstlane(F.tid >> 6);
    F.G = gridDim.x; { int bx = blockIdx.x; asm volatile("" : "+s"(bx)); F.bx = bx; F.vcu = (F.G % 8 == 0) ? (bx % 8) * (F.G / 8) + bx / 8 : bx; }
    F.out = (float*)kp[35]; F.ws = (unsigned char*)kp[36]; F.ctl = (gu32*)(F.ws + WS_CTL);
}
__device__ __forceinline__ void grid_bar(int wv) {
    Frame F; mk_frame(F, wv);
    XcdBarrier bar; bar.bar = (unsigned*)(F.ctl + CW_BAR); bar.x = xb_xcc_id(); bar.st = F.MISC + 8;
    xcd_barrier(bar);
}
__global__ void __launch_bounds__(NWAVES * 64, 2) mega_fwd(Args args) {
    const int wv = __builtin_amdgcn_readfirstlane((int)threadIdx.x >> 6);
    { Frame F; mk_frame(F, wv);
      for (int u = F.tid; u < (LDS_BYTES - LDSCTL_OFF) / 4; u += NWAVES * 64) ((LAS unsigned*)(F.lds + LDSCTL_OFF))[u] = 0u;
      __syncthreads();
      (void)xcd_barrier_post((unsigned*)(F.ctl + CW_BAR), F.MISC + 8);
      p0_prologue_a(F);
    }
    grid_bar(wv);
    { Frame F; mk_frame(F, wv); p0_prologue_b(F); }
    grid_bar(wv);
#pragma unroll 1
    for (int l = 0; l < NLAYER; ++l) {
#define LAYER_VARS const float* mod = WSP(float, WS_MOD) + (size_t)l * 2 * 24576; const float* xin = l == 0 ? F.kin[I_X] : F.out; (void)mod; (void)xin
        { Frame F; mk_frame(F, wv); LAYER_VARS; if (l == 0) rms_phase(F, F.kin[I_X], mod + 0, mod + 4096); else rms_phase_bf(F, mod + 0, mod + 4096); }
        grid_bar(wv);
        { Frame F; mk_frame(F, wv);
          pg8::Gemm g{WSP(pg8::bf16_t, WS_XN), WSP(pg8::bf16_t, WS_WIN + l * WIN_L), M, NIN, DM}; pg8::StaticOrder S; S.init(M, NIN, F.G, F.bx);
          pg8::EpiCols E{WSP(pg8::bf16_t, WS_COLS), WSP(float, WS_LOWR)};
          pg8::gemm_phase<pg8::EpiCols, pg8::StaticOrder, true, true>(F.lds + RING_OFF, g, S, E, F.tid); }
        grid_bar(wv);
        { Frame F; mk_frame(F, wv); prep_norm(F, l); }
        { Frame F; mk_frame(F, wv); prep_loga(F, l); }
        { Frame F; mk_frame(F, wv); prep_rwkv(F, l); }
        { Frame F; mk_frame(F, wv); prep_vt(F, 0); }
        { Frame F; mk_frame(F, wv); prep_vt(F, 1); }
        { Frame F; mk_frame(F, wv); prep_vt(F, 2); }
        { Frame F; mk_frame(F, wv); prep_vt(F, 3); }
        { Frame F; mk_frame(F, wv); prep_vt(F, 4); }
        { Frame F; mk_frame(F, wv); prep_gla(F); }
        grid_bar(wv);
        { Frame F; mk_frame(F, wv); mixers_v4(F, l, l); }
        grid_bar(wv);
        { Frame F; mk_frame(F, wv); gla_post(F, l); }
        grid_bar(wv);
        { Frame F; mk_frame(F, wv); LAYER_VARS;
          pg8::Gemm g{WSP(pg8::bf16_t, WS_MIXED), WSP(pg8::bf16_t, WS_WOUT + l * WOUT_L), M, DM, DM}; pg8::StaticOrder S; S.init(M, DM, F.G, F.bx);
          pg8::EpiRes E{l == 0 ? (const void*)F.kin[I_X] : (const void*)WSP(bf16, WS_XR), (void*)WSP(bf16, WS_XR), mod + 2 * 4096, l != 0, true};
          pg8::gemm_phase<pg8::EpiRes, pg8::StaticOrder, true, true>(F.lds + RING_OFF, g, S, E, F.tid); }
        grid_bar(wv);
        { Frame F; mk_frame(F, wv); LAYER_VARS; rms_phase_bf(F, mod + 3 * 4096, mod + 4 * 4096); }
        grid_bar(wv);
        { Frame F; mk_frame(F, wv);
          pg8::Gemm g{WSP(pg8::bf16_t, WS_XN), WSP(pg8::bf16_t, WS_W13 + l * W13_L), M, 2 * DFF, DM}; pg8::StaticOrder S; S.init(M, 2 * DFF, F.G, F.bx);
          pg8::EpiSwiglu E{WSP(pg8::bf16_t, WS_HID)};
          pg8::gemm_phase<pg8::EpiSwiglu, pg8::StaticOrder, true, true>(F.lds + RING_OFF, g, S, E, F.tid); }
        grid_bar(wv);
        { Frame F; mk_frame(F, wv); LAYER_VARS;
          pg8::Gemm g{WSP(pg8::bf16_t, WS_HID), WSP(pg8::bf16_t, WS_W2 + l * W2_L), M, DM, DFF}; pg8::StaticOrder S; S.init(M, DM, F.G, F.bx);
          pg8::EpiRes E{(const void*)WSP(bf16, WS_XR), l + 1 < NLAYER ? (void*)WSP(bf16, WS_XR) : (void*)F.out, mod + 5 * 4096, true, l + 1 < NLAYER};
          pg8::gemm_phase<pg8::EpiRes, pg8::StaticOrder, true, true>(F.lds + RING_OFF, g, S, E, F.tid); }
        if (l + 1 < NLAYER) grid_bar(wv);
#undef LAYER_VARS
    }
}

extern "C" void kernel_launch(void* const* d_in, const int* in_sizes, int n_in, void* d_out, int out_size, void* d_ws, size_t ws_size, hipStream_t stream) {
    static int grid = 0;
    if (grid == 0) {
        if (n_in != 35 || in_sizes[0] != M * DM || out_size != M * DM || ws_size < WS_END) { fprintf(stderr, "kernel_launch: unexpected shapes: n_in %d in0 %d out %d ws %zu (need %zu)\n", n_in, n_in > 0 ? in_sizes[0] : -1, out_size, ws_size, (size_t)WS_END); grid = -1; return; }
        int dev = 0, cus = 0, per_cu = 0;
        if (hipGetDevice(&dev) != hipSuccess || hipDeviceGetAttribute(&cus, hipDeviceAttributeMultiprocessorCount, dev) != hipSuccess) { grid = -1; return; }
        if (hipFuncSetAttribute((const void*)mega_fwd, hipFuncAttributeMaxDynamicSharedMemorySize, LDS_BYTES) != hipSuccess) { fprintf(stderr, "kernel_launch: hipFuncSetAttribute failed\n"); grid = -1; return; }
        if (hipOccupancyMaxActiveBlocksPerMultiprocessor(&per_cu, (const void*)mega_fwd, NWAVES * 64, LDS_BYTES) != hipSuccess || per_cu < 1) fprintf(stderr, "kernel_launch: occupancy query says %d\n", per_cu);
        (void)hipGetLastError();
        grid = cus;
    }
    if (grid < 0) return;
    if (hipMemsetAsync((char*)d_ws + WS_CTL, 0, CTL_ZERO_BYTES, stream) != hipSuccess) return;
    Args a{};
    for (int i = 0; i < 35; ++i) a.in[i] = (const float*)d_in[i];
    a.out = (float*)d_out; a.ws = (unsigned char*)d_ws;
    hipLaunchKernelGGL(mega_fwd, dim3(grid), dim3(NWAVES * 64), LDS_BYTES, stream, a);
}
```

```cpp
#include <hip/hip_runtime.h>
#include <cstdio>
#include <cstdint>
namespace pg8 {
#define PG8_LAS __attribute__((address_space(3)))
typedef unsigned short bf16_t;
typedef short bf16x8 __attribute__((ext_vector_type(8)));
typedef float f32x4 __attribute__((ext_vector_type(4)));
typedef unsigned u32x4 __attribute__((ext_vector_type(4)));
constexpr int BM = 256, BK = 64, HALF = 128, HTB = HALF * BK * 2  , STAGE_BYTES = 8 * HTB, NXCD = 8, WGM = 8;

__host__ __device__ __forceinline__ int lds_byte(int r, int c) { const int st = (r >> 4) * 2 + (c >> 5), rr = r & 15, cc = c & 31, ob = rr * 64 + cc * 2; return st * 1024 + (ob ^ (((ob >> 9) & 1) << 5)); }
__host__ __device__ __forceinline__ void stage_rc(int b, int& R, int& C) { const int st = b / 1024, sb = b % 1024, swz = sb ^ (((sb >> 9) & 1) << 5); R = (st >> 1) * 16 + swz / 64; C = (st & 1) * 32 + (swz % 64) / 2; }
__host__ __device__ __forceinline__ int perm32(int rho) { const int n = rho >> 4, i = rho & 15; return 8 * (i >> 2) + 4 * n + (i & 3); }

struct Unit { int pm, pn; };
struct Gemm { const bf16_t* A; const bf16_t* Bt; int M, N, K; };

struct StaticOrder {
    int nM, nN, nwg, G, c;
    __host__ __device__ void init(int M, int N, int G_, int c_) { nM = M / BM; nN = N / BM; nwg = nM * nN; G = G_; c = c_; }
    __host__ __device__ bool next(int i, Unit& u) const {
        const long L = (long)i * G + c; if (L >= nwg) return false;
        int wgid = (int)L; { const int q = nwg / NXCD, r = nwg % NXCD, xcd = wgid % NXCD, off = wgid / NXCD; wgid = (xcd < r ? xcd * (q + 1) : r * (q + 1) + (xcd - r) * q) + off; }
        const int nig = WGM * nN, gid = wgid / nig, fm = gid * WGM, gsz = (nM - fm) < WGM ? (nM - fm) : WGM;
        u.pm = fm + ((wgid % nig) % gsz); u.pn = (wgid % nig) / gsz; return true;
    }
    __device__ __forceinline__ void a_ready(const Unit&) const {}
    __device__ __forceinline__ void done(const Unit&) const {}
};

typedef float f32x2c_t __attribute__((ext_vector_type(2))); typedef __bf16 bf16x2c_t __attribute__((ext_vector_type(2)));
__device__ __forceinline__ unsigned cvt_pk_bf16(float lo, float hi) { const f32x2c_t v = {lo, hi}; return __builtin_bit_cast(unsigned, __builtin_convertvector(v, bf16x2c_t)); }
typedef float f32x2 __attribute__((ext_vector_type(2)));
__device__ __forceinline__ float silu_f(float x) { return x * __builtin_amdgcn_rcpf(1.0f + __builtin_amdgcn_exp2f(-1.4426950408889634f * x)); }
struct EpiCols {
    static constexpr bool PERM = true, AFTER_DRAIN = false;
    bf16_t* O; float* L;
    __device__ __forceinline__ void operator()(const f32x4 (&acc)[2][2][4][2], const Unit& u, int wr, int wc, int fr, int fq) const {
        const int row0 = u.pm * BM + wr * 64 + fr;
        if (u.pn < 41) {
            const int col0 = u.pn * BM + wc * 32 + 8 * fq;
#pragma unroll
            for (int ai = 0; ai < 2; ++ai)
#pragma unroll
                for (int m = 0; m < 4; ++m) { bf16_t* rowp = O + (size_t)(row0 + ai * HALF + m * 16) * 10496 + col0;
#pragma unroll
                    for (int bj = 0; bj < 2; ++bj) { const f32x4 v0 = acc[ai][bj][m][0], v1 = acc[ai][bj][m][1];
                        u32x4 w; w.x = cvt_pk_bf16(v0[0], v0[1]); w.y = cvt_pk_bf16(v0[2], v0[3]); w.z = cvt_pk_bf16(v1[0], v1[1]); w.w = cvt_pk_bf16(v1[2], v1[3]);
                        *(u32x4*)(rowp + bj * HALF) = w; } }
        } else {
            const int col0 = wc * 32 + 8 * fq;
#pragma unroll
            for (int ai = 0; ai < 2; ++ai)
#pragma unroll
                for (int m = 0; m < 4; ++m) { float* rowp = L + (size_t)(row0 + ai * HALF + m * 16) * 256 + col0;
#pragma unroll
                    for (int bj = 0; bj < 2; ++bj) { *(f32x4*)(rowp + bj * HALF) = acc[ai][bj][m][0]; *(f32x4*)(rowp + bj * HALF + 4) = acc[ai][bj][m][1]; } }
        }
    }
};
struct EpiRes {
    static constexpr bool PERM = true, AFTER_DRAIN = false;
    const void* base; void* out; const float* gate; bool base_bf, out_bf;
    __device__ __forceinline__ void operator()(const f32x4 (&acc)[2][2][4][2], const Unit& u, int wr, int wc, int fr, int fq) const {
        const int row0 = u.pm * BM + wr * 64 + fr, col0 = u.pn * BM + wc * 32 + 8 * fq;
        const float* gp = gate + (size_t)(u.pm >> 5) * 24576 + col0;
        f32x4 gv[2][2];
#pragma unroll
        for (int bj = 0; bj < 2; ++bj)
#pragma unroll
            for (int n = 0; n < 2; ++n) gv[bj][n] = *(const f32x4*)(gp + bj * HALF + n * 4);
#pragma unroll
        for (int ai = 0; ai < 2; ++ai) {
            f32x4 r[4][2][2];
            if (base_bf) {
#pragma unroll
                for (int m = 0; m < 4; ++m)
#pragma unroll
                    for (int bj = 0; bj < 2; ++bj) { const u32x4 w = *(const u32x4*)((const bf16_t*)base + (size_t)(row0 + ai * HALF + m * 16) * 4096 + col0 + bj * HALF);
                        r[m][bj][0] = (f32x4){__builtin_bit_cast(float, w.x << 16), __builtin_bit_cast(float, w.x & 0xffff0000u), __builtin_bit_cast(float, w.y << 16), __builtin_bit_cast(float, w.y & 0xffff0000u)};
                        r[m][bj][1] = (f32x4){__builtin_bit_cast(float, w.z << 16), __builtin_bit_cast(float, w.z & 0xffff0000u), __builtin_bit_cast(float, w.w << 16), __builtin_bit_cast(float, w.w & 0xffff0000u)}; }
            } else {
#pragma unroll
                for (int m = 0; m < 4; ++m)
#pragma unroll
                    for (int bj = 0; bj < 2; ++bj)
#pragma unroll
                        for (int n = 0; n < 2; ++n) r[m][bj][n] = *(const f32x4*)((const float*)base + (size_t)(row0 + ai * HALF + m * 16) * 4096 + col0 + bj * HALF + n * 4);
            }
#pragma unroll
            for (int m = 0; m < 4; ++m)
#pragma unroll
                for (int bj = 0; bj < 2; ++bj)
#pragma unroll
                    for (int n = 0; n < 2; ++n) r[m][bj][n] = r[m][bj][n] + gv[bj][n] * acc[ai][bj][m][n];
            if (out_bf) {
#pragma unroll
                for (int m = 0; m < 4; ++m)
#pragma unroll
                    for (int bj = 0; bj < 2; ++bj) { const f32x4 v0 = r[m][bj][0], v1 = r[m][bj][1];
                        u32x4 w; w.x = cvt_pk_bf16(v0[0], v0[1]); w.y = cvt_pk_bf16(v0[2], v0[3]); w.z = cvt_pk_bf16(v1[0], v1[1]); w.w = cvt_pk_bf16(v1[2], v1[3]);
                        *(u32x4*)((bf16_t*)out + (size_t)(row0 + ai * HALF + m * 16) * 4096 + col0 + bj * HALF) = w; }
            } else {
#pragma unroll
                for (int m = 0; m < 4; ++m)
#pragma unroll
                    for (int bj = 0; bj < 2; ++bj)
#pragma unroll
                        for (int n = 0; n < 2; ++n) *(f32x4*)((float*)out + (size_t)(row0 + ai * HALF + m * 16) * 4096 + col0 + bj * HALF + n * 4) = r[m][bj][n];
            }
            asm volatile("" ::: "memory");
        }
    }
};
struct EpiSwiglu {
    static constexpr bool PERM = true, AFTER_DRAIN = false;
    bf16_t* H;
    __device__ __forceinline__ void operator()(const f32x4 (&acc)[2][2][4][2], const Unit& u, int wr, int wc, int fr, int fq) const {
        const int row0 = u.pm * BM + wr * 64 + fr, col0 = u.pn * HALF + wc * 32 + 8 * fq;
#pragma unroll
        for (int ai = 0; ai < 2; ++ai)
#pragma unroll
            for (int m = 0; m < 4; ++m) { bf16_t* rowp = H + (size_t)(row0 + ai * HALF + m * 16) * 11008 + col0;
                const f32x4 a0 = acc[ai][0][m][0], a1 = acc[ai][0][m][1], b0 = acc[ai][1][m][0], b1 = acc[ai][1][m][1];
                u32x4 w; w.x = cvt_pk_bf16(silu_f(a0[0]) * b0[0], silu_f(a0[1]) * b0[1]); w.y = cvt_pk_bf16(silu_f(a0[2]) * b0[2], silu_f(a0[3]) * b0[3]);
                w.z = cvt_pk_bf16(silu_f(a1[0]) * b1[0], silu_f(a1[1]) * b1[1]); w.w = cvt_pk_bf16(silu_f(a1[2]) * b1[2], silu_f(a1[3]) * b1[3]);
                *(u32x4*)rowp = w; }
    }
};
template <class Epi, class Sched, bool ALIGN_EPI = false, bool SP2 = false>
__device__ __forceinline__ void gemm_phase(PG8_LAS unsigned char* lds, const Gemm g, const Sched& S, const Epi& E, int tid_in) {
    int tid_ = tid_in; asm volatile("" : "+v"(tid_));
    const int tid = tid_, wid = __builtin_amdgcn_readfirstlane(tid >> 6), lane = tid & 63, wr = wid >> 2, wc = wid & 3, fr = lane & 15, fq = lane >> 4;
    const int K = g.K, nt = K / BK;
    unsigned voffA[2], voffB[2];
#pragma unroll
    for (int i = 0; i < 2; ++i) { int R, C; stage_rc(tid * 16 + i * 8192, R, C); const int Rb = Epi::PERM ? ((R & ~31) + perm32(R & 31)) : R;
        voffA[i] = (unsigned)(R * K + C) * 2u; voffB[i] = (unsigned)(Rb * K + C) * 2u; }
    const size_t kstep = (size_t)(BK * 2);
    const size_t hstep = (size_t)HALF * K * 2;
    const size_t tstep = 2 * hstep;
    const unsigned ldsw = (unsigned)wid * 1024u;
    const int aoff = lds_byte(wr * 64 + fr, fq * 8), boff = lds_byte(wc * 32 + fr, fq * 8);
#define PG8_SA(b, h) (((b) * 2 + (h)) * HTB)
#define PG8_SB(b, h) ((4 + (b) * 2 + (h)) * HTB)
#define PG8_STAGE(bufoff, gbase, voff) do { _Pragma("unroll") for (int _i = 0; _i < 2; ++_i) \
        __builtin_amdgcn_global_load_lds((const unsigned*)((const char*)(gbase) + (voff)[_i]), (PG8_LAS unsigned*)(lds + (bufoff) + ldsw + _i * 8192), 16, 0, 0); } while (0)
#define PG8_LDA(dst, b, h) do { _Pragma("unroll") for (int m = 0; m < 4; ++m) _Pragma("unroll") for (int k = 0; k < 2; ++k) dst[m][k] = *(const PG8_LAS bf16x8*)(lds + PG8_SA(b, h) + aoff + m * 2048 + k * 1024); } while (0)
#define PG8_LDB(dst, b, h) do { _Pragma("unroll") for (int n = 0; n < 2; ++n) _Pragma("unroll") for (int k = 0; k < 2; ++k) dst[n][k] = *(const PG8_LAS bf16x8*)(lds + PG8_SB(b, h) + boff + n * 2048 + k * 1024); } while (0)
#define PG8_MMA(ai, bj, At, Bt) do { __builtin_amdgcn_s_setprio(1); _Pragma("unroll") for (int m = 0; m < 4; ++m) _Pragma("unroll") for (int n = 0; n < 2; ++n) _Pragma("unroll") for (int k = 0; k < 2; ++k) \
        acc[ai][bj][m][n] = __builtin_amdgcn_mfma_f32_16x16x32_bf16(Bt[n][k], At[m][k], acc[ai][bj][m][n], 0, 0, 0); __builtin_amdgcn_s_setprio(0); } while (0)
#define PG8_WAIT_V(n) asm volatile("s_waitcnt vmcnt(" #n ")" ::: "memory")
#define PG8_WAIT_L(n) asm volatile("s_waitcnt lgkmcnt(" #n ")" ::: "memory")
#define PG8_BAR __builtin_amdgcn_s_barrier()
#define PG8_SCHED __builtin_amdgcn_sched_barrier(0)
    Unit cur, nxt; int ui = 0;
    if (!S.next(0, cur)) return;
    f32x4 acc[2][2][4][2];
#pragma unroll
    for (int a = 0; a < 2; ++a)
#pragma unroll
        for (int b = 0; b < 2; ++b)
#pragma unroll
            for (int m = 0; m < 4; ++m)
#pragma unroll
                for (int n = 0; n < 2; ++n) acc[a][b][m][n] = (f32x4){0.f, 0.f, 0.f, 0.f};
    bf16x8 At[4][2], B0[2][2], B1[2][2];
    const char* cA = (const char*)g.A + (size_t)cur.pm * tstep; const char* cB = (const char*)g.Bt + (size_t)cur.pn * tstep;
    S.a_ready(cur);
    if constexpr (SP2) {
        PG8_STAGE(PG8_SB(0, 0), cB, voffB); PG8_STAGE(PG8_SB(0, 1), cB + hstep, voffB); PG8_STAGE(PG8_SA(0, 0), cA, voffA); PG8_STAGE(PG8_SA(0, 1), cA + hstep, voffA);
        if (wr == 1) PG8_BAR;
        PG8_WAIT_V(2); PG8_BAR;
        PG8_STAGE(PG8_SB(1, 0), cB + kstep, voffB); PG8_STAGE(PG8_SA(1, 0), cA + kstep, voffA); PG8_STAGE(PG8_SB(1, 1), cB + hstep + kstep, voffB);
        PG8_WAIT_V(6); PG8_BAR;
    } else {
        PG8_STAGE(PG8_SB(0, 0), cB, voffB); PG8_STAGE(PG8_SA(0, 0), cA, voffA); PG8_STAGE(PG8_SB(0, 1), cB + hstep, voffB); PG8_STAGE(PG8_SA(0, 1), cA + hstep, voffA);
        if (wr == 1) PG8_BAR;
        PG8_WAIT_V(4); PG8_BAR;
        PG8_STAGE(PG8_SB(1, 0), cB + kstep, voffB); PG8_STAGE(PG8_SA(1, 0), cA + kstep, voffA); PG8_STAGE(PG8_SB(1, 1), cB + hstep + kstep, voffB);
        PG8_WAIT_V(6); PG8_BAR;
    }
    for (;;) {
        const bool has_next = S.next(ui + 1, nxt);
        const char* nA = has_next ? (const char*)g.A + (size_t)nxt.pm * tstep : cA; const char* nB = has_next ? (const char*)g.Bt + (size_t)nxt.pn * tstep : cB;
        for (int t = 0; t < nt; t += 2) {
            const bool last = (t == nt - 2);
            const char* a1 = cA + (size_t)(t + 1) * kstep;
            const char* a2 = last ? nA : cA + (size_t)(t + 2) * kstep; const char* b2 = last ? nB : cB + (size_t)(t + 2) * kstep;
            const char* a3 = a2 + kstep; const char* b3 = b2 + kstep;
            if (last && has_next) S.a_ready(nxt);
            if constexpr (SP2) {
            PG8_LDB(B0, 0, 0); PG8_LDB(B1, 0, 1); PG8_SCHED; PG8_LDA(At, 0, 0); PG8_STAGE(PG8_SA(1, 1), a1 + hstep, voffA);
            PG8_WAIT_V(8); PG8_WAIT_L(0); PG8_BAR; PG8_MMA(0, 0, At, B0); PG8_MMA(0, 1, At, B1); PG8_BAR; PG8_SCHED;
            PG8_LDA(At, 0, 1); PG8_STAGE(PG8_SB(0, 0), b2, voffB); PG8_STAGE(PG8_SB(0, 1), b2 + hstep, voffB); PG8_STAGE(PG8_SA(0, 0), a2, voffA);
            PG8_WAIT_V(8); PG8_WAIT_L(0); PG8_BAR; PG8_MMA(1, 0, At, B0); PG8_MMA(1, 1, At, B1); PG8_BAR; PG8_SCHED;
            PG8_LDB(B0, 1, 0); PG8_LDB(B1, 1, 1); PG8_SCHED; PG8_LDA(At, 1, 0); PG8_STAGE(PG8_SA(0, 1), a2 + hstep, voffA);
            PG8_WAIT_V(8); PG8_WAIT_L(0); PG8_BAR; PG8_MMA(0, 0, At, B0); PG8_MMA(0, 1, At, B1); PG8_BAR; PG8_SCHED;
            PG8_LDA(At, 1, 1); PG8_STAGE(PG8_SB(1, 0), b3, voffB); PG8_STAGE(PG8_SB(1, 1), b3 + hstep, voffB); PG8_STAGE(PG8_SA(1, 0), a3, voffA);
            PG8_WAIT_V(8); PG8_WAIT_L(0); PG8_BAR; PG8_MMA(1, 0, At, B0); PG8_MMA(1, 1, At, B1); PG8_BAR; PG8_SCHED;
            } else {
            PG8_LDB(B0, 0, 0); PG8_SCHED; PG8_LDA(At, 0, 0); PG8_STAGE(PG8_SA(1, 1), a1 + hstep, voffA);
            PG8_WAIT_L(8); PG8_BAR; PG8_WAIT_L(0); PG8_MMA(0, 0, At, B0); PG8_BAR; PG8_SCHED;
            PG8_LDB(B1, 0, 1); PG8_STAGE(PG8_SB(0, 0), b2, voffB);
            PG8_BAR; PG8_WAIT_L(0); PG8_MMA(0, 1, At, B1); PG8_BAR;
            PG8_LDA(At, 0, 1); PG8_STAGE(PG8_SA(0, 0), a2, voffA);
            PG8_BAR; PG8_WAIT_L(0); PG8_MMA(1, 0, At, B0); PG8_BAR; PG8_SCHED;
            PG8_STAGE(PG8_SB(0, 1), b2 + hstep, voffB);
            PG8_WAIT_V(6); PG8_BAR; PG8_MMA(1, 1, At, B1); PG8_BAR;
            PG8_LDB(B0, 1, 0); PG8_SCHED; PG8_LDA(At, 1, 0); PG8_STAGE(PG8_SA(0, 1), a2 + hstep, voffA);
            PG8_WAIT_L(8); PG8_BAR; PG8_WAIT_L(0); PG8_MMA(0, 0, At, B0); PG8_BAR; PG8_SCHED;
            PG8_LDB(B1, 1, 1); PG8_STAGE(PG8_SB(1, 0), b3, voffB);
            PG8_BAR; PG8_WAIT_L(0); PG8_MMA(0, 1, At, B1); PG8_BAR;
            PG8_LDA(At, 1, 1); PG8_STAGE(PG8_SA(1, 0), a3, voffA);
            PG8_BAR; PG8_WAIT_L(0); PG8_MMA(1, 0, At, B0); PG8_BAR; PG8_SCHED;
            PG8_STAGE(PG8_SB(1, 1), b3 + hstep, voffB);
            PG8_WAIT_V(6); PG8_BAR; PG8_MMA(1, 1, At, B1); PG8_BAR;
            }
        }
        if constexpr (ALIGN_EPI) { if (wr == 0) PG8_BAR; }
        if constexpr (!Epi::AFTER_DRAIN) { E(acc, cur, wr, wc, fr, fq); S.done(cur); }
        if (!has_next) break;
#pragma unroll
        for (int a = 0; a < 2; ++a)
#pragma unroll
            for (int b = 0; b < 2; ++b)
#pragma unroll
                for (int m = 0; m < 4; ++m)
#pragma unroll
                    for (int n = 0; n < 2; ++n) acc[a][b][m][n] = (f32x4){0.f, 0.f, 0.f, 0.f};
        cur = nxt; cA = nA; cB = nB; ++ui;
        if constexpr (ALIGN_EPI) { if (wr == 1) PG8_BAR; }
    }
    PG8_WAIT_V(0);
    if constexpr (!ALIGN_EPI) { if (wr == 0) PG8_BAR; }
    PG8_BAR;
    if constexpr (Epi::AFTER_DRAIN) { E.fused(acc, cur, wr, wc, fr, fq, lds, wid, lane); S.done(cur); }
#undef PG8_SA
#undef PG8_SB
#undef PG8_STAGE
#undef PG8_LDA
#undef PG8_LDB
#undef PG8_MMA
#undef PG8_WAIT_V
#undef PG8_WAIT_L
#undef PG8_BAR
#undef PG8_SCHED
}
}
constexpr int BATCH = 2, SEQ = 8192, DM = 4096, M = BATCH * SEQ, DFF = 11008, NLAYER = 2;
constexpr int P_IN = 10704, NIN = 10752, NMAIN = 10496;
constexpr int CA_Q = 0, CA_K = 1024, CA_V = 2048;
constexpr int CB_Q = 3072, CB_K = 3584, CB_V = 4096, CB_G = 5120;
constexpr int CC_R = 6144, CC_K = 7168, CC_V = 8192;
constexpr int CD_Q = 9216, CD_K = 10240, CD_V = 10368;
constexpr float LOG2E = 1.4426950408889634f;
constexpr float QSCALE = 0.125f * LOG2E;
constexpr int NWAVES = 8;

constexpr size_t MiB = 1u << 20;
constexpr size_t WS_CTL = 0, CTL_ZERO_BYTES = 1 * MiB;
constexpr size_t WS_MODP = 2 * MiB;
constexpr size_t WS_MOD = 14 * MiB;
constexpr size_t WS_TAB = 15 * MiB;
constexpr size_t WS_WIN = 16 * MiB, WIN_L = 84 * MiB;
constexpr size_t WS_WOUT = 184 * MiB, WOUT_L = 32 * MiB;
constexpr size_t WS_W13 = 248 * MiB, W13_L = 172 * MiB;
constexpr size_t WS_W2 = 592 * MiB, W2_L = 86 * MiB;
constexpr size_t WS_XN = 764 * MiB;
constexpr size_t WS_COLS = 892 * MiB;
constexpr size_t WS_LOWR = 1220 * MiB;
constexpr size_t WS_HID = 892 * MiB;
constexpr size_t WS_QKA = 1236 * MiB;
constexpr size_t WS_QKD = 1300 * MiB;
constexpr size_t WS_LOGA = 1336 * MiB;
constexpr size_t WS_RW = 1368 * MiB, RW_ONE = 64 * MiB;
constexpr size_t WS_VFIRST = 1816 * MiB;
constexpr size_t WS_MIXED = 1880 * MiB;
constexpr int VROW = SEQ + 64;
constexpr size_t WS_VTA = 2008 * MiB;
constexpr size_t WS_VTD = 2041 * MiB;
constexpr size_t WS_QDEC = 2046 * MiB, WS_KDT = 2062 * MiB, WS_AM = 2078 * MiB, WS_EBL = 2086 * MiB;
constexpr size_t WS_VTB = 2087 * MiB;
constexpr size_t WS_RWC = 2120 * MiB;
constexpr size_t WS_OB = 2446 * MiB;
constexpr size_t WS_PSG = 2478 * MiB;
constexpr size_t WS_WF = 2479 * MiB;
constexpr size_t WS_XR = 2480 * MiB;
constexpr size_t WS_END = 2608 * MiB;
constexpr int CW_BAR = 4096;
constexpr int CW_Q = 16384;

constexpr int RING_OFF = 0, RING_BYTES = 131072;
constexpr int LDSCTL_OFF = RING_BYTES, MISC_OFF = LDSCTL_OFF + 320;
constexpr int LDS_BYTES = 147456;

#define GAS __attribute__((address_space(1)))
#define LAS __attribute__((address_space(3)))
typedef unsigned short bf16;
typedef unsigned v4u __attribute__((ext_vector_type(4)));
typedef unsigned v2u __attribute__((ext_vector_type(2)));
typedef float f32x4 __attribute__((ext_vector_type(4)));
typedef short bf16x8 __attribute__((ext_vector_type(8)));
typedef GAS unsigned gu32;
#define RLX_AGENT __ATOMIC_RELAXED, __HIP_MEMORY_SCOPE_AGENT
#define LDS_WAIT() asm volatile("s_waitcnt lgkmcnt(0)" ::: "memory")
#define VM_WAIT() asm volatile("s_waitcnt vmcnt(0)" ::: "memory")
typedef float f32x2_t __attribute__((ext_vector_type(2))); typedef __bf16 bf16x2_t __attribute__((ext_vector_type(2)));
__device__ __forceinline__ unsigned pk2(float lo, float hi) { const f32x2_t v = {lo, hi}; return __builtin_bit_cast(unsigned, __builtin_convertvector(v, bf16x2_t)); }
__device__ __forceinline__ unsigned f2bf(float f) { return pk2(f, f) & 0xffffu; }
__device__ __forceinline__ float bf2f(unsigned short h) { return __builtin_bit_cast(float, (unsigned)h << 16); }
__device__ __forceinline__ float bflo(unsigned w) { return __builtin_bit_cast(float, w << 16); }
__device__ __forceinline__ float bfhi(unsigned w) { return __builtin_bit_cast(float, w & 0xffff0000u); }
template <int CTRL> __device__ __forceinline__ float dpp_f(float v) { return __builtin_bit_cast(float, __builtin_amdgcn_update_dpp(0, __builtin_bit_cast(int, v), CTRL, 0xF, 0xF, true)); }
__device__ __forceinline__ float sum8(float v) {
    v += dpp_f<0xB1>(v); v += dpp_f<0x4E>(v); v += dpp_f<0x141>(v); return v; }
__device__ __forceinline__ float sum32(float v) {
    v = sum8(v); v += dpp_f<0x140>(v); v += __builtin_bit_cast(float, __builtin_amdgcn_ds_swizzle(__builtin_bit_cast(int, v), 0x401F)); return v; }
__device__ __forceinline__ float wave_sum(float v) {
    v = sum8(v); v += dpp_f<0x140>(v);
    v += __builtin_bit_cast(float, __builtin_amdgcn_ds_swizzle(__builtin_bit_cast(int, v), 0x401F));
    { const int u = __builtin_bit_cast(int, v); v = __builtin_bit_cast(float, __builtin_amdgcn_readlane(u, 0)) + __builtin_bit_cast(float, __builtin_amdgcn_readlane(u, 32)); }
    return v;
}
__device__ __forceinline__ float sigmoid_f(float x) { return __builtin_amdgcn_rcpf(1.0f + __builtin_amdgcn_exp2f(-LOG2E * x)); }
__device__ __forceinline__ float silu_g(float x) { return x * sigmoid_f(x); }
__device__ __forceinline__ void unpack8(const v4u r, float (&f)[8]) { f[0] = bflo(r.x); f[1] = bfhi(r.x); f[2] = bflo(r.y); f[3] = bfhi(r.y); f[4] = bflo(r.z); f[5] = bfhi(r.z); f[6] = bflo(r.w); f[7] = bfhi(r.w); }
__device__ __forceinline__ v4u pack8(const float (&f)[8]) { v4u o; o.x = pk2(f[0], f[1]); o.y = pk2(f[2], f[3]); o.z = pk2(f[4], f[5]); o.w = pk2(f[6], f[7]); return o; }

#define XB_TMO      128
#define XB_XCNT(j)  (256  + 64 * (j))
#define XB_XSUB(j)  (1280 + 64 * (j))
#define XB_XGEN(j)  (2304 + 64 * (j))
#define XB_TOP      3328
#define XB_TOPGEN   3392
#define XCD_BAR_WORDS 3456
#define XB_SPIN_CAP (1u << 23)

__device__ __forceinline__ unsigned xb_ld(unsigned* p)              { return __hip_atomic_load(p, __ATOMIC_RELAXED, __HIP_MEMORY_SCOPE_AGENT); }
__device__ __forceinline__ unsigned xb_add(unsigned* p, unsigned v) { return __hip_atomic_fetch_add(p, v, __ATOMIC_RELAXED, __HIP_MEMORY_SCOPE_AGENT); }
__device__ __forceinline__ unsigned xb_xcc_id() { return (unsigned)__builtin_amdgcn_s_getreg((3 << 11) | 20) & 0xFu; }
#define XB_SPIN(cond, bar) do { unsigned _sp = 0; while (cond) { __builtin_amdgcn_s_sleep(1); \
    if ((++_sp & 255u) == 0u) { if (xb_ld(&(bar)[XB_TMO])) break; if (_sp > XB_SPIN_CAP) { atomicAdd(&(bar)[XB_TMO], 1u); break; } } } } while (0)

struct XcdBarrier {
    unsigned* bar; unsigned x;
    volatile LAS unsigned* st;
};

__device__ __forceinline__ XcdBarrier xcd_barrier_post(unsigned* bar, volatile LAS unsigned* st) {
    XcdBarrier b; b.bar = bar; b.x = xb_xcc_id(); b.st = st;
    if (threadIdx.x == 0) (void)xb_add(&bar[XB_XCNT(b.x)], 1u);
    return b;
}
__device__ __forceinline__ void xcd_barrier_complete(unsigned* bar, unsigned x, unsigned& nloc, unsigned& nx) {
    const unsigned G = gridDim.x * gridDim.y * gridDim.z;
    unsigned sum, cnt, mine, sp = 0u;
    for (;;) {
        sum = 0u; cnt = 0u; mine = 0u;
#pragma unroll
        for (unsigned j = 0; j < 16; ++j) { const unsigned c = xb_ld(&bar[XB_XCNT(j)]); sum += c; cnt += (c > 0u) ? 1u : 0u; mine = (j == x) ? c : mine; }
        if (sum == G) break;
        __builtin_amdgcn_s_sleep(1);
        if ((++sp & 255u) == 0u) { if (xb_ld(&bar[XB_TMO])) break; if (sp > XB_SPIN_CAP) { atomicAdd(&bar[XB_TMO], 1u); break; } }
    }
    nloc = mine > 0u ? mine : 1u; nx = cnt > 0u ? cnt : 1u;
}

__device__ __forceinline__ void xcd_barrier(const XcdBarrier& b) {
    asm volatile("s_waitcnt vmcnt(0)" ::: "memory");
    __syncthreads();
    if (threadIdx.x == 0) {
        unsigned* bar = b.bar;
        __builtin_amdgcn_s_waitcnt(0);
        unsigned nloc = b.st[0], nx = b.st[1];
        if (nloc == 0u) { xcd_barrier_complete(bar, b.x, nloc, nx); b.st[0] = nloc; b.st[1] = nx; }
        const unsigned old = xb_add(&bar[XB_XSUB(b.x)], 1u);
        const unsigned gen = old / nloc;
        if (old + 1u == (gen + 1u) * nloc) {
            __builtin_amdgcn_fence(__ATOMIC_RELEASE, "agent");
            asm volatile("s_waitcnt vmcnt(0)" ::: "memory");
            const unsigned og = xb_add(&bar[XB_TOP], 1u);
            const unsigned tg = og / nx;
            if (og + 1u == (tg + 1u) * nx) xb_add(&bar[XB_TOPGEN], 1u);
            else XB_SPIN(xb_ld(&bar[XB_TOPGEN]) == tg, bar);
            __builtin_amdgcn_fence(__ATOMIC_ACQUIRE, "agent");
            xb_add(&bar[XB_XGEN(b.x)], 1u);
            asm volatile("s_waitcnt vmcnt(0)" ::: "memory");
        } else {
            XB_SPIN(xb_ld(&bar[XB_XGEN(b.x)]) == gen, bar);
            __builtin_amdgcn_fence(__ATOMIC_ACQUIRE, "agent");
            asm volatile("s_waitcnt vmcnt(0)" ::: "memory");
        }
    }
    __syncthreads();
}

typedef const float* const __attribute__((address_space(4)))* kargp;
struct Frame {
    LAS unsigned char* lds;
    volatile LAS unsigned* MISC;
    gu32* ctl;
    int tid, lane, wave;
    int vcu, G, bx;
    kargp kin;
    float* out;
    unsigned char* ws;
};
enum { I_X = 0, I_C, I_RELB, I_ADAW, I_ADAB, I_WIN, I_WOUT, I_DQN, I_DKN, I_DLAM, I_DSUB, I_GGU, I_GGB, I_GON, I_RMU, I_RWUP, I_RW0, I_RAUP, I_RA0, I_RGUP,
       I_RKK, I_RKA, I_RRK, I_RLNW, I_RLNB, I_VRD, I_VRMU, I_VRUP, I_VR0, I_SQN, I_SKN, I_SSINK, I_W1, I_W3, I_W2 };

#define WSP(T, off) ((T*)(F.ws + (off)))
__device__ __forceinline__ void relaunder_tid(Frame& F) { int t = F.tid; asm volatile("" : "+v"(t)); F.tid = t; F.lane = t & 63; F.wave = __builtin_amdgcn_readfirstlane(t >> 6); }
__device__ __forceinline__ void relaunder(Frame& F) { kargp p = F.kin; asm volatile("" : "+s"(p)); F.kin = p; }

__device__ __forceinline__ void conv_item(const float* src, int ld, int col0, int ncols, int K, bf16* WT, int row0, int kb, LAS float* scr, int lane) {
    const int k0 = 64 * kb;
    { const int n = lane & 31; const bool ok = src != nullptr && n < ncols; const float* sp = src + (size_t)(k0 + (lane >> 5)) * ld + col0 + n; float v[32];
#pragma unroll
      for (int i = 0; i < 32; ++i) v[i] = ok ? sp[(size_t)(2 * i) * ld] : 0.f;
#pragma unroll
      for (int i = 0; i < 32; ++i) scr[(2 * i + (lane >> 5)) * 33 + n] = v[i]; }
    LDS_WAIT(); asm volatile("" ::: "memory");
    const int c = lane & 7;
#pragma unroll
    for (int j = 0; j < 4; ++j) { const int n = (lane >> 3) + 8 * j; const LAS float* s = scr + (8 * c) * 33 + n;
        v4u o; o.x = pk2(s[0 * 33], s[1 * 33]); o.y = pk2(s[2 * 33], s[3 * 33]); o.z = pk2(s[4 * 33], s[5 * 33]); o.w = pk2(s[6 * 33], s[7 * 33]);
        if (n < ncols) *(GAS v4u*)(WT + (size_t)(row0 + n) * K + k0 + 8 * c) = o; }
    LDS_WAIT(); asm volatile("" ::: "memory");
}
__device__ __forceinline__ int t5_bucket(int d) {
    if (d < 16) return d;
    int v = 16 + (int)(logf((float)d * (1.0f / 16.0f)) / logf(8.0f) * 16.0f);
    return v < 31 ? v : 31;
}
__device__ __forceinline__ void p0_prologue_a(Frame& F) {
    const int gw = F.vcu * NWAVES + F.wave, NGW = F.G * NWAVES;
    LAS float* ldsf = (LAS float*)(F.lds + RING_OFF);
    for (int i = F.tid; i < 2 * DM; i += NWAVES * 64) ldsf[i] = silu_g(F.kin[I_C][i]);
    __syncthreads();
    float* MODP = WSP(float, WS_MODP);
    for (int it = gw; it < 6144; it += NGW) {
        const int l = it / 3072, rem = it % 3072, kc = rem / 96, ng = rem % 96, n0 = 256 * ng + 4 * F.lane;
        const float* w = F.kin[I_ADAW] + ((size_t)l * DM + kc * 128) * 24576 + n0;
        f32x4 a0 = {0.f, 0.f, 0.f, 0.f}, a1 = {0.f, 0.f, 0.f, 0.f};
#pragma unroll 16
        for (int k = 0; k < 128; ++k) { const f32x4 wv = *(const f32x4*)(w + (size_t)k * 24576); const float s0 = ldsf[kc * 128 + k], s1 = ldsf[DM + kc * 128 + k]; a0 += wv * s0; a1 += wv * s1; }
        *(f32x4*)(MODP + ((size_t)(l * 32 + kc) * 2 + 0) * 24576 + n0) = a0;
        *(f32x4*)(MODP + ((size_t)(l * 32 + kc) * 2 + 1) * 24576 + n0) = a1;
    }
    for (int idx = F.bx * (NWAVES * 64) + F.tid; idx < NLAYER * 448 * 64; idx += F.G * NWAVES * 64) {
        const int l = idx / (448 * 64), rem = idx % (448 * 64), blk = rem >> 6, ln = rem & 63, n = ln & 15, g = ln >> 4;
        const int m = blk < 384 ? blk >> 7 : 3, nt = blk < 384 ? (blk & 127) >> 1 : blk - 384, ks = blk < 384 ? (blk & 1) : 0;
        const float* W = m == 0 ? F.kin[I_RWUP] + (size_t)l * 65536 : (m == 1 ? F.kin[I_RAUP] + (size_t)l * 65536 : (m == 2 ? F.kin[I_RGUP] + (size_t)l * 65536 : (l ? F.kin[I_VRUP] + (size_t)(l - 1) * 32768 : nullptr)));
        float f[8];
#pragma unroll
        for (int e = 0; e < 8; ++e) f[e] = W != nullptr ? W[(size_t)(32 * ks + 8 * g + e) * 1024 + 16 * nt + n] : 0.f;
        *(v4u*)(WSP(bf16, WS_WF) + ((size_t)(l * 448 + blk) * 64 + ln) * 8) = pack8(f);
    }
    __syncthreads();
    LAS float* scr = (LAS float*)(F.lds + RING_OFF + F.wave * 16384);
    constexpr int I_IN = 337 * 64, I_OUT = 128 * 64, I_13 = 688 * 64, I_2 = 128 * 172, I_L = I_IN + I_OUT + I_13 + I_2;
    for (int it = gw; it < NLAYER * I_L; it += NGW) {
        const int l = it / I_L; int r = it % I_L;
        if (r < I_IN) {
            const int kb = r / 337, cb = r % 337; const float* src = F.kin[I_WIN] + (size_t)l * DM * P_IN; int ld = P_IN, col0, row0, nc = 32;
            if (cb < 192) { col0 = 32 * cb; row0 = 32 * cb; }
            else if (cb < 288) { col0 = 6160 + 32 * (cb - 192); row0 = 6144 + 32 * (cb - 192); }
            else if (cb < 328) { col0 = 9424 + 32 * (cb - 288); row0 = 9216 + 32 * (cb - 288); }
            else if (cb == 328) { col0 = 6144; row0 = 10496; nc = 16; }
            else if (cb < 335) { col0 = 9232 + 32 * (cb - 329); row0 = 10512 + 32 * (cb - 329); }
            else if (cb == 335) { src = l ? F.kin[I_VRD] + (size_t)(l - 1) * DM * 32 : nullptr; ld = 32; col0 = 0; row0 = 10704; }
            else { src = nullptr; col0 = 0; row0 = 10736; nc = 16; }
            conv_item(src, ld, col0, nc, DM, WSP(bf16, WS_WIN + l * WIN_L), row0, kb, scr, F.lane); continue; }
        r -= I_IN;
        if (r < I_OUT) { const int kb = r / 128, cb = r % 128; conv_item(F.kin[I_WOUT] + (size_t)l * DM * DM, DM, 32 * cb, 32, DM, WSP(bf16, WS_WOUT + l * WOUT_L), 32 * cb, kb, scr, F.lane); continue; }
        r -= I_OUT;
        if (r < I_13) { const int kb = r / 688, cb = r % 688, pn = cb >> 3, wi = cb & 7;
            const float* src = (wi < 4 ? F.kin[I_W1] : F.kin[I_W3]) + (size_t)l * DM * DFF;
            conv_item(src, DFF, 128 * pn + 32 * (wi & 3), 32, DM, WSP(bf16, WS_W13 + l * W13_L), 32 * cb, kb, scr, F.lane); continue; }
        r -= I_13;
        { const int kb = r / 128, cb = r % 128; conv_item(F.kin[I_W2] + (size_t)l * DFF * DM, DM, 32 * cb, 32, DFF, WSP(bf16, WS_W2 + l * W2_L), 32 * cb, kb, scr, F.lane); }
    }
}
__device__ __forceinline__ void p0_prologue_b(Frame& F) {
    const int gt = F.bx * (NWAVES * 64) + F.tid, NT = F.G * NWAVES * 64;
    const float* MODP = WSP(float, WS_MODP); float* MOD = WSP(float, WS_MOD);
    for (int idx = gt; idx < NLAYER * 2 * 24576; idx += NT) {
        const int l = idx / 49152, rem = idx % 49152, b = rem / 24576, n = rem % 24576;
        float s = F.kin[I_ADAB][l * 24576 + n];
#pragma unroll 8
        for (int kc = 0; kc < 32; ++kc) s += MODP[((size_t)(l * 32 + kc) * 2 + b) * 24576 + n];
        MOD[idx] = s;
    }
    if (F.bx == 0) { float* TAB = WSP(float, WS_TAB);
        for (int i = F.tid; i < 24 * 128; i += NWAVES * 64) { const int hh = i >> 7, d = i & 127; TAB[i] = F.kin[I_RELB][t5_bucket(d) * 24 + hh] * LOG2E; } }
}
__device__ __forceinline__ void rms_phase(Frame& F, const float* xin, const float* sh, const float* sc) {
    const int gw = F.vcu * NWAVES + F.wave, NGW = F.G * NWAVES;
    bf16* XN = WSP(bf16, WS_XN);
    for (int m = gw; m < M; m += NGW) {
        const int b = m >> 13;
        const f32x4* xr = (const f32x4*)(xin + (size_t)m * DM) + F.lane;
        f32x4 v[16]; float ss = 0.f;
#pragma unroll
        for (int j = 0; j < 16; ++j) { v[j] = xr[64 * j]; ss += (v[j].x * v[j].x + v[j].y * v[j].y) + (v[j].z * v[j].z + v[j].w * v[j].w); }
        const float rstd = rsqrtf(wave_sum(ss) * (1.0f / DM) + 1e-6f);
        const f32x4* scp = (const f32x4*)(sc + (size_t)b * 24576) + F.lane; const f32x4* shp = (const f32x4*)(sh + (size_t)b * 24576) + F.lane;
        v2u* o8 = (v2u*)(XN + (size_t)m * DM) + F.lane;
#pragma unroll
        for (int j = 0; j < 16; ++j) { const f32x4 s4 = scp[64 * j], h4 = shp[64 * j]; const f32x4 o = v[j] * rstd * (s4 + 1.0f) + h4;
            v2u w; w.x = pk2(o.x, o.y); w.y = pk2(o.z, o.w); o8[64 * j] = w; }
    }
}
__device__ __forceinline__ void rms_phase_bf(Frame& F, const float* sh, const float* sc) {
    const int gw = F.vcu * NWAVES + F.wave, NGW = F.G * NWAVES;
    bf16* XN = WSP(bf16, WS_XN); const bf16* XR = WSP(bf16, WS_XR);
    for (int m = gw; m < M; m += NGW) {
        const int b = m >> 13;
        const v4u* xr = (const v4u*)(XR + (size_t)m * DM) + F.lane;
        v4u raw[8]; float ss = 0.f;
#pragma unroll
        for (int j = 0; j < 8; ++j) raw[j] = xr[64 * j];
#pragma unroll
        for (int j = 0; j < 8; ++j) { float f[8]; unpack8(raw[j], f);
#pragma unroll
            for (int e = 0; e < 8; ++e) ss += f[e] * f[e]; }
        const float rstd = rsqrtf(wave_sum(ss) * (1.0f / DM) + 1e-6f);
        const float* scp = sc + (size_t)b * 24576 + 8 * F.lane; const float* shp = sh + (size_t)b * 24576 + 8 * F.lane;
        v4u* o16 = (v4u*)(XN + (size_t)m * DM) + F.lane;
#pragma unroll
        for (int j = 0; j < 8; ++j) { float f[8]; unpack8(raw[j], f);
            const f32x4 s0 = *(const f32x4*)(scp + 512 * j), s1 = *(const f32x4*)(scp + 512 * j + 4), h0 = *(const f32x4*)(shp + 512 * j), h1 = *(const f32x4*)(shp + 512 * j + 4);
            float o[8];
#pragma unroll
            for (int e = 0; e < 4; ++e) { o[e] = f[e] * rstd * (s0[e] + 1.0f) + h0[e]; o[4 + e] = f[4 + e] * rstd * (s1[e] + 1.0f) + h1[e]; }
            o16[64 * j] = pack8(o); }
    }
}
__device__ __forceinline__ void prep_norm(Frame& F, int l) {
    const int gw = F.vcu * NWAVES + F.wave, NGW = F.G * NWAVES, lane = F.lane, sub = lane >> 3, ch = lane & 7;
    float gqa[8], gka[8], gqd[8], gkd[8];
#pragma unroll
    for (int e = 0; e < 8; ++e) { gqa[e] = F.kin[I_DQN][l * 64 + ch * 8 + e] * QSCALE; gka[e] = F.kin[I_DKN][l * 64 + ch * 8 + e];
                                  gqd[e] = F.kin[I_SQN][l * 64 + ch * 8 + e] * QSCALE; gkd[e] = F.kin[I_SKN][l * 64 + ch * 8 + e]; }
    const bf16* COLS = WSP(bf16, WS_COLS); bf16* QKA = WSP(bf16, WS_QKA); bf16* QKD = WSP(bf16, WS_QKD);
    for (int m = gw; m < M; m += NGW) {
        const bf16* src = COLS + (size_t)m * NMAIN;
#pragma unroll
        for (int i = 0; i < 4; ++i) { const int vec = i * 8 + sub, col = vec * 64 + ch * 8;
            float f[8]; unpack8(*(const v4u*)(src + CA_Q + col), f); float ss = 0.f;
#pragma unroll
            for (int e = 0; e < 8; ++e) ss += f[e] * f[e];
            ss = sum8(ss);
            const float rstd = rsqrtf(ss * (1.0f / 64.0f) + 1e-6f);
#pragma unroll
            for (int e = 0; e < 8; ++e) f[e] = f[e] * rstd * (i < 2 ? gqa[e] : gka[e]);
            *(v4u*)(QKA + (size_t)m * 2048 + col) = pack8(f); }
#pragma unroll
        for (int i = 0; i < 3; ++i) { const int vec = i * 8 + sub, col = vec * 64 + ch * 8;
            if (vec < 18) { float f[8]; unpack8(*(const v4u*)(src + CD_Q + col), f); float ss = 0.f;
#pragma unroll
                for (int e = 0; e < 8; ++e) ss += f[e] * f[e];
                ss = sum8(ss);
                const float rstd = rsqrtf(ss * (1.0f / 64.0f) + 1e-6f);
#pragma unroll
                for (int e = 0; e < 8; ++e) f[e] = f[e] * rstd * (vec < 16 ? gqd[e] : gkd[e]);
                *(v4u*)(QKD + (size_t)m * 1152 + col) = pack8(f); } }
    }
}
__device__ __forceinline__ void prep_loga(Frame& F, int l) {
    LAS float* gdl = (LAS float*)(F.lds + RING_OFF);
    float gu[16];
#pragma unroll
    for (int j = 0; j < 16; ++j) gu[j] = F.kin[I_GGU][((size_t)l * 16 + j) * 512 + F.tid];
    const float bias = F.kin[I_GGB][l * 512 + F.tid];
    const float* LOWR = WSP(float, WS_LOWR); float* LOGA = WSP(float, WS_LOGA);
    for (int tile = F.bx; tile < M / 64; tile += F.G) {
        const size_t row0 = (size_t)tile * 64;
        __syncthreads();
#pragma unroll
        for (int i = 0; i < 2; ++i) { const int idx = F.tid + 512 * i; gdl[idx] = LOWR[(row0 + (idx >> 4)) * 256 + (idx & 15)]; }
        __syncthreads();
#pragma unroll 4
        for (int t = 0; t < 64; ++t) { const LAS f32x4* gp = (const LAS f32x4*)(gdl + t * 16); const f32x4 g0 = gp[0], g1 = gp[1], g2 = gp[2], g3 = gp[3];
            float z = bias + g0.x * gu[0] + g0.y * gu[1] + g0.z * gu[2] + g0.w * gu[3] + g1.x * gu[4] + g1.y * gu[5] + g1.z * gu[6] + g1.w * gu[7]
                    + g2.x * gu[8] + g2.y * gu[9] + g2.z * gu[10] + g2.w * gu[11] + g3.x * gu[12] + g3.y * gu[13] + g3.z * gu[14] + g3.w * gu[15];
            LOGA[(row0 + t) * 512 + F.tid] = (fminf(z, 0.f) - __logf(1.0f + __expf(-fabsf(z)))) * (1.0f / 16.0f); }
    }
}
__device__ __forceinline__ int next_item(Frame& F, gu32* ctr) {
    volatile LAS int* slot = (volatile LAS int*)(F.lds + LDSCTL_OFF + 64);
    __syncthreads();
    if (F.tid == 0) *slot = (int)__hip_atomic_fetch_add(ctr, 1u, RLX_AGENT);
    __syncthreads();
    return *slot;
}
typedef float f32x16 __attribute__((ext_vector_type(16)));
__device__ __forceinline__ float xother32(float v) { unsigned a = __builtin_bit_cast(unsigned, v), b = a; asm volatile("" : "+v"(b)); auto rr = __builtin_amdgcn_permlane32_swap(a, b, false, false);
    const unsigned lo = rr[0], hi = rr[1]; return __builtin_bit_cast(float, (unsigned)((__builtin_amdgcn_mbcnt_hi(~0u, __builtin_amdgcn_mbcnt_lo(~0u, 0u)) & 32u) ? lo : hi)); }
__device__ __forceinline__ float xsum32(float v) { return v + xother32(v); }
__device__ __forceinline__ float xmax32(float v) { return fmaxf(v, xother32(v)); }
__device__ __forceinline__ int crow16(int r, int hi) { return (r & 3) + 8 * (r >> 2) + 4 * hi; }
template <bool ISA>
__device__ __forceinline__ void attn_unit(Frame& F, int l, int b, int hx, int qb) {
    constexpr int DV = ISA ? 128 : 64, NDV = DV / 32, KSTR = ISA ? 272 : 144, VSTR = 144, KBYTES = 64 * KSTR, VBYTES = DV * VSTR, BUFB = KBYTES + VBYTES, NCH = ISA ? 2 : 1;
    constexpr float NEG = -1e30f;
    LAS unsigned char* L = F.lds + RING_OFF;
    const int tid = F.tid, lane = F.lane, r32 = lane & 31, hi = lane >> 5, qs = F.wave & 3, grp = F.wave >> 2, q0 = qb * 128;
    const int kvh = hx >> 2, hd = kvh * 8 + (hx & 3) * 2 + grp;
    const bf16* Qp; const bf16* Kp; const bf16* VT; int ldq;
    if (ISA) { const bf16* QKA = WSP(bf16, WS_QKA); Qp = QKA + (size_t)b * SEQ * 2048 + hx * 128 + grp * 64; Kp = QKA + (size_t)b * SEQ * 2048 + 1024 + hx * 128; ldq = 2048; VT = WSP(bf16, WS_VTA) + (size_t)(b * 8 + hx) * 128 * VROW; }
    else { const bf16* QKD = WSP(bf16, WS_QKD); Qp = QKD + (size_t)b * SEQ * 1152 + hd * 64; Kp = QKD + (size_t)b * SEQ * 1152 + 1024 + kvh * 64; ldq = 1152; VT = WSP(bf16, WS_VTD) + (size_t)(b * 2 + kvh) * 64 * VROW; }
    const int qpos = q0 + 32 * qs + r32;
    bf16x8 qr[4];
#pragma unroll
    for (int d0 = 0; d0 < 4; ++d0) qr[d0] = *(const bf16x8*)(Qp + (size_t)qpos * ldq + d0 * 16 + hi * 8);
    LAS float* Bt = (LAS float*)(L + 2 * BUFB);
    { const float* TAB = WSP(float, WS_TAB);
      if (ISA) { if (tid < 130) Bt[tid] = tid == 0 ? NEG : (tid == 129 ? 0.f : TAB[hx * 128 + tid - 1] - TAB[hx * 128 + 127]); }
      else { if (tid < 260) { const int gi = tid >= 130, t = tid - 130 * gi; Bt[tid] = (t == 0 || t == 129) ? NEG : TAB[(8 + kvh * 8 + (hx & 3) * 2 + gi) * 128 + t - 1]; } } }
    const int TQ = q0 >> 6, T0 = ISA ? 0 : (TQ >= 2 ? TQ - 2 : 0), T1 = TQ + 1;
    v4u kreg[NCH], vreg[NCH];
#define AT_GLOAD(T) do { _Pragma("unroll") for (int i_ = 0; i_ < NCH; ++i_) { const int c_ = tid + 512 * i_; \
        const int kr_ = ISA ? (c_ >> 4) : (c_ >> 3), kc_ = ISA ? (c_ & 15) : (c_ & 7); kreg[i_] = *(const v4u*)(Kp + (size_t)((T) * 64 + kr_) * ldq + kc_ * 8); \
        const int vr_ = c_ >> 3, vc_ = c_ & 7; vreg[i_] = *(const v4u*)(VT + (size_t)vr_ * VROW + (T) * 64 + vc_ * 8); } } while (0)
#define AT_LWRITE(buf) do { _Pragma("unroll") for (int i_ = 0; i_ < NCH; ++i_) { const int c_ = tid + 512 * i_; \
        const int kr_ = ISA ? (c_ >> 4) : (c_ >> 3), kc_ = ISA ? (c_ & 15) : (c_ & 7); *(LAS v4u*)(L + (buf) * BUFB + kr_ * KSTR + kc_ * 16) = kreg[i_]; \
        const int vr_ = c_ >> 3, vc_ = c_ & 7; *(LAS v4u*)(L + (buf) * BUFB + KBYTES + vr_ * VSTR + vc_ * 16) = vreg[i_]; } } while (0)
    f32x16 o[NDV];
#pragma unroll
    for (int i = 0; i < NDV; ++i) o[i] = (f32x16){0.f, 0.f, 0.f, 0.f, 0.f, 0.f, 0.f, 0.f, 0.f, 0.f, 0.f, 0.f, 0.f, 0.f, 0.f, 0.f};
    float m_run = ISA ? NEG : F.kin[I_SSINK][l * 16 + hd] * LOG2E, l_run = ISA ? 0.f : (hi == 0 ? 1.f : 0.f);
    const int krow = (r32 & 16) | (r32 & 3) | ((r32 & 4) << 1) | ((r32 & 8) >> 1);
    const int koff = krow * KSTR + (ISA ? grp * 128 : 0) + hi * 16, voff = KBYTES + r32 * VSTR + hi * 16;
    AT_GLOAD(T0); AT_LWRITE(0); __syncthreads();
#pragma unroll 1
    for (int T = T0; T <= T1; ++T) {
        const int cur = (T - T0) & 1;
        AT_GLOAD(T < T1 ? T + 1 : T1);
        LAS const unsigned char* Kb = L + cur * BUFB;
        f32x16 s[2];
#pragma unroll
        for (int blk = 0; blk < 2; ++blk) { s[blk] = (f32x16){0.f, 0.f, 0.f, 0.f, 0.f, 0.f, 0.f, 0.f, 0.f, 0.f, 0.f, 0.f, 0.f, 0.f, 0.f, 0.f};
#pragma unroll
            for (int d0 = 0; d0 < 4; ++d0) { const bf16x8 kf = *(const LAS bf16x8*)(Kb + koff + blk * 32 * KSTR + d0 * 32); s[blk] = __builtin_amdgcn_mfma_f32_32x32x16_bf16(kf, qr[d0], s[blk], 0, 0, 0); } }
        bf16x8 vfc[NDV], vfn[NDV];
#pragma unroll
        for (int i = 0; i < NDV; ++i) vfc[i] = *(const LAS bf16x8*)(Kb + voff + i * 32 * VSTR);
        if (!ISA || T >= TQ - 2) {
            const LAS float* bt = Bt + (ISA ? 0 : grp * 130) + 1; const int d0 = qpos - T * 64 - 8 * hi;
#pragma unroll
            for (int blk = 0; blk < 2; ++blk)
#pragma unroll
                for (int r = 0; r < 16; ++r) { const int dist = d0 - (32 * blk + 16 * (r >> 3) + (r & 7)); const int di = dist < -1 ? -1 : (dist > 128 ? 128 : dist); s[blk][r] += bt[di]; } }
        float mt = s[0][0];
#pragma unroll
        for (int r = 1; r < 16; ++r) mt = fmaxf(mt, s[0][r]);
#pragma unroll
        for (int r = 0; r < 16; ++r) mt = fmaxf(mt, s[1][r]);
        mt = xmax32(mt);
        const float m_new = fmaxf(m_run, mt);
        if (__any(m_new > m_run)) { const float alpha = __builtin_amdgcn_exp2f(m_run - m_new); l_run *= alpha;
#pragma unroll
            for (int i = 0; i < NDV; ++i)
#pragma unroll
                for (int r = 0; r < 16; ++r) o[i][r] *= alpha;
            m_run = m_new; }
        float ls = 0.f;
#pragma unroll
        for (int blk = 0; blk < 2; ++blk)
#pragma unroll
            for (int r = 0; r < 16; ++r) { const float pv_ = __builtin_amdgcn_exp2f(s[blk][r] - m_run); s[blk][r] = pv_; ls += pv_; }
        l_run += ls;
#pragma unroll
        for (int sl = 0; sl < 4; ++sl) { const int blk = sl >> 1, r0 = 8 * (sl & 1);
            v4u pw; pw.x = pg8::cvt_pk_bf16(s[blk][r0], s[blk][r0 + 1]); pw.y = pg8::cvt_pk_bf16(s[blk][r0 + 2], s[blk][r0 + 3]); pw.z = pg8::cvt_pk_bf16(s[blk][r0 + 4], s[blk][r0 + 5]); pw.w = pg8::cvt_pk_bf16(s[blk][r0 + 6], s[blk][r0 + 7]);
            const bf16x8 pf = __builtin_bit_cast(bf16x8, pw);
#pragma unroll
            for (int i = 0; i < NDV; ++i) { if (sl < 3) vfn[i] = *(const LAS bf16x8*)(Kb + voff + i * 32 * VSTR + (sl + 1) * 32); o[i] = __builtin_amdgcn_mfma_f32_32x32x16_bf16(vfc[i], pf, o[i], 0, 0, 0); }
#pragma unroll
            for (int i = 0; i < NDV; ++i) vfc[i] = vfn[i]; }
        AT_LWRITE(cur ^ 1);
        __syncthreads();
    }
#undef AT_GLOAD
#undef AT_LWRITE
    const float inv = 1.0f / xsum32(l_run);
    bf16* MIX = WSP(bf16, WS_MIXED);
    if (ISA) {
        int ll_ = l; asm volatile("" : "+s"(ll_)); const float lam_init = ll_ == 0 ? 0.2f : 0.35550906759f;     float lam_full;
        { const float* lm = F.kin[I_DLAM] + (size_t)l * 256; const float s1 = wave_sum(lm[lane] * lm[64 + lane]), s2 = wave_sum(lm[128 + lane] * lm[192 + lane]); lam_full = __expf(s1) - __expf(s2) + lam_init; }
        LAS float* R1 = (LAS float*)L;
        LAS bf16* R2 = (LAS bf16*)(L + 66048);
        const int ql = 32 * qs + r32;
        if (grp == 1) {
#pragma unroll
            for (int i = 0; i < NDV; ++i)
#pragma unroll
                for (int r = 0; r < 16; ++r) R1[ql * 129 + 32 * i + crow16(r, hi)] = lam_full * inv * o[i][r]; }
        __syncthreads();
        if (grp == 0) { float ss = 0.f;
#pragma unroll
            for (int i = 0; i < NDV; ++i)
#pragma unroll
                for (int r = 0; r < 16; ++r) { const float d = o[i][r] * inv - R1[ql * 129 + 32 * i + crow16(r, hi)]; o[i][r] = d; ss += d * d; }
            const float rstd = rsqrtf(xsum32(ss) * (1.0f / 128.0f) + 1e-6f) * (1.0f - lam_init);
            const float* sl = F.kin[I_DSUB] + l * 128;
#pragma unroll
            for (int i = 0; i < NDV; ++i)
#pragma unroll
                for (int r = 0; r < 16; ++r) { const int dv = 32 * i + crow16(r, hi); R2[ql * 132 + dv] = (bf16)f2bf(o[i][r] * rstd * sl[dv]); } }
        __syncthreads();
#pragma unroll
        for (int i = 0; i < 4; ++i) { const int c = tid + 512 * i, row = c >> 4, ch = c & 15; const LAS v2u* sp = (const LAS v2u*)(R2 + row * 132 + ch * 8); const v2u a = sp[0], bb = sp[1];
            *(v4u*)(MIX + (size_t)(b * SEQ + q0 + row) * DM + hx * 128 + ch * 8) = (v4u){a.x, a.y, bb.x, bb.y}; }
    } else {
        LAS bf16* R = (LAS bf16*)L + F.wave * 2176;
#pragma unroll
        for (int i = 0; i < NDV; ++i)
#pragma unroll
            for (int r = 0; r < 16; ++r) R[r32 * 68 + 32 * i + crow16(r, hi)] = (bf16)f2bf(o[i][r] * inv);
#pragma unroll
        for (int i = 0; i < 4; ++i) { const int c = lane + 64 * i, row = c >> 3, ch = c & 7; const LAS v2u* sp = (const LAS v2u*)(R + row * 68 + ch * 8); const v2u a = sp[0], bb = sp[1];
            *(v4u*)(MIX + (size_t)(b * SEQ + q0 + 32 * qs + row) * DM + 3072 + hd * 64 + ch * 8) = (v4u){a.x, a.y, bb.x, bb.y}; }
    }
}
__device__ __forceinline__ void prep_gla(Frame& F) {
    LAS float* Lb = (LAS float*)(F.lds + RING_OFF); LAS float* Qd = Lb + 64 * 129; LAS float* Ki = Qd + 64 * 129; LAS bf16* Kt = (LAS bf16*)(Ki + 64 * 129);
    const bf16* COLS = WSP(bf16, WS_COLS); const float* LOGA = WSP(float, WS_LOGA);
    bf16* QDEC = WSP(bf16, WS_QDEC); bf16* KDT = WSP(bf16, WS_KDT); bf16* AMg = WSP(bf16, WS_AM); float* EBL = WSP(float, WS_EBL);
    for (int u = F.bx; u < 1024; u += F.G) {
        const int b = u >> 9, h = (u >> 7) & 3, ck = u & 127; const size_t row0 = (size_t)b * SEQ + ck * 64;
        __syncthreads();
        f32x4 lg[4]; v4u qv[2], kv[2];
#pragma unroll
        for (int i = 0; i < 4; ++i) { const int i4 = F.tid + 512 * i, t = i4 >> 5, d4 = (i4 & 31) * 4; lg[i] = *(const f32x4*)(LOGA + (row0 + t) * 512 + h * 128 + d4); }
#pragma unroll
        for (int i = 0; i < 2; ++i) { const int i8 = F.tid + 512 * i, t = i8 >> 4, d8 = (i8 & 15) * 8; const bf16* p = COLS + (row0 + t) * NMAIN + h * 128 + d8; qv[i] = *(const v4u*)(p + CB_Q); kv[i] = *(const v4u*)(p + CB_K); }
#pragma unroll
        for (int i = 0; i < 4; ++i) { const int i4 = F.tid + 512 * i, t = i4 >> 5, d4 = (i4 & 31) * 4;
#pragma unroll
            for (int e = 0; e < 4; ++e) Lb[t * 129 + d4 + e] = lg[i][e]; }
        __syncthreads();
        if (F.tid < 128) { float a[64];
#pragma unroll
            for (int t = 0; t < 64; ++t) a[t] = Lb[t * 129 + F.tid];
#pragma unroll
            for (int t = 1; t < 64; ++t) a[t] += a[t - 1];
#pragma unroll
            for (int t = 0; t < 64; ++t) Lb[t * 129 + F.tid] = a[t];
            EBL[(size_t)u * 128 + F.tid] = __expf(a[63]); }
        __syncthreads();
#pragma unroll
        for (int i = 0; i < 2; ++i) { const int i8 = F.tid + 512 * i, t = i8 >> 4, d8 = (i8 & 15) * 8; float q[8], k[8], qo[8]; unpack8(qv[i], q); unpack8(kv[i], k);
#pragma unroll
            for (int e = 0; e < 8; ++e) { const int d = d8 + e; const float bt = Lb[t * 129 + d], bl = Lb[63 * 129 + d];
                const float qd = q[e] * 0.08838834764831845f * __expf(bt); Qd[t * 129 + d] = qd; Ki[t * 129 + d] = k[e] * __expf(-bt); Kt[d * 72 + t] = (bf16)f2bf(k[e] * __expf(bl - bt)); qo[e] = qd; }
            *(v4u*)(QDEC + ((size_t)u * 64 + t) * 128 + d8) = pack8(qo); }
        __syncthreads();
#pragma unroll
        for (int i = 0; i < 2; ++i) { const int c_ = F.tid + 512 * i, row = c_ >> 3, ch = c_ & 7; const LAS v2u* sp = (const LAS v2u*)(Kt + row * 72 + ch * 8); const v2u a = sp[0], bb = sp[1];
            *(v4u*)(KDT + ((size_t)u * 128 + row) * 64 + ch * 8) = (v4u){a.x, a.y, bb.x, bb.y}; }
        {
          const int n = F.lane & 15, gq = F.lane >> 4, ct = F.wave >> 1, st0 = 2 * (F.wave & 1);
          f32x4 c0 = (f32x4){0.f, 0.f, 0.f, 0.f}, c1 = (f32x4){0.f, 0.f, 0.f, 0.f};
          if (st0 <= ct) {
              const LAS float* ap = Qd + (16 * ct + n) * 129 + gq; const LAS float* bp0 = Ki + (16 * st0 + n) * 129 + gq; const LAS float* bp1 = bp0 + 16 * 129;
#pragma unroll 8
              for (int ks = 0; ks < 32; ++ks) { const float av = ap[4 * ks]; c0 = __builtin_amdgcn_mfma_f32_16x16x4f32(av, bp0[4 * ks], c0, 0, 0, 0); c1 = __builtin_amdgcn_mfma_f32_16x16x4f32(av, bp1[4 * ks], c1, 0, 0, 0); } }
#pragma unroll
          for (int rr = 0; rr < 4; ++rr) { const int c = 16 * ct + 4 * gq + rr, s0 = 16 * st0 + n, s1 = s0 + 16;
              bf16* op = AMg + ((size_t)u * 64 + c) * 64; op[s0] = (bf16)f2bf(s0 <= c ? c0[rr] : 0.f); op[s1] = (bf16)f2bf(s1 <= c ? c1[rr] : 0.f); } }
    }
}
template <int PASS> __device__ __forceinline__ void prep_vt(Frame& F) {
    LAS bf16* T = (LAS bf16*)(F.lds + RING_OFF);
    const bf16* COLS = WSP(bf16, WS_COLS);
    constexpr int ncol = PASS == 4 ? 128 : 512, nch = ncol >> 3, NI = 64 * nch / (NWAVES * 64);
    constexpr int col0 = PASS < 2 ? CA_V + 512 * PASS : (PASS < 4 ? CB_V + 512 * (PASS - 2) : CD_V);
    bf16* dst0 = PASS < 2 ? WSP(bf16, WS_VTA) + (size_t)(512 * PASS) * VROW : (PASS < 4 ? WSP(bf16, WS_VTB) + (size_t)(512 * (PASS - 2)) * VROW : WSP(bf16, WS_VTD));
    constexpr int rows_b = PASS == 4 ? 128 : 1024;
    for (int tile = F.bx; tile < M / 64; tile += F.G) {
        const int b = tile >> 7, t0 = (tile & 127) * 64;
        __syncthreads();
        v4u v[NI];
#pragma unroll
        for (int i = 0; i < NI; ++i) { const int idx = F.tid + NWAVES * 64 * i, tok = idx / nch, ch = idx % nch; v[i] = *(const v4u*)(COLS + (size_t)(b * SEQ + t0 + tok) * NMAIN + col0 + ch * 8); }
#pragma unroll
        for (int i = 0; i < NI; ++i) { const int idx = F.tid + NWAVES * 64 * i, tok = idx / nch, ch = idx % nch; LAS unsigned* d = (LAS unsigned*)(T + tok * 522 + ch * 8); d[0] = v[i].x; d[1] = v[i].y; d[2] = v[i].z; d[3] = v[i].w; }
        __syncthreads();
#pragma unroll
        for (int i = 0; i < NI; ++i) { const int idx = F.tid + NWAVES * 64 * i, vrow = idx >> 3, ch = idx & 7;
            unsigned e[8];
#pragma unroll
            for (int k = 0; k < 8; ++k) e[k] = T[(ch * 8 + k) * 522 + vrow];
            v4u o; o.x = e[0] | (e[1] << 16); o.y = e[2] | (e[3] << 16); o.z = e[4] | (e[5] << 16); o.w = e[6] | (e[7] << 16);
            *(v4u*)(dst0 + ((size_t)b * rows_b + vrow) * VROW + t0 + ch * 8) = o; }
    }
}
typedef float f32x4v __attribute__((ext_vector_type(4)));
__device__ __forceinline__ float sum16(float v) { v = sum8(v); v += dpp_f<0x140>(v); return v; }
#define LDS_BARRIER() asm volatile("s_waitcnt lgkmcnt(0)\n\ts_barrier" ::: "memory")
template <int HACK = 0> __device__ __forceinline__ void gla_scan_unit(Frame& F, int l, int b, int h, int vh) {
    LAS unsigned char* L = F.lds + RING_OFF;
    constexpr int OQD = 0, OKT = 17408, OAM = 35840, OVT = 45056, OOT = 63488, OEB = 80896, OPS = 81408;
    const int tid = F.tid, lane = F.lane, n = lane & 15, g = lane >> 4, w = F.wave;
    const bf16* QDEC = WSP(bf16, WS_QDEC); const bf16* KDT = WSP(bf16, WS_KDT); const bf16* AMg = WSP(bf16, WS_AM); const float* EBL = WSP(float, WS_EBL);
    const bf16* VTB = WSP(bf16, WS_VTB) + (size_t)((b * 4 + h) * 256 + 128 * vh) * VROW; bf16* OB = WSP(bf16, WS_OB); float* PSG = WSP(float, WS_PSG);
    f32x4v S[8];
#pragma unroll
    for (int dt = 0; dt < 8; ++dt) S[dt] = (f32x4v){0.f, 0.f, 0.f, 0.f};
    v4u pq[2], pk[2], pa, pv[2]; float pe = 0.f;
#define GL_ISSUE(CK) do { const size_t u_ = (size_t)(b * 4 + h) * 128 + (CK); \
        _Pragma("unroll") for (int i = 0; i < 2; ++i) { const int c_ = tid + 512 * i; pq[i] = *(const v4u*)(QDEC + (u_ * 64 + (c_ >> 4)) * 128 + (c_ & 15) * 8); pk[i] = *(const v4u*)(KDT + (u_ * 128 + (c_ >> 3)) * 64 + (c_ & 7) * 8); \
            pv[i] = *(const v4u*)(VTB + (size_t)(c_ >> 3) * VROW + (CK) * 64 + (c_ & 7) * 8); } \
        pa = *(const v4u*)(AMg + (u_ * 64 + (tid >> 3)) * 64 + (tid & 7) * 8); \
        pe = EBL[u_ * 128 + (tid & 127)]; } while (0)
#define GL_WRITE() do { _Pragma("unroll") for (int i = 0; i < 2; ++i) { const int c_ = tid + 512 * i; *(LAS v4u*)(L + OQD + (c_ >> 4) * 272 + (c_ & 15) * 16) = pq[i]; *(LAS v4u*)(L + OKT + (c_ >> 3) * 144 + (c_ & 7) * 16) = pk[i]; \
            *(LAS v4u*)(L + OVT + (c_ >> 3) * 144 + (c_ & 7) * 16) = pv[i]; } \
        *(LAS v4u*)(L + OAM + (tid >> 3) * 144 + (tid & 7) * 16) = pa; \
        ((LAS float*)(L + OEB))[tid & 127] = pe; } while (0)
    GL_ISSUE(0); GL_WRITE();
    LDS_BARRIER();
#pragma unroll 1
    for (int ck = 0; ck < 128; ++ck) {
        const size_t row0 = (size_t)b * SEQ + ck * 64;
        GL_ISSUE((HACK & 1) && ck >= 2 ? 2 : (ck + 1 < 128 ? ck + 1 : 127));
        bf16x8 vf[2];
#pragma unroll
        for (int ks = 0; ks < 2; ++ks) vf[ks] = *(const LAS bf16x8*)(L + OVT + (16 * w + n) * 144 + (32 * ks + 8 * g) * 2);
        f32x4v o[4];
#pragma unroll
        for (int ct = 0; ct < 4; ++ct) o[ct] = (f32x4v){0.f, 0.f, 0.f, 0.f};
#pragma unroll
        for (int ct = 0; ct < 4; ++ct)
#pragma unroll
            for (int ks = 0; ks < 2; ++ks) { const bf16x8 af = *(const LAS bf16x8*)(L + OAM + (16 * ct + n) * 144 + (32 * ks + 8 * g) * 2); o[ct] = __builtin_amdgcn_mfma_f32_16x16x32_bf16(af, vf[ks], o[ct], 0, 0, 0); }
#pragma unroll
        for (int kk = 0; kk < 4; ++kk) { v4u pw; pw.x = pg8::cvt_pk_bf16(S[2 * kk][0], S[2 * kk][1]); pw.y = pg8::cvt_pk_bf16(S[2 * kk][2], S[2 * kk][3]);
            pw.z = pg8::cvt_pk_bf16(S[2 * kk + 1][0], S[2 * kk + 1][1]); pw.w = pg8::cvt_pk_bf16(S[2 * kk + 1][2], S[2 * kk + 1][3]); const bf16x8 sf = __builtin_bit_cast(bf16x8, pw);
#pragma unroll
            for (int ct = 0; ct < 4; ++ct) { const LAS unsigned char* qp = L + OQD + (16 * ct + n) * 272 + (32 * kk + 4 * g) * 2; const v2u qa = *(const LAS v2u*)qp, qb = *(const LAS v2u*)(qp + 32);
                o[ct] = __builtin_amdgcn_mfma_f32_16x16x32_bf16(__builtin_bit_cast(bf16x8, (v4u){qa.x, qa.y, qb.x, qb.y}), sf, o[ct], 0, 0, 0); } }
#pragma unroll
        for (int dt = 0; dt < 8; ++dt) { const f32x4v eb = *(const LAS f32x4v*)(L + OEB + (16 * dt + 4 * g) * 4); S[dt] = S[dt] * eb;
#pragma unroll
            for (int ks = 0; ks < 2; ++ks) { const bf16x8 kf = *(const LAS bf16x8*)(L + OKT + (16 * dt + n) * 144 + (32 * ks + 8 * g) * 2); S[dt] = __builtin_amdgcn_mfma_f32_16x16x32_bf16(kf, vf[ks], S[dt], 0, 0, 0); } }
        LAS float* PS = (LAS float*)(L + OPS) + (ck & 1) * 512;
#pragma unroll
        for (int ct = 0; ct < 4; ++ct)
#pragma unroll
            for (int r = 0; r < 4; ++r) { const float ss = sum16(o[ct][r] * o[ct][r]); if (n == 0) PS[(16 * ct + 4 * g + r) * 8 + w] = ss;
                *(LAS bf16*)(L + OOT + (16 * ct + 4 * g + r) * 272 + (16 * w + n) * 2) = (bf16)f2bf(o[ct][r]); }
        LDS_BARRIER();
        GL_WRITE();
        if (!(HACK & 2)) {
#pragma unroll
        for (int i = 0; i < 2; ++i) { const int c_ = tid + 512 * i, tok = c_ >> 4, ch = c_ & 15; *(v4u*)(OB + (row0 + tok) * 1024 + h * 256 + 128 * vh + ch * 8) = *(const LAS v4u*)(L + OOT + tok * 272 + ch * 16); }
        if (tid < 64) { const LAS f32x4v* pp = (const LAS f32x4v*)(PS + tid * 8); const f32x4v p0 = pp[0], p1 = pp[1]; PSG[(row0 + tid) * 8 + h * 2 + vh] = ((p0.x + p0.y) + (p0.z + p0.w)) + ((p1.x + p1.y) + (p1.z + p1.w)); } }
        LDS_BARRIER();
    }
#undef GL_ISSUE
#undef GL_WRITE
}
__device__ __forceinline__ void gla_post(Frame& F, int l) {
    const bf16* OB = WSP(bf16, WS_OB); const float* PSG = WSP(float, WS_PSG); const bf16* COLS = WSP(bf16, WS_COLS); bf16* MIX = WSP(bf16, WS_MIXED);
    const int ch = F.tid & 127, h = ch >> 5; float gain8[8];
#pragma unroll
    for (int e = 0; e < 8; ++e) gain8[e] = F.kin[I_GON][l * 256 + (ch & 31) * 8 + e];
    for (int row0 = F.bx * 4 + (F.tid >> 7); row0 < M; row0 += F.G * 16) {
        v4u ovr[4], gvr[4]; f32x2_t ps[4];
#pragma unroll
        for (int i = 0; i < 4; ++i) { const int row = row0 + F.G * 4 * i < M ? row0 + F.G * 4 * i : row0;
            ovr[i] = *(const v4u*)(OB + (size_t)row * 1024 + ch * 8); gvr[i] = *(const v4u*)(COLS + (size_t)row * NMAIN + CB_G + ch * 8); ps[i] = *(const f32x2_t*)(PSG + (size_t)row * 8 + h * 2); }
#pragma unroll
        for (int i = 0; i < 4; ++i) { const int row = row0 + F.G * 4 * i; float ov[8], gv[8]; unpack8(ovr[i], ov); unpack8(gvr[i], gv);
            const float rstd = rsqrtf((ps[i].x + ps[i].y) * (1.0f / 256.0f) + 1e-6f);
#pragma unroll
            for (int e = 0; e < 8; ++e) ov[e] = ov[e] * (rstd * gain8[e]) * silu_g(gv[e]);
            if (row < M) *(v4u*)(MIX + (size_t)row * DM + 1024 + ch * 8) = pack8(ov); }
    }
}
constexpr int RC_AT = 0, RC_RT = 2048, RC_BK = 4096, RC_VF = 8192, RC_GF = 10240, RC_U0 = 12288, RC_Y0 = 16384, RC_P15 = 20480, RC_BN = 20736, RC_BYTES = 20800;
__device__ __forceinline__ void rwkv_chunks_of_tile(Frame& F, int l, int tile) {
    const int team = F.tid >> 8, tt = F.tid & 255;
    LAS float* Lt = (LAS float*)(F.lds + RING_OFF) + team * 12288;
    LAS float* XA = Lt; LAS float* XR = Lt + 1040; LAS float* ZB = Lt + 2080; LAS float* ZK = Lt + 3120; LAS float* TB = Lt + 4160; LAS float* TK = Lt + 5200; LAS float* VV = Lt + 6240;
    LAS float* ATl = Lt + 7280; LAS float* U0l = Lt + 8320; LAS float* W1 = Lt + 9360;
    LAS float* Aab = Lt + 10400; LAS float* Aak = Lt + 10672; LAS float* Arb = Lt + 10944; LAS float* Ark = Lt + 11216; LAS float* TT = Lt + 11488;
    const float* RW = WSP(float, WS_RW); const unsigned* RWU = WSP(unsigned, WS_RW); constexpr size_t RS = RW_ONE / 4; unsigned char* RWC = F.ws + WS_RWC;
    float pw_[6], pr_[4], pk_[4], pv_[4], pa_[4], pb_[4], pg_[4];
#define RC_FETCH(P) do { const int h_ = 2 * (P) + team; const size_t cb_ = (size_t)tile * 16 * 1024 + h_ * 64 + (tt & 63); const int q_ = tt >> 6; \
        pw_[4] = RW[RS + cb_ + (size_t)(q_ ? 4 * q_ - 1 : 0) * 1024]; pw_[5] = RW[RS + cb_ + (size_t)15 * 1024];            \
        _Pragma("unroll") for (int e = 0; e < 4; ++e) { const size_t o_ = cb_ + (size_t)(4 * q_ + e) * 1024; pw_[e] = RW[RS + o_]; const unsigned u0 = RWU[o_], u2 = RWU[2 * RS + o_], u3 = RWU[3 * RS + o_]; \
            pr_[e] = bflo(u0); pk_[e] = bfhi(u0); pv_[e] = bflo(u2); pg_[e] = bfhi(u2); pa_[e] = bflo(u3); pb_[e] = bfhi(u3); } } while (0)
    RC_FETCH(0);
#pragma unroll 1
    for (int pair = 0; pair < 8; ++pair) {
        const int uc = ((tile >> 9) * 16 + 2 * pair + team) * 512 + (tile & 511), b = uc >> 13, h = (uc >> 9) & 15, ck = uc & 511; unsigned char* rec = RWC + ((size_t)ck * 32 + (uc >> 9)) * RC_BYTES;     (void)b;
        __syncthreads();
        {
          const int j = tt & 63, q = tt >> 6;
          const float cl = pw_[5], clm = q ? pw_[4] : 0.f; const float clq[4] = {pw_[0], pw_[1], pw_[2], pw_[3]};
#pragma unroll
          for (int e = 0; e < 4; ++e) { const int t = 4 * q + e; const float cprev = e == 0 ? clm : clq[e - 1], cc = clq[e];
              const float rr = pr_[e], kk = pk_[e], vv = pv_[e], aa = pa_[e], bb = pb_[e];
              XA[t * 65 + j] = aa * __expf(cprev); XR[t * 65 + j] = rr * __expf(cc); const float ei = __expf(-cc), ef = __expf(cl - cc);
              ZB[t * 65 + j] = bb * ei; ZK[t * 65 + j] = kk * ei; TB[t * 65 + j] = bb * ef; TK[t * 65 + j] = kk * ef; VV[t * 65 + j] = vv; }
          if (q == 0) ((float*)(rec + RC_P15))[j] = __expf(cl);
          { v2u gw; gw.x = pk2(pg_[0], pg_[1]); gw.y = pk2(pg_[2], pg_[3]); *(v2u*)(rec + RC_GF + (((j >> 4) * 64 + 16 * q + (j & 15)) * 8)) = gw; } }
        RC_FETCH(pair < 7 ? pair + 1 : 7);
        __syncthreads();
        {
          const int q = tt >> 6, n = tt & 15, g = (tt >> 4) & 3; const LAS float* X = (q & 2) ? XR : XA; const LAS float* Z = (q & 1) ? ZK : ZB; LAS float* O = q == 0 ? Aab : (q == 1 ? Aak : (q == 2 ? Arb : Ark));
          f32x4v c = (f32x4v){0.f, 0.f, 0.f, 0.f};
#pragma unroll
          for (int ks = 0; ks < 16; ++ks) c = __builtin_amdgcn_mfma_f32_16x16x4f32(X[n * 65 + 4 * ks + g], Z[n * 65 + 4 * ks + g], c, 0, 0, 0);
#pragma unroll
          for (int rr = 0; rr < 4; ++rr) { const int t = 4 * g + rr; O[t * 17 + n] = ((q & 2) ? n <= t : n < t) ? c[rr] : 0.f; }
          { const int t = tt >> 4, jq = tt & 15; const float* rkp = F.kin[I_RRK] + l * 1024 + h * 64 + 4 * jq; float bn = 0.f;
#pragma unroll
            for (int e = 0; e < 4; ++e) bn += XR[t * 65 + 4 * jq + e] * ZK[t * 65 + 4 * jq + e] * rkp[e];
            bn = sum16(bn); if (jq == 0) ((float*)(rec + RC_BN))[t] = bn; } }
        __syncthreads();
        {
          if (tt < 16) { float col[16];
#pragma unroll
              for (int t = 0; t < 16; ++t) { float acc = (t == tt) ? 1.f : 0.f;
#pragma unroll
                  for (int s = 0; s < 16; ++s) if (s < t) acc += Aab[t * 17 + s] * col[s];
                  col[t] = acc; TT[t * 17 + tt] = acc; } }
          const int q = tt >> 6, n = tt & 15, g = (tt >> 4) & 3; f32x4v c = (f32x4v){0.f, 0.f, 0.f, 0.f};
#pragma unroll
          for (int ks = 0; ks < 4; ++ks) c = __builtin_amdgcn_mfma_f32_16x16x4f32(Aak[n * 17 + 4 * ks + g], VV[(4 * ks + g) * 65 + 16 * q + n], c, 0, 0, 0);
#pragma unroll
          for (int rr = 0; rr < 4; ++rr) W1[(4 * g + rr) * 65 + 16 * q + n] = c[rr]; }
        __syncthreads();
        {
          const int q = tt >> 6, n = tt & 15, g = (tt >> 4) & 3; f32x4v ca = (f32x4v){0.f, 0.f, 0.f, 0.f}, cu = (f32x4v){0.f, 0.f, 0.f, 0.f};
#pragma unroll
          for (int ks = 0; ks < 4; ++ks) { const float tv = TT[n * 17 + 4 * ks + g]; ca = __builtin_amdgcn_mfma_f32_16x16x4f32(tv, XA[(4 * ks + g) * 65 + 16 * q + n], ca, 0, 0, 0); cu = __builtin_amdgcn_mfma_f32_16x16x4f32(tv, W1[(4 * ks + g) * 65 + 16 * q + n], cu, 0, 0, 0); }
#pragma unroll
          for (int rr = 0; rr < 4; ++rr) { ATl[(4 * g + rr) * 65 + 16 * q + n] = ca[rr]; U0l[(4 * g + rr) * 65 + 16 * q + n] = cu[rr]; }
          *(f32x4v*)(rec + RC_U0 + ((q * 64 + 16 * g + n) * 16)) = cu; }
        __syncthreads();
        {
          const int q = tt >> 6, n = tt & 15, g = (tt >> 4) & 3; f32x4v cr, cy = (f32x4v){0.f, 0.f, 0.f, 0.f};
#pragma unroll
          for (int rr = 0; rr < 4; ++rr) cr[rr] = XR[(4 * g + rr) * 65 + 16 * q + n];
#pragma unroll
          for (int ks = 0; ks < 4; ++ks) { const float arb = Arb[n * 17 + 4 * ks + g], ark = Ark[n * 17 + 4 * ks + g];
              cr = __builtin_amdgcn_mfma_f32_16x16x4f32(arb, ATl[(4 * ks + g) * 65 + 16 * q + n], cr, 0, 0, 0);
              cy = __builtin_amdgcn_mfma_f32_16x16x4f32(arb, U0l[(4 * ks + g) * 65 + 16 * q + n], cy, 0, 0, 0);
              cy = __builtin_amdgcn_mfma_f32_16x16x4f32(ark, VV[(4 * ks + g) * 65 + 16 * q + n], cy, 0, 0, 0); }
          *(f32x4v*)(rec + RC_Y0 + ((q * 64 + 16 * g + n) * 16)) = cy;
#pragma unroll
          for (int rr = 0; rr < 4; ++rr) W1[(4 * g + rr) * 65 + 16 * q + n] = cr[rr]; }
        __syncthreads();
        { const int t = tt & 15, jq = tt >> 4, kk = jq >> 3, half = (jq & 7) >> 2, g = jq & 3, j0 = 4 * jq;
          v2u wa, wr; wa.x = pk2(ATl[t * 65 + j0], ATl[t * 65 + j0 + 1]); wa.y = pk2(ATl[t * 65 + j0 + 2], ATl[t * 65 + j0 + 3]); wr.x = pk2(W1[t * 65 + j0], W1[t * 65 + j0 + 1]); wr.y = pk2(W1[t * 65 + j0 + 2], W1[t * 65 + j0 + 3]);
          *(v2u*)(rec + RC_AT + kk * 1024 + (16 * g + t) * 16 + half * 8) = wa; *(v2u*)(rec + RC_RT + kk * 1024 + (16 * g + t) * 16 + half * 8) = wr;
          const int j = tt & 63, gg = tt >> 6; v4u bk; bk.x = pk2(TB[(4 * gg) * 65 + j], TB[(4 * gg + 1) * 65 + j]); bk.y = pk2(TB[(4 * gg + 2) * 65 + j], TB[(4 * gg + 3) * 65 + j]);
          bk.z = pk2(TK[(4 * gg) * 65 + j], TK[(4 * gg + 1) * 65 + j]); bk.w = pk2(TK[(4 * gg + 2) * 65 + j], TK[(4 * gg + 3) * 65 + j]);
          *(v4u*)(rec + RC_BK + (j >> 4) * 1024 + (16 * gg + (j & 15)) * 16) = bk;
          v2u vf; vf.x = pk2(VV[(4 * gg) * 65 + j], VV[(4 * gg + 1) * 65 + j]); vf.y = pk2(VV[(4 * gg + 2) * 65 + j], VV[(4 * gg + 3) * 65 + j]);
          *(v2u*)(rec + RC_VF + ((j >> 4) * 64 + 16 * gg + (j & 15)) * 8) = vf; }
    }
}
#undef RC_FETCH
template <int HACK = 0> __device__ __forceinline__ void rwkv_scan_unit(Frame& F, int l, int b, int h) {
    LAS unsigned char* L = F.lds + RING_OFF;
    const unsigned char* recs = F.ws + WS_RWC + (size_t)(b * 16 + h) * RC_BYTES;
    const int lane = F.lane, n = lane & 15, g = lane >> 4;
    LAS float* XS = (LAS float*)(L + 2 * RC_BYTES);
    if (F.wave >= 2) {
        const int li = F.tid - 128;
        int px[4];
#pragma unroll
        for (int k = 0; k < 4; ++k) { const int x = li + 384 * k; px[k] = x < 1300 ? x : 1299; }
        v4u p0[4], p1[4], p2[4], p3[4], p4[4], p5[4], p6[4], p7[4];
#define RWL_ISSUE(P, CK) do { const int ck_ = (CK) < 512 ? ((HACK & 1) && (CK) >= 4 ? 3 : (CK)) : 511; const v4u* src_ = (const v4u*)(recs + (size_t)ck_ * 32 * RC_BYTES); \
        _Pragma("unroll") for (int k = 0; k < 4; ++k) P[k] = src_[px[k]]; } while (0)
#define RWL_WRITE(P, CK) do { LAS v4u* dst_ = (LAS v4u*)(L + ((CK) & 1) * RC_BYTES); _Pragma("unroll") for (int k = 0; k < 4; ++k) dst_[px[k]] = P[k]; } while (0)
        RWL_ISSUE(p0, 0); RWL_ISSUE(p1, 1); RWL_ISSUE(p2, 2); RWL_ISSUE(p3, 3); RWL_ISSUE(p4, 4); RWL_ISSUE(p5, 5); RWL_ISSUE(p6, 6); RWL_ISSUE(p7, 7);
        RWL_WRITE(p0, 0); RWL_ISSUE(p0, 8);
        LDS_BARRIER();
#pragma unroll 1
        for (int ck = 0; ck < 512; ck += 8) {
            RWL_WRITE(p1, ck + 1); RWL_ISSUE(p1, ck + 9); LDS_BARRIER();
            RWL_WRITE(p2, ck + 2); RWL_ISSUE(p2, ck + 10); LDS_BARRIER();
            RWL_WRITE(p3, ck + 3); RWL_ISSUE(p3, ck + 11); LDS_BARRIER();
            RWL_WRITE(p4, ck + 4); RWL_ISSUE(p4, ck + 12); LDS_BARRIER();
            RWL_WRITE(p5, ck + 5); RWL_ISSUE(p5, ck + 13); LDS_BARRIER();
            RWL_WRITE(p6, ck + 6); RWL_ISSUE(p6, ck + 14); LDS_BARRIER();
            RWL_WRITE(p7, ck + 7); RWL_ISSUE(p7, ck + 15); LDS_BARRIER();
            RWL_WRITE(p0, ck + 8); RWL_ISSUE(p0, ck + 16); LDS_BARRIER();
        }
#undef RWL_ISSUE
#undef RWL_WRITE
        return;
    }
    const int cw = F.wave;
    f32x4v S[4][2];
#pragma unroll
    for (int jt = 0; jt < 4; ++jt)
#pragma unroll
        for (int it = 0; it < 2; ++it) S[jt][it] = (f32x4v){0.f, 0.f, 0.f, 0.f};
    float lnw[2], lnb[2];
#pragma unroll
    for (int it = 0; it < 2; ++it) { lnw[it] = F.kin[I_RLNW][l * 1024 + h * 64 + 16 * (2 * cw + it) + n]; lnb[it] = F.kin[I_RLNB][l * 1024 + h * 64 + 16 * (2 * cw + it) + n]; }
    bf16* MIX = WSP(bf16, WS_MIXED) + ((size_t)b * SEQ) * DM + 2048 + h * 64 + 32 * cw + n;
    f32x4v Yp[2] = {(f32x4v){0.f, 0.f, 0.f, 0.f}, (f32x4v){0.f, 0.f, 0.f, 0.f}}, bnp = (f32x4v){0.f, 0.f, 0.f, 0.f}; v2u gfp[2] = {(v2u){0u, 0u}, (v2u){0u, 0u}}, vfp[2] = {(v2u){0u, 0u}, (v2u){0u, 0u}};
    LDS_BARRIER();
#pragma unroll 1
    for (int ck = 0; ck <= 512; ++ck) {
        if (ck > 0) {
            const LAS float* xs = XS + ((ck - 1) & 1) * 64; const f32x4v a0 = *(const LAS f32x4v*)(xs + 8 * g), a1 = *(const LAS f32x4v*)(xs + 8 * g + 4), b0 = *(const LAS f32x4v*)(xs + 32 + 8 * g), b1 = *(const LAS f32x4v*)(xs + 32 + 8 * g + 4);
            const float s1[4] = {a0[0] + b0[0], a0[2] + b0[2], a1[0] + b1[0], a1[2] + b1[2]}, s2[4] = {a0[1] + b0[1], a0[3] + b0[3], a1[1] + b1[1], a1[3] + b1[3]};
#pragma unroll
            for (int it = 0; it < 2; ++it) { const float gt[4] = {bflo(gfp[it].x), bfhi(gfp[it].x), bflo(gfp[it].y), bfhi(gfp[it].y)}, vt[4] = {bflo(vfp[it].x), bfhi(vfp[it].x), bflo(vfp[it].y), bfhi(vfp[it].y)};
#pragma unroll
                for (int r = 0; r < 4; ++r) { const float mean = s1[r] * (1.0f / 64.0f), var = fmaxf(s2[r] * (1.0f / 64.0f) - mean * mean, 0.f), rstd = rsqrtf(var + 64e-5f);
                    if (!(HACK & 2)) MIX[(size_t)((ck - 1) * 16 + 4 * g + r) * DM + 16 * it] = (bf16)f2bf(((Yp[it][r] - mean) * rstd * lnw[it] + lnb[it] + bnp[r] * vt[r]) * gt[r]); } }
            if (ck == 512) break;
        }
        if (HACK & 4) { LDS_BARRIER(); continue; }
        const LAS unsigned char* R = L + (ck & 1) * RC_BYTES;
        bf16x8 at[2], rt[2];
#pragma unroll
        for (int kk = 0; kk < 2; ++kk) { at[kk] = *(const LAS bf16x8*)(R + RC_AT + kk * 1024 + lane * 16); rt[kk] = *(const LAS bf16x8*)(R + RC_RT + kk * 1024 + lane * 16); }
        f32x4v U[2], Y[2];
#pragma unroll
        for (int it = 0; it < 2; ++it) { U[it] = *(const LAS f32x4v*)(R + RC_U0 + (2 * cw + it) * 1024 + lane * 16); Y[it] = *(const LAS f32x4v*)(R + RC_Y0 + (2 * cw + it) * 1024 + lane * 16); }
#pragma unroll
        for (int kk = 0; kk < 2; ++kk)
#pragma unroll
            for (int it = 0; it < 2; ++it) { v4u pw; pw.x = pg8::cvt_pk_bf16(S[2 * kk][it][0], S[2 * kk][it][1]); pw.y = pg8::cvt_pk_bf16(S[2 * kk][it][2], S[2 * kk][it][3]);
                pw.z = pg8::cvt_pk_bf16(S[2 * kk + 1][it][0], S[2 * kk + 1][it][1]); pw.w = pg8::cvt_pk_bf16(S[2 * kk + 1][it][2], S[2 * kk + 1][it][3]); const bf16x8 sf = __builtin_bit_cast(bf16x8, pw);
                U[it] = __builtin_amdgcn_mfma_f32_16x16x32_bf16(at[kk], sf, U[it], 0, 0, 0); Y[it] = __builtin_amdgcn_mfma_f32_16x16x32_bf16(rt[kk], sf, Y[it], 0, 0, 0); }
        bf16x8 uv[2];
#pragma unroll
        for (int it = 0; it < 2; ++it) { vfp[it] = *(const LAS v2u*)(R + RC_VF + (2 * cw + it) * 512 + lane * 8); gfp[it] = *(const LAS v2u*)(R + RC_GF + (2 * cw + it) * 512 + lane * 8);
            v4u pw; pw.x = pg8::cvt_pk_bf16(U[it][0], U[it][1]); pw.y = pg8::cvt_pk_bf16(U[it][2], U[it][3]); pw.z = vfp[it].x; pw.w = vfp[it].y; uv[it] = __builtin_bit_cast(bf16x8, pw); }
#pragma unroll
        for (int jt = 0; jt < 4; ++jt) { const bf16x8 bk = *(const LAS bf16x8*)(R + RC_BK + jt * 1024 + lane * 16); const f32x4v p15 = *(const LAS f32x4v*)(R + RC_P15 + (16 * jt + 4 * g) * 4);
#pragma unroll
            for (int it = 0; it < 2; ++it) S[jt][it] = __builtin_amdgcn_mfma_f32_16x16x32_bf16(bk, uv[it], S[jt][it] * p15, 0, 0, 0); }
        bnp = *(const LAS f32x4v*)(R + RC_BN + 16 * g); Yp[0] = Y[0]; Yp[1] = Y[1];
        { LAS float* xo = XS + (ck & 1) * 64 + cw * 32; const f32x4v sm = Y[0] + Y[1], sq = Y[0] * Y[0] + Y[1] * Y[1];
#pragma unroll
          for (int r = 0; r < 4; ++r) { const float a = sum16(sm[r]), q = sum16(sq[r]); if (n == 0) { xo[(4 * g + r) * 2] = a; xo[(4 * g + r) * 2 + 1] = q; } } }
        LDS_BARRIER();
    }
}
template <int HACK = 0> __device__ __forceinline__ void mixers_v4(Frame& F, int l, int qi, int mask = 15) {
    gu32* ctr = F.ctl + CW_Q + 64 * qi;
    for (;;) {
        const int it = next_item(F, ctr); relaunder(F); relaunder_tid(F);
        if (it < 32) { if (mask & 1) rwkv_scan_unit<HACK>(F, l, it >> 4, it & 15); }
        else if (it < 48) { const int j = it - 32; if (mask & 2) gla_scan_unit<HACK>(F, l, j >> 3, (j >> 1) & 3, j & 1); }
        else if (it < 48 + 1024) { const int j = it - 48, qb = 63 - (j >> 4), bh = j & 15; if (mask & 4) attn_unit<true>(F, l, bh >> 3, bh & 7, qb); }
        else if (it < 48 + 2048) { const int j = it - 1072, qb = j & 63, bh = j >> 6; if (mask & 8) attn_unit<false>(F, l, bh >> 3, bh & 7, qb); }
        else break;
    }
}
template <int HACK = 0> __device__ __forceinline__ void prep_rwkv(Frame& F, int l) {
    LAS float* zl = (LAS float*)(F.lds + RING_OFF) + 4096;
    LAS bf16* inb = (LAS bf16*)(F.lds + RING_OFF);
    const float* mu = F.kin[I_RMU] + (size_t)l * 3264;
    const float* LOWR = WSP(float, WS_LOWR); const bf16* COLS = WSP(bf16, WS_COLS);
    float* RW = WSP(float, WS_RW); unsigned* RWU = WSP(unsigned, WS_RW); float* VF = WSP(float, WS_VFIRST);
    constexpr size_t RS = RW_ONE / 4;
    for (int tile = F.bx; tile < M / 16; tile += F.G) {
        const int row0 = tile * 16;
        relaunder(F); relaunder_tid(F);
        __syncthreads();
        {
            float cur_[7], prv_[7], mu_[7];
#pragma unroll
            for (int q = 0; q < 7; ++q) { const int idx = F.tid + NWAVES * 64 * q, tt = idx / 224, j = idx % 224, row = row0 + tt;
                const int col = j < 192 ? 16 + j : 208 + (j - 192);
                const float* mp = j < 192 ? mu + 3072 + j : F.kin[I_VRMU] + (l ? (l - 1) * 32 : 0) + (j - 192);
                cur_[q] = LOWR[(size_t)row * 256 + col]; prv_[q] = LOWR[(size_t)((row & (SEQ - 1)) ? row - 1 : row) * 256 + col]; mu_[q] = *mp; }
#pragma unroll
            for (int q = 0; q < 7; ++q) { const int idx = F.tid + NWAVES * 64 * q, tt = idx / 224, j = idx % 224, row = row0 + tt;
                const float prev = (row & (SEQ - 1)) ? prv_[q] : 0.f, muv = (j >= 192 && l == 0) ? 0.f : mu_[q];
                float x = cur_[q] + (prev - cur_[q]) * muv;
                if (j < 64) x = tanhf(x); else if (j >= 128 && j < 192) x = sigmoid_f(x);
                inb[tt * 232 + j] = (bf16)f2bf(x); } }
        __syncthreads();
        {
            const int c = 2 * F.tid;
            float accw[2][16], acca[2][16], accg[2][16], accv[2][16];
#pragma unroll
            for (int e = 0; e < 2; ++e) { const float bw = F.kin[I_RW0][l * 1024 + c + e], ba = F.kin[I_RA0][l * 1024 + c + e], bv = l ? F.kin[I_VR0][(l - 1) * 1024 + c + e] : 0.f;
#pragma unroll
              for (int tt = 0; tt < 16; ++tt) { accw[e][tt] = bw; acca[e][tt] = ba; accg[e][tt] = 0.f; accv[e][tt] = bv; } }
#define LOWRANK_MFMA(ACC, MI, JOFF, NKS) do { const bf16* wf_ = WSP(bf16, WS_WF) + ((size_t)(l * 448 + ((MI) < 3 ? (MI) * 128 + 16 * (NKS) / 2 * F.wave : 384 + 8 * F.wave)) * 64 + F.lane) * 8; \
            bf16x8 af_[NKS], bf_[8][NKS]; \
            _Pragma("unroll") for (int ks = 0; ks < (NKS); ++ks) af_[ks] = *(const LAS bf16x8*)(inb + (F.lane & 15) * 232 + (JOFF) + 32 * ks + 8 * (F.lane >> 4)); \
            _Pragma("unroll") for (int nt = 0; nt < 8; ++nt) _Pragma("unroll") for (int ks = 0; ks < (NKS); ++ks) bf_[nt][ks] = *(const bf16x8*)(wf_ + (size_t)(nt * (NKS) + ks) * 512); \
            _Pragma("unroll") for (int nt = 0; nt < 8; ++nt) { f32x4 c4 = {0.f, 0.f, 0.f, 0.f}; \
                _Pragma("unroll") for (int ks = 0; ks < (NKS); ++ks) c4 = __builtin_amdgcn_mfma_f32_16x16x32_bf16(af_[ks], bf_[nt][ks], c4, 0, 0, 0); \
                _Pragma("unroll") for (int rr = 0; rr < 4; ++rr) zl[(4 * (F.lane >> 4) + rr) * 1028 + 128 * F.wave + 16 * nt + (F.lane & 15)] = c4[rr]; } \
            __syncthreads(); \
            _Pragma("unroll") for (int tt = 0; tt < 16; ++tt) { const f32x2_t z2 = *(const LAS f32x2_t*)(zl + tt * 1028 + c); ACC[0][tt] += z2.x; ACC[1][tt] += z2.y; } \
            __syncthreads(); } while (0)
            if (!(HACK & 1)) { LOWRANK_MFMA(accw, 0, 0, 2); relaunder(F);
            LOWRANK_MFMA(acca, 1, 64, 2); relaunder(F);
            LOWRANK_MFMA(accg, 2, 128, 2); relaunder(F);
            if (l) LOWRANK_MFMA(accv, 3, 192, 1); }
#undef LOWRANK_MFMA
            relaunder(F);
            float mur[2], muk[2], muv[2], kkv[2], kav[2], pr[2] = {0.f, 0.f}, pk[2] = {0.f, 0.f}, pv[2] = {0.f, 0.f}; float cl[2] = {0.f, 0.f};
#pragma unroll
            for (int e = 0; e < 2; ++e) { mur[e] = F.kin[I_RMU][l * 3264 + c + e]; muk[e] = F.kin[I_RMU][l * 3264 + 1024 + c + e]; muv[e] = F.kin[I_RMU][l * 3264 + 2048 + c + e]; kkv[e] = F.kin[I_RKK][l * 1024 + c + e]; kav[e] = F.kin[I_RKA][l * 1024 + c + e]; }
            if ((row0 & (SEQ - 1)) != 0) { const bf16* p = COLS + (size_t)(row0 - 1) * NMAIN + c; const unsigned ur = *(const unsigned*)(p + CC_R), uk = *(const unsigned*)(p + CC_K), uv = *(const unsigned*)(p + CC_V);
                pr[0] = bflo(ur); pr[1] = bfhi(ur); pk[0] = bflo(uk); pk[1] = bfhi(uk); pv[0] = bflo(uv); pv[1] = bfhi(uv); }
            constexpr int PFD = 4;
            unsigned pur[16], puk[16], puv[16]; f32x2_t pvf[16];
#define PF_TOK(T) do { const bf16* p_ = COLS + (size_t)(row0 + (T)) * NMAIN + c; pur[T] = *(const unsigned*)(p_ + CC_R); puk[T] = *(const unsigned*)(p_ + CC_K); puv[T] = *(const unsigned*)(p_ + CC_V); \
                pvf[T] = *(const f32x2_t*)(VF + (size_t)(row0 + (T)) * 1024 + c); } while (0)
#pragma unroll
            for (int tt = 0; tt < PFD; ++tt) PF_TOK(tt);
            asm volatile("" ::: "memory");
            if (!(HACK & 4))
#pragma unroll
            for (int tt = 0; tt < 16; ++tt) { const int row = row0 + tt; const size_t o = (size_t)row * 1024 + c;
                if (tt + PFD < 16) { PF_TOK(tt + PFD < 16 ? tt + PFD : 15); }
                asm volatile("" ::: "memory");
                const unsigned ur = pur[tt], uk = puk[tt], uv = puv[tt];
                const float cr[2] = {bflo(ur), bfhi(ur)}, ck[2] = {bflo(uk), bfhi(uk)}, cv[2] = {bflo(uv), bfhi(uv)};
                f32x2_t vf2 = pvf[tt];
                float r[2], k[2], v[2], dec[2], av[2], kk[2], km[2];
#pragma unroll
                for (int e = 0; e < 2; ++e) { r[e] = cr[e] + (pr[e] - cr[e]) * mur[e]; k[e] = ck[e] + (pk[e] - ck[e]) * muk[e]; v[e] = cv[e] + (pv[e] - cv[e]) * muv[e]; pr[e] = cr[e]; pk[e] = ck[e]; pv[e] = cv[e];
                    if (l == 0) vf2[e] = v[e]; else { const float vg = sigmoid_f(accv[e][tt]); v[e] = v[e] + (vf2[e] - v[e]) * vg; }
                    cl[e] += -0.6065306597126334f * sigmoid_f(accw[e][tt]); dec[e] = cl[e]; av[e] = sigmoid_f(acca[e][tt]); kk[e] = k[e] * kkv[e]; km[e] = k[e] * (1.0f + (av[e] - 1.0f) * kav[e]); }
                const float ss = sum32(kk[0] * kk[0] + kk[1] * kk[1]), rn = rsqrtf(fmaxf(ss, 1e-24f)); kk[0] *= rn; kk[1] *= rn;
                if (l == 0) *(f32x2_t*)(VF + o) = vf2;
                *(f32x2_t*)(RW + RS + o) = (f32x2_t){dec[0], dec[1]};
                *(v2u*)(RWU + o) = (v2u){pk2(r[0], km[0]), pk2(r[1], km[1])}; *(v2u*)(RWU + 2 * RS + o) = (v2u){pk2(v[0], accg[0][tt]), pk2(v[1], accg[1][tt])};
                *(v2u*)(RWU + 3 * RS + o) = (v2u){pk2(-kk[0], kk[0] * av[0]), pk2(-kk[1], kk[1] * av[1])}; }
#undef PF_TOK
        }
        asm volatile("s_waitcnt vmcnt(0)" ::: "memory"); __syncthreads();
        __builtin_amdgcn_fence(__ATOMIC_ACQUIRE, "agent"); asm volatile("s_waitcnt vmcnt(0)" ::: "memory");
        if (!(HACK & 2)) rwkv_chunks_of_tile(F, l, tile);
    }
}
struct Args { const float* in[35]; float* out; unsigned char* ws; };
__device__ __forceinline__ void mk_frame(Frame& F, int wv) {
    extern __shared__ __attribute__((aligned(16))) unsigned char lds[];
    kargp kp = (kargp)__builtin_amdgcn_kernarg_segment_ptr(); asm volatile("" : "+s"(kp));
    F.kin = kp;
    F.lds = (LAS unsigned char*)lds;
    F.MISC = (volatile LAS unsigned*)(F.lds + MISC_OFF);
    { int w_ = wv; asm volatile("" : "+s"(w_)); int t_ = (int)__builtin_amdgcn_mbcnt_hi(~0u, __builtin_amdgcn_mbcnt_lo(~0u, (unsigned)w_ * 64u)); asm volatile("" : "+v"(t_)); F.tid = t_; } F.lane = F.tid & 63; F.wave = __builtin_amdgcn_readfirstlane(F.tid >> 6);
    F.G = gridDim.x; { int bx = blockIdx.x; asm volatile("" : "+s"(bx)); F.bx = bx; F.vcu = (F.G % 8 == 0) ? (bx % 8) * (F.G / 8) + bx / 8 : bx; }
    F.out = (float*)kp[35]; F.ws = (unsigned char*)kp[36]; F.ctl = (gu32*)(F.ws + WS_CTL);
}
__device__ __forceinline__ void grid_bar(int wv) {
    Frame F; mk_frame(F, wv);
    XcdBarrier bar; bar.bar = (unsigned*)(F.ctl + CW_BAR); bar.x = xb_xcc_id(); bar.st = F.MISC + 8;
    xcd_barrier(bar);
}
__global__ void __launch_bounds__(NWAVES * 64, 2) mega_fwd(Args args) {
    const int wv = __builtin_amdgcn_readfirstlane((int)threadIdx.x >> 6);
    { Frame F; mk_frame(F, wv);
      for (int u = F.tid; u < (LDS_BYTES - LDSCTL_OFF) / 4; u += NWAVES * 64) ((LAS unsigned*)(F.lds + LDSCTL_OFF))[u] = 0u;
      __syncthreads();
      (void)xcd_barrier_post((unsigned*)(F.ctl + CW_BAR), F.MISC + 8);
      p0_prologue_a(F);
    }
    grid_bar(wv);
    { Frame F; mk_frame(F, wv); p0_prologue_b(F); }
    grid_bar(wv);
#pragma unroll 1
    for (int l = 0; l < NLAYER; ++l) {
#define LAYER_VARS const float* mod = WSP(float, WS_MOD) + (size_t)l * 2 * 24576; const float* xin = l == 0 ? F.kin[I_X] : F.out; (void)mod; (void)xin
        { Frame F; mk_frame(F, wv); LAYER_VARS; if (l == 0) rms_phase(F, F.kin[I_X], mod + 0, mod + 4096); else rms_phase_bf(F, mod + 0, mod + 4096); }
        grid_bar(wv);
        { Frame F; mk_frame(F, wv);
          pg8::Gemm g{WSP(pg8::bf16_t, WS_XN), WSP(pg8::bf16_t, WS_WIN + l * WIN_L), M, NIN, DM}; pg8::StaticOrder S; S.init(M, NIN, F.G, F.bx);
          pg8::EpiCols E{WSP(pg8::bf16_t, WS_COLS), WSP(float, WS_LOWR)};
          pg8::gemm_phase<pg8::EpiCols, pg8::StaticOrder, true, true>(F.lds + RING_OFF, g, S, E, F.tid); }
        grid_bar(wv);
        { Frame F; mk_frame(F, wv); prep_norm(F, l); }
        { Frame F; mk_frame(F, wv); prep_loga(F, l); }
        { Frame F; mk_frame(F, wv); prep_rwkv(F, l); }
        { Frame F; mk_frame(F, wv); prep_vt<0>(F); }
        { Frame F; mk_frame(F, wv); prep_vt<1>(F); }
        { Frame F; mk_frame(F, wv); prep_vt<2>(F); }
        { Frame F; mk_frame(F, wv); prep_vt<3>(F); }
        { Frame F; mk_frame(F, wv); prep_vt<4>(F); }
        { Frame F; mk_frame(F, wv); prep_gla(F); }
        grid_bar(wv);
        { Frame F; mk_frame(F, wv); mixers_v4(F, l, l); }
        grid_bar(wv);
        { Frame F; mk_frame(F, wv); gla_post(F, l); }
        grid_bar(wv);
        { Frame F; mk_frame(F, wv); LAYER_VARS;
          pg8::Gemm g{WSP(pg8::bf16_t, WS_MIXED), WSP(pg8::bf16_t, WS_WOUT + l * WOUT_L), M, DM, DM}; pg8::StaticOrder S; S.init(M, DM, F.G, F.bx);
          pg8::EpiRes E{l == 0 ? (const void*)F.kin[I_X] : (const void*)WSP(bf16, WS_XR), (void*)WSP(bf16, WS_XR), mod + 2 * 4096, l != 0, true};
          pg8::gemm_phase<pg8::EpiRes, pg8::StaticOrder, true, true>(F.lds + RING_OFF, g, S, E, F.tid); }
        grid_bar(wv);
        { Frame F; mk_frame(F, wv); LAYER_VARS; rms_phase_bf(F, mod + 3 * 4096, mod + 4 * 4096); }
        grid_bar(wv);
        { Frame F; mk_frame(F, wv);
          pg8::Gemm g{WSP(pg8::bf16_t, WS_XN), WSP(pg8::bf16_t, WS_W13 + l * W13_L), M, 2 * DFF, DM}; pg8::StaticOrder S; S.init(M, 2 * DFF, F.G, F.bx);
          pg8::EpiSwiglu E{WSP(pg8::bf16_t, WS_HID)};
          pg8::gemm_phase<pg8::EpiSwiglu, pg8::StaticOrder, true, true>(F.lds + RING_OFF, g, S, E, F.tid); }
        grid_bar(wv);
        { Frame F; mk_frame(F, wv); LAYER_VARS;
          pg8::Gemm g{WSP(pg8::bf16_t, WS_HID), WSP(pg8::bf16_t, WS_W2 + l * W2_L), M, DM, DFF}; pg8::StaticOrder S; S.init(M, DM, F.G, F.bx);
          pg8::EpiRes E{(const void*)WSP(bf16, WS_XR), l + 1 < NLAYER ? (void*)WSP(bf16, WS_XR) : (void*)F.out, mod + 5 * 4096, true, l + 1 < NLAYER};
          pg8::gemm_phase<pg8::EpiRes, pg8::StaticOrder, true, true>(F.lds + RING_OFF, g, S, E, F.tid); }
        if (l + 1 < NLAYER) grid_bar(wv);
#undef LAYER_VARS
    }
}

extern "C" void kernel_launch(void* const* d_in, const int* in_sizes, int n_in, void* d_out, int out_size, void* d_ws, size_t ws_size, hipStream_t stream) {
    static int grid = 0;
    if (grid == 0) {
        if (n_in != 35 || in_sizes[0] != M * DM || out_size != M * DM || ws_size < WS_END) { fprintf(stderr, "kernel_launch: unexpected shapes: n_in %d in0 %d out %d ws %zu (need %zu)\n", n_in, n_in > 0 ? in_sizes[0] : -1, out_size, ws_size, (size_t)WS_END); grid = -1; return; }
        int dev = 0, cus = 0, per_cu = 0;
        if (hipGetDevice(&dev) != hipSuccess || hipDeviceGetAttribute(&cus, hipDeviceAttributeMultiprocessorCount, dev) != hipSuccess) { grid = -1; return; }
        if (hipFuncSetAttribute((const void*)mega_fwd, hipFuncAttributeMaxDynamicSharedMemorySize, LDS_BYTES) != hipSuccess) { fprintf(stderr, "kernel_launch: hipFuncSetAttribute failed\n"); grid = -1; return; }
        if (hipOccupancyMaxActiveBlocksPerMultiprocessor(&per_cu, (const void*)mega_fwd, NWAVES * 64, LDS_BYTES) != hipSuccess || per_cu < 1) fprintf(stderr, "kernel_launch: occupancy query says %d\n", per_cu);
        (void)hipGetLastError();
        grid = cus;
    }
    if (grid < 0) return;
    if (hipMemsetAsync((char*)d_ws + WS_CTL, 0, CTL_ZERO_BYTES, stream) != hipSuccess) return;
    Args a{};
    for (int i = 0; i < 35; ++i) a.in[i] = (const float*)d_in[i];
    a.out = (float*)d_out; a.ws = (unsigned char*)d_ws;
    hipLaunchKernelGGL(mega_fwd, dim3(grid), dim3(NWAVES * 64), LDS_BYTES, stream, a);
}
```

```cpp
#include <hip/hip_runtime.h>
#include <cstdio>
#include <cstdint>
namespace pg8 {
#define PG8_LAS __attribute__((address_space(3)))
typedef unsigned short bf16_t;
typedef short bf16x8 __attribute__((ext_vector_type(8)));
typedef float f32x4 __attribute__((ext_vector_type(4)));
typedef unsigned u32x4 __attribute__((ext_vector_type(4)));
constexpr int BM = 256, BK = 64, HALF = 128, HTB = HALF * BK * 2  , STAGE_BYTES = 8 * HTB, NXCD = 8, WGM = 8;

__host__ __device__ __forceinline__ int lds_byte(int r, int c) { const int st = (r >> 4) * 2 + (c >> 5), rr = r & 15, cc = c & 31, ob = rr * 64 + cc * 2; return st * 1024 + (ob ^ (((ob >> 9) & 1) << 5)); }
__host__ __device__ __forceinline__ void stage_rc(int b, int& R, int& C) { const int st = b / 1024, sb = b % 1024, swz = sb ^ (((sb >> 9) & 1) << 5); R = (st >> 1) * 16 + swz / 64; C = (st & 1) * 32 + (swz % 64) / 2; }
__host__ __device__ __forceinline__ int perm32(int rho) { const int n = rho >> 4, i = rho & 15; return 8 * (i >> 2) + 4 * n + (i & 3); }

struct Unit { int pm, pn; };
struct Gemm { const bf16_t* A; const bf16_t* Bt; int M, N, K; };

struct StaticOrder {
    int nM, nN, nwg, G, c;
    __host__ __device__ void init(int M, int N, int G_, int c_) { nM = M / BM; nN = N / BM; nwg = nM * nN; G = G_; c = c_; }
    __host__ __device__ bool next(int i, Unit& u) const {
        const long L = (long)i * G + c; if (L >= nwg) return false;
        int wgid = (int)L; { const int q = nwg / NXCD, r = nwg % NXCD, xcd = wgid % NXCD, off = wgid / NXCD; wgid = (xcd < r ? xcd * (q + 1) : r * (q + 1) + (xcd - r) * q) + off; }
        const int nig = WGM * nN, gid = wgid / nig, fm = gid * WGM, gsz = (nM - fm) < WGM ? (nM - fm) : WGM;
        u.pm = fm + ((wgid % nig) % gsz); u.pn = (wgid % nig) / gsz; return true;
    }
    __device__ __forceinline__ void a_ready(const Unit&) const {}
    __device__ __forceinline__ void done(const Unit&) const {}
};

typedef float f32x2c_t __attribute__((ext_vector_type(2))); typedef __bf16 bf16x2c_t __attribute__((ext_vector_type(2)));
__device__ __forceinline__ unsigned cvt_pk_bf16(float lo, float hi) { const f32x2c_t v = {lo, hi}; return __builtin_bit_cast(unsigned, __builtin_convertvector(v, bf16x2c_t)); }
typedef float f32x2 __attribute__((ext_vector_type(2)));
__device__ __forceinline__ float silu_f(float x) { return x * __builtin_amdgcn_rcpf(1.0f + __builtin_amdgcn_exp2f(-1.4426950408889634f * x)); }
struct EpiCols {
    static constexpr bool PERM = true, AFTER_DRAIN = false;
    bf16_t* O; float* L;
    __device__ __forceinline__ void operator()(const f32x4 (&acc)[2][2][4][2], const Unit& u, int wr, int wc, int fr, int fq) const {
        const int row0 = u.pm * BM + wr * 64 + fr;
        if (u.pn < 41) {
            const int col0 = u.pn * BM + wc * 32 + 8 * fq;
#pragma unroll
            for (int ai = 0; ai < 2; ++ai)
#pragma unroll
                for (int m = 0; m < 4; ++m) { bf16_t* rowp = O + (size_t)(row0 + ai * HALF + m * 16) * 10496 + col0;
#pragma unroll
                    for (int bj = 0; bj < 2; ++bj) { const f32x4 v0 = acc[ai][bj][m][0], v1 = acc[ai][bj][m][1];
                        u32x4 w; w.x = cvt_pk_bf16(v0[0], v0[1]); w.y = cvt_pk_bf16(v0[2], v0[3]); w.z = cvt_pk_bf16(v1[0], v1[1]); w.w = cvt_pk_bf16(v1[2], v1[3]);
                        *(u32x4*)(rowp + bj * HALF) = w; } }
        } else {
            const int col0 = wc * 32 + 8 * fq;
#pragma unroll
            for (int ai = 0; ai < 2; ++ai)
#pragma unroll
                for (int m = 0; m < 4; ++m) { float* rowp = L + (size_t)(row0 + ai * HALF + m * 16) * 256 + col0;
#pragma unroll
                    for (int bj = 0; bj < 2; ++bj) { *(f32x4*)(rowp + bj * HALF) = acc[ai][bj][m][0]; *(f32x4*)(rowp + bj * HALF + 4) = acc[ai][bj][m][1]; } }
        }
    }
};
struct EpiRes {
    static constexpr bool PERM = true, AFTER_DRAIN = false;
    const void* base; void* out; const float* gate; bool base_bf, out_bf;
    __device__ __forceinline__ void operator()(const f32x4 (&acc)[2][2][4][2], const Unit& u, int wr, int wc, int fr, int fq) const {
        const int row0 = u.pm * BM + wr * 64 + fr, col0 = u.pn * BM + wc * 32 + 8 * fq;
        const float* gp = gate + (size_t)(u.pm >> 5) * 24576 + col0;
        f32x4 gv[2][2];
#pragma unroll
        for (int bj = 0; bj < 2; ++bj)
#pragma unroll
            for (int n = 0; n < 2; ++n) gv[bj][n] = *(const f32x4*)(gp + bj * HALF + n * 4);
#pragma unroll
        for (int ai = 0; ai < 2; ++ai) {
            f32x4 r[4][2][2];
            if (base_bf) {
#pragma unroll
                for (int m = 0; m < 4; ++m)
#pragma unroll
                    for (int bj = 0; bj < 2; ++bj) { const u32x4 w = *(const u32x4*)((const bf16_t*)base + (size_t)(row0 + ai * HALF + m * 16) * 4096 + col0 + bj * HALF);
                        r[m][bj][0] = (f32x4){__builtin_bit_cast(float, w.x << 16), __builtin_bit_cast(float, w.x & 0xffff0000u), __builtin_bit_cast(float, w.y << 16), __builtin_bit_cast(float, w.y & 0xffff0000u)};
                        r[m][bj][1] = (f32x4){__builtin_bit_cast(float, w.z << 16), __builtin_bit_cast(float, w.z & 0xffff0000u), __builtin_bit_cast(float, w.w << 16), __builtin_bit_cast(float, w.w & 0xffff0000u)}; }
            } else {
#pragma unroll
                for (int m = 0; m < 4; ++m)
#pragma unroll
                    for (int bj = 0; bj < 2; ++bj)
#pragma unroll
                        for (int n = 0; n < 2; ++n) r[m][bj][n] = *(const f32x4*)((const float*)base + (size_t)(row0 + ai * HALF + m * 16) * 4096 + col0 + bj * HALF + n * 4);
            }
#pragma unroll
            for (int m = 0; m < 4; ++m)
#pragma unroll
                for (int bj = 0; bj < 2; ++bj)
#pragma unroll
                    for (int n = 0; n < 2; ++n) r[m][bj][n] = r[m][bj][n] + gv[bj][n] * acc[ai][bj][m][n];
            if (out_bf) {
#pragma unroll
                for (int m = 0; m < 4; ++m)
#pragma unroll
                    for (int bj = 0; bj < 2; ++bj) { const f32x4 v0 = r[m][bj][0], v1 = r[m][bj][1];
                        u32x4 w; w.x = cvt_pk_bf16(v0[0], v0[1]); w.y = cvt_pk_bf16(v0[2], v0[3]); w.z = cvt_pk_bf16(v1[0], v1[1]); w.w = cvt_pk_bf16(v1[2], v1[3]);
                        *(u32x4*)((bf16_t*)out + (size_t)(row0 + ai * HALF + m * 16) * 4096 + col0 + bj * HALF) = w; }
            } else {
#pragma unroll
                for (int m = 0; m < 4; ++m)
#pragma unroll
                    for (int bj = 0; bj < 2; ++bj)
#pragma unroll
                        for (int n = 0; n < 2; ++n) *(f32x4*)((float*)out + (size_t)(row0 + ai * HALF + m * 16) * 4096 + col0 + bj * HALF + n * 4) = r[m][bj][n];
            }
            asm volatile("" ::: "memory");
        }
    }
};
struct EpiSwiglu {
    static constexpr bool PERM = true, AFTER_DRAIN = false;
    bf16_t* H;
    __device__ __forceinline__ void operator()(const f32x4 (&acc)[2][2][4][2], const Unit& u, int wr, int wc, int fr, int fq) const {
        const int row0 = u.pm * BM + wr * 64 + fr, col0 = u.pn * HALF + wc * 32 + 8 * fq;
#pragma unroll
        for (int ai = 0; ai < 2; ++ai)
#pragma unroll
            for (int m = 0; m < 4; ++m) { bf16_t* rowp = H + (size_t)(row0 + ai * HALF + m * 16) * 11008 + col0;
                const f32x4 a0 = acc[ai][0][m][0], a1 = acc[ai][0][m][1], b0 = acc[ai][1][m][0], b1 = acc[ai][1][m][1];
                u32x4 w; w.x = cvt_pk_bf16(silu_f(a0[0]) * b0[0], silu_f(a0[1]) * b0[1]); w.y = cvt_pk_bf16(silu_f(a0[2]) * b0[2], silu_f(a0[3]) * b0[3]);
                w.z = cvt_pk_bf16(silu_f(a1[0]) * b1[0], silu_f(a1[1]) * b1[1]); w.w = cvt_pk_bf16(silu_f(a1[2]) * b1[2], silu_f(a1[3]) * b1[3]);
                *(u32x4*)rowp = w; }
    }
};
template <class Epi, class Sched, bool ALIGN_EPI = false, bool SP2 = false>
__device__ __forceinline__ void gemm_phase(PG8_LAS unsigned char* lds, const Gemm g, const Sched& S, const Epi& E, int tid_in) {
    int tid_ = tid_in; asm volatile("" : "+v"(tid_));
    const int tid = tid_, wid = __builtin_amdgcn_readfirstlane(tid >> 6), lane = tid & 63, wr = wid >> 2, wc = wid & 3, fr = lane & 15, fq = lane >> 4;
    const int K = g.K, nt = K / BK;
    unsigned voffA[2], voffB[2];
#pragma unroll
    for (int i = 0; i < 2; ++i) { int R, C; stage_rc(tid * 16 + i * 8192, R, C); const int Rb = Epi::PERM ? ((R & ~31) + perm32(R & 31)) : R;
        voffA[i] = (unsigned)(R * K + C) * 2u; voffB[i] = (unsigned)(Rb * K + C) * 2u; }
    const size_t kstep = (size_t)(BK * 2);
    const size_t hstep = (size_t)HALF * K * 2;
    const size_t tstep = 2 * hstep;
    const unsigned ldsw = (unsigned)wid * 1024u;
    const int aoff = lds_byte(wr * 64 + fr, fq * 8), boff = lds_byte(wc * 32 + fr, fq * 8);
#define PG8_SA(b, h) (((b) * 2 + (h)) * HTB)
#define PG8_SB(b, h) ((4 + (b) * 2 + (h)) * HTB)
#define PG8_STAGE(bufoff, gbase, voff) do { _Pragma("unroll") for (int _i = 0; _i < 2; ++_i) \
        __builtin_amdgcn_global_load_lds((const unsigned*)((const char*)(gbase) + (voff)[_i]), (PG8_LAS unsigned*)(lds + (bufoff) + ldsw + _i * 8192), 16, 0, 0); } while (0)
#define PG8_LDA(dst, b, h) do { _Pragma("unroll") for (int m = 0; m < 4; ++m) _Pragma("unroll") for (int k = 0; k < 2; ++k) dst[m][k] = *(const PG8_LAS bf16x8*)(lds + PG8_SA(b, h) + aoff + m * 2048 + k * 1024); } while (0)
#define PG8_LDB(dst, b, h) do { _Pragma("unroll") for (int n = 0; n < 2; ++n) _Pragma("unroll") for (int k = 0; k < 2; ++k) dst[n][k] = *(const PG8_LAS bf16x8*)(lds + PG8_SB(b, h) + boff + n * 2048 + k * 1024); } while (0)
#define PG8_MMA(ai, bj, At, Bt) do { __builtin_amdgcn_s_setprio(1); _Pragma("unroll") for (int m = 0; m < 4; ++m) _Pragma("unroll") for (int n = 0; n < 2; ++n) _Pragma("unroll") for (int k = 0; k < 2; ++k) \
        acc[ai][bj][m][n] = __builtin_amdgcn_mfma_f32_16x16x32_bf16(Bt[n][k], At[m][k], acc[ai][bj][m][n], 0, 0, 0); __builtin_amdgcn_s_setprio(0); } while (0)
#define PG8_WAIT_V(n) asm volatile("s_waitcnt vmcnt(" #n ")" ::: "memory")
#define PG8_WAIT_L(n) asm volatile("s_waitcnt lgkmcnt(" #n ")" ::: "memory")
#define PG8_BAR __builtin_amdgcn_s_barrier()
#define PG8_SCHED __builtin_amdgcn_sched_barrier(0)
    Unit cur, nxt; int ui = 0;
    if (!S.next(0, cur)) return;
    f32x4 acc[2][2][4][2];
#pragma unroll
    for (int a = 0; a < 2; ++a)
#pragma unroll
        for (int b = 0; b < 2; ++b)
#pragma unroll
            for (int m = 0; m < 4; ++m)
#pragma unroll
                for (int n = 0; n < 2; ++n) acc[a][b][m][n] = (f32x4){0.f, 0.f, 0.f, 0.f};
    bf16x8 At[4][2], B0[2][2], B1[2][2];
    const char* cA = (const char*)g.A + (size_t)cur.pm * tstep; const char* cB = (const char*)g.Bt + (size_t)cur.pn * tstep;
    S.a_ready(cur);
    if constexpr (SP2) {
        PG8_STAGE(PG8_SB(0, 0), cB, voffB); PG8_STAGE(PG8_SB(0, 1), cB + hstep, voffB); PG8_STAGE(PG8_SA(0, 0), cA, voffA); PG8_STAGE(PG8_SA(0, 1), cA + hstep, voffA);
        if (wr == 1) PG8_BAR;
        PG8_WAIT_V(2); PG8_BAR;
        PG8_STAGE(PG8_SB(1, 0), cB + kstep, voffB); PG8_STAGE(PG8_SA(1, 0), cA + kstep, voffA); PG8_STAGE(PG8_SB(1, 1), cB + hstep + kstep, voffB);
        PG8_WAIT_V(6); PG8_BAR;
    } else {
        PG8_STAGE(PG8_SB(0, 0), cB, voffB); PG8_STAGE(PG8_SA(0, 0), cA, voffA); PG8_STAGE(PG8_SB(0, 1), cB + hstep, voffB); PG8_STAGE(PG8_SA(0, 1), cA + hstep, voffA);
        if (wr == 1) PG8_BAR;
        PG8_WAIT_V(4); PG8_BAR;
        PG8_STAGE(PG8_SB(1, 0), cB + kstep, voffB); PG8_STAGE(PG8_SA(1, 0), cA + kstep, voffA); PG8_STAGE(PG8_SB(1, 1), cB + hstep + kstep, voffB);
        PG8_WAIT_V(6); PG8_BAR;
    }
    for (;;) {
        const bool has_next = S.next(ui + 1, nxt);
        const char* nA = has_next ? (const char*)g.A + (size_t)nxt.pm * tstep : cA; const char* nB = has_next ? (const char*)g.Bt + (size_t)nxt.pn * tstep : cB;
        for (int t = 0; t < nt; t += 2) {
            const bool last = (t == nt - 2);
            const char* a1 = cA + (size_t)(t + 1) * kstep;
            const char* a2 = last ? nA : cA + (size_t)(t + 2) * kstep; const char* b2 = last ? nB : cB + (size_t)(t + 2) * kstep;
            const char* a3 = a2 + kstep; const char* b3 = b2 + kstep;
            if (last && has_next) S.a_ready(nxt);
            if constexpr (SP2) {
            PG8_LDB(B0, 0, 0); PG8_LDB(B1, 0, 1); PG8_SCHED; PG8_LDA(At, 0, 0); PG8_STAGE(PG8_SA(1, 1), a1 + hstep, voffA);
            PG8_WAIT_V(8); PG8_WAIT_L(0); PG8_BAR; PG8_MMA(0, 0, At, B0); PG8_MMA(0, 1, At, B1); PG8_BAR; PG8_SCHED;
            PG8_LDA(At, 0, 1); PG8_STAGE(PG8_SB(0, 0), b2, voffB); PG8_STAGE(PG8_SB(0, 1), b2 + hstep, voffB); PG8_STAGE(PG8_SA(0, 0), a2, voffA);
            PG8_WAIT_V(8); PG8_WAIT_L(0); PG8_BAR; PG8_MMA(1, 0, At, B0); PG8_MMA(1, 1, At, B1); PG8_BAR; PG8_SCHED;
            PG8_LDB(B0, 1, 0); PG8_LDB(B1, 1, 1); PG8_SCHED; PG8_LDA(At, 1, 0); PG8_STAGE(PG8_SA(0, 1), a2 + hstep, voffA);
            PG8_WAIT_V(8); PG8_WAIT_L(0); PG8_BAR; PG8_MMA(0, 0, At, B0); PG8_MMA(0, 1, At, B1); PG8_BAR; PG8_SCHED;
            PG8_LDA(At, 1, 1); PG8_STAGE(PG8_SB(1, 0), b3, voffB); PG8_STAGE(PG8_SB(1, 1), b3 + hstep, voffB); PG8_STAGE(PG8_SA(1, 0), a3, voffA);
            PG8_WAIT_V(8); PG8_WAIT_L(0); PG8_BAR; PG8_MMA(1, 0, At, B0); PG8_MMA(1, 1, At, B1); PG8_BAR; PG8_SCHED;
            } else {
            PG8_LDB(B0, 0, 0); PG8_SCHED; PG8_LDA(At, 0, 0); PG8_STAGE(PG8_SA(1, 1), a1 + hstep, voffA);
            PG8_WAIT_L(8); PG8_BAR; PG8_WAIT_L(0); PG8_MMA(0, 0, At, B0); PG8_BAR; PG8_SCHED;
            PG8_LDB(B1, 0, 1); PG8_STAGE(PG8_SB(0, 0), b2, voffB);
            PG8_BAR; PG8_WAIT_L(0); PG8_MMA(0, 1, At, B1); PG8_BAR;
            PG8_LDA(At, 0, 1); PG8_STAGE(PG8_SA(0, 0), a2, voffA);
            PG8_BAR; PG8_WAIT_L(0); PG8_MMA(1, 0, At, B0); PG8_BAR; PG8_SCHED;
            PG8_STAGE(PG8_SB(0, 1), b2 + hstep, voffB);
            PG8_WAIT_V(6); PG8_BAR; PG8_MMA(1, 1, At, B1); PG8_BAR;
            PG8_LDB(B0, 1, 0); PG8_SCHED; PG8_LDA(At, 1, 0); PG8_STAGE(PG8_SA(0, 1), a2 + hstep, voffA);
            PG8_WAIT_L(8); PG8_BAR; PG8_WAIT_L(0); PG8_MMA(0, 0, At, B0); PG8_BAR; PG8_SCHED;
            PG8_LDB(B1, 1, 1); PG8_STAGE(PG8_SB(1, 0), b3, voffB);
            PG8_BAR; PG8_WAIT_L(0); PG8_MMA(0, 1, At, B1); PG8_BAR;
            PG8_LDA(At, 1, 1); PG8_STAGE(PG8_SA(1, 0), a3, voffA);
            PG8_BAR; PG8_WAIT_L(0); PG8_MMA(1, 0, At, B0); PG8_BAR; PG8_SCHED;
            PG8_STAGE(PG8_SB(1, 1), b3 + hstep, voffB);
            PG8_WAIT_V(6); PG8_BAR; PG8_MMA(1, 1, At, B1); PG8_BAR;
            }
        }
        if constexpr (ALIGN_EPI) { if (wr == 0) PG8_BAR; }
        if constexpr (!Epi::AFTER_DRAIN) { E(acc, cur, wr, wc, fr, fq); S.done(cur); }
        if (!has_next) break;
#pragma unroll
        for (int a = 0; a < 2; ++a)
#pragma unroll
            for (int b = 0; b < 2; ++b)
#pragma unroll
                for (int m = 0; m < 4; ++m)
#pragma unroll
                    for (int n = 0; n < 2; ++n) acc[a][b][m][n] = (f32x4){0.f, 0.f, 0.f, 0.f};
        cur = nxt; cA = nA; cB = nB; ++ui;
        if constexpr (ALIGN_EPI) { if (wr == 1) PG8_BAR; }
    }
    PG8_WAIT_V(0);
    if constexpr (!ALIGN_EPI) { if (wr == 0) PG8_BAR; }
    PG8_BAR;
    if constexpr (Epi::AFTER_DRAIN) { E.fused(acc, cur, wr, wc, fr, fq, lds, wid, lane); S.done(cur); }
#undef PG8_SA
#undef PG8_SB
#undef PG8_STAGE
#undef PG8_LDA
#undef PG8_LDB
#undef PG8_MMA
#undef PG8_WAIT_V
#undef PG8_WAIT_L
#undef PG8_BAR
#undef PG8_SCHED
}
}
constexpr int BATCH = 2, SEQ = 8192, DM = 4096, M = BATCH * SEQ, DFF = 11008, NLAYER = 2;
constexpr int P_IN = 10704, NIN = 10752, NMAIN = 10496;
constexpr int CA_Q = 0, CA_K = 1024, CA_V = 2048;
constexpr int CB_Q = 3072, CB_K = 3584, CB_V = 4096, CB_G = 5120;
constexpr int CC_R = 6144, CC_K = 7168, CC_V = 8192;
constexpr int CD_Q = 9216, CD_K = 10240, CD_V = 10368;
constexpr float LOG2E = 1.4426950408889634f;
constexpr float QSCALE = 0.125f * LOG2E;
constexpr int NWAVES = 8;

constexpr size_t MiB = 1u << 20;
constexpr size_t WS_CTL = 0, CTL_ZERO_BYTES = 1 * MiB;
constexpr size_t WS_MODP = 2 * MiB;
constexpr size_t WS_MOD = 14 * MiB;
constexpr size_t WS_TAB = 15 * MiB;
constexpr size_t WS_WIN = 16 * MiB, WIN_L = 84 * MiB;
constexpr size_t WS_WOUT = 184 * MiB, WOUT_L = 32 * MiB;
constexpr size_t WS_W13 = 248 * MiB, W13_L = 172 * MiB;
constexpr size_t WS_W2 = 592 * MiB, W2_L = 86 * MiB;
constexpr size_t WS_XN = 764 * MiB;
constexpr size_t WS_COLS = 892 * MiB;
constexpr size_t WS_LOWR = 1220 * MiB;
constexpr size_t WS_HID = 892 * MiB;
constexpr size_t WS_QKA = 1236 * MiB;
constexpr size_t WS_QKD = 1300 * MiB;
constexpr size_t WS_LOGA = 1336 * MiB;
constexpr size_t WS_RW = 1368 * MiB, RW_ONE = 64 * MiB;
constexpr size_t WS_VFIRST = 1816 * MiB;
constexpr size_t WS_MIXED = 1880 * MiB;
constexpr int VROW = SEQ + 64;
constexpr size_t WS_VTA = 2008 * MiB;
constexpr size_t WS_VTD = 2041 * MiB;
constexpr size_t WS_QDEC = 2046 * MiB, WS_KDT = 2062 * MiB, WS_AM = 2078 * MiB, WS_EBL = 2086 * MiB;
constexpr size_t WS_VTB = 2087 * MiB;
constexpr size_t WS_RWC = 2120 * MiB;
constexpr size_t WS_OB = 2446 * MiB;
constexpr size_t WS_PSG = 2478 * MiB;
constexpr size_t WS_WF = 2479 * MiB;
constexpr size_t WS_XR = 2480 * MiB;
constexpr size_t WS_END = 2608 * MiB;
constexpr int CW_BAR = 4096;
constexpr int CW_Q = 16384;

constexpr int RING_OFF = 0, RING_BYTES = 131072;
constexpr int LDSCTL_OFF = RING_BYTES, MISC_OFF = LDSCTL_OFF + 320;
constexpr int LDS_BYTES = 147456;

#define GAS __attribute__((address_space(1)))
#define LAS __attribute__((address_space(3)))
typedef unsigned short bf16;
typedef unsigned v4u __attribute__((ext_vector_type(4)));
typedef unsigned v2u __attribute__((ext_vector_type(2)));
typedef float f32x4 __attribute__((ext_vector_type(4)));
typedef short bf16x8 __attribute__((ext_vector_type(8)));
typedef GAS unsigned gu32;
#define RLX_AGENT __ATOMIC_RELAXED, __HIP_MEMORY_SCOPE_AGENT
#define LDS_WAIT() asm volatile("s_waitcnt lgkmcnt(0)" ::: "memory")
#define VM_WAIT() asm volatile("s_waitcnt vmcnt(0)" ::: "memory")
typedef float f32x2_t __attribute__((ext_vector_type(2))); typedef __bf16 bf16x2_t __attribute__((ext_vector_type(2)));
__device__ __forceinline__ unsigned pk2(float lo, float hi) { const f32x2_t v = {lo, hi}; return __builtin_bit_cast(unsigned, __builtin_convertvector(v, bf16x2_t)); }
__device__ __forceinline__ unsigned f2bf(float f) { return pk2(f, f) & 0xffffu; }
__device__ __forceinline__ float bf2f(unsigned short h) { return __builtin_bit_cast(float, (unsigned)h << 16); }
__device__ __forceinline__ float bflo(unsigned w) { return __builtin_bit_cast(float, w << 16); }
__device__ __forceinline__ float bfhi(unsigned w) { return __builtin_bit_cast(float, w & 0xffff0000u); }
template <int CTRL> __device__ __forceinline__ float dpp_f(float v) { return __builtin_bit_cast(float, __builtin_amdgcn_update_dpp(0, __builtin_bit_cast(int, v), CTRL, 0xF, 0xF, true)); }
__device__ __forceinline__ float sum8(float v) {
    v += dpp_f<0xB1>(v); v += dpp_f<0x4E>(v); v += dpp_f<0x141>(v); return v; }
__device__ __forceinline__ float sum32(float v) {
    v = sum8(v); v += dpp_f<0x140>(v); v += __builtin_bit_cast(float, __builtin_amdgcn_ds_swizzle(__builtin_bit_cast(int, v), 0x401F)); return v; }
__device__ __forceinline__ float wave_sum(float v) {
    v = sum8(v); v += dpp_f<0x140>(v);
    v += __builtin_bit_cast(float, __builtin_amdgcn_ds_swizzle(__builtin_bit_cast(int, v), 0x401F));
    { const int u = __builtin_bit_cast(int, v); v = __builtin_bit_cast(float, __builtin_amdgcn_readlane(u, 0)) + __builtin_bit_cast(float, __builtin_amdgcn_readlane(u, 32)); }
    return v;
}
__device__ __forceinline__ float sigmoid_f(float x) { return __builtin_amdgcn_rcpf(1.0f + __builtin_amdgcn_exp2f(-LOG2E * x)); }
__device__ __forceinline__ float silu_g(float x) { return x * sigmoid_f(x); }
__device__ __forceinline__ void unpack8(const v4u r, float (&f)[8]) { f[0] = bflo(r.x); f[1] = bfhi(r.x); f[2] = bflo(r.y); f[3] = bfhi(r.y); f[4] = bflo(r.z); f[5] = bfhi(r.z); f[6] = bflo(r.w); f[7] = bfhi(r.w); }
__device__ __forceinline__ v4u pack8(const float (&f)[8]) { v4u o; o.x = pk2(f[0], f[1]); o.y = pk2(f[2], f[3]); o.z = pk2(f[4], f[5]); o.w = pk2(f[6], f[7]); return o; }

#define XB_TMO      128
#define XB_XCNT(j)  (256  + 64 * (j))
#define XB_XSUB(j)  (1280 + 64 * (j))
#define XB_XGEN(j)  (2304 + 64 * (j))
#define XB_TOP      3328
#define XB_TOPGEN   3392
#define XCD_BAR_WORDS 3456
#define XB_SPIN_CAP (1u << 23)

__device__ __forceinline__ unsigned xb_ld(unsigned* p)              { return __hip_atomic_load(p, __ATOMIC_RELAXED, __HIP_MEMORY_SCOPE_AGENT); }
__device__ __forceinline__ unsigned xb_add(unsigned* p, unsigned v) { return __hip_atomic_fetch_add(p, v, __ATOMIC_RELAXED, __HIP_MEMORY_SCOPE_AGENT); }
__device__ __forceinline__ unsigned xb_xcc_id() { return (unsigned)__builtin_amdgcn_s_getreg((3 << 11) | 20) & 0xFu; }
#define XB_SPIN(cond, bar) do { unsigned _sp = 0; while (cond) { __builtin_amdgcn_s_sleep(1); \
    if ((++_sp & 255u) == 0u) { if (xb_ld(&(bar)[XB_TMO])) break; if (_sp > XB_SPIN_CAP) { atomicAdd(&(bar)[XB_TMO], 1u); break; } } } } while (0)

struct XcdBarrier {
    unsigned* bar; unsigned x;
    volatile LAS unsigned* st;
};

__device__ __forceinline__ XcdBarrier xcd_barrier_post(unsigned* bar, volatile LAS unsigned* st) {
    XcdBarrier b; b.bar = bar; b.x = xb_xcc_id(); b.st = st;
    if (threadIdx.x == 0) (void)xb_add(&bar[XB_XCNT(b.x)], 1u);
    return b;
}
__device__ __forceinline__ void xcd_barrier_complete(unsigned* bar, unsigned x, unsigned& nloc, unsigned& nx) {
    const unsigned G = gridDim.x * gridDim.y * gridDim.z;
    unsigned sum, cnt, mine, sp = 0u;
    for (;;) {
        sum = 0u; cnt = 0u; mine = 0u;
#pragma unroll
        for (unsigned j = 0; j < 16; ++j) { const unsigned c = xb_ld(&bar[XB_XCNT(j)]); sum += c; cnt += (c > 0u) ? 1u : 0u; mine = (j == x) ? c : mine; }
        if (sum == G) break;
        __builtin_amdgcn_s_sleep(1);
        if ((++sp & 255u) == 0u) { if (xb_ld(&bar[XB_TMO])) break; if (sp > XB_SPIN_CAP) { atomicAdd(&bar[XB_TMO], 1u); break; } }
    }
    nloc = mine > 0u ? mine : 1u; nx = cnt > 0u ? cnt : 1u;
}

__device__ __forceinline__ void xcd_barrier(const XcdBarrier& b) {
    asm volatile("s_waitcnt vmcnt(0)" ::: "memory");
    __syncthreads();
    if (threadIdx.x == 0) {
        unsigned* bar = b.bar;
        __builtin_amdgcn_s_waitcnt(0);
        unsigned nloc = b.st[0], nx = b.st[1];
        if (nloc == 0u) { xcd_barrier_complete(bar, b.x, nloc, nx); b.st[0] = nloc; b.st[1] = nx; }
        const unsigned old = xb_add(&bar[XB_XSUB(b.x)], 1u);
        const unsigned gen = old / nloc;
        if (old + 1u == (gen + 1u) * nloc) {
            __builtin_amdgcn_fence(__ATOMIC_RELEASE, "agent");
            asm volatile("s_waitcnt vmcnt(0)" ::: "memory");
            const unsigned og = xb_add(&bar[XB_TOP], 1u);
            const unsigned tg = og / nx;
            if (og + 1u == (tg + 1u) * nx) xb_add(&bar[XB_TOPGEN], 1u);
            else XB_SPIN(xb_ld(&bar[XB_TOPGEN]) == tg, bar);
            __builtin_amdgcn_fence(__ATOMIC_ACQUIRE, "agent");
            xb_add(&bar[XB_XGEN(b.x)], 1u);
            asm volatile("s_waitcnt vmcnt(0)" ::: "memory");
        } else {
            XB_SPIN(xb_ld(&bar[XB_XGEN(b.x)]) == gen, bar);
            __builtin_amdgcn_fence(__ATOMIC_ACQUIRE, "agent");
            asm volatile("s_waitcnt vmcnt(0)" ::: "memory");
        }
    }
    __syncthreads();
}

typedef const float* const __attribute__((address_space(4)))* kargp;
struct Frame {
    LAS unsigned char* lds;
    volatile LAS unsigned* MISC;
    gu32* ctl;
    int tid, lane, wave;
    int vcu, G, bx;
    kargp kin;
    float* out;
    unsigned char* ws;
};
enum { I_X = 0, I_C, I_RELB, I_ADAW, I_ADAB, I_WIN, I_WOUT, I_DQN, I_DKN, I_DLAM, I_DSUB, I_GGU, I_GGB, I_GON, I_RMU, I_RWUP, I_RW0, I_RAUP, I_RA0, I_RGUP,
       I_RKK, I_RKA, I_RRK, I_RLNW, I_RLNB, I_VRD, I_VRMU, I_VRUP, I_VR0, I_SQN, I_SKN, I_SSINK, I_W1, I_W3, I_W2 };

#define WSP(T, off) ((T*)(F.ws + (off)))
__device__ __forceinline__ void relaunder_tid(Frame& F) { int t = F.tid; asm volatile("" : "+v"(t)); F.tid = t; F.lane = t & 63; F.wave = __builtin_amdgcn_readfirstlane(t >> 6); }
__device__ __forceinline__ void relaunder(Frame& F) { kargp p = F.kin; asm volatile("" : "+s"(p)); F.kin = p; }

__device__ __forceinline__ void conv_item(const float* src, int ld, int col0, int ncols, int K, bf16* WT, int row0, int kb, LAS float* scr, int lane) {
    const int k0 = 64 * kb;
    { const int n = lane & 31; const bool ok = src != nullptr && n < ncols; const float* sp = src + (size_t)(k0 + (lane >> 5)) * ld + col0 + n; float v[32];
#pragma unroll
      for (int i = 0; i < 32; ++i) v[i] = ok ? sp[(size_t)(2 * i) * ld] : 0.f;
#pragma unroll
      for (int i = 0; i < 32; ++i) scr[(2 * i + (lane >> 5)) * 33 + n] = v[i]; }
    LDS_WAIT(); asm volatile("" ::: "memory");
    const int c = lane & 7;
#pragma unroll
    for (int j = 0; j < 4; ++j) { const int n = (lane >> 3) + 8 * j; const LAS float* s = scr + (8 * c) * 33 + n;
        v4u o; o.x = pk2(s[0 * 33], s[1 * 33]); o.y = pk2(s[2 * 33], s[3 * 33]); o.z = pk2(s[4 * 33], s[5 * 33]); o.w = pk2(s[6 * 33], s[7 * 33]);
        if (n < ncols) *(GAS v4u*)(WT + (size_t)(row0 + n) * K + k0 + 8 * c) = o; }
    LDS_WAIT(); asm volatile("" ::: "memory");
}
__device__ __forceinline__ int t5_bucket(int d) {
    if (d < 16) return d;
    int v = 16 + (int)(logf((float)d * (1.0f / 16.0f)) / logf(8.0f) * 16.0f);
    return v < 31 ? v : 31;
}
__device__ __forceinline__ void p0_prologue_a(Frame& F) {
    const int gw = F.vcu * NWAVES + F.wave, NGW = F.G * NWAVES;
    LAS float* ldsf = (LAS float*)(F.lds + RING_OFF);
    { float cv[16];
#pragma unroll
      for (int q = 0; q < 16; ++q) cv[q] = F.kin[I_C][F.tid + NWAVES * 64 * q];
#pragma unroll
      for (int q = 0; q < 16; ++q) ldsf[F.tid + NWAVES * 64 * q] = silu_g(cv[q]); }
    __syncthreads();
    float* MODP = WSP(float, WS_MODP);
    for (int it = gw; it < 6144; it += NGW) {
        const int l = it / 3072, rem = it % 3072, kc = rem / 96, ng = rem % 96, n0 = 256 * ng + 4 * F.lane;
        const float* w = F.kin[I_ADAW] + ((size_t)l * DM + kc * 128) * 24576 + n0;
        f32x4 a0 = {0.f, 0.f, 0.f, 0.f}, a1 = {0.f, 0.f, 0.f, 0.f};
#pragma unroll 16
        for (int k = 0; k < 128; ++k) { const f32x4 wv = *(const f32x4*)(w + (size_t)k * 24576); const float s0 = ldsf[kc * 128 + k], s1 = ldsf[DM + kc * 128 + k]; a0 += wv * s0; a1 += wv * s1; }
        *(f32x4*)(MODP + ((size_t)(l * 32 + kc) * 2 + 0) * 24576 + n0) = a0;
        *(f32x4*)(MODP + ((size_t)(l * 32 + kc) * 2 + 1) * 24576 + n0) = a1;
    }
    for (int idx = F.bx * (NWAVES * 64) + F.tid; idx < NLAYER * 448 * 64; idx += F.G * NWAVES * 64) {
        const int l = idx / (448 * 64), rem = idx % (448 * 64), blk = rem >> 6, ln = rem & 63, n = ln & 15, g = ln >> 4;
        const int m = blk < 384 ? blk >> 7 : 3, nt = blk < 384 ? (blk & 127) >> 1 : blk - 384, ks = blk < 384 ? (blk & 1) : 0;
        const float* W = m == 0 ? F.kin[I_RWUP] + (size_t)l * 65536 : (m == 1 ? F.kin[I_RAUP] + (size_t)l * 65536 : (m == 2 ? F.kin[I_RGUP] + (size_t)l * 65536 : (l ? F.kin[I_VRUP] + (size_t)(l - 1) * 32768 : nullptr)));
        float f[8];
#pragma unroll
        for (int e = 0; e < 8; ++e) f[e] = W != nullptr ? W[(size_t)(32 * ks + 8 * g + e) * 1024 + 16 * nt + n] : 0.f;
        *(v4u*)(WSP(bf16, WS_WF) + ((size_t)(l * 448 + blk) * 64 + ln) * 8) = pack8(f);
    }
    __syncthreads();
    LAS float* scr = (LAS float*)(F.lds + RING_OFF + F.wave * 16384);
    constexpr int I_IN = 337 * 64, I_OUT = 128 * 64, I_13 = 688 * 64, I_2 = 128 * 172, I_L = I_IN + I_OUT + I_13 + I_2;
    for (int it = gw; it < NLAYER * I_L; it += NGW) {
        const int l = it / I_L; int r = it % I_L;
        if (r < I_IN) {
            const int kb = r / 337, cb = r % 337; const float* src = F.kin[I_WIN] + (size_t)l * DM * P_IN; int ld = P_IN, col0, row0, nc = 32;
            if (cb < 192) { col0 = 32 * cb; row0 = 32 * cb; }
            else if (cb < 288) { col0 = 6160 + 32 * (cb - 192); row0 = 6144 + 32 * (cb - 192); }
            else if (cb < 328) { col0 = 9424 + 32 * (cb - 288); row0 = 9216 + 32 * (cb - 288); }
            else if (cb == 328) { col0 = 6144; row0 = 10496; nc = 16; }
            else if (cb < 335) { col0 = 9232 + 32 * (cb - 329); row0 = 10512 + 32 * (cb - 329); }
            else if (cb == 335) { src = l ? F.kin[I_VRD] + (size_t)(l - 1) * DM * 32 : nullptr; ld = 32; col0 = 0; row0 = 10704; }
            else { src = nullptr; col0 = 0; row0 = 10736; nc = 16; }
            conv_item(src, ld, col0, nc, DM, WSP(bf16, WS_WIN + l * WIN_L), row0, kb, scr, F.lane); continue; }
        r -= I_IN;
        if (r < I_OUT) { const int kb = r / 128, cb = r % 128; conv_item(F.kin[I_WOUT] + (size_t)l * DM * DM, DM, 32 * cb, 32, DM, WSP(bf16, WS_WOUT + l * WOUT_L), 32 * cb, kb, scr, F.lane); continue; }
        r -= I_OUT;
        if (r < I_13) { const int kb = r / 688, cb = r % 688, pn = cb >> 3, wi = cb & 7;
            const float* src = (wi < 4 ? F.kin[I_W1] : F.kin[I_W3]) + (size_t)l * DM * DFF;
            conv_item(src, DFF, 128 * pn + 32 * (wi & 3), 32, DM, WSP(bf16, WS_W13 + l * W13_L), 32 * cb, kb, scr, F.lane); continue; }
        r -= I_13;
        { const int kb = r / 128, cb = r % 128; conv_item(F.kin[I_W2] + (size_t)l * DFF * DM, DM, 32 * cb, 32, DFF, WSP(bf16, WS_W2 + l * W2_L), 32 * cb, kb, scr, F.lane); }
    }
}
__device__ __forceinline__ void p0_prologue_b(Frame& F) {
    const int gt = F.bx * (NWAVES * 64) + F.tid, NT = F.G * NWAVES * 64;
    const float* MODP = WSP(float, WS_MODP); float* MOD = WSP(float, WS_MOD);
    for (int idx = gt; idx < NLAYER * 2 * 24576; idx += NT) {
        const int l = idx / 49152, rem = idx % 49152, b = rem / 24576, n = rem % 24576;
        float s = F.kin[I_ADAB][l * 24576 + n];
#pragma unroll 8
        for (int kc = 0; kc < 32; ++kc) s += MODP[((size_t)(l * 32 + kc) * 2 + b) * 24576 + n];
        MOD[idx] = s;
    }
    if (F.bx == 0) { float* TAB = WSP(float, WS_TAB);
        float tv[6];
#pragma unroll
        for (int q = 0; q < 6; ++q) { const int i = F.tid + NWAVES * 64 * q, hh = i >> 7, d = i & 127; tv[q] = F.kin[I_RELB][t5_bucket(d) * 24 + hh]; }
#pragma unroll
        for (int q = 0; q < 6; ++q) TAB[F.tid + NWAVES * 64 * q] = tv[q] * LOG2E; }
}
__device__ __forceinline__ void rms_phase(Frame& F, const float* xin, const float* sh, const float* sc) {
    const int gw = F.vcu * NWAVES + F.wave, NGW = F.G * NWAVES;
    bf16* XN = WSP(bf16, WS_XN);
    for (int m = gw; m < M; m += NGW) {
        const int b = m >> 13;
        const f32x4* xr = (const f32x4*)(xin + (size_t)m * DM) + F.lane;
        f32x4 v[16]; float ss = 0.f;
#pragma unroll
        for (int j = 0; j < 16; ++j) { v[j] = xr[64 * j]; ss += (v[j].x * v[j].x + v[j].y * v[j].y) + (v[j].z * v[j].z + v[j].w * v[j].w); }
        const float rstd = rsqrtf(wave_sum(ss) * (1.0f / DM) + 1e-6f);
        const f32x4* scp = (const f32x4*)(sc + (size_t)b * 24576) + F.lane; const f32x4* shp = (const f32x4*)(sh + (size_t)b * 24576) + F.lane;
        v2u* o8 = (v2u*)(XN + (size_t)m * DM) + F.lane;
#pragma unroll
        for (int j = 0; j < 16; ++j) { const f32x4 s4 = scp[64 * j], h4 = shp[64 * j]; const f32x4 o = v[j] * rstd * (s4 + 1.0f) + h4;
            v2u w; w.x = pk2(o.x, o.y); w.y = pk2(o.z, o.w); o8[64 * j] = w; }
    }
}
__device__ __forceinline__ void rms_phase_bf(Frame& F, const float* sh, const float* sc) {
    const int gw = F.vcu * NWAVES + F.wave, NGW = F.G * NWAVES;
    bf16* XN = WSP(bf16, WS_XN); const bf16* XR = WSP(bf16, WS_XR);
    for (int m = gw; m < M; m += NGW) {
        const int b = m >> 13;
        const v4u* xr = (const v4u*)(XR + (size_t)m * DM) + F.lane;
        v4u raw[8]; float ss = 0.f;
#pragma unroll
        for (int j = 0; j < 8; ++j) raw[j] = xr[64 * j];
#pragma unroll
        for (int j = 0; j < 8; ++j) { float f[8]; unpack8(raw[j], f);
#pragma unroll
            for (int e = 0; e < 8; ++e) ss += f[e] * f[e]; }
        const float rstd = rsqrtf(wave_sum(ss) * (1.0f / DM) + 1e-6f);
        const float* scp = sc + (size_t)b * 24576 + 8 * F.lane; const float* shp = sh + (size_t)b * 24576 + 8 * F.lane;
        v4u* o16 = (v4u*)(XN + (size_t)m * DM) + F.lane;
#pragma unroll
        for (int j = 0; j < 8; ++j) { float f[8]; unpack8(raw[j], f);
            const f32x4 s0 = *(const f32x4*)(scp + 512 * j), s1 = *(const f32x4*)(scp + 512 * j + 4), h0 = *(const f32x4*)(shp + 512 * j), h1 = *(const f32x4*)(shp + 512 * j + 4);
            float o[8];
#pragma unroll
            for (int e = 0; e < 4; ++e) { o[e] = f[e] * rstd * (s0[e] + 1.0f) + h0[e]; o[4 + e] = f[4 + e] * rstd * (s1[e] + 1.0f) + h1[e]; }
            o16[64 * j] = pack8(o); }
    }
}
__device__ __forceinline__ void prep_norm(Frame& F, int l) {
    const int gw = F.vcu * NWAVES + F.wave, NGW = F.G * NWAVES, lane = F.lane, sub = lane >> 3, ch = lane & 7;
    float gqa[8], gka[8], gqd[8], gkd[8];
#pragma unroll
    for (int e = 0; e < 8; ++e) { gqa[e] = F.kin[I_DQN][l * 64 + ch * 8 + e] * QSCALE; gka[e] = F.kin[I_DKN][l * 64 + ch * 8 + e];
                                  gqd[e] = F.kin[I_SQN][l * 64 + ch * 8 + e] * QSCALE; gkd[e] = F.kin[I_SKN][l * 64 + ch * 8 + e]; }
    const bf16* COLS = WSP(bf16, WS_COLS); bf16* QKA = WSP(bf16, WS_QKA); bf16* QKD = WSP(bf16, WS_QKD);
    for (int m0 = gw; m0 < M; m0 += 2 * NGW) {
        v4u ra[2][4], rd[2][3];
#pragma unroll
        for (int r = 0; r < 2; ++r) { const int m = m0 + r * NGW < M ? m0 + r * NGW : m0; const bf16* src = COLS + (size_t)m * NMAIN;
#pragma unroll
            for (int i = 0; i < 4; ++i) ra[r][i] = *(const v4u*)(src + CA_Q + (i * 8 + sub) * 64 + ch * 8);
#pragma unroll
            for (int i = 0; i < 3; ++i) { const int vec = i * 8 + sub; rd[r][i] = *(const v4u*)(src + CD_Q + (vec < 18 ? vec : 17) * 64 + ch * 8); } }
#pragma unroll
        for (int r = 0; r < 2; ++r) { const int m = m0 + r * NGW; if (m < M) {
#pragma unroll
            for (int i = 0; i < 4; ++i) { const int vec = i * 8 + sub, col = vec * 64 + ch * 8;
                float f[8]; unpack8(ra[r][i], f); float ss = 0.f;
#pragma unroll
                for (int e = 0; e < 8; ++e) ss += f[e] * f[e];
                ss = sum8(ss);
                const float rstd = rsqrtf(ss * (1.0f / 64.0f) + 1e-6f);
#pragma unroll
                for (int e = 0; e < 8; ++e) f[e] = f[e] * rstd * (i < 2 ? gqa[e] : gka[e]);
                *(v4u*)(QKA + (size_t)m * 2048 + col) = pack8(f); }
#pragma unroll
            for (int i = 0; i < 3; ++i) { const int vec = i * 8 + sub, col = vec * 64 + ch * 8;
                float f[8]; unpack8(rd[r][i], f); float ss = 0.f;
#pragma unroll
                for (int e = 0; e < 8; ++e) ss += f[e] * f[e];
                ss = sum8(ss);
                const float rstd = rsqrtf(ss * (1.0f / 64.0f) + 1e-6f);
#pragma unroll
                for (int e = 0; e < 8; ++e) f[e] = f[e] * rstd * (vec < 16 ? gqd[e] : gkd[e]);
                if (vec < 18) *(v4u*)(QKD + (size_t)m * 1152 + col) = pack8(f); } } }
    }
}
__device__ __forceinline__ void prep_loga(Frame& F, int l) {
    LAS float* gdl = (LAS float*)(F.lds + RING_OFF);
    float gu[16];
#pragma unroll
    for (int j = 0; j < 16; ++j) gu[j] = F.kin[I_GGU][((size_t)l * 16 + j) * 512 + F.tid];
    const float bias = F.kin[I_GGB][l * 512 + F.tid];
    const float* LOWR = WSP(float, WS_LOWR); float* LOGA = WSP(float, WS_LOGA);
    for (int tile = F.bx; tile < M / 64; tile += F.G) {
        const size_t row0 = (size_t)tile * 64;
        __syncthreads();
#pragma unroll
        for (int i = 0; i < 2; ++i) { const int idx = F.tid + 512 * i; gdl[idx] = LOWR[(row0 + (idx >> 4)) * 256 + (idx & 15)]; }
        __syncthreads();
#pragma unroll 4
        for (int t = 0; t < 64; ++t) { const LAS f32x4* gp = (const LAS f32x4*)(gdl + t * 16); const f32x4 g0 = gp[0], g1 = gp[1], g2 = gp[2], g3 = gp[3];
            float z = bias + g0.x * gu[0] + g0.y * gu[1] + g0.z * gu[2] + g0.w * gu[3] + g1.x * gu[4] + g1.y * gu[5] + g1.z * gu[6] + g1.w * gu[7]
                    + g2.x * gu[8] + g2.y * gu[9] + g2.z * gu[10] + g2.w * gu[11] + g3.x * gu[12] + g3.y * gu[13] + g3.z * gu[14] + g3.w * gu[15];
            LOGA[(row0 + t) * 512 + F.tid] = (fminf(z, 0.f) - __logf(1.0f + __expf(-fabsf(z)))) * (1.0f / 16.0f); }
    }
}
__device__ __forceinline__ int next_item(Frame& F, gu32* ctr) {
    volatile LAS int* slot = (volatile LAS int*)(F.lds + LDSCTL_OFF + 64);
    __syncthreads();
    if (F.tid == 0) *slot = (int)__hip_atomic_fetch_add(ctr, 1u, RLX_AGENT);
    __syncthreads();
    return *slot;
}
typedef float f32x16 __attribute__((ext_vector_type(16)));
__device__ __forceinline__ float xother32(float v) { unsigned a = __builtin_bit_cast(unsigned, v), b = a; asm volatile("" : "+v"(b)); auto rr = __builtin_amdgcn_permlane32_swap(a, b, false, false);
    const unsigned lo = rr[0], hi = rr[1]; return __builtin_bit_cast(float, (unsigned)((__builtin_amdgcn_mbcnt_hi(~0u, __builtin_amdgcn_mbcnt_lo(~0u, 0u)) & 32u) ? lo : hi)); }
__device__ __forceinline__ float xsum32(float v) { return v + xother32(v); }
__device__ __forceinline__ float xmax32(float v) { return fmaxf(v, xother32(v)); }
__device__ __forceinline__ int crow16(int r, int hi) { return (r & 3) + 8 * (r >> 2) + 4 * hi; }
template <bool ISA>
__device__ __forceinline__ void attn_unit(Frame& F, int l, int b, int hx, int qb) {
    constexpr int DV = ISA ? 128 : 64, NDV = DV / 32, KSTR = ISA ? 272 : 144, VSTR = 144, KBYTES = 64 * KSTR, VBYTES = DV * VSTR, BUFB = KBYTES + VBYTES, NCH = ISA ? 2 : 1;
    constexpr float NEG = -1e30f;
    LAS unsigned char* L = F.lds + RING_OFF;
    const int tid = F.tid, lane = F.lane, r32 = lane & 31, hi = lane >> 5, qs = F.wave & 3, grp = F.wave >> 2, q0 = qb * 128;
    const int kvh = hx >> 2, hd = kvh * 8 + (hx & 3) * 2 + grp;
    const bf16* Qp; const bf16* Kp; const bf16* VT; int ldq;
    if (ISA) { const bf16* QKA = WSP(bf16, WS_QKA); Qp = QKA + (size_t)b * SEQ * 2048 + hx * 128 + grp * 64; Kp = QKA + (size_t)b * SEQ * 2048 + 1024 + hx * 128; ldq = 2048; VT = WSP(bf16, WS_VTA) + (size_t)(b * 8 + hx) * 128 * VROW; }
    else { const bf16* QKD = WSP(bf16, WS_QKD); Qp = QKD + (size_t)b * SEQ * 1152 + hd * 64; Kp = QKD + (size_t)b * SEQ * 1152 + 1024 + kvh * 64; ldq = 1152; VT = WSP(bf16, WS_VTD) + (size_t)(b * 2 + kvh) * 64 * VROW; }
    const int qpos = q0 + 32 * qs + r32;
    bf16x8 qr[4];
#pragma unroll
    for (int d0 = 0; d0 < 4; ++d0) qr[d0] = *(const bf16x8*)(Qp + (size_t)qpos * ldq + d0 * 16 + hi * 8);
    LAS float* Bt = (LAS float*)(L + 2 * BUFB);
    { const float* TAB = WSP(float, WS_TAB);
      if (ISA) { if (tid < 130) Bt[tid] = tid == 0 ? NEG : (tid == 129 ? 0.f : TAB[hx * 128 + tid - 1] - TAB[hx * 128 + 127]); }
      else { if (tid < 260) { const int gi = tid >= 130, t = tid - 130 * gi; Bt[tid] = (t == 0 || t == 129) ? NEG : TAB[(8 + kvh * 8 + (hx & 3) * 2 + gi) * 128 + t - 1]; } } }
    const int TQ = q0 >> 6, T0 = ISA ? 0 : (TQ >= 2 ? TQ - 2 : 0), T1 = TQ + 1;
    v4u kreg[NCH], vreg[NCH];
#define AT_GLOAD(T) do { _Pragma("unroll") for (int i_ = 0; i_ < NCH; ++i_) { const int c_ = tid + 512 * i_; \
        const int kr_ = ISA ? (c_ >> 4) : (c_ >> 3), kc_ = ISA ? (c_ & 15) : (c_ & 7); kreg[i_] = *(const v4u*)(Kp + (size_t)((T) * 64 + kr_) * ldq + kc_ * 8); \
        const int vr_ = c_ >> 3, vc_ = c_ & 7; vreg[i_] = *(const v4u*)(VT + (size_t)vr_ * VROW + (T) * 64 + vc_ * 8); } } while (0)
#define AT_LWRITE(buf) do { _Pragma("unroll") for (int i_ = 0; i_ < NCH; ++i_) { const int c_ = tid + 512 * i_; \
        const int kr_ = ISA ? (c_ >> 4) : (c_ >> 3), kc_ = ISA ? (c_ & 15) : (c_ & 7); *(LAS v4u*)(L + (buf) * BUFB + kr_ * KSTR + kc_ * 16) = kreg[i_]; \
        const int vr_ = c_ >> 3, vc_ = c_ & 7; *(LAS v4u*)(L + (buf) * BUFB + KBYTES + vr_ * VSTR + vc_ * 16) = vreg[i_]; } } while (0)
    f32x16 o[NDV];
#pragma unroll
    for (int i = 0; i < NDV; ++i) o[i] = (f32x16){0.f, 0.f, 0.f, 0.f, 0.f, 0.f, 0.f, 0.f, 0.f, 0.f, 0.f, 0.f, 0.f, 0.f, 0.f, 0.f};
    float m_run = ISA ? NEG : F.kin[I_SSINK][l * 16 + hd] * LOG2E, l_run = ISA ? 0.f : (hi == 0 ? 1.f : 0.f);
    const int krow = (r32 & 16) | (r32 & 3) | ((r32 & 4) << 1) | ((r32 & 8) >> 1);
    const int koff = krow * KSTR + (ISA ? grp * 128 : 0) + hi * 16, voff = KBYTES + r32 * VSTR + hi * 16;
    AT_GLOAD(T0); AT_LWRITE(0); __syncthreads();
#pragma unroll 1
    for (int T = T0; T <= T1; ++T) {
        const int cur = (T - T0) & 1;
        AT_GLOAD(T < T1 ? T + 1 : T1);
        LAS const unsigned char* Kb = L + cur * BUFB;
        f32x16 s[2];
#pragma unroll
        for (int blk = 0; blk < 2; ++blk) { s[blk] = (f32x16){0.f, 0.f, 0.f, 0.f, 0.f, 0.f, 0.f, 0.f, 0.f, 0.f, 0.f, 0.f, 0.f, 0.f, 0.f, 0.f};
#pragma unroll
            for (int d0 = 0; d0 < 4; ++d0) { const bf16x8 kf = *(const LAS bf16x8*)(Kb + koff + blk * 32 * KSTR + d0 * 32); s[blk] = __builtin_amdgcn_mfma_f32_32x32x16_bf16(kf, qr[d0], s[blk], 0, 0, 0); } }
        bf16x8 vfc[NDV], vfn[NDV];
#pragma unroll
        for (int i = 0; i < NDV; ++i) vfc[i] = *(const LAS bf16x8*)(Kb + voff + i * 32 * VSTR);
        if (!ISA || T >= TQ - 2) {
            const LAS float* bt = Bt + (ISA ? 0 : grp * 130) + 1; const int d0 = qpos - T * 64 - 8 * hi;
#pragma unroll
            for (int blk = 0; blk < 2; ++blk)
#pragma unroll
                for (int r = 0; r < 16; ++r) { const int dist = d0 - (32 * blk + 16 * (r >> 3) + (r & 7)); const int di = dist < -1 ? -1 : (dist > 128 ? 128 : dist); s[blk][r] += bt[di]; } }
        float mt = s[0][0];
#pragma unroll
        for (int r = 1; r < 16; ++r) mt = fmaxf(mt, s[0][r]);
#pragma unroll
        for (int r = 0; r < 16; ++r) mt = fmaxf(mt, s[1][r]);
        mt = xmax32(mt);
        const float m_new = fmaxf(m_run, mt);
        if (__any(m_new > m_run)) { const float alpha = __builtin_amdgcn_exp2f(m_run - m_new); l_run *= alpha;
#pragma unroll
            for (int i = 0; i < NDV; ++i)
#pragma unroll
                for (int r = 0; r < 16; ++r) o[i][r] *= alpha;
            m_run = m_new; }
        float ls = 0.f;
#pragma unroll
        for (int blk = 0; blk < 2; ++blk)
#pragma unroll
            for (int r = 0; r < 16; ++r) { const float pv_ = __builtin_amdgcn_exp2f(s[blk][r] - m_run); s[blk][r] = pv_; ls += pv_; }
        l_run += ls;
#pragma unroll
        for (int sl = 0; sl < 4; ++sl) { const int blk = sl >> 1, r0 = 8 * (sl & 1);
            v4u pw; pw.x = pg8::cvt_pk_bf16(s[blk][r0], s[blk][r0 + 1]); pw.y = pg8::cvt_pk_bf16(s[blk][r0 + 2], s[blk][r0 + 3]); pw.z = pg8::cvt_pk_bf16(s[blk][r0 + 4], s[blk][r0 + 5]); pw.w = pg8::cvt_pk_bf16(s[blk][r0 + 6], s[blk][r0 + 7]);
            const bf16x8 pf = __builtin_bit_cast(bf16x8, pw);
#pragma unroll
            for (int i = 0; i < NDV; ++i) { if (sl < 3) vfn[i] = *(const LAS bf16x8*)(Kb + voff + i * 32 * VSTR + (sl + 1) * 32); o[i] = __builtin_amdgcn_mfma_f32_32x32x16_bf16(vfc[i], pf, o[i], 0, 0, 0); }
#pragma unroll
            for (int i = 0; i < NDV; ++i) vfc[i] = vfn[i]; }
        AT_LWRITE(cur ^ 1);
        __syncthreads();
    }
#undef AT_GLOAD
#undef AT_LWRITE
    const float inv = 1.0f / xsum32(l_run);
    bf16* MIX = WSP(bf16, WS_MIXED);
    if (ISA) {
        int ll_ = l; asm volatile("" : "+s"(ll_)); const float lam_init = ll_ == 0 ? 0.2f : 0.35550906759f;     float lam_full;
        { const float* lm = F.kin[I_DLAM] + (size_t)l * 256; const float s1 = wave_sum(lm[lane] * lm[64 + lane]), s2 = wave_sum(lm[128 + lane] * lm[192 + lane]); lam_full = __expf(s1) - __expf(s2) + lam_init; }
        LAS float* R1 = (LAS float*)L;
        LAS bf16* R2 = (LAS bf16*)(L + 66048);
        const int ql = 32 * qs + r32;
        if (grp == 1) {
#pragma unroll
            for (int i = 0; i < NDV; ++i)
#pragma unroll
                for (int r = 0; r < 16; ++r) R1[ql * 129 + 32 * i + crow16(r, hi)] = lam_full * inv * o[i][r]; }
        __syncthreads();
        if (grp == 0) { float ss = 0.f;
#pragma unroll
            for (int i = 0; i < NDV; ++i)
#pragma unroll
                for (int r = 0; r < 16; ++r) { const float d = o[i][r] * inv - R1[ql * 129 + 32 * i + crow16(r, hi)]; o[i][r] = d; ss += d * d; }
            const float rstd = rsqrtf(xsum32(ss) * (1.0f / 128.0f) + 1e-6f) * (1.0f - lam_init);
            const float* sl = F.kin[I_DSUB] + l * 128;
#pragma unroll
            for (int i = 0; i < NDV; ++i)
#pragma unroll
                for (int r = 0; r < 16; ++r) { const int dv = 32 * i + crow16(r, hi); R2[ql * 132 + dv] = (bf16)f2bf(o[i][r] * rstd * sl[dv]); } }
        __syncthreads();
#pragma unroll
        for (int i = 0; i < 4; ++i) { const int c = tid + 512 * i, row = c >> 4, ch = c & 15; const LAS v2u* sp = (const LAS v2u*)(R2 + row * 132 + ch * 8); const v2u a = sp[0], bb = sp[1];
            *(v4u*)(MIX + (size_t)(b * SEQ + q0 + row) * DM + hx * 128 + ch * 8) = (v4u){a.x, a.y, bb.x, bb.y}; }
    } else {
        LAS bf16* R = (LAS bf16*)L + F.wave * 2176;
#pragma unroll
        for (int i = 0; i < NDV; ++i)
#pragma unroll
            for (int r = 0; r < 16; ++r) R[r32 * 68 + 32 * i + crow16(r, hi)] = (bf16)f2bf(o[i][r] * inv);
#pragma unroll
        for (int i = 0; i < 4; ++i) { const int c = lane + 64 * i, row = c >> 3, ch = c & 7; const LAS v2u* sp = (const LAS v2u*)(R + row * 68 + ch * 8); const v2u a = sp[0], bb = sp[1];
            *(v4u*)(MIX + (size_t)(b * SEQ + q0 + 32 * qs + row) * DM + 3072 + hd * 64 + ch * 8) = (v4u){a.x, a.y, bb.x, bb.y}; }
    }
}
__device__ __forceinline__ void prep_gla(Frame& F) {
    LAS float* Lb = (LAS float*)(F.lds + RING_OFF); LAS float* Qd = Lb + 64 * 129; LAS float* Ki = Qd + 64 * 129; LAS bf16* Kt = (LAS bf16*)(Ki + 64 * 129);
    const bf16* COLS = WSP(bf16, WS_COLS); const float* LOGA = WSP(float, WS_LOGA);
    bf16* QDEC = WSP(bf16, WS_QDEC); bf16* KDT = WSP(bf16, WS_KDT); bf16* AMg = WSP(bf16, WS_AM); float* EBL = WSP(float, WS_EBL);
    for (int u = F.bx; u < 1024; u += F.G) {
        const int b = u >> 9, h = (u >> 7) & 3, ck = u & 127; const size_t row0 = (size_t)b * SEQ + ck * 64;
        __syncthreads();
        f32x4 lg[4]; v4u qv[2], kv[2];
#pragma unroll
        for (int i = 0; i < 4; ++i) { const int i4 = F.tid + 512 * i, t = i4 >> 5, d4 = (i4 & 31) * 4; lg[i] = *(const f32x4*)(LOGA + (row0 + t) * 512 + h * 128 + d4); }
#pragma unroll
        for (int i = 0; i < 2; ++i) { const int i8 = F.tid + 512 * i, t = i8 >> 4, d8 = (i8 & 15) * 8; const bf16* p = COLS + (row0 + t) * NMAIN + h * 128 + d8; qv[i] = *(const v4u*)(p + CB_Q); kv[i] = *(const v4u*)(p + CB_K); }
#pragma unroll
        for (int i = 0; i < 4; ++i) { const int i4 = F.tid + 512 * i, t = i4 >> 5, d4 = (i4 & 31) * 4;
#pragma unroll
            for (int e = 0; e < 4; ++e) Lb[t * 129 + d4 + e] = lg[i][e]; }
        __syncthreads();
        if (F.tid < 128) { float a[64];
#pragma unroll
            for (int t = 0; t < 64; ++t) a[t] = Lb[t * 129 + F.tid];
#pragma unroll
            for (int t = 1; t < 64; ++t) a[t] += a[t - 1];
#pragma unroll
            for (int t = 0; t < 64; ++t) Lb[t * 129 + F.tid] = a[t];
            EBL[(size_t)u * 128 + F.tid] = __expf(a[63]); }
        __syncthreads();
#pragma unroll
        for (int i = 0; i < 2; ++i) { const int i8 = F.tid + 512 * i, t = i8 >> 4, d8 = (i8 & 15) * 8; float q[8], k[8], qo[8]; unpack8(qv[i], q); unpack8(kv[i], k);
#pragma unroll
            for (int e = 0; e < 8; ++e) { const int d = d8 + e; const float bt = Lb[t * 129 + d], bl = Lb[63 * 129 + d];
                const float qd = q[e] * 0.08838834764831845f * __expf(bt); Qd[t * 129 + d] = qd; Ki[t * 129 + d] = k[e] * __expf(-bt); Kt[d * 72 + t] = (bf16)f2bf(k[e] * __expf(bl - bt)); qo[e] = qd; }
            *(v4u*)(QDEC + ((size_t)u * 64 + t) * 128 + d8) = pack8(qo); }
        __syncthreads();
#pragma unroll
        for (int i = 0; i < 2; ++i) { const int c_ = F.tid + 512 * i, row = c_ >> 3, ch = c_ & 7; const LAS v2u* sp = (const LAS v2u*)(Kt + row * 72 + ch * 8); const v2u a = sp[0], bb = sp[1];
            *(v4u*)(KDT + ((size_t)u * 128 + row) * 64 + ch * 8) = (v4u){a.x, a.y, bb.x, bb.y}; }
        {
          const int n = F.lane & 15, gq = F.lane >> 4, ct = F.wave >> 1, st0 = 2 * (F.wave & 1);
          f32x4 c0 = (f32x4){0.f, 0.f, 0.f, 0.f}, c1 = (f32x4){0.f, 0.f, 0.f, 0.f};
          if (st0 <= ct) {
              const LAS float* ap = Qd + (16 * ct + n) * 129 + gq; const LAS float* bp0 = Ki + (16 * st0 + n) * 129 + gq; const LAS float* bp1 = bp0 + 16 * 129;
#pragma unroll 8
              for (int ks = 0; ks < 32; ++ks) { const float av = ap[4 * ks]; c0 = __builtin_amdgcn_mfma_f32_16x16x4f32(av, bp0[4 * ks], c0, 0, 0, 0); c1 = __builtin_amdgcn_mfma_f32_16x16x4f32(av, bp1[4 * ks], c1, 0, 0, 0); } }
#pragma unroll
          for (int rr = 0; rr < 4; ++rr) { const int c = 16 * ct + 4 * gq + rr, s0 = 16 * st0 + n, s1 = s0 + 16;
              bf16* op = AMg + ((size_t)u * 64 + c) * 64; op[s0] = (bf16)f2bf(s0 <= c ? c0[rr] : 0.f); op[s1] = (bf16)f2bf(s1 <= c ? c1[rr] : 0.f); } }
    }
}
template <int PASS> __device__ __forceinline__ void prep_vt(Frame& F) {
    LAS bf16* T = (LAS bf16*)(F.lds + RING_OFF);
    const bf16* COLS = WSP(bf16, WS_COLS);
    constexpr int ncol = PASS == 4 ? 128 : 512, nch = ncol >> 3, NI = 64 * nch / (NWAVES * 64);
    constexpr int col0 = PASS < 2 ? CA_V + 512 * PASS : (PASS < 4 ? CB_V + 512 * (PASS - 2) : CD_V);
    bf16* dst0 = PASS < 2 ? WSP(bf16, WS_VTA) + (size_t)(512 * PASS) * VROW : (PASS < 4 ? WSP(bf16, WS_VTB) + (size_t)(512 * (PASS - 2)) * VROW : WSP(bf16, WS_VTD));
    constexpr int rows_b = PASS == 4 ? 128 : 1024;
    for (int tile = F.bx; tile < M / 64; tile += F.G) {
        const int b = tile >> 7, t0 = (tile & 127) * 64;
        __syncthreads();
        v4u v[NI];
#pragma unroll
        for (int i = 0; i < NI; ++i) { const int idx = F.tid + NWAVES * 64 * i, tok = idx / nch, ch = idx % nch; v[i] = *(const v4u*)(COLS + (size_t)(b * SEQ + t0 + tok) * NMAIN + col0 + ch * 8); }
#pragma unroll
        for (int i = 0; i < NI; ++i) { const int idx = F.tid + NWAVES * 64 * i, tok = idx / nch, ch = idx % nch; LAS unsigned* d = (LAS unsigned*)(T + tok * 522 + ch * 8); d[0] = v[i].x; d[1] = v[i].y; d[2] = v[i].z; d[3] = v[i].w; }
        __syncthreads();
#pragma unroll
        for (int i = 0; i < NI; ++i) { const int idx = F.tid + NWAVES * 64 * i, vrow = idx >> 3, ch = idx & 7;
            unsigned e[8];
#pragma unroll
            for (int k = 0; k < 8; ++k) e[k] = T[(ch * 8 + k) * 522 + vrow];
            v4u o; o.x = e[0] | (e[1] << 16); o.y = e[2] | (e[3] << 16); o.z = e[4] | (e[5] << 16); o.w = e[6] | (e[7] << 16);
            *(v4u*)(dst0 + ((size_t)b * rows_b + vrow) * VROW + t0 + ch * 8) = o; }
    }
}
typedef float f32x4v __attribute__((ext_vector_type(4)));
__device__ __forceinline__ float sum16(float v) { v = sum8(v); v += dpp_f<0x140>(v); return v; }
#define LDS_BARRIER() asm volatile("s_waitcnt lgkmcnt(0)\n\ts_barrier" ::: "memory")
template <int HACK = 0> __device__ __forceinline__ void gla_scan_unit(Frame& F, int l, int b, int h, int vh) {
    LAS unsigned char* L = F.lds + RING_OFF;
    constexpr int OQD = 0, OKT = 17408, OAM = 35840, OVT = 45056, OOT = 63488, OEB = 80896, OPS = 81408;
    const int tid = F.tid, lane = F.lane, n = lane & 15, g = lane >> 4, w = F.wave;
    const bf16* QDEC = WSP(bf16, WS_QDEC); const bf16* KDT = WSP(bf16, WS_KDT); const bf16* AMg = WSP(bf16, WS_AM); const float* EBL = WSP(float, WS_EBL);
    const bf16* VTB = WSP(bf16, WS_VTB) + (size_t)((b * 4 + h) * 256 + 128 * vh) * VROW; bf16* OB = WSP(bf16, WS_OB); float* PSG = WSP(float, WS_PSG);
    f32x4v S[8];
#pragma unroll
    for (int dt = 0; dt < 8; ++dt) S[dt] = (f32x4v){0.f, 0.f, 0.f, 0.f};
    v4u pq[2], pk[2], pa, pv[2]; float pe = 0.f;
#define GL_ISSUE(CK) do { const size_t u_ = (size_t)(b * 4 + h) * 128 + (CK); \
        _Pragma("unroll") for (int i = 0; i < 2; ++i) { const int c_ = tid + 512 * i; pq[i] = *(const v4u*)(QDEC + (u_ * 64 + (c_ >> 4)) * 128 + (c_ & 15) * 8); pk[i] = *(const v4u*)(KDT + (u_ * 128 + (c_ >> 3)) * 64 + (c_ & 7) * 8); \
            pv[i] = *(const v4u*)(VTB + (size_t)(c_ >> 3) * VROW + (CK) * 64 + (c_ & 7) * 8); } \
        pa = *(const v4u*)(AMg + (u_ * 64 + (tid >> 3)) * 64 + (tid & 7) * 8); \
        pe = EBL[u_ * 128 + (tid & 127)]; } while (0)
#define GL_WRITE() do { _Pragma("unroll") for (int i = 0; i < 2; ++i) { const int c_ = tid + 512 * i; *(LAS v4u*)(L + OQD + (c_ >> 4) * 272 + (c_ & 15) * 16) = pq[i]; *(LAS v4u*)(L + OKT + (c_ >> 3) * 144 + (c_ & 7) * 16) = pk[i]; \
            *(LAS v4u*)(L + OVT + (c_ >> 3) * 144 + (c_ & 7) * 16) = pv[i]; } \
        *(LAS v4u*)(L + OAM + (tid >> 3) * 144 + (tid & 7) * 16) = pa; \
        ((LAS float*)(L + OEB))[tid & 127] = pe; } while (0)
    GL_ISSUE(0); GL_WRITE();
    LDS_BARRIER();
#pragma unroll 1
    for (int ck = 0; ck < 128; ++ck) {
        const size_t row0 = (size_t)b * SEQ + ck * 64;
        GL_ISSUE((HACK & 1) && ck >= 2 ? 2 : (ck + 1 < 128 ? ck + 1 : 127));
        bf16x8 vf[2];
#pragma unroll
        for (int ks = 0; ks < 2; ++ks) vf[ks] = *(const LAS bf16x8*)(L + OVT + (16 * w + n) * 144 + (32 * ks + 8 * g) * 2);
        f32x4v o[4];
#pragma unroll
        for (int ct = 0; ct < 4; ++ct) o[ct] = (f32x4v){0.f, 0.f, 0.f, 0.f};
#pragma unroll
        for (int ct = 0; ct < 4; ++ct)
#pragma unroll
            for (int ks = 0; ks < 2; ++ks) { const bf16x8 af = *(const LAS bf16x8*)(L + OAM + (16 * ct + n) * 144 + (32 * ks + 8 * g) * 2); o[ct] = __builtin_amdgcn_mfma_f32_16x16x32_bf16(af, vf[ks], o[ct], 0, 0, 0); }
#pragma unroll
        for (int kk = 0; kk < 4; ++kk) { v4u pw; pw.x = pg8::cvt_pk_bf16(S[2 * kk][0], S[2 * kk][1]); pw.y = pg8::cvt_pk_bf16(S[2 * kk][2], S[2 * kk][3]);
            pw.z = pg8::cvt_pk_bf16(S[2 * kk + 1][0], S[2 * kk + 1][1]); pw.w = pg8::cvt_pk_bf16(S[2 * kk + 1][2], S[2 * kk + 1][3]); const bf16x8 sf = __builtin_bit_cast(bf16x8, pw);
#pragma unroll
            for (int ct = 0; ct < 4; ++ct) { const LAS unsigned char* qp = L + OQD + (16 * ct + n) * 272 + (32 * kk + 4 * g) * 2; const v2u qa = *(const LAS v2u*)qp, qb = *(const LAS v2u*)(qp + 32);
                o[ct] = __builtin_amdgcn_mfma_f32_16x16x32_bf16(__builtin_bit_cast(bf16x8, (v4u){qa.x, qa.y, qb.x, qb.y}), sf, o[ct], 0, 0, 0); } }
#pragma unroll
        for (int dt = 0; dt < 8; ++dt) { const f32x4v eb = *(const LAS f32x4v*)(L + OEB + (16 * dt + 4 * g) * 4); S[dt] = S[dt] * eb;
#pragma unroll
            for (int ks = 0; ks < 2; ++ks) { const bf16x8 kf = *(const LAS bf16x8*)(L + OKT + (16 * dt + n) * 144 + (32 * ks + 8 * g) * 2); S[dt] = __builtin_amdgcn_mfma_f32_16x16x32_bf16(kf, vf[ks], S[dt], 0, 0, 0); } }
        LAS float* PS = (LAS float*)(L + OPS) + (ck & 1) * 512;
#pragma unroll
        for (int ct = 0; ct < 4; ++ct)
#pragma unroll
            for (int r = 0; r < 4; ++r) { const float ss = sum16(o[ct][r] * o[ct][r]); if (n == 0) PS[(16 * ct + 4 * g + r) * 8 + w] = ss;
                *(LAS bf16*)(L + OOT + (16 * ct + 4 * g + r) * 272 + (16 * w + n) * 2) = (bf16)f2bf(o[ct][r]); }
        LDS_BARRIER();
        GL_WRITE();
        if (!(HACK & 2)) {
#pragma unroll
        for (int i = 0; i < 2; ++i) { const int c_ = tid + 512 * i, tok = c_ >> 4, ch = c_ & 15; *(v4u*)(OB + (row0 + tok) * 1024 + h * 256 + 128 * vh + ch * 8) = *(const LAS v4u*)(L + OOT + tok * 272 + ch * 16); }
        if (tid < 64) { const LAS f32x4v* pp = (const LAS f32x4v*)(PS + tid * 8); const f32x4v p0 = pp[0], p1 = pp[1]; PSG[(row0 + tid) * 8 + h * 2 + vh] = ((p0.x + p0.y) + (p0.z + p0.w)) + ((p1.x + p1.y) + (p1.z + p1.w)); } }
        LDS_BARRIER();
    }
#undef GL_ISSUE
#undef GL_WRITE
}
__device__ __forceinline__ void gla_post(Frame& F, int l) {
    const bf16* OB = WSP(bf16, WS_OB); const float* PSG = WSP(float, WS_PSG); const bf16* COLS = WSP(bf16, WS_COLS); bf16* MIX = WSP(bf16, WS_MIXED);
    const int ch = F.tid & 127, h = ch >> 5; float gain8[8];
#pragma unroll
    for (int e = 0; e < 8; ++e) gain8[e] = F.kin[I_GON][l * 256 + (ch & 31) * 8 + e];
    for (int row0 = F.bx * 4 + (F.tid >> 7); row0 < M; row0 += F.G * 16) {
        v4u ovr[4], gvr[4]; f32x2_t ps[4];
#pragma unroll
        for (int i = 0; i < 4; ++i) { const int row = row0 + F.G * 4 * i < M ? row0 + F.G * 4 * i : row0;
            ovr[i] = *(const v4u*)(OB + (size_t)row * 1024 + ch * 8); gvr[i] = *(const v4u*)(COLS + (size_t)row * NMAIN + CB_G + ch * 8); ps[i] = *(const f32x2_t*)(PSG + (size_t)row * 8 + h * 2); }
#pragma unroll
        for (int i = 0; i < 4; ++i) { const int row = row0 + F.G * 4 * i; float ov[8], gv[8]; unpack8(ovr[i], ov); unpack8(gvr[i], gv);
            const float rstd = rsqrtf((ps[i].x + ps[i].y) * (1.0f / 256.0f) + 1e-6f);
#pragma unroll
            for (int e = 0; e < 8; ++e) ov[e] = ov[e] * (rstd * gain8[e]) * silu_g(gv[e]);
            if (row < M) *(v4u*)(MIX + (size_t)row * DM + 1024 + ch * 8) = pack8(ov); }
    }
}
constexpr int RC_AT = 0, RC_RT = 2048, RC_BK = 4096, RC_VF = 8192, RC_GF = 10240, RC_U0 = 12288, RC_Y0 = 16384, RC_P15 = 20480, RC_BN = 20736, RC_BYTES = 20800;
__device__ __forceinline__ void rwkv_chunks_of_tile(Frame& F, int l, int tile) {
    const int team = F.tid >> 8, tt = F.tid & 255;
    LAS float* Lt = (LAS float*)(F.lds + RING_OFF) + team * 12288;
    LAS float* XA = Lt; LAS float* XR = Lt + 1040; LAS float* ZB = Lt + 2080; LAS float* ZK = Lt + 3120; LAS float* TB = Lt + 4160; LAS float* TK = Lt + 5200; LAS float* VV = Lt + 6240;
    LAS float* ATl = Lt + 7280; LAS float* U0l = Lt + 8320; LAS float* W1 = Lt + 9360;
    LAS float* Aab = Lt + 10400; LAS float* Aak = Lt + 10672; LAS float* Arb = Lt + 10944; LAS float* Ark = Lt + 11216; LAS float* TT = Lt + 11488;
    const float* RW = WSP(float, WS_RW); const unsigned* RWU = WSP(unsigned, WS_RW); constexpr size_t RS = RW_ONE / 4; unsigned char* RWC = F.ws + WS_RWC;
    float pw_[6], pr_[4], pk_[4], pv_[4], pa_[4], pb_[4], pg_[4];
#define RC_FETCH(P) do { const int h_ = 2 * (P) + team; const size_t cb_ = (size_t)tile * 16 * 1024 + h_ * 64 + (tt & 63); const int q_ = tt >> 6; \
        pw_[4] = RW[RS + cb_ + (size_t)(q_ ? 4 * q_ - 1 : 0) * 1024]; pw_[5] = RW[RS + cb_ + (size_t)15 * 1024];            \
        _Pragma("unroll") for (int e = 0; e < 4; ++e) { const size_t o_ = cb_ + (size_t)(4 * q_ + e) * 1024; pw_[e] = RW[RS + o_]; const unsigned u0 = RWU[o_], u2 = RWU[2 * RS + o_], u3 = RWU[3 * RS + o_]; \
            pr_[e] = bflo(u0); pk_[e] = bfhi(u0); pv_[e] = bflo(u2); pg_[e] = bfhi(u2); pa_[e] = bflo(u3); pb_[e] = bfhi(u3); } } while (0)
    RC_FETCH(0);
#pragma unroll 1
    for (int pair = 0; pair < 8; ++pair) {
        const int uc = ((tile >> 9) * 16 + 2 * pair + team) * 512 + (tile & 511), b = uc >> 13, h = (uc >> 9) & 15, ck = uc & 511; unsigned char* rec = RWC + ((size_t)ck * 32 + (uc >> 9)) * RC_BYTES;     (void)b;
        __syncthreads();
        {
          const int j = tt & 63, q = tt >> 6;
          const float cl = pw_[5], clm = q ? pw_[4] : 0.f; const float clq[4] = {pw_[0], pw_[1], pw_[2], pw_[3]};
#pragma unroll
          for (int e = 0; e < 4; ++e) { const int t = 4 * q + e; const float cprev = e == 0 ? clm : clq[e - 1], cc = clq[e];
              const float rr = pr_[e], kk = pk_[e], vv = pv_[e], aa = pa_[e], bb = pb_[e];
              XA[t * 65 + j] = aa * __expf(cprev); XR[t * 65 + j] = rr * __expf(cc); const float ei = __expf(-cc), ef = __expf(cl - cc);
              ZB[t * 65 + j] = bb * ei; ZK[t * 65 + j] = kk * ei; TB[t * 65 + j] = bb * ef; TK[t * 65 + j] = kk * ef; VV[t * 65 + j] = vv; }
          if (q == 0) ((float*)(rec + RC_P15))[j] = __expf(cl);
          { v2u gw; gw.x = pk2(pg_[0], pg_[1]); gw.y = pk2(pg_[2], pg_[3]); *(v2u*)(rec + RC_GF + (((j >> 4) * 64 + 16 * q + (j & 15)) * 8)) = gw; } }
        RC_FETCH(pair < 7 ? pair + 1 : 7);
        __syncthreads();
        {
          const int q = tt >> 6, n = tt & 15, g = (tt >> 4) & 3; const LAS float* X = (q & 2) ? XR : XA; const LAS float* Z = (q & 1) ? ZK : ZB; LAS float* O = q == 0 ? Aab : (q == 1 ? Aak : (q == 2 ? Arb : Ark));
          f32x4v c = (f32x4v){0.f, 0.f, 0.f, 0.f};
#pragma unroll
          for (int ks = 0; ks < 16; ++ks) c = __builtin_amdgcn_mfma_f32_16x16x4f32(X[n * 65 + 4 * ks + g], Z[n * 65 + 4 * ks + g], c, 0, 0, 0);
#pragma unroll
          for (int rr = 0; rr < 4; ++rr) { const int t = 4 * g + rr; O[t * 17 + n] = ((q & 2) ? n <= t : n < t) ? c[rr] : 0.f; }
          { const int t = tt >> 4, jq = tt & 15; const float* rkp = F.kin[I_RRK] + l * 1024 + h * 64 + 4 * jq; float bn = 0.f;
#pragma unroll
            for (int e = 0; e < 4; ++e) bn += XR[t * 65 + 4 * jq + e] * ZK[t * 65 + 4 * jq + e] * rkp[e];
            bn = sum16(bn); if (jq == 0) ((float*)(rec + RC_BN))[t] = bn; } }
        __syncthreads();
        {
          if (tt < 16) { float col[16];
#pragma unroll
              for (int t = 0; t < 16; ++t) { float acc = (t == tt) ? 1.f : 0.f;
#pragma unroll
                  for (int s = 0; s < 16; ++s) if (s < t) acc += Aab[t * 17 + s] * col[s];
                  col[t] = acc; TT[t * 17 + tt] = acc; } }
          const int q = tt >> 6, n = tt & 15, g = (tt >> 4) & 3; f32x4v c = (f32x4v){0.f, 0.f, 0.f, 0.f};
#pragma unroll
          for (int ks = 0; ks < 4; ++ks) c = __builtin_amdgcn_mfma_f32_16x16x4f32(Aak[n * 17 + 4 * ks + g], VV[(4 * ks + g) * 65 + 16 * q + n], c, 0, 0, 0);
#pragma unroll
          for (int rr = 0; rr < 4; ++rr) W1[(4 * g + rr) * 65 + 16 * q + n] = c[rr]; }
        __syncthreads();
        {
          const int q = tt >> 6, n = tt & 15, g = (tt >> 4) & 3; f32x4v ca = (f32x4v){0.f, 0.f, 0.f, 0.f}, cu = (f32x4v){0.f, 0.f, 0.f, 0.f};
#pragma unroll
          for (int ks = 0; ks < 4; ++ks) { const float tv = TT[n * 17 + 4 * ks + g]; ca = __builtin_amdgcn_mfma_f32_16x16x4f32(tv, XA[(4 * ks + g) * 65 + 16 * q + n], ca, 0, 0, 0); cu = __builtin_amdgcn_mfma_f32_16x16x4f32(tv, W1[(4 * ks + g) * 65 + 16 * q + n], cu, 0, 0, 0); }
#pragma unroll
          for (int rr = 0; rr < 4; ++rr) { ATl[(4 * g + rr) * 65 + 16 * q + n] = ca[rr]; U0l[(4 * g + rr) * 65 + 16 * q + n] = cu[rr]; }
          *(f32x4v*)(rec + RC_U0 + ((q * 64 + 16 * g + n) * 16)) = cu; }
        __syncthreads();
        {
          const int q = tt >> 6, n = tt & 15, g = (tt >> 4) & 3; f32x4v cr, cy = (f32x4v){0.f, 0.f, 0.f, 0.f};
#pragma unroll
          for (int rr = 0; rr < 4; ++rr) cr[rr] = XR[(4 * g + rr) * 65 + 16 * q + n];
#pragma unroll
          for (int ks = 0; ks < 4; ++ks) { const float arb = Arb[n * 17 + 4 * ks + g], ark = Ark[n * 17 + 4 * ks + g];
              cr = __builtin_amdgcn_mfma_f32_16x16x4f32(arb, ATl[(4 * ks + g) * 65 + 16 * q + n], cr, 0, 0, 0);
              cy = __builtin_amdgcn_mfma_f32_16x16x4f32(arb, U0l[(4 * ks + g) * 65 + 16 * q + n], cy, 0, 0, 0);
              cy = __builtin_amdgcn_mfma_f32_16x16x4f32(ark, VV[(4 * ks + g) * 65 + 16 * q + n], cy, 0, 0, 0); }
          *(f32x4v*)(rec + RC_Y0 + ((q * 64 + 16 * g + n) * 16)) = cy;
#pragma unroll
          for (int rr = 0; rr < 4; ++rr) W1[(4 * g + rr) * 65 + 16 * q + n] = cr[rr]; }
        __syncthreads();
        { const int t = tt & 15, jq = tt >> 4, kk = jq >> 3, half = (jq & 7) >> 2, g = jq & 3, j0 = 4 * jq;
          v2u wa, wr; wa.x = pk2(ATl[t * 65 + j0], ATl[t * 65 + j0 + 1]); wa.y = pk2(ATl[t * 65 + j0 + 2], ATl[t * 65 + j0 + 3]); wr.x = pk2(W1[t * 65 + j0], W1[t * 65 + j0 + 1]); wr.y = pk2(W1[t * 65 + j0 + 2], W1[t * 65 + j0 + 3]);
          *(v2u*)(rec + RC_AT + kk * 1024 + (16 * g + t) * 16 + half * 8) = wa; *(v2u*)(rec + RC_RT + kk * 1024 + (16 * g + t) * 16 + half * 8) = wr;
          const int j = tt & 63, gg = tt >> 6; v4u bk; bk.x = pk2(TB[(4 * gg) * 65 + j], TB[(4 * gg + 1) * 65 + j]); bk.y = pk2(TB[(4 * gg + 2) * 65 + j], TB[(4 * gg + 3) * 65 + j]);
          bk.z = pk2(TK[(4 * gg) * 65 + j], TK[(4 * gg + 1) * 65 + j]); bk.w = pk2(TK[(4 * gg + 2) * 65 + j], TK[(4 * gg + 3) * 65 + j]);
          *(v4u*)(rec + RC_BK + (j >> 4) * 1024 + (16 * gg + (j & 15)) * 16) = bk;
          v2u vf; vf.x = pk2(VV[(4 * gg) * 65 + j], VV[(4 * gg + 1) * 65 + j]); vf.y = pk2(VV[(4 * gg + 2) * 65 + j], VV[(4 * gg + 3) * 65 + j]);
          *(v2u*)(rec + RC_VF + ((j >> 4) * 64 + 16 * gg + (j & 15)) * 8) = vf; }
    }
}
#undef RC_FETCH
template <int HACK = 0> __device__ __forceinline__ void rwkv_scan_unit(Frame& F, int l, int b, int h) {
    LAS unsigned char* L = F.lds + RING_OFF;
    const unsigned char* recs = F.ws + WS_RWC + (size_t)(b * 16 + h) * RC_BYTES;
    const int lane = F.lane, n = lane & 15, g = lane >> 4;
    LAS float* XS = (LAS float*)(L + 2 * RC_BYTES);
    if (F.wave >= 2) {
        const int li = F.tid - 128;
        int px[4];
#pragma unroll
        for (int k = 0; k < 4; ++k) { const int x = li + 384 * k; px[k] = x < 1300 ? x : 1299; }
        v4u p0[4], p1[4], p2[4], p3[4], p4[4], p5[4], p6[4], p7[4];
#define RWL_ISSUE(P, CK) do { const int ck_ = (CK) < 512 ? ((HACK & 1) && (CK) >= 4 ? 3 : (CK)) : 511; const v4u* src_ = (const v4u*)(recs + (size_t)ck_ * 32 * RC_BYTES); \
        _Pragma("unroll") for (int k = 0; k < 4; ++k) P[k] = src_[px[k]]; } while (0)
#define RWL_WRITE(P, CK) do { LAS v4u* dst_ = (LAS v4u*)(L + ((CK) & 1) * RC_BYTES); _Pragma("unroll") for (int k = 0; k < 4; ++k) dst_[px[k]] = P[k]; } while (0)
        RWL_ISSUE(p0, 0); RWL_ISSUE(p1, 1); RWL_ISSUE(p2, 2); RWL_ISSUE(p3, 3); RWL_ISSUE(p4, 4); RWL_ISSUE(p5, 5); RWL_ISSUE(p6, 6); RWL_ISSUE(p7, 7);
        RWL_WRITE(p0, 0); RWL_ISSUE(p0, 8);
        LDS_BARRIER();
#pragma unroll 1
        for (int ck = 0; ck < 512; ck += 8) {
            RWL_WRITE(p1, ck + 1); RWL_ISSUE(p1, ck + 9); LDS_BARRIER();
            RWL_WRITE(p2, ck + 2); RWL_ISSUE(p2, ck + 10); LDS_BARRIER();
            RWL_WRITE(p3, ck + 3); RWL_ISSUE(p3, ck + 11); LDS_BARRIER();
            RWL_WRITE(p4, ck + 4); RWL_ISSUE(p4, ck + 12); LDS_BARRIER();
            RWL_WRITE(p5, ck + 5); RWL_ISSUE(p5, ck + 13); LDS_BARRIER();
            RWL_WRITE(p6, ck + 6); RWL_ISSUE(p6, ck + 14); LDS_BARRIER();
            RWL_WRITE(p7, ck + 7); RWL_ISSUE(p7, ck + 15); LDS_BARRIER();
            RWL_WRITE(p0, ck + 8); RWL_ISSUE(p0, ck + 16); LDS_BARRIER();
        }
#undef RWL_ISSUE
#undef RWL_WRITE
        return;
    }
    const int cw = F.wave;
    f32x4v S[4][2];
#pragma unroll
    for (int jt = 0; jt < 4; ++jt)
#pragma unroll
        for (int it = 0; it < 2; ++it) S[jt][it] = (f32x4v){0.f, 0.f, 0.f, 0.f};
    float lnw[2], lnb[2];
#pragma unroll
    for (int it = 0; it < 2; ++it) { lnw[it] = F.kin[I_RLNW][l * 1024 + h * 64 + 16 * (2 * cw + it) + n]; lnb[it] = F.kin[I_RLNB][l * 1024 + h * 64 + 16 * (2 * cw + it) + n]; }
    bf16* MIX = WSP(bf16, WS_MIXED) + ((size_t)b * SEQ) * DM + 2048 + h * 64 + 32 * cw + n;
    f32x4v Yp[2] = {(f32x4v){0.f, 0.f, 0.f, 0.f}, (f32x4v){0.f, 0.f, 0.f, 0.f}}, bnp = (f32x4v){0.f, 0.f, 0.f, 0.f}; v2u gfp[2] = {(v2u){0u, 0u}, (v2u){0u, 0u}}, vfp[2] = {(v2u){0u, 0u}, (v2u){0u, 0u}};
    LDS_BARRIER();
#pragma unroll 1
    for (int ck = 0; ck <= 512; ++ck) {
        if (ck > 0) {
            const LAS float* xs = XS + ((ck - 1) & 1) * 64; const f32x4v a0 = *(const LAS f32x4v*)(xs + 8 * g), a1 = *(const LAS f32x4v*)(xs + 8 * g + 4), b0 = *(const LAS f32x4v*)(xs + 32 + 8 * g), b1 = *(const LAS f32x4v*)(xs + 32 + 8 * g + 4);
            const float s1[4] = {a0[0] + b0[0], a0[2] + b0[2], a1[0] + b1[0], a1[2] + b1[2]}, s2[4] = {a0[1] + b0[1], a0[3] + b0[3], a1[1] + b1[1], a1[3] + b1[3]};
#pragma unroll
            for (int it = 0; it < 2; ++it) { const float gt[4] = {bflo(gfp[it].x), bfhi(gfp[it].x), bflo(gfp[it].y), bfhi(gfp[it].y)}, vt[4] = {bflo(vfp[it].x), bfhi(vfp[it].x), bflo(vfp[it].y), bfhi(vfp[it].y)};
#pragma unroll
                for (int r = 0; r < 4; ++r) { const float mean = s1[r] * (1.0f / 64.0f), var = fmaxf(s2[r] * (1.0f / 64.0f) - mean * mean, 0.f), rstd = rsqrtf(var + 64e-5f);
                    if (!(HACK & 2)) MIX[(size_t)((ck - 1) * 16 + 4 * g + r) * DM + 16 * it] = (bf16)f2bf(((Yp[it][r] - mean) * rstd * lnw[it] + lnb[it] + bnp[r] * vt[r]) * gt[r]); } }
            if (ck == 512) break;
        }
        if (HACK & 4) { LDS_BARRIER(); continue; }
        const LAS unsigned char* R = L + (ck & 1) * RC_BYTES;
        bf16x8 at[2], rt[2];
#pragma unroll
        for (int kk = 0; kk < 2; ++kk) { at[kk] = *(const LAS bf16x8*)(R + RC_AT + kk * 1024 + lane * 16); rt[kk] = *(const LAS bf16x8*)(R + RC_RT + kk * 1024 + lane * 16); }
        f32x4v U[2], Y[2];
#pragma unroll
        for (int it = 0; it < 2; ++it) { U[it] = *(const LAS f32x4v*)(R + RC_U0 + (2 * cw + it) * 1024 + lane * 16); Y[it] = *(const LAS f32x4v*)(R + RC_Y0 + (2 * cw + it) * 1024 + lane * 16); }
#pragma unroll
        for (int kk = 0; kk < 2; ++kk)
#pragma unroll
            for (int it = 0; it < 2; ++it) { v4u pw; pw.x = pg8::cvt_pk_bf16(S[2 * kk][it][0], S[2 * kk][it][1]); pw.y = pg8::cvt_pk_bf16(S[2 * kk][it][2], S[2 * kk][it][3]);
                pw.z = pg8::cvt_pk_bf16(S[2 * kk + 1][it][0], S[2 * kk + 1][it][1]); pw.w = pg8::cvt_pk_bf16(S[2 * kk + 1][it][2], S[2 * kk + 1][it][3]); const bf16x8 sf = __builtin_bit_cast(bf16x8, pw);
                U[it] = __builtin_amdgcn_mfma_f32_16x16x32_bf16(at[kk], sf, U[it], 0, 0, 0); Y[it] = __builtin_amdgcn_mfma_f32_16x16x32_bf16(rt[kk], sf, Y[it], 0, 0, 0); }
        bf16x8 uv[2];
#pragma unroll
        for (int it = 0; it < 2; ++it) { vfp[it] = *(const LAS v2u*)(R + RC_VF + (2 * cw + it) * 512 + lane * 8); gfp[it] = *(const LAS v2u*)(R + RC_GF + (2 * cw + it) * 512 + lane * 8);
            v4u pw; pw.x = pg8::cvt_pk_bf16(U[it][0], U[it][1]); pw.y = pg8::cvt_pk_bf16(U[it][2], U[it][3]); pw.z = vfp[it].x; pw.w = vfp[it].y; uv[it] = __builtin_bit_cast(bf16x8, pw); }
#pragma unroll
        for (int jt = 0; jt < 4; ++jt) { const bf16x8 bk = *(const LAS bf16x8*)(R + RC_BK + jt * 1024 + lane * 16); const f32x4v p15 = *(const LAS f32x4v*)(R + RC_P15 + (16 * jt + 4 * g) * 4);
#pragma unroll
            for (int it = 0; it < 2; ++it) S[jt][it] = __builtin_amdgcn_mfma_f32_16x16x32_bf16(bk, uv[it], S[jt][it] * p15, 0, 0, 0); }
        bnp = *(const LAS f32x4v*)(R + RC_BN + 16 * g); Yp[0] = Y[0]; Yp[1] = Y[1];
        { LAS float* xo = XS + (ck & 1) * 64 + cw * 32; const f32x4v sm = Y[0] + Y[1], sq = Y[0] * Y[0] + Y[1] * Y[1];
#pragma unroll
          for (int r = 0; r < 4; ++r) { const float a = sum16(sm[r]), q = sum16(sq[r]); if (n == 0) { xo[(4 * g + r) * 2] = a; xo[(4 * g + r) * 2 + 1] = q; } } }
        LDS_BARRIER();
    }
}
template <int HACK = 0> __device__ __forceinline__ void mixers_v4(Frame& F, int l, int qi, int mask = 15) {
    gu32* ctr = F.ctl + CW_Q + 64 * qi;
    for (;;) {
        const int it = next_item(F, ctr); relaunder(F); relaunder_tid(F);
        if (it < 32) { if (mask & 1) rwkv_scan_unit<HACK>(F, l, it >> 4, it & 15); }
        else if (it < 48) { const int j = it - 32; if (mask & 2) gla_scan_unit<HACK>(F, l, j >> 3, (j >> 1) & 3, j & 1); }
        else if (it < 48 + 1024) { const int j = it - 48, qb = 63 - (j >> 4), bh = j & 15; if (mask & 4) attn_unit<true>(F, l, bh >> 3, bh & 7, qb); }
        else if (it < 48 + 2048) { const int j = it - 1072, qb = j & 63, bh = j >> 6; if (mask & 8) attn_unit<false>(F, l, bh >> 3, bh & 7, qb); }
        else break;
    }
}
template <int HACK = 0> __device__ __forceinline__ void prep_rwkv(Frame& F, int l) {
    LAS float* zl = (LAS float*)(F.lds + RING_OFF) + 4096;
    LAS bf16* inb = (LAS bf16*)(F.lds + RING_OFF);
    const float* mu = F.kin[I_RMU] + (size_t)l * 3264;
    const float* LOWR = WSP(float, WS_LOWR); const bf16* COLS = WSP(bf16, WS_COLS);
    float* RW = WSP(float, WS_RW); unsigned* RWU = WSP(unsigned, WS_RW); float* VF = WSP(float, WS_VFIRST);
    constexpr size_t RS = RW_ONE / 4;
    for (int tile = F.bx; tile < M / 16; tile += F.G) {
        const int row0 = tile * 16;
        relaunder(F); relaunder_tid(F);
        __syncthreads();
        {
            float cur_[7], prv_[7], mu_[7];
#pragma unroll
            for (int q = 0; q < 7; ++q) { const int idx = F.tid + NWAVES * 64 * q, tt = idx / 224, j = idx % 224, row = row0 + tt;
                const int col = j < 192 ? 16 + j : 208 + (j - 192);
                const float* mp = j < 192 ? mu + 3072 + j : F.kin[I_VRMU] + (l ? (l - 1) * 32 : 0) + (j - 192);
                cur_[q] = LOWR[(size_t)row * 256 + col]; prv_[q] = LOWR[(size_t)((row & (SEQ - 1)) ? row - 1 : row) * 256 + col]; mu_[q] = *mp; }
#pragma unroll
            for (int q = 0; q < 7; ++q) { const int idx = F.tid + NWAVES * 64 * q, tt = idx / 224, j = idx % 224, row = row0 + tt;
                const float prev = (row & (SEQ - 1)) ? prv_[q] : 0.f, muv = (j >= 192 && l == 0) ? 0.f : mu_[q];
                float x = cur_[q] + (prev - cur_[q]) * muv;
                if (j < 64) x = tanhf(x); else if (j >= 128 && j < 192) x = sigmoid_f(x);
                inb[tt * 232 + j] = (bf16)f2bf(x); } }
        __syncthreads();
        {
            const int c = 2 * F.tid;
            float accw[2][16], acca[2][16], accg[2][16], accv[2][16];
#pragma unroll
            for (int e = 0; e < 2; ++e) { const float bw = F.kin[I_RW0][l * 1024 + c + e], ba = F.kin[I_RA0][l * 1024 + c + e], bv = l ? F.kin[I_VR0][(l - 1) * 1024 + c + e] : 0.f;
#pragma unroll
              for (int tt = 0; tt < 16; ++tt) { accw[e][tt] = bw; acca[e][tt] = ba; accg[e][tt] = 0.f; accv[e][tt] = bv; } }
#define LOWRANK_MFMA(ACC, MI, JOFF, NKS) do { const bf16* wf_ = WSP(bf16, WS_WF) + ((size_t)(l * 448 + ((MI) < 3 ? (MI) * 128 + 16 * (NKS) / 2 * F.wave : 384 + 8 * F.wave)) * 64 + F.lane) * 8; \
            bf16x8 af_[NKS], bf_[8][NKS]; \
            _Pragma("unroll") for (int ks = 0; ks < (NKS); ++ks) af_[ks] = *(const LAS bf16x8*)(inb + (F.lane & 15) * 232 + (JOFF) + 32 * ks + 8 * (F.lane >> 4)); \
            _Pragma("unroll") for (int nt = 0; nt < 8; ++nt) _Pragma("unroll") for (int ks = 0; ks < (NKS); ++ks) bf_[nt][ks] = *(const bf16x8*)(wf_ + (size_t)(nt * (NKS) + ks) * 512); \
            _Pragma("unroll") for (int nt = 0; nt < 8; ++nt) { f32x4 c4 = {0.f, 0.f, 0.f, 0.f}; \
                _Pragma("unroll") for (int ks = 0; ks < (NKS); ++ks) c4 = __builtin_amdgcn_mfma_f32_16x16x32_bf16(af_[ks], bf_[nt][ks], c4, 0, 0, 0); \
                _Pragma("unroll") for (int rr = 0; rr < 4; ++rr) zl[(4 * (F.lane >> 4) + rr) * 1028 + 128 * F.wave + 16 * nt + (F.lane & 15)] = c4[rr]; } \
            __syncthreads(); \
            _Pragma("unroll") for (int tt = 0; tt < 16; ++tt) { const f32x2_t z2 = *(const LAS f32x2_t*)(zl + tt * 1028 + c); ACC[0][tt] += z2.x; ACC[1][tt] += z2.y; } \
            __syncthreads(); } while (0)
            if (!(HACK & 1)) { LOWRANK_MFMA(accw, 0, 0, 2); relaunder(F);
            LOWRANK_MFMA(acca, 1, 64, 2); relaunder(F);
            LOWRANK_MFMA(accg, 2, 128, 2); relaunder(F);
            if (l) LOWRANK_MFMA(accv, 3, 192, 1); }
#undef LOWRANK_MFMA
            relaunder(F);
            float mur[2], muk[2], muv[2], kkv[2], kav[2], pr[2] = {0.f, 0.f}, pk[2] = {0.f, 0.f}, pv[2] = {0.f, 0.f}; float cl[2] = {0.f, 0.f};
#pragma unroll
            for (int e = 0; e < 2; ++e) { mur[e] = F.kin[I_RMU][l * 3264 + c + e]; muk[e] = F.kin[I_RMU][l * 3264 + 1024 + c + e]; muv[e] = F.kin[I_RMU][l * 3264 + 2048 + c + e]; kkv[e] = F.kin[I_RKK][l * 1024 + c + e]; kav[e] = F.kin[I_RKA][l * 1024 + c + e]; }
            if ((row0 & (SEQ - 1)) != 0) { const bf16* p = COLS + (size_t)(row0 - 1) * NMAIN + c; const unsigned ur = *(const unsigned*)(p + CC_R), uk = *(const unsigned*)(p + CC_K), uv = *(const unsigned*)(p + CC_V);
                pr[0] = bflo(ur); pr[1] = bfhi(ur); pk[0] = bflo(uk); pk[1] = bfhi(uk); pv[0] = bflo(uv); pv[1] = bfhi(uv); }
            constexpr int PFD = 4;
            unsigned pur[16], puk[16], puv[16]; f32x2_t pvf[16];
#define PF_TOK(T) do { const bf16* p_ = COLS + (size_t)(row0 + (T)) * NMAIN + c; pur[T] = *(const unsigned*)(p_ + CC_R); puk[T] = *(const unsigned*)(p_ + CC_K); puv[T] = *(const unsigned*)(p_ + CC_V); \
                pvf[T] = *(const f32x2_t*)(VF + (size_t)(row0 + (T)) * 1024 + c); } while (0)
#pragma unroll
            for (int tt = 0; tt < PFD; ++tt) PF_TOK(tt);
            asm volatile("" ::: "memory");
            if (!(HACK & 4))
#pragma unroll
            for (int tt = 0; tt < 16; ++tt) { const int row = row0 + tt; const size_t o = (size_t)row * 1024 + c;
                if (tt + PFD < 16) { PF_TOK(tt + PFD < 16 ? tt + PFD : 15); }
                asm volatile("" ::: "memory");
                const unsigned ur = pur[tt], uk = puk[tt], uv = puv[tt];
                const float cr[2] = {bflo(ur), bfhi(ur)}, ck[2] = {bflo(uk), bfhi(uk)}, cv[2] = {bflo(uv), bfhi(uv)};
                f32x2_t vf2 = pvf[tt];
                float r[2], k[2], v[2], dec[2], av[2], kk[2], km[2];
#pragma unroll
                for (int e = 0; e < 2; ++e) { r[e] = cr[e] + (pr[e] - cr[e]) * mur[e]; k[e] = ck[e] + (pk[e] - ck[e]) * muk[e]; v[e] = cv[e] + (pv[e] - cv[e]) * muv[e]; pr[e] = cr[e]; pk[e] = ck[e]; pv[e] = cv[e];
                    if (l == 0) vf2[e] = v[e]; else { const float vg = sigmoid_f(accv[e][tt]); v[e] = v[e] + (vf2[e] - v[e]) * vg; }
                    cl[e] += -0.6065306597126334f * sigmoid_f(accw[e][tt]); dec[e] = cl[e]; av[e] = sigmoid_f(acca[e][tt]); kk[e] = k[e] * kkv[e]; km[e] = k[e] * (1.0f + (av[e] - 1.0f) * kav[e]); }
                const float ss = sum32(kk[0] * kk[0] + kk[1] * kk[1]), rn = rsqrtf(fmaxf(ss, 1e-24f)); kk[0] *= rn; kk[1] *= rn;
                if (l == 0) *(f32x2_t*)(VF + o) = vf2;
                *(f32x2_t*)(RW + RS + o) = (f32x2_t){dec[0], dec[1]};
                *(v2u*)(RWU + o) = (v2u){pk2(r[0], km[0]), pk2(r[1], km[1])}; *(v2u*)(RWU + 2 * RS + o) = (v2u){pk2(v[0], accg[0][tt]), pk2(v[1], accg[1][tt])};
                *(v2u*)(RWU + 3 * RS + o) = (v2u){pk2(-kk[0], kk[0] * av[0]), pk2(-kk[1], kk[1] * av[1])}; }
#undef PF_TOK
        }
        asm volatile("s_waitcnt vmcnt(0)" ::: "memory"); __syncthreads();
        __builtin_amdgcn_fence(__ATOMIC_ACQUIRE, "agent"); asm volatile("s_waitcnt vmcnt(0)" ::: "memory");
        if (!(HACK & 2)) rwkv_chunks_of_tile(F, l, tile);
    }
}
struct Args { const float* in[35]; float* out; unsigned char* ws; };
__device__ __forceinline__ void mk_frame(Frame& F, int wv) {
    extern __shared__ __attribute__((aligned(16))) unsigned char lds[];
    kargp kp = (kargp)__builtin_amdgcn_kernarg_segment_ptr(); asm volatile("" : "+s"(kp));
    F.kin = kp;
    F.lds = (LAS unsigned char*)lds;
    F.MISC = (volatile LAS unsigned*)(F.lds + MISC_OFF);
    { int w_ = wv; asm volatile("" : "+s"(w_)); int t_ = (int)__builtin_amdgcn_mbcnt_hi(~0u, __builtin_amdgcn_mbcnt_lo(~0u, (unsigned)w_ * 64u)); asm volatile("" : "+v"(t_)); F.tid = t_; } F.lane = F.tid & 63; F.wave = __builtin_amdgcn_readfirstlane(F.tid >> 6);
    F.G = gridDim.x; { int bx = blockIdx.x; asm volatile("" : "+s"(bx)); F.bx = bx; F.vcu = (F.G % 8 == 0) ? (bx % 8) * (F.G / 8) + bx / 8 : bx; }
    F.out = (float*)kp[35]; F.ws = (unsigned char*)kp[36]; F.ctl = (gu32*)(F.ws + WS_CTL);
}
__device__ __forceinline__ void grid_bar(int wv) {
    Frame F; mk_frame(F, wv);
    XcdBarrier bar; bar.bar = (unsigned*)(F.ctl + CW_BAR); bar.x = xb_xcc_id(); bar.st = F.MISC + 8;
    xcd_barrier(bar);
}
__global__ void __launch_bounds__(NWAVES * 64, 2) mega_fwd(Args args) {
    const int wv = __builtin_amdgcn_readfirstlane((int)threadIdx.x >> 6);
    { Frame F; mk_frame(F, wv);
      for (int u = F.tid; u < (LDS_BYTES - LDSCTL_OFF) / 4; u += NWAVES * 64) ((LAS unsigned*)(F.lds + LDSCTL_OFF))[u] = 0u;
      __syncthreads();
      (void)xcd_barrier_post((unsigned*)(F.ctl + CW_BAR), F.MISC + 8);
      p0_prologue_a(F);
    }
    grid_bar(wv);
    { Frame F; mk_frame(F, wv); p0_prologue_b(F); }
    grid_bar(wv);
#pragma unroll 1
    for (int l = 0; l < NLAYER; ++l) {
#define LAYER_VARS const float* mod = WSP(float, WS_MOD) + (size_t)l * 2 * 24576; const float* xin = l == 0 ? F.kin[I_X] : F.out; (void)mod; (void)xin
        { Frame F; mk_frame(F, wv); LAYER_VARS; if (l == 0) rms_phase(F, F.kin[I_X], mod + 0, mod + 4096); else rms_phase_bf(F, mod + 0, mod + 4096); }
        grid_bar(wv);
        { Frame F; mk_frame(F, wv);
          pg8::Gemm g{WSP(pg8::bf16_t, WS_XN), WSP(pg8::bf16_t, WS_WIN + l * WIN_L), M, NIN, DM}; pg8::StaticOrder S; S.init(M, NIN, F.G, F.bx);
          pg8::EpiCols E{WSP(pg8::bf16_t, WS_COLS), WSP(float, WS_LOWR)};
          pg8::gemm_phase<pg8::EpiCols, pg8::StaticOrder, true, true>(F.lds + RING_OFF, g, S, E, F.tid); }
        grid_bar(wv);
        { Frame F; mk_frame(F, wv); prep_norm(F, l); }
        { Frame F; mk_frame(F, wv); prep_loga(F, l); }
        { Frame F; mk_frame(F, wv); prep_rwkv(F, l); }
        { Frame F; mk_frame(F, wv); prep_vt<0>(F); }
        { Frame F; mk_frame(F, wv); prep_vt<1>(F); }
        { Frame F; mk_frame(F, wv); prep_vt<2>(F); }
        { Frame F; mk_frame(F, wv); prep_vt<3>(F); }
        { Frame F; mk_frame(F, wv); prep_vt<4>(F); }
        { Frame F; mk_frame(F, wv); prep_gla(F); }
        grid_bar(wv);
        { Frame F; mk_frame(F, wv); mixers_v4(F, l, l); }
        grid_bar(wv);
        { Frame F; mk_frame(F, wv); gla_post(F, l); }
        grid_bar(wv);
        { Frame F; mk_frame(F, wv); LAYER_VARS;
          pg8::Gemm g{WSP(pg8::bf16_t, WS_MIXED), WSP(pg8::bf16_t, WS_WOUT + l * WOUT_L), M, DM, DM}; pg8::StaticOrder S; S.init(M, DM, F.G, F.bx);
          pg8::EpiRes E{l == 0 ? (const void*)F.kin[I_X] : (const void*)WSP(bf16, WS_XR), (void*)WSP(bf16, WS_XR), mod + 2 * 4096, l != 0, true};
          pg8::gemm_phase<pg8::EpiRes, pg8::StaticOrder, true, true>(F.lds + RING_OFF, g, S, E, F.tid); }
        grid_bar(wv);
        { Frame F; mk_frame(F, wv); LAYER_VARS; rms_phase_bf(F, mod + 3 * 4096, mod + 4 * 4096); }
        grid_bar(wv);
        { Frame F; mk_frame(F, wv);
          pg8::Gemm g{WSP(pg8::bf16_t, WS_XN), WSP(pg8::bf16_t, WS_W13 + l * W13_L), M, 2 * DFF, DM}; pg8::StaticOrder S; S.init(M, 2 * DFF, F.G, F.bx);
          pg8::EpiSwiglu E{WSP(pg8::bf16_t, WS_HID)};
          pg8::gemm_phase<pg8::EpiSwiglu, pg8::StaticOrder, true, true>(F.lds + RING_OFF, g, S, E, F.tid); }
        grid_bar(wv);
        { Frame F; mk_frame(F, wv); LAYER_VARS;
          pg8::Gemm g{WSP(pg8::bf16_t, WS_HID), WSP(pg8::bf16_t, WS_W2 + l * W2_L), M, DM, DFF}; pg8::StaticOrder S; S.init(M, DM, F.G, F.bx);
          pg8::EpiRes E{(const void*)WSP(bf16, WS_XR), l + 1 < NLAYER ? (void*)WSP(bf16, WS_XR) : (void*)F.out, mod + 5 * 4096, true, l + 1 < NLAYER};
          pg8::gemm_phase<pg8::EpiRes, pg8::StaticOrder, true, true>(F.lds + RING_OFF, g, S, E, F.tid); }
        if (l + 1 < NLAYER) grid_bar(wv);
#undef LAYER_VARS
    }
}

extern "C" void kernel_launch(void* const* d_in, const int* in_sizes, int n_in, void* d_out, int out_size, void* d_ws, size_t ws_size, hipStream_t stream) {
    static int grid = 0;
    if (grid == 0) {
        if (n_in != 35 || in_sizes[0] != M * DM || out_size != M * DM || ws_size < WS_END) { fprintf(stderr, "kernel_launch: unexpected shapes: n_in %d in0 %d out %d ws %zu (need %zu)\n", n_in, n_in > 0 ? in_sizes[0] : -1, out_size, ws_size, (size_t)WS_END); grid = -1; return; }
        int dev = 0, cus = 0, per_cu = 0;
        if (hipGetDevice(&dev) != hipSuccess || hipDeviceGetAttribute(&cus, hipDeviceAttributeMultiprocessorCount, dev) != hipSuccess) { grid = -1; return; }
        if (hipFuncSetAttribute((const void*)mega_fwd, hipFuncAttributeMaxDynamicSharedMemorySize, LDS_BYTES) != hipSuccess) { fprintf(stderr, "kernel_launch: hipFuncSetAttribute failed\n"); grid = -1; return; }
        if (hipOccupancyMaxActiveBlocksPerMultiprocessor(&per_cu, (const void*)mega_fwd, NWAVES * 64, LDS_BYTES) != hipSuccess || per_cu < 1) fprintf(stderr, "kernel_launch: occupancy query says %d\n", per_cu);
        (void)hipGetLastError();
        grid = cus;
    }
    if (grid < 0) return;
    if (hipMemsetAsync((char*)d_ws + WS_CTL, 0, CTL_ZERO_BYTES, stream) != hipSuccess) return;
    Args a{};
    for (int i = 0; i < 35; ++i) a.in[i] = (const float*)d_in[i];
    a.out = (float*)d_out; a.ws = (unsigned char*)d_ws;
    hipLaunchKernelGGL(mega_fwd, dim3(grid), dim3(NWAVES * 64), LDS_BYTES, stream, a);
}
```

```cpp
#include <hip/hip_runtime.h>
#include <cstdio>
#include <cstdint>
namespace pg8 {
#define PG8_LAS __attribute__((address_space(3)))
typedef unsigned short bf16_t;
typedef short bf16x8 __attribute__((ext_vector_type(8)));
typedef float f32x4 __attribute__((ext_vector_type(4)));
typedef unsigned u32x4 __attribute__((ext_vector_type(4)));
constexpr int BM = 256, BK = 64, HALF = 128, HTB = HALF * BK * 2  , STAGE_BYTES = 8 * HTB, NXCD = 8, WGM = 8;

__host__ __device__ __forceinline__ int lds_byte(int r, int c) { const int st = (r >> 4) * 2 + (c >> 5), rr = r & 15, cc = c & 31, ob = rr * 64 + cc * 2; return st * 1024 + (ob ^ (((ob >> 9) & 1) << 5)); }
__host__ __device__ __forceinline__ void stage_rc(int b, int& R, int& C) { const int st = b / 1024, sb = b % 1024, swz = sb ^ (((sb >> 9) & 1) << 5); R = (st >> 1) * 16 + swz / 64; C = (st & 1) * 32 + (swz % 64) / 2; }
__host__ __device__ __forceinline__ int perm32(int rho) { const int n = rho >> 4, i = rho & 15; return 8 * (i >> 2) + 4 * n + (i & 3); }

struct Unit { int pm, pn; };
struct Gemm { const bf16_t* A; const bf16_t* Bt; int M, N, K; };

struct StaticOrder {
    int nM, nN, nwg, G, c;
    __host__ __device__ void init(int M, int N, int G_, int c_) { nM = M / BM; nN = N / BM; nwg = nM * nN; G = G_; c = c_; }
    __host__ __device__ bool next(int i, Unit& u) const {
        const long L = (long)i * G + c; if (L >= nwg) return false;
        int wgid = (int)L; { const int q = nwg / NXCD, r = nwg % NXCD, xcd = wgid % NXCD, off = wgid / NXCD; wgid = (xcd < r ? xcd * (q + 1) : r * (q + 1) + (xcd - r) * q) + off; }
        const int nig = WGM * nN, gid = wgid / nig, fm = gid * WGM, gsz = (nM - fm) < WGM ? (nM - fm) : WGM;
        u.pm = fm + ((wgid % nig) % gsz); u.pn = (wgid % nig) / gsz; return true;
    }
    __device__ __forceinline__ void a_ready(const Unit&) const {}
    __device__ __forceinline__ void done(const Unit&) const {}
};

typedef float f32x2c_t __attribute__((ext_vector_type(2))); typedef __bf16 bf16x2c_t __attribute__((ext_vector_type(2)));
__device__ __forceinline__ unsigned cvt_pk_bf16(float lo, float hi) { const f32x2c_t v = {lo, hi}; return __builtin_bit_cast(unsigned, __builtin_convertvector(v, bf16x2c_t)); }
typedef float f32x2 __attribute__((ext_vector_type(2)));
__device__ __forceinline__ float silu_f(float x) { return x * __builtin_amdgcn_rcpf(1.0f + __builtin_amdgcn_exp2f(-1.4426950408889634f * x)); }
struct EpiCols {
    static constexpr bool PERM = true, AFTER_DRAIN = false;
    bf16_t* O; float* L;
    __device__ __forceinline__ void operator()(const f32x4 (&acc)[2][2][4][2], const Unit& u, int wr, int wc, int fr, int fq) const {
        const int row0 = u.pm * BM + wr * 64 + fr;
        if (u.pn < 41) {
            const int col0 = u.pn * BM + wc * 32 + 8 * fq;
#pragma unroll
            for (int ai = 0; ai < 2; ++ai)
#pragma unroll
                for (int m = 0; m < 4; ++m) { bf16_t* rowp = O + (size_t)(row0 + ai * HALF + m * 16) * 10496 + col0;
#pragma unroll
                    for (int bj = 0; bj < 2; ++bj) { const f32x4 v0 = acc[ai][bj][m][0], v1 = acc[ai][bj][m][1];
                        u32x4 w; w.x = cvt_pk_bf16(v0[0], v0[1]); w.y = cvt_pk_bf16(v0[2], v0[3]); w.z = cvt_pk_bf16(v1[0], v1[1]); w.w = cvt_pk_bf16(v1[2], v1[3]);
                        *(u32x4*)(rowp + bj * HALF) = w; } }
        } else {
            const int col0 = wc * 32 + 8 * fq;
#pragma unroll
            for (int ai = 0; ai < 2; ++ai)
#pragma unroll
                for (int m = 0; m < 4; ++m) { float* rowp = L + (size_t)(row0 + ai * HALF + m * 16) * 256 + col0;
#pragma unroll
                    for (int bj = 0; bj < 2; ++bj) { *(f32x4*)(rowp + bj * HALF) = acc[ai][bj][m][0]; *(f32x4*)(rowp + bj * HALF + 4) = acc[ai][bj][m][1]; } }
        }
    }
};
struct EpiRes {
    static constexpr bool PERM = true, AFTER_DRAIN = false;
    const void* base; void* out; const float* gate; bool base_bf, out_bf;
    __device__ __forceinline__ void operator()(const f32x4 (&acc)[2][2][4][2], const Unit& u, int wr, int wc, int fr, int fq) const {
        const int row0 = u.pm * BM + wr * 64 + fr, col0 = u.pn * BM + wc * 32 + 8 * fq;
        const float* gp = gate + (size_t)(u.pm >> 5) * 24576 + col0;
        f32x4 gv[2][2];
#pragma unroll
        for (int bj = 0; bj < 2; ++bj)
#pragma unroll
            for (int n = 0; n < 2; ++n) gv[bj][n] = *(const f32x4*)(gp + bj * HALF + n * 4);
#pragma unroll
        for (int ai = 0; ai < 2; ++ai) {
            f32x4 r[4][2][2];
            if (base_bf) {
#pragma unroll
                for (int m = 0; m < 4; ++m)
#pragma unroll
                    for (int bj = 0; bj < 2; ++bj) { const u32x4 w = *(const u32x4*)((const bf16_t*)base + (size_t)(row0 + ai * HALF + m * 16) * 4096 + col0 + bj * HALF);
                        r[m][bj][0] = (f32x4){__builtin_bit_cast(float, w.x << 16), __builtin_bit_cast(float, w.x & 0xffff0000u), __builtin_bit_cast(float, w.y << 16), __builtin_bit_cast(float, w.y & 0xffff0000u)};
                        r[m][bj][1] = (f32x4){__builtin_bit_cast(float, w.z << 16), __builtin_bit_cast(float, w.z & 0xffff0000u), __builtin_bit_cast(float, w.w << 16), __builtin_bit_cast(float, w.w & 0xffff0000u)}; }
            } else {
#pragma unroll
                for (int m = 0; m < 4; ++m)
#pragma unroll
                    for (int bj = 0; bj < 2; ++bj)
#pragma unroll
                        for (int n = 0; n < 2; ++n) r[m][bj][n] = *(const f32x4*)((const float*)base + (size_t)(row0 + ai * HALF + m * 16) * 4096 + col0 + bj * HALF + n * 4);
            }
#pragma unroll
            for (int m = 0; m < 4; ++m)
#pragma unroll
                for (int bj = 0; bj < 2; ++bj)
#pragma unroll
                    for (int n = 0; n < 2; ++n) r[m][bj][n] = r[m][bj][n] + gv[bj][n] * acc[ai][bj][m][n];
            if (out_bf) {
#pragma unroll
                for (int m = 0; m < 4; ++m)
#pragma unroll
                    for (int bj = 0; bj < 2; ++bj) { const f32x4 v0 = r[m][bj][0], v1 = r[m][bj][1];
                        u32x4 w; w.x = cvt_pk_bf16(v0[0], v0[1]); w.y = cvt_pk_bf16(v0[2], v0[3]); w.z = cvt_pk_bf16(v1[0], v1[1]); w.w = cvt_pk_bf16(v1[2], v1[3]);
                        *(u32x4*)((bf16_t*)out + (size_t)(row0 + ai * HALF + m * 16) * 4096 + col0 + bj * HALF) = w; }
            } else {
#pragma unroll
                for (int m = 0; m < 4; ++m)
#pragma unroll
                    for (int bj = 0; bj < 2; ++bj)
#pragma unroll
                        for (int n = 0; n < 2; ++n) *(f32x4*)((float*)out + (size_t)(row0 + ai * HALF + m * 16) * 4096 + col0 + bj * HALF + n * 4) = r[m][bj][n];
            }
            asm volatile("" ::: "memory");
        }
    }
};
struct EpiSwiglu {
    static constexpr bool PERM = true, AFTER_DRAIN = false;
    bf16_t* H;
    __device__ __forceinline__ void operator()(const f32x4 (&acc)[2][2][4][2], const Unit& u, int wr, int wc, int fr, int fq) const {
        const int row0 = u.pm * BM + wr * 64 + fr, col0 = u.pn * HALF + wc * 32 + 8 * fq;
#pragma unroll
        for (int ai = 0; ai < 2; ++ai)
#pragma unroll
            for (int m = 0; m < 4; ++m) { bf16_t* rowp = H + (size_t)(row0 + ai * HALF + m * 16) * 11008 + col0;
                const f32x4 a0 = acc[ai][0][m][0], a1 = acc[ai][0][m][1], b0 = acc[ai][1][m][0], b1 = acc[ai][1][m][1];
                u32x4 w; w.x = cvt_pk_bf16(silu_f(a0[0]) * b0[0], silu_f(a0[1]) * b0[1]); w.y = cvt_pk_bf16(silu_f(a0[2]) * b0[2], silu_f(a0[3]) * b0[3]);
                w.z = cvt_pk_bf16(silu_f(a1[0]) * b1[0], silu_f(a1[1]) * b1[1]); w.w = cvt_pk_bf16(silu_f(a1[2]) * b1[2], silu_f(a1[3]) * b1[3]);
                *(u32x4*)rowp = w; }
    }
};
template <class Epi, class Sched, bool ALIGN_EPI = false, bool SP2 = false>
__device__ __forceinline__ void gemm_phase(PG8_LAS unsigned char* lds, const Gemm g, const Sched& S, const Epi& E, int tid_in) {
    int tid_ = tid_in; asm volatile("" : "+v"(tid_));
    const int tid = tid_, wid = __builtin_amdgcn_readfirstlane(tid >> 6), lane = tid & 63, wr = wid >> 2, wc = wid & 3, fr = lane & 15, fq = lane >> 4;
    const int K = g.K, nt = K / BK;
    unsigned voffA[2], voffB[2];
#pragma unroll
    for (int i = 0; i < 2; ++i) { int R, C; stage_rc(tid * 16 + i * 8192, R, C); const int Rb = Epi::PERM ? ((R & ~31) + perm32(R & 31)) : R;
        voffA[i] = (unsigned)(R * K + C) * 2u; voffB[i] = (unsigned)(Rb * K + C) * 2u; }
    const size_t kstep = (size_t)(BK * 2);
    const size_t hstep = (size_t)HALF * K * 2;
    const size_t tstep = 2 * hstep;
    const unsigned ldsw = (unsigned)wid * 1024u;
    const int aoff = lds_byte(wr * 64 + fr, fq * 8), boff = lds_byte(wc * 32 + fr, fq * 8);
#define PG8_SA(b, h) (((b) * 2 + (h)) * HTB)
#define PG8_SB(b, h) ((4 + (b) * 2 + (h)) * HTB)
#define PG8_STAGE(bufoff, gbase, voff) do { _Pragma("unroll") for (int _i = 0; _i < 2; ++_i) \
        __builtin_amdgcn_global_load_lds((const unsigned*)((const char*)(gbase) + (voff)[_i]), (PG8_LAS unsigned*)(lds + (bufoff) + ldsw + _i * 8192), 16, 0, 0); } while (0)
#define PG8_LDA(dst, b, h) do { _Pragma("unroll") for (int m = 0; m < 4; ++m) _Pragma("unroll") for (int k = 0; k < 2; ++k) dst[m][k] = *(const PG8_LAS bf16x8*)(lds + PG8_SA(b, h) + aoff + m * 2048 + k * 1024); } while (0)
#define PG8_LDB(dst, b, h) do { _Pragma("unroll") for (int n = 0; n < 2; ++n) _Pragma("unroll") for (int k = 0; k < 2; ++k) dst[n][k] = *(const PG8_LAS bf16x8*)(lds + PG8_SB(b, h) + boff + n * 2048 + k * 1024); } while (0)
#define PG8_MMA(ai, bj, At, Bt) do { __builtin_amdgcn_s_setprio(1); _Pragma("unroll") for (int m = 0; m < 4; ++m) _Pragma("unroll") for (int n = 0; n < 2; ++n) _Pragma("unroll") for (int k = 0; k < 2; ++k) \
        acc[ai][bj][m][n] = __builtin_amdgcn_mfma_f32_16x16x32_bf16(Bt[n][k], At[m][k], acc[ai][bj][m][n], 0, 0, 0); __builtin_amdgcn_s_setprio(0); } while (0)
#define PG8_WAIT_V(n) asm volatile("s_waitcnt vmcnt(" #n ")" ::: "memory")
#define PG8_WAIT_L(n) asm volatile("s_waitcnt lgkmcnt(" #n ")" ::: "memory")
#define PG8_BAR __builtin_amdgcn_s_barrier()
#define PG8_SCHED __builtin_amdgcn_sched_barrier(0)
    Unit cur, nxt; int ui = 0;
    if (!S.next(0, cur)) return;
    f32x4 acc[2][2][4][2];
#pragma unroll
    for (int a = 0; a < 2; ++a)
#pragma unroll
        for (int b = 0; b < 2; ++b)
#pragma unroll
            for (int m = 0; m < 4; ++m)
#pragma unroll
                for (int n = 0; n < 2; ++n) acc[a][b][m][n] = (f32x4){0.f, 0.f, 0.f, 0.f};
    bf16x8 At[4][2], B0[2][2], B1[2][2];
    const char* cA = (const char*)g.A + (size_t)cur.pm * tstep; const char* cB = (const char*)g.Bt + (size_t)cur.pn * tstep;
    S.a_ready(cur);
    if constexpr (SP2) {
        PG8_STAGE(PG8_SB(0, 0), cB, voffB); PG8_STAGE(PG8_SB(0, 1), cB + hstep, voffB); PG8_STAGE(PG8_SA(0, 0), cA, voffA); PG8_STAGE(PG8_SA(0, 1), cA + hstep, voffA);
        if (wr == 1) PG8_BAR;
        PG8_WAIT_V(2); PG8_BAR;
        PG8_STAGE(PG8_SB(1, 0), cB + kstep, voffB); PG8_STAGE(PG8_SA(1, 0), cA + kstep, voffA); PG8_STAGE(PG8_SB(1, 1), cB + hstep + kstep, voffB);
        PG8_WAIT_V(6); PG8_BAR;
    } else {
        PG8_STAGE(PG8_SB(0, 0), cB, voffB); PG8_STAGE(PG8_SA(0, 0), cA, voffA); PG8_STAGE(PG8_SB(0, 1), cB + hstep, voffB); PG8_STAGE(PG8_SA(0, 1), cA + hstep, voffA);
        if (wr == 1) PG8_BAR;
        PG8_WAIT_V(4); PG8_BAR;
        PG8_STAGE(PG8_SB(1, 0), cB + kstep, voffB); PG8_STAGE(PG8_SA(1, 0), cA + kstep, voffA); PG8_STAGE(PG8_SB(1, 1), cB + hstep + kstep, voffB);
        PG8_WAIT_V(6); PG8_BAR;
    }
    for (;;) {
        const bool has_next = S.next(ui + 1, nxt);
        const char* nA = has_next ? (const char*)g.A + (size_t)nxt.pm * tstep : cA; const char* nB = has_next ? (const char*)g.Bt + (size_t)nxt.pn * tstep : cB;
        for (int t = 0; t < nt; t += 2) {
            const bool last = (t == nt - 2);
            const char* a1 = cA + (size_t)(t + 1) * kstep;
            const char* a2 = last ? nA : cA + (size_t)(t + 2) * kstep; const char* b2 = last ? nB : cB + (size_t)(t + 2) * kstep;
            const char* a3 = a2 + kstep; const char* b3 = b2 + kstep;
            if (last && has_next) S.a_ready(nxt);
            if constexpr (SP2) {
            PG8_LDB(B0, 0, 0); PG8_LDB(B1, 0, 1); PG8_SCHED; PG8_LDA(At, 0, 0); PG8_STAGE(PG8_SA(1, 1), a1 + hstep, voffA);
            PG8_WAIT_V(8); PG8_WAIT_L(0); PG8_BAR; PG8_MMA(0, 0, At, B0); PG8_MMA(0, 1, At, B1); PG8_BAR; PG8_SCHED;
            PG8_LDA(At, 0, 1); PG8_STAGE(PG8_SB(0, 0), b2, voffB); PG8_STAGE(PG8_SB(0, 1), b2 + hstep, voffB); PG8_STAGE(PG8_SA(0, 0), a2, voffA);
            PG8_WAIT_V(8); PG8_WAIT_L(0); PG8_BAR; PG8_MMA(1, 0, At, B0); PG8_MMA(1, 1, At, B1); PG8_BAR; PG8_SCHED;
            PG8_LDB(B0, 1, 0); PG8_LDB(B1, 1, 1); PG8_SCHED; PG8_LDA(At, 1, 0); PG8_STAGE(PG8_SA(0, 1), a2 + hstep, voffA);
            PG8_WAIT_V(8); PG8_WAIT_L(0); PG8_BAR; PG8_MMA(0, 0, At, B0); PG8_MMA(0, 1, At, B1); PG8_BAR; PG8_SCHED;
            PG8_LDA(At, 1, 1); PG8_STAGE(PG8_SB(1, 0), b3, voffB); PG8_STAGE(PG8_SB(1, 1), b3 + hstep, voffB); PG8_STAGE(PG8_SA(1, 0), a3, voffA);
            PG8_WAIT_V(8); PG8_WAIT_L(0); PG8_BAR; PG8_MMA(1, 0, At, B0); PG8_MMA(1, 1, At, B1); PG8_BAR; PG8_SCHED;
            } else {
            PG8_LDB(B0, 0, 0); PG8_SCHED; PG8_LDA(At, 0, 0); PG8_STAGE(PG8_SA(1, 1), a1 + hstep, voffA);
            PG8_WAIT_L(8); PG8_BAR; PG8_WAIT_L(0); PG8_MMA(0, 0, At, B0); PG8_BAR; PG8_SCHED;
            PG8_LDB(B1, 0, 1); PG8_STAGE(PG8_SB(0, 0), b2, voffB);
            PG8_BAR; PG8_WAIT_L(0); PG8_MMA(0, 1, At, B1); PG8_BAR;
            PG8_LDA(At, 0, 1); PG8_STAGE(PG8_SA(0, 0), a2, voffA);
            PG8_BAR; PG8_WAIT_L(0); PG8_MMA(1, 0, At, B0); PG8_BAR; PG8_SCHED;
            PG8_STAGE(PG8_SB(0, 1), b2 + hstep, voffB);
            PG8_WAIT_V(6); PG8_BAR; PG8_MMA(1, 1, At, B1); PG8_BAR;
            PG8_LDB(B0, 1, 0); PG8_SCHED; PG8_LDA(At, 1, 0); PG8_STAGE(PG8_SA(0, 1), a2 + hstep, voffA);
            PG8_WAIT_L(8); PG8_BAR; PG8_WAIT_L(0); PG8_MMA(0, 0, At, B0); PG8_BAR; PG8_SCHED;
            PG8_LDB(B1, 1, 1); PG8_STAGE(PG8_SB(1, 0), b3, voffB);
            PG8_BAR; PG8_WAIT_L(0); PG8_MMA(0, 1, At, B1); PG8_BAR;
            PG8_LDA(At, 1, 1); PG8_STAGE(PG8_SA(1, 0), a3, voffA);
            PG8_BAR; PG8_WAIT_L(0); PG8_MMA(1, 0, At, B0); PG8_BAR; PG8_SCHED;
            PG8_STAGE(PG8_SB(1, 1), b3 + hstep, voffB);
            PG8_WAIT_V(6); PG8_BAR; PG8_MMA(1, 1, At, B1); PG8_BAR;
            }
        }
        if constexpr (ALIGN_EPI) { if (wr == 0) PG8_BAR; }
        if constexpr (!Epi::AFTER_DRAIN) { E(acc, cur, wr, wc, fr, fq); S.done(cur); }
        if (!has_next) break;
#pragma unroll
        for (int a = 0; a < 2; ++a)
#pragma unroll
            for (int b = 0; b < 2; ++b)
#pragma unroll
                for (int m = 0; m < 4; ++m)
#pragma unroll
                    for (int n = 0; n < 2; ++n) acc[a][b][m][n] = (f32x4){0.f, 0.f, 0.f, 0.f};
        cur = nxt; cA = nA; cB = nB; ++ui;
        if constexpr (ALIGN_EPI) { if (wr == 1) PG8_BAR; }
    }
    PG8_WAIT_V(0);
    if constexpr (!ALIGN_EPI) { if (wr == 0) PG8_BAR; }
    PG8_BAR;
    if constexpr (Epi::AFTER_DRAIN) { E.fused(acc, cur, wr, wc, fr, fq, lds, wid, lane); S.done(cur); }
#undef PG8_SA
#undef PG8_SB
#undef PG8_STAGE
#undef PG8_LDA
#undef PG8_LDB
#undef PG8_MMA
#undef PG8_WAIT_V
#undef PG8_WAIT_L
#undef PG8_BAR
#undef PG8_SCHED
}
}
constexpr int BATCH = 2, SEQ = 8192, DM = 4096, M = BATCH * SEQ, DFF = 11008, NLAYER = 2;
constexpr int P_IN = 10704, NIN = 10752, NMAIN = 10496;
constexpr int CA_Q = 0, CA_K = 1024, CA_V = 2048;
constexpr int CB_Q = 3072, CB_K = 3584, CB_V = 4096, CB_G = 5120;
constexpr int CC_R = 6144, CC_K = 7168, CC_V = 8192;
constexpr int CD_Q = 9216, CD_K = 10240, CD_V = 10368;
constexpr float LOG2E = 1.4426950408889634f;
constexpr float QSCALE = 0.125f * LOG2E;
constexpr int NWAVES = 8;

constexpr size_t MiB = 1u << 20;
constexpr size_t WS_CTL = 0, CTL_ZERO_BYTES = 1 * MiB;
constexpr size_t WS_MODP = 2 * MiB;
constexpr size_t WS_MOD = 14 * MiB;
constexpr size_t WS_TAB = 15 * MiB;
constexpr size_t WS_WIN = 16 * MiB, WIN_L = 84 * MiB;
constexpr size_t WS_WOUT = 184 * MiB, WOUT_L = 32 * MiB;
constexpr size_t WS_W13 = 248 * MiB, W13_L = 172 * MiB;
constexpr size_t WS_W2 = 592 * MiB, W2_L = 86 * MiB;
constexpr size_t WS_XN = 764 * MiB;
constexpr size_t WS_COLS = 892 * MiB;
constexpr size_t WS_LOWR = 1220 * MiB;
constexpr size_t WS_HID = 892 * MiB;
constexpr size_t WS_QKA = 1236 * MiB;
constexpr size_t WS_QKD = 1300 * MiB;
constexpr size_t WS_LOGA = 1336 * MiB;
constexpr size_t WS_RW = 1368 * MiB, RW_ONE = 64 * MiB;
constexpr size_t WS_VFIRST = 1816 * MiB;
constexpr size_t WS_MIXED = 1880 * MiB;
constexpr int VROW = SEQ + 64;
constexpr size_t WS_VTA = 2008 * MiB;
constexpr size_t WS_VTD = 2041 * MiB;
constexpr size_t WS_QDEC = 2046 * MiB, WS_KDT = 2062 * MiB, WS_AM = 2078 * MiB, WS_EBL = 2086 * MiB;
constexpr size_t WS_VTB = 2087 * MiB;
constexpr size_t WS_RWC = 2120 * MiB;
constexpr size_t WS_OB = 2446 * MiB;
constexpr size_t WS_PSG = 2478 * MiB;
constexpr size_t WS_WF = 2479 * MiB;
constexpr size_t WS_XR = 2480 * MiB;
constexpr size_t WS_END = 2608 * MiB;
constexpr int CW_BAR = 4096;
constexpr int CW_Q = 16384;

constexpr int RING_OFF = 0, RING_BYTES = 131072;
constexpr int LDSCTL_OFF = RING_BYTES, MISC_OFF = LDSCTL_OFF + 320;
constexpr int LDS_BYTES = 147456;

#define GAS __attribute__((address_space(1)))
#define LAS __attribute__((address_space(3)))
typedef unsigned short bf16;
typedef unsigned v4u __attribute__((ext_vector_type(4)));
typedef unsigned v2u __attribute__((ext_vector_type(2)));
typedef float f32x4 __attribute__((ext_vector_type(4)));
typedef short bf16x8 __attribute__((ext_vector_type(8)));
typedef GAS unsigned gu32;
#define RLX_AGENT __ATOMIC_RELAXED, __HIP_MEMORY_SCOPE_AGENT
#define LDS_WAIT() asm volatile("s_waitcnt lgkmcnt(0)" ::: "memory")
#define VM_WAIT() asm volatile("s_waitcnt vmcnt(0)" ::: "memory")
typedef float f32x2_t __attribute__((ext_vector_type(2))); typedef __bf16 bf16x2_t __attribute__((ext_vector_type(2)));
__device__ __forceinline__ unsigned pk2(float lo, float hi) { const f32x2_t v = {lo, hi}; return __builtin_bit_cast(unsigned, __builtin_convertvector(v, bf16x2_t)); }
__device__ __forceinline__ unsigned f2bf(float f) { return pk2(f, f) & 0xffffu; }
__device__ __forceinline__ float bf2f(unsigned short h) { return __builtin_bit_cast(float, (unsigned)h << 16); }
__device__ __forceinline__ float bflo(unsigned w) { return __builtin_bit_cast(float, w << 16); }
__device__ __forceinline__ float bfhi(unsigned w) { return __builtin_bit_cast(float, w & 0xffff0000u); }
template <int CTRL> __device__ __forceinline__ float dpp_f(float v) { return __builtin_bit_cast(float, __builtin_amdgcn_update_dpp(0, __builtin_bit_cast(int, v), CTRL, 0xF, 0xF, true)); }
__device__ __forceinline__ float sum8(float v) {
    v += dpp_f<0xB1>(v); v += dpp_f<0x4E>(v); v += dpp_f<0x141>(v); return v; }
__device__ __forceinline__ float sum32(float v) {
    v = sum8(v); v += dpp_f<0x140>(v); v += __builtin_bit_cast(float, __builtin_amdgcn_ds_swizzle(__builtin_bit_cast(int, v), 0x401F)); return v; }
__device__ __forceinline__ float wave_sum(float v) {
    v = sum8(v); v += dpp_f<0x140>(v);
    v += __builtin_bit_cast(float, __builtin_amdgcn_ds_swizzle(__builtin_bit_cast(int, v), 0x401F));
    { const int u = __builtin_bit_cast(int, v); v = __builtin_bit_cast(float, __builtin_amdgcn_readlane(u, 0)) + __builtin_bit_cast(float, __builtin_amdgcn_readlane(u, 32)); }
    return v;
}
__device__ __forceinline__ float sigmoid_f(float x) { return __builtin_amdgcn_rcpf(1.0f + __builtin_amdgcn_exp2f(-LOG2E * x)); }
__device__ __forceinline__ float silu_g(float x) { return x * sigmoid_f(x); }
__device__ __forceinline__ void unpack8(const v4u r, float (&f)[8]) { f[0] = bflo(r.x); f[1] = bfhi(r.x); f[2] = bflo(r.y); f[3] = bfhi(r.y); f[4] = bflo(r.z); f[5] = bfhi(r.z); f[6] = bflo(r.w); f[7] = bfhi(r.w); }
__device__ __forceinline__ v4u pack8(const float (&f)[8]) { v4u o; o.x = pk2(f[0], f[1]); o.y = pk2(f[2], f[3]); o.z = pk2(f[4], f[5]); o.w = pk2(f[6], f[7]); return o; }

#define XB_TMO      128
#define XB_XCNT(j)  (256  + 64 * (j))
#define XB_XSUB(j)  (1280 + 64 * (j))
#define XB_XGEN(j)  (2304 + 64 * (j))
#define XB_TOP      3328
#define XB_TOPGEN   3392
#define XCD_BAR_WORDS 3456
#define XB_SPIN_CAP (1u << 23)

__device__ __forceinline__ unsigned xb_ld(unsigned* p)              { return __hip_atomic_load(p, __ATOMIC_RELAXED, __HIP_MEMORY_SCOPE_AGENT); }
__device__ __forceinline__ unsigned xb_add(unsigned* p, unsigned v) { return __hip_atomic_fetch_add(p, v, __ATOMIC_RELAXED, __HIP_MEMORY_SCOPE_AGENT); }
__device__ __forceinline__ unsigned xb_xcc_id() { return (unsigned)__builtin_amdgcn_s_getreg((3 << 11) | 20) & 0xFu; }
#define XB_SPIN(cond, bar) do { unsigned _sp = 0; while (cond) { __builtin_amdgcn_s_sleep(1); \
    if ((++_sp & 255u) == 0u) { if (xb_ld(&(bar)[XB_TMO])) break; if (_sp > XB_SPIN_CAP) { atomicAdd(&(bar)[XB_TMO], 1u); break; } } } } while (0)

struct XcdBarrier {
    unsigned* bar; unsigned x;
    volatile LAS unsigned* st;
};

__device__ __forceinline__ XcdBarrier xcd_barrier_post(unsigned* bar, volatile LAS unsigned* st) {
    XcdBarrier b; b.bar = bar; b.x = xb_xcc_id(); b.st = st;
    if (threadIdx.x == 0) (void)xb_add(&bar[XB_XCNT(b.x)], 1u);
    return b;
}
__device__ __forceinline__ void xcd_barrier_complete(unsigned* bar, unsigned x, unsigned& nloc, unsigned& nx) {
    const unsigned G = gridDim.x * gridDim.y * gridDim.z;
    unsigned sum, cnt, mine, sp = 0u;
    for (;;) {
        sum = 0u; cnt = 0u; mine = 0u;
#pragma unroll
        for (unsigned j = 0; j < 16; ++j) { const unsigned c = xb_ld(&bar[XB_XCNT(j)]); sum += c; cnt += (c > 0u) ? 1u : 0u; mine = (j == x) ? c : mine; }
        if (sum == G) break;
        __builtin_amdgcn_s_sleep(1);
        if ((++sp & 255u) == 0u) { if (xb_ld(&bar[XB_TMO])) break; if (sp > XB_SPIN_CAP) { atomicAdd(&bar[XB_TMO], 1u); break; } }
    }
    nloc = mine > 0u ? mine : 1u; nx = cnt > 0u ? cnt : 1u;
}

__device__ __forceinline__ void xcd_barrier(const XcdBarrier& b) {
    asm volatile("s_waitcnt vmcnt(0)" ::: "memory");
    __syncthreads();
    if (threadIdx.x == 0) {
        unsigned* bar = b.bar;
        __builtin_amdgcn_s_waitcnt(0);
        unsigned nloc = b.st[0], nx = b.st[1];
        if (nloc == 0u) { xcd_barrier_complete(bar, b.x, nloc, nx); b.st[0] = nloc; b.st[1] = nx; }
        const unsigned old = xb_add(&bar[XB_XSUB(b.x)], 1u);
        const unsigned gen = old / nloc;
        if (old + 1u == (gen + 1u) * nloc) {
            __builtin_amdgcn_fence(__ATOMIC_RELEASE, "agent");
            asm volatile("s_waitcnt vmcnt(0)" ::: "memory");
            const unsigned og = xb_add(&bar[XB_TOP], 1u);
            const unsigned tg = og / nx;
            if (og + 1u == (tg + 1u) * nx) xb_add(&bar[XB_TOPGEN], 1u);
            else XB_SPIN(xb_ld(&bar[XB_TOPGEN]) == tg, bar);
            __builtin_amdgcn_fence(__ATOMIC_ACQUIRE, "agent");
            xb_add(&bar[XB_XGEN(b.x)], 1u);
            asm volatile("s_waitcnt vmcnt(0)" ::: "memory");
        } else {
            XB_SPIN(xb_ld(&bar[XB_XGEN(b.x)]) == gen, bar);
            __builtin_amdgcn_fence(__ATOMIC_ACQUIRE, "agent");
            asm volatile("s_waitcnt vmcnt(0)" ::: "memory");
        }
    }
    __syncthreads();
}

typedef const float* const __attribute__((address_space(4)))* kargp;
struct Frame {
    LAS unsigned char* lds;
    volatile LAS unsigned* MISC;
    gu32* ctl;
    int tid, lane, wave;
    int vcu, G, bx;
    kargp kin;
    float* out;
    unsigned char* ws;
};
enum { I_X = 0, I_C, I_RELB, I_ADAW, I_ADAB, I_WIN, I_WOUT, I_DQN, I_DKN, I_DLAM, I_DSUB, I_GGU, I_GGB, I_GON, I_RMU, I_RWUP, I_RW0, I_RAUP, I_RA0, I_RGUP,
       I_RKK, I_RKA, I_RRK, I_RLNW, I_RLNB, I_VRD, I_VRMU, I_VRUP, I_VR0, I_SQN, I_SKN, I_SSINK, I_W1, I_W3, I_W2 };

#define WSP(T, off) ((T*)(F.ws + (off)))
__device__ __forceinline__ void relaunder_tid(Frame& F) { int t = F.tid; asm volatile("" : "+v"(t)); F.tid = t; F.lane = t & 63; F.wave = __builtin_amdgcn_readfirstlane(t >> 6); }
__device__ __forceinline__ void relaunder(Frame& F) { kargp p = F.kin; asm volatile("" : "+s"(p)); F.kin = p; }

__device__ __forceinline__ void conv_item(const float* src, int ld, int col0, int ncols, int K, bf16* WT, int row0, int kb, LAS float* scr, int lane) {
    const int k0 = 64 * kb;
    { const int n = lane & 31; const bool ok = src != nullptr && n < ncols; const float* sp = src + (size_t)(k0 + (lane >> 5)) * ld + col0 + n; float v[32];
#pragma unroll
      for (int i = 0; i < 32; ++i) v[i] = ok ? sp[(size_t)(2 * i) * ld] : 0.f;
#pragma unroll
      for (int i = 0; i < 32; ++i) scr[(2 * i + (lane >> 5)) * 33 + n] = v[i]; }
    LDS_WAIT(); asm volatile("" ::: "memory");
    const int c = lane & 7;
#pragma unroll
    for (int j = 0; j < 4; ++j) { const int n = (lane >> 3) + 8 * j; const LAS float* s = scr + (8 * c) * 33 + n;
        v4u o; o.x = pk2(s[0 * 33], s[1 * 33]); o.y = pk2(s[2 * 33], s[3 * 33]); o.z = pk2(s[4 * 33], s[5 * 33]); o.w = pk2(s[6 * 33], s[7 * 33]);
        if (n < ncols) *(GAS v4u*)(WT + (size_t)(row0 + n) * K + k0 + 8 * c) = o; }
    LDS_WAIT(); asm volatile("" ::: "memory");
}
__device__ __forceinline__ int t5_bucket(int d) {
    if (d < 16) return d;
    int v = 16 + (int)(logf((float)d * (1.0f / 16.0f)) / logf(8.0f) * 16.0f);
    return v < 31 ? v : 31;
}
__device__ __forceinline__ void p0_prologue_a(Frame& F) {
    const int gw = F.vcu * NWAVES + F.wave, NGW = F.G * NWAVES;
    LAS float* ldsf = (LAS float*)(F.lds + RING_OFF);
    { float cv[16];
#pragma unroll
      for (int q = 0; q < 16; ++q) cv[q] = F.kin[I_C][F.tid + NWAVES * 64 * q];
#pragma unroll
      for (int q = 0; q < 16; ++q) ldsf[F.tid + NWAVES * 64 * q] = silu_g(cv[q]); }
    __syncthreads();
    float* MODP = WSP(float, WS_MODP);
    for (int it = gw; it < 6144; it += NGW) {
        const int l = it / 3072, rem = it % 3072, kc = rem / 96, ng = rem % 96, n0 = 256 * ng + 4 * F.lane;
        const float* w = F.kin[I_ADAW] + ((size_t)l * DM + kc * 128) * 24576 + n0;
        f32x4 a0 = {0.f, 0.f, 0.f, 0.f}, a1 = {0.f, 0.f, 0.f, 0.f};
#pragma unroll 16
        for (int k = 0; k < 128; ++k) { const f32x4 wv = *(const f32x4*)(w + (size_t)k * 24576); const float s0 = ldsf[kc * 128 + k], s1 = ldsf[DM + kc * 128 + k]; a0 += wv * s0; a1 += wv * s1; }
        *(f32x4*)(MODP + ((size_t)(l * 32 + kc) * 2 + 0) * 24576 + n0) = a0;
        *(f32x4*)(MODP + ((size_t)(l * 32 + kc) * 2 + 1) * 24576 + n0) = a1;
    }
    for (int idx = F.bx * (NWAVES * 64) + F.tid; idx < NLAYER * 448 * 64; idx += F.G * NWAVES * 64) {
        const int l = idx / (448 * 64), rem = idx % (448 * 64), blk = rem >> 6, ln = rem & 63, n = ln & 15, g = ln >> 4;
        const int m = blk < 384 ? blk >> 7 : 3, nt = blk < 384 ? (blk & 127) >> 1 : blk - 384, ks = blk < 384 ? (blk & 1) : 0;
        const float* W = m == 0 ? F.kin[I_RWUP] + (size_t)l * 65536 : (m == 1 ? F.kin[I_RAUP] + (size_t)l * 65536 : (m == 2 ? F.kin[I_RGUP] + (size_t)l * 65536 : (l ? F.kin[I_VRUP] + (size_t)(l - 1) * 32768 : nullptr)));
        float f[8];
#pragma unroll
        for (int e = 0; e < 8; ++e) f[e] = W != nullptr ? W[(size_t)(32 * ks + 8 * g + e) * 1024 + 16 * nt + n] : 0.f;
        *(v4u*)(WSP(bf16, WS_WF) + ((size_t)(l * 448 + blk) * 64 + ln) * 8) = pack8(f);
    }
    __syncthreads();
    LAS float* scr = (LAS float*)(F.lds + RING_OFF + F.wave * 16384);
    constexpr int I_IN = 337 * 64, I_OUT = 128 * 64, I_13 = 688 * 64, I_2 = 128 * 172, I_L = I_IN + I_OUT + I_13 + I_2;
    for (int it = gw; it < NLAYER * I_L; it += NGW) {
        const int l = it / I_L; int r = it % I_L;
        if (r < I_IN) {
            const int kb = r / 337, cb = r % 337; const float* src = F.kin[I_WIN] + (size_t)l * DM * P_IN; int ld = P_IN, col0, row0, nc = 32;
            if (cb < 192) { col0 = 32 * cb; row0 = 32 * cb; }
            else if (cb < 288) { col0 = 6160 + 32 * (cb - 192); row0 = 6144 + 32 * (cb - 192); }
            else if (cb < 328) { col0 = 9424 + 32 * (cb - 288); row0 = 9216 + 32 * (cb - 288); }
            else if (cb == 328) { col0 = 6144; row0 = 10496; nc = 16; }
            else if (cb < 335) { col0 = 9232 + 32 * (cb - 329); row0 = 10512 + 32 * (cb - 329); }
            else if (cb == 335) { src = l ? F.kin[I_VRD] + (size_t)(l - 1) * DM * 32 : nullptr; ld = 32; col0 = 0; row0 = 10704; }
            else { src = nullptr; col0 = 0; row0 = 10736; nc = 16; }
            conv_item(src, ld, col0, nc, DM, WSP(bf16, WS_WIN + l * WIN_L), row0, kb, scr, F.lane); continue; }
        r -= I_IN;
        if (r < I_OUT) { const int kb = r / 128, cb = r % 128; conv_item(F.kin[I_WOUT] + (size_t)l * DM * DM, DM, 32 * cb, 32, DM, WSP(bf16, WS_WOUT + l * WOUT_L), 32 * cb, kb, scr, F.lane); continue; }
        r -= I_OUT;
        if (r < I_13) { const int kb = r / 688, cb = r % 688, pn = cb >> 3, wi = cb & 7;
            const float* src = (wi < 4 ? F.kin[I_W1] : F.kin[I_W3]) + (size_t)l * DM * DFF;
            conv_item(src, DFF, 128 * pn + 32 * (wi & 3), 32, DM, WSP(bf16, WS_W13 + l * W13_L), 32 * cb, kb, scr, F.lane); continue; }
        r -= I_13;
        { const int kb = r / 128, cb = r % 128; conv_item(F.kin[I_W2] + (size_t)l * DFF * DM, DM, 32 * cb, 32, DFF, WSP(bf16, WS_W2 + l * W2_L), 32 * cb, kb, scr, F.lane); }
    }
}
__device__ __forceinline__ void p0_prologue_b(Frame& F) {
    const int gt = F.bx * (NWAVES * 64) + F.tid, NT = F.G * NWAVES * 64;
    const float* MODP = WSP(float, WS_MODP); float* MOD = WSP(float, WS_MOD);
    for (int idx = gt; idx < NLAYER * 2 * 24576; idx += NT) {
        const int l = idx / 49152, rem = idx % 49152, b = rem / 24576, n = rem % 24576;
        float s = F.kin[I_ADAB][l * 24576 + n];
#pragma unroll 8
        for (int kc = 0; kc < 32; ++kc) s += MODP[((size_t)(l * 32 + kc) * 2 + b) * 24576 + n];
        MOD[idx] = s;
    }
    if (F.bx == 0) { float* TAB = WSP(float, WS_TAB);
        float tv[6];
#pragma unroll
        for (int q = 0; q < 6; ++q) { const int i = F.tid + NWAVES * 64 * q, hh = i >> 7, d = i & 127; tv[q] = F.kin[I_RELB][t5_bucket(d) * 24 + hh]; }
#pragma unroll
        for (int q = 0; q < 6; ++q) TAB[F.tid + NWAVES * 64 * q] = tv[q] * LOG2E; }
}
__device__ __forceinline__ void rms_phase(Frame& F, const float* xin, const float* sh, const float* sc) {
    const int gw = F.vcu * NWAVES + F.wave, NGW = F.G * NWAVES;
    bf16* XN = WSP(bf16, WS_XN);
    for (int m = gw; m < M; m += NGW) {
        const int b = m >> 13;
        const f32x4* xr = (const f32x4*)(xin + (size_t)m * DM) + F.lane;
        f32x4 v[16]; float ss = 0.f;
#pragma unroll
        for (int j = 0; j < 16; ++j) { v[j] = xr[64 * j]; ss += (v[j].x * v[j].x + v[j].y * v[j].y) + (v[j].z * v[j].z + v[j].w * v[j].w); }
        const float rstd = rsqrtf(wave_sum(ss) * (1.0f / DM) + 1e-6f);
        const f32x4* scp = (const f32x4*)(sc + (size_t)b * 24576) + F.lane; const f32x4* shp = (const f32x4*)(sh + (size_t)b * 24576) + F.lane;
        v2u* o8 = (v2u*)(XN + (size_t)m * DM) + F.lane;
#pragma unroll
        for (int j = 0; j < 16; ++j) { const f32x4 s4 = scp[64 * j], h4 = shp[64 * j]; const f32x4 o = v[j] * rstd * (s4 + 1.0f) + h4;
            v2u w; w.x = pk2(o.x, o.y); w.y = pk2(o.z, o.w); o8[64 * j] = w; }
    }
}
__device__ __forceinline__ void rms_phase_bf(Frame& F, const float* sh, const float* sc) {
    const int gw = F.vcu * NWAVES + F.wave, NGW = F.G * NWAVES;
    bf16* XN = WSP(bf16, WS_XN); const bf16* XR = WSP(bf16, WS_XR);
    for (int m = gw; m < M; m += NGW) {
        const int b = m >> 13;
        const v4u* xr = (const v4u*)(XR + (size_t)m * DM) + F.lane;
        v4u raw[8]; float ss = 0.f;
#pragma unroll
        for (int j = 0; j < 8; ++j) raw[j] = xr[64 * j];
#pragma unroll
        for (int j = 0; j < 8; ++j) { float f[8]; unpack8(raw[j], f);
#pragma unroll
            for (int e = 0; e < 8; ++e) ss += f[e] * f[e]; }
        const float rstd = rsqrtf(wave_sum(ss) * (1.0f / DM) + 1e-6f);
        const float* scp = sc + (size_t)b * 24576 + 8 * F.lane; const float* shp = sh + (size_t)b * 24576 + 8 * F.lane;
        v4u* o16 = (v4u*)(XN + (size_t)m * DM) + F.lane;
#pragma unroll
        for (int j = 0; j < 8; ++j) { float f[8]; unpack8(raw[j], f);
            const f32x4 s0 = *(const f32x4*)(scp + 512 * j), s1 = *(const f32x4*)(scp + 512 * j + 4), h0 = *(const f32x4*)(shp + 512 * j), h1 = *(const f32x4*)(shp + 512 * j + 4);
            float o[8];
#pragma unroll
            for (int e = 0; e < 4; ++e) { o[e] = f[e] * rstd * (s0[e] + 1.0f) + h0[e]; o[4 + e] = f[4 + e] * rstd * (s1[e] + 1.0f) + h1[e]; }
            o16[64 * j] = pack8(o); }
    }
}
__device__ __forceinline__ void prep_norm(Frame& F, int l) {
    const int gw = F.vcu * NWAVES + F.wave, NGW = F.G * NWAVES, lane = F.lane, sub = lane >> 3, ch = lane & 7;
    float gqa[8], gka[8], gqd[8], gkd[8];
#pragma unroll
    for (int e = 0; e < 8; ++e) { gqa[e] = F.kin[I_DQN][l * 64 + ch * 8 + e] * QSCALE; gka[e] = F.kin[I_DKN][l * 64 + ch * 8 + e];
                                  gqd[e] = F.kin[I_SQN][l * 64 + ch * 8 + e] * QSCALE; gkd[e] = F.kin[I_SKN][l * 64 + ch * 8 + e]; }
    const bf16* COLS = WSP(bf16, WS_COLS); bf16* QKA = WSP(bf16, WS_QKA); bf16* QKD = WSP(bf16, WS_QKD);
    for (int m0 = gw; m0 < M; m0 += 2 * NGW) {
        v4u ra[2][4], rd[2][3];
#pragma unroll
        for (int r = 0; r < 2; ++r) { const int m = m0 + r * NGW < M ? m0 + r * NGW : m0; const bf16* src = COLS + (size_t)m * NMAIN;
#pragma unroll
            for (int i = 0; i < 4; ++i) ra[r][i] = *(const v4u*)(src + CA_Q + (i * 8 + sub) * 64 + ch * 8);
#pragma unroll
            for (int i = 0; i < 3; ++i) { const int vec = i * 8 + sub; rd[r][i] = *(const v4u*)(src + CD_Q + (vec < 18 ? vec : 17) * 64 + ch * 8); } }
#pragma unroll
        for (int r = 0; r < 2; ++r) { const int m = m0 + r * NGW; if (m < M) {
#pragma unroll
            for (int i = 0; i < 4; ++i) { const int vec = i * 8 + sub, col = vec * 64 + ch * 8;
                float f[8]; unpack8(ra[r][i], f); float ss = 0.f;
#pragma unroll
                for (int e = 0; e < 8; ++e) ss += f[e] * f[e];
                ss = sum8(ss);
                const float rstd = rsqrtf(ss * (1.0f / 64.0f) + 1e-6f);
#pragma unroll
                for (int e = 0; e < 8; ++e) f[e] = f[e] * rstd * (i < 2 ? gqa[e] : gka[e]);
                *(v4u*)(QKA + (size_t)m * 2048 + col) = pack8(f); }
#pragma unroll
            for (int i = 0; i < 3; ++i) { const int vec = i * 8 + sub, col = vec * 64 + ch * 8;
                float f[8]; unpack8(rd[r][i], f); float ss = 0.f;
#pragma unroll
                for (int e = 0; e < 8; ++e) ss += f[e] * f[e];
                ss = sum8(ss);
                const float rstd = rsqrtf(ss * (1.0f / 64.0f) + 1e-6f);
#pragma unroll
                for (int e = 0; e < 8; ++e) f[e] = f[e] * rstd * (vec < 16 ? gqd[e] : gkd[e]);
                if (vec < 18) *(v4u*)(QKD + (size_t)m * 1152 + col) = pack8(f); } } }
    }
}
__device__ __forceinline__ void prep_loga(Frame& F, int l) {
    LAS float* gdl = (LAS float*)(F.lds + RING_OFF);
    float gu[16];
#pragma unroll
    for (int j = 0; j < 16; ++j) gu[j] = F.kin[I_GGU][((size_t)l * 16 + j) * 512 + F.tid];
    const float bias = F.kin[I_GGB][l * 512 + F.tid];
    const float* LOWR = WSP(float, WS_LOWR); float* LOGA = WSP(float, WS_LOGA);
    for (int tile = F.bx; tile < M / 64; tile += F.G) {
        const size_t row0 = (size_t)tile * 64;
        __syncthreads();
#pragma unroll
        for (int i = 0; i < 2; ++i) { const int idx = F.tid + 512 * i; gdl[idx] = LOWR[(row0 + (idx >> 4)) * 256 + (idx & 15)]; }
        __syncthreads();
#pragma unroll 4
        for (int t = 0; t < 64; ++t) { const LAS f32x4* gp = (const LAS f32x4*)(gdl + t * 16); const f32x4 g0 = gp[0], g1 = gp[1], g2 = gp[2], g3 = gp[3];
            float z = bias + g0.x * gu[0] + g0.y * gu[1] + g0.z * gu[2] + g0.w * gu[3] + g1.x * gu[4] + g1.y * gu[5] + g1.z * gu[6] + g1.w * gu[7]
                    + g2.x * gu[8] + g2.y * gu[9] + g2.z * gu[10] + g2.w * gu[11] + g3.x * gu[12] + g3.y * gu[13] + g3.z * gu[14] + g3.w * gu[15];
            LOGA[(row0 + t) * 512 + F.tid] = (fminf(z, 0.f) - __logf(1.0f + __expf(-fabsf(z)))) * (1.0f / 16.0f); }
    }
}
__device__ __forceinline__ int next_item(Frame& F, gu32* ctr) {
    volatile LAS int* slot = (volatile LAS int*)(F.lds + LDSCTL_OFF + 64);
    __syncthreads();
    if (F.tid == 0) *slot = (int)__hip_atomic_fetch_add(ctr, 1u, RLX_AGENT);
    __syncthreads();
    return *slot;
}
typedef float f32x16 __attribute__((ext_vector_type(16)));
__device__ __forceinline__ float xother32(float v) { unsigned a = __builtin_bit_cast(unsigned, v), b = a; asm volatile("" : "+v"(b)); auto rr = __builtin_amdgcn_permlane32_swap(a, b, false, false);
    const unsigned lo = rr[0], hi = rr[1]; return __builtin_bit_cast(float, (unsigned)((__builtin_amdgcn_mbcnt_hi(~0u, __builtin_amdgcn_mbcnt_lo(~0u, 0u)) & 32u) ? lo : hi)); }
__device__ __forceinline__ float xsum32(float v) { return v + xother32(v); }
__device__ __forceinline__ float xmax32(float v) { return fmaxf(v, xother32(v)); }
__device__ __forceinline__ int crow16(int r, int hi) { return (r & 3) + 8 * (r >> 2) + 4 * hi; }
template <bool ISA>
__device__ __forceinline__ void attn_unit(Frame& F, int l, int b, int hx, int qb) {
    constexpr int DV = ISA ? 128 : 64, NDV = DV / 32, KSTR = ISA ? 272 : 144, VSTR = 144, KBYTES = 64 * KSTR, VBYTES = DV * VSTR, BUFB = KBYTES + VBYTES, NCH = ISA ? 2 : 1;
    constexpr float NEG = -1e30f;
    LAS unsigned char* L = F.lds + RING_OFF;
    const int tid = F.tid, lane = F.lane, r32 = lane & 31, hi = lane >> 5, qs = F.wave & 3, grp = F.wave >> 2, q0 = qb * 128;
    const int kvh = hx >> 2, hd = kvh * 8 + (hx & 3) * 2 + grp;
    const bf16* Qp; const bf16* Kp; const bf16* VT; int ldq;
    if (ISA) { const bf16* QKA = WSP(bf16, WS_QKA); Qp = QKA + (size_t)b * SEQ * 2048 + hx * 128 + grp * 64; Kp = QKA + (size_t)b * SEQ * 2048 + 1024 + hx * 128; ldq = 2048; VT = WSP(bf16, WS_VTA) + (size_t)(b * 8 + hx) * 128 * VROW; }
    else { const bf16* QKD = WSP(bf16, WS_QKD); Qp = QKD + (size_t)b * SEQ * 1152 + hd * 64; Kp = QKD + (size_t)b * SEQ * 1152 + 1024 + kvh * 64; ldq = 1152; VT = WSP(bf16, WS_VTD) + (size_t)(b * 2 + kvh) * 64 * VROW; }
    const int qpos = q0 + 32 * qs + r32;
    bf16x8 qr[4];
#pragma unroll
    for (int d0 = 0; d0 < 4; ++d0) qr[d0] = *(const bf16x8*)(Qp + (size_t)qpos * ldq + d0 * 16 + hi * 8);
    LAS float* Bt = (LAS float*)(L + 2 * BUFB);
    { const float* TAB = WSP(float, WS_TAB);
      if (ISA) { if (tid < 130) Bt[tid] = tid == 0 ? NEG : (tid == 129 ? 0.f : TAB[hx * 128 + tid - 1] - TAB[hx * 128 + 127]); }
      else { if (tid < 260) { const int gi = tid >= 130, t = tid - 130 * gi; Bt[tid] = (t == 0 || t == 129) ? NEG : TAB[(8 + kvh * 8 + (hx & 3) * 2 + gi) * 128 + t - 1]; } } }
    const int TQ = q0 >> 6, T0 = ISA ? 0 : (TQ >= 2 ? TQ - 2 : 0), T1 = TQ + 1;
    v4u kreg[NCH], vreg[NCH];
#define AT_GLOAD(T) do { _Pragma("unroll") for (int i_ = 0; i_ < NCH; ++i_) { const int c_ = tid + 512 * i_; \
        const int kr_ = ISA ? (c_ >> 4) : (c_ >> 3), kc_ = ISA ? (c_ & 15) : (c_ & 7); kreg[i_] = *(const v4u*)(Kp + (size_t)((T) * 64 + kr_) * ldq + kc_ * 8); \
        const int vr_ = c_ >> 3, vc_ = c_ & 7; vreg[i_] = *(const v4u*)(VT + (size_t)vr_ * VROW + (T) * 64 + vc_ * 8); } } while (0)
#define AT_LWRITE(buf) do { _Pragma("unroll") for (int i_ = 0; i_ < NCH; ++i_) { const int c_ = tid + 512 * i_; \
        const int kr_ = ISA ? (c_ >> 4) : (c_ >> 3), kc_ = ISA ? (c_ & 15) : (c_ & 7); *(LAS v4u*)(L + (buf) * BUFB + kr_ * KSTR + kc_ * 16) = kreg[i_]; \
        const int vr_ = c_ >> 3, vc_ = c_ & 7; *(LAS v4u*)(L + (buf) * BUFB + KBYTES + vr_ * VSTR + vc_ * 16) = vreg[i_]; } } while (0)
    f32x16 o[NDV];
#pragma unroll
    for (int i = 0; i < NDV; ++i) o[i] = (f32x16){0.f, 0.f, 0.f, 0.f, 0.f, 0.f, 0.f, 0.f, 0.f, 0.f, 0.f, 0.f, 0.f, 0.f, 0.f, 0.f};
    float m_run = ISA ? NEG : F.kin[I_SSINK][l * 16 + hd] * LOG2E, l_run = ISA ? 0.f : (hi == 0 ? 1.f : 0.f);
    const int krow = (r32 & 16) | (r32 & 3) | ((r32 & 4) << 1) | ((r32 & 8) >> 1);
    const int koff = krow * KSTR + (ISA ? grp * 128 : 0) + hi * 16, voff = KBYTES + r32 * VSTR + hi * 16;
    AT_GLOAD(T0); AT_LWRITE(0); __syncthreads();
#pragma unroll 1
    for (int T = T0; T <= T1; ++T) {
        const int cur = (T - T0) & 1;
        AT_GLOAD(T < T1 ? T + 1 : T1);
        LAS const unsigned char* Kb = L + cur * BUFB;
        f32x16 s[2];
#pragma unroll
        for (int blk = 0; blk < 2; ++blk) { s[blk] = (f32x16){0.f, 0.f, 0.f, 0.f, 0.f, 0.f, 0.f, 0.f, 0.f, 0.f, 0.f, 0.f, 0.f, 0.f, 0.f, 0.f};
#pragma unroll
            for (int d0 = 0; d0 < 4; ++d0) { const bf16x8 kf = *(const LAS bf16x8*)(Kb + koff + blk * 32 * KSTR + d0 * 32); s[blk] = __builtin_amdgcn_mfma_f32_32x32x16_bf16(kf, qr[d0], s[blk], 0, 0, 0); } }
        bf16x8 vfc[NDV], vfn[NDV];
#pragma unroll
        for (int i = 0; i < NDV; ++i) vfc[i] = *(const LAS bf16x8*)(Kb + voff + i * 32 * VSTR);
        if (!ISA || T >= TQ - 2) {
            const LAS float* bt = Bt + (ISA ? 0 : grp * 130) + 1; const int d0 = qpos - T * 64 - 8 * hi;
#pragma unroll
            for (int blk = 0; blk < 2; ++blk)
#pragma unroll
                for (int r = 0; r < 16; ++r) { const int dist = d0 - (32 * blk + 16 * (r >> 3) + (r & 7)); const int di = dist < -1 ? -1 : (dist > 128 ? 128 : dist); s[blk][r] += bt[di]; } }
        float mt = s[0][0];
#pragma unroll
        for (int r = 1; r < 16; ++r) mt = fmaxf(mt, s[0][r]);
#pragma unroll
        for (int r = 0; r < 16; ++r) mt = fmaxf(mt, s[1][r]);
        mt = xmax32(mt);
        const float m_new = fmaxf(m_run, mt);
        if (__any(m_new > m_run)) { const float alpha = __builtin_amdgcn_exp2f(m_run - m_new); l_run *= alpha;
#pragma unroll
            for (int i = 0; i < NDV; ++i)
#pragma unroll
                for (int r = 0; r < 16; ++r) o[i][r] *= alpha;
            m_run = m_new; }
        float ls = 0.f;
#pragma unroll
        for (int blk = 0; blk < 2; ++blk)
#pragma unroll
            for (int r = 0; r < 16; ++r) { const float pv_ = __builtin_amdgcn_exp2f(s[blk][r] - m_run); s[blk][r] = pv_; ls += pv_; }
        l_run += ls;
#pragma unroll
        for (int sl = 0; sl < 4; ++sl) { const int blk = sl >> 1, r0 = 8 * (sl & 1);
            v4u pw; pw.x = pg8::cvt_pk_bf16(s[blk][r0], s[blk][r0 + 1]); pw.y = pg8::cvt_pk_bf16(s[blk][r0 + 2], s[blk][r0 + 3]); pw.z = pg8::cvt_pk_bf16(s[blk][r0 + 4], s[blk][r0 + 5]); pw.w = pg8::cvt_pk_bf16(s[blk][r0 + 6], s[blk][r0 + 7]);
            const bf16x8 pf = __builtin_bit_cast(bf16x8, pw);
#pragma unroll
            for (int i = 0; i < NDV; ++i) { if (sl < 3) vfn[i] = *(const LAS bf16x8*)(Kb + voff + i * 32 * VSTR + (sl + 1) * 32); o[i] = __builtin_amdgcn_mfma_f32_32x32x16_bf16(vfc[i], pf, o[i], 0, 0, 0); }
#pragma unroll
            for (int i = 0; i < NDV; ++i) vfc[i] = vfn[i]; }
        AT_LWRITE(cur ^ 1);
        __syncthreads();
    }
#undef AT_GLOAD
#undef AT_LWRITE
    const float inv = 1.0f / xsum32(l_run);
    bf16* MIX = WSP(bf16, WS_MIXED);
    if (ISA) {
        int ll_ = l; asm volatile("" : "+s"(ll_)); const float lam_init = ll_ == 0 ? 0.2f : 0.35550906759f;     float lam_full;
        { const float* lm = F.kin[I_DLAM] + (size_t)l * 256; const float s1 = wave_sum(lm[lane] * lm[64 + lane]), s2 = wave_sum(lm[128 + lane] * lm[192 + lane]); lam_full = __expf(s1) - __expf(s2) + lam_init; }
        LAS float* R1 = (LAS float*)L;
        LAS bf16* R2 = (LAS bf16*)(L + 66048);
        const int ql = 32 * qs + r32;
        if (grp == 1) {
#pragma unroll
            for (int i = 0; i < NDV; ++i)
#pragma unroll
                for (int r = 0; r < 16; ++r) R1[ql * 129 + 32 * i + crow16(r, hi)] = lam_full * inv * o[i][r]; }
        __syncthreads();
        if (grp == 0) { float ss = 0.f;
#pragma unroll
            for (int i = 0; i < NDV; ++i)
#pragma unroll
                for (int r = 0; r < 16; ++r) { const float d = o[i][r] * inv - R1[ql * 129 + 32 * i + crow16(r, hi)]; o[i][r] = d; ss += d * d; }
            const float rstd = rsqrtf(xsum32(ss) * (1.0f / 128.0f) + 1e-6f) * (1.0f - lam_init);
            const float* sl = F.kin[I_DSUB] + l * 128;
#pragma unroll
            for (int i = 0; i < NDV; ++i)
#pragma unroll
                for (int r = 0; r < 16; ++r) { const int dv = 32 * i + crow16(r, hi); R2[ql * 132 + dv] = (bf16)f2bf(o[i][r] * rstd * sl[dv]); } }
        __syncthreads();
#pragma unroll
        for (int i = 0; i < 4; ++i) { const int c = tid + 512 * i, row = c >> 4, ch = c & 15; const LAS v2u* sp = (const LAS v2u*)(R2 + row * 132 + ch * 8); const v2u a = sp[0], bb = sp[1];
            *(v4u*)(MIX + (size_t)(b * SEQ + q0 + row) * DM + hx * 128 + ch * 8) = (v4u){a.x, a.y, bb.x, bb.y}; }
    } else {
        LAS bf16* R = (LAS bf16*)L + F.wave * 2176;
#pragma unroll
        for (int i = 0; i < NDV; ++i)
#pragma unroll
            for (int r = 0; r < 16; ++r) R[r32 * 68 + 32 * i + crow16(r, hi)] = (bf16)f2bf(o[i][r] * inv);
#pragma unroll
        for (int i = 0; i < 4; ++i) { const int c = lane + 64 * i, row = c >> 3, ch = c & 7; const LAS v2u* sp = (const LAS v2u*)(R + row * 68 + ch * 8); const v2u a = sp[0], bb = sp[1];
            *(v4u*)(MIX + (size_t)(b * SEQ + q0 + 32 * qs + row) * DM + 3072 + hd * 64 + ch * 8) = (v4u){a.x, a.y, bb.x, bb.y}; }
    }
}
__device__ __forceinline__ void prep_gla(Frame& F) {
    LAS float* Lb = (LAS float*)(F.lds + RING_OFF); LAS float* Qd = Lb + 64 * 129; LAS float* Ki = Qd + 64 * 129; LAS bf16* Kt = (LAS bf16*)(Ki + 64 * 129);
    const bf16* COLS = WSP(bf16, WS_COLS); const float* LOGA = WSP(float, WS_LOGA);
    bf16* QDEC = WSP(bf16, WS_QDEC); bf16* KDT = WSP(bf16, WS_KDT); bf16* AMg = WSP(bf16, WS_AM); float* EBL = WSP(float, WS_EBL);
    for (int u = F.bx; u < 1024; u += F.G) {
        const int b = u >> 9, h = (u >> 7) & 3, ck = u & 127; const size_t row0 = (size_t)b * SEQ + ck * 64;
        __syncthreads();
        f32x4 lg[4]; v4u qv[2], kv[2];
#pragma unroll
        for (int i = 0; i < 4; ++i) { const int i4 = F.tid + 512 * i, t = i4 >> 5, d4 = (i4 & 31) * 4; lg[i] = *(const f32x4*)(LOGA + (row0 + t) * 512 + h * 128 + d4); }
#pragma unroll
        for (int i = 0; i < 2; ++i) { const int i8 = F.tid + 512 * i, t = i8 >> 4, d8 = (i8 & 15) * 8; const bf16* p = COLS + (row0 + t) * NMAIN + h * 128 + d8; qv[i] = *(const v4u*)(p + CB_Q); kv[i] = *(const v4u*)(p + CB_K); }
#pragma unroll
        for (int i = 0; i < 4; ++i) { const int i4 = F.tid + 512 * i, t = i4 >> 5, d4 = (i4 & 31) * 4;
#pragma unroll
            for (int e = 0; e < 4; ++e) Lb[t * 129 + d4 + e] = lg[i][e]; }
        __syncthreads();
        if (F.tid < 128) { float a[64];
#pragma unroll
            for (int t = 0; t < 64; ++t) a[t] = Lb[t * 129 + F.tid];
#pragma unroll
            for (int t = 1; t < 64; ++t) a[t] += a[t - 1];
#pragma unroll
            for (int t = 0; t < 64; ++t) Lb[t * 129 + F.tid] = a[t];
            EBL[(size_t)u * 128 + F.tid] = __expf(a[63]); }
        __syncthreads();
#pragma unroll
        for (int i = 0; i < 2; ++i) { const int i8 = F.tid + 512 * i, t = i8 >> 4, d8 = (i8 & 15) * 8; float q[8], k[8], qo[8]; unpack8(qv[i], q); unpack8(kv[i], k);
#pragma unroll
            for (int e = 0; e < 8; ++e) { const int d = d8 + e; const float bt = Lb[t * 129 + d], bl = Lb[63 * 129 + d];
                const float qd = q[e] * 0.08838834764831845f * __expf(bt); Qd[t * 129 + d] = qd; Ki[t * 129 + d] = k[e] * __expf(-bt); Kt[d * 72 + t] = (bf16)f2bf(k[e] * __expf(bl - bt)); qo[e] = qd; }
            *(v4u*)(QDEC + ((size_t)u * 64 + t) * 128 + d8) = pack8(qo); }
        __syncthreads();
#pragma unroll
        for (int i = 0; i < 2; ++i) { const int c_ = F.tid + 512 * i, row = c_ >> 3, ch = c_ & 7; const LAS v2u* sp = (const LAS v2u*)(Kt + row * 72 + ch * 8); const v2u a = sp[0], bb = sp[1];
            *(v4u*)(KDT + ((size_t)u * 128 + row) * 64 + ch * 8) = (v4u){a.x, a.y, bb.x, bb.y}; }
        {
          const int n = F.lane & 15, gq = F.lane >> 4, ct = F.wave >> 1, st0 = 2 * (F.wave & 1);
          f32x4 c0 = (f32x4){0.f, 0.f, 0.f, 0.f}, c1 = (f32x4){0.f, 0.f, 0.f, 0.f};
          if (st0 <= ct) {
              const LAS float* ap = Qd + (16 * ct + n) * 129 + gq; const LAS float* bp0 = Ki + (16 * st0 + n) * 129 + gq; const LAS float* bp1 = bp0 + 16 * 129;
#pragma unroll 8
              for (int ks = 0; ks < 32; ++ks) { const float av = ap[4 * ks]; c0 = __builtin_amdgcn_mfma_f32_16x16x4f32(av, bp0[4 * ks], c0, 0, 0, 0); c1 = __builtin_amdgcn_mfma_f32_16x16x4f32(av, bp1[4 * ks], c1, 0, 0, 0); } }
#pragma unroll
          for (int rr = 0; rr < 4; ++rr) { const int c = 16 * ct + 4 * gq + rr, s0 = 16 * st0 + n, s1 = s0 + 16;
              bf16* op = AMg + ((size_t)u * 64 + c) * 64; op[s0] = (bf16)f2bf(s0 <= c ? c0[rr] : 0.f); op[s1] = (bf16)f2bf(s1 <= c ? c1[rr] : 0.f); } }
    }
}
template <int PASS> __device__ __forceinline__ void prep_vt(Frame& F) {
    LAS bf16* T = (LAS bf16*)(F.lds + RING_OFF);
    const bf16* COLS = WSP(bf16, WS_COLS);
    constexpr int ncol = PASS == 4 ? 128 : 512, nch = ncol >> 3, NI = 64 * nch / (NWAVES * 64);
    constexpr int col0 = PASS < 2 ? CA_V + 512 * PASS : (PASS < 4 ? CB_V + 512 * (PASS - 2) : CD_V);
    bf16* dst0 = PASS < 2 ? WSP(bf16, WS_VTA) + (size_t)(512 * PASS) * VROW : (PASS < 4 ? WSP(bf16, WS_VTB) + (size_t)(512 * (PASS - 2)) * VROW : WSP(bf16, WS_VTD));
    constexpr int rows_b = PASS == 4 ? 128 : 1024;
    for (int tile = F.bx; tile < M / 64; tile += F.G) {
        const int b = tile >> 7, t0 = (tile & 127) * 64;
        __syncthreads();
        v4u v[NI];
#pragma unroll
        for (int i = 0; i < NI; ++i) { const int idx = F.tid + NWAVES * 64 * i, tok = idx / nch, ch = idx % nch; v[i] = *(const v4u*)(COLS + (size_t)(b * SEQ + t0 + tok) * NMAIN + col0 + ch * 8); }
#pragma unroll
        for (int i = 0; i < NI; ++i) { const int idx = F.tid + NWAVES * 64 * i, tok = idx / nch, ch = idx % nch; LAS unsigned* d = (LAS unsigned*)(T + tok * 522 + ch * 8); d[0] = v[i].x; d[1] = v[i].y; d[2] = v[i].z; d[3] = v[i].w; }
        __syncthreads();
#pragma unroll
        for (int i = 0; i < NI; ++i) { const int idx = F.tid + NWAVES * 64 * i, vrow = idx >> 3, ch = idx & 7;
            unsigned e[8];
#pragma unroll
            for (int k = 0; k < 8; ++k) e[k] = T[(ch * 8 + k) * 522 + vrow];
            v4u o; o.x = e[0] | (e[1] << 16); o.y = e[2] | (e[3] << 16); o.z = e[4] | (e[5] << 16); o.w = e[6] | (e[7] << 16);
            *(v4u*)(dst0 + ((size_t)b * rows_b + vrow) * VROW + t0 + ch * 8) = o; }
    }
}
typedef float f32x4v __attribute__((ext_vector_type(4)));
__device__ __forceinline__ float sum16(float v) { v = sum8(v); v += dpp_f<0x140>(v); return v; }
#define LDS_BARRIER() asm volatile("s_waitcnt lgkmcnt(0)\n\ts_barrier" ::: "memory")
template <int HACK = 0> __device__ __forceinline__ void gla_scan_unit(Frame& F, int l, int b, int h, int vh) {
    LAS unsigned char* L = F.lds + RING_OFF;
    constexpr int OQD = 0, OKT = 17408, OAM = 35840, OVT = 45056, OOT = 63488, OEB = 80896, OPS = 81408;
    const int tid = F.tid, lane = F.lane, n = lane & 15, g = lane >> 4, w = F.wave;
    const bf16* QDEC = WSP(bf16, WS_QDEC); const bf16* KDT = WSP(bf16, WS_KDT); const bf16* AMg = WSP(bf16, WS_AM); const float* EBL = WSP(float, WS_EBL);
    const bf16* VTB = WSP(bf16, WS_VTB) + (size_t)((b * 4 + h) * 256 + 128 * vh) * VROW; bf16* OB = WSP(bf16, WS_OB); float* PSG = WSP(float, WS_PSG);
    f32x4v S[8];
#pragma unroll
    for (int dt = 0; dt < 8; ++dt) S[dt] = (f32x4v){0.f, 0.f, 0.f, 0.f};
    v4u pq[2], pk[2], pa, pv[2]; float pe = 0.f;
#define GL_ISSUE(CK) do { const size_t u_ = (size_t)(b * 4 + h) * 128 + (CK); \
        _Pragma("unroll") for (int i = 0; i < 2; ++i) { const int c_ = tid + 512 * i; pq[i] = *(const v4u*)(QDEC + (u_ * 64 + (c_ >> 4)) * 128 + (c_ & 15) * 8); pk[i] = *(const v4u*)(KDT + (u_ * 128 + (c_ >> 3)) * 64 + (c_ & 7) * 8); \
            pv[i] = *(const v4u*)(VTB + (size_t)(c_ >> 3) * VROW + (CK) * 64 + (c_ & 7) * 8); } \
        pa = *(const v4u*)(AMg + (u_ * 64 + (tid >> 3)) * 64 + (tid & 7) * 8); \
        pe = EBL[u_ * 128 + (tid & 127)]; } while (0)
#define GL_WRITE() do { _Pragma("unroll") for (int i = 0; i < 2; ++i) { const int c_ = tid + 512 * i; *(LAS v4u*)(L + OQD + (c_ >> 4) * 272 + (c_ & 15) * 16) = pq[i]; *(LAS v4u*)(L + OKT + (c_ >> 3) * 144 + (c_ & 7) * 16) = pk[i]; \
            *(LAS v4u*)(L + OVT + (c_ >> 3) * 144 + (c_ & 7) * 16) = pv[i]; } \
        *(LAS v4u*)(L + OAM + (tid >> 3) * 144 + (tid & 7) * 16) = pa; \
        ((LAS float*)(L + OEB))[tid & 127] = pe; } while (0)
    GL_ISSUE(0); GL_WRITE();
    LDS_BARRIER();
#pragma unroll 1
    for (int ck = 0; ck < 128; ++ck) {
        const size_t row0 = (size_t)b * SEQ + ck * 64;
        GL_ISSUE((HACK & 1) && ck >= 2 ? 2 : (ck + 1 < 128 ? ck + 1 : 127));
        bf16x8 vf[2];
#pragma unroll
        for (int ks = 0; ks < 2; ++ks) vf[ks] = *(const LAS bf16x8*)(L + OVT + (16 * w + n) * 144 + (32 * ks + 8 * g) * 2);
        f32x4v o[4];
#pragma unroll
        for (int ct = 0; ct < 4; ++ct) o[ct] = (f32x4v){0.f, 0.f, 0.f, 0.f};
#pragma unroll
        for (int ct = 0; ct < 4; ++ct)
#pragma unroll
            for (int ks = 0; ks < 2; ++ks) { const bf16x8 af = *(const LAS bf16x8*)(L + OAM + (16 * ct + n) * 144 + (32 * ks + 8 * g) * 2); o[ct] = __builtin_amdgcn_mfma_f32_16x16x32_bf16(af, vf[ks], o[ct], 0, 0, 0); }
#pragma unroll
        for (int kk = 0; kk < 4; ++kk) { v4u pw; pw.x = pg8::cvt_pk_bf16(S[2 * kk][0], S[2 * kk][1]); pw.y = pg8::cvt_pk_bf16(S[2 * kk][2], S[2 * kk][3]);
            pw.z = pg8::cvt_pk_bf16(S[2 * kk + 1][0], S[2 * kk + 1][1]); pw.w = pg8::cvt_pk_bf16(S[2 * kk + 1][2], S[2 * kk + 1][3]); const bf16x8 sf = __builtin_bit_cast(bf16x8, pw);
#pragma unroll
            for (int ct = 0; ct < 4; ++ct) { const LAS unsigned char* qp = L + OQD + (16 * ct + n) * 272 + (32 * kk + 4 * g) * 2; const v2u qa = *(const LAS v2u*)qp, qb = *(const LAS v2u*)(qp + 32);
                o[ct] = __builtin_amdgcn_mfma_f32_16x16x32_bf16(__builtin_bit_cast(bf16x8, (v4u){qa.x, qa.y, qb.x, qb.y}), sf, o[ct], 0, 0, 0); } }
#pragma unroll
        for (int dt = 0; dt < 8; ++dt) { const f32x4v eb = *(const LAS f32x4v*)(L + OEB + (16 * dt + 4 * g) * 4); S[dt] = S[dt] * eb;
#pragma unroll
            for (int ks = 0; ks < 2; ++ks) { const bf16x8 kf = *(const LAS bf16x8*)(L + OKT + (16 * dt + n) * 144 + (32 * ks + 8 * g) * 2); S[dt] = __builtin_amdgcn_mfma_f32_16x16x32_bf16(kf, vf[ks], S[dt], 0, 0, 0); } }
        LAS float* PS = (LAS float*)(L + OPS) + (ck & 1) * 512;
#pragma unroll
        for (int ct = 0; ct < 4; ++ct)
#pragma unroll
            for (int r = 0; r < 4; ++r) { const float ss = sum16(o[ct][r] * o[ct][r]); if (n == 0) PS[(16 * ct + 4 * g + r) * 8 + w] = ss;
                *(LAS bf16*)(L + OOT + (16 * ct + 4 * g + r) * 272 + (16 * w + n) * 2) = (bf16)f2bf(o[ct][r]); }
        LDS_BARRIER();
        GL_WRITE();
        if (!(HACK & 2)) {
#pragma unroll
        for (int i = 0; i < 2; ++i) { const int c_ = tid + 512 * i, tok = c_ >> 4, ch = c_ & 15; *(v4u*)(OB + (row0 + tok) * 1024 + h * 256 + 128 * vh + ch * 8) = *(const LAS v4u*)(L + OOT + tok * 272 + ch * 16); }
        if (tid < 64) { const LAS f32x4v* pp = (const LAS f32x4v*)(PS + tid * 8); const f32x4v p0 = pp[0], p1 = pp[1]; PSG[(row0 + tid) * 8 + h * 2 + vh] = ((p0.x + p0.y) + (p0.z + p0.w)) + ((p1.x + p1.y) + (p1.z + p1.w)); } }
        LDS_BARRIER();
    }
#undef GL_ISSUE
#undef GL_WRITE
}
__device__ __forceinline__ void gla_post(Frame& F, int l) {
    const bf16* OB = WSP(bf16, WS_OB); const float* PSG = WSP(float, WS_PSG); const bf16* COLS = WSP(bf16, WS_COLS); bf16* MIX = WSP(bf16, WS_MIXED);
    const int ch = F.tid & 127, h = ch >> 5; float gain8[8];
#pragma unroll
    for (int e = 0; e < 8; ++e) gain8[e] = F.kin[I_GON][l * 256 + (ch & 31) * 8 + e];
    for (int row0 = F.bx * 4 + (F.tid >> 7); row0 < M; row0 += F.G * 16) {
        v4u ovr[4], gvr[4]; f32x2_t ps[4];
#pragma unroll
        for (int i = 0; i < 4; ++i) { const int row = row0 + F.G * 4 * i < M ? row0 + F.G * 4 * i : row0;
            ovr[i] = *(const v4u*)(OB + (size_t)row * 1024 + ch * 8); gvr[i] = *(const v4u*)(COLS + (size_t)row * NMAIN + CB_G + ch * 8); ps[i] = *(const f32x2_t*)(PSG + (size_t)row * 8 + h * 2); }
#pragma unroll
        for (int i = 0; i < 4; ++i) { const int row = row0 + F.G * 4 * i; float ov[8], gv[8]; unpack8(ovr[i], ov); unpack8(gvr[i], gv);
            const float rstd = rsqrtf((ps[i].x + ps[i].y) * (1.0f / 256.0f) + 1e-6f);
#pragma unroll
            for (int e = 0; e < 8; ++e) ov[e] = ov[e] * (rstd * gain8[e]) * silu_g(gv[e]);
            if (row < M) *(v4u*)(MIX + (size_t)row * DM + 1024 + ch * 8) = pack8(ov); }
    }
}
constexpr int RC_AT = 0, RC_RT = 2048, RC_BK = 4096, RC_VF = 8192, RC_GF = 10240, RC_U0 = 12288, RC_Y0 = 16384, RC_P15 = 20480, RC_BN = 20736, RC_BYTES = 20800;
__device__ __forceinline__ void rwkv_chunks_of_tile(Frame& F, int l, int tile) {
    const int team = F.tid >> 8, tt = F.tid & 255;
    LAS float* Lt = (LAS float*)(F.lds + RING_OFF) + team * 12288;
    LAS float* XA = Lt; LAS float* XR = Lt + 1040; LAS float* ZB = Lt + 2080; LAS float* ZK = Lt + 3120; LAS float* TB = Lt + 4160; LAS float* TK = Lt + 5200; LAS float* VV = Lt + 6240;
    LAS float* ATl = Lt + 7280; LAS float* U0l = Lt + 8320; LAS float* W1 = Lt + 9360;
    LAS float* Aab = Lt + 10400; LAS float* Aak = Lt + 10672; LAS float* Arb = Lt + 10944; LAS float* Ark = Lt + 11216; LAS float* TT = Lt + 11488;
    const float* RW = WSP(float, WS_RW); const unsigned* RWU = WSP(unsigned, WS_RW); constexpr size_t RS = RW_ONE / 4; unsigned char* RWC = F.ws + WS_RWC;
    float pw_[6], pr_[4], pk_[4], pv_[4], pa_[4], pb_[4], pg_[4];
#define RC_FETCH(P) do { const int h_ = 2 * (P) + team; const size_t cb_ = (size_t)tile * 16 * 1024 + h_ * 64 + (tt & 63); const int q_ = tt >> 6; \
        pw_[4] = RW[RS + cb_ + (size_t)(q_ ? 4 * q_ - 1 : 0) * 1024]; pw_[5] = RW[RS + cb_ + (size_t)15 * 1024];            \
        _Pragma("unroll") for (int e = 0; e < 4; ++e) { const size_t o_ = cb_ + (size_t)(4 * q_ + e) * 1024; pw_[e] = RW[RS + o_]; const unsigned u0 = RWU[o_], u2 = RWU[2 * RS + o_], u3 = RWU[3 * RS + o_]; \
            pr_[e] = bflo(u0); pk_[e] = bfhi(u0); pv_[e] = bflo(u2); pg_[e] = bfhi(u2); pa_[e] = bflo(u3); pb_[e] = bfhi(u3); } } while (0)
    RC_FETCH(0);
#pragma unroll 1
    for (int pair = 0; pair < 8; ++pair) {
        const int uc = ((tile >> 9) * 16 + 2 * pair + team) * 512 + (tile & 511), b = uc >> 13, h = (uc >> 9) & 15, ck = uc & 511; unsigned char* rec = RWC + ((size_t)ck * 32 + (uc >> 9)) * RC_BYTES;     (void)b;
        __syncthreads();
        {
          const int j = tt & 63, q = tt >> 6;
          const float cl = pw_[5], clm = q ? pw_[4] : 0.f; const float clq[4] = {pw_[0], pw_[1], pw_[2], pw_[3]};
#pragma unroll
          for (int e = 0; e < 4; ++e) { const int t = 4 * q + e; const float cprev = e == 0 ? clm : clq[e - 1], cc = clq[e];
              const float rr = pr_[e], kk = pk_[e], vv = pv_[e], aa = pa_[e], bb = pb_[e];
              XA[t * 65 + j] = aa * __expf(cprev); XR[t * 65 + j] = rr * __expf(cc); const float ei = __expf(-cc), ef = __expf(cl - cc);
              ZB[t * 65 + j] = bb * ei; ZK[t * 65 + j] = kk * ei; TB[t * 65 + j] = bb * ef; TK[t * 65 + j] = kk * ef; VV[t * 65 + j] = vv; }
          if (q == 0) ((float*)(rec + RC_P15))[j] = __expf(cl);
          { v2u gw; gw.x = pk2(pg_[0], pg_[1]); gw.y = pk2(pg_[2], pg_[3]); *(v2u*)(rec + RC_GF + (((j >> 4) * 64 + 16 * q + (j & 15)) * 8)) = gw; } }
        RC_FETCH(pair < 7 ? pair + 1 : 7);
        __syncthreads();
        {
          const int q = tt >> 6, n = tt & 15, g = (tt >> 4) & 3; const LAS float* X = (q & 2) ? XR : XA; const LAS float* Z = (q & 1) ? ZK : ZB; LAS float* O = q == 0 ? Aab : (q == 1 ? Aak : (q == 2 ? Arb : Ark));
          f32x4v c = (f32x4v){0.f, 0.f, 0.f, 0.f};
#pragma unroll
          for (int ks = 0; ks < 16; ++ks) c = __builtin_amdgcn_mfma_f32_16x16x4f32(X[n * 65 + 4 * ks + g], Z[n * 65 + 4 * ks + g], c, 0, 0, 0);
#pragma unroll
          for (int rr = 0; rr < 4; ++rr) { const int t = 4 * g + rr; O[t * 17 + n] = ((q & 2) ? n <= t : n < t) ? c[rr] : 0.f; }
          { const int t = tt >> 4, jq = tt & 15; const float* rkp = F.kin[I_RRK] + l * 1024 + h * 64 + 4 * jq; float bn = 0.f;
#pragma unroll
            for (int e = 0; e < 4; ++e) bn += XR[t * 65 + 4 * jq + e] * ZK[t * 65 + 4 * jq + e] * rkp[e];
            bn = sum16(bn); if (jq == 0) ((float*)(rec + RC_BN))[t] = bn; } }
        __syncthreads();
        {
          if (tt < 16) { float col[16];
#pragma unroll
              for (int t = 0; t < 16; ++t) { float acc = (t == tt) ? 1.f : 0.f;
#pragma unroll
                  for (int s = 0; s < 16; ++s) if (s < t) acc += Aab[t * 17 + s] * col[s];
                  col[t] = acc; TT[t * 17 + tt] = acc; } }
          const int q = tt >> 6, n = tt & 15, g = (tt >> 4) & 3; f32x4v c = (f32x4v){0.f, 0.f, 0.f, 0.f};
#pragma unroll
          for (int ks = 0; ks < 4; ++ks) c = __builtin_amdgcn_mfma_f32_16x16x4f32(Aak[n * 17 + 4 * ks + g], VV[(4 * ks + g) * 65 + 16 * q + n], c, 0, 0, 0);
#pragma unroll
          for (int rr = 0; rr < 4; ++rr) W1[(4 * g + rr) * 65 + 16 * q + n] = c[rr]; }
        __syncthreads();
        {
          const int q = tt >> 6, n = tt & 15, g = (tt >> 4) & 3; f32x4v ca = (f32x4v){0.f, 0.f, 0.f, 0.f}, cu = (f32x4v){0.f, 0.f, 0.f, 0.f};
#pragma unroll
          for (int ks = 0; ks < 4; ++ks) { const float tv = TT[n * 17 + 4 * ks + g]; ca = __builtin_amdgcn_mfma_f32_16x16x4f32(tv, XA[(4 * ks + g) * 65 + 16 * q + n], ca, 0, 0, 0); cu = __builtin_amdgcn_mfma_f32_16x16x4f32(tv, W1[(4 * ks + g) * 65 + 16 * q + n], cu, 0, 0, 0); }
#pragma unroll
          for (int rr = 0; rr < 4; ++rr) { ATl[(4 * g + rr) * 65 + 16 * q + n] = ca[rr]; U0l[(4 * g + rr) * 65 + 16 * q + n] = cu[rr]; }
          *(f32x4v*)(rec + RC_U0 + ((q * 64 + 16 * g + n) * 16)) = cu; }
        __syncthreads();
        {
          const int q = tt >> 6, n = tt & 15, g = (tt >> 4) & 3; f32x4v cr, cy = (f32x4v){0.f, 0.f, 0.f, 0.f};
#pragma unroll
          for (int rr = 0; rr < 4; ++rr) cr[rr] = XR[(4 * g + rr) * 65 + 16 * q + n];
#pragma unroll
          for (int ks = 0; ks < 4; ++ks) { const float arb = Arb[n * 17 + 4 * ks + g], ark = Ark[n * 17 + 4 * ks + g];
              cr = __builtin_amdgcn_mfma_f32_16x16x4f32(arb, ATl[(4 * ks + g) * 65 + 16 * q + n], cr, 0, 0, 0);
              cy = __builtin_amdgcn_mfma_f32_16x16x4f32(arb, U0l[(4 * ks + g) * 65 + 16 * q + n], cy, 0, 0, 0);
              cy = __builtin_amdgcn_mfma_f32_16x16x4f32(ark, VV[(4 * ks + g) * 65 + 16 * q + n], cy, 0, 0, 0); }
          *(f32x4v*)(rec + RC_Y0 + ((q * 64 + 16 * g + n) * 16)) = cy;
#pragma unroll
          for (int rr = 0; rr < 4; ++rr) W1[(4 * g + rr) * 65 + 16 * q + n] = cr[rr]; }
        __syncthreads();
        { const int t = tt & 15, jq = tt >> 4, kk = jq >> 3, half = (jq & 7) >> 2, g = jq & 3, j0 = 4 * jq;
          v2u wa, wr; wa.x = pk2(ATl[t * 65 + j0], ATl[t * 65 + j0 + 1]); wa.y = pk2(ATl[t * 65 + j0 + 2], ATl[t * 65 + j0 + 3]); wr.x = pk2(W1[t * 65 + j0], W1[t * 65 + j0 + 1]); wr.y = pk2(W1[t * 65 + j0 + 2], W1[t * 65 + j0 + 3]);
          *(v2u*)(rec + RC_AT + kk * 1024 + (16 * g + t) * 16 + half * 8) = wa; *(v2u*)(rec + RC_RT + kk * 1024 + (16 * g + t) * 16 + half * 8) = wr;
          const int j = tt & 63, gg = tt >> 6; v4u bk; bk.x = pk2(TB[(4 * gg) * 65 + j], TB[(4 * gg + 1) * 65 + j]); bk.y = pk2(TB[(4 * gg + 2) * 65 + j], TB[(4 * gg + 3) * 65 + j]);
          bk.z = pk2(TK[(4 * gg) * 65 + j], TK[(4 * gg + 1) * 65 + j]); bk.w = pk2(TK[(4 * gg + 2) * 65 + j], TK[(4 * gg + 3) * 65 + j]);
          *(v4u*)(rec + RC_BK + (j >> 4) * 1024 + (16 * gg + (j & 15)) * 16) = bk;
          v2u vf; vf.x = pk2(VV[(4 * gg) * 65 + j], VV[(4 * gg + 1) * 65 + j]); vf.y = pk2(VV[(4 * gg + 2) * 65 + j], VV[(4 * gg + 3) * 65 + j]);
          *(v2u*)(rec + RC_VF + ((j >> 4) * 64 + 16 * gg + (j & 15)) * 8) = vf; }
    }
}
#undef RC_FETCH
template <int HACK = 0> __device__ __forceinline__ void rwkv_scan_unit(Frame& F, int l, int b, int h) {
    LAS unsigned char* L = F.lds + RING_OFF;
    const unsigned char* recs = F.ws + WS_RWC + (size_t)(b * 16 + h) * RC_BYTES;
    const int lane = F.lane, n = lane & 15, g = lane >> 4;
    LAS float* XS = (LAS float*)(L + 2 * RC_BYTES);
    if (F.wave >= 2) {
        const int li = F.tid - 128;
        int px[4];
#pragma unroll
        for (int k = 0; k < 4; ++k) { const int x = li + 384 * k; px[k] = x < 1300 ? x : 1299; }
        v4u p0[4], p1[4], p2[4], p3[4], p4[4], p5[4], p6[4], p7[4];
#define RWL_ISSUE(P, CK) do { const int ck_ = (CK) < 512 ? ((HACK & 1) && (CK) >= 4 ? 3 : (CK)) : 511; const v4u* src_ = (const v4u*)(recs + (size_t)ck_ * 32 * RC_BYTES); \
        _Pragma("unroll") for (int k = 0; k < 4; ++k) P[k] = src_[px[k]]; } while (0)
#define RWL_WRITE(P, CK) do { LAS v4u* dst_ = (LAS v4u*)(L + ((CK) & 1) * RC_BYTES); _Pragma("unroll") for (int k = 0; k < 4; ++k) dst_[px[k]] = P[k]; } while (0)
        RWL_ISSUE(p0, 0); RWL_ISSUE(p1, 1); RWL_ISSUE(p2, 2); RWL_ISSUE(p3, 3); RWL_ISSUE(p4, 4); RWL_ISSUE(p5, 5); RWL_ISSUE(p6, 6); RWL_ISSUE(p7, 7);
        RWL_WRITE(p0, 0); RWL_ISSUE(p0, 8);
        LDS_BARRIER();
#pragma unroll 1
        for (int ck = 0; ck < 512; ck += 8) {
            RWL_WRITE(p1, ck + 1); RWL_ISSUE(p1, ck + 9); LDS_BARRIER();
            RWL_WRITE(p2, ck + 2); RWL_ISSUE(p2, ck + 10); LDS_BARRIER();
            RWL_WRITE(p3, ck + 3); RWL_ISSUE(p3, ck + 11); LDS_BARRIER();
            RWL_WRITE(p4, ck + 4); RWL_ISSUE(p4, ck + 12); LDS_BARRIER();
            RWL_WRITE(p5, ck + 5); RWL_ISSUE(p5, ck + 13); LDS_BARRIER();
            RWL_WRITE(p6, ck + 6); RWL_ISSUE(p6, ck + 14); LDS_BARRIER();
            RWL_WRITE(p7, ck + 7); RWL_ISSUE(p7, ck + 15); LDS_BARRIER();
            RWL_WRITE(p0, ck + 8); RWL_ISSUE(p0, ck + 16); LDS_BARRIER();
        }
#undef RWL_ISSUE
#undef RWL_WRITE
        return;
    }
    const int cw = F.wave;
    f32x4v S[4][2];
#pragma unroll
    for (int jt = 0; jt < 4; ++jt)
#pragma unroll
        for (int it = 0; it < 2; ++it) S[jt][it] = (f32x4v){0.f, 0.f, 0.f, 0.f};
    float lnw[2], lnb[2];
#pragma unroll
    for (int it = 0; it < 2; ++it) { lnw[it] = F.kin[I_RLNW][l * 1024 + h * 64 + 16 * (2 * cw + it) + n]; lnb[it] = F.kin[I_RLNB][l * 1024 + h * 64 + 16 * (2 * cw + it) + n]; }
    bf16* MIX = WSP(bf16, WS_MIXED) + ((size_t)b * SEQ) * DM + 2048 + h * 64 + 32 * cw + n;
    f32x4v Yp[2] = {(f32x4v){0.f, 0.f, 0.f, 0.f}, (f32x4v){0.f, 0.f, 0.f, 0.f}}, bnp = (f32x4v){0.f, 0.f, 0.f, 0.f}; v2u gfp[2] = {(v2u){0u, 0u}, (v2u){0u, 0u}}, vfp[2] = {(v2u){0u, 0u}, (v2u){0u, 0u}};
    LDS_BARRIER();
#pragma unroll 1
    for (int ck = 0; ck <= 512; ++ck) {
        if (ck > 0) {
            const LAS float* xs = XS + ((ck - 1) & 1) * 64; const f32x4v a0 = *(const LAS f32x4v*)(xs + 8 * g), a1 = *(const LAS f32x4v*)(xs + 8 * g + 4), b0 = *(const LAS f32x4v*)(xs + 32 + 8 * g), b1 = *(const LAS f32x4v*)(xs + 32 + 8 * g + 4);
            const float s1[4] = {a0[0] + b0[0], a0[2] + b0[2], a1[0] + b1[0], a1[2] + b1[2]}, s2[4] = {a0[1] + b0[1], a0[3] + b0[3], a1[1] + b1[1], a1[3] + b1[3]};
#pragma unroll
            for (int it = 0; it < 2; ++it) { const float gt[4] = {bflo(gfp[it].x), bfhi(gfp[it].x), bflo(gfp[it].y), bfhi(gfp[it].y)}, vt[4] = {bflo(vfp[it].x), bfhi(vfp[it].x), bflo(vfp[it].y), bfhi(vfp[it].y)};
#pragma unroll
                for (int r = 0; r < 4; ++r) { const float mean = s1[r] * (1.0f / 64.0f), var = fmaxf(s2[r] * (1.0f / 64.0f) - mean * mean, 0.f), rstd = rsqrtf(var + 64e-5f);
                    if (!(HACK & 2)) MIX[(size_t)((ck - 1) * 16 + 4 * g + r) * DM + 16 * it] = (bf16)f2bf(((Yp[it][r] - mean) * rstd * lnw[it] + lnb[it] + bnp[r] * vt[r]) * gt[r]); } }
            if (ck == 512) break;
        }
        if (HACK & 4) { LDS_BARRIER(); continue; }
        const LAS unsigned char* R = L + (ck & 1) * RC_BYTES;
        bf16x8 at[2], rt[2];
#pragma unroll
        for (int kk = 0; kk < 2; ++kk) { at[kk] = *(const LAS bf16x8*)(R + RC_AT + kk * 1024 + lane * 16); rt[kk] = *(const LAS bf16x8*)(R + RC_RT + kk * 1024 + lane * 16); }
        f32x4v U[2], Y[2];
#pragma unroll
        for (int it = 0; it < 2; ++it) { U[it] = *(const LAS f32x4v*)(R + RC_U0 + (2 * cw + it) * 1024 + lane * 16); Y[it] = *(const LAS f32x4v*)(R + RC_Y0 + (2 * cw + it) * 1024 + lane * 16); }
#pragma unroll
        for (int kk = 0; kk < 2; ++kk)
#pragma unroll
            for (int it = 0; it < 2; ++it) { v4u pw; pw.x = pg8::cvt_pk_bf16(S[2 * kk][it][0], S[2 * kk][it][1]); pw.y = pg8::cvt_pk_bf16(S[2 * kk][it][2], S[2 * kk][it][3]);
                pw.z = pg8::cvt_pk_bf16(S[2 * kk + 1][it][0], S[2 * kk + 1][it][1]); pw.w = pg8::cvt_pk_bf16(S[2 * kk + 1][it][2], S[2 * kk + 1][it][3]); const bf16x8 sf = __builtin_bit_cast(bf16x8, pw);
                U[it] = __builtin_amdgcn_mfma_f32_16x16x32_bf16(at[kk], sf, U[it], 0, 0, 0); Y[it] = __builtin_amdgcn_mfma_f32_16x16x32_bf16(rt[kk], sf, Y[it], 0, 0, 0); }
        bf16x8 uv[2];
#pragma unroll
        for (int it = 0; it < 2; ++it) { vfp[it] = *(const LAS v2u*)(R + RC_VF + (2 * cw + it) * 512 + lane * 8); gfp[it] = *(const LAS v2u*)(R + RC_GF + (2 * cw + it) * 512 + lane * 8);
            v4u pw; pw.x = pg8::cvt_pk_bf16(U[it][0], U[it][1]); pw.y = pg8::cvt_pk_bf16(U[it][2], U[it][3]); pw.z = vfp[it].x; pw.w = vfp[it].y; uv[it] = __builtin_bit_cast(bf16x8, pw); }
#pragma unroll
        for (int jt = 0; jt < 4; ++jt) { const bf16x8 bk = *(const LAS bf16x8*)(R + RC_BK + jt * 1024 + lane * 16); const f32x4v p15 = *(const LAS f32x4v*)(R + RC_P15 + (16 * jt + 4 * g) * 4);
#pragma unroll
            for (int it = 0; it < 2; ++it) S[jt][it] = __builtin_amdgcn_mfma_f32_16x16x32_bf16(bk, uv[it], S[jt][it] * p15, 0, 0, 0); }
        bnp = *(const LAS f32x4v*)(R + RC_BN + 16 * g); Yp[0] = Y[0]; Yp[1] = Y[1];
        { LAS float* xo = XS + (ck & 1) * 64 + cw * 32; const f32x4v sm = Y[0] + Y[1], sq = Y[0] * Y[0] + Y[1] * Y[1];
#pragma unroll
          for (int r = 0; r < 4; ++r) { const float a = sum16(sm[r]), q = sum16(sq[r]); if (n == 0) { xo[(4 * g + r) * 2] = a; xo[(4 * g + r) * 2 + 1] = q; } } }
        LDS_BARRIER();
    }
}
template <int HACK = 0> __device__ __forceinline__ void mixers_v4(Frame& F, int l, int qi, int mask = 15) {
    gu32* ctr = F.ctl + CW_Q + 64 * qi;
    for (;;) {
        const int it = next_item(F, ctr); relaunder(F); relaunder_tid(F);
        if (it < 32) { if (mask & 1) rwkv_scan_unit<HACK>(F, l, it >> 4, it & 15); }
        else if (it < 48) { const int j = it - 32; if (mask & 2) gla_scan_unit<HACK>(F, l, j >> 3, (j >> 1) & 3, j & 1); }
        else if (it < 48 + 1024) { const int j = it - 48, qb = 63 - (j >> 4), bh = j & 15; if (mask & 4) attn_unit<true>(F, l, bh >> 3, bh & 7, qb); }
        else if (it < 48 + 2048) { const int j = it - 1072, qb = j & 63, bh = j >> 6; if (mask & 8) attn_unit<false>(F, l, bh >> 3, bh & 7, qb); }
        else break;
    }
}
template <int HACK = 0> __device__ __forceinline__ void prep_rwkv(Frame& F, int l) {
    LAS float* zl = (LAS float*)(F.lds + RING_OFF) + 4096;
    LAS bf16* inb = (LAS bf16*)(F.lds + RING_OFF);
    const float* mu = F.kin[I_RMU] + (size_t)l * 3264;
    const float* LOWR = WSP(float, WS_LOWR); const bf16* COLS = WSP(bf16, WS_COLS);
    float* RW = WSP(float, WS_RW); unsigned* RWU = WSP(unsigned, WS_RW); float* VF = WSP(float, WS_VFIRST);
    constexpr size_t RS = RW_ONE / 4;
    for (int tile = F.bx; tile < M / 16; tile += F.G) {
        const int row0 = tile * 16;
        relaunder(F); relaunder_tid(F);
        __syncthreads();
        {
            float cur_[7], prv_[7], mu_[7];
#pragma unroll
            for (int q = 0; q < 7; ++q) { const int idx = F.tid + NWAVES * 64 * q, tt = idx / 224, j = idx % 224, row = row0 + tt;
                const int col = j < 192 ? 16 + j : 208 + (j - 192);
                const float* mp = j < 192 ? mu + 3072 + j : F.kin[I_VRMU] + (l ? (l - 1) * 32 : 0) + (j - 192);
                cur_[q] = LOWR[(size_t)row * 256 + col]; prv_[q] = LOWR[(size_t)((row & (SEQ - 1)) ? row - 1 : row) * 256 + col]; mu_[q] = *mp; }
#pragma unroll
            for (int q = 0; q < 7; ++q) { const int idx = F.tid + NWAVES * 64 * q, tt = idx / 224, j = idx % 224, row = row0 + tt;
                const float prev = (row & (SEQ - 1)) ? prv_[q] : 0.f, muv = (j >= 192 && l == 0) ? 0.f : mu_[q];
                float x = cur_[q] + (prev - cur_[q]) * muv;
                if (j < 64) x = tanhf(x); else if (j >= 128 && j < 192) x = sigmoid_f(x);
                inb[tt * 232 + j] = (bf16)f2bf(x); } }
        __syncthreads();
        {
            const int c = 2 * F.tid;
            float accw[2][16], acca[2][16], accg[2][16], accv[2][16];
#pragma unroll
            for (int e = 0; e < 2; ++e) { const float bw = F.kin[I_RW0][l * 1024 + c + e], ba = F.kin[I_RA0][l * 1024 + c + e], bv = l ? F.kin[I_VR0][(l - 1) * 1024 + c + e] : 0.f;
#pragma unroll
              for (int tt = 0; tt < 16; ++tt) { accw[e][tt] = bw; acca[e][tt] = ba; accg[e][tt] = 0.f; accv[e][tt] = bv; } }
#define LOWRANK_MFMA(ACC, MI, JOFF, NKS) do { const bf16* wf_ = WSP(bf16, WS_WF) + ((size_t)(l * 448 + ((MI) < 3 ? (MI) * 128 + 16 * (NKS) / 2 * F.wave : 384 + 8 * F.wave)) * 64 + F.lane) * 8; \
            bf16x8 af_[NKS], bf_[8][NKS]; \
            _Pragma("unroll") for (int ks = 0; ks < (NKS); ++ks) af_[ks] = *(const LAS bf16x8*)(inb + (F.lane & 15) * 232 + (JOFF) + 32 * ks + 8 * (F.lane >> 4)); \
            _Pragma("unroll") for (int nt = 0; nt < 8; ++nt) _Pragma("unroll") for (int ks = 0; ks < (NKS); ++ks) bf_[nt][ks] = *(const bf16x8*)(wf_ + (size_t)(nt * (NKS) + ks) * 512); \
            _Pragma("unroll") for (int nt = 0; nt < 8; ++nt) { f32x4 c4 = {0.f, 0.f, 0.f, 0.f}; \
                _Pragma("unroll") for (int ks = 0; ks < (NKS); ++ks) c4 = __builtin_amdgcn_mfma_f32_16x16x32_bf16(af_[ks], bf_[nt][ks], c4, 0, 0, 0); \
                _Pragma("unroll") for (int rr = 0; rr < 4; ++rr) zl[(4 * (F.lane >> 4) + rr) * 1028 + 128 * F.wave + 16 * nt + (F.lane & 15)] = c4[rr]; } \
            __builtin_amdgcn_wave_barrier(); asm volatile("s_waitcnt lgkmcnt(0)" ::: "memory"); __builtin_amdgcn_wave_barrier();   \
            _Pragma("unroll") for (int tt = 0; tt < 16; ++tt) { const f32x2_t z2 = *(const LAS f32x2_t*)(zl + tt * 1028 + c); ACC[0][tt] += z2.x; ACC[1][tt] += z2.y; } \
            __builtin_amdgcn_wave_barrier(); asm volatile("s_waitcnt lgkmcnt(0)" ::: "memory"); __builtin_amdgcn_wave_barrier(); } while (0)
            if (!(HACK & 1)) { LOWRANK_MFMA(accw, 0, 0, 2); relaunder(F);
            LOWRANK_MFMA(acca, 1, 64, 2); relaunder(F);
            LOWRANK_MFMA(accg, 2, 128, 2); relaunder(F);
            if (l) LOWRANK_MFMA(accv, 3, 192, 1); }
#undef LOWRANK_MFMA
            relaunder(F);
            float mur[2], muk[2], muv[2], kkv[2], kav[2], pr[2] = {0.f, 0.f}, pk[2] = {0.f, 0.f}, pv[2] = {0.f, 0.f}; float cl[2] = {0.f, 0.f};
#pragma unroll
            for (int e = 0; e < 2; ++e) { mur[e] = F.kin[I_RMU][l * 3264 + c + e]; muk[e] = F.kin[I_RMU][l * 3264 + 1024 + c + e]; muv[e] = F.kin[I_RMU][l * 3264 + 2048 + c + e]; kkv[e] = F.kin[I_RKK][l * 1024 + c + e]; kav[e] = F.kin[I_RKA][l * 1024 + c + e]; }
            if ((row0 & (SEQ - 1)) != 0) { const bf16* p = COLS + (size_t)(row0 - 1) * NMAIN + c; const unsigned ur = *(const unsigned*)(p + CC_R), uk = *(const unsigned*)(p + CC_K), uv = *(const unsigned*)(p + CC_V);
                pr[0] = bflo(ur); pr[1] = bfhi(ur); pk[0] = bflo(uk); pk[1] = bfhi(uk); pv[0] = bflo(uv); pv[1] = bfhi(uv); }
            constexpr int PFD = 4;
            unsigned pur[16], puk[16], puv[16]; f32x2_t pvf[16];
#define PF_TOK(T) do { const bf16* p_ = COLS + (size_t)(row0 + (T)) * NMAIN + c; pur[T] = *(const unsigned*)(p_ + CC_R); puk[T] = *(const unsigned*)(p_ + CC_K); puv[T] = *(const unsigned*)(p_ + CC_V); \
                pvf[T] = *(const f32x2_t*)(VF + (size_t)(row0 + (T)) * 1024 + c); } while (0)
#pragma unroll
            for (int tt = 0; tt < PFD; ++tt) PF_TOK(tt);
            asm volatile("" ::: "memory");
            if (!(HACK & 4))
#pragma unroll
            for (int tt = 0; tt < 16; ++tt) { const int row = row0 + tt; const size_t o = (size_t)row * 1024 + c;
                if (tt + PFD < 16) { PF_TOK(tt + PFD < 16 ? tt + PFD : 15); }
                asm volatile("" ::: "memory");
                const unsigned ur = pur[tt], uk = puk[tt], uv = puv[tt];
                const float cr[2] = {bflo(ur), bfhi(ur)}, ck[2] = {bflo(uk), bfhi(uk)}, cv[2] = {bflo(uv), bfhi(uv)};
                f32x2_t vf2 = pvf[tt];
                float r[2], k[2], v[2], dec[2], av[2], kk[2], km[2];
#pragma unroll
                for (int e = 0; e < 2; ++e) { r[e] = cr[e] + (pr[e] - cr[e]) * mur[e]; k[e] = ck[e] + (pk[e] - ck[e]) * muk[e]; v[e] = cv[e] + (pv[e] - cv[e]) * muv[e]; pr[e] = cr[e]; pk[e] = ck[e]; pv[e] = cv[e];
                    if (l == 0) vf2[e] = v[e]; else { const float vg = sigmoid_f(accv[e][tt]); v[e] = v[e] + (vf2[e] - v[e]) * vg; }
                    cl[e] += -0.6065306597126334f * sigmoid_f(accw[e][tt]); dec[e] = cl[e]; av[e] = sigmoid_f(acca[e][tt]); kk[e] = k[e] * kkv[e]; km[e] = k[e] * (1.0f + (av[e] - 1.0f) * kav[e]); }
                const float ss = sum32(kk[0] * kk[0] + kk[1] * kk[1]), rn = rsqrtf(fmaxf(ss, 1e-24f)); kk[0] *= rn; kk[1] *= rn;
                if (l == 0) *(f32x2_t*)(VF + o) = vf2;
                *(f32x2_t*)(RW + RS + o) = (f32x2_t){dec[0], dec[1]};
                *(v2u*)(RWU + o) = (v2u){pk2(r[0], km[0]), pk2(r[1], km[1])}; *(v2u*)(RWU + 2 * RS + o) = (v2u){pk2(v[0], accg[0][tt]), pk2(v[1], accg[1][tt])};
                *(v2u*)(RWU + 3 * RS + o) = (v2u){pk2(-kk[0], kk[0] * av[0]), pk2(-kk[1], kk[1] * av[1])}; }
#undef PF_TOK
        }
        asm volatile("s_waitcnt vmcnt(0)" ::: "memory"); __syncthreads();
        __builtin_amdgcn_fence(__ATOMIC_ACQUIRE, "agent"); asm volatile("s_waitcnt vmcnt(0)" ::: "memory");
        if (!(HACK & 2)) rwkv_chunks_of_tile(F, l, tile);
    }
}
struct Args { const float* in[35]; float* out; unsigned char* ws; };
__device__ __forceinline__ void mk_frame(Frame& F, int wv) {
    extern __shared__ __attribute__((aligned(16))) unsigned char lds[];
    kargp kp = (kargp)__builtin_amdgcn_kernarg_segment_ptr(); asm volatile("" : "+s"(kp));
    F.kin = kp;
    F.lds = (LAS unsigned char*)lds;
    F.MISC = (volatile LAS unsigned*)(F.lds + MISC_OFF);
    { int w_ = wv; asm volatile("" : "+s"(w_)); int t_ = (int)__builtin_amdgcn_mbcnt_hi(~0u, __builtin_amdgcn_mbcnt_lo(~0u, (unsigned)w_ * 64u)); asm volatile("" : "+v"(t_)); F.tid = t_; } F.lane = F.tid & 63; F.wave = __builtin_amdgcn_readfirstlane(F.tid >> 6);
    F.G = gridDim.x; { int bx = blockIdx.x; asm volatile("" : "+s"(bx)); F.bx = bx; F.vcu = (F.G % 8 == 0) ? (bx % 8) * (F.G / 8) + bx / 8 : bx; }
    F.out = (float*)kp[35]; F.ws = (unsigned char*)kp[36]; F.ctl = (gu32*)(F.ws + WS_CTL);
}
__device__ __forceinline__ void grid_bar(int wv) {
    Frame F; mk_frame(F, wv);
    XcdBarrier bar; bar.bar = (unsigned*)(F.ctl + CW_BAR); bar.x = xb_xcc_id(); bar.st = F.MISC + 8;
    xcd_barrier(bar);
}
__global__ void __launch_bounds__(NWAVES * 64, 2) mega_fwd(Args args) {
    const int wv = __builtin_amdgcn_readfirstlane((int)threadIdx.x >> 6);
    { Frame F; mk_frame(F, wv);
      for (int u = F.tid; u < (LDS_BYTES - LDSCTL_OFF) / 4; u += NWAVES * 64) ((LAS unsigned*)(F.lds + LDSCTL_OFF))[u] = 0u;
      __syncthreads();
      (void)xcd_barrier_post((unsigned*)(F.ctl + CW_BAR), F.MISC + 8);
      p0_prologue_a(F);
    }
    grid_bar(wv);
    { Frame F; mk_frame(F, wv); p0_prologue_b(F); }
    grid_bar(wv);
#pragma unroll 1
    for (int l = 0; l < NLAYER; ++l) {
#define LAYER_VARS const float* mod = WSP(float, WS_MOD) + (size_t)l * 2 * 24576; const float* xin = l == 0 ? F.kin[I_X] : F.out; (void)mod; (void)xin
        { Frame F; mk_frame(F, wv); LAYER_VARS; if (l == 0) rms_phase(F, F.kin[I_X], mod + 0, mod + 4096); else rms_phase_bf(F, mod + 0, mod + 4096); }
        grid_bar(wv);
        { Frame F; mk_frame(F, wv);
          pg8::Gemm g{WSP(pg8::bf16_t, WS_XN), WSP(pg8::bf16_t, WS_WIN + l * WIN_L), M, NIN, DM}; pg8::StaticOrder S; S.init(M, NIN, F.G, F.bx);
          pg8::EpiCols E{WSP(pg8::bf16_t, WS_COLS), WSP(float, WS_LOWR)};
          pg8::gemm_phase<pg8::EpiCols, pg8::StaticOrder, true, true>(F.lds + RING_OFF, g, S, E, F.tid); }
        grid_bar(wv);
        { Frame F; mk_frame(F, wv); prep_norm(F, l); }
        { Frame F; mk_frame(F, wv); prep_loga(F, l); }
        { Frame F; mk_frame(F, wv); prep_rwkv(F, l); }
        { Frame F; mk_frame(F, wv); prep_vt<0>(F); }
        { Frame F; mk_frame(F, wv); prep_vt<1>(F); }
        { Frame F; mk_frame(F, wv); prep_vt<2>(F); }
        { Frame F; mk_frame(F, wv); prep_vt<3>(F); }
        { Frame F; mk_frame(F, wv); prep_vt<4>(F); }
        { Frame F; mk_frame(F, wv); prep_gla(F); }
        grid_bar(wv);
        { Frame F; mk_frame(F, wv); mixers_v4(F, l, l); }
        grid_bar(wv);
        { Frame F; mk_frame(F, wv); gla_post(F, l); }
        grid_bar(wv);
        { Frame F; mk_frame(F, wv); LAYER_VARS;
          pg8::Gemm g{WSP(pg8::bf16_t, WS_MIXED), WSP(pg8::bf16_t, WS_WOUT + l * WOUT_L), M, DM, DM}; pg8::StaticOrder S; S.init(M, DM, F.G, F.bx);
          pg8::EpiRes E{l == 0 ? (const void*)F.kin[I_X] : (const void*)WSP(bf16, WS_XR), (void*)WSP(bf16, WS_XR), mod + 2 * 4096, l != 0, true};
          pg8::gemm_phase<pg8::EpiRes, pg8::StaticOrder, true, true>(F.lds + RING_OFF, g, S, E, F.tid); }
        grid_bar(wv);
        { Frame F; mk_frame(F, wv); LAYER_VARS; rms_phase_bf(F, mod + 3 * 4096, mod + 4 * 4096); }
        grid_bar(wv);
        { Frame F; mk_frame(F, wv);
          pg8::Gemm g{WSP(pg8::bf16_t, WS_XN), WSP(pg8::bf16_t, WS_W13 + l * W13_L), M, 2 * DFF, DM}; pg8::StaticOrder S; S.init(M, 2 * DFF, F.G, F.bx);
          pg8::EpiSwiglu E{WSP(pg8::bf16_t, WS_HID)};
          pg8::gemm_phase<pg8::EpiSwiglu, pg8::StaticOrder, true, true>(F.lds + RING_OFF, g, S, E, F.tid); }
        grid_bar(wv);
        { Frame F; mk_frame(F, wv); LAYER_VARS;
          pg8::Gemm g{WSP(pg8::bf16_t, WS_HID), WSP(pg8::bf16_t, WS_W2 + l * W2_L), M, DM, DFF}; pg8::StaticOrder S; S.init(M, DM, F.G, F.bx);
          pg8::EpiRes E{(const void*)WSP(bf16, WS_XR), l + 1 < NLAYER ? (void*)WSP(bf16, WS_XR) : (void*)F.out, mod + 5 * 4096, true, l + 1 < NLAYER};
          pg8::gemm_phase<pg8::EpiRes, pg8::StaticOrder, true, true>(F.lds + RING_OFF, g, S, E, F.tid); }
        if (l + 1 < NLAYER) grid_bar(wv);
#undef LAYER_VARS
    }
}

extern "C" void kernel_launch(void* const* d_in, const int* in_sizes, int n_in, void* d_out, int out_size, void* d_ws, size_t ws_size, hipStream_t stream) {
    static int grid = 0;
    if (grid == 0) {
        if (n_in != 35 || in_sizes[0] != M * DM || out_size != M * DM || ws_size < WS_END) { fprintf(stderr, "kernel_launch: unexpected shapes: n_in %d in0 %d out %d ws %zu (need %zu)\n", n_in, n_in > 0 ? in_sizes[0] : -1, out_size, ws_size, (size_t)WS_END); grid = -1; return; }
        int dev = 0, cus = 0, per_cu = 0;
        if (hipGetDevice(&dev) != hipSuccess || hipDeviceGetAttribute(&cus, hipDeviceAttributeMultiprocessorCount, dev) != hipSuccess) { grid = -1; return; }
        if (hipFuncSetAttribute((const void*)mega_fwd, hipFuncAttributeMaxDynamicSharedMemorySize, LDS_BYTES) != hipSuccess) { fprintf(stderr, "kernel_launch: hipFuncSetAttribute failed\n"); grid = -1; return; }
        if (hipOccupancyMaxActiveBlocksPerMultiprocessor(&per_cu, (const void*)mega_fwd, NWAVES * 64, LDS_BYTES) != hipSuccess || per_cu < 1) fprintf(stderr, "kernel_launch: occupancy query says %d\n", per_cu);
        (void)hipGetLastError();
        grid = cus;
    }
    if (grid < 0) return;
    if (hipMemsetAsync((char*)d_ws + WS_CTL, 0, CTL_ZERO_BYTES, stream) != hipSuccess) return;
    Args a{};
    for (int i = 0; i < 35; ++i) a.in[i] = (const float*)d_in[i];
    a.out = (float*)d_out; a.ws = (unsigned char*)d_ws;
    hipLaunchKernelGGL(mega_fwd, dim3(grid), dim3(NWAVES * 64), LDS_BYTES, stream, a);
}
```

```cpp
#include <hip/hip_runtime.h>
#include <cstdio>
#include <cstdint>
namespace pg8 {
#define PG8_LAS __attribute__((address_space(3)))
typedef unsigned short bf16_t;
typedef short bf16x8 __attribute__((ext_vector_type(8)));
typedef float f32x4 __attribute__((ext_vector_type(4)));
typedef unsigned u32x4 __attribute__((ext_vector_type(4)));
constexpr int BM = 256, BK = 64, HALF = 128, HTB = HALF * BK * 2  , STAGE_BYTES = 8 * HTB, NXCD = 8, WGM = 8;

__host__ __device__ __forceinline__ int lds_byte(int r, int c) { const int st = (r >> 4) * 2 + (c >> 5), rr = r & 15, cc = c & 31, ob = rr * 64 + cc * 2; return st * 1024 + (ob ^ (((ob >> 9) & 1) << 5)); }
__host__ __device__ __forceinline__ void stage_rc(int b, int& R, int& C) { const int st = b / 1024, sb = b % 1024, swz = sb ^ (((sb >> 9) & 1) << 5); R = (st >> 1) * 16 + swz / 64; C = (st & 1) * 32 + (swz % 64) / 2; }
__host__ __device__ __forceinline__ int perm32(int rho) { const int n = rho >> 4, i = rho & 15; return 8 * (i >> 2) + 4 * n + (i & 3); }

struct Unit { int pm, pn; };
struct Gemm { const bf16_t* A; const bf16_t* Bt; int M, N, K; };

struct StaticOrder {
    int nM, nN, nwg, G, c;
    __host__ __device__ void init(int M, int N, int G_, int c_) { nM = M / BM; nN = N / BM; nwg = nM * nN; G = G_; c = c_; }
    __host__ __device__ bool next(int i, Unit& u) const {
        const long L = (long)i * G + c; if (L >= nwg) return false;
        int wgid = (int)L; { const int q = nwg / NXCD, r = nwg % NXCD, xcd = wgid % NXCD, off = wgid / NXCD; wgid = (xcd < r ? xcd * (q + 1) : r * (q + 1) + (xcd - r) * q) + off; }
        const int nig = WGM * nN, gid = wgid / nig, fm = gid * WGM, gsz = (nM - fm) < WGM ? (nM - fm) : WGM;
        u.pm = fm + ((wgid % nig) % gsz); u.pn = (wgid % nig) / gsz; return true;
    }
    __device__ __forceinline__ void a_ready(const Unit&) const {}
    __device__ __forceinline__ void done(const Unit&) const {}
};

typedef float f32x2c_t __attribute__((ext_vector_type(2))); typedef __bf16 bf16x2c_t __attribute__((ext_vector_type(2)));
__device__ __forceinline__ unsigned cvt_pk_bf16(float lo, float hi) { const f32x2c_t v = {lo, hi}; return __builtin_bit_cast(unsigned, __builtin_convertvector(v, bf16x2c_t)); }
typedef float f32x2 __attribute__((ext_vector_type(2)));
__device__ __forceinline__ float silu_f(float x) { return x * __builtin_amdgcn_rcpf(1.0f + __builtin_amdgcn_exp2f(-1.4426950408889634f * x)); }
struct EpiCols {
    static constexpr bool PERM = true, AFTER_DRAIN = false;
    bf16_t* O; float* L;
    __device__ __forceinline__ void operator()(const f32x4 (&acc)[2][2][4][2], const Unit& u, int wr, int wc, int fr, int fq) const {
        const int row0 = u.pm * BM + wr * 64 + fr;
        if (u.pn < 41) {
            const int col0 = u.pn * BM + wc * 32 + 8 * fq;
#pragma unroll
            for (int ai = 0; ai < 2; ++ai)
#pragma unroll
                for (int m = 0; m < 4; ++m) { bf16_t* rowp = O + (size_t)(row0 + ai * HALF + m * 16) * 10496 + col0;
#pragma unroll
                    for (int bj = 0; bj < 2; ++bj) { const f32x4 v0 = acc[ai][bj][m][0], v1 = acc[ai][bj][m][1];
                        u32x4 w; w.x = cvt_pk_bf16(v0[0], v0[1]); w.y = cvt_pk_bf16(v0[2], v0[3]); w.z = cvt_pk_bf16(v1[0], v1[1]); w.w = cvt_pk_bf16(v1[2], v1[3]);
                        *(u32x4*)(rowp + bj * HALF) = w; } }
        } else {
            const int col0 = wc * 32 + 8 * fq;
#pragma unroll
            for (int ai = 0; ai < 2; ++ai)
#pragma unroll
                for (int m = 0; m < 4; ++m) { float* rowp = L + (size_t)(row0 + ai * HALF + m * 16) * 256 + col0;
#pragma unroll
                    for (int bj = 0; bj < 2; ++bj) { *(f32x4*)(rowp + bj * HALF) = acc[ai][bj][m][0]; *(f32x4*)(rowp + bj * HALF + 4) = acc[ai][bj][m][1]; } }
        }
    }
};
struct EpiRes {
    static constexpr bool PERM = true, AFTER_DRAIN = false;
    const void* base; void* out; const float* gate; bool base_bf, out_bf;
    __device__ __forceinline__ void operator()(const f32x4 (&acc)[2][2][4][2], const Unit& u, int wr, int wc, int fr, int fq) const {
        const int row0 = u.pm * BM + wr * 64 + fr, col0 = u.pn * BM + wc * 32 + 8 * fq;
        const float* gp = gate + (size_t)(u.pm >> 5) * 24576 + col0;
        f32x4 gv[2][2];
#pragma unroll
        for (int bj = 0; bj < 2; ++bj)
#pragma unroll
            for (int n = 0; n < 2; ++n) gv[bj][n] = *(const f32x4*)(gp + bj * HALF + n * 4);
#pragma unroll
        for (int ai = 0; ai < 2; ++ai) {
            f32x4 r[4][2][2];
            if (base_bf) {
#pragma unroll
                for (int m = 0; m < 4; ++m)
#pragma unroll
                    for (int bj = 0; bj < 2; ++bj) { const u32x4 w = *(const u32x4*)((const bf16_t*)base + (size_t)(row0 + ai * HALF + m * 16) * 4096 + col0 + bj * HALF);
                        r[m][bj][0] = (f32x4){__builtin_bit_cast(float, w.x << 16), __builtin_bit_cast(float, w.x & 0xffff0000u), __builtin_bit_cast(float, w.y << 16), __builtin_bit_cast(float, w.y & 0xffff0000u)};
                        r[m][bj][1] = (f32x4){__builtin_bit_cast(float, w.z << 16), __builtin_bit_cast(float, w.z & 0xffff0000u), __builtin_bit_cast(float, w.w << 16), __builtin_bit_cast(float, w.w & 0xffff0000u)}; }
            } else {
#pragma unroll
                for (int m = 0; m < 4; ++m)
#pragma unroll
                    for (int bj = 0; bj < 2; ++bj)
#pragma unroll
                        for (int n = 0; n < 2; ++n) r[m][bj][n] = *(const f32x4*)((const float*)base + (size_t)(row0 + ai * HALF + m * 16) * 4096 + col0 + bj * HALF + n * 4);
            }
#pragma unroll
            for (int m = 0; m < 4; ++m)
#pragma unroll
                for (int bj = 0; bj < 2; ++bj)
#pragma unroll
                    for (int n = 0; n < 2; ++n) r[m][bj][n] = r[m][bj][n] + gv[bj][n] * acc[ai][bj][m][n];
            if (out_bf) {
#pragma unroll
                for (int m = 0; m < 4; ++m)
#pragma unroll
                    for (int bj = 0; bj < 2; ++bj) { const f32x4 v0 = r[m][bj][0], v1 = r[m][bj][1];
                        u32x4 w; w.x = cvt_pk_bf16(v0[0], v0[1]); w.y = cvt_pk_bf16(v0[2], v0[3]); w.z = cvt_pk_bf16(v1[0], v1[1]); w.w = cvt_pk_bf16(v1[2], v1[3]);
                        *(u32x4*)((bf16_t*)out + (size_t)(row0 + ai * HALF + m * 16) * 4096 + col0 + bj * HALF) = w; }
            } else {
#pragma unroll
                for (int m = 0; m < 4; ++m)
#pragma unroll
                    for (int bj = 0; bj < 2; ++bj)
#pragma unroll
                        for (int n = 0; n < 2; ++n) *(f32x4*)((float*)out + (size_t)(row0 + ai * HALF + m * 16) * 4096 + col0 + bj * HALF + n * 4) = r[m][bj][n];
            }
            asm volatile("" ::: "memory");
        }
    }
};
struct EpiSwiglu {
    static constexpr bool PERM = true, AFTER_DRAIN = false;
    bf16_t* H;
    __device__ __forceinline__ void operator()(const f32x4 (&acc)[2][2][4][2], const Unit& u, int wr, int wc, int fr, int fq) const {
        const int row0 = u.pm * BM + wr * 64 + fr, col0 = u.pn * HALF + wc * 32 + 8 * fq;
#pragma unroll
        for (int ai = 0; ai < 2; ++ai)
#pragma unroll
            for (int m = 0; m < 4; ++m) { bf16_t* rowp = H + (size_t)(row0 + ai * HALF + m * 16) * 11008 + col0;
                const f32x4 a0 = acc[ai][0][m][0], a1 = acc[ai][0][m][1], b0 = acc[ai][1][m][0], b1 = acc[ai][1][m][1];
                u32x4 w; w.x = cvt_pk_bf16(silu_f(a0[0]) * b0[0], silu_f(a0[1]) * b0[1]); w.y = cvt_pk_bf16(silu_f(a0[2]) * b0[2], silu_f(a0[3]) * b0[3]);
                w.z = cvt_pk_bf16(silu_f(a1[0]) * b1[0], silu_f(a1[1]) * b1[1]); w.w = cvt_pk_bf16(silu_f(a1[2]) * b1[2], silu_f(a1[3]) * b1[3]);
                *(u32x4*)rowp = w; }
    }
};
template <class Epi, class Sched, bool ALIGN_EPI = false, bool SP2 = false>
__device__ __forceinline__ void gemm_phase(PG8_LAS unsigned char* lds, const Gemm g, const Sched& S, const Epi& E, int tid_in) {
    int tid_ = tid_in; asm volatile("" : "+v"(tid_));
    const int tid = tid_, wid = __builtin_amdgcn_readfirstlane(tid >> 6), lane = tid & 63, wr = wid >> 2, wc = wid & 3, fr = lane & 15, fq = lane >> 4;
    const int K = g.K, nt = K / BK;
    unsigned voffA[2], voffB[2];
#pragma unroll
    for (int i = 0; i < 2; ++i) { int R, C; stage_rc(tid * 16 + i * 8192, R, C); const int Rb = Epi::PERM ? ((R & ~31) + perm32(R & 31)) : R;
        voffA[i] = (unsigned)(R * K + C) * 2u; voffB[i] = (unsigned)(Rb * K + C) * 2u; }
    const size_t kstep = (size_t)(BK * 2);
    const size_t hstep = (size_t)HALF * K * 2;
    const size_t tstep = 2 * hstep;
    const unsigned ldsw = (unsigned)wid * 1024u;
    const int aoff = lds_byte(wr * 64 + fr, fq * 8), boff = lds_byte(wc * 32 + fr, fq * 8);
#define PG8_SA(b, h) (((b) * 2 + (h)) * HTB)
#define PG8_SB(b, h) ((4 + (b) * 2 + (h)) * HTB)
#define PG8_STAGE(bufoff, gbase, voff) do { _Pragma("unroll") for (int _i = 0; _i < 2; ++_i) \
        __builtin_amdgcn_global_load_lds((const unsigned*)((const char*)(gbase) + (voff)[_i]), (PG8_LAS unsigned*)(lds + (bufoff) + ldsw + _i * 8192), 16, 0, 0); } while (0)
#define PG8_LDA(dst, b, h) do { _Pragma("unroll") for (int m = 0; m < 4; ++m) _Pragma("unroll") for (int k = 0; k < 2; ++k) dst[m][k] = *(const PG8_LAS bf16x8*)(lds + PG8_SA(b, h) + aoff + m * 2048 + k * 1024); } while (0)
#define PG8_LDB(dst, b, h) do { _Pragma("unroll") for (int n = 0; n < 2; ++n) _Pragma("unroll") for (int k = 0; k < 2; ++k) dst[n][k] = *(const PG8_LAS bf16x8*)(lds + PG8_SB(b, h) + boff + n * 2048 + k * 1024); } while (0)
#define PG8_MMA(ai, bj, At, Bt) do { __builtin_amdgcn_s_setprio(1); _Pragma("unroll") for (int m = 0; m < 4; ++m) _Pragma("unroll") for (int n = 0; n < 2; ++n) _Pragma("unroll") for (int k = 0; k < 2; ++k) \
        acc[ai][bj][m][n] = __builtin_amdgcn_mfma_f32_16x16x32_bf16(Bt[n][k], At[m][k], acc[ai][bj][m][n], 0, 0, 0); __builtin_amdgcn_s_setprio(0); } while (0)
#define PG8_WAIT_V(n) asm volatile("s_waitcnt vmcnt(" #n ")" ::: "memory")
#define PG8_WAIT_L(n) asm volatile("s_waitcnt lgkmcnt(" #n ")" ::: "memory")
#define PG8_BAR __builtin_amdgcn_s_barrier()
#define PG8_SCHED __builtin_amdgcn_sched_barrier(0)
    Unit cur, nxt; int ui = 0;
    if (!S.next(0, cur)) return;
    f32x4 acc[2][2][4][2];
#pragma unroll
    for (int a = 0; a < 2; ++a)
#pragma unroll
        for (int b = 0; b < 2; ++b)
#pragma unroll
            for (int m = 0; m < 4; ++m)
#pragma unroll
                for (int n = 0; n < 2; ++n) acc[a][b][m][n] = (f32x4){0.f, 0.f, 0.f, 0.f};
    bf16x8 At[4][2], B0[2][2], B1[2][2];
    const char* cA = (const char*)g.A + (size_t)cur.pm * tstep; const char* cB = (const char*)g.Bt + (size_t)cur.pn * tstep;
    S.a_ready(cur);
    if constexpr (SP2) {
        PG8_STAGE(PG8_SB(0, 0), cB, voffB); PG8_STAGE(PG8_SB(0, 1), cB + hstep, voffB); PG8_STAGE(PG8_SA(0, 0), cA, voffA); PG8_STAGE(PG8_SA(0, 1), cA + hstep, voffA);
        if (wr == 1) PG8_BAR;
        PG8_WAIT_V(2); PG8_BAR;
        PG8_STAGE(PG8_SB(1, 0), cB + kstep, voffB); PG8_STAGE(PG8_SA(1, 0), cA + kstep, voffA); PG8_STAGE(PG8_SB(1, 1), cB + hstep + kstep, voffB);
        PG8_WAIT_V(6); PG8_BAR;
    } else {
        PG8_STAGE(PG8_SB(0, 0), cB, voffB); PG8_STAGE(PG8_SA(0, 0), cA, voffA); PG8_STAGE(PG8_SB(0, 1), cB + hstep, voffB); PG8_STAGE(PG8_SA(0, 1), cA + hstep, voffA);
        if (wr == 1) PG8_BAR;
        PG8_WAIT_V(4); PG8_BAR;
        PG8_STAGE(PG8_SB(1, 0), cB + kstep, voffB); PG8_STAGE(PG8_SA(1, 0), cA + kstep, voffA); PG8_STAGE(PG8_SB(1, 1), cB + hstep + kstep, voffB);
        PG8_WAIT_V(6); PG8_BAR;
    }
    for (;;) {
        const bool has_next = S.next(ui + 1, nxt);
        const char* nA = has_next ? (const char*)g.A + (size_t)nxt.pm * tstep : cA; const char* nB = has_next ? (const char*)g.Bt + (size_t)nxt.pn * tstep : cB;
        for (int t = 0; t < nt; t += 2) {
            const bool last = (t == nt - 2);
            const char* a1 = cA + (size_t)(t + 1) * kstep;
            const char* a2 = last ? nA : cA + (size_t)(t + 2) * kstep; const char* b2 = last ? nB : cB + (size_t)(t + 2) * kstep;
            const char* a3 = a2 + kstep; const char* b3 = b2 + kstep;
            if (last && has_next) S.a_ready(nxt);
            if constexpr (SP2) {
            PG8_LDB(B0, 0, 0); PG8_LDB(B1, 0, 1); PG8_SCHED; PG8_LDA(At, 0, 0); PG8_STAGE(PG8_SA(1, 1), a1 + hstep, voffA);
            PG8_WAIT_V(8); PG8_WAIT_L(0); PG8_BAR; PG8_MMA(0, 0, At, B0); PG8_MMA(0, 1, At, B1); PG8_BAR; PG8_SCHED;
            PG8_LDA(At, 0, 1); PG8_STAGE(PG8_SB(0, 0), b2, voffB); PG8_STAGE(PG8_SB(0, 1), b2 + hstep, voffB); PG8_STAGE(PG8_SA(0, 0), a2, voffA);
            PG8_WAIT_V(8); PG8_WAIT_L(0); PG8_BAR; PG8_MMA(1, 0, At, B0); PG8_MMA(1, 1, At, B1); PG8_BAR; PG8_SCHED;
            PG8_LDB(B0, 1, 0); PG8_LDB(B1, 1, 1); PG8_SCHED; PG8_LDA(At, 1, 0); PG8_STAGE(PG8_SA(0, 1), a2 + hstep, voffA);
            PG8_WAIT_V(8); PG8_WAIT_L(0); PG8_BAR; PG8_MMA(0, 0, At, B0); PG8_MMA(0, 1, At, B1); PG8_BAR; PG8_SCHED;
            PG8_LDA(At, 1, 1); PG8_STAGE(PG8_SB(1, 0), b3, voffB); PG8_STAGE(PG8_SB(1, 1), b3 + hstep, voffB); PG8_STAGE(PG8_SA(1, 0), a3, voffA);
            PG8_WAIT_V(8); PG8_WAIT_L(0); PG8_BAR; PG8_MMA(1, 0, At, B0); PG8_MMA(1, 1, At, B1); PG8_BAR; PG8_SCHED;
            } else {
            PG8_LDB(B0, 0, 0); PG8_SCHED; PG8_LDA(At, 0, 0); PG8_STAGE(PG8_SA(1, 1), a1 + hstep, voffA);
            PG8_WAIT_L(8); PG8_BAR; PG8_WAIT_L(0); PG8_MMA(0, 0, At, B0); PG8_BAR; PG8_SCHED;
            PG8_LDB(B1, 0, 1); PG8_STAGE(PG8_SB(0, 0), b2, voffB);
            PG8_BAR; PG8_WAIT_L(0); PG8_MMA(0, 1, At, B1); PG8_BAR;
            PG8_LDA(At, 0, 1); PG8_STAGE(PG8_SA(0, 0), a2, voffA);
            PG8_BAR; PG8_WAIT_L(0); PG8_MMA(1, 0, At, B0); PG8_BAR; PG8_SCHED;
            PG8_STAGE(PG8_SB(0, 1), b2 + hstep, voffB);
            PG8_WAIT_V(6); PG8_BAR; PG8_MMA(1, 1, At, B1); PG8_BAR;
            PG8_LDB(B0, 1, 0); PG8_SCHED; PG8_LDA(At, 1, 0); PG8_STAGE(PG8_SA(0, 1), a2 + hstep, voffA);
            PG8_WAIT_L(8); PG8_BAR; PG8_WAIT_L(0); PG8_MMA(0, 0, At, B0); PG8_BAR; PG8_SCHED;
            PG8_LDB(B1, 1, 1); PG8_STAGE(PG8_SB(1, 0), b3, voffB);
            PG8_BAR; PG8_WAIT_L(0); PG8_MMA(0, 1, At, B1); PG8_BAR;
            PG8_LDA(At, 1, 1); PG8_STAGE(PG8_SA(1, 0), a3, voffA);
            PG8_BAR; PG8_WAIT_L(0); PG8_MMA(1, 0, At, B0); PG8_BAR; PG8_SCHED;
            PG8_STAGE(PG8_SB(1, 1), b3 + hstep, voffB);
            PG8_WAIT_V(6); PG8_BAR; PG8_MMA(1, 1, At, B1); PG8_BAR;
            }
        }
        if constexpr (ALIGN_EPI) { if (wr == 0) PG8_BAR; }
        if constexpr (!Epi::AFTER_DRAIN) { unsigned z_ = 0u; asm volatile("" : "+s"(z_)); const int le_ = (int)__builtin_amdgcn_mbcnt_hi(~0u, __builtin_amdgcn_mbcnt_lo(~0u, z_));
          E(acc, cur, wr, wc, le_ & 15, le_ >> 4); S.done(cur); }
        if (!has_next) break;
#pragma unroll
        for (int a = 0; a < 2; ++a)
#pragma unroll
            for (int b = 0; b < 2; ++b)
#pragma unroll
                for (int m = 0; m < 4; ++m)
#pragma unroll
                    for (int n = 0; n < 2; ++n) acc[a][b][m][n] = (f32x4){0.f, 0.f, 0.f, 0.f};
        cur = nxt; cA = nA; cB = nB; ++ui;
        if constexpr (ALIGN_EPI) { if (wr == 1) PG8_BAR; }
    }
    PG8_WAIT_V(0);
    if constexpr (!ALIGN_EPI) { if (wr == 0) PG8_BAR; }
    PG8_BAR;
    if constexpr (Epi::AFTER_DRAIN) { E.fused(acc, cur, wr, wc, fr, fq, lds, wid, lane); S.done(cur); }
#undef PG8_SA
#undef PG8_SB
#undef PG8_STAGE
#undef PG8_LDA
#undef PG8_LDB
#undef PG8_MMA
#undef PG8_WAIT_V
#undef PG8_WAIT_L
#undef PG8_BAR
#undef PG8_SCHED
}
}
constexpr int BATCH = 2, SEQ = 8192, DM = 4096, M = BATCH * SEQ, DFF = 11008, NLAYER = 2;
constexpr int P_IN = 10704, NIN = 10752, NMAIN = 10496;
constexpr int CA_Q = 0, CA_K = 1024, CA_V = 2048;
constexpr int CB_Q = 3072, CB_K = 3584, CB_V = 4096, CB_G = 5120;
constexpr int CC_R = 6144, CC_K = 7168, CC_V = 8192;
constexpr int CD_Q = 9216, CD_K = 10240, CD_V = 10368;
constexpr float LOG2E = 1.4426950408889634f;
constexpr float QSCALE = 0.125f * LOG2E;
constexpr int NWAVES = 8;

constexpr size_t MiB = 1u << 20;
constexpr size_t WS_CTL = 0, CTL_ZERO_BYTES = 1 * MiB;
constexpr size_t WS_MODP = 2 * MiB;
constexpr size_t WS_MOD = 14 * MiB;
constexpr size_t WS_TAB = 15 * MiB;
constexpr size_t WS_WIN = 16 * MiB, WIN_L = 84 * MiB;
constexpr size_t WS_WOUT = 184 * MiB, WOUT_L = 32 * MiB;
constexpr size_t WS_W13 = 248 * MiB, W13_L = 172 * MiB;
constexpr size_t WS_W2 = 592 * MiB, W2_L = 86 * MiB;
constexpr size_t WS_XN = 764 * MiB;
constexpr size_t WS_COLS = 892 * MiB;
constexpr size_t WS_LOWR = 1220 * MiB;
constexpr size_t WS_HID = 892 * MiB;
constexpr size_t WS_QKA = 1236 * MiB;
constexpr size_t WS_QKD = 1300 * MiB;
constexpr size_t WS_LOGA = 1336 * MiB;
constexpr size_t WS_RW = 1368 * MiB, RW_ONE = 64 * MiB;
constexpr size_t WS_VFIRST = 1816 * MiB;
constexpr size_t WS_MIXED = 1880 * MiB;
constexpr int VROW = SEQ + 64;
constexpr size_t WS_VTA = 2008 * MiB;
constexpr size_t WS_VTD = 2041 * MiB;
constexpr size_t WS_QDEC = 2046 * MiB, WS_KDT = 2062 * MiB, WS_AM = 2078 * MiB, WS_EBL = 2086 * MiB;
constexpr size_t WS_VTB = 2087 * MiB;
constexpr size_t WS_RWC = 2120 * MiB;
constexpr size_t WS_OB = 2446 * MiB;
constexpr size_t WS_PSG = 2478 * MiB;
constexpr size_t WS_WF = 2479 * MiB;
constexpr size_t WS_XR = 2480 * MiB;
constexpr size_t WS_END = 2608 * MiB;
constexpr int CW_BAR = 4096;
constexpr int CW_Q = 16384;

constexpr int RING_OFF = 0, RING_BYTES = 131072;
constexpr int LDSCTL_OFF = RING_BYTES, MISC_OFF = LDSCTL_OFF + 320;
constexpr int LDS_BYTES = 147456;

#define GAS __attribute__((address_space(1)))
#define LAS __attribute__((address_space(3)))
typedef unsigned short bf16;
typedef unsigned v4u __attribute__((ext_vector_type(4)));
typedef unsigned v2u __attribute__((ext_vector_type(2)));
typedef float f32x4 __attribute__((ext_vector_type(4)));
typedef short bf16x8 __attribute__((ext_vector_type(8)));
typedef GAS unsigned gu32;
#define RLX_AGENT __ATOMIC_RELAXED, __HIP_MEMORY_SCOPE_AGENT
#define LDS_WAIT() asm volatile("s_waitcnt lgkmcnt(0)" ::: "memory")
#define VM_WAIT() asm volatile("s_waitcnt vmcnt(0)" ::: "memory")
typedef float f32x2_t __attribute__((ext_vector_type(2))); typedef __bf16 bf16x2_t __attribute__((ext_vector_type(2)));
__device__ __forceinline__ unsigned pk2(float lo, float hi) { const f32x2_t v = {lo, hi}; return __builtin_bit_cast(unsigned, __builtin_convertvector(v, bf16x2_t)); }
__device__ __forceinline__ unsigned f2bf(float f) { return pk2(f, f) & 0xffffu; }
__device__ __forceinline__ float bf2f(unsigned short h) { return __builtin_bit_cast(float, (unsigned)h << 16); }
__device__ __forceinline__ float bflo(unsigned w) { return __builtin_bit_cast(float, w << 16); }
__device__ __forceinline__ float bfhi(unsigned w) { return __builtin_bit_cast(float, w & 0xffff0000u); }
template <int CTRL> __device__ __forceinline__ float dpp_f(float v) { return __builtin_bit_cast(float, __builtin_amdgcn_update_dpp(0, __builtin_bit_cast(int, v), CTRL, 0xF, 0xF, true)); }
__device__ __forceinline__ float sum8(float v) {
    v += dpp_f<0xB1>(v); v += dpp_f<0x4E>(v); v += dpp_f<0x141>(v); return v; }
__device__ __forceinline__ float sum32(float v) {
    v = sum8(v); v += dpp_f<0x140>(v); v += __builtin_bit_cast(float, __builtin_amdgcn_ds_swizzle(__builtin_bit_cast(int, v), 0x401F)); return v; }
__device__ __forceinline__ float wave_sum(float v) {
    v = sum8(v); v += dpp_f<0x140>(v);
    v += __builtin_bit_cast(float, __builtin_amdgcn_ds_swizzle(__builtin_bit_cast(int, v), 0x401F));
    { const int u = __builtin_bit_cast(int, v); v = __builtin_bit_cast(float, __builtin_amdgcn_readlane(u, 0)) + __builtin_bit_cast(float, __builtin_amdgcn_readlane(u, 32)); }
    return v;
}
__device__ __forceinline__ float sigmoid_f(float x) { return __builtin_amdgcn_rcpf(1.0f + __builtin_amdgcn_exp2f(-LOG2E * x)); }
__device__ __forceinline__ float silu_g(float x) { return x * sigmoid_f(x); }
__device__ __forceinline__ void unpack8(const v4u r, float (&f)[8]) { f[0] = bflo(r.x); f[1] = bfhi(r.x); f[2] = bflo(r.y); f[3] = bfhi(r.y); f[4] = bflo(r.z); f[5] = bfhi(r.z); f[6] = bflo(r.w); f[7] = bfhi(r.w); }
__device__ __forceinline__ v4u pack8(const float (&f)[8]) { v4u o; o.x = pk2(f[0], f[1]); o.y = pk2(f[2], f[3]); o.z = pk2(f[4], f[5]); o.w = pk2(f[6], f[7]); return o; }

#define XB_TMO      128
#define XB_XCNT(j)  (256  + 64 * (j))
#define XB_XSUB(j)  (1280 + 64 * (j))
#define XB_XGEN(j)  (2304 + 64 * (j))
#define XB_TOP      3328
#define XB_TOPGEN   3392
#define XCD_BAR_WORDS 3456
#define XB_SPIN_CAP (1u << 23)

__device__ __forceinline__ unsigned xb_ld(unsigned* p)              { return __hip_atomic_load(p, __ATOMIC_RELAXED, __HIP_MEMORY_SCOPE_AGENT); }
__device__ __forceinline__ unsigned xb_add(unsigned* p, unsigned v) { return __hip_atomic_fetch_add(p, v, __ATOMIC_RELAXED, __HIP_MEMORY_SCOPE_AGENT); }
__device__ __forceinline__ unsigned xb_xcc_id() { return (unsigned)__builtin_amdgcn_s_getreg((3 << 11) | 20) & 0xFu; }
#define XB_SPIN(cond, bar) do { unsigned _sp = 0; while (cond) { __builtin_amdgcn_s_sleep(1); \
    if ((++_sp & 255u) == 0u) { if (xb_ld(&(bar)[XB_TMO])) break; if (_sp > XB_SPIN_CAP) { atomicAdd(&(bar)[XB_TMO], 1u); break; } } } } while (0)

struct XcdBarrier {
    unsigned* bar; unsigned x;
    volatile LAS unsigned* st;
};

__device__ __forceinline__ XcdBarrier xcd_barrier_post(unsigned* bar, volatile LAS unsigned* st) {
    XcdBarrier b; b.bar = bar; b.x = xb_xcc_id(); b.st = st;
    if (threadIdx.x == 0) (void)xb_add(&bar[XB_XCNT(b.x)], 1u);
    return b;
}
__device__ __forceinline__ void xcd_barrier_complete(unsigned* bar, unsigned x, unsigned& nloc, unsigned& nx) {
    const unsigned G = gridDim.x * gridDim.y * gridDim.z;
    unsigned sum, cnt, mine, sp = 0u;
    for (;;) {
        sum = 0u; cnt = 0u; mine = 0u;
#pragma unroll
        for (unsigned j = 0; j < 16; ++j) { const unsigned c = xb_ld(&bar[XB_XCNT(j)]); sum += c; cnt += (c > 0u) ? 1u : 0u; mine = (j == x) ? c : mine; }
        if (sum == G) break;
        __builtin_amdgcn_s_sleep(1);
        if ((++sp & 255u) == 0u) { if (xb_ld(&bar[XB_TMO])) break; if (sp > XB_SPIN_CAP) { atomicAdd(&bar[XB_TMO], 1u); break; } }
    }
    nloc = mine > 0u ? mine : 1u; nx = cnt > 0u ? cnt : 1u;
}

__device__ __forceinline__ void xcd_barrier(const XcdBarrier& b) {
    asm volatile("s_waitcnt vmcnt(0)" ::: "memory");
    __syncthreads();
    if (threadIdx.x == 0) {
        unsigned* bar = b.bar;
        __builtin_amdgcn_s_waitcnt(0);
        unsigned nloc = b.st[0], nx = b.st[1];
        if (nloc == 0u) { xcd_barrier_complete(bar, b.x, nloc, nx); b.st[0] = nloc; b.st[1] = nx; }
        const unsigned old = xb_add(&bar[XB_XSUB(b.x)], 1u);
        const unsigned gen = old / nloc;
        if (old + 1u == (gen + 1u) * nloc) {
            __builtin_amdgcn_fence(__ATOMIC_RELEASE, "agent");
            asm volatile("s_waitcnt vmcnt(0)" ::: "memory");
            const unsigned og = xb_add(&bar[XB_TOP], 1u);
            const unsigned tg = og / nx;
            if (og + 1u == (tg + 1u) * nx) xb_add(&bar[XB_TOPGEN], 1u);
            else XB_SPIN(xb_ld(&bar[XB_TOPGEN]) == tg, bar);
            __builtin_amdgcn_fence(__ATOMIC_ACQUIRE, "agent");
            xb_add(&bar[XB_XGEN(b.x)], 1u);
            asm volatile("s_waitcnt vmcnt(0)" ::: "memory");
        } else {
            XB_SPIN(xb_ld(&bar[XB_XGEN(b.x)]) == gen, bar);
            __builtin_amdgcn_fence(__ATOMIC_ACQUIRE, "agent");
            asm volatile("s_waitcnt vmcnt(0)" ::: "memory");
        }
    }
    __syncthreads();
}

typedef const float* const __attribute__((address_space(4)))* kargp;
struct Frame {
    LAS unsigned char* lds;
    volatile LAS unsigned* MISC;
    gu32* ctl;
    int tid, lane, wave;
    int vcu, G, bx;
    kargp kin;
    float* out;
    unsigned char* ws;
};
enum { I_X = 0, I_C, I_RELB, I_ADAW, I_ADAB, I_WIN, I_WOUT, I_DQN, I_DKN, I_DLAM, I_DSUB, I_GGU, I_GGB, I_GON, I_RMU, I_RWUP, I_RW0, I_RAUP, I_RA0, I_RGUP,
       I_RKK, I_RKA, I_RRK, I_RLNW, I_RLNB, I_VRD, I_VRMU, I_VRUP, I_VR0, I_SQN, I_SKN, I_SSINK, I_W1, I_W3, I_W2 };

#define WSP(T, off) ((T*)(F.ws + (off)))
__device__ __forceinline__ void relaunder_tid(Frame& F) { int t = F.tid; asm volatile("" : "+v"(t)); F.tid = t; F.lane = t & 63; F.wave = __builtin_amdgcn_readfirstlane(t >> 6); }
__device__ __forceinline__ void relaunder(Frame& F) { kargp p = F.kin; asm volatile("" : "+s"(p)); F.kin = p; }

__device__ __forceinline__ void conv_item(const float* src, int ld, int col0, int ncols, int K, bf16* WT, int row0, int kb, LAS float* scr, int lane) {
    const int k0 = 64 * kb;
    { const int n = lane & 31; const bool ok = src != nullptr && n < ncols; const float* sp = src + (size_t)(k0 + (lane >> 5)) * ld + col0 + n; float v[32];
#pragma unroll
      for (int i = 0; i < 32; ++i) v[i] = ok ? sp[(size_t)(2 * i) * ld] : 0.f;
#pragma unroll
      for (int i = 0; i < 32; ++i) scr[(2 * i + (lane >> 5)) * 33 + n] = v[i]; }
    LDS_WAIT(); asm volatile("" ::: "memory");
    const int c = lane & 7;
#pragma unroll
    for (int j = 0; j < 4; ++j) { const int n = (lane >> 3) + 8 * j; const LAS float* s = scr + (8 * c) * 33 + n;
        v4u o; o.x = pk2(s[0 * 33], s[1 * 33]); o.y = pk2(s[2 * 33], s[3 * 33]); o.z = pk2(s[4 * 33], s[5 * 33]); o.w = pk2(s[6 * 33], s[7 * 33]);
        if (n < ncols) *(GAS v4u*)(WT + (size_t)(row0 + n) * K + k0 + 8 * c) = o; }
    LDS_WAIT(); asm volatile("" ::: "memory");
}
__device__ __forceinline__ int t5_bucket(int d) {
    if (d < 16) return d;
    int v = 16 + (int)(logf((float)d * (1.0f / 16.0f)) / logf(8.0f) * 16.0f);
    return v < 31 ? v : 31;
}
__device__ __forceinline__ void p0_prologue_a(Frame& F) {
    const int gw = F.vcu * NWAVES + F.wave, NGW = F.G * NWAVES;
    LAS float* ldsf = (LAS float*)(F.lds + RING_OFF);
    { float cv[16];
#pragma unroll
      for (int q = 0; q < 16; ++q) cv[q] = F.kin[I_C][F.tid + NWAVES * 64 * q];
#pragma unroll
      for (int q = 0; q < 16; ++q) ldsf[F.tid + NWAVES * 64 * q] = silu_g(cv[q]); }
    __syncthreads();
    float* MODP = WSP(float, WS_MODP);
    for (int it = gw; it < 6144; it += NGW) {
        const int l = it / 3072, rem = it % 3072, kc = rem / 96, ng = rem % 96, n0 = 256 * ng + 4 * F.lane;
        const float* w = F.kin[I_ADAW] + ((size_t)l * DM + kc * 128) * 24576 + n0;
        f32x4 a0 = {0.f, 0.f, 0.f, 0.f}, a1 = {0.f, 0.f, 0.f, 0.f};
#pragma unroll 16
        for (int k = 0; k < 128; ++k) { const f32x4 wv = *(const f32x4*)(w + (size_t)k * 24576); const float s0 = ldsf[kc * 128 + k], s1 = ldsf[DM + kc * 128 + k]; a0 += wv * s0; a1 += wv * s1; }
        *(f32x4*)(MODP + ((size_t)(l * 32 + kc) * 2 + 0) * 24576 + n0) = a0;
        *(f32x4*)(MODP + ((size_t)(l * 32 + kc) * 2 + 1) * 24576 + n0) = a1;
    }
    for (int idx = F.bx * (NWAVES * 64) + F.tid; idx < NLAYER * 448 * 64; idx += F.G * NWAVES * 64) {
        const int l = idx / (448 * 64), rem = idx % (448 * 64), blk = rem >> 6, ln = rem & 63, n = ln & 15, g = ln >> 4;
        const int m = blk < 384 ? blk >> 7 : 3, nt = blk < 384 ? (blk & 127) >> 1 : blk - 384, ks = blk < 384 ? (blk & 1) : 0;
        const float* W = m == 0 ? F.kin[I_RWUP] + (size_t)l * 65536 : (m == 1 ? F.kin[I_RAUP] + (size_t)l * 65536 : (m == 2 ? F.kin[I_RGUP] + (size_t)l * 65536 : (l ? F.kin[I_VRUP] + (size_t)(l - 1) * 32768 : nullptr)));
        float f[8];
#pragma unroll
        for (int e = 0; e < 8; ++e) f[e] = W != nullptr ? W[(size_t)(32 * ks + 8 * g + e) * 1024 + 16 * nt + n] : 0.f;
        *(v4u*)(WSP(bf16, WS_WF) + ((size_t)(l * 448 + blk) * 64 + ln) * 8) = pack8(f);
    }
    __syncthreads();
    LAS float* scr = (LAS float*)(F.lds + RING_OFF + F.wave * 16384);
    constexpr int I_IN = 337 * 64, I_OUT = 128 * 64, I_13 = 688 * 64, I_2 = 128 * 172, I_L = I_IN + I_OUT + I_13 + I_2;
    for (int it = gw; it < NLAYER * I_L; it += NGW) {
        const int l = it / I_L; int r = it % I_L;
        if (r < I_IN) {
            const int kb = r / 337, cb = r % 337; const float* src = F.kin[I_WIN] + (size_t)l * DM * P_IN; int ld = P_IN, col0, row0, nc = 32;
            if (cb < 192) { col0 = 32 * cb; row0 = 32 * cb; }
            else if (cb < 288) { col0 = 6160 + 32 * (cb - 192); row0 = 6144 + 32 * (cb - 192); }
            else if (cb < 328) { col0 = 9424 + 32 * (cb - 288); row0 = 9216 + 32 * (cb - 288); }
            else if (cb == 328) { col0 = 6144; row0 = 10496; nc = 16; }
            else if (cb < 335) { col0 = 9232 + 32 * (cb - 329); row0 = 10512 + 32 * (cb - 329); }
            else if (cb == 335) { src = l ? F.kin[I_VRD] + (size_t)(l - 1) * DM * 32 : nullptr; ld = 32; col0 = 0; row0 = 10704; }
            else { src = nullptr; col0 = 0; row0 = 10736; nc = 16; }
            conv_item(src, ld, col0, nc, DM, WSP(bf16, WS_WIN + l * WIN_L), row0, kb, scr, F.lane); continue; }
        r -= I_IN;
        if (r < I_OUT) { const int kb = r / 128, cb = r % 128; conv_item(F.kin[I_WOUT] + (size_t)l * DM * DM, DM, 32 * cb, 32, DM, WSP(bf16, WS_WOUT + l * WOUT_L), 32 * cb, kb, scr, F.lane); continue; }
        r -= I_OUT;
        if (r < I_13) { const int kb = r / 688, cb = r % 688, pn = cb >> 3, wi = cb & 7;
            const float* src = (wi < 4 ? F.kin[I_W1] : F.kin[I_W3]) + (size_t)l * DM * DFF;
            conv_item(src, DFF, 128 * pn + 32 * (wi & 3), 32, DM, WSP(bf16, WS_W13 + l * W13_L), 32 * cb, kb, scr, F.lane); continue; }
        r -= I_13;
        { const int kb = r / 128, cb = r % 128; conv_item(F.kin[I_W2] + (size_t)l * DFF * DM, DM, 32 * cb, 32, DFF, WSP(bf16, WS_W2 + l * W2_L), 32 * cb, kb, scr, F.lane); }
    }
}
__device__ __forceinline__ void p0_prologue_b(Frame& F) {
    const int gt = F.bx * (NWAVES * 64) + F.tid, NT = F.G * NWAVES * 64;
    const float* MODP = WSP(float, WS_MODP); float* MOD = WSP(float, WS_MOD);
    for (int idx = gt; idx < NLAYER * 2 * 24576; idx += NT) {
        const int l = idx / 49152, rem = idx % 49152, b = rem / 24576, n = rem % 24576;
        float s = F.kin[I_ADAB][l * 24576 + n];
#pragma unroll 8
        for (int kc = 0; kc < 32; ++kc) s += MODP[((size_t)(l * 32 + kc) * 2 + b) * 24576 + n];
        MOD[idx] = s;
    }
    if (F.bx == 0) { float* TAB = WSP(float, WS_TAB);
        float tv[6];
#pragma unroll
        for (int q = 0; q < 6; ++q) { const int i = F.tid + NWAVES * 64 * q, hh = i >> 7, d = i & 127; tv[q] = F.kin[I_RELB][t5_bucket(d) * 24 + hh]; }
#pragma unroll
        for (int q = 0; q < 6; ++q) TAB[F.tid + NWAVES * 64 * q] = tv[q] * LOG2E; }
}
__device__ __forceinline__ void rms_phase(Frame& F, const float* xin, const float* sh, const float* sc) {
    const int gw = F.vcu * NWAVES + F.wave, NGW = F.G * NWAVES;
    bf16* XN = WSP(bf16, WS_XN);
#pragma unroll 1
    for (int b = 0; b < BATCH; ++b) {
        relaunder(F); relaunder_tid(F);
        f32x4 s4[16], h4[16];
        { const f32x4* scp = (const f32x4*)(sc + (size_t)b * 24576) + F.lane; const f32x4* shp = (const f32x4*)(sh + (size_t)b * 24576) + F.lane;
#pragma unroll
          for (int j = 0; j < 16; ++j) { s4[j] = scp[64 * j] + 1.0f; h4[j] = shp[64 * j]; } }
#pragma unroll 1
        for (int m = b * SEQ + gw; m < (b + 1) * SEQ; m += NGW) {
            relaunder_tid(F);
            const f32x4* xr = (const f32x4*)(xin + (size_t)m * DM) + F.lane;
            f32x4 v[16]; float ss = 0.f;
#pragma unroll
            for (int j = 0; j < 16; ++j) v[j] = xr[64 * j];
#pragma unroll
            for (int j = 0; j < 16; ++j) ss += (v[j].x * v[j].x + v[j].y * v[j].y) + (v[j].z * v[j].z + v[j].w * v[j].w);
            const float rstd = rsqrtf(wave_sum(ss) * (1.0f / DM) + 1e-6f);
            v2u* o8 = (v2u*)(XN + (size_t)m * DM) + F.lane;
#pragma unroll
            for (int j = 0; j < 16; ++j) { const f32x4 o = v[j] * rstd * s4[j] + h4[j]; v2u w; w.x = pk2(o.x, o.y); w.y = pk2(o.z, o.w); o8[64 * j] = w; }
        }
    }
}
__device__ __forceinline__ void rms_phase_bf(Frame& F, const float* sh, const float* sc) {
    const int gw = F.vcu * NWAVES + F.wave, NGW = F.G * NWAVES;
    bf16* XN = WSP(bf16, WS_XN); const bf16* XR = WSP(bf16, WS_XR);
#pragma unroll 1
    for (int b = 0; b < BATCH; ++b) {
        relaunder(F); relaunder_tid(F);
        f32x4 s0[8], s1[8], h0[8], h1[8];
        { const float* scp = sc + (size_t)b * 24576 + 8 * F.lane; const float* shp = sh + (size_t)b * 24576 + 8 * F.lane;
#pragma unroll
          for (int j = 0; j < 8; ++j) { s0[j] = *(const f32x4*)(scp + 512 * j) + 1.0f; s1[j] = *(const f32x4*)(scp + 512 * j + 4) + 1.0f; h0[j] = *(const f32x4*)(shp + 512 * j); h1[j] = *(const f32x4*)(shp + 512 * j + 4); } }
        const int mend = (b + 1) * SEQ; int m = b * SEQ + gw;
        v4u raw[8];
        if (m < mend) {
#pragma unroll
            for (int j = 0; j < 8; ++j) raw[j] = ((const v4u*)(XR + (size_t)m * DM) + F.lane)[64 * j];
        }
#pragma unroll 1
        for (; m < mend; m += NGW) {
            relaunder_tid(F);
            v4u nxt[8]; { const int mn = m + NGW < mend ? m + NGW : m;
#pragma unroll
              for (int j = 0; j < 8; ++j) nxt[j] = ((const v4u*)(XR + (size_t)mn * DM) + F.lane)[64 * j]; }
            float ss = 0.f;
#pragma unroll
            for (int j = 0; j < 8; ++j) { float f[8]; unpack8(raw[j], f);
#pragma unroll
                for (int e = 0; e < 8; ++e) ss += f[e] * f[e]; }
            const float rstd = rsqrtf(wave_sum(ss) * (1.0f / DM) + 1e-6f);
            v4u* o16 = (v4u*)(XN + (size_t)m * DM) + F.lane;
#pragma unroll
            for (int j = 0; j < 8; ++j) { float f[8]; unpack8(raw[j], f); float o[8];
#pragma unroll
                for (int e = 0; e < 4; ++e) { o[e] = f[e] * rstd * s0[j][e] + h0[j][e]; o[4 + e] = f[4 + e] * rstd * s1[j][e] + h1[j][e]; }
                o16[64 * j] = pack8(o); }
#pragma unroll
            for (int j = 0; j < 8; ++j) raw[j] = nxt[j];
        }
    }
}
__device__ __forceinline__ void prep_norm(Frame& F, int l) {
    const int gw = F.vcu * NWAVES + F.wave, NGW = F.G * NWAVES, lane = F.lane, sub = lane >> 3, ch = lane & 7;
    float gqa[8], gka[8], gqd[8], gkd[8];
#pragma unroll
    for (int e = 0; e < 8; ++e) { gqa[e] = F.kin[I_DQN][l * 64 + ch * 8 + e] * QSCALE; gka[e] = F.kin[I_DKN][l * 64 + ch * 8 + e];
                                  gqd[e] = F.kin[I_SQN][l * 64 + ch * 8 + e] * QSCALE; gkd[e] = F.kin[I_SKN][l * 64 + ch * 8 + e]; }
    const bf16* COLS = WSP(bf16, WS_COLS); bf16* QKA = WSP(bf16, WS_QKA); bf16* QKD = WSP(bf16, WS_QKD);
    for (int m0 = gw; m0 < M; m0 += 2 * NGW) {
        v4u ra[2][4], rd[2][3];
#pragma unroll
        for (int r = 0; r < 2; ++r) { const int m = m0 + r * NGW < M ? m0 + r * NGW : m0; const bf16* src = COLS + (size_t)m * NMAIN;
#pragma unroll
            for (int i = 0; i < 4; ++i) ra[r][i] = *(const v4u*)(src + CA_Q + (i * 8 + sub) * 64 + ch * 8);
#pragma unroll
            for (int i = 0; i < 3; ++i) { const int vec = i * 8 + sub; rd[r][i] = *(const v4u*)(src + CD_Q + (vec < 18 ? vec : 17) * 64 + ch * 8); } }
#pragma unroll
        for (int r = 0; r < 2; ++r) { const int m = m0 + r * NGW; if (m < M) {
#pragma unroll
            for (int i = 0; i < 4; ++i) { const int vec = i * 8 + sub, col = vec * 64 + ch * 8;
                float f[8]; unpack8(ra[r][i], f); float ss = 0.f;
#pragma unroll
                for (int e = 0; e < 8; ++e) ss += f[e] * f[e];
                ss = sum8(ss);
                const float rstd = rsqrtf(ss * (1.0f / 64.0f) + 1e-6f);
#pragma unroll
                for (int e = 0; e < 8; ++e) f[e] = f[e] * rstd * (i < 2 ? gqa[e] : gka[e]);
                *(v4u*)(QKA + (size_t)m * 2048 + col) = pack8(f); }
#pragma unroll
            for (int i = 0; i < 3; ++i) { const int vec = i * 8 + sub, col = vec * 64 + ch * 8;
                float f[8]; unpack8(rd[r][i], f); float ss = 0.f;
#pragma unroll
                for (int e = 0; e < 8; ++e) ss += f[e] * f[e];
                ss = sum8(ss);
                const float rstd = rsqrtf(ss * (1.0f / 64.0f) + 1e-6f);
#pragma unroll
                for (int e = 0; e < 8; ++e) f[e] = f[e] * rstd * (vec < 16 ? gqd[e] : gkd[e]);
                if (vec < 18) *(v4u*)(QKD + (size_t)m * 1152 + col) = pack8(f); } } }
    }
}
__device__ __forceinline__ void prep_loga(Frame& F, int l) {
    LAS float* gdl = (LAS float*)(F.lds + RING_OFF);
    float gu[16];
#pragma unroll
    for (int j = 0; j < 16; ++j) gu[j] = F.kin[I_GGU][((size_t)l * 16 + j) * 512 + F.tid];
    const float bias = F.kin[I_GGB][l * 512 + F.tid];
    const float* LOWR = WSP(float, WS_LOWR); float* LOGA = WSP(float, WS_LOGA);
    for (int tile = F.bx; tile < M / 64; tile += F.G) {
        const size_t row0 = (size_t)tile * 64;
        __syncthreads();
#pragma unroll
        for (int i = 0; i < 2; ++i) { const int idx = F.tid + 512 * i; gdl[idx] = LOWR[(row0 + (idx >> 4)) * 256 + (idx & 15)]; }
        __syncthreads();
#pragma unroll 4
        for (int t = 0; t < 64; ++t) { const LAS f32x4* gp = (const LAS f32x4*)(gdl + t * 16); const f32x4 g0 = gp[0], g1 = gp[1], g2 = gp[2], g3 = gp[3];
            float z = bias + g0.x * gu[0] + g0.y * gu[1] + g0.z * gu[2] + g0.w * gu[3] + g1.x * gu[4] + g1.y * gu[5] + g1.z * gu[6] + g1.w * gu[7]
                    + g2.x * gu[8] + g2.y * gu[9] + g2.z * gu[10] + g2.w * gu[11] + g3.x * gu[12] + g3.y * gu[13] + g3.z * gu[14] + g3.w * gu[15];
            LOGA[(row0 + t) * 512 + F.tid] = (fminf(z, 0.f) - __logf(1.0f + __expf(-fabsf(z)))) * (1.0f / 16.0f); }
    }
}
__device__ __forceinline__ int next_item(Frame& F, gu32* ctr) {
    volatile LAS int* slot = (volatile LAS int*)(F.lds + LDSCTL_OFF + 64);
    __syncthreads();
    if (F.tid == 0) *slot = (int)__hip_atomic_fetch_add(ctr, 1u, RLX_AGENT);
    __syncthreads();
    return *slot;
}
typedef float f32x16 __attribute__((ext_vector_type(16)));
__device__ __forceinline__ float xother32(float v) { unsigned a = __builtin_bit_cast(unsigned, v), b = a; asm volatile("" : "+v"(b)); auto rr = __builtin_amdgcn_permlane32_swap(a, b, false, false);
    const unsigned lo = rr[0], hi = rr[1]; return __builtin_bit_cast(float, (unsigned)((__builtin_amdgcn_mbcnt_hi(~0u, __builtin_amdgcn_mbcnt_lo(~0u, 0u)) & 32u) ? lo : hi)); }
__device__ __forceinline__ float xsum32(float v) { return v + xother32(v); }
__device__ __forceinline__ float xmax32(float v) { return fmaxf(v, xother32(v)); }
__device__ __forceinline__ int crow16(int r, int hi) { return (r & 3) + 8 * (r >> 2) + 4 * hi; }
template <bool ISA>
__device__ __forceinline__ void attn_unit(Frame& F, int l, int b, int hx, int qb) {
    constexpr int DV = ISA ? 128 : 64, NDV = DV / 32, KSTR = ISA ? 272 : 144, VSTR = 144, KBYTES = 64 * KSTR, VBYTES = DV * VSTR, BUFB = KBYTES + VBYTES, NCH = ISA ? 2 : 1;
    constexpr float NEG = -1e30f;
    LAS unsigned char* L = F.lds + RING_OFF;
    const int tid = F.tid, lane = F.lane, r32 = lane & 31, hi = lane >> 5, qs = F.wave & 3, grp = F.wave >> 2, q0 = qb * 128;
    const int kvh = hx >> 2, hd = kvh * 8 + (hx & 3) * 2 + grp;
    const bf16* Qp; const bf16* Kp; const bf16* VT; int ldq;
    if (ISA) { const bf16* QKA = WSP(bf16, WS_QKA); Qp = QKA + (size_t)b * SEQ * 2048 + hx * 128 + grp * 64; Kp = QKA + (size_t)b * SEQ * 2048 + 1024 + hx * 128; ldq = 2048; VT = WSP(bf16, WS_VTA) + (size_t)(b * 8 + hx) * 128 * VROW; }
    else { const bf16* QKD = WSP(bf16, WS_QKD); Qp = QKD + (size_t)b * SEQ * 1152 + hd * 64; Kp = QKD + (size_t)b * SEQ * 1152 + 1024 + kvh * 64; ldq = 1152; VT = WSP(bf16, WS_VTD) + (size_t)(b * 2 + kvh) * 64 * VROW; }
    const int qpos = q0 + 32 * qs + r32;
    bf16x8 qr[4];
#pragma unroll
    for (int d0 = 0; d0 < 4; ++d0) qr[d0] = *(const bf16x8*)(Qp + (size_t)qpos * ldq + d0 * 16 + hi * 8);
    LAS float* Bt = (LAS float*)(L + 2 * BUFB);
    { const float* TAB = WSP(float, WS_TAB);
      if (ISA) { if (tid < 130) Bt[tid] = tid == 0 ? NEG : (tid == 129 ? 0.f : TAB[hx * 128 + tid - 1] - TAB[hx * 128 + 127]); }
      else { if (tid < 260) { const int gi = tid >= 130, t = tid - 130 * gi; Bt[tid] = (t == 0 || t == 129) ? NEG : TAB[(8 + kvh * 8 + (hx & 3) * 2 + gi) * 128 + t - 1]; } } }
    const int TQ = q0 >> 6, T0 = ISA ? 0 : (TQ >= 2 ? TQ - 2 : 0), T1 = TQ + 1;
    v4u kreg[NCH], vreg[NCH];
#define AT_GLOAD(T) do { _Pragma("unroll") for (int i_ = 0; i_ < NCH; ++i_) { const int c_ = tid + 512 * i_; \
        const int kr_ = ISA ? (c_ >> 4) : (c_ >> 3), kc_ = ISA ? (c_ & 15) : (c_ & 7); kreg[i_] = *(const v4u*)(Kp + (size_t)((T) * 64 + kr_) * ldq + kc_ * 8); \
        const int vr_ = c_ >> 3, vc_ = c_ & 7; vreg[i_] = *(const v4u*)(VT + (size_t)vr_ * VROW + (T) * 64 + vc_ * 8); } } while (0)
#define AT_LWRITE(buf) do { _Pragma("unroll") for (int i_ = 0; i_ < NCH; ++i_) { const int c_ = tid + 512 * i_; \
        const int kr_ = ISA ? (c_ >> 4) : (c_ >> 3), kc_ = ISA ? (c_ & 15) : (c_ & 7); *(LAS v4u*)(L + (buf) * BUFB + kr_ * KSTR + kc_ * 16) = kreg[i_]; \
        const int vr_ = c_ >> 3, vc_ = c_ & 7; *(LAS v4u*)(L + (buf) * BUFB + KBYTES + vr_ * VSTR + vc_ * 16) = vreg[i_]; } } while (0)
    f32x16 o[NDV];
#pragma unroll
    for (int i = 0; i < NDV; ++i) o[i] = (f32x16){0.f, 0.f, 0.f, 0.f, 0.f, 0.f, 0.f, 0.f, 0.f, 0.f, 0.f, 0.f, 0.f, 0.f, 0.f, 0.f};
    float m_run = ISA ? NEG : F.kin[I_SSINK][l * 16 + hd] * LOG2E, l_run = ISA ? 0.f : (hi == 0 ? 1.f : 0.f);
    const int krow = (r32 & 16) | (r32 & 3) | ((r32 & 4) << 1) | ((r32 & 8) >> 1);
    const int koff = krow * KSTR + (ISA ? grp * 128 : 0) + hi * 16, voff = KBYTES + r32 * VSTR + hi * 16;
    AT_GLOAD(T0); AT_LWRITE(0); __syncthreads();
#pragma unroll 1
    for (int T = T0; T <= T1; ++T) {
        const int cur = (T - T0) & 1;
        AT_GLOAD(T < T1 ? T + 1 : T1);
        LAS const unsigned char* Kb = L + cur * BUFB;
        f32x16 s[2];
#pragma unroll
        for (int blk = 0; blk < 2; ++blk) { s[blk] = (f32x16){0.f, 0.f, 0.f, 0.f, 0.f, 0.f, 0.f, 0.f, 0.f, 0.f, 0.f, 0.f, 0.f, 0.f, 0.f, 0.f};
#pragma unroll
            for (int d0 = 0; d0 < 4; ++d0) { const bf16x8 kf = *(const LAS bf16x8*)(Kb + koff + blk * 32 * KSTR + d0 * 32); s[blk] = __builtin_amdgcn_mfma_f32_32x32x16_bf16(kf, qr[d0], s[blk], 0, 0, 0); } }
        bf16x8 vfc[NDV], vfn[NDV];
#pragma unroll
        for (int i = 0; i < NDV; ++i) vfc[i] = *(const LAS bf16x8*)(Kb + voff + i * 32 * VSTR);
        if (!ISA || T >= TQ - 2) {
            const LAS float* bt = Bt + (ISA ? 0 : grp * 130) + 1; const int d0 = qpos - T * 64 - 8 * hi;
#pragma unroll
            for (int blk = 0; blk < 2; ++blk)
#pragma unroll
                for (int r = 0; r < 16; ++r) { const int dist = d0 - (32 * blk + 16 * (r >> 3) + (r & 7)); const int di = dist < -1 ? -1 : (dist > 128 ? 128 : dist); s[blk][r] += bt[di]; } }
        float mt = s[0][0];
#pragma unroll
        for (int r = 1; r < 16; ++r) mt = fmaxf(mt, s[0][r]);
#pragma unroll
        for (int r = 0; r < 16; ++r) mt = fmaxf(mt, s[1][r]);
        mt = xmax32(mt);
        const float m_new = fmaxf(m_run, mt);
        if (__any(m_new > m_run)) { const float alpha = __builtin_amdgcn_exp2f(m_run - m_new); l_run *= alpha;
#pragma unroll
            for (int i = 0; i < NDV; ++i)
#pragma unroll
                for (int r = 0; r < 16; ++r) o[i][r] *= alpha;
            m_run = m_new; }
        float ls = 0.f;
#pragma unroll
        for (int blk = 0; blk < 2; ++blk)
#pragma unroll
            for (int r = 0; r < 16; ++r) { const float pv_ = __builtin_amdgcn_exp2f(s[blk][r] - m_run); s[blk][r] = pv_; ls += pv_; }
        l_run += ls;
#pragma unroll
        for (int sl = 0; sl < 4; ++sl) { const int blk = sl >> 1, r0 = 8 * (sl & 1);
            v4u pw; pw.x = pg8::cvt_pk_bf16(s[blk][r0], s[blk][r0 + 1]); pw.y = pg8::cvt_pk_bf16(s[blk][r0 + 2], s[blk][r0 + 3]); pw.z = pg8::cvt_pk_bf16(s[blk][r0 + 4], s[blk][r0 + 5]); pw.w = pg8::cvt_pk_bf16(s[blk][r0 + 6], s[blk][r0 + 7]);
            const bf16x8 pf = __builtin_bit_cast(bf16x8, pw);
#pragma unroll
            for (int i = 0; i < NDV; ++i) { if (sl < 3) vfn[i] = *(const LAS bf16x8*)(Kb + voff + i * 32 * VSTR + (sl + 1) * 32); o[i] = __builtin_amdgcn_mfma_f32_32x32x16_bf16(vfc[i], pf, o[i], 0, 0, 0); }
#pragma unroll
            for (int i = 0; i < NDV; ++i) vfc[i] = vfn[i]; }
        AT_LWRITE(cur ^ 1);
        __syncthreads();
    }
#undef AT_GLOAD
#undef AT_LWRITE
    const float inv = 1.0f / xsum32(l_run);
    bf16* MIX = WSP(bf16, WS_MIXED);
    if (ISA) {
        int ll_ = l; asm volatile("" : "+s"(ll_)); const float lam_init = ll_ == 0 ? 0.2f : 0.35550906759f;     float lam_full;
        { const float* lm = F.kin[I_DLAM] + (size_t)l * 256; const float s1 = wave_sum(lm[lane] * lm[64 + lane]), s2 = wave_sum(lm[128 + lane] * lm[192 + lane]); lam_full = __expf(s1) - __expf(s2) + lam_init; }
        LAS float* R1 = (LAS float*)L;
        LAS bf16* R2 = (LAS bf16*)(L + 66048);
        const int ql = 32 * qs + r32;
        if (grp == 1) {
#pragma unroll
            for (int i = 0; i < NDV; ++i)
#pragma unroll
                for (int r = 0; r < 16; ++r) R1[ql * 129 + 32 * i + crow16(r, hi)] = lam_full * inv * o[i][r]; }
        __syncthreads();
        if (grp == 0) { float ss = 0.f;
#pragma unroll
            for (int i = 0; i < NDV; ++i)
#pragma unroll
                for (int r = 0; r < 16; ++r) { const float d = o[i][r] * inv - R1[ql * 129 + 32 * i + crow16(r, hi)]; o[i][r] = d; ss += d * d; }
            const float rstd = rsqrtf(xsum32(ss) * (1.0f / 128.0f) + 1e-6f) * (1.0f - lam_init);
            const float* sl = F.kin[I_DSUB] + l * 128;
#pragma unroll
            for (int i = 0; i < NDV; ++i)
#pragma unroll
                for (int r = 0; r < 16; ++r) { const int dv = 32 * i + crow16(r, hi); R2[ql * 132 + dv] = (bf16)f2bf(o[i][r] * rstd * sl[dv]); } }
        __syncthreads();
#pragma unroll
        for (int i = 0; i < 4; ++i) { const int c = tid + 512 * i, row = c >> 4, ch = c & 15; const LAS v2u* sp = (const LAS v2u*)(R2 + row * 132 + ch * 8); const v2u a = sp[0], bb = sp[1];
            *(v4u*)(MIX + (size_t)(b * SEQ + q0 + row) * DM + hx * 128 + ch * 8) = (v4u){a.x, a.y, bb.x, bb.y}; }
    } else {
        LAS bf16* R = (LAS bf16*)L + F.wave * 2176;
#pragma unroll
        for (int i = 0; i < NDV; ++i)
#pragma unroll
            for (int r = 0; r < 16; ++r) R[r32 * 68 + 32 * i + crow16(r, hi)] = (bf16)f2bf(o[i][r] * inv);
#pragma unroll
        for (int i = 0; i < 4; ++i) { const int c = lane + 64 * i, row = c >> 3, ch = c & 7; const LAS v2u* sp = (const LAS v2u*)(R + row * 68 + ch * 8); const v2u a = sp[0], bb = sp[1];
            *(v4u*)(MIX + (size_t)(b * SEQ + q0 + 32 * qs + row) * DM + 3072 + hd * 64 + ch * 8) = (v4u){a.x, a.y, bb.x, bb.y}; }
    }
}
__device__ __forceinline__ void prep_gla(Frame& F) {
    LAS float* Lb = (LAS float*)(F.lds + RING_OFF); LAS float* Qd = Lb + 64 * 129; LAS float* Ki = Qd + 64 * 129; LAS bf16* Kt = (LAS bf16*)(Ki + 64 * 129);
    const bf16* COLS = WSP(bf16, WS_COLS); const float* LOGA = WSP(float, WS_LOGA);
    bf16* QDEC = WSP(bf16, WS_QDEC); bf16* KDT = WSP(bf16, WS_KDT); bf16* AMg = WSP(bf16, WS_AM); float* EBL = WSP(float, WS_EBL);
    for (int u = F.bx; u < 1024; u += F.G) {
        const int b = u >> 9, h = (u >> 7) & 3, ck = u & 127; const size_t row0 = (size_t)b * SEQ + ck * 64;
        __syncthreads();
        f32x4 lg[4]; v4u qv[2], kv[2];
#pragma unroll
        for (int i = 0; i < 4; ++i) { const int i4 = F.tid + 512 * i, t = i4 >> 5, d4 = (i4 & 31) * 4; lg[i] = *(const f32x4*)(LOGA + (row0 + t) * 512 + h * 128 + d4); }
#pragma unroll
        for (int i = 0; i < 2; ++i) { const int i8 = F.tid + 512 * i, t = i8 >> 4, d8 = (i8 & 15) * 8; const bf16* p = COLS + (row0 + t) * NMAIN + h * 128 + d8; qv[i] = *(const v4u*)(p + CB_Q); kv[i] = *(const v4u*)(p + CB_K); }
#pragma unroll
        for (int i = 0; i < 4; ++i) { const int i4 = F.tid + 512 * i, t = i4 >> 5, d4 = (i4 & 31) * 4;
#pragma unroll
            for (int e = 0; e < 4; ++e) Lb[t * 129 + d4 + e] = lg[i][e]; }
        __syncthreads();
        if (F.tid < 128) { float a[64];
#pragma unroll
            for (int t = 0; t < 64; ++t) a[t] = Lb[t * 129 + F.tid];
#pragma unroll
            for (int t = 1; t < 64; ++t) a[t] += a[t - 1];
#pragma unroll
            for (int t = 0; t < 64; ++t) Lb[t * 129 + F.tid] = a[t];
            EBL[(size_t)u * 128 + F.tid] = __expf(a[63]); }
        __syncthreads();
#pragma unroll
        for (int i = 0; i < 2; ++i) { const int i8 = F.tid + 512 * i, t = i8 >> 4, d8 = (i8 & 15) * 8; float q[8], k[8], qo[8]; unpack8(qv[i], q); unpack8(kv[i], k);
#pragma unroll
            for (int e = 0; e < 8; ++e) { const int d = d8 + e; const float bt = Lb[t * 129 + d], bl = Lb[63 * 129 + d];
                const float qd = q[e] * 0.08838834764831845f * __expf(bt); Qd[t * 129 + d] = qd; Ki[t * 129 + d] = k[e] * __expf(-bt); Kt[d * 72 + t] = (bf16)f2bf(k[e] * __expf(bl - bt)); qo[e] = qd; }
            *(v4u*)(QDEC + ((size_t)u * 64 + t) * 128 + d8) = pack8(qo); }
        __syncthreads();
#pragma unroll
        for (int i = 0; i < 2; ++i) { const int c_ = F.tid + 512 * i, row = c_ >> 3, ch = c_ & 7; const LAS v2u* sp = (const LAS v2u*)(Kt + row * 72 + ch * 8); const v2u a = sp[0], bb = sp[1];
            *(v4u*)(KDT + ((size_t)u * 128 + row) * 64 + ch * 8) = (v4u){a.x, a.y, bb.x, bb.y}; }
        {
          const int n = F.lane & 15, gq = F.lane >> 4, ct = F.wave >> 1, st0 = 2 * (F.wave & 1);
          f32x4 c0 = (f32x4){0.f, 0.f, 0.f, 0.f}, c1 = (f32x4){0.f, 0.f, 0.f, 0.f};
          if (st0 <= ct) {
              const LAS float* ap = Qd + (16 * ct + n) * 129 + gq; const LAS float* bp0 = Ki + (16 * st0 + n) * 129 + gq; const LAS float* bp1 = bp0 + 16 * 129;
#pragma unroll 8
              for (int ks = 0; ks < 32; ++ks) { const float av = ap[4 * ks]; c0 = __builtin_amdgcn_mfma_f32_16x16x4f32(av, bp0[4 * ks], c0, 0, 0, 0); c1 = __builtin_amdgcn_mfma_f32_16x16x4f32(av, bp1[4 * ks], c1, 0, 0, 0); } }
#pragma unroll
          for (int rr = 0; rr < 4; ++rr) { const int c = 16 * ct + 4 * gq + rr, s0 = 16 * st0 + n, s1 = s0 + 16;
              bf16* op = AMg + ((size_t)u * 64 + c) * 64; op[s0] = (bf16)f2bf(s0 <= c ? c0[rr] : 0.f); op[s1] = (bf16)f2bf(s1 <= c ? c1[rr] : 0.f); } }
    }
}
template <int PASS> __device__ __forceinline__ void prep_vt(Frame& F) {
    LAS bf16* T = (LAS bf16*)(F.lds + RING_OFF);
    const bf16* COLS = WSP(bf16, WS_COLS);
    constexpr int ncol = PASS == 4 ? 128 : 512, nch = ncol >> 3, NI = 64 * nch / (NWAVES * 64);
    constexpr int col0 = PASS < 2 ? CA_V + 512 * PASS : (PASS < 4 ? CB_V + 512 * (PASS - 2) : CD_V);
    bf16* dst0 = PASS < 2 ? WSP(bf16, WS_VTA) + (size_t)(512 * PASS) * VROW : (PASS < 4 ? WSP(bf16, WS_VTB) + (size_t)(512 * (PASS - 2)) * VROW : WSP(bf16, WS_VTD));
    constexpr int rows_b = PASS == 4 ? 128 : 1024;
    for (int tile = F.bx; tile < M / 64; tile += F.G) {
        const int b = tile >> 7, t0 = (tile & 127) * 64;
        __syncthreads();
        v4u v[NI];
#pragma unroll
        for (int i = 0; i < NI; ++i) { const int idx = F.tid + NWAVES * 64 * i, tok = idx / nch, ch = idx % nch; v[i] = *(const v4u*)(COLS + (size_t)(b * SEQ + t0 + tok) * NMAIN + col0 + ch * 8); }
#pragma unroll
        for (int i = 0; i < NI; ++i) { const int idx = F.tid + NWAVES * 64 * i, tok = idx / nch, ch = idx % nch; LAS unsigned* d = (LAS unsigned*)(T + tok * 522 + ch * 8); d[0] = v[i].x; d[1] = v[i].y; d[2] = v[i].z; d[3] = v[i].w; }
        __syncthreads();
#pragma unroll
        for (int i = 0; i < NI; ++i) { const int idx = F.tid + NWAVES * 64 * i, vrow = idx >> 3, ch = idx & 7;
            unsigned e[8];
#pragma unroll
            for (int k = 0; k < 8; ++k) e[k] = T[(ch * 8 + k) * 522 + vrow];
            v4u o; o.x = e[0] | (e[1] << 16); o.y = e[2] | (e[3] << 16); o.z = e[4] | (e[5] << 16); o.w = e[6] | (e[7] << 16);
            *(v4u*)(dst0 + ((size_t)b * rows_b + vrow) * VROW + t0 + ch * 8) = o; }
    }
}
typedef float f32x4v __attribute__((ext_vector_type(4)));
__device__ __forceinline__ float sum16(float v) { v = sum8(v); v += dpp_f<0x140>(v); return v; }
#define LDS_BARRIER() asm volatile("s_waitcnt lgkmcnt(0)\n\ts_barrier" ::: "memory")
template <int HACK = 0> __device__ __forceinline__ void gla_scan_unit(Frame& F, int l, int b, int h, int vh) {
    LAS unsigned char* L = F.lds + RING_OFF;
    constexpr int OQD = 0, OKT = 17408, OAM = 35840, OVT = 45056, OOT = 63488, OEB = 80896, OPS = 81408;
    const int tid = F.tid, lane = F.lane, n = lane & 15, g = lane >> 4, w = F.wave;
    const bf16* QDEC = WSP(bf16, WS_QDEC); const bf16* KDT = WSP(bf16, WS_KDT); const bf16* AMg = WSP(bf16, WS_AM); const float* EBL = WSP(float, WS_EBL);
    const bf16* VTB = WSP(bf16, WS_VTB) + (size_t)((b * 4 + h) * 256 + 128 * vh) * VROW; bf16* OB = WSP(bf16, WS_OB); float* PSG = WSP(float, WS_PSG);
    f32x4v S[8];
#pragma unroll
    for (int dt = 0; dt < 8; ++dt) S[dt] = (f32x4v){0.f, 0.f, 0.f, 0.f};
    v4u pq[2], pk[2], pa, pv[2]; float pe = 0.f;
#define GL_ISSUE(CK) do { const size_t u_ = (size_t)(b * 4 + h) * 128 + (CK); \
        _Pragma("unroll") for (int i = 0; i < 2; ++i) { const int c_ = tid + 512 * i; pq[i] = *(const v4u*)(QDEC + (u_ * 64 + (c_ >> 4)) * 128 + (c_ & 15) * 8); pk[i] = *(const v4u*)(KDT + (u_ * 128 + (c_ >> 3)) * 64 + (c_ & 7) * 8); \
            pv[i] = *(const v4u*)(VTB + (size_t)(c_ >> 3) * VROW + (CK) * 64 + (c_ & 7) * 8); } \
        pa = *(const v4u*)(AMg + (u_ * 64 + (tid >> 3)) * 64 + (tid & 7) * 8); \
        pe = EBL[u_ * 128 + (tid & 127)]; } while (0)
#define GL_WRITE() do { _Pragma("unroll") for (int i = 0; i < 2; ++i) { const int c_ = tid + 512 * i; *(LAS v4u*)(L + OQD + (c_ >> 4) * 272 + (c_ & 15) * 16) = pq[i]; *(LAS v4u*)(L + OKT + (c_ >> 3) * 144 + (c_ & 7) * 16) = pk[i]; \
            *(LAS v4u*)(L + OVT + (c_ >> 3) * 144 + (c_ & 7) * 16) = pv[i]; } \
        *(LAS v4u*)(L + OAM + (tid >> 3) * 144 + (tid & 7) * 16) = pa; \
        ((LAS float*)(L + OEB))[tid & 127] = pe; } while (0)
    GL_ISSUE(0); GL_WRITE();
    LDS_BARRIER();
#pragma unroll 1
    for (int ck = 0; ck < 128; ++ck) {
        const size_t row0 = (size_t)b * SEQ + ck * 64;
        GL_ISSUE((HACK & 1) && ck >= 2 ? 2 : (ck + 1 < 128 ? ck + 1 : 127));
        bf16x8 vf[2];
#pragma unroll
        for (int ks = 0; ks < 2; ++ks) vf[ks] = *(const LAS bf16x8*)(L + OVT + (16 * w + n) * 144 + (32 * ks + 8 * g) * 2);
        f32x4v o[4];
#pragma unroll
        for (int ct = 0; ct < 4; ++ct) o[ct] = (f32x4v){0.f, 0.f, 0.f, 0.f};
#pragma unroll
        for (int ct = 0; ct < 4; ++ct)
#pragma unroll
            for (int ks = 0; ks < 2; ++ks) { const bf16x8 af = *(const LAS bf16x8*)(L + OAM + (16 * ct + n) * 144 + (32 * ks + 8 * g) * 2); o[ct] = __builtin_amdgcn_mfma_f32_16x16x32_bf16(af, vf[ks], o[ct], 0, 0, 0); }
#pragma unroll
        for (int kk = 0; kk < 4; ++kk) { v4u pw; pw.x = pg8::cvt_pk_bf16(S[2 * kk][0], S[2 * kk][1]); pw.y = pg8::cvt_pk_bf16(S[2 * kk][2], S[2 * kk][3]);
            pw.z = pg8::cvt_pk_bf16(S[2 * kk + 1][0], S[2 * kk + 1][1]); pw.w = pg8::cvt_pk_bf16(S[2 * kk + 1][2], S[2 * kk + 1][3]); const bf16x8 sf = __builtin_bit_cast(bf16x8, pw);
#pragma unroll
            for (int ct = 0; ct < 4; ++ct) { const LAS unsigned char* qp = L + OQD + (16 * ct + n) * 272 + (32 * kk + 4 * g) * 2; const v2u qa = *(const LAS v2u*)qp, qb = *(const LAS v2u*)(qp + 32);
                o[ct] = __builtin_amdgcn_mfma_f32_16x16x32_bf16(__builtin_bit_cast(bf16x8, (v4u){qa.x, qa.y, qb.x, qb.y}), sf, o[ct], 0, 0, 0); } }
#pragma unroll
        for (int dt = 0; dt < 8; ++dt) { const f32x4v eb = *(const LAS f32x4v*)(L + OEB + (16 * dt + 4 * g) * 4); S[dt] = S[dt] * eb;
#pragma unroll
            for (int ks = 0; ks < 2; ++ks) { const bf16x8 kf = *(const LAS bf16x8*)(L + OKT + (16 * dt + n) * 144 + (32 * ks + 8 * g) * 2); S[dt] = __builtin_amdgcn_mfma_f32_16x16x32_bf16(kf, vf[ks], S[dt], 0, 0, 0); } }
        LAS float* PS = (LAS float*)(L + OPS) + (ck & 1) * 512;
#pragma unroll
        for (int ct = 0; ct < 4; ++ct)
#pragma unroll
            for (int r = 0; r < 4; ++r) { const float ss = sum16(o[ct][r] * o[ct][r]); if (n == 0) PS[(16 * ct + 4 * g + r) * 8 + w] = ss;
                *(LAS bf16*)(L + OOT + (16 * ct + 4 * g + r) * 272 + (16 * w + n) * 2) = (bf16)f2bf(o[ct][r]); }
        LDS_BARRIER();
        GL_WRITE();
        if (!(HACK & 2)) {
#pragma unroll
        for (int i = 0; i < 2; ++i) { const int c_ = tid + 512 * i, tok = c_ >> 4, ch = c_ & 15; *(v4u*)(OB + (row0 + tok) * 1024 + h * 256 + 128 * vh + ch * 8) = *(const LAS v4u*)(L + OOT + tok * 272 + ch * 16); }
        if (tid < 64) { const LAS f32x4v* pp = (const LAS f32x4v*)(PS + tid * 8); const f32x4v p0 = pp[0], p1 = pp[1]; PSG[(row0 + tid) * 8 + h * 2 + vh] = ((p0.x + p0.y) + (p0.z + p0.w)) + ((p1.x + p1.y) + (p1.z + p1.w)); } }
        LDS_BARRIER();
    }
#undef GL_ISSUE
#undef GL_WRITE
}
__device__ __forceinline__ void gla_post(Frame& F, int l) {
    const bf16* OB = WSP(bf16, WS_OB); const float* PSG = WSP(float, WS_PSG); const bf16* COLS = WSP(bf16, WS_COLS); bf16* MIX = WSP(bf16, WS_MIXED);
    const int ch = F.tid & 127, h = ch >> 5; float gain8[8];
#pragma unroll
    for (int e = 0; e < 8; ++e) gain8[e] = F.kin[I_GON][l * 256 + (ch & 31) * 8 + e];
    for (int row0 = F.bx * 4 + (F.tid >> 7); row0 < M; row0 += F.G * 16) {
        v4u ovr[4], gvr[4]; f32x2_t ps[4];
#pragma unroll
        for (int i = 0; i < 4; ++i) { const int row = row0 + F.G * 4 * i < M ? row0 + F.G * 4 * i : row0;
            ovr[i] = *(const v4u*)(OB + (size_t)row * 1024 + ch * 8); gvr[i] = *(const v4u*)(COLS + (size_t)row * NMAIN + CB_G + ch * 8); ps[i] = *(const f32x2_t*)(PSG + (size_t)row * 8 + h * 2); }
#pragma unroll
        for (int i = 0; i < 4; ++i) { const int row = row0 + F.G * 4 * i; float ov[8], gv[8]; unpack8(ovr[i], ov); unpack8(gvr[i], gv);
            const float rstd = rsqrtf((ps[i].x + ps[i].y) * (1.0f / 256.0f) + 1e-6f);
#pragma unroll
            for (int e = 0; e < 8; ++e) ov[e] = ov[e] * (rstd * gain8[e]) * silu_g(gv[e]);
            if (row < M) *(v4u*)(MIX + (size_t)row * DM + 1024 + ch * 8) = pack8(ov); }
    }
}
constexpr int RC_AT = 0, RC_RT = 2048, RC_BK = 4096, RC_VF = 8192, RC_GF = 10240, RC_U0 = 12288, RC_Y0 = 16384, RC_P15 = 20480, RC_BN = 20736, RC_BYTES = 20800;
__device__ __forceinline__ void rwkv_chunks_of_tile(Frame& F, int l, int tile) {
    const int team = F.tid >> 8, tt = F.tid & 255;
    LAS float* Lt = (LAS float*)(F.lds + RING_OFF) + team * 12288;
    LAS float* XA = Lt; LAS float* XR = Lt + 1040; LAS float* ZB = Lt + 2080; LAS float* ZK = Lt + 3120; LAS float* TB = Lt + 4160; LAS float* TK = Lt + 5200; LAS float* VV = Lt + 6240;
    LAS float* ATl = Lt + 7280; LAS float* U0l = Lt + 8320; LAS float* W1 = Lt + 9360;
    LAS float* Aab = Lt + 10400; LAS float* Aak = Lt + 10672; LAS float* Arb = Lt + 10944; LAS float* Ark = Lt + 11216; LAS float* TT = Lt + 11488;
    const float* RW = WSP(float, WS_RW); const unsigned* RWU = WSP(unsigned, WS_RW); constexpr size_t RS = RW_ONE / 4; unsigned char* RWC = F.ws + WS_RWC;
    float pw_[6], pr_[4], pk_[4], pv_[4], pa_[4], pb_[4], pg_[4];
#define RC_FETCH(P) do { const int h_ = 2 * (P) + team; const size_t cb_ = (size_t)tile * 16 * 1024 + h_ * 64 + (tt & 63); const int q_ = tt >> 6; \
        pw_[4] = RW[RS + cb_ + (size_t)(q_ ? 4 * q_ - 1 : 0) * 1024]; pw_[5] = RW[RS + cb_ + (size_t)15 * 1024];            \
        _Pragma("unroll") for (int e = 0; e < 4; ++e) { const size_t o_ = cb_ + (size_t)(4 * q_ + e) * 1024; pw_[e] = RW[RS + o_]; const unsigned u0 = RWU[o_], u2 = RWU[2 * RS + o_], u3 = RWU[3 * RS + o_]; \
            pr_[e] = bflo(u0); pk_[e] = bfhi(u0); pv_[e] = bflo(u2); pg_[e] = bfhi(u2); pa_[e] = bflo(u3); pb_[e] = bfhi(u3); } } while (0)
    RC_FETCH(0);
#pragma unroll 1
    for (int pair = 0; pair < 8; ++pair) {
        const int uc = ((tile >> 9) * 16 + 2 * pair + team) * 512 + (tile & 511), b = uc >> 13, h = (uc >> 9) & 15, ck = uc & 511; unsigned char* rec = RWC + ((size_t)ck * 32 + (uc >> 9)) * RC_BYTES;     (void)b;
        __syncthreads();
        {
          const int j = tt & 63, q = tt >> 6;
          const float cl = pw_[5], clm = q ? pw_[4] : 0.f; const float clq[4] = {pw_[0], pw_[1], pw_[2], pw_[3]};
#pragma unroll
          for (int e = 0; e < 4; ++e) { const int t = 4 * q + e; const float cprev = e == 0 ? clm : clq[e - 1], cc = clq[e];
              const float rr = pr_[e], kk = pk_[e], vv = pv_[e], aa = pa_[e], bb = pb_[e];
              XA[t * 65 + j] = aa * __expf(cprev); XR[t * 65 + j] = rr * __expf(cc); const float ei = __expf(-cc), ef = __expf(cl - cc);
              ZB[t * 65 + j] = bb * ei; ZK[t * 65 + j] = kk * ei; TB[t * 65 + j] = bb * ef; TK[t * 65 + j] = kk * ef; VV[t * 65 + j] = vv; }
          if (q == 0) ((float*)(rec + RC_P15))[j] = __expf(cl);
          { v2u gw; gw.x = pk2(pg_[0], pg_[1]); gw.y = pk2(pg_[2], pg_[3]); *(v2u*)(rec + RC_GF + (((j >> 4) * 64 + 16 * q + (j & 15)) * 8)) = gw; } }
        RC_FETCH(pair < 7 ? pair + 1 : 7);
        __syncthreads();
        {
          const int q = tt >> 6, n = tt & 15, g = (tt >> 4) & 3; const LAS float* X = (q & 2) ? XR : XA; const LAS float* Z = (q & 1) ? ZK : ZB; LAS float* O = q == 0 ? Aab : (q == 1 ? Aak : (q == 2 ? Arb : Ark));
          f32x4v c = (f32x4v){0.f, 0.f, 0.f, 0.f};
#pragma unroll
          for (int ks = 0; ks < 16; ++ks) c = __builtin_amdgcn_mfma_f32_16x16x4f32(X[n * 65 + 4 * ks + g], Z[n * 65 + 4 * ks + g], c, 0, 0, 0);
#pragma unroll
          for (int rr = 0; rr < 4; ++rr) { const int t = 4 * g + rr; O[t * 17 + n] = ((q & 2) ? n <= t : n < t) ? c[rr] : 0.f; }
          { const int t = tt >> 4, jq = tt & 15; const float* rkp = F.kin[I_RRK] + l * 1024 + h * 64 + 4 * jq; float bn = 0.f;
#pragma unroll
            for (int e = 0; e < 4; ++e) bn += XR[t * 65 + 4 * jq + e] * ZK[t * 65 + 4 * jq + e] * rkp[e];
            bn = sum16(bn); if (jq == 0) ((float*)(rec + RC_BN))[t] = bn; } }
        __syncthreads();
        {
          if (tt < 16) { float col[16];
#pragma unroll
              for (int t = 0; t < 16; ++t) { float acc = (t == tt) ? 1.f : 0.f;
#pragma unroll
                  for (int s = 0; s < 16; ++s) if (s < t) acc += Aab[t * 17 + s] * col[s];
                  col[t] = acc; TT[t * 17 + tt] = acc; } }
          const int q = tt >> 6, n = tt & 15, g = (tt >> 4) & 3; f32x4v c = (f32x4v){0.f, 0.f, 0.f, 0.f};
#pragma unroll
          for (int ks = 0; ks < 4; ++ks) c = __builtin_amdgcn_mfma_f32_16x16x4f32(Aak[n * 17 + 4 * ks + g], VV[(4 * ks + g) * 65 + 16 * q + n], c, 0, 0, 0);
#pragma unroll
          for (int rr = 0; rr < 4; ++rr) W1[(4 * g + rr) * 65 + 16 * q + n] = c[rr]; }
        __syncthreads();
        {
          const int q = tt >> 6, n = tt & 15, g = (tt >> 4) & 3; f32x4v ca = (f32x4v){0.f, 0.f, 0.f, 0.f}, cu = (f32x4v){0.f, 0.f, 0.f, 0.f};
#pragma unroll
          for (int ks = 0; ks < 4; ++ks) { const float tv = TT[n * 17 + 4 * ks + g]; ca = __builtin_amdgcn_mfma_f32_16x16x4f32(tv, XA[(4 * ks + g) * 65 + 16 * q + n], ca, 0, 0, 0); cu = __builtin_amdgcn_mfma_f32_16x16x4f32(tv, W1[(4 * ks + g) * 65 + 16 * q + n], cu, 0, 0, 0); }
#pragma unroll
          for (int rr = 0; rr < 4; ++rr) { ATl[(4 * g + rr) * 65 + 16 * q + n] = ca[rr]; U0l[(4 * g + rr) * 65 + 16 * q + n] = cu[rr]; }
          *(f32x4v*)(rec + RC_U0 + ((q * 64 + 16 * g + n) * 16)) = cu; }
        __syncthreads();
        {
          const int q = tt >> 6, n = tt & 15, g = (tt >> 4) & 3; f32x4v cr, cy = (f32x4v){0.f, 0.f, 0.f, 0.f};
#pragma unroll
          for (int rr = 0; rr < 4; ++rr) cr[rr] = XR[(4 * g + rr) * 65 + 16 * q + n];
#pragma unroll
          for (int ks = 0; ks < 4; ++ks) { const float arb = Arb[n * 17 + 4 * ks + g], ark = Ark[n * 17 + 4 * ks + g];
              cr = __builtin_amdgcn_mfma_f32_16x16x4f32(arb, ATl[(4 * ks + g) * 65 + 16 * q + n], cr, 0, 0, 0);
              cy = __builtin_amdgcn_mfma_f32_16x16x4f32(arb, U0l[(4 * ks + g) * 65 + 16 * q + n], cy, 0, 0, 0);
              cy = __builtin_amdgcn_mfma_f32_16x16x4f32(ark, VV[(4 * ks + g) * 65 + 16 * q + n], cy, 0, 0, 0); }
          *(f32x4v*)(rec + RC_Y0 + ((q * 64 + 16 * g + n) * 16)) = cy;
#pragma unroll
          for (int rr = 0; rr < 4; ++rr) W1[(4 * g + rr) * 65 + 16 * q + n] = cr[rr]; }
        __syncthreads();
        { const int t = tt & 15, jq = tt >> 4, kk = jq >> 3, half = (jq & 7) >> 2, g = jq & 3, j0 = 4 * jq;
          v2u wa, wr; wa.x = pk2(ATl[t * 65 + j0], ATl[t * 65 + j0 + 1]); wa.y = pk2(ATl[t * 65 + j0 + 2], ATl[t * 65 + j0 + 3]); wr.x = pk2(W1[t * 65 + j0], W1[t * 65 + j0 + 1]); wr.y = pk2(W1[t * 65 + j0 + 2], W1[t * 65 + j0 + 3]);
          *(v2u*)(rec + RC_AT + kk * 1024 + (16 * g + t) * 16 + half * 8) = wa; *(v2u*)(rec + RC_RT + kk * 1024 + (16 * g + t) * 16 + half * 8) = wr;
          const int j = tt & 63, gg = tt >> 6; v4u bk; bk.x = pk2(TB[(4 * gg) * 65 + j], TB[(4 * gg + 1) * 65 + j]); bk.y = pk2(TB[(4 * gg + 2) * 65 + j], TB[(4 * gg + 3) * 65 + j]);
          bk.z = pk2(TK[(4 * gg) * 65 + j], TK[(4 * gg + 1) * 65 + j]); bk.w = pk2(TK[(4 * gg + 2) * 65 + j], TK[(4 * gg + 3) * 65 + j]);
          *(v4u*)(rec + RC_BK + (j >> 4) * 1024 + (16 * gg + (j & 15)) * 16) = bk;
          v2u vf; vf.x = pk2(VV[(4 * gg) * 65 + j], VV[(4 * gg + 1) * 65 + j]); vf.y = pk2(VV[(4 * gg + 2) * 65 + j], VV[(4 * gg + 3) * 65 + j]);
          *(v2u*)(rec + RC_VF + ((j >> 4) * 64 + 16 * gg + (j & 15)) * 8) = vf; }
    }
}
#undef RC_FETCH
template <int HACK = 0> __device__ __forceinline__ void rwkv_scan_unit(Frame& F, int l, int b, int h) {
    LAS unsigned char* L = F.lds + RING_OFF;
    const unsigned char* recs = F.ws + WS_RWC + (size_t)(b * 16 + h) * RC_BYTES;
    const int lane = F.lane, n = lane & 15, g = lane >> 4;
    LAS float* XS = (LAS float*)(L + 2 * RC_BYTES);
    if (F.wave >= 2) {
        const int li = F.tid - 128;
        int px[4];
#pragma unroll
        for (int k = 0; k < 4; ++k) { const int x = li + 384 * k; px[k] = x < 1300 ? x : 1299; }
        v4u p0[4], p1[4], p2[4], p3[4], p4[4], p5[4], p6[4], p7[4];
#define RWL_ISSUE(P, CK) do { const int ck_ = (CK) < 512 ? ((HACK & 1) && (CK) >= 4 ? 3 : (CK)) : 511; const v4u* src_ = (const v4u*)(recs + (size_t)ck_ * 32 * RC_BYTES); \
        _Pragma("unroll") for (int k = 0; k < 4; ++k) P[k] = src_[px[k]]; } while (0)
#define RWL_WRITE(P, CK) do { LAS v4u* dst_ = (LAS v4u*)(L + ((CK) & 1) * RC_BYTES); _Pragma("unroll") for (int k = 0; k < 4; ++k) dst_[px[k]] = P[k]; } while (0)
        RWL_ISSUE(p0, 0); RWL_ISSUE(p1, 1); RWL_ISSUE(p2, 2); RWL_ISSUE(p3, 3); RWL_ISSUE(p4, 4); RWL_ISSUE(p5, 5); RWL_ISSUE(p6, 6); RWL_ISSUE(p7, 7);
        RWL_WRITE(p0, 0); RWL_ISSUE(p0, 8);
        LDS_BARRIER();
#pragma unroll 1
        for (int ck = 0; ck < 512; ck += 8) {
            RWL_WRITE(p1, ck + 1); RWL_ISSUE(p1, ck + 9); LDS_BARRIER();
            RWL_WRITE(p2, ck + 2); RWL_ISSUE(p2, ck + 10); LDS_BARRIER();
            RWL_WRITE(p3, ck + 3); RWL_ISSUE(p3, ck + 11); LDS_BARRIER();
            RWL_WRITE(p4, ck + 4); RWL_ISSUE(p4, ck + 12); LDS_BARRIER();
            RWL_WRITE(p5, ck + 5); RWL_ISSUE(p5, ck + 13); LDS_BARRIER();
            RWL_WRITE(p6, ck + 6); RWL_ISSUE(p6, ck + 14); LDS_BARRIER();
            RWL_WRITE(p7, ck + 7); RWL_ISSUE(p7, ck + 15); LDS_BARRIER();
            RWL_WRITE(p0, ck + 8); RWL_ISSUE(p0, ck + 16); LDS_BARRIER();
        }
#undef RWL_ISSUE
#undef RWL_WRITE
        return;
    }
    const int cw = F.wave;
    f32x4v S[4][2];
#pragma unroll
    for (int jt = 0; jt < 4; ++jt)
#pragma unroll
        for (int it = 0; it < 2; ++it) S[jt][it] = (f32x4v){0.f, 0.f, 0.f, 0.f};
    float lnw[2], lnb[2];
#pragma unroll
    for (int it = 0; it < 2; ++it) { lnw[it] = F.kin[I_RLNW][l * 1024 + h * 64 + 16 * (2 * cw + it) + n]; lnb[it] = F.kin[I_RLNB][l * 1024 + h * 64 + 16 * (2 * cw + it) + n]; }
    bf16* MIX = WSP(bf16, WS_MIXED) + ((size_t)b * SEQ) * DM + 2048 + h * 64 + 32 * cw + n;
    f32x4v Yp[2] = {(f32x4v){0.f, 0.f, 0.f, 0.f}, (f32x4v){0.f, 0.f, 0.f, 0.f}}, bnp = (f32x4v){0.f, 0.f, 0.f, 0.f}; v2u gfp[2] = {(v2u){0u, 0u}, (v2u){0u, 0u}}, vfp[2] = {(v2u){0u, 0u}, (v2u){0u, 0u}};
    LDS_BARRIER();
#pragma unroll 1
    for (int ck = 0; ck <= 512; ++ck) {
        if (ck > 0) {
            const LAS float* xs = XS + ((ck - 1) & 1) * 64; const f32x4v a0 = *(const LAS f32x4v*)(xs + 8 * g), a1 = *(const LAS f32x4v*)(xs + 8 * g + 4), b0 = *(const LAS f32x4v*)(xs + 32 + 8 * g), b1 = *(const LAS f32x4v*)(xs + 32 + 8 * g + 4);
            const float s1[4] = {a0[0] + b0[0], a0[2] + b0[2], a1[0] + b1[0], a1[2] + b1[2]}, s2[4] = {a0[1] + b0[1], a0[3] + b0[3], a1[1] + b1[1], a1[3] + b1[3]};
#pragma unroll
            for (int it = 0; it < 2; ++it) { const float gt[4] = {bflo(gfp[it].x), bfhi(gfp[it].x), bflo(gfp[it].y), bfhi(gfp[it].y)}, vt[4] = {bflo(vfp[it].x), bfhi(vfp[it].x), bflo(vfp[it].y), bfhi(vfp[it].y)};
#pragma unroll
                for (int r = 0; r < 4; ++r) { const float mean = s1[r] * (1.0f / 64.0f), var = fmaxf(s2[r] * (1.0f / 64.0f) - mean * mean, 0.f), rstd = rsqrtf(var + 64e-5f);
                    if (!(HACK & 2)) MIX[(size_t)((ck - 1) * 16 + 4 * g + r) * DM + 16 * it] = (bf16)f2bf(((Yp[it][r] - mean) * rstd * lnw[it] + lnb[it] + bnp[r] * vt[r]) * gt[r]); } }
            if (ck == 512) break;
        }
        if (HACK & 4) { LDS_BARRIER(); continue; }
        const LAS unsigned char* R = L + (ck & 1) * RC_BYTES;
        bf16x8 at[2], rt[2];
#pragma unroll
        for (int kk = 0; kk < 2; ++kk) { at[kk] = *(const LAS bf16x8*)(R + RC_AT + kk * 1024 + lane * 16); rt[kk] = *(const LAS bf16x8*)(R + RC_RT + kk * 1024 + lane * 16); }
        f32x4v U[2], Y[2];
#pragma unroll
        for (int it = 0; it < 2; ++it) { U[it] = *(const LAS f32x4v*)(R + RC_U0 + (2 * cw + it) * 1024 + lane * 16); Y[it] = *(const LAS f32x4v*)(R + RC_Y0 + (2 * cw + it) * 1024 + lane * 16); }
#pragma unroll
        for (int kk = 0; kk < 2; ++kk)
#pragma unroll
            for (int it = 0; it < 2; ++it) { v4u pw; pw.x = pg8::cvt_pk_bf16(S[2 * kk][it][0], S[2 * kk][it][1]); pw.y = pg8::cvt_pk_bf16(S[2 * kk][it][2], S[2 * kk][it][3]);
                pw.z = pg8::cvt_pk_bf16(S[2 * kk + 1][it][0], S[2 * kk + 1][it][1]); pw.w = pg8::cvt_pk_bf16(S[2 * kk + 1][it][2], S[2 * kk + 1][it][3]); const bf16x8 sf = __builtin_bit_cast(bf16x8, pw);
                U[it] = __builtin_amdgcn_mfma_f32_16x16x32_bf16(at[kk], sf, U[it], 0, 0, 0); Y[it] = __builtin_amdgcn_mfma_f32_16x16x32_bf16(rt[kk], sf, Y[it], 0, 0, 0); }
        bf16x8 uv[2];
#pragma unroll
        for (int it = 0; it < 2; ++it) { vfp[it] = *(const LAS v2u*)(R + RC_VF + (2 * cw + it) * 512 + lane * 8); gfp[it] = *(const LAS v2u*)(R + RC_GF + (2 * cw + it) * 512 + lane * 8);
            v4u pw; pw.x = pg8::cvt_pk_bf16(U[it][0], U[it][1]); pw.y = pg8::cvt_pk_bf16(U[it][2], U[it][3]); pw.z = vfp[it].x; pw.w = vfp[it].y; uv[it] = __builtin_bit_cast(bf16x8, pw); }
#pragma unroll
        for (int jt = 0; jt < 4; ++jt) { const bf16x8 bk = *(const LAS bf16x8*)(R + RC_BK + jt * 1024 + lane * 16); const f32x4v p15 = *(const LAS f32x4v*)(R + RC_P15 + (16 * jt + 4 * g) * 4);
#pragma unroll
            for (int it = 0; it < 2; ++it) S[jt][it] = __builtin_amdgcn_mfma_f32_16x16x32_bf16(bk, uv[it], S[jt][it] * p15, 0, 0, 0); }
        bnp = *(const LAS f32x4v*)(R + RC_BN + 16 * g); Yp[0] = Y[0]; Yp[1] = Y[1];
        { LAS float* xo = XS + (ck & 1) * 64 + cw * 32; const f32x4v sm = Y[0] + Y[1], sq = Y[0] * Y[0] + Y[1] * Y[1];
#pragma unroll
          for (int r = 0; r < 4; ++r) { const float a = sum16(sm[r]), q = sum16(sq[r]); if (n == 0) { xo[(4 * g + r) * 2] = a; xo[(4 * g + r) * 2 + 1] = q; } } }
        LDS_BARRIER();
    }
}
template <int HACK = 0> __device__ __forceinline__ void mixers_v4(Frame& F, int l, int qi, int mask = 15) {
    gu32* ctr = F.ctl + CW_Q + 64 * qi;
    for (;;) {
        const int it = next_item(F, ctr); relaunder(F); relaunder_tid(F);
        if (it < 32) { if (mask & 1) rwkv_scan_unit<HACK>(F, l, it >> 4, it & 15); }
        else if (it < 48) { const int j = it - 32; if (mask & 2) gla_scan_unit<HACK>(F, l, j >> 3, (j >> 1) & 3, j & 1); }
        else if (it < 48 + 1024) { const int j = it - 48, qb = 63 - (j >> 4), bh = j & 15; if (mask & 4) attn_unit<true>(F, l, bh >> 3, bh & 7, qb); }
        else if (it < 48 + 2048) { const int j = it - 1072, qb = j & 63, bh = j >> 6; if (mask & 8) attn_unit<false>(F, l, bh >> 3, bh & 7, qb); }
        else break;
    }
}
template <int HACK = 0> __device__ __forceinline__ void prep_rwkv(Frame& F, int l) {
    LAS float* zl = (LAS float*)(F.lds + RING_OFF) + 4096;
    LAS bf16* inb = (LAS bf16*)(F.lds + RING_OFF);
    const float* mu = F.kin[I_RMU] + (size_t)l * 3264;
    const float* LOWR = WSP(float, WS_LOWR); const bf16* COLS = WSP(bf16, WS_COLS);
    float* RW = WSP(float, WS_RW); unsigned* RWU = WSP(unsigned, WS_RW); float* VF = WSP(float, WS_VFIRST);
    constexpr size_t RS = RW_ONE / 4;
    for (int tile = F.bx; tile < M / 16; tile += F.G) {
        const int row0 = tile * 16;
        relaunder(F); relaunder_tid(F);
        __syncthreads();
        {
            float cur_[7], prv_[7], mu_[7];
#pragma unroll
            for (int q = 0; q < 7; ++q) { const int idx = F.tid + NWAVES * 64 * q, tt = idx / 224, j = idx % 224, row = row0 + tt;
                const int col = j < 192 ? 16 + j : 208 + (j - 192);
                const float* mp = j < 192 ? mu + 3072 + j : F.kin[I_VRMU] + (l ? (l - 1) * 32 : 0) + (j - 192);
                cur_[q] = LOWR[(size_t)row * 256 + col]; prv_[q] = LOWR[(size_t)((row & (SEQ - 1)) ? row - 1 : row) * 256 + col]; mu_[q] = *mp; }
#pragma unroll
            for (int q = 0; q < 7; ++q) { const int idx = F.tid + NWAVES * 64 * q, tt = idx / 224, j = idx % 224, row = row0 + tt;
                const float prev = (row & (SEQ - 1)) ? prv_[q] : 0.f, muv = (j >= 192 && l == 0) ? 0.f : mu_[q];
                float x = cur_[q] + (prev - cur_[q]) * muv;
                if (j < 64) x = tanhf(x); else if (j >= 128 && j < 192) x = sigmoid_f(x);
                inb[tt * 232 + j] = (bf16)f2bf(x); } }
        __syncthreads();
        {
            const int c = 2 * F.tid;
            float accw[2][16], acca[2][16], accg[2][16], accv[2][16];
#pragma unroll
            for (int e = 0; e < 2; ++e) { const float bw = F.kin[I_RW0][l * 1024 + c + e], ba = F.kin[I_RA0][l * 1024 + c + e], bv = l ? F.kin[I_VR0][(l - 1) * 1024 + c + e] : 0.f;
#pragma unroll
              for (int tt = 0; tt < 16; ++tt) { accw[e][tt] = bw; acca[e][tt] = ba; accg[e][tt] = 0.f; accv[e][tt] = bv; } }
#define LOWRANK_MFMA(ACC, MI, JOFF, NKS) do { const bf16* wf_ = WSP(bf16, WS_WF) + ((size_t)(l * 448 + ((MI) < 3 ? (MI) * 128 + 16 * (NKS) / 2 * F.wave : 384 + 8 * F.wave)) * 64 + F.lane) * 8; \
            bf16x8 af_[NKS], bf_[8][NKS]; \
            _Pragma("unroll") for (int ks = 0; ks < (NKS); ++ks) af_[ks] = *(const LAS bf16x8*)(inb + (F.lane & 15) * 232 + (JOFF) + 32 * ks + 8 * (F.lane >> 4)); \
            _Pragma("unroll") for (int nt = 0; nt < 8; ++nt) _Pragma("unroll") for (int ks = 0; ks < (NKS); ++ks) bf_[nt][ks] = *(const bf16x8*)(wf_ + (size_t)(nt * (NKS) + ks) * 512); \
            _Pragma("unroll") for (int nt = 0; nt < 8; ++nt) { f32x4 c4 = {0.f, 0.f, 0.f, 0.f}; \
                _Pragma("unroll") for (int ks = 0; ks < (NKS); ++ks) c4 = __builtin_amdgcn_mfma_f32_16x16x32_bf16(af_[ks], bf_[nt][ks], c4, 0, 0, 0); \
                _Pragma("unroll") for (int rr = 0; rr < 4; ++rr) zl[(4 * (F.lane >> 4) + rr) * 1028 + 128 * F.wave + 16 * nt + (F.lane & 15)] = c4[rr]; } \
            __builtin_amdgcn_wave_barrier(); asm volatile("s_waitcnt lgkmcnt(0)" ::: "memory"); __builtin_amdgcn_wave_barrier();   \
            _Pragma("unroll") for (int tt = 0; tt < 16; ++tt) { const f32x2_t z2 = *(const LAS f32x2_t*)(zl + tt * 1028 + c); ACC[0][tt] += z2.x; ACC[1][tt] += z2.y; } \
            __builtin_amdgcn_wave_barrier(); asm volatile("s_waitcnt lgkmcnt(0)" ::: "memory"); __builtin_amdgcn_wave_barrier(); } while (0)
            if (!(HACK & 1)) { LOWRANK_MFMA(accw, 0, 0, 2); relaunder(F);
            LOWRANK_MFMA(acca, 1, 64, 2); relaunder(F);
            LOWRANK_MFMA(accg, 2, 128, 2); relaunder(F);
            if (l) LOWRANK_MFMA(accv, 3, 192, 1); }
#undef LOWRANK_MFMA
            relaunder(F);
            float mur[2], muk[2], muv[2], kkv[2], kav[2], pr[2] = {0.f, 0.f}, pk[2] = {0.f, 0.f}, pv[2] = {0.f, 0.f}; float cl[2] = {0.f, 0.f};
#pragma unroll
            for (int e = 0; e < 2; ++e) { mur[e] = F.kin[I_RMU][l * 3264 + c + e]; muk[e] = F.kin[I_RMU][l * 3264 + 1024 + c + e]; muv[e] = F.kin[I_RMU][l * 3264 + 2048 + c + e]; kkv[e] = F.kin[I_RKK][l * 1024 + c + e]; kav[e] = F.kin[I_RKA][l * 1024 + c + e]; }
            if ((row0 & (SEQ - 1)) != 0) { const bf16* p = COLS + (size_t)(row0 - 1) * NMAIN + c; const unsigned ur = *(const unsigned*)(p + CC_R), uk = *(const unsigned*)(p + CC_K), uv = *(const unsigned*)(p + CC_V);
                pr[0] = bflo(ur); pr[1] = bfhi(ur); pk[0] = bflo(uk); pk[1] = bfhi(uk); pv[0] = bflo(uv); pv[1] = bfhi(uv); }
            constexpr int PFD = 4;
            unsigned pur[16], puk[16], puv[16]; f32x2_t pvf[16];
#define PF_TOK(T) do { const bf16* p_ = COLS + (size_t)(row0 + (T)) * NMAIN + c; pur[T] = *(const unsigned*)(p_ + CC_R); puk[T] = *(const unsigned*)(p_ + CC_K); puv[T] = *(const unsigned*)(p_ + CC_V); \
                pvf[T] = *(const f32x2_t*)(VF + (size_t)(row0 + (T)) * 1024 + c); } while (0)
#pragma unroll
            for (int tt = 0; tt < PFD; ++tt) PF_TOK(tt);
            asm volatile("" ::: "memory");
            if (!(HACK & 4))
#pragma unroll
            for (int tt = 0; tt < 16; ++tt) { const int row = row0 + tt; const size_t o = (size_t)row * 1024 + c;
                if (tt + PFD < 16) { PF_TOK(tt + PFD < 16 ? tt + PFD : 15); }
                asm volatile("" ::: "memory");
                const unsigned ur = pur[tt], uk = puk[tt], uv = puv[tt];
                const float cr[2] = {bflo(ur), bfhi(ur)}, ck[2] = {bflo(uk), bfhi(uk)}, cv[2] = {bflo(uv), bfhi(uv)};
                f32x2_t vf2 = pvf[tt];
                float r[2], k[2], v[2], dec[2], av[2], kk[2], km[2];
#pragma unroll
                for (int e = 0; e < 2; ++e) { r[e] = cr[e] + (pr[e] - cr[e]) * mur[e]; k[e] = ck[e] + (pk[e] - ck[e]) * muk[e]; v[e] = cv[e] + (pv[e] - cv[e]) * muv[e]; pr[e] = cr[e]; pk[e] = ck[e]; pv[e] = cv[e];
                    if (l == 0) vf2[e] = v[e]; else { const float vg = sigmoid_f(accv[e][tt]); v[e] = v[e] + (vf2[e] - v[e]) * vg; }
                    cl[e] += -0.6065306597126334f * sigmoid_f(accw[e][tt]); dec[e] = cl[e]; av[e] = sigmoid_f(acca[e][tt]); kk[e] = k[e] * kkv[e]; km[e] = k[e] * (1.0f + (av[e] - 1.0f) * kav[e]); }
                const float ss = sum32(kk[0] * kk[0] + kk[1] * kk[1]), rn = rsqrtf(fmaxf(ss, 1e-24f)); kk[0] *= rn; kk[1] *= rn;
                if (l == 0) *(f32x2_t*)(VF + o) = vf2;
                *(f32x2_t*)(RW + RS + o) = (f32x2_t){dec[0], dec[1]};
                *(v2u*)(RWU + o) = (v2u){pk2(r[0], km[0]), pk2(r[1], km[1])}; *(v2u*)(RWU + 2 * RS + o) = (v2u){pk2(v[0], accg[0][tt]), pk2(v[1], accg[1][tt])};
                *(v2u*)(RWU + 3 * RS + o) = (v2u){pk2(-kk[0], kk[0] * av[0]), pk2(-kk[1], kk[1] * av[1])}; }
#undef PF_TOK
        }
        asm volatile("s_waitcnt vmcnt(0)" ::: "memory"); __syncthreads();
        __builtin_amdgcn_fence(__ATOMIC_ACQUIRE, "agent"); asm volatile("s_waitcnt vmcnt(0)" ::: "memory");
        if (!(HACK & 2)) rwkv_chunks_of_tile(F, l, tile);
    }
}
struct Args { const float* in[35]; float* out; unsigned char* ws; };
__device__ __forceinline__ void mk_frame(Frame& F, int wv) {
    extern __shared__ __attribute__((aligned(16))) unsigned char lds[];
    kargp kp = (kargp)__builtin_amdgcn_kernarg_segment_ptr(); asm volatile("" : "+s"(kp));
    F.kin = kp;
    F.lds = (LAS unsigned char*)lds;
    F.MISC = (volatile LAS unsigned*)(F.lds + MISC_OFF);
    { int w_ = wv; asm volatile("" : "+s"(w_)); int t_ = (int)__builtin_amdgcn_mbcnt_hi(~0u, __builtin_amdgcn_mbcnt_lo(~0u, (unsigned)w_ * 64u)); asm volatile("" : "+v"(t_)); F.tid = t_; } F.lane = F.tid & 63; F.wave = __builtin_amdgcn_readfirstlane(F.tid >> 6);
    F.G = gridDim.x; { int bx = blockIdx.x; asm volatile("" : "+s"(bx)); F.bx = bx; F.vcu = (F.G % 8 == 0) ? (bx % 8) * (F.G / 8) + bx / 8 : bx; }
    F.out = (float*)kp[35]; F.ws = (unsigned char*)kp[36]; F.ctl = (gu32*)(F.ws + WS_CTL);
}
__device__ __forceinline__ void grid_bar(int wv) {
    Frame F; mk_frame(F, wv);
    XcdBarrier bar; bar.bar = (unsigned*)(F.ctl + CW_BAR); bar.x = xb_xcc_id(); bar.st = F.MISC + 8;
    xcd_barrier(bar);
}
__global__ void __launch_bounds__(NWAVES * 64, 2) mega_fwd(Args args) {
    const int wv = __builtin_amdgcn_readfirstlane((int)threadIdx.x >> 6);
    { Frame F; mk_frame(F, wv);
      for (int u = F.tid; u < (LDS_BYTES - LDSCTL_OFF) / 4; u += NWAVES * 64) ((LAS unsigned*)(F.lds + LDSCTL_OFF))[u] = 0u;
      __syncthreads();
      (void)xcd_barrier_post((unsigned*)(F.ctl + CW_BAR), F.MISC + 8);
      p0_prologue_a(F);
    }
    grid_bar(wv);
    { Frame F; mk_frame(F, wv); p0_prologue_b(F); }
    grid_bar(wv);
#pragma unroll 1
    for (int l = 0; l < NLAYER; ++l) {
#define LAYER_VARS const float* mod = WSP(float, WS_MOD) + (size_t)l * 2 * 24576; const float* xin = l == 0 ? F.kin[I_X] : F.out; (void)mod; (void)xin
        { Frame F; mk_frame(F, wv); LAYER_VARS; if (l == 0) rms_phase(F, F.kin[I_X], mod + 0, mod + 4096); else rms_phase_bf(F, mod + 0, mod + 4096); }
        grid_bar(wv);
        { Frame F; mk_frame(F, wv);
          pg8::Gemm g{WSP(pg8::bf16_t, WS_XN), WSP(pg8::bf16_t, WS_WIN + l * WIN_L), M, NIN, DM}; pg8::StaticOrder S; S.init(M, NIN, F.G, F.bx);
          pg8::EpiCols E{WSP(pg8::bf16_t, WS_COLS), WSP(float, WS_LOWR)};
          pg8::gemm_phase<pg8::EpiCols, pg8::StaticOrder, true, true>(F.lds + RING_OFF, g, S, E, F.tid); }
        grid_bar(wv);
        { Frame F; mk_frame(F, wv); prep_norm(F, l); }
        { Frame F; mk_frame(F, wv); prep_loga(F, l); }
        { Frame F; mk_frame(F, wv); prep_rwkv(F, l); }
        { Frame F; mk_frame(F, wv); prep_vt<0>(F); }
        { Frame F; mk_frame(F, wv); prep_vt<1>(F); }
        { Frame F; mk_frame(F, wv); prep_vt<2>(F); }
        { Frame F; mk_frame(F, wv); prep_vt<3>(F); }
        { Frame F; mk_frame(F, wv); prep_vt<4>(F); }
        { Frame F; mk_frame(F, wv); prep_gla(F); }
        grid_bar(wv);
        { Frame F; mk_frame(F, wv); mixers_v4(F, l, l); }
        grid_bar(wv);
        { Frame F; mk_frame(F, wv); gla_post(F, l); }
        grid_bar(wv);
        { Frame F; mk_frame(F, wv); LAYER_VARS;
          pg8::Gemm g{WSP(pg8::bf16_t, WS_MIXED), WSP(pg8::bf16_t, WS_WOUT + l * WOUT_L), M, DM, DM}; pg8::StaticOrder S; S.init(M, DM, F.G, F.bx);
          pg8::EpiRes E{l == 0 ? (const void*)F.kin[I_X] : (const void*)WSP(bf16, WS_XR), (void*)WSP(bf16, WS_XR), mod + 2 * 4096, l != 0, true};
          pg8::gemm_phase<pg8::EpiRes, pg8::StaticOrder, true, true>(F.lds + RING_OFF, g, S, E, F.tid); }
        grid_bar(wv);
        { Frame F; mk_frame(F, wv); LAYER_VARS; rms_phase_bf(F, mod + 3 * 4096, mod + 4 * 4096); }
        grid_bar(wv);
        { Frame F; mk_frame(F, wv);
          pg8::Gemm g{WSP(pg8::bf16_t, WS_XN), WSP(pg8::bf16_t, WS_W13 + l * W13_L), M, 2 * DFF, DM}; pg8::StaticOrder S; S.init(M, 2 * DFF, F.G, F.bx);
          pg8::EpiSwiglu E{WSP(pg8::bf16_t, WS_HID)};
          pg8::gemm_phase<pg8::EpiSwiglu, pg8::StaticOrder, true, true>(F.lds + RING_OFF, g, S, E, F.tid); }
        grid_bar(wv);
        { Frame F; mk_frame(F, wv); LAYER_VARS;
          pg8::Gemm g{WSP(pg8::bf16_t, WS_HID), WSP(pg8::bf16_t, WS_W2 + l * W2_L), M, DM, DFF}; pg8::StaticOrder S; S.init(M, DM, F.G, F.bx);
          pg8::EpiRes E{(const void*)WSP(bf16, WS_XR), l + 1 < NLAYER ? (void*)WSP(bf16, WS_XR) : (void*)F.out, mod + 5 * 4096, true, l + 1 < NLAYER};
          pg8::gemm_phase<pg8::EpiRes, pg8::StaticOrder, true, true>(F.lds + RING_OFF, g, S, E, F.tid); }
        if (l + 1 < NLAYER) grid_bar(wv);
#undef LAYER_VARS
    }
}

extern "C" void kernel_launch(void* const* d_in, const int* in_sizes, int n_in, void* d_out, int out_size, void* d_ws, size_t ws_size, hipStream_t stream) {
    static int grid = 0;
    if (grid == 0) {
        if (n_in != 35 || in_sizes[0] != M * DM || out_size != M * DM || ws_size < WS_END) { fprintf(stderr, "kernel_launch: unexpected shapes: n_in %d in0 %d out %d ws %zu (need %zu)\n", n_in, n_in > 0 ? in_sizes[0] : -1, out_size, ws_size, (size_t)WS_END); grid = -1; return; }
        int dev = 0, cus = 0, per_cu = 0;
        if (hipGetDevice(&dev) != hipSuccess || hipDeviceGetAttribute(&cus, hipDeviceAttributeMultiprocessorCount, dev) != hipSuccess) { grid = -1; return; }
        if (hipFuncSetAttribute((const void*)mega_fwd, hipFuncAttributeMaxDynamicSharedMemorySize, LDS_BYTES) != hipSuccess) { fprintf(stderr, "kernel_launch: hipFuncSetAttribute failed\n"); grid = -1; return; }
        if (hipOccupancyMaxActiveBlocksPerMultiprocessor(&per_cu, (const void*)mega_fwd, NWAVES * 64, LDS_BYTES) != hipSuccess || per_cu < 1) fprintf(stderr, "kernel_launch: occupancy query says %d\n", per_cu);
        (void)hipGetLastError();
        grid = cus;
    }
    if (grid < 0) return;
    if (hipMemsetAsync((char*)d_ws + WS_CTL, 0, CTL_ZERO_BYTES, stream) != hipSuccess) return;
    Args a{};
    for (int i = 0; i < 35; ++i) a.in[i] = (const float*)d_in[i];
    a.out = (float*)d_out; a.ws = (unsigned char*)d_ws;
    hipLaunchKernelGGL(mega_fwd, dim3(grid), dim3(NWAVES * 64), LDS_BYTES, stream, a);
}
```

```cpp
#include <hip/hip_runtime.h>
#include <cstdio>
#include <cstdint>
namespace pg8 {
#define PG8_LAS __attribute__((address_space(3)))
typedef unsigned short bf16_t;
typedef short bf16x8 __attribute__((ext_vector_type(8)));
typedef float f32x4 __attribute__((ext_vector_type(4)));
typedef unsigned u32x4 __attribute__((ext_vector_type(4)));
constexpr int BM = 256, BK = 64, HALF = 128, HTB = HALF * BK * 2  , STAGE_BYTES = 8 * HTB, NXCD = 8, WGM = 8;

__host__ __device__ __forceinline__ int lds_byte(int r, int c) { const int st = (r >> 4) * 2 + (c >> 5), rr = r & 15, cc = c & 31, ob = rr * 64 + cc * 2; return st * 1024 + (ob ^ (((ob >> 9) & 1) << 5)); }
__host__ __device__ __forceinline__ void stage_rc(int b, int& R, int& C) { const int st = b / 1024, sb = b % 1024, swz = sb ^ (((sb >> 9) & 1) << 5); R = (st >> 1) * 16 + swz / 64; C = (st & 1) * 32 + (swz % 64) / 2; }
__host__ __device__ __forceinline__ int perm32(int rho) { const int n = rho >> 4, i = rho & 15; return 8 * (i >> 2) + 4 * n + (i & 3); }

struct Unit { int pm, pn; };
struct Gemm { const bf16_t* A; const bf16_t* Bt; int M, N, K; };

struct StaticOrder {
    int nM, nN, nwg, G, c;
    __host__ __device__ void init(int M, int N, int G_, int c_) { nM = M / BM; nN = N / BM; nwg = nM * nN; G = G_; c = c_; }
    __host__ __device__ bool next(int i, Unit& u) const {
        const long L = (long)i * G + c; if (L >= nwg) return false;
        int wgid = (int)L; { const int q = nwg / NXCD, r = nwg % NXCD, xcd = wgid % NXCD, off = wgid / NXCD; wgid = (xcd < r ? xcd * (q + 1) : r * (q + 1) + (xcd - r) * q) + off; }
        const int nig = WGM * nN, gid = wgid / nig, fm = gid * WGM, gsz = (nM - fm) < WGM ? (nM - fm) : WGM;
        u.pm = fm + ((wgid % nig) % gsz); u.pn = (wgid % nig) / gsz; return true;
    }
    __device__ __forceinline__ void a_ready(const Unit&) const {}
    __device__ __forceinline__ void done(const Unit&) const {}
};

typedef float f32x2c_t __attribute__((ext_vector_type(2))); typedef __bf16 bf16x2c_t __attribute__((ext_vector_type(2)));
__device__ __forceinline__ unsigned cvt_pk_bf16(float lo, float hi) { const f32x2c_t v = {lo, hi}; return __builtin_bit_cast(unsigned, __builtin_convertvector(v, bf16x2c_t)); }
typedef float f32x2 __attribute__((ext_vector_type(2)));
__device__ __forceinline__ float silu_f(float x) { return x * __builtin_amdgcn_rcpf(1.0f + __builtin_amdgcn_exp2f(-1.4426950408889634f * x)); }
struct EpiCols {
    static constexpr bool PERM = true, AFTER_DRAIN = false;
    bf16_t* O; float* L;
    __device__ __forceinline__ void operator()(const f32x4 (&acc)[2][2][4][2], const Unit& u, int wr, int wc, int fr, int fq) const {
        const int row0 = u.pm * BM + wr * 64 + fr;
        if (u.pn < 41) {
            const int col0 = u.pn * BM + wc * 32 + 8 * fq;
#pragma unroll
            for (int ai = 0; ai < 2; ++ai)
#pragma unroll
                for (int m = 0; m < 4; ++m) { bf16_t* rowp = O + (size_t)(row0 + ai * HALF + m * 16) * 10496 + col0;
#pragma unroll
                    for (int bj = 0; bj < 2; ++bj) { const f32x4 v0 = acc[ai][bj][m][0], v1 = acc[ai][bj][m][1];
                        u32x4 w; w.x = cvt_pk_bf16(v0[0], v0[1]); w.y = cvt_pk_bf16(v0[2], v0[3]); w.z = cvt_pk_bf16(v1[0], v1[1]); w.w = cvt_pk_bf16(v1[2], v1[3]);
                        *(u32x4*)(rowp + bj * HALF) = w; } }
        } else {
            const int col0 = wc * 32 + 8 * fq;
#pragma unroll
            for (int ai = 0; ai < 2; ++ai)
#pragma unroll
                for (int m = 0; m < 4; ++m) { float* rowp = L + (size_t)(row0 + ai * HALF + m * 16) * 256 + col0;
#pragma unroll
                    for (int bj = 0; bj < 2; ++bj) { *(f32x4*)(rowp + bj * HALF) = acc[ai][bj][m][0]; *(f32x4*)(rowp + bj * HALF + 4) = acc[ai][bj][m][1]; } }
        }
    }
};
struct EpiRes {
    static constexpr bool PERM = true, AFTER_DRAIN = false;
    const void* base; void* out; const float* gate; bool base_bf, out_bf;
    __device__ __forceinline__ void operator()(const f32x4 (&acc)[2][2][4][2], const Unit& u, int wr, int wc, int fr, int fq) const {
        const int row0 = u.pm * BM + wr * 64 + fr, col0 = u.pn * BM + wc * 32 + 8 * fq;
        const float* gp = gate + (size_t)(u.pm >> 5) * 24576 + col0;
        f32x4 gv[2][2];
#pragma unroll
        for (int bj = 0; bj < 2; ++bj)
#pragma unroll
            for (int n = 0; n < 2; ++n) gv[bj][n] = *(const f32x4*)(gp + bj * HALF + n * 4);
#pragma unroll
        for (int ai = 0; ai < 2; ++ai) {
            f32x4 r[4][2][2];
            if (base_bf) {
#pragma unroll
                for (int m = 0; m < 4; ++m)
#pragma unroll
                    for (int bj = 0; bj < 2; ++bj) { const u32x4 w = *(const u32x4*)((const bf16_t*)base + (size_t)(row0 + ai * HALF + m * 16) * 4096 + col0 + bj * HALF);
                        r[m][bj][0] = (f32x4){__builtin_bit_cast(float, w.x << 16), __builtin_bit_cast(float, w.x & 0xffff0000u), __builtin_bit_cast(float, w.y << 16), __builtin_bit_cast(float, w.y & 0xffff0000u)};
                        r[m][bj][1] = (f32x4){__builtin_bit_cast(float, w.z << 16), __builtin_bit_cast(float, w.z & 0xffff0000u), __builtin_bit_cast(float, w.w << 16), __builtin_bit_cast(float, w.w & 0xffff0000u)}; }
            } else {
#pragma unroll
                for (int m = 0; m < 4; ++m)
#pragma unroll
                    for (int bj = 0; bj < 2; ++bj)
#pragma unroll
                        for (int n = 0; n < 2; ++n) r[m][bj][n] = *(const f32x4*)((const float*)base + (size_t)(row0 + ai * HALF + m * 16) * 4096 + col0 + bj * HALF + n * 4);
            }
#pragma unroll
            for (int m = 0; m < 4; ++m)
#pragma unroll
                for (int bj = 0; bj < 2; ++bj)
#pragma unroll
                    for (int n = 0; n < 2; ++n) r[m][bj][n] = r[m][bj][n] + gv[bj][n] * acc[ai][bj][m][n];
            if (out_bf) {
#pragma unroll
                for (int m = 0; m < 4; ++m)
#pragma unroll
                    for (int bj = 0; bj < 2; ++bj) { const f32x4 v0 = r[m][bj][0], v1 = r[m][bj][1];
                        u32x4 w; w.x = cvt_pk_bf16(v0[0], v0[1]); w.y = cvt_pk_bf16(v0[2], v0[3]); w.z = cvt_pk_bf16(v1[0], v1[1]); w.w = cvt_pk_bf16(v1[2], v1[3]);
                        *(u32x4*)((bf16_t*)out + (size_t)(row0 + ai * HALF + m * 16) * 4096 + col0 + bj * HALF) = w; }
            } else {
#pragma unroll
                for (int m = 0; m < 4; ++m)
#pragma unroll
                    for (int bj = 0; bj < 2; ++bj)
#pragma unroll
                        for (int n = 0; n < 2; ++n) *(f32x4*)((float*)out + (size_t)(row0 + ai * HALF + m * 16) * 4096 + col0 + bj * HALF + n * 4) = r[m][bj][n];
            }
            asm volatile("" ::: "memory");
        }
    }
};
struct EpiSwiglu {
    static constexpr bool PERM = true, AFTER_DRAIN = false;
    bf16_t* H;
    __device__ __forceinline__ void operator()(const f32x4 (&acc)[2][2][4][2], const Unit& u, int wr, int wc, int fr, int fq) const {
        const int row0 = u.pm * BM + wr * 64 + fr, col0 = u.pn * HALF + wc * 32 + 8 * fq;
#pragma unroll
        for (int ai = 0; ai < 2; ++ai)
#pragma unroll
            for (int m = 0; m < 4; ++m) { bf16_t* rowp = H + (size_t)(row0 + ai * HALF + m * 16) * 11008 + col0;
                const f32x4 a0 = acc[ai][0][m][0], a1 = acc[ai][0][m][1], b0 = acc[ai][1][m][0], b1 = acc[ai][1][m][1];
                u32x4 w; w.x = cvt_pk_bf16(silu_f(a0[0]) * b0[0], silu_f(a0[1]) * b0[1]); w.y = cvt_pk_bf16(silu_f(a0[2]) * b0[2], silu_f(a0[3]) * b0[3]);
                w.z = cvt_pk_bf16(silu_f(a1[0]) * b1[0], silu_f(a1[1]) * b1[1]); w.w = cvt_pk_bf16(silu_f(a1[2]) * b1[2], silu_f(a1[3]) * b1[3]);
                *(u32x4*)rowp = w; }
    }
};
template <class Epi, class Sched, bool ALIGN_EPI = false, bool SP2 = false>
__device__ __forceinline__ void gemm_phase(PG8_LAS unsigned char* lds, const Gemm g, const Sched& S, const Epi& E, int tid_in) {
    int tid_ = tid_in; asm volatile("" : "+v"(tid_));
    const int tid = tid_, wid = __builtin_amdgcn_readfirstlane(tid >> 6), lane = tid & 63, wr = wid >> 2, wc = wid & 3, fr = lane & 15, fq = lane >> 4;
    const int K = g.K, nt = K / BK;
    unsigned voffA[2], voffB[2];
#pragma unroll
    for (int i = 0; i < 2; ++i) { int R, C; stage_rc(tid * 16 + i * 8192, R, C); const int Rb = Epi::PERM ? ((R & ~31) + perm32(R & 31)) : R;
        voffA[i] = (unsigned)(R * K + C) * 2u; voffB[i] = (unsigned)(Rb * K + C) * 2u; }
    const size_t kstep = (size_t)(BK * 2);
    const size_t hstep = (size_t)HALF * K * 2;
    const size_t tstep = 2 * hstep;
    const unsigned ldsw = (unsigned)wid * 1024u;
    const int aoff = lds_byte(wr * 64 + fr, fq * 8), boff = lds_byte(wc * 32 + fr, fq * 8);
#define PG8_SA(b, h) (((b) * 2 + (h)) * HTB)
#define PG8_SB(b, h) ((4 + (b) * 2 + (h)) * HTB)
#define PG8_STAGE(bufoff, gbase, voff) do { _Pragma("unroll") for (int _i = 0; _i < 2; ++_i) \
        __builtin_amdgcn_global_load_lds((const unsigned*)((const char*)(gbase) + (voff)[_i]), (PG8_LAS unsigned*)(lds + (bufoff) + ldsw + _i * 8192), 16, 0, 0); } while (0)
#define PG8_LDA(dst, b, h) do { _Pragma("unroll") for (int m = 0; m < 4; ++m) _Pragma("unroll") for (int k = 0; k < 2; ++k) dst[m][k] = *(const PG8_LAS bf16x8*)(lds + PG8_SA(b, h) + aoff + m * 2048 + k * 1024); } while (0)
#define PG8_LDB(dst, b, h) do { _Pragma("unroll") for (int n = 0; n < 2; ++n) _Pragma("unroll") for (int k = 0; k < 2; ++k) dst[n][k] = *(const PG8_LAS bf16x8*)(lds + PG8_SB(b, h) + boff + n * 2048 + k * 1024); } while (0)
#define PG8_MMA(ai, bj, At, Bt) do { __builtin_amdgcn_s_setprio(1); _Pragma("unroll") for (int m = 0; m < 4; ++m) _Pragma("unroll") for (int n = 0; n < 2; ++n) _Pragma("unroll") for (int k = 0; k < 2; ++k) \
        acc[ai][bj][m][n] = __builtin_amdgcn_mfma_f32_16x16x32_bf16(Bt[n][k], At[m][k], acc[ai][bj][m][n], 0, 0, 0); __builtin_amdgcn_s_setprio(0); } while (0)
#define PG8_WAIT_V(n) asm volatile("s_waitcnt vmcnt(" #n ")" ::: "memory")
#define PG8_WAIT_L(n) asm volatile("s_waitcnt lgkmcnt(" #n ")" ::: "memory")
#define PG8_BAR __builtin_amdgcn_s_barrier()
#define PG8_SCHED __builtin_amdgcn_sched_barrier(0)
    Unit cur, nxt; int ui = 0;
    if (!S.next(0, cur)) return;
    f32x4 acc[2][2][4][2];
#pragma unroll
    for (int a = 0; a < 2; ++a)
#pragma unroll
        for (int b = 0; b < 2; ++b)
#pragma unroll
            for (int m = 0; m < 4; ++m)
#pragma unroll
                for (int n = 0; n < 2; ++n) acc[a][b][m][n] = (f32x4){0.f, 0.f, 0.f, 0.f};
    bf16x8 At[4][2], B0[2][2], B1[2][2];
    const char* cA = (const char*)g.A + (size_t)cur.pm * tstep; const char* cB = (const char*)g.Bt + (size_t)cur.pn * tstep;
    S.a_ready(cur);
    if constexpr (SP2) {
        PG8_STAGE(PG8_SB(0, 0), cB, voffB); PG8_STAGE(PG8_SB(0, 1), cB + hstep, voffB); PG8_STAGE(PG8_SA(0, 0), cA, voffA); PG8_STAGE(PG8_SA(0, 1), cA + hstep, voffA);
        if (wr == 1) PG8_BAR;
        PG8_WAIT_V(2); PG8_BAR;
        PG8_STAGE(PG8_SB(1, 0), cB + kstep, voffB); PG8_STAGE(PG8_SA(1, 0), cA + kstep, voffA); PG8_STAGE(PG8_SB(1, 1), cB + hstep + kstep, voffB);
        PG8_WAIT_V(6); PG8_BAR;
    } else {
        PG8_STAGE(PG8_SB(0, 0), cB, voffB); PG8_STAGE(PG8_SA(0, 0), cA, voffA); PG8_STAGE(PG8_SB(0, 1), cB + hstep, voffB); PG8_STAGE(PG8_SA(0, 1), cA + hstep, voffA);
        if (wr == 1) PG8_BAR;
        PG8_WAIT_V(4); PG8_BAR;
        PG8_STAGE(PG8_SB(1, 0), cB + kstep, voffB); PG8_STAGE(PG8_SA(1, 0), cA + kstep, voffA); PG8_STAGE(PG8_SB(1, 1), cB + hstep + kstep, voffB);
        PG8_WAIT_V(6); PG8_BAR;
    }
    for (;;) {
        const bool has_next = S.next(ui + 1, nxt);
        const char* nA = has_next ? (const char*)g.A + (size_t)nxt.pm * tstep : cA; const char* nB = has_next ? (const char*)g.Bt + (size_t)nxt.pn * tstep : cB;
        for (int t = 0; t < nt; t += 2) {
            const bool last = (t == nt - 2);
            const char* a1 = cA + (size_t)(t + 1) * kstep;
            const char* a2 = last ? nA : cA + (size_t)(t + 2) * kstep; const char* b2 = last ? nB : cB + (size_t)(t + 2) * kstep;
            const char* a3 = a2 + kstep; const char* b3 = b2 + kstep;
            if (last && has_next) S.a_ready(nxt);
            if constexpr (SP2) {
            PG8_LDB(B0, 0, 0); PG8_LDB(B1, 0, 1); PG8_SCHED; PG8_LDA(At, 0, 0); PG8_STAGE(PG8_SA(1, 1), a1 + hstep, voffA);
            PG8_WAIT_V(8); PG8_WAIT_L(0); PG8_BAR; PG8_MMA(0, 0, At, B0); PG8_MMA(0, 1, At, B1); PG8_BAR; PG8_SCHED;
            PG8_LDA(At, 0, 1); PG8_STAGE(PG8_SB(0, 0), b2, voffB); PG8_STAGE(PG8_SB(0, 1), b2 + hstep, voffB); PG8_STAGE(PG8_SA(0, 0), a2, voffA);
            PG8_WAIT_V(8); PG8_WAIT_L(0); PG8_BAR; PG8_MMA(1, 0, At, B0); PG8_MMA(1, 1, At, B1); PG8_BAR; PG8_SCHED;
            PG8_LDB(B0, 1, 0); PG8_LDB(B1, 1, 1); PG8_SCHED; PG8_LDA(At, 1, 0); PG8_STAGE(PG8_SA(0, 1), a2 + hstep, voffA);
            PG8_WAIT_V(8); PG8_WAIT_L(0); PG8_BAR; PG8_MMA(0, 0, At, B0); PG8_MMA(0, 1, At, B1); PG8_BAR; PG8_SCHED;
            PG8_LDA(At, 1, 1); PG8_STAGE(PG8_SB(1, 0), b3, voffB); PG8_STAGE(PG8_SB(1, 1), b3 + hstep, voffB); PG8_STAGE(PG8_SA(1, 0), a3, voffA);
            PG8_WAIT_V(8); PG8_WAIT_L(0); PG8_BAR; PG8_MMA(1, 0, At, B0); PG8_MMA(1, 1, At, B1); PG8_BAR; PG8_SCHED;
            } else {
            PG8_LDB(B0, 0, 0); PG8_SCHED; PG8_LDA(At, 0, 0); PG8_STAGE(PG8_SA(1, 1), a1 + hstep, voffA);
            PG8_WAIT_L(8); PG8_BAR; PG8_WAIT_L(0); PG8_MMA(0, 0, At, B0); PG8_BAR; PG8_SCHED;
            PG8_LDB(B1, 0, 1); PG8_STAGE(PG8_SB(0, 0), b2, voffB);
            PG8_BAR; PG8_WAIT_L(0); PG8_MMA(0, 1, At, B1); PG8_BAR;
            PG8_LDA(At, 0, 1); PG8_STAGE(PG8_SA(0, 0), a2, voffA);
            PG8_BAR; PG8_WAIT_L(0); PG8_MMA(1, 0, At, B0); PG8_BAR; PG8_SCHED;
            PG8_STAGE(PG8_SB(0, 1), b2 + hstep, voffB);
            PG8_WAIT_V(6); PG8_BAR; PG8_MMA(1, 1, At, B1); PG8_BAR;
            PG8_LDB(B0, 1, 0); PG8_SCHED; PG8_LDA(At, 1, 0); PG8_STAGE(PG8_SA(0, 1), a2 + hstep, voffA);
            PG8_WAIT_L(8); PG8_BAR; PG8_WAIT_L(0); PG8_MMA(0, 0, At, B0); PG8_BAR; PG8_SCHED;
            PG8_LDB(B1, 1, 1); PG8_STAGE(PG8_SB(1, 0), b3, voffB);
            PG8_BAR; PG8_WAIT_L(0); PG8_MMA(0, 1, At, B1); PG8_BAR;
            PG8_LDA(At, 1, 1); PG8_STAGE(PG8_SA(1, 0), a3, voffA);
            PG8_BAR; PG8_WAIT_L(0); PG8_MMA(1, 0, At, B0); PG8_BAR; PG8_SCHED;
            PG8_STAGE(PG8_SB(1, 1), b3 + hstep, voffB);
            PG8_WAIT_V(6); PG8_BAR; PG8_MMA(1, 1, At, B1); PG8_BAR;
            }
        }
        if constexpr (ALIGN_EPI) { if (wr == 0) PG8_BAR; }
        if constexpr (!Epi::AFTER_DRAIN) { unsigned z_ = 0u; asm volatile("" : "+s"(z_)); const int le_ = (int)__builtin_amdgcn_mbcnt_hi(~0u, __builtin_amdgcn_mbcnt_lo(~0u, z_));
          E(acc, cur, wr, wc, le_ & 15, le_ >> 4); S.done(cur); }
        if (!has_next) break;
#pragma unroll
        for (int a = 0; a < 2; ++a)
#pragma unroll
            for (int b = 0; b < 2; ++b)
#pragma unroll
                for (int m = 0; m < 4; ++m)
#pragma unroll
                    for (int n = 0; n < 2; ++n) acc[a][b][m][n] = (f32x4){0.f, 0.f, 0.f, 0.f};
        cur = nxt; cA = nA; cB = nB; ++ui;
        if constexpr (ALIGN_EPI) { if (wr == 1) PG8_BAR; }
    }
    PG8_WAIT_V(0);
    if constexpr (!ALIGN_EPI) { if (wr == 0) PG8_BAR; }
    PG8_BAR;
    if constexpr (Epi::AFTER_DRAIN) { E.fused(acc, cur, wr, wc, fr, fq, lds, wid, lane); S.done(cur); }
#undef PG8_SA
#undef PG8_SB
#undef PG8_STAGE
#undef PG8_LDA
#undef PG8_LDB
#undef PG8_MMA
#undef PG8_WAIT_V
#undef PG8_WAIT_L
#undef PG8_BAR
#undef PG8_SCHED
}
}
constexpr int BATCH = 2, SEQ = 8192, DM = 4096, M = BATCH * SEQ, DFF = 11008, NLAYER = 2;
constexpr int P_IN = 10704, NIN = 10752, NMAIN = 10496;
constexpr int CA_Q = 0, CA_K = 1024, CA_V = 2048;
constexpr int CB_Q = 3072, CB_K = 3584, CB_V = 4096, CB_G = 5120;
constexpr int CC_R = 6144, CC_K = 7168, CC_V = 8192;
constexpr int CD_Q = 9216, CD_K = 10240, CD_V = 10368;
constexpr float LOG2E = 1.4426950408889634f;
constexpr float QSCALE = 0.125f * LOG2E;
constexpr int NWAVES = 8;

constexpr size_t MiB = 1u << 20;
constexpr size_t WS_CTL = 0, CTL_ZERO_BYTES = 1 * MiB;
constexpr size_t WS_MODP = 2 * MiB;
constexpr size_t WS_MOD = 14 * MiB;
constexpr size_t WS_TAB = 15 * MiB;
constexpr size_t WS_WIN = 16 * MiB, WIN_L = 84 * MiB;
constexpr size_t WS_WOUT = 184 * MiB, WOUT_L = 32 * MiB;
constexpr size_t WS_W13 = 248 * MiB, W13_L = 172 * MiB;
constexpr size_t WS_W2 = 592 * MiB, W2_L = 86 * MiB;
constexpr size_t WS_XN = 764 * MiB;
constexpr size_t WS_COLS = 892 * MiB;
constexpr size_t WS_LOWR = 1220 * MiB;
constexpr size_t WS_HID = 892 * MiB;
constexpr size_t WS_QKA = 1236 * MiB;
constexpr size_t WS_QKD = 1300 * MiB;
constexpr size_t WS_LOGA = 1336 * MiB;
constexpr size_t WS_RW = 1368 * MiB, RW_ONE = 64 * MiB;
constexpr size_t WS_VFIRST = 1816 * MiB;
constexpr size_t WS_MIXED = 1880 * MiB;
constexpr int VROW = SEQ + 64;
constexpr size_t WS_VTA = 2008 * MiB;
constexpr size_t WS_VTD = 2041 * MiB;
constexpr size_t WS_QDEC = 2046 * MiB, WS_KDT = 2062 * MiB, WS_AM = 2078 * MiB, WS_EBL = 2086 * MiB;
constexpr size_t WS_VTB = 2087 * MiB;
constexpr size_t WS_RWC = 2120 * MiB;
constexpr size_t WS_OB = 2446 * MiB;
constexpr size_t WS_PSG = 2478 * MiB;
constexpr size_t WS_WF = 2479 * MiB;
constexpr size_t WS_XR = 2480 * MiB;
constexpr size_t WS_END = 2608 * MiB;
constexpr int CW_BAR = 4096;
constexpr int CW_Q = 16384;

constexpr int RING_OFF = 0, RING_BYTES = 131072;
constexpr int LDSCTL_OFF = RING_BYTES, MISC_OFF = LDSCTL_OFF + 320;
constexpr int LDS_BYTES = 147456;

#define GAS __attribute__((address_space(1)))
#define LAS __attribute__((address_space(3)))
typedef unsigned short bf16;
typedef unsigned v4u __attribute__((ext_vector_type(4)));
typedef unsigned v2u __attribute__((ext_vector_type(2)));
typedef float f32x4 __attribute__((ext_vector_type(4)));
typedef short bf16x8 __attribute__((ext_vector_type(8)));
typedef GAS unsigned gu32;
#define RLX_AGENT __ATOMIC_RELAXED, __HIP_MEMORY_SCOPE_AGENT
#define LDS_WAIT() asm volatile("s_waitcnt lgkmcnt(0)" ::: "memory")
#define VM_WAIT() asm volatile("s_waitcnt vmcnt(0)" ::: "memory")
typedef float f32x2_t __attribute__((ext_vector_type(2))); typedef __bf16 bf16x2_t __attribute__((ext_vector_type(2)));
__device__ __forceinline__ unsigned pk2(float lo, float hi) { const f32x2_t v = {lo, hi}; return __builtin_bit_cast(unsigned, __builtin_convertvector(v, bf16x2_t)); }
__device__ __forceinline__ unsigned f2bf(float f) { return pk2(f, f) & 0xffffu; }
__device__ __forceinline__ float bf2f(unsigned short h) { return __builtin_bit_cast(float, (unsigned)h << 16); }
__device__ __forceinline__ float bflo(unsigned w) { return __builtin_bit_cast(float, w << 16); }
__device__ __forceinline__ float bfhi(unsigned w) { return __builtin_bit_cast(float, w & 0xffff0000u); }
template <int CTRL> __device__ __forceinline__ float dpp_f(float v) { return __builtin_bit_cast(float, __builtin_amdgcn_update_dpp(0, __builtin_bit_cast(int, v), CTRL, 0xF, 0xF, true)); }
__device__ __forceinline__ float sum8(float v) {
    v += dpp_f<0xB1>(v); v += dpp_f<0x4E>(v); v += dpp_f<0x141>(v); return v; }
__device__ __forceinline__ float sum32(float v) {
    v = sum8(v); v += dpp_f<0x140>(v); v += __builtin_bit_cast(float, __builtin_amdgcn_ds_swizzle(__builtin_bit_cast(int, v), 0x401F)); return v; }
__device__ __forceinline__ float wave_sum(float v) {
    v = sum8(v); v += dpp_f<0x140>(v);
    v += __builtin_bit_cast(float, __builtin_amdgcn_ds_swizzle(__builtin_bit_cast(int, v), 0x401F));
    { const int u = __builtin_bit_cast(int, v); v = __builtin_bit_cast(float, __builtin_amdgcn_readlane(u, 0)) + __builtin_bit_cast(float, __builtin_amdgcn_readlane(u, 32)); }
    return v;
}
__device__ __forceinline__ float sigmoid_f(float x) { return __builtin_amdgcn_rcpf(1.0f + __builtin_amdgcn_exp2f(-LOG2E * x)); }
__device__ __forceinline__ float silu_g(float x) { return x * sigmoid_f(x); }
__device__ __forceinline__ void unpack8(const v4u r, float (&f)[8]) { f[0] = bflo(r.x); f[1] = bfhi(r.x); f[2] = bflo(r.y); f[3] = bfhi(r.y); f[4] = bflo(r.z); f[5] = bfhi(r.z); f[6] = bflo(r.w); f[7] = bfhi(r.w); }
__device__ __forceinline__ v4u pack8(const float (&f)[8]) { v4u o; o.x = pk2(f[0], f[1]); o.y = pk2(f[2], f[3]); o.z = pk2(f[4], f[5]); o.w = pk2(f[6], f[7]); return o; }

#define XB_TMO      128
#define XB_XCNT(j)  (256  + 64 * (j))
#define XB_XSUB(j)  (1280 + 64 * (j))
#define XB_XGEN(j)  (2304 + 64 * (j))
#define XB_TOP      3328
#define XB_TOPGEN   3392
#define XCD_BAR_WORDS 3456
#define XB_SPIN_CAP (1u << 23)

__device__ __forceinline__ unsigned xb_ld(unsigned* p)              { return __hip_atomic_load(p, __ATOMIC_RELAXED, __HIP_MEMORY_SCOPE_AGENT); }
__device__ __forceinline__ unsigned xb_add(unsigned* p, unsigned v) { return __hip_atomic_fetch_add(p, v, __ATOMIC_RELAXED, __HIP_MEMORY_SCOPE_AGENT); }
__device__ __forceinline__ unsigned xb_xcc_id() { return (unsigned)__builtin_amdgcn_s_getreg((3 << 11) | 20) & 0xFu; }
#define XB_SPIN(cond, bar) do { unsigned _sp = 0; while (cond) { __builtin_amdgcn_s_sleep(1); \
    if ((++_sp & 255u) == 0u) { if (xb_ld(&(bar)[XB_TMO])) break; if (_sp > XB_SPIN_CAP) { atomicAdd(&(bar)[XB_TMO], 1u); break; } } } } while (0)

struct XcdBarrier {
    unsigned* bar; unsigned x;
    volatile LAS unsigned* st;
};

__device__ __forceinline__ XcdBarrier xcd_barrier_post(unsigned* bar, volatile LAS unsigned* st) {
    XcdBarrier b; b.bar = bar; b.x = xb_xcc_id(); b.st = st;
    if (threadIdx.x == 0) (void)xb_add(&bar[XB_XCNT(b.x)], 1u);
    return b;
}
__device__ __forceinline__ void xcd_barrier_complete(unsigned* bar, unsigned x, unsigned& nloc, unsigned& nx) {
    const unsigned G = gridDim.x * gridDim.y * gridDim.z;
    unsigned sum, cnt, mine, sp = 0u;
    for (;;) {
        sum = 0u; cnt = 0u; mine = 0u;
#pragma unroll
        for (unsigned j = 0; j < 16; ++j) { const unsigned c = xb_ld(&bar[XB_XCNT(j)]); sum += c; cnt += (c > 0u) ? 1u : 0u; mine = (j == x) ? c : mine; }
        if (sum == G) break;
        __builtin_amdgcn_s_sleep(1);
        if ((++sp & 255u) == 0u) { if (xb_ld(&bar[XB_TMO])) break; if (sp > XB_SPIN_CAP) { atomicAdd(&bar[XB_TMO], 1u); break; } }
    }
    nloc = mine > 0u ? mine : 1u; nx = cnt > 0u ? cnt : 1u;
}

__device__ __forceinline__ void xcd_barrier(const XcdBarrier& b) {
    asm volatile("s_waitcnt vmcnt(0)" ::: "memory");
    __syncthreads();
    if (threadIdx.x == 0) {
        unsigned* bar = b.bar;
        __builtin_amdgcn_s_waitcnt(0);
        unsigned nloc = b.st[0], nx = b.st[1];
        if (nloc == 0u) { xcd_barrier_complete(bar, b.x, nloc, nx); b.st[0] = nloc; b.st[1] = nx; }
        const unsigned old = xb_add(&bar[XB_XSUB(b.x)], 1u);
        const unsigned gen = old / nloc;
        if (old + 1u == (gen + 1u) * nloc) {
            __builtin_amdgcn_fence(__ATOMIC_RELEASE, "agent");
            asm volatile("s_waitcnt vmcnt(0)" ::: "memory");
            const unsigned og = xb_add(&bar[XB_TOP], 1u);
            const unsigned tg = og / nx;
            if (og + 1u == (tg + 1u) * nx) xb_add(&bar[XB_TOPGEN], 1u);
            else XB_SPIN(xb_ld(&bar[XB_TOPGEN]) == tg, bar);
            __builtin_amdgcn_fence(__ATOMIC_ACQUIRE, "agent");
            xb_add(&bar[XB_XGEN(b.x)], 1u);
            asm volatile("s_waitcnt vmcnt(0)" ::: "memory");
        } else {
            XB_SPIN(xb_ld(&bar[XB_XGEN(b.x)]) == gen, bar);
            __builtin_amdgcn_fence(__ATOMIC_ACQUIRE, "agent");
            asm volatile("s_waitcnt vmcnt(0)" ::: "memory");
        }
    }
    __syncthreads();
}

typedef const float* const __attribute__((address_space(4)))* kargp;
struct Frame {
    LAS unsigned char* lds;
    volatile LAS unsigned* MISC;
    gu32* ctl;
    int tid, lane, wave;
    int vcu, G, bx;
    kargp kin;
    float* out;
    unsigned char* ws;
};
enum { I_X = 0, I_C, I_RELB, I_ADAW, I_ADAB, I_WIN, I_WOUT, I_DQN, I_DKN, I_DLAM, I_DSUB, I_GGU, I_GGB, I_GON, I_RMU, I_RWUP, I_RW0, I_RAUP, I_RA0, I_RGUP,
       I_RKK, I_RKA, I_RRK, I_RLNW, I_RLNB, I_VRD, I_VRMU, I_VRUP, I_VR0, I_SQN, I_SKN, I_SSINK, I_W1, I_W3, I_W2 };

#define WSP(T, off) ((T*)(F.ws + (off)))
__device__ __forceinline__ void relaunder_tid(Frame& F) { int t = F.tid; asm volatile("" : "+v"(t)); F.tid = t; F.lane = t & 63; F.wave = __builtin_amdgcn_readfirstlane(t >> 6); }
__device__ __forceinline__ void relaunder(Frame& F) { kargp p = F.kin; asm volatile("" : "+s"(p)); F.kin = p; }

__device__ __forceinline__ void conv_item(const float* src, int ld, int col0, int ncols, int K, bf16* WT, int row0, int kb, LAS float* scr, int lane) {
    const int k0 = 64 * kb;
    { const int n = lane & 31; const bool ok = src != nullptr && n < ncols; const float* sp = src + (size_t)(k0 + (lane >> 5)) * ld + col0 + n; float v[32];
#pragma unroll
      for (int i = 0; i < 32; ++i) v[i] = ok ? sp[(size_t)(2 * i) * ld] : 0.f;
#pragma unroll
      for (int i = 0; i < 32; ++i) scr[(2 * i + (lane >> 5)) * 33 + n] = v[i]; }
    LDS_WAIT(); asm volatile("" ::: "memory");
    const int c = lane & 7;
#pragma unroll
    for (int j = 0; j < 4; ++j) { const int n = (lane >> 3) + 8 * j; const LAS float* s = scr + (8 * c) * 33 + n;
        v4u o; o.x = pk2(s[0 * 33], s[1 * 33]); o.y = pk2(s[2 * 33], s[3 * 33]); o.z = pk2(s[4 * 33], s[5 * 33]); o.w = pk2(s[6 * 33], s[7 * 33]);
        if (n < ncols) *(GAS v4u*)(WT + (size_t)(row0 + n) * K + k0 + 8 * c) = o; }
    LDS_WAIT(); asm volatile("" ::: "memory");
}
__device__ __forceinline__ int t5_bucket(int d) {
    if (d < 16) return d;
    int v = 16 + (int)(logf((float)d * (1.0f / 16.0f)) / logf(8.0f) * 16.0f);
    return v < 31 ? v : 31;
}
__device__ __forceinline__ void p0_prologue_a(Frame& F) {
    const int gw = F.vcu * NWAVES + F.wave, NGW = F.G * NWAVES;
    LAS float* ldsf = (LAS float*)(F.lds + RING_OFF);
    { float cv[16];
#pragma unroll
      for (int q = 0; q < 16; ++q) cv[q] = F.kin[I_C][F.tid + NWAVES * 64 * q];
#pragma unroll
      for (int q = 0; q < 16; ++q) ldsf[F.tid + NWAVES * 64 * q] = silu_g(cv[q]); }
    __syncthreads();
    float* MODP = WSP(float, WS_MODP);
    for (int it = gw; it < 6144; it += NGW) {
        const int l = it / 3072, rem = it % 3072, kc = rem / 96, ng = rem % 96, n0 = 256 * ng + 4 * F.lane;
        const float* w = F.kin[I_ADAW] + ((size_t)l * DM + kc * 128) * 24576 + n0;
        f32x4 a0 = {0.f, 0.f, 0.f, 0.f}, a1 = {0.f, 0.f, 0.f, 0.f};
#pragma unroll 16
        for (int k = 0; k < 128; ++k) { const f32x4 wv = *(const f32x4*)(w + (size_t)k * 24576); const float s0 = ldsf[kc * 128 + k], s1 = ldsf[DM + kc * 128 + k]; a0 += wv * s0; a1 += wv * s1; }
        *(f32x4*)(MODP + ((size_t)(l * 32 + kc) * 2 + 0) * 24576 + n0) = a0;
        *(f32x4*)(MODP + ((size_t)(l * 32 + kc) * 2 + 1) * 24576 + n0) = a1;
    }
    for (int idx = F.bx * (NWAVES * 64) + F.tid; idx < NLAYER * 448 * 64; idx += F.G * NWAVES * 64) {
        const int l = idx / (448 * 64), rem = idx % (448 * 64), blk = rem >> 6, ln = rem & 63, n = ln & 15, g = ln >> 4;
        const int m = blk < 384 ? blk >> 7 : 3, nt = blk < 384 ? (blk & 127) >> 1 : blk - 384, ks = blk < 384 ? (blk & 1) : 0;
        const float* W = m == 0 ? F.kin[I_RWUP] + (size_t)l * 65536 : (m == 1 ? F.kin[I_RAUP] + (size_t)l * 65536 : (m == 2 ? F.kin[I_RGUP] + (size_t)l * 65536 : (l ? F.kin[I_VRUP] + (size_t)(l - 1) * 32768 : nullptr)));
        float f[8];
#pragma unroll
        for (int e = 0; e < 8; ++e) f[e] = W != nullptr ? W[(size_t)(32 * ks + 8 * g + e) * 1024 + 16 * nt + n] : 0.f;
        *(v4u*)(WSP(bf16, WS_WF) + ((size_t)(l * 448 + blk) * 64 + ln) * 8) = pack8(f);
    }
    __syncthreads();
    LAS float* scr = (LAS float*)(F.lds + RING_OFF + F.wave * 16384);
    constexpr int I_IN = 337 * 64, I_OUT = 128 * 64, I_13 = 688 * 64, I_2 = 128 * 172, I_L = I_IN + I_OUT + I_13 + I_2;
    for (int it = gw; it < NLAYER * I_L; it += NGW) {
        const int l = it / I_L; int r = it % I_L;
        if (r < I_IN) {
            const int kb = r / 337, cb = r % 337; const float* src = F.kin[I_WIN] + (size_t)l * DM * P_IN; int ld = P_IN, col0, row0, nc = 32;
            if (cb < 192) { col0 = 32 * cb; row0 = 32 * cb; }
            else if (cb < 288) { col0 = 6160 + 32 * (cb - 192); row0 = 6144 + 32 * (cb - 192); }
            else if (cb < 328) { col0 = 9424 + 32 * (cb - 288); row0 = 9216 + 32 * (cb - 288); }
            else if (cb == 328) { col0 = 6144; row0 = 10496; nc = 16; }
            else if (cb < 335) { col0 = 9232 + 32 * (cb - 329); row0 = 10512 + 32 * (cb - 329); }
            else if (cb == 335) { src = l ? F.kin[I_VRD] + (size_t)(l - 1) * DM * 32 : nullptr; ld = 32; col0 = 0; row0 = 10704; }
            else { src = nullptr; col0 = 0; row0 = 10736; nc = 16; }
            conv_item(src, ld, col0, nc, DM, WSP(bf16, WS_WIN + l * WIN_L), row0, kb, scr, F.lane); continue; }
        r -= I_IN;
        if (r < I_OUT) { const int kb = r / 128, cb = r % 128; conv_item(F.kin[I_WOUT] + (size_t)l * DM * DM, DM, 32 * cb, 32, DM, WSP(bf16, WS_WOUT + l * WOUT_L), 32 * cb, kb, scr, F.lane); continue; }
        r -= I_OUT;
        if (r < I_13) { const int kb = r / 688, cb = r % 688, pn = cb >> 3, wi = cb & 7;
            const float* src = (wi < 4 ? F.kin[I_W1] : F.kin[I_W3]) + (size_t)l * DM * DFF;
            conv_item(src, DFF, 128 * pn + 32 * (wi & 3), 32, DM, WSP(bf16, WS_W13 + l * W13_L), 32 * cb, kb, scr, F.lane); continue; }
        r -= I_13;
        { const int kb = r / 128, cb = r % 128; conv_item(F.kin[I_W2] + (size_t)l * DFF * DM, DM, 32 * cb, 32, DFF, WSP(bf16, WS_W2 + l * W2_L), 32 * cb, kb, scr, F.lane); }
    }
}
__device__ __forceinline__ void p0_prologue_b(Frame& F) {
    const int gt = F.bx * (NWAVES * 64) + F.tid, NT = F.G * NWAVES * 64;
    const float* MODP = WSP(float, WS_MODP); float* MOD = WSP(float, WS_MOD);
    for (int idx = gt; idx < NLAYER * 2 * 24576; idx += NT) {
        const int l = idx / 49152, rem = idx % 49152, b = rem / 24576, n = rem % 24576;
        float s = F.kin[I_ADAB][l * 24576 + n];
#pragma unroll 8
        for (int kc = 0; kc < 32; ++kc) s += MODP[((size_t)(l * 32 + kc) * 2 + b) * 24576 + n];
        MOD[idx] = s;
    }
    if (F.bx == 0) { float* TAB = WSP(float, WS_TAB);
        float tv[6];
#pragma unroll
        for (int q = 0; q < 6; ++q) { const int i = F.tid + NWAVES * 64 * q, hh = i >> 7, d = i & 127; tv[q] = F.kin[I_RELB][t5_bucket(d) * 24 + hh]; }
#pragma unroll
        for (int q = 0; q < 6; ++q) TAB[F.tid + NWAVES * 64 * q] = tv[q] * LOG2E; }
}
__device__ __forceinline__ void rms_phase(Frame& F, const float* xin, const float* sh, const float* sc) {
    const int gw = F.vcu * NWAVES + F.wave, NGW = F.G * NWAVES;
    bf16* XN = WSP(bf16, WS_XN);
#pragma unroll 1
    for (int b = 0; b < BATCH; ++b) {
        relaunder(F); relaunder_tid(F);
        f32x4 s4[16], h4[16];
        { const f32x4* scp = (const f32x4*)(sc + (size_t)b * 24576) + F.lane; const f32x4* shp = (const f32x4*)(sh + (size_t)b * 24576) + F.lane;
#pragma unroll
          for (int j = 0; j < 16; ++j) { s4[j] = scp[64 * j] + 1.0f; h4[j] = shp[64 * j]; } }
#pragma unroll 1
        for (int m = b * SEQ + gw; m < (b + 1) * SEQ; m += NGW) {
            relaunder_tid(F);
            const f32x4* xr = (const f32x4*)(xin + (size_t)m * DM) + F.lane;
            f32x4 v[16]; float ss = 0.f;
#pragma unroll
            for (int j = 0; j < 16; ++j) v[j] = xr[64 * j];
#pragma unroll
            for (int j = 0; j < 16; ++j) ss += (v[j].x * v[j].x + v[j].y * v[j].y) + (v[j].z * v[j].z + v[j].w * v[j].w);
            const float rstd = rsqrtf(wave_sum(ss) * (1.0f / DM) + 1e-6f);
            v2u* o8 = (v2u*)(XN + (size_t)m * DM) + F.lane;
#pragma unroll
            for (int j = 0; j < 16; ++j) { const f32x4 o = v[j] * rstd * s4[j] + h4[j]; v2u w; w.x = pk2(o.x, o.y); w.y = pk2(o.z, o.w); o8[64 * j] = w; }
        }
    }
}
__device__ __forceinline__ void rms_phase_bf(Frame& F, const float* sh, const float* sc) {
    const int gw = F.vcu * NWAVES + F.wave, NGW = F.G * NWAVES;
    bf16* XN = WSP(bf16, WS_XN); const bf16* XR = WSP(bf16, WS_XR);
#pragma unroll 1
    for (int b = 0; b < BATCH; ++b) {
        relaunder(F); relaunder_tid(F);
        f32x4 s0[8], s1[8], h0[8], h1[8];
        { const float* scp = sc + (size_t)b * 24576 + 8 * F.lane; const float* shp = sh + (size_t)b * 24576 + 8 * F.lane;
#pragma unroll
          for (int j = 0; j < 8; ++j) { s0[j] = *(const f32x4*)(scp + 512 * j) + 1.0f; s1[j] = *(const f32x4*)(scp + 512 * j + 4) + 1.0f; h0[j] = *(const f32x4*)(shp + 512 * j); h1[j] = *(const f32x4*)(shp + 512 * j + 4); } }
        const int mend = (b + 1) * SEQ; int m = b * SEQ + gw;
        v4u raw[8];
        if (m < mend) {
#pragma unroll
            for (int j = 0; j < 8; ++j) raw[j] = ((const v4u*)(XR + (size_t)m * DM) + F.lane)[64 * j];
        }
#pragma unroll 1
        for (; m < mend; m += NGW) {
            relaunder_tid(F);
            v4u nxt[8]; { const int mn = m + NGW < mend ? m + NGW : m;
#pragma unroll
              for (int j = 0; j < 8; ++j) nxt[j] = ((const v4u*)(XR + (size_t)mn * DM) + F.lane)[64 * j]; }
            float ss = 0.f;
#pragma unroll
            for (int j = 0; j < 8; ++j) { float f[8]; unpack8(raw[j], f);
#pragma unroll
                for (int e = 0; e < 8; ++e) ss += f[e] * f[e]; }
            const float rstd = rsqrtf(wave_sum(ss) * (1.0f / DM) + 1e-6f);
            v4u* o16 = (v4u*)(XN + (size_t)m * DM) + F.lane;
#pragma unroll
            for (int j = 0; j < 8; ++j) { float f[8]; unpack8(raw[j], f); float o[8];
#pragma unroll
                for (int e = 0; e < 4; ++e) { o[e] = f[e] * rstd * s0[j][e] + h0[j][e]; o[4 + e] = f[4 + e] * rstd * s1[j][e] + h1[j][e]; }
                o16[64 * j] = pack8(o); }
#pragma unroll
            for (int j = 0; j < 8; ++j) raw[j] = nxt[j];
        }
    }
}
__device__ __forceinline__ void prep_norm(Frame& F, int l) {
    const int gw = F.vcu * NWAVES + F.wave, NGW = F.G * NWAVES, lane = F.lane, sub = lane >> 3, ch = lane & 7;
    float gqa[8], gka[8], gqd[8], gkd[8];
#pragma unroll
    for (int e = 0; e < 8; ++e) { gqa[e] = F.kin[I_DQN][l * 64 + ch * 8 + e] * QSCALE; gka[e] = F.kin[I_DKN][l * 64 + ch * 8 + e];
                                  gqd[e] = F.kin[I_SQN][l * 64 + ch * 8 + e] * QSCALE; gkd[e] = F.kin[I_SKN][l * 64 + ch * 8 + e]; }
    const bf16* COLS = WSP(bf16, WS_COLS); bf16* QKA = WSP(bf16, WS_QKA); bf16* QKD = WSP(bf16, WS_QKD);
    for (int m0 = gw; m0 < M; m0 += 2 * NGW) {
        v4u ra[2][4], rd[2][3];
#pragma unroll
        for (int r = 0; r < 2; ++r) { const int m = m0 + r * NGW < M ? m0 + r * NGW : m0; const bf16* src = COLS + (size_t)m * NMAIN;
#pragma unroll
            for (int i = 0; i < 4; ++i) ra[r][i] = *(const v4u*)(src + CA_Q + (i * 8 + sub) * 64 + ch * 8);
#pragma unroll
            for (int i = 0; i < 3; ++i) { const int vec = i * 8 + sub; rd[r][i] = *(const v4u*)(src + CD_Q + (vec < 18 ? vec : 17) * 64 + ch * 8); } }
#pragma unroll
        for (int r = 0; r < 2; ++r) { const int m = m0 + r * NGW; if (m < M) {
#pragma unroll
            for (int i = 0; i < 4; ++i) { const int vec = i * 8 + sub, col = vec * 64 + ch * 8;
                float f[8]; unpack8(ra[r][i], f); float ss = 0.f;
#pragma unroll
                for (int e = 0; e < 8; ++e) ss += f[e] * f[e];
                ss = sum8(ss);
                const float rstd = rsqrtf(ss * (1.0f / 64.0f) + 1e-6f);
#pragma unroll
                for (int e = 0; e < 8; ++e) f[e] = f[e] * rstd * (i < 2 ? gqa[e] : gka[e]);
                *(v4u*)(QKA + (size_t)m * 2048 + col) = pack8(f); }
#pragma unroll
            for (int i = 0; i < 3; ++i) { const int vec = i * 8 + sub, col = vec * 64 + ch * 8;
                float f[8]; unpack8(rd[r][i], f); float ss = 0.f;
#pragma unroll
                for (int e = 0; e < 8; ++e) ss += f[e] * f[e];
                ss = sum8(ss);
                const float rstd = rsqrtf(ss * (1.0f / 64.0f) + 1e-6f);
#pragma unroll
                for (int e = 0; e < 8; ++e) f[e] = f[e] * rstd * (vec < 16 ? gqd[e] : gkd[e]);
                if (vec < 18) *(v4u*)(QKD + (size_t)m * 1152 + col) = pack8(f); } } }
    }
}
__device__ __forceinline__ void prep_loga(Frame& F, int l) {
    LAS float* gdl = (LAS float*)(F.lds + RING_OFF);
    float gu[16];
#pragma unroll
    for (int j = 0; j < 16; ++j) gu[j] = F.kin[I_GGU][((size_t)l * 16 + j) * 512 + F.tid];
    const float bias = F.kin[I_GGB][l * 512 + F.tid];
    const float* LOWR = WSP(float, WS_LOWR); float* LOGA = WSP(float, WS_LOGA);
    for (int tile = F.bx; tile < M / 64; tile += F.G) {
        const size_t row0 = (size_t)tile * 64;
        __syncthreads();
#pragma unroll
        for (int i = 0; i < 2; ++i) { const int idx = F.tid + 512 * i; gdl[idx] = LOWR[(row0 + (idx >> 4)) * 256 + (idx & 15)]; }
        __syncthreads();
#pragma unroll 4
        for (int t = 0; t < 64; ++t) { const LAS f32x4* gp = (const LAS f32x4*)(gdl + t * 16); const f32x4 g0 = gp[0], g1 = gp[1], g2 = gp[2], g3 = gp[3];
            float z = bias + g0.x * gu[0] + g0.y * gu[1] + g0.z * gu[2] + g0.w * gu[3] + g1.x * gu[4] + g1.y * gu[5] + g1.z * gu[6] + g1.w * gu[7]
                    + g2.x * gu[8] + g2.y * gu[9] + g2.z * gu[10] + g2.w * gu[11] + g3.x * gu[12] + g3.y * gu[13] + g3.z * gu[14] + g3.w * gu[15];
            LOGA[(row0 + t) * 512 + F.tid] = (fminf(z, 0.f) - __logf(1.0f + __expf(-fabsf(z)))) * (1.0f / 16.0f); }
    }
}
__device__ __forceinline__ int next_item(Frame& F, gu32* ctr) {
    volatile LAS int* slot = (volatile LAS int*)(F.lds + LDSCTL_OFF + 64);
    __syncthreads();
    if (F.tid == 0) *slot = (int)__hip_atomic_fetch_add(ctr, 1u, RLX_AGENT);
    __syncthreads();
    return *slot;
}
typedef float f32x16 __attribute__((ext_vector_type(16)));
__device__ __forceinline__ float xother32(float v) { unsigned a = __builtin_bit_cast(unsigned, v), b = a; asm volatile("" : "+v"(b)); auto rr = __builtin_amdgcn_permlane32_swap(a, b, false, false);
    const unsigned lo = rr[0], hi = rr[1]; return __builtin_bit_cast(float, (unsigned)((__builtin_amdgcn_mbcnt_hi(~0u, __builtin_amdgcn_mbcnt_lo(~0u, 0u)) & 32u) ? lo : hi)); }
__device__ __forceinline__ float xsum32(float v) { return v + xother32(v); }
__device__ __forceinline__ float xmax32(float v) { return fmaxf(v, xother32(v)); }
__device__ __forceinline__ int crow16(int r, int hi) { return (r & 3) + 8 * (r >> 2) + 4 * hi; }
template <bool ISA>
__device__ __forceinline__ void attn_unit(Frame& F, int l, int b, int hx, int qb) {
    constexpr int DV = ISA ? 128 : 64, NDV = DV / 32, KSTR = ISA ? 272 : 144, VSTR = 144, KBYTES = 64 * KSTR, VBYTES = DV * VSTR, BUFB = KBYTES + VBYTES, NCH = ISA ? 2 : 1;
    constexpr float NEG = -1e30f;
    LAS unsigned char* L = F.lds + RING_OFF;
    const int tid = F.tid, lane = F.lane, r32 = lane & 31, hi = lane >> 5, qs = F.wave & 3, grp = F.wave >> 2, q0 = qb * 128;
    const int kvh = hx >> 2, hd = kvh * 8 + (hx & 3) * 2 + grp;
    const bf16* Qp; const bf16* Kp; const bf16* VT; int ldq;
    if (ISA) { const bf16* QKA = WSP(bf16, WS_QKA); Qp = QKA + (size_t)b * SEQ * 2048 + hx * 128 + grp * 64; Kp = QKA + (size_t)b * SEQ * 2048 + 1024 + hx * 128; ldq = 2048; VT = WSP(bf16, WS_VTA) + (size_t)(b * 8 + hx) * 128 * VROW; }
    else { const bf16* QKD = WSP(bf16, WS_QKD); Qp = QKD + (size_t)b * SEQ * 1152 + hd * 64; Kp = QKD + (size_t)b * SEQ * 1152 + 1024 + kvh * 64; ldq = 1152; VT = WSP(bf16, WS_VTD) + (size_t)(b * 2 + kvh) * 64 * VROW; }
    const int qpos = q0 + 32 * qs + r32;
    bf16x8 qr[4];
#pragma unroll
    for (int d0 = 0; d0 < 4; ++d0) qr[d0] = *(const bf16x8*)(Qp + (size_t)qpos * ldq + d0 * 16 + hi * 8);
    LAS float* Bt = (LAS float*)(L + 2 * BUFB);
    { const float* TAB = WSP(float, WS_TAB);
      if (ISA) { if (tid < 130) Bt[tid] = tid == 0 ? NEG : (tid == 129 ? 0.f : TAB[hx * 128 + tid - 1] - TAB[hx * 128 + 127]); }
      else { if (tid < 260) { const int gi = tid >= 130, t = tid - 130 * gi; Bt[tid] = (t == 0 || t == 129) ? NEG : TAB[(8 + kvh * 8 + (hx & 3) * 2 + gi) * 128 + t - 1]; } } }
    const int TQ = q0 >> 6, T0 = ISA ? 0 : (TQ >= 2 ? TQ - 2 : 0), T1 = TQ + 1;
    v4u kreg[NCH], vreg[NCH];
#define AT_GLOAD(T) do { _Pragma("unroll") for (int i_ = 0; i_ < NCH; ++i_) { const int c_ = tid + 512 * i_; \
        const int kr_ = ISA ? (c_ >> 4) : (c_ >> 3), kc_ = ISA ? (c_ & 15) : (c_ & 7); kreg[i_] = *(const v4u*)(Kp + (size_t)((T) * 64 + kr_) * ldq + kc_ * 8); \
        const int vr_ = c_ >> 3, vc_ = c_ & 7; vreg[i_] = *(const v4u*)(VT + (size_t)vr_ * VROW + (T) * 64 + vc_ * 8); } } while (0)
#define AT_LWRITE(buf) do { _Pragma("unroll") for (int i_ = 0; i_ < NCH; ++i_) { const int c_ = tid + 512 * i_; \
        const int kr_ = ISA ? (c_ >> 4) : (c_ >> 3), kc_ = ISA ? (c_ & 15) : (c_ & 7); *(LAS v4u*)(L + (buf) * BUFB + kr_ * KSTR + kc_ * 16) = kreg[i_]; \
        const int vr_ = c_ >> 3, vc_ = c_ & 7; *(LAS v4u*)(L + (buf) * BUFB + KBYTES + vr_ * VSTR + vc_ * 16) = vreg[i_]; } } while (0)
    f32x16 o[NDV];
#pragma unroll
    for (int i = 0; i < NDV; ++i) o[i] = (f32x16){0.f, 0.f, 0.f, 0.f, 0.f, 0.f, 0.f, 0.f, 0.f, 0.f, 0.f, 0.f, 0.f, 0.f, 0.f, 0.f};
    float m_run = ISA ? NEG : F.kin[I_SSINK][l * 16 + hd] * LOG2E, l_run = ISA ? 0.f : (hi == 0 ? 1.f : 0.f);
    const int krow = (r32 & 16) | (r32 & 3) | ((r32 & 4) << 1) | ((r32 & 8) >> 1);
    const int koff = krow * KSTR + (ISA ? grp * 128 : 0) + hi * 16, voff = KBYTES + r32 * VSTR + hi * 16;
    AT_GLOAD(T0); AT_LWRITE(0); __syncthreads();
#pragma unroll 1
    for (int T = T0; T <= T1; ++T) {
        const int cur = (T - T0) & 1;
        AT_GLOAD(T < T1 ? T + 1 : T1);
        LAS const unsigned char* Kb = L + cur * BUFB;
        f32x16 s[2];
        const float m_ref = fmaxf(m_run, -1.0e4f), nm = -m_ref;
#pragma unroll
        for (int blk = 0; blk < 2; ++blk) { s[blk] = (f32x16){nm, nm, nm, nm, nm, nm, nm, nm, nm, nm, nm, nm, nm, nm, nm, nm};
#pragma unroll
            for (int d0 = 0; d0 < 4; ++d0) { const bf16x8 kf = *(const LAS bf16x8*)(Kb + koff + blk * 32 * KSTR + d0 * 32); s[blk] = __builtin_amdgcn_mfma_f32_32x32x16_bf16(kf, qr[d0], s[blk], 0, 0, 0); } }
        bf16x8 vfc[NDV], vfn[NDV];
#pragma unroll
        for (int i = 0; i < NDV; ++i) vfc[i] = *(const LAS bf16x8*)(Kb + voff + i * 32 * VSTR);
        if (!ISA || T >= TQ - 2) {
            const LAS float* bt = Bt + (ISA ? 0 : grp * 130) + 1; const int d0 = qpos - T * 64 - 8 * hi;
#pragma unroll
            for (int blk = 0; blk < 2; ++blk)
#pragma unroll
                for (int r = 0; r < 16; ++r) { const int dist = d0 - (32 * blk + 16 * (r >> 3) + (r & 7)); const int di = dist < -1 ? -1 : (dist > 128 ? 128 : dist); s[blk][r] += bt[di]; } }
        float mt = s[0][0];
#pragma unroll
        for (int r = 1; r < 16; ++r) mt = fmaxf(mt, s[0][r]);
#pragma unroll
        for (int r = 0; r < 16; ++r) mt = fmaxf(mt, s[1][r]);
        mt = xmax32(mt);
        if (__any(mt > 8.0f)) { const float sh = mt > 8.0f ? mt : 0.f, alpha = __builtin_amdgcn_exp2f(-sh); l_run *= alpha;
#pragma unroll
            for (int i = 0; i < NDV; ++i)
#pragma unroll
                for (int r = 0; r < 16; ++r) o[i][r] *= alpha;
#pragma unroll
            for (int blk = 0; blk < 2; ++blk)
#pragma unroll
                for (int r = 0; r < 16; ++r) s[blk][r] -= sh;
            m_run = m_ref + sh; }
        else m_run = m_ref;
        float ls = 0.f;
#pragma unroll
        for (int blk = 0; blk < 2; ++blk)
#pragma unroll
            for (int r = 0; r < 16; ++r) { const float pv_ = __builtin_amdgcn_exp2f(s[blk][r]); s[blk][r] = pv_; ls += pv_; }
        l_run += ls;
#pragma unroll
        for (int sl = 0; sl < 4; ++sl) { const int blk = sl >> 1, r0 = 8 * (sl & 1);
            v4u pw; pw.x = pg8::cvt_pk_bf16(s[blk][r0], s[blk][r0 + 1]); pw.y = pg8::cvt_pk_bf16(s[blk][r0 + 2], s[blk][r0 + 3]); pw.z = pg8::cvt_pk_bf16(s[blk][r0 + 4], s[blk][r0 + 5]); pw.w = pg8::cvt_pk_bf16(s[blk][r0 + 6], s[blk][r0 + 7]);
            const bf16x8 pf = __builtin_bit_cast(bf16x8, pw);
#pragma unroll
            for (int i = 0; i < NDV; ++i) { if (sl < 3) vfn[i] = *(const LAS bf16x8*)(Kb + voff + i * 32 * VSTR + (sl + 1) * 32); o[i] = __builtin_amdgcn_mfma_f32_32x32x16_bf16(vfc[i], pf, o[i], 0, 0, 0); }
#pragma unroll
            for (int i = 0; i < NDV; ++i) vfc[i] = vfn[i]; }
        AT_LWRITE(cur ^ 1);
        __syncthreads();
    }
#undef AT_GLOAD
#undef AT_LWRITE
    const float inv = 1.0f / xsum32(l_run);
    bf16* MIX = WSP(bf16, WS_MIXED);
    if (ISA) {
        int ll_ = l; asm volatile("" : "+s"(ll_)); const float lam_init = ll_ == 0 ? 0.2f : 0.35550906759f;     float lam_full;
        { const float* lm = F.kin[I_DLAM] + (size_t)l * 256; const float s1 = wave_sum(lm[lane] * lm[64 + lane]), s2 = wave_sum(lm[128 + lane] * lm[192 + lane]); lam_full = __expf(s1) - __expf(s2) + lam_init; }
        LAS float* R1 = (LAS float*)L;
        LAS bf16* R2 = (LAS bf16*)(L + 66048);
        const int ql = 32 * qs + r32;
        if (grp == 1) {
#pragma unroll
            for (int i = 0; i < NDV; ++i)
#pragma unroll
                for (int r = 0; r < 16; ++r) R1[ql * 129 + 32 * i + crow16(r, hi)] = lam_full * inv * o[i][r]; }
        __syncthreads();
        if (grp == 0) { float ss = 0.f;
#pragma unroll
            for (int i = 0; i < NDV; ++i)
#pragma unroll
                for (int r = 0; r < 16; ++r) { const float d = o[i][r] * inv - R1[ql * 129 + 32 * i + crow16(r, hi)]; o[i][r] = d; ss += d * d; }
            const float rstd = rsqrtf(xsum32(ss) * (1.0f / 128.0f) + 1e-6f) * (1.0f - lam_init);
            const float* sl = F.kin[I_DSUB] + l * 128;
#pragma unroll
            for (int i = 0; i < NDV; ++i)
#pragma unroll
                for (int r = 0; r < 16; ++r) { const int dv = 32 * i + crow16(r, hi); R2[ql * 132 + dv] = (bf16)f2bf(o[i][r] * rstd * sl[dv]); } }
        __syncthreads();
#pragma unroll
        for (int i = 0; i < 4; ++i) { const int c = tid + 512 * i, row = c >> 4, ch = c & 15; const LAS v2u* sp = (const LAS v2u*)(R2 + row * 132 + ch * 8); const v2u a = sp[0], bb = sp[1];
            *(v4u*)(MIX + (size_t)(b * SEQ + q0 + row) * DM + hx * 128 + ch * 8) = (v4u){a.x, a.y, bb.x, bb.y}; }
    } else {
        LAS bf16* R = (LAS bf16*)L + F.wave * 2176;
#pragma unroll
        for (int i = 0; i < NDV; ++i)
#pragma unroll
            for (int r = 0; r < 16; ++r) R[r32 * 68 + 32 * i + crow16(r, hi)] = (bf16)f2bf(o[i][r] * inv);
#pragma unroll
        for (int i = 0; i < 4; ++i) { const int c = lane + 64 * i, row = c >> 3, ch = c & 7; const LAS v2u* sp = (const LAS v2u*)(R + row * 68 + ch * 8); const v2u a = sp[0], bb = sp[1];
            *(v4u*)(MIX + (size_t)(b * SEQ + q0 + 32 * qs + row) * DM + 3072 + hd * 64 + ch * 8) = (v4u){a.x, a.y, bb.x, bb.y}; }
    }
}
__device__ __forceinline__ void prep_gla(Frame& F) {
    LAS float* Lb = (LAS float*)(F.lds + RING_OFF); LAS float* Qd = Lb + 64 * 129; LAS float* Ki = Qd + 64 * 129; LAS bf16* Kt = (LAS bf16*)(Ki + 64 * 129);
    const bf16* COLS = WSP(bf16, WS_COLS); const float* LOGA = WSP(float, WS_LOGA);
    bf16* QDEC = WSP(bf16, WS_QDEC); bf16* KDT = WSP(bf16, WS_KDT); bf16* AMg = WSP(bf16, WS_AM); float* EBL = WSP(float, WS_EBL);
    for (int u = F.bx; u < 1024; u += F.G) {
        const int b = u >> 9, h = (u >> 7) & 3, ck = u & 127; const size_t row0 = (size_t)b * SEQ + ck * 64;
        __syncthreads();
        f32x4 lg[4]; v4u qv[2], kv[2];
#pragma unroll
        for (int i = 0; i < 4; ++i) { const int i4 = F.tid + 512 * i, t = i4 >> 5, d4 = (i4 & 31) * 4; lg[i] = *(const f32x4*)(LOGA + (row0 + t) * 512 + h * 128 + d4); }
#pragma unroll
        for (int i = 0; i < 2; ++i) { const int i8 = F.tid + 512 * i, t = i8 >> 4, d8 = (i8 & 15) * 8; const bf16* p = COLS + (row0 + t) * NMAIN + h * 128 + d8; qv[i] = *(const v4u*)(p + CB_Q); kv[i] = *(const v4u*)(p + CB_K); }
#pragma unroll
        for (int i = 0; i < 4; ++i) { const int i4 = F.tid + 512 * i, t = i4 >> 5, d4 = (i4 & 31) * 4;
#pragma unroll
            for (int e = 0; e < 4; ++e) Lb[t * 129 + d4 + e] = lg[i][e]; }
        __syncthreads();
        if (F.tid < 128) { float a[64];
#pragma unroll
            for (int t = 0; t < 64; ++t) a[t] = Lb[t * 129 + F.tid];
#pragma unroll
            for (int t = 1; t < 64; ++t) a[t] += a[t - 1];
#pragma unroll
            for (int t = 0; t < 64; ++t) Lb[t * 129 + F.tid] = a[t];
            EBL[(size_t)u * 128 + F.tid] = __expf(a[63]); }
        __syncthreads();
#pragma unroll
        for (int i = 0; i < 2; ++i) { const int i8 = F.tid + 512 * i, t = i8 >> 4, d8 = (i8 & 15) * 8; float q[8], k[8], qo[8]; unpack8(qv[i], q); unpack8(kv[i], k);
#pragma unroll
            for (int e = 0; e < 8; ++e) { const int d = d8 + e; const float bt = Lb[t * 129 + d], bl = Lb[63 * 129 + d];
                const float qd = q[e] * 0.08838834764831845f * __expf(bt); Qd[t * 129 + d] = qd; Ki[t * 129 + d] = k[e] * __expf(-bt); Kt[d * 72 + t] = (bf16)f2bf(k[e] * __expf(bl - bt)); qo[e] = qd; }
            *(v4u*)(QDEC + ((size_t)u * 64 + t) * 128 + d8) = pack8(qo); }
        __syncthreads();
#pragma unroll
        for (int i = 0; i < 2; ++i) { const int c_ = F.tid + 512 * i, row = c_ >> 3, ch = c_ & 7; const LAS v2u* sp = (const LAS v2u*)(Kt + row * 72 + ch * 8); const v2u a = sp[0], bb = sp[1];
            *(v4u*)(KDT + ((size_t)u * 128 + row) * 64 + ch * 8) = (v4u){a.x, a.y, bb.x, bb.y}; }
        {
          const int n = F.lane & 15, gq = F.lane >> 4, ct = F.wave >> 1, st0 = 2 * (F.wave & 1);
          f32x4 c0 = (f32x4){0.f, 0.f, 0.f, 0.f}, c1 = (f32x4){0.f, 0.f, 0.f, 0.f};
          if (st0 <= ct) {
              const LAS float* ap = Qd + (16 * ct + n) * 129 + gq; const LAS float* bp0 = Ki + (16 * st0 + n) * 129 + gq; const LAS float* bp1 = bp0 + 16 * 129;
#pragma unroll 8
              for (int ks = 0; ks < 32; ++ks) { const float av = ap[4 * ks]; c0 = __builtin_amdgcn_mfma_f32_16x16x4f32(av, bp0[4 * ks], c0, 0, 0, 0); c1 = __builtin_amdgcn_mfma_f32_16x16x4f32(av, bp1[4 * ks], c1, 0, 0, 0); } }
#pragma unroll
          for (int rr = 0; rr < 4; ++rr) { const int c = 16 * ct + 4 * gq + rr, s0 = 16 * st0 + n, s1 = s0 + 16;
              bf16* op = AMg + ((size_t)u * 64 + c) * 64; op[s0] = (bf16)f2bf(s0 <= c ? c0[rr] : 0.f); op[s1] = (bf16)f2bf(s1 <= c ? c1[rr] : 0.f); } }
    }
}
template <int PASS> __device__ __forceinline__ void prep_vt(Frame& F) {
    LAS bf16* T = (LAS bf16*)(F.lds + RING_OFF);
    const bf16* COLS = WSP(bf16, WS_COLS);
    constexpr int ncol = PASS == 4 ? 128 : 512, nch = ncol >> 3, NI = 64 * nch / (NWAVES * 64);
    constexpr int col0 = PASS < 2 ? CA_V + 512 * PASS : (PASS < 4 ? CB_V + 512 * (PASS - 2) : CD_V);
    bf16* dst0 = PASS < 2 ? WSP(bf16, WS_VTA) + (size_t)(512 * PASS) * VROW : (PASS < 4 ? WSP(bf16, WS_VTB) + (size_t)(512 * (PASS - 2)) * VROW : WSP(bf16, WS_VTD));
    constexpr int rows_b = PASS == 4 ? 128 : 1024;
    for (int tile = F.bx; tile < M / 64; tile += F.G) {
        const int b = tile >> 7, t0 = (tile & 127) * 64;
        __syncthreads();
        v4u v[NI];
#pragma unroll
        for (int i = 0; i < NI; ++i) { const int idx = F.tid + NWAVES * 64 * i, tok = idx / nch, ch = idx % nch; v[i] = *(const v4u*)(COLS + (size_t)(b * SEQ + t0 + tok) * NMAIN + col0 + ch * 8); }
#pragma unroll
        for (int i = 0; i < NI; ++i) { const int idx = F.tid + NWAVES * 64 * i, tok = idx / nch, ch = idx % nch; LAS unsigned* d = (LAS unsigned*)(T + tok * 522 + ch * 8); d[0] = v[i].x; d[1] = v[i].y; d[2] = v[i].z; d[3] = v[i].w; }
        __syncthreads();
#pragma unroll
        for (int i = 0; i < NI; ++i) { const int idx = F.tid + NWAVES * 64 * i, vrow = idx >> 3, ch = idx & 7;
            unsigned e[8];
#pragma unroll
            for (int k = 0; k < 8; ++k) e[k] = T[(ch * 8 + k) * 522 + vrow];
            v4u o; o.x = e[0] | (e[1] << 16); o.y = e[2] | (e[3] << 16); o.z = e[4] | (e[5] << 16); o.w = e[6] | (e[7] << 16);
            *(v4u*)(dst0 + ((size_t)b * rows_b + vrow) * VROW + t0 + ch * 8) = o; }
    }
}
typedef float f32x4v __attribute__((ext_vector_type(4)));
__device__ __forceinline__ float sum16(float v) { v = sum8(v); v += dpp_f<0x140>(v); return v; }
#define LDS_BARRIER() asm volatile("s_waitcnt lgkmcnt(0)\n\ts_barrier" ::: "memory")
template <int HACK = 0> __device__ __forceinline__ void gla_scan_unit(Frame& F, int l, int b, int h, int vh) {
    LAS unsigned char* L = F.lds + RING_OFF;
    constexpr int OQD = 0, OKT = 17408, OAM = 35840, OVT = 45056, OOT = 63488, OEB = 80896, OPS = 81408;
    const int tid = F.tid, lane = F.lane, n = lane & 15, g = lane >> 4, w = F.wave;
    const bf16* QDEC = WSP(bf16, WS_QDEC); const bf16* KDT = WSP(bf16, WS_KDT); const bf16* AMg = WSP(bf16, WS_AM); const float* EBL = WSP(float, WS_EBL);
    const bf16* VTB = WSP(bf16, WS_VTB) + (size_t)((b * 4 + h) * 256 + 128 * vh) * VROW; bf16* OB = WSP(bf16, WS_OB); float* PSG = WSP(float, WS_PSG);
    f32x4v S[8];
#pragma unroll
    for (int dt = 0; dt < 8; ++dt) S[dt] = (f32x4v){0.f, 0.f, 0.f, 0.f};
    v4u pq[2], pk[2], pa, pv[2]; float pe = 0.f;
#define GL_ISSUE(CK) do { const size_t u_ = (size_t)(b * 4 + h) * 128 + (CK); \
        _Pragma("unroll") for (int i = 0; i < 2; ++i) { const int c_ = tid + 512 * i; pq[i] = *(const v4u*)(QDEC + (u_ * 64 + (c_ >> 4)) * 128 + (c_ & 15) * 8); pk[i] = *(const v4u*)(KDT + (u_ * 128 + (c_ >> 3)) * 64 + (c_ & 7) * 8); \
            pv[i] = *(const v4u*)(VTB + (size_t)(c_ >> 3) * VROW + (CK) * 64 + (c_ & 7) * 8); } \
        pa = *(const v4u*)(AMg + (u_ * 64 + (tid >> 3)) * 64 + (tid & 7) * 8); \
        pe = EBL[u_ * 128 + (tid & 127)]; } while (0)
#define GL_WRITE() do { _Pragma("unroll") for (int i = 0; i < 2; ++i) { const int c_ = tid + 512 * i; *(LAS v4u*)(L + OQD + (c_ >> 4) * 272 + (c_ & 15) * 16) = pq[i]; *(LAS v4u*)(L + OKT + (c_ >> 3) * 144 + (c_ & 7) * 16) = pk[i]; \
            *(LAS v4u*)(L + OVT + (c_ >> 3) * 144 + (c_ & 7) * 16) = pv[i]; } \
        *(LAS v4u*)(L + OAM + (tid >> 3) * 144 + (tid & 7) * 16) = pa; \
        ((LAS float*)(L + OEB))[tid & 127] = pe; } while (0)
    GL_ISSUE(0); GL_WRITE();
    LDS_BARRIER();
#pragma unroll 1
    for (int ck = 0; ck < 128; ++ck) {
        const size_t row0 = (size_t)b * SEQ + ck * 64;
        GL_ISSUE((HACK & 1) && ck >= 2 ? 2 : (ck + 1 < 128 ? ck + 1 : 127));
        bf16x8 vf[2];
#pragma unroll
        for (int ks = 0; ks < 2; ++ks) vf[ks] = *(const LAS bf16x8*)(L + OVT + (16 * w + n) * 144 + (32 * ks + 8 * g) * 2);
        f32x4v o[4];
#pragma unroll
        for (int ct = 0; ct < 4; ++ct) o[ct] = (f32x4v){0.f, 0.f, 0.f, 0.f};
#pragma unroll
        for (int ct = 0; ct < 4; ++ct)
#pragma unroll
            for (int ks = 0; ks < 2; ++ks) { const bf16x8 af = *(const LAS bf16x8*)(L + OAM + (16 * ct + n) * 144 + (32 * ks + 8 * g) * 2); o[ct] = __builtin_amdgcn_mfma_f32_16x16x32_bf16(af, vf[ks], o[ct], 0, 0, 0); }
#pragma unroll
        for (int kk = 0; kk < 4; ++kk) { v4u pw; pw.x = pg8::cvt_pk_bf16(S[2 * kk][0], S[2 * kk][1]); pw.y = pg8::cvt_pk_bf16(S[2 * kk][2], S[2 * kk][3]);
            pw.z = pg8::cvt_pk_bf16(S[2 * kk + 1][0], S[2 * kk + 1][1]); pw.w = pg8::cvt_pk_bf16(S[2 * kk + 1][2], S[2 * kk + 1][3]); const bf16x8 sf = __builtin_bit_cast(bf16x8, pw);
#pragma unroll
            for (int ct = 0; ct < 4; ++ct) { const LAS unsigned char* qp = L + OQD + (16 * ct + n) * 272 + (32 * kk + 4 * g) * 2; const v2u qa = *(const LAS v2u*)qp, qb = *(const LAS v2u*)(qp + 32);
                o[ct] = __builtin_amdgcn_mfma_f32_16x16x32_bf16(__builtin_bit_cast(bf16x8, (v4u){qa.x, qa.y, qb.x, qb.y}), sf, o[ct], 0, 0, 0); } }
#pragma unroll
        for (int dt = 0; dt < 8; ++dt) { const f32x4v eb = *(const LAS f32x4v*)(L + OEB + (16 * dt + 4 * g) * 4); S[dt] = S[dt] * eb;
#pragma unroll
            for (int ks = 0; ks < 2; ++ks) { const bf16x8 kf = *(const LAS bf16x8*)(L + OKT + (16 * dt + n) * 144 + (32 * ks + 8 * g) * 2); S[dt] = __builtin_amdgcn_mfma_f32_16x16x32_bf16(kf, vf[ks], S[dt], 0, 0, 0); } }
        LAS float* PS = (LAS float*)(L + OPS) + (ck & 1) * 512;
#pragma unroll
        for (int ct = 0; ct < 4; ++ct)
#pragma unroll
            for (int r = 0; r < 4; ++r) { const float ss = sum16(o[ct][r] * o[ct][r]); if (n == 0) PS[(16 * ct + 4 * g + r) * 8 + w] = ss;
                *(LAS bf16*)(L + OOT + (16 * ct + 4 * g + r) * 272 + (16 * w + n) * 2) = (bf16)f2bf(o[ct][r]); }
        LDS_BARRIER();
        GL_WRITE();
        if (!(HACK & 2)) {
#pragma unroll
        for (int i = 0; i < 2; ++i) { const int c_ = tid + 512 * i, tok = c_ >> 4, ch = c_ & 15; *(v4u*)(OB + (row0 + tok) * 1024 + h * 256 + 128 * vh + ch * 8) = *(const LAS v4u*)(L + OOT + tok * 272 + ch * 16); }
        if (tid < 64) { const LAS f32x4v* pp = (const LAS f32x4v*)(PS + tid * 8); const f32x4v p0 = pp[0], p1 = pp[1]; PSG[(row0 + tid) * 8 + h * 2 + vh] = ((p0.x + p0.y) + (p0.z + p0.w)) + ((p1.x + p1.y) + (p1.z + p1.w)); } }
        LDS_BARRIER();
    }
#undef GL_ISSUE
#undef GL_WRITE
}
__device__ __forceinline__ void gla_post(Frame& F, int l) {
    const bf16* OB = WSP(bf16, WS_OB); const float* PSG = WSP(float, WS_PSG); const bf16* COLS = WSP(bf16, WS_COLS); bf16* MIX = WSP(bf16, WS_MIXED);
    const int ch = F.tid & 127, h = ch >> 5; float gain8[8];
#pragma unroll
    for (int e = 0; e < 8; ++e) gain8[e] = F.kin[I_GON][l * 256 + (ch & 31) * 8 + e];
    for (int row0 = F.bx * 4 + (F.tid >> 7); row0 < M; row0 += F.G * 16) {
        v4u ovr[4], gvr[4]; f32x2_t ps[4];
#pragma unroll
        for (int i = 0; i < 4; ++i) { const int row = row0 + F.G * 4 * i < M ? row0 + F.G * 4 * i : row0;
            ovr[i] = *(const v4u*)(OB + (size_t)row * 1024 + ch * 8); gvr[i] = *(const v4u*)(COLS + (size_t)row * NMAIN + CB_G + ch * 8); ps[i] = *(const f32x2_t*)(PSG + (size_t)row * 8 + h * 2); }
#pragma unroll
        for (int i = 0; i < 4; ++i) { const int row = row0 + F.G * 4 * i; float ov[8], gv[8]; unpack8(ovr[i], ov); unpack8(gvr[i], gv);
            const float rstd = rsqrtf((ps[i].x + ps[i].y) * (1.0f / 256.0f) + 1e-6f);
#pragma unroll
            for (int e = 0; e < 8; ++e) ov[e] = ov[e] * (rstd * gain8[e]) * silu_g(gv[e]);
            if (row < M) *(v4u*)(MIX + (size_t)row * DM + 1024 + ch * 8) = pack8(ov); }
    }
}
constexpr int RC_AT = 0, RC_RT = 2048, RC_BK = 4096, RC_VF = 8192, RC_GF = 10240, RC_U0 = 12288, RC_Y0 = 16384, RC_P15 = 20480, RC_BN = 20736, RC_BYTES = 20800;
__device__ __forceinline__ void rwkv_chunks_of_tile(Frame& F, int l, int tile) {
    const int team = F.tid >> 8, tt = F.tid & 255;
    LAS float* Lt = (LAS float*)(F.lds + RING_OFF) + team * 12288;
    LAS float* XA = Lt; LAS float* XR = Lt + 1040; LAS float* ZB = Lt + 2080; LAS float* ZK = Lt + 3120; LAS float* TB = Lt + 4160; LAS float* TK = Lt + 5200; LAS float* VV = Lt + 6240;
    LAS float* ATl = Lt + 7280; LAS float* U0l = Lt + 8320; LAS float* W1 = Lt + 9360;
    LAS float* Aab = Lt + 10400; LAS float* Aak = Lt + 10672; LAS float* Arb = Lt + 10944; LAS float* Ark = Lt + 11216; LAS float* TT = Lt + 11488;
    const float* RW = WSP(float, WS_RW); const unsigned* RWU = WSP(unsigned, WS_RW); constexpr size_t RS = RW_ONE / 4; unsigned char* RWC = F.ws + WS_RWC;
    float pw_[6], pr_[4], pk_[4], pv_[4], pa_[4], pb_[4], pg_[4];
#define RC_FETCH(P) do { const int h_ = 2 * (P) + team; const size_t cb_ = (size_t)tile * 16 * 1024 + h_ * 64 + (tt & 63); const int q_ = tt >> 6; \
        pw_[4] = RW[RS + cb_ + (size_t)(q_ ? 4 * q_ - 1 : 0) * 1024]; pw_[5] = RW[RS + cb_ + (size_t)15 * 1024];            \
        _Pragma("unroll") for (int e = 0; e < 4; ++e) { const size_t o_ = cb_ + (size_t)(4 * q_ + e) * 1024; pw_[e] = RW[RS + o_]; const unsigned u0 = RWU[o_], u2 = RWU[2 * RS + o_], u3 = RWU[3 * RS + o_]; \
            pr_[e] = bflo(u0); pk_[e] = bfhi(u0); pv_[e] = bflo(u2); pg_[e] = bfhi(u2); pa_[e] = bflo(u3); pb_[e] = bfhi(u3); } } while (0)
    RC_FETCH(0);
#pragma unroll 1
    for (int pair = 0; pair < 8; ++pair) {
        const int uc = ((tile >> 9) * 16 + 2 * pair + team) * 512 + (tile & 511), b = uc >> 13, h = (uc >> 9) & 15, ck = uc & 511; unsigned char* rec = RWC + ((size_t)ck * 32 + (uc >> 9)) * RC_BYTES;     (void)b;
        __syncthreads();
        {
          const int j = tt & 63, q = tt >> 6;
          const float cl = pw_[5], clm = q ? pw_[4] : 0.f; const float clq[4] = {pw_[0], pw_[1], pw_[2], pw_[3]};
#pragma unroll
          for (int e = 0; e < 4; ++e) { const int t = 4 * q + e; const float cprev = e == 0 ? clm : clq[e - 1], cc = clq[e];
              const float rr = pr_[e], kk = pk_[e], vv = pv_[e], aa = pa_[e], bb = pb_[e];
              XA[t * 65 + j] = aa * __expf(cprev); XR[t * 65 + j] = rr * __expf(cc); const float ei = __expf(-cc), ef = __expf(cl - cc);
              ZB[t * 65 + j] = bb * ei; ZK[t * 65 + j] = kk * ei; TB[t * 65 + j] = bb * ef; TK[t * 65 + j] = kk * ef; VV[t * 65 + j] = vv; }
          if (q == 0) ((float*)(rec + RC_P15))[j] = __expf(cl);
          { v2u gw; gw.x = pk2(pg_[0], pg_[1]); gw.y = pk2(pg_[2], pg_[3]); *(v2u*)(rec + RC_GF + (((j >> 4) * 64 + 16 * q + (j & 15)) * 8)) = gw; } }
        RC_FETCH(pair < 7 ? pair + 1 : 7);
        __syncthreads();
        {
          const int q = tt >> 6, n = tt & 15, g = (tt >> 4) & 3; const LAS float* X = (q & 2) ? XR : XA; const LAS float* Z = (q & 1) ? ZK : ZB; LAS float* O = q == 0 ? Aab : (q == 1 ? Aak : (q == 2 ? Arb : Ark));
          f32x4v c = (f32x4v){0.f, 0.f, 0.f, 0.f};
#pragma unroll
          for (int ks = 0; ks < 16; ++ks) c = __builtin_amdgcn_mfma_f32_16x16x4f32(X[n * 65 + 4 * ks + g], Z[n * 65 + 4 * ks + g], c, 0, 0, 0);
#pragma unroll
          for (int rr = 0; rr < 4; ++rr) { const int t = 4 * g + rr; O[t * 17 + n] = ((q & 2) ? n <= t : n < t) ? c[rr] : 0.f; }
          { const int t = tt >> 4, jq = tt & 15; const float* rkp = F.kin[I_RRK] + l * 1024 + h * 64 + 4 * jq; float bn = 0.f;
#pragma unroll
            for (int e = 0; e < 4; ++e) bn += XR[t * 65 + 4 * jq + e] * ZK[t * 65 + 4 * jq + e] * rkp[e];
            bn = sum16(bn); if (jq == 0) ((float*)(rec + RC_BN))[t] = bn; } }
        __syncthreads();
        {
          if (tt < 16) { float col[16];
#pragma unroll
              for (int t = 0; t < 16; ++t) { float acc = (t == tt) ? 1.f : 0.f;
#pragma unroll
                  for (int s = 0; s < 16; ++s) if (s < t) acc += Aab[t * 17 + s] * col[s];
                  col[t] = acc; TT[t * 17 + tt] = acc; } }
          const int q = tt >> 6, n = tt & 15, g = (tt >> 4) & 3; f32x4v c = (f32x4v){0.f, 0.f, 0.f, 0.f};
#pragma unroll
          for (int ks = 0; ks < 4; ++ks) c = __builtin_amdgcn_mfma_f32_16x16x4f32(Aak[n * 17 + 4 * ks + g], VV[(4 * ks + g) * 65 + 16 * q + n], c, 0, 0, 0);
#pragma unroll
          for (int rr = 0; rr < 4; ++rr) W1[(4 * g + rr) * 65 + 16 * q + n] = c[rr]; }
        __syncthreads();
        {
          const int q = tt >> 6, n = tt & 15, g = (tt >> 4) & 3; f32x4v ca = (f32x4v){0.f, 0.f, 0.f, 0.f}, cu = (f32x4v){0.f, 0.f, 0.f, 0.f};
#pragma unroll
          for (int ks = 0; ks < 4; ++ks) { const float tv = TT[n * 17 + 4 * ks + g]; ca = __builtin_amdgcn_mfma_f32_16x16x4f32(tv, XA[(4 * ks + g) * 65 + 16 * q + n], ca, 0, 0, 0); cu = __builtin_amdgcn_mfma_f32_16x16x4f32(tv, W1[(4 * ks + g) * 65 + 16 * q + n], cu, 0, 0, 0); }
#pragma unroll
          for (int rr = 0; rr < 4; ++rr) { ATl[(4 * g + rr) * 65 + 16 * q + n] = ca[rr]; U0l[(4 * g + rr) * 65 + 16 * q + n] = cu[rr]; }
          *(f32x4v*)(rec + RC_U0 + ((q * 64 + 16 * g + n) * 16)) = cu; }
        __syncthreads();
        {
          const int q = tt >> 6, n = tt & 15, g = (tt >> 4) & 3; f32x4v cr, cy = (f32x4v){0.f, 0.f, 0.f, 0.f};
#pragma unroll
          for (int rr = 0; rr < 4; ++rr) cr[rr] = XR[(4 * g + rr) * 65 + 16 * q + n];
#pragma unroll
          for (int ks = 0; ks < 4; ++ks) { const float arb = Arb[n * 17 + 4 * ks + g], ark = Ark[n * 17 + 4 * ks + g];
              cr = __builtin_amdgcn_mfma_f32_16x16x4f32(arb, ATl[(4 * ks + g) * 65 + 16 * q + n], cr, 0, 0, 0);
              cy = __builtin_amdgcn_mfma_f32_16x16x4f32(arb, U0l[(4 * ks + g) * 65 + 16 * q + n], cy, 0, 0, 0);
              cy = __builtin_amdgcn_mfma_f32_16x16x4f32(ark, VV[(4 * ks + g) * 65 + 16 * q + n], cy, 0, 0, 0); }
          *(f32x4v*)(rec + RC_Y0 + ((q * 64 + 16 * g + n) * 16)) = cy;
#pragma unroll
          for (int rr = 0; rr < 4; ++rr) W1[(4 * g + rr) * 65 + 16 * q + n] = cr[rr]; }
        __syncthreads();
        { const int t = tt & 15, jq = tt >> 4, kk = jq >> 3, half = (jq & 7) >> 2, g = jq & 3, j0 = 4 * jq;
          v2u wa, wr; wa.x = pk2(ATl[t * 65 + j0], ATl[t * 65 + j0 + 1]); wa.y = pk2(ATl[t * 65 + j0 + 2], ATl[t * 65 + j0 + 3]); wr.x = pk2(W1[t * 65 + j0], W1[t * 65 + j0 + 1]); wr.y = pk2(W1[t * 65 + j0 + 2], W1[t * 65 + j0 + 3]);
          *(v2u*)(rec + RC_AT + kk * 1024 + (16 * g + t) * 16 + half * 8) = wa; *(v2u*)(rec + RC_RT + kk * 1024 + (16 * g + t) * 16 + half * 8) = wr;
          const int j = tt & 63, gg = tt >> 6; v4u bk; bk.x = pk2(TB[(4 * gg) * 65 + j], TB[(4 * gg + 1) * 65 + j]); bk.y = pk2(TB[(4 * gg + 2) * 65 + j], TB[(4 * gg + 3) * 65 + j]);
          bk.z = pk2(TK[(4 * gg) * 65 + j], TK[(4 * gg + 1) * 65 + j]); bk.w = pk2(TK[(4 * gg + 2) * 65 + j], TK[(4 * gg + 3) * 65 + j]);
          *(v4u*)(rec + RC_BK + (j >> 4) * 1024 + (16 * gg + (j & 15)) * 16) = bk;
          v2u vf; vf.x = pk2(VV[(4 * gg) * 65 + j], VV[(4 * gg + 1) * 65 + j]); vf.y = pk2(VV[(4 * gg + 2) * 65 + j], VV[(4 * gg + 3) * 65 + j]);
          *(v2u*)(rec + RC_VF + ((j >> 4) * 64 + 16 * gg + (j & 15)) * 8) = vf; }
    }
}
#undef RC_FETCH
template <int HACK = 0> __device__ __forceinline__ void rwkv_scan_unit(Frame& F, int l, int b, int h) {
    LAS unsigned char* L = F.lds + RING_OFF;
    const unsigned char* recs = F.ws + WS_RWC + (size_t)(b * 16 + h) * RC_BYTES;
    const int lane = F.lane, n = lane & 15, g = lane >> 4;
    LAS float* XS = (LAS float*)(L + 2 * RC_BYTES);
    if (F.wave >= 2) {
        const int li = F.tid - 128;
        int px[4];
#pragma unroll
        for (int k = 0; k < 4; ++k) { const int x = li + 384 * k; px[k] = x < 1300 ? x : 1299; }
        v4u p0[4], p1[4], p2[4], p3[4], p4[4], p5[4], p6[4], p7[4];
#define RWL_ISSUE(P, CK) do { const int ck_ = (CK) < 512 ? ((HACK & 1) && (CK) >= 4 ? 3 : (CK)) : 511; const v4u* src_ = (const v4u*)(recs + (size_t)ck_ * 32 * RC_BYTES); \
        _Pragma("unroll") for (int k = 0; k < 4; ++k) P[k] = src_[px[k]]; } while (0)
#define RWL_WRITE(P, CK) do { LAS v4u* dst_ = (LAS v4u*)(L + ((CK) & 1) * RC_BYTES); _Pragma("unroll") for (int k = 0; k < 4; ++k) dst_[px[k]] = P[k]; } while (0)
        RWL_ISSUE(p0, 0); RWL_ISSUE(p1, 1); RWL_ISSUE(p2, 2); RWL_ISSUE(p3, 3); RWL_ISSUE(p4, 4); RWL_ISSUE(p5, 5); RWL_ISSUE(p6, 6); RWL_ISSUE(p7, 7);
        RWL_WRITE(p0, 0); RWL_ISSUE(p0, 8);
        LDS_BARRIER();
#pragma unroll 1
        for (int ck = 0; ck < 512; ck += 8) {
            RWL_WRITE(p1, ck + 1); RWL_ISSUE(p1, ck + 9); LDS_BARRIER();
            RWL_WRITE(p2, ck + 2); RWL_ISSUE(p2, ck + 10); LDS_BARRIER();
            RWL_WRITE(p3, ck + 3); RWL_ISSUE(p3, ck + 11); LDS_BARRIER();
            RWL_WRITE(p4, ck + 4); RWL_ISSUE(p4, ck + 12); LDS_BARRIER();
            RWL_WRITE(p5, ck + 5); RWL_ISSUE(p5, ck + 13); LDS_BARRIER();
            RWL_WRITE(p6, ck + 6); RWL_ISSUE(p6, ck + 14); LDS_BARRIER();
            RWL_WRITE(p7, ck + 7); RWL_ISSUE(p7, ck + 15); LDS_BARRIER();
            RWL_WRITE(p0, ck + 8); RWL_ISSUE(p0, ck + 16); LDS_BARRIER();
        }
#undef RWL_ISSUE
#undef RWL_WRITE
        return;
    }
    const int cw = F.wave;
    f32x4v S[4][2];
#pragma unroll
    for (int jt = 0; jt < 4; ++jt)
#pragma unroll
        for (int it = 0; it < 2; ++it) S[jt][it] = (f32x4v){0.f, 0.f, 0.f, 0.f};
    float lnw[2], lnb[2];
#pragma unroll
    for (int it = 0; it < 2; ++it) { lnw[it] = F.kin[I_RLNW][l * 1024 + h * 64 + 16 * (2 * cw + it) + n]; lnb[it] = F.kin[I_RLNB][l * 1024 + h * 64 + 16 * (2 * cw + it) + n]; }
    bf16* MIX = WSP(bf16, WS_MIXED) + ((size_t)b * SEQ) * DM + 2048 + h * 64 + 32 * cw + n;
    f32x4v Yp[2] = {(f32x4v){0.f, 0.f, 0.f, 0.f}, (f32x4v){0.f, 0.f, 0.f, 0.f}}, bnp = (f32x4v){0.f, 0.f, 0.f, 0.f}; v2u gfp[2] = {(v2u){0u, 0u}, (v2u){0u, 0u}}, vfp[2] = {(v2u){0u, 0u}, (v2u){0u, 0u}};
    LDS_BARRIER();
#pragma unroll 1
    for (int ck = 0; ck <= 512; ++ck) {
        if (ck > 0) {
            const LAS float* xs = XS + ((ck - 1) & 1) * 64; const f32x4v a0 = *(const LAS f32x4v*)(xs + 8 * g), a1 = *(const LAS f32x4v*)(xs + 8 * g + 4), b0 = *(const LAS f32x4v*)(xs + 32 + 8 * g), b1 = *(const LAS f32x4v*)(xs + 32 + 8 * g + 4);
            const float s1[4] = {a0[0] + b0[0], a0[2] + b0[2], a1[0] + b1[0], a1[2] + b1[2]}, s2[4] = {a0[1] + b0[1], a0[3] + b0[3], a1[1] + b1[1], a1[3] + b1[3]};
#pragma unroll
            for (int it = 0; it < 2; ++it) { const float gt[4] = {bflo(gfp[it].x), bfhi(gfp[it].x), bflo(gfp[it].y), bfhi(gfp[it].y)}, vt[4] = {bflo(vfp[it].x), bfhi(vfp[it].x), bflo(vfp[it].y), bfhi(vfp[it].y)};
#pragma unroll
                for (int r = 0; r < 4; ++r) { const float mean = s1[r] * (1.0f / 64.0f), var = fmaxf(s2[r] * (1.0f / 64.0f) - mean * mean, 0.f), rstd = rsqrtf(var + 64e-5f);
                    if (!(HACK & 2)) MIX[(size_t)((ck - 1) * 16 + 4 * g + r) * DM + 16 * it] = (bf16)f2bf(((Yp[it][r] - mean) * rstd * lnw[it] + lnb[it] + bnp[r] * vt[r]) * gt[r]); } }
            if (ck == 512) break;
        }
        if (HACK & 4) { LDS_BARRIER(); continue; }
        const LAS unsigned char* R = L + (ck & 1) * RC_BYTES;
        bf16x8 at[2], rt[2];
#pragma unroll
        for (int kk = 0; kk < 2; ++kk) { at[kk] = *(const LAS bf16x8*)(R + RC_AT + kk * 1024 + lane * 16); rt[kk] = *(const LAS bf16x8*)(R + RC_RT + kk * 1024 + lane * 16); }
        f32x4v U[2], Y[2];
#pragma unroll
        for (int it = 0; it < 2; ++it) { U[it] = *(const LAS f32x4v*)(R + RC_U0 + (2 * cw + it) * 1024 + lane * 16); Y[it] = *(const LAS f32x4v*)(R + RC_Y0 + (2 * cw + it) * 1024 + lane * 16); }
#pragma unroll
        for (int kk = 0; kk < 2; ++kk)
#pragma unroll
            for (int it = 0; it < 2; ++it) { v4u pw; pw.x = pg8::cvt_pk_bf16(S[2 * kk][it][0], S[2 * kk][it][1]); pw.y = pg8::cvt_pk_bf16(S[2 * kk][it][2], S[2 * kk][it][3]);
                pw.z = pg8::cvt_pk_bf16(S[2 * kk + 1][it][0], S[2 * kk + 1][it][1]); pw.w = pg8::cvt_pk_bf16(S[2 * kk + 1][it][2], S[2 * kk + 1][it][3]); const bf16x8 sf = __builtin_bit_cast(bf16x8, pw);
                U[it] = __builtin_amdgcn_mfma_f32_16x16x32_bf16(at[kk], sf, U[it], 0, 0, 0); Y[it] = __builtin_amdgcn_mfma_f32_16x16x32_bf16(rt[kk], sf, Y[it], 0, 0, 0); }
        bf16x8 uv[2];
#pragma unroll
        for (int it = 0; it < 2; ++it) { vfp[it] = *(const LAS v2u*)(R + RC_VF + (2 * cw + it) * 512 + lane * 8); gfp[it] = *(const LAS v2u*)(R + RC_GF + (2 * cw + it) * 512 + lane * 8);
            v4u pw; pw.x = pg8::cvt_pk_bf16(U[it][0], U[it][1]); pw.y = pg8::cvt_pk_bf16(U[it][2], U[it][3]); pw.z = vfp[it].x; pw.w = vfp[it].y; uv[it] = __builtin_bit_cast(bf16x8, pw); }
#pragma unroll
        for (int jt = 0; jt < 4; ++jt) { const bf16x8 bk = *(const LAS bf16x8*)(R + RC_BK + jt * 1024 + lane * 16); const f32x4v p15 = *(const LAS f32x4v*)(R + RC_P15 + (16 * jt + 4 * g) * 4);
#pragma unroll
            for (int it = 0; it < 2; ++it) S[jt][it] = __builtin_amdgcn_mfma_f32_16x16x32_bf16(bk, uv[it], S[jt][it] * p15, 0, 0, 0); }
        bnp = *(const LAS f32x4v*)(R + RC_BN + 16 * g); Yp[0] = Y[0]; Yp[1] = Y[1];
        { LAS float* xo = XS + (ck & 1) * 64 + cw * 32; const f32x4v sm = Y[0] + Y[1], sq = Y[0] * Y[0] + Y[1] * Y[1];
#pragma unroll
          for (int r = 0; r < 4; ++r) { const float a = sum16(sm[r]), q = sum16(sq[r]); if (n == 0) { xo[(4 * g + r) * 2] = a; xo[(4 * g + r) * 2 + 1] = q; } } }
        LDS_BARRIER();
    }
}
template <int HACK = 0> __device__ __forceinline__ void mixers_v4(Frame& F, int l, int qi, int mask = 15) {
    gu32* ctr = F.ctl + CW_Q + 64 * qi;
    for (;;) {
        const int it = next_item(F, ctr); relaunder(F); relaunder_tid(F);
        if (it < 32) { if (mask & 1) rwkv_scan_unit<HACK>(F, l, it >> 4, it & 15); }
        else if (it < 48) { const int j = it - 32; if (mask & 2) gla_scan_unit<HACK>(F, l, j >> 3, (j >> 1) & 3, j & 1); }
        else if (it < 48 + 1024) { const int j = it - 48, qb = 63 - (j >> 4), bh = j & 15; if (mask & 4) attn_unit<true>(F, l, bh >> 3, bh & 7, qb); }
        else if (it < 48 + 2048) { const int j = it - 1072, qb = j & 63, bh = j >> 6; if (mask & 8) attn_unit<false>(F, l, bh >> 3, bh & 7, qb); }
        else break;
    }
}
template <int HACK = 0> __device__ __forceinline__ void prep_rwkv(Frame& F, int l) {
    LAS float* zl = (LAS float*)(F.lds + RING_OFF) + 4096;
    LAS bf16* inb = (LAS bf16*)(F.lds + RING_OFF);
    const float* mu = F.kin[I_RMU] + (size_t)l * 3264;
    const float* LOWR = WSP(float, WS_LOWR); const bf16* COLS = WSP(bf16, WS_COLS);
    float* RW = WSP(float, WS_RW); unsigned* RWU = WSP(unsigned, WS_RW); float* VF = WSP(float, WS_VFIRST);
    constexpr size_t RS = RW_ONE / 4;
    for (int tile = F.bx; tile < M / 16; tile += F.G) {
        const int row0 = tile * 16;
        relaunder(F); relaunder_tid(F);
        __syncthreads();
        {
            float cur_[7], prv_[7], mu_[7];
#pragma unroll
            for (int q = 0; q < 7; ++q) { const int idx = F.tid + NWAVES * 64 * q, tt = idx / 224, j = idx % 224, row = row0 + tt;
                const int col = j < 192 ? 16 + j : 208 + (j - 192);
                const float* mp = j < 192 ? mu + 3072 + j : F.kin[I_VRMU] + (l ? (l - 1) * 32 : 0) + (j - 192);
                cur_[q] = LOWR[(size_t)row * 256 + col]; prv_[q] = LOWR[(size_t)((row & (SEQ - 1)) ? row - 1 : row) * 256 + col]; mu_[q] = *mp; }
#pragma unroll
            for (int q = 0; q < 7; ++q) { const int idx = F.tid + NWAVES * 64 * q, tt = idx / 224, j = idx % 224, row = row0 + tt;
                const float prev = (row & (SEQ - 1)) ? prv_[q] : 0.f, muv = (j >= 192 && l == 0) ? 0.f : mu_[q];
                float x = cur_[q] + (prev - cur_[q]) * muv;
                if (j < 64) x = tanhf(x); else if (j >= 128 && j < 192) x = sigmoid_f(x);
                inb[tt * 232 + j] = (bf16)f2bf(x); } }
        __syncthreads();
        {
            const int c = 2 * F.tid;
            float accw[2][16], acca[2][16], accg[2][16], accv[2][16];
#pragma unroll
            for (int e = 0; e < 2; ++e) { const float bw = F.kin[I_RW0][l * 1024 + c + e], ba = F.kin[I_RA0][l * 1024 + c + e], bv = l ? F.kin[I_VR0][(l - 1) * 1024 + c + e] : 0.f;
#pragma unroll
              for (int tt = 0; tt < 16; ++tt) { accw[e][tt] = bw; acca[e][tt] = ba; accg[e][tt] = 0.f; accv[e][tt] = bv; } }
#define LOWRANK_MFMA(ACC, MI, JOFF, NKS) do { const bf16* wf_ = WSP(bf16, WS_WF) + ((size_t)(l * 448 + ((MI) < 3 ? (MI) * 128 + 16 * (NKS) / 2 * F.wave : 384 + 8 * F.wave)) * 64 + F.lane) * 8; \
            bf16x8 af_[NKS], bf_[8][NKS]; \
            _Pragma("unroll") for (int ks = 0; ks < (NKS); ++ks) af_[ks] = *(const LAS bf16x8*)(inb + (F.lane & 15) * 232 + (JOFF) + 32 * ks + 8 * (F.lane >> 4)); \
            _Pragma("unroll") for (int nt = 0; nt < 8; ++nt) _Pragma("unroll") for (int ks = 0; ks < (NKS); ++ks) bf_[nt][ks] = *(const bf16x8*)(wf_ + (size_t)(nt * (NKS) + ks) * 512); \
            _Pragma("unroll") for (int nt = 0; nt < 8; ++nt) { f32x4 c4 = {0.f, 0.f, 0.f, 0.f}; \
                _Pragma("unroll") for (int ks = 0; ks < (NKS); ++ks) c4 = __builtin_amdgcn_mfma_f32_16x16x32_bf16(af_[ks], bf_[nt][ks], c4, 0, 0, 0); \
                _Pragma("unroll") for (int rr = 0; rr < 4; ++rr) zl[(4 * (F.lane >> 4) + rr) * 1028 + 128 * F.wave + 16 * nt + (F.lane & 15)] = c4[rr]; } \
            __builtin_amdgcn_wave_barrier(); asm volatile("s_waitcnt lgkmcnt(0)" ::: "memory"); __builtin_amdgcn_wave_barrier();   \
            _Pragma("unroll") for (int tt = 0; tt < 16; ++tt) { const f32x2_t z2 = *(const LAS f32x2_t*)(zl + tt * 1028 + c); ACC[0][tt] += z2.x; ACC[1][tt] += z2.y; } \
            __builtin_amdgcn_wave_barrier(); asm volatile("s_waitcnt lgkmcnt(0)" ::: "memory"); __builtin_amdgcn_wave_barrier(); } while (0)
            if (!(HACK & 1)) { LOWRANK_MFMA(accw, 0, 0, 2); relaunder(F);
            LOWRANK_MFMA(acca, 1, 64, 2); relaunder(F);
            LOWRANK_MFMA(accg, 2, 128, 2); relaunder(F);
            if (l) LOWRANK_MFMA(accv, 3, 192, 1); }
#undef LOWRANK_MFMA
            relaunder(F);
            float mur[2], muk[2], muv[2], kkv[2], kav[2], pr[2] = {0.f, 0.f}, pk[2] = {0.f, 0.f}, pv[2] = {0.f, 0.f}; float cl[2] = {0.f, 0.f};
#pragma unroll
            for (int e = 0; e < 2; ++e) { mur[e] = F.kin[I_RMU][l * 3264 + c + e]; muk[e] = F.kin[I_RMU][l * 3264 + 1024 + c + e]; muv[e] = F.kin[I_RMU][l * 3264 + 2048 + c + e]; kkv[e] = F.kin[I_RKK][l * 1024 + c + e]; kav[e] = F.kin[I_RKA][l * 1024 + c + e]; }
            if ((row0 & (SEQ - 1)) != 0) { const bf16* p = COLS + (size_t)(row0 - 1) * NMAIN + c; const unsigned ur = *(const unsigned*)(p + CC_R), uk = *(const unsigned*)(p + CC_K), uv = *(const unsigned*)(p + CC_V);
                pr[0] = bflo(ur); pr[1] = bfhi(ur); pk[0] = bflo(uk); pk[1] = bfhi(uk); pv[0] = bflo(uv); pv[1] = bfhi(uv); }
            constexpr int PFD = 4;
            unsigned pur[16], puk[16], puv[16]; f32x2_t pvf[16];
#define PF_TOK(T) do { const bf16* p_ = COLS + (size_t)(row0 + (T)) * NMAIN + c; pur[T] = *(const unsigned*)(p_ + CC_R); puk[T] = *(const unsigned*)(p_ + CC_K); puv[T] = *(const unsigned*)(p_ + CC_V); \
                pvf[T] = *(const f32x2_t*)(VF + (size_t)(row0 + (T)) * 1024 + c); } while (0)
#pragma unroll
            for (int tt = 0; tt < PFD; ++tt) PF_TOK(tt);
            asm volatile("" ::: "memory");
            if (!(HACK & 4))
#pragma unroll
            for (int tt = 0; tt < 16; ++tt) { const int row = row0 + tt; const size_t o = (size_t)row * 1024 + c;
                if (tt + PFD < 16) { PF_TOK(tt + PFD < 16 ? tt + PFD : 15); }
                asm volatile("" ::: "memory");
                const unsigned ur = pur[tt], uk = puk[tt], uv = puv[tt];
                const float cr[2] = {bflo(ur), bfhi(ur)}, ck[2] = {bflo(uk), bfhi(uk)}, cv[2] = {bflo(uv), bfhi(uv)};
                f32x2_t vf2 = pvf[tt];
                float r[2], k[2], v[2], dec[2], av[2], kk[2], km[2];
#pragma unroll
                for (int e = 0; e < 2; ++e) { r[e] = cr[e] + (pr[e] - cr[e]) * mur[e]; k[e] = ck[e] + (pk[e] - ck[e]) * muk[e]; v[e] = cv[e] + (pv[e] - cv[e]) * muv[e]; pr[e] = cr[e]; pk[e] = ck[e]; pv[e] = cv[e];
                    if (l == 0) vf2[e] = v[e]; else { const float vg = sigmoid_f(accv[e][tt]); v[e] = v[e] + (vf2[e] - v[e]) * vg; }
                    cl[e] += -0.6065306597126334f * sigmoid_f(accw[e][tt]); dec[e] = cl[e]; av[e] = sigmoid_f(acca[e][tt]); kk[e] = k[e] * kkv[e]; km[e] = k[e] * (1.0f + (av[e] - 1.0f) * kav[e]); }
                const float ss = sum32(kk[0] * kk[0] + kk[1] * kk[1]), rn = rsqrtf(fmaxf(ss, 1e-24f)); kk[0] *= rn; kk[1] *= rn;
                if (l == 0) *(f32x2_t*)(VF + o) = vf2;
                *(f32x2_t*)(RW + RS + o) = (f32x2_t){dec[0], dec[1]};
                *(v2u*)(RWU + o) = (v2u){pk2(r[0], km[0]), pk2(r[1], km[1])}; *(v2u*)(RWU + 2 * RS + o) = (v2u){pk2(v[0], accg[0][tt]), pk2(v[1], accg[1][tt])};
                *(v2u*)(RWU + 3 * RS + o) = (v2u){pk2(-kk[0], kk[0] * av[0]), pk2(-kk[1], kk[1] * av[1])}; }
#undef PF_TOK
        }
        asm volatile("s_waitcnt vmcnt(0)" ::: "memory"); __syncthreads();
        __builtin_amdgcn_fence(__ATOMIC_ACQUIRE, "agent"); asm volatile("s_waitcnt vmcnt(0)" ::: "memory");
        if (!(HACK & 2)) rwkv_chunks_of_tile(F, l, tile);
    }
}
struct Args { const float* in[35]; float* out; unsigned char* ws; };
__device__ __forceinline__ void mk_frame(Frame& F, int wv) {
    extern __shared__ __attribute__((aligned(16))) unsigned char lds[];
    kargp kp = (kargp)__builtin_amdgcn_kernarg_segment_ptr(); asm volatile("" : "+s"(kp));
    F.kin = kp;
    F.lds = (LAS unsigned char*)lds;
    F.MISC = (volatile LAS unsigned*)(F.lds + MISC_OFF);
    { int w_ = wv; asm volatile("" : "+s"(w_)); int t_ = (int)__builtin_amdgcn_mbcnt_hi(~0u, __builtin_amdgcn_mbcnt_lo(~0u, (unsigned)w_ * 64u)); asm volatile("" : "+v"(t_)); F.tid = t_; } F.lane = F.tid & 63; F.wave = __builtin_amdgcn_readfirstlane(F.tid >> 6);
    F.G = gridDim.x; { int bx = blockIdx.x; asm volatile("" : "+s"(bx)); F.bx = bx; F.vcu = (F.G % 8 == 0) ? (bx % 8) * (F.G / 8) + bx / 8 : bx; }
    F.out = (float*)kp[35]; F.ws = (unsigned char*)kp[36]; F.ctl = (gu32*)(F.ws + WS_CTL);
}
__device__ __forceinline__ void grid_bar(int wv) {
    Frame F; mk_frame(F, wv);
    XcdBarrier bar; bar.bar = (unsigned*)(F.ctl + CW_BAR); bar.x = xb_xcc_id(); bar.st = F.MISC + 8;
    xcd_barrier(bar);
}
__global__ void __launch_bounds__(NWAVES * 64, 2) mega_fwd(Args args) {
    const int wv = __builtin_amdgcn_readfirstlane((int)threadIdx.x >> 6);
    { Frame F; mk_frame(F, wv);
      for (int u = F.tid; u < (LDS_BYTES - LDSCTL_OFF) / 4; u += NWAVES * 64) ((LAS unsigned*)(F.lds + LDSCTL_OFF))[u] = 0u;
      __syncthreads();
      (void)xcd_barrier_post((unsigned*)(F.ctl + CW_BAR), F.MISC + 8);
      p0_prologue_a(F);
    }
    grid_bar(wv);
    { Frame F; mk_frame(F, wv); p0_prologue_b(F); }
    grid_bar(wv);
#pragma unroll 1
    for (int l = 0; l < NLAYER; ++l) {
#define LAYER_VARS const float* mod = WSP(float, WS_MOD) + (size_t)l * 2 * 24576; const float* xin = l == 0 ? F.kin[I_X] : F.out; (void)mod; (void)xin
        { Frame F; mk_frame(F, wv); LAYER_VARS; if (l == 0) rms_phase(F, F.kin[I_X], mod + 0, mod + 4096); else rms_phase_bf(F, mod + 0, mod + 4096); }
        grid_bar(wv);
        { Frame F; mk_frame(F, wv);
          pg8::Gemm g{WSP(pg8::bf16_t, WS_XN), WSP(pg8::bf16_t, WS_WIN + l * WIN_L), M, NIN, DM}; pg8::StaticOrder S; S.init(M, NIN, F.G, F.bx);
          pg8::EpiCols E{WSP(pg8::bf16_t, WS_COLS), WSP(float, WS_LOWR)};
          pg8::gemm_phase<pg8::EpiCols, pg8::StaticOrder, true, true>(F.lds + RING_OFF, g, S, E, F.tid); }
        grid_bar(wv);
        { Frame F; mk_frame(F, wv); prep_norm(F, l); }
        { Frame F; mk_frame(F, wv); prep_loga(F, l); }
        { Frame F; mk_frame(F, wv); prep_rwkv(F, l); }
        { Frame F; mk_frame(F, wv); prep_vt<0>(F); }
        { Frame F; mk_frame(F, wv); prep_vt<1>(F); }
        { Frame F; mk_frame(F, wv); prep_vt<2>(F); }
        { Frame F; mk_frame(F, wv); prep_vt<3>(F); }
        { Frame F; mk_frame(F, wv); prep_vt<4>(F); }
        { Frame F; mk_frame(F, wv); prep_gla(F); }
        grid_bar(wv);
        { Frame F; mk_frame(F, wv); mixers_v4(F, l, l); }
        grid_bar(wv);
        { Frame F; mk_frame(F, wv); gla_post(F, l); }
        grid_bar(wv);
        { Frame F; mk_frame(F, wv); LAYER_VARS;
          pg8::Gemm g{WSP(pg8::bf16_t, WS_MIXED), WSP(pg8::bf16_t, WS_WOUT + l * WOUT_L), M, DM, DM}; pg8::StaticOrder S; S.init(M, DM, F.G, F.bx);
          pg8::EpiRes E{l == 0 ? (const void*)F.kin[I_X] : (const void*)WSP(bf16, WS_XR), (void*)WSP(bf16, WS_XR), mod + 2 * 4096, l != 0, true};
          pg8::gemm_phase<pg8::EpiRes, pg8::StaticOrder, true, true>(F.lds + RING_OFF, g, S, E, F.tid); }
        grid_bar(wv);
        { Frame F; mk_frame(F, wv); LAYER_VARS; rms_phase_bf(F, mod + 3 * 4096, mod + 4 * 4096); }
        grid_bar(wv);
        { Frame F; mk_frame(F, wv);
          pg8::Gemm g{WSP(pg8::bf16_t, WS_XN), WSP(pg8::bf16_t, WS_W13 + l * W13_L), M, 2 * DFF, DM}; pg8::StaticOrder S; S.init(M, 2 * DFF, F.G, F.bx);
          pg8::EpiSwiglu E{WSP(pg8::bf16_t, WS_HID)};
          pg8::gemm_phase<pg8::EpiSwiglu, pg8::StaticOrder, true, true>(F.lds + RING_OFF, g, S, E, F.tid); }
        grid_bar(wv);
        { Frame F; mk_frame(F, wv); LAYER_VARS;
          pg8::Gemm g{WSP(pg8::bf16_t, WS_HID), WSP(pg8::bf16_t, WS_W2 + l * W2_L), M, DM, DFF}; pg8::StaticOrder S; S.init(M, DM, F.G, F.bx);
          pg8::EpiRes E{(const void*)WSP(bf16, WS_XR), l + 1 < NLAYER ? (void*)WSP(bf16, WS_XR) : (void*)F.out, mod + 5 * 4096, true, l + 1 < NLAYER};
          pg8::gemm_phase<pg8::EpiRes, pg8::StaticOrder, true, true>(F.lds + RING_OFF, g, S, E, F.tid); }
        if (l + 1 < NLAYER) grid_bar(wv);
#undef LAYER_VARS
    }
}

extern "C" void kernel_launch(void* const* d_in, const int* in_sizes, int n_in, void* d_out, int out_size, void* d_ws, size_t ws_size, hipStream_t stream) {
    static int grid = 0;
    if (grid == 0) {
        if (n_in != 35 || in_sizes[0] != M * DM || out_size != M * DM || ws_size < WS_END) { fprintf(stderr, "kernel_launch: unexpected shapes: n_in %d in0 %d out %d ws %zu (need %zu)\n", n_in, n_in > 0 ? in_sizes[0] : -1, out_size, ws_size, (size_t)WS_END); grid = -1; return; }
        int dev = 0, cus = 0, per_cu = 0;
        if (hipGetDevice(&dev) != hipSuccess || hipDeviceGetAttribute(&cus, hipDeviceAttributeMultiprocessorCount, dev) != hipSuccess) { grid = -1; return; }
        if (hipFuncSetAttribute((const void*)mega_fwd, hipFuncAttributeMaxDynamicSharedMemorySize, LDS_BYTES) != hipSuccess) { fprintf(stderr, "kernel_launch: hipFuncSetAttribute failed\n"); grid = -1; return; }
        if (hipOccupancyMaxActiveBlocksPerMultiprocessor(&per_cu, (const void*)mega_fwd, NWAVES * 64, LDS_BYTES) != hipSuccess || per_cu < 1) fprintf(stderr, "kernel_launch: occupancy query says %d\n", per_cu);
        (void)hipGetLastError();
        grid = cus;
    }
    if (grid < 0) return;
    if (hipMemsetAsync((char*)d_ws + WS_CTL, 0, CTL_ZERO_BYTES, stream) != hipSuccess) return;
    Args a{};
    for (int i = 0; i < 35; ++i) a.in[i] = (const float*)d_in[i];
    a.out = (float*)d_out; a.ws = (unsigned char*)d_ws;
    hipLaunchKernelGGL(mega_fwd, dim3(grid), dim3(NWAVES * 64), LDS_BYTES, stream, a);
}
```

```cpp
#include <hip/hip_runtime.h>
#include <cstdio>
#include <cstdint>
namespace pg8 {
#define PG8_LAS __attribute__((address_space(3)))
typedef unsigned short bf16_t;
typedef short bf16x8 __attribute__((ext_vector_type(8)));
typedef float f32x4 __attribute__((ext_vector_type(4)));
typedef unsigned u32x4 __attribute__((ext_vector_type(4)));
constexpr int BM = 256, BK = 64, HALF = 128, HTB = HALF * BK * 2  , STAGE_BYTES = 8 * HTB, NXCD = 8, WGM = 8;

__host__ __device__ __forceinline__ int lds_byte(int r, int c) { const int st = (r >> 4) * 2 + (c >> 5), rr = r & 15, cc = c & 31, ob = rr * 64 + cc * 2; return st * 1024 + (ob ^ (((ob >> 9) & 1) << 5)); }
__host__ __device__ __forceinline__ void stage_rc(int b, int& R, int& C) { const int st = b / 1024, sb = b % 1024, swz = sb ^ (((sb >> 9) & 1) << 5); R = (st >> 1) * 16 + swz / 64; C = (st & 1) * 32 + (swz % 64) / 2; }
__host__ __device__ __forceinline__ int perm32(int rho) { const int n = rho >> 4, i = rho & 15; return 8 * (i >> 2) + 4 * n + (i & 3); }

struct Unit { int pm, pn; };
struct Gemm { const bf16_t* A; const bf16_t* Bt; int M, N, K; };

struct StaticOrder {
    int nM, nN, nwg, G, c;
    __host__ __device__ void init(int M, int N, int G_, int c_) { nM = M / BM; nN = N / BM; nwg = nM * nN; G = G_; c = c_; }
    __host__ __device__ bool next(int i, Unit& u) const {
        const long L = (long)i * G + c; if (L >= nwg) return false;
        int wgid = (int)L; { const int q = nwg / NXCD, r = nwg % NXCD, xcd = wgid % NXCD, off = wgid / NXCD; wgid = (xcd < r ? xcd * (q + 1) : r * (q + 1) + (xcd - r) * q) + off; }
        const int nig = WGM * nN, gid = wgid / nig, fm = gid * WGM, gsz = (nM - fm) < WGM ? (nM - fm) : WGM;
        u.pm = fm + ((wgid % nig) % gsz); u.pn = (wgid % nig) / gsz; return true;
    }
    __device__ __forceinline__ void a_ready(const Unit&) const {}
    __device__ __forceinline__ void done(const Unit&) const {}
};

typedef float f32x2c_t __attribute__((ext_vector_type(2))); typedef __bf16 bf16x2c_t __attribute__((ext_vector_type(2)));
__device__ __forceinline__ unsigned cvt_pk_bf16(float lo, float hi) { const f32x2c_t v = {lo, hi}; return __builtin_bit_cast(unsigned, __builtin_convertvector(v, bf16x2c_t)); }
typedef float f32x2 __attribute__((ext_vector_type(2)));
__device__ __forceinline__ float silu_f(float x) { return x * __builtin_amdgcn_rcpf(1.0f + __builtin_amdgcn_exp2f(-1.4426950408889634f * x)); }
struct EpiCols {
    static constexpr bool PERM = true, AFTER_DRAIN = false;
    bf16_t* O; float* L;
    __device__ __forceinline__ void operator()(const f32x4 (&acc)[2][2][4][2], const Unit& u, int wr, int wc, int fr, int fq) const {
        const int row0 = u.pm * BM + wr * 64 + fr;
        if (u.pn < 41) {
            const int col0 = u.pn * BM + wc * 32 + 8 * fq;
#pragma unroll
            for (int ai = 0; ai < 2; ++ai)
#pragma unroll
                for (int m = 0; m < 4; ++m) { bf16_t* rowp = O + (size_t)(row0 + ai * HALF + m * 16) * 10496 + col0;
#pragma unroll
                    for (int bj = 0; bj < 2; ++bj) { const f32x4 v0 = acc[ai][bj][m][0], v1 = acc[ai][bj][m][1];
                        u32x4 w; w.x = cvt_pk_bf16(v0[0], v0[1]); w.y = cvt_pk_bf16(v0[2], v0[3]); w.z = cvt_pk_bf16(v1[0], v1[1]); w.w = cvt_pk_bf16(v1[2], v1[3]);
                        *(u32x4*)(rowp + bj * HALF) = w; } }
        } else {
            const int col0 = wc * 32 + 8 * fq;
#pragma unroll
            for (int ai = 0; ai < 2; ++ai)
#pragma unroll
                for (int m = 0; m < 4; ++m) { float* rowp = L + (size_t)(row0 + ai * HALF + m * 16) * 256 + col0;
#pragma unroll
                    for (int bj = 0; bj < 2; ++bj) { *(f32x4*)(rowp + bj * HALF) = acc[ai][bj][m][0]; *(f32x4*)(rowp + bj * HALF + 4) = acc[ai][bj][m][1]; } }
        }
    }
};
struct EpiRes {
    static constexpr bool PERM = true, AFTER_DRAIN = false;
    const void* base; void* out; const float* gate; bool base_bf, out_bf;
    __device__ __forceinline__ void operator()(const f32x4 (&acc)[2][2][4][2], const Unit& u, int wr, int wc, int fr, int fq) const {
        const int row0 = u.pm * BM + wr * 64 + fr, col0 = u.pn * BM + wc * 32 + 8 * fq;
        const float* gp = gate + (size_t)(u.pm >> 5) * 24576 + col0;
        f32x4 gv[2][2];
#pragma unroll
        for (int bj = 0; bj < 2; ++bj)
#pragma unroll
            for (int n = 0; n < 2; ++n) gv[bj][n] = *(const f32x4*)(gp + bj * HALF + n * 4);
#pragma unroll
        for (int ai = 0; ai < 2; ++ai) {
            f32x4 r[4][2][2];
            if (base_bf) {
#pragma unroll
                for (int m = 0; m < 4; ++m)
#pragma unroll
                    for (int bj = 0; bj < 2; ++bj) { const u32x4 w = *(const u32x4*)((const bf16_t*)base + (size_t)(row0 + ai * HALF + m * 16) * 4096 + col0 + bj * HALF);
                        r[m][bj][0] = (f32x4){__builtin_bit_cast(float, w.x << 16), __builtin_bit_cast(float, w.x & 0xffff0000u), __builtin_bit_cast(float, w.y << 16), __builtin_bit_cast(float, w.y & 0xffff0000u)};
                        r[m][bj][1] = (f32x4){__builtin_bit_cast(float, w.z << 16), __builtin_bit_cast(float, w.z & 0xffff0000u), __builtin_bit_cast(float, w.w << 16), __builtin_bit_cast(float, w.w & 0xffff0000u)}; }
            } else {
#pragma unroll
                for (int m = 0; m < 4; ++m)
#pragma unroll
                    for (int bj = 0; bj < 2; ++bj)
#pragma unroll
                        for (int n = 0; n < 2; ++n) r[m][bj][n] = *(const f32x4*)((const float*)base + (size_t)(row0 + ai * HALF + m * 16) * 4096 + col0 + bj * HALF + n * 4);
            }
#pragma unroll
            for (int m = 0; m < 4; ++m)
#pragma unroll
                for (int bj = 0; bj < 2; ++bj)
#pragma unroll
                    for (int n = 0; n < 2; ++n) r[m][bj][n] = r[m][bj][n] + gv[bj][n] * acc[ai][bj][m][n];
            if (out_bf) {
#pragma unroll
                for (int m = 0; m < 4; ++m)
#pragma unroll
                    for (int bj = 0; bj < 2; ++bj) { const f32x4 v0 = r[m][bj][0], v1 = r[m][bj][1];
                        u32x4 w; w.x = cvt_pk_bf16(v0[0], v0[1]); w.y = cvt_pk_bf16(v0[2], v0[3]); w.z = cvt_pk_bf16(v1[0], v1[1]); w.w = cvt_pk_bf16(v1[2], v1[3]);
                        *(u32x4*)((bf16_t*)out + (size_t)(row0 + ai * HALF + m * 16) * 4096 + col0 + bj * HALF) = w; }
            } else {
#pragma unroll
                for (int m = 0; m < 4; ++m)
#pragma unroll
                    for (int bj = 0; bj < 2; ++bj)
#pragma unroll
                        for (int n = 0; n < 2; ++n) *(f32x4*)((float*)out + (size_t)(row0 + ai * HALF + m * 16) * 4096 + col0 + bj * HALF + n * 4) = r[m][bj][n];
            }
            asm volatile("" ::: "memory");
        }
    }
};
struct EpiSwiglu {
    static constexpr bool PERM = true, AFTER_DRAIN = false;
    bf16_t* H;
    __device__ __forceinline__ void operator()(const f32x4 (&acc)[2][2][4][2], const Unit& u, int wr, int wc, int fr, int fq) const {
        const int row0 = u.pm * BM + wr * 64 + fr, col0 = u.pn * HALF + wc * 32 + 8 * fq;
#pragma unroll
        for (int ai = 0; ai < 2; ++ai)
#pragma unroll
            for (int m = 0; m < 4; ++m) { bf16_t* rowp = H + (size_t)(row0 + ai * HALF + m * 16) * 11008 + col0;
                const f32x4 a0 = acc[ai][0][m][0], a1 = acc[ai][0][m][1], b0 = acc[ai][1][m][0], b1 = acc[ai][1][m][1];
                u32x4 w; w.x = cvt_pk_bf16(silu_f(a0[0]) * b0[0], silu_f(a0[1]) * b0[1]); w.y = cvt_pk_bf16(silu_f(a0[2]) * b0[2], silu_f(a0[3]) * b0[3]);
                w.z = cvt_pk_bf16(silu_f(a1[0]) * b1[0], silu_f(a1[1]) * b1[1]); w.w = cvt_pk_bf16(silu_f(a1[2]) * b1[2], silu_f(a1[3]) * b1[3]);
                *(u32x4*)rowp = w; }
    }
};
template <class Epi, class Sched, bool ALIGN_EPI = false, bool SP2 = false>
__device__ __forceinline__ void gemm_phase(PG8_LAS unsigned char* lds, const Gemm g, const Sched& S, const Epi& E, int tid_in) {
    int tid_ = tid_in; asm volatile("" : "+v"(tid_));
    const int tid = tid_, wid = __builtin_amdgcn_readfirstlane(tid >> 6), lane = tid & 63, wr = wid >> 2, wc = wid & 3, fr = lane & 15, fq = lane >> 4;
    const int K = g.K, nt = K / BK;
    unsigned voffA[2], voffB[2];
#pragma unroll
    for (int i = 0; i < 2; ++i) { int R, C; stage_rc(tid * 16 + i * 8192, R, C); const int Rb = Epi::PERM ? ((R & ~31) + perm32(R & 31)) : R;
        voffA[i] = (unsigned)(R * K + C) * 2u; voffB[i] = (unsigned)(Rb * K + C) * 2u; }
    const size_t kstep = (size_t)(BK * 2);
    const size_t hstep = (size_t)HALF * K * 2;
    const size_t tstep = 2 * hstep;
    const unsigned ldsw = (unsigned)wid * 1024u;
    const int aoff = lds_byte(wr * 64 + fr, fq * 8), boff = lds_byte(wc * 32 + fr, fq * 8);
#define PG8_SA(b, h) (((b) * 2 + (h)) * HTB)
#define PG8_SB(b, h) ((4 + (b) * 2 + (h)) * HTB)
#define PG8_STAGE(bufoff, gbase, voff) do { _Pragma("unroll") for (int _i = 0; _i < 2; ++_i) \
        __builtin_amdgcn_global_load_lds((const unsigned*)((const char*)(gbase) + (voff)[_i]), (PG8_LAS unsigned*)(lds + (bufoff) + ldsw + _i * 8192), 16, 0, 0); } while (0)
#define PG8_LDA(dst, b, h) do { _Pragma("unroll") for (int m = 0; m < 4; ++m) _Pragma("unroll") for (int k = 0; k < 2; ++k) dst[m][k] = *(const PG8_LAS bf16x8*)(lds + PG8_SA(b, h) + aoff + m * 2048 + k * 1024); } while (0)
#define PG8_LDB(dst, b, h) do { _Pragma("unroll") for (int n = 0; n < 2; ++n) _Pragma("unroll") for (int k = 0; k < 2; ++k) dst[n][k] = *(const PG8_LAS bf16x8*)(lds + PG8_SB(b, h) + boff + n * 2048 + k * 1024); } while (0)
#define PG8_MMA(ai, bj, At, Bt) do { __builtin_amdgcn_s_setprio(1); _Pragma("unroll") for (int m = 0; m < 4; ++m) _Pragma("unroll") for (int n = 0; n < 2; ++n) _Pragma("unroll") for (int k = 0; k < 2; ++k) \
        acc[ai][bj][m][n] = __builtin_amdgcn_mfma_f32_16x16x32_bf16(Bt[n][k], At[m][k], acc[ai][bj][m][n], 0, 0, 0); __builtin_amdgcn_s_setprio(0); } while (0)
#define PG8_WAIT_V(n) asm volatile("s_waitcnt vmcnt(" #n ")" ::: "memory")
#define PG8_WAIT_L(n) asm volatile("s_waitcnt lgkmcnt(" #n ")" ::: "memory")
#define PG8_BAR __builtin_amdgcn_s_barrier()
#define PG8_SCHED __builtin_amdgcn_sched_barrier(0)
    Unit cur, nxt; int ui = 0;
    if (!S.next(0, cur)) return;
    f32x4 acc[2][2][4][2];
#pragma unroll
    for (int a = 0; a < 2; ++a)
#pragma unroll
        for (int b = 0; b < 2; ++b)
#pragma unroll
            for (int m = 0; m < 4; ++m)
#pragma unroll
                for (int n = 0; n < 2; ++n) acc[a][b][m][n] = (f32x4){0.f, 0.f, 0.f, 0.f};
    bf16x8 At[4][2], B0[2][2], B1[2][2];
    const char* cA = (const char*)g.A + (size_t)cur.pm * tstep; const char* cB = (const char*)g.Bt + (size_t)cur.pn * tstep;
    S.a_ready(cur);
    if constexpr (SP2) {
        PG8_STAGE(PG8_SB(0, 0), cB, voffB); PG8_STAGE(PG8_SB(0, 1), cB + hstep, voffB); PG8_STAGE(PG8_SA(0, 0), cA, voffA); PG8_STAGE(PG8_SA(0, 1), cA + hstep, voffA);
        if (wr == 1) PG8_BAR;
        PG8_WAIT_V(2); PG8_BAR;
        PG8_STAGE(PG8_SB(1, 0), cB + kstep, voffB); PG8_STAGE(PG8_SA(1, 0), cA + kstep, voffA); PG8_STAGE(PG8_SB(1, 1), cB + hstep + kstep, voffB);
        PG8_WAIT_V(6); PG8_BAR;
    } else {
        PG8_STAGE(PG8_SB(0, 0), cB, voffB); PG8_STAGE(PG8_SA(0, 0), cA, voffA); PG8_STAGE(PG8_SB(0, 1), cB + hstep, voffB); PG8_STAGE(PG8_SA(0, 1), cA + hstep, voffA);
        if (wr == 1) PG8_BAR;
        PG8_WAIT_V(4); PG8_BAR;
        PG8_STAGE(PG8_SB(1, 0), cB + kstep, voffB); PG8_STAGE(PG8_SA(1, 0), cA + kstep, voffA); PG8_STAGE(PG8_SB(1, 1), cB + hstep + kstep, voffB);
        PG8_WAIT_V(6); PG8_BAR;
    }
    for (;;) {
        const bool has_next = S.next(ui + 1, nxt);
        const char* nA = has_next ? (const char*)g.A + (size_t)nxt.pm * tstep : cA; const char* nB = has_next ? (const char*)g.Bt + (size_t)nxt.pn * tstep : cB;
        for (int t = 0; t < nt; t += 2) {
            const bool last = (t == nt - 2);
            const char* a1 = cA + (size_t)(t + 1) * kstep;
            const char* a2 = last ? nA : cA + (size_t)(t + 2) * kstep; const char* b2 = last ? nB : cB + (size_t)(t + 2) * kstep;
            const char* a3 = a2 + kstep; const char* b3 = b2 + kstep;
            if (last && has_next) S.a_ready(nxt);
            if constexpr (SP2) {
            PG8_LDB(B0, 0, 0); PG8_LDB(B1, 0, 1); PG8_SCHED; PG8_LDA(At, 0, 0); PG8_STAGE(PG8_SA(1, 1), a1 + hstep, voffA);
            PG8_WAIT_V(8); PG8_WAIT_L(0); PG8_BAR; PG8_MMA(0, 0, At, B0); PG8_MMA(0, 1, At, B1); PG8_BAR; PG8_SCHED;
            PG8_LDA(At, 0, 1); PG8_STAGE(PG8_SB(0, 0), b2, voffB); PG8_STAGE(PG8_SB(0, 1), b2 + hstep, voffB); PG8_STAGE(PG8_SA(0, 0), a2, voffA);
            PG8_WAIT_V(8); PG8_WAIT_L(0); PG8_BAR; PG8_MMA(1, 0, At, B0); PG8_MMA(1, 1, At, B1); PG8_BAR; PG8_SCHED;
            PG8_LDB(B0, 1, 0); PG8_LDB(B1, 1, 1); PG8_SCHED; PG8_LDA(At, 1, 0); PG8_STAGE(PG8_SA(0, 1), a2 + hstep, voffA);
            PG8_WAIT_V(8); PG8_WAIT_L(0); PG8_BAR; PG8_MMA(0, 0, At, B0); PG8_MMA(0, 1, At, B1); PG8_BAR; PG8_SCHED;
            PG8_LDA(At, 1, 1); PG8_STAGE(PG8_SB(1, 0), b3, voffB); PG8_STAGE(PG8_SB(1, 1), b3 + hstep, voffB); PG8_STAGE(PG8_SA(1, 0), a3, voffA);
            PG8_WAIT_V(8); PG8_WAIT_L(0); PG8_BAR; PG8_MMA(1, 0, At, B0); PG8_MMA(1, 1, At, B1); PG8_BAR; PG8_SCHED;
            } else {
            PG8_LDB(B0, 0, 0); PG8_SCHED; PG8_LDA(At, 0, 0); PG8_STAGE(PG8_SA(1, 1), a1 + hstep, voffA);
            PG8_WAIT_L(8); PG8_BAR; PG8_WAIT_L(0); PG8_MMA(0, 0, At, B0); PG8_BAR; PG8_SCHED;
            PG8_LDB(B1, 0, 1); PG8_STAGE(PG8_SB(0, 0), b2, voffB);
            PG8_BAR; PG8_WAIT_L(0); PG8_MMA(0, 1, At, B1); PG8_BAR;
            PG8_LDA(At, 0, 1); PG8_STAGE(PG8_SA(0, 0), a2, voffA);
            PG8_BAR; PG8_WAIT_L(0); PG8_MMA(1, 0, At, B0); PG8_BAR; PG8_SCHED;
            PG8_STAGE(PG8_SB(0, 1), b2 + hstep, voffB);
            PG8_WAIT_V(6); PG8_BAR; PG8_MMA(1, 1, At, B1); PG8_BAR;
            PG8_LDB(B0, 1, 0); PG8_SCHED; PG8_LDA(At, 1, 0); PG8_STAGE(PG8_SA(0, 1), a2 + hstep, voffA);
            PG8_WAIT_L(8); PG8_BAR; PG8_WAIT_L(0); PG8_MMA(0, 0, At, B0); PG8_BAR; PG8_SCHED;
            PG8_LDB(B1, 1, 1); PG8_STAGE(PG8_SB(1, 0), b3, voffB);
            PG8_BAR; PG8_WAIT_L(0); PG8_MMA(0, 1, At, B1); PG8_BAR;
            PG8_LDA(At, 1, 1); PG8_STAGE(PG8_SA(1, 0), a3, voffA);
            PG8_BAR; PG8_WAIT_L(0); PG8_MMA(1, 0, At, B0); PG8_BAR; PG8_SCHED;
            PG8_STAGE(PG8_SB(1, 1), b3 + hstep, voffB);
            PG8_WAIT_V(6); PG8_BAR; PG8_MMA(1, 1, At, B1); PG8_BAR;
            }
        }
        if constexpr (ALIGN_EPI) { if (wr == 0) PG8_BAR; }
        if constexpr (!Epi::AFTER_DRAIN) { unsigned z_ = 0u; asm volatile("" : "+s"(z_)); const int le_ = (int)__builtin_amdgcn_mbcnt_hi(~0u, __builtin_amdgcn_mbcnt_lo(~0u, z_));
          E(acc, cur, wr, wc, le_ & 15, le_ >> 4); S.done(cur); }
        if (!has_next) break;
#pragma unroll
        for (int a = 0; a < 2; ++a)
#pragma unroll
            for (int b = 0; b < 2; ++b)
#pragma unroll
                for (int m = 0; m < 4; ++m)
#pragma unroll
                    for (int n = 0; n < 2; ++n) acc[a][b][m][n] = (f32x4){0.f, 0.f, 0.f, 0.f};
        cur = nxt; cA = nA; cB = nB; ++ui;
        if constexpr (ALIGN_EPI) { if (wr == 1) PG8_BAR; }
    }
    PG8_WAIT_V(0);
    if constexpr (!ALIGN_EPI) { if (wr == 0) PG8_BAR; }
    PG8_BAR;
    if constexpr (Epi::AFTER_DRAIN) { E.fused(acc, cur, wr, wc, fr, fq, lds, wid, lane); S.done(cur); }
#undef PG8_SA
#undef PG8_SB
#undef PG8_STAGE
#undef PG8_LDA
#undef PG8_LDB
#undef PG8_MMA
#undef PG8_WAIT_V
#undef PG8_WAIT_L
#undef PG8_BAR
#undef PG8_SCHED
}
}
constexpr int BATCH = 2, SEQ = 8192, DM = 4096, M = BATCH * SEQ, DFF = 11008, NLAYER = 2;
constexpr int P_IN = 10704, NIN = 10752, NMAIN = 10496;
constexpr int CA_Q = 0, CA_K = 1024, CA_V = 2048;
constexpr int CB_Q = 3072, CB_K = 3584, CB_V = 4096, CB_G = 5120;
constexpr int CC_R = 6144, CC_K = 7168, CC_V = 8192;
constexpr int CD_Q = 9216, CD_K = 10240, CD_V = 10368;
constexpr float LOG2E = 1.4426950408889634f;
constexpr float QSCALE = 0.125f * LOG2E;
constexpr int NWAVES = 8;

constexpr size_t MiB = 1u << 20;
constexpr size_t WS_CTL = 0, CTL_ZERO_BYTES = 1 * MiB;
constexpr size_t WS_MODP = 2 * MiB;
constexpr size_t WS_MOD = 14 * MiB;
constexpr size_t WS_TAB = 15 * MiB;
constexpr size_t WS_WIN = 16 * MiB, WIN_L = 84 * MiB;
constexpr size_t WS_WOUT = 184 * MiB, WOUT_L = 32 * MiB;
constexpr size_t WS_W13 = 248 * MiB, W13_L = 172 * MiB;
constexpr size_t WS_W2 = 592 * MiB, W2_L = 86 * MiB;
constexpr size_t WS_XN = 764 * MiB;
constexpr size_t WS_COLS = 892 * MiB;
constexpr size_t WS_LOWR = 1220 * MiB;
constexpr size_t WS_HID = 892 * MiB;
constexpr size_t WS_QKA = 1236 * MiB;
constexpr size_t WS_QKD = 1300 * MiB;
constexpr size_t WS_LOGA = 1336 * MiB;
constexpr size_t WS_RW = 1368 * MiB, RW_ONE = 64 * MiB;
constexpr size_t WS_VFIRST = 1816 * MiB;
constexpr size_t WS_MIXED = 1880 * MiB;
constexpr int VROW = SEQ + 64;
constexpr size_t WS_VTA = 2008 * MiB;
constexpr size_t WS_VTD = 2041 * MiB;
constexpr size_t WS_QDEC = 2046 * MiB, WS_KDT = 2062 * MiB, WS_AM = 2078 * MiB, WS_EBL = 2086 * MiB;
constexpr size_t WS_VTB = 2087 * MiB;
constexpr size_t WS_RWC = 2120 * MiB;
constexpr size_t WS_OB = 2446 * MiB;
constexpr size_t WS_PSG = 2478 * MiB;
constexpr size_t WS_WF = 2479 * MiB;
constexpr size_t WS_XR = 2480 * MiB;
constexpr size_t WS_END = 2608 * MiB;
constexpr int CW_BAR = 4096;
constexpr int CW_Q = 16384;

constexpr int RING_OFF = 0, RING_BYTES = 131072;
constexpr int LDSCTL_OFF = RING_BYTES, MISC_OFF = LDSCTL_OFF + 320;
constexpr int LDS_BYTES = 147456;

#define GAS __attribute__((address_space(1)))
#define LAS __attribute__((address_space(3)))
typedef unsigned short bf16;
typedef unsigned v4u __attribute__((ext_vector_type(4)));
typedef unsigned v2u __attribute__((ext_vector_type(2)));
typedef float f32x4 __attribute__((ext_vector_type(4)));
typedef short bf16x8 __attribute__((ext_vector_type(8)));
typedef GAS unsigned gu32;
#define RLX_AGENT __ATOMIC_RELAXED, __HIP_MEMORY_SCOPE_AGENT
#define LDS_WAIT() asm volatile("s_waitcnt lgkmcnt(0)" ::: "memory")
#define VM_WAIT() asm volatile("s_waitcnt vmcnt(0)" ::: "memory")
typedef float f32x2_t __attribute__((ext_vector_type(2))); typedef __bf16 bf16x2_t __attribute__((ext_vector_type(2)));
__device__ __forceinline__ unsigned pk2(float lo, float hi) { const f32x2_t v = {lo, hi}; return __builtin_bit_cast(unsigned, __builtin_convertvector(v, bf16x2_t)); }
__device__ __forceinline__ unsigned f2bf(float f) { return pk2(f, f) & 0xffffu; }
__device__ __forceinline__ float bf2f(unsigned short h) { return __builtin_bit_cast(float, (unsigned)h << 16); }
__device__ __forceinline__ float bflo(unsigned w) { return __builtin_bit_cast(float, w << 16); }
__device__ __forceinline__ float bfhi(unsigned w) { return __builtin_bit_cast(float, w & 0xffff0000u); }
template <int CTRL> __device__ __forceinline__ float dpp_f(float v) { return __builtin_bit_cast(float, __builtin_amdgcn_update_dpp(0, __builtin_bit_cast(int, v), CTRL, 0xF, 0xF, true)); }
__device__ __forceinline__ float sum8(float v) {
    v += dpp_f<0xB1>(v); v += dpp_f<0x4E>(v); v += dpp_f<0x141>(v); return v; }
__device__ __forceinline__ float sum32(float v) {
    v = sum8(v); v += dpp_f<0x140>(v); v += __builtin_bit_cast(float, __builtin_amdgcn_ds_swizzle(__builtin_bit_cast(int, v), 0x401F)); return v; }
__device__ __forceinline__ float wave_sum(float v) {
    v = sum8(v); v += dpp_f<0x140>(v);
    v += __builtin_bit_cast(float, __builtin_amdgcn_ds_swizzle(__builtin_bit_cast(int, v), 0x401F));
    { const int u = __builtin_bit_cast(int, v); v = __builtin_bit_cast(float, __builtin_amdgcn_readlane(u, 0)) + __builtin_bit_cast(float, __builtin_amdgcn_readlane(u, 32)); }
    return v;
}
__device__ __forceinline__ float sigmoid_f(float x) { return __builtin_amdgcn_rcpf(1.0f + __builtin_amdgcn_exp2f(-LOG2E * x)); }
__device__ __forceinline__ float silu_g(float x) { return x * sigmoid_f(x); }
__device__ __forceinline__ void unpack8(const v4u r, float (&f)[8]) { f[0] = bflo(r.x); f[1] = bfhi(r.x); f[2] = bflo(r.y); f[3] = bfhi(r.y); f[4] = bflo(r.z); f[5] = bfhi(r.z); f[6] = bflo(r.w); f[7] = bfhi(r.w); }
__device__ __forceinline__ v4u pack8(const float (&f)[8]) { v4u o; o.x = pk2(f[0], f[1]); o.y = pk2(f[2], f[3]); o.z = pk2(f[4], f[5]); o.w = pk2(f[6], f[7]); return o; }

#define XB_TMO      128
#define XB_XCNT(j)  (256  + 64 * (j))
#define XB_XSUB(j)  (1280 + 64 * (j))
#define XB_XGEN(j)  (2304 + 64 * (j))
#define XB_TOP      3328
#define XB_TOPGEN   3392
#define XCD_BAR_WORDS 3456
#define XB_SPIN_CAP (1u << 23)

__device__ __forceinline__ unsigned xb_ld(unsigned* p)              { return __hip_atomic_load(p, __ATOMIC_RELAXED, __HIP_MEMORY_SCOPE_AGENT); }
__device__ __forceinline__ unsigned xb_add(unsigned* p, unsigned v) { return __hip_atomic_fetch_add(p, v, __ATOMIC_RELAXED, __HIP_MEMORY_SCOPE_AGENT); }
__device__ __forceinline__ unsigned xb_xcc_id() { return (unsigned)__builtin_amdgcn_s_getreg((3 << 11) | 20) & 0xFu; }
#define XB_SPIN(cond, bar) do { unsigned _sp = 0; while (cond) { __builtin_amdgcn_s_sleep(1); \
    if ((++_sp & 255u) == 0u) { if (xb_ld(&(bar)[XB_TMO])) break; if (_sp > XB_SPIN_CAP) { atomicAdd(&(bar)[XB_TMO], 1u); break; } } } } while (0)

struct XcdBarrier {
    unsigned* bar; unsigned x;
    volatile LAS unsigned* st;
};

__device__ __forceinline__ XcdBarrier xcd_barrier_post(unsigned* bar, volatile LAS unsigned* st) {
    XcdBarrier b; b.bar = bar; b.x = xb_xcc_id(); b.st = st;
    if (threadIdx.x == 0) (void)xb_add(&bar[XB_XCNT(b.x)], 1u);
    return b;
}
__device__ __forceinline__ void xcd_barrier_complete(unsigned* bar, unsigned x, unsigned& nloc, unsigned& nx) {
    const unsigned G = gridDim.x * gridDim.y * gridDim.z;
    unsigned sum, cnt, mine, sp = 0u;
    for (;;) {
        sum = 0u; cnt = 0u; mine = 0u;
#pragma unroll
        for (unsigned j = 0; j < 16; ++j) { const unsigned c = xb_ld(&bar[XB_XCNT(j)]); sum += c; cnt += (c > 0u) ? 1u : 0u; mine = (j == x) ? c : mine; }
        if (sum == G) break;
        __builtin_amdgcn_s_sleep(1);
        if ((++sp & 255u) == 0u) { if (xb_ld(&bar[XB_TMO])) break; if (sp > XB_SPIN_CAP) { atomicAdd(&bar[XB_TMO], 1u); break; } }
    }
    nloc = mine > 0u ? mine : 1u; nx = cnt > 0u ? cnt : 1u;
}

__device__ __forceinline__ void xcd_barrier(const XcdBarrier& b) {
    asm volatile("s_waitcnt vmcnt(0)" ::: "memory");
    __syncthreads();
    if (threadIdx.x == 0) {
        unsigned* bar = b.bar;
        __builtin_amdgcn_s_waitcnt(0);
        unsigned nloc = b.st[0], nx = b.st[1];
        if (nloc == 0u) { xcd_barrier_complete(bar, b.x, nloc, nx); b.st[0] = nloc; b.st[1] = nx; }
        const unsigned old = xb_add(&bar[XB_XSUB(b.x)], 1u);
        const unsigned gen = old / nloc;
        if (old + 1u == (gen + 1u) * nloc) {
            __builtin_amdgcn_fence(__ATOMIC_RELEASE, "agent");
            asm volatile("s_waitcnt vmcnt(0)" ::: "memory");
            const unsigned og = xb_add(&bar[XB_TOP], 1u);
            const unsigned tg = og / nx;
            if (og + 1u == (tg + 1u) * nx) xb_add(&bar[XB_TOPGEN], 1u);
            else XB_SPIN(xb_ld(&bar[XB_TOPGEN]) == tg, bar);
            __builtin_amdgcn_fence(__ATOMIC_ACQUIRE, "agent");
            xb_add(&bar[XB_XGEN(b.x)], 1u);
            asm volatile("s_waitcnt vmcnt(0)" ::: "memory");
        } else {
            XB_SPIN(xb_ld(&bar[XB_XGEN(b.x)]) == gen, bar);
            __builtin_amdgcn_fence(__ATOMIC_ACQUIRE, "agent");
            asm volatile("s_waitcnt vmcnt(0)" ::: "memory");
        }
    }
    __syncthreads();
}

typedef const float* const __attribute__((address_space(4)))* kargp;
struct Frame {
    LAS unsigned char* lds;
    volatile LAS unsigned* MISC;
    gu32* ctl;
    int tid, lane, wave;
    int vcu, G, bx;
    kargp kin;
    float* out;
    unsigned char* ws;
};
enum { I_X = 0, I_C, I_RELB, I_ADAW, I_ADAB, I_WIN, I_WOUT, I_DQN, I_DKN, I_DLAM, I_DSUB, I_GGU, I_GGB, I_GON, I_RMU, I_RWUP, I_RW0, I_RAUP, I_RA0, I_RGUP,
       I_RKK, I_RKA, I_RRK, I_RLNW, I_RLNB, I_VRD, I_VRMU, I_VRUP, I_VR0, I_SQN, I_SKN, I_SSINK, I_W1, I_W3, I_W2 };

#define WSP(T, off) ((T*)(F.ws + (off)))
__device__ __forceinline__ void relaunder_tid(Frame& F) { int t = F.tid; asm volatile("" : "+v"(t)); F.tid = t; F.lane = t & 63; F.wave = __builtin_amdgcn_readfirstlane(t >> 6); }
__device__ __forceinline__ void relaunder(Frame& F) { kargp p = F.kin; asm volatile("" : "+s"(p)); F.kin = p; }

__device__ __forceinline__ void conv_item(const float* src, int ld, int col0, int ncols, int K, bf16* WT, int row0, int kb, LAS float* scr, int lane) {
    const int k0 = 64 * kb;
    { const int n = lane & 31; const bool ok = src != nullptr && n < ncols; const float* sp = src + (size_t)(k0 + (lane >> 5)) * ld + col0 + n; float v[32];
#pragma unroll
      for (int i = 0; i < 32; ++i) v[i] = ok ? sp[(size_t)(2 * i) * ld] : 0.f;
#pragma unroll
      for (int i = 0; i < 32; ++i) scr[(2 * i + (lane >> 5)) * 33 + n] = v[i]; }
    LDS_WAIT(); asm volatile("" ::: "memory");
    const int c = lane & 7;
#pragma unroll
    for (int j = 0; j < 4; ++j) { const int n = (lane >> 3) + 8 * j; const LAS float* s = scr + (8 * c) * 33 + n;
        v4u o; o.x = pk2(s[0 * 33], s[1 * 33]); o.y = pk2(s[2 * 33], s[3 * 33]); o.z = pk2(s[4 * 33], s[5 * 33]); o.w = pk2(s[6 * 33], s[7 * 33]);
        if (n < ncols) *(GAS v4u*)(WT + (size_t)(row0 + n) * K + k0 + 8 * c) = o; }
    LDS_WAIT(); asm volatile("" ::: "memory");
}
__device__ __forceinline__ int t5_bucket(int d) {
    if (d < 16) return d;
    int v = 16 + (int)(logf((float)d * (1.0f / 16.0f)) / logf(8.0f) * 16.0f);
    return v < 31 ? v : 31;
}
__device__ __forceinline__ void p0_prologue_a(Frame& F) {
    const int gw = F.vcu * NWAVES + F.wave, NGW = F.G * NWAVES;
    LAS float* ldsf = (LAS float*)(F.lds + RING_OFF);
    { float cv[16];
#pragma unroll
      for (int q = 0; q < 16; ++q) cv[q] = F.kin[I_C][F.tid + NWAVES * 64 * q];
#pragma unroll
      for (int q = 0; q < 16; ++q) ldsf[F.tid + NWAVES * 64 * q] = silu_g(cv[q]); }
    __syncthreads();
    float* MODP = WSP(float, WS_MODP);
    for (int it = gw; it < 6144; it += NGW) {
        const int l = it / 3072, rem = it % 3072, kc = rem / 96, ng = rem % 96, n0 = 256 * ng + 4 * F.lane;
        const float* w = F.kin[I_ADAW] + ((size_t)l * DM + kc * 128) * 24576 + n0;
        f32x4 a0 = {0.f, 0.f, 0.f, 0.f}, a1 = {0.f, 0.f, 0.f, 0.f};
#pragma unroll 16
        for (int k = 0; k < 128; ++k) { const f32x4 wv = *(const f32x4*)(w + (size_t)k * 24576); const float s0 = ldsf[kc * 128 + k], s1 = ldsf[DM + kc * 128 + k]; a0 += wv * s0; a1 += wv * s1; }
        *(f32x4*)(MODP + ((size_t)(l * 32 + kc) * 2 + 0) * 24576 + n0) = a0;
        *(f32x4*)(MODP + ((size_t)(l * 32 + kc) * 2 + 1) * 24576 + n0) = a1;
    }
    for (int idx = F.bx * (NWAVES * 64) + F.tid; idx < NLAYER * 448 * 64; idx += F.G * NWAVES * 64) {
        const int l = idx / (448 * 64), rem = idx % (448 * 64), blk = rem >> 6, ln = rem & 63, n = ln & 15, g = ln >> 4;
        const int m = blk < 384 ? blk >> 7 : 3, nt = blk < 384 ? (blk & 127) >> 1 : blk - 384, ks = blk < 384 ? (blk & 1) : 0;
        const float* W = m == 0 ? F.kin[I_RWUP] + (size_t)l * 65536 : (m == 1 ? F.kin[I_RAUP] + (size_t)l * 65536 : (m == 2 ? F.kin[I_RGUP] + (size_t)l * 65536 : (l ? F.kin[I_VRUP] + (size_t)(l - 1) * 32768 : nullptr)));
        float f[8];
#pragma unroll
        for (int e = 0; e < 8; ++e) f[e] = W != nullptr ? W[(size_t)(32 * ks + 8 * g + e) * 1024 + 16 * nt + n] : 0.f;
        *(v4u*)(WSP(bf16, WS_WF) + ((size_t)(l * 448 + blk) * 64 + ln) * 8) = pack8(f);
    }
    __syncthreads();
    LAS float* scr = (LAS float*)(F.lds + RING_OFF + F.wave * 16384);
    constexpr int I_IN = 337 * 64, I_OUT = 128 * 64, I_13 = 688 * 64, I_2 = 128 * 172, I_L = I_IN + I_OUT + I_13 + I_2;
    for (int it = gw; it < NLAYER * I_L; it += NGW) {
        const int l = it / I_L; int r = it % I_L;
        if (r < I_IN) {
            const int kb = r / 337, cb = r % 337; const float* src = F.kin[I_WIN] + (size_t)l * DM * P_IN; int ld = P_IN, col0, row0, nc = 32;
            if (cb < 192) { col0 = 32 * cb; row0 = 32 * cb; }
            else if (cb < 288) { col0 = 6160 + 32 * (cb - 192); row0 = 6144 + 32 * (cb - 192); }
            else if (cb < 328) { col0 = 9424 + 32 * (cb - 288); row0 = 9216 + 32 * (cb - 288); }
            else if (cb == 328) { col0 = 6144; row0 = 10496; nc = 16; }
            else if (cb < 335) { col0 = 9232 + 32 * (cb - 329); row0 = 10512 + 32 * (cb - 329); }
            else if (cb == 335) { src = l ? F.kin[I_VRD] + (size_t)(l - 1) * DM * 32 : nullptr; ld = 32; col0 = 0; row0 = 10704; }
            else { src = nullptr; col0 = 0; row0 = 10736; nc = 16; }
            conv_item(src, ld, col0, nc, DM, WSP(bf16, WS_WIN + l * WIN_L), row0, kb, scr, F.lane); continue; }
        r -= I_IN;
        if (r < I_OUT) { const int kb = r / 128, cb = r % 128; conv_item(F.kin[I_WOUT] + (size_t)l * DM * DM, DM, 32 * cb, 32, DM, WSP(bf16, WS_WOUT + l * WOUT_L), 32 * cb, kb, scr, F.lane); continue; }
        r -= I_OUT;
        if (r < I_13) { const int kb = r / 688, cb = r % 688, pn = cb >> 3, wi = cb & 7;
            const float* src = (wi < 4 ? F.kin[I_W1] : F.kin[I_W3]) + (size_t)l * DM * DFF;
            conv_item(src, DFF, 128 * pn + 32 * (wi & 3), 32, DM, WSP(bf16, WS_W13 + l * W13_L), 32 * cb, kb, scr, F.lane); continue; }
        r -= I_13;
        { const int kb = r / 128, cb = r % 128; conv_item(F.kin[I_W2] + (size_t)l * DFF * DM, DM, 32 * cb, 32, DFF, WSP(bf16, WS_W2 + l * W2_L), 32 * cb, kb, scr, F.lane); }
    }
}
__device__ __forceinline__ void p0_prologue_b(Frame& F) {
    const int gt = F.bx * (NWAVES * 64) + F.tid, NT = F.G * NWAVES * 64;
    const float* MODP = WSP(float, WS_MODP); float* MOD = WSP(float, WS_MOD);
    for (int idx = gt; idx < NLAYER * 2 * 24576; idx += NT) {
        const int l = idx / 49152, rem = idx % 49152, b = rem / 24576, n = rem % 24576;
        float s = F.kin[I_ADAB][l * 24576 + n];
#pragma unroll 8
        for (int kc = 0; kc < 32; ++kc) s += MODP[((size_t)(l * 32 + kc) * 2 + b) * 24576 + n];
        MOD[idx] = s;
    }
    if (F.bx == 0) { float* TAB = WSP(float, WS_TAB);
        float tv[6];
#pragma unroll
        for (int q = 0; q < 6; ++q) { const int i = F.tid + NWAVES * 64 * q, hh = i >> 7, d = i & 127; tv[q] = F.kin[I_RELB][t5_bucket(d) * 24 + hh]; }
#pragma unroll
        for (int q = 0; q < 6; ++q) TAB[F.tid + NWAVES * 64 * q] = tv[q] * LOG2E; }
}
__device__ __forceinline__ void rms_phase(Frame& F, const float* xin, const float* sh, const float* sc) {
    const int gw = F.vcu * NWAVES + F.wave, NGW = F.G * NWAVES;
    bf16* XN = WSP(bf16, WS_XN);
#pragma unroll 1
    for (int b = 0; b < BATCH; ++b) {
        relaunder(F); relaunder_tid(F);
        f32x4 s4[16], h4[16];
        { const f32x4* scp = (const f32x4*)(sc + (size_t)b * 24576) + F.lane; const f32x4* shp = (const f32x4*)(sh + (size_t)b * 24576) + F.lane;
#pragma unroll
          for (int j = 0; j < 16; ++j) { s4[j] = scp[64 * j] + 1.0f; h4[j] = shp[64 * j]; } }
#pragma unroll 1
        for (int m = b * SEQ + gw; m < (b + 1) * SEQ; m += NGW) {
            relaunder_tid(F);
            const f32x4* xr = (const f32x4*)(xin + (size_t)m * DM) + F.lane;
            f32x4 v[16]; float ss = 0.f;
#pragma unroll
            for (int j = 0; j < 16; ++j) v[j] = xr[64 * j];
#pragma unroll
            for (int j = 0; j < 16; ++j) ss += (v[j].x * v[j].x + v[j].y * v[j].y) + (v[j].z * v[j].z + v[j].w * v[j].w);
            const float rstd = rsqrtf(wave_sum(ss) * (1.0f / DM) + 1e-6f);
            v2u* o8 = (v2u*)(XN + (size_t)m * DM) + F.lane;
#pragma unroll
            for (int j = 0; j < 16; ++j) { const f32x4 o = v[j] * rstd * s4[j] + h4[j]; v2u w; w.x = pk2(o.x, o.y); w.y = pk2(o.z, o.w); o8[64 * j] = w; }
        }
    }
}
__device__ __forceinline__ void rms_phase_bf(Frame& F, const float* sh, const float* sc) {
    const int gw = F.vcu * NWAVES + F.wave, NGW = F.G * NWAVES;
    bf16* XN = WSP(bf16, WS_XN); const bf16* XR = WSP(bf16, WS_XR);
#pragma unroll 1
    for (int b = 0; b < BATCH; ++b) {
        relaunder(F); relaunder_tid(F);
        f32x4 s0[8], s1[8], h0[8], h1[8];
        { const float* scp = sc + (size_t)b * 24576 + 8 * F.lane; const float* shp = sh + (size_t)b * 24576 + 8 * F.lane;
#pragma unroll
          for (int j = 0; j < 8; ++j) { s0[j] = *(const f32x4*)(scp + 512 * j) + 1.0f; s1[j] = *(const f32x4*)(scp + 512 * j + 4) + 1.0f; h0[j] = *(const f32x4*)(shp + 512 * j); h1[j] = *(const f32x4*)(shp + 512 * j + 4); } }
        const int mend = (b + 1) * SEQ; int m = b * SEQ + gw;
        v4u raw[8];
        if (m < mend) {
#pragma unroll
            for (int j = 0; j < 8; ++j) raw[j] = ((const v4u*)(XR + (size_t)m * DM) + F.lane)[64 * j];
        }
#pragma unroll 1
        for (; m < mend; m += NGW) {
            relaunder_tid(F);
            v4u nxt[8]; { const int mn = m + NGW < mend ? m + NGW : m;
#pragma unroll
              for (int j = 0; j < 8; ++j) nxt[j] = ((const v4u*)(XR + (size_t)mn * DM) + F.lane)[64 * j]; }
            float ss = 0.f;
#pragma unroll
            for (int j = 0; j < 8; ++j) { float f[8]; unpack8(raw[j], f);
#pragma unroll
                for (int e = 0; e < 8; ++e) ss += f[e] * f[e]; }
            const float rstd = rsqrtf(wave_sum(ss) * (1.0f / DM) + 1e-6f);
            v4u* o16 = (v4u*)(XN + (size_t)m * DM) + F.lane;
#pragma unroll
            for (int j = 0; j < 8; ++j) { float f[8]; unpack8(raw[j], f); float o[8];
#pragma unroll
                for (int e = 0; e < 4; ++e) { o[e] = f[e] * rstd * s0[j][e] + h0[j][e]; o[4 + e] = f[4 + e] * rstd * s1[j][e] + h1[j][e]; }
                o16[64 * j] = pack8(o); }
#pragma unroll
            for (int j = 0; j < 8; ++j) raw[j] = nxt[j];
        }
    }
}
__device__ __forceinline__ void prep_norm(Frame& F, int l) {
    const int gw = F.vcu * NWAVES + F.wave, NGW = F.G * NWAVES, lane = F.lane, sub = lane >> 3, ch = lane & 7;
    float gqa[8], gka[8], gqd[8], gkd[8];
#pragma unroll
    for (int e = 0; e < 8; ++e) { gqa[e] = F.kin[I_DQN][l * 64 + ch * 8 + e] * QSCALE; gka[e] = F.kin[I_DKN][l * 64 + ch * 8 + e];
                                  gqd[e] = F.kin[I_SQN][l * 64 + ch * 8 + e] * QSCALE; gkd[e] = F.kin[I_SKN][l * 64 + ch * 8 + e]; }
    const bf16* COLS = WSP(bf16, WS_COLS); bf16* QKA = WSP(bf16, WS_QKA); bf16* QKD = WSP(bf16, WS_QKD);
    for (int m0 = gw; m0 < M; m0 += 2 * NGW) {
        v4u ra[2][4], rd[2][3];
#pragma unroll
        for (int r = 0; r < 2; ++r) { const int m = m0 + r * NGW < M ? m0 + r * NGW : m0; const bf16* src = COLS + (size_t)m * NMAIN;
#pragma unroll
            for (int i = 0; i < 4; ++i) ra[r][i] = *(const v4u*)(src + CA_Q + (i * 8 + sub) * 64 + ch * 8);
#pragma unroll
            for (int i = 0; i < 3; ++i) { const int vec = i * 8 + sub; rd[r][i] = *(const v4u*)(src + CD_Q + (vec < 18 ? vec : 17) * 64 + ch * 8); } }
#pragma unroll
        for (int r = 0; r < 2; ++r) { const int m = m0 + r * NGW; if (m < M) {
#pragma unroll
            for (int i = 0; i < 4; ++i) { const int vec = i * 8 + sub, col = vec * 64 + ch * 8;
                float f[8]; unpack8(ra[r][i], f); float ss = 0.f;
#pragma unroll
                for (int e = 0; e < 8; ++e) ss += f[e] * f[e];
                ss = sum8(ss);
                const float rstd = rsqrtf(ss * (1.0f / 64.0f) + 1e-6f);
#pragma unroll
                for (int e = 0; e < 8; ++e) f[e] = f[e] * rstd * (i < 2 ? gqa[e] : gka[e]);
                *(v4u*)(QKA + (size_t)m * 2048 + col) = pack8(f); }
#pragma unroll
            for (int i = 0; i < 3; ++i) { const int vec = i * 8 + sub, col = vec * 64 + ch * 8;
                float f[8]; unpack8(rd[r][i], f); float ss = 0.f;
#pragma unroll
                for (int e = 0; e < 8; ++e) ss += f[e] * f[e];
                ss = sum8(ss);
                const float rstd = rsqrtf(ss * (1.0f / 64.0f) + 1e-6f);
#pragma unroll
                for (int e = 0; e < 8; ++e) f[e] = f[e] * rstd * (vec < 16 ? gqd[e] : gkd[e]);
                if (vec < 18) *(v4u*)(QKD + (size_t)m * 1152 + col) = pack8(f); } } }
    }
}
__device__ __forceinline__ void prep_loga(Frame& F, int l) {
    LAS float* gdl = (LAS float*)(F.lds + RING_OFF);
    float gu[16];
#pragma unroll
    for (int j = 0; j < 16; ++j) gu[j] = F.kin[I_GGU][((size_t)l * 16 + j) * 512 + F.tid];
    const float bias = F.kin[I_GGB][l * 512 + F.tid];
    const float* LOWR = WSP(float, WS_LOWR); float* LOGA = WSP(float, WS_LOGA);
    for (int tile = F.bx; tile < M / 64; tile += F.G) {
        const size_t row0 = (size_t)tile * 64;
        __syncthreads();
#pragma unroll
        for (int i = 0; i < 2; ++i) { const int idx = F.tid + 512 * i; gdl[idx] = LOWR[(row0 + (idx >> 4)) * 256 + (idx & 15)]; }
        __syncthreads();
#pragma unroll 4
        for (int t = 0; t < 64; ++t) { const LAS f32x4* gp = (const LAS f32x4*)(gdl + t * 16); const f32x4 g0 = gp[0], g1 = gp[1], g2 = gp[2], g3 = gp[3];
            float z = bias + g0.x * gu[0] + g0.y * gu[1] + g0.z * gu[2] + g0.w * gu[3] + g1.x * gu[4] + g1.y * gu[5] + g1.z * gu[6] + g1.w * gu[7]
                    + g2.x * gu[8] + g2.y * gu[9] + g2.z * gu[10] + g2.w * gu[11] + g3.x * gu[12] + g3.y * gu[13] + g3.z * gu[14] + g3.w * gu[15];
            LOGA[(row0 + t) * 512 + F.tid] = (fminf(z, 0.f) - __logf(1.0f + __expf(-fabsf(z)))) * (1.0f / 16.0f); }
    }
}
__device__ __forceinline__ int next_item(Frame& F, gu32* ctr) {
    volatile LAS int* slot = (volatile LAS int*)(F.lds + LDSCTL_OFF + 64);
    __syncthreads();
    if (F.tid == 0) *slot = (int)__hip_atomic_fetch_add(ctr, 1u, RLX_AGENT);
    __syncthreads();
    return *slot;
}
typedef float f32x16 __attribute__((ext_vector_type(16)));
__device__ __forceinline__ float xother32(float v) { unsigned a = __builtin_bit_cast(unsigned, v), b = a; asm volatile("" : "+v"(b)); auto rr = __builtin_amdgcn_permlane32_swap(a, b, false, false);
    const unsigned lo = rr[0], hi = rr[1]; return __builtin_bit_cast(float, (unsigned)((__builtin_amdgcn_mbcnt_hi(~0u, __builtin_amdgcn_mbcnt_lo(~0u, 0u)) & 32u) ? lo : hi)); }
__device__ __forceinline__ float xsum32(float v) { return v + xother32(v); }
__device__ __forceinline__ float xmax32(float v) { return fmaxf(v, xother32(v)); }
__device__ __forceinline__ int crow16(int r, int hi) { return (r & 3) + 8 * (r >> 2) + 4 * hi; }
template <bool ISA>
__device__ __forceinline__ void attn_unit(Frame& F, int l, int b, int hx, int qb) {
    constexpr int DV = ISA ? 128 : 64, NDV = DV / 32, KSTR = ISA ? 272 : 144, VSTR = 144, KBYTES = 64 * KSTR, VBYTES = DV * VSTR, BUFB = KBYTES + VBYTES, NCH = ISA ? 2 : 1;
    constexpr float NEG = -1e30f;
    LAS unsigned char* L = F.lds + RING_OFF;
    const int tid = F.tid, lane = F.lane, r32 = lane & 31, hi = lane >> 5, qs = F.wave & 3, grp = F.wave >> 2, q0 = qb * 128;
    const int kvh = hx >> 2, hd = kvh * 8 + (hx & 3) * 2 + grp;
    const bf16* Qp; const bf16* Kp; const bf16* VT; int ldq;
    if (ISA) { const bf16* QKA = WSP(bf16, WS_QKA); Qp = QKA + (size_t)b * SEQ * 2048 + hx * 128 + grp * 64; Kp = QKA + (size_t)b * SEQ * 2048 + 1024 + hx * 128; ldq = 2048; VT = WSP(bf16, WS_VTA) + (size_t)(b * 8 + hx) * 128 * VROW; }
    else { const bf16* QKD = WSP(bf16, WS_QKD); Qp = QKD + (size_t)b * SEQ * 1152 + hd * 64; Kp = QKD + (size_t)b * SEQ * 1152 + 1024 + kvh * 64; ldq = 1152; VT = WSP(bf16, WS_VTD) + (size_t)(b * 2 + kvh) * 64 * VROW; }
    const int qpos = q0 + 32 * qs + r32;
    bf16x8 qr[4];
#pragma unroll
    for (int d0 = 0; d0 < 4; ++d0) qr[d0] = *(const bf16x8*)(Qp + (size_t)qpos * ldq + d0 * 16 + hi * 8);
    LAS float* Bt = (LAS float*)(L + 2 * BUFB);
    { const float* TAB = WSP(float, WS_TAB);
      if (ISA) { if (tid < 130) Bt[tid] = tid == 0 ? NEG : (tid == 129 ? 0.f : TAB[hx * 128 + tid - 1] - TAB[hx * 128 + 127]); }
      else { if (tid < 260) { const int gi = tid >= 130, t = tid - 130 * gi; Bt[tid] = (t == 0 || t == 129) ? NEG : TAB[(8 + kvh * 8 + (hx & 3) * 2 + gi) * 128 + t - 1]; } } }
    const int TQ = q0 >> 6, T0 = ISA ? 0 : (TQ >= 2 ? TQ - 2 : 0), T1 = TQ + 1;
    v4u kreg[NCH], vreg[NCH];
#define AT_GLOAD(T) do { _Pragma("unroll") for (int i_ = 0; i_ < NCH; ++i_) { const int c_ = tid + 512 * i_; \
        const int kr_ = ISA ? (c_ >> 4) : (c_ >> 3), kc_ = ISA ? (c_ & 15) : (c_ & 7); kreg[i_] = *(const v4u*)(Kp + (size_t)((T) * 64 + kr_) * ldq + kc_ * 8); \
        const int vr_ = c_ >> 3, vc_ = c_ & 7; vreg[i_] = *(const v4u*)(VT + (size_t)vr_ * VROW + (T) * 64 + vc_ * 8); } } while (0)
#define AT_LWRITE(buf) do { _Pragma("unroll") for (int i_ = 0; i_ < NCH; ++i_) { const int c_ = tid + 512 * i_; \
        const int kr_ = ISA ? (c_ >> 4) : (c_ >> 3), kc_ = ISA ? (c_ & 15) : (c_ & 7); *(LAS v4u*)(L + (buf) * BUFB + kr_ * KSTR + kc_ * 16) = kreg[i_]; \
        const int vr_ = c_ >> 3, vc_ = c_ & 7; *(LAS v4u*)(L + (buf) * BUFB + KBYTES + vr_ * VSTR + vc_ * 16) = vreg[i_]; } } while (0)
    f32x16 o[NDV];
#pragma unroll
    for (int i = 0; i < NDV; ++i) o[i] = (f32x16){0.f, 0.f, 0.f, 0.f, 0.f, 0.f, 0.f, 0.f, 0.f, 0.f, 0.f, 0.f, 0.f, 0.f, 0.f, 0.f};
    float m_run = ISA ? -1.0e4f : fmaxf(F.kin[I_SSINK][l * 16 + hd] * LOG2E, -1.0e4f), l_run = ISA ? 0.f : (hi == 0 ? 1.f : 0.f);
    f32x16 nmv; { const float nm = -m_run; nmv = (f32x16){nm, nm, nm, nm, nm, nm, nm, nm, nm, nm, nm, nm, nm, nm, nm, nm}; }
    const int krow = (r32 & 16) | (r32 & 3) | ((r32 & 4) << 1) | ((r32 & 8) >> 1);
    const int koff = krow * KSTR + (ISA ? grp * 128 : 0) + hi * 16, voff = KBYTES + r32 * VSTR + hi * 16;
    AT_GLOAD(T0); AT_LWRITE(0); __syncthreads();
#pragma unroll 1
    for (int T = T0; T <= T1; ++T) {
        const int cur = (T - T0) & 1;
        AT_GLOAD(T < T1 ? T + 1 : T1);
        LAS const unsigned char* Kb = L + cur * BUFB;
        f32x16 s[2];
#pragma unroll
        for (int blk = 0; blk < 2; ++blk) {
#pragma unroll
            for (int d0 = 0; d0 < 4; ++d0) { const bf16x8 kf = *(const LAS bf16x8*)(Kb + koff + blk * 32 * KSTR + d0 * 32); s[blk] = __builtin_amdgcn_mfma_f32_32x32x16_bf16(kf, qr[d0], d0 == 0 ? nmv : s[blk], 0, 0, 0); } }
        bf16x8 vfc[NDV], vfn[NDV];
#pragma unroll
        for (int i = 0; i < NDV; ++i) vfc[i] = *(const LAS bf16x8*)(Kb + voff + i * 32 * VSTR);
        if (!ISA || T >= TQ - 2) {
            const LAS float* bt = Bt + (ISA ? 0 : grp * 130) + 1; const int d0 = qpos - T * 64 - 8 * hi;
#pragma unroll
            for (int blk = 0; blk < 2; ++blk)
#pragma unroll
                for (int r = 0; r < 16; ++r) { const int dist = d0 - (32 * blk + 16 * (r >> 3) + (r & 7)); const int di = dist < -1 ? -1 : (dist > 128 ? 128 : dist); s[blk][r] += bt[di]; } }
        float mt, mt1;
        { float m0 = s[0][0], m1 = s[0][8], m2 = s[1][0], m3 = s[1][8];
#pragma unroll
          for (int r = 1; r < 8; ++r) { m0 = fmaxf(m0, s[0][r]); m1 = fmaxf(m1, s[0][8 + r]); m2 = fmaxf(m2, s[1][r]); m3 = fmaxf(m3, s[1][8 + r]); }
          mt = fmaxf(m0, m1); mt1 = fmaxf(m2, m3); mt = fmaxf(mt, mt1); }
        mt = xmax32(mt);
        if (__any(mt > 8.0f)) { const float sh = mt > 8.0f ? mt : 0.f, alpha = __builtin_amdgcn_exp2f(-sh); l_run *= alpha;
#pragma unroll
            for (int i = 0; i < NDV; ++i)
#pragma unroll
                for (int r = 0; r < 16; ++r) o[i][r] *= alpha;
#pragma unroll
            for (int blk = 0; blk < 2; ++blk)
#pragma unroll
                for (int r = 0; r < 16; ++r) s[blk][r] -= sh;
            m_run += sh; const float nm = -m_run; nmv = (f32x16){nm, nm, nm, nm, nm, nm, nm, nm, nm, nm, nm, nm, nm, nm, nm, nm}; }
        float ls0 = 0.f, ls1 = 0.f, ls2 = 0.f, ls3 = 0.f;
#pragma unroll
        for (int blk = 0; blk < 2; ++blk)
#pragma unroll
            for (int r = 0; r < 16; r += 4) { const float p0 = __builtin_amdgcn_exp2f(s[blk][r]), p1 = __builtin_amdgcn_exp2f(s[blk][r + 1]), p2 = __builtin_amdgcn_exp2f(s[blk][r + 2]), p3 = __builtin_amdgcn_exp2f(s[blk][r + 3]);
                s[blk][r] = p0; s[blk][r + 1] = p1; s[blk][r + 2] = p2; s[blk][r + 3] = p3; ls0 += p0; ls1 += p1; ls2 += p2; ls3 += p3; }
        const float ls = (ls0 + ls1) + (ls2 + ls3);
        l_run += ls;
#pragma unroll
        for (int sl = 0; sl < 4; ++sl) { const int blk = sl >> 1, r0 = 8 * (sl & 1);
            v4u pw; pw.x = pg8::cvt_pk_bf16(s[blk][r0], s[blk][r0 + 1]); pw.y = pg8::cvt_pk_bf16(s[blk][r0 + 2], s[blk][r0 + 3]); pw.z = pg8::cvt_pk_bf16(s[blk][r0 + 4], s[blk][r0 + 5]); pw.w = pg8::cvt_pk_bf16(s[blk][r0 + 6], s[blk][r0 + 7]);
            const bf16x8 pf = __builtin_bit_cast(bf16x8, pw);
#pragma unroll
            for (int i = 0; i < NDV; ++i) { if (sl < 3) vfn[i] = *(const LAS bf16x8*)(Kb + voff + i * 32 * VSTR + (sl + 1) * 32); o[i] = __builtin_amdgcn_mfma_f32_32x32x16_bf16(vfc[i], pf, o[i], 0, 0, 0); }
#pragma unroll
            for (int i = 0; i < NDV; ++i) vfc[i] = vfn[i]; }
        AT_LWRITE(cur ^ 1);
        __syncthreads();
    }
#undef AT_GLOAD
#undef AT_LWRITE
    const float inv = 1.0f / xsum32(l_run);
    bf16* MIX = WSP(bf16, WS_MIXED);
    if (ISA) {
        int ll_ = l; asm volatile("" : "+s"(ll_)); const float lam_init = ll_ == 0 ? 0.2f : 0.35550906759f;     float lam_full;
        { const float* lm = F.kin[I_DLAM] + (size_t)l * 256; const float s1 = wave_sum(lm[lane] * lm[64 + lane]), s2 = wave_sum(lm[128 + lane] * lm[192 + lane]); lam_full = __expf(s1) - __expf(s2) + lam_init; }
        LAS float* R1 = (LAS float*)L;
        LAS bf16* R2 = (LAS bf16*)(L + 66048);
        const int ql = 32 * qs + r32;
        if (grp == 1) {
#pragma unroll
            for (int i = 0; i < NDV; ++i)
#pragma unroll
                for (int r = 0; r < 16; ++r) R1[ql * 129 + 32 * i + crow16(r, hi)] = lam_full * inv * o[i][r]; }
        __syncthreads();
        if (grp == 0) { float ss = 0.f;
#pragma unroll
            for (int i = 0; i < NDV; ++i)
#pragma unroll
                for (int r = 0; r < 16; ++r) { const float d = o[i][r] * inv - R1[ql * 129 + 32 * i + crow16(r, hi)]; o[i][r] = d; ss += d * d; }
            const float rstd = rsqrtf(xsum32(ss) * (1.0f / 128.0f) + 1e-6f) * (1.0f - lam_init);
            const float* sl = F.kin[I_DSUB] + l * 128;
#pragma unroll
            for (int i = 0; i < NDV; ++i)
#pragma unroll
                for (int r = 0; r < 16; ++r) { const int dv = 32 * i + crow16(r, hi); R2[ql * 132 + dv] = (bf16)f2bf(o[i][r] * rstd * sl[dv]); } }
        __syncthreads();
#pragma unroll
        for (int i = 0; i < 4; ++i) { const int c = tid + 512 * i, row = c >> 4, ch = c & 15; const LAS v2u* sp = (const LAS v2u*)(R2 + row * 132 + ch * 8); const v2u a = sp[0], bb = sp[1];
            *(v4u*)(MIX + (size_t)(b * SEQ + q0 + row) * DM + hx * 128 + ch * 8) = (v4u){a.x, a.y, bb.x, bb.y}; }
    } else {
        LAS bf16* R = (LAS bf16*)L + F.wave * 2176;
#pragma unroll
        for (int i = 0; i < NDV; ++i)
#pragma unroll
            for (int r = 0; r < 16; ++r) R[r32 * 68 + 32 * i + crow16(r, hi)] = (bf16)f2bf(o[i][r] * inv);
#pragma unroll
        for (int i = 0; i < 4; ++i) { const int c = lane + 64 * i, row = c >> 3, ch = c & 7; const LAS v2u* sp = (const LAS v2u*)(R + row * 68 + ch * 8); const v2u a = sp[0], bb = sp[1];
            *(v4u*)(MIX + (size_t)(b * SEQ + q0 + 32 * qs + row) * DM + 3072 + hd * 64 + ch * 8) = (v4u){a.x, a.y, bb.x, bb.y}; }
    }
}
__device__ __forceinline__ void prep_gla(Frame& F) {
    LAS float* Lb = (LAS float*)(F.lds + RING_OFF); LAS float* Qd = Lb + 64 * 129; LAS float* Ki = Qd + 64 * 129; LAS bf16* Kt = (LAS bf16*)(Ki + 64 * 129);
    const bf16* COLS = WSP(bf16, WS_COLS); const float* LOGA = WSP(float, WS_LOGA);
    bf16* QDEC = WSP(bf16, WS_QDEC); bf16* KDT = WSP(bf16, WS_KDT); bf16* AMg = WSP(bf16, WS_AM); float* EBL = WSP(float, WS_EBL);
    for (int u = F.bx; u < 1024; u += F.G) {
        const int b = u >> 9, h = (u >> 7) & 3, ck = u & 127; const size_t row0 = (size_t)b * SEQ + ck * 64;
        __syncthreads();
        f32x4 lg[4]; v4u qv[2], kv[2];
#pragma unroll
        for (int i = 0; i < 4; ++i) { const int i4 = F.tid + 512 * i, t = i4 >> 5, d4 = (i4 & 31) * 4; lg[i] = *(const f32x4*)(LOGA + (row0 + t) * 512 + h * 128 + d4); }
#pragma unroll
        for (int i = 0; i < 2; ++i) { const int i8 = F.tid + 512 * i, t = i8 >> 4, d8 = (i8 & 15) * 8; const bf16* p = COLS + (row0 + t) * NMAIN + h * 128 + d8; qv[i] = *(const v4u*)(p + CB_Q); kv[i] = *(const v4u*)(p + CB_K); }
#pragma unroll
        for (int i = 0; i < 4; ++i) { const int i4 = F.tid + 512 * i, t = i4 >> 5, d4 = (i4 & 31) * 4;
#pragma unroll
            for (int e = 0; e < 4; ++e) Lb[t * 129 + d4 + e] = lg[i][e]; }
        __syncthreads();
        if (F.tid < 128) { float a[64];
#pragma unroll
            for (int t = 0; t < 64; ++t) a[t] = Lb[t * 129 + F.tid];
#pragma unroll
            for (int t = 1; t < 64; ++t) a[t] += a[t - 1];
#pragma unroll
            for (int t = 0; t < 64; ++t) Lb[t * 129 + F.tid] = a[t];
            EBL[(size_t)u * 128 + F.tid] = __expf(a[63]); }
        __syncthreads();
#pragma unroll
        for (int i = 0; i < 2; ++i) { const int i8 = F.tid + 512 * i, t = i8 >> 4, d8 = (i8 & 15) * 8; float q[8], k[8], qo[8]; unpack8(qv[i], q); unpack8(kv[i], k);
#pragma unroll
            for (int e = 0; e < 8; ++e) { const int d = d8 + e; const float bt = Lb[t * 129 + d], bl = Lb[63 * 129 + d];
                const float qd = q[e] * 0.08838834764831845f * __expf(bt); Qd[t * 129 + d] = qd; Ki[t * 129 + d] = k[e] * __expf(-bt); Kt[d * 72 + t] = (bf16)f2bf(k[e] * __expf(bl - bt)); qo[e] = qd; }
            *(v4u*)(QDEC + ((size_t)u * 64 + t) * 128 + d8) = pack8(qo); }
        __syncthreads();
#pragma unroll
        for (int i = 0; i < 2; ++i) { const int c_ = F.tid + 512 * i, row = c_ >> 3, ch = c_ & 7; const LAS v2u* sp = (const LAS v2u*)(Kt + row * 72 + ch * 8); const v2u a = sp[0], bb = sp[1];
            *(v4u*)(KDT + ((size_t)u * 128 + row) * 64 + ch * 8) = (v4u){a.x, a.y, bb.x, bb.y}; }
        {
          const int n = F.lane & 15, gq = F.lane >> 4, ct = F.wave >> 1, st0 = 2 * (F.wave & 1);
          f32x4 c0 = (f32x4){0.f, 0.f, 0.f, 0.f}, c1 = (f32x4){0.f, 0.f, 0.f, 0.f};
          if (st0 <= ct) {
              const LAS float* ap = Qd + (16 * ct + n) * 129 + gq; const LAS float* bp0 = Ki + (16 * st0 + n) * 129 + gq; const LAS float* bp1 = bp0 + 16 * 129;
#pragma unroll 8
              for (int ks = 0; ks < 32; ++ks) { const float av = ap[4 * ks]; c0 = __builtin_amdgcn_mfma_f32_16x16x4f32(av, bp0[4 * ks], c0, 0, 0, 0); c1 = __builtin_amdgcn_mfma_f32_16x16x4f32(av, bp1[4 * ks], c1, 0, 0, 0); } }
#pragma unroll
          for (int rr = 0; rr < 4; ++rr) { const int c = 16 * ct + 4 * gq + rr, s0 = 16 * st0 + n, s1 = s0 + 16;
              bf16* op = AMg + ((size_t)u * 64 + c) * 64; op[s0] = (bf16)f2bf(s0 <= c ? c0[rr] : 0.f); op[s1] = (bf16)f2bf(s1 <= c ? c1[rr] : 0.f); } }
    }
}
template <int PASS> __device__ __forceinline__ void prep_vt(Frame& F) {
    LAS bf16* T = (LAS bf16*)(F.lds + RING_OFF);
    const bf16* COLS = WSP(bf16, WS_COLS);
    constexpr int ncol = PASS == 4 ? 128 : 512, nch = ncol >> 3, NI = 64 * nch / (NWAVES * 64);
    constexpr int col0 = PASS < 2 ? CA_V + 512 * PASS : (PASS < 4 ? CB_V + 512 * (PASS - 2) : CD_V);
    bf16* dst0 = PASS < 2 ? WSP(bf16, WS_VTA) + (size_t)(512 * PASS) * VROW : (PASS < 4 ? WSP(bf16, WS_VTB) + (size_t)(512 * (PASS - 2)) * VROW : WSP(bf16, WS_VTD));
    constexpr int rows_b = PASS == 4 ? 128 : 1024;
    for (int tile = F.bx; tile < M / 64; tile += F.G) {
        const int b = tile >> 7, t0 = (tile & 127) * 64;
        __syncthreads();
        v4u v[NI];
#pragma unroll
        for (int i = 0; i < NI; ++i) { const int idx = F.tid + NWAVES * 64 * i, tok = idx / nch, ch = idx % nch; v[i] = *(const v4u*)(COLS + (size_t)(b * SEQ + t0 + tok) * NMAIN + col0 + ch * 8); }
#pragma unroll
        for (int i = 0; i < NI; ++i) { const int idx = F.tid + NWAVES * 64 * i, tok = idx / nch, ch = idx % nch; LAS unsigned* d = (LAS unsigned*)(T + tok * 522 + ch * 8); d[0] = v[i].x; d[1] = v[i].y; d[2] = v[i].z; d[3] = v[i].w; }
        __syncthreads();
#pragma unroll
        for (int i = 0; i < NI; ++i) { const int idx = F.tid + NWAVES * 64 * i, vrow = idx >> 3, ch = idx & 7;
            unsigned e[8];
#pragma unroll
            for (int k = 0; k < 8; ++k) e[k] = T[(ch * 8 + k) * 522 + vrow];
            v4u o; o.x = e[0] | (e[1] << 16); o.y = e[2] | (e[3] << 16); o.z = e[4] | (e[5] << 16); o.w = e[6] | (e[7] << 16);
            *(v4u*)(dst0 + ((size_t)b * rows_b + vrow) * VROW + t0 + ch * 8) = o; }
    }
}
typedef float f32x4v __attribute__((ext_vector_type(4)));
__device__ __forceinline__ float sum16(float v) { v = sum8(v); v += dpp_f<0x140>(v); return v; }
#define LDS_BARRIER() asm volatile("s_waitcnt lgkmcnt(0)\n\ts_barrier" ::: "memory")
template <int HACK = 0> __device__ __forceinline__ void gla_scan_unit(Frame& F, int l, int b, int h, int vh) {
    LAS unsigned char* L = F.lds + RING_OFF;
    constexpr int OQD = 0, OKT = 17408, OAM = 35840, OVT = 45056, OOT = 63488, OEB = 80896, OPS = 81408;
    const int tid = F.tid, lane = F.lane, n = lane & 15, g = lane >> 4, w = F.wave;
    const bf16* QDEC = WSP(bf16, WS_QDEC); const bf16* KDT = WSP(bf16, WS_KDT); const bf16* AMg = WSP(bf16, WS_AM); const float* EBL = WSP(float, WS_EBL);
    const bf16* VTB = WSP(bf16, WS_VTB) + (size_t)((b * 4 + h) * 256 + 128 * vh) * VROW; bf16* OB = WSP(bf16, WS_OB); float* PSG = WSP(float, WS_PSG);
    f32x4v S[8];
#pragma unroll
    for (int dt = 0; dt < 8; ++dt) S[dt] = (f32x4v){0.f, 0.f, 0.f, 0.f};
    v4u pq[2], pk[2], pa, pv[2]; float pe = 0.f;
#define GL_ISSUE(CK) do { const size_t u_ = (size_t)(b * 4 + h) * 128 + (CK); \
        _Pragma("unroll") for (int i = 0; i < 2; ++i) { const int c_ = tid + 512 * i; pq[i] = *(const v4u*)(QDEC + (u_ * 64 + (c_ >> 4)) * 128 + (c_ & 15) * 8); pk[i] = *(const v4u*)(KDT + (u_ * 128 + (c_ >> 3)) * 64 + (c_ & 7) * 8); \
            pv[i] = *(const v4u*)(VTB + (size_t)(c_ >> 3) * VROW + (CK) * 64 + (c_ & 7) * 8); } \
        pa = *(const v4u*)(AMg + (u_ * 64 + (tid >> 3)) * 64 + (tid & 7) * 8); \
        pe = EBL[u_ * 128 + (tid & 127)]; } while (0)
#define GL_WRITE() do { _Pragma("unroll") for (int i = 0; i < 2; ++i) { const int c_ = tid + 512 * i; *(LAS v4u*)(L + OQD + (c_ >> 4) * 272 + (c_ & 15) * 16) = pq[i]; *(LAS v4u*)(L + OKT + (c_ >> 3) * 144 + (c_ & 7) * 16) = pk[i]; \
            *(LAS v4u*)(L + OVT + (c_ >> 3) * 144 + (c_ & 7) * 16) = pv[i]; } \
        *(LAS v4u*)(L + OAM + (tid >> 3) * 144 + (tid & 7) * 16) = pa; \
        ((LAS float*)(L + OEB))[tid & 127] = pe; } while (0)
    GL_ISSUE(0); GL_WRITE();
    LDS_BARRIER();
#pragma unroll 1
    for (int ck = 0; ck < 128; ++ck) {
        const size_t row0 = (size_t)b * SEQ + ck * 64;
        GL_ISSUE((HACK & 1) && ck >= 2 ? 2 : (ck + 1 < 128 ? ck + 1 : 127));
        bf16x8 vf[2];
#pragma unroll
        for (int ks = 0; ks < 2; ++ks) vf[ks] = *(const LAS bf16x8*)(L + OVT + (16 * w + n) * 144 + (32 * ks + 8 * g) * 2);
        f32x4v o[4];
#pragma unroll
        for (int ct = 0; ct < 4; ++ct) o[ct] = (f32x4v){0.f, 0.f, 0.f, 0.f};
#pragma unroll
        for (int ct = 0; ct < 4; ++ct)
#pragma unroll
            for (int ks = 0; ks < 2; ++ks) { const bf16x8 af = *(const LAS bf16x8*)(L + OAM + (16 * ct + n) * 144 + (32 * ks + 8 * g) * 2); o[ct] = __builtin_amdgcn_mfma_f32_16x16x32_bf16(af, vf[ks], o[ct], 0, 0, 0); }
#pragma unroll
        for (int kk = 0; kk < 4; ++kk) { v4u pw; pw.x = pg8::cvt_pk_bf16(S[2 * kk][0], S[2 * kk][1]); pw.y = pg8::cvt_pk_bf16(S[2 * kk][2], S[2 * kk][3]);
            pw.z = pg8::cvt_pk_bf16(S[2 * kk + 1][0], S[2 * kk + 1][1]); pw.w = pg8::cvt_pk_bf16(S[2 * kk + 1][2], S[2 * kk + 1][3]); const bf16x8 sf = __builtin_bit_cast(bf16x8, pw);
#pragma unroll
            for (int ct = 0; ct < 4; ++ct) { const LAS unsigned char* qp = L + OQD + (16 * ct + n) * 272 + (32 * kk + 4 * g) * 2; const v2u qa = *(const LAS v2u*)qp, qb = *(const LAS v2u*)(qp + 32);
                o[ct] = __builtin_amdgcn_mfma_f32_16x16x32_bf16(__builtin_bit_cast(bf16x8, (v4u){qa.x, qa.y, qb.x, qb.y}), sf, o[ct], 0, 0, 0); } }
#pragma unroll
        for (int dt = 0; dt < 8; ++dt) { const f32x4v eb = *(const LAS f32x4v*)(L + OEB + (16 * dt + 4 * g) * 4); S[dt] = S[dt] * eb;
#pragma unroll
            for (int ks = 0; ks < 2; ++ks) { const bf16x8 kf = *(const LAS bf16x8*)(L + OKT + (16 * dt + n) * 144 + (32 * ks + 8 * g) * 2); S[dt] = __builtin_amdgcn_mfma_f32_16x16x32_bf16(kf, vf[ks], S[dt], 0, 0, 0); } }
        LAS float* PS = (LAS float*)(L + OPS) + (ck & 1) * 512;
#pragma unroll
        for (int ct = 0; ct < 4; ++ct)
#pragma unroll
            for (int r = 0; r < 4; ++r) { const float ss = sum16(o[ct][r] * o[ct][r]); if (n == 0) PS[(16 * ct + 4 * g + r) * 8 + w] = ss;
                *(LAS bf16*)(L + OOT + (16 * ct + 4 * g + r) * 272 + (16 * w + n) * 2) = (bf16)f2bf(o[ct][r]); }
        LDS_BARRIER();
        GL_WRITE();
        if (!(HACK & 2)) {
#pragma unroll
        for (int i = 0; i < 2; ++i) { const int c_ = tid + 512 * i, tok = c_ >> 4, ch = c_ & 15; *(v4u*)(OB + (row0 + tok) * 1024 + h * 256 + 128 * vh + ch * 8) = *(const LAS v4u*)(L + OOT + tok * 272 + ch * 16); }
        if (tid < 64) { const LAS f32x4v* pp = (const LAS f32x4v*)(PS + tid * 8); const f32x4v p0 = pp[0], p1 = pp[1]; PSG[(row0 + tid) * 8 + h * 2 + vh] = ((p0.x + p0.y) + (p0.z + p0.w)) + ((p1.x + p1.y) + (p1.z + p1.w)); } }
        LDS_BARRIER();
    }
#undef GL_ISSUE
#undef GL_WRITE
}
__device__ __forceinline__ void gla_post(Frame& F, int l) {
    const bf16* OB = WSP(bf16, WS_OB); const float* PSG = WSP(float, WS_PSG); const bf16* COLS = WSP(bf16, WS_COLS); bf16* MIX = WSP(bf16, WS_MIXED);
    const int ch = F.tid & 127, h = ch >> 5; float gain8[8];
#pragma unroll
    for (int e = 0; e < 8; ++e) gain8[e] = F.kin[I_GON][l * 256 + (ch & 31) * 8 + e];
    for (int row0 = F.bx * 4 + (F.tid >> 7); row0 < M; row0 += F.G * 16) {
        v4u ovr[4], gvr[4]; f32x2_t ps[4];
#pragma unroll
        for (int i = 0; i < 4; ++i) { const int row = row0 + F.G * 4 * i < M ? row0 + F.G * 4 * i : row0;
            ovr[i] = *(const v4u*)(OB + (size_t)row * 1024 + ch * 8); gvr[i] = *(const v4u*)(COLS + (size_t)row * NMAIN + CB_G + ch * 8); ps[i] = *(const f32x2_t*)(PSG + (size_t)row * 8 + h * 2); }
#pragma unroll
        for (int i = 0; i < 4; ++i) { const int row = row0 + F.G * 4 * i; float ov[8], gv[8]; unpack8(ovr[i], ov); unpack8(gvr[i], gv);
            const float rstd = rsqrtf((ps[i].x + ps[i].y) * (1.0f / 256.0f) + 1e-6f);
#pragma unroll
            for (int e = 0; e < 8; ++e) ov[e] = ov[e] * (rstd * gain8[e]) * silu_g(gv[e]);
            if (row < M) *(v4u*)(MIX + (size_t)row * DM + 1024 + ch * 8) = pack8(ov); }
    }
}
constexpr int RC_AT = 0, RC_RT = 2048, RC_BK = 4096, RC_VF = 8192, RC_GF = 10240, RC_U0 = 12288, RC_Y0 = 16384, RC_P15 = 20480, RC_BN = 20736, RC_BYTES = 20800;
__device__ __forceinline__ void rwkv_chunks_of_tile(Frame& F, int l, int tile) {
    const int team = F.tid >> 8, tt = F.tid & 255;
    LAS float* Lt = (LAS float*)(F.lds + RING_OFF) + team * 12288;
    LAS float* XA = Lt; LAS float* XR = Lt + 1040; LAS float* ZB = Lt + 2080; LAS float* ZK = Lt + 3120; LAS float* TB = Lt + 4160; LAS float* TK = Lt + 5200; LAS float* VV = Lt + 6240;
    LAS float* ATl = Lt + 7280; LAS float* U0l = Lt + 8320; LAS float* W1 = Lt + 9360;
    LAS float* Aab = Lt + 10400; LAS float* Aak = Lt + 10672; LAS float* Arb = Lt + 10944; LAS float* Ark = Lt + 11216; LAS float* TT = Lt + 11488;
    const float* RW = WSP(float, WS_RW); const unsigned* RWU = WSP(unsigned, WS_RW); constexpr size_t RS = RW_ONE / 4; unsigned char* RWC = F.ws + WS_RWC;
    float pw_[6], pr_[4], pk_[4], pv_[4], pa_[4], pb_[4], pg_[4];
#define RC_FETCH(P) do { const int h_ = 2 * (P) + team; const size_t cb_ = (size_t)tile * 16 * 1024 + h_ * 64 + (tt & 63); const int q_ = tt >> 6; \
        pw_[4] = RW[RS + cb_ + (size_t)(q_ ? 4 * q_ - 1 : 0) * 1024]; pw_[5] = RW[RS + cb_ + (size_t)15 * 1024];            \
        _Pragma("unroll") for (int e = 0; e < 4; ++e) { const size_t o_ = cb_ + (size_t)(4 * q_ + e) * 1024; pw_[e] = RW[RS + o_]; const unsigned u0 = RWU[o_], u2 = RWU[2 * RS + o_], u3 = RWU[3 * RS + o_]; \
            pr_[e] = bflo(u0); pk_[e] = bfhi(u0); pv_[e] = bflo(u2); pg_[e] = bfhi(u2); pa_[e] = bflo(u3); pb_[e] = bfhi(u3); } } while (0)
    RC_FETCH(0);
#pragma unroll 1
    for (int pair = 0; pair < 8; ++pair) {
        const int uc = ((tile >> 9) * 16 + 2 * pair + team) * 512 + (tile & 511), b = uc >> 13, h = (uc >> 9) & 15, ck = uc & 511; unsigned char* rec = RWC + ((size_t)ck * 32 + (uc >> 9)) * RC_BYTES;     (void)b;
        __syncthreads();
        {
          const int j = tt & 63, q = tt >> 6;
          const float cl = pw_[5], clm = q ? pw_[4] : 0.f; const float clq[4] = {pw_[0], pw_[1], pw_[2], pw_[3]};
#pragma unroll
          for (int e = 0; e < 4; ++e) { const int t = 4 * q + e; const float cprev = e == 0 ? clm : clq[e - 1], cc = clq[e];
              const float rr = pr_[e], kk = pk_[e], vv = pv_[e], aa = pa_[e], bb = pb_[e];
              XA[t * 65 + j] = aa * __expf(cprev); XR[t * 65 + j] = rr * __expf(cc); const float ei = __expf(-cc), ef = __expf(cl - cc);
              ZB[t * 65 + j] = bb * ei; ZK[t * 65 + j] = kk * ei; TB[t * 65 + j] = bb * ef; TK[t * 65 + j] = kk * ef; VV[t * 65 + j] = vv; }
          if (q == 0) ((float*)(rec + RC_P15))[j] = __expf(cl);
          { v2u gw; gw.x = pk2(pg_[0], pg_[1]); gw.y = pk2(pg_[2], pg_[3]); *(v2u*)(rec + RC_GF + (((j >> 4) * 64 + 16 * q + (j & 15)) * 8)) = gw; } }
        RC_FETCH(pair < 7 ? pair + 1 : 7);
        __syncthreads();
        {
          const int q = tt >> 6, n = tt & 15, g = (tt >> 4) & 3; const LAS float* X = (q & 2) ? XR : XA; const LAS float* Z = (q & 1) ? ZK : ZB; LAS float* O = q == 0 ? Aab : (q == 1 ? Aak : (q == 2 ? Arb : Ark));
          f32x4v c = (f32x4v){0.f, 0.f, 0.f, 0.f};
#pragma unroll
          for (int ks = 0; ks < 16; ++ks) c = __builtin_amdgcn_mfma_f32_16x16x4f32(X[n * 65 + 4 * ks + g], Z[n * 65 + 4 * ks + g], c, 0, 0, 0);
#pragma unroll
          for (int rr = 0; rr < 4; ++rr) { const int t = 4 * g + rr; O[t * 17 + n] = ((q & 2) ? n <= t : n < t) ? c[rr] : 0.f; }
          { const int t = tt >> 4, jq = tt & 15; const float* rkp = F.kin[I_RRK] + l * 1024 + h * 64 + 4 * jq; float bn = 0.f;
#pragma unroll
            for (int e = 0; e < 4; ++e) bn += XR[t * 65 + 4 * jq + e] * ZK[t * 65 + 4 * jq + e] * rkp[e];
            bn = sum16(bn); if (jq == 0) ((float*)(rec + RC_BN))[t] = bn; } }
        __syncthreads();
        {
          if (tt < 16) { float col[16];
#pragma unroll
              for (int t = 0; t < 16; ++t) { float acc = (t == tt) ? 1.f : 0.f;
#pragma unroll
                  for (int s = 0; s < 16; ++s) if (s < t) acc += Aab[t * 17 + s] * col[s];
                  col[t] = acc; TT[t * 17 + tt] = acc; } }
          const int q = tt >> 6, n = tt & 15, g = (tt >> 4) & 3; f32x4v c = (f32x4v){0.f, 0.f, 0.f, 0.f};
#pragma unroll
          for (int ks = 0; ks < 4; ++ks) c = __builtin_amdgcn_mfma_f32_16x16x4f32(Aak[n * 17 + 4 * ks + g], VV[(4 * ks + g) * 65 + 16 * q + n], c, 0, 0, 0);
#pragma unroll
          for (int rr = 0; rr < 4; ++rr) W1[(4 * g + rr) * 65 + 16 * q + n] = c[rr]; }
        __syncthreads();
        {
          const int q = tt >> 6, n = tt & 15, g = (tt >> 4) & 3; f32x4v ca = (f32x4v){0.f, 0.f, 0.f, 0.f}, cu = (f32x4v){0.f, 0.f, 0.f, 0.f};
#pragma unroll
          for (int ks = 0; ks < 4; ++ks) { const float tv = TT[n * 17 + 4 * ks + g]; ca = __builtin_amdgcn_mfma_f32_16x16x4f32(tv, XA[(4 * ks + g) * 65 + 16 * q + n], ca, 0, 0, 0); cu = __builtin_amdgcn_mfma_f32_16x16x4f32(tv, W1[(4 * ks + g) * 65 + 16 * q + n], cu, 0, 0, 0); }
#pragma unroll
          for (int rr = 0; rr < 4; ++rr) { ATl[(4 * g + rr) * 65 + 16 * q + n] = ca[rr]; U0l[(4 * g + rr) * 65 + 16 * q + n] = cu[rr]; }
          *(f32x4v*)(rec + RC_U0 + ((q * 64 + 16 * g + n) * 16)) = cu; }
        __syncthreads();
        {
          const int q = tt >> 6, n = tt & 15, g = (tt >> 4) & 3; f32x4v cr, cy = (f32x4v){0.f, 0.f, 0.f, 0.f};
#pragma unroll
          for (int rr = 0; rr < 4; ++rr) cr[rr] = XR[(4 * g + rr) * 65 + 16 * q + n];
#pragma unroll
          for (int ks = 0; ks < 4; ++ks) { const float arb = Arb[n * 17 + 4 * ks + g], ark = Ark[n * 17 + 4 * ks + g];
              cr = __builtin_amdgcn_mfma_f32_16x16x4f32(arb, ATl[(4 * ks + g) * 65 + 16 * q + n], cr, 0, 0, 0);
              cy = __builtin_amdgcn_mfma_f32_16x16x4f32(arb, U0l[(4 * ks + g) * 65 + 16 * q + n], cy, 0, 0, 0);
              cy = __builtin_amdgcn_mfma_f32_16x16x4f32(ark, VV[(4 * ks + g) * 65 + 16 * q + n], cy, 0, 0, 0); }
          *(f32x4v*)(rec + RC_Y0 + ((q * 64 + 16 * g + n) * 16)) = cy;
#pragma unroll
          for (int rr = 0; rr < 4; ++rr) W1[(4 * g + rr) * 65 + 16 * q + n] = cr[rr]; }
        __syncthreads();
        { const int t = tt & 15, jq = tt >> 4, kk = jq >> 3, half = (jq & 7) >> 2, g = jq & 3, j0 = 4 * jq;
          v2u wa, wr; wa.x = pk2(ATl[t * 65 + j0], ATl[t * 65 + j0 + 1]); wa.y = pk2(ATl[t * 65 + j0 + 2], ATl[t * 65 + j0 + 3]); wr.x = pk2(W1[t * 65 + j0], W1[t * 65 + j0 + 1]); wr.y = pk2(W1[t * 65 + j0 + 2], W1[t * 65 + j0 + 3]);
          *(v2u*)(rec + RC_AT + kk * 1024 + (16 * g + t) * 16 + half * 8) = wa; *(v2u*)(rec + RC_RT + kk * 1024 + (16 * g + t) * 16 + half * 8) = wr;
          const int j = tt & 63, gg = tt >> 6; v4u bk; bk.x = pk2(TB[(4 * gg) * 65 + j], TB[(4 * gg + 1) * 65 + j]); bk.y = pk2(TB[(4 * gg + 2) * 65 + j], TB[(4 * gg + 3) * 65 + j]);
          bk.z = pk2(TK[(4 * gg) * 65 + j], TK[(4 * gg + 1) * 65 + j]); bk.w = pk2(TK[(4 * gg + 2) * 65 + j], TK[(4 * gg + 3) * 65 + j]);
          *(v4u*)(rec + RC_BK + (j >> 4) * 1024 + (16 * gg + (j & 15)) * 16) = bk;
          v2u vf; vf.x = pk2(VV[(4 * gg) * 65 + j], VV[(4 * gg + 1) * 65 + j]); vf.y = pk2(VV[(4 * gg + 2) * 65 + j], VV[(4 * gg + 3) * 65 + j]);
          *(v2u*)(rec + RC_VF + ((j >> 4) * 64 + 16 * gg + (j & 15)) * 8) = vf; }
    }
}
#undef RC_FETCH
template <int HACK = 0> __device__ __forceinline__ void rwkv_scan_unit(Frame& F, int l, int b, int h) {
    LAS unsigned char* L = F.lds + RING_OFF;
    const unsigned char* recs = F.ws + WS_RWC + (size_t)(b * 16 + h) * RC_BYTES;
    const int lane = F.lane, n = lane & 15, g = lane >> 4;
    LAS float* XS = (LAS float*)(L + 2 * RC_BYTES);
    if (F.wave >= 2) {
        const int li = F.tid - 128;
        int px[4];
#pragma unroll
        for (int k = 0; k < 4; ++k) { const int x = li + 384 * k; px[k] = x < 1300 ? x : 1299; }
        v4u p0[4], p1[4], p2[4], p3[4], p4[4], p5[4], p6[4], p7[4];
#define RWL_ISSUE(P, CK) do { const int ck_ = (CK) < 512 ? ((HACK & 1) && (CK) >= 4 ? 3 : (CK)) : 511; const v4u* src_ = (const v4u*)(recs + (size_t)ck_ * 32 * RC_BYTES); \
        _Pragma("unroll") for (int k = 0; k < 4; ++k) P[k] = src_[px[k]]; } while (0)
#define RWL_WRITE(P, CK) do { LAS v4u* dst_ = (LAS v4u*)(L + ((CK) & 1) * RC_BYTES); _Pragma("unroll") for (int k = 0; k < 4; ++k) dst_[px[k]] = P[k]; } while (0)
        RWL_ISSUE(p0, 0); RWL_ISSUE(p1, 1); RWL_ISSUE(p2, 2); RWL_ISSUE(p3, 3); RWL_ISSUE(p4, 4); RWL_ISSUE(p5, 5); RWL_ISSUE(p6, 6); RWL_ISSUE(p7, 7);
        RWL_WRITE(p0, 0); RWL_ISSUE(p0, 8);
        LDS_BARRIER();
#pragma unroll 1
        for (int ck = 0; ck < 512; ck += 8) {
            RWL_WRITE(p1, ck + 1); RWL_ISSUE(p1, ck + 9); LDS_BARRIER();
            RWL_WRITE(p2, ck + 2); RWL_ISSUE(p2, ck + 10); LDS_BARRIER();
            RWL_WRITE(p3, ck + 3); RWL_ISSUE(p3, ck + 11); LDS_BARRIER();
            RWL_WRITE(p4, ck + 4); RWL_ISSUE(p4, ck + 12); LDS_BARRIER();
            RWL_WRITE(p5, ck + 5); RWL_ISSUE(p5, ck + 13); LDS_BARRIER();
            RWL_WRITE(p6, ck + 6); RWL_ISSUE(p6, ck + 14); LDS_BARRIER();
            RWL_WRITE(p7, ck + 7); RWL_ISSUE(p7, ck + 15); LDS_BARRIER();
            RWL_WRITE(p0, ck + 8); RWL_ISSUE(p0, ck + 16); LDS_BARRIER();
        }
#undef RWL_ISSUE
#undef RWL_WRITE
        return;
    }
    const int cw = F.wave;
    f32x4v S[4][2];
#pragma unroll
    for (int jt = 0; jt < 4; ++jt)
#pragma unroll
        for (int it = 0; it < 2; ++it) S[jt][it] = (f32x4v){0.f, 0.f, 0.f, 0.f};
    float lnw[2], lnb[2];
#pragma unroll
    for (int it = 0; it < 2; ++it) { lnw[it] = F.kin[I_RLNW][l * 1024 + h * 64 + 16 * (2 * cw + it) + n]; lnb[it] = F.kin[I_RLNB][l * 1024 + h * 64 + 16 * (2 * cw + it) + n]; }
    bf16* MIX = WSP(bf16, WS_MIXED) + ((size_t)b * SEQ) * DM + 2048 + h * 64 + 32 * cw + n;
    f32x4v Yp[2] = {(f32x4v){0.f, 0.f, 0.f, 0.f}, (f32x4v){0.f, 0.f, 0.f, 0.f}}, bnp = (f32x4v){0.f, 0.f, 0.f, 0.f}; v2u gfp[2] = {(v2u){0u, 0u}, (v2u){0u, 0u}}, vfp[2] = {(v2u){0u, 0u}, (v2u){0u, 0u}};
    LDS_BARRIER();
#pragma unroll 1
    for (int ck = 0; ck <= 512; ++ck) {
        if (ck > 0) {
            const LAS float* xs = XS + ((ck - 1) & 1) * 64; const f32x4v a0 = *(const LAS f32x4v*)(xs + 8 * g), a1 = *(const LAS f32x4v*)(xs + 8 * g + 4), b0 = *(const LAS f32x4v*)(xs + 32 + 8 * g), b1 = *(const LAS f32x4v*)(xs + 32 + 8 * g + 4);
            const float s1[4] = {a0[0] + b0[0], a0[2] + b0[2], a1[0] + b1[0], a1[2] + b1[2]}, s2[4] = {a0[1] + b0[1], a0[3] + b0[3], a1[1] + b1[1], a1[3] + b1[3]};
#pragma unroll
            for (int it = 0; it < 2; ++it) { const float gt[4] = {bflo(gfp[it].x), bfhi(gfp[it].x), bflo(gfp[it].y), bfhi(gfp[it].y)}, vt[4] = {bflo(vfp[it].x), bfhi(vfp[it].x), bflo(vfp[it].y), bfhi(vfp[it].y)};
#pragma unroll
                for (int r = 0; r < 4; ++r) { const float mean = s1[r] * (1.0f / 64.0f), var = fmaxf(s2[r] * (1.0f / 64.0f) - mean * mean, 0.f), rstd = rsqrtf(var + 64e-5f);
                    if (!(HACK & 2)) MIX[(size_t)((ck - 1) * 16 + 4 * g + r) * DM + 16 * it] = (bf16)f2bf(((Yp[it][r] - mean) * rstd * lnw[it] + lnb[it] + bnp[r] * vt[r]) * gt[r]); } }
            if (ck == 512) break;
        }
        if (HACK & 4) { LDS_BARRIER(); continue; }
        const LAS unsigned char* R = L + (ck & 1) * RC_BYTES;
        bf16x8 at[2], rt[2];
#pragma unroll
        for (int kk = 0; kk < 2; ++kk) { at[kk] = *(const LAS bf16x8*)(R + RC_AT + kk * 1024 + lane * 16); rt[kk] = *(const LAS bf16x8*)(R + RC_RT + kk * 1024 + lane * 16); }
        f32x4v U[2], Y[2];
#pragma unroll
        for (int it = 0; it < 2; ++it) { U[it] = *(const LAS f32x4v*)(R + RC_U0 + (2 * cw + it) * 1024 + lane * 16); Y[it] = *(const LAS f32x4v*)(R + RC_Y0 + (2 * cw + it) * 1024 + lane * 16); }
#pragma unroll
        for (int kk = 0; kk < 2; ++kk)
#pragma unroll
            for (int it = 0; it < 2; ++it) { v4u pw; pw.x = pg8::cvt_pk_bf16(S[2 * kk][it][0], S[2 * kk][it][1]); pw.y = pg8::cvt_pk_bf16(S[2 * kk][it][2], S[2 * kk][it][3]);
                pw.z = pg8::cvt_pk_bf16(S[2 * kk + 1][it][0], S[2 * kk + 1][it][1]); pw.w = pg8::cvt_pk_bf16(S[2 * kk + 1][it][2], S[2 * kk + 1][it][3]); const bf16x8 sf = __builtin_bit_cast(bf16x8, pw);
                U[it] = __builtin_amdgcn_mfma_f32_16x16x32_bf16(at[kk], sf, U[it], 0, 0, 0); Y[it] = __builtin_amdgcn_mfma_f32_16x16x32_bf16(rt[kk], sf, Y[it], 0, 0, 0); }
        bf16x8 uv[2];
#pragma unroll
        for (int it = 0; it < 2; ++it) { vfp[it] = *(const LAS v2u*)(R + RC_VF + (2 * cw + it) * 512 + lane * 8); gfp[it] = *(const LAS v2u*)(R + RC_GF + (2 * cw + it) * 512 + lane * 8);
            v4u pw; pw.x = pg8::cvt_pk_bf16(U[it][0], U[it][1]); pw.y = pg8::cvt_pk_bf16(U[it][2], U[it][3]); pw.z = vfp[it].x; pw.w = vfp[it].y; uv[it] = __builtin_bit_cast(bf16x8, pw); }
#pragma unroll
        for (int jt = 0; jt < 4; ++jt) { const bf16x8 bk = *(const LAS bf16x8*)(R + RC_BK + jt * 1024 + lane * 16); const f32x4v p15 = *(const LAS f32x4v*)(R + RC_P15 + (16 * jt + 4 * g) * 4);
#pragma unroll
            for (int it = 0; it < 2; ++it) S[jt][it] = __builtin_amdgcn_mfma_f32_16x16x32_bf16(bk, uv[it], S[jt][it] * p15, 0, 0, 0); }
        bnp = *(const LAS f32x4v*)(R + RC_BN + 16 * g); Yp[0] = Y[0]; Yp[1] = Y[1];
        { LAS float* xo = XS + (ck & 1) * 64 + cw * 32; const f32x4v sm = Y[0] + Y[1], sq = Y[0] * Y[0] + Y[1] * Y[1];
#pragma unroll
          for (int r = 0; r < 4; ++r) { const float a = sum16(sm[r]), q = sum16(sq[r]); if (n == 0) { xo[(4 * g + r) * 2] = a; xo[(4 * g + r) * 2 + 1] = q; } } }
        LDS_BARRIER();
    }
}
template <int HACK = 0> __device__ __forceinline__ void mixers_v4(Frame& F, int l, int qi, int mask = 15) {
    gu32* ctr = F.ctl + CW_Q + 64 * qi;
    for (;;) {
        const int it = next_item(F, ctr); relaunder(F); relaunder_tid(F);
        if (it < 32) { if (mask & 1) rwkv_scan_unit<HACK>(F, l, it >> 4, it & 15); }
        else if (it < 48) { const int j = it - 32; if (mask & 2) gla_scan_unit<HACK>(F, l, j >> 3, (j >> 1) & 3, j & 1); }
        else if (it < 48 + 1024) { const int j = it - 48, qb = 63 - (j >> 4), bh = j & 15; if (mask & 4) attn_unit<true>(F, l, bh >> 3, bh & 7, qb); }
        else if (it < 48 + 2048) { const int j = it - 1072, qb = j & 63, bh = j >> 6; if (mask & 8) attn_unit<false>(F, l, bh >> 3, bh & 7, qb); }
        else break;
    }
}
template <int HACK = 0> __device__ __forceinline__ void prep_rwkv(Frame& F, int l) {
    LAS float* zl = (LAS float*)(F.lds + RING_OFF) + 4096;
    LAS bf16* inb = (LAS bf16*)(F.lds + RING_OFF);
    const float* mu = F.kin[I_RMU] + (size_t)l * 3264;
    const float* LOWR = WSP(float, WS_LOWR); const bf16* COLS = WSP(bf16, WS_COLS);
    float* RW = WSP(float, WS_RW); unsigned* RWU = WSP(unsigned, WS_RW); float* VF = WSP(float, WS_VFIRST);
    constexpr size_t RS = RW_ONE / 4;
    for (int tile = F.bx; tile < M / 16; tile += F.G) {
        const int row0 = tile * 16;
        relaunder(F); relaunder_tid(F);
        __syncthreads();
        {
            float cur_[7], prv_[7], mu_[7];
#pragma unroll
            for (int q = 0; q < 7; ++q) { const int idx = F.tid + NWAVES * 64 * q, tt = idx / 224, j = idx % 224, row = row0 + tt;
                const int col = j < 192 ? 16 + j : 208 + (j - 192);
                const float* mp = j < 192 ? mu + 3072 + j : F.kin[I_VRMU] + (l ? (l - 1) * 32 : 0) + (j - 192);
                cur_[q] = LOWR[(size_t)row * 256 + col]; prv_[q] = LOWR[(size_t)((row & (SEQ - 1)) ? row - 1 : row) * 256 + col]; mu_[q] = *mp; }
#pragma unroll
            for (int q = 0; q < 7; ++q) { const int idx = F.tid + NWAVES * 64 * q, tt = idx / 224, j = idx % 224, row = row0 + tt;
                const float prev = (row & (SEQ - 1)) ? prv_[q] : 0.f, muv = (j >= 192 && l == 0) ? 0.f : mu_[q];
                float x = cur_[q] + (prev - cur_[q]) * muv;
                if (j < 64) x = tanhf(x); else if (j >= 128 && j < 192) x = sigmoid_f(x);
                inb[tt * 232 + j] = (bf16)f2bf(x); } }
        __syncthreads();
        {
            const int c = 2 * F.tid;
            float accw[2][16], acca[2][16], accg[2][16], accv[2][16];
#pragma unroll
            for (int e = 0; e < 2; ++e) { const float bw = F.kin[I_RW0][l * 1024 + c + e], ba = F.kin[I_RA0][l * 1024 + c + e], bv = l ? F.kin[I_VR0][(l - 1) * 1024 + c + e] : 0.f;
#pragma unroll
              for (int tt = 0; tt < 16; ++tt) { accw[e][tt] = bw; acca[e][tt] = ba; accg[e][tt] = 0.f; accv[e][tt] = bv; } }
#define LOWRANK_MFMA(ACC, MI, JOFF, NKS) do { const bf16* wf_ = WSP(bf16, WS_WF) + ((size_t)(l * 448 + ((MI) < 3 ? (MI) * 128 + 16 * (NKS) / 2 * F.wave : 384 + 8 * F.wave)) * 64 + F.lane) * 8; \
            bf16x8 af_[NKS], bf_[8][NKS]; \
            _Pragma("unroll") for (int ks = 0; ks < (NKS); ++ks) af_[ks] = *(const LAS bf16x8*)(inb + (F.lane & 15) * 232 + (JOFF) + 32 * ks + 8 * (F.lane >> 4)); \
            _Pragma("unroll") for (int nt = 0; nt < 8; ++nt) _Pragma("unroll") for (int ks = 0; ks < (NKS); ++ks) bf_[nt][ks] = *(const bf16x8*)(wf_ + (size_t)(nt * (NKS) + ks) * 512); \
            _Pragma("unroll") for (int nt = 0; nt < 8; ++nt) { f32x4 c4 = {0.f, 0.f, 0.f, 0.f}; \
                _Pragma("unroll") for (int ks = 0; ks < (NKS); ++ks) c4 = __builtin_amdgcn_mfma_f32_16x16x32_bf16(af_[ks], bf_[nt][ks], c4, 0, 0, 0); \
                _Pragma("unroll") for (int rr = 0; rr < 4; ++rr) zl[(4 * (F.lane >> 4) + rr) * 1028 + 128 * F.wave + 16 * nt + (F.lane & 15)] = c4[rr]; } \
            __builtin_amdgcn_wave_barrier(); asm volatile("s_waitcnt lgkmcnt(0)" ::: "memory"); __builtin_amdgcn_wave_barrier();   \
            _Pragma("unroll") for (int tt = 0; tt < 16; ++tt) { const f32x2_t z2 = *(const LAS f32x2_t*)(zl + tt * 1028 + c); ACC[0][tt] += z2.x; ACC[1][tt] += z2.y; } \
            __builtin_amdgcn_wave_barrier(); asm volatile("s_waitcnt lgkmcnt(0)" ::: "memory"); __builtin_amdgcn_wave_barrier(); } while (0)
            if (!(HACK & 1)) { LOWRANK_MFMA(accw, 0, 0, 2); relaunder(F);
            LOWRANK_MFMA(acca, 1, 64, 2); relaunder(F);
            LOWRANK_MFMA(accg, 2, 128, 2); relaunder(F);
            if (l) LOWRANK_MFMA(accv, 3, 192, 1); }
#undef LOWRANK_MFMA
            relaunder(F);
            float mur[2], muk[2], muv[2], kkv[2], kav[2], pr[2] = {0.f, 0.f}, pk[2] = {0.f, 0.f}, pv[2] = {0.f, 0.f}; float cl[2] = {0.f, 0.f};
#pragma unroll
            for (int e = 0; e < 2; ++e) { mur[e] = F.kin[I_RMU][l * 3264 + c + e]; muk[e] = F.kin[I_RMU][l * 3264 + 1024 + c + e]; muv[e] = F.kin[I_RMU][l * 3264 + 2048 + c + e]; kkv[e] = F.kin[I_RKK][l * 1024 + c + e]; kav[e] = F.kin[I_RKA][l * 1024 + c + e]; }
            if ((row0 & (SEQ - 1)) != 0) { const bf16* p = COLS + (size_t)(row0 - 1) * NMAIN + c; const unsigned ur = *(const unsigned*)(p + CC_R), uk = *(const unsigned*)(p + CC_K), uv = *(const unsigned*)(p + CC_V);
                pr[0] = bflo(ur); pr[1] = bfhi(ur); pk[0] = bflo(uk); pk[1] = bfhi(uk); pv[0] = bflo(uv); pv[1] = bfhi(uv); }
            constexpr int PFD = 4;
            unsigned pur[16], puk[16], puv[16]; f32x2_t pvf[16];
#define PF_TOK(T) do { const bf16* p_ = COLS + (size_t)(row0 + (T)) * NMAIN + c; pur[T] = *(const unsigned*)(p_ + CC_R); puk[T] = *(const unsigned*)(p_ + CC_K); puv[T] = *(const unsigned*)(p_ + CC_V); \
                pvf[T] = *(const f32x2_t*)(VF + (size_t)(row0 + (T)) * 1024 + c); } while (0)
#pragma unroll
            for (int tt = 0; tt < PFD; ++tt) PF_TOK(tt);
            asm volatile("" ::: "memory");
            if (!(HACK & 4))
#pragma unroll
            for (int tt = 0; tt < 16; ++tt) { const int row = row0 + tt; const size_t o = (size_t)row * 1024 + c;
                if (tt + PFD < 16) { PF_TOK(tt + PFD < 16 ? tt + PFD : 15); }
                asm volatile("" ::: "memory");
                const unsigned ur = pur[tt], uk = puk[tt], uv = puv[tt];
                const float cr[2] = {bflo(ur), bfhi(ur)}, ck[2] = {bflo(uk), bfhi(uk)}, cv[2] = {bflo(uv), bfhi(uv)};
                f32x2_t vf2 = pvf[tt];
                float r[2], k[2], v[2], dec[2], av[2], kk[2], km[2];
#pragma unroll
                for (int e = 0; e < 2; ++e) { r[e] = cr[e] + (pr[e] - cr[e]) * mur[e]; k[e] = ck[e] + (pk[e] - ck[e]) * muk[e]; v[e] = cv[e] + (pv[e] - cv[e]) * muv[e]; pr[e] = cr[e]; pk[e] = ck[e]; pv[e] = cv[e];
                    if (l == 0) vf2[e] = v[e]; else { const float vg = sigmoid_f(accv[e][tt]); v[e] = v[e] + (vf2[e] - v[e]) * vg; }
                    cl[e] += -0.6065306597126334f * sigmoid_f(accw[e][tt]); dec[e] = cl[e]; av[e] = sigmoid_f(acca[e][tt]); kk[e] = k[e] * kkv[e]; km[e] = k[e] * (1.0f + (av[e] - 1.0f) * kav[e]); }
                const float ss = sum32(kk[0] * kk[0] + kk[1] * kk[1]), rn = rsqrtf(fmaxf(ss, 1e-24f)); kk[0] *= rn; kk[1] *= rn;
                if (l == 0) *(f32x2_t*)(VF + o) = vf2;
                *(f32x2_t*)(RW + RS + o) = (f32x2_t){dec[0], dec[1]};
                *(v2u*)(RWU + o) = (v2u){pk2(r[0], km[0]), pk2(r[1], km[1])}; *(v2u*)(RWU + 2 * RS + o) = (v2u){pk2(v[0], accg[0][tt]), pk2(v[1], accg[1][tt])};
                *(v2u*)(RWU + 3 * RS + o) = (v2u){pk2(-kk[0], kk[0] * av[0]), pk2(-kk[1], kk[1] * av[1])}; }
#undef PF_TOK
        }
        asm volatile("s_waitcnt vmcnt(0)" ::: "memory"); __syncthreads();
        __builtin_amdgcn_fence(__ATOMIC_ACQUIRE, "agent"); asm volatile("s_waitcnt vmcnt(0)" ::: "memory");
        if (!(HACK & 2)) rwkv_chunks_of_tile(F, l, tile);
    }
}
struct Args { const float* in[35]; float* out; unsigned char* ws; };
__device__ __forceinline__ void mk_frame(Frame& F, int wv) {
    extern __shared__ __attribute__((aligned(16))) unsigned char lds[];
    kargp kp = (kargp)__builtin_amdgcn_kernarg_segment_ptr(); asm volatile("" : "+s"(kp));
    F.kin = kp;
    F.lds = (LAS unsigned char*)lds;
    F.MISC = (volatile LAS unsigned*)(F.lds + MISC_OFF);
    { int w_ = wv; asm volatile("" : "+s"(w_)); int t_ = (int)__builtin_amdgcn_mbcnt_hi(~0u, __builtin_amdgcn_mbcnt_lo(~0u, (unsigned)w_ * 64u)); asm volatile("" : "+v"(t_)); F.tid = t_; } F.lane = F.tid & 63; F.wave = __builtin_amdgcn_readfirstlane(F.tid >> 6);
    F.G = gridDim.x; { int bx = blockIdx.x; asm volatile("" : "+s"(bx)); F.bx = bx; F.vcu = (F.G % 8 == 0) ? (bx % 8) * (F.G / 8) + bx / 8 : bx; }
    F.out = (float*)kp[35]; F.ws = (unsigned char*)kp[36]; F.ctl = (gu32*)(F.ws + WS_CTL);
}
__device__ __forceinline__ void grid_bar(int wv) {
    Frame F; mk_frame(F, wv);
    XcdBarrier bar; bar.bar = (unsigned*)(F.ctl + CW_BAR); bar.x = xb_xcc_id(); bar.st = F.MISC + 8;
    xcd_barrier(bar);
}
__global__ void __launch_bounds__(NWAVES * 64, 2) mega_fwd(Args args) {
    const int wv = __builtin_amdgcn_readfirstlane((int)threadIdx.x >> 6);
    { Frame F; mk_frame(F, wv);
      for (int u = F.tid; u < (LDS_BYTES - LDSCTL_OFF) / 4; u += NWAVES * 64) ((LAS unsigned*)(F.lds + LDSCTL_OFF))[u] = 0u;
      __syncthreads();
      (void)xcd_barrier_post((unsigned*)(F.ctl + CW_BAR), F.MISC + 8);
      p0_prologue_a(F);
    }
    grid_bar(wv);
    { Frame F; mk_frame(F, wv); p0_prologue_b(F); }
    grid_bar(wv);
#pragma unroll 1
    for (int l = 0; l < NLAYER; ++l) {
#define LAYER_VARS const float* mod = WSP(float, WS_MOD) + (size_t)l * 2 * 24576; const float* xin = l == 0 ? F.kin[I_X] : F.out; (void)mod; (void)xin
        { Frame F; mk_frame(F, wv); LAYER_VARS; if (l == 0) rms_phase(F, F.kin[I_X], mod + 0, mod + 4096); else rms_phase_bf(F, mod + 0, mod + 4096); }
        grid_bar(wv);
        { Frame F; mk_frame(F, wv);
          pg8::Gemm g{WSP(pg8::bf16_t, WS_XN), WSP(pg8::bf16_t, WS_WIN + l * WIN_L), M, NIN, DM}; pg8::StaticOrder S; S.init(M, NIN, F.G, F.bx);
          pg8::EpiCols E{WSP(pg8::bf16_t, WS_COLS), WSP(float, WS_LOWR)};
          pg8::gemm_phase<pg8::EpiCols, pg8::StaticOrder, true, true>(F.lds + RING_OFF, g, S, E, F.tid); }
        grid_bar(wv);
        { Frame F; mk_frame(F, wv); prep_norm(F, l); }
        { Frame F; mk_frame(F, wv); prep_loga(F, l); }
        { Frame F; mk_frame(F, wv); prep_rwkv(F, l); }
        { Frame F; mk_frame(F, wv); prep_vt<0>(F); }
        { Frame F; mk_frame(F, wv); prep_vt<1>(F); }
        { Frame F; mk_frame(F, wv); prep_vt<2>(F); }
        { Frame F; mk_frame(F, wv); prep_vt<3>(F); }
        { Frame F; mk_frame(F, wv); prep_vt<4>(F); }
        { Frame F; mk_frame(F, wv); prep_gla(F); }
        grid_bar(wv);
        { Frame F; mk_frame(F, wv); mixers_v4(F, l, l); }
        grid_bar(wv);
        { Frame F; mk_frame(F, wv); gla_post(F, l); }
        grid_bar(wv);
        { Frame F; mk_frame(F, wv); LAYER_VARS;
          pg8::Gemm g{WSP(pg8::bf16_t, WS_MIXED), WSP(pg8::bf16_t, WS_WOUT + l * WOUT_L), M, DM, DM}; pg8::StaticOrder S; S.init(M, DM, F.G, F.bx);
          pg8::EpiRes E{l == 0 ? (const void*)F.kin[I_X] : (const void*)WSP(bf16, WS_XR), (void*)WSP(bf16, WS_XR), mod + 2 * 4096, l != 0, true};
          pg8::gemm_phase<pg8::EpiRes, pg8::StaticOrder, true, true>(F.lds + RING_OFF, g, S, E, F.tid); }
        grid_bar(wv);
        { Frame F; mk_frame(F, wv); LAYER_VARS; rms_phase_bf(F, mod + 3 * 4096, mod + 4 * 4096); }
        grid_bar(wv);
        { Frame F; mk_frame(F, wv);
          pg8::Gemm g{WSP(pg8::bf16_t, WS_XN), WSP(pg8::bf16_t, WS_W13 + l * W13_L), M, 2 * DFF, DM}; pg8::StaticOrder S; S.init(M, 2 * DFF, F.G, F.bx);
          pg8::EpiSwiglu E{WSP(pg8::bf16_t, WS_HID)};
          pg8::gemm_phase<pg8::EpiSwiglu, pg8::StaticOrder, true, true>(F.lds + RING_OFF, g, S, E, F.tid); }
        grid_bar(wv);
        { Frame F; mk_frame(F, wv); LAYER_VARS;
          pg8::Gemm g{WSP(pg8::bf16_t, WS_HID), WSP(pg8::bf16_t, WS_W2 + l * W2_L), M, DM, DFF}; pg8::StaticOrder S; S.init(M, DM, F.G, F.bx);
          pg8::EpiRes E{(const void*)WSP(bf16, WS_XR), l + 1 < NLAYER ? (void*)WSP(bf16, WS_XR) : (void*)F.out, mod + 5 * 4096, true, l + 1 < NLAYER};
          pg8::gemm_phase<pg8::EpiRes, pg8::StaticOrder, true, true>(F.lds + RING_OFF, g, S, E, F.tid); }
        if (l + 1 < NLAYER) grid_bar(wv);
#undef LAYER_VARS
    }
}

extern "C" void kernel_launch(void* const* d_in, const int* in_sizes, int n_in, void* d_out, int out_size, void* d_ws, size_t ws_size, hipStream_t stream) {
    static int grid = 0;
    if (grid == 0) {
        if (n_in != 35 || in_sizes[0] != M * DM || out_size != M * DM || ws_size < WS_END) { fprintf(stderr, "kernel_launch: unexpected shapes: n_in %d in0 %d out %d ws %zu (need %zu)\n", n_in, n_in > 0 ? in_sizes[0] : -1, out_size, ws_size, (size_t)WS_END); grid = -1; return; }
        int dev = 0, cus = 0, per_cu = 0;
        if (hipGetDevice(&dev) != hipSuccess || hipDeviceGetAttribute(&cus, hipDeviceAttributeMultiprocessorCount, dev) != hipSuccess) { grid = -1; return; }
        if (hipFuncSetAttribute((const void*)mega_fwd, hipFuncAttributeMaxDynamicSharedMemorySize, LDS_BYTES) != hipSuccess) { fprintf(stderr, "kernel_launch: hipFuncSetAttribute failed\n"); grid = -1; return; }
        if (hipOccupancyMaxActiveBlocksPerMultiprocessor(&per_cu, (const void*)mega_fwd, NWAVES * 64, LDS_BYTES) != hipSuccess || per_cu < 1) fprintf(stderr, "kernel_launch: occupancy query says %d\n", per_cu);
        (void)hipGetLastError();
        grid = cus;
    }
    if (grid < 0) return;
    if (hipMemsetAsync((char*)d_ws + WS_CTL, 0, CTL_ZERO_BYTES, stream) != hipSuccess) return;
    Args a{};
    for (int i = 0; i < 35; ++i) a.in[i] = (const float*)d_in[i];
    a.out = (float*)d_out; a.ws = (unsigned char*)d_ws;
    hipLaunchKernelGGL(mega_fwd, dim3(grid), dim3(NWAVES * 64), LDS_BYTES, stream, a);
}
```

```cpp
#include <hip/hip_runtime.h>
#include <cstdio>
#include <cstdint>
namespace pg8 {
#define PG8_LAS __attribute__((address_space(3)))
typedef unsigned short bf16_t;
typedef short bf16x8 __attribute__((ext_vector_type(8)));
typedef float f32x4 __attribute__((ext_vector_type(4)));
typedef unsigned u32x4 __attribute__((ext_vector_type(4)));
constexpr int BM = 256, BK = 64, HALF = 128, HTB = HALF * BK * 2  , STAGE_BYTES = 8 * HTB, NXCD = 8, WGM = 8;

__host__ __device__ __forceinline__ int lds_byte(int r, int c) { const int st = (r >> 4) * 2 + (c >> 5), rr = r & 15, cc = c & 31, ob = rr * 64 + cc * 2; return st * 1024 + (ob ^ (((ob >> 9) & 1) << 5)); }
__host__ __device__ __forceinline__ void stage_rc(int b, int& R, int& C) { const int st = b / 1024, sb = b % 1024, swz = sb ^ (((sb >> 9) & 1) << 5); R = (st >> 1) * 16 + swz / 64; C = (st & 1) * 32 + (swz % 64) / 2; }
__host__ __device__ __forceinline__ int perm32(int rho) { const int n = rho >> 4, i = rho & 15; return 8 * (i >> 2) + 4 * n + (i & 3); }

struct Unit { int pm, pn; };
struct Gemm { const bf16_t* A; const bf16_t* Bt; int M, N, K; };

struct StaticOrder {
    int nM, nN, nwg, G, c;
    __host__ __device__ void init(int M, int N, int G_, int c_) { nM = M / BM; nN = N / BM; nwg = nM * nN; G = G_; c = c_; }
    __host__ __device__ bool next(int i, Unit& u) const {
        const long L = (long)i * G + c; if (L >= nwg) return false;
        int wgid = (int)L; { const int q = nwg / NXCD, r = nwg % NXCD, xcd = wgid % NXCD, off = wgid / NXCD; wgid = (xcd < r ? xcd * (q + 1) : r * (q + 1) + (xcd - r) * q) + off; }
        const int nig = WGM * nN, gid = wgid / nig, fm = gid * WGM, gsz = (nM - fm) < WGM ? (nM - fm) : WGM;
        u.pm = fm + ((wgid % nig) % gsz); u.pn = (wgid % nig) / gsz; return true;
    }
    __device__ __forceinline__ void a_ready(const Unit&) const {}
    __device__ __forceinline__ void done(const Unit&) const {}
};

typedef float f32x2c_t __attribute__((ext_vector_type(2))); typedef __bf16 bf16x2c_t __attribute__((ext_vector_type(2)));
__device__ __forceinline__ unsigned cvt_pk_bf16(float lo, float hi) { const f32x2c_t v = {lo, hi}; return __builtin_bit_cast(unsigned, __builtin_convertvector(v, bf16x2c_t)); }
typedef float f32x2 __attribute__((ext_vector_type(2)));
__device__ __forceinline__ float silu_f(float x) { return x * __builtin_amdgcn_rcpf(1.0f + __builtin_amdgcn_exp2f(-1.4426950408889634f * x)); }
struct EpiCols {
    static constexpr bool PERM = true, AFTER_DRAIN = false;
    bf16_t* O; float* L;
    __device__ __forceinline__ void operator()(const f32x4 (&acc)[2][2][4][2], const Unit& u, int wr, int wc, int fr, int fq) const {
        const int row0 = u.pm * BM + wr * 64 + fr;
        if (u.pn < 41) {
            const int col0 = u.pn * BM + wc * 32 + 8 * fq;
#pragma unroll
            for (int ai = 0; ai < 2; ++ai)
#pragma unroll
                for (int m = 0; m < 4; ++m) { bf16_t* rowp = O + (size_t)(row0 + ai * HALF + m * 16) * 10496 + col0;
#pragma unroll
                    for (int bj = 0; bj < 2; ++bj) { const f32x4 v0 = acc[ai][bj][m][0], v1 = acc[ai][bj][m][1];
                        u32x4 w; w.x = cvt_pk_bf16(v0[0], v0[1]); w.y = cvt_pk_bf16(v0[2], v0[3]); w.z = cvt_pk_bf16(v1[0], v1[1]); w.w = cvt_pk_bf16(v1[2], v1[3]);
                        *(u32x4*)(rowp + bj * HALF) = w; } }
        } else {
            const int col0 = wc * 32 + 8 * fq;
#pragma unroll
            for (int ai = 0; ai < 2; ++ai)
#pragma unroll
                for (int m = 0; m < 4; ++m) { float* rowp = L + (size_t)(row0 + ai * HALF + m * 16) * 256 + col0;
#pragma unroll
                    for (int bj = 0; bj < 2; ++bj) { *(f32x4*)(rowp + bj * HALF) = acc[ai][bj][m][0]; *(f32x4*)(rowp + bj * HALF + 4) = acc[ai][bj][m][1]; } }
        }
    }
};
struct EpiRes {
    static constexpr bool PERM = true, AFTER_DRAIN = false;
    const void* base; void* out; const float* gate; bool base_bf, out_bf;
    __device__ __forceinline__ void operator()(const f32x4 (&acc)[2][2][4][2], const Unit& u, int wr, int wc, int fr, int fq) const {
        const int row0 = u.pm * BM + wr * 64 + fr, col0 = u.pn * BM + wc * 32 + 8 * fq;
        const float* gp = gate + (size_t)(u.pm >> 5) * 24576 + col0;
        f32x4 gv[2][2];
#pragma unroll
        for (int bj = 0; bj < 2; ++bj)
#pragma unroll
            for (int n = 0; n < 2; ++n) gv[bj][n] = *(const f32x4*)(gp + bj * HALF + n * 4);
#pragma unroll
        for (int ai = 0; ai < 2; ++ai) {
            f32x4 r[4][2][2];
            if (base_bf) {
#pragma unroll
                for (int m = 0; m < 4; ++m)
#pragma unroll
                    for (int bj = 0; bj < 2; ++bj) { const u32x4 w = *(const u32x4*)((const bf16_t*)base + (size_t)(row0 + ai * HALF + m * 16) * 4096 + col0 + bj * HALF);
                        r[m][bj][0] = (f32x4){__builtin_bit_cast(float, w.x << 16), __builtin_bit_cast(float, w.x & 0xffff0000u), __builtin_bit_cast(float, w.y << 16), __builtin_bit_cast(float, w.y & 0xffff0000u)};
                        r[m][bj][1] = (f32x4){__builtin_bit_cast(float, w.z << 16), __builtin_bit_cast(float, w.z & 0xffff0000u), __builtin_bit_cast(float, w.w << 16), __builtin_bit_cast(float, w.w & 0xffff0000u)}; }
            } else {
#pragma unroll
                for (int m = 0; m < 4; ++m)
#pragma unroll
                    for (int bj = 0; bj < 2; ++bj)
#pragma unroll
                        for (int n = 0; n < 2; ++n) r[m][bj][n] = *(const f32x4*)((const float*)base + (size_t)(row0 + ai * HALF + m * 16) * 4096 + col0 + bj * HALF + n * 4);
            }
#pragma unroll
            for (int m = 0; m < 4; ++m)
#pragma unroll
                for (int bj = 0; bj < 2; ++bj)
#pragma unroll
                    for (int n = 0; n < 2; ++n) r[m][bj][n] = r[m][bj][n] + gv[bj][n] * acc[ai][bj][m][n];
            if (out_bf) {
#pragma unroll
                for (int m = 0; m < 4; ++m)
#pragma unroll
                    for (int bj = 0; bj < 2; ++bj) { const f32x4 v0 = r[m][bj][0], v1 = r[m][bj][1];
                        u32x4 w; w.x = cvt_pk_bf16(v0[0], v0[1]); w.y = cvt_pk_bf16(v0[2], v0[3]); w.z = cvt_pk_bf16(v1[0], v1[1]); w.w = cvt_pk_bf16(v1[2], v1[3]);
                        *(u32x4*)((bf16_t*)out + (size_t)(row0 + ai * HALF + m * 16) * 4096 + col0 + bj * HALF) = w; }
            } else {
#pragma unroll
                for (int m = 0; m < 4; ++m)
#pragma unroll
                    for (int bj = 0; bj < 2; ++bj)
#pragma unroll
                        for (int n = 0; n < 2; ++n) *(f32x4*)((float*)out + (size_t)(row0 + ai * HALF + m * 16) * 4096 + col0 + bj * HALF + n * 4) = r[m][bj][n];
            }
            asm volatile("" ::: "memory");
        }
    }
};
struct EpiSwiglu {
    static constexpr bool PERM = true, AFTER_DRAIN = false;
    bf16_t* H;
    __device__ __forceinline__ void operator()(const f32x4 (&acc)[2][2][4][2], const Unit& u, int wr, int wc, int fr, int fq) const {
        const int row0 = u.pm * BM + wr * 64 + fr, col0 = u.pn * HALF + wc * 32 + 8 * fq;
#pragma unroll
        for (int ai = 0; ai < 2; ++ai)
#pragma unroll
            for (int m = 0; m < 4; ++m) { bf16_t* rowp = H + (size_t)(row0 + ai * HALF + m * 16) * 11008 + col0;
                const f32x4 a0 = acc[ai][0][m][0], a1 = acc[ai][0][m][1], b0 = acc[ai][1][m][0], b1 = acc[ai][1][m][1];
                u32x4 w; w.x = cvt_pk_bf16(silu_f(a0[0]) * b0[0], silu_f(a0[1]) * b0[1]); w.y = cvt_pk_bf16(silu_f(a0[2]) * b0[2], silu_f(a0[3]) * b0[3]);
                w.z = cvt_pk_bf16(silu_f(a1[0]) * b1[0], silu_f(a1[1]) * b1[1]); w.w = cvt_pk_bf16(silu_f(a1[2]) * b1[2], silu_f(a1[3]) * b1[3]);
                *(u32x4*)rowp = w; }
    }
};
template <class Epi, class Sched, bool ALIGN_EPI = false, bool SP2 = false>
__device__ __forceinline__ void gemm_phase(PG8_LAS unsigned char* lds, const Gemm g, const Sched& S, const Epi& E, int tid_in) {
    int tid_ = tid_in; asm volatile("" : "+v"(tid_));
    const int tid = tid_, wid = __builtin_amdgcn_readfirstlane(tid >> 6), lane = tid & 63, wr = wid >> 2, wc = wid & 3, fr = lane & 15, fq = lane >> 4;
    const int K = g.K, nt = K / BK;
    unsigned voffA[2], voffB[2];
#pragma unroll
    for (int i = 0; i < 2; ++i) { int R, C; stage_rc(tid * 16 + i * 8192, R, C); const int Rb = Epi::PERM ? ((R & ~31) + perm32(R & 31)) : R;
        voffA[i] = (unsigned)(R * K + C) * 2u; voffB[i] = (unsigned)(Rb * K + C) * 2u; }
    const size_t kstep = (size_t)(BK * 2);
    const size_t hstep = (size_t)HALF * K * 2;
    const size_t tstep = 2 * hstep;
    const unsigned ldsw = (unsigned)wid * 1024u;
    const int aoff = lds_byte(wr * 64 + fr, fq * 8), boff = lds_byte(wc * 32 + fr, fq * 8);
#define PG8_SA(b, h) (((b) * 2 + (h)) * HTB)
#define PG8_SB(b, h) ((4 + (b) * 2 + (h)) * HTB)
#define PG8_STAGE(bufoff, gbase, voff) do { _Pragma("unroll") for (int _i = 0; _i < 2; ++_i) \
        __builtin_amdgcn_global_load_lds((const unsigned*)((const char*)(gbase) + (voff)[_i]), (PG8_LAS unsigned*)(lds + (bufoff) + ldsw + _i * 8192), 16, 0, 0); } while (0)
#define PG8_LDA(dst, b, h) do { _Pragma("unroll") for (int m = 0; m < 4; ++m) _Pragma("unroll") for (int k = 0; k < 2; ++k) dst[m][k] = *(const PG8_LAS bf16x8*)(lds + PG8_SA(b, h) + aoff + m * 2048 + k * 1024); } while (0)
#define PG8_LDB(dst, b, h) do { _Pragma("unroll") for (int n = 0; n < 2; ++n) _Pragma("unroll") for (int k = 0; k < 2; ++k) dst[n][k] = *(const PG8_LAS bf16x8*)(lds + PG8_SB(b, h) + boff + n * 2048 + k * 1024); } while (0)
#define PG8_MMA(ai, bj, At, Bt) do { __builtin_amdgcn_s_setprio(1); _Pragma("unroll") for (int m = 0; m < 4; ++m) _Pragma("unroll") for (int n = 0; n < 2; ++n) _Pragma("unroll") for (int k = 0; k < 2; ++k) \
        acc[ai][bj][m][n] = __builtin_amdgcn_mfma_f32_16x16x32_bf16(Bt[n][k], At[m][k], acc[ai][bj][m][n], 0, 0, 0); __builtin_amdgcn_s_setprio(0); } while (0)
#define PG8_WAIT_V(n) asm volatile("s_waitcnt vmcnt(" #n ")" ::: "memory")
#define PG8_WAIT_L(n) asm volatile("s_waitcnt lgkmcnt(" #n ")" ::: "memory")
#define PG8_BAR __builtin_amdgcn_s_barrier()
#define PG8_SCHED __builtin_amdgcn_sched_barrier(0)
    Unit cur, nxt; int ui = 0;
    if (!S.next(0, cur)) return;
    f32x4 acc[2][2][4][2];
#pragma unroll
    for (int a = 0; a < 2; ++a)
#pragma unroll
        for (int b = 0; b < 2; ++b)
#pragma unroll
            for (int m = 0; m < 4; ++m)
#pragma unroll
                for (int n = 0; n < 2; ++n) acc[a][b][m][n] = (f32x4){0.f, 0.f, 0.f, 0.f};
    bf16x8 At[4][2], B0[2][2], B1[2][2];
    const char* cA = (const char*)g.A + (size_t)cur.pm * tstep; const char* cB = (const char*)g.Bt + (size_t)cur.pn * tstep;
    S.a_ready(cur);
    if constexpr (SP2) {
        PG8_STAGE(PG8_SB(0, 0), cB, voffB); PG8_STAGE(PG8_SB(0, 1), cB + hstep, voffB); PG8_STAGE(PG8_SA(0, 0), cA, voffA); PG8_STAGE(PG8_SA(0, 1), cA + hstep, voffA);
        if (wr == 1) PG8_BAR;
        PG8_WAIT_V(2); PG8_BAR;
        PG8_STAGE(PG8_SB(1, 0), cB + kstep, voffB); PG8_STAGE(PG8_SA(1, 0), cA + kstep, voffA); PG8_STAGE(PG8_SB(1, 1), cB + hstep + kstep, voffB);
        PG8_WAIT_V(6); PG8_BAR;
    } else {
        PG8_STAGE(PG8_SB(0, 0), cB, voffB); PG8_STAGE(PG8_SA(0, 0), cA, voffA); PG8_STAGE(PG8_SB(0, 1), cB + hstep, voffB); PG8_STAGE(PG8_SA(0, 1), cA + hstep, voffA);
        if (wr == 1) PG8_BAR;
        PG8_WAIT_V(4); PG8_BAR;
        PG8_STAGE(PG8_SB(1, 0), cB + kstep, voffB); PG8_STAGE(PG8_SA(1, 0), cA + kstep, voffA); PG8_STAGE(PG8_SB(1, 1), cB + hstep + kstep, voffB);
        PG8_WAIT_V(6); PG8_BAR;
    }
    for (;;) {
        const bool has_next = S.next(ui + 1, nxt);
        const char* nA = has_next ? (const char*)g.A + (size_t)nxt.pm * tstep : cA; const char* nB = has_next ? (const char*)g.Bt + (size_t)nxt.pn * tstep : cB;
        for (int t = 0; t < nt; t += 2) {
            const bool last = (t == nt - 2);
            const char* a1 = cA + (size_t)(t + 1) * kstep;
            const char* a2 = last ? nA : cA + (size_t)(t + 2) * kstep; const char* b2 = last ? nB : cB + (size_t)(t + 2) * kstep;
            const char* a3 = a2 + kstep; const char* b3 = b2 + kstep;
            if (last && has_next) S.a_ready(nxt);
            if constexpr (SP2) {
            PG8_LDB(B0, 0, 0); PG8_LDB(B1, 0, 1); PG8_SCHED; PG8_LDA(At, 0, 0); PG8_STAGE(PG8_SA(1, 1), a1 + hstep, voffA);
            PG8_WAIT_V(8); PG8_WAIT_L(0); PG8_BAR; PG8_MMA(0, 0, At, B0); PG8_MMA(0, 1, At, B1); PG8_BAR; PG8_SCHED;
            PG8_LDA(At, 0, 1); PG8_STAGE(PG8_SB(0, 0), b2, voffB); PG8_STAGE(PG8_SB(0, 1), b2 + hstep, voffB); PG8_STAGE(PG8_SA(0, 0), a2, voffA);
            PG8_WAIT_V(8); PG8_WAIT_L(0); PG8_BAR; PG8_MMA(1, 0, At, B0); PG8_MMA(1, 1, At, B1); PG8_BAR; PG8_SCHED;
            PG8_LDB(B0, 1, 0); PG8_LDB(B1, 1, 1); PG8_SCHED; PG8_LDA(At, 1, 0); PG8_STAGE(PG8_SA(0, 1), a2 + hstep, voffA);
            PG8_WAIT_V(8); PG8_WAIT_L(0); PG8_BAR; PG8_MMA(0, 0, At, B0); PG8_MMA(0, 1, At, B1); PG8_BAR; PG8_SCHED;
            PG8_LDA(At, 1, 1); PG8_STAGE(PG8_SB(1, 0), b3, voffB); PG8_STAGE(PG8_SB(1, 1), b3 + hstep, voffB); PG8_STAGE(PG8_SA(1, 0), a3, voffA);
            PG8_WAIT_V(8); PG8_WAIT_L(0); PG8_BAR; PG8_MMA(1, 0, At, B0); PG8_MMA(1, 1, At, B1); PG8_BAR; PG8_SCHED;
            } else {
            PG8_LDB(B0, 0, 0); PG8_SCHED; PG8_LDA(At, 0, 0); PG8_STAGE(PG8_SA(1, 1), a1 + hstep, voffA);
            PG8_WAIT_L(8); PG8_BAR; PG8_WAIT_L(0); PG8_MMA(0, 0, At, B0); PG8_BAR; PG8_SCHED;
            PG8_LDB(B1, 0, 1); PG8_STAGE(PG8_SB(0, 0), b2, voffB);
            PG8_BAR; PG8_WAIT_L(0); PG8_MMA(0, 1, At, B1); PG8_BAR;
            PG8_LDA(At, 0, 1); PG8_STAGE(PG8_SA(0, 0), a2, voffA);
            PG8_BAR; PG8_WAIT_L(0); PG8_MMA(1, 0, At, B0); PG8_BAR; PG8_SCHED;
            PG8_STAGE(PG8_SB(0, 1), b2 + hstep, voffB);
            PG8_WAIT_V(6); PG8_BAR; PG8_MMA(1, 1, At, B1); PG8_BAR;
            PG8_LDB(B0, 1, 0); PG8_SCHED; PG8_LDA(At, 1, 0); PG8_STAGE(PG8_SA(0, 1), a2 + hstep, voffA);
            PG8_WAIT_L(8); PG8_BAR; PG8_WAIT_L(0); PG8_MMA(0, 0, At, B0); PG8_BAR; PG8_SCHED;
            PG8_LDB(B1, 1, 1); PG8_STAGE(PG8_SB(1, 0), b3, voffB);
            PG8_BAR; PG8_WAIT_L(0); PG8_MMA(0, 1, At, B1); PG8_BAR;
            PG8_LDA(At, 1, 1); PG8_STAGE(PG8_SA(1, 0), a3, voffA);
            PG8_BAR; PG8_WAIT_L(0); PG8_MMA(1, 0, At, B0); PG8_BAR; PG8_SCHED;
            PG8_STAGE(PG8_SB(1, 1), b3 + hstep, voffB);
            PG8_WAIT_V(6); PG8_BAR; PG8_MMA(1, 1, At, B1); PG8_BAR;
            }
        }
        if constexpr (ALIGN_EPI) { if (wr == 0) PG8_BAR; }
        if constexpr (!Epi::AFTER_DRAIN) { unsigned z_ = 0u; asm volatile("" : "+s"(z_)); const int le_ = (int)__builtin_amdgcn_mbcnt_hi(~0u, __builtin_amdgcn_mbcnt_lo(~0u, z_));
          E(acc, cur, wr, wc, le_ & 15, le_ >> 4); S.done(cur); }
        if (!has_next) break;
#pragma unroll
        for (int a = 0; a < 2; ++a)
#pragma unroll
            for (int b = 0; b < 2; ++b)
#pragma unroll
                for (int m = 0; m < 4; ++m)
#pragma unroll
                    for (int n = 0; n < 2; ++n) acc[a][b][m][n] = (f32x4){0.f, 0.f, 0.f, 0.f};
        cur = nxt; cA = nA; cB = nB; ++ui;
        if constexpr (ALIGN_EPI) { if (wr == 1) PG8_BAR; }
    }
    PG8_WAIT_V(0);
    if constexpr (!ALIGN_EPI) { if (wr == 0) PG8_BAR; }
    PG8_BAR;
    if constexpr (Epi::AFTER_DRAIN) { E.fused(acc, cur, wr, wc, fr, fq, lds, wid, lane); S.done(cur); }
#undef PG8_SA
#undef PG8_SB
#undef PG8_STAGE
#undef PG8_LDA
#undef PG8_LDB
#undef PG8_MMA
#undef PG8_WAIT_V
#undef PG8_WAIT_L
#undef PG8_BAR
#undef PG8_SCHED
}
}
constexpr int BATCH = 2, SEQ = 8192, DM = 4096, M = BATCH * SEQ, DFF = 11008, NLAYER = 2;
constexpr int P_IN = 10704, NIN = 10752, NMAIN = 10496;
constexpr int CA_Q = 0, CA_K = 1024, CA_V = 2048;
constexpr int CB_Q = 3072, CB_K = 3584, CB_V = 4096, CB_G = 5120;
constexpr int CC_R = 6144, CC_K = 7168, CC_V = 8192;
constexpr int CD_Q = 9216, CD_K = 10240, CD_V = 10368;
constexpr float LOG2E = 1.4426950408889634f;
constexpr float QSCALE = 0.125f * LOG2E;
constexpr int NWAVES = 8;

constexpr size_t MiB = 1u << 20;
constexpr size_t WS_CTL = 0, CTL_ZERO_BYTES = 1 * MiB;
constexpr size_t WS_MODP = 2 * MiB;
constexpr size_t WS_MOD = 14 * MiB;
constexpr size_t WS_TAB = 15 * MiB;
constexpr size_t WS_WIN = 16 * MiB, WIN_L = 84 * MiB;
constexpr size_t WS_WOUT = 184 * MiB, WOUT_L = 32 * MiB;
constexpr size_t WS_W13 = 248 * MiB, W13_L = 172 * MiB;
constexpr size_t WS_W2 = 592 * MiB, W2_L = 86 * MiB;
constexpr size_t WS_XN = 764 * MiB;
constexpr size_t WS_COLS = 892 * MiB;
constexpr size_t WS_LOWR = 1220 * MiB;
constexpr size_t WS_HID = 892 * MiB;
constexpr size_t WS_QKA = 1236 * MiB;
constexpr size_t WS_QKD = 1300 * MiB;
constexpr size_t WS_LOGA = 1336 * MiB;
constexpr size_t WS_RW = 1368 * MiB, RW_ONE = 64 * MiB;
constexpr size_t WS_VFIRST = 1816 * MiB;
constexpr size_t WS_MIXED = 1880 * MiB;
constexpr int VROW = SEQ + 64;
constexpr size_t WS_VTA = 2008 * MiB;
constexpr size_t WS_VTD = 2041 * MiB;
constexpr size_t WS_QDEC = 2046 * MiB, WS_KDT = 2062 * MiB, WS_AM = 2078 * MiB, WS_EBL = 2086 * MiB;
constexpr size_t WS_VTB = 2087 * MiB;
constexpr size_t WS_RWC = 2120 * MiB;
constexpr size_t WS_OB = 2446 * MiB;
constexpr size_t WS_PSG = 2478 * MiB;
constexpr size_t WS_WF = 2479 * MiB;
constexpr size_t WS_XR = 2480 * MiB;
constexpr size_t WS_END = 2608 * MiB;
constexpr int CW_BAR = 4096;
constexpr int CW_Q = 16384;

constexpr int RING_OFF = 0, RING_BYTES = 131072;
constexpr int LDSCTL_OFF = RING_BYTES, MISC_OFF = LDSCTL_OFF + 320;
constexpr int LDS_BYTES = 147456;

#define GAS __attribute__((address_space(1)))
#define LAS __attribute__((address_space(3)))
typedef unsigned short bf16;
typedef unsigned v4u __attribute__((ext_vector_type(4)));
typedef unsigned v2u __attribute__((ext_vector_type(2)));
typedef float f32x4 __attribute__((ext_vector_type(4)));
typedef short bf16x8 __attribute__((ext_vector_type(8)));
typedef GAS unsigned gu32;
#define RLX_AGENT __ATOMIC_RELAXED, __HIP_MEMORY_SCOPE_AGENT
#define LDS_WAIT() asm volatile("s_waitcnt lgkmcnt(0)" ::: "memory")
#define VM_WAIT() asm volatile("s_waitcnt vmcnt(0)" ::: "memory")
typedef float f32x2_t __attribute__((ext_vector_type(2))); typedef __bf16 bf16x2_t __attribute__((ext_vector_type(2)));
__device__ __forceinline__ unsigned pk2(float lo, float hi) { const f32x2_t v = {lo, hi}; return __builtin_bit_cast(unsigned, __builtin_convertvector(v, bf16x2_t)); }
__device__ __forceinline__ unsigned f2bf(float f) { return pk2(f, f) & 0xffffu; }
__device__ __forceinline__ float bf2f(unsigned short h) { return __builtin_bit_cast(float, (unsigned)h << 16); }
__device__ __forceinline__ float bflo(unsigned w) { return __builtin_bit_cast(float, w << 16); }
__device__ __forceinline__ float bfhi(unsigned w) { return __builtin_bit_cast(float, w & 0xffff0000u); }
template <int CTRL> __device__ __forceinline__ float dpp_f(float v) { return __builtin_bit_cast(float, __builtin_amdgcn_update_dpp(0, __builtin_bit_cast(int, v), CTRL, 0xF, 0xF, true)); }
__device__ __forceinline__ float sum8(float v) {
    v += dpp_f<0xB1>(v); v += dpp_f<0x4E>(v); v += dpp_f<0x141>(v); return v; }
__device__ __forceinline__ float sum32(float v) {
    v = sum8(v); v += dpp_f<0x140>(v); v += __builtin_bit_cast(float, __builtin_amdgcn_ds_swizzle(__builtin_bit_cast(int, v), 0x401F)); return v; }
__device__ __forceinline__ float wave_sum(float v) {
    v = sum8(v); v += dpp_f<0x140>(v);
    v += __builtin_bit_cast(float, __builtin_amdgcn_ds_swizzle(__builtin_bit_cast(int, v), 0x401F));
    { const int u = __builtin_bit_cast(int, v); v = __builtin_bit_cast(float, __builtin_amdgcn_readlane(u, 0)) + __builtin_bit_cast(float, __builtin_amdgcn_readlane(u, 32)); }
    return v;
}
__device__ __forceinline__ float sigmoid_f(float x) { return __builtin_amdgcn_rcpf(1.0f + __builtin_amdgcn_exp2f(-LOG2E * x)); }
__device__ __forceinline__ float silu_g(float x) { return x * sigmoid_f(x); }
__device__ __forceinline__ void unpack8(const v4u r, float (&f)[8]) { f[0] = bflo(r.x); f[1] = bfhi(r.x); f[2] = bflo(r.y); f[3] = bfhi(r.y); f[4] = bflo(r.z); f[5] = bfhi(r.z); f[6] = bflo(r.w); f[7] = bfhi(r.w); }
__device__ __forceinline__ v4u pack8(const float (&f)[8]) { v4u o; o.x = pk2(f[0], f[1]); o.y = pk2(f[2], f[3]); o.z = pk2(f[4], f[5]); o.w = pk2(f[6], f[7]); return o; }

#define XB_TMO      128
#define XB_XCNT(j)  (256  + 64 * (j))
#define XB_XSUB(j)  (1280 + 64 * (j))
#define XB_XGEN(j)  (2304 + 64 * (j))
#define XB_TOP      3328
#define XB_TOPGEN   3392
#define XCD_BAR_WORDS 3456
#define XB_SPIN_CAP (1u << 23)

__device__ __forceinline__ unsigned xb_ld(unsigned* p)              { return __hip_atomic_load(p, __ATOMIC_RELAXED, __HIP_MEMORY_SCOPE_AGENT); }
__device__ __forceinline__ unsigned xb_add(unsigned* p, unsigned v) { return __hip_atomic_fetch_add(p, v, __ATOMIC_RELAXED, __HIP_MEMORY_SCOPE_AGENT); }
__device__ __forceinline__ unsigned xb_xcc_id() { return (unsigned)__builtin_amdgcn_s_getreg((3 << 11) | 20) & 0xFu; }
#define XB_SPIN(cond, bar) do { unsigned _sp = 0; while (cond) { __builtin_amdgcn_s_sleep(1); \
    if ((++_sp & 255u) == 0u) { if (xb_ld(&(bar)[XB_TMO])) break; if (_sp > XB_SPIN_CAP) { atomicAdd(&(bar)[XB_TMO], 1u); break; } } } } while (0)

struct XcdBarrier {
    unsigned* bar; unsigned x;
    volatile LAS unsigned* st;
};

__device__ __forceinline__ XcdBarrier xcd_barrier_post(unsigned* bar, volatile LAS unsigned* st) {
    XcdBarrier b; b.bar = bar; b.x = xb_xcc_id(); b.st = st;
    if (threadIdx.x == 0) (void)xb_add(&bar[XB_XCNT(b.x)], 1u);
    return b;
}
__device__ __forceinline__ void xcd_barrier_complete(unsigned* bar, unsigned x, unsigned& nloc, unsigned& nx) {
    const unsigned G = gridDim.x * gridDim.y * gridDim.z;
    unsigned sum, cnt, mine, sp = 0u;
    for (;;) {
        sum = 0u; cnt = 0u; mine = 0u;
#pragma unroll
        for (unsigned j = 0; j < 16; ++j) { const unsigned c = xb_ld(&bar[XB_XCNT(j)]); sum += c; cnt += (c > 0u) ? 1u : 0u; mine = (j == x) ? c : mine; }
        if (sum == G) break;
        __builtin_amdgcn_s_sleep(1);
        if ((++sp & 255u) == 0u) { if (xb_ld(&bar[XB_TMO])) break; if (sp > XB_SPIN_CAP) { atomicAdd(&bar[XB_TMO], 1u); break; } }
    }
    nloc = mine > 0u ? mine : 1u; nx = cnt > 0u ? cnt : 1u;
}

__device__ __forceinline__ void xcd_barrier(const XcdBarrier& b) {
    asm volatile("s_waitcnt vmcnt(0)" ::: "memory");
    __syncthreads();
    if (threadIdx.x == 0) {
        unsigned* bar = b.bar;
        __builtin_amdgcn_s_waitcnt(0);
        unsigned nloc = b.st[0], nx = b.st[1];
        if (nloc == 0u) { xcd_barrier_complete(bar, b.x, nloc, nx); b.st[0] = nloc; b.st[1] = nx; }
        const unsigned old = xb_add(&bar[XB_XSUB(b.x)], 1u);
        const unsigned gen = old / nloc;
        if (old + 1u == (gen + 1u) * nloc) {
            __builtin_amdgcn_fence(__ATOMIC_RELEASE, "agent");
            asm volatile("s_waitcnt vmcnt(0)" ::: "memory");
            const unsigned og = xb_add(&bar[XB_TOP], 1u);
            const unsigned tg = og / nx;
            if (og + 1u == (tg + 1u) * nx) xb_add(&bar[XB_TOPGEN], 1u);
            else XB_SPIN(xb_ld(&bar[XB_TOPGEN]) == tg, bar);
            __builtin_amdgcn_fence(__ATOMIC_ACQUIRE, "agent");
            xb_add(&bar[XB_XGEN(b.x)], 1u);
            asm volatile("s_waitcnt vmcnt(0)" ::: "memory");
        } else {
            XB_SPIN(xb_ld(&bar[XB_XGEN(b.x)]) == gen, bar);
            __builtin_amdgcn_fence(__ATOMIC_ACQUIRE, "agent");
            asm volatile("s_waitcnt vmcnt(0)" ::: "memory");
        }
    }
    __syncthreads();
}

typedef const float* const __attribute__((address_space(4)))* kargp;
struct Frame {
    LAS unsigned char* lds;
    volatile LAS unsigned* MISC;
    gu32* ctl;
    int tid, lane, wave;
    int vcu, G, bx;
    kargp kin;
    float* out;
    unsigned char* ws;
};
enum { I_X = 0, I_C, I_RELB, I_ADAW, I_ADAB, I_WIN, I_WOUT, I_DQN, I_DKN, I_DLAM, I_DSUB, I_GGU, I_GGB, I_GON, I_RMU, I_RWUP, I_RW0, I_RAUP, I_RA0, I_RGUP,
       I_RKK, I_RKA, I_RRK, I_RLNW, I_RLNB, I_VRD, I_VRMU, I_VRUP, I_VR0, I_SQN, I_SKN, I_SSINK, I_W1, I_W3, I_W2 };

#define WSP(T, off) ((T*)(F.ws + (off)))
__device__ __forceinline__ void relaunder_tid(Frame& F) { int t = F.tid; asm volatile("" : "+v"(t)); F.tid = t; F.lane = t & 63; F.wave = __builtin_amdgcn_readfirstlane(t >> 6); }
__device__ __forceinline__ void relaunder(Frame& F) { kargp p = F.kin; asm volatile("" : "+s"(p)); F.kin = p; }

__device__ __forceinline__ void conv_item(const float* src, int ld, int col0, int ncols, int K, bf16* WT, int row0, int kb, LAS float* scr, int lane) {
    const int k0 = 64 * kb;
    { const int n = lane & 31; const bool ok = src != nullptr && n < ncols; const float* sp = src + (size_t)(k0 + (lane >> 5)) * ld + col0 + n; float v[32];
#pragma unroll
      for (int i = 0; i < 32; ++i) v[i] = ok ? sp[(size_t)(2 * i) * ld] : 0.f;
#pragma unroll
      for (int i = 0; i < 32; ++i) scr[(2 * i + (lane >> 5)) * 33 + n] = v[i]; }
    LDS_WAIT(); asm volatile("" ::: "memory");
    const int c = lane & 7;
#pragma unroll
    for (int j = 0; j < 4; ++j) { const int n = (lane >> 3) + 8 * j; const LAS float* s = scr + (8 * c) * 33 + n;
        v4u o; o.x = pk2(s[0 * 33], s[1 * 33]); o.y = pk2(s[2 * 33], s[3 * 33]); o.z = pk2(s[4 * 33], s[5 * 33]); o.w = pk2(s[6 * 33], s[7 * 33]);
        if (n < ncols) *(GAS v4u*)(WT + (size_t)(row0 + n) * K + k0 + 8 * c) = o; }
    LDS_WAIT(); asm volatile("" ::: "memory");
}
__device__ __forceinline__ int t5_bucket(int d) {
    if (d < 16) return d;
    int v = 16 + (int)(logf((float)d * (1.0f / 16.0f)) / logf(8.0f) * 16.0f);
    return v < 31 ? v : 31;
}
constexpr int CONV_I_IN = 337 * 64, CONV_I_OUT = 128 * 64, CONV_I_13 = 688 * 64, CONV_I_2 = 128 * 172, CONV_I_L = CONV_I_IN + CONV_I_OUT + CONV_I_13 + CONV_I_2, CONV_TOTAL = NLAYER * CONV_I_L;
constexpr int CONV_PER_Q = 128, CONV_NQ = (CONV_TOTAL - CONV_I_IN + CONV_PER_Q - 1) / CONV_PER_Q;
__device__ __forceinline__ void conv_dispatch(Frame& F, int it, LAS float* scr) {
    constexpr int I_IN = CONV_I_IN, I_OUT = CONV_I_OUT, I_13 = CONV_I_13, I_L = CONV_I_L;
    {
        const int l = it / I_L; int r = it % I_L;
        if (r < I_IN) {
            const int kb = r / 337, cb = r % 337; const float* src = F.kin[I_WIN] + (size_t)l * DM * P_IN; int ld = P_IN, col0, row0, nc = 32;
            if (cb < 192) { col0 = 32 * cb; row0 = 32 * cb; }
            else if (cb < 288) { col0 = 6160 + 32 * (cb - 192); row0 = 6144 + 32 * (cb - 192); }
            else if (cb < 328) { col0 = 9424 + 32 * (cb - 288); row0 = 9216 + 32 * (cb - 288); }
            else if (cb == 328) { col0 = 6144; row0 = 10496; nc = 16; }
            else if (cb < 335) { col0 = 9232 + 32 * (cb - 329); row0 = 10512 + 32 * (cb - 329); }
            else if (cb == 335) { src = l ? F.kin[I_VRD] + (size_t)(l - 1) * DM * 32 : nullptr; ld = 32; col0 = 0; row0 = 10704; }
            else { src = nullptr; col0 = 0; row0 = 10736; nc = 16; }
            conv_item(src, ld, col0, nc, DM, WSP(bf16, WS_WIN + l * WIN_L), row0, kb, scr, F.lane); return; }
        r -= I_IN;
        if (r < I_OUT) { const int kb = r / 128, cb = r % 128; conv_item(F.kin[I_WOUT] + (size_t)l * DM * DM, DM, 32 * cb, 32, DM, WSP(bf16, WS_WOUT + l * WOUT_L), 32 * cb, kb, scr, F.lane); return; }
        r -= I_OUT;
        if (r < I_13) { const int kb = r / 688, cb = r % 688, pn = cb >> 3, wi = cb & 7;
            const float* src = (wi < 4 ? F.kin[I_W1] : F.kin[I_W3]) + (size_t)l * DM * DFF;
            conv_item(src, DFF, 128 * pn + 32 * (wi & 3), 32, DM, WSP(bf16, WS_W13 + l * W13_L), 32 * cb, kb, scr, F.lane); return; }
        r -= I_13;
        { const int kb = r / 128, cb = r % 128; conv_item(F.kin[I_W2] + (size_t)l * DFF * DM, DM, 32 * cb, 32, DFF, WSP(bf16, WS_W2 + l * W2_L), 32 * cb, kb, scr, F.lane); }
    }
}
__device__ __forceinline__ void p0_prologue_a(Frame& F) {
    const int gw = F.vcu * NWAVES + F.wave, NGW = F.G * NWAVES;
    LAS float* ldsf = (LAS float*)(F.lds + RING_OFF);
    { float cv[16];
#pragma unroll
      for (int q = 0; q < 16; ++q) cv[q] = F.kin[I_C][F.tid + NWAVES * 64 * q];
#pragma unroll
      for (int q = 0; q < 16; ++q) ldsf[F.tid + NWAVES * 64 * q] = silu_g(cv[q]); }
    __syncthreads();
    float* MODP = WSP(float, WS_MODP);
    for (int it = gw; it < 6144; it += NGW) {
        const int l = it / 3072, rem = it % 3072, kc = rem / 96, ng = rem % 96, n0 = 256 * ng + 4 * F.lane;
        const float* w = F.kin[I_ADAW] + ((size_t)l * DM + kc * 128) * 24576 + n0;
        f32x4 a0 = {0.f, 0.f, 0.f, 0.f}, a1 = {0.f, 0.f, 0.f, 0.f};
#pragma unroll 16
        for (int k = 0; k < 128; ++k) { const f32x4 wv = *(const f32x4*)(w + (size_t)k * 24576); const float s0 = ldsf[kc * 128 + k], s1 = ldsf[DM + kc * 128 + k]; a0 += wv * s0; a1 += wv * s1; }
        *(f32x4*)(MODP + ((size_t)(l * 32 + kc) * 2 + 0) * 24576 + n0) = a0;
        *(f32x4*)(MODP + ((size_t)(l * 32 + kc) * 2 + 1) * 24576 + n0) = a1;
    }
    for (int idx = F.bx * (NWAVES * 64) + F.tid; idx < NLAYER * 448 * 64; idx += F.G * NWAVES * 64) {
        const int l = idx / (448 * 64), rem = idx % (448 * 64), blk = rem >> 6, ln = rem & 63, n = ln & 15, g = ln >> 4;
        const int m = blk < 384 ? blk >> 7 : 3, nt = blk < 384 ? (blk & 127) >> 1 : blk - 384, ks = blk < 384 ? (blk & 1) : 0;
        const float* W = m == 0 ? F.kin[I_RWUP] + (size_t)l * 65536 : (m == 1 ? F.kin[I_RAUP] + (size_t)l * 65536 : (m == 2 ? F.kin[I_RGUP] + (size_t)l * 65536 : (l ? F.kin[I_VRUP] + (size_t)(l - 1) * 32768 : nullptr)));
        float f[8];
#pragma unroll
        for (int e = 0; e < 8; ++e) f[e] = W != nullptr ? W[(size_t)(32 * ks + 8 * g + e) * 1024 + 16 * nt + n] : 0.f;
        *(v4u*)(WSP(bf16, WS_WF) + ((size_t)(l * 448 + blk) * 64 + ln) * 8) = pack8(f);
    }
    __syncthreads();
    LAS float* scr = (LAS float*)(F.lds + RING_OFF + F.wave * 16384);
    for (int it = gw; it < CONV_I_IN; it += NGW) conv_dispatch(F, it, scr);
}
__device__ __forceinline__ void p0_prologue_b(Frame& F) {
    const int gt = F.bx * (NWAVES * 64) + F.tid, NT = F.G * NWAVES * 64;
    const float* MODP = WSP(float, WS_MODP); float* MOD = WSP(float, WS_MOD);
    for (int idx = gt; idx < NLAYER * 2 * 24576; idx += NT) {
        const int l = idx / 49152, rem = idx % 49152, b = rem / 24576, n = rem % 24576;
        float s = F.kin[I_ADAB][l * 24576 + n];
#pragma unroll 8
        for (int kc = 0; kc < 32; ++kc) s += MODP[((size_t)(l * 32 + kc) * 2 + b) * 24576 + n];
        MOD[idx] = s;
    }
    if (F.bx == 0) { float* TAB = WSP(float, WS_TAB);
        float tv[6];
#pragma unroll
        for (int q = 0; q < 6; ++q) { const int i = F.tid + NWAVES * 64 * q, hh = i >> 7, d = i & 127; tv[q] = F.kin[I_RELB][t5_bucket(d) * 24 + hh]; }
#pragma unroll
        for (int q = 0; q < 6; ++q) TAB[F.tid + NWAVES * 64 * q] = tv[q] * LOG2E; }
}
__device__ __forceinline__ void rms_phase(Frame& F, const float* xin, const float* sh, const float* sc) {
    const int gw = F.vcu * NWAVES + F.wave, NGW = F.G * NWAVES;
    bf16* XN = WSP(bf16, WS_XN);
#pragma unroll 1
    for (int b = 0; b < BATCH; ++b) {
        relaunder(F); relaunder_tid(F);
        f32x4 s4[16], h4[16];
        { const f32x4* scp = (const f32x4*)(sc + (size_t)b * 24576) + F.lane; const f32x4* shp = (const f32x4*)(sh + (size_t)b * 24576) + F.lane;
#pragma unroll
          for (int j = 0; j < 16; ++j) { s4[j] = scp[64 * j] + 1.0f; h4[j] = shp[64 * j]; } }
#pragma unroll 1
        for (int m = b * SEQ + gw; m < (b + 1) * SEQ; m += NGW) {
            relaunder_tid(F);
            const f32x4* xr = (const f32x4*)(xin + (size_t)m * DM) + F.lane;
            f32x4 v[16]; float ss = 0.f;
#pragma unroll
            for (int j = 0; j < 16; ++j) v[j] = xr[64 * j];
#pragma unroll
            for (int j = 0; j < 16; ++j) ss += (v[j].x * v[j].x + v[j].y * v[j].y) + (v[j].z * v[j].z + v[j].w * v[j].w);
            const float rstd = rsqrtf(wave_sum(ss) * (1.0f / DM) + 1e-6f);
            v2u* o8 = (v2u*)(XN + (size_t)m * DM) + F.lane;
#pragma unroll
            for (int j = 0; j < 16; ++j) { const f32x4 o = v[j] * rstd * s4[j] + h4[j]; v2u w; w.x = pk2(o.x, o.y); w.y = pk2(o.z, o.w); o8[64 * j] = w; }
        }
    }
}
__device__ __forceinline__ void rms_phase_bf(Frame& F, const float* sh, const float* sc) {
    const int gw = F.vcu * NWAVES + F.wave, NGW = F.G * NWAVES;
    bf16* XN = WSP(bf16, WS_XN); const bf16* XR = WSP(bf16, WS_XR);
#pragma unroll 1
    for (int b = 0; b < BATCH; ++b) {
        relaunder(F); relaunder_tid(F);
        f32x4 s0[8], s1[8], h0[8], h1[8];
        { const float* scp = sc + (size_t)b * 24576 + 8 * F.lane; const float* shp = sh + (size_t)b * 24576 + 8 * F.lane;
#pragma unroll
          for (int j = 0; j < 8; ++j) { s0[j] = *(const f32x4*)(scp + 512 * j) + 1.0f; s1[j] = *(const f32x4*)(scp + 512 * j + 4) + 1.0f; h0[j] = *(const f32x4*)(shp + 512 * j); h1[j] = *(const f32x4*)(shp + 512 * j + 4); } }
        const int mend = (b + 1) * SEQ; int m = b * SEQ + gw;
        v4u raw[8];
        if (m < mend) {
#pragma unroll
            for (int j = 0; j < 8; ++j) raw[j] = ((const v4u*)(XR + (size_t)m * DM) + F.lane)[64 * j];
        }
#pragma unroll 1
        for (; m < mend; m += NGW) {
            relaunder_tid(F);
            v4u nxt[8]; { const int mn = m + NGW < mend ? m + NGW : m;
#pragma unroll
              for (int j = 0; j < 8; ++j) nxt[j] = ((const v4u*)(XR + (size_t)mn * DM) + F.lane)[64 * j]; }
            float ss = 0.f;
#pragma unroll
            for (int j = 0; j < 8; ++j) { float f[8]; unpack8(raw[j], f);
#pragma unroll
                for (int e = 0; e < 8; ++e) ss += f[e] * f[e]; }
            const float rstd = rsqrtf(wave_sum(ss) * (1.0f / DM) + 1e-6f);
            v4u* o16 = (v4u*)(XN + (size_t)m * DM) + F.lane;
#pragma unroll
            for (int j = 0; j < 8; ++j) { float f[8]; unpack8(raw[j], f); float o[8];
#pragma unroll
                for (int e = 0; e < 4; ++e) { o[e] = f[e] * rstd * s0[j][e] + h0[j][e]; o[4 + e] = f[4 + e] * rstd * s1[j][e] + h1[j][e]; }
                o16[64 * j] = pack8(o); }
#pragma unroll
            for (int j = 0; j < 8; ++j) raw[j] = nxt[j];
        }
    }
}
__device__ __forceinline__ void prep_norm(Frame& F, int l) {
    const int gw = F.vcu * NWAVES + F.wave, NGW = F.G * NWAVES, lane = F.lane, sub = lane >> 3, ch = lane & 7;
    float gqa[8], gka[8], gqd[8], gkd[8];
#pragma unroll
    for (int e = 0; e < 8; ++e) { gqa[e] = F.kin[I_DQN][l * 64 + ch * 8 + e] * QSCALE; gka[e] = F.kin[I_DKN][l * 64 + ch * 8 + e];
                                  gqd[e] = F.kin[I_SQN][l * 64 + ch * 8 + e] * QSCALE; gkd[e] = F.kin[I_SKN][l * 64 + ch * 8 + e]; }
    const bf16* COLS = WSP(bf16, WS_COLS); bf16* QKA = WSP(bf16, WS_QKA); bf16* QKD = WSP(bf16, WS_QKD);
    for (int m0 = gw; m0 < M; m0 += 2 * NGW) {
        v4u ra[2][4], rd[2][3];
#pragma unroll
        for (int r = 0; r < 2; ++r) { const int m = m0 + r * NGW < M ? m0 + r * NGW : m0; const bf16* src = COLS + (size_t)m * NMAIN;
#pragma unroll
            for (int i = 0; i < 4; ++i) ra[r][i] = *(const v4u*)(src + CA_Q + (i * 8 + sub) * 64 + ch * 8);
#pragma unroll
            for (int i = 0; i < 3; ++i) { const int vec = i * 8 + sub; rd[r][i] = *(const v4u*)(src + CD_Q + (vec < 18 ? vec : 17) * 64 + ch * 8); } }
#pragma unroll
        for (int r = 0; r < 2; ++r) { const int m = m0 + r * NGW; if (m < M) {
#pragma unroll
            for (int i = 0; i < 4; ++i) { const int vec = i * 8 + sub, col = vec * 64 + ch * 8;
                float f[8]; unpack8(ra[r][i], f); float ss = 0.f;
#pragma unroll
                for (int e = 0; e < 8; ++e) ss += f[e] * f[e];
                ss = sum8(ss);
                const float rstd = rsqrtf(ss * (1.0f / 64.0f) + 1e-6f);
#pragma unroll
                for (int e = 0; e < 8; ++e) f[e] = f[e] * rstd * (i < 2 ? gqa[e] : gka[e]);
                *(v4u*)(QKA + (size_t)m * 2048 + col) = pack8(f); }
#pragma unroll
            for (int i = 0; i < 3; ++i) { const int vec = i * 8 + sub, col = vec * 64 + ch * 8;
                float f[8]; unpack8(rd[r][i], f); float ss = 0.f;
#pragma unroll
                for (int e = 0; e < 8; ++e) ss += f[e] * f[e];
                ss = sum8(ss);
                const float rstd = rsqrtf(ss * (1.0f / 64.0f) + 1e-6f);
#pragma unroll
                for (int e = 0; e < 8; ++e) f[e] = f[e] * rstd * (vec < 16 ? gqd[e] : gkd[e]);
                if (vec < 18) *(v4u*)(QKD + (size_t)m * 1152 + col) = pack8(f); } } }
    }
}
__device__ __forceinline__ void prep_loga(Frame& F, int l) {
    LAS float* gdl = (LAS float*)(F.lds + RING_OFF);
    float gu[16];
#pragma unroll
    for (int j = 0; j < 16; ++j) gu[j] = F.kin[I_GGU][((size_t)l * 16 + j) * 512 + F.tid];
    const float bias = F.kin[I_GGB][l * 512 + F.tid];
    const float* LOWR = WSP(float, WS_LOWR); float* LOGA = WSP(float, WS_LOGA);
    for (int tile = F.bx; tile < M / 64; tile += F.G) {
        const size_t row0 = (size_t)tile * 64;
        __syncthreads();
#pragma unroll
        for (int i = 0; i < 2; ++i) { const int idx = F.tid + 512 * i; gdl[idx] = LOWR[(row0 + (idx >> 4)) * 256 + (idx & 15)]; }
        __syncthreads();
#pragma unroll 4
        for (int t = 0; t < 64; ++t) { const LAS f32x4* gp = (const LAS f32x4*)(gdl + t * 16); const f32x4 g0 = gp[0], g1 = gp[1], g2 = gp[2], g3 = gp[3];
            float z = bias + g0.x * gu[0] + g0.y * gu[1] + g0.z * gu[2] + g0.w * gu[3] + g1.x * gu[4] + g1.y * gu[5] + g1.z * gu[6] + g1.w * gu[7]
                    + g2.x * gu[8] + g2.y * gu[9] + g2.z * gu[10] + g2.w * gu[11] + g3.x * gu[12] + g3.y * gu[13] + g3.z * gu[14] + g3.w * gu[15];
            LOGA[(row0 + t) * 512 + F.tid] = (fminf(z, 0.f) - __logf(1.0f + __expf(-fabsf(z)))) * (1.0f / 16.0f); }
    }
}
__device__ __forceinline__ int next_item(Frame& F, gu32* ctr) {
    volatile LAS int* slot = (volatile LAS int*)(F.lds + LDSCTL_OFF + 64);
    __syncthreads();
    if (F.tid == 0) *slot = (int)__hip_atomic_fetch_add(ctr, 1u, RLX_AGENT);
    __syncthreads();
    return *slot;
}
typedef float f32x16 __attribute__((ext_vector_type(16)));
__device__ __forceinline__ float xother32(float v) { unsigned a = __builtin_bit_cast(unsigned, v), b = a; asm volatile("" : "+v"(b)); auto rr = __builtin_amdgcn_permlane32_swap(a, b, false, false);
    const unsigned lo = rr[0], hi = rr[1]; return __builtin_bit_cast(float, (unsigned)((__builtin_amdgcn_mbcnt_hi(~0u, __builtin_amdgcn_mbcnt_lo(~0u, 0u)) & 32u) ? lo : hi)); }
__device__ __forceinline__ float xsum32(float v) { return v + xother32(v); }
__device__ __forceinline__ float xmax32(float v) { return fmaxf(v, xother32(v)); }
__device__ __forceinline__ int crow16(int r, int hi) { return (r & 3) + 8 * (r >> 2) + 4 * hi; }
template <bool ISA>
__device__ __forceinline__ void attn_unit(Frame& F, int l, int b, int hx, int qb) {
    constexpr int DV = ISA ? 128 : 64, NDV = DV / 32, KSTR = ISA ? 272 : 144, VSTR = 144, KBYTES = 64 * KSTR, VBYTES = DV * VSTR, BUFB = KBYTES + VBYTES, NCH = ISA ? 2 : 1;
    constexpr float NEG = -1e30f;
    LAS unsigned char* L = F.lds + RING_OFF;
    const int tid = F.tid, lane = F.lane, r32 = lane & 31, hi = lane >> 5, qs = F.wave & 3, grp = F.wave >> 2, q0 = qb * 128;
    const int kvh = hx >> 2, hd = kvh * 8 + (hx & 3) * 2 + grp;
    const bf16* Qp; const bf16* Kp; const bf16* VT; int ldq;
    if (ISA) { const bf16* QKA = WSP(bf16, WS_QKA); Qp = QKA + (size_t)b * SEQ * 2048 + hx * 128 + grp * 64; Kp = QKA + (size_t)b * SEQ * 2048 + 1024 + hx * 128; ldq = 2048; VT = WSP(bf16, WS_VTA) + (size_t)(b * 8 + hx) * 128 * VROW; }
    else { const bf16* QKD = WSP(bf16, WS_QKD); Qp = QKD + (size_t)b * SEQ * 1152 + hd * 64; Kp = QKD + (size_t)b * SEQ * 1152 + 1024 + kvh * 64; ldq = 1152; VT = WSP(bf16, WS_VTD) + (size_t)(b * 2 + kvh) * 64 * VROW; }
    const int qpos = q0 + 32 * qs + r32;
    bf16x8 qr[4];
#pragma unroll
    for (int d0 = 0; d0 < 4; ++d0) qr[d0] = *(const bf16x8*)(Qp + (size_t)qpos * ldq + d0 * 16 + hi * 8);
    LAS float* Bt = (LAS float*)(L + 2 * BUFB);
    { const float* TAB = WSP(float, WS_TAB);
      if (ISA) { if (tid < 130) Bt[tid] = tid == 0 ? NEG : (tid == 129 ? 0.f : TAB[hx * 128 + tid - 1] - TAB[hx * 128 + 127]); }
      else { if (tid < 260) { const int gi = tid >= 130, t = tid - 130 * gi; Bt[tid] = (t == 0 || t == 129) ? NEG : TAB[(8 + kvh * 8 + (hx & 3) * 2 + gi) * 128 + t - 1]; } } }
    const int TQ = q0 >> 6, T0 = ISA ? 0 : (TQ >= 2 ? TQ - 2 : 0), T1 = TQ + 1;
    v4u kreg[NCH], vreg[NCH];
#define AT_GLOAD(T) do { _Pragma("unroll") for (int i_ = 0; i_ < NCH; ++i_) { const int c_ = tid + 512 * i_; \
        const int kr_ = ISA ? (c_ >> 4) : (c_ >> 3), kc_ = ISA ? (c_ & 15) : (c_ & 7); kreg[i_] = *(const v4u*)(Kp + (size_t)((T) * 64 + kr_) * ldq + kc_ * 8); \
        const int vr_ = c_ >> 3, vc_ = c_ & 7; vreg[i_] = *(const v4u*)(VT + (size_t)vr_ * VROW + (T) * 64 + vc_ * 8); } } while (0)
#define AT_LWRITE(buf) do { _Pragma("unroll") for (int i_ = 0; i_ < NCH; ++i_) { const int c_ = tid + 512 * i_; \
        const int kr_ = ISA ? (c_ >> 4) : (c_ >> 3), kc_ = ISA ? (c_ & 15) : (c_ & 7); *(LAS v4u*)(L + (buf) * BUFB + kr_ * KSTR + kc_ * 16) = kreg[i_]; \
        const int vr_ = c_ >> 3, vc_ = c_ & 7; *(LAS v4u*)(L + (buf) * BUFB + KBYTES + vr_ * VSTR + vc_ * 16) = vreg[i_]; } } while (0)
    f32x16 o[NDV];
#pragma unroll
    for (int i = 0; i < NDV; ++i) o[i] = (f32x16){0.f, 0.f, 0.f, 0.f, 0.f, 0.f, 0.f, 0.f, 0.f, 0.f, 0.f, 0.f, 0.f, 0.f, 0.f, 0.f};
    float m_run = ISA ? -1.0e4f : fmaxf(F.kin[I_SSINK][l * 16 + hd] * LOG2E, -1.0e4f), l_run = ISA ? 0.f : (hi == 0 ? 1.f : 0.f);
    f32x16 nmv; { const float nm = -m_run; nmv = (f32x16){nm, nm, nm, nm, nm, nm, nm, nm, nm, nm, nm, nm, nm, nm, nm, nm}; }
    const int krow = (r32 & 16) | (r32 & 3) | ((r32 & 4) << 1) | ((r32 & 8) >> 1);
    const int koff = krow * KSTR + (ISA ? grp * 128 : 0) + hi * 16, voff = KBYTES + r32 * VSTR + hi * 16;
    AT_GLOAD(T0); AT_LWRITE(0); __syncthreads();
#pragma unroll 1
    for (int T = T0; T <= T1; ++T) {
        const int cur = (T - T0) & 1;
        AT_GLOAD(T < T1 ? T + 1 : T1);
        LAS const unsigned char* Kb = L + cur * BUFB;
        f32x16 s[2];
#pragma unroll
        for (int blk = 0; blk < 2; ++blk) {
#pragma unroll
            for (int d0 = 0; d0 < 4; ++d0) { const bf16x8 kf = *(const LAS bf16x8*)(Kb + koff + blk * 32 * KSTR + d0 * 32); s[blk] = __builtin_amdgcn_mfma_f32_32x32x16_bf16(kf, qr[d0], d0 == 0 ? nmv : s[blk], 0, 0, 0); } }
        bf16x8 vfc[NDV], vfn[NDV];
#pragma unroll
        for (int i = 0; i < NDV; ++i) vfc[i] = *(const LAS bf16x8*)(Kb + voff + i * 32 * VSTR);
        if (!ISA || T >= TQ - 2) {
            const LAS float* bt = Bt + (ISA ? 0 : grp * 130) + 1; const int d0 = qpos - T * 64 - 8 * hi;
#pragma unroll
            for (int blk = 0; blk < 2; ++blk)
#pragma unroll
                for (int r = 0; r < 16; ++r) { const int dist = d0 - (32 * blk + 16 * (r >> 3) + (r & 7)); const int di = dist < -1 ? -1 : (dist > 128 ? 128 : dist); s[blk][r] += bt[di]; } }
        float mt, mt1;
        { float m0 = s[0][0], m1 = s[0][8], m2 = s[1][0], m3 = s[1][8];
#pragma unroll
          for (int r = 1; r < 8; ++r) { m0 = fmaxf(m0, s[0][r]); m1 = fmaxf(m1, s[0][8 + r]); m2 = fmaxf(m2, s[1][r]); m3 = fmaxf(m3, s[1][8 + r]); }
          mt = fmaxf(m0, m1); mt1 = fmaxf(m2, m3); mt = fmaxf(mt, mt1); }
        mt = xmax32(mt);
        if (__any(mt > 8.0f)) { const float sh = mt > 8.0f ? mt : 0.f, alpha = __builtin_amdgcn_exp2f(-sh); l_run *= alpha;
#pragma unroll
            for (int i = 0; i < NDV; ++i)
#pragma unroll
                for (int r = 0; r < 16; ++r) o[i][r] *= alpha;
#pragma unroll
            for (int blk = 0; blk < 2; ++blk)
#pragma unroll
                for (int r = 0; r < 16; ++r) s[blk][r] -= sh;
            m_run += sh; const float nm = -m_run; nmv = (f32x16){nm, nm, nm, nm, nm, nm, nm, nm, nm, nm, nm, nm, nm, nm, nm, nm}; }
        float ls0 = 0.f, ls1 = 0.f, ls2 = 0.f, ls3 = 0.f;
#pragma unroll
        for (int blk = 0; blk < 2; ++blk)
#pragma unroll
            for (int r = 0; r < 16; r += 4) { const float p0 = __builtin_amdgcn_exp2f(s[blk][r]), p1 = __builtin_amdgcn_exp2f(s[blk][r + 1]), p2 = __builtin_amdgcn_exp2f(s[blk][r + 2]), p3 = __builtin_amdgcn_exp2f(s[blk][r + 3]);
                s[blk][r] = p0; s[blk][r + 1] = p1; s[blk][r + 2] = p2; s[blk][r + 3] = p3; ls0 += p0; ls1 += p1; ls2 += p2; ls3 += p3; }
        const float ls = (ls0 + ls1) + (ls2 + ls3);
        l_run += ls;
#pragma unroll
        for (int sl = 0; sl < 4; ++sl) { const int blk = sl >> 1, r0 = 8 * (sl & 1);
            v4u pw; pw.x = pg8::cvt_pk_bf16(s[blk][r0], s[blk][r0 + 1]); pw.y = pg8::cvt_pk_bf16(s[blk][r0 + 2], s[blk][r0 + 3]); pw.z = pg8::cvt_pk_bf16(s[blk][r0 + 4], s[blk][r0 + 5]); pw.w = pg8::cvt_pk_bf16(s[blk][r0 + 6], s[blk][r0 + 7]);
            const bf16x8 pf = __builtin_bit_cast(bf16x8, pw);
#pragma unroll
            for (int i = 0; i < NDV; ++i) { if (sl < 3) vfn[i] = *(const LAS bf16x8*)(Kb + voff + i * 32 * VSTR + (sl + 1) * 32); o[i] = __builtin_amdgcn_mfma_f32_32x32x16_bf16(vfc[i], pf, o[i], 0, 0, 0); }
#pragma unroll
            for (int i = 0; i < NDV; ++i) vfc[i] = vfn[i]; }
        AT_LWRITE(cur ^ 1);
        __syncthreads();
    }
#undef AT_GLOAD
#undef AT_LWRITE
    const float inv = 1.0f / xsum32(l_run);
    bf16* MIX = WSP(bf16, WS_MIXED);
    if (ISA) {
        int ll_ = l; asm volatile("" : "+s"(ll_)); const float lam_init = ll_ == 0 ? 0.2f : 0.35550906759f;     float lam_full;
        { const float* lm = F.kin[I_DLAM] + (size_t)l * 256; const float s1 = wave_sum(lm[lane] * lm[64 + lane]), s2 = wave_sum(lm[128 + lane] * lm[192 + lane]); lam_full = __expf(s1) - __expf(s2) + lam_init; }
        LAS float* R1 = (LAS float*)L;
        LAS bf16* R2 = (LAS bf16*)(L + 66048);
        const int ql = 32 * qs + r32;
        if (grp == 1) {
#pragma unroll
            for (int i = 0; i < NDV; ++i)
#pragma unroll
                for (int r = 0; r < 16; ++r) R1[ql * 129 + 32 * i + crow16(r, hi)] = lam_full * inv * o[i][r]; }
        __syncthreads();
        if (grp == 0) { float ss = 0.f;
#pragma unroll
            for (int i = 0; i < NDV; ++i)
#pragma unroll
                for (int r = 0; r < 16; ++r) { const float d = o[i][r] * inv - R1[ql * 129 + 32 * i + crow16(r, hi)]; o[i][r] = d; ss += d * d; }
            const float rstd = rsqrtf(xsum32(ss) * (1.0f / 128.0f) + 1e-6f) * (1.0f - lam_init);
            const float* sl = F.kin[I_DSUB] + l * 128;
#pragma unroll
            for (int i = 0; i < NDV; ++i)
#pragma unroll
                for (int r = 0; r < 16; ++r) { const int dv = 32 * i + crow16(r, hi); R2[ql * 132 + dv] = (bf16)f2bf(o[i][r] * rstd * sl[dv]); } }
        __syncthreads();
#pragma unroll
        for (int i = 0; i < 4; ++i) { const int c = tid + 512 * i, row = c >> 4, ch = c & 15; const LAS v2u* sp = (const LAS v2u*)(R2 + row * 132 + ch * 8); const v2u a = sp[0], bb = sp[1];
            *(v4u*)(MIX + (size_t)(b * SEQ + q0 + row) * DM + hx * 128 + ch * 8) = (v4u){a.x, a.y, bb.x, bb.y}; }
    } else {
        LAS bf16* R = (LAS bf16*)L + F.wave * 2176;
#pragma unroll
        for (int i = 0; i < NDV; ++i)
#pragma unroll
            for (int r = 0; r < 16; ++r) R[r32 * 68 + 32 * i + crow16(r, hi)] = (bf16)f2bf(o[i][r] * inv);
#pragma unroll
        for (int i = 0; i < 4; ++i) { const int c = lane + 64 * i, row = c >> 3, ch = c & 7; const LAS v2u* sp = (const LAS v2u*)(R + row * 68 + ch * 8); const v2u a = sp[0], bb = sp[1];
            *(v4u*)(MIX + (size_t)(b * SEQ + q0 + 32 * qs + row) * DM + 3072 + hd * 64 + ch * 8) = (v4u){a.x, a.y, bb.x, bb.y}; }
    }
}
__device__ __forceinline__ void prep_gla(Frame& F) {
    LAS float* Lb = (LAS float*)(F.lds + RING_OFF); LAS float* Qd = Lb + 64 * 129; LAS float* Ki = Qd + 64 * 129; LAS bf16* Kt = (LAS bf16*)(Ki + 64 * 129);
    const bf16* COLS = WSP(bf16, WS_COLS); const float* LOGA = WSP(float, WS_LOGA);
    bf16* QDEC = WSP(bf16, WS_QDEC); bf16* KDT = WSP(bf16, WS_KDT); bf16* AMg = WSP(bf16, WS_AM); float* EBL = WSP(float, WS_EBL);
    for (int u = F.bx; u < 1024; u += F.G) {
        const int b = u >> 9, h = (u >> 7) & 3, ck = u & 127; const size_t row0 = (size_t)b * SEQ + ck * 64;
        __syncthreads();
        f32x4 lg[4]; v4u qv[2], kv[2];
#pragma unroll
        for (int i = 0; i < 4; ++i) { const int i4 = F.tid + 512 * i, t = i4 >> 5, d4 = (i4 & 31) * 4; lg[i] = *(const f32x4*)(LOGA + (row0 + t) * 512 + h * 128 + d4); }
#pragma unroll
        for (int i = 0; i < 2; ++i) { const int i8 = F.tid + 512 * i, t = i8 >> 4, d8 = (i8 & 15) * 8; const bf16* p = COLS + (row0 + t) * NMAIN + h * 128 + d8; qv[i] = *(const v4u*)(p + CB_Q); kv[i] = *(const v4u*)(p + CB_K); }
#pragma unroll
        for (int i = 0; i < 4; ++i) { const int i4 = F.tid + 512 * i, t = i4 >> 5, d4 = (i4 & 31) * 4;
#pragma unroll
            for (int e = 0; e < 4; ++e) Lb[t * 129 + d4 + e] = lg[i][e]; }
        __syncthreads();
        if (F.tid < 128) { float a[64];
#pragma unroll
            for (int t = 0; t < 64; ++t) a[t] = Lb[t * 129 + F.tid];
#pragma unroll
            for (int t = 1; t < 64; ++t) a[t] += a[t - 1];
#pragma unroll
            for (int t = 0; t < 64; ++t) Lb[t * 129 + F.tid] = a[t];
            EBL[(size_t)u * 128 + F.tid] = __expf(a[63]); }
        __syncthreads();
#pragma unroll
        for (int i = 0; i < 2; ++i) { const int i8 = F.tid + 512 * i, t = i8 >> 4, d8 = (i8 & 15) * 8; float q[8], k[8], qo[8]; unpack8(qv[i], q); unpack8(kv[i], k);
#pragma unroll
            for (int e = 0; e < 8; ++e) { const int d = d8 + e; const float bt = Lb[t * 129 + d], bl = Lb[63 * 129 + d];
                const float qd = q[e] * 0.08838834764831845f * __expf(bt); Qd[t * 129 + d] = qd; Ki[t * 129 + d] = k[e] * __expf(-bt); Kt[d * 72 + t] = (bf16)f2bf(k[e] * __expf(bl - bt)); qo[e] = qd; }
            *(v4u*)(QDEC + ((size_t)u * 64 + t) * 128 + d8) = pack8(qo); }
        __syncthreads();
#pragma unroll
        for (int i = 0; i < 2; ++i) { const int c_ = F.tid + 512 * i, row = c_ >> 3, ch = c_ & 7; const LAS v2u* sp = (const LAS v2u*)(Kt + row * 72 + ch * 8); const v2u a = sp[0], bb = sp[1];
            *(v4u*)(KDT + ((size_t)u * 128 + row) * 64 + ch * 8) = (v4u){a.x, a.y, bb.x, bb.y}; }
        {
          const int n = F.lane & 15, gq = F.lane >> 4, ct = F.wave >> 1, st0 = 2 * (F.wave & 1);
          f32x4 c0 = (f32x4){0.f, 0.f, 0.f, 0.f}, c1 = (f32x4){0.f, 0.f, 0.f, 0.f};
          if (st0 <= ct) {
              const LAS float* ap = Qd + (16 * ct + n) * 129 + gq; const LAS float* bp0 = Ki + (16 * st0 + n) * 129 + gq; const LAS float* bp1 = bp0 + 16 * 129;
#pragma unroll 8
              for (int ks = 0; ks < 32; ++ks) { const float av = ap[4 * ks]; c0 = __builtin_amdgcn_mfma_f32_16x16x4f32(av, bp0[4 * ks], c0, 0, 0, 0); c1 = __builtin_amdgcn_mfma_f32_16x16x4f32(av, bp1[4 * ks], c1, 0, 0, 0); } }
#pragma unroll
          for (int rr = 0; rr < 4; ++rr) { const int c = 16 * ct + 4 * gq + rr, s0 = 16 * st0 + n, s1 = s0 + 16;
              bf16* op = AMg + ((size_t)u * 64 + c) * 64; op[s0] = (bf16)f2bf(s0 <= c ? c0[rr] : 0.f); op[s1] = (bf16)f2bf(s1 <= c ? c1[rr] : 0.f); } }
    }
}
template <int PASS> __device__ __forceinline__ void prep_vt(Frame& F) {
    LAS bf16* T = (LAS bf16*)(F.lds + RING_OFF);
    const bf16* COLS = WSP(bf16, WS_COLS);
    constexpr int ncol = PASS == 4 ? 128 : 512, nch = ncol >> 3, NI = 64 * nch / (NWAVES * 64);
    constexpr int col0 = PASS < 2 ? CA_V + 512 * PASS : (PASS < 4 ? CB_V + 512 * (PASS - 2) : CD_V);
    bf16* dst0 = PASS < 2 ? WSP(bf16, WS_VTA) + (size_t)(512 * PASS) * VROW : (PASS < 4 ? WSP(bf16, WS_VTB) + (size_t)(512 * (PASS - 2)) * VROW : WSP(bf16, WS_VTD));
    constexpr int rows_b = PASS == 4 ? 128 : 1024;
    for (int tile = F.bx; tile < M / 64; tile += F.G) {
        const int b = tile >> 7, t0 = (tile & 127) * 64;
        __syncthreads();
        v4u v[NI];
#pragma unroll
        for (int i = 0; i < NI; ++i) { const int idx = F.tid + NWAVES * 64 * i, tok = idx / nch, ch = idx % nch; v[i] = *(const v4u*)(COLS + (size_t)(b * SEQ + t0 + tok) * NMAIN + col0 + ch * 8); }
#pragma unroll
        for (int i = 0; i < NI; ++i) { const int idx = F.tid + NWAVES * 64 * i, tok = idx / nch, ch = idx % nch; LAS unsigned* d = (LAS unsigned*)(T + tok * 522 + ch * 8); d[0] = v[i].x; d[1] = v[i].y; d[2] = v[i].z; d[3] = v[i].w; }
        __syncthreads();
#pragma unroll
        for (int i = 0; i < NI; ++i) { const int idx = F.tid + NWAVES * 64 * i, vrow = idx >> 3, ch = idx & 7;
            unsigned e[8];
#pragma unroll
            for (int k = 0; k < 8; ++k) e[k] = T[(ch * 8 + k) * 522 + vrow];
            v4u o; o.x = e[0] | (e[1] << 16); o.y = e[2] | (e[3] << 16); o.z = e[4] | (e[5] << 16); o.w = e[6] | (e[7] << 16);
            *(v4u*)(dst0 + ((size_t)b * rows_b + vrow) * VROW + t0 + ch * 8) = o; }
    }
}
typedef float f32x4v __attribute__((ext_vector_type(4)));
__device__ __forceinline__ float sum16(float v) { v = sum8(v); v += dpp_f<0x140>(v); return v; }
#define LDS_BARRIER() asm volatile("s_waitcnt lgkmcnt(0)\n\ts_barrier" ::: "memory")
template <int HACK = 0> __device__ __forceinline__ void gla_scan_unit(Frame& F, int l, int b, int h, int vh) {
    LAS unsigned char* L = F.lds + RING_OFF;
    constexpr int OQD = 0, OKT = 17408, OAM = 35840, OVT = 45056, OOT = 63488, OEB = 80896, OPS = 81408;
    const int tid = F.tid, lane = F.lane, n = lane & 15, g = lane >> 4, w = F.wave;
    const bf16* QDEC = WSP(bf16, WS_QDEC); const bf16* KDT = WSP(bf16, WS_KDT); const bf16* AMg = WSP(bf16, WS_AM); const float* EBL = WSP(float, WS_EBL);
    const bf16* VTB = WSP(bf16, WS_VTB) + (size_t)((b * 4 + h) * 256 + 128 * vh) * VROW; bf16* OB = WSP(bf16, WS_OB); float* PSG = WSP(float, WS_PSG);
    f32x4v S[8];
#pragma unroll
    for (int dt = 0; dt < 8; ++dt) S[dt] = (f32x4v){0.f, 0.f, 0.f, 0.f};
    v4u pq[2], pk[2], pa, pv[2]; float pe = 0.f;
#define GL_ISSUE(CK) do { const size_t u_ = (size_t)(b * 4 + h) * 128 + (CK); \
        _Pragma("unroll") for (int i = 0; i < 2; ++i) { const int c_ = tid + 512 * i; pq[i] = *(const v4u*)(QDEC + (u_ * 64 + (c_ >> 4)) * 128 + (c_ & 15) * 8); pk[i] = *(const v4u*)(KDT + (u_ * 128 + (c_ >> 3)) * 64 + (c_ & 7) * 8); \
            pv[i] = *(const v4u*)(VTB + (size_t)(c_ >> 3) * VROW + (CK) * 64 + (c_ & 7) * 8); } \
        pa = *(const v4u*)(AMg + (u_ * 64 + (tid >> 3)) * 64 + (tid & 7) * 8); \
        pe = EBL[u_ * 128 + (tid & 127)]; } while (0)
#define GL_WRITE() do { _Pragma("unroll") for (int i = 0; i < 2; ++i) { const int c_ = tid + 512 * i; *(LAS v4u*)(L + OQD + (c_ >> 4) * 272 + (c_ & 15) * 16) = pq[i]; *(LAS v4u*)(L + OKT + (c_ >> 3) * 144 + (c_ & 7) * 16) = pk[i]; \
            *(LAS v4u*)(L + OVT + (c_ >> 3) * 144 + (c_ & 7) * 16) = pv[i]; } \
        *(LAS v4u*)(L + OAM + (tid >> 3) * 144 + (tid & 7) * 16) = pa; \
        ((LAS float*)(L + OEB))[tid & 127] = pe; } while (0)
    GL_ISSUE(0); GL_WRITE();
    LDS_BARRIER();
#pragma unroll 1
    for (int ck = 0; ck < 128; ++ck) {
        const size_t row0 = (size_t)b * SEQ + ck * 64;
        GL_ISSUE((HACK & 1) && ck >= 2 ? 2 : (ck + 1 < 128 ? ck + 1 : 127));
        bf16x8 vf[2];
#pragma unroll
        for (int ks = 0; ks < 2; ++ks) vf[ks] = *(const LAS bf16x8*)(L + OVT + (16 * w + n) * 144 + (32 * ks + 8 * g) * 2);
        f32x4v o[4];
#pragma unroll
        for (int ct = 0; ct < 4; ++ct) o[ct] = (f32x4v){0.f, 0.f, 0.f, 0.f};
#pragma unroll
        for (int ct = 0; ct < 4; ++ct)
#pragma unroll
            for (int ks = 0; ks < 2; ++ks) { const bf16x8 af = *(const LAS bf16x8*)(L + OAM + (16 * ct + n) * 144 + (32 * ks + 8 * g) * 2); o[ct] = __builtin_amdgcn_mfma_f32_16x16x32_bf16(af, vf[ks], o[ct], 0, 0, 0); }
#pragma unroll
        for (int kk = 0; kk < 4; ++kk) { v4u pw; pw.x = pg8::cvt_pk_bf16(S[2 * kk][0], S[2 * kk][1]); pw.y = pg8::cvt_pk_bf16(S[2 * kk][2], S[2 * kk][3]);
            pw.z = pg8::cvt_pk_bf16(S[2 * kk + 1][0], S[2 * kk + 1][1]); pw.w = pg8::cvt_pk_bf16(S[2 * kk + 1][2], S[2 * kk + 1][3]); const bf16x8 sf = __builtin_bit_cast(bf16x8, pw);
#pragma unroll
            for (int ct = 0; ct < 4; ++ct) { const LAS unsigned char* qp = L + OQD + (16 * ct + n) * 272 + (32 * kk + 4 * g) * 2; const v2u qa = *(const LAS v2u*)qp, qb = *(const LAS v2u*)(qp + 32);
                o[ct] = __builtin_amdgcn_mfma_f32_16x16x32_bf16(__builtin_bit_cast(bf16x8, (v4u){qa.x, qa.y, qb.x, qb.y}), sf, o[ct], 0, 0, 0); } }
#pragma unroll
        for (int dt = 0; dt < 8; ++dt) { const f32x4v eb = *(const LAS f32x4v*)(L + OEB + (16 * dt + 4 * g) * 4); S[dt] = S[dt] * eb;
#pragma unroll
            for (int ks = 0; ks < 2; ++ks) { const bf16x8 kf = *(const LAS bf16x8*)(L + OKT + (16 * dt + n) * 144 + (32 * ks + 8 * g) * 2); S[dt] = __builtin_amdgcn_mfma_f32_16x16x32_bf16(kf, vf[ks], S[dt], 0, 0, 0); } }
        LAS float* PS = (LAS float*)(L + OPS) + (ck & 1) * 512;
#pragma unroll
        for (int ct = 0; ct < 4; ++ct)
#pragma unroll
            for (int r = 0; r < 4; ++r) { const float ss = sum16(o[ct][r] * o[ct][r]); if (n == 0) PS[(16 * ct + 4 * g + r) * 8 + w] = ss;
                *(LAS bf16*)(L + OOT + (16 * ct + 4 * g + r) * 272 + (16 * w + n) * 2) = (bf16)f2bf(o[ct][r]); }
        LDS_BARRIER();
        GL_WRITE();
        if (!(HACK & 2)) {
#pragma unroll
        for (int i = 0; i < 2; ++i) { const int c_ = tid + 512 * i, tok = c_ >> 4, ch = c_ & 15; *(v4u*)(OB + (row0 + tok) * 1024 + h * 256 + 128 * vh + ch * 8) = *(const LAS v4u*)(L + OOT + tok * 272 + ch * 16); }
        if (tid < 64) { const LAS f32x4v* pp = (const LAS f32x4v*)(PS + tid * 8); const f32x4v p0 = pp[0], p1 = pp[1]; PSG[(row0 + tid) * 8 + h * 2 + vh] = ((p0.x + p0.y) + (p0.z + p0.w)) + ((p1.x + p1.y) + (p1.z + p1.w)); } }
        LDS_BARRIER();
    }
#undef GL_ISSUE
#undef GL_WRITE
}
__device__ __forceinline__ void gla_post(Frame& F, int l) {
    const bf16* OB = WSP(bf16, WS_OB); const float* PSG = WSP(float, WS_PSG); const bf16* COLS = WSP(bf16, WS_COLS); bf16* MIX = WSP(bf16, WS_MIXED);
    const int ch = F.tid & 127, h = ch >> 5; float gain8[8];
#pragma unroll
    for (int e = 0; e < 8; ++e) gain8[e] = F.kin[I_GON][l * 256 + (ch & 31) * 8 + e];
    for (int row0 = F.bx * 4 + (F.tid >> 7); row0 < M; row0 += F.G * 16) {
        v4u ovr[4], gvr[4]; f32x2_t ps[4];
#pragma unroll
        for (int i = 0; i < 4; ++i) { const int row = row0 + F.G * 4 * i < M ? row0 + F.G * 4 * i : row0;
            ovr[i] = *(const v4u*)(OB + (size_t)row * 1024 + ch * 8); gvr[i] = *(const v4u*)(COLS + (size_t)row * NMAIN + CB_G + ch * 8); ps[i] = *(const f32x2_t*)(PSG + (size_t)row * 8 + h * 2); }
#pragma unroll
        for (int i = 0; i < 4; ++i) { const int row = row0 + F.G * 4 * i; float ov[8], gv[8]; unpack8(ovr[i], ov); unpack8(gvr[i], gv);
            const float rstd = rsqrtf((ps[i].x + ps[i].y) * (1.0f / 256.0f) + 1e-6f);
#pragma unroll
            for (int e = 0; e < 8; ++e) ov[e] = ov[e] * (rstd * gain8[e]) * silu_g(gv[e]);
            if (row < M) *(v4u*)(MIX + (size_t)row * DM + 1024 + ch * 8) = pack8(ov); }
    }
}
constexpr int RC_AT = 0, RC_RT = 2048, RC_BK = 4096, RC_VF = 8192, RC_GF = 10240, RC_U0 = 12288, RC_Y0 = 16384, RC_P15 = 20480, RC_BN = 20736, RC_BYTES = 20800;
__device__ __forceinline__ void rwkv_chunks_of_tile(Frame& F, int l, int tile) {
    const int team = F.tid >> 8, tt = F.tid & 255;
    LAS float* Lt = (LAS float*)(F.lds + RING_OFF) + team * 12288;
    LAS float* XA = Lt; LAS float* XR = Lt + 1040; LAS float* ZB = Lt + 2080; LAS float* ZK = Lt + 3120; LAS float* TB = Lt + 4160; LAS float* TK = Lt + 5200; LAS float* VV = Lt + 6240;
    LAS float* ATl = Lt + 7280; LAS float* U0l = Lt + 8320; LAS float* W1 = Lt + 9360;
    LAS float* Aab = Lt + 10400; LAS float* Aak = Lt + 10672; LAS float* Arb = Lt + 10944; LAS float* Ark = Lt + 11216; LAS float* TT = Lt + 11488;
    const float* RW = WSP(float, WS_RW); const unsigned* RWU = WSP(unsigned, WS_RW); constexpr size_t RS = RW_ONE / 4; unsigned char* RWC = F.ws + WS_RWC;
    float pw_[6], pr_[4], pk_[4], pv_[4], pa_[4], pb_[4], pg_[4];
#define RC_FETCH(P) do { const int h_ = 2 * (P) + team; const size_t cb_ = (size_t)tile * 16 * 1024 + h_ * 64 + (tt & 63); const int q_ = tt >> 6; \
        pw_[4] = RW[RS + cb_ + (size_t)(q_ ? 4 * q_ - 1 : 0) * 1024]; pw_[5] = RW[RS + cb_ + (size_t)15 * 1024];            \
        _Pragma("unroll") for (int e = 0; e < 4; ++e) { const size_t o_ = cb_ + (size_t)(4 * q_ + e) * 1024; pw_[e] = RW[RS + o_]; const unsigned u0 = RWU[o_], u2 = RWU[2 * RS + o_], u3 = RWU[3 * RS + o_]; \
            pr_[e] = bflo(u0); pk_[e] = bfhi(u0); pv_[e] = bflo(u2); pg_[e] = bfhi(u2); pa_[e] = bflo(u3); pb_[e] = bfhi(u3); } } while (0)
    RC_FETCH(0);
#pragma unroll 1
    for (int pair = 0; pair < 8; ++pair) {
        const int uc = ((tile >> 9) * 16 + 2 * pair + team) * 512 + (tile & 511), b = uc >> 13, h = (uc >> 9) & 15, ck = uc & 511; unsigned char* rec = RWC + ((size_t)ck * 32 + (uc >> 9)) * RC_BYTES;     (void)b;
        __syncthreads();
        {
          const int j = tt & 63, q = tt >> 6;
          const float cl = pw_[5], clm = q ? pw_[4] : 0.f; const float clq[4] = {pw_[0], pw_[1], pw_[2], pw_[3]};
#pragma unroll
          for (int e = 0; e < 4; ++e) { const int t = 4 * q + e; const float cprev = e == 0 ? clm : clq[e - 1], cc = clq[e];
              const float rr = pr_[e], kk = pk_[e], vv = pv_[e], aa = pa_[e], bb = pb_[e];
              XA[t * 65 + j] = aa * __expf(cprev); XR[t * 65 + j] = rr * __expf(cc); const float ei = __expf(-cc), ef = __expf(cl - cc);
              ZB[t * 65 + j] = bb * ei; ZK[t * 65 + j] = kk * ei; TB[t * 65 + j] = bb * ef; TK[t * 65 + j] = kk * ef; VV[t * 65 + j] = vv; }
          if (q == 0) ((float*)(rec + RC_P15))[j] = __expf(cl);
          { v2u gw; gw.x = pk2(pg_[0], pg_[1]); gw.y = pk2(pg_[2], pg_[3]); *(v2u*)(rec + RC_GF + (((j >> 4) * 64 + 16 * q + (j & 15)) * 8)) = gw; } }
        RC_FETCH(pair < 7 ? pair + 1 : 7);
        __syncthreads();
        {
          const int q = tt >> 6, n = tt & 15, g = (tt >> 4) & 3; const LAS float* X = (q & 2) ? XR : XA; const LAS float* Z = (q & 1) ? ZK : ZB; LAS float* O = q == 0 ? Aab : (q == 1 ? Aak : (q == 2 ? Arb : Ark));
          f32x4v c = (f32x4v){0.f, 0.f, 0.f, 0.f};
#pragma unroll
          for (int ks = 0; ks < 16; ++ks) c = __builtin_amdgcn_mfma_f32_16x16x4f32(X[n * 65 + 4 * ks + g], Z[n * 65 + 4 * ks + g], c, 0, 0, 0);
#pragma unroll
          for (int rr = 0; rr < 4; ++rr) { const int t = 4 * g + rr; O[t * 17 + n] = ((q & 2) ? n <= t : n < t) ? c[rr] : 0.f; }
          { const int t = tt >> 4, jq = tt & 15; const float* rkp = F.kin[I_RRK] + l * 1024 + h * 64 + 4 * jq; float bn = 0.f;
#pragma unroll
            for (int e = 0; e < 4; ++e) bn += XR[t * 65 + 4 * jq + e] * ZK[t * 65 + 4 * jq + e] * rkp[e];
            bn = sum16(bn); if (jq == 0) ((float*)(rec + RC_BN))[t] = bn; } }
        __syncthreads();
        {
          if (tt < 16) { float col[16];
#pragma unroll
              for (int t = 0; t < 16; ++t) { float acc = (t == tt) ? 1.f : 0.f;
#pragma unroll
                  for (int s = 0; s < 16; ++s) if (s < t) acc += Aab[t * 17 + s] * col[s];
                  col[t] = acc; TT[t * 17 + tt] = acc; } }
          const int q = tt >> 6, n = tt & 15, g = (tt >> 4) & 3; f32x4v c = (f32x4v){0.f, 0.f, 0.f, 0.f};
#pragma unroll
          for (int ks = 0; ks < 4; ++ks) c = __builtin_amdgcn_mfma_f32_16x16x4f32(Aak[n * 17 + 4 * ks + g], VV[(4 * ks + g) * 65 + 16 * q + n], c, 0, 0, 0);
#pragma unroll
          for (int rr = 0; rr < 4; ++rr) W1[(4 * g + rr) * 65 + 16 * q + n] = c[rr]; }
        __syncthreads();
        {
          const int q = tt >> 6, n = tt & 15, g = (tt >> 4) & 3; f32x4v ca = (f32x4v){0.f, 0.f, 0.f, 0.f}, cu = (f32x4v){0.f, 0.f, 0.f, 0.f};
#pragma unroll
          for (int ks = 0; ks < 4; ++ks) { const float tv = TT[n * 17 + 4 * ks + g]; ca = __builtin_amdgcn_mfma_f32_16x16x4f32(tv, XA[(4 * ks + g) * 65 + 16 * q + n], ca, 0, 0, 0); cu = __builtin_amdgcn_mfma_f32_16x16x4f32(tv, W1[(4 * ks + g) * 65 + 16 * q + n], cu, 0, 0, 0); }
#pragma unroll
          for (int rr = 0; rr < 4; ++rr) { ATl[(4 * g + rr) * 65 + 16 * q + n] = ca[rr]; U0l[(4 * g + rr) * 65 + 16 * q + n] = cu[rr]; }
          *(f32x4v*)(rec + RC_U0 + ((q * 64 + 16 * g + n) * 16)) = cu; }
        __syncthreads();
        {
          const int q = tt >> 6, n = tt & 15, g = (tt >> 4) & 3; f32x4v cr, cy = (f32x4v){0.f, 0.f, 0.f, 0.f};
#pragma unroll
          for (int rr = 0; rr < 4; ++rr) cr[rr] = XR[(4 * g + rr) * 65 + 16 * q + n];
#pragma unroll
          for (int ks = 0; ks < 4; ++ks) { const float arb = Arb[n * 17 + 4 * ks + g], ark = Ark[n * 17 + 4 * ks + g];
              cr = __builtin_amdgcn_mfma_f32_16x16x4f32(arb, ATl[(4 * ks + g) * 65 + 16 * q + n], cr, 0, 0, 0);
              cy = __builtin_amdgcn_mfma_f32_16x16x4f32(arb, U0l[(4 * ks + g) * 65 + 16 * q + n], cy, 0, 0, 0);
              cy = __builtin_amdgcn_mfma_f32_16x16x4f32(ark, VV[(4 * ks + g) * 65 + 16 * q + n], cy, 0, 0, 0); }
          *(f32x4v*)(rec + RC_Y0 + ((q * 64 + 16 * g + n) * 16)) = cy;
#pragma unroll
          for (int rr = 0; rr < 4; ++rr) W1[(4 * g + rr) * 65 + 16 * q + n] = cr[rr]; }
        __syncthreads();
        { const int t = tt & 15, jq = tt >> 4, kk = jq >> 3, half = (jq & 7) >> 2, g = jq & 3, j0 = 4 * jq;
          v2u wa, wr; wa.x = pk2(ATl[t * 65 + j0], ATl[t * 65 + j0 + 1]); wa.y = pk2(ATl[t * 65 + j0 + 2], ATl[t * 65 + j0 + 3]); wr.x = pk2(W1[t * 65 + j0], W1[t * 65 + j0 + 1]); wr.y = pk2(W1[t * 65 + j0 + 2], W1[t * 65 + j0 + 3]);
          *(v2u*)(rec + RC_AT + kk * 1024 + (16 * g + t) * 16 + half * 8) = wa; *(v2u*)(rec + RC_RT + kk * 1024 + (16 * g + t) * 16 + half * 8) = wr;
          const int j = tt & 63, gg = tt >> 6; v4u bk; bk.x = pk2(TB[(4 * gg) * 65 + j], TB[(4 * gg + 1) * 65 + j]); bk.y = pk2(TB[(4 * gg + 2) * 65 + j], TB[(4 * gg + 3) * 65 + j]);
          bk.z = pk2(TK[(4 * gg) * 65 + j], TK[(4 * gg + 1) * 65 + j]); bk.w = pk2(TK[(4 * gg + 2) * 65 + j], TK[(4 * gg + 3) * 65 + j]);
          *(v4u*)(rec + RC_BK + (j >> 4) * 1024 + (16 * gg + (j & 15)) * 16) = bk;
          v2u vf; vf.x = pk2(VV[(4 * gg) * 65 + j], VV[(4 * gg + 1) * 65 + j]); vf.y = pk2(VV[(4 * gg + 2) * 65 + j], VV[(4 * gg + 3) * 65 + j]);
          *(v2u*)(rec + RC_VF + ((j >> 4) * 64 + 16 * gg + (j & 15)) * 8) = vf; }
    }
}
#undef RC_FETCH
template <int HACK = 0> __device__ __forceinline__ void rwkv_scan_unit(Frame& F, int l, int b, int h) {
    LAS unsigned char* L = F.lds + RING_OFF;
    const unsigned char* recs = F.ws + WS_RWC + (size_t)(b * 16 + h) * RC_BYTES;
    const int lane = F.lane, n = lane & 15, g = lane >> 4;
    LAS float* XS = (LAS float*)(L + 2 * RC_BYTES);
    if (F.wave >= 2) {
        const int li = F.tid - 128;
        int px[4];
#pragma unroll
        for (int k = 0; k < 4; ++k) { const int x = li + 384 * k; px[k] = x < 1300 ? x : 1299; }
        v4u p0[4], p1[4], p2[4], p3[4], p4[4], p5[4], p6[4], p7[4];
#define RWL_ISSUE(P, CK) do { const int ck_ = (CK) < 512 ? ((HACK & 1) && (CK) >= 4 ? 3 : (CK)) : 511; const v4u* src_ = (const v4u*)(recs + (size_t)ck_ * 32 * RC_BYTES); \
        _Pragma("unroll") for (int k = 0; k < 4; ++k) P[k] = src_[px[k]]; } while (0)
#define RWL_WRITE(P, CK) do { LAS v4u* dst_ = (LAS v4u*)(L + ((CK) & 1) * RC_BYTES); _Pragma("unroll") for (int k = 0; k < 4; ++k) dst_[px[k]] = P[k]; } while (0)
        RWL_ISSUE(p0, 0); RWL_ISSUE(p1, 1); RWL_ISSUE(p2, 2); RWL_ISSUE(p3, 3); RWL_ISSUE(p4, 4); RWL_ISSUE(p5, 5); RWL_ISSUE(p6, 6); RWL_ISSUE(p7, 7);
        RWL_WRITE(p0, 0); RWL_ISSUE(p0, 8);
        LDS_BARRIER();
#pragma unroll 1
        for (int ck = 0; ck < 512; ck += 8) {
            RWL_WRITE(p1, ck + 1); RWL_ISSUE(p1, ck + 9); LDS_BARRIER();
            RWL_WRITE(p2, ck + 2); RWL_ISSUE(p2, ck + 10); LDS_BARRIER();
            RWL_WRITE(p3, ck + 3); RWL_ISSUE(p3, ck + 11); LDS_BARRIER();
            RWL_WRITE(p4, ck + 4); RWL_ISSUE(p4, ck + 12); LDS_BARRIER();
            RWL_WRITE(p5, ck + 5); RWL_ISSUE(p5, ck + 13); LDS_BARRIER();
            RWL_WRITE(p6, ck + 6); RWL_ISSUE(p6, ck + 14); LDS_BARRIER();
            RWL_WRITE(p7, ck + 7); RWL_ISSUE(p7, ck + 15); LDS_BARRIER();
            RWL_WRITE(p0, ck + 8); RWL_ISSUE(p0, ck + 16); LDS_BARRIER();
        }
#undef RWL_ISSUE
#undef RWL_WRITE
        return;
    }
    const int cw = F.wave;
    f32x4v S[4][2];
#pragma unroll
    for (int jt = 0; jt < 4; ++jt)
#pragma unroll
        for (int it = 0; it < 2; ++it) S[jt][it] = (f32x4v){0.f, 0.f, 0.f, 0.f};
    float lnw[2], lnb[2];
#pragma unroll
    for (int it = 0; it < 2; ++it) { lnw[it] = F.kin[I_RLNW][l * 1024 + h * 64 + 16 * (2 * cw + it) + n]; lnb[it] = F.kin[I_RLNB][l * 1024 + h * 64 + 16 * (2 * cw + it) + n]; }
    bf16* MIX = WSP(bf16, WS_MIXED) + ((size_t)b * SEQ) * DM + 2048 + h * 64 + 32 * cw + n;
    f32x4v Yp[2] = {(f32x4v){0.f, 0.f, 0.f, 0.f}, (f32x4v){0.f, 0.f, 0.f, 0.f}}, bnp = (f32x4v){0.f, 0.f, 0.f, 0.f}; v2u gfp[2] = {(v2u){0u, 0u}, (v2u){0u, 0u}}, vfp[2] = {(v2u){0u, 0u}, (v2u){0u, 0u}};
    LDS_BARRIER();
#pragma unroll 1
    for (int ck = 0; ck <= 512; ++ck) {
        if (ck > 0) {
            const LAS float* xs = XS + ((ck - 1) & 1) * 64; const f32x4v a0 = *(const LAS f32x4v*)(xs + 8 * g), a1 = *(const LAS f32x4v*)(xs + 8 * g + 4), b0 = *(const LAS f32x4v*)(xs + 32 + 8 * g), b1 = *(const LAS f32x4v*)(xs + 32 + 8 * g + 4);
            const float s1[4] = {a0[0] + b0[0], a0[2] + b0[2], a1[0] + b1[0], a1[2] + b1[2]}, s2[4] = {a0[1] + b0[1], a0[3] + b0[3], a1[1] + b1[1], a1[3] + b1[3]};
#pragma unroll
            for (int it = 0; it < 2; ++it) { const float gt[4] = {bflo(gfp[it].x), bfhi(gfp[it].x), bflo(gfp[it].y), bfhi(gfp[it].y)}, vt[4] = {bflo(vfp[it].x), bfhi(vfp[it].x), bflo(vfp[it].y), bfhi(vfp[it].y)};
#pragma unroll
                for (int r = 0; r < 4; ++r) { const float mean = s1[r] * (1.0f / 64.0f), var = fmaxf(s2[r] * (1.0f / 64.0f) - mean * mean, 0.f), rstd = rsqrtf(var + 64e-5f);
                    if (!(HACK & 2)) MIX[(size_t)((ck - 1) * 16 + 4 * g + r) * DM + 16 * it] = (bf16)f2bf(((Yp[it][r] - mean) * rstd * lnw[it] + lnb[it] + bnp[r] * vt[r]) * gt[r]); } }
            if (ck == 512) break;
        }
        if (HACK & 4) { LDS_BARRIER(); continue; }
        const LAS unsigned char* R = L + (ck & 1) * RC_BYTES;
        bf16x8 at[2], rt[2];
#pragma unroll
        for (int kk = 0; kk < 2; ++kk) { at[kk] = *(const LAS bf16x8*)(R + RC_AT + kk * 1024 + lane * 16); rt[kk] = *(const LAS bf16x8*)(R + RC_RT + kk * 1024 + lane * 16); }
        f32x4v U[2], Y[2];
#pragma unroll
        for (int it = 0; it < 2; ++it) { U[it] = *(const LAS f32x4v*)(R + RC_U0 + (2 * cw + it) * 1024 + lane * 16); Y[it] = *(const LAS f32x4v*)(R + RC_Y0 + (2 * cw + it) * 1024 + lane * 16); }
#pragma unroll
        for (int kk = 0; kk < 2; ++kk)
#pragma unroll
            for (int it = 0; it < 2; ++it) { v4u pw; pw.x = pg8::cvt_pk_bf16(S[2 * kk][it][0], S[2 * kk][it][1]); pw.y = pg8::cvt_pk_bf16(S[2 * kk][it][2], S[2 * kk][it][3]);
                pw.z = pg8::cvt_pk_bf16(S[2 * kk + 1][it][0], S[2 * kk + 1][it][1]); pw.w = pg8::cvt_pk_bf16(S[2 * kk + 1][it][2], S[2 * kk + 1][it][3]); const bf16x8 sf = __builtin_bit_cast(bf16x8, pw);
                U[it] = __builtin_amdgcn_mfma_f32_16x16x32_bf16(at[kk], sf, U[it], 0, 0, 0); Y[it] = __builtin_amdgcn_mfma_f32_16x16x32_bf16(rt[kk], sf, Y[it], 0, 0, 0); }
        bf16x8 uv[2];
#pragma unroll
        for (int it = 0; it < 2; ++it) { vfp[it] = *(const LAS v2u*)(R + RC_VF + (2 * cw + it) * 512 + lane * 8); gfp[it] = *(const LAS v2u*)(R + RC_GF + (2 * cw + it) * 512 + lane * 8);
            v4u pw; pw.x = pg8::cvt_pk_bf16(U[it][0], U[it][1]); pw.y = pg8::cvt_pk_bf16(U[it][2], U[it][3]); pw.z = vfp[it].x; pw.w = vfp[it].y; uv[it] = __builtin_bit_cast(bf16x8, pw); }
#pragma unroll
        for (int jt = 0; jt < 4; ++jt) { const bf16x8 bk = *(const LAS bf16x8*)(R + RC_BK + jt * 1024 + lane * 16); const f32x4v p15 = *(const LAS f32x4v*)(R + RC_P15 + (16 * jt + 4 * g) * 4);
#pragma unroll
            for (int it = 0; it < 2; ++it) S[jt][it] = __builtin_amdgcn_mfma_f32_16x16x32_bf16(bk, uv[it], S[jt][it] * p15, 0, 0, 0); }
        bnp = *(const LAS f32x4v*)(R + RC_BN + 16 * g); Yp[0] = Y[0]; Yp[1] = Y[1];
        { LAS float* xo = XS + (ck & 1) * 64 + cw * 32; const f32x4v sm = Y[0] + Y[1], sq = Y[0] * Y[0] + Y[1] * Y[1];
#pragma unroll
          for (int r = 0; r < 4; ++r) { const float a = sum16(sm[r]), q = sum16(sq[r]); if (n == 0) { xo[(4 * g + r) * 2] = a; xo[(4 * g + r) * 2 + 1] = q; } } }
        LDS_BARRIER();
    }
}
template <int HACK = 0> __device__ __forceinline__ void mixers_v4(Frame& F, int l, int qi, int mask = 15) {
    gu32* ctr = F.ctl + CW_Q + 64 * qi;
    constexpr int NG5 = 683;
    static_assert(2 * NG5 >= CONV_NQ && 3 * NG5 >= 2048, "queue pattern");
    for (;;) {
        const int it = next_item(F, ctr); relaunder(F); relaunder_tid(F);
        if (it < 32) { if (mask & 1) rwkv_scan_unit<HACK>(F, l, it >> 4, it & 15); continue; }
        if (it < 48) { const int j = it - 32; if (mask & 2) gla_scan_unit<HACK>(F, l, j >> 3, (j >> 1) & 3, j & 1); continue; }
        int ai;
        if (l == 0) { const int k = it - 48; if (k >= 5 * NG5) break; const int g = k / 5, p = k - 5 * g;
            if (p == 0 || p == 2) { const int ci = 2 * g + (p >> 1);
                if (ci < CONV_NQ) { LAS float* scr = (LAS float*)(F.lds + RING_OFF + F.wave * 16384);
#pragma unroll 1
                    for (int j = 0; j < CONV_PER_Q / NWAVES; ++j) { const int cit = CONV_I_IN + ci * CONV_PER_Q + F.wave + NWAVES * j; if (cit < CONV_TOTAL) conv_dispatch(F, cit, scr); } }
                continue; }
            ai = 3 * g + (p == 1 ? 0 : (p == 3 ? 1 : 2)); }
        else { ai = it - 48; if (ai >= 2048) break; }
        if (ai < 1024) { const int qb = 63 - (ai >> 4), bh = ai & 15; if (mask & 4) attn_unit<true>(F, l, bh >> 3, bh & 7, qb); }
        else if (ai < 2048) { const int j = ai - 1024, qb = j & 63, bh = j >> 6; if (mask & 8) attn_unit<false>(F, l, bh >> 3, bh & 7, qb); }
    }
}
template <int HACK = 0> __device__ __forceinline__ void prep_rwkv(Frame& F, int l) {
    LAS float* zl = (LAS float*)(F.lds + RING_OFF) + 4096;
    LAS bf16* inb = (LAS bf16*)(F.lds + RING_OFF);
    const float* mu = F.kin[I_RMU] + (size_t)l * 3264;
    const float* LOWR = WSP(float, WS_LOWR); const bf16* COLS = WSP(bf16, WS_COLS);
    float* RW = WSP(float, WS_RW); unsigned* RWU = WSP(unsigned, WS_RW); float* VF = WSP(float, WS_VFIRST);
    constexpr size_t RS = RW_ONE / 4;
    for (int tile = F.bx; tile < M / 16; tile += F.G) {
        const int row0 = tile * 16;
        relaunder(F); relaunder_tid(F);
        __syncthreads();
        {
            float cur_[7], prv_[7], mu_[7];
#pragma unroll
            for (int q = 0; q < 7; ++q) { const int idx = F.tid + NWAVES * 64 * q, tt = idx / 224, j = idx % 224, row = row0 + tt;
                const int col = j < 192 ? 16 + j : 208 + (j - 192);
                const float* mp = j < 192 ? mu + 3072 + j : F.kin[I_VRMU] + (l ? (l - 1) * 32 : 0) + (j - 192);
                cur_[q] = LOWR[(size_t)row * 256 + col]; prv_[q] = LOWR[(size_t)((row & (SEQ - 1)) ? row - 1 : row) * 256 + col]; mu_[q] = *mp; }
#pragma unroll
            for (int q = 0; q < 7; ++q) { const int idx = F.tid + NWAVES * 64 * q, tt = idx / 224, j = idx % 224, row = row0 + tt;
                const float prev = (row & (SEQ - 1)) ? prv_[q] : 0.f, muv = (j >= 192 && l == 0) ? 0.f : mu_[q];
                float x = cur_[q] + (prev - cur_[q]) * muv;
                if (j < 64) x = tanhf(x); else if (j >= 128 && j < 192) x = sigmoid_f(x);
                inb[tt * 232 + j] = (bf16)f2bf(x); } }
        __syncthreads();
        {
            const int c = 2 * F.tid;
            float accw[2][16], acca[2][16], accg[2][16], accv[2][16];
#pragma unroll
            for (int e = 0; e < 2; ++e) { const float bw = F.kin[I_RW0][l * 1024 + c + e], ba = F.kin[I_RA0][l * 1024 + c + e], bv = l ? F.kin[I_VR0][(l - 1) * 1024 + c + e] : 0.f;
#pragma unroll
              for (int tt = 0; tt < 16; ++tt) { accw[e][tt] = bw; acca[e][tt] = ba; accg[e][tt] = 0.f; accv[e][tt] = bv; } }
#define LOWRANK_MFMA(ACC, MI, JOFF, NKS) do { const bf16* wf_ = WSP(bf16, WS_WF) + ((size_t)(l * 448 + ((MI) < 3 ? (MI) * 128 + 16 * (NKS) / 2 * F.wave : 384 + 8 * F.wave)) * 64 + F.lane) * 8; \
            bf16x8 af_[NKS], bf_[8][NKS]; \
            _Pragma("unroll") for (int ks = 0; ks < (NKS); ++ks) af_[ks] = *(const LAS bf16x8*)(inb + (F.lane & 15) * 232 + (JOFF) + 32 * ks + 8 * (F.lane >> 4)); \
            _Pragma("unroll") for (int nt = 0; nt < 8; ++nt) _Pragma("unroll") for (int ks = 0; ks < (NKS); ++ks) bf_[nt][ks] = *(const bf16x8*)(wf_ + (size_t)(nt * (NKS) + ks) * 512); \
            _Pragma("unroll") for (int nt = 0; nt < 8; ++nt) { f32x4 c4 = {0.f, 0.f, 0.f, 0.f}; \
                _Pragma("unroll") for (int ks = 0; ks < (NKS); ++ks) c4 = __builtin_amdgcn_mfma_f32_16x16x32_bf16(af_[ks], bf_[nt][ks], c4, 0, 0, 0); \
                _Pragma("unroll") for (int rr = 0; rr < 4; ++rr) zl[(4 * (F.lane >> 4) + rr) * 1028 + 128 * F.wave + 16 * nt + (F.lane & 15)] = c4[rr]; } \
            __builtin_amdgcn_wave_barrier(); asm volatile("s_waitcnt lgkmcnt(0)" ::: "memory"); __builtin_amdgcn_wave_barrier();   \
            _Pragma("unroll") for (int tt = 0; tt < 16; ++tt) { const f32x2_t z2 = *(const LAS f32x2_t*)(zl + tt * 1028 + c); ACC[0][tt] += z2.x; ACC[1][tt] += z2.y; } \
            __builtin_amdgcn_wave_barrier(); asm volatile("s_waitcnt lgkmcnt(0)" ::: "memory"); __builtin_amdgcn_wave_barrier(); } while (0)
            if (!(HACK & 1)) { LOWRANK_MFMA(accw, 0, 0, 2); relaunder(F);
            LOWRANK_MFMA(acca, 1, 64, 2); relaunder(F);
            LOWRANK_MFMA(accg, 2, 128, 2); relaunder(F);
            if (l) LOWRANK_MFMA(accv, 3, 192, 1); }
#undef LOWRANK_MFMA
            relaunder(F);
            float mur[2], muk[2], muv[2], kkv[2], kav[2], pr[2] = {0.f, 0.f}, pk[2] = {0.f, 0.f}, pv[2] = {0.f, 0.f}; float cl[2] = {0.f, 0.f};
#pragma unroll
            for (int e = 0; e < 2; ++e) { mur[e] = F.kin[I_RMU][l * 3264 + c + e]; muk[e] = F.kin[I_RMU][l * 3264 + 1024 + c + e]; muv[e] = F.kin[I_RMU][l * 3264 + 2048 + c + e]; kkv[e] = F.kin[I_RKK][l * 1024 + c + e]; kav[e] = F.kin[I_RKA][l * 1024 + c + e]; }
            if ((row0 & (SEQ - 1)) != 0) { const bf16* p = COLS + (size_t)(row0 - 1) * NMAIN + c; const unsigned ur = *(const unsigned*)(p + CC_R), uk = *(const unsigned*)(p + CC_K), uv = *(const unsigned*)(p + CC_V);
                pr[0] = bflo(ur); pr[1] = bfhi(ur); pk[0] = bflo(uk); pk[1] = bfhi(uk); pv[0] = bflo(uv); pv[1] = bfhi(uv); }
            constexpr int PFD = 4;
            unsigned pur[16], puk[16], puv[16]; f32x2_t pvf[16];
#define PF_TOK(T) do { const bf16* p_ = COLS + (size_t)(row0 + (T)) * NMAIN + c; pur[T] = *(const unsigned*)(p_ + CC_R); puk[T] = *(const unsigned*)(p_ + CC_K); puv[T] = *(const unsigned*)(p_ + CC_V); \
                pvf[T] = *(const f32x2_t*)(VF + (size_t)(row0 + (T)) * 1024 + c); } while (0)
#pragma unroll
            for (int tt = 0; tt < PFD; ++tt) PF_TOK(tt);
            asm volatile("" ::: "memory");
            if (!(HACK & 4))
#pragma unroll
            for (int tt = 0; tt < 16; ++tt) { const int row = row0 + tt; const size_t o = (size_t)row * 1024 + c;
                if (tt + PFD < 16) { PF_TOK(tt + PFD < 16 ? tt + PFD : 15); }
                asm volatile("" ::: "memory");
                const unsigned ur = pur[tt], uk = puk[tt], uv = puv[tt];
                const float cr[2] = {bflo(ur), bfhi(ur)}, ck[2] = {bflo(uk), bfhi(uk)}, cv[2] = {bflo(uv), bfhi(uv)};
                f32x2_t vf2 = pvf[tt];
                float r[2], k[2], v[2], dec[2], av[2], kk[2], km[2];
#pragma unroll
                for (int e = 0; e < 2; ++e) { r[e] = cr[e] + (pr[e] - cr[e]) * mur[e]; k[e] = ck[e] + (pk[e] - ck[e]) * muk[e]; v[e] = cv[e] + (pv[e] - cv[e]) * muv[e]; pr[e] = cr[e]; pk[e] = ck[e]; pv[e] = cv[e];
                    if (l == 0) vf2[e] = v[e]; else { const float vg = sigmoid_f(accv[e][tt]); v[e] = v[e] + (vf2[e] - v[e]) * vg; }
                    cl[e] += -0.6065306597126334f * sigmoid_f(accw[e][tt]); dec[e] = cl[e]; av[e] = sigmoid_f(acca[e][tt]); kk[e] = k[e] * kkv[e]; km[e] = k[e] * (1.0f + (av[e] - 1.0f) * kav[e]); }
                const float ss = sum32(kk[0] * kk[0] + kk[1] * kk[1]), rn = rsqrtf(fmaxf(ss, 1e-24f)); kk[0] *= rn; kk[1] *= rn;
                if (l == 0) *(f32x2_t*)(VF + o) = vf2;
                *(f32x2_t*)(RW + RS + o) = (f32x2_t){dec[0], dec[1]};
                *(v2u*)(RWU + o) = (v2u){pk2(r[0], km[0]), pk2(r[1], km[1])}; *(v2u*)(RWU + 2 * RS + o) = (v2u){pk2(v[0], accg[0][tt]), pk2(v[1], accg[1][tt])};
                *(v2u*)(RWU + 3 * RS + o) = (v2u){pk2(-kk[0], kk[0] * av[0]), pk2(-kk[1], kk[1] * av[1])}; }
#undef PF_TOK
        }
        asm volatile("s_waitcnt vmcnt(0)" ::: "memory"); __syncthreads();
        __builtin_amdgcn_fence(__ATOMIC_ACQUIRE, "agent"); asm volatile("s_waitcnt vmcnt(0)" ::: "memory");
        if (!(HACK & 2)) rwkv_chunks_of_tile(F, l, tile);
    }
}
struct Args { const float* in[35]; float* out; unsigned char* ws; };
__device__ __forceinline__ void mk_frame(Frame& F, int wv) {
    extern __shared__ __attribute__((aligned(16))) unsigned char lds[];
    kargp kp = (kargp)__builtin_amdgcn_kernarg_segment_ptr(); asm volatile("" : "+s"(kp));
    F.kin = kp;
    F.lds = (LAS unsigned char*)lds;
    F.MISC = (volatile LAS unsigned*)(F.lds + MISC_OFF);
    { int w_ = wv; asm volatile("" : "+s"(w_)); int t_ = (int)__builtin_amdgcn_mbcnt_hi(~0u, __builtin_amdgcn_mbcnt_lo(~0u, (unsigned)w_ * 64u)); asm volatile("" : "+v"(t_)); F.tid = t_; } F.lane = F.tid & 63; F.wave = __builtin_amdgcn_readfirstlane(F.tid >> 6);
    F.G = gridDim.x; { int bx = blockIdx.x; asm volatile("" : "+s"(bx)); F.bx = bx; F.vcu = (F.G % 8 == 0) ? (bx % 8) * (F.G / 8) + bx / 8 : bx; }
    F.out = (float*)kp[35]; F.ws = (unsigned char*)kp[36]; F.ctl = (gu32*)(F.ws + WS_CTL);
}
__device__ __forceinline__ void grid_bar(int wv) {
    Frame F; mk_frame(F, wv);
    XcdBarrier bar; bar.bar = (unsigned*)(F.ctl + CW_BAR); bar.x = xb_xcc_id(); bar.st = F.MISC + 8;
    xcd_barrier(bar);
}
__global__ void __launch_bounds__(NWAVES * 64, 2) mega_fwd(Args args) {
    const int wv = __builtin_amdgcn_readfirstlane((int)threadIdx.x >> 6);
    { Frame F; mk_frame(F, wv);
      for (int u = F.tid; u < (LDS_BYTES - LDSCTL_OFF) / 4; u += NWAVES * 64) ((LAS unsigned*)(F.lds + LDSCTL_OFF))[u] = 0u;
      __syncthreads();
      (void)xcd_barrier_post((unsigned*)(F.ctl + CW_BAR), F.MISC + 8);
      p0_prologue_a(F);
    }
    grid_bar(wv);
    { Frame F; mk_frame(F, wv); p0_prologue_b(F); }
    grid_bar(wv);
#pragma unroll 1
    for (int l = 0; l < NLAYER; ++l) {
#define LAYER_VARS const float* mod = WSP(float, WS_MOD) + (size_t)l * 2 * 24576; const float* xin = l == 0 ? F.kin[I_X] : F.out; (void)mod; (void)xin
        { Frame F; mk_frame(F, wv); LAYER_VARS; if (l == 0) rms_phase(F, F.kin[I_X], mod + 0, mod + 4096); else rms_phase_bf(F, mod + 0, mod + 4096); }
        grid_bar(wv);
        { Frame F; mk_frame(F, wv);
          pg8::Gemm g{WSP(pg8::bf16_t, WS_XN), WSP(pg8::bf16_t, WS_WIN + l * WIN_L), M, NIN, DM}; pg8::StaticOrder S; S.init(M, NIN, F.G, F.bx);
          pg8::EpiCols E{WSP(pg8::bf16_t, WS_COLS), WSP(float, WS_LOWR)};
          pg8::gemm_phase<pg8::EpiCols, pg8::StaticOrder, true, true>(F.lds + RING_OFF, g, S, E, F.tid); }
        grid_bar(wv);
        { Frame F; mk_frame(F, wv); prep_norm(F, l); }
        { Frame F; mk_frame(F, wv); prep_loga(F, l); }
        { Frame F; mk_frame(F, wv); prep_rwkv(F, l); }
        { Frame F; mk_frame(F, wv); prep_vt<0>(F); }
        { Frame F; mk_frame(F, wv); prep_vt<1>(F); }
        { Frame F; mk_frame(F, wv); prep_vt<2>(F); }
        { Frame F; mk_frame(F, wv); prep_vt<3>(F); }
        { Frame F; mk_frame(F, wv); prep_vt<4>(F); }
        { Frame F; mk_frame(F, wv); prep_gla(F); }
        grid_bar(wv);
        { Frame F; mk_frame(F, wv); mixers_v4(F, l, l); }
        grid_bar(wv);
        { Frame F; mk_frame(F, wv); gla_post(F, l); }
        grid_bar(wv);
        { Frame F; mk_frame(F, wv); LAYER_VARS;
          pg8::Gemm g{WSP(pg8::bf16_t, WS_MIXED), WSP(pg8::bf16_t, WS_WOUT + l * WOUT_L), M, DM, DM}; pg8::StaticOrder S; S.init(M, DM, F.G, F.bx);
          pg8::EpiRes E{l == 0 ? (const void*)F.kin[I_X] : (const void*)WSP(bf16, WS_XR), (void*)WSP(bf16, WS_XR), mod + 2 * 4096, l != 0, true};
          pg8::gemm_phase<pg8::EpiRes, pg8::StaticOrder, true, true>(F.lds + RING_OFF, g, S, E, F.tid); }
        grid_bar(wv);
        { Frame F; mk_frame(F, wv); LAYER_VARS; rms_phase_bf(F, mod + 3 * 4096, mod + 4 * 4096); }
        grid_bar(wv);
        { Frame F; mk_frame(F, wv);
          pg8::Gemm g{WSP(pg8::bf16_t, WS_XN), WSP(pg8::bf16_t, WS_W13 + l * W13_L), M, 2 * DFF, DM}; pg8::StaticOrder S; S.init(M, 2 * DFF, F.G, F.bx);
          pg8::EpiSwiglu E{WSP(pg8::bf16_t, WS_HID)};
          pg8::gemm_phase<pg8::EpiSwiglu, pg8::StaticOrder, true, true>(F.lds + RING_OFF, g, S, E, F.tid); }
        grid_bar(wv);
        { Frame F; mk_frame(F, wv); LAYER_VARS;
          pg8::Gemm g{WSP(pg8::bf16_t, WS_HID), WSP(pg8::bf16_t, WS_W2 + l * W2_L), M, DM, DFF}; pg8::StaticOrder S; S.init(M, DM, F.G, F.bx);
          pg8::EpiRes E{(const void*)WSP(bf16, WS_XR), l + 1 < NLAYER ? (void*)WSP(bf16, WS_XR) : (void*)F.out, mod + 5 * 4096, true, l + 1 < NLAYER};
          pg8::gemm_phase<pg8::EpiRes, pg8::StaticOrder, true, true>(F.lds + RING_OFF, g, S, E, F.tid); }
        if (l + 1 < NLAYER) grid_bar(wv);
#undef LAYER_VARS
    }
}

extern "C" void kernel_launch(void* const* d_in, const int* in_sizes, int n_in, void* d_out, int out_size, void* d_ws, size_t ws_size, hipStream_t stream) {
    static int grid = 0;
    if (grid == 0) {
        if (n_in != 35 || in_sizes[0] != M * DM || out_size != M * DM || ws_size < WS_END) { fprintf(stderr, "kernel_launch: unexpected shapes: n_in %d in0 %d out %d ws %zu (need %zu)\n", n_in, n_in > 0 ? in_sizes[0] : -1, out_size, ws_size, (size_t)WS_END); grid = -1; return; }
        int dev = 0, cus = 0, per_cu = 0;
        if (hipGetDevice(&dev) != hipSuccess || hipDeviceGetAttribute(&cus, hipDeviceAttributeMultiprocessorCount, dev) != hipSuccess) { grid = -1; return; }
        if (hipFuncSetAttribute((const void*)mega_fwd, hipFuncAttributeMaxDynamicSharedMemorySize, LDS_BYTES) != hipSuccess) { fprintf(stderr, "kernel_launch: hipFuncSetAttribute failed\n"); grid = -1; return; }
        if (hipOccupancyMaxActiveBlocksPerMultiprocessor(&per_cu, (const void*)mega_fwd, NWAVES * 64, LDS_BYTES) != hipSuccess || per_cu < 1) fprintf(stderr, "kernel_launch: occupancy query says %d\n", per_cu);
        (void)hipGetLastError();
        grid = cus;
    }
    if (grid < 0) return;
    if (hipMemsetAsync((char*)d_ws + WS_CTL, 0, CTL_ZERO_BYTES, stream) != hipSuccess) return;
    Args a{};
    for (int i = 0; i < 35; ++i) a.in[i] = (const float*)d_in[i];
    a.out = (float*)d_out; a.ws = (unsigned char*)d_ws;
    hipLaunchKernelGGL(mega_fwd, dim3(grid), dim3(NWAVES * 64), LDS_BYTES, stream, a);
}
```
